# Optimizing an MI355X kernel written in HIP

```python
import jax, jax.numpy as jnp
from jax import lax
import numpy as np

D_MODEL = 1024
BATCH = 8
SEQ = 4096
DEPTH = 2

GRID_W = 64
CTX_LEN = 256
N_EVEN = (DEPTH + 1) // 2
N_ODD = DEPTH // 2
N_MOD = 6
EPS = 1e-6

FOURIER_HEADS = 4
FOURIER_HEAD_DIM = D_MODEL // 8
FOURIER_WIDTH = FOURIER_HEADS * FOURIER_HEAD_DIM
CONV_HEADS = 4
CONV_WIDTH = D_MODEL // 2
CONV_K = 3
EVEN_IN = FOURIER_WIDTH + 3 * CONV_WIDTH
EVEN_MIX = FOURIER_WIDTH + CONV_WIDTH

POOL_WINDOWS = (2, 4, 8, 16)
POOL_GROUPS = 4
POOL_GROUP_DIM = D_MODEL // 8
POOL_WIDTH = POOL_GROUPS * POOL_GROUP_DIM
HEAD_DIM = 64
N_Q_HEADS = (D_MODEL // 2) // HEAD_DIM
N_KV_HEADS = N_Q_HEADS // 4
Q_PER_KV = N_Q_HEADS // N_KV_HEADS
ATTN_WIDTH = N_Q_HEADS * HEAD_DIM
KV_WIDTH = N_KV_HEADS * HEAD_DIM
ODD_IN = POOL_WIDTH + ATTN_WIDTH + 2 * KV_WIDTH
ODD_MIX = POOL_WIDTH + ATTN_WIDTH
WINDOW = 128
BLOCK = 128
ROPE_THETA = 10000.0

N_EXPERTS = 16
N_GROUPS = 4
EXPERTS_PER_GROUP = N_EXPERTS // N_GROUPS
TOP_K = 2
D_EXPERT = D_MODEL // 2

kernel_name = "hybrid_fourier_conv_pool_swa_moe_dit"


def rmsnorm(x, g):
    xf = x.astype(jnp.float32)
    y = xf * lax.rsqrt(jnp.mean(xf * xf, axis=-1, keepdims=True) + EPS)
    return (y * g.astype(jnp.float32)).astype(x.dtype)


def modulate(h, shift, scale):
    return h * (1 + scale) + shift


def ada_mod(s, w, b):
    return jnp.split(s @ w + b, N_MOD, axis=-1)


def fourier_mix(u):
    f = jnp.fft.fft2(u.astype(jnp.float32), axes=(1, 3), norm="ortho")
    return jnp.real(f).astype(u.dtype)


def short_conv(u, w):
    n = u.shape[1]
    p = CONV_K // 2
    up = jnp.pad(u, ((0, 0), (p, p), (0, 0)))
    out = up[:, 0:n] * w[0]
    for k in range(1, CONV_K):
        out = out + up[:, k:k + n] * w[k]
    return out


def even_mixer(h, w_in, conv_w, w_out):
    b, n, _ = h.shape
    proj = h @ w_in
    u_f, g_b, g_c, u_c = jnp.split(
        proj, [FOURIER_WIDTH, FOURIER_WIDTH + CONV_WIDTH, FOURIER_WIDTH + 2 * CONV_WIDTH], axis=-1)
    y_f = fourier_mix(u_f.reshape(b, n, FOURIER_HEADS, FOURIER_HEAD_DIM)).reshape(b, n, FOURIER_WIDTH)
    y_c = g_b * short_conv(g_c * u_c, conv_w)
    return jnp.concatenate([y_f, y_c], axis=-1) @ w_out


def multiscale_pool(u):
    n = u.shape[1]
    uf = u.astype(jnp.float32)
    cs = jnp.pad(jnp.cumsum(uf, axis=1), ((0, 0), (1, 0), (0, 0)))
    t = jnp.arange(n)
    outs = []
    for gi, w in enumerate(POOL_WINDOWS):
        r = w // 2
        lo = jnp.clip(t - r, 0, n)
        hi = jnp.clip(t + r + 1, 0, n)
        sl = slice(gi * POOL_GROUP_DIM, (gi + 1) * POOL_GROUP_DIM)
        seg = cs[:, :, sl]
        cnt = (hi - lo).astype(jnp.float32)[None, :, None]
        outs.append((seg[:, hi] - seg[:, lo]) / cnt - uf[:, :, sl])
    return jnp.concatenate(outs, axis=-1).astype(u.dtype)


def pool_branch(u, pool_w, pool_scale):
    b, n, _ = u.shape
    p = multiscale_pool(u).reshape(b, n, POOL_GROUPS, POOL_GROUP_DIM)
    y = jnp.einsum('bngc,gcd->bngd', p, pool_w).reshape(b, n, POOL_WIDTH)
    return y * pool_scale


def axial_rope_tables(row_ids, col_ids):
    quarter = HEAD_DIM // 4
    inv = ROPE_THETA ** (-jnp.arange(quarter, dtype=jnp.float32) / quarter)
    ang = jnp.stack([row_ids.astype(jnp.float32)[:, None] * inv,
                     col_ids.astype(jnp.float32)[:, None] * inv], axis=1)
    return jnp.cos(ang), jnp.sin(ang)


def apply_rope(x, cos, sin):
    xf = x.astype(jnp.float32).reshape(*x.shape[:-1], 2, 2, HEAD_DIM // 4)
    x1, x2 = xf[..., 0, :], xf[..., 1, :]
    c = cos[None, :, None]
    s = sin[None, :, None]
    out = jnp.stack([x1 * c - x2 * s, x2 * c + x1 * s], axis=-2)
    return out.reshape(x.shape).astype(x.dtype)


def latent_attention(q, k, v, k_ctx, v_ctx, sink):
    b, n, _, _ = q.shape
    nb = n // BLOCK
    span = 3 * BLOCK
    scale = HEAD_DIM ** -0.5
    qb = q.reshape(b, nb, BLOCK, N_KV_HEADS, Q_PER_KV, HEAD_DIM)
    pad = ((0, 0), (BLOCK, BLOCK), (0, 0), (0, 0))
    kp, vp = jnp.pad(k, pad), jnp.pad(v, pad)

    def band(z):
        return jnp.concatenate(
            [z[:, i * BLOCK:i * BLOCK + n].reshape(b, nb, BLOCK, N_KV_HEADS, HEAD_DIM) for i in range(3)],
            axis=2)

    kb, vb = band(kp), band(vp)
    s_lat = jnp.einsum('bnqkgd,bnskd->bnkgqs', qb, kb).astype(jnp.float32) * scale
    qi = jnp.arange(BLOCK)[:, None]
    kj = jnp.arange(span)[None, :]
    rel = kj - BLOCK - qi
    key_pos = jnp.arange(nb)[:, None, None] * BLOCK - BLOCK + kj[None]
    valid = (jnp.abs(rel) <= WINDOW)[None] & (key_pos >= 0) & (key_pos < n)
    s_lat = jnp.where(valid[None, :, None, None], s_lat, -jnp.inf)
    s_ctx = jnp.einsum('bnqkgd,blkd->bnkgql', qb, k_ctx).astype(jnp.float32) * scale
    sink_b = jnp.broadcast_to(
        sink.astype(jnp.float32).reshape(N_KV_HEADS, Q_PER_KV)[None, None, :, :, None, None],
        (b, nb, N_KV_HEADS, Q_PER_KV, BLOCK, 1))
    p = jax.nn.softmax(jnp.concatenate([s_lat, s_ctx, sink_b], axis=-1), axis=-1)
    l = k_ctx.shape[1]
    p_lat = p[..., :span].astype(v.dtype)
    p_ctx = p[..., span:span + l].astype(v.dtype)
    o = (jnp.einsum('bnkgqs,bnskd->bnqkgd', p_lat, vb)
         + jnp.einsum('bnkgql,blkd->bnqkgd', p_ctx, v_ctx))
    return o.reshape(b, n, ATTN_WIDTH)


def context_attention(q, k, v, sink):
    b, l, _, _ = q.shape
    scale = HEAD_DIM ** -0.5
    qg = q.reshape(b, l, N_KV_HEADS, Q_PER_KV, HEAD_DIM)
    s = jnp.einsum('blkgd,bmkd->bkglm', qg, k).astype(jnp.float32) * scale
    sink_b = jnp.broadcast_to(
        sink.astype(jnp.float32).reshape(N_KV_HEADS, Q_PER_KV)[None, :, :, None, None],
        (b, N_KV_HEADS, Q_PER_KV, l, 1))
    p = jax.nn.softmax(jnp.concatenate([s, sink_b], axis=-1), axis=-1)[..., :l].astype(v.dtype)
    o = jnp.einsum('bkglm,bmkd->blkgd', p, v)
    return o.reshape(b, l, ATTN_WIDTH)


def odd_mixer(a, ac, cos, sin, w_in, pool_w, pool_scale, sink, w_out, need_ctx):
    b, n, _ = a.shape
    l = ac.shape[1]
    kv0 = POOL_WIDTH + ATTN_WIDTH
    proj = a @ w_in
    u_pool = proj[..., :POOL_WIDTH]
    q = apply_rope(proj[..., POOL_WIDTH:kv0].reshape(b, n, N_Q_HEADS, HEAD_DIM), cos, sin)
    k = apply_rope(proj[..., kv0:kv0 + KV_WIDTH].reshape(b, n, N_KV_HEADS, HEAD_DIM), cos, sin)
    v = proj[..., kv0 + KV_WIDTH:].reshape(b, n, N_KV_HEADS, HEAD_DIM)
    if need_ctx:
        proj_c = ac @ w_in
        kv_c = proj_c[..., kv0:]
    else:
        kv_c = ac @ w_in[:, kv0:]
    k_c = kv_c[..., :KV_WIDTH].reshape(b, l, N_KV_HEADS, HEAD_DIM)
    v_c = kv_c[..., KV_WIDTH:].reshape(b, l, N_KV_HEADS, HEAD_DIM)
    y = jnp.concatenate([pool_branch(u_pool, pool_w, pool_scale),
                         latent_attention(q, k, v, k_c, v_c, sink)], axis=-1) @ w_out
    if need_ctx:
        q_c = proj_c[..., POOL_WIDTH:kv0].reshape(b, l, N_Q_HEADS, HEAD_DIM)
        yc = jnp.concatenate([pool_branch(proj_c[..., :POOL_WIDTH], pool_w, pool_scale),
                              context_attention(q_c, k_c, v_c, sink)], axis=-1) @ w_out
        return y, yc
    return y, None


def grouped_moe(h, router_w, router_b, w_gate, w_up, w_down):
    t = h.shape[0]
    aff = jax.nn.sigmoid((h @ router_w).astype(jnp.float32))
    sel = aff + router_b.astype(jnp.float32)
    group_score = lax.top_k(sel.reshape(t, N_GROUPS, EXPERTS_PER_GROUP), 2)[0].sum(-1)
    best = jnp.argmax(group_score, axis=-1)
    in_group = (jnp.arange(N_EXPERTS) // EXPERTS_PER_GROUP)[None, :] == best[:, None]
    _, idx = lax.top_k(jnp.where(in_group, sel, -jnp.inf), TOP_K)
    w_sel = jnp.take_along_axis(aff, idx, axis=-1)
    w_sel = w_sel / jnp.sum(w_sel, axis=-1, keepdims=True)
    combine = jnp.sum(jax.nn.one_hot(idx, N_EXPERTS, dtype=jnp.float32) * w_sel[..., None], axis=1)
    combine = combine.astype(h.dtype)
    out = jnp.zeros_like(h)
    for e in range(N_EXPERTS):
        hid = jax.nn.silu(h @ w_gate[e]) * (h @ w_up[e])
        out = out + combine[:, e:e + 1] * (hid @ w_down[e])
    return out


def setup_inputs(seed: int = 0) -> dict:
    key = jax.random.key(seed)
    ks = jax.random.split(key, 24)
    f32 = jnp.float32
    nrm = lambda k, shape, s: jax.random.normal(k, shape, f32) * s
    D = D_MODEL
    return {
        "x": nrm(ks[0], (BATCH, SEQ, D), 1.0),
        "c": nrm(ks[1], (BATCH, D), 1.0),
        "ctx": nrm(ks[2], (BATCH, CTX_LEN, D), 1.0),
        "c_ctx": nrm(ks[3], (D,), 1.0),
        "ada_w": nrm(ks[4], (DEPTH, D, N_MOD * D), 0.5 * D ** -0.5),
        "ada_b": nrm(ks[5], (DEPTH, N_MOD * D), 0.02),
        "norm_mix_g": 1.0 + nrm(ks[6], (DEPTH, D), 0.02),
        "norm_ffn_g": 1.0 + nrm(ks[7], (DEPTH, D), 0.02),
        "even_w_in": nrm(ks[8], (N_EVEN, D, EVEN_IN), D ** -0.5),
        "even_conv_w": nrm(ks[9], (N_EVEN, CONV_K, CONV_WIDTH), CONV_K ** -0.5),
        "even_w_out": nrm(ks[10], (N_EVEN, EVEN_MIX, D), EVEN_MIX ** -0.5),
        "odd_w_in": nrm(ks[11], (N_ODD, D, ODD_IN), D ** -0.5),
        "odd_pool_w": nrm(ks[12], (N_ODD, POOL_GROUPS, POOL_GROUP_DIM, POOL_GROUP_DIM), POOL_GROUP_DIM ** -0.5),
        "odd_pool_scale": 1.0 + nrm(ks[13], (N_ODD, POOL_WIDTH), 0.02),
        "odd_sink": nrm(ks[14], (N_ODD, N_Q_HEADS), 0.5),
        "odd_w_out": nrm(ks[15], (N_ODD, ODD_MIX, D), ODD_MIX ** -0.5),
        "router_w": nrm(ks[16], (D, N_EXPERTS), D ** -0.5),
        "router_b": nrm(ks[17], (N_EXPERTS,), 0.01),
        "moe_w_gate": nrm(ks[18], (DEPTH, N_EXPERTS, D, D_EXPERT), D ** -0.5),
        "moe_w_up": nrm(ks[19], (DEPTH, N_EXPERTS, D, D_EXPERT), D ** -0.5),
        "moe_w_down": nrm(ks[20], (DEPTH, N_EXPERTS, D_EXPERT, D), D_EXPERT ** -0.5),
        "final_g": 1.0 + nrm(ks[21], (D,), 0.02),
    }


def reference(x, c, ctx, c_ctx, ada_w, ada_b, norm_mix_g, norm_ffn_g,
              even_w_in, even_conv_w, even_w_out,
              odd_w_in, odd_pool_w, odd_pool_scale, odd_sink, odd_w_out,
              router_w, router_b, moe_w_gate, moe_w_up, moe_w_down, final_g):
    b, n, d = x.shape
    l = ctx.shape[1]
    rows = n // GRID_W
    row_ids = jnp.repeat(jnp.arange(rows), GRID_W)
    col_ids = jnp.tile(jnp.arange(GRID_W), rows)
    cos, sin = axial_rope_tables(row_ids, col_ids)
    s_lat = jax.nn.silu(c)
    s_ctx = jax.nn.silu(c_ctx)
    h, hc = x, ctx
    for layer in range(DEPTH):
        last = layer == DEPTH - 1
        j = layer // 2
        m = [z[:, None, :] for z in ada_mod(s_lat, ada_w[layer], ada_b[layer])]
        mc = ada_mod(s_ctx, ada_w[layer], ada_b[layer])
        a = modulate(rmsnorm(h, norm_mix_g[layer]), m[0], m[1])
        if layer % 2 == 0:
            y = even_mixer(a, even_w_in[j], even_conv_w[j], even_w_out[j])
            if not last:
                ac = modulate(rmsnorm(hc, norm_mix_g[layer]), mc[0], mc[1])
                yc = even_mixer(ac, even_w_in[j], even_conv_w[j], even_w_out[j])
        else:
            ac = modulate(rmsnorm(hc, norm_mix_g[layer]), mc[0], mc[1])
            y, yc = odd_mixer(a, ac, cos, sin, odd_w_in[j], odd_pool_w[j], odd_pool_scale[j],
                              odd_sink[j], odd_w_out[j], not last)
        h = h + m[2] * y
        f = modulate(rmsnorm(h, norm_ffn_g[layer]), m[3], m[4])
        if not last:
            hc = hc + mc[2] * yc
            fc = modulate(rmsnorm(hc, norm_ffn_g[layer]), mc[3], mc[4])
            tokens = jnp.concatenate([f.reshape(b * n, d), fc.reshape(b * l, d)], axis=0)
            out = grouped_moe(tokens, router_w, router_b,
                              moe_w_gate[layer], moe_w_up[layer], moe_w_down[layer])
            h = h + m[5] * out[:b * n].reshape(b, n, d)
            hc = hc + mc[5] * out[b * n:].reshape(b, l, d)
        else:
            out = grouped_moe(f.reshape(b * n, d), router_w, router_b,
                              moe_w_gate[layer], moe_w_up[layer], moe_w_down[layer])
            h = h + m[5] * out.reshape(b, n, d)
    return rmsnorm(h, final_g)
```

```cpp
#include <hip/hip_runtime.h>
#include <cstdio>
#include <cstdint>
#include <type_traits>

#ifndef MK_MULTI
#define MK_MULTI 0
#endif
#ifndef DBG_STOP
#define DBG_STOP 16
#endif

#ifndef DBG_DOUBLE
#define DBG_DOUBLE 0u
#endif
#ifndef FP8_G1_L0
#define FP8_G1_L0 1
#endif
#ifndef FP8_G1_L1
#define FP8_G1_L1 1
#endif
#ifndef FP8_G2_L0
#define FP8_G2_L0 1
#endif
#ifndef FP8_G2_L1
#define FP8_G2_L1 1
#endif
#define LAS __attribute__((address_space(3)))
#define GAS __attribute__((address_space(1)))
typedef unsigned short bf16;
typedef short bf16x8 __attribute__((ext_vector_type(8)));
typedef short s16x4 __attribute__((ext_vector_type(4)));
typedef float f32x4 __attribute__((ext_vector_type(4)));
typedef float f32x16 __attribute__((ext_vector_type(16)));
typedef unsigned u32x4 __attribute__((ext_vector_type(4)));
typedef unsigned u32x2 __attribute__((ext_vector_type(2)));

constexpr int NB = 8, NSEQ = 4096, D = 1024, LCTX = 256;
constexpr int TL = NB * NSEQ, TC = NB * LCTX, T = TL + TC;
constexpr int EIN = 2048;
constexpr int OIN = 1280;
constexpr int NE = 16, DE = 512;
constexpr int MAXSLOT = 73728;
constexpr float EPS = 1e-6f;

constexpr size_t KiB = 1024, MiB = 1024 * 1024;
constexpr size_t WS_CTL = 0, CTL_ZERO_BYTES = 64 * KiB;
constexpr size_t WS_MODS = 64 * KiB;
constexpr size_t WS_ROPE = WS_MODS + 512 * KiB;
constexpr size_t WS_WA = WS_ROPE + 8 * KiB;
constexpr size_t WS_WAC = WS_WA + 32 * KiB;
constexpr size_t WS_WCC = WS_WAC + 2 * KiB;
constexpr size_t WS_FD = 3 * MiB - 64 * KiB;
constexpr size_t WS_BCNT = WS_WCC + 16 * KiB;
constexpr size_t WS_TILEMAP = WS_BCNT + 16 * KiB;
constexpr size_t WS_SLOT = WS_TILEMAP + 2 * KiB;
constexpr size_t WS_WROW = WS_SLOT + 288 * KiB;
constexpr size_t WS_ROUTE = WS_WROW + 288 * KiB;
constexpr size_t WS_WC = 3 * MiB;
constexpr size_t WS_W_EIN = 4 * MiB;
constexpr size_t WS_W_EOUT = 9 * MiB;
constexpr size_t WS_W_OIN = 11 * MiB;
constexpr size_t WS_W_OOUT = 14 * MiB;
constexpr size_t WS_W_POOL = 16 * MiB;
constexpr size_t WS_W_M1 = 17 * MiB;
constexpr size_t WS_W_M2 = 81 * MiB;
constexpr size_t WS_HC = 113 * MiB;
constexpr size_t WS_BUFA = 121 * MiB;
constexpr size_t WS_BUFP = 189 * MiB;
constexpr size_t WS_BUFZ = 360 * MiB;
constexpr size_t WS_TOKMAP = 432 * MiB;
constexpr size_t WS_HB = 435 * MiB;
constexpr size_t WS_END = 503 * MiB;
constexpr size_t WS_GCNT = 16 * KiB;
static_assert(WS_ROUTE + (size_t)T * 32 <= WS_WC, "small region");
static_assert((size_t)T * EIN * 2 <= WS_BUFZ - WS_BUFP && (size_t)MAXSLOT * 1024 * 2 <= WS_BUFZ - WS_BUFP, "BUFP");
static_assert((size_t)MAXSLOT * 512 * 2 <= WS_TOKMAP - WS_BUFZ && (size_t)T * 1024 * 2 <= WS_TOKMAP - WS_BUFZ, "BUFZ");
static_assert((size_t)16 * T * 4 <= WS_HB - WS_TOKMAP && (size_t)T * 1024 * 2 <= WS_END - WS_HB, "TOKMAP / HB");
static_assert((size_t)T * 1024 * 2 <= WS_BUFP - WS_BUFA, "BUFA");

constexpr int LDS_BYTES = 163840;
constexpr int LDS_GIDX = 147456;
constexpr int LDS_CTL = 146432;
constexpr int NWAVES = 8;

__device__ __forceinline__ unsigned f2bf(float f) { unsigned u = __builtin_bit_cast(unsigned, f); return (u + 0x7fffu + ((u >> 16) & 1u)) >> 16; }
__device__ __forceinline__ unsigned pk2(float lo, float hi) { return f2bf(lo) | (f2bf(hi) << 16); }
__device__ __forceinline__ float bflo(unsigned w) { return __builtin_bit_cast(float, w << 16); }
__device__ __forceinline__ float bfhi(unsigned w) { return __builtin_bit_cast(float, w & 0xffff0000u); }
__device__ __forceinline__ float wave_sum(float v) {
#pragma unroll
    for (int o = 1; o < 64; o <<= 1) v += __shfl_xor(v, o);
    return v;
}
__device__ __forceinline__ int ld_coh(const int* p) { return (int)__hip_atomic_load((const unsigned*)p, __ATOMIC_RELAXED, __HIP_MEMORY_SCOPE_AGENT); }
__device__ __forceinline__ float ld_cohf(const float* p) { return __builtin_bit_cast(float, __hip_atomic_load((const unsigned*)p, __ATOMIC_RELAXED, __HIP_MEMORY_SCOPE_AGENT)); }
#define LDS_WAIT() asm volatile("s_waitcnt lgkmcnt(0)" ::: "memory")

#define XB_TMO      128
#define XB_XCNT(j)  (256  + 64 * (j))
#define XB_XSUB(j)  (1280 + 64 * (j))
#define XB_XGEN(j)  (2304 + 64 * (j))
#define XB_TOP      3328
#define XB_TOPGEN   3392
#define XCD_BAR_WORDS 3456
#define XB_SPIN_CAP (1u << 18)
__device__ __forceinline__ unsigned xb_ld(unsigned* p)              { return __hip_atomic_load(p, __ATOMIC_RELAXED, __HIP_MEMORY_SCOPE_AGENT); }
__device__ __forceinline__ unsigned xb_add(unsigned* p, unsigned v) { return __hip_atomic_fetch_add(p, v, __ATOMIC_RELAXED, __HIP_MEMORY_SCOPE_AGENT); }
__device__ __forceinline__ unsigned xb_xcc_id() { return (unsigned)__builtin_amdgcn_s_getreg((3 << 11) | 20) & 0xFu; }
#define XB_SPIN(cond, bar) do { unsigned _sp = 0; while (cond) { __builtin_amdgcn_s_sleep(1); \
    if ((++_sp & 255u) == 0u) { if (xb_ld(&(bar)[XB_TMO])) break; if (_sp > XB_SPIN_CAP) { atomicAdd(&(bar)[XB_TMO], 1u); break; } } } } while (0)
struct XcdBarrier { unsigned* bar; unsigned x; volatile LAS unsigned* st; };
__device__ __forceinline__ XcdBarrier xcd_barrier_post(unsigned* bar, volatile LAS unsigned* st) {
    XcdBarrier b; b.bar = bar; b.x = xb_xcc_id(); b.st = st;
    if (threadIdx.x == 0) (void)xb_add(&bar[XB_XCNT(b.x)], 1u);
    return b;
}
__device__ __forceinline__ void xcd_barrier_complete(unsigned* bar, unsigned x, unsigned& nloc, unsigned& nx) {
    const unsigned G = gridDim.x * gridDim.y * gridDim.z;
    unsigned sum, cnt, mine, sp = 0u;
    for (;;) {
        sum = 0u; cnt = 0u; mine = 0u;
#pragma unroll
        for (unsigned j = 0; j < 16; ++j) { const unsigned c = xb_ld(&bar[XB_XCNT(j)]); sum += c; cnt += (c > 0u) ? 1u : 0u; mine = (j == x) ? c : mine; }
        if (sum == G) break;
        __builtin_amdgcn_s_sleep(1);
        if ((++sp & 255u) == 0u) { if (xb_ld(&bar[XB_TMO])) break; if (sp > XB_SPIN_CAP) { atomicAdd(&bar[XB_TMO], 1u); break; } }
    }
    nloc = mine > 0u ? mine : 1u; nx = cnt > 0u ? cnt : 1u;
}
__device__ __forceinline__ void xcd_barrier(const XcdBarrier& b) {
    asm volatile("s_waitcnt vmcnt(0)" ::: "memory");
    __syncthreads();
    if (threadIdx.x == 0) {
        unsigned* bar = b.bar;
        __builtin_amdgcn_s_waitcnt(0);
        unsigned nloc = b.st[0], nx = b.st[1];
        if (nloc == 0u) { xcd_barrier_complete(bar, b.x, nloc, nx); b.st[0] = nloc; b.st[1] = nx; }
        const unsigned old = xb_add(&bar[XB_XSUB(b.x)], 1u);
        const unsigned gen = old / nloc;
        if (old + 1u == (gen + 1u) * nloc) {
            __builtin_amdgcn_fence(__ATOMIC_RELEASE, "agent");
            asm volatile("s_waitcnt vmcnt(0)" ::: "memory");
            const unsigned og = xb_add(&bar[XB_TOP], 1u);
            const unsigned tg = og / nx;
            if (og + 1u == (tg + 1u) * nx) xb_add(&bar[XB_TOPGEN], 1u);
            else XB_SPIN(xb_ld(&bar[XB_TOPGEN]) == tg, bar);
            __builtin_amdgcn_fence(__ATOMIC_ACQUIRE, "agent");
            xb_add(&bar[XB_XGEN(b.x)], 1u);
            asm volatile("s_waitcnt vmcnt(0)" ::: "memory");
        } else {
            XB_SPIN(xb_ld(&bar[XB_XGEN(b.x)]) == gen, bar);
            __builtin_amdgcn_fence(__ATOMIC_ACQUIRE, "agent");
            asm volatile("s_waitcnt vmcnt(0)" ::: "memory");
        }
    }
    __syncthreads();
}

namespace pg8 {
constexpr int BM = 256, BK = 64, HALF = 128, HTB = HALF * BK * 2, STAGE_BYTES = 8 * HTB;
__host__ __device__ __forceinline__ int lds_byte(int r, int c) { const int st = (r >> 4) * 2 + (c >> 5), rr = r & 15, cc = c & 31, ob = rr * 64 + cc * 2; return st * 1024 + (ob ^ (((ob >> 9) & 1) << 5)); }
__host__ __device__ __forceinline__ void stage_rc(int b, int& R, int& C) { const int st = b / 1024, sb = b % 1024, swz = sb ^ (((sb >> 9) & 1) << 5); R = (st >> 1) * 16 + swz / 64; C = (st & 1) * 32 + (swz % 64) / 2; }
__host__ __device__ __forceinline__ int perm32(int rho) { const int n = rho >> 4, i = rho & 15; return 8 * (i >> 2) + 4 * n + (i & 3); }
struct Unit { int pm, pn, e; };
__device__ __forceinline__ unsigned cvt_pk_bf16(float lo, float hi) { unsigned r; asm volatile("v_cvt_pk_bf16_f32 %0, %1, %2" : "=v"(r) : "v"(lo), "v"(hi)); return r; }

typedef int v8i32 __attribute__((ext_vector_type(8)));
typedef int v4i32 __attribute__((ext_vector_type(4)));
__device__ __forceinline__ v8i32 cat16(const bf16x8 lo, const bf16x8 hi) { return __builtin_shufflevector(__builtin_bit_cast(v4i32, lo), __builtin_bit_cast(v4i32, hi), 0, 1, 2, 3, 4, 5, 6, 7); }
template <class Epi, class Sched, bool FP8 = false>
__device__ __forceinline__ void gemm_phase(LAS unsigned char* lds, const int K, const Sched& S, const Epi& E) {
    const int tid = threadIdx.x, wid = __builtin_amdgcn_readfirstlane(tid >> 6), lane = tid & 63, wr = wid >> 2, wc = wid & 3, fr = lane & 15, fq = lane >> 4;
    const int nt = K / BK;
    int tidv = tid;
#define PG8_VB(i) ([&]() -> unsigned { int R_, C_; stage_rc(tidv * 16 + (i) * 8192, R_, C_); const int Rb_ = Epi::PERM ? ((R_ & ~31) + perm32(R_ & 31)) : R_; return (unsigned)(Rb_ * K + C_) * 2u; }())
#define PG8_VA(h, i) ([&]() -> unsigned { int R_, C_; stage_rc(tidv * 16 + (i) * 8192, R_, C_); return (unsigned)((128 * (h) + R_) * K + C_) * 2u; }())
    const size_t kstep = (size_t)(BK * 2);
    const size_t hstep = (size_t)HALF * K * 2;
    const unsigned ldsw = (unsigned)wid * 1024u;
#define aoff (lds_byte(wr * 64 + (tidv & 15), ((tidv >> 4) & 3) * 8))
#define boff (lds_byte(wc * 32 + (tidv & 15), ((tidv >> 4) & 3) * 8))
#define PG8_SA(b, h) (((b) * 2 + (h)) * HTB)
#define PG8_SB(b, h) ((4 + (b) * 2 + (h)) * HTB)
#define PG8_STAGEB(bufoff, gbase) do { _Pragma("unroll") for (int _i = 0; _i < 2; ++_i) \
        __builtin_amdgcn_global_load_lds((const unsigned*)((const char*)(gbase) + PG8_VB(_i)), (LAS unsigned*)(lds + (bufoff) + ldsw + _i * 8192), 16, 0, 0); } while (0)
#define PG8_STAGEA(bufoff, gbase, h, NEXT) do { _Pragma("unroll") for (int _i = 0; _i < 2; ++_i) { unsigned vo_; \
        if constexpr (Sched::GATHER) { int R_, C_; stage_rc(tidv * 16 + _i * 8192, R_, C_); const unsigned raw_ = gidx[((((NEXT) && usen) ? (gslot ^ 1u) : gslot) * 4u + (h) * 2 + _i) * 512u + tid]; vo_ = (raw_ * (unsigned)K + (unsigned)C_) * 2u; } \
        else vo_ = PG8_VA(h, _i); \
        __builtin_amdgcn_global_load_lds((const unsigned*)((const char*)(gbase) + vo_), (LAS unsigned*)(lds + (bufoff) + ldsw + _i * 8192), 16, 0, 0); } } while (0)
#define PG8_LDA(dst, b, h) do { _Pragma("unroll") for (int m = 0; m < 4; ++m) _Pragma("unroll") for (int k = 0; k < 2; ++k) dst[m][k] = *(const LAS bf16x8*)(lds + PG8_SA(b, h) + aoff + m * 2048 + k * 1024); } while (0)
#define PG8_LDB(dst, b, h) do { _Pragma("unroll") for (int n = 0; n < 2; ++n) _Pragma("unroll") for (int k = 0; k < 2; ++k) dst[n][k] = *(const LAS bf16x8*)(lds + PG8_SB(b, h) + boff + n * 2048 + k * 1024); } while (0)
#define PG8_MMA(ai, bj, At, Bt) do { __builtin_amdgcn_s_setprio(1); _Pragma("unroll") for (int m = 0; m < 4; ++m) _Pragma("unroll") for (int n = 0; n < 2; ++n) { \
        if constexpr (FP8) acc[ai][bj][m][n] = __builtin_amdgcn_mfma_scale_f32_16x16x128_f8f6f4(cat16(Bt[n][0], Bt[n][1]), cat16(At[m][0], At[m][1]), acc[ai][bj][m][n], 0, 0, 0, 0x7f7f7f7f, 0, 0x7f7f7f7f); \
        else { _Pragma("unroll") for (int k = 0; k < 2; ++k) acc[ai][bj][m][n] = __builtin_amdgcn_mfma_f32_16x16x32_bf16(Bt[n][k], At[m][k], acc[ai][bj][m][n], 0, 0, 0); } } \
        __builtin_amdgcn_s_setprio(0); } while (0)
#define PG8_WAIT_V(n) asm volatile("s_waitcnt vmcnt(" #n ")" ::: "memory")
#define PG8_WAIT_L(n) asm volatile("s_waitcnt lgkmcnt(" #n ")" ::: "memory")
#define PG8_BAR __builtin_amdgcn_s_barrier()
#define PG8_SCHED __builtin_amdgcn_sched_barrier(0)
#define PG8_ITER(A1, A2, A3, B2, B3) do { \
            PG8_LDB(B0, 0, 0); PG8_LDB(B1, 0, 1); PG8_SCHED; PG8_LDA(At, 0, 0); PG8_STAGEA(PG8_SA(1, 1), A1, 1, 0); \
            PG8_WAIT_V(8); PG8_WAIT_L(0); PG8_BAR; PG8_MMA(0, 0, At, B0); PG8_MMA(0, 1, At, B1); PG8_BAR; PG8_SCHED; \
            PG8_LDA(At, 0, 1); PG8_STAGEB(PG8_SB(0, 0), B2); PG8_STAGEB(PG8_SB(0, 1), (B2) + hstep); PG8_STAGEA(PG8_SA(0, 0), A2, 0, 1); \
            PG8_WAIT_V(8); PG8_WAIT_L(0); PG8_BAR; PG8_MMA(1, 0, At, B0); PG8_MMA(1, 1, At, B1); PG8_BAR; PG8_SCHED; \
            PG8_LDB(B0, 1, 0); PG8_LDB(B1, 1, 1); PG8_SCHED; PG8_LDA(At, 1, 0); PG8_STAGEA(PG8_SA(0, 1), A2, 1, 1); \
            PG8_WAIT_V(8); PG8_WAIT_L(0); PG8_BAR; PG8_MMA(0, 0, At, B0); PG8_MMA(0, 1, At, B1); PG8_BAR; PG8_SCHED; \
            PG8_LDA(At, 1, 1); PG8_STAGEB(PG8_SB(1, 0), B3); PG8_STAGEB(PG8_SB(1, 1), (B3) + hstep); PG8_STAGEA(PG8_SA(1, 0), A3, 0, 1); \
            PG8_WAIT_V(8); PG8_WAIT_L(0); PG8_BAR; PG8_MMA(1, 0, At, B0); PG8_MMA(1, 1, At, B1); PG8_BAR; PG8_SCHED; } while (0)
    Unit cur, nxt; int ui = 0;
    if (!S.next(0, cur)) return;
    f32x4 acc[2][2][4][2];
#pragma unroll
    for (int a = 0; a < 2; ++a)
#pragma unroll
        for (int b = 0; b < 2; ++b)
#pragma unroll
            for (int m = 0; m < 4; ++m)
#pragma unroll
                for (int n = 0; n < 2; ++n) acc[a][b][m][n] = (f32x4){0.f, 0.f, 0.f, 0.f};
    bf16x8 At[4][2], B0[2][2], B1[2][2];
    const LAS unsigned* gidx = (const LAS unsigned*)(lds + LDS_GIDX); unsigned gslot = 0u;
    if constexpr (Sched::GATHER) { S.idx_dma(cur, (LAS unsigned*)(lds + LDS_GIDX), tidv, wid); asm volatile("s_waitcnt vmcnt(0)" ::: "memory"); }
    const char* cA = S.a_base(cur); const char* cB = S.b_base(cur);
    constexpr bool usen = false;
    PG8_STAGEB(PG8_SB(0, 0), cB); PG8_STAGEB(PG8_SB(0, 1), cB + hstep); PG8_STAGEA(PG8_SA(0, 0), cA, 0, 0); PG8_STAGEA(PG8_SA(0, 1), cA, 1, 0);
    if (wr == 1) PG8_BAR;
    PG8_WAIT_V(2); PG8_BAR;
    PG8_STAGEB(PG8_SB(1, 0), cB + kstep); PG8_STAGEA(PG8_SA(1, 0), cA + kstep, 0, 0); PG8_STAGEB(PG8_SB(1, 1), cB + hstep + kstep);
    PG8_WAIT_V(6); PG8_BAR;
    for (;;) {
        const bool has_next = S.next(ui + 1, nxt);
        const char* nA = has_next ? S.a_base(nxt) : cA; const char* nB = has_next ? S.b_base(nxt) : cB;
#pragma unroll 1
        for (int t = 0; t < nt; t += 2) {
            const bool last = (t == nt - 2);
            const char* a1 = cA + (size_t)(t + 1) * kstep;
            const char* a2 = last ? nA : cA + (size_t)(t + 2) * kstep; const char* b2 = last ? nB : cB + (size_t)(t + 2) * kstep;
            tidv = tid; asm volatile("" : "+v"(tidv));
            if constexpr (Sched::GATHER) {
                if (t == nt - 4 && has_next) S.idx_dma(nxt, (LAS unsigned*)(lds + LDS_GIDX) + (gslot ^ 1u) * 2048u, tidv, wid);
            }
            const bool usen = last && has_next;
            PG8_ITER(a1, a2, a2 + kstep, b2, b2 + kstep);
        }
        if (wr == 0) PG8_BAR;
        E(acc, cur, wr, wc, fr, fq);
        if (!has_next) break;
#pragma unroll
        for (int a = 0; a < 2; ++a)
#pragma unroll
            for (int b = 0; b < 2; ++b)
#pragma unroll
                for (int m = 0; m < 4; ++m)
#pragma unroll
                    for (int n = 0; n < 2; ++n) acc[a][b][m][n] = (f32x4){0.f, 0.f, 0.f, 0.f};
        cur = nxt; cA = nA; cB = nB; ++ui;
        if constexpr (Sched::GATHER) gslot ^= 1u;
        if (wr == 1) PG8_BAR;
    }
    PG8_WAIT_V(0);
    PG8_BAR;
#undef PG8_ITER
#undef aoff
#undef boff
#undef PG8_SA
#undef PG8_SB
#undef PG8_STAGEA
#undef PG8_STAGEB
#undef PG8_VA
#undef PG8_VB
#undef PG8_LDA
#undef PG8_LDB
#undef PG8_MMA
#undef PG8_WAIT_V
#undef PG8_WAIT_L
#undef PG8_BAR
#undef PG8_SCHED
}

struct SchedDense {
    static constexpr bool GATHER = false;
    const char* A; const char* Bt; int K, nN, nMfull, pnx, nUnits, c, G;
    __device__ __forceinline__ bool next(int i, Unit& u) const {
        const int L = i * G + c; if (L >= nUnits) return false;
        const int full = nMfull * nN;
        if (L < full) { u.pm = L / nN; u.pn = L - u.pm * nN; } else { u.pm = nMfull + (L - full); u.pn = pnx; }
        u.e = 0; return true;
    }
    __device__ __forceinline__ const char* a_base(const Unit& u) const { return A + (size_t)u.pm * 256 * K * 2; }
    __device__ __forceinline__ const char* b_base(const Unit& u) const { return Bt + (size_t)u.pn * 256 * K * 2; }
};
template <bool GATHER_> struct SchedMoe {
    static constexpr bool GATHER = GATHER_, gather = GATHER_;
    const char* A; const char* W; const int* tokmap; const LAS int* tb; const LAS int* cn; int K; size_t wstride; int nUnits, c, G;
    __device__ __forceinline__ bool next(int i, Unit& u) const {
        const int L = i * G + c; if (L >= nUnits) return false;
        u.pm = L >> 2; u.pn = L & 3; int e = 0;
#pragma unroll
        for (int q = 1; q < 16; ++q) if (u.pm >= __builtin_amdgcn_readfirstlane(tb[q])) e = q;
        u.e = __builtin_amdgcn_readfirstlane(e); return true;
    }
    __device__ __forceinline__ const char* a_base(const Unit& u) const { return gather ? A : A + (size_t)u.pm * 256 * K * 2; }
    __device__ __forceinline__ const char* b_base(const Unit& u) const { return W + (size_t)u.e * wstride + (size_t)u.pn * 256 * K * 2; }
    __device__ __forceinline__ void idx_dma(const Unit& u, LAS unsigned* slot, int tidv, int wid) const {
        const int p0 = (u.pm - __builtin_amdgcn_readfirstlane(tb[u.e])) * 256, last = __builtin_amdgcn_readfirstlane(cn[u.e]) - 1; const int* tm = tokmap + (size_t)u.e * T;
#pragma unroll
        for (int h = 0; h < 2; ++h)
#pragma unroll
            for (int i = 0; i < 2; ++i) { int R_, C_; stage_rc(tidv * 16 + i * 8192, R_, C_); int pos = p0 + 128 * h + R_; pos = pos < last ? pos : last;
                __builtin_amdgcn_global_load_lds((const unsigned*)(tm + pos), slot + (h * 2 + i) * 512 + wid * 64, 4, 0, 0); }
    }
};

struct EpiStore {
    static constexpr bool PERM = true;
    bf16* O; int ldc;
    __device__ __forceinline__ void operator()(const f32x4 (&acc)[2][2][4][2], const Unit& u, int wr, int wc, int fr, int fq) const {
        const int row0 = u.pm * BM + wr * 64 + fr, col0 = u.pn * BM + wc * 32 + 8 * fq;
#pragma unroll
        for (int ai = 0; ai < 2; ++ai)
#pragma unroll
            for (int m = 0; m < 4; ++m) { bf16* rowp = O + (size_t)(row0 + ai * HALF + m * 16) * ldc + col0;
#pragma unroll
                for (int bj = 0; bj < 2; ++bj) { const f32x4 v0 = acc[ai][bj][m][0], v1 = acc[ai][bj][m][1];
                    u32x4 w; w.x = cvt_pk_bf16(v0[0], v0[1]); w.y = cvt_pk_bf16(v0[2], v0[3]); w.z = cvt_pk_bf16(v1[0], v1[1]); w.w = cvt_pk_bf16(v1[2], v1[3]);
                    *(u32x4*)(rowp + bj * HALF) = w; } }
    }
};
template <bool SRC_F32> struct EpiResid {
    static constexpr bool PERM = true;
    const float* srcL; const float* srcC; bf16* H; const float* gate;
    __device__ __forceinline__ void operator()(const f32x4 (&acc)[2][2][4][2], const Unit& u, int wr, int wc, int fr, int fq) const {
        const float* g = gate + (u.pm < 128 ? (u.pm >> 4) : 8) * 6144;
        const float* src = (u.pm < 128) ? srcL + (size_t)u.pm * 256 * 1024 : srcC + (size_t)(u.pm - 128) * 256 * 1024;
        bf16* dst = H + (size_t)u.pm * 256 * 1024;
        const int row0 = wr * 64 + fr, col0 = u.pn * BM + wc * 32 + 8 * fq;
        f32x4 gv[2][2];
#pragma unroll
        for (int bj = 0; bj < 2; ++bj)
#pragma unroll
            for (int n = 0; n < 2; ++n) gv[bj][n] = *(const f32x4*)(g + col0 + bj * HALF + 4 * n);
#pragma unroll
        for (int ai = 0; ai < 2; ++ai)
#pragma unroll
            for (int m = 0; m < 4; ++m) { const size_t ro = (size_t)(row0 + ai * HALF + m * 16) * 1024 + col0;
#pragma unroll
                for (int bj = 0; bj < 2; ++bj) {
                    f32x4 s0, s1;
                    if constexpr (SRC_F32) { s0 = *(const f32x4*)(src + ro + bj * HALF); s1 = *(const f32x4*)(src + ro + bj * HALF + 4); }
                    else { const u32x4 hv = *(const u32x4*)(dst + ro + bj * HALF); s0 = (f32x4){bflo(hv.x), bfhi(hv.x), bflo(hv.y), bfhi(hv.y)}; s1 = (f32x4){bflo(hv.z), bfhi(hv.z), bflo(hv.w), bfhi(hv.w)}; }
                    const f32x4 v0 = s0 + gv[bj][0] * acc[ai][bj][m][0], v1 = s1 + gv[bj][1] * acc[ai][bj][m][1];
                    u32x4 w; w.x = cvt_pk_bf16(v0[0], v0[1]); w.y = cvt_pk_bf16(v0[2], v0[3]); w.z = cvt_pk_bf16(v1[0], v1[1]); w.w = cvt_pk_bf16(v1[2], v1[3]);
                    *(u32x4*)(dst + ro + bj * HALF) = w; } }
    }
};
__device__ __forceinline__ float silu_f(float x) { return x * __builtin_amdgcn_rcpf(1.0f + __expf(-x)); }
struct EpiSwiglu {
    static constexpr bool PERM = true;
    bf16* H;
    __device__ __forceinline__ void operator()(const f32x4 (&acc)[2][2][4][2], const Unit& u, int wr, int wc, int fr, int fq) const {
        const int row0 = u.pm * BM + wr * 64 + fr, col0 = u.pn * 128 + wc * 32 + 8 * fq;
#pragma unroll
        for (int ai = 0; ai < 2; ++ai)
#pragma unroll
            for (int m = 0; m < 4; ++m) { bf16* p = H + (size_t)(row0 + ai * HALF + m * 16) * 512 + col0;
                const f32x4 g0 = acc[ai][0][m][0], g1 = acc[ai][0][m][1], u0 = acc[ai][1][m][0], u1 = acc[ai][1][m][1];
                u32x4 w; w.x = cvt_pk_bf16(silu_f(g0[0]) * u0[0], silu_f(g0[1]) * u0[1]); w.y = cvt_pk_bf16(silu_f(g0[2]) * u0[2], silu_f(g0[3]) * u0[3]);
                w.z = cvt_pk_bf16(silu_f(g1[0]) * u1[0], silu_f(g1[1]) * u1[1]); w.w = cvt_pk_bf16(silu_f(g1[2]) * u1[2], silu_f(g1[3]) * u1[3]);
                *(u32x4*)p = w; }
    }
};
__device__ __forceinline__ unsigned pk4_fp8(float a, float b, float c, float d) { int p = __builtin_amdgcn_cvt_pk_fp8_f32(a, b, 0, false); p = __builtin_amdgcn_cvt_pk_fp8_f32(c, d, p, true); return (unsigned)p; }
constexpr float W1_SCALE = 32.0f, W2_SCALE = 16.0f, HID_SCALE = 4.0f;
struct EpiSwiglu8 {
    static constexpr bool PERM = true;
    unsigned char* H; float in_scale;
    __device__ __forceinline__ void operator()(const f32x4 (&acc)[2][2][4][2], const Unit& u, int wr, int wc, int fr, int fq) const {
        const int row0 = u.pm * BM + wr * 64 + fr, col0 = u.pn * 128 + wc * 32 + 8 * fq;
        const float IS = 1.0f / in_scale, OS = HID_SCALE / in_scale;
#pragma unroll
        for (int ai = 0; ai < 2; ++ai)
#pragma unroll
            for (int m = 0; m < 4; ++m) { unsigned char* p = H + (size_t)(row0 + ai * HALF + m * 16) * 512 + col0;
                const f32x4 g0 = acc[ai][0][m][0] * IS, g1 = acc[ai][0][m][1] * IS, u0 = acc[ai][1][m][0] * OS, u1 = acc[ai][1][m][1] * OS;
#define HC8(x) __builtin_fminf(__builtin_fmaxf((x), -448.0f), 448.0f)
                u32x2 w; w.x = pk4_fp8(HC8(silu_f(g0[0]) * u0[0]), HC8(silu_f(g0[1]) * u0[1]), HC8(silu_f(g0[2]) * u0[2]), HC8(silu_f(g0[3]) * u0[3]));
                w.y = pk4_fp8(HC8(silu_f(g1[0]) * u1[0]), HC8(silu_f(g1[1]) * u1[1]), HC8(silu_f(g1[2]) * u1[2]), HC8(silu_f(g1[3]) * u1[3]));
#undef HC8
                *(u32x2*)p = w; }
    }
};
struct EpiStoreS {
    static constexpr bool PERM = true;
    bf16* O; int ldc; float scale;
    __device__ __forceinline__ void operator()(const f32x4 (&acc)[2][2][4][2], const Unit& u, int wr, int wc, int fr, int fq) const {
        const int row0 = u.pm * BM + wr * 64 + fr, col0 = u.pn * BM + wc * 32 + 8 * fq;
#pragma unroll
        for (int ai = 0; ai < 2; ++ai)
#pragma unroll
            for (int m = 0; m < 4; ++m) { bf16* rowp = O + (size_t)(row0 + ai * HALF + m * 16) * ldc + col0;
#pragma unroll
                for (int bj = 0; bj < 2; ++bj) { const f32x4 v0 = acc[ai][bj][m][0] * scale, v1 = acc[ai][bj][m][1] * scale;
                    u32x4 w; w.x = cvt_pk_bf16(v0[0], v0[1]); w.y = cvt_pk_bf16(v0[2], v0[3]); w.z = cvt_pk_bf16(v1[0], v1[1]); w.w = cvt_pk_bf16(v1[2], v1[3]);
                    *(u32x4*)(rowp + bj * HALF) = w; } }
    }
};
struct EpiScaleRow {
    static constexpr bool PERM = true;
    bf16* O; const float* wrow;
    __device__ __forceinline__ void operator()(const f32x4 (&acc)[2][2][4][2], const Unit& u, int wr, int wc, int fr, int fq) const {
        const int row0 = u.pm * BM + wr * 64 + fr, col0 = u.pn * BM + wc * 32 + 8 * fq;
#pragma unroll
        for (int ai = 0; ai < 2; ++ai)
#pragma unroll
            for (int m = 0; m < 4; ++m) { const int row = row0 + ai * HALF + m * 16; const float s = wrow[row]; bf16* rowp = O + (size_t)row * 1024 + col0;
#pragma unroll
                for (int bj = 0; bj < 2; ++bj) { const f32x4 v0 = acc[ai][bj][m][0] * s, v1 = acc[ai][bj][m][1] * s;
                    u32x4 w; w.x = cvt_pk_bf16(v0[0], v0[1]); w.y = cvt_pk_bf16(v0[2], v0[3]); w.z = cvt_pk_bf16(v1[0], v1[1]); w.w = cvt_pk_bf16(v1[2], v1[3]);
                    *(u32x4*)(rowp + bj * HALF) = w; } }
    }
};
}

struct Args { const float* in[22]; float* out; unsigned char* ws; int ph_lo, ph_hi; };
enum { I_X = 0, I_C, I_CTX, I_CCTX, I_ADAW, I_ADAB, I_NMG, I_NFG, I_EWIN, I_ECONV, I_EWOUT, I_OWIN, I_OPOOLW, I_OPOOLS, I_OSINK, I_OWOUT, I_RW, I_RB, I_MG, I_MU, I_MD, I_FG };

struct Frame {
    LAS unsigned char* lds;
    int tid, lane, wave, vcu, G;
    unsigned char* ws; const float* const* in; float* out;
};
__device__ __forceinline__ bf16* h_row(const Frame& F, int t) { return (bf16*)(F.ws + WS_HB) + (size_t)t * D; }
__device__ __forceinline__ int mod_row(int t) { return t < TL ? (t >> 12) : 8; }

struct TItem { const float* src; bf16* dst; int ldw, ldd; float f8scale; };
__device__ __forceinline__ void titem_load(const TItem& t, f32x4 (&r)[8], int lane) {
#pragma unroll
    for (int i = 0; i < 8; ++i) r[i] = *(const f32x4*)(t.src + (size_t)((lane >> 3) + 8 * i) * t.ldw + 4 * (lane & 7));
}
__device__ __forceinline__ void titem_process(const TItem& t, const f32x4 (&r)[8], LAS float* scr, int lane) {
#pragma unroll
    for (int i = 0; i < 8; ++i) { LAS float* d = scr + ((lane >> 3) + 8 * i) * 33 + 4 * (lane & 7); d[0] = r[i].x; d[1] = r[i].y; d[2] = r[i].z; d[3] = r[i].w; }
    LDS_WAIT(); asm volatile("" ::: "memory");
    const int c = lane & 7;
    if (t.f8scale != 0.0f) {
        const float sc = t.f8scale; unsigned char* d8 = (unsigned char*)t.dst;
#pragma unroll
        for (int j = 0; j < 4; ++j) { const int n = (lane >> 3) + 8 * j; const LAS float* s = scr + (8 * c) * 33 + n;
            u32x2 o; o.x = pg8::pk4_fp8(s[0 * 33] * sc, s[1 * 33] * sc, s[2 * 33] * sc, s[3 * 33] * sc); o.y = pg8::pk4_fp8(s[4 * 33] * sc, s[5 * 33] * sc, s[6 * 33] * sc, s[7 * 33] * sc);
            *(u32x2*)(d8 + (size_t)n * t.ldd + 8 * c) = o; }
    } else {
#pragma unroll
        for (int j = 0; j < 4; ++j) { const int n = (lane >> 3) + 8 * j; const LAS float* s = scr + (8 * c) * 33 + n;
            u32x4 o; o.x = pk2(s[0 * 33], s[1 * 33]); o.y = pk2(s[2 * 33], s[3 * 33]); o.z = pk2(s[4 * 33], s[5 * 33]); o.w = pk2(s[6 * 33], s[7 * 33]);
            *(u32x4*)(t.dst + (size_t)n * t.ldd + 8 * c) = o; }
    }
    LDS_WAIT(); asm volatile("" ::: "memory");
}
constexpr int TS0 = 1024, TS1 = 512, TS2 = 384, TS3 = 512, TS4 = 0, TS5 = 8192, TS6 = 8192, TS7 = 8192, TNITEMS = TS0 + TS1 + TS2 + TS3 + TS4 + TS5 + TS6 + TS7;
__device__ __forceinline__ TItem titem_moe(const float* const* in, unsigned char* ws, int kind, int le, int rr) {
    TItem t; const int layer = le >> 4, e = le & 15; const bool f8 = (kind < 2) ? (layer ? (FP8_G1_L1 != 0) : (FP8_G1_L0 != 0)) : (layer ? (FP8_G2_L1 != 0) : (FP8_G2_L0 != 0));
    if (kind < 2) { const int kb = (rr >> 4) & 15, nb = rr & 15, n0 = nb * 32; const int drow = (n0 >> 7) * 256 + (n0 & 127) + kind * 128;
        t.src = in[kind ? I_MU : I_MG] + (size_t)le * 524288 + (size_t)(kb * 64) * 512 + n0; t.ldw = 512;
        unsigned char* base = ws + WS_W_M1 + (size_t)layer * 32 * MiB;
        if (f8) { t.dst = (bf16*)(base + (size_t)e * MiB + (size_t)drow * 1024 + kb * 64); t.ldd = 1024; t.f8scale = pg8::W1_SCALE; }
        else { t.dst = (bf16*)(base + (size_t)e * 2 * MiB) + (size_t)drow * 1024 + kb * 64; t.ldd = 1024; t.f8scale = 0.0f; } }
    else { const int kb = (rr >> 5) & 7, nb = rr & 31;
        t.src = in[I_MD] + (size_t)le * 524288 + (size_t)(kb * 64) * 1024 + nb * 32; t.ldw = 1024;
        unsigned char* base = ws + WS_W_M2 + (size_t)layer * 16 * MiB;
        if (f8) { t.dst = (bf16*)(base + (size_t)e * 512 * KiB + (size_t)(nb * 32) * 512 + kb * 64); t.ldd = 512; t.f8scale = pg8::W2_SCALE; }
        else { t.dst = (bf16*)(base + (size_t)e * MiB) + (size_t)(nb * 32) * 512 + kb * 64; t.ldd = 512; t.f8scale = 0.0f; } }
    return t;
}
__device__ __forceinline__ TItem titem_decode(const float* const* in, unsigned char* ws, int r) {
    TItem t;
    if (r < TS0) { const int kb = r / 64, nb = r % 64; t.src = in[I_EWIN] + (size_t)(kb * 64) * 2048 + nb * 32; t.ldw = 2048; t.dst = (bf16*)(ws + WS_W_EIN) + (size_t)(nb * 32) * 1024 + kb * 64; t.ldd = 1024; t.f8scale = 0.0f; return t; } r -= TS0;
    if (r < TS1) { const int kb = r / 32, nb = r % 32; t.src = in[I_EWOUT] + (size_t)(kb * 64) * 1024 + nb * 32; t.ldw = 1024; t.dst = (bf16*)(ws + WS_W_EOUT) + (size_t)(nb * 32) * 1024 + kb * 64; t.ldd = 1024; t.f8scale = 0.0f; return t; } r -= TS1;
    if (r < TS2) { const int kb = r / 24, nb = 16 + r % 24; t.src = in[I_OWIN] + (size_t)(kb * 64) * 1280 + nb * 32; t.ldw = 1280; t.dst = (bf16*)(ws + WS_W_OIN) + (size_t)(nb * 32) * 1024 + kb * 64; t.ldd = 1024; t.f8scale = 0.0f; return t; } r -= TS2;
    if (r < TS3) { const int kb = r / 32, nb = r % 32; t.src = in[I_OWOUT] + (size_t)(kb * 64) * 1024 + nb * 32; t.ldw = 1024; t.dst = (bf16*)(ws + WS_W_OOUT) + (size_t)(nb * 32) * 1024 + kb * 64; t.ldd = 1024; t.f8scale = 0.0f; return t; } r -= TS3;
    if (r < TS5 + TS6 + TS7) return titem_moe(in, ws, r / 8192, (r % 8192) >> 8, r % 256);
    return t;
}
constexpr int NL1 = 12288;
__device__ __forceinline__ TItem titem_l1(const float* const* in, unsigned char* ws, int r) { return titem_moe(in, ws, r / 4096, 16 + ((r % 4096) >> 8), r % 256); }

constexpr size_t WS_CONVCTR = 20 * KiB;
__device__ __forceinline__ void convert_l1(Frame& F, int quota) {
    unsigned* ctr = (unsigned*)(F.ws + WS_CONVCTR);
    LAS float* scr = (LAS float*)(F.lds + F.wave * 17408);
    for (int ch = 0; ch < quota; ++ch) {
        const int c0 = __builtin_amdgcn_readfirstlane(F.lane == 0 ? (int)__hip_atomic_fetch_add(ctr, 4u, __ATOMIC_RELAXED, __HIP_MEMORY_SCOPE_AGENT) : 0);
        if (c0 >= NL1) break;
        f32x4 cur[8], nxt[8];
        TItem tc = titem_l1(F.in, F.ws, c0);
        titem_load(tc, nxt, F.lane);
#pragma unroll 1
        for (int i = 0; i < 4; ++i) {
#pragma unroll
            for (int j = 0; j < 8; ++j) cur[j] = nxt[j];
            const TItem tcur = tc;
            if (i < 3) { tc = titem_l1(F.in, F.ws, c0 + i + 1); titem_load(tc, nxt, F.lane); }
            titem_process(tcur, cur, scr, F.lane);
        }
    }
}
__device__ __forceinline__ void tail_fill(Frame& F, int nUnits, int quota) {
    const int rounds = (nUnits + F.G - 1) / F.G;
    if ((rounds - 1) * F.G + F.vcu >= nUnits) convert_l1(F, quota);
}

__device__ __forceinline__ void norm_mod_store(const f32x4 (&v)[4], const float* g, const float* shift, const float* scale, bf16* orow, int lane) {
    float s2 = 0.f;
#pragma unroll
    for (int j = 0; j < 4; ++j) s2 += (v[j].x * v[j].x + v[j].y * v[j].y) + (v[j].z * v[j].z + v[j].w * v[j].w);
    const float rstd = 1.0f / sqrtf(wave_sum(s2) * (1.0f / D) + EPS);
#pragma unroll
    for (int j = 0; j < 4; ++j) { const int c = 4 * lane + 256 * j;
        const f32x4 gg = *(const f32x4*)(g + c), sh = *(const f32x4*)(shift + c), sc = *(const f32x4*)(scale + c);
        const f32x4 y = v[j] * rstd * gg * (sc + 1.0f) + sh;
        u32x2 o; o.x = pk2(y.x, y.y); o.y = pk2(y.z, y.w);
        *(u32x2*)(orow + c) = o; }
}

template <int NQ> __device__ __forceinline__ void p1_tokens(Frame& F, int t) {
    const float* mods = (const float*)(F.ws + WS_MODS);
    bf16* A = (bf16*)(F.ws + WS_BUFA);
    f32x4 v[NQ][4];
#pragma unroll
    for (int q = 0; q < NQ; ++q) { const int tq = t + q; const float* xr = tq < TL ? F.in[I_X] + (size_t)tq * D : F.in[I_CTX] + (size_t)(tq - TL) * D;
#pragma unroll
        for (int j = 0; j < 4; ++j) v[q][j] = *(const f32x4*)(xr + 4 * F.lane + 256 * j); }
    const float* m = mods + (size_t)mod_row(t) * 6144;
#pragma unroll
    for (int q = 0; q < NQ; ++q) norm_mod_store(v[q], F.in[I_NMG], m, m + 1024, A + (size_t)(t + q) * D, F.lane);
}
__device__ __forceinline__ void phase_mods(Frame& F) {
    const float* const* in = F.in;
    LAS float* S = (LAS float*)F.lds;
    LAS float* red = S + 9 * 1024;
    for (int i = F.tid; i < 9 * 1024; i += 512) { const float v = (i < 8192) ? in[I_C][i] : in[I_CCTX][i - 8192]; S[i] = v / (1.0f + expf(-v)); }
    __syncthreads();
    const int bx = blockIdx.x, layer = bx >> 7, col0 = (bx & 127) * 48;
    const int j = F.tid % 12, rg = F.tid / 12;
    if (rg < 42) {
        const float* W = in[I_ADAW] + (size_t)layer * 1024 * 6144 + col0 + 4 * j;
        f32x4 w[25];
#pragma unroll
        for (int i = 0; i < 25; ++i) { const int k = rg + 42 * i; w[i] = (k < 1024) ? *(const f32x4*)(W + (size_t)k * 6144) : (f32x4){0.f, 0.f, 0.f, 0.f}; }
        f32x4 acc[9];
#pragma unroll
        for (int r = 0; r < 9; ++r) acc[r] = (f32x4){0.f, 0.f, 0.f, 0.f};
#pragma unroll
        for (int i = 0; i < 25; ++i) { const int k = min(rg + 42 * i, 1023);
#pragma unroll
            for (int r = 0; r < 9; ++r) acc[r] += w[i] * S[r * 1024 + k]; }
#pragma unroll
        for (int r = 0; r < 9; ++r) *(LAS f32x4*)(red + (rg * 9 + r) * 48 + 4 * j) = acc[r];
    }
    __syncthreads();
    for (int i = F.tid; i < 432; i += 512) { const int r = i / 48, c = i % 48; float sum = in[I_ADAB][layer * 6144 + col0 + c];
        for (int g = 0; g < 42; ++g) sum += red[(g * 9 + r) * 48 + c];
        ((float*)(F.ws + WS_MODS))[(layer * 9 + r) * 6144 + col0 + c] = sum; }
}

__device__ __forceinline__ void phase_prologue_a(Frame& F) {
    const float* const* in = F.in;
    unsigned char* ws = F.ws;
    LAS float* ldsf = (LAS float*)F.lds;
    __syncthreads();
    {
        const int gt = blockIdx.x * 512 + F.tid, NT = F.G * 512;
        float* rope = (float*)(ws + WS_ROPE);
        for (int i = gt; i < 1024; i += NT) { const int coord = i >> 4, q = i & 15; const float inv = powf(10000.0f, -(float)q / 16.0f); const float ang = (float)coord * inv;
            rope[i] = cosf(ang); rope[1024 + i] = sinf(ang); }
        bf16* WA = (bf16*)(ws + WS_WA);
        for (int i = gt; i < 128 * 128; i += NT) { const int m = i >> 7, k = i & 127, rp = m >> 6, j1 = m & 63, ri = k >> 6, n1 = k & 63;
            const float a = 2.0f * (float)((j1 * n1) & 63) / 64.0f; const float c = cospif(a), s = sinpif(a);
            const float v = (rp == 0) ? (ri == 0 ? c : s) : (ri == 0 ? -s : c); WA[i] = (bf16)f2bf(v); }
        bf16* WAC = (bf16*)(ws + WS_WAC);
        for (int i = gt; i < 32 * 32; i += NT) { const int m = i >> 5, k = i & 31, rp = m >> 4, j1 = m & 15, ri = k >> 4, n1 = k & 15;
            const float a = 2.0f * (float)((j1 * n1) & 15) / 16.0f; const float c = cospif(a), s = sinpif(a);
            const float v = (rp == 0) ? (ri == 0 ? c : s) : (ri == 0 ? -s : c); WAC[i] = (bf16)f2bf(v); }
        bf16* WC = (bf16*)(ws + WS_WC);
        for (int i = gt; i < 64 * 64 * 128; i += NT) { const int j1 = i >> 13, j2 = (i >> 7) & 63, k = i & 127, ri = k >> 6, n2 = k & 63;
            const float a = 2.0f * (float)((n2 * (j1 + 64 * j2)) & 4095) / 4096.0f; const float v = (ri == 0 ? cospif(a) : sinpif(a)) * (1.0f / 64.0f); WC[i] = (bf16)f2bf(v); }
        bf16* FD = (bf16*)(ws + WS_FD);
        for (int i = gt; i < 256 * 128; i += NT) { const int col = i >> 7, c = i & 127, ri = col >> 7, k2 = col & 127;
            const float a = 2.0f * (float)((c * k2) & 127) / 128.0f; const float v = (ri == 0 ? cospif(a) : -sinpif(a)) * 0.08838834764831845f; FD[i] = (bf16)f2bf(v); }
        bf16* WCC = (bf16*)(ws + WS_WCC);
        for (int i = gt; i < 16 * 16 * 32; i += NT) { const int j1 = i >> 9, j2 = (i >> 5) & 15, k = i & 31, ri = k >> 4, n2 = k & 15;
            const float a = 2.0f * (float)((n2 * (j1 + 16 * j2)) & 255) / 256.0f; const float v = (ri == 0 ? cospif(a) : sinpif(a)) * (1.0f / 16.0f); WCC[i] = (bf16)f2bf(v); }
    }
    LAS float* tw = (LAS float*)(F.lds + 139264);
    if (F.tid < 128) { const float a = 2.0f * (float)F.tid / 128.0f; tw[F.tid] = cospif(a); tw[128 + F.tid] = sinpif(a); }
    __syncthreads();
    LAS float* scr = (LAS float*)(F.lds + F.wave * 17408);
    const int gw = F.vcu * NWAVES + F.wave, NGW = F.G * NWAVES;
    const int fid = F.vcu * 2 + F.wave;
    if (F.wave < 2) { const int r = fid;
        const int g = r >> 7, db = (r >> 5) & 3, kb = r & 31, k0 = kb * 32, d0 = db * 32;
        const float* Wp = in[I_OWIN] + (size_t)k0 * 1280 + g * 128;
        { float tl[32][2];
#pragma unroll
          for (int rr = 0; rr < 32; ++rr) { tl[rr][0] = Wp[(size_t)rr * 1280 + F.lane]; tl[rr][1] = Wp[(size_t)rr * 1280 + 64 + F.lane]; }
#pragma unroll
          for (int rr = 0; rr < 32; ++rr) { scr[rr * 129 + F.lane] = tl[rr][0]; scr[rr * 129 + 64 + F.lane] = tl[rr][1]; } }
        LDS_WAIT(); asm volatile("" ::: "memory");
        const int k = F.lane & 31, oh = F.lane >> 5;
        const float* pw = in[I_OPOOLW] + (size_t)g * 16384 + d0 + 16 * oh;
        float acc[16];
#pragma unroll
        for (int t = 0; t < 16; ++t) acc[t] = 0.f;
        for (int c0 = 0; c0 < 128; c0 += 8) {
            f32x4 p[8][4];
#pragma unroll
            for (int cc = 0; cc < 8; ++cc)
#pragma unroll
                for (int j = 0; j < 4; ++j) p[cc][j] = *(const f32x4*)(pw + (c0 + cc) * 128 + 4 * j);
#pragma unroll
            for (int cc = 0; cc < 8; ++cc) { const float w = scr[k * 129 + c0 + cc];
#pragma unroll
                for (int j = 0; j < 4; ++j) { acc[4 * j] += w * p[cc][j].x; acc[4 * j + 1] += w * p[cc][j].y; acc[4 * j + 2] += w * p[cc][j].z; acc[4 * j + 3] += w * p[cc][j].w; } }
        }
        const float* psc = in[I_OPOOLS] + g * 128 + d0 + 16 * oh;
        bf16* dst = (bf16*)(ws + WS_W_OIN) + (size_t)(g * 128 + d0 + 16 * oh) * 1024 + k0 + k;
#pragma unroll
        for (int t = 0; t < 16; ++t) dst[(size_t)t * 1024] = (bf16)f2bf(acc[t] * psc[t]);
        LDS_WAIT(); asm volatile("" ::: "memory");
    }
    {
        LAS unsigned* ctr = (LAS unsigned*)(F.lds + LDS_CTL + 32);
        constexpr int PER = (TNITEMS + 255) / 256;
        const int base = F.vcu * PER, lim = min(PER, TNITEMS - base);
        f32x4 cur[8], nxt[8];
        int it = __builtin_amdgcn_readfirstlane(F.lane == 0 ? (int)atomicAdd((unsigned*)ctr, 1u) : 0);
        TItem tc = titem_decode(in, ws, base + (it < lim ? it : 0));
        if (it < lim) titem_load(tc, nxt, F.lane);
        while (it < lim) {
#pragma unroll
            for (int i = 0; i < 8; ++i) cur[i] = nxt[i];
            const TItem tcur = tc;
            const int itn = __builtin_amdgcn_readfirstlane(F.lane == 0 ? (int)atomicAdd((unsigned*)ctr, 1u) : 0);
            if (itn < lim) { tc = titem_decode(in, ws, base + itn); titem_load(tc, nxt, F.lane); }
            titem_process(tcur, cur, scr, F.lane);
            it = itn;
        }
    }
    {
        LAS unsigned* ctr2 = (LAS unsigned*)(F.lds + LDS_CTL + 36);
        for (;;) {
            const int it = __builtin_amdgcn_readfirstlane(F.lane == 0 ? (int)atomicAdd((unsigned*)ctr2, 1u) : 0);
            if (it >= 40) break;
            if (it < 32) p1_tokens<4>(F, 4 * (32 * (int)blockIdx.x + it)); else p1_tokens<1>(F, TL + 8 * (int)blockIdx.x + (it - 32));
        }
    }
}

struct DftP { const bf16* dbase; size_t dstride; const bf16* W; bf16* obase; size_t ostride; };
template <int MODE> __device__ __forceinline__ DftP dft_params(const Frame& F, int u) {
    const bf16* P = (const bf16*)(F.ws + WS_BUFP); bf16* Z = (bf16*)(F.ws + WS_BUFZ); bf16* MIX = (bf16*)(F.ws + WS_BUFA);
    DftP p;
    if constexpr (MODE == 0) { const int chunk = u & 3, n2 = (u >> 2) & 63, b = u >> 8;
        p.dbase = P + (size_t)(b * 4096 + n2) * EIN + chunk * 128; p.dstride = (size_t)64 * EIN; p.W = (const bf16*)(F.ws + WS_WA);
        p.obase = Z + (size_t)((b * 64) * 64 + n2) * 1024 + chunk * 128; p.ostride = (size_t)64 * 1024; }
    if constexpr (MODE == 1) { const int chunk = u & 3, n2 = (u >> 2) & 15, b = u >> 6;
        p.dbase = P + (size_t)(TL + b * 256 + n2) * EIN + chunk * 128; p.dstride = (size_t)16 * EIN; p.W = (const bf16*)(F.ws + WS_WAC);
        p.obase = Z + (size_t)(TL + (b * 16) * 16 + n2) * 1024 + chunk * 128; p.ostride = (size_t)16 * 1024; }
    if constexpr (MODE == 2) { const int chunk = u & 3, j1 = (u >> 2) & 63, b = u >> 8;
        p.dbase = Z + (size_t)((b * 64 + j1) * 64) * 1024 + chunk * 128; p.dstride = (size_t)1024; p.W = (const bf16*)(F.ws + WS_WC) + (size_t)j1 * 64 * 128;
        p.obase = MIX + (size_t)(b * 4096 + j1) * D + chunk * 128; p.ostride = (size_t)64 * D; }
    if constexpr (MODE == 3) { const int chunk = u & 3, j1 = (u >> 2) & 15, b = u >> 6;
        p.dbase = Z + (size_t)(TL + (b * 16 + j1) * 16) * 1024 + chunk * 128; p.dstride = (size_t)1024; p.W = (const bf16*)(F.ws + WS_WCC) + (size_t)j1 * 16 * 32;
        p.obase = MIX + (size_t)(TL + b * 256 + j1) * D + chunk * 128; p.ostride = (size_t)16 * D; }
    return p;
}
template <int MODE, int KD, int MD, int J>
__device__ __forceinline__ void dft_units(Frame& F, int nunits) {
    constexpr int LD = KD + 8;
    constexpr int NP = (KD * 16 + 511) / 512;
    constexpr int GM = KD / 8 - 1;
    LAS bf16* DT = (LAS bf16*)F.lds;
    u32x4 pre[NP];
    int u = F.vcu;
    if (u < nunits) { const DftP p = dft_params<MODE>(F, u);
#pragma unroll
        for (int i = 0; i < NP; ++i) { const int pc = F.tid + 512 * i; if (pc < KD * 16) { const int k = pc >> 4, c8 = pc & 15, ri = k / (KD / 2), nn = k % (KD / 2);
            pre[i] = *(const u32x4*)(p.dbase + (size_t)nn * p.dstride + ri * 512 + c8 * 8); } } }
    const int a = F.lane & 15, q = F.lane >> 4;
    for (; u < nunits; u += F.G) {
        const DftP p = dft_params<MODE>(F, u);
#pragma unroll
        for (int i = 0; i < NP; ++i) { const int pc = F.tid + 512 * i; if (pc < KD * 16) { const int k = pc >> 4, c8 = pc & 15; const u32x4 v = pre[i];
            LAS bf16* d = DT + (c8 * 8) * LD + (k ^ ((c8 & GM) << 3));
            d[0 * LD] = (bf16)(v.x & 0xffff); d[1 * LD] = (bf16)(v.x >> 16); d[2 * LD] = (bf16)(v.y & 0xffff); d[3 * LD] = (bf16)(v.y >> 16);
            d[4 * LD] = (bf16)(v.z & 0xffff); d[5 * LD] = (bf16)(v.z >> 16); d[6 * LD] = (bf16)(v.w & 0xffff); d[7 * LD] = (bf16)(v.w >> 16); } }
        __syncthreads();
        if (u + F.G < nunits) { const DftP pn = dft_params<MODE>(F, u + F.G);
#pragma unroll
            for (int i = 0; i < NP; ++i) { const int pc = F.tid + 512 * i; if (pc < KD * 16) { const int k = pc >> 4, c8 = pc & 15, ri = k / (KD / 2), nn = k % (KD / 2);
                pre[i] = *(const u32x4*)(pn.dbase + (size_t)nn * pn.dstride + ri * 512 + c8 * 8); } } }
        for (int task = F.wave; task < (MD / 16) * 2; task += NWAVES) {
            const int mt = task >> 1, cht = task & 1;
            f32x4 acc[4];
#pragma unroll
            for (int ct = 0; ct < 4; ++ct) acc[ct] = (f32x4){0.f, 0.f, 0.f, 0.f};
#pragma unroll
            for (int ks = 0; ks < KD / 32; ++ks) {
                const bf16x8 bw = *(const bf16x8*)(p.W + (size_t)(mt * 16 + a) * KD + ks * 32 + 8 * q);
#pragma unroll
                for (int ct = 0; ct < 4; ++ct) {
                    const int ch = cht * 64 + 16 * (a >> 2) + 4 * ct + (a & 3);
                    const bf16x8 av = *(const LAS bf16x8*)(DT + ch * LD + ((ks * 32 + 8 * q) ^ (((ch >> 3) & GM) << 3)));
                    acc[ct] = __builtin_amdgcn_mfma_f32_16x16x32_bf16(av, bw, acc[ct], 0, 0, 0);
                }
            }
            const int m = mt * 16 + a, rm = m / J, j = m % J;
            bf16* o = p.obase + (size_t)j * p.ostride + rm * 512 + cht * 64 + 16 * q;
            u32x4 w0, w1;
            w0.x = pk2(acc[0][0], acc[0][1]); w0.y = pk2(acc[0][2], acc[0][3]); w0.z = pk2(acc[1][0], acc[1][1]); w0.w = pk2(acc[1][2], acc[1][3]);
            w1.x = pk2(acc[2][0], acc[2][1]); w1.y = pk2(acc[2][2], acc[2][3]); w1.z = pk2(acc[3][0], acc[3][1]); w1.w = pk2(acc[3][2], acc[3][3]);
            *(u32x4*)o = w0; *(u32x4*)(o + 8) = w1;
        }
        __syncthreads();
    }
}

template <int MODE, int NR>
__device__ __forceinline__ void dft_units_a(Frame& F, int nunits) {
    constexpr int KD = 2 * NR, MD = 2 * NR, J = NR, LD = KD + 8, GM = KD / 8 - 1, ULD = 136;
    constexpr int NP = (NR * 16 + 511) / 512;
    LAS bf16* FDl = (LAS bf16*)F.lds; LAS bf16* U = (LAS bf16*)(F.lds + 69632); LAS bf16* DT = (LAS bf16*)(F.lds + 69632 + 64 * ULD * 2);
    { const bf16* FD = (const bf16*)(F.ws + WS_FD);
      for (int p = F.tid; p < 256 * 16; p += 512) { const int r = p >> 4, c8 = p & 15; *(LAS u32x4*)(FDl + r * ULD + 8 * c8) = *(const u32x4*)(FD + r * 128 + 8 * c8); } }
    u32x4 pre[NP];
    int u = F.vcu;
    if (u < nunits) { const DftP p = dft_params<MODE>(F, u);
#pragma unroll
        for (int i = 0; i < NP; ++i) { const int pc = F.tid + 512 * i; if (pc < NR * 16) pre[i] = *(const u32x4*)(p.dbase + (size_t)(pc >> 4) * p.dstride + (pc & 15) * 8); } }
    const int a = F.lane & 15, q = F.lane >> 4;
    for (; u < nunits; u += F.G) {
        const DftP p = dft_params<MODE>(F, u);
#pragma unroll
        for (int i = 0; i < NP; ++i) { const int pc = F.tid + 512 * i; if (pc < NR * 16) *(LAS u32x4*)(U + (pc >> 4) * ULD + (pc & 15) * 8) = pre[i]; }
        __syncthreads();
        if (u + F.G < nunits) { const DftP pn = dft_params<MODE>(F, u + F.G);
#pragma unroll
            for (int i = 0; i < NP; ++i) { const int pc = F.tid + 512 * i; if (pc < NR * 16) pre[i] = *(const u32x4*)(pn.dbase + (size_t)(pc >> 4) * pn.dstride + (pc & 15) * 8); } }
        {
            f32x4 acc[NR / 16][2];
#pragma unroll
            for (int mt = 0; mt < NR / 16; ++mt) { acc[mt][0] = (f32x4){0.f, 0.f, 0.f, 0.f}; acc[mt][1] = (f32x4){0.f, 0.f, 0.f, 0.f}; }
#pragma unroll
            for (int ks = 0; ks < 4; ++ks) {
                const bf16x8 b0 = *(const LAS bf16x8*)(FDl + ((2 * F.wave) * 16 + a) * ULD + ks * 32 + 8 * q), b1 = *(const LAS bf16x8*)(FDl + ((2 * F.wave + 1) * 16 + a) * ULD + ks * 32 + 8 * q);
#pragma unroll
                for (int mt = 0; mt < NR / 16; ++mt) { const bf16x8 av = *(const LAS bf16x8*)(U + (mt * 16 + a) * ULD + ks * 32 + 8 * q);
                    acc[mt][0] = __builtin_amdgcn_mfma_f32_16x16x32_bf16(av, b0, acc[mt][0], 0, 0, 0); acc[mt][1] = __builtin_amdgcn_mfma_f32_16x16x32_bf16(av, b1, acc[mt][1], 0, 0, 0); }
            }
#pragma unroll
            for (int t = 0; t < 2; ++t) { const int col = (2 * F.wave + t) * 16 + a, ri = col >> 7, k2 = col & 127;
#pragma unroll
                for (int mt = 0; mt < NR / 16; ++mt) { const int k0 = ri * NR + 16 * mt + 4 * q;
                    u32x2 w; w.x = pk2(acc[mt][t][0], acc[mt][t][1]); w.y = pk2(acc[mt][t][2], acc[mt][t][3]);
                    *(LAS u32x2*)(DT + k2 * LD + (k0 ^ (((k2 >> 3) & GM) << 3))) = w; } }
        }
        __syncthreads();
        for (int task = F.wave; task < (MD / 16) * 2; task += NWAVES) {
            const int mt = task >> 1, cht = task & 1;
            f32x4 acc[4];
#pragma unroll
            for (int ct = 0; ct < 4; ++ct) acc[ct] = (f32x4){0.f, 0.f, 0.f, 0.f};
#pragma unroll
            for (int ks = 0; ks < KD / 32; ++ks) {
                const bf16x8 bw = *(const bf16x8*)(p.W + (size_t)(mt * 16 + a) * KD + ks * 32 + 8 * q);
#pragma unroll
                for (int ct = 0; ct < 4; ++ct) {
                    const int ch = cht * 64 + 16 * (a >> 2) + 4 * ct + (a & 3);
                    const bf16x8 av = *(const LAS bf16x8*)(DT + ch * LD + ((ks * 32 + 8 * q) ^ (((ch >> 3) & GM) << 3)));
                    acc[ct] = __builtin_amdgcn_mfma_f32_16x16x32_bf16(av, bw, acc[ct], 0, 0, 0);
                }
            }
            const int m = mt * 16 + a, rm = m / J, j = m % J;
            bf16* o = p.obase + (size_t)j * p.ostride + rm * 512 + cht * 64 + 16 * q;
            u32x4 w0, w1;
            w0.x = pk2(acc[0][0], acc[0][1]); w0.y = pk2(acc[0][2], acc[0][3]); w0.z = pk2(acc[1][0], acc[1][1]); w0.w = pk2(acc[1][2], acc[1][3]);
            w1.x = pk2(acc[2][0], acc[2][1]); w1.y = pk2(acc[2][2], acc[2][3]); w1.z = pk2(acc[3][0], acc[3][1]); w1.w = pk2(acc[3][2], acc[3][3]);
            *(u32x4*)o = w0; *(u32x4*)(o + 8) = w1;
        }
        __syncthreads();
    }
}

__device__ __forceinline__ void phase_fourier_a_conv(Frame& F) {
    const bf16* P = (const bf16*)(F.ws + WS_BUFP);
    dft_units_a<0, 64>(F, 2048);
    __syncthreads();
    dft_units_a<1, 16>(F, 512);
    bf16* MIX = (bf16*)(F.ws + WS_BUFA);
    const float* cw = F.in[I_ECONV];
    float w0[8], w1[8], w2[8];
#pragma unroll
    for (int i = 0; i < 8; ++i) { w0[i] = cw[8 * F.lane + i]; w1[i] = cw[512 + 8 * F.lane + i]; w2[i] = cw[1024 + 8 * F.lane + i]; }
    const int gw = F.vcu * NWAVES + F.wave, NGW = F.G * NWAVES;
    auto conv_tokens = [&](int t, auto ntc) {
        constexpr int NT = decltype(ntc)::value;
        int pos, len; if (t < TL) { pos = t & 4095; len = 4096; } else { pos = (t - TL) & 255; len = 256; }
        const bf16* row = P + (size_t)t * EIN + 8 * F.lane;
        u32x4 gb[NT], gc[NT + 2], uc[NT + 2];
#pragma unroll
        for (int d = 0; d < NT + 2; ++d) { const int pp = pos + d - 1;
            if (pp >= 0 && pp < len) { gc[d] = *(const u32x4*)(row + (ptrdiff_t)(d - 1) * EIN + 1024); uc[d] = *(const u32x4*)(row + (ptrdiff_t)(d - 1) * EIN + 1536); }
            else { gc[d] = (u32x4){0u, 0u, 0u, 0u}; uc[d] = (u32x4){0u, 0u, 0u, 0u}; } }
#pragma unroll
        for (int q = 0; q < NT; ++q) gb[q] = *(const u32x4*)(row + (size_t)q * EIN + 512);
        float pl[NT + 2][8];
#pragma unroll
        for (int d = 0; d < NT + 2; ++d)
#pragma unroll
            for (int i = 0; i < 4; ++i) { pl[d][2 * i] = bflo(gc[d][i]) * bflo(uc[d][i]); pl[d][2 * i + 1] = bfhi(gc[d][i]) * bfhi(uc[d][i]); }
#pragma unroll
        for (int q = 0; q < NT; ++q) {
            float y[8];
#pragma unroll
            for (int i = 0; i < 4; ++i) {
                y[2 * i] = bflo(gb[q][i]) * (w0[2 * i] * pl[q][2 * i] + w1[2 * i] * pl[q + 1][2 * i] + w2[2 * i] * pl[q + 2][2 * i]);
                y[2 * i + 1] = bfhi(gb[q][i]) * (w0[2 * i + 1] * pl[q][2 * i + 1] + w1[2 * i + 1] * pl[q + 1][2 * i + 1] + w2[2 * i + 1] * pl[q + 2][2 * i + 1]);
            }
            u32x4 o; o.x = pk2(y[0], y[1]); o.y = pk2(y[2], y[3]); o.z = pk2(y[4], y[5]); o.w = pk2(y[6], y[7]);
            *(u32x4*)(MIX + (size_t)(t + q) * D + 512 + 8 * F.lane) = o;
        }
    };
    for (int t = 4 * gw; t < TL; t += 4 * NGW) conv_tokens(t, std::integral_constant<int, 4>{});
    for (int t = TL + gw; t < T; t += NGW) conv_tokens(t, std::integral_constant<int, 1>{});
}

__device__ __forceinline__ void phase_fourier_c(Frame& F) {
    dft_units<2, 128, 64, 64>(F, 2048);
    dft_units<3, 32, 16, 16>(F, 512);
}

constexpr int RW_LD = 1032;
__device__ __forceinline__ void phase_route(Frame& F, int layer, int ntok) {
    LAS bf16* rwh = (LAS bf16*)F.lds;
    LAS bf16* rwl = (LAS bf16*)(F.lds + 33024);
    LAS unsigned* cnt = (LAS unsigned*)(F.lds + 66048);
    LAS int* gb = (LAS int*)(F.lds + 66048 + 128);
    LAS float* lgs = (LAS float*)(F.lds + 66048 + 256) + F.wave * 256;
    LAS int* tinfo = (LAS int*)(F.lds + 66048 + 256 + 8192);
    LAS float* GS = (LAS float*)(F.lds + 81920);
    LAS float* SH = GS + 2048;
    const float* RW = F.in[I_RW];
    const int per = ntok / F.G, t0 = blockIdx.x * per, r0 = mod_row(t0);
    const float* mods = (const float*)(F.ws + WS_MODS) + (size_t)layer * 9 * 6144;
    const float* g = F.in[I_NFG] + layer * 1024;
    for (int i = F.tid; i < 16384; i += 512) { const int k = i >> 4, e = i & 15; const float w = RW[i]; const unsigned hi = f2bf(w); const float wl = w - __builtin_bit_cast(float, hi << 16);
        rwh[e * RW_LD + k] = (bf16)hi; rwl[e * RW_LD + k] = (bf16)f2bf(wl); }
    for (int i = F.tid; i < 2048; i += 512) { const int sl = i >> 10, c = i & 1023; const int rr = min(r0 + sl, 8); const float* m = mods + (size_t)rr * 6144;
        GS[i] = g[c] * (m[4 * 1024 + c] + 1.0f); SH[i] = m[3 * 1024 + c]; }
    if (F.tid < 16) cnt[F.tid] = 0u;
    __syncthreads();
    bf16* FB = (bf16*)(F.ws + WS_BUFA);
    const bool f8 = layer ? (FP8_G1_L1 != 0) : (FP8_G1_L0 != 0);
    int* route = (int*)(F.ws + WS_ROUTE);
    const int tk = F.lane & 15, kg = F.lane >> 4;
    for (int g0 = 16 * F.wave; g0 < per; g0 += 16 * NWAVES) {
        const int nv = min(16, per - g0);
        const int tq = t0 + g0 + (tk < nv ? tk : 0);
        const bf16* hr = h_row(F, tq) + 8 * kg;
        float s2 = 0.f;
        {
            u32x4 raw[32];
#pragma unroll
            for (int ks = 0; ks < 32; ++ks) raw[ks] = *(const u32x4*)(hr + 32 * ks);
#pragma unroll
            for (int ks = 0; ks < 32; ++ks)
#pragma unroll
                for (int i = 0; i < 4; ++i) { const float a = bflo(raw[ks][i]), b2 = bfhi(raw[ks][i]); s2 += a * a + b2 * b2; }
        }
        s2 += __shfl_xor(s2, 16); s2 += __shfl_xor(s2, 32);
        const float rstd = 1.0f / sqrtf(s2 * (1.0f / D) + EPS);
        const int sl = (mod_row(tq) != r0) ? 1024 : 0;
        const LAS float* gsp = GS + sl + 8 * kg; const LAS float* shp = SH + sl + 8 * kg;
        unsigned char* fb8 = (unsigned char*)FB + (size_t)tq * D + 8 * kg;
        bf16* fb16 = FB + (size_t)tq * D + 8 * kg;
        f32x4 acc = (f32x4){0.f, 0.f, 0.f, 0.f};
        u32x4 nx[8];
#pragma unroll
        for (int j = 0; j < 8; ++j) nx[j] = *(const u32x4*)(hr + 32 * j);
#pragma unroll 1
        for (int k4 = 0; k4 < 4; ++k4) {
            u32x4 cu[8];
#pragma unroll
            for (int j = 0; j < 8; ++j) cu[j] = nx[j];
            if (k4 < 3) {
#pragma unroll
                for (int j = 0; j < 8; ++j) nx[j] = *(const u32x4*)(hr + 32 * (8 * k4 + 8 + j)); }
#pragma unroll
            for (int j = 0; j < 8; ++j) {
                const int ks = 8 * k4 + j;
                const f32x4 g0v = *(const LAS f32x4*)(gsp + 32 * ks), g1v = *(const LAS f32x4*)(gsp + 32 * ks + 4), s0v = *(const LAS f32x4*)(shp + 32 * ks), s1v = *(const LAS f32x4*)(shp + 32 * ks + 4);
                float f[8];
                f[0] = bflo(cu[j].x) * rstd * g0v.x + s0v.x; f[1] = bfhi(cu[j].x) * rstd * g0v.y + s0v.y; f[2] = bflo(cu[j].y) * rstd * g0v.z + s0v.z; f[3] = bfhi(cu[j].y) * rstd * g0v.w + s0v.w;
                f[4] = bflo(cu[j].z) * rstd * g1v.x + s1v.x; f[5] = bfhi(cu[j].z) * rstd * g1v.y + s1v.y; f[6] = bflo(cu[j].w) * rstd * g1v.z + s1v.z; f[7] = bfhi(cu[j].w) * rstd * g1v.w + s1v.w;
                u32x4 hi, lo;
#pragma unroll
                for (int i = 0; i < 4; ++i) { const unsigned h0 = f2bf(f[2 * i]), h1 = f2bf(f[2 * i + 1]); hi[i] = h0 | (h1 << 16);
                    lo[i] = pk2(f[2 * i] - __builtin_bit_cast(float, h0 << 16), f[2 * i + 1] - __builtin_bit_cast(float, h1 << 16)); }
                if (tk < nv) {
                    if (f8) { u32x2 o; o.x = pg8::pk4_fp8(f[0], f[1], f[2], f[3]); o.y = pg8::pk4_fp8(f[4], f[5], f[6], f[7]); *(u32x2*)(fb8 + 32 * ks) = o; }
                    else *(u32x4*)(fb16 + 32 * ks) = hi;
                }
                const bf16x8 bh = *(const LAS bf16x8*)(rwh + tk * RW_LD + 32 * ks + 8 * kg), bl = *(const LAS bf16x8*)(rwl + tk * RW_LD + 32 * ks + 8 * kg);
                const bf16x8 ah = __builtin_bit_cast(bf16x8, hi), al = __builtin_bit_cast(bf16x8, lo);
                acc = __builtin_amdgcn_mfma_f32_16x16x32_bf16(ah, bh, acc, 0, 0, 0);
                acc = __builtin_amdgcn_mfma_f32_16x16x32_bf16(ah, bl, acc, 0, 0, 0);
                acc = __builtin_amdgcn_mfma_f32_16x16x32_bf16(al, bh, acc, 0, 0, 0);
            }
        }
#pragma unroll
        for (int j = 0; j < 4; ++j) lgs[(4 * kg + j) * 16 + tk] = acc[j];
        LDS_WAIT(); asm volatile("" ::: "memory");
        if (F.lane < nv) {
            const int tqq = t0 + g0 + F.lane;
            float aff[16], sel[16];
#pragma unroll
            for (int e4 = 0; e4 < 4; ++e4) { const f32x4 l4 = *(const LAS f32x4*)(lgs + F.lane * 16 + 4 * e4); const f32x4 b4 = *(const f32x4*)(F.in[I_RB] + 4 * e4);
                aff[4 * e4] = 1.0f / (1.0f + expf(-l4.x)); aff[4 * e4 + 1] = 1.0f / (1.0f + expf(-l4.y)); aff[4 * e4 + 2] = 1.0f / (1.0f + expf(-l4.z)); aff[4 * e4 + 3] = 1.0f / (1.0f + expf(-l4.w));
                sel[4 * e4] = aff[4 * e4] + b4.x; sel[4 * e4 + 1] = aff[4 * e4 + 1] + b4.y; sel[4 * e4 + 2] = aff[4 * e4 + 2] + b4.z; sel[4 * e4 + 3] = aff[4 * e4 + 3] + b4.w; }
            int best = 0; float bs = -1e30f;
#pragma unroll
            for (int gq = 0; gq < 4; ++gq) { const float a = sel[4 * gq], b = sel[4 * gq + 1], c = sel[4 * gq + 2], d = sel[4 * gq + 3];
                const float s = fmaxf(fmaxf(fmaxf(a + b, a + c), fmaxf(a + d, b + c)), fmaxf(b + d, c + d));
                if (s > bs) { bs = s; best = gq; } }
            float sv[4], av[4];
#pragma unroll
            for (int i = 0; i < 4; ++i) { sv[i] = sel[i]; av[i] = aff[i]; }
#pragma unroll
            for (int gq = 1; gq < 4; ++gq) if (best == gq) {
#pragma unroll
                for (int i = 0; i < 4; ++i) { sv[i] = sel[4 * gq + i]; av[i] = aff[4 * gq + i]; } }
            int i1 = 0; float s1 = sv[0], a1 = av[0];
#pragma unroll
            for (int i = 1; i < 4; ++i) if (sv[i] > s1) { s1 = sv[i]; a1 = av[i]; i1 = i; }
            int i2 = -1; float s2v = -1e30f, a2 = 0.f;
#pragma unroll
            for (int i = 0; i < 4; ++i) if (i != i1 && sv[i] > s2v) { s2v = sv[i]; a2 = av[i]; i2 = i; }
            const int e1 = 4 * best + i1, e2 = 4 * best + i2;
            const float wsum = a1 + a2, w1 = a1 / wsum, w2 = a2 / wsum;
            const unsigned r1 = atomicAdd((unsigned*)(cnt + e1), 1u), r2 = atomicAdd((unsigned*)(cnt + e2), 1u);
            int* ro = route + (size_t)tqq * 8;
            ro[0] = e1; ro[1] = e2; ro[4] = __builtin_bit_cast(int, w1); ro[5] = __builtin_bit_cast(int, w2);
            tinfo[4 * (tqq - t0) + 0] = e1; tinfo[4 * (tqq - t0) + 1] = e2; tinfo[4 * (tqq - t0) + 2] = (int)r1; tinfo[4 * (tqq - t0) + 3] = (int)r2;
        }
        LDS_WAIT(); asm volatile("" ::: "memory");
    }
    __syncthreads();
    if (F.tid < 16) gb[F.tid] = (int)__hip_atomic_fetch_add((unsigned*)(F.ws + WS_GCNT) + layer * 16 + F.tid, cnt[F.tid], __ATOMIC_RELAXED, __HIP_MEMORY_SCOPE_AGENT);
    __syncthreads();
    int* tokmap = (int*)(F.ws + WS_TOKMAP);
    for (int i = F.tid; i < per; i += 512) {
        const int e1 = tinfo[4 * i], e2 = tinfo[4 * i + 1], p1 = gb[e1] + tinfo[4 * i + 2], p2 = gb[e2] + tinfo[4 * i + 3];
        tokmap[(size_t)e1 * T + p1] = t0 + i; tokmap[(size_t)e2 * T + p2] = t0 + i;
        int* ro = route + (size_t)(t0 + i) * 8; ro[2] = p1; ro[3] = p2;
    }
}

__device__ __forceinline__ int moe_tables(Frame& F, int layer) {
    LAS int* tb = (LAS int*)(F.lds + LDS_CTL + 64); LAS int* cn = (LAS int*)(F.lds + LDS_CTL + 192);
    __syncthreads();
    if (F.tid < 16) cn[F.tid] = ld_coh((const int*)(F.ws + WS_GCNT) + layer * 16 + F.tid);
    __syncthreads();
    if (F.tid == 0) { int b = 0; for (int e = 0; e < 16; ++e) { tb[e] = b; b += (cn[e] + 255) >> 8; } tb[16] = b; }
    __syncthreads();
    return __builtin_amdgcn_readfirstlane(tb[16]);
}

template <int NQ> __device__ __forceinline__ void combine_tokens(Frame& F, int layer, int t) {
    const float* mods = (const float*)(F.ws + WS_MODS);
    const bf16* OS = (const bf16*)(F.ws + WS_BUFP);
    const int* route = (const int*)(F.ws + WS_ROUTE);
    const LAS int* tb = (const LAS int*)(F.lds + LDS_CTL + 64);
    bf16* A = (bf16*)(F.ws + WS_BUFA);
    {
        int rc[NQ][4]; float w0[NQ], w1[NQ];
#pragma unroll
        for (int q = 0; q < NQ; ++q) { const int* ro = route + (size_t)(t + q) * 8;
#pragma unroll
            for (int i = 0; i < 4; ++i) rc[q][i] = ld_coh(ro + i);
            w0[q] = ld_cohf((const float*)(ro + 4)); w1[q] = ld_cohf((const float*)(ro + 5)); }
        f32x4 v[NQ][4]; u32x2 oa[NQ][4], ob[NQ][4];
#pragma unroll
        for (int q = 0; q < NQ; ++q) { const bf16* hr = h_row(F, t + q);
            const size_t s0 = (size_t)(tb[rc[q][0]] * 256 + rc[q][2]) * D, s1 = (size_t)(tb[rc[q][1]] * 256 + rc[q][3]) * D;
#pragma unroll
            for (int j = 0; j < 4; ++j) { const int c = 4 * F.lane + 256 * j; { const u32x2 hv = *(const u32x2*)(hr + c); v[q][j] = (f32x4){bflo(hv.x), bfhi(hv.x), bflo(hv.y), bfhi(hv.y)}; } oa[q][j] = *(const u32x2*)(OS + s0 + c); ob[q][j] = *(const u32x2*)(OS + s1 + c); } }
        const int mr = mod_row(t);
        const float* m5 = mods + (size_t)(layer * 9 + mr) * 6144 + 5 * 1024;
#pragma unroll
        for (int j = 0; j < 4; ++j) { const f32x4 g5 = *(const f32x4*)(m5 + 4 * F.lane + 256 * j);
#pragma unroll
            for (int q = 0; q < NQ; ++q) { const u32x2 a = oa[q][j], b2 = ob[q][j];
                const f32x4 o = (f32x4){w0[q] * bflo(a.x) + w1[q] * bflo(b2.x), w0[q] * bfhi(a.x) + w1[q] * bfhi(b2.x), w0[q] * bflo(a.y) + w1[q] * bflo(b2.y), w0[q] * bfhi(a.y) + w1[q] * bfhi(b2.y)};
                v[q][j] = v[q][j] + g5 * o; } }
#pragma unroll
        for (int q = 0; q < NQ; ++q) {
            if (layer == 0) {
                bf16* hr = h_row(F, t + q);
#pragma unroll
                for (int j = 0; j < 4; ++j) { u32x2 o; o.x = pk2(v[q][j].x, v[q][j].y); o.y = pk2(v[q][j].z, v[q][j].w); *(u32x2*)(hr + 4 * F.lane + 256 * j) = o; }
                const float* m = mods + (size_t)(9 + mr) * 6144;
                norm_mod_store(v[q], F.in[I_NMG] + 1024, m, m + 1024, A + (size_t)(t + q) * D, F.lane);
            } else {
                float s2 = 0.f;
#pragma unroll
                for (int j = 0; j < 4; ++j) s2 += (v[q][j].x * v[q][j].x + v[q][j].y * v[q][j].y) + (v[q][j].z * v[q][j].z + v[q][j].w * v[q][j].w);
                const float rstd = 1.0f / sqrtf(wave_sum(s2) * (1.0f / D) + EPS);
                float* orow = F.out + (size_t)(t + q) * D;
#pragma unroll
                for (int j = 0; j < 4; ++j) { const int c = 4 * F.lane + 256 * j; *(f32x4*)(orow + c) = v[q][j] * rstd * *(const f32x4*)(F.in[I_FG] + c); }
            }
        }
    }
}
__device__ __forceinline__ void phase_combine(Frame& F, int layer, int ntok) {
    const int gw = F.vcu * NWAVES + F.wave, NGW = F.G * NWAVES;
    if (layer == 0) { for (int t = 2 * gw; t < TL; t += 2 * NGW) combine_tokens<2>(F, 0, t); for (int t = TL + gw; t < ntok; t += NGW) combine_tokens<1>(F, 0, t); }
    else { for (int t = 4 * gw; t < TL; t += 4 * NGW) combine_tokens<4>(F, 1, t); }
}

constexpr int KV_LD = 72, VL_OFF = 384 * KV_LD * 2, ROPE_LDS = 131072;
typedef short v4i16_t __attribute__((ext_vector_type(4)));

__device__ __forceinline__ bf16x8 rope_pack(const u32x4 x1, const u32x4 x2, const LAS float* cs, const LAS float* sn, float scale, bool second) {
    const f32x4 c0 = *(const LAS f32x4*)cs, c1 = *(const LAS f32x4*)(cs + 4), s0 = *(const LAS f32x4*)sn, s1 = *(const LAS f32x4*)(sn + 4);
    float c[8] = {c0.x, c0.y, c0.z, c0.w, c1.x, c1.y, c1.z, c1.w}, s[8] = {s0.x, s0.y, s0.z, s0.w, s1.x, s1.y, s1.z, s1.w};
    float a[8], b[8];
#pragma unroll
    for (int i = 0; i < 4; ++i) { a[2 * i] = bflo(x1[i]); a[2 * i + 1] = bfhi(x1[i]); b[2 * i] = bflo(x2[i]); b[2 * i + 1] = bfhi(x2[i]); }
    float o[8];
#pragma unroll
    for (int i = 0; i < 8; ++i) o[i] = (second ? (b[i] * c[i] + a[i] * s[i]) : (a[i] * c[i] - b[i] * s[i])) * scale;
    u32x4 w; w.x = pk2(o[0], o[1]); w.y = pk2(o[2], o[3]); w.z = pk2(o[4], o[5]); w.w = pk2(o[6], o[7]);
    return __builtin_bit_cast(bf16x8, w);
}

struct AttnU { int b, qb, kvh; };
__device__ __forceinline__ AttnU attn_unit_of(int u) { AttnU r; r.kvh = u & 1; r.qb = (u >> 1) & 31; r.b = u >> 6; return r; }

__device__ __forceinline__ void attn_load_latk(Frame& F, const bf16* P1, AttnU u, u32x4 (&lk)[2][4]) {
    const u32x4 z = (u32x4){0u, 0u, 0u, 0u};
#pragma unroll
    for (int it = 0; it < 2; ++it) { const int task = F.tid + 512 * it, kidx = task >> 1, hh = task & 1, pos = u.qb * 128 - 128 + kidx;
        const bool ok = task < 768 && pos >= 0 && pos < NSEQ;
        const bf16* row = P1 + (size_t)(u.b * NSEQ + (ok ? pos : 0)) * OIN + 1024 + u.kvh * 64 + 8 * hh;
#pragma unroll
        for (int st = 0; st < 4; ++st) lk[it][st] = ok ? *(const u32x4*)(row + 16 * st) : z; }
}
__device__ __forceinline__ void attn_load_latv(Frame& F, const bf16* P1, AttnU u, u32x4 (&lv)[6]) {
    const u32x4 z = (u32x4){0u, 0u, 0u, 0u};
#pragma unroll
    for (int it = 0; it < 6; ++it) { const int task = F.tid + 512 * it, kidx = task >> 3, c8 = task & 7, pos = u.qb * 128 - 128 + kidx;
        const bool ok = pos >= 0 && pos < NSEQ;
        lv[it] = ok ? *(const u32x4*)(P1 + (size_t)(u.b * NSEQ + (ok ? pos : 0)) * OIN + 1152 + u.kvh * 64 + 8 * c8) : z; }
}
__device__ __forceinline__ void attn_write_lat(Frame& F, AttnU u, const u32x4 (&lk)[2][4], const u32x4 (&lv)[6]) {
    LAS bf16* KL = (LAS bf16*)F.lds; LAS bf16* VL = (LAS bf16*)(F.lds + VL_OFF); const LAS float* rope = (const LAS float*)(F.lds + ROPE_LDS);
#pragma unroll
    for (int it = 0; it < 2; ++it) { const int task = F.tid + 512 * it, kidx = task >> 1, hh = task & 1; int pos = u.qb * 128 - 128 + kidx; pos = pos < 0 ? 0 : (pos > NSEQ - 1 ? NSEQ - 1 : pos);
        if (task < 768) {
            LAS bf16* d = KL + kidx * KV_LD + 8 * hh;
            const LAS float* c0 = rope + (pos >> 6) * 16 + 8 * hh; const LAS float* c1 = rope + (pos & 63) * 16 + 8 * hh;
            *(LAS bf16x8*)(d) = rope_pack(lk[it][0], lk[it][1], c0, c0 + 1024, 1.0f, false);
            *(LAS bf16x8*)(d + 16) = rope_pack(lk[it][0], lk[it][1], c0, c0 + 1024, 1.0f, true);
            *(LAS bf16x8*)(d + 32) = rope_pack(lk[it][2], lk[it][3], c1, c1 + 1024, 1.0f, false);
            *(LAS bf16x8*)(d + 48) = rope_pack(lk[it][2], lk[it][3], c1, c1 + 1024, 1.0f, true);
        } }
#pragma unroll
    for (int it = 0; it < 6; ++it) { const int task = F.tid + 512 * it, kidx = task >> 3, c8 = task & 7; *(LAS u32x4*)(VL + kidx * KV_LD + 8 * c8) = lv[it]; }
}
__device__ __forceinline__ void attn_load_ctx(Frame& F, const bf16* P1, AttnU u, u32x4 (&ck)[4], u32x4 (&cv)[4]) {
#pragma unroll
    for (int it = 0; it < 4; ++it) { const int task = F.tid + 512 * it, kidx = task >> 3, c8 = task & 7;
        const bf16* row = P1 + (size_t)(TL + u.b * LCTX + kidx) * OIN + 1024 + u.kvh * 64 + 8 * c8;
        ck[it] = *(const u32x4*)row; cv[it] = *(const u32x4*)(row + 128); }
}
__device__ __forceinline__ void attn_write_ctx(Frame& F, const u32x4 (&ck)[4], const u32x4 (&cv)[4]) {
    LAS bf16* KL = (LAS bf16*)F.lds; LAS bf16* VL = (LAS bf16*)(F.lds + VL_OFF);
#pragma unroll
    for (int it = 0; it < 4; ++it) { const int task = F.tid + 512 * it, kidx = task >> 3, c8 = task & 7;
        *(LAS u32x4*)(KL + kidx * KV_LD + 8 * c8) = ck[it]; *(LAS u32x4*)(VL + kidx * KV_LD + 8 * c8) = cv[it]; }
}

__device__ __forceinline__ unsigned cvtpk(float lo, float hi) { unsigned r; asm volatile("v_cvt_pk_bf16_f32 %0, %1, %2" : "=v"(r) : "v"(lo), "v"(hi)); return r; }
__device__ __forceinline__ float xhalf_max(float x) { const auto r = __builtin_amdgcn_permlane32_swap(__builtin_bit_cast(unsigned, x), __builtin_bit_cast(unsigned, x), false, false);
    return fmaxf(__builtin_bit_cast(float, r[0]), __builtin_bit_cast(float, r[1])); }
__device__ __forceinline__ float xhalf_sum(float x) { const auto r = __builtin_amdgcn_permlane32_swap(__builtin_bit_cast(unsigned, x), __builtin_bit_cast(unsigned, x), false, false);
    return __builtin_bit_cast(float, r[0]) + __builtin_bit_cast(float, r[1]); }
__device__ __forceinline__ void attn_tiles(Frame& F, int kt0, int kt1, int mk0, int mk1, const bf16x8 (&qf)[4], f32x16 (&O)[2], float& mrun, float& lrun, int qrel) {
    if (kt0 > kt1) return;
    const LAS bf16* KL = (const LAS bf16*)F.lds; const LAS bf16* VL = (const LAS bf16*)(F.lds + VL_OFF);
    const int r32 = F.lane & 31, hh = F.lane >> 5;
    const int q4 = (F.lane & 15) >> 2, p4 = F.lane & 3, blk = (F.lane >> 4) & 1;
    const LAS bf16* kp = KL + (kt0 * 32 + r32) * KV_LD + 8 * hh;
    const LAS bf16* vp = VL + (kt0 * 32 + 4 * hh + q4) * KV_LD + 16 * blk + 4 * p4;
    bf16x8 kn[4];
#pragma unroll
    for (int st = 0; st < 4; ++st) kn[st] = *(const LAS bf16x8*)(kp + 16 * st);
    for (int kt = kt0; kt <= kt1; ++kt) {
        bf16x8 kf[4];
#pragma unroll
        for (int st = 0; st < 4; ++st) kf[st] = kn[st];
        v4i16_t vlo[2][2], vhi[2][2];
#pragma unroll
        for (int dt = 0; dt < 2; ++dt)
#pragma unroll
            for (int s2 = 0; s2 < 2; ++s2) { vlo[dt][s2] = __builtin_amdgcn_ds_read_tr16_b64_v4i16((LAS v4i16_t*)(vp + (16 * s2) * KV_LD + dt * 32));
                vhi[dt][s2] = __builtin_amdgcn_ds_read_tr16_b64_v4i16((LAS v4i16_t*)(vp + (16 * s2 + 8) * KV_LD + dt * 32)); }
        kp += 32 * KV_LD; vp += 32 * KV_LD;
        if (kt < kt1) {
#pragma unroll
            for (int st = 0; st < 4; ++st) kn[st] = *(const LAS bf16x8*)(kp + 16 * st); }
        __builtin_amdgcn_sched_barrier(0);
        f32x16 s;
#pragma unroll
        for (int r = 0; r < 16; ++r) s[r] = 0.f;
#pragma unroll
        for (int st = 0; st < 4; ++st) s = __builtin_amdgcn_mfma_f32_32x32x16_bf16(kf[st], qf[st], s, 0, 0, 0);
        if (kt == mk0 || kt == mk1) {
#pragma unroll
            for (int r = 0; r < 16; ++r) { const int dlt = kt * 32 + (r & 3) + 8 * (r >> 2) + 4 * hh - qrel; s[r] = (dlt <= 128 && dlt >= -128) ? s[r] : -INFINITY; } }
        float mx = fmaxf(fmaxf(s[0], s[1]), fmaxf(s[2], s[3]));
#pragma unroll
        for (int r = 4; r < 16; r += 4) mx = fmaxf(mx, fmaxf(fmaxf(s[r], s[r + 1]), fmaxf(s[r + 2], s[r + 3])));
        mx = xhalf_max(mx);
        const float mnew = fmaxf(mrun, mx);
        float ps0 = 0.f, ps1 = 0.f;
#pragma unroll
        for (int r = 0; r < 16; r += 2) { s[r] = __builtin_amdgcn_exp2f(s[r] - mnew); s[r + 1] = __builtin_amdgcn_exp2f(s[r + 1] - mnew); ps0 += s[r]; ps1 += s[r + 1]; }
        const float ps = xhalf_sum(ps0 + ps1);
        if (__any(mnew > mrun)) {
            const float alpha = __builtin_amdgcn_exp2f(mrun - mnew);
            lrun *= alpha;
#pragma unroll
            for (int dt = 0; dt < 2; ++dt)
#pragma unroll
                for (int r = 0; r < 16; ++r) O[dt][r] *= alpha;
        }
        lrun += ps; mrun = mnew;
        bf16x8 pb[2];
#pragma unroll
        for (int s2 = 0; s2 < 2; ++s2) { u32x4 w; w.x = cvtpk(s[8 * s2 + 0], s[8 * s2 + 1]); w.y = cvtpk(s[8 * s2 + 2], s[8 * s2 + 3]); w.z = cvtpk(s[8 * s2 + 4], s[8 * s2 + 5]); w.w = cvtpk(s[8 * s2 + 6], s[8 * s2 + 7]);
            pb[s2] = __builtin_bit_cast(bf16x8, w); }
#pragma unroll
        for (int dt = 0; dt < 2; ++dt)
#pragma unroll
            for (int s2 = 0; s2 < 2; ++s2) {
                const bf16x8 va = (bf16x8){vlo[dt][s2][0], vlo[dt][s2][1], vlo[dt][s2][2], vlo[dt][s2][3], vhi[dt][s2][0], vhi[dt][s2][1], vhi[dt][s2][2], vhi[dt][s2][3]};
                O[dt] = __builtin_amdgcn_mfma_f32_32x32x16_bf16(va, pb[s2], O[dt], 0, 0, 0);
            }
    }
}

__device__ __forceinline__ void phase_attn(Frame& F) {
    const bf16* P1 = (const bf16*)(F.ws + WS_BUFP);
    bf16* MIX = (bf16*)(F.ws + WS_BUFA);
    const int r32 = F.lane & 31, hh = F.lane >> 5;
    constexpr float QSC = 0.125f * 1.4426950408889634f;
    LAS float* ropel = (LAS float*)(F.lds + ROPE_LDS);
    for (int i = F.tid; i < 2048; i += 512) ropel[i] = ((const float*)(F.ws + WS_ROPE))[i];
    u32x4 lk[2][4], lv[6], ck[4], cv[4];
    const int nu = (512 - F.vcu + F.G - 1) / F.G;
    if (nu > 0) attn_load_latk(F, P1, attn_unit_of(F.vcu), lk);
    for (int ui = 0; ui < nu; ++ui) {
        const AttnU u = attn_unit_of(F.vcu + ui * F.G);
        u32x4 qr[2][4];
#pragma unroll
        for (int i = 0; i < 2; ++i) { const int task = F.wave + 8 * i, g = task & 3, sub = task >> 2, head = u.kvh * 4 + g, pos = u.qb * 128 + 32 * sub + r32;
            const bf16* row = P1 + (size_t)(u.b * NSEQ + pos) * OIN + 512 + head * 64 + 8 * hh;
#pragma unroll
            for (int st = 0; st < 4; ++st) qr[i][st] = *(const u32x4*)(row + 16 * st); }
        attn_load_latv(F, P1, u, lv);
        __syncthreads();
        attn_write_lat(F, u, lk, lv);
        bf16x8 qf[2][4]; f32x16 O[2][2]; float mrun[2], lrun[2];
#pragma unroll
        for (int i = 0; i < 2; ++i) { const int task = F.wave + 8 * i, g = task & 3, sub = task >> 2, head = u.kvh * 4 + g, pos = u.qb * 128 + 32 * sub + r32;
            const LAS float* c0 = ropel + (pos >> 6) * 16 + 8 * hh; const LAS float* c1 = ropel + (pos & 63) * 16 + 8 * hh;
            qf[i][0] = rope_pack(qr[i][0], qr[i][1], c0, c0 + 1024, QSC, false); qf[i][1] = rope_pack(qr[i][0], qr[i][1], c0, c0 + 1024, QSC, true);
            qf[i][2] = rope_pack(qr[i][2], qr[i][3], c1, c1 + 1024, QSC, false); qf[i][3] = rope_pack(qr[i][2], qr[i][3], c1, c1 + 1024, QSC, true);
            mrun[i] = F.in[I_OSINK][head] * 1.4426950408889634f; lrun[i] = 1.0f;
#pragma unroll
            for (int dt = 0; dt < 2; ++dt)
#pragma unroll
                for (int r = 0; r < 16; ++r) O[i][dt][r] = 0.f; }
        __syncthreads();
        const int kt_lo = (u.qb == 0) ? 4 : 0, kt_hi = (u.qb == 31) ? 7 : 11;
#pragma unroll
        for (int i = 0; i < 2; ++i) { const int sub = (F.wave + 8 * i) >> 2, qrel = 128 + 32 * sub + r32;
            attn_tiles(F, max(sub, kt_lo), min(sub + 8, kt_hi), sub, sub + 8, qf[i], O[i], mrun[i], lrun[i], qrel); }
        attn_load_ctx(F, P1, u, ck, cv);
        __syncthreads();
        attn_write_ctx(F, ck, cv);
        __syncthreads();
        if (ui + 1 < nu) attn_load_latk(F, P1, attn_unit_of(F.vcu + (ui + 1) * F.G), lk);
#pragma unroll
        for (int i = 0; i < 2; ++i) {
            attn_tiles(F, 0, 7, -1, -1, qf[i], O[i], mrun[i], lrun[i], 0);
            const int task = F.wave + 8 * i, g = task & 3, sub = task >> 2, head = u.kvh * 4 + g, pos = u.qb * 128 + 32 * sub + r32;
            const float inv = 1.0f / lrun[i];
            bf16* o = MIX + (size_t)(u.b * NSEQ + pos) * D + 512 + head * 64 + 4 * hh;
#pragma unroll
            for (int dt = 0; dt < 2; ++dt)
#pragma unroll
                for (int rg = 0; rg < 4; ++rg) { u32x2 w; w.x = pk2(O[i][dt][4 * rg] * inv, O[i][dt][4 * rg + 1] * inv); w.y = pk2(O[i][dt][4 * rg + 2] * inv, O[i][dt][4 * rg + 3] * inv);
                    *(u32x2*)(o + dt * 32 + 8 * rg) = w; }
        }
    }
    __syncthreads();
}

__device__ __forceinline__ void phase_pool_stencil(Frame& F) {
    const bf16* P1 = (const bf16*)(F.ws + WS_BUFP);
    bf16* MIX = (bf16*)(F.ws + WS_BUFA);
    const int gw = F.vcu * NWAVES + F.wave, NGW = F.G * NWAVES;
    const int r = 1 << (F.lane >> 4);
    constexpr int NT = 8, NR = NT + 16;
    for (int t = NT * gw; t < TL; t += NT * NGW) {
        const int pos = t & 4095;
        const bf16* base = P1 + (size_t)t * OIN + 8 * F.lane;
        u32x4 v[NR];
#pragma unroll
        for (int jj = 0; jj < NR; ++jj) { const int pj = pos + jj - 8; const bool ok = pj >= 0 && pj < NSEQ; v[jj] = ok ? *(const u32x4*)(base + (ptrdiff_t)(jj - 8) * OIN) : (u32x4){0u, 0u, 0u, 0u}; }
        float acc[NT][8];
#pragma unroll
        for (int q = 0; q < NT; ++q)
#pragma unroll
            for (int i = 0; i < 8; ++i) acc[q][i] = 0.f;
#pragma unroll
        for (int jj = 0; jj < NR; ++jj) {
            float x[8];
#pragma unroll
            for (int i = 0; i < 4; ++i) { x[2 * i] = bflo(v[jj][i]); x[2 * i + 1] = bfhi(v[jj][i]); }
#pragma unroll
            for (int q = 0; q < NT; ++q) { const int dd = jj - 8 - q; if (dd >= -8 && dd <= 8) { const float w = (dd <= r && dd >= -r) ? 1.0f : 0.0f;
#pragma unroll
                for (int i = 0; i < 8; ++i) acc[q][i] += w * x[i]; } }
        }
#pragma unroll
        for (int q = 0; q < NT; ++q) {
            const int pq = pos + q, lo = max(pq - r, 0), hi = min(pq + r + 1, NSEQ);
            const float ic = 1.0f / (float)(hi - lo);
            const u32x4 sv = v[q + 8];
            u32x4 o;
#pragma unroll
            for (int i = 0; i < 4; ++i) o[i] = pk2(acc[q][2 * i] * ic - bflo(sv[i]), acc[q][2 * i + 1] * ic - bfhi(sv[i]));
            *(u32x4*)(MIX + (size_t)(t + q) * D + 8 * F.lane) = o;
        }
    }
}

__device__ __forceinline__ void phase_attn_pool(Frame& F) {
    phase_attn(F);
#ifdef DBG_ATTN2
    phase_attn(F);
#endif
    phase_pool_stencil(F);
}

constexpr int NPHASE = 20;
__global__ void __launch_bounds__(NWAVES * 64, 2) mk_fwd(Args args) {
    extern __shared__ __attribute__((aligned(16))) unsigned char lds_raw[];
    Frame F;
    F.lds = (LAS unsigned char*)lds_raw;
    F.tid = threadIdx.x; F.lane = F.tid & 63; F.wave = __builtin_amdgcn_readfirstlane(F.tid >> 6);
    F.G = gridDim.x; { const int bx = blockIdx.x; F.vcu = (F.G % 8 == 0) ? (bx % 8) * (F.G / 8) + bx / 8 : bx; }
    F.ws = args.ws; F.in = args.in; F.out = args.out;
    for (int u = F.tid; u < (LDS_BYTES - LDS_CTL) / 4; u += NWAVES * 64) ((LAS unsigned*)(F.lds + LDS_CTL))[u] = 0u;
    __syncthreads();
    const int lo = args.ph_lo, hi = args.ph_hi;
    XcdBarrier bar; bar.bar = (unsigned*)(F.ws + WS_CTL); bar.x = 0; bar.st = nullptr;
    if (hi - lo > 1) bar = xcd_barrier_post((unsigned*)(F.ws + WS_CTL), (volatile LAS unsigned*)(F.lds + LDS_CTL));
#define IN(k) (lo <= (k) && (k) < hi)
#ifndef PHASE_MASK
#define PHASE_MASK 0xffffffffu
#endif
#define PH(k, ...) if constexpr (((PHASE_MASK >> (k)) & 1u) != 0u) if (IN(k)) { __VA_ARGS__ if constexpr (((DBG_DOUBLE >> (k)) & 1u) != 0u) { __VA_ARGS__ } }
#define SEAM(k) do { if (IN(k) && IN((k) + 1)) xcd_barrier(bar); } while (0)
    unsigned char* ws = F.ws;
    const float* mods = (const float*)(ws + WS_MODS);

    PH(0, { phase_mods(F); }) SEAM(0);
    PH(1, { phase_prologue_a(F); }) SEAM(1);
    PH(2, {
        pg8::SchedDense S{(const char*)(ws + WS_BUFA), (const char*)(ws + WS_W_EIN), 1024, 8, 136, 0, 1088, F.vcu, F.G};
        pg8::EpiStore E{(bf16*)(ws + WS_BUFP), EIN};
        pg8::gemm_phase<pg8::EpiStore, pg8::SchedDense>(F.lds, 1024, S, E);
    }) SEAM(2);
    PH(3, { phase_fourier_a_conv(F); }) SEAM(3);
    PH(4, { phase_fourier_c(F); }) SEAM(4);
    PH(5, {
        pg8::SchedDense S{(const char*)(ws + WS_BUFA), (const char*)(ws + WS_W_EOUT), 1024, 4, 136, 0, 544, F.vcu, F.G};
        pg8::EpiResid<true> E{F.in[I_X], F.in[I_CTX], (bf16*)(ws + WS_HB), mods + 2 * 1024};
        pg8::gemm_phase<pg8::EpiResid<true>, pg8::SchedDense>(F.lds, 1024, S, E);
    }) SEAM(5);
    PH(6, { phase_route(F, 0, T); }) SEAM(6);
    PH(7, {
        const int ntile = moe_tables(F, 0);
        if constexpr (FP8_G1_L0) {
            pg8::SchedMoe<true> S{(const char*)(ws + WS_BUFA), (const char*)(ws + WS_W_M1) + (size_t)0 * 32 * MiB, (const int*)(ws + WS_TOKMAP), (const LAS int*)(F.lds + LDS_CTL + 64), (const LAS int*)(F.lds + LDS_CTL + 192), 512, (size_t)MiB, ntile * 4, F.vcu, F.G};
            pg8::EpiSwiglu8 E{(unsigned char*)(ws + WS_BUFZ), pg8::W1_SCALE};
            pg8::gemm_phase<pg8::EpiSwiglu8, pg8::SchedMoe<true>, true>(F.lds, 512, S, E);
        } else {
            pg8::SchedMoe<true> S{(const char*)(ws + WS_BUFA), (const char*)(ws + WS_W_M1) + (size_t)0 * 32 * MiB, (const int*)(ws + WS_TOKMAP), (const LAS int*)(F.lds + LDS_CTL + 64), (const LAS int*)(F.lds + LDS_CTL + 192), 1024, (size_t)2 * MiB, ntile * 4, F.vcu, F.G};
            if constexpr (FP8_G2_L0) { pg8::EpiSwiglu8 E{(unsigned char*)(ws + WS_BUFZ), 1.0f}; pg8::gemm_phase<pg8::EpiSwiglu8, pg8::SchedMoe<true>>(F.lds, 1024, S, E); }
            else { pg8::EpiSwiglu E{(bf16*)(ws + WS_BUFZ)}; pg8::gemm_phase<pg8::EpiSwiglu, pg8::SchedMoe<true>>(F.lds, 1024, S, E); }
        }
    }) SEAM(7);
    PH(8, {
        const int ntile = moe_tables(F, 0);
        if constexpr (FP8_G2_L0) {
            pg8::SchedMoe<false> S{(const char*)(ws + WS_BUFZ), (const char*)(ws + WS_W_M2) + (size_t)0 * 16 * MiB, nullptr, (const LAS int*)(F.lds + LDS_CTL + 64), (const LAS int*)(F.lds + LDS_CTL + 192), 256, (size_t)512 * KiB, ntile * 4, F.vcu, F.G};
            pg8::EpiStoreS E{(bf16*)(ws + WS_BUFP), 1024, 1.0f / (pg8::HID_SCALE * pg8::W2_SCALE)};
            pg8::gemm_phase<pg8::EpiStoreS, pg8::SchedMoe<false>, true>(F.lds, 256, S, E);
        } else {
            pg8::SchedMoe<false> S{(const char*)(ws + WS_BUFZ), (const char*)(ws + WS_W_M2) + (size_t)0 * 16 * MiB, nullptr, (const LAS int*)(F.lds + LDS_CTL + 64), (const LAS int*)(F.lds + LDS_CTL + 192), 512, (size_t)MiB, ntile * 4, F.vcu, F.G};
            pg8::EpiStore E{(bf16*)(ws + WS_BUFP), 1024};
            pg8::gemm_phase<pg8::EpiStore, pg8::SchedMoe<false>>(F.lds, 512, S, E);
        }
    }) SEAM(8);
    PH(9, { (void)moe_tables(F, 0); phase_combine(F, 0, T); }) SEAM(9);
    PH(10, {
        pg8::SchedDense S{(const char*)(ws + WS_BUFA), (const char*)(ws + WS_W_OIN), 1024, 5, 128, 4, 648, F.vcu, F.G};
        pg8::EpiStore E{(bf16*)(ws + WS_BUFP), OIN};
        pg8::gemm_phase<pg8::EpiStore, pg8::SchedDense>(F.lds, 1024, S, E);
    }) SEAM(10);
    PH(11, { phase_attn_pool(F); }) SEAM(11);
    PH(12, {
        pg8::SchedDense S{(const char*)(ws + WS_BUFA), (const char*)(ws + WS_W_OOUT), 1024, 4, 128, 0, 512, F.vcu, F.G};
        pg8::EpiResid<false> E{nullptr, nullptr, (bf16*)(ws + WS_HB), mods + 9 * 6144 + 2 * 1024};
        pg8::gemm_phase<pg8::EpiResid<false>, pg8::SchedDense>(F.lds, 1024, S, E);
    }) SEAM(12);
    PH(13, { phase_route(F, 1, TL); }) SEAM(13);
    PH(14, {
        const int ntile = moe_tables(F, 1);
        if constexpr (FP8_G1_L1) {
            pg8::SchedMoe<true> S{(const char*)(ws + WS_BUFA), (const char*)(ws + WS_W_M1) + (size_t)1 * 32 * MiB, (const int*)(ws + WS_TOKMAP), (const LAS int*)(F.lds + LDS_CTL + 64), (const LAS int*)(F.lds + LDS_CTL + 192), 512, (size_t)MiB, ntile * 4, F.vcu, F.G};
            pg8::EpiSwiglu8 E{(unsigned char*)(ws + WS_BUFZ), pg8::W1_SCALE};
            pg8::gemm_phase<pg8::EpiSwiglu8, pg8::SchedMoe<true>, true>(F.lds, 512, S, E);
        } else {
            pg8::SchedMoe<true> S{(const char*)(ws + WS_BUFA), (const char*)(ws + WS_W_M1) + (size_t)1 * 32 * MiB, (const int*)(ws + WS_TOKMAP), (const LAS int*)(F.lds + LDS_CTL + 64), (const LAS int*)(F.lds + LDS_CTL + 192), 1024, (size_t)2 * MiB, ntile * 4, F.vcu, F.G};
            if constexpr (FP8_G2_L1) { pg8::EpiSwiglu8 E{(unsigned char*)(ws + WS_BUFZ), 1.0f}; pg8::gemm_phase<pg8::EpiSwiglu8, pg8::SchedMoe<true>>(F.lds, 1024, S, E); }
            else { pg8::EpiSwiglu E{(bf16*)(ws + WS_BUFZ)}; pg8::gemm_phase<pg8::EpiSwiglu, pg8::SchedMoe<true>>(F.lds, 1024, S, E); }
        }
    }) SEAM(14);
    PH(15, {
        const int ntile = moe_tables(F, 1);
        if constexpr (FP8_G2_L1) {
            pg8::SchedMoe<false> S{(const char*)(ws + WS_BUFZ), (const char*)(ws + WS_W_M2) + (size_t)1 * 16 * MiB, nullptr, (const LAS int*)(F.lds + LDS_CTL + 64), (const LAS int*)(F.lds + LDS_CTL + 192), 256, (size_t)512 * KiB, ntile * 4, F.vcu, F.G};
            pg8::EpiStoreS E{(bf16*)(ws + WS_BUFP), 1024, 1.0f / (pg8::HID_SCALE * pg8::W2_SCALE)};
            pg8::gemm_phase<pg8::EpiStoreS, pg8::SchedMoe<false>, true>(F.lds, 256, S, E);
        } else {
            pg8::SchedMoe<false> S{(const char*)(ws + WS_BUFZ), (const char*)(ws + WS_W_M2) + (size_t)1 * 16 * MiB, nullptr, (const LAS int*)(F.lds + LDS_CTL + 64), (const LAS int*)(F.lds + LDS_CTL + 192), 512, (size_t)MiB, ntile * 4, F.vcu, F.G};
            pg8::EpiStore E{(bf16*)(ws + WS_BUFP), 1024};
            pg8::gemm_phase<pg8::EpiStore, pg8::SchedMoe<false>>(F.lds, 512, S, E);
        }
    }) SEAM(15);
    PH(16, { (void)moe_tables(F, 1); phase_combine(F, 1, TL); }) SEAM(16);
#ifdef DBG_XBAR
    if (hi - lo > 1) { for (int xb = 0; xb < DBG_XBAR; ++xb) xcd_barrier(bar); }
#endif
#undef IN
#undef SEAM
}

extern "C" void kernel_launch(void* const* d_in, const int* in_sizes, int n_in, void* d_out, int out_size, void* d_ws, size_t ws_size, hipStream_t stream) {
    static int grid = 0;
    if (grid == 0) {
        if (n_in != 22 || ws_size < WS_END) { fprintf(stderr, "kernel_launch: unexpected inputs (n_in %d, ws %zu)\n", n_in, ws_size); grid = -1; return; }
        int dev = 0, cus = 0, per_cu = 0;
        if (hipGetDevice(&dev) != hipSuccess || hipDeviceGetAttribute(&cus, hipDeviceAttributeMultiprocessorCount, dev) != hipSuccess) { grid = -1; return; }
        if (hipFuncSetAttribute((const void*)mk_fwd, hipFuncAttributeMaxDynamicSharedMemorySize, LDS_BYTES) != hipSuccess) { fprintf(stderr, "kernel_launch: hipFuncSetAttribute failed\n"); grid = -1; return; }
        if (hipOccupancyMaxActiveBlocksPerMultiprocessor(&per_cu, (const void*)mk_fwd, NWAVES * 64, LDS_BYTES) != hipSuccess || per_cu < 1) { fprintf(stderr, "kernel_launch: occupancy query says %d\n", per_cu); }
        (void)hipGetLastError();
        grid = cus;
        if (grid != 256) { fprintf(stderr, "kernel_launch: %d CUs; this build assumes 256\n", grid); }
    }
    if (grid < 0) return;
    (void)hipMemsetAsync((char*)d_ws + WS_CTL, 0, CTL_ZERO_BYTES, stream);
    Args a{};
    for (int i = 0; i < 22; ++i) a.in[i] = (const float*)d_in[i];
    a.out = (float*)d_out; a.ws = (unsigned char*)d_ws;
#if MK_MULTI
    for (int p = 0; p <= DBG_STOP; ++p) { a.ph_lo = p; a.ph_hi = p + 1; hipLaunchKernelGGL(mk_fwd, dim3(grid), dim3(NWAVES * 64), LDS_BYTES, stream, a); }
    if (DBG_STOP < 16) { a.ph_lo = 17; a.ph_hi = 18; hipLaunchKernelGGL(mk_fwd, dim3(grid), dim3(NWAVES * 64), LDS_BYTES, stream, a); }
#else
    a.ph_lo = 0; a.ph_hi = 17;
    hipLaunchKernelGGL(mk_fwd, dim3(grid), dim3(NWAVES * 64), LDS_BYTES, stream, a);
#endif
}
```

```cpp
#include <hip/hip_runtime.h>
#include <cstdio>
#include <cstdint>
#include <type_traits>

#ifndef MK_MULTI
#define MK_MULTI 0
#endif
#ifndef DBG_STOP
#define DBG_STOP 16
#endif

#ifndef DBG_DOUBLE
#define DBG_DOUBLE 0u
#endif
#ifndef FP8_G1_L0
#define FP8_G1_L0 1
#endif
#ifndef FP8_G1_L1
#define FP8_G1_L1 1
#endif
#ifndef FP8_G2_L0
#define FP8_G2_L0 1
#endif
#ifndef FP8_G2_L1
#define FP8_G2_L1 1
#endif
#define LAS __attribute__((address_space(3)))
#define GAS __attribute__((address_space(1)))
typedef unsigned short bf16;
typedef short bf16x8 __attribute__((ext_vector_type(8)));
typedef short s16x4 __attribute__((ext_vector_type(4)));
typedef float f32x4 __attribute__((ext_vector_type(4)));
typedef float f32x16 __attribute__((ext_vector_type(16)));
typedef unsigned u32x4 __attribute__((ext_vector_type(4)));
typedef unsigned u32x2 __attribute__((ext_vector_type(2)));

constexpr int NB = 8, NSEQ = 4096, D = 1024, LCTX = 256;
constexpr int TL = NB * NSEQ, TC = NB * LCTX, T = TL + TC;
constexpr int EIN = 2048;
constexpr int OIN = 1280;
constexpr int NE = 16, DE = 512;
constexpr int MAXSLOT = 73728;
constexpr float EPS = 1e-6f;

constexpr size_t KiB = 1024, MiB = 1024 * 1024;
constexpr size_t WS_CTL = 0, CTL_ZERO_BYTES = 64 * KiB;
constexpr size_t WS_MODS = 64 * KiB;
constexpr size_t WS_ROPE = WS_MODS + 512 * KiB;
constexpr size_t WS_WA = WS_ROPE + 8 * KiB;
constexpr size_t WS_WAC = WS_WA + 32 * KiB;
constexpr size_t WS_WCC = WS_WAC + 2 * KiB;
constexpr size_t WS_FD = 3 * MiB - 64 * KiB;
constexpr size_t WS_BCNT = WS_WCC + 16 * KiB;
constexpr size_t WS_TILEMAP = WS_BCNT + 16 * KiB;
constexpr size_t WS_SLOT = WS_TILEMAP + 2 * KiB;
constexpr size_t WS_WROW = WS_SLOT + 288 * KiB;
constexpr size_t WS_ROUTE = WS_WROW + 288 * KiB;
constexpr size_t WS_WC = 3 * MiB;
constexpr size_t WS_W_EIN = 4 * MiB;
constexpr size_t WS_W_EOUT = 9 * MiB;
constexpr size_t WS_W_OIN = 11 * MiB;
constexpr size_t WS_W_OOUT = 14 * MiB;
constexpr size_t WS_W_POOL = 16 * MiB;
constexpr size_t WS_W_M1 = 17 * MiB;
constexpr size_t WS_W_M2 = 81 * MiB;
constexpr size_t WS_HC = 113 * MiB;
constexpr size_t WS_BUFA = 121 * MiB;
constexpr size_t WS_BUFP = 189 * MiB;
constexpr size_t WS_BUFZ = 360 * MiB;
constexpr size_t WS_TOKMAP = 432 * MiB;
constexpr size_t WS_HB = 435 * MiB;
constexpr size_t WS_END = 503 * MiB;
constexpr size_t WS_GCNT = 16 * KiB;
static_assert(WS_ROUTE + (size_t)T * 32 <= WS_WC, "small region");
static_assert((size_t)T * EIN * 2 <= WS_BUFZ - WS_BUFP && (size_t)MAXSLOT * 1024 * 2 <= WS_BUFZ - WS_BUFP, "BUFP");
static_assert((size_t)MAXSLOT * 512 * 2 <= WS_TOKMAP - WS_BUFZ && (size_t)T * 1024 * 2 <= WS_TOKMAP - WS_BUFZ, "BUFZ");
static_assert((size_t)16 * T * 4 <= WS_HB - WS_TOKMAP && (size_t)T * 1024 * 2 <= WS_END - WS_HB, "TOKMAP / HB");
static_assert((size_t)T * 1024 * 2 <= WS_BUFP - WS_BUFA, "BUFA");

constexpr int LDS_BYTES = 163840;
constexpr int LDS_GIDX = 147456;
constexpr int LDS_CTL = 146432;
constexpr int NWAVES = 8;

__device__ __forceinline__ unsigned f2bf(float f) { unsigned u = __builtin_bit_cast(unsigned, f); return (u + 0x7fffu + ((u >> 16) & 1u)) >> 16; }
__device__ __forceinline__ unsigned pk2(float lo, float hi) { return f2bf(lo) | (f2bf(hi) << 16); }
__device__ __forceinline__ float bflo(unsigned w) { return __builtin_bit_cast(float, w << 16); }
__device__ __forceinline__ float bfhi(unsigned w) { return __builtin_bit_cast(float, w & 0xffff0000u); }
__device__ __forceinline__ float wave_sum(float v) {
#pragma unroll
    for (int o = 1; o < 64; o <<= 1) v += __shfl_xor(v, o);
    return v;
}
__device__ __forceinline__ int ld_coh(const int* p) { return (int)__hip_atomic_load((const unsigned*)p, __ATOMIC_RELAXED, __HIP_MEMORY_SCOPE_AGENT); }
__device__ __forceinline__ float ld_cohf(const float* p) { return __builtin_bit_cast(float, __hip_atomic_load((const unsigned*)p, __ATOMIC_RELAXED, __HIP_MEMORY_SCOPE_AGENT)); }
#define LDS_WAIT() asm volatile("s_waitcnt lgkmcnt(0)" ::: "memory")

#define XB_TMO      128
#define XB_XCNT(j)  (256  + 64 * (j))
#define XB_XSUB(j)  (1280 + 64 * (j))
#define XB_XGEN(j)  (2304 + 64 * (j))
#define XB_TOP      3328
#define XB_TOPGEN   3392
#define XCD_BAR_WORDS 3456
#define XB_SPIN_CAP (1u << 18)
__device__ __forceinline__ unsigned xb_ld(unsigned* p)              { return __hip_atomic_load(p, __ATOMIC_RELAXED, __HIP_MEMORY_SCOPE_AGENT); }
__device__ __forceinline__ unsigned xb_add(unsigned* p, unsigned v) { return __hip_atomic_fetch_add(p, v, __ATOMIC_RELAXED, __HIP_MEMORY_SCOPE_AGENT); }
__device__ __forceinline__ unsigned xb_xcc_id() { return (unsigned)__builtin_amdgcn_s_getreg((3 << 11) | 20) & 0xFu; }
#define XB_SPIN(cond, bar) do { unsigned _sp = 0; while (cond) { __builtin_amdgcn_s_sleep(1); \
    if ((++_sp & 255u) == 0u) { if (xb_ld(&(bar)[XB_TMO])) break; if (_sp > XB_SPIN_CAP) { atomicAdd(&(bar)[XB_TMO], 1u); break; } } } } while (0)
struct XcdBarrier { unsigned* bar; unsigned x; volatile LAS unsigned* st; };
__device__ __forceinline__ XcdBarrier xcd_barrier_post(unsigned* bar, volatile LAS unsigned* st) {
    XcdBarrier b; b.bar = bar; b.x = xb_xcc_id(); b.st = st;
    if (threadIdx.x == 0) (void)xb_add(&bar[XB_XCNT(b.x)], 1u);
    return b;
}
__device__ __forceinline__ void xcd_barrier_complete(unsigned* bar, unsigned x, unsigned& nloc, unsigned& nx) {
    const unsigned G = gridDim.x * gridDim.y * gridDim.z;
    unsigned sum, cnt, mine, sp = 0u;
    for (;;) {
        sum = 0u; cnt = 0u; mine = 0u;
#pragma unroll
        for (unsigned j = 0; j < 16; ++j) { const unsigned c = xb_ld(&bar[XB_XCNT(j)]); sum += c; cnt += (c > 0u) ? 1u : 0u; mine = (j == x) ? c : mine; }
        if (sum == G) break;
        __builtin_amdgcn_s_sleep(1);
        if ((++sp & 255u) == 0u) { if (xb_ld(&bar[XB_TMO])) break; if (sp > XB_SPIN_CAP) { atomicAdd(&bar[XB_TMO], 1u); break; } }
    }
    nloc = mine > 0u ? mine : 1u; nx = cnt > 0u ? cnt : 1u;
}
__device__ __forceinline__ void xcd_barrier(const XcdBarrier& b) {
    asm volatile("s_waitcnt vmcnt(0)" ::: "memory");
    __syncthreads();
    if (threadIdx.x == 0) {
        unsigned* bar = b.bar;
        __builtin_amdgcn_s_waitcnt(0);
        unsigned nloc = b.st[0], nx = b.st[1];
        if (nloc == 0u) { xcd_barrier_complete(bar, b.x, nloc, nx); b.st[0] = nloc; b.st[1] = nx; }
        const unsigned old = xb_add(&bar[XB_XSUB(b.x)], 1u);
        const unsigned gen = old / nloc;
        if (old + 1u == (gen + 1u) * nloc) {
            __builtin_amdgcn_fence(__ATOMIC_RELEASE, "agent");
            asm volatile("s_waitcnt vmcnt(0)" ::: "memory");
            const unsigned og = xb_add(&bar[XB_TOP], 1u);
            const unsigned tg = og / nx;
            if (og + 1u == (tg + 1u) * nx) xb_add(&bar[XB_TOPGEN], 1u);
            else XB_SPIN(xb_ld(&bar[XB_TOPGEN]) == tg, bar);
            __builtin_amdgcn_fence(__ATOMIC_ACQUIRE, "agent");
            xb_add(&bar[XB_XGEN(b.x)], 1u);
            asm volatile("s_waitcnt vmcnt(0)" ::: "memory");
        } else {
            XB_SPIN(xb_ld(&bar[XB_XGEN(b.x)]) == gen, bar);
            __builtin_amdgcn_fence(__ATOMIC_ACQUIRE, "agent");
            asm volatile("s_waitcnt vmcnt(0)" ::: "memory");
        }
    }
    __syncthreads();
}

namespace pg8 {
constexpr int BM = 256, BK = 64, HALF = 128, HTB = HALF * BK * 2, STAGE_BYTES = 8 * HTB;
__host__ __device__ __forceinline__ int lds_byte(int r, int c) { const int st = (r >> 4) * 2 + (c >> 5), rr = r & 15, cc = c & 31, ob = rr * 64 + cc * 2; return st * 1024 + (ob ^ (((ob >> 9) & 1) << 5)); }
__host__ __device__ __forceinline__ void stage_rc(int b, int& R, int& C) { const int st = b / 1024, sb = b % 1024, swz = sb ^ (((sb >> 9) & 1) << 5); R = (st >> 1) * 16 + swz / 64; C = (st & 1) * 32 + (swz % 64) / 2; }
__host__ __device__ __forceinline__ int perm32(int rho) { const int n = rho >> 4, i = rho & 15; return 8 * (i >> 2) + 4 * n + (i & 3); }
struct Unit { int pm, pn, e; };
__device__ __forceinline__ unsigned cvt_pk_bf16(float lo, float hi) { unsigned r; asm volatile("v_cvt_pk_bf16_f32 %0, %1, %2" : "=v"(r) : "v"(lo), "v"(hi)); return r; }

typedef int v8i32 __attribute__((ext_vector_type(8)));
typedef int v4i32 __attribute__((ext_vector_type(4)));
__device__ __forceinline__ v8i32 cat16(const bf16x8 lo, const bf16x8 hi) { return __builtin_shufflevector(__builtin_bit_cast(v4i32, lo), __builtin_bit_cast(v4i32, hi), 0, 1, 2, 3, 4, 5, 6, 7); }
template <class Epi, class Sched, bool FP8 = false>
__device__ __forceinline__ void gemm_phase(LAS unsigned char* lds, const int K, const Sched& S, const Epi& E) {
    const int tid = threadIdx.x, wid = __builtin_amdgcn_readfirstlane(tid >> 6), lane = tid & 63, wr = wid >> 2, wc = wid & 3, fr = lane & 15, fq = lane >> 4;
    const int nt = K / BK;
    int tidv = tid;
#define PG8_VB(i) ([&]() -> unsigned { int R_, C_; stage_rc(tidv * 16 + (i) * 8192, R_, C_); const int Rb_ = Epi::PERM ? ((R_ & ~31) + perm32(R_ & 31)) : R_; return (unsigned)(Rb_ * K + C_) * 2u; }())
#define PG8_VA(h, i) ([&]() -> unsigned { int R_, C_; stage_rc(tidv * 16 + (i) * 8192, R_, C_); return (unsigned)((128 * (h) + R_) * K + C_) * 2u; }())
    const size_t kstep = (size_t)(BK * 2);
    const size_t hstep = (size_t)HALF * K * 2;
    const unsigned ldsw = (unsigned)wid * 1024u;
#define aoff (lds_byte(wr * 64 + (tidv & 15), ((tidv >> 4) & 3) * 8))
#define boff (lds_byte(wc * 32 + (tidv & 15), ((tidv >> 4) & 3) * 8))
#define PG8_SA(b, h) (((b) * 2 + (h)) * HTB)
#define PG8_SB(b, h) ((4 + (b) * 2 + (h)) * HTB)
#define PG8_STAGEB(bufoff, gbase) do { _Pragma("unroll") for (int _i = 0; _i < 2; ++_i) \
        __builtin_amdgcn_global_load_lds((const unsigned*)((const char*)(gbase) + PG8_VB(_i)), (LAS unsigned*)(lds + (bufoff) + ldsw + _i * 8192), 16, 0, 0); } while (0)
#define PG8_STAGEA(bufoff, gbase, h, NEXT) do { _Pragma("unroll") for (int _i = 0; _i < 2; ++_i) { unsigned vo_; \
        if constexpr (Sched::GATHER) { int R_, C_; stage_rc(tidv * 16 + _i * 8192, R_, C_); const unsigned raw_ = gidx[((((NEXT) && usen) ? (gslot ^ 1u) : gslot) * 4u + (h) * 2 + _i) * 512u + tid]; vo_ = (raw_ * (unsigned)K + (unsigned)C_) * 2u; } \
        else vo_ = PG8_VA(h, _i); \
        __builtin_amdgcn_global_load_lds((const unsigned*)((const char*)(gbase) + vo_), (LAS unsigned*)(lds + (bufoff) + ldsw + _i * 8192), 16, 0, 0); } } while (0)
#define PG8_LDA(dst, b, h) do { _Pragma("unroll") for (int m = 0; m < 4; ++m) _Pragma("unroll") for (int k = 0; k < 2; ++k) dst[m][k] = *(const LAS bf16x8*)(lds + PG8_SA(b, h) + aoff + m * 2048 + k * 1024); } while (0)
#define PG8_LDB(dst, b, h) do { _Pragma("unroll") for (int n = 0; n < 2; ++n) _Pragma("unroll") for (int k = 0; k < 2; ++k) dst[n][k] = *(const LAS bf16x8*)(lds + PG8_SB(b, h) + boff + n * 2048 + k * 1024); } while (0)
#define PG8_MMA(ai, bj, At, Bt) do { __builtin_amdgcn_s_setprio(1); _Pragma("unroll") for (int m = 0; m < 4; ++m) _Pragma("unroll") for (int n = 0; n < 2; ++n) { \
        if constexpr (FP8) acc[ai][bj][m][n] = __builtin_amdgcn_mfma_scale_f32_16x16x128_f8f6f4(cat16(Bt[n][0], Bt[n][1]), cat16(At[m][0], At[m][1]), acc[ai][bj][m][n], 0, 0, 0, 0x7f7f7f7f, 0, 0x7f7f7f7f); \
        else { _Pragma("unroll") for (int k = 0; k < 2; ++k) acc[ai][bj][m][n] = __builtin_amdgcn_mfma_f32_16x16x32_bf16(Bt[n][k], At[m][k], acc[ai][bj][m][n], 0, 0, 0); } } \
        __builtin_amdgcn_s_setprio(0); } while (0)
#define PG8_WAIT_V(n) asm volatile("s_waitcnt vmcnt(" #n ")" ::: "memory")
#define PG8_WAIT_L(n) asm volatile("s_waitcnt lgkmcnt(" #n ")" ::: "memory")
#define PG8_BAR __builtin_amdgcn_s_barrier()
#define PG8_SCHED __builtin_amdgcn_sched_barrier(0)
#define PG8_ITER(A1, A2, A3, B2, B3) do { \
            PG8_LDB(B0, 0, 0); PG8_LDB(B1, 0, 1); PG8_SCHED; PG8_LDA(At, 0, 0); PG8_STAGEA(PG8_SA(1, 1), A1, 1, 0); \
            PG8_WAIT_V(8); PG8_WAIT_L(0); PG8_BAR; PG8_MMA(0, 0, At, B0); PG8_MMA(0, 1, At, B1); PG8_BAR; PG8_SCHED; \
            PG8_LDA(At, 0, 1); PG8_STAGEB(PG8_SB(0, 0), B2); PG8_STAGEB(PG8_SB(0, 1), (B2) + hstep); PG8_STAGEA(PG8_SA(0, 0), A2, 0, 1); \
            PG8_WAIT_V(8); PG8_WAIT_L(0); PG8_BAR; PG8_MMA(1, 0, At, B0); PG8_MMA(1, 1, At, B1); PG8_BAR; PG8_SCHED; \
            PG8_LDB(B0, 1, 0); PG8_LDB(B1, 1, 1); PG8_SCHED; PG8_LDA(At, 1, 0); PG8_STAGEA(PG8_SA(0, 1), A2, 1, 1); \
            PG8_WAIT_V(8); PG8_WAIT_L(0); PG8_BAR; PG8_MMA(0, 0, At, B0); PG8_MMA(0, 1, At, B1); PG8_BAR; PG8_SCHED; \
            PG8_LDA(At, 1, 1); PG8_STAGEB(PG8_SB(1, 0), B3); PG8_STAGEB(PG8_SB(1, 1), (B3) + hstep); PG8_STAGEA(PG8_SA(1, 0), A3, 0, 1); \
            PG8_WAIT_V(8); PG8_WAIT_L(0); PG8_BAR; PG8_MMA(1, 0, At, B0); PG8_MMA(1, 1, At, B1); PG8_BAR; PG8_SCHED; } while (0)
    Unit cur, nxt; int ui = 0;
    if (!S.next(0, cur)) return;
    f32x4 acc[2][2][4][2];
#pragma unroll
    for (int a = 0; a < 2; ++a)
#pragma unroll
        for (int b = 0; b < 2; ++b)
#pragma unroll
            for (int m = 0; m < 4; ++m)
#pragma unroll
                for (int n = 0; n < 2; ++n) acc[a][b][m][n] = (f32x4){0.f, 0.f, 0.f, 0.f};
    bf16x8 At[4][2], B0[2][2], B1[2][2];
    const LAS unsigned* gidx = (const LAS unsigned*)(lds + LDS_GIDX); unsigned gslot = 0u;
    if constexpr (Sched::GATHER) { S.idx_dma(cur, (LAS unsigned*)(lds + LDS_GIDX), tidv, wid); asm volatile("s_waitcnt vmcnt(0)" ::: "memory"); }
    const char* cA = S.a_base(cur); const char* cB = S.b_base(cur);
    constexpr bool usen = false;
    PG8_STAGEB(PG8_SB(0, 0), cB); PG8_STAGEB(PG8_SB(0, 1), cB + hstep); PG8_STAGEA(PG8_SA(0, 0), cA, 0, 0); PG8_STAGEA(PG8_SA(0, 1), cA, 1, 0);
    if (wr == 1) PG8_BAR;
    PG8_WAIT_V(2); PG8_BAR;
    PG8_STAGEB(PG8_SB(1, 0), cB + kstep); PG8_STAGEA(PG8_SA(1, 0), cA + kstep, 0, 0); PG8_STAGEB(PG8_SB(1, 1), cB + hstep + kstep);
    PG8_WAIT_V(6); PG8_BAR;
    for (;;) {
        const bool has_next = S.next(ui + 1, nxt);
        const char* nA = has_next ? S.a_base(nxt) : cA; const char* nB = has_next ? S.b_base(nxt) : cB;
#pragma unroll 1
        for (int t = 0; t < nt; t += 2) {
            const bool last = (t == nt - 2);
            const char* a1 = cA + (size_t)(t + 1) * kstep;
            const char* a2 = last ? nA : cA + (size_t)(t + 2) * kstep; const char* b2 = last ? nB : cB + (size_t)(t + 2) * kstep;
            tidv = tid; asm volatile("" : "+v"(tidv));
            if constexpr (Sched::GATHER) {
                if (t == nt - 4 && has_next) S.idx_dma(nxt, (LAS unsigned*)(lds + LDS_GIDX) + (gslot ^ 1u) * 2048u, tidv, wid);
            }
            const bool usen = last && has_next;
            PG8_ITER(a1, a2, a2 + kstep, b2, b2 + kstep);
        }
        if (wr == 0) PG8_BAR;
        E(acc, cur, wr, wc, fr, fq);
        if (!has_next) break;
#pragma unroll
        for (int a = 0; a < 2; ++a)
#pragma unroll
            for (int b = 0; b < 2; ++b)
#pragma unroll
                for (int m = 0; m < 4; ++m)
#pragma unroll
                    for (int n = 0; n < 2; ++n) acc[a][b][m][n] = (f32x4){0.f, 0.f, 0.f, 0.f};
        cur = nxt; cA = nA; cB = nB; ++ui;
        if constexpr (Sched::GATHER) gslot ^= 1u;
        if (wr == 1) PG8_BAR;
    }
    PG8_WAIT_V(0);
    PG8_BAR;
#undef PG8_ITER
#undef aoff
#undef boff
#undef PG8_SA
#undef PG8_SB
#undef PG8_STAGEA
#undef PG8_STAGEB
#undef PG8_VA
#undef PG8_VB
#undef PG8_LDA
#undef PG8_LDB
#undef PG8_MMA
#undef PG8_WAIT_V
#undef PG8_WAIT_L
#undef PG8_BAR
#undef PG8_SCHED
}

struct SchedDense {
    static constexpr bool GATHER = false;
    const char* A; const char* Bt; int K, nN, nMfull, pnx, nUnits, c, G;
    __device__ __forceinline__ bool next(int i, Unit& u) const {
        const int L = i * G + c; if (L >= nUnits) return false;
        const int full = nMfull * nN;
        if (L < full) { u.pm = L / nN; u.pn = L - u.pm * nN; } else { u.pm = nMfull + (L - full); u.pn = pnx; }
        u.e = 0; return true;
    }
    __device__ __forceinline__ const char* a_base(const Unit& u) const { return A + (size_t)u.pm * 256 * K * 2; }
    __device__ __forceinline__ const char* b_base(const Unit& u) const { return Bt + (size_t)u.pn * 256 * K * 2; }
};
template <bool GATHER_> struct SchedMoe {
    static constexpr bool GATHER = GATHER_, gather = GATHER_;
    const char* A; const char* W; const int* tokmap; const LAS int* tb; const LAS int* cn; int K; size_t wstride; int nUnits, c, G;
    __device__ __forceinline__ bool next(int i, Unit& u) const {
        const int L = i * G + c; if (L >= nUnits) return false;
        u.pm = L >> 2; u.pn = L & 3; int e = 0;
#pragma unroll
        for (int q = 1; q < 16; ++q) if (u.pm >= __builtin_amdgcn_readfirstlane(tb[q])) e = q;
        u.e = __builtin_amdgcn_readfirstlane(e); return true;
    }
    __device__ __forceinline__ const char* a_base(const Unit& u) const { return gather ? A : A + (size_t)u.pm * 256 * K * 2; }
    __device__ __forceinline__ const char* b_base(const Unit& u) const { return W + (size_t)u.e * wstride + (size_t)u.pn * 256 * K * 2; }
    __device__ __forceinline__ void idx_dma(const Unit& u, LAS unsigned* slot, int tidv, int wid) const {
        const int p0 = (u.pm - __builtin_amdgcn_readfirstlane(tb[u.e])) * 256, last = __builtin_amdgcn_readfirstlane(cn[u.e]) - 1; const int* tm = tokmap + (size_t)u.e * T;
#pragma unroll
        for (int h = 0; h < 2; ++h)
#pragma unroll
            for (int i = 0; i < 2; ++i) { int R_, C_; stage_rc(tidv * 16 + i * 8192, R_, C_); int pos = p0 + 128 * h + R_; pos = pos < last ? pos : last;
                __builtin_amdgcn_global_load_lds((const unsigned*)(tm + pos), slot + (h * 2 + i) * 512 + wid * 64, 4, 0, 0); }
    }
};

struct EpiStore {
    static constexpr bool PERM = true;
    bf16* O; int ldc;
    __device__ __forceinline__ void operator()(const f32x4 (&acc)[2][2][4][2], const Unit& u, int wr, int wc, int fr, int fq) const {
        const int row0 = u.pm * BM + wr * 64 + fr, col0 = u.pn * BM + wc * 32 + 8 * fq;
#pragma unroll
        for (int ai = 0; ai < 2; ++ai)
#pragma unroll
            for (int m = 0; m < 4; ++m) { bf16* rowp = O + (size_t)(row0 + ai * HALF + m * 16) * ldc + col0;
#pragma unroll
                for (int bj = 0; bj < 2; ++bj) { const f32x4 v0 = acc[ai][bj][m][0], v1 = acc[ai][bj][m][1];
                    u32x4 w; w.x = cvt_pk_bf16(v0[0], v0[1]); w.y = cvt_pk_bf16(v0[2], v0[3]); w.z = cvt_pk_bf16(v1[0], v1[1]); w.w = cvt_pk_bf16(v1[2], v1[3]);
                    *(u32x4*)(rowp + bj * HALF) = w; } }
    }
};
template <bool SRC_F32> struct EpiResid {
    static constexpr bool PERM = true;
    const float* srcL; const float* srcC; bf16* H; const float* gate;
    __device__ __forceinline__ void operator()(const f32x4 (&acc)[2][2][4][2], const Unit& u, int wr, int wc, int fr, int fq) const {
        const float* g = gate + (u.pm < 128 ? (u.pm >> 4) : 8) * 6144;
        const float* src = (u.pm < 128) ? srcL + (size_t)u.pm * 256 * 1024 : srcC + (size_t)(u.pm - 128) * 256 * 1024;
        bf16* dst = H + (size_t)u.pm * 256 * 1024;
        const int row0 = wr * 64 + fr, col0 = u.pn * BM + wc * 32 + 8 * fq;
        f32x4 gv[2][2];
#pragma unroll
        for (int bj = 0; bj < 2; ++bj)
#pragma unroll
            for (int n = 0; n < 2; ++n) gv[bj][n] = *(const f32x4*)(g + col0 + bj * HALF + 4 * n);
#pragma unroll
        for (int ai = 0; ai < 2; ++ai)
#pragma unroll
            for (int m = 0; m < 4; ++m) { const size_t ro = (size_t)(row0 + ai * HALF + m * 16) * 1024 + col0;
#pragma unroll
                for (int bj = 0; bj < 2; ++bj) {
                    f32x4 s0, s1;
                    if constexpr (SRC_F32) { s0 = *(const f32x4*)(src + ro + bj * HALF); s1 = *(const f32x4*)(src + ro + bj * HALF + 4); }
                    else { const u32x4 hv = *(const u32x4*)(dst + ro + bj * HALF); s0 = (f32x4){bflo(hv.x), bfhi(hv.x), bflo(hv.y), bfhi(hv.y)}; s1 = (f32x4){bflo(hv.z), bfhi(hv.z), bflo(hv.w), bfhi(hv.w)}; }
                    const f32x4 v0 = s0 + gv[bj][0] * acc[ai][bj][m][0], v1 = s1 + gv[bj][1] * acc[ai][bj][m][1];
                    u32x4 w; w.x = cvt_pk_bf16(v0[0], v0[1]); w.y = cvt_pk_bf16(v0[2], v0[3]); w.z = cvt_pk_bf16(v1[0], v1[1]); w.w = cvt_pk_bf16(v1[2], v1[3]);
                    *(u32x4*)(dst + ro + bj * HALF) = w; } }
    }
};
__device__ __forceinline__ float silu_f(float x) { return x * __builtin_amdgcn_rcpf(1.0f + __expf(-x)); }
struct EpiSwiglu {
    static constexpr bool PERM = true;
    bf16* H;
    __device__ __forceinline__ void operator()(const f32x4 (&acc)[2][2][4][2], const Unit& u, int wr, int wc, int fr, int fq) const {
        const int row0 = u.pm * BM + wr * 64 + fr, col0 = u.pn * 128 + wc * 32 + 8 * fq;
#pragma unroll
        for (int ai = 0; ai < 2; ++ai)
#pragma unroll
            for (int m = 0; m < 4; ++m) { bf16* p = H + (size_t)(row0 + ai * HALF + m * 16) * 512 + col0;
                const f32x4 g0 = acc[ai][0][m][0], g1 = acc[ai][0][m][1], u0 = acc[ai][1][m][0], u1 = acc[ai][1][m][1];
                u32x4 w; w.x = cvt_pk_bf16(silu_f(g0[0]) * u0[0], silu_f(g0[1]) * u0[1]); w.y = cvt_pk_bf16(silu_f(g0[2]) * u0[2], silu_f(g0[3]) * u0[3]);
                w.z = cvt_pk_bf16(silu_f(g1[0]) * u1[0], silu_f(g1[1]) * u1[1]); w.w = cvt_pk_bf16(silu_f(g1[2]) * u1[2], silu_f(g1[3]) * u1[3]);
                *(u32x4*)p = w; }
    }
};
__device__ __forceinline__ unsigned pk4_fp8(float a, float b, float c, float d) { int p = __builtin_amdgcn_cvt_pk_fp8_f32(a, b, 0, false); p = __builtin_amdgcn_cvt_pk_fp8_f32(c, d, p, true); return (unsigned)p; }
constexpr float W1_SCALE = 32.0f, W2_SCALE = 16.0f, HID_SCALE = 4.0f;
struct EpiSwiglu8 {
    static constexpr bool PERM = true;
    unsigned char* H; float in_scale;
    __device__ __forceinline__ void operator()(const f32x4 (&acc)[2][2][4][2], const Unit& u, int wr, int wc, int fr, int fq) const {
        const int row0 = u.pm * BM + wr * 64 + fr, col0 = u.pn * 128 + wc * 32 + 8 * fq;
        const float IS = 1.0f / in_scale, OS = HID_SCALE / in_scale;
#pragma unroll
        for (int ai = 0; ai < 2; ++ai)
#pragma unroll
            for (int m = 0; m < 4; ++m) { unsigned char* p = H + (size_t)(row0 + ai * HALF + m * 16) * 512 + col0;
                const f32x4 g0 = acc[ai][0][m][0] * IS, g1 = acc[ai][0][m][1] * IS, u0 = acc[ai][1][m][0] * OS, u1 = acc[ai][1][m][1] * OS;
#define HC8(x) __builtin_fminf(__builtin_fmaxf((x), -448.0f), 448.0f)
                u32x2 w; w.x = pk4_fp8(HC8(silu_f(g0[0]) * u0[0]), HC8(silu_f(g0[1]) * u0[1]), HC8(silu_f(g0[2]) * u0[2]), HC8(silu_f(g0[3]) * u0[3]));
                w.y = pk4_fp8(HC8(silu_f(g1[0]) * u1[0]), HC8(silu_f(g1[1]) * u1[1]), HC8(silu_f(g1[2]) * u1[2]), HC8(silu_f(g1[3]) * u1[3]));
#undef HC8
                *(u32x2*)p = w; }
    }
};
struct EpiStoreS {
    static constexpr bool PERM = true;
    bf16* O; int ldc; float scale;
    __device__ __forceinline__ void operator()(const f32x4 (&acc)[2][2][4][2], const Unit& u, int wr, int wc, int fr, int fq) const {
        const int row0 = u.pm * BM + wr * 64 + fr, col0 = u.pn * BM + wc * 32 + 8 * fq;
#pragma unroll
        for (int ai = 0; ai < 2; ++ai)
#pragma unroll
            for (int m = 0; m < 4; ++m) { bf16* rowp = O + (size_t)(row0 + ai * HALF + m * 16) * ldc + col0;
#pragma unroll
                for (int bj = 0; bj < 2; ++bj) { const f32x4 v0 = acc[ai][bj][m][0] * scale, v1 = acc[ai][bj][m][1] * scale;
                    u32x4 w; w.x = cvt_pk_bf16(v0[0], v0[1]); w.y = cvt_pk_bf16(v0[2], v0[3]); w.z = cvt_pk_bf16(v1[0], v1[1]); w.w = cvt_pk_bf16(v1[2], v1[3]);
                    *(u32x4*)(rowp + bj * HALF) = w; } }
    }
};
struct EpiScaleRow {
    static constexpr bool PERM = true;
    bf16* O; const float* wrow;
    __device__ __forceinline__ void operator()(const f32x4 (&acc)[2][2][4][2], const Unit& u, int wr, int wc, int fr, int fq) const {
        const int row0 = u.pm * BM + wr * 64 + fr, col0 = u.pn * BM + wc * 32 + 8 * fq;
#pragma unroll
        for (int ai = 0; ai < 2; ++ai)
#pragma unroll
            for (int m = 0; m < 4; ++m) { const int row = row0 + ai * HALF + m * 16; const float s = wrow[row]; bf16* rowp = O + (size_t)row * 1024 + col0;
#pragma unroll
                for (int bj = 0; bj < 2; ++bj) { const f32x4 v0 = acc[ai][bj][m][0] * s, v1 = acc[ai][bj][m][1] * s;
                    u32x4 w; w.x = cvt_pk_bf16(v0[0], v0[1]); w.y = cvt_pk_bf16(v0[2], v0[3]); w.z = cvt_pk_bf16(v1[0], v1[1]); w.w = cvt_pk_bf16(v1[2], v1[3]);
                    *(u32x4*)(rowp + bj * HALF) = w; } }
    }
};
}

struct Args { const float* in[22]; float* out; unsigned char* ws; int ph_lo, ph_hi; };
enum { I_X = 0, I_C, I_CTX, I_CCTX, I_ADAW, I_ADAB, I_NMG, I_NFG, I_EWIN, I_ECONV, I_EWOUT, I_OWIN, I_OPOOLW, I_OPOOLS, I_OSINK, I_OWOUT, I_RW, I_RB, I_MG, I_MU, I_MD, I_FG };

struct Frame {
    LAS unsigned char* lds;
    int tid, lane, wave, vcu, G;
    unsigned char* ws; const float* const* in; float* out;
};
__device__ __forceinline__ bf16* h_row(const Frame& F, int t) { return (bf16*)(F.ws + WS_HB) + (size_t)t * D; }
__device__ __forceinline__ int mod_row(int t) { return t < TL ? (t >> 12) : 8; }

struct TItem { const float* src; bf16* dst; int ldw, ldd; float f8scale; };
__device__ __forceinline__ void titem_load(const TItem& t, f32x4 (&r)[8], int lane) {
#pragma unroll
    for (int i = 0; i < 8; ++i) r[i] = __builtin_nontemporal_load((const f32x4*)(t.src + (size_t)((lane >> 3) + 8 * i) * t.ldw + 4 * (lane & 7)));
}
__device__ __forceinline__ void titem_process(const TItem& t, const f32x4 (&r)[8], LAS float* scr, int lane) {
#pragma unroll
    for (int i = 0; i < 8; ++i) { LAS float* d = scr + ((lane >> 3) + 8 * i) * 33 + 4 * (lane & 7); d[0] = r[i].x; d[1] = r[i].y; d[2] = r[i].z; d[3] = r[i].w; }
    LDS_WAIT(); asm volatile("" ::: "memory");
    const int c = lane & 7;
    if (t.f8scale != 0.0f) {
        const float sc = t.f8scale; unsigned char* d8 = (unsigned char*)t.dst;
#pragma unroll
        for (int j = 0; j < 4; ++j) { const int n = (lane >> 3) + 8 * j; const LAS float* s = scr + (8 * c) * 33 + n;
            u32x2 o; o.x = pg8::pk4_fp8(s[0 * 33] * sc, s[1 * 33] * sc, s[2 * 33] * sc, s[3 * 33] * sc); o.y = pg8::pk4_fp8(s[4 * 33] * sc, s[5 * 33] * sc, s[6 * 33] * sc, s[7 * 33] * sc);
            *(u32x2*)(d8 + (size_t)n * t.ldd + 8 * c) = o; }
    } else {
#pragma unroll
        for (int j = 0; j < 4; ++j) { const int n = (lane >> 3) + 8 * j; const LAS float* s = scr + (8 * c) * 33 + n;
            u32x4 o; o.x = pk2(s[0 * 33], s[1 * 33]); o.y = pk2(s[2 * 33], s[3 * 33]); o.z = pk2(s[4 * 33], s[5 * 33]); o.w = pk2(s[6 * 33], s[7 * 33]);
            *(u32x4*)(t.dst + (size_t)n * t.ldd + 8 * c) = o; }
    }
    LDS_WAIT(); asm volatile("" ::: "memory");
}
constexpr int TS0 = 1024, TS1 = 512, TS2 = 384, TS3 = 512, TS4 = 0, TS5 = 8192, TS6 = 8192, TS7 = 8192, TNITEMS = TS0 + TS1 + TS2 + TS3 + TS4 + TS5 + TS6 + TS7;
__device__ __forceinline__ TItem titem_moe(const float* const* in, unsigned char* ws, int kind, int le, int rr) {
    TItem t; const int layer = le >> 4, e = le & 15; const bool f8 = (kind < 2) ? (layer ? (FP8_G1_L1 != 0) : (FP8_G1_L0 != 0)) : (layer ? (FP8_G2_L1 != 0) : (FP8_G2_L0 != 0));
    if (kind < 2) { const int kb = (rr >> 4) & 15, nb = rr & 15, n0 = nb * 32; const int drow = (n0 >> 7) * 256 + (n0 & 127) + kind * 128;
        t.src = in[kind ? I_MU : I_MG] + (size_t)le * 524288 + (size_t)(kb * 64) * 512 + n0; t.ldw = 512;
        unsigned char* base = ws + WS_W_M1 + (size_t)layer * 32 * MiB;
        if (f8) { t.dst = (bf16*)(base + (size_t)e * MiB + (size_t)drow * 1024 + kb * 64); t.ldd = 1024; t.f8scale = pg8::W1_SCALE; }
        else { t.dst = (bf16*)(base + (size_t)e * 2 * MiB) + (size_t)drow * 1024 + kb * 64; t.ldd = 1024; t.f8scale = 0.0f; } }
    else { const int kb = (rr >> 5) & 7, nb = rr & 31;
        t.src = in[I_MD] + (size_t)le * 524288 + (size_t)(kb * 64) * 1024 + nb * 32; t.ldw = 1024;
        unsigned char* base = ws + WS_W_M2 + (size_t)layer * 16 * MiB;
        if (f8) { t.dst = (bf16*)(base + (size_t)e * 512 * KiB + (size_t)(nb * 32) * 512 + kb * 64); t.ldd = 512; t.f8scale = pg8::W2_SCALE; }
        else { t.dst = (bf16*)(base + (size_t)e * MiB) + (size_t)(nb * 32) * 512 + kb * 64; t.ldd = 512; t.f8scale = 0.0f; } }
    return t;
}
__device__ __forceinline__ TItem titem_decode(const float* const* in, unsigned char* ws, int r) {
    TItem t;
    if (r < TS0) { const int kb = r / 64, nb = r % 64; t.src = in[I_EWIN] + (size_t)(kb * 64) * 2048 + nb * 32; t.ldw = 2048; t.dst = (bf16*)(ws + WS_W_EIN) + (size_t)(nb * 32) * 1024 + kb * 64; t.ldd = 1024; t.f8scale = 0.0f; return t; } r -= TS0;
    if (r < TS1) { const int kb = r / 32, nb = r % 32; t.src = in[I_EWOUT] + (size_t)(kb * 64) * 1024 + nb * 32; t.ldw = 1024; t.dst = (bf16*)(ws + WS_W_EOUT) + (size_t)(nb * 32) * 1024 + kb * 64; t.ldd = 1024; t.f8scale = 0.0f; return t; } r -= TS1;
    if (r < TS2) { const int kb = r / 24, nb = 16 + r % 24; t.src = in[I_OWIN] + (size_t)(kb * 64) * 1280 + nb * 32; t.ldw = 1280; t.dst = (bf16*)(ws + WS_W_OIN) + (size_t)(nb * 32) * 1024 + kb * 64; t.ldd = 1024; t.f8scale = 0.0f; return t; } r -= TS2;
    if (r < TS3) { const int kb = r / 32, nb = r % 32; t.src = in[I_OWOUT] + (size_t)(kb * 64) * 1024 + nb * 32; t.ldw = 1024; t.dst = (bf16*)(ws + WS_W_OOUT) + (size_t)(nb * 32) * 1024 + kb * 64; t.ldd = 1024; t.f8scale = 0.0f; return t; } r -= TS3;
    if (r < TS5 + TS6 + TS7) return titem_moe(in, ws, r / 8192, (r % 8192) >> 8, r % 256);
    return t;
}
constexpr int NL1 = 12288;
__device__ __forceinline__ TItem titem_l1(const float* const* in, unsigned char* ws, int r) { return titem_moe(in, ws, r / 4096, 16 + ((r % 4096) >> 8), r % 256); }

constexpr size_t WS_CONVCTR = 20 * KiB;
__device__ __forceinline__ void convert_l1(Frame& F, int quota) {
    unsigned* ctr = (unsigned*)(F.ws + WS_CONVCTR);
    LAS float* scr = (LAS float*)(F.lds + F.wave * 17408);
    for (int ch = 0; ch < quota; ++ch) {
        const int c0 = __builtin_amdgcn_readfirstlane(F.lane == 0 ? (int)__hip_atomic_fetch_add(ctr, 4u, __ATOMIC_RELAXED, __HIP_MEMORY_SCOPE_AGENT) : 0);
        if (c0 >= NL1) break;
        f32x4 cur[8], nxt[8];
        TItem tc = titem_l1(F.in, F.ws, c0);
        titem_load(tc, nxt, F.lane);
#pragma unroll 1
        for (int i = 0; i < 4; ++i) {
#pragma unroll
            for (int j = 0; j < 8; ++j) cur[j] = nxt[j];
            const TItem tcur = tc;
            if (i < 3) { tc = titem_l1(F.in, F.ws, c0 + i + 1); titem_load(tc, nxt, F.lane); }
            titem_process(tcur, cur, scr, F.lane);
        }
    }
}
__device__ __forceinline__ void tail_fill(Frame& F, int nUnits, int quota) {
    const int rounds = (nUnits + F.G - 1) / F.G;
    if ((rounds - 1) * F.G + F.vcu >= nUnits) convert_l1(F, quota);
}

__device__ __forceinline__ void norm_mod_store(const f32x4 (&v)[4], const float* g, const float* shift, const float* scale, bf16* orow, int lane) {
    float s2 = 0.f;
#pragma unroll
    for (int j = 0; j < 4; ++j) s2 += (v[j].x * v[j].x + v[j].y * v[j].y) + (v[j].z * v[j].z + v[j].w * v[j].w);
    const float rstd = 1.0f / sqrtf(wave_sum(s2) * (1.0f / D) + EPS);
#pragma unroll
    for (int j = 0; j < 4; ++j) { const int c = 4 * lane + 256 * j;
        const f32x4 gg = *(const f32x4*)(g + c), sh = *(const f32x4*)(shift + c), sc = *(const f32x4*)(scale + c);
        const f32x4 y = v[j] * rstd * gg * (sc + 1.0f) + sh;
        u32x2 o; o.x = pk2(y.x, y.y); o.y = pk2(y.z, y.w);
        *(u32x2*)(orow + c) = o; }
}

template <int NQ> __device__ __forceinline__ void p1_tokens(Frame& F, int t) {
    const float* mods = (const float*)(F.ws + WS_MODS);
    bf16* A = (bf16*)(F.ws + WS_BUFA);
    f32x4 v[NQ][4];
#pragma unroll
    for (int q = 0; q < NQ; ++q) { const int tq = t + q; const float* xr = tq < TL ? F.in[I_X] + (size_t)tq * D : F.in[I_CTX] + (size_t)(tq - TL) * D;
#pragma unroll
        for (int j = 0; j < 4; ++j) v[q][j] = __builtin_nontemporal_load((const f32x4*)(xr + 4 * F.lane + 256 * j)); }
    const float* m = mods + (size_t)mod_row(t) * 6144;
#pragma unroll
    for (int q = 0; q < NQ; ++q) norm_mod_store(v[q], F.in[I_NMG], m, m + 1024, A + (size_t)(t + q) * D, F.lane);
}
__device__ __forceinline__ void phase_mods(Frame& F) {
    const float* const* in = F.in;
    LAS float* S = (LAS float*)F.lds;
    LAS float* red = S + 9 * 1024;
    for (int i = F.tid; i < 9 * 1024; i += 512) { const float v = (i < 8192) ? in[I_C][i] : in[I_CCTX][i - 8192]; S[i] = v / (1.0f + expf(-v)); }
    __syncthreads();
    const int bx = blockIdx.x, layer = bx >> 7, col0 = (bx & 127) * 48;
    const int j = F.tid % 12, rg = F.tid / 12;
    if (rg < 42) {
        const float* W = in[I_ADAW] + (size_t)layer * 1024 * 6144 + col0 + 4 * j;
        f32x4 w[25];
#pragma unroll
        for (int i = 0; i < 25; ++i) { const int k = rg + 42 * i; w[i] = (k < 1024) ? __builtin_nontemporal_load((const f32x4*)(W + (size_t)k * 6144)) : (f32x4){0.f, 0.f, 0.f, 0.f}; }
        f32x4 acc[9];
#pragma unroll
        for (int r = 0; r < 9; ++r) acc[r] = (f32x4){0.f, 0.f, 0.f, 0.f};
#pragma unroll
        for (int i = 0; i < 25; ++i) { const int k = min(rg + 42 * i, 1023);
#pragma unroll
            for (int r = 0; r < 9; ++r) acc[r] += w[i] * S[r * 1024 + k]; }
#pragma unroll
        for (int r = 0; r < 9; ++r) *(LAS f32x4*)(red + (rg * 9 + r) * 48 + 4 * j) = acc[r];
    }
    __syncthreads();
    for (int i = F.tid; i < 432; i += 512) { const int r = i / 48, c = i % 48; float sum = in[I_ADAB][layer * 6144 + col0 + c];
        for (int g = 0; g < 42; ++g) sum += red[(g * 9 + r) * 48 + c];
        ((float*)(F.ws + WS_MODS))[(layer * 9 + r) * 6144 + col0 + c] = sum; }
}

__device__ __forceinline__ void phase_prologue_a(Frame& F) {
    const float* const* in = F.in;
    unsigned char* ws = F.ws;
    LAS float* ldsf = (LAS float*)F.lds;
    __syncthreads();
    {
        const int gt = blockIdx.x * 512 + F.tid, NT = F.G * 512;
        float* rope = (float*)(ws + WS_ROPE);
        for (int i = gt; i < 1024; i += NT) { const int coord = i >> 4, q = i & 15; const float inv = powf(10000.0f, -(float)q / 16.0f); const float ang = (float)coord * inv;
            rope[i] = cosf(ang); rope[1024 + i] = sinf(ang); }
        bf16* WA = (bf16*)(ws + WS_WA);
        for (int i = gt; i < 128 * 128; i += NT) { const int m = i >> 7, k = i & 127, rp = m >> 6, j1 = m & 63, ri = k >> 6, n1 = k & 63;
            const float a = 2.0f * (float)((j1 * n1) & 63) / 64.0f; const float c = cospif(a), s = sinpif(a);
            const float v = (rp == 0) ? (ri == 0 ? c : s) : (ri == 0 ? -s : c); WA[i] = (bf16)f2bf(v); }
        bf16* WAC = (bf16*)(ws + WS_WAC);
        for (int i = gt; i < 32 * 32; i += NT) { const int m = i >> 5, k = i & 31, rp = m >> 4, j1 = m & 15, ri = k >> 4, n1 = k & 15;
            const float a = 2.0f * (float)((j1 * n1) & 15) / 16.0f; const float c = cospif(a), s = sinpif(a);
            const float v = (rp == 0) ? (ri == 0 ? c : s) : (ri == 0 ? -s : c); WAC[i] = (bf16)f2bf(v); }
        bf16* WC = (bf16*)(ws + WS_WC);
        for (int i = gt; i < 64 * 64 * 128; i += NT) { const int j1 = i >> 13, j2 = (i >> 7) & 63, k = i & 127, ri = k >> 6, n2 = k & 63;
            const float a = 2.0f * (float)((n2 * (j1 + 64 * j2)) & 4095) / 4096.0f; const float v = (ri == 0 ? cospif(a) : sinpif(a)) * (1.0f / 64.0f); WC[i] = (bf16)f2bf(v); }
        bf16* FD = (bf16*)(ws + WS_FD);
        for (int i = gt; i < 256 * 128; i += NT) { const int col = i >> 7, c = i & 127, ri = col >> 7, k2 = col & 127;
            const float a = 2.0f * (float)((c * k2) & 127) / 128.0f; const float v = (ri == 0 ? cospif(a) : -sinpif(a)) * 0.08838834764831845f; FD[i] = (bf16)f2bf(v); }
        bf16* WCC = (bf16*)(ws + WS_WCC);
        for (int i = gt; i < 16 * 16 * 32; i += NT) { const int j1 = i >> 9, j2 = (i >> 5) & 15, k = i & 31, ri = k >> 4, n2 = k & 15;
            const float a = 2.0f * (float)((n2 * (j1 + 16 * j2)) & 255) / 256.0f; const float v = (ri == 0 ? cospif(a) : sinpif(a)) * (1.0f / 16.0f); WCC[i] = (bf16)f2bf(v); }
    }
    LAS float* tw = (LAS float*)(F.lds + 139264);
    if (F.tid < 128) { const float a = 2.0f * (float)F.tid / 128.0f; tw[F.tid] = cospif(a); tw[128 + F.tid] = sinpif(a); }
    __syncthreads();
    LAS float* scr = (LAS float*)(F.lds + F.wave * 17408);
    const int gw = F.vcu * NWAVES + F.wave, NGW = F.G * NWAVES;
    const int fid = F.vcu * 2 + F.wave;
    if (F.wave < 2) { const int r = fid;
        const int g = r >> 7, db = (r >> 5) & 3, kb = r & 31, k0 = kb * 32, d0 = db * 32;
        const float* Wp = in[I_OWIN] + (size_t)k0 * 1280 + g * 128;
        { float tl[32][2];
#pragma unroll
          for (int rr = 0; rr < 32; ++rr) { tl[rr][0] = Wp[(size_t)rr * 1280 + F.lane]; tl[rr][1] = Wp[(size_t)rr * 1280 + 64 + F.lane]; }
#pragma unroll
          for (int rr = 0; rr < 32; ++rr) { scr[rr * 129 + F.lane] = tl[rr][0]; scr[rr * 129 + 64 + F.lane] = tl[rr][1]; } }
        LDS_WAIT(); asm volatile("" ::: "memory");
        const int k = F.lane & 31, oh = F.lane >> 5;
        const float* pw = in[I_OPOOLW] + (size_t)g * 16384 + d0 + 16 * oh;
        float acc[16];
#pragma unroll
        for (int t = 0; t < 16; ++t) acc[t] = 0.f;
        for (int c0 = 0; c0 < 128; c0 += 8) {
            f32x4 p[8][4];
#pragma unroll
            for (int cc = 0; cc < 8; ++cc)
#pragma unroll
                for (int j = 0; j < 4; ++j) p[cc][j] = *(const f32x4*)(pw + (c0 + cc) * 128 + 4 * j);
#pragma unroll
            for (int cc = 0; cc < 8; ++cc) { const float w = scr[k * 129 + c0 + cc];
#pragma unroll
                for (int j = 0; j < 4; ++j) { acc[4 * j] += w * p[cc][j].x; acc[4 * j + 1] += w * p[cc][j].y; acc[4 * j + 2] += w * p[cc][j].z; acc[4 * j + 3] += w * p[cc][j].w; } }
        }
        const float* psc = in[I_OPOOLS] + g * 128 + d0 + 16 * oh;
        bf16* dst = (bf16*)(ws + WS_W_OIN) + (size_t)(g * 128 + d0 + 16 * oh) * 1024 + k0 + k;
#pragma unroll
        for (int t = 0; t < 16; ++t) dst[(size_t)t * 1024] = (bf16)f2bf(acc[t] * psc[t]);
        LDS_WAIT(); asm volatile("" ::: "memory");
    }
    {
        LAS unsigned* ctr = (LAS unsigned*)(F.lds + LDS_CTL + 32);
        constexpr int PER = (TNITEMS + 255) / 256;
        const int base = F.vcu * PER, lim = min(PER, TNITEMS - base);
        f32x4 cur[8], nxt[8];
        int it = __builtin_amdgcn_readfirstlane(F.lane == 0 ? (int)atomicAdd((unsigned*)ctr, 1u) : 0);
        TItem tc = titem_decode(in, ws, base + (it < lim ? it : 0));
        if (it < lim) titem_load(tc, nxt, F.lane);
        while (it < lim) {
#pragma unroll
            for (int i = 0; i < 8; ++i) cur[i] = nxt[i];
            const TItem tcur = tc;
            const int itn = __builtin_amdgcn_readfirstlane(F.lane == 0 ? (int)atomicAdd((unsigned*)ctr, 1u) : 0);
            if (itn < lim) { tc = titem_decode(in, ws, base + itn); titem_load(tc, nxt, F.lane); }
            titem_process(tcur, cur, scr, F.lane);
            it = itn;
        }
    }
    {
        LAS unsigned* ctr2 = (LAS unsigned*)(F.lds + LDS_CTL + 36);
        for (;;) {
            const int it = __builtin_amdgcn_readfirstlane(F.lane == 0 ? (int)atomicAdd((unsigned*)ctr2, 1u) : 0);
            if (it >= 40) break;
            if (it < 32) p1_tokens<4>(F, 4 * (32 * (int)blockIdx.x + it)); else p1_tokens<1>(F, TL + 8 * (int)blockIdx.x + (it - 32));
        }
    }
}

struct DftP { const bf16* dbase; size_t dstride; const bf16* W; bf16* obase; size_t ostride; };
template <int MODE> __device__ __forceinline__ DftP dft_params(const Frame& F, int u) {
    const bf16* P = (const bf16*)(F.ws + WS_BUFP); bf16* Z = (bf16*)(F.ws + WS_BUFZ); bf16* MIX = (bf16*)(F.ws + WS_BUFA);
    DftP p;
    if constexpr (MODE == 0) { const int chunk = u & 3, n2 = (u >> 2) & 63, b = u >> 8;
        p.dbase = P + (size_t)(b * 4096 + n2) * EIN + chunk * 128; p.dstride = (size_t)64 * EIN; p.W = (const bf16*)(F.ws + WS_WA);
        p.obase = Z + (size_t)((b * 64) * 64 + n2) * 1024 + chunk * 128; p.ostride = (size_t)64 * 1024; }
    if constexpr (MODE == 1) { const int chunk = u & 3, n2 = (u >> 2) & 15, b = u >> 6;
        p.dbase = P + (size_t)(TL + b * 256 + n2) * EIN + chunk * 128; p.dstride = (size_t)16 * EIN; p.W = (const bf16*)(F.ws + WS_WAC);
        p.obase = Z + (size_t)(TL + (b * 16) * 16 + n2) * 1024 + chunk * 128; p.ostride = (size_t)16 * 1024; }
    if constexpr (MODE == 2) { const int chunk = u & 3, j1 = (u >> 2) & 63, b = u >> 8;
        p.dbase = Z + (size_t)((b * 64 + j1) * 64) * 1024 + chunk * 128; p.dstride = (size_t)1024; p.W = (const bf16*)(F.ws + WS_WC) + (size_t)j1 * 64 * 128;
        p.obase = MIX + (size_t)(b * 4096 + j1) * D + chunk * 128; p.ostride = (size_t)64 * D; }
    if constexpr (MODE == 3) { const int chunk = u & 3, j1 = (u >> 2) & 15, b = u >> 6;
        p.dbase = Z + (size_t)(TL + (b * 16 + j1) * 16) * 1024 + chunk * 128; p.dstride = (size_t)1024; p.W = (const bf16*)(F.ws + WS_WCC) + (size_t)j1 * 16 * 32;
        p.obase = MIX + (size_t)(TL + b * 256 + j1) * D + chunk * 128; p.ostride = (size_t)16 * D; }
    return p;
}
template <int MODE, int KD, int MD, int J>
__device__ __forceinline__ void dft_units(Frame& F, int nunits) {
    constexpr int LD = KD + 8;
    constexpr int NP = (KD * 16 + 511) / 512;
    constexpr int GM = KD / 8 - 1;
    LAS bf16* DT = (LAS bf16*)F.lds;
    u32x4 pre[NP];
    int u = F.vcu;
    if (u < nunits) { const DftP p = dft_params<MODE>(F, u);
#pragma unroll
        for (int i = 0; i < NP; ++i) { const int pc = F.tid + 512 * i; if (pc < KD * 16) { const int k = pc >> 4, c8 = pc & 15, ri = k / (KD / 2), nn = k % (KD / 2);
            pre[i] = *(const u32x4*)(p.dbase + (size_t)nn * p.dstride + ri * 512 + c8 * 8); } } }
    const int a = F.lane & 15, q = F.lane >> 4;
    for (; u < nunits; u += F.G) {
        const DftP p = dft_params<MODE>(F, u);
#pragma unroll
        for (int i = 0; i < NP; ++i) { const int pc = F.tid + 512 * i; if (pc < KD * 16) { const int k = pc >> 4, c8 = pc & 15; const u32x4 v = pre[i];
            LAS bf16* d = DT + (c8 * 8) * LD + (k ^ ((c8 & GM) << 3));
            d[0 * LD] = (bf16)(v.x & 0xffff); d[1 * LD] = (bf16)(v.x >> 16); d[2 * LD] = (bf16)(v.y & 0xffff); d[3 * LD] = (bf16)(v.y >> 16);
            d[4 * LD] = (bf16)(v.z & 0xffff); d[5 * LD] = (bf16)(v.z >> 16); d[6 * LD] = (bf16)(v.w & 0xffff); d[7 * LD] = (bf16)(v.w >> 16); } }
        __syncthreads();
        if (u + F.G < nunits) { const DftP pn = dft_params<MODE>(F, u + F.G);
#pragma unroll
            for (int i = 0; i < NP; ++i) { const int pc = F.tid + 512 * i; if (pc < KD * 16) { const int k = pc >> 4, c8 = pc & 15, ri = k / (KD / 2), nn = k % (KD / 2);
                pre[i] = *(const u32x4*)(pn.dbase + (size_t)nn * pn.dstride + ri * 512 + c8 * 8); } } }
        for (int task = F.wave; task < (MD / 16) * 2; task += NWAVES) {
            const int mt = task >> 1, cht = task & 1;
            f32x4 acc[4];
#pragma unroll
            for (int ct = 0; ct < 4; ++ct) acc[ct] = (f32x4){0.f, 0.f, 0.f, 0.f};
#pragma unroll
            for (int ks = 0; ks < KD / 32; ++ks) {
                const bf16x8 bw = *(const bf16x8*)(p.W + (size_t)(mt * 16 + a) * KD + ks * 32 + 8 * q);
#pragma unroll
                for (int ct = 0; ct < 4; ++ct) {
                    const int ch = cht * 64 + 16 * (a >> 2) + 4 * ct + (a & 3);
                    const bf16x8 av = *(const LAS bf16x8*)(DT + ch * LD + ((ks * 32 + 8 * q) ^ (((ch >> 3) & GM) << 3)));
                    acc[ct] = __builtin_amdgcn_mfma_f32_16x16x32_bf16(av, bw, acc[ct], 0, 0, 0);
                }
            }
            const int m = mt * 16 + a, rm = m / J, j = m % J;
            bf16* o = p.obase + (size_t)j * p.ostride + rm * 512 + cht * 64 + 16 * q;
            u32x4 w0, w1;
            w0.x = pk2(acc[0][0], acc[0][1]); w0.y = pk2(acc[0][2], acc[0][3]); w0.z = pk2(acc[1][0], acc[1][1]); w0.w = pk2(acc[1][2], acc[1][3]);
            w1.x = pk2(acc[2][0], acc[2][1]); w1.y = pk2(acc[2][2], acc[2][3]); w1.z = pk2(acc[3][0], acc[3][1]); w1.w = pk2(acc[3][2], acc[3][3]);
            *(u32x4*)o = w0; *(u32x4*)(o + 8) = w1;
        }
        __syncthreads();
    }
}

template <int MODE, int NR>
__device__ __forceinline__ void dft_units_a(Frame& F, int nunits) {
    constexpr int KD = 2 * NR, MD = 2 * NR, J = NR, LD = KD + 8, GM = KD / 8 - 1, ULD = 136;
    constexpr int NP = (NR * 16 + 511) / 512;
    LAS bf16* FDl = (LAS bf16*)F.lds; LAS bf16* U = (LAS bf16*)(F.lds + 69632); LAS bf16* DT = (LAS bf16*)(F.lds + 69632 + 64 * ULD * 2);
    { const bf16* FD = (const bf16*)(F.ws + WS_FD);
      for (int p = F.tid; p < 256 * 16; p += 512) { const int r = p >> 4, c8 = p & 15; *(LAS u32x4*)(FDl + r * ULD + 8 * c8) = *(const u32x4*)(FD + r * 128 + 8 * c8); } }
    u32x4 pre[NP];
    int u = F.vcu;
    if (u < nunits) { const DftP p = dft_params<MODE>(F, u);
#pragma unroll
        for (int i = 0; i < NP; ++i) { const int pc = F.tid + 512 * i; if (pc < NR * 16) pre[i] = *(const u32x4*)(p.dbase + (size_t)(pc >> 4) * p.dstride + (pc & 15) * 8); } }
    const int a = F.lane & 15, q = F.lane >> 4;
    for (; u < nunits; u += F.G) {
        const DftP p = dft_params<MODE>(F, u);
#pragma unroll
        for (int i = 0; i < NP; ++i) { const int pc = F.tid + 512 * i; if (pc < NR * 16) *(LAS u32x4*)(U + (pc >> 4) * ULD + (pc & 15) * 8) = pre[i]; }
        __syncthreads();
        if (u + F.G < nunits) { const DftP pn = dft_params<MODE>(F, u + F.G);
#pragma unroll
            for (int i = 0; i < NP; ++i) { const int pc = F.tid + 512 * i; if (pc < NR * 16) pre[i] = *(const u32x4*)(pn.dbase + (size_t)(pc >> 4) * pn.dstride + (pc & 15) * 8); } }
        {
            f32x4 acc[NR / 16][2];
#pragma unroll
            for (int mt = 0; mt < NR / 16; ++mt) { acc[mt][0] = (f32x4){0.f, 0.f, 0.f, 0.f}; acc[mt][1] = (f32x4){0.f, 0.f, 0.f, 0.f}; }
#pragma unroll
            for (int ks = 0; ks < 4; ++ks) {
                const bf16x8 b0 = *(const LAS bf16x8*)(FDl + ((2 * F.wave) * 16 + a) * ULD + ks * 32 + 8 * q), b1 = *(const LAS bf16x8*)(FDl + ((2 * F.wave + 1) * 16 + a) * ULD + ks * 32 + 8 * q);
#pragma unroll
                for (int mt = 0; mt < NR / 16; ++mt) { const bf16x8 av = *(const LAS bf16x8*)(U + (mt * 16 + a) * ULD + ks * 32 + 8 * q);
                    acc[mt][0] = __builtin_amdgcn_mfma_f32_16x16x32_bf16(av, b0, acc[mt][0], 0, 0, 0); acc[mt][1] = __builtin_amdgcn_mfma_f32_16x16x32_bf16(av, b1, acc[mt][1], 0, 0, 0); }
            }
#pragma unroll
            for (int t = 0; t < 2; ++t) { const int col = (2 * F.wave + t) * 16 + a, ri = col >> 7, k2 = col & 127;
#pragma unroll
                for (int mt = 0; mt < NR / 16; ++mt) { const int k0 = ri * NR + 16 * mt + 4 * q;
                    u32x2 w; w.x = pk2(acc[mt][t][0], acc[mt][t][1]); w.y = pk2(acc[mt][t][2], acc[mt][t][3]);
                    *(LAS u32x2*)(DT + k2 * LD + (k0 ^ (((k2 >> 3) & GM) << 3))) = w; } }
        }
        __syncthreads();
        for (int task = F.wave; task < (MD / 16) * 2; task += NWAVES) {
            const int mt = task >> 1, cht = task & 1;
            f32x4 acc[4];
#pragma unroll
            for (int ct = 0; ct < 4; ++ct) acc[ct] = (f32x4){0.f, 0.f, 0.f, 0.f};
#pragma unroll
            for (int ks = 0; ks < KD / 32; ++ks) {
                const bf16x8 bw = *(const bf16x8*)(p.W + (size_t)(mt * 16 + a) * KD + ks * 32 + 8 * q);
#pragma unroll
                for (int ct = 0; ct < 4; ++ct) {
                    const int ch = cht * 64 + 16 * (a >> 2) + 4 * ct + (a & 3);
                    const bf16x8 av = *(const LAS bf16x8*)(DT + ch * LD + ((ks * 32 + 8 * q) ^ (((ch >> 3) & GM) << 3)));
                    acc[ct] = __builtin_amdgcn_mfma_f32_16x16x32_bf16(av, bw, acc[ct], 0, 0, 0);
                }
            }
            const int m = mt * 16 + a, rm = m / J, j = m % J;
            bf16* o = p.obase + (size_t)j * p.ostride + rm * 512 + cht * 64 + 16 * q;
            u32x4 w0, w1;
            w0.x = pk2(acc[0][0], acc[0][1]); w0.y = pk2(acc[0][2], acc[0][3]); w0.z = pk2(acc[1][0], acc[1][1]); w0.w = pk2(acc[1][2], acc[1][3]);
            w1.x = pk2(acc[2][0], acc[2][1]); w1.y = pk2(acc[2][2], acc[2][3]); w1.z = pk2(acc[3][0], acc[3][1]); w1.w = pk2(acc[3][2], acc[3][3]);
            *(u32x4*)o = w0; *(u32x4*)(o + 8) = w1;
        }
        __syncthreads();
    }
}

__device__ __forceinline__ void phase_fourier_a_conv(Frame& F) {
    const bf16* P = (const bf16*)(F.ws + WS_BUFP);
    dft_units_a<0, 64>(F, 2048);
    __syncthreads();
    dft_units_a<1, 16>(F, 512);
    bf16* MIX = (bf16*)(F.ws + WS_BUFA);
    const float* cw = F.in[I_ECONV];
    float w0[8], w1[8], w2[8];
#pragma unroll
    for (int i = 0; i < 8; ++i) { w0[i] = cw[8 * F.lane + i]; w1[i] = cw[512 + 8 * F.lane + i]; w2[i] = cw[1024 + 8 * F.lane + i]; }
    const int gw = F.vcu * NWAVES + F.wave, NGW = F.G * NWAVES;
    auto conv_tokens = [&](int t, auto ntc) {
        constexpr int NT = decltype(ntc)::value;
        int pos, len; if (t < TL) { pos = t & 4095; len = 4096; } else { pos = (t - TL) & 255; len = 256; }
        const bf16* row = P + (size_t)t * EIN + 8 * F.lane;
        u32x4 gb[NT], gc[NT + 2], uc[NT + 2];
#pragma unroll
        for (int d = 0; d < NT + 2; ++d) { const int pp = pos + d - 1;
            if (pp >= 0 && pp < len) { gc[d] = *(const u32x4*)(row + (ptrdiff_t)(d - 1) * EIN + 1024); uc[d] = *(const u32x4*)(row + (ptrdiff_t)(d - 1) * EIN + 1536); }
            else { gc[d] = (u32x4){0u, 0u, 0u, 0u}; uc[d] = (u32x4){0u, 0u, 0u, 0u}; } }
#pragma unroll
        for (int q = 0; q < NT; ++q) gb[q] = *(const u32x4*)(row + (size_t)q * EIN + 512);
        float pl[NT + 2][8];
#pragma unroll
        for (int d = 0; d < NT + 2; ++d)
#pragma unroll
            for (int i = 0; i < 4; ++i) { pl[d][2 * i] = bflo(gc[d][i]) * bflo(uc[d][i]); pl[d][2 * i + 1] = bfhi(gc[d][i]) * bfhi(uc[d][i]); }
#pragma unroll
        for (int q = 0; q < NT; ++q) {
            float y[8];
#pragma unroll
            for (int i = 0; i < 4; ++i) {
                y[2 * i] = bflo(gb[q][i]) * (w0[2 * i] * pl[q][2 * i] + w1[2 * i] * pl[q + 1][2 * i] + w2[2 * i] * pl[q + 2][2 * i]);
                y[2 * i + 1] = bfhi(gb[q][i]) * (w0[2 * i + 1] * pl[q][2 * i + 1] + w1[2 * i + 1] * pl[q + 1][2 * i + 1] + w2[2 * i + 1] * pl[q + 2][2 * i + 1]);
            }
            u32x4 o; o.x = pk2(y[0], y[1]); o.y = pk2(y[2], y[3]); o.z = pk2(y[4], y[5]); o.w = pk2(y[6], y[7]);
            *(u32x4*)(MIX + (size_t)(t + q) * D + 512 + 8 * F.lane) = o;
        }
    };
    for (int t = 4 * gw; t < TL; t += 4 * NGW) conv_tokens(t, std::integral_constant<int, 4>{});
    for (int t = TL + gw; t < T; t += NGW) conv_tokens(t, std::integral_constant<int, 1>{});
}

__device__ __forceinline__ void phase_fourier_c(Frame& F) {
    dft_units<2, 128, 64, 64>(F, 2048);
    dft_units<3, 32, 16, 16>(F, 512);
}

constexpr int RW_LD = 1032;
__device__ __forceinline__ void phase_route(Frame& F, int layer, int ntok) {
    LAS bf16* rwh = (LAS bf16*)F.lds;
    LAS bf16* rwl = (LAS bf16*)(F.lds + 33024);
    LAS unsigned* cnt = (LAS unsigned*)(F.lds + 66048);
    LAS int* gb = (LAS int*)(F.lds + 66048 + 128);
    LAS float* lgs = (LAS float*)(F.lds + 66048 + 256) + F.wave * 256;
    LAS int* tinfo = (LAS int*)(F.lds + 66048 + 256 + 8192);
    LAS float* GS = (LAS float*)(F.lds + 81920);
    LAS float* SH = GS + 2048;
    const float* RW = F.in[I_RW];
    const int per = ntok / F.G, t0 = blockIdx.x * per, r0 = mod_row(t0);
    const float* mods = (const float*)(F.ws + WS_MODS) + (size_t)layer * 9 * 6144;
    const float* g = F.in[I_NFG] + layer * 1024;
    for (int i = F.tid; i < 16384; i += 512) { const int k = i >> 4, e = i & 15; const float w = RW[i]; const unsigned hi = f2bf(w); const float wl = w - __builtin_bit_cast(float, hi << 16);
        rwh[e * RW_LD + k] = (bf16)hi; rwl[e * RW_LD + k] = (bf16)f2bf(wl); }
    for (int i = F.tid; i < 2048; i += 512) { const int sl = i >> 10, c = i & 1023; const int rr = min(r0 + sl, 8); const float* m = mods + (size_t)rr * 6144;
        GS[i] = g[c] * (m[4 * 1024 + c] + 1.0f); SH[i] = m[3 * 1024 + c]; }
    if (F.tid < 16) cnt[F.tid] = 0u;
    __syncthreads();
    bf16* FB = (bf16*)(F.ws + WS_BUFA);
    const bool f8 = layer ? (FP8_G1_L1 != 0) : (FP8_G1_L0 != 0);
    int* route = (int*)(F.ws + WS_ROUTE);
    const int tk = F.lane & 15, kg = F.lane >> 4;
    for (int g0 = 16 * F.wave; g0 < per; g0 += 16 * NWAVES) {
        const int nv = min(16, per - g0);
        const int tq = t0 + g0 + (tk < nv ? tk : 0);
        const bf16* hr = h_row(F, tq) + 8 * kg;
        float s2 = 0.f;
        {
            u32x4 raw[32];
#pragma unroll
            for (int ks = 0; ks < 32; ++ks) raw[ks] = *(const u32x4*)(hr + 32 * ks);
#pragma unroll
            for (int ks = 0; ks < 32; ++ks)
#pragma unroll
                for (int i = 0; i < 4; ++i) { const float a = bflo(raw[ks][i]), b2 = bfhi(raw[ks][i]); s2 += a * a + b2 * b2; }
        }
        s2 += __shfl_xor(s2, 16); s2 += __shfl_xor(s2, 32);
        const float rstd = 1.0f / sqrtf(s2 * (1.0f / D) + EPS);
        const int sl = (mod_row(tq) != r0) ? 1024 : 0;
        const LAS float* gsp = GS + sl + 8 * kg; const LAS float* shp = SH + sl + 8 * kg;
        unsigned char* fb8 = (unsigned char*)FB + (size_t)tq * D + 8 * kg;
        bf16* fb16 = FB + (size_t)tq * D + 8 * kg;
        f32x4 acc = (f32x4){0.f, 0.f, 0.f, 0.f};
        u32x4 nx[8];
#pragma unroll
        for (int j = 0; j < 8; ++j) nx[j] = *(const u32x4*)(hr + 32 * j);
#pragma unroll 1
        for (int k4 = 0; k4 < 4; ++k4) {
            u32x4 cu[8];
#pragma unroll
            for (int j = 0; j < 8; ++j) cu[j] = nx[j];
            if (k4 < 3) {
#pragma unroll
                for (int j = 0; j < 8; ++j) nx[j] = *(const u32x4*)(hr + 32 * (8 * k4 + 8 + j)); }
#pragma unroll
            for (int j = 0; j < 8; ++j) {
                const int ks = 8 * k4 + j;
                const f32x4 g0v = *(const LAS f32x4*)(gsp + 32 * ks), g1v = *(const LAS f32x4*)(gsp + 32 * ks + 4), s0v = *(const LAS f32x4*)(shp + 32 * ks), s1v = *(const LAS f32x4*)(shp + 32 * ks + 4);
                float f[8];
                f[0] = bflo(cu[j].x) * rstd * g0v.x + s0v.x; f[1] = bfhi(cu[j].x) * rstd * g0v.y + s0v.y; f[2] = bflo(cu[j].y) * rstd * g0v.z + s0v.z; f[3] = bfhi(cu[j].y) * rstd * g0v.w + s0v.w;
                f[4] = bflo(cu[j].z) * rstd * g1v.x + s1v.x; f[5] = bfhi(cu[j].z) * rstd * g1v.y + s1v.y; f[6] = bflo(cu[j].w) * rstd * g1v.z + s1v.z; f[7] = bfhi(cu[j].w) * rstd * g1v.w + s1v.w;
                u32x4 hi, lo;
#pragma unroll
                for (int i = 0; i < 4; ++i) { const unsigned h0 = f2bf(f[2 * i]), h1 = f2bf(f[2 * i + 1]); hi[i] = h0 | (h1 << 16);
                    lo[i] = pk2(f[2 * i] - __builtin_bit_cast(float, h0 << 16), f[2 * i + 1] - __builtin_bit_cast(float, h1 << 16)); }
                if (tk < nv) {
                    if (f8) { u32x2 o; o.x = pg8::pk4_fp8(f[0], f[1], f[2], f[3]); o.y = pg8::pk4_fp8(f[4], f[5], f[6], f[7]); *(u32x2*)(fb8 + 32 * ks) = o; }
                    else *(u32x4*)(fb16 + 32 * ks) = hi;
                }
                const bf16x8 bh = *(const LAS bf16x8*)(rwh + tk * RW_LD + 32 * ks + 8 * kg), bl = *(const LAS bf16x8*)(rwl + tk * RW_LD + 32 * ks + 8 * kg);
                const bf16x8 ah = __builtin_bit_cast(bf16x8, hi), al = __builtin_bit_cast(bf16x8, lo);
                acc = __builtin_amdgcn_mfma_f32_16x16x32_bf16(ah, bh, acc, 0, 0, 0);
                acc = __builtin_amdgcn_mfma_f32_16x16x32_bf16(ah, bl, acc, 0, 0, 0);
                acc = __builtin_amdgcn_mfma_f32_16x16x32_bf16(al, bh, acc, 0, 0, 0);
            }
        }
#pragma unroll
        for (int j = 0; j < 4; ++j) lgs[(4 * kg + j) * 16 + tk] = acc[j];
        LDS_WAIT(); asm volatile("" ::: "memory");
        if (F.lane < nv) {
            const int tqq = t0 + g0 + F.lane;
            float aff[16], sel[16];
#pragma unroll
            for (int e4 = 0; e4 < 4; ++e4) { const f32x4 l4 = *(const LAS f32x4*)(lgs + F.lane * 16 + 4 * e4); const f32x4 b4 = *(const f32x4*)(F.in[I_RB] + 4 * e4);
                aff[4 * e4] = 1.0f / (1.0f + expf(-l4.x)); aff[4 * e4 + 1] = 1.0f / (1.0f + expf(-l4.y)); aff[4 * e4 + 2] = 1.0f / (1.0f + expf(-l4.z)); aff[4 * e4 + 3] = 1.0f / (1.0f + expf(-l4.w));
                sel[4 * e4] = aff[4 * e4] + b4.x; sel[4 * e4 + 1] = aff[4 * e4 + 1] + b4.y; sel[4 * e4 + 2] = aff[4 * e4 + 2] + b4.z; sel[4 * e4 + 3] = aff[4 * e4 + 3] + b4.w; }
            int best = 0; float bs = -1e30f;
#pragma unroll
            for (int gq = 0; gq < 4; ++gq) { const float a = sel[4 * gq], b = sel[4 * gq + 1], c = sel[4 * gq + 2], d = sel[4 * gq + 3];
                const float s = fmaxf(fmaxf(fmaxf(a + b, a + c), fmaxf(a + d, b + c)), fmaxf(b + d, c + d));
                if (s > bs) { bs = s; best = gq; } }
            float sv[4], av[4];
#pragma unroll
            for (int i = 0; i < 4; ++i) { sv[i] = sel[i]; av[i] = aff[i]; }
#pragma unroll
            for (int gq = 1; gq < 4; ++gq) if (best == gq) {
#pragma unroll
                for (int i = 0; i < 4; ++i) { sv[i] = sel[4 * gq + i]; av[i] = aff[4 * gq + i]; } }
            int i1 = 0; float s1 = sv[0], a1 = av[0];
#pragma unroll
            for (int i = 1; i < 4; ++i) if (sv[i] > s1) { s1 = sv[i]; a1 = av[i]; i1 = i; }
            int i2 = -1; float s2v = -1e30f, a2 = 0.f;
#pragma unroll
            for (int i = 0; i < 4; ++i) if (i != i1 && sv[i] > s2v) { s2v = sv[i]; a2 = av[i]; i2 = i; }
            const int e1 = 4 * best + i1, e2 = 4 * best + i2;
            const float wsum = a1 + a2, w1 = a1 / wsum, w2 = a2 / wsum;
            const unsigned r1 = atomicAdd((unsigned*)(cnt + e1), 1u), r2 = atomicAdd((unsigned*)(cnt + e2), 1u);
            int* ro = route + (size_t)tqq * 8;
            ro[0] = e1; ro[1] = e2; ro[4] = __builtin_bit_cast(int, w1); ro[5] = __builtin_bit_cast(int, w2);
            tinfo[4 * (tqq - t0) + 0] = e1; tinfo[4 * (tqq - t0) + 1] = e2; tinfo[4 * (tqq - t0) + 2] = (int)r1; tinfo[4 * (tqq - t0) + 3] = (int)r2;
        }
        LDS_WAIT(); asm volatile("" ::: "memory");
    }
    __syncthreads();
    if (F.tid < 16) gb[F.tid] = (int)__hip_atomic_fetch_add((unsigned*)(F.ws + WS_GCNT) + layer * 16 + F.tid, cnt[F.tid], __ATOMIC_RELAXED, __HIP_MEMORY_SCOPE_AGENT);
    __syncthreads();
    int* tokmap = (int*)(F.ws + WS_TOKMAP);
    for (int i = F.tid; i < per; i += 512) {
        const int e1 = tinfo[4 * i], e2 = tinfo[4 * i + 1], p1 = gb[e1] + tinfo[4 * i + 2], p2 = gb[e2] + tinfo[4 * i + 3];
        tokmap[(size_t)e1 * T + p1] = t0 + i; tokmap[(size_t)e2 * T + p2] = t0 + i;
        int* ro = route + (size_t)(t0 + i) * 8; ro[2] = p1; ro[3] = p2;
    }
}

__device__ __forceinline__ int moe_tables(Frame& F, int layer) {
    LAS int* tb = (LAS int*)(F.lds + LDS_CTL + 64); LAS int* cn = (LAS int*)(F.lds + LDS_CTL + 192);
    __syncthreads();
    if (F.tid < 16) cn[F.tid] = ld_coh((const int*)(F.ws + WS_GCNT) + layer * 16 + F.tid);
    __syncthreads();
    if (F.tid == 0) { int b = 0; for (int e = 0; e < 16; ++e) { tb[e] = b; b += (cn[e] + 255) >> 8; } tb[16] = b; }
    __syncthreads();
    return __builtin_amdgcn_readfirstlane(tb[16]);
}

template <int NQ> __device__ __forceinline__ void combine_tokens(Frame& F, int layer, int t) {
    const float* mods = (const float*)(F.ws + WS_MODS);
    const bf16* OS = (const bf16*)(F.ws + WS_BUFP);
    const int* route = (const int*)(F.ws + WS_ROUTE);
    const LAS int* tb = (const LAS int*)(F.lds + LDS_CTL + 64);
    bf16* A = (bf16*)(F.ws + WS_BUFA);
    {
        int rc[NQ][4]; float w0[NQ], w1[NQ];
#pragma unroll
        for (int q = 0; q < NQ; ++q) { const int* ro = route + (size_t)(t + q) * 8;
#pragma unroll
            for (int i = 0; i < 4; ++i) rc[q][i] = ld_coh(ro + i);
            w0[q] = ld_cohf((const float*)(ro + 4)); w1[q] = ld_cohf((const float*)(ro + 5)); }
        f32x4 v[NQ][4]; u32x2 oa[NQ][4], ob[NQ][4];
#pragma unroll
        for (int q = 0; q < NQ; ++q) { const bf16* hr = h_row(F, t + q);
            const size_t s0 = (size_t)(tb[rc[q][0]] * 256 + rc[q][2]) * D, s1 = (size_t)(tb[rc[q][1]] * 256 + rc[q][3]) * D;
#pragma unroll
            for (int j = 0; j < 4; ++j) { const int c = 4 * F.lane + 256 * j; { const u32x2 hv = *(const u32x2*)(hr + c); v[q][j] = (f32x4){bflo(hv.x), bfhi(hv.x), bflo(hv.y), bfhi(hv.y)}; } oa[q][j] = *(const u32x2*)(OS + s0 + c); ob[q][j] = *(const u32x2*)(OS + s1 + c); } }
        const int mr = mod_row(t);
        const float* m5 = mods + (size_t)(layer * 9 + mr) * 6144 + 5 * 1024;
#pragma unroll
        for (int j = 0; j < 4; ++j) { const f32x4 g5 = *(const f32x4*)(m5 + 4 * F.lane + 256 * j);
#pragma unroll
            for (int q = 0; q < NQ; ++q) { const u32x2 a = oa[q][j], b2 = ob[q][j];
                const f32x4 o = (f32x4){w0[q] * bflo(a.x) + w1[q] * bflo(b2.x), w0[q] * bfhi(a.x) + w1[q] * bfhi(b2.x), w0[q] * bflo(a.y) + w1[q] * bflo(b2.y), w0[q] * bfhi(a.y) + w1[q] * bfhi(b2.y)};
                v[q][j] = v[q][j] + g5 * o; } }
#pragma unroll
        for (int q = 0; q < NQ; ++q) {
            if (layer == 0) {
                bf16* hr = h_row(F, t + q);
#pragma unroll
                for (int j = 0; j < 4; ++j) { u32x2 o; o.x = pk2(v[q][j].x, v[q][j].y); o.y = pk2(v[q][j].z, v[q][j].w); *(u32x2*)(hr + 4 * F.lane + 256 * j) = o; }
                const float* m = mods + (size_t)(9 + mr) * 6144;
                norm_mod_store(v[q], F.in[I_NMG] + 1024, m, m + 1024, A + (size_t)(t + q) * D, F.lane);
            } else {
                float s2 = 0.f;
#pragma unroll
                for (int j = 0; j < 4; ++j) s2 += (v[q][j].x * v[q][j].x + v[q][j].y * v[q][j].y) + (v[q][j].z * v[q][j].z + v[q][j].w * v[q][j].w);
                const float rstd = 1.0f / sqrtf(wave_sum(s2) * (1.0f / D) + EPS);
                float* orow = F.out + (size_t)(t + q) * D;
#pragma unroll
                for (int j = 0; j < 4; ++j) { const int c = 4 * F.lane + 256 * j; *(f32x4*)(orow + c) = v[q][j] * rstd * *(const f32x4*)(F.in[I_FG] + c); }
            }
        }
    }
}
__device__ __forceinline__ void phase_combine(Frame& F, int layer, int ntok) {
    const int gw = F.vcu * NWAVES + F.wave, NGW = F.G * NWAVES;
    if (layer == 0) { for (int t = 2 * gw; t < TL; t += 2 * NGW) combine_tokens<2>(F, 0, t); for (int t = TL + gw; t < ntok; t += NGW) combine_tokens<1>(F, 0, t); }
    else { for (int t = 4 * gw; t < TL; t += 4 * NGW) combine_tokens<4>(F, 1, t); }
}

constexpr int KV_LD = 72, VL_OFF = 384 * KV_LD * 2, ROPE_LDS = 131072;
typedef short v4i16_t __attribute__((ext_vector_type(4)));

__device__ __forceinline__ bf16x8 rope_pack(const u32x4 x1, const u32x4 x2, const LAS float* cs, const LAS float* sn, float scale, bool second) {
    const f32x4 c0 = *(const LAS f32x4*)cs, c1 = *(const LAS f32x4*)(cs + 4), s0 = *(const LAS f32x4*)sn, s1 = *(const LAS f32x4*)(sn + 4);
    float c[8] = {c0.x, c0.y, c0.z, c0.w, c1.x, c1.y, c1.z, c1.w}, s[8] = {s0.x, s0.y, s0.z, s0.w, s1.x, s1.y, s1.z, s1.w};
    float a[8], b[8];
#pragma unroll
    for (int i = 0; i < 4; ++i) { a[2 * i] = bflo(x1[i]); a[2 * i + 1] = bfhi(x1[i]); b[2 * i] = bflo(x2[i]); b[2 * i + 1] = bfhi(x2[i]); }
    float o[8];
#pragma unroll
    for (int i = 0; i < 8; ++i) o[i] = (second ? (b[i] * c[i] + a[i] * s[i]) : (a[i] * c[i] - b[i] * s[i])) * scale;
    u32x4 w; w.x = pk2(o[0], o[1]); w.y = pk2(o[2], o[3]); w.z = pk2(o[4], o[5]); w.w = pk2(o[6], o[7]);
    return __builtin_bit_cast(bf16x8, w);
}

struct AttnU { int b, qb, kvh; };
__device__ __forceinline__ AttnU attn_unit_of(int u) { AttnU r; r.kvh = u & 1; r.qb = (u >> 1) & 31; r.b = u >> 6; return r; }

__device__ __forceinline__ void attn_load_latk(Frame& F, const bf16* P1, AttnU u, u32x4 (&lk)[2][4]) {
    const u32x4 z = (u32x4){0u, 0u, 0u, 0u};
#pragma unroll
    for (int it = 0; it < 2; ++it) { const int task = F.tid + 512 * it, kidx = task >> 1, hh = task & 1, pos = u.qb * 128 - 128 + kidx;
        const bool ok = task < 768 && pos >= 0 && pos < NSEQ;
        const bf16* row = P1 + (size_t)(u.b * NSEQ + (ok ? pos : 0)) * OIN + 1024 + u.kvh * 64 + 8 * hh;
#pragma unroll
        for (int st = 0; st < 4; ++st) lk[it][st] = ok ? *(const u32x4*)(row + 16 * st) : z; }
}
__device__ __forceinline__ void attn_load_latv(Frame& F, const bf16* P1, AttnU u, u32x4 (&lv)[6]) {
    const u32x4 z = (u32x4){0u, 0u, 0u, 0u};
#pragma unroll
    for (int it = 0; it < 6; ++it) { const int task = F.tid + 512 * it, kidx = task >> 3, c8 = task & 7, pos = u.qb * 128 - 128 + kidx;
        const bool ok = pos >= 0 && pos < NSEQ;
        lv[it] = ok ? *(const u32x4*)(P1 + (size_t)(u.b * NSEQ + (ok ? pos : 0)) * OIN + 1152 + u.kvh * 64 + 8 * c8) : z; }
}
__device__ __forceinline__ void attn_write_lat(Frame& F, AttnU u, const u32x4 (&lk)[2][4], const u32x4 (&lv)[6]) {
    LAS bf16* KL = (LAS bf16*)F.lds; LAS bf16* VL = (LAS bf16*)(F.lds + VL_OFF); const LAS float* rope = (const LAS float*)(F.lds + ROPE_LDS);
#pragma unroll
    for (int it = 0; it < 2; ++it) { const int task = F.tid + 512 * it, kidx = task >> 1, hh = task & 1; int pos = u.qb * 128 - 128 + kidx; pos = pos < 0 ? 0 : (pos > NSEQ - 1 ? NSEQ - 1 : pos);
        if (task < 768) {
            LAS bf16* d = KL + kidx * KV_LD + 8 * hh;
            const LAS float* c0 = rope + (pos >> 6) * 16 + 8 * hh; const LAS float* c1 = rope + (pos & 63) * 16 + 8 * hh;
            *(LAS bf16x8*)(d) = rope_pack(lk[it][0], lk[it][1], c0, c0 + 1024, 1.0f, false);
            *(LAS bf16x8*)(d + 16) = rope_pack(lk[it][0], lk[it][1], c0, c0 + 1024, 1.0f, true);
            *(LAS bf16x8*)(d + 32) = rope_pack(lk[it][2], lk[it][3], c1, c1 + 1024, 1.0f, false);
            *(LAS bf16x8*)(d + 48) = rope_pack(lk[it][2], lk[it][3], c1, c1 + 1024, 1.0f, true);
        } }
#pragma unroll
    for (int it = 0; it < 6; ++it) { const int task = F.tid + 512 * it, kidx = task >> 3, c8 = task & 7; *(LAS u32x4*)(VL + kidx * KV_LD + 8 * c8) = lv[it]; }
}
__device__ __forceinline__ void attn_load_ctx(Frame& F, const bf16* P1, AttnU u, u32x4 (&ck)[4], u32x4 (&cv)[4]) {
#pragma unroll
    for (int it = 0; it < 4; ++it) { const int task = F.tid + 512 * it, kidx = task >> 3, c8 = task & 7;
        const bf16* row = P1 + (size_t)(TL + u.b * LCTX + kidx) * OIN + 1024 + u.kvh * 64 + 8 * c8;
        ck[it] = *(const u32x4*)row; cv[it] = *(const u32x4*)(row + 128); }
}
__device__ __forceinline__ void attn_write_ctx(Frame& F, const u32x4 (&ck)[4], const u32x4 (&cv)[4]) {
    LAS bf16* KL = (LAS bf16*)F.lds; LAS bf16* VL = (LAS bf16*)(F.lds + VL_OFF);
#pragma unroll
    for (int it = 0; it < 4; ++it) { const int task = F.tid + 512 * it, kidx = task >> 3, c8 = task & 7;
        *(LAS u32x4*)(KL + kidx * KV_LD + 8 * c8) = ck[it]; *(LAS u32x4*)(VL + kidx * KV_LD + 8 * c8) = cv[it]; }
}

__device__ __forceinline__ unsigned cvtpk(float lo, float hi) { unsigned r; asm volatile("v_cvt_pk_bf16_f32 %0, %1, %2" : "=v"(r) : "v"(lo), "v"(hi)); return r; }
__device__ __forceinline__ float xhalf_max(float x) { const auto r = __builtin_amdgcn_permlane32_swap(__builtin_bit_cast(unsigned, x), __builtin_bit_cast(unsigned, x), false, false);
    return fmaxf(__builtin_bit_cast(float, r[0]), __builtin_bit_cast(float, r[1])); }
__device__ __forceinline__ float xhalf_sum(float x) { const auto r = __builtin_amdgcn_permlane32_swap(__builtin_bit_cast(unsigned, x), __builtin_bit_cast(unsigned, x), false, false);
    return __builtin_bit_cast(float, r[0]) + __builtin_bit_cast(float, r[1]); }
__device__ __forceinline__ void attn_tiles(Frame& F, int kt0, int kt1, int mk0, int mk1, const bf16x8 (&qf)[4], f32x16 (&O)[2], float& mrun, float& lrun, int qrel) {
    if (kt0 > kt1) return;
    const LAS bf16* KL = (const LAS bf16*)F.lds; const LAS bf16* VL = (const LAS bf16*)(F.lds + VL_OFF);
    const int r32 = F.lane & 31, hh = F.lane >> 5;
    const int q4 = (F.lane & 15) >> 2, p4 = F.lane & 3, blk = (F.lane >> 4) & 1;
    const LAS bf16* kp = KL + (kt0 * 32 + r32) * KV_LD + 8 * hh;
    const LAS bf16* vp = VL + (kt0 * 32 + 4 * hh + q4) * KV_LD + 16 * blk + 4 * p4;
    bf16x8 kn[4];
#pragma unroll
    for (int st = 0; st < 4; ++st) kn[st] = *(const LAS bf16x8*)(kp + 16 * st);
    for (int kt = kt0; kt <= kt1; ++kt) {
        bf16x8 kf[4];
#pragma unroll
        for (int st = 0; st < 4; ++st) kf[st] = kn[st];
        v4i16_t vlo[2][2], vhi[2][2];
#pragma unroll
        for (int dt = 0; dt < 2; ++dt)
#pragma unroll
            for (int s2 = 0; s2 < 2; ++s2) { vlo[dt][s2] = __builtin_amdgcn_ds_read_tr16_b64_v4i16((LAS v4i16_t*)(vp + (16 * s2) * KV_LD + dt * 32));
                vhi[dt][s2] = __builtin_amdgcn_ds_read_tr16_b64_v4i16((LAS v4i16_t*)(vp + (16 * s2 + 8) * KV_LD + dt * 32)); }
        kp += 32 * KV_LD; vp += 32 * KV_LD;
        if (kt < kt1) {
#pragma unroll
            for (int st = 0; st < 4; ++st) kn[st] = *(const LAS bf16x8*)(kp + 16 * st); }
        __builtin_amdgcn_sched_barrier(0);
        f32x16 s;
#pragma unroll
        for (int r = 0; r < 16; ++r) s[r] = 0.f;
#pragma unroll
        for (int st = 0; st < 4; ++st) s = __builtin_amdgcn_mfma_f32_32x32x16_bf16(kf[st], qf[st], s, 0, 0, 0);
        if (kt == mk0 || kt == mk1) {
#pragma unroll
            for (int r = 0; r < 16; ++r) { const int dlt = kt * 32 + (r & 3) + 8 * (r >> 2) + 4 * hh - qrel; s[r] = (dlt <= 128 && dlt >= -128) ? s[r] : -INFINITY; } }
        float mx = fmaxf(fmaxf(s[0], s[1]), fmaxf(s[2], s[3]));
#pragma unroll
        for (int r = 4; r < 16; r += 4) mx = fmaxf(mx, fmaxf(fmaxf(s[r], s[r + 1]), fmaxf(s[r + 2], s[r + 3])));
        mx = xhalf_max(mx);
        const float mnew = fmaxf(mrun, mx);
        float ps0 = 0.f, ps1 = 0.f;
#pragma unroll
        for (int r = 0; r < 16; r += 2) { s[r] = __builtin_amdgcn_exp2f(s[r] - mnew); s[r + 1] = __builtin_amdgcn_exp2f(s[r + 1] - mnew); ps0 += s[r]; ps1 += s[r + 1]; }
        const float ps = xhalf_sum(ps0 + ps1);
        if (__any(mnew > mrun)) {
            const float alpha = __builtin_amdgcn_exp2f(mrun - mnew);
            lrun *= alpha;
#pragma unroll
            for (int dt = 0; dt < 2; ++dt)
#pragma unroll
                for (int r = 0; r < 16; ++r) O[dt][r] *= alpha;
        }
        lrun += ps; mrun = mnew;
        bf16x8 pb[2];
#pragma unroll
        for (int s2 = 0; s2 < 2; ++s2) { u32x4 w; w.x = cvtpk(s[8 * s2 + 0], s[8 * s2 + 1]); w.y = cvtpk(s[8 * s2 + 2], s[8 * s2 + 3]); w.z = cvtpk(s[8 * s2 + 4], s[8 * s2 + 5]); w.w = cvtpk(s[8 * s2 + 6], s[8 * s2 + 7]);
            pb[s2] = __builtin_bit_cast(bf16x8, w); }
#pragma unroll
        for (int dt = 0; dt < 2; ++dt)
#pragma unroll
            for (int s2 = 0; s2 < 2; ++s2) {
                const bf16x8 va = (bf16x8){vlo[dt][s2][0], vlo[dt][s2][1], vlo[dt][s2][2], vlo[dt][s2][3], vhi[dt][s2][0], vhi[dt][s2][1], vhi[dt][s2][2], vhi[dt][s2][3]};
                O[dt] = __builtin_amdgcn_mfma_f32_32x32x16_bf16(va, pb[s2], O[dt], 0, 0, 0);
            }
    }
}

__device__ __forceinline__ void phase_attn(Frame& F) {
    const bf16* P1 = (const bf16*)(F.ws + WS_BUFP);
    bf16* MIX = (bf16*)(F.ws + WS_BUFA);
    const int r32 = F.lane & 31, hh = F.lane >> 5;
    constexpr float QSC = 0.125f * 1.4426950408889634f;
    LAS float* ropel = (LAS float*)(F.lds + ROPE_LDS);
    for (int i = F.tid; i < 2048; i += 512) ropel[i] = ((const float*)(F.ws + WS_ROPE))[i];
    u32x4 lk[2][4], lv[6], ck[4], cv[4];
    const int nu = (512 - F.vcu + F.G - 1) / F.G;
    if (nu > 0) attn_load_latk(F, P1, attn_unit_of(F.vcu), lk);
    for (int ui = 0; ui < nu; ++ui) {
        const AttnU u = attn_unit_of(F.vcu + ui * F.G);
        u32x4 qr[2][4];
#pragma unroll
        for (int i = 0; i < 2; ++i) { const int task = F.wave + 8 * i, g = task & 3, sub = task >> 2, head = u.kvh * 4 + g, pos = u.qb * 128 + 32 * sub + r32;
            const bf16* row = P1 + (size_t)(u.b * NSEQ + pos) * OIN + 512 + head * 64 + 8 * hh;
#pragma unroll
            for (int st = 0; st < 4; ++st) qr[i][st] = *(const u32x4*)(row + 16 * st); }
        attn_load_latv(F, P1, u, lv);
        __syncthreads();
        attn_write_lat(F, u, lk, lv);
        bf16x8 qf[2][4]; f32x16 O[2][2]; float mrun[2], lrun[2];
#pragma unroll
        for (int i = 0; i < 2; ++i) { const int task = F.wave + 8 * i, g = task & 3, sub = task >> 2, head = u.kvh * 4 + g, pos = u.qb * 128 + 32 * sub + r32;
            const LAS float* c0 = ropel + (pos >> 6) * 16 + 8 * hh; const LAS float* c1 = ropel + (pos & 63) * 16 + 8 * hh;
            qf[i][0] = rope_pack(qr[i][0], qr[i][1], c0, c0 + 1024, QSC, false); qf[i][1] = rope_pack(qr[i][0], qr[i][1], c0, c0 + 1024, QSC, true);
            qf[i][2] = rope_pack(qr[i][2], qr[i][3], c1, c1 + 1024, QSC, false); qf[i][3] = rope_pack(qr[i][2], qr[i][3], c1, c1 + 1024, QSC, true);
            mrun[i] = F.in[I_OSINK][head] * 1.4426950408889634f; lrun[i] = 1.0f;
#pragma unroll
            for (int dt = 0; dt < 2; ++dt)
#pragma unroll
                for (int r = 0; r < 16; ++r) O[i][dt][r] = 0.f; }
        __syncthreads();
        const int kt_lo = (u.qb == 0) ? 4 : 0, kt_hi = (u.qb == 31) ? 7 : 11;
#pragma unroll
        for (int i = 0; i < 2; ++i) { const int sub = (F.wave + 8 * i) >> 2, qrel = 128 + 32 * sub + r32;
            attn_tiles(F, max(sub, kt_lo), min(sub + 8, kt_hi), sub, sub + 8, qf[i], O[i], mrun[i], lrun[i], qrel); }
        attn_load_ctx(F, P1, u, ck, cv);
        __syncthreads();
        attn_write_ctx(F, ck, cv);
        __syncthreads();
        if (ui + 1 < nu) attn_load_latk(F, P1, attn_unit_of(F.vcu + (ui + 1) * F.G), lk);
#pragma unroll
        for (int i = 0; i < 2; ++i) {
            attn_tiles(F, 0, 7, -1, -1, qf[i], O[i], mrun[i], lrun[i], 0);
            const int task = F.wave + 8 * i, g = task & 3, sub = task >> 2, head = u.kvh * 4 + g, pos = u.qb * 128 + 32 * sub + r32;
            const float inv = 1.0f / lrun[i];
            bf16* o = MIX + (size_t)(u.b * NSEQ + pos) * D + 512 + head * 64 + 4 * hh;
#pragma unroll
            for (int dt = 0; dt < 2; ++dt)
#pragma unroll
                for (int rg = 0; rg < 4; ++rg) { u32x2 w; w.x = pk2(O[i][dt][4 * rg] * inv, O[i][dt][4 * rg + 1] * inv); w.y = pk2(O[i][dt][4 * rg + 2] * inv, O[i][dt][4 * rg + 3] * inv);
                    *(u32x2*)(o + dt * 32 + 8 * rg) = w; }
        }
    }
    __syncthreads();
}

__device__ __forceinline__ void phase_pool_stencil(Frame& F) {
    const bf16* P1 = (const bf16*)(F.ws + WS_BUFP);
    bf16* MIX = (bf16*)(F.ws + WS_BUFA);
    const int gw = F.vcu * NWAVES + F.wave, NGW = F.G * NWAVES;
    const int r = 1 << (F.lane >> 4);
    constexpr int NT = 8, NR = NT + 16;
    for (int t = NT * gw; t < TL; t += NT * NGW) {
        const int pos = t & 4095;
        const bf16* base = P1 + (size_t)t * OIN + 8 * F.lane;
        u32x4 v[NR];
#pragma unroll
        for (int jj = 0; jj < NR; ++jj) { const int pj = pos + jj - 8; const bool ok = pj >= 0 && pj < NSEQ; v[jj] = ok ? *(const u32x4*)(base + (ptrdiff_t)(jj - 8) * OIN) : (u32x4){0u, 0u, 0u, 0u}; }
        float acc[NT][8];
#pragma unroll
        for (int q = 0; q < NT; ++q)
#pragma unroll
            for (int i = 0; i < 8; ++i) acc[q][i] = 0.f;
#pragma unroll
        for (int jj = 0; jj < NR; ++jj) {
            float x[8];
#pragma unroll
            for (int i = 0; i < 4; ++i) { x[2 * i] = bflo(v[jj][i]); x[2 * i + 1] = bfhi(v[jj][i]); }
#pragma unroll
            for (int q = 0; q < NT; ++q) { const int dd = jj - 8 - q; if (dd >= -8 && dd <= 8) { const float w = (dd <= r && dd >= -r) ? 1.0f : 0.0f;
#pragma unroll
                for (int i = 0; i < 8; ++i) acc[q][i] += w * x[i]; } }
        }
#pragma unroll
        for (int q = 0; q < NT; ++q) {
            const int pq = pos + q, lo = max(pq - r, 0), hi = min(pq + r + 1, NSEQ);
            const float ic = 1.0f / (float)(hi - lo);
            const u32x4 sv = v[q + 8];
            u32x4 o;
#pragma unroll
            for (int i = 0; i < 4; ++i) o[i] = pk2(acc[q][2 * i] * ic - bflo(sv[i]), acc[q][2 * i + 1] * ic - bfhi(sv[i]));
            *(u32x4*)(MIX + (size_t)(t + q) * D + 8 * F.lane) = o;
        }
    }
}

__device__ __forceinline__ void phase_attn_pool(Frame& F) {
    phase_attn(F);
#ifdef DBG_ATTN2
    phase_attn(F);
#endif
    phase_pool_stencil(F);
}

constexpr int NPHASE = 20;
__global__ void __launch_bounds__(NWAVES * 64, 2) mk_fwd(Args args) {
    extern __shared__ __attribute__((aligned(16))) unsigned char lds_raw[];
    Frame F;
    F.lds = (LAS unsigned char*)lds_raw;
    F.tid = threadIdx.x; F.lane = F.tid & 63; F.wave = __builtin_amdgcn_readfirstlane(F.tid >> 6);
    F.G = gridDim.x; { const int bx = blockIdx.x; F.vcu = (F.G % 8 == 0) ? (bx % 8) * (F.G / 8) + bx / 8 : bx; }
    F.ws = args.ws; F.in = args.in; F.out = args.out;
    for (int u = F.tid; u < (LDS_BYTES - LDS_CTL) / 4; u += NWAVES * 64) ((LAS unsigned*)(F.lds + LDS_CTL))[u] = 0u;
    __syncthreads();
    const int lo = args.ph_lo, hi = args.ph_hi;
    XcdBarrier bar; bar.bar = (unsigned*)(F.ws + WS_CTL); bar.x = 0; bar.st = nullptr;
    if (hi - lo > 1) bar = xcd_barrier_post((unsigned*)(F.ws + WS_CTL), (volatile LAS unsigned*)(F.lds + LDS_CTL));
#define IN(k) (lo <= (k) && (k) < hi)
#ifndef PHASE_MASK
#define PHASE_MASK 0xffffffffu
#endif
#define PH(k, ...) if constexpr (((PHASE_MASK >> (k)) & 1u) != 0u) if (IN(k)) { __VA_ARGS__ if constexpr (((DBG_DOUBLE >> (k)) & 1u) != 0u) { __VA_ARGS__ } }
#define SEAM(k) do { if (IN(k) && IN((k) + 1)) xcd_barrier(bar); } while (0)
    unsigned char* ws = F.ws;
    const float* mods = (const float*)(ws + WS_MODS);

    PH(0, { phase_mods(F); }) SEAM(0);
    PH(1, { phase_prologue_a(F); }) SEAM(1);
    PH(2, {
        pg8::SchedDense S{(const char*)(ws + WS_BUFA), (const char*)(ws + WS_W_EIN), 1024, 8, 136, 0, 1088, F.vcu, F.G};
        pg8::EpiStore E{(bf16*)(ws + WS_BUFP), EIN};
        pg8::gemm_phase<pg8::EpiStore, pg8::SchedDense>(F.lds, 1024, S, E);
    }) SEAM(2);
    PH(3, { phase_fourier_a_conv(F); }) SEAM(3);
    PH(4, { phase_fourier_c(F); }) SEAM(4);
    PH(5, {
        pg8::SchedDense S{(const char*)(ws + WS_BUFA), (const char*)(ws + WS_W_EOUT), 1024, 4, 136, 0, 544, F.vcu, F.G};
        pg8::EpiResid<true> E{F.in[I_X], F.in[I_CTX], (bf16*)(ws + WS_HB), mods + 2 * 1024};
        pg8::gemm_phase<pg8::EpiResid<true>, pg8::SchedDense>(F.lds, 1024, S, E);
    }) SEAM(5);
    PH(6, { phase_route(F, 0, T); }) SEAM(6);
    PH(7, {
        const int ntile = moe_tables(F, 0);
        if constexpr (FP8_G1_L0) {
            pg8::SchedMoe<true> S{(const char*)(ws + WS_BUFA), (const char*)(ws + WS_W_M1) + (size_t)0 * 32 * MiB, (const int*)(ws + WS_TOKMAP), (const LAS int*)(F.lds + LDS_CTL + 64), (const LAS int*)(F.lds + LDS_CTL + 192), 512, (size_t)MiB, ntile * 4, F.vcu, F.G};
            pg8::EpiSwiglu8 E{(unsigned char*)(ws + WS_BUFZ), pg8::W1_SCALE};
            pg8::gemm_phase<pg8::EpiSwiglu8, pg8::SchedMoe<true>, true>(F.lds, 512, S, E);
        } else {
            pg8::SchedMoe<true> S{(const char*)(ws + WS_BUFA), (const char*)(ws + WS_W_M1) + (size_t)0 * 32 * MiB, (const int*)(ws + WS_TOKMAP), (const LAS int*)(F.lds + LDS_CTL + 64), (const LAS int*)(F.lds + LDS_CTL + 192), 1024, (size_t)2 * MiB, ntile * 4, F.vcu, F.G};
            if constexpr (FP8_G2_L0) { pg8::EpiSwiglu8 E{(unsigned char*)(ws + WS_BUFZ), 1.0f}; pg8::gemm_phase<pg8::EpiSwiglu8, pg8::SchedMoe<true>>(F.lds, 1024, S, E); }
            else { pg8::EpiSwiglu E{(bf16*)(ws + WS_BUFZ)}; pg8::gemm_phase<pg8::EpiSwiglu, pg8::SchedMoe<true>>(F.lds, 1024, S, E); }
        }
    }) SEAM(7);
    PH(8, {
        const int ntile = moe_tables(F, 0);
        if constexpr (FP8_G2_L0) {
            pg8::SchedMoe<false> S{(const char*)(ws + WS_BUFZ), (const char*)(ws + WS_W_M2) + (size_t)0 * 16 * MiB, nullptr, (const LAS int*)(F.lds + LDS_CTL + 64), (const LAS int*)(F.lds + LDS_CTL + 192), 256, (size_t)512 * KiB, ntile * 4, F.vcu, F.G};
            pg8::EpiStoreS E{(bf16*)(ws + WS_BUFP), 1024, 1.0f / (pg8::HID_SCALE * pg8::W2_SCALE)};
            pg8::gemm_phase<pg8::EpiStoreS, pg8::SchedMoe<false>, true>(F.lds, 256, S, E);
        } else {
            pg8::SchedMoe<false> S{(const char*)(ws + WS_BUFZ), (const char*)(ws + WS_W_M2) + (size_t)0 * 16 * MiB, nullptr, (const LAS int*)(F.lds + LDS_CTL + 64), (const LAS int*)(F.lds + LDS_CTL + 192), 512, (size_t)MiB, ntile * 4, F.vcu, F.G};
            pg8::EpiStore E{(bf16*)(ws + WS_BUFP), 1024};
            pg8::gemm_phase<pg8::EpiStore, pg8::SchedMoe<false>>(F.lds, 512, S, E);
        }
    }) SEAM(8);
    PH(9, { (void)moe_tables(F, 0); phase_combine(F, 0, T); }) SEAM(9);
    PH(10, {
        pg8::SchedDense S{(const char*)(ws + WS_BUFA), (const char*)(ws + WS_W_OIN), 1024, 5, 128, 4, 648, F.vcu, F.G};
        pg8::EpiStore E{(bf16*)(ws + WS_BUFP), OIN};
        pg8::gemm_phase<pg8::EpiStore, pg8::SchedDense>(F.lds, 1024, S, E);
    }) SEAM(10);
    PH(11, { phase_attn_pool(F); }) SEAM(11);
    PH(12, {
        pg8::SchedDense S{(const char*)(ws + WS_BUFA), (const char*)(ws + WS_W_OOUT), 1024, 4, 128, 0, 512, F.vcu, F.G};
        pg8::EpiResid<false> E{nullptr, nullptr, (bf16*)(ws + WS_HB), mods + 9 * 6144 + 2 * 1024};
        pg8::gemm_phase<pg8::EpiResid<false>, pg8::SchedDense>(F.lds, 1024, S, E);
    }) SEAM(12);
    PH(13, { phase_route(F, 1, TL); }) SEAM(13);
    PH(14, {
        const int ntile = moe_tables(F, 1);
        if constexpr (FP8_G1_L1) {
            pg8::SchedMoe<true> S{(const char*)(ws + WS_BUFA), (const char*)(ws + WS_W_M1) + (size_t)1 * 32 * MiB, (const int*)(ws + WS_TOKMAP), (const LAS int*)(F.lds + LDS_CTL + 64), (const LAS int*)(F.lds + LDS_CTL + 192), 512, (size_t)MiB, ntile * 4, F.vcu, F.G};
            pg8::EpiSwiglu8 E{(unsigned char*)(ws + WS_BUFZ), pg8::W1_SCALE};
            pg8::gemm_phase<pg8::EpiSwiglu8, pg8::SchedMoe<true>, true>(F.lds, 512, S, E);
        } else {
            pg8::SchedMoe<true> S{(const char*)(ws + WS_BUFA), (const char*)(ws + WS_W_M1) + (size_t)1 * 32 * MiB, (const int*)(ws + WS_TOKMAP), (const LAS int*)(F.lds + LDS_CTL + 64), (const LAS int*)(F.lds + LDS_CTL + 192), 1024, (size_t)2 * MiB, ntile * 4, F.vcu, F.G};
            if constexpr (FP8_G2_L1) { pg8::EpiSwiglu8 E{(unsigned char*)(ws + WS_BUFZ), 1.0f}; pg8::gemm_phase<pg8::EpiSwiglu8, pg8::SchedMoe<true>>(F.lds, 1024, S, E); }
            else { pg8::EpiSwiglu E{(bf16*)(ws + WS_BUFZ)}; pg8::gemm_phase<pg8::EpiSwiglu, pg8::SchedMoe<true>>(F.lds, 1024, S, E); }
        }
    }) SEAM(14);
    PH(15, {
        const int ntile = moe_tables(F, 1);
        if constexpr (FP8_G2_L1) {
            pg8::SchedMoe<false> S{(const char*)(ws + WS_BUFZ), (const char*)(ws + WS_W_M2) + (size_t)1 * 16 * MiB, nullptr, (const LAS int*)(F.lds + LDS_CTL + 64), (const LAS int*)(F.lds + LDS_CTL + 192), 256, (size_t)512 * KiB, ntile * 4, F.vcu, F.G};
            pg8::EpiStoreS E{(bf16*)(ws + WS_BUFP), 1024, 1.0f / (pg8::HID_SCALE * pg8::W2_SCALE)};
            pg8::gemm_phase<pg8::EpiStoreS, pg8::SchedMoe<false>, true>(F.lds, 256, S, E);
        } else {
            pg8::SchedMoe<false> S{(const char*)(ws + WS_BUFZ), (const char*)(ws + WS_W_M2) + (size_t)1 * 16 * MiB, nullptr, (const LAS int*)(F.lds + LDS_CTL + 64), (const LAS int*)(F.lds + LDS_CTL + 192), 512, (size_t)MiB, ntile * 4, F.vcu, F.G};
            pg8::EpiStore E{(bf16*)(ws + WS_BUFP), 1024};
            pg8::gemm_phase<pg8::EpiStore, pg8::SchedMoe<false>>(F.lds, 512, S, E);
        }
    }) SEAM(15);
    PH(16, { (void)moe_tables(F, 1); phase_combine(F, 1, TL); }) SEAM(16);
#ifdef DBG_XBAR
    if (hi - lo > 1) { for (int xb = 0; xb < DBG_XBAR; ++xb) xcd_barrier(bar); }
#endif
#undef IN
#undef SEAM
}

extern "C" void kernel_launch(void* const* d_in, const int* in_sizes, int n_in, void* d_out, int out_size, void* d_ws, size_t ws_size, hipStream_t stream) {
    static int grid = 0;
    if (grid == 0) {
        if (n_in != 22 || ws_size < WS_END) { fprintf(stderr, "kernel_launch: unexpected inputs (n_in %d, ws %zu)\n", n_in, ws_size); grid = -1; return; }
        int dev = 0, cus = 0, per_cu = 0;
        if (hipGetDevice(&dev) != hipSuccess || hipDeviceGetAttribute(&cus, hipDeviceAttributeMultiprocessorCount, dev) != hipSuccess) { grid = -1; return; }
        if (hipFuncSetAttribute((const void*)mk_fwd, hipFuncAttributeMaxDynamicSharedMemorySize, LDS_BYTES) != hipSuccess) { fprintf(stderr, "kernel_launch: hipFuncSetAttribute failed\n"); grid = -1; return; }
        if (hipOccupancyMaxActiveBlocksPerMultiprocessor(&per_cu, (const void*)mk_fwd, NWAVES * 64, LDS_BYTES) != hipSuccess || per_cu < 1) { fprintf(stderr, "kernel_launch: occupancy query says %d\n", per_cu); }
        (void)hipGetLastError();
        grid = cus;
        if (grid != 256) { fprintf(stderr, "kernel_launch: %d CUs; this build assumes 256\n", grid); }
    }
    if (grid < 0) return;
    (void)hipMemsetAsync((char*)d_ws + WS_CTL, 0, CTL_ZERO_BYTES, stream);
    Args a{};
    for (int i = 0; i < 22; ++i) a.in[i] = (const float*)d_in[i];
    a.out = (float*)d_out; a.ws = (unsigned char*)d_ws;
#if MK_MULTI
    for (int p = 0; p <= DBG_STOP; ++p) { a.ph_lo = p; a.ph_hi = p + 1; hipLaunchKernelGGL(mk_fwd, dim3(grid), dim3(NWAVES * 64), LDS_BYTES, stream, a); }
    if (DBG_STOP < 16) { a.ph_lo = 17; a.ph_hi = 18; hipLaunchKernelGGL(mk_fwd, dim3(grid), dim3(NWAVES * 64), LDS_BYTES, stream, a); }
#else
    a.ph_lo = 0; a.ph_hi = 17;
    hipLaunchKernelGGL(mk_fwd, dim3(grid), dim3(NWAVES * 64), LDS_BYTES, stream, a);
#endif
}
```

```cpp
#include <hip/hip_runtime.h>
#include <cstdio>
#include <cstdint>
#include <type_traits>

#ifndef MK_MULTI
#define MK_MULTI 0
#endif
#ifndef DBG_STOP
#define DBG_STOP 16
#endif

#ifndef DBG_DOUBLE
#define DBG_DOUBLE 0u
#endif
#ifndef FP8_G1_L0
#define FP8_G1_L0 1
#endif
#ifndef FP8_G1_L1
#define FP8_G1_L1 1
#endif
#ifndef FP8_G2_L0
#define FP8_G2_L0 1
#endif
#ifndef FP8_G2_L1
#define FP8_G2_L1 1
#endif
#define LAS __attribute__((address_space(3)))
#define GAS __attribute__((address_space(1)))
typedef unsigned short bf16;
typedef short bf16x8 __attribute__((ext_vector_type(8)));
typedef short s16x4 __attribute__((ext_vector_type(4)));
typedef float f32x4 __attribute__((ext_vector_type(4)));
typedef float f32x16 __attribute__((ext_vector_type(16)));
typedef unsigned u32x4 __attribute__((ext_vector_type(4)));
typedef unsigned u32x2 __attribute__((ext_vector_type(2)));

constexpr int NB = 8, NSEQ = 4096, D = 1024, LCTX = 256;
constexpr int TL = NB * NSEQ, TC = NB * LCTX, T = TL + TC;
constexpr int EIN = 2048;
constexpr int OIN = 1280;
constexpr int NE = 16, DE = 512;
constexpr int MAXSLOT = 73728;
constexpr float EPS = 1e-6f;

constexpr size_t KiB = 1024, MiB = 1024 * 1024;
constexpr size_t WS_CTL = 0, CTL_ZERO_BYTES = 64 * KiB;
constexpr size_t WS_MODS = 64 * KiB;
constexpr size_t WS_ROPE = WS_MODS + 512 * KiB;
constexpr size_t WS_WA = WS_ROPE + 8 * KiB;
constexpr size_t WS_WAC = WS_WA + 32 * KiB;
constexpr size_t WS_WCC = WS_WAC + 2 * KiB;
constexpr size_t WS_FD = 3 * MiB - 64 * KiB;
constexpr size_t WS_BCNT = WS_WCC + 16 * KiB;
constexpr size_t WS_TILEMAP = WS_BCNT + 16 * KiB;
constexpr size_t WS_SLOT = WS_TILEMAP + 2 * KiB;
constexpr size_t WS_WROW = WS_SLOT + 288 * KiB;
constexpr size_t WS_ROUTE = WS_WROW + 288 * KiB;
constexpr size_t WS_WC = 3 * MiB;
constexpr size_t WS_W_EIN = 4 * MiB;
constexpr size_t WS_W_EOUT = 9 * MiB;
constexpr size_t WS_W_OIN = 11 * MiB;
constexpr size_t WS_W_OOUT = 14 * MiB;
constexpr size_t WS_W_POOL = 16 * MiB;
constexpr size_t WS_W_M1 = 17 * MiB;
constexpr size_t WS_W_M2 = 81 * MiB;
constexpr size_t WS_HC = 113 * MiB;
constexpr size_t WS_BUFA = 121 * MiB;
constexpr size_t WS_BUFP = 189 * MiB;
constexpr size_t WS_BUFZ = 360 * MiB;
constexpr size_t WS_TOKMAP = 432 * MiB;
constexpr size_t WS_HB = 435 * MiB;
constexpr size_t WS_END = 503 * MiB;
constexpr size_t WS_GCNT = 16 * KiB;
static_assert(WS_ROUTE + (size_t)T * 32 <= WS_WC, "small region");
static_assert((size_t)T * EIN * 2 <= WS_BUFZ - WS_BUFP && (size_t)MAXSLOT * 1024 * 2 <= WS_BUFZ - WS_BUFP, "BUFP");
static_assert((size_t)MAXSLOT * 512 * 2 <= WS_TOKMAP - WS_BUFZ && (size_t)T * 1024 * 2 <= WS_TOKMAP - WS_BUFZ, "BUFZ");
static_assert((size_t)16 * T * 4 <= WS_HB - WS_TOKMAP && (size_t)T * 1024 * 2 <= WS_END - WS_HB, "TOKMAP / HB");
static_assert((size_t)T * 1024 * 2 <= WS_BUFP - WS_BUFA, "BUFA");

constexpr int LDS_BYTES = 163840;
constexpr int LDS_GIDX = 147456;
constexpr int LDS_CTL = 146432;
constexpr int NWAVES = 8;

__device__ __forceinline__ unsigned f2bf(float f) { unsigned u = __builtin_bit_cast(unsigned, f); return (u + 0x7fffu + ((u >> 16) & 1u)) >> 16; }
__device__ __forceinline__ unsigned pk2(float lo, float hi) { return f2bf(lo) | (f2bf(hi) << 16); }
__device__ __forceinline__ float bflo(unsigned w) { return __builtin_bit_cast(float, w << 16); }
__device__ __forceinline__ float bfhi(unsigned w) { return __builtin_bit_cast(float, w & 0xffff0000u); }
__device__ __forceinline__ float wave_sum(float v) {
#pragma unroll
    for (int o = 1; o < 64; o <<= 1) v += __shfl_xor(v, o);
    return v;
}
__device__ __forceinline__ int ld_coh(const int* p) { return (int)__hip_atomic_load((const unsigned*)p, __ATOMIC_RELAXED, __HIP_MEMORY_SCOPE_AGENT); }
__device__ __forceinline__ float ld_cohf(const float* p) { return __builtin_bit_cast(float, __hip_atomic_load((const unsigned*)p, __ATOMIC_RELAXED, __HIP_MEMORY_SCOPE_AGENT)); }
#define LDS_WAIT() asm volatile("s_waitcnt lgkmcnt(0)" ::: "memory")

#define XB_TMO      128
#define XB_XCNT(j)  (256  + 64 * (j))
#define XB_XSUB(j)  (1280 + 64 * (j))
#define XB_XGEN(j)  (2304 + 64 * (j))
#define XB_TOP      3328
#define XB_TOPGEN   3392
#define XCD_BAR_WORDS 3456
#define XB_SPIN_CAP (1u << 18)
__device__ __forceinline__ unsigned xb_ld(unsigned* p)              { return __hip_atomic_load(p, __ATOMIC_RELAXED, __HIP_MEMORY_SCOPE_AGENT); }
__device__ __forceinline__ unsigned xb_add(unsigned* p, unsigned v) { return __hip_atomic_fetch_add(p, v, __ATOMIC_RELAXED, __HIP_MEMORY_SCOPE_AGENT); }
__device__ __forceinline__ unsigned xb_xcc_id() { return (unsigned)__builtin_amdgcn_s_getreg((3 << 11) | 20) & 0xFu; }
#define XB_SPIN(cond, bar) do { unsigned _sp = 0; while (cond) { __builtin_amdgcn_s_sleep(1); \
    if ((++_sp & 255u) == 0u) { if (xb_ld(&(bar)[XB_TMO])) break; if (_sp > XB_SPIN_CAP) { atomicAdd(&(bar)[XB_TMO], 1u); break; } } } } while (0)
struct XcdBarrier { unsigned* bar; unsigned x; volatile LAS unsigned* st; };
__device__ __forceinline__ XcdBarrier xcd_barrier_post(unsigned* bar, volatile LAS unsigned* st) {
    XcdBarrier b; b.bar = bar; b.x = xb_xcc_id(); b.st = st;
    if (threadIdx.x == 0) (void)xb_add(&bar[XB_XCNT(b.x)], 1u);
    return b;
}
__device__ __forceinline__ void xcd_barrier_complete(unsigned* bar, unsigned x, unsigned& nloc, unsigned& nx) {
    const unsigned G = gridDim.x * gridDim.y * gridDim.z;
    unsigned sum, cnt, mine, sp = 0u;
    for (;;) {
        sum = 0u; cnt = 0u; mine = 0u;
#pragma unroll
        for (unsigned j = 0; j < 16; ++j) { const unsigned c = xb_ld(&bar[XB_XCNT(j)]); sum += c; cnt += (c > 0u) ? 1u : 0u; mine = (j == x) ? c : mine; }
        if (sum == G) break;
        __builtin_amdgcn_s_sleep(1);
        if ((++sp & 255u) == 0u) { if (xb_ld(&bar[XB_TMO])) break; if (sp > XB_SPIN_CAP) { atomicAdd(&bar[XB_TMO], 1u); break; } }
    }
    nloc = mine > 0u ? mine : 1u; nx = cnt > 0u ? cnt : 1u;
}
__device__ __forceinline__ void xcd_barrier(const XcdBarrier& b) {
    asm volatile("s_waitcnt vmcnt(0)" ::: "memory");
    __syncthreads();
    if (threadIdx.x == 0) {
        unsigned* bar = b.bar;
        __builtin_amdgcn_s_waitcnt(0);
        unsigned nloc = b.st[0], nx = b.st[1];
        if (nloc == 0u) { xcd_barrier_complete(bar, b.x, nloc, nx); b.st[0] = nloc; b.st[1] = nx; }
        const unsigned old = xb_add(&bar[XB_XSUB(b.x)], 1u);
        const unsigned gen = old / nloc;
        if (old + 1u == (gen + 1u) * nloc) {
            __builtin_amdgcn_fence(__ATOMIC_RELEASE, "agent");
            asm volatile("s_waitcnt vmcnt(0)" ::: "memory");
            const unsigned og = xb_add(&bar[XB_TOP], 1u);
            const unsigned tg = og / nx;
            if (og + 1u == (tg + 1u) * nx) xb_add(&bar[XB_TOPGEN], 1u);
            else XB_SPIN(xb_ld(&bar[XB_TOPGEN]) == tg, bar);
            __builtin_amdgcn_fence(__ATOMIC_ACQUIRE, "agent");
            xb_add(&bar[XB_XGEN(b.x)], 1u);
            asm volatile("s_waitcnt vmcnt(0)" ::: "memory");
        } else {
            XB_SPIN(xb_ld(&bar[XB_XGEN(b.x)]) == gen, bar);
            __builtin_amdgcn_fence(__ATOMIC_ACQUIRE, "agent");
            asm volatile("s_waitcnt vmcnt(0)" ::: "memory");
        }
    }
    __syncthreads();
}

namespace pg8 {
constexpr int BM = 256, BK = 64, HALF = 128, HTB = HALF * BK * 2, STAGE_BYTES = 8 * HTB;
__host__ __device__ __forceinline__ int lds_byte(int r, int c) { const int st = (r >> 4) * 2 + (c >> 5), rr = r & 15, cc = c & 31, ob = rr * 64 + cc * 2; return st * 1024 + (ob ^ (((ob >> 9) & 1) << 5)); }
__host__ __device__ __forceinline__ void stage_rc(int b, int& R, int& C) { const int st = b / 1024, sb = b % 1024, swz = sb ^ (((sb >> 9) & 1) << 5); R = (st >> 1) * 16 + swz / 64; C = (st & 1) * 32 + (swz % 64) / 2; }
__host__ __device__ __forceinline__ int perm32(int rho) { const int n = rho >> 4, i = rho & 15; return 8 * (i >> 2) + 4 * n + (i & 3); }
struct Unit { int pm, pn, e; };
__device__ __forceinline__ unsigned cvt_pk_bf16(float lo, float hi) { unsigned r; asm volatile("v_cvt_pk_bf16_f32 %0, %1, %2" : "=v"(r) : "v"(lo), "v"(hi)); return r; }

typedef int v8i32 __attribute__((ext_vector_type(8)));
typedef int v4i32 __attribute__((ext_vector_type(4)));
__device__ __forceinline__ v8i32 cat16(const bf16x8 lo, const bf16x8 hi) { return __builtin_shufflevector(__builtin_bit_cast(v4i32, lo), __builtin_bit_cast(v4i32, hi), 0, 1, 2, 3, 4, 5, 6, 7); }
template <class Epi, class Sched, bool FP8 = false>
__device__ __forceinline__ void gemm_phase(LAS unsigned char* lds, const int K, const Sched& S, const Epi& E) {
    const int tid = threadIdx.x, wid = __builtin_amdgcn_readfirstlane(tid >> 6), lane = tid & 63, wr = wid >> 2, wc = wid & 3, fr = lane & 15, fq = lane >> 4;
    const int nt = K / BK;
    int tidv = tid;
#define PG8_VB(i) ([&]() -> unsigned { int R_, C_; stage_rc(tidv * 16 + (i) * 8192, R_, C_); const int Rb_ = Epi::PERM ? ((R_ & ~31) + perm32(R_ & 31)) : R_; return (unsigned)(Rb_ * K + C_) * 2u; }())
#define PG8_VA(h, i) ([&]() -> unsigned { int R_, C_; stage_rc(tidv * 16 + (i) * 8192, R_, C_); return (unsigned)((128 * (h) + R_) * K + C_) * 2u; }())
    const size_t kstep = (size_t)(BK * 2);
    const size_t hstep = (size_t)HALF * K * 2;
    const unsigned ldsw = (unsigned)wid * 1024u;
#define aoff (lds_byte(wr * 64 + (tidv & 15), ((tidv >> 4) & 3) * 8))
#define boff (lds_byte(wc * 32 + (tidv & 15), ((tidv >> 4) & 3) * 8))
#define PG8_SA(b, h) (((b) * 2 + (h)) * HTB)
#define PG8_SB(b, h) ((4 + (b) * 2 + (h)) * HTB)
#define PG8_STAGEB(bufoff, gbase) do { _Pragma("unroll") for (int _i = 0; _i < 2; ++_i) \
        __builtin_amdgcn_global_load_lds((const unsigned*)((const char*)(gbase) + PG8_VB(_i)), (LAS unsigned*)(lds + (bufoff) + ldsw + _i * 8192), 16, 0, 0); } while (0)
#define PG8_STAGEA(bufoff, gbase, h, NEXT) do { _Pragma("unroll") for (int _i = 0; _i < 2; ++_i) { unsigned vo_; \
        if constexpr (Sched::GATHER) { int R_, C_; stage_rc(tidv * 16 + _i * 8192, R_, C_); const unsigned raw_ = gidx[((((NEXT) && usen) ? (gslot ^ 1u) : gslot) * 4u + (h) * 2 + _i) * 512u + tid]; vo_ = (raw_ * (unsigned)K + (unsigned)C_) * 2u; } \
        else vo_ = PG8_VA(h, _i); \
        __builtin_amdgcn_global_load_lds((const unsigned*)((const char*)(gbase) + vo_), (LAS unsigned*)(lds + (bufoff) + ldsw + _i * 8192), 16, 0, 0); } } while (0)
#define PG8_LDA(dst, b, h) do { _Pragma("unroll") for (int m = 0; m < 4; ++m) _Pragma("unroll") for (int k = 0; k < 2; ++k) dst[m][k] = *(const LAS bf16x8*)(lds + PG8_SA(b, h) + aoff + m * 2048 + k * 1024); } while (0)
#define PG8_LDB(dst, b, h) do { _Pragma("unroll") for (int n = 0; n < 2; ++n) _Pragma("unroll") for (int k = 0; k < 2; ++k) dst[n][k] = *(const LAS bf16x8*)(lds + PG8_SB(b, h) + boff + n * 2048 + k * 1024); } while (0)
#define PG8_MMA(ai, bj, At, Bt) do { __builtin_amdgcn_s_setprio(1); _Pragma("unroll") for (int m = 0; m < 4; ++m) _Pragma("unroll") for (int n = 0; n < 2; ++n) { \
        if constexpr (FP8) acc[ai][bj][m][n] = __builtin_amdgcn_mfma_scale_f32_16x16x128_f8f6f4(cat16(Bt[n][0], Bt[n][1]), cat16(At[m][0], At[m][1]), acc[ai][bj][m][n], 0, 0, 0, 0x7f7f7f7f, 0, 0x7f7f7f7f); \
        else { _Pragma("unroll") for (int k = 0; k < 2; ++k) acc[ai][bj][m][n] = __builtin_amdgcn_mfma_f32_16x16x32_bf16(Bt[n][k], At[m][k], acc[ai][bj][m][n], 0, 0, 0); } } \
        __builtin_amdgcn_s_setprio(0); } while (0)
#define PG8_WAIT_V(n) asm volatile("s_waitcnt vmcnt(" #n ")" ::: "memory")
#define PG8_WAIT_L(n) asm volatile("s_waitcnt lgkmcnt(" #n ")" ::: "memory")
#define PG8_BAR __builtin_amdgcn_s_barrier()
#define PG8_SCHED __builtin_amdgcn_sched_barrier(0)
#define PG8_ITER(A1, A2, A3, B2, B3) do { \
            PG8_LDB(B0, 0, 0); PG8_LDB(B1, 0, 1); PG8_SCHED; PG8_LDA(At, 0, 0); PG8_STAGEA(PG8_SA(1, 1), A1, 1, 0); \
            PG8_WAIT_V(8); PG8_WAIT_L(0); PG8_BAR; PG8_MMA(0, 0, At, B0); PG8_MMA(0, 1, At, B1); PG8_BAR; PG8_SCHED; \
            PG8_LDA(At, 0, 1); PG8_STAGEB(PG8_SB(0, 0), B2); PG8_STAGEB(PG8_SB(0, 1), (B2) + hstep); PG8_STAGEA(PG8_SA(0, 0), A2, 0, 1); \
            PG8_WAIT_V(8); PG8_WAIT_L(0); PG8_BAR; PG8_MMA(1, 0, At, B0); PG8_MMA(1, 1, At, B1); PG8_BAR; PG8_SCHED; \
            PG8_LDB(B0, 1, 0); PG8_LDB(B1, 1, 1); PG8_SCHED; PG8_LDA(At, 1, 0); PG8_STAGEA(PG8_SA(0, 1), A2, 1, 1); \
            PG8_WAIT_V(8); PG8_WAIT_L(0); PG8_BAR; PG8_MMA(0, 0, At, B0); PG8_MMA(0, 1, At, B1); PG8_BAR; PG8_SCHED; \
            PG8_LDA(At, 1, 1); PG8_STAGEB(PG8_SB(1, 0), B3); PG8_STAGEB(PG8_SB(1, 1), (B3) + hstep); PG8_STAGEA(PG8_SA(1, 0), A3, 0, 1); \
            PG8_WAIT_V(8); PG8_WAIT_L(0); PG8_BAR; PG8_MMA(1, 0, At, B0); PG8_MMA(1, 1, At, B1); PG8_BAR; PG8_SCHED; } while (0)
    Unit cur, nxt; int ui = 0;
    if (!S.next(0, cur)) return;
    f32x4 acc[2][2][4][2];
#pragma unroll
    for (int a = 0; a < 2; ++a)
#pragma unroll
        for (int b = 0; b < 2; ++b)
#pragma unroll
            for (int m = 0; m < 4; ++m)
#pragma unroll
                for (int n = 0; n < 2; ++n) acc[a][b][m][n] = (f32x4){0.f, 0.f, 0.f, 0.f};
    bf16x8 At[4][2], B0[2][2], B1[2][2];
    const LAS unsigned* gidx = (const LAS unsigned*)(lds + LDS_GIDX); unsigned gslot = 0u;
    if constexpr (Sched::GATHER) { S.idx_dma(cur, (LAS unsigned*)(lds + LDS_GIDX), tidv, wid); asm volatile("s_waitcnt vmcnt(0)" ::: "memory"); }
    const char* cA = S.a_base(cur); const char* cB = S.b_base(cur);
    constexpr bool usen = false;
    PG8_STAGEB(PG8_SB(0, 0), cB); PG8_STAGEB(PG8_SB(0, 1), cB + hstep); PG8_STAGEA(PG8_SA(0, 0), cA, 0, 0); PG8_STAGEA(PG8_SA(0, 1), cA, 1, 0);
    if (wr == 1) PG8_BAR;
    PG8_WAIT_V(2); PG8_BAR;
    PG8_STAGEB(PG8_SB(1, 0), cB + kstep); PG8_STAGEA(PG8_SA(1, 0), cA + kstep, 0, 0); PG8_STAGEB(PG8_SB(1, 1), cB + hstep + kstep);
    PG8_WAIT_V(6); PG8_BAR;
    for (;;) {
        const bool has_next = S.next(ui + 1, nxt);
        const char* nA = has_next ? S.a_base(nxt) : cA; const char* nB = has_next ? S.b_base(nxt) : cB;
#pragma unroll 1
        for (int t = 0; t < nt; t += 2) {
            const bool last = (t == nt - 2);
            const char* a1 = cA + (size_t)(t + 1) * kstep;
            const char* a2 = last ? nA : cA + (size_t)(t + 2) * kstep; const char* b2 = last ? nB : cB + (size_t)(t + 2) * kstep;
            tidv = tid; asm volatile("" : "+v"(tidv));
            if constexpr (Sched::GATHER) {
                if (t == nt - 4 && has_next) S.idx_dma(nxt, (LAS unsigned*)(lds + LDS_GIDX) + (gslot ^ 1u) * 2048u, tidv, wid);
            }
            const bool usen = last && has_next;
            PG8_ITER(a1, a2, a2 + kstep, b2, b2 + kstep);
        }
        if (wr == 0) PG8_BAR;
        E(acc, cur, wr, wc, fr, fq);
        if (!has_next) break;
#pragma unroll
        for (int a = 0; a < 2; ++a)
#pragma unroll
            for (int b = 0; b < 2; ++b)
#pragma unroll
                for (int m = 0; m < 4; ++m)
#pragma unroll
                    for (int n = 0; n < 2; ++n) acc[a][b][m][n] = (f32x4){0.f, 0.f, 0.f, 0.f};
        cur = nxt; cA = nA; cB = nB; ++ui;
        if constexpr (Sched::GATHER) gslot ^= 1u;
        if (wr == 1) PG8_BAR;
    }
    PG8_WAIT_V(0);
    PG8_BAR;
#undef PG8_ITER
#undef aoff
#undef boff
#undef PG8_SA
#undef PG8_SB
#undef PG8_STAGEA
#undef PG8_STAGEB
#undef PG8_VA
#undef PG8_VB
#undef PG8_LDA
#undef PG8_LDB
#undef PG8_MMA
#undef PG8_WAIT_V
#undef PG8_WAIT_L
#undef PG8_BAR
#undef PG8_SCHED
}

struct SchedDense {
    static constexpr bool GATHER = false;
    const char* A; const char* Bt; int K, nN, nMfull, pnx, nUnits, c, G;
    __device__ __forceinline__ bool next(int i, Unit& u) const {
        const int L = i * G + c; if (L >= nUnits) return false;
        const int full = nMfull * nN;
        if (L < full) { u.pm = L / nN; u.pn = L - u.pm * nN; } else { u.pm = nMfull + (L - full); u.pn = pnx; }
        u.e = 0; return true;
    }
    __device__ __forceinline__ const char* a_base(const Unit& u) const { return A + (size_t)u.pm * 256 * K * 2; }
    __device__ __forceinline__ const char* b_base(const Unit& u) const { return Bt + (size_t)u.pn * 256 * K * 2; }
};
template <bool GATHER_> struct SchedMoe {
    static constexpr bool GATHER = GATHER_, gather = GATHER_;
    const char* A; const char* W; const int* tokmap; const LAS int* tb; const LAS int* cn; int K; size_t wstride; int nUnits, c, G;
    __device__ __forceinline__ bool next(int i, Unit& u) const {
        const int L = i * G + c; if (L >= nUnits) return false;
        u.pm = L >> 2; u.pn = L & 3; int e = 0;
#pragma unroll
        for (int q = 1; q < 16; ++q) if (u.pm >= __builtin_amdgcn_readfirstlane(tb[q])) e = q;
        u.e = __builtin_amdgcn_readfirstlane(e); return true;
    }
    __device__ __forceinline__ const char* a_base(const Unit& u) const { return gather ? A : A + (size_t)u.pm * 256 * K * 2; }
    __device__ __forceinline__ const char* b_base(const Unit& u) const { return W + (size_t)u.e * wstride + (size_t)u.pn * 256 * K * 2; }
    __device__ __forceinline__ void idx_dma(const Unit& u, LAS unsigned* slot, int tidv, int wid) const {
        const int p0 = (u.pm - __builtin_amdgcn_readfirstlane(tb[u.e])) * 256, last = __builtin_amdgcn_readfirstlane(cn[u.e]) - 1; const int* tm = tokmap + (size_t)u.e * T;
#pragma unroll
        for (int h = 0; h < 2; ++h)
#pragma unroll
            for (int i = 0; i < 2; ++i) { int R_, C_; stage_rc(tidv * 16 + i * 8192, R_, C_); int pos = p0 + 128 * h + R_; pos = pos < last ? pos : last;
                __builtin_amdgcn_global_load_lds((const unsigned*)(tm + pos), slot + (h * 2 + i) * 512 + wid * 64, 4, 0, 0); }
    }
};

struct EpiStore {
    static constexpr bool PERM = true;
    bf16* O; int ldc;
    __device__ __forceinline__ void operator()(const f32x4 (&acc)[2][2][4][2], const Unit& u, int wr, int wc, int fr, int fq) const {
        const int row0 = u.pm * BM + wr * 64 + fr, col0 = u.pn * BM + wc * 32 + 8 * fq;
#pragma unroll
        for (int ai = 0; ai < 2; ++ai)
#pragma unroll
            for (int m = 0; m < 4; ++m) { bf16* rowp = O + (size_t)(row0 + ai * HALF + m * 16) * ldc + col0;
#pragma unroll
                for (int bj = 0; bj < 2; ++bj) { const f32x4 v0 = acc[ai][bj][m][0], v1 = acc[ai][bj][m][1];
                    u32x4 w; w.x = cvt_pk_bf16(v0[0], v0[1]); w.y = cvt_pk_bf16(v0[2], v0[3]); w.z = cvt_pk_bf16(v1[0], v1[1]); w.w = cvt_pk_bf16(v1[2], v1[3]);
                    *(u32x4*)(rowp + bj * HALF) = w; } }
    }
};
template <bool SRC_F32> struct EpiResid {
    static constexpr bool PERM = true;
    const float* srcL; const float* srcC; bf16* H; const float* gate;
    __device__ __forceinline__ void operator()(const f32x4 (&acc)[2][2][4][2], const Unit& u, int wr, int wc, int fr, int fq) const {
        const float* g = gate + (u.pm < 128 ? (u.pm >> 4) : 8) * 6144;
        const float* src = (u.pm < 128) ? srcL + (size_t)u.pm * 256 * 1024 : srcC + (size_t)(u.pm - 128) * 256 * 1024;
        bf16* dst = H + (size_t)u.pm * 256 * 1024;
        const int row0 = wr * 64 + fr, col0 = u.pn * BM + wc * 32 + 8 * fq;
        f32x4 gv[2][2];
#pragma unroll
        for (int bj = 0; bj < 2; ++bj)
#pragma unroll
            for (int n = 0; n < 2; ++n) gv[bj][n] = *(const f32x4*)(g + col0 + bj * HALF + 4 * n);
#pragma unroll
        for (int ai = 0; ai < 2; ++ai)
#pragma unroll
            for (int m = 0; m < 4; ++m) { const size_t ro = (size_t)(row0 + ai * HALF + m * 16) * 1024 + col0;
#pragma unroll
                for (int bj = 0; bj < 2; ++bj) {
                    f32x4 s0, s1;
                    if constexpr (SRC_F32) { s0 = __builtin_nontemporal_load((const f32x4*)(src + ro + bj * HALF)); s1 = __builtin_nontemporal_load((const f32x4*)(src + ro + bj * HALF + 4)); }
                    else { const u32x4 hv = *(const u32x4*)(dst + ro + bj * HALF); s0 = (f32x4){bflo(hv.x), bfhi(hv.x), bflo(hv.y), bfhi(hv.y)}; s1 = (f32x4){bflo(hv.z), bfhi(hv.z), bflo(hv.w), bfhi(hv.w)}; }
                    const f32x4 v0 = s0 + gv[bj][0] * acc[ai][bj][m][0], v1 = s1 + gv[bj][1] * acc[ai][bj][m][1];
                    u32x4 w; w.x = cvt_pk_bf16(v0[0], v0[1]); w.y = cvt_pk_bf16(v0[2], v0[3]); w.z = cvt_pk_bf16(v1[0], v1[1]); w.w = cvt_pk_bf16(v1[2], v1[3]);
                    *(u32x4*)(dst + ro + bj * HALF) = w; } }
    }
};
__device__ __forceinline__ float silu_f(float x) { return x * __builtin_amdgcn_rcpf(1.0f + __expf(-x)); }
struct EpiSwiglu {
    static constexpr bool PERM = true;
    bf16* H;
    __device__ __forceinline__ void operator()(const f32x4 (&acc)[2][2][4][2], const Unit& u, int wr, int wc, int fr, int fq) const {
        const int row0 = u.pm * BM + wr * 64 + fr, col0 = u.pn * 128 + wc * 32 + 8 * fq;
#pragma unroll
        for (int ai = 0; ai < 2; ++ai)
#pragma unroll
            for (int m = 0; m < 4; ++m) { bf16* p = H + (size_t)(row0 + ai * HALF + m * 16) * 512 + col0;
                const f32x4 g0 = acc[ai][0][m][0], g1 = acc[ai][0][m][1], u0 = acc[ai][1][m][0], u1 = acc[ai][1][m][1];
                u32x4 w; w.x = cvt_pk_bf16(silu_f(g0[0]) * u0[0], silu_f(g0[1]) * u0[1]); w.y = cvt_pk_bf16(silu_f(g0[2]) * u0[2], silu_f(g0[3]) * u0[3]);
                w.z = cvt_pk_bf16(silu_f(g1[0]) * u1[0], silu_f(g1[1]) * u1[1]); w.w = cvt_pk_bf16(silu_f(g1[2]) * u1[2], silu_f(g1[3]) * u1[3]);
                *(u32x4*)p = w; }
    }
};
__device__ __forceinline__ unsigned pk4_fp8(float a, float b, float c, float d) { int p = __builtin_amdgcn_cvt_pk_fp8_f32(a, b, 0, false); p = __builtin_amdgcn_cvt_pk_fp8_f32(c, d, p, true); return (unsigned)p; }
constexpr float W1_SCALE = 32.0f, W2_SCALE = 16.0f, HID_SCALE = 4.0f;
struct EpiSwiglu8 {
    static constexpr bool PERM = true;
    unsigned char* H; float in_scale;
    __device__ __forceinline__ void operator()(const f32x4 (&acc)[2][2][4][2], const Unit& u, int wr, int wc, int fr, int fq) const {
        const int row0 = u.pm * BM + wr * 64 + fr, col0 = u.pn * 128 + wc * 32 + 8 * fq;
        const float IS = 1.0f / in_scale, OS = HID_SCALE / in_scale;
#pragma unroll
        for (int ai = 0; ai < 2; ++ai)
#pragma unroll
            for (int m = 0; m < 4; ++m) { unsigned char* p = H + (size_t)(row0 + ai * HALF + m * 16) * 512 + col0;
                const f32x4 g0 = acc[ai][0][m][0] * IS, g1 = acc[ai][0][m][1] * IS, u0 = acc[ai][1][m][0] * OS, u1 = acc[ai][1][m][1] * OS;
#define HC8(x) __builtin_fminf(__builtin_fmaxf((x), -448.0f), 448.0f)
                u32x2 w; w.x = pk4_fp8(HC8(silu_f(g0[0]) * u0[0]), HC8(silu_f(g0[1]) * u0[1]), HC8(silu_f(g0[2]) * u0[2]), HC8(silu_f(g0[3]) * u0[3]));
                w.y = pk4_fp8(HC8(silu_f(g1[0]) * u1[0]), HC8(silu_f(g1[1]) * u1[1]), HC8(silu_f(g1[2]) * u1[2]), HC8(silu_f(g1[3]) * u1[3]));
#undef HC8
                *(u32x2*)p = w; }
    }
};
struct EpiStoreS {
    static constexpr bool PERM = true;
    bf16* O; int ldc; float scale;
    __device__ __forceinline__ void operator()(const f32x4 (&acc)[2][2][4][2], const Unit& u, int wr, int wc, int fr, int fq) const {
        const int row0 = u.pm * BM + wr * 64 + fr, col0 = u.pn * BM + wc * 32 + 8 * fq;
#pragma unroll
        for (int ai = 0; ai < 2; ++ai)
#pragma unroll
            for (int m = 0; m < 4; ++m) { bf16* rowp = O + (size_t)(row0 + ai * HALF + m * 16) * ldc + col0;
#pragma unroll
                for (int bj = 0; bj < 2; ++bj) { const f32x4 v0 = acc[ai][bj][m][0] * scale, v1 = acc[ai][bj][m][1] * scale;
                    u32x4 w; w.x = cvt_pk_bf16(v0[0], v0[1]); w.y = cvt_pk_bf16(v0[2], v0[3]); w.z = cvt_pk_bf16(v1[0], v1[1]); w.w = cvt_pk_bf16(v1[2], v1[3]);
                    *(u32x4*)(rowp + bj * HALF) = w; } }
    }
};
struct EpiScaleRow {
    static constexpr bool PERM = true;
    bf16* O; const float* wrow;
    __device__ __forceinline__ void operator()(const f32x4 (&acc)[2][2][4][2], const Unit& u, int wr, int wc, int fr, int fq) const {
        const int row0 = u.pm * BM + wr * 64 + fr, col0 = u.pn * BM + wc * 32 + 8 * fq;
#pragma unroll
        for (int ai = 0; ai < 2; ++ai)
#pragma unroll
            for (int m = 0; m < 4; ++m) { const int row = row0 + ai * HALF + m * 16; const float s = wrow[row]; bf16* rowp = O + (size_t)row * 1024 + col0;
#pragma unroll
                for (int bj = 0; bj < 2; ++bj) { const f32x4 v0 = acc[ai][bj][m][0] * s, v1 = acc[ai][bj][m][1] * s;
                    u32x4 w; w.x = cvt_pk_bf16(v0[0], v0[1]); w.y = cvt_pk_bf16(v0[2], v0[3]); w.z = cvt_pk_bf16(v1[0], v1[1]); w.w = cvt_pk_bf16(v1[2], v1[3]);
                    *(u32x4*)(rowp + bj * HALF) = w; } }
    }
};
}

struct Args { const float* in[22]; float* out; unsigned char* ws; int ph_lo, ph_hi; };
enum { I_X = 0, I_C, I_CTX, I_CCTX, I_ADAW, I_ADAB, I_NMG, I_NFG, I_EWIN, I_ECONV, I_EWOUT, I_OWIN, I_OPOOLW, I_OPOOLS, I_OSINK, I_OWOUT, I_RW, I_RB, I_MG, I_MU, I_MD, I_FG };

struct Frame {
    LAS unsigned char* lds;
    int tid, lane, wave, vcu, G;
    unsigned char* ws; const float* const* in; float* out;
};
__device__ __forceinline__ bf16* h_row(const Frame& F, int t) { return (bf16*)(F.ws + WS_HB) + (size_t)t * D; }
__device__ __forceinline__ int mod_row(int t) { return t < TL ? (t >> 12) : 8; }

struct TItem { const float* src; bf16* dst; int ldw, ldd; float f8scale; };
__device__ __forceinline__ void titem_load(const TItem& t, f32x4 (&r)[8], int lane) {
#pragma unroll
    for (int i = 0; i < 8; ++i) r[i] = __builtin_nontemporal_load((const f32x4*)(t.src + (size_t)((lane >> 3) + 8 * i) * t.ldw + 4 * (lane & 7)));
}
__device__ __forceinline__ void titem_process(const TItem& t, const f32x4 (&r)[8], LAS float* scr, int lane) {
#pragma unroll
    for (int i = 0; i < 8; ++i) { LAS float* d = scr + ((lane >> 3) + 8 * i) * 33 + 4 * (lane & 7); d[0] = r[i].x; d[1] = r[i].y; d[2] = r[i].z; d[3] = r[i].w; }
    LDS_WAIT(); asm volatile("" ::: "memory");
    const int c = lane & 7;
    if (t.f8scale != 0.0f) {
        const float sc = t.f8scale; unsigned char* d8 = (unsigned char*)t.dst;
#pragma unroll
        for (int j = 0; j < 4; ++j) { const int n = (lane >> 3) + 8 * j; const LAS float* s = scr + (8 * c) * 33 + n;
            u32x2 o; o.x = pg8::pk4_fp8(s[0 * 33] * sc, s[1 * 33] * sc, s[2 * 33] * sc, s[3 * 33] * sc); o.y = pg8::pk4_fp8(s[4 * 33] * sc, s[5 * 33] * sc, s[6 * 33] * sc, s[7 * 33] * sc);
            *(u32x2*)(d8 + (size_t)n * t.ldd + 8 * c) = o; }
    } else {
#pragma unroll
        for (int j = 0; j < 4; ++j) { const int n = (lane >> 3) + 8 * j; const LAS float* s = scr + (8 * c) * 33 + n;
            u32x4 o; o.x = pk2(s[0 * 33], s[1 * 33]); o.y = pk2(s[2 * 33], s[3 * 33]); o.z = pk2(s[4 * 33], s[5 * 33]); o.w = pk2(s[6 * 33], s[7 * 33]);
            *(u32x4*)(t.dst + (size_t)n * t.ldd + 8 * c) = o; }
    }
    LDS_WAIT(); asm volatile("" ::: "memory");
}
constexpr int TS0 = 1024, TS1 = 512, TS2 = 384, TS3 = 512, TS4 = 0, TS5 = 8192, TS6 = 8192, TS7 = 8192, TNITEMS = TS0 + TS1 + TS2 + TS3 + TS4 + TS5 + TS6 + TS7;
__device__ __forceinline__ TItem titem_moe(const float* const* in, unsigned char* ws, int kind, int le, int rr) {
    TItem t; const int layer = le >> 4, e = le & 15; const bool f8 = (kind < 2) ? (layer ? (FP8_G1_L1 != 0) : (FP8_G1_L0 != 0)) : (layer ? (FP8_G2_L1 != 0) : (FP8_G2_L0 != 0));
    if (kind < 2) { const int kb = (rr >> 4) & 15, nb = rr & 15, n0 = nb * 32; const int drow = (n0 >> 7) * 256 + (n0 & 127) + kind * 128;
        t.src = in[kind ? I_MU : I_MG] + (size_t)le * 524288 + (size_t)(kb * 64) * 512 + n0; t.ldw = 512;
        unsigned char* base = ws + WS_W_M1 + (size_t)layer * 32 * MiB;
        if (f8) { t.dst = (bf16*)(base + (size_t)e * MiB + (size_t)drow * 1024 + kb * 64); t.ldd = 1024; t.f8scale = pg8::W1_SCALE; }
        else { t.dst = (bf16*)(base + (size_t)e * 2 * MiB) + (size_t)drow * 1024 + kb * 64; t.ldd = 1024; t.f8scale = 0.0f; } }
    else { const int kb = (rr >> 5) & 7, nb = rr & 31;
        t.src = in[I_MD] + (size_t)le * 524288 + (size_t)(kb * 64) * 1024 + nb * 32; t.ldw = 1024;
        unsigned char* base = ws + WS_W_M2 + (size_t)layer * 16 * MiB;
        if (f8) { t.dst = (bf16*)(base + (size_t)e * 512 * KiB + (size_t)(nb * 32) * 512 + kb * 64); t.ldd = 512; t.f8scale = pg8::W2_SCALE; }
        else { t.dst = (bf16*)(base + (size_t)e * MiB) + (size_t)(nb * 32) * 512 + kb * 64; t.ldd = 512; t.f8scale = 0.0f; } }
    return t;
}
__device__ __forceinline__ TItem titem_decode(const float* const* in, unsigned char* ws, int r) {
    TItem t;
    if (r < TS0) { const int kb = r / 64, nb = r % 64; t.src = in[I_EWIN] + (size_t)(kb * 64) * 2048 + nb * 32; t.ldw = 2048; t.dst = (bf16*)(ws + WS_W_EIN) + (size_t)(nb * 32) * 1024 + kb * 64; t.ldd = 1024; t.f8scale = 0.0f; return t; } r -= TS0;
    if (r < TS1) { const int kb = r / 32, nb = r % 32; t.src = in[I_EWOUT] + (size_t)(kb * 64) * 1024 + nb * 32; t.ldw = 1024; t.dst = (bf16*)(ws + WS_W_EOUT) + (size_t)(nb * 32) * 1024 + kb * 64; t.ldd = 1024; t.f8scale = 0.0f; return t; } r -= TS1;
    if (r < TS2) { const int kb = r / 24, nb = 16 + r % 24; t.src = in[I_OWIN] + (size_t)(kb * 64) * 1280 + nb * 32; t.ldw = 1280; t.dst = (bf16*)(ws + WS_W_OIN) + (size_t)(nb * 32) * 1024 + kb * 64; t.ldd = 1024; t.f8scale = 0.0f; return t; } r -= TS2;
    if (r < TS3) { const int kb = r / 32, nb = r % 32; t.src = in[I_OWOUT] + (size_t)(kb * 64) * 1024 + nb * 32; t.ldw = 1024; t.dst = (bf16*)(ws + WS_W_OOUT) + (size_t)(nb * 32) * 1024 + kb * 64; t.ldd = 1024; t.f8scale = 0.0f; return t; } r -= TS3;
    if (r < TS5 + TS6 + TS7) return titem_moe(in, ws, r / 8192, (r % 8192) >> 8, r % 256);
    return t;
}
constexpr int NL1 = 12288;
__device__ __forceinline__ TItem titem_l1(const float* const* in, unsigned char* ws, int r) { return titem_moe(in, ws, r / 4096, 16 + ((r % 4096) >> 8), r % 256); }

constexpr size_t WS_CONVCTR = 20 * KiB;
__device__ __forceinline__ void convert_l1(Frame& F, int quota) {
    unsigned* ctr = (unsigned*)(F.ws + WS_CONVCTR);
    LAS float* scr = (LAS float*)(F.lds + F.wave * 17408);
    for (int ch = 0; ch < quota; ++ch) {
        const int c0 = __builtin_amdgcn_readfirstlane(F.lane == 0 ? (int)__hip_atomic_fetch_add(ctr, 4u, __ATOMIC_RELAXED, __HIP_MEMORY_SCOPE_AGENT) : 0);
        if (c0 >= NL1) break;
        f32x4 cur[8], nxt[8];
        TItem tc = titem_l1(F.in, F.ws, c0);
        titem_load(tc, nxt, F.lane);
#pragma unroll 1
        for (int i = 0; i < 4; ++i) {
#pragma unroll
            for (int j = 0; j < 8; ++j) cur[j] = nxt[j];
            const TItem tcur = tc;
            if (i < 3) { tc = titem_l1(F.in, F.ws, c0 + i + 1); titem_load(tc, nxt, F.lane); }
            titem_process(tcur, cur, scr, F.lane);
        }
    }
}
__device__ __forceinline__ void tail_fill(Frame& F, int nUnits, int quota) {
    const int rounds = (nUnits + F.G - 1) / F.G;
    if ((rounds - 1) * F.G + F.vcu >= nUnits) convert_l1(F, quota);
}

__device__ __forceinline__ void norm_mod_store(const f32x4 (&v)[4], const float* g, const float* shift, const float* scale, bf16* orow, int lane) {
    float s2 = 0.f;
#pragma unroll
    for (int j = 0; j < 4; ++j) s2 += (v[j].x * v[j].x + v[j].y * v[j].y) + (v[j].z * v[j].z + v[j].w * v[j].w);
    const float rstd = 1.0f / sqrtf(wave_sum(s2) * (1.0f / D) + EPS);
#pragma unroll
    for (int j = 0; j < 4; ++j) { const int c = 4 * lane + 256 * j;
        const f32x4 gg = *(const f32x4*)(g + c), sh = *(const f32x4*)(shift + c), sc = *(const f32x4*)(scale + c);
        const f32x4 y = v[j] * rstd * gg * (sc + 1.0f) + sh;
        u32x2 o; o.x = pk2(y.x, y.y); o.y = pk2(y.z, y.w);
        *(u32x2*)(orow + c) = o; }
}

template <int NQ> __device__ __forceinline__ void p1_tokens(Frame& F, int t) {
    const float* mods = (const float*)(F.ws + WS_MODS);
    bf16* A = (bf16*)(F.ws + WS_BUFA);
    f32x4 v[NQ][4];
#pragma unroll
    for (int q = 0; q < NQ; ++q) { const int tq = t + q; const float* xr = tq < TL ? F.in[I_X] + (size_t)tq * D : F.in[I_CTX] + (size_t)(tq - TL) * D;
#pragma unroll
        for (int j = 0; j < 4; ++j) v[q][j] = __builtin_nontemporal_load((const f32x4*)(xr + 4 * F.lane + 256 * j)); }
    const float* m = mods + (size_t)mod_row(t) * 6144;
#pragma unroll
    for (int q = 0; q < NQ; ++q) norm_mod_store(v[q], F.in[I_NMG], m, m + 1024, A + (size_t)(t + q) * D, F.lane);
}
__device__ __forceinline__ void phase_mods(Frame& F) {
    const float* const* in = F.in;
    LAS float* S = (LAS float*)F.lds;
    LAS float* red = S + 9 * 1024;
    for (int i = F.tid; i < 9 * 1024; i += 512) { const float v = (i < 8192) ? in[I_C][i] : in[I_CCTX][i - 8192]; S[i] = v / (1.0f + expf(-v)); }
    __syncthreads();
    const int bx = blockIdx.x, layer = bx >> 7, col0 = (bx & 127) * 48;
    const int j = F.tid % 12, rg = F.tid / 12;
    if (rg < 42) {
        const float* W = in[I_ADAW] + (size_t)layer * 1024 * 6144 + col0 + 4 * j;
        f32x4 w[25];
#pragma unroll
        for (int i = 0; i < 25; ++i) { const int k = rg + 42 * i; w[i] = (k < 1024) ? __builtin_nontemporal_load((const f32x4*)(W + (size_t)k * 6144)) : (f32x4){0.f, 0.f, 0.f, 0.f}; }
        f32x4 acc[9];
#pragma unroll
        for (int r = 0; r < 9; ++r) acc[r] = (f32x4){0.f, 0.f, 0.f, 0.f};
#pragma unroll
        for (int i = 0; i < 25; ++i) { const int k = min(rg + 42 * i, 1023);
#pragma unroll
            for (int r = 0; r < 9; ++r) acc[r] += w[i] * S[r * 1024 + k]; }
#pragma unroll
        for (int r = 0; r < 9; ++r) *(LAS f32x4*)(red + (rg * 9 + r) * 48 + 4 * j) = acc[r];
    }
    __syncthreads();
    for (int i = F.tid; i < 432; i += 512) { const int r = i / 48, c = i % 48; float sum = in[I_ADAB][layer * 6144 + col0 + c];
        for (int g = 0; g < 42; ++g) sum += red[(g * 9 + r) * 48 + c];
        ((float*)(F.ws + WS_MODS))[(layer * 9 + r) * 6144 + col0 + c] = sum; }
}

__device__ __forceinline__ void phase_prologue_a(Frame& F) {
    const float* const* in = F.in;
    unsigned char* ws = F.ws;
    LAS float* ldsf = (LAS float*)F.lds;
    __syncthreads();
    {
        const int gt = blockIdx.x * 512 + F.tid, NT = F.G * 512;
        float* rope = (float*)(ws + WS_ROPE);
        for (int i = gt; i < 1024; i += NT) { const int coord = i >> 4, q = i & 15; const float inv = powf(10000.0f, -(float)q / 16.0f); const float ang = (float)coord * inv;
            rope[i] = cosf(ang); rope[1024 + i] = sinf(ang); }
        bf16* WA = (bf16*)(ws + WS_WA);
        for (int i = gt; i < 128 * 128; i += NT) { const int m = i >> 7, k = i & 127, rp = m >> 6, j1 = m & 63, ri = k >> 6, n1 = k & 63;
            const float a = 2.0f * (float)((j1 * n1) & 63) / 64.0f; const float c = cospif(a), s = sinpif(a);
            const float v = (rp == 0) ? (ri == 0 ? c : s) : (ri == 0 ? -s : c); WA[i] = (bf16)f2bf(v); }
        bf16* WAC = (bf16*)(ws + WS_WAC);
        for (int i = gt; i < 32 * 32; i += NT) { const int m = i >> 5, k = i & 31, rp = m >> 4, j1 = m & 15, ri = k >> 4, n1 = k & 15;
            const float a = 2.0f * (float)((j1 * n1) & 15) / 16.0f; const float c = cospif(a), s = sinpif(a);
            const float v = (rp == 0) ? (ri == 0 ? c : s) : (ri == 0 ? -s : c); WAC[i] = (bf16)f2bf(v); }
        bf16* WC = (bf16*)(ws + WS_WC);
        for (int i = gt; i < 64 * 64 * 128; i += NT) { const int j1 = i >> 13, j2 = (i >> 7) & 63, k = i & 127, ri = k >> 6, n2 = k & 63;
            const float a = 2.0f * (float)((n2 * (j1 + 64 * j2)) & 4095) / 4096.0f; const float v = (ri == 0 ? cospif(a) : sinpif(a)) * (1.0f / 64.0f); WC[i] = (bf16)f2bf(v); }
        bf16* FD = (bf16*)(ws + WS_FD);
        for (int i = gt; i < 256 * 128; i += NT) { const int col = i >> 7, c = i & 127, ri = col >> 7, k2 = col & 127;
            const float a = 2.0f * (float)((c * k2) & 127) / 128.0f; const float v = (ri == 0 ? cospif(a) : -sinpif(a)) * 0.08838834764831845f; FD[i] = (bf16)f2bf(v); }
        bf16* WCC = (bf16*)(ws + WS_WCC);
        for (int i = gt; i < 16 * 16 * 32; i += NT) { const int j1 = i >> 9, j2 = (i >> 5) & 15, k = i & 31, ri = k >> 4, n2 = k & 15;
            const float a = 2.0f * (float)((n2 * (j1 + 16 * j2)) & 255) / 256.0f; const float v = (ri == 0 ? cospif(a) : sinpif(a)) * (1.0f / 16.0f); WCC[i] = (bf16)f2bf(v); }
    }
    LAS float* tw = (LAS float*)(F.lds + 139264);
    if (F.tid < 128) { const float a = 2.0f * (float)F.tid / 128.0f; tw[F.tid] = cospif(a); tw[128 + F.tid] = sinpif(a); }
    __syncthreads();
    LAS float* scr = (LAS float*)(F.lds + F.wave * 17408);
    const int gw = F.vcu * NWAVES + F.wave, NGW = F.G * NWAVES;
    const int fid = F.vcu * 2 + F.wave;
    if (F.wave < 2) { const int r = fid;
        const int g = r >> 7, db = (r >> 5) & 3, kb = r & 31, k0 = kb * 32, d0 = db * 32;
        const float* Wp = in[I_OWIN] + (size_t)k0 * 1280 + g * 128;
        { float tl[32][2];
#pragma unroll
          for (int rr = 0; rr < 32; ++rr) { tl[rr][0] = Wp[(size_t)rr * 1280 + F.lane]; tl[rr][1] = Wp[(size_t)rr * 1280 + 64 + F.lane]; }
#pragma unroll
          for (int rr = 0; rr < 32; ++rr) { scr[rr * 129 + F.lane] = tl[rr][0]; scr[rr * 129 + 64 + F.lane] = tl[rr][1]; } }
        LDS_WAIT(); asm volatile("" ::: "memory");
        const int k = F.lane & 31, oh = F.lane >> 5;
        const float* pw = in[I_OPOOLW] + (size_t)g * 16384 + d0 + 16 * oh;
        float acc[16];
#pragma unroll
        for (int t = 0; t < 16; ++t) acc[t] = 0.f;
        for (int c0 = 0; c0 < 128; c0 += 8) {
            f32x4 p[8][4];
#pragma unroll
            for (int cc = 0; cc < 8; ++cc)
#pragma unroll
                for (int j = 0; j < 4; ++j) p[cc][j] = *(const f32x4*)(pw + (c0 + cc) * 128 + 4 * j);
#pragma unroll
            for (int cc = 0; cc < 8; ++cc) { const float w = scr[k * 129 + c0 + cc];
#pragma unroll
                for (int j = 0; j < 4; ++j) { acc[4 * j] += w * p[cc][j].x; acc[4 * j + 1] += w * p[cc][j].y; acc[4 * j + 2] += w * p[cc][j].z; acc[4 * j + 3] += w * p[cc][j].w; } }
        }
        const float* psc = in[I_OPOOLS] + g * 128 + d0 + 16 * oh;
        bf16* dst = (bf16*)(ws + WS_W_OIN) + (size_t)(g * 128 + d0 + 16 * oh) * 1024 + k0 + k;
#pragma unroll
        for (int t = 0; t < 16; ++t) dst[(size_t)t * 1024] = (bf16)f2bf(acc[t] * psc[t]);
        LDS_WAIT(); asm volatile("" ::: "memory");
    }
    {
        LAS unsigned* ctr = (LAS unsigned*)(F.lds + LDS_CTL + 32);
        constexpr int PER = (TNITEMS + 255) / 256;
        const int base = F.vcu * PER, lim = min(PER, TNITEMS - base);
        f32x4 cur[8], nxt[8];
        int it = __builtin_amdgcn_readfirstlane(F.lane == 0 ? (int)atomicAdd((unsigned*)ctr, 1u) : 0);
        TItem tc = titem_decode(in, ws, base + (it < lim ? it : 0));
        if (it < lim) titem_load(tc, nxt, F.lane);
        while (it < lim) {
#pragma unroll
            for (int i = 0; i < 8; ++i) cur[i] = nxt[i];
            const TItem tcur = tc;
            const int itn = __builtin_amdgcn_readfirstlane(F.lane == 0 ? (int)atomicAdd((unsigned*)ctr, 1u) : 0);
            if (itn < lim) { tc = titem_decode(in, ws, base + itn); titem_load(tc, nxt, F.lane); }
            titem_process(tcur, cur, scr, F.lane);
            it = itn;
        }
    }
    {
        LAS unsigned* ctr2 = (LAS unsigned*)(F.lds + LDS_CTL + 36);
        for (;;) {
            const int it = __builtin_amdgcn_readfirstlane(F.lane == 0 ? (int)atomicAdd((unsigned*)ctr2, 1u) : 0);
            if (it >= 40) break;
            if (it < 32) p1_tokens<4>(F, 4 * (32 * (int)blockIdx.x + it)); else p1_tokens<1>(F, TL + 8 * (int)blockIdx.x + (it - 32));
        }
    }
}

struct DftP { const bf16* dbase; size_t dstride; const bf16* W; bf16* obase; size_t ostride; };
template <int MODE> __device__ __forceinline__ DftP dft_params(const Frame& F, int u) {
    const bf16* P = (const bf16*)(F.ws + WS_BUFP); bf16* Z = (bf16*)(F.ws + WS_BUFZ); bf16* MIX = (bf16*)(F.ws + WS_BUFA);
    DftP p;
    if constexpr (MODE == 0) { const int chunk = u & 3, n2 = (u >> 2) & 63, b = u >> 8;
        p.dbase = P + (size_t)(b * 4096 + n2) * EIN + chunk * 128; p.dstride = (size_t)64 * EIN; p.W = (const bf16*)(F.ws + WS_WA);
        p.obase = Z + (size_t)((b * 64) * 64 + n2) * 1024 + chunk * 128; p.ostride = (size_t)64 * 1024; }
    if constexpr (MODE == 1) { const int chunk = u & 3, n2 = (u >> 2) & 15, b = u >> 6;
        p.dbase = P + (size_t)(TL + b * 256 + n2) * EIN + chunk * 128; p.dstride = (size_t)16 * EIN; p.W = (const bf16*)(F.ws + WS_WAC);
        p.obase = Z + (size_t)(TL + (b * 16) * 16 + n2) * 1024 + chunk * 128; p.ostride = (size_t)16 * 1024; }
    if constexpr (MODE == 2) { const int chunk = u & 3, j1 = (u >> 2) & 63, b = u >> 8;
        p.dbase = Z + (size_t)((b * 64 + j1) * 64) * 1024 + chunk * 128; p.dstride = (size_t)1024; p.W = (const bf16*)(F.ws + WS_WC) + (size_t)j1 * 64 * 128;
        p.obase = MIX + (size_t)(b * 4096 + j1) * D + chunk * 128; p.ostride = (size_t)64 * D; }
    if constexpr (MODE == 3) { const int chunk = u & 3, j1 = (u >> 2) & 15, b = u >> 6;
        p.dbase = Z + (size_t)(TL + (b * 16 + j1) * 16) * 1024 + chunk * 128; p.dstride = (size_t)1024; p.W = (const bf16*)(F.ws + WS_WCC) + (size_t)j1 * 16 * 32;
        p.obase = MIX + (size_t)(TL + b * 256 + j1) * D + chunk * 128; p.ostride = (size_t)16 * D; }
    return p;
}
template <int MODE, int KD, int MD, int J>
__device__ __forceinline__ void dft_units(Frame& F, int nunits) {
    constexpr int LD = KD + 8;
    constexpr int NP = (KD * 16 + 511) / 512;
    constexpr int GM = KD / 8 - 1;
    LAS bf16* DT = (LAS bf16*)F.lds;
    u32x4 pre[NP];
    int u = F.vcu;
    if (u < nunits) { const DftP p = dft_params<MODE>(F, u);
#pragma unroll
        for (int i = 0; i < NP; ++i) { const int pc = F.tid + 512 * i; if (pc < KD * 16) { const int k = pc >> 4, c8 = pc & 15, ri = k / (KD / 2), nn = k % (KD / 2);
            pre[i] = *(const u32x4*)(p.dbase + (size_t)nn * p.dstride + ri * 512 + c8 * 8); } } }
    const int a = F.lane & 15, q = F.lane >> 4;
    for (; u < nunits; u += F.G) {
        const DftP p = dft_params<MODE>(F, u);
#pragma unroll
        for (int i = 0; i < NP; ++i) { const int pc = F.tid + 512 * i; if (pc < KD * 16) { const int k = pc >> 4, c8 = pc & 15; const u32x4 v = pre[i];
            LAS bf16* d = DT + (c8 * 8) * LD + (k ^ ((c8 & GM) << 3));
            d[0 * LD] = (bf16)(v.x & 0xffff); d[1 * LD] = (bf16)(v.x >> 16); d[2 * LD] = (bf16)(v.y & 0xffff); d[3 * LD] = (bf16)(v.y >> 16);
            d[4 * LD] = (bf16)(v.z & 0xffff); d[5 * LD] = (bf16)(v.z >> 16); d[6 * LD] = (bf16)(v.w & 0xffff); d[7 * LD] = (bf16)(v.w >> 16); } }
        __syncthreads();
        if (u + F.G < nunits) { const DftP pn = dft_params<MODE>(F, u + F.G);
#pragma unroll
            for (int i = 0; i < NP; ++i) { const int pc = F.tid + 512 * i; if (pc < KD * 16) { const int k = pc >> 4, c8 = pc & 15, ri = k / (KD / 2), nn = k % (KD / 2);
                pre[i] = *(const u32x4*)(pn.dbase + (size_t)nn * pn.dstride + ri * 512 + c8 * 8); } } }
        for (int task = F.wave; task < (MD / 16) * 2; task += NWAVES) {
            const int mt = task >> 1, cht = task & 1;
            f32x4 acc[4];
#pragma unroll
            for (int ct = 0; ct < 4; ++ct) acc[ct] = (f32x4){0.f, 0.f, 0.f, 0.f};
#pragma unroll
            for (int ks = 0; ks < KD / 32; ++ks) {
                const bf16x8 bw = *(const bf16x8*)(p.W + (size_t)(mt * 16 + a) * KD + ks * 32 + 8 * q);
#pragma unroll
                for (int ct = 0; ct < 4; ++ct) {
                    const int ch = cht * 64 + 16 * (a >> 2) + 4 * ct + (a & 3);
                    const bf16x8 av = *(const LAS bf16x8*)(DT + ch * LD + ((ks * 32 + 8 * q) ^ (((ch >> 3) & GM) << 3)));
                    acc[ct] = __builtin_amdgcn_mfma_f32_16x16x32_bf16(av, bw, acc[ct], 0, 0, 0);
                }
            }
            const int m = mt * 16 + a, rm = m / J, j = m % J;
            bf16* o = p.obase + (size_t)j * p.ostride + rm * 512 + cht * 64 + 16 * q;
            u32x4 w0, w1;
            w0.x = pk2(acc[0][0], acc[0][1]); w0.y = pk2(acc[0][2], acc[0][3]); w0.z = pk2(acc[1][0], acc[1][1]); w0.w = pk2(acc[1][2], acc[1][3]);
            w1.x = pk2(acc[2][0], acc[2][1]); w1.y = pk2(acc[2][2], acc[2][3]); w1.z = pk2(acc[3][0], acc[3][1]); w1.w = pk2(acc[3][2], acc[3][3]);
            *(u32x4*)o = w0; *(u32x4*)(o + 8) = w1;
        }
        __syncthreads();
    }
}

template <int MODE, int NR>
__device__ __forceinline__ void dft_units_a(Frame& F, int nunits) {
    constexpr int KD = 2 * NR, MD = 2 * NR, J = NR, LD = KD + 8, GM = KD / 8 - 1, ULD = 136;
    constexpr int NP = (NR * 16 + 511) / 512;
    LAS bf16* FDl = (LAS bf16*)F.lds; LAS bf16* U = (LAS bf16*)(F.lds + 69632); LAS bf16* DT = (LAS bf16*)(F.lds + 69632 + 64 * ULD * 2);
    { const bf16* FD = (const bf16*)(F.ws + WS_FD);
      for (int p = F.tid; p < 256 * 16; p += 512) { const int r = p >> 4, c8 = p & 15; *(LAS u32x4*)(FDl + r * ULD + 8 * c8) = *(const u32x4*)(FD + r * 128 + 8 * c8); } }
    u32x4 pre[NP];
    int u = F.vcu;
    if (u < nunits) { const DftP p = dft_params<MODE>(F, u);
#pragma unroll
        for (int i = 0; i < NP; ++i) { const int pc = F.tid + 512 * i; if (pc < NR * 16) pre[i] = *(const u32x4*)(p.dbase + (size_t)(pc >> 4) * p.dstride + (pc & 15) * 8); } }
    const int a = F.lane & 15, q = F.lane >> 4;
    for (; u < nunits; u += F.G) {
        const DftP p = dft_params<MODE>(F, u);
#pragma unroll
        for (int i = 0; i < NP; ++i) { const int pc = F.tid + 512 * i; if (pc < NR * 16) *(LAS u32x4*)(U + (pc >> 4) * ULD + (pc & 15) * 8) = pre[i]; }
        __syncthreads();
        if (u + F.G < nunits) { const DftP pn = dft_params<MODE>(F, u + F.G);
#pragma unroll
            for (int i = 0; i < NP; ++i) { const int pc = F.tid + 512 * i; if (pc < NR * 16) pre[i] = *(const u32x4*)(pn.dbase + (size_t)(pc >> 4) * pn.dstride + (pc & 15) * 8); } }
        {
            f32x4 acc[NR / 16][2];
#pragma unroll
            for (int mt = 0; mt < NR / 16; ++mt) { acc[mt][0] = (f32x4){0.f, 0.f, 0.f, 0.f}; acc[mt][1] = (f32x4){0.f, 0.f, 0.f, 0.f}; }
#pragma unroll
            for (int ks = 0; ks < 4; ++ks) {
                const bf16x8 b0 = *(const LAS bf16x8*)(FDl + ((2 * F.wave) * 16 + a) * ULD + ks * 32 + 8 * q), b1 = *(const LAS bf16x8*)(FDl + ((2 * F.wave + 1) * 16 + a) * ULD + ks * 32 + 8 * q);
#pragma unroll
                for (int mt = 0; mt < NR / 16; ++mt) { const bf16x8 av = *(const LAS bf16x8*)(U + (mt * 16 + a) * ULD + ks * 32 + 8 * q);
                    acc[mt][0] = __builtin_amdgcn_mfma_f32_16x16x32_bf16(av, b0, acc[mt][0], 0, 0, 0); acc[mt][1] = __builtin_amdgcn_mfma_f32_16x16x32_bf16(av, b1, acc[mt][1], 0, 0, 0); }
            }
#pragma unroll
            for (int t = 0; t < 2; ++t) { const int col = (2 * F.wave + t) * 16 + a, ri = col >> 7, k2 = col & 127;
#pragma unroll
                for (int mt = 0; mt < NR / 16; ++mt) { const int k0 = ri * NR + 16 * mt + 4 * q;
                    u32x2 w; w.x = pk2(acc[mt][t][0], acc[mt][t][1]); w.y = pk2(acc[mt][t][2], acc[mt][t][3]);
                    *(LAS u32x2*)(DT + k2 * LD + (k0 ^ (((k2 >> 3) & GM) << 3))) = w; } }
        }
        __syncthreads();
        for (int task = F.wave; task < (MD / 16) * 2; task += NWAVES) {
            const int mt = task >> 1, cht = task & 1;
            f32x4 acc[4];
#pragma unroll
            for (int ct = 0; ct < 4; ++ct) acc[ct] = (f32x4){0.f, 0.f, 0.f, 0.f};
#pragma unroll
            for (int ks = 0; ks < KD / 32; ++ks) {
                const bf16x8 bw = *(const bf16x8*)(p.W + (size_t)(mt * 16 + a) * KD + ks * 32 + 8 * q);
#pragma unroll
                for (int ct = 0; ct < 4; ++ct) {
                    const int ch = cht * 64 + 16 * (a >> 2) + 4 * ct + (a & 3);
                    const bf16x8 av = *(const LAS bf16x8*)(DT + ch * LD + ((ks * 32 + 8 * q) ^ (((ch >> 3) & GM) << 3)));
                    acc[ct] = __builtin_amdgcn_mfma_f32_16x16x32_bf16(av, bw, acc[ct], 0, 0, 0);
                }
            }
            const int m = mt * 16 + a, rm = m / J, j = m % J;
            bf16* o = p.obase + (size_t)j * p.ostride + rm * 512 + cht * 64 + 16 * q;
            u32x4 w0, w1;
            w0.x = pk2(acc[0][0], acc[0][1]); w0.y = pk2(acc[0][2], acc[0][3]); w0.z = pk2(acc[1][0], acc[1][1]); w0.w = pk2(acc[1][2], acc[1][3]);
            w1.x = pk2(acc[2][0], acc[2][1]); w1.y = pk2(acc[2][2], acc[2][3]); w1.z = pk2(acc[3][0], acc[3][1]); w1.w = pk2(acc[3][2], acc[3][3]);
            *(u32x4*)o = w0; *(u32x4*)(o + 8) = w1;
        }
        __syncthreads();
    }
}

__device__ __forceinline__ void phase_fourier_a_conv(Frame& F) {
    const bf16* P = (const bf16*)(F.ws + WS_BUFP);
    dft_units_a<0, 64>(F, 2048);
    __syncthreads();
    dft_units_a<1, 16>(F, 512);
    bf16* MIX = (bf16*)(F.ws + WS_BUFA);
    const float* cw = F.in[I_ECONV];
    float w0[8], w1[8], w2[8];
#pragma unroll
    for (int i = 0; i < 8; ++i) { w0[i] = cw[8 * F.lane + i]; w1[i] = cw[512 + 8 * F.lane + i]; w2[i] = cw[1024 + 8 * F.lane + i]; }
    const int gw = F.vcu * NWAVES + F.wave, NGW = F.G * NWAVES;
    auto conv_tokens = [&](int t, auto ntc) {
        constexpr int NT = decltype(ntc)::value;
        int pos, len; if (t < TL) { pos = t & 4095; len = 4096; } else { pos = (t - TL) & 255; len = 256; }
        const bf16* row = P + (size_t)t * EIN + 8 * F.lane;
        u32x4 gb[NT], gc[NT + 2], uc[NT + 2];
#pragma unroll
        for (int d = 0; d < NT + 2; ++d) { const int pp = pos + d - 1;
            if (pp >= 0 && pp < len) { gc[d] = *(const u32x4*)(row + (ptrdiff_t)(d - 1) * EIN + 1024); uc[d] = *(const u32x4*)(row + (ptrdiff_t)(d - 1) * EIN + 1536); }
            else { gc[d] = (u32x4){0u, 0u, 0u, 0u}; uc[d] = (u32x4){0u, 0u, 0u, 0u}; } }
#pragma unroll
        for (int q = 0; q < NT; ++q) gb[q] = *(const u32x4*)(row + (size_t)q * EIN + 512);
        float pl[NT + 2][8];
#pragma unroll
        for (int d = 0; d < NT + 2; ++d)
#pragma unroll
            for (int i = 0; i < 4; ++i) { pl[d][2 * i] = bflo(gc[d][i]) * bflo(uc[d][i]); pl[d][2 * i + 1] = bfhi(gc[d][i]) * bfhi(uc[d][i]); }
#pragma unroll
        for (int q = 0; q < NT; ++q) {
            float y[8];
#pragma unroll
            for (int i = 0; i < 4; ++i) {
                y[2 * i] = bflo(gb[q][i]) * (w0[2 * i] * pl[q][2 * i] + w1[2 * i] * pl[q + 1][2 * i] + w2[2 * i] * pl[q + 2][2 * i]);
                y[2 * i + 1] = bfhi(gb[q][i]) * (w0[2 * i + 1] * pl[q][2 * i + 1] + w1[2 * i + 1] * pl[q + 1][2 * i + 1] + w2[2 * i + 1] * pl[q + 2][2 * i + 1]);
            }
            u32x4 o; o.x = pk2(y[0], y[1]); o.y = pk2(y[2], y[3]); o.z = pk2(y[4], y[5]); o.w = pk2(y[6], y[7]);
            *(u32x4*)(MIX + (size_t)(t + q) * D + 512 + 8 * F.lane) = o;
        }
    };
    for (int t = 4 * gw; t < TL; t += 4 * NGW) conv_tokens(t, std::integral_constant<int, 4>{});
    for (int t = TL + gw; t < T; t += NGW) conv_tokens(t, std::integral_constant<int, 1>{});
}

__device__ __forceinline__ void phase_fourier_c(Frame& F) {
    dft_units<2, 128, 64, 64>(F, 2048);
    dft_units<3, 32, 16, 16>(F, 512);
}

constexpr int RW_LD = 1032;
__device__ __forceinline__ void phase_route(Frame& F, int layer, int ntok) {
    LAS bf16* rwh = (LAS bf16*)F.lds;
    LAS bf16* rwl = (LAS bf16*)(F.lds + 33024);
    LAS unsigned* cnt = (LAS unsigned*)(F.lds + 66048);
    LAS int* gb = (LAS int*)(F.lds + 66048 + 128);
    LAS float* lgs = (LAS float*)(F.lds + 66048 + 256) + F.wave * 256;
    LAS int* tinfo = (LAS int*)(F.lds + 66048 + 256 + 8192);
    LAS float* GS = (LAS float*)(F.lds + 81920);
    LAS float* SH = GS + 2048;
    const float* RW = F.in[I_RW];
    const int per = ntok / F.G, t0 = blockIdx.x * per, r0 = mod_row(t0);
    const float* mods = (const float*)(F.ws + WS_MODS) + (size_t)layer * 9 * 6144;
    const float* g = F.in[I_NFG] + layer * 1024;
    for (int i = F.tid; i < 16384; i += 512) { const int k = i >> 4, e = i & 15; const float w = RW[i]; const unsigned hi = f2bf(w); const float wl = w - __builtin_bit_cast(float, hi << 16);
        rwh[e * RW_LD + k] = (bf16)hi; rwl[e * RW_LD + k] = (bf16)f2bf(wl); }
    for (int i = F.tid; i < 2048; i += 512) { const int sl = i >> 10, c = i & 1023; const int rr = min(r0 + sl, 8); const float* m = mods + (size_t)rr * 6144;
        GS[i] = g[c] * (m[4 * 1024 + c] + 1.0f); SH[i] = m[3 * 1024 + c]; }
    if (F.tid < 16) cnt[F.tid] = 0u;
    __syncthreads();
    bf16* FB = (bf16*)(F.ws + WS_BUFA);
    const bool f8 = layer ? (FP8_G1_L1 != 0) : (FP8_G1_L0 != 0);
    int* route = (int*)(F.ws + WS_ROUTE);
    const int tk = F.lane & 15, kg = F.lane >> 4;
    for (int g0 = 16 * F.wave; g0 < per; g0 += 16 * NWAVES) {
        const int nv = min(16, per - g0);
        const int tq = t0 + g0 + (tk < nv ? tk : 0);
        const bf16* hr = h_row(F, tq) + 8 * kg;
        float s2 = 0.f;
        {
            u32x4 raw[32];
#pragma unroll
            for (int ks = 0; ks < 32; ++ks) raw[ks] = *(const u32x4*)(hr + 32 * ks);
#pragma unroll
            for (int ks = 0; ks < 32; ++ks)
#pragma unroll
                for (int i = 0; i < 4; ++i) { const float a = bflo(raw[ks][i]), b2 = bfhi(raw[ks][i]); s2 += a * a + b2 * b2; }
        }
        s2 += __shfl_xor(s2, 16); s2 += __shfl_xor(s2, 32);
        const float rstd = 1.0f / sqrtf(s2 * (1.0f / D) + EPS);
        const int sl = (mod_row(tq) != r0) ? 1024 : 0;
        const LAS float* gsp = GS + sl + 8 * kg; const LAS float* shp = SH + sl + 8 * kg;
        unsigned char* fb8 = (unsigned char*)FB + (size_t)tq * D + 8 * kg;
        bf16* fb16 = FB + (size_t)tq * D + 8 * kg;
        f32x4 acc = (f32x4){0.f, 0.f, 0.f, 0.f};
        u32x4 nx[8];
#pragma unroll
        for (int j = 0; j < 8; ++j) nx[j] = *(const u32x4*)(hr + 32 * j);
#pragma unroll 1
        for (int k4 = 0; k4 < 4; ++k4) {
            u32x4 cu[8];
#pragma unroll
            for (int j = 0; j < 8; ++j) cu[j] = nx[j];
            if (k4 < 3) {
#pragma unroll
                for (int j = 0; j < 8; ++j) nx[j] = *(const u32x4*)(hr + 32 * (8 * k4 + 8 + j)); }
#pragma unroll
            for (int j = 0; j < 8; ++j) {
                const int ks = 8 * k4 + j;
                const f32x4 g0v = *(const LAS f32x4*)(gsp + 32 * ks), g1v = *(const LAS f32x4*)(gsp + 32 * ks + 4), s0v = *(const LAS f32x4*)(shp + 32 * ks), s1v = *(const LAS f32x4*)(shp + 32 * ks + 4);
                float f[8];
                f[0] = bflo(cu[j].x) * rstd * g0v.x + s0v.x; f[1] = bfhi(cu[j].x) * rstd * g0v.y + s0v.y; f[2] = bflo(cu[j].y) * rstd * g0v.z + s0v.z; f[3] = bfhi(cu[j].y) * rstd * g0v.w + s0v.w;
                f[4] = bflo(cu[j].z) * rstd * g1v.x + s1v.x; f[5] = bfhi(cu[j].z) * rstd * g1v.y + s1v.y; f[6] = bflo(cu[j].w) * rstd * g1v.z + s1v.z; f[7] = bfhi(cu[j].w) * rstd * g1v.w + s1v.w;
                u32x4 hi, lo;
#pragma unroll
                for (int i = 0; i < 4; ++i) { const unsigned h0 = f2bf(f[2 * i]), h1 = f2bf(f[2 * i + 1]); hi[i] = h0 | (h1 << 16);
                    lo[i] = pk2(f[2 * i] - __builtin_bit_cast(float, h0 << 16), f[2 * i + 1] - __builtin_bit_cast(float, h1 << 16)); }
                if (tk < nv) {
                    if (f8) { u32x2 o; o.x = pg8::pk4_fp8(f[0], f[1], f[2], f[3]); o.y = pg8::pk4_fp8(f[4], f[5], f[6], f[7]); *(u32x2*)(fb8 + 32 * ks) = o; }
                    else *(u32x4*)(fb16 + 32 * ks) = hi;
                }
                const bf16x8 bh = *(const LAS bf16x8*)(rwh + tk * RW_LD + 32 * ks + 8 * kg), bl = *(const LAS bf16x8*)(rwl + tk * RW_LD + 32 * ks + 8 * kg);
                const bf16x8 ah = __builtin_bit_cast(bf16x8, hi), al = __builtin_bit_cast(bf16x8, lo);
                acc = __builtin_amdgcn_mfma_f32_16x16x32_bf16(ah, bh, acc, 0, 0, 0);
                acc = __builtin_amdgcn_mfma_f32_16x16x32_bf16(ah, bl, acc, 0, 0, 0);
                acc = __builtin_amdgcn_mfma_f32_16x16x32_bf16(al, bh, acc, 0, 0, 0);
            }
        }
#pragma unroll
        for (int j = 0; j < 4; ++j) lgs[(4 * kg + j) * 16 + tk] = acc[j];
        LDS_WAIT(); asm volatile("" ::: "memory");
        if (F.lane < nv) {
            const int tqq = t0 + g0 + F.lane;
            float aff[16], sel[16];
#pragma unroll
            for (int e4 = 0; e4 < 4; ++e4) { const f32x4 l4 = *(const LAS f32x4*)(lgs + F.lane * 16 + 4 * e4); const f32x4 b4 = *(const f32x4*)(F.in[I_RB] + 4 * e4);
                aff[4 * e4] = 1.0f / (1.0f + expf(-l4.x)); aff[4 * e4 + 1] = 1.0f / (1.0f + expf(-l4.y)); aff[4 * e4 + 2] = 1.0f / (1.0f + expf(-l4.z)); aff[4 * e4 + 3] = 1.0f / (1.0f + expf(-l4.w));
                sel[4 * e4] = aff[4 * e4] + b4.x; sel[4 * e4 + 1] = aff[4 * e4 + 1] + b4.y; sel[4 * e4 + 2] = aff[4 * e4 + 2] + b4.z; sel[4 * e4 + 3] = aff[4 * e4 + 3] + b4.w; }
            int best = 0; float bs = -1e30f;
#pragma unroll
            for (int gq = 0; gq < 4; ++gq) { const float a = sel[4 * gq], b = sel[4 * gq + 1], c = sel[4 * gq + 2], d = sel[4 * gq + 3];
                const float s = fmaxf(fmaxf(fmaxf(a + b, a + c), fmaxf(a + d, b + c)), fmaxf(b + d, c + d));
                if (s > bs) { bs = s; best = gq; } }
            float sv[4], av[4];
#pragma unroll
            for (int i = 0; i < 4; ++i) { sv[i] = sel[i]; av[i] = aff[i]; }
#pragma unroll
            for (int gq = 1; gq < 4; ++gq) if (best == gq) {
#pragma unroll
                for (int i = 0; i < 4; ++i) { sv[i] = sel[4 * gq + i]; av[i] = aff[4 * gq + i]; } }
            int i1 = 0; float s1 = sv[0], a1 = av[0];
#pragma unroll
            for (int i = 1; i < 4; ++i) if (sv[i] > s1) { s1 = sv[i]; a1 = av[i]; i1 = i; }
            int i2 = -1; float s2v = -1e30f, a2 = 0.f;
#pragma unroll
            for (int i = 0; i < 4; ++i) if (i != i1 && sv[i] > s2v) { s2v = sv[i]; a2 = av[i]; i2 = i; }
            const int e1 = 4 * best + i1, e2 = 4 * best + i2;
            const float wsum = a1 + a2, w1 = a1 / wsum, w2 = a2 / wsum;
            const unsigned r1 = atomicAdd((unsigned*)(cnt + e1), 1u), r2 = atomicAdd((unsigned*)(cnt + e2), 1u);
            int* ro = route + (size_t)tqq * 8;
            ro[0] = e1; ro[1] = e2; ro[4] = __builtin_bit_cast(int, w1); ro[5] = __builtin_bit_cast(int, w2);
            tinfo[4 * (tqq - t0) + 0] = e1; tinfo[4 * (tqq - t0) + 1] = e2; tinfo[4 * (tqq - t0) + 2] = (int)r1; tinfo[4 * (tqq - t0) + 3] = (int)r2;
        }
        LDS_WAIT(); asm volatile("" ::: "memory");
    }
    __syncthreads();
    if (F.tid < 16) gb[F.tid] = (int)__hip_atomic_fetch_add((unsigned*)(F.ws + WS_GCNT) + layer * 16 + F.tid, cnt[F.tid], __ATOMIC_RELAXED, __HIP_MEMORY_SCOPE_AGENT);
    __syncthreads();
    int* tokmap = (int*)(F.ws + WS_TOKMAP);
    for (int i = F.tid; i < per; i += 512) {
        const int e1 = tinfo[4 * i], e2 = tinfo[4 * i + 1], p1 = gb[e1] + tinfo[4 * i + 2], p2 = gb[e2] + tinfo[4 * i + 3];
        tokmap[(size_t)e1 * T + p1] = t0 + i; tokmap[(size_t)e2 * T + p2] = t0 + i;
        int* ro = route + (size_t)(t0 + i) * 8; ro[2] = p1; ro[3] = p2;
    }
}

__device__ __forceinline__ int moe_tables(Frame& F, int layer) {
    LAS int* tb = (LAS int*)(F.lds + LDS_CTL + 64); LAS int* cn = (LAS int*)(F.lds + LDS_CTL + 192);
    __syncthreads();
    if (F.tid < 16) cn[F.tid] = ld_coh((const int*)(F.ws + WS_GCNT) + layer * 16 + F.tid);
    __syncthreads();
    if (F.tid == 0) { int b = 0; for (int e = 0; e < 16; ++e) { tb[e] = b; b += (cn[e] + 255) >> 8; } tb[16] = b; }
    __syncthreads();
    return __builtin_amdgcn_readfirstlane(tb[16]);
}

template <int NQ> __device__ __forceinline__ void combine_tokens(Frame& F, int layer, int t) {
    const float* mods = (const float*)(F.ws + WS_MODS);
    const bf16* OS = (const bf16*)(F.ws + WS_BUFP);
    const int* route = (const int*)(F.ws + WS_ROUTE);
    const LAS int* tb = (const LAS int*)(F.lds + LDS_CTL + 64);
    bf16* A = (bf16*)(F.ws + WS_BUFA);
    {
        int rc[NQ][4]; float w0[NQ], w1[NQ];
#pragma unroll
        for (int q = 0; q < NQ; ++q) { const int* ro = route + (size_t)(t + q) * 8;
#pragma unroll
            for (int i = 0; i < 4; ++i) rc[q][i] = ld_coh(ro + i);
            w0[q] = ld_cohf((const float*)(ro + 4)); w1[q] = ld_cohf((const float*)(ro + 5)); }
        f32x4 v[NQ][4]; u32x2 oa[NQ][4], ob[NQ][4];
#pragma unroll
        for (int q = 0; q < NQ; ++q) { const bf16* hr = h_row(F, t + q);
            const size_t s0 = (size_t)(tb[rc[q][0]] * 256 + rc[q][2]) * D, s1 = (size_t)(tb[rc[q][1]] * 256 + rc[q][3]) * D;
#pragma unroll
            for (int j = 0; j < 4; ++j) { const int c = 4 * F.lane + 256 * j; { const u32x2 hv = *(const u32x2*)(hr + c); v[q][j] = (f32x4){bflo(hv.x), bfhi(hv.x), bflo(hv.y), bfhi(hv.y)}; } oa[q][j] = __builtin_nontemporal_load((const u32x2*)(OS + s0 + c)); ob[q][j] = __builtin_nontemporal_load((const u32x2*)(OS + s1 + c)); } }
        const int mr = mod_row(t);
        const float* m5 = mods + (size_t)(layer * 9 + mr) * 6144 + 5 * 1024;
#pragma unroll
        for (int j = 0; j < 4; ++j) { const f32x4 g5 = *(const f32x4*)(m5 + 4 * F.lane + 256 * j);
#pragma unroll
            for (int q = 0; q < NQ; ++q) { const u32x2 a = oa[q][j], b2 = ob[q][j];
                const f32x4 o = (f32x4){w0[q] * bflo(a.x) + w1[q] * bflo(b2.x), w0[q] * bfhi(a.x) + w1[q] * bfhi(b2.x), w0[q] * bflo(a.y) + w1[q] * bflo(b2.y), w0[q] * bfhi(a.y) + w1[q] * bfhi(b2.y)};
                v[q][j] = v[q][j] + g5 * o; } }
#pragma unroll
        for (int q = 0; q < NQ; ++q) {
            if (layer == 0) {
                bf16* hr = h_row(F, t + q);
#pragma unroll
                for (int j = 0; j < 4; ++j) { u32x2 o; o.x = pk2(v[q][j].x, v[q][j].y); o.y = pk2(v[q][j].z, v[q][j].w); *(u32x2*)(hr + 4 * F.lane + 256 * j) = o; }
                const float* m = mods + (size_t)(9 + mr) * 6144;
                norm_mod_store(v[q], F.in[I_NMG] + 1024, m, m + 1024, A + (size_t)(t + q) * D, F.lane);
            } else {
                float s2 = 0.f;
#pragma unroll
                for (int j = 0; j < 4; ++j) s2 += (v[q][j].x * v[q][j].x + v[q][j].y * v[q][j].y) + (v[q][j].z * v[q][j].z + v[q][j].w * v[q][j].w);
                const float rstd = 1.0f / sqrtf(wave_sum(s2) * (1.0f / D) + EPS);
                float* orow = F.out + (size_t)(t + q) * D;
#pragma unroll
                for (int j = 0; j < 4; ++j) { const int c = 4 * F.lane + 256 * j; __builtin_nontemporal_store(v[q][j] * rstd * *(const f32x4*)(F.in[I_FG] + c), (f32x4*)(orow + c)); }
            }
        }
    }
}
__device__ __forceinline__ void phase_combine(Frame& F, int layer, int ntok) {
    const int gw = F.vcu * NWAVES + F.wave, NGW = F.G * NWAVES;
    if (layer == 0) { for (int t = 2 * gw; t < TL; t += 2 * NGW) combine_tokens<2>(F, 0, t); for (int t = TL + gw; t < ntok; t += NGW) combine_tokens<1>(F, 0, t); }
    else { for (int t = 4 * gw; t < TL; t += 4 * NGW) combine_tokens<4>(F, 1, t); }
}

constexpr int KV_LD = 72, VL_OFF = 384 * KV_LD * 2, ROPE_LDS = 131072;
typedef short v4i16_t __attribute__((ext_vector_type(4)));

__device__ __forceinline__ bf16x8 rope_pack(const u32x4 x1, const u32x4 x2, const LAS float* cs, const LAS float* sn, float scale, bool second) {
    const f32x4 c0 = *(const LAS f32x4*)cs, c1 = *(const LAS f32x4*)(cs + 4), s0 = *(const LAS f32x4*)sn, s1 = *(const LAS f32x4*)(sn + 4);
    float c[8] = {c0.x, c0.y, c0.z, c0.w, c1.x, c1.y, c1.z, c1.w}, s[8] = {s0.x, s0.y, s0.z, s0.w, s1.x, s1.y, s1.z, s1.w};
    float a[8], b[8];
#pragma unroll
    for (int i = 0; i < 4; ++i) { a[2 * i] = bflo(x1[i]); a[2 * i + 1] = bfhi(x1[i]); b[2 * i] = bflo(x2[i]); b[2 * i + 1] = bfhi(x2[i]); }
    float o[8];
#pragma unroll
    for (int i = 0; i < 8; ++i) o[i] = (second ? (b[i] * c[i] + a[i] * s[i]) : (a[i] * c[i] - b[i] * s[i])) * scale;
    u32x4 w; w.x = pk2(o[0], o[1]); w.y = pk2(o[2], o[3]); w.z = pk2(o[4], o[5]); w.w = pk2(o[6], o[7]);
    return __builtin_bit_cast(bf16x8, w);
}

struct AttnU { int b, qb, kvh; };
__device__ __forceinline__ AttnU attn_unit_of(int u) { AttnU r; r.kvh = u & 1; r.qb = (u >> 1) & 31; r.b = u >> 6; return r; }

__device__ __forceinline__ void attn_load_latk(Frame& F, const bf16* P1, AttnU u, u32x4 (&lk)[2][4]) {
    const u32x4 z = (u32x4){0u, 0u, 0u, 0u};
#pragma unroll
    for (int it = 0; it < 2; ++it) { const int task = F.tid + 512 * it, kidx = task >> 1, hh = task & 1, pos = u.qb * 128 - 128 + kidx;
        const bool ok = task < 768 && pos >= 0 && pos < NSEQ;
        const bf16* row = P1 + (size_t)(u.b * NSEQ + (ok ? pos : 0)) * OIN + 1024 + u.kvh * 64 + 8 * hh;
#pragma unroll
        for (int st = 0; st < 4; ++st) lk[it][st] = ok ? *(const u32x4*)(row + 16 * st) : z; }
}
__device__ __forceinline__ void attn_load_latv(Frame& F, const bf16* P1, AttnU u, u32x4 (&lv)[6]) {
    const u32x4 z = (u32x4){0u, 0u, 0u, 0u};
#pragma unroll
    for (int it = 0; it < 6; ++it) { const int task = F.tid + 512 * it, kidx = task >> 3, c8 = task & 7, pos = u.qb * 128 - 128 + kidx;
        const bool ok = pos >= 0 && pos < NSEQ;
        lv[it] = ok ? *(const u32x4*)(P1 + (size_t)(u.b * NSEQ + (ok ? pos : 0)) * OIN + 1152 + u.kvh * 64 + 8 * c8) : z; }
}
__device__ __forceinline__ void attn_write_lat(Frame& F, AttnU u, const u32x4 (&lk)[2][4], const u32x4 (&lv)[6]) {
    LAS bf16* KL = (LAS bf16*)F.lds; LAS bf16* VL = (LAS bf16*)(F.lds + VL_OFF); const LAS float* rope = (const LAS float*)(F.lds + ROPE_LDS);
#pragma unroll
    for (int it = 0; it < 2; ++it) { const int task = F.tid + 512 * it, kidx = task >> 1, hh = task & 1; int pos = u.qb * 128 - 128 + kidx; pos = pos < 0 ? 0 : (pos > NSEQ - 1 ? NSEQ - 1 : pos);
        if (task < 768) {
            LAS bf16* d = KL + kidx * KV_LD + 8 * hh;
            const LAS float* c0 = rope + (pos >> 6) * 16 + 8 * hh; const LAS float* c1 = rope + (pos & 63) * 16 + 8 * hh;
            *(LAS bf16x8*)(d) = rope_pack(lk[it][0], lk[it][1], c0, c0 + 1024, 1.0f, false);
            *(LAS bf16x8*)(d + 16) = rope_pack(lk[it][0], lk[it][1], c0, c0 + 1024, 1.0f, true);
            *(LAS bf16x8*)(d + 32) = rope_pack(lk[it][2], lk[it][3], c1, c1 + 1024, 1.0f, false);
            *(LAS bf16x8*)(d + 48) = rope_pack(lk[it][2], lk[it][3], c1, c1 + 1024, 1.0f, true);
        } }
#pragma unroll
    for (int it = 0; it < 6; ++it) { const int task = F.tid + 512 * it, kidx = task >> 3, c8 = task & 7; *(LAS u32x4*)(VL + kidx * KV_LD + 8 * c8) = lv[it]; }
}
__device__ __forceinline__ void attn_load_ctx(Frame& F, const bf16* P1, AttnU u, u32x4 (&ck)[4], u32x4 (&cv)[4]) {
#pragma unroll
    for (int it = 0; it < 4; ++it) { const int task = F.tid + 512 * it, kidx = task >> 3, c8 = task & 7;
        const bf16* row = P1 + (size_t)(TL + u.b * LCTX + kidx) * OIN + 1024 + u.kvh * 64 + 8 * c8;
        ck[it] = *(const u32x4*)row; cv[it] = *(const u32x4*)(row + 128); }
}
__device__ __forceinline__ void attn_write_ctx(Frame& F, const u32x4 (&ck)[4], const u32x4 (&cv)[4]) {
    LAS bf16* KL = (LAS bf16*)F.lds; LAS bf16* VL = (LAS bf16*)(F.lds + VL_OFF);
#pragma unroll
    for (int it = 0; it < 4; ++it) { const int task = F.tid + 512 * it, kidx = task >> 3, c8 = task & 7;
        *(LAS u32x4*)(KL + kidx * KV_LD + 8 * c8) = ck[it]; *(LAS u32x4*)(VL + kidx * KV_LD + 8 * c8) = cv[it]; }
}

__device__ __forceinline__ unsigned cvtpk(float lo, float hi) { unsigned r; asm volatile("v_cvt_pk_bf16_f32 %0, %1, %2" : "=v"(r) : "v"(lo), "v"(hi)); return r; }
__device__ __forceinline__ float xhalf_max(float x) { const auto r = __builtin_amdgcn_permlane32_swap(__builtin_bit_cast(unsigned, x), __builtin_bit_cast(unsigned, x), false, false);
    return fmaxf(__builtin_bit_cast(float, r[0]), __builtin_bit_cast(float, r[1])); }
__device__ __forceinline__ float xhalf_sum(float x) { const auto r = __builtin_amdgcn_permlane32_swap(__builtin_bit_cast(unsigned, x), __builtin_bit_cast(unsigned, x), false, false);
    return __builtin_bit_cast(float, r[0]) + __builtin_bit_cast(float, r[1]); }
__device__ __forceinline__ void attn_tiles(Frame& F, int kt0, int kt1, int mk0, int mk1, const bf16x8 (&qf)[4], f32x16 (&O)[2], float& mrun, float& lrun, int qrel) {
    if (kt0 > kt1) return;
    const LAS bf16* KL = (const LAS bf16*)F.lds; const LAS bf16* VL = (const LAS bf16*)(F.lds + VL_OFF);
    const int r32 = F.lane & 31, hh = F.lane >> 5;
    const int q4 = (F.lane & 15) >> 2, p4 = F.lane & 3, blk = (F.lane >> 4) & 1;
    const LAS bf16* kp = KL + (kt0 * 32 + r32) * KV_LD + 8 * hh;
    const LAS bf16* vp = VL + (kt0 * 32 + 4 * hh + q4) * KV_LD + 16 * blk + 4 * p4;
    bf16x8 kn[4];
#pragma unroll
    for (int st = 0; st < 4; ++st) kn[st] = *(const LAS bf16x8*)(kp + 16 * st);
    for (int kt = kt0; kt <= kt1; ++kt) {
        bf16x8 kf[4];
#pragma unroll
        for (int st = 0; st < 4; ++st) kf[st] = kn[st];
        v4i16_t vlo[2][2], vhi[2][2];
#pragma unroll
        for (int dt = 0; dt < 2; ++dt)
#pragma unroll
            for (int s2 = 0; s2 < 2; ++s2) { vlo[dt][s2] = __builtin_amdgcn_ds_read_tr16_b64_v4i16((LAS v4i16_t*)(vp + (16 * s2) * KV_LD + dt * 32));
                vhi[dt][s2] = __builtin_amdgcn_ds_read_tr16_b64_v4i16((LAS v4i16_t*)(vp + (16 * s2 + 8) * KV_LD + dt * 32)); }
        kp += 32 * KV_LD; vp += 32 * KV_LD;
        if (kt < kt1) {
#pragma unroll
            for (int st = 0; st < 4; ++st) kn[st] = *(const LAS bf16x8*)(kp + 16 * st); }
        __builtin_amdgcn_sched_barrier(0);
        f32x16 s;
#pragma unroll
        for (int r = 0; r < 16; ++r) s[r] = 0.f;
#pragma unroll
        for (int st = 0; st < 4; ++st) s = __builtin_amdgcn_mfma_f32_32x32x16_bf16(kf[st], qf[st], s, 0, 0, 0);
        if (kt == mk0 || kt == mk1) {
#pragma unroll
            for (int r = 0; r < 16; ++r) { const int dlt = kt * 32 + (r & 3) + 8 * (r >> 2) + 4 * hh - qrel; s[r] = (dlt <= 128 && dlt >= -128) ? s[r] : -INFINITY; } }
        float mx = fmaxf(fmaxf(s[0], s[1]), fmaxf(s[2], s[3]));
#pragma unroll
        for (int r = 4; r < 16; r += 4) mx = fmaxf(mx, fmaxf(fmaxf(s[r], s[r + 1]), fmaxf(s[r + 2], s[r + 3])));
        mx = xhalf_max(mx);
        const float mnew = fmaxf(mrun, mx);
        float ps0 = 0.f, ps1 = 0.f;
#pragma unroll
        for (int r = 0; r < 16; r += 2) { s[r] = __builtin_amdgcn_exp2f(s[r] - mnew); s[r + 1] = __builtin_amdgcn_exp2f(s[r + 1] - mnew); ps0 += s[r]; ps1 += s[r + 1]; }
        const float ps = xhalf_sum(ps0 + ps1);
        if (__any(mnew > mrun)) {
            const float alpha = __builtin_amdgcn_exp2f(mrun - mnew);
            lrun *= alpha;
#pragma unroll
            for (int dt = 0; dt < 2; ++dt)
#pragma unroll
                for (int r = 0; r < 16; ++r) O[dt][r] *= alpha;
        }
        lrun += ps; mrun = mnew;
        bf16x8 pb[2];
#pragma unroll
        for (int s2 = 0; s2 < 2; ++s2) { u32x4 w; w.x = cvtpk(s[8 * s2 + 0], s[8 * s2 + 1]); w.y = cvtpk(s[8 * s2 + 2], s[8 * s2 + 3]); w.z = cvtpk(s[8 * s2 + 4], s[8 * s2 + 5]); w.w = cvtpk(s[8 * s2 + 6], s[8 * s2 + 7]);
            pb[s2] = __builtin_bit_cast(bf16x8, w); }
#pragma unroll
        for (int dt = 0; dt < 2; ++dt)
#pragma unroll
            for (int s2 = 0; s2 < 2; ++s2) {
                const bf16x8 va = (bf16x8){vlo[dt][s2][0], vlo[dt][s2][1], vlo[dt][s2][2], vlo[dt][s2][3], vhi[dt][s2][0], vhi[dt][s2][1], vhi[dt][s2][2], vhi[dt][s2][3]};
                O[dt] = __builtin_amdgcn_mfma_f32_32x32x16_bf16(va, pb[s2], O[dt], 0, 0, 0);
            }
    }
}

__device__ __forceinline__ void phase_attn(Frame& F) {
    const bf16* P1 = (const bf16*)(F.ws + WS_BUFP);
    bf16* MIX = (bf16*)(F.ws + WS_BUFA);
    const int r32 = F.lane & 31, hh = F.lane >> 5;
    constexpr float QSC = 0.125f * 1.4426950408889634f;
    LAS float* ropel = (LAS float*)(F.lds + ROPE_LDS);
    for (int i = F.tid; i < 2048; i += 512) ropel[i] = ((const float*)(F.ws + WS_ROPE))[i];
    u32x4 lk[2][4], lv[6], ck[4], cv[4];
    const int nu = (512 - F.vcu + F.G - 1) / F.G;
    if (nu > 0) attn_load_latk(F, P1, attn_unit_of(F.vcu), lk);
    for (int ui = 0; ui < nu; ++ui) {
        const AttnU u = attn_unit_of(F.vcu + ui * F.G);
        u32x4 qr[2][4];
#pragma unroll
        for (int i = 0; i < 2; ++i) { const int task = F.wave + 8 * i, g = task & 3, sub = task >> 2, head = u.kvh * 4 + g, pos = u.qb * 128 + 32 * sub + r32;
            const bf16* row = P1 + (size_t)(u.b * NSEQ + pos) * OIN + 512 + head * 64 + 8 * hh;
#pragma unroll
            for (int st = 0; st < 4; ++st) qr[i][st] = *(const u32x4*)(row + 16 * st); }
        attn_load_latv(F, P1, u, lv);
        __syncthreads();
        attn_write_lat(F, u, lk, lv);
        bf16x8 qf[2][4]; f32x16 O[2][2]; float mrun[2], lrun[2];
#pragma unroll
        for (int i = 0; i < 2; ++i) { const int task = F.wave + 8 * i, g = task & 3, sub = task >> 2, head = u.kvh * 4 + g, pos = u.qb * 128 + 32 * sub + r32;
            const LAS float* c0 = ropel + (pos >> 6) * 16 + 8 * hh; const LAS float* c1 = ropel + (pos & 63) * 16 + 8 * hh;
            qf[i][0] = rope_pack(qr[i][0], qr[i][1], c0, c0 + 1024, QSC, false); qf[i][1] = rope_pack(qr[i][0], qr[i][1], c0, c0 + 1024, QSC, true);
            qf[i][2] = rope_pack(qr[i][2], qr[i][3], c1, c1 + 1024, QSC, false); qf[i][3] = rope_pack(qr[i][2], qr[i][3], c1, c1 + 1024, QSC, true);
            mrun[i] = F.in[I_OSINK][head] * 1.4426950408889634f; lrun[i] = 1.0f;
#pragma unroll
            for (int dt = 0; dt < 2; ++dt)
#pragma unroll
                for (int r = 0; r < 16; ++r) O[i][dt][r] = 0.f; }
        __syncthreads();
        const int kt_lo = (u.qb == 0) ? 4 : 0, kt_hi = (u.qb == 31) ? 7 : 11;
#pragma unroll
        for (int i = 0; i < 2; ++i) { const int sub = (F.wave + 8 * i) >> 2, qrel = 128 + 32 * sub + r32;
            attn_tiles(F, max(sub, kt_lo), min(sub + 8, kt_hi), sub, sub + 8, qf[i], O[i], mrun[i], lrun[i], qrel); }
        attn_load_ctx(F, P1, u, ck, cv);
        __syncthreads();
        attn_write_ctx(F, ck, cv);
        __syncthreads();
        if (ui + 1 < nu) attn_load_latk(F, P1, attn_unit_of(F.vcu + (ui + 1) * F.G), lk);
#pragma unroll
        for (int i = 0; i < 2; ++i) {
            attn_tiles(F, 0, 7, -1, -1, qf[i], O[i], mrun[i], lrun[i], 0);
            const int task = F.wave + 8 * i, g = task & 3, sub = task >> 2, head = u.kvh * 4 + g, pos = u.qb * 128 + 32 * sub + r32;
            const float inv = 1.0f / lrun[i];
            bf16* o = MIX + (size_t)(u.b * NSEQ + pos) * D + 512 + head * 64 + 4 * hh;
#pragma unroll
            for (int dt = 0; dt < 2; ++dt)
#pragma unroll
                for (int rg = 0; rg < 4; ++rg) { u32x2 w; w.x = pk2(O[i][dt][4 * rg] * inv, O[i][dt][4 * rg + 1] * inv); w.y = pk2(O[i][dt][4 * rg + 2] * inv, O[i][dt][4 * rg + 3] * inv);
                    *(u32x2*)(o + dt * 32 + 8 * rg) = w; }
        }
    }
    __syncthreads();
}

__device__ __forceinline__ void phase_pool_stencil(Frame& F) {
    const bf16* P1 = (const bf16*)(F.ws + WS_BUFP);
    bf16* MIX = (bf16*)(F.ws + WS_BUFA);
    const int gw = F.vcu * NWAVES + F.wave, NGW = F.G * NWAVES;
    const int r = 1 << (F.lane >> 4);
    constexpr int NT = 8, NR = NT + 16;
    for (int t = NT * gw; t < TL; t += NT * NGW) {
        const int pos = t & 4095;
        const bf16* base = P1 + (size_t)t * OIN + 8 * F.lane;
        u32x4 v[NR];
#pragma unroll
        for (int jj = 0; jj < NR; ++jj) { const int pj = pos + jj - 8; const bool ok = pj >= 0 && pj < NSEQ; v[jj] = ok ? *(const u32x4*)(base + (ptrdiff_t)(jj - 8) * OIN) : (u32x4){0u, 0u, 0u, 0u}; }
        float acc[NT][8];
#pragma unroll
        for (int q = 0; q < NT; ++q)
#pragma unroll
            for (int i = 0; i < 8; ++i) acc[q][i] = 0.f;
#pragma unroll
        for (int jj = 0; jj < NR; ++jj) {
            float x[8];
#pragma unroll
            for (int i = 0; i < 4; ++i) { x[2 * i] = bflo(v[jj][i]); x[2 * i + 1] = bfhi(v[jj][i]); }
#pragma unroll
            for (int q = 0; q < NT; ++q) { const int dd = jj - 8 - q; if (dd >= -8 && dd <= 8) { const float w = (dd <= r && dd >= -r) ? 1.0f : 0.0f;
#pragma unroll
                for (int i = 0; i < 8; ++i) acc[q][i] += w * x[i]; } }
        }
#pragma unroll
        for (int q = 0; q < NT; ++q) {
            const int pq = pos + q, lo = max(pq - r, 0), hi = min(pq + r + 1, NSEQ);
            const float ic = 1.0f / (float)(hi - lo);
            const u32x4 sv = v[q + 8];
            u32x4 o;
#pragma unroll
            for (int i = 0; i < 4; ++i) o[i] = pk2(acc[q][2 * i] * ic - bflo(sv[i]), acc[q][2 * i + 1] * ic - bfhi(sv[i]));
            *(u32x4*)(MIX + (size_t)(t + q) * D + 8 * F.lane) = o;
        }
    }
}

__device__ __forceinline__ void phase_attn_pool(Frame& F) {
    phase_attn(F);
#ifdef DBG_ATTN2
    phase_attn(F);
#endif
    phase_pool_stencil(F);
}

constexpr int NPHASE = 20;
__global__ void __launch_bounds__(NWAVES * 64, 2) mk_fwd(Args args) {
    extern __shared__ __attribute__((aligned(16))) unsigned char lds_raw[];
    Frame F;
    F.lds = (LAS unsigned char*)lds_raw;
    F.tid = threadIdx.x; F.lane = F.tid & 63; F.wave = __builtin_amdgcn_readfirstlane(F.tid >> 6);
    F.G = gridDim.x; { const int bx = blockIdx.x; F.vcu = (F.G % 8 == 0) ? (bx % 8) * (F.G / 8) + bx / 8 : bx; }
    F.ws = args.ws; F.in = args.in; F.out = args.out;
    for (int u = F.tid; u < (LDS_BYTES - LDS_CTL) / 4; u += NWAVES * 64) ((LAS unsigned*)(F.lds + LDS_CTL))[u] = 0u;
    __syncthreads();
    const int lo = args.ph_lo, hi = args.ph_hi;
    XcdBarrier bar; bar.bar = (unsigned*)(F.ws + WS_CTL); bar.x = 0; bar.st = nullptr;
    if (hi - lo > 1) bar = xcd_barrier_post((unsigned*)(F.ws + WS_CTL), (volatile LAS unsigned*)(F.lds + LDS_CTL));
#define IN(k) (lo <= (k) && (k) < hi)
#ifndef PHASE_MASK
#define PHASE_MASK 0xffffffffu
#endif
#define PH(k, ...) if constexpr (((PHASE_MASK >> (k)) & 1u) != 0u) if (IN(k)) { __VA_ARGS__ if constexpr (((DBG_DOUBLE >> (k)) & 1u) != 0u) { __VA_ARGS__ } }
#define SEAM(k) do { if (IN(k) && IN((k) + 1)) xcd_barrier(bar); } while (0)
    unsigned char* ws = F.ws;
    const float* mods = (const float*)(ws + WS_MODS);

    PH(0, { phase_mods(F); }) SEAM(0);
    PH(1, { phase_prologue_a(F); }) SEAM(1);
    PH(2, {
        pg8::SchedDense S{(const char*)(ws + WS_BUFA), (const char*)(ws + WS_W_EIN), 1024, 8, 136, 0, 1088, F.vcu, F.G};
        pg8::EpiStore E{(bf16*)(ws + WS_BUFP), EIN};
        pg8::gemm_phase<pg8::EpiStore, pg8::SchedDense>(F.lds, 1024, S, E);
    }) SEAM(2);
    PH(3, { phase_fourier_a_conv(F); }) SEAM(3);
    PH(4, { phase_fourier_c(F); }) SEAM(4);
    PH(5, {
        pg8::SchedDense S{(const char*)(ws + WS_BUFA), (const char*)(ws + WS_W_EOUT), 1024, 4, 136, 0, 544, F.vcu, F.G};
        pg8::EpiResid<true> E{F.in[I_X], F.in[I_CTX], (bf16*)(ws + WS_HB), mods + 2 * 1024};
        pg8::gemm_phase<pg8::EpiResid<true>, pg8::SchedDense>(F.lds, 1024, S, E);
    }) SEAM(5);
    PH(6, { phase_route(F, 0, T); }) SEAM(6);
    PH(7, {
        const int ntile = moe_tables(F, 0);
        if constexpr (FP8_G1_L0) {
            pg8::SchedMoe<true> S{(const char*)(ws + WS_BUFA), (const char*)(ws + WS_W_M1) + (size_t)0 * 32 * MiB, (const int*)(ws + WS_TOKMAP), (const LAS int*)(F.lds + LDS_CTL + 64), (const LAS int*)(F.lds + LDS_CTL + 192), 512, (size_t)MiB, ntile * 4, F.vcu, F.G};
            pg8::EpiSwiglu8 E{(unsigned char*)(ws + WS_BUFZ), pg8::W1_SCALE};
            pg8::gemm_phase<pg8::EpiSwiglu8, pg8::SchedMoe<true>, true>(F.lds, 512, S, E);
        } else {
            pg8::SchedMoe<true> S{(const char*)(ws + WS_BUFA), (const char*)(ws + WS_W_M1) + (size_t)0 * 32 * MiB, (const int*)(ws + WS_TOKMAP), (const LAS int*)(F.lds + LDS_CTL + 64), (const LAS int*)(F.lds + LDS_CTL + 192), 1024, (size_t)2 * MiB, ntile * 4, F.vcu, F.G};
            if constexpr (FP8_G2_L0) { pg8::EpiSwiglu8 E{(unsigned char*)(ws + WS_BUFZ), 1.0f}; pg8::gemm_phase<pg8::EpiSwiglu8, pg8::SchedMoe<true>>(F.lds, 1024, S, E); }
            else { pg8::EpiSwiglu E{(bf16*)(ws + WS_BUFZ)}; pg8::gemm_phase<pg8::EpiSwiglu, pg8::SchedMoe<true>>(F.lds, 1024, S, E); }
        }
    }) SEAM(7);
    PH(8, {
        const int ntile = moe_tables(F, 0);
        if constexpr (FP8_G2_L0) {
            pg8::SchedMoe<false> S{(const char*)(ws + WS_BUFZ), (const char*)(ws + WS_W_M2) + (size_t)0 * 16 * MiB, nullptr, (const LAS int*)(F.lds + LDS_CTL + 64), (const LAS int*)(F.lds + LDS_CTL + 192), 256, (size_t)512 * KiB, ntile * 4, F.vcu, F.G};
            pg8::EpiStoreS E{(bf16*)(ws + WS_BUFP), 1024, 1.0f / (pg8::HID_SCALE * pg8::W2_SCALE)};
            pg8::gemm_phase<pg8::EpiStoreS, pg8::SchedMoe<false>, true>(F.lds, 256, S, E);
        } else {
            pg8::SchedMoe<false> S{(const char*)(ws + WS_BUFZ), (const char*)(ws + WS_W_M2) + (size_t)0 * 16 * MiB, nullptr, (const LAS int*)(F.lds + LDS_CTL + 64), (const LAS int*)(F.lds + LDS_CTL + 192), 512, (size_t)MiB, ntile * 4, F.vcu, F.G};
            pg8::EpiStore E{(bf16*)(ws + WS_BUFP), 1024};
            pg8::gemm_phase<pg8::EpiStore, pg8::SchedMoe<false>>(F.lds, 512, S, E);
        }
    }) SEAM(8);
    PH(9, { (void)moe_tables(F, 0); phase_combine(F, 0, T); }) SEAM(9);
    PH(10, {
        pg8::SchedDense S{(const char*)(ws + WS_BUFA), (const char*)(ws + WS_W_OIN), 1024, 5, 128, 4, 648, F.vcu, F.G};
        pg8::EpiStore E{(bf16*)(ws + WS_BUFP), OIN};
        pg8::gemm_phase<pg8::EpiStore, pg8::SchedDense>(F.lds, 1024, S, E);
    }) SEAM(10);
    PH(11, { phase_attn_pool(F); }) SEAM(11);
    PH(12, {
        pg8::SchedDense S{(const char*)(ws + WS_BUFA), (const char*)(ws + WS_W_OOUT), 1024, 4, 128, 0, 512, F.vcu, F.G};
        pg8::EpiResid<false> E{nullptr, nullptr, (bf16*)(ws + WS_HB), mods + 9 * 6144 + 2 * 1024};
        pg8::gemm_phase<pg8::EpiResid<false>, pg8::SchedDense>(F.lds, 1024, S, E);
    }) SEAM(12);
    PH(13, { phase_route(F, 1, TL); }) SEAM(13);
    PH(14, {
        const int ntile = moe_tables(F, 1);
        if constexpr (FP8_G1_L1) {
            pg8::SchedMoe<true> S{(const char*)(ws + WS_BUFA), (const char*)(ws + WS_W_M1) + (size_t)1 * 32 * MiB, (const int*)(ws + WS_TOKMAP), (const LAS int*)(F.lds + LDS_CTL + 64), (const LAS int*)(F.lds + LDS_CTL + 192), 512, (size_t)MiB, ntile * 4, F.vcu, F.G};
            pg8::EpiSwiglu8 E{(unsigned char*)(ws + WS_BUFZ), pg8::W1_SCALE};
            pg8::gemm_phase<pg8::EpiSwiglu8, pg8::SchedMoe<true>, true>(F.lds, 512, S, E);
        } else {
            pg8::SchedMoe<true> S{(const char*)(ws + WS_BUFA), (const char*)(ws + WS_W_M1) + (size_t)1 * 32 * MiB, (const int*)(ws + WS_TOKMAP), (const LAS int*)(F.lds + LDS_CTL + 64), (const LAS int*)(F.lds + LDS_CTL + 192), 1024, (size_t)2 * MiB, ntile * 4, F.vcu, F.G};
            if constexpr (FP8_G2_L1) { pg8::EpiSwiglu8 E{(unsigned char*)(ws + WS_BUFZ), 1.0f}; pg8::gemm_phase<pg8::EpiSwiglu8, pg8::SchedMoe<true>>(F.lds, 1024, S, E); }
            else { pg8::EpiSwiglu E{(bf16*)(ws + WS_BUFZ)}; pg8::gemm_phase<pg8::EpiSwiglu, pg8::SchedMoe<true>>(F.lds, 1024, S, E); }
        }
    }) SEAM(14);
    PH(15, {
        const int ntile = moe_tables(F, 1);
        if constexpr (FP8_G2_L1) {
            pg8::SchedMoe<false> S{(const char*)(ws + WS_BUFZ), (const char*)(ws + WS_W_M2) + (size_t)1 * 16 * MiB, nullptr, (const LAS int*)(F.lds + LDS_CTL + 64), (const LAS int*)(F.lds + LDS_CTL + 192), 256, (size_t)512 * KiB, ntile * 4, F.vcu, F.G};
            pg8::EpiStoreS E{(bf16*)(ws + WS_BUFP), 1024, 1.0f / (pg8::HID_SCALE * pg8::W2_SCALE)};
            pg8::gemm_phase<pg8::EpiStoreS, pg8::SchedMoe<false>, true>(F.lds, 256, S, E);
        } else {
            pg8::SchedMoe<false> S{(const char*)(ws + WS_BUFZ), (const char*)(ws + WS_W_M2) + (size_t)1 * 16 * MiB, nullptr, (const LAS int*)(F.lds + LDS_CTL + 64), (const LAS int*)(F.lds + LDS_CTL + 192), 512, (size_t)MiB, ntile * 4, F.vcu, F.G};
            pg8::EpiStore E{(bf16*)(ws + WS_BUFP), 1024};
            pg8::gemm_phase<pg8::EpiStore, pg8::SchedMoe<false>>(F.lds, 512, S, E);
        }
    }) SEAM(15);
    PH(16, { (void)moe_tables(F, 1); phase_combine(F, 1, TL); }) SEAM(16);
#ifdef DBG_XBAR
    if (hi - lo > 1) { for (int xb = 0; xb < DBG_XBAR; ++xb) xcd_barrier(bar); }
#endif
#undef IN
#undef SEAM
}

extern "C" void kernel_launch(void* const* d_in, const int* in_sizes, int n_in, void* d_out, int out_size, void* d_ws, size_t ws_size, hipStream_t stream) {
    static int grid = 0;
    if (grid == 0) {
        if (n_in != 22 || ws_size < WS_END) { fprintf(stderr, "kernel_launch: unexpected inputs (n_in %d, ws %zu)\n", n_in, ws_size); grid = -1; return; }
        int dev = 0, cus = 0, per_cu = 0;
        if (hipGetDevice(&dev) != hipSuccess || hipDeviceGetAttribute(&cus, hipDeviceAttributeMultiprocessorCount, dev) != hipSuccess) { grid = -1; return; }
        if (hipFuncSetAttribute((const void*)mk_fwd, hipFuncAttributeMaxDynamicSharedMemorySize, LDS_BYTES) != hipSuccess) { fprintf(stderr, "kernel_launch: hipFuncSetAttribute failed\n"); grid = -1; return; }
        if (hipOccupancyMaxActiveBlocksPerMultiprocessor(&per_cu, (const void*)mk_fwd, NWAVES * 64, LDS_BYTES) != hipSuccess || per_cu < 1) { fprintf(stderr, "kernel_launch: occupancy query says %d\n", per_cu); }
        (void)hipGetLastError();
        grid = cus;
        if (grid != 256) { fprintf(stderr, "kernel_launch: %d CUs; this build assumes 256\n", grid); }
    }
    if (grid < 0) return;
    (void)hipMemsetAsync((char*)d_ws + WS_CTL, 0, CTL_ZERO_BYTES, stream);
    Args a{};
    for (int i = 0; i < 22; ++i) a.in[i] = (const float*)d_in[i];
    a.out = (float*)d_out; a.ws = (unsigned char*)d_ws;
#if MK_MULTI
    for (int p = 0; p <= DBG_STOP; ++p) { a.ph_lo = p; a.ph_hi = p + 1; hipLaunchKernelGGL(mk_fwd, dim3(grid), dim3(NWAVES * 64), LDS_BYTES, stream, a); }
    if (DBG_STOP < 16) { a.ph_lo = 17; a.ph_hi = 18; hipLaunchKernelGGL(mk_fwd, dim3(grid), dim3(NWAVES * 64), LDS_BYTES, stream, a); }
#else
    a.ph_lo = 0; a.ph_hi = 17;
    hipLaunchKernelGGL(mk_fwd, dim3(grid), dim3(NWAVES * 64), LDS_BYTES, stream, a);
#endif
}
```

```cpp
#include <hip/hip_runtime.h>
#include <cstdio>
#include <cstdint>
#include <type_traits>

#ifndef MK_MULTI
#define MK_MULTI 0
#endif
#ifndef DBG_STOP
#define DBG_STOP 16
#endif

#ifndef DBG_DOUBLE
#define DBG_DOUBLE 0u
#endif
#ifndef FP8_G1_L0
#define FP8_G1_L0 1
#endif
#ifndef FP8_G1_L1
#define FP8_G1_L1 1
#endif
#ifndef FP8_G2_L0
#define FP8_G2_L0 1
#endif
#ifndef FP8_G2_L1
#define FP8_G2_L1 1
#endif
#define LAS __attribute__((address_space(3)))
#define GAS __attribute__((address_space(1)))
typedef unsigned short bf16;
typedef short bf16x8 __attribute__((ext_vector_type(8)));
typedef short s16x4 __attribute__((ext_vector_type(4)));
typedef float f32x4 __attribute__((ext_vector_type(4)));
typedef float f32x16 __attribute__((ext_vector_type(16)));
typedef unsigned u32x4 __attribute__((ext_vector_type(4)));
typedef unsigned u32x2 __attribute__((ext_vector_type(2)));

constexpr int NB = 8, NSEQ = 4096, D = 1024, LCTX = 256;
constexpr int TL = NB * NSEQ, TC = NB * LCTX, T = TL + TC;
constexpr int EIN = 2048;
constexpr int OIN = 1280;
constexpr int NE = 16, DE = 512;
constexpr int MAXSLOT = 73728;
constexpr float EPS = 1e-6f;

constexpr size_t KiB = 1024, MiB = 1024 * 1024;
constexpr size_t WS_CTL = 0, CTL_ZERO_BYTES = 64 * KiB;
constexpr size_t WS_MODS = 64 * KiB;
constexpr size_t WS_ROPE = WS_MODS + 512 * KiB;
constexpr size_t WS_WA = WS_ROPE + 8 * KiB;
constexpr size_t WS_WAC = WS_WA + 32 * KiB;
constexpr size_t WS_WCC = WS_WAC + 2 * KiB;
constexpr size_t WS_FD = 3 * MiB - 64 * KiB;
constexpr size_t WS_BCNT = WS_WCC + 16 * KiB;
constexpr size_t WS_TILEMAP = WS_BCNT + 16 * KiB;
constexpr size_t WS_SLOT = WS_TILEMAP + 2 * KiB;
constexpr size_t WS_WROW = WS_SLOT + 288 * KiB;
constexpr size_t WS_ROUTE = WS_WROW + 288 * KiB;
constexpr size_t WS_WC = 3 * MiB;
constexpr size_t WS_W_EIN = 4 * MiB;
constexpr size_t WS_W_EOUT = 9 * MiB;
constexpr size_t WS_W_OIN = 11 * MiB;
constexpr size_t WS_W_OOUT = 14 * MiB;
constexpr size_t WS_W_POOL = 16 * MiB;
constexpr size_t WS_W_M1 = 17 * MiB;
constexpr size_t WS_W_M2 = 81 * MiB;
constexpr size_t WS_HC = 113 * MiB;
constexpr size_t WS_BUFA = 121 * MiB;
constexpr size_t WS_BUFP = 189 * MiB;
constexpr size_t WS_BUFZ = 360 * MiB;
constexpr size_t WS_TOKMAP = 432 * MiB;
constexpr size_t WS_HB = 435 * MiB;
constexpr size_t WS_END = 503 * MiB;
constexpr size_t WS_GCNT = 16 * KiB;
static_assert(WS_ROUTE + (size_t)T * 32 <= WS_WC, "small region");
static_assert((size_t)T * EIN * 2 <= WS_BUFZ - WS_BUFP && (size_t)MAXSLOT * 1024 * 2 <= WS_BUFZ - WS_BUFP, "BUFP");
static_assert((size_t)MAXSLOT * 512 * 2 <= WS_TOKMAP - WS_BUFZ && (size_t)T * 1024 * 2 <= WS_TOKMAP - WS_BUFZ, "BUFZ");
static_assert((size_t)16 * T * 4 <= WS_HB - WS_TOKMAP && (size_t)T * 1024 * 2 <= WS_END - WS_HB, "TOKMAP / HB");
static_assert((size_t)T * 1024 * 2 <= WS_BUFP - WS_BUFA, "BUFA");

constexpr int LDS_BYTES = 163840;
constexpr int LDS_GIDX = 147456;
constexpr int LDS_CTL = 146432;
constexpr int NWAVES = 8;

__device__ __forceinline__ unsigned f2bf(float f) { unsigned u = __builtin_bit_cast(unsigned, f); return (u + 0x7fffu + ((u >> 16) & 1u)) >> 16; }
__device__ __forceinline__ unsigned pk2(float lo, float hi) { return f2bf(lo) | (f2bf(hi) << 16); }
__device__ __forceinline__ float bflo(unsigned w) { return __builtin_bit_cast(float, w << 16); }
__device__ __forceinline__ float bfhi(unsigned w) { return __builtin_bit_cast(float, w & 0xffff0000u); }
__device__ __forceinline__ float wave_sum(float v) {
#pragma unroll
    for (int o = 1; o < 64; o <<= 1) v += __shfl_xor(v, o);
    return v;
}
__device__ __forceinline__ int ld_coh(const int* p) { return (int)__hip_atomic_load((const unsigned*)p, __ATOMIC_RELAXED, __HIP_MEMORY_SCOPE_AGENT); }
__device__ __forceinline__ float ld_cohf(const float* p) { return __builtin_bit_cast(float, __hip_atomic_load((const unsigned*)p, __ATOMIC_RELAXED, __HIP_MEMORY_SCOPE_AGENT)); }
#define LDS_WAIT() asm volatile("s_waitcnt lgkmcnt(0)" ::: "memory")

#define XB_TMO      128
#define XB_XCNT(j)  (256  + 64 * (j))
#define XB_XSUB(j)  (1280 + 64 * (j))
#define XB_XGEN(j)  (2304 + 64 * (j))
#define XB_TOP      3328
#define XB_TOPGEN   3392
#define XCD_BAR_WORDS 3456
#define XB_SPIN_CAP (1u << 18)
__device__ __forceinline__ unsigned xb_ld(unsigned* p)              { return __hip_atomic_load(p, __ATOMIC_RELAXED, __HIP_MEMORY_SCOPE_AGENT); }
__device__ __forceinline__ unsigned xb_add(unsigned* p, unsigned v) { return __hip_atomic_fetch_add(p, v, __ATOMIC_RELAXED, __HIP_MEMORY_SCOPE_AGENT); }
__device__ __forceinline__ unsigned xb_xcc_id() { return (unsigned)__builtin_amdgcn_s_getreg((3 << 11) | 20) & 0xFu; }
#define XB_SPIN(cond, bar) do { unsigned _sp = 0; while (cond) { __builtin_amdgcn_s_sleep(1); \
    if ((++_sp & 255u) == 0u) { if (xb_ld(&(bar)[XB_TMO])) break; if (_sp > XB_SPIN_CAP) { atomicAdd(&(bar)[XB_TMO], 1u); break; } } } } while (0)
struct XcdBarrier { unsigned* bar; unsigned x; volatile LAS unsigned* st; };
__device__ __forceinline__ XcdBarrier xcd_barrier_post(unsigned* bar, volatile LAS unsigned* st) {
    XcdBarrier b; b.bar = bar; b.x = xb_xcc_id(); b.st = st;
    if (threadIdx.x == 0) (void)xb_add(&bar[XB_XCNT(b.x)], 1u);
    return b;
}
__device__ __forceinline__ void xcd_barrier_complete(unsigned* bar, unsigned x, unsigned& nloc, unsigned& nx) {
    const unsigned G = gridDim.x * gridDim.y * gridDim.z;
    unsigned sum, cnt, mine, sp = 0u;
    for (;;) {
        sum = 0u; cnt = 0u; mine = 0u;
#pragma unroll
        for (unsigned j = 0; j < 16; ++j) { const unsigned c = xb_ld(&bar[XB_XCNT(j)]); sum += c; cnt += (c > 0u) ? 1u : 0u; mine = (j == x) ? c : mine; }
        if (sum == G) break;
        __builtin_amdgcn_s_sleep(1);
        if ((++sp & 255u) == 0u) { if (xb_ld(&bar[XB_TMO])) break; if (sp > XB_SPIN_CAP) { atomicAdd(&bar[XB_TMO], 1u); break; } }
    }
    nloc = mine > 0u ? mine : 1u; nx = cnt > 0u ? cnt : 1u;
}
__device__ __forceinline__ void xcd_barrier(const XcdBarrier& b) {
    asm volatile("s_waitcnt vmcnt(0)" ::: "memory");
    __syncthreads();
    if (threadIdx.x == 0) {
        unsigned* bar = b.bar;
        __builtin_amdgcn_s_waitcnt(0);
        unsigned nloc = b.st[0], nx = b.st[1];
        if (nloc == 0u) { xcd_barrier_complete(bar, b.x, nloc, nx); b.st[0] = nloc; b.st[1] = nx; }
        const unsigned old = xb_add(&bar[XB_XSUB(b.x)], 1u);
        const unsigned gen = old / nloc;
        if (old + 1u == (gen + 1u) * nloc) {
            __builtin_amdgcn_fence(__ATOMIC_RELEASE, "agent");
            asm volatile("s_waitcnt vmcnt(0)" ::: "memory");
            const unsigned og = xb_add(&bar[XB_TOP], 1u);
            const unsigned tg = og / nx;
            if (og + 1u == (tg + 1u) * nx) xb_add(&bar[XB_TOPGEN], 1u);
            else XB_SPIN(xb_ld(&bar[XB_TOPGEN]) == tg, bar);
            __builtin_amdgcn_fence(__ATOMIC_ACQUIRE, "agent");
            xb_add(&bar[XB_XGEN(b.x)], 1u);
            asm volatile("s_waitcnt vmcnt(0)" ::: "memory");
        } else {
            XB_SPIN(xb_ld(&bar[XB_XGEN(b.x)]) == gen, bar);
            __builtin_amdgcn_fence(__ATOMIC_ACQUIRE, "agent");
            asm volatile("s_waitcnt vmcnt(0)" ::: "memory");
        }
    }
    __syncthreads();
}

namespace pg8 {
constexpr int BM = 256, BK = 64, HALF = 128, HTB = HALF * BK * 2, STAGE_BYTES = 8 * HTB;
__host__ __device__ __forceinline__ int lds_byte(int r, int c) { const int st = (r >> 4) * 2 + (c >> 5), rr = r & 15, cc = c & 31, ob = rr * 64 + cc * 2; return st * 1024 + (ob ^ (((ob >> 9) & 1) << 5)); }
__host__ __device__ __forceinline__ void stage_rc(int b, int& R, int& C) { const int st = b / 1024, sb = b % 1024, swz = sb ^ (((sb >> 9) & 1) << 5); R = (st >> 1) * 16 + swz / 64; C = (st & 1) * 32 + (swz % 64) / 2; }
__host__ __device__ __forceinline__ int perm32(int rho) { const int n = rho >> 4, i = rho & 15; return 8 * (i >> 2) + 4 * n + (i & 3); }
struct Unit { int pm, pn, e; };
__device__ __forceinline__ unsigned cvt_pk_bf16(float lo, float hi) { unsigned r; asm volatile("v_cvt_pk_bf16_f32 %0, %1, %2" : "=v"(r) : "v"(lo), "v"(hi)); return r; }

typedef int v8i32 __attribute__((ext_vector_type(8)));
typedef int v4i32 __attribute__((ext_vector_type(4)));
__device__ __forceinline__ v8i32 cat16(const bf16x8 lo, const bf16x8 hi) { return __builtin_shufflevector(__builtin_bit_cast(v4i32, lo), __builtin_bit_cast(v4i32, hi), 0, 1, 2, 3, 4, 5, 6, 7); }
template <class Epi, class Sched, bool FP8 = false>
__device__ __forceinline__ void gemm_phase(LAS unsigned char* lds, const int K, const Sched& S, const Epi& E) {
    const int tid = threadIdx.x, wid = __builtin_amdgcn_readfirstlane(tid >> 6), lane = tid & 63, wr = wid >> 2, wc = wid & 3, fr = lane & 15, fq = lane >> 4;
    const int nt = K / BK;
    int tidv = tid;
#define PG8_VB(i) ([&]() -> unsigned { int R_, C_; stage_rc(tidv * 16 + (i) * 8192, R_, C_); const int Rb_ = Epi::PERM ? ((R_ & ~31) + perm32(R_ & 31)) : R_; return (unsigned)(Rb_ * K + C_) * 2u; }())
#define PG8_VA(h, i) ([&]() -> unsigned { int R_, C_; stage_rc(tidv * 16 + (i) * 8192, R_, C_); return (unsigned)((128 * (h) + R_) * K + C_) * 2u; }())
    const size_t kstep = (size_t)(BK * 2);
    const size_t hstep = (size_t)HALF * K * 2;
    const unsigned ldsw = (unsigned)wid * 1024u;
#define aoff (lds_byte(wr * 64 + (tidv & 15), ((tidv >> 4) & 3) * 8))
#define boff (lds_byte(wc * 32 + (tidv & 15), ((tidv >> 4) & 3) * 8))
#define PG8_SA(b, h) (((b) * 2 + (h)) * HTB)
#define PG8_SB(b, h) ((4 + (b) * 2 + (h)) * HTB)
#define PG8_STAGEB(bufoff, gbase) do { _Pragma("unroll") for (int _i = 0; _i < 2; ++_i) \
        __builtin_amdgcn_global_load_lds((const unsigned*)((const char*)(gbase) + PG8_VB(_i)), (LAS unsigned*)(lds + (bufoff) + ldsw + _i * 8192), 16, 0, 0); } while (0)
#define PG8_STAGEA(bufoff, gbase, h, NEXT) do { _Pragma("unroll") for (int _i = 0; _i < 2; ++_i) { unsigned vo_; \
        if constexpr (Sched::GATHER) { int R_, C_; stage_rc(tidv * 16 + _i * 8192, R_, C_); const unsigned raw_ = gidx[((((NEXT) && usen) ? (gslot ^ 1u) : gslot) * 4u + (h) * 2 + _i) * 512u + tid]; vo_ = (raw_ * (unsigned)K + (unsigned)C_) * 2u; } \
        else vo_ = PG8_VA(h, _i); \
        __builtin_amdgcn_global_load_lds((const unsigned*)((const char*)(gbase) + vo_), (LAS unsigned*)(lds + (bufoff) + ldsw + _i * 8192), 16, 0, 0); } } while (0)
#define PG8_LDA(dst, b, h) do { _Pragma("unroll") for (int m = 0; m < 4; ++m) _Pragma("unroll") for (int k = 0; k < 2; ++k) dst[m][k] = *(const LAS bf16x8*)(lds + PG8_SA(b, h) + aoff + m * 2048 + k * 1024); } while (0)
#define PG8_LDB(dst, b, h) do { _Pragma("unroll") for (int n = 0; n < 2; ++n) _Pragma("unroll") for (int k = 0; k < 2; ++k) dst[n][k] = *(const LAS bf16x8*)(lds + PG8_SB(b, h) + boff + n * 2048 + k * 1024); } while (0)
#define PG8_MMA(ai, bj, At, Bt) do { __builtin_amdgcn_s_setprio(1); _Pragma("unroll") for (int m = 0; m < 4; ++m) _Pragma("unroll") for (int n = 0; n < 2; ++n) { \
        if constexpr (FP8) acc[ai][bj][m][n] = __builtin_amdgcn_mfma_scale_f32_16x16x128_f8f6f4(cat16(Bt[n][0], Bt[n][1]), cat16(At[m][0], At[m][1]), acc[ai][bj][m][n], 0, 0, 0, 0x7f7f7f7f, 0, 0x7f7f7f7f); \
        else { _Pragma("unroll") for (int k = 0; k < 2; ++k) acc[ai][bj][m][n] = __builtin_amdgcn_mfma_f32_16x16x32_bf16(Bt[n][k], At[m][k], acc[ai][bj][m][n], 0, 0, 0); } } \
        __builtin_amdgcn_s_setprio(0); } while (0)
#define PG8_WAIT_V(n) asm volatile("s_waitcnt vmcnt(" #n ")" ::: "memory")
#define PG8_WAIT_L(n) asm volatile("s_waitcnt lgkmcnt(" #n ")" ::: "memory")
#define PG8_BAR __builtin_amdgcn_s_barrier()
#define PG8_SCHED __builtin_amdgcn_sched_barrier(0)
#define PG8_ITER(A1, A2, A3, B2, B3) do { \
            PG8_LDB(B0, 0, 0); PG8_LDB(B1, 0, 1); PG8_SCHED; PG8_LDA(At, 0, 0); PG8_STAGEA(PG8_SA(1, 1), A1, 1, 0); \
            PG8_WAIT_V(8); PG8_WAIT_L(0); PG8_BAR; PG8_MMA(0, 0, At, B0); PG8_MMA(0, 1, At, B1); PG8_BAR; PG8_SCHED; \
            PG8_LDA(At, 0, 1); PG8_STAGEB(PG8_SB(0, 0), B2); PG8_STAGEB(PG8_SB(0, 1), (B2) + hstep); PG8_STAGEA(PG8_SA(0, 0), A2, 0, 1); \
            PG8_WAIT_V(8); PG8_WAIT_L(0); PG8_BAR; PG8_MMA(1, 0, At, B0); PG8_MMA(1, 1, At, B1); PG8_BAR; PG8_SCHED; \
            PG8_LDB(B0, 1, 0); PG8_LDB(B1, 1, 1); PG8_SCHED; PG8_LDA(At, 1, 0); PG8_STAGEA(PG8_SA(0, 1), A2, 1, 1); \
            PG8_WAIT_V(8); PG8_WAIT_L(0); PG8_BAR; PG8_MMA(0, 0, At, B0); PG8_MMA(0, 1, At, B1); PG8_BAR; PG8_SCHED; \
            PG8_LDA(At, 1, 1); PG8_STAGEB(PG8_SB(1, 0), B3); PG8_STAGEB(PG8_SB(1, 1), (B3) + hstep); PG8_STAGEA(PG8_SA(1, 0), A3, 0, 1); \
            PG8_WAIT_V(8); PG8_WAIT_L(0); PG8_BAR; PG8_MMA(1, 0, At, B0); PG8_MMA(1, 1, At, B1); PG8_BAR; PG8_SCHED; } while (0)
    Unit cur, nxt; int ui = 0;
    if (!S.next(0, cur)) return;
    f32x4 acc[2][2][4][2];
#pragma unroll
    for (int a = 0; a < 2; ++a)
#pragma unroll
        for (int b = 0; b < 2; ++b)
#pragma unroll
            for (int m = 0; m < 4; ++m)
#pragma unroll
                for (int n = 0; n < 2; ++n) acc[a][b][m][n] = (f32x4){0.f, 0.f, 0.f, 0.f};
    bf16x8 At[4][2], B0[2][2], B1[2][2];
    const LAS unsigned* gidx = (const LAS unsigned*)(lds + LDS_GIDX); unsigned gslot = 0u;
    if constexpr (Sched::GATHER) { S.idx_dma(cur, (LAS unsigned*)(lds + LDS_GIDX), tidv, wid); asm volatile("s_waitcnt vmcnt(0)" ::: "memory"); }
    const char* cA = S.a_base(cur); const char* cB = S.b_base(cur);
    constexpr bool usen = false;
    PG8_STAGEB(PG8_SB(0, 0), cB); PG8_STAGEB(PG8_SB(0, 1), cB + hstep); PG8_STAGEA(PG8_SA(0, 0), cA, 0, 0); PG8_STAGEA(PG8_SA(0, 1), cA, 1, 0);
    if (wr == 1) PG8_BAR;
    PG8_WAIT_V(2); PG8_BAR;
    PG8_STAGEB(PG8_SB(1, 0), cB + kstep); PG8_STAGEA(PG8_SA(1, 0), cA + kstep, 0, 0); PG8_STAGEB(PG8_SB(1, 1), cB + hstep + kstep);
    PG8_WAIT_V(6); PG8_BAR;
    for (;;) {
        const bool has_next = S.next(ui + 1, nxt);
        const char* nA = has_next ? S.a_base(nxt) : cA; const char* nB = has_next ? S.b_base(nxt) : cB;
#pragma unroll 1
        for (int t = 0; t < nt; t += 2) {
            const bool last = (t == nt - 2);
            const char* a1 = cA + (size_t)(t + 1) * kstep;
            const char* a2 = last ? nA : cA + (size_t)(t + 2) * kstep; const char* b2 = last ? nB : cB + (size_t)(t + 2) * kstep;
            tidv = tid; asm volatile("" : "+v"(tidv));
            if constexpr (Sched::GATHER) {
                if (t == nt - 4 && has_next) S.idx_dma(nxt, (LAS unsigned*)(lds + LDS_GIDX) + (gslot ^ 1u) * 2048u, tidv, wid);
            }
            const bool usen = last && has_next;
            PG8_ITER(a1, a2, a2 + kstep, b2, b2 + kstep);
        }
        if (wr == 0) PG8_BAR;
        E(acc, cur, wr, wc, fr, fq);
        if (!has_next) break;
#pragma unroll
        for (int a = 0; a < 2; ++a)
#pragma unroll
            for (int b = 0; b < 2; ++b)
#pragma unroll
                for (int m = 0; m < 4; ++m)
#pragma unroll
                    for (int n = 0; n < 2; ++n) acc[a][b][m][n] = (f32x4){0.f, 0.f, 0.f, 0.f};
        cur = nxt; cA = nA; cB = nB; ++ui;
        if constexpr (Sched::GATHER) gslot ^= 1u;
        if (wr == 1) PG8_BAR;
    }
    PG8_WAIT_V(0);
    PG8_BAR;
#undef PG8_ITER
#undef aoff
#undef boff
#undef PG8_SA
#undef PG8_SB
#undef PG8_STAGEA
#undef PG8_STAGEB
#undef PG8_VA
#undef PG8_VB
#undef PG8_LDA
#undef PG8_LDB
#undef PG8_MMA
#undef PG8_WAIT_V
#undef PG8_WAIT_L
#undef PG8_BAR
#undef PG8_SCHED
}

struct SchedDense {
    static constexpr bool GATHER = false;
    const char* A; const char* Bt; int K, nN, nMfull, pnx, nUnits, c, G;
    __device__ __forceinline__ bool next(int i, Unit& u) const {
        const int L = i * G + c; if (L >= nUnits) return false;
        const int full = nMfull * nN;
        if (L < full) { u.pm = L / nN; u.pn = L - u.pm * nN; } else { u.pm = nMfull + (L - full); u.pn = pnx; }
        u.e = 0; return true;
    }
    __device__ __forceinline__ const char* a_base(const Unit& u) const { return A + (size_t)u.pm * 256 * K * 2; }
    __device__ __forceinline__ const char* b_base(const Unit& u) const { return Bt + (size_t)u.pn * 256 * K * 2; }
};
template <bool GATHER_> struct SchedMoe {
    static constexpr bool GATHER = GATHER_, gather = GATHER_;
    const char* A; const char* W; const int* tokmap; const LAS int* tb; const LAS int* cn; int K; size_t wstride; int nUnits, c, G;
    __device__ __forceinline__ bool next(int i, Unit& u) const {
        const int L = i * G + c; if (L >= nUnits) return false;
        u.pm = L >> 2; u.pn = L & 3; int e = 0;
#pragma unroll
        for (int q = 1; q < 16; ++q) if (u.pm >= __builtin_amdgcn_readfirstlane(tb[q])) e = q;
        u.e = __builtin_amdgcn_readfirstlane(e); return true;
    }
    __device__ __forceinline__ const char* a_base(const Unit& u) const { return gather ? A : A + (size_t)u.pm * 256 * K * 2; }
    __device__ __forceinline__ const char* b_base(const Unit& u) const { return W + (size_t)u.e * wstride + (size_t)u.pn * 256 * K * 2; }
    __device__ __forceinline__ void idx_dma(const Unit& u, LAS unsigned* slot, int tidv, int wid) const {
        const int p0 = (u.pm - __builtin_amdgcn_readfirstlane(tb[u.e])) * 256, last = __builtin_amdgcn_readfirstlane(cn[u.e]) - 1; const int* tm = tokmap + (size_t)u.e * T;
#pragma unroll
        for (int h = 0; h < 2; ++h)
#pragma unroll
            for (int i = 0; i < 2; ++i) { int R_, C_; stage_rc(tidv * 16 + i * 8192, R_, C_); int pos = p0 + 128 * h + R_; pos = pos < last ? pos : last;
                __builtin_amdgcn_global_load_lds((const unsigned*)(tm + pos), slot + (h * 2 + i) * 512 + wid * 64, 4, 0, 0); }
    }
};

struct EpiStore {
    static constexpr bool PERM = true;
    bf16* O; int ldc;
    __device__ __forceinline__ void operator()(const f32x4 (&acc)[2][2][4][2], const Unit& u, int wr, int wc, int fr, int fq) const {
        const int row0 = u.pm * BM + wr * 64 + fr, col0 = u.pn * BM + wc * 32 + 8 * fq;
#pragma unroll
        for (int ai = 0; ai < 2; ++ai)
#pragma unroll
            for (int m = 0; m < 4; ++m) { bf16* rowp = O + (size_t)(row0 + ai * HALF + m * 16) * ldc + col0;
#pragma unroll
                for (int bj = 0; bj < 2; ++bj) { const f32x4 v0 = acc[ai][bj][m][0], v1 = acc[ai][bj][m][1];
                    u32x4 w; w.x = cvt_pk_bf16(v0[0], v0[1]); w.y = cvt_pk_bf16(v0[2], v0[3]); w.z = cvt_pk_bf16(v1[0], v1[1]); w.w = cvt_pk_bf16(v1[2], v1[3]);
                    *(u32x4*)(rowp + bj * HALF) = w; } }
    }
};
template <bool SRC_F32> struct EpiResid {
    static constexpr bool PERM = true;
    const float* srcL; const float* srcC; bf16* H; const float* gate;
    __device__ __forceinline__ void operator()(const f32x4 (&acc)[2][2][4][2], const Unit& u, int wr, int wc, int fr, int fq) const {
        const float* g = gate + (u.pm < 128 ? (u.pm >> 4) : 8) * 6144;
        const float* src = (u.pm < 128) ? srcL + (size_t)u.pm * 256 * 1024 : srcC + (size_t)(u.pm - 128) * 256 * 1024;
        bf16* dst = H + (size_t)u.pm * 256 * 1024;
        const int row0 = wr * 64 + fr, col0 = u.pn * BM + wc * 32 + 8 * fq;
        f32x4 gv[2][2];
#pragma unroll
        for (int bj = 0; bj < 2; ++bj)
#pragma unroll
            for (int n = 0; n < 2; ++n) gv[bj][n] = *(const f32x4*)(g + col0 + bj * HALF + 4 * n);
#pragma unroll
        for (int ai = 0; ai < 2; ++ai)
#pragma unroll
            for (int m = 0; m < 4; ++m) { const size_t ro = (size_t)(row0 + ai * HALF + m * 16) * 1024 + col0;
#pragma unroll
                for (int bj = 0; bj < 2; ++bj) {
                    f32x4 s0, s1;
                    if constexpr (SRC_F32) { s0 = __builtin_nontemporal_load((const f32x4*)(src + ro + bj * HALF)); s1 = __builtin_nontemporal_load((const f32x4*)(src + ro + bj * HALF + 4)); }
                    else { const u32x4 hv = *(const u32x4*)(dst + ro + bj * HALF); s0 = (f32x4){bflo(hv.x), bfhi(hv.x), bflo(hv.y), bfhi(hv.y)}; s1 = (f32x4){bflo(hv.z), bfhi(hv.z), bflo(hv.w), bfhi(hv.w)}; }
                    const f32x4 v0 = s0 + gv[bj][0] * acc[ai][bj][m][0], v1 = s1 + gv[bj][1] * acc[ai][bj][m][1];
                    u32x4 w; w.x = cvt_pk_bf16(v0[0], v0[1]); w.y = cvt_pk_bf16(v0[2], v0[3]); w.z = cvt_pk_bf16(v1[0], v1[1]); w.w = cvt_pk_bf16(v1[2], v1[3]);
                    *(u32x4*)(dst + ro + bj * HALF) = w; } }
    }
};
__device__ __forceinline__ float silu_f(float x) { return x * __builtin_amdgcn_rcpf(1.0f + __expf(-x)); }
struct EpiSwiglu {
    static constexpr bool PERM = true;
    bf16* H;
    __device__ __forceinline__ void operator()(const f32x4 (&acc)[2][2][4][2], const Unit& u, int wr, int wc, int fr, int fq) const {
        const int row0 = u.pm * BM + wr * 64 + fr, col0 = u.pn * 128 + wc * 32 + 8 * fq;
#pragma unroll
        for (int ai = 0; ai < 2; ++ai)
#pragma unroll
            for (int m = 0; m < 4; ++m) { bf16* p = H + (size_t)(row0 + ai * HALF + m * 16) * 512 + col0;
                const f32x4 g0 = acc[ai][0][m][0], g1 = acc[ai][0][m][1], u0 = acc[ai][1][m][0], u1 = acc[ai][1][m][1];
                u32x4 w; w.x = cvt_pk_bf16(silu_f(g0[0]) * u0[0], silu_f(g0[1]) * u0[1]); w.y = cvt_pk_bf16(silu_f(g0[2]) * u0[2], silu_f(g0[3]) * u0[3]);
                w.z = cvt_pk_bf16(silu_f(g1[0]) * u1[0], silu_f(g1[1]) * u1[1]); w.w = cvt_pk_bf16(silu_f(g1[2]) * u1[2], silu_f(g1[3]) * u1[3]);
                *(u32x4*)p = w; }
    }
};
__device__ __forceinline__ unsigned pk4_fp8(float a, float b, float c, float d) { int p = __builtin_amdgcn_cvt_pk_fp8_f32(a, b, 0, false); p = __builtin_amdgcn_cvt_pk_fp8_f32(c, d, p, true); return (unsigned)p; }
constexpr float W1_SCALE = 32.0f, W2_SCALE = 16.0f, HID_SCALE = 4.0f;
struct EpiSwiglu8 {
    static constexpr bool PERM = true;
    unsigned char* H; float in_scale;
    __device__ __forceinline__ void operator()(const f32x4 (&acc)[2][2][4][2], const Unit& u, int wr, int wc, int fr, int fq) const {
        const int row0 = u.pm * BM + wr * 64 + fr, col0 = u.pn * 128 + wc * 32 + 8 * fq;
        const float IS = 1.0f / in_scale, OS = HID_SCALE / in_scale;
#pragma unroll
        for (int ai = 0; ai < 2; ++ai)
#pragma unroll
            for (int m = 0; m < 4; ++m) { unsigned char* p = H + (size_t)(row0 + ai * HALF + m * 16) * 512 + col0;
                const f32x4 g0 = acc[ai][0][m][0] * IS, g1 = acc[ai][0][m][1] * IS, u0 = acc[ai][1][m][0] * OS, u1 = acc[ai][1][m][1] * OS;
#define HC8(x) __builtin_fminf(__builtin_fmaxf((x), -448.0f), 448.0f)
                u32x2 w; w.x = pk4_fp8(HC8(silu_f(g0[0]) * u0[0]), HC8(silu_f(g0[1]) * u0[1]), HC8(silu_f(g0[2]) * u0[2]), HC8(silu_f(g0[3]) * u0[3]));
                w.y = pk4_fp8(HC8(silu_f(g1[0]) * u1[0]), HC8(silu_f(g1[1]) * u1[1]), HC8(silu_f(g1[2]) * u1[2]), HC8(silu_f(g1[3]) * u1[3]));
#undef HC8
                *(u32x2*)p = w; }
    }
};
struct EpiStoreS {
    static constexpr bool PERM = true;
    bf16* O; int ldc; float scale;
    __device__ __forceinline__ void operator()(const f32x4 (&acc)[2][2][4][2], const Unit& u, int wr, int wc, int fr, int fq) const {
        const int row0 = u.pm * BM + wr * 64 + fr, col0 = u.pn * BM + wc * 32 + 8 * fq;
#pragma unroll
        for (int ai = 0; ai < 2; ++ai)
#pragma unroll
            for (int m = 0; m < 4; ++m) { bf16* rowp = O + (size_t)(row0 + ai * HALF + m * 16) * ldc + col0;
#pragma unroll
                for (int bj = 0; bj < 2; ++bj) { const f32x4 v0 = acc[ai][bj][m][0] * scale, v1 = acc[ai][bj][m][1] * scale;
                    u32x4 w; w.x = cvt_pk_bf16(v0[0], v0[1]); w.y = cvt_pk_bf16(v0[2], v0[3]); w.z = cvt_pk_bf16(v1[0], v1[1]); w.w = cvt_pk_bf16(v1[2], v1[3]);
                    *(u32x4*)(rowp + bj * HALF) = w; } }
    }
};
struct EpiScaleRow {
    static constexpr bool PERM = true;
    bf16* O; const float* wrow;
    __device__ __forceinline__ void operator()(const f32x4 (&acc)[2][2][4][2], const Unit& u, int wr, int wc, int fr, int fq) const {
        const int row0 = u.pm * BM + wr * 64 + fr, col0 = u.pn * BM + wc * 32 + 8 * fq;
#pragma unroll
        for (int ai = 0; ai < 2; ++ai)
#pragma unroll
            for (int m = 0; m < 4; ++m) { const int row = row0 + ai * HALF + m * 16; const float s = wrow[row]; bf16* rowp = O + (size_t)row * 1024 + col0;
#pragma unroll
                for (int bj = 0; bj < 2; ++bj) { const f32x4 v0 = acc[ai][bj][m][0] * s, v1 = acc[ai][bj][m][1] * s;
                    u32x4 w; w.x = cvt_pk_bf16(v0[0], v0[1]); w.y = cvt_pk_bf16(v0[2], v0[3]); w.z = cvt_pk_bf16(v1[0], v1[1]); w.w = cvt_pk_bf16(v1[2], v1[3]);
                    *(u32x4*)(rowp + bj * HALF) = w; } }
    }
};
}

struct Args { const float* in[22]; float* out; unsigned char* ws; int ph_lo, ph_hi; };
enum { I_X = 0, I_C, I_CTX, I_CCTX, I_ADAW, I_ADAB, I_NMG, I_NFG, I_EWIN, I_ECONV, I_EWOUT, I_OWIN, I_OPOOLW, I_OPOOLS, I_OSINK, I_OWOUT, I_RW, I_RB, I_MG, I_MU, I_MD, I_FG };

struct Frame {
    LAS unsigned char* lds;
    int tid, lane, wave, vcu, G;
    unsigned char* ws; const float* const* in; float* out;
};
__device__ __forceinline__ bf16* h_row(const Frame& F, int t) { return (bf16*)(F.ws + WS_HB) + (size_t)t * D; }
__device__ __forceinline__ int mod_row(int t) { return t < TL ? (t >> 12) : 8; }

struct TItem { const float* src; bf16* dst; int ldw, ldd; float f8scale; };
__device__ __forceinline__ void titem_load(const TItem& t, f32x4 (&r)[8], int lane) {
#pragma unroll
    for (int i = 0; i < 8; ++i) r[i] = __builtin_nontemporal_load((const f32x4*)(t.src + (size_t)((lane >> 3) + 8 * i) * t.ldw + 4 * (lane & 7)));
}
__device__ __forceinline__ void titem_process(const TItem& t, const f32x4 (&r)[8], LAS float* scr, int lane) {
#pragma unroll
    for (int i = 0; i < 8; ++i) { LAS float* d = scr + ((lane >> 3) + 8 * i) * 33 + 4 * (lane & 7); d[0] = r[i].x; d[1] = r[i].y; d[2] = r[i].z; d[3] = r[i].w; }
    LDS_WAIT(); asm volatile("" ::: "memory");
    const int c = lane & 7;
    if (t.f8scale != 0.0f) {
        const float sc = t.f8scale; unsigned char* d8 = (unsigned char*)t.dst;
#pragma unroll
        for (int j = 0; j < 4; ++j) { const int n = (lane >> 3) + 8 * j; const LAS float* s = scr + (8 * c) * 33 + n;
            u32x2 o; o.x = pg8::pk4_fp8(s[0 * 33] * sc, s[1 * 33] * sc, s[2 * 33] * sc, s[3 * 33] * sc); o.y = pg8::pk4_fp8(s[4 * 33] * sc, s[5 * 33] * sc, s[6 * 33] * sc, s[7 * 33] * sc);
            *(u32x2*)(d8 + (size_t)n * t.ldd + 8 * c) = o; }
    } else {
#pragma unroll
        for (int j = 0; j < 4; ++j) { const int n = (lane >> 3) + 8 * j; const LAS float* s = scr + (8 * c) * 33 + n;
            u32x4 o; o.x = pk2(s[0 * 33], s[1 * 33]); o.y = pk2(s[2 * 33], s[3 * 33]); o.z = pk2(s[4 * 33], s[5 * 33]); o.w = pk2(s[6 * 33], s[7 * 33]);
            *(u32x4*)(t.dst + (size_t)n * t.ldd + 8 * c) = o; }
    }
    LDS_WAIT(); asm volatile("" ::: "memory");
}
constexpr int TS0 = 1024, TS1 = 512, TS2 = 384, TS3 = 512, TS4 = 0, TS5 = 8192, TS6 = 8192, TS7 = 8192, TNITEMS = TS0 + TS1 + TS2 + TS3 + TS4 + TS5 + TS6 + TS7;
__device__ __forceinline__ TItem titem_moe(const float* const* in, unsigned char* ws, int kind, int le, int rr) {
    TItem t; const int layer = le >> 4, e = le & 15; const bool f8 = (kind < 2) ? (layer ? (FP8_G1_L1 != 0) : (FP8_G1_L0 != 0)) : (layer ? (FP8_G2_L1 != 0) : (FP8_G2_L0 != 0));
    if (kind < 2) { const int kb = (rr >> 4) & 15, nb = rr & 15, n0 = nb * 32; const int drow = (n0 >> 7) * 256 + (n0 & 127) + kind * 128;
        t.src = in[kind ? I_MU : I_MG] + (size_t)le * 524288 + (size_t)(kb * 64) * 512 + n0; t.ldw = 512;
        unsigned char* base = ws + WS_W_M1 + (size_t)layer * 32 * MiB;
        if (f8) { t.dst = (bf16*)(base + (size_t)e * MiB + (size_t)drow * 1024 + kb * 64); t.ldd = 1024; t.f8scale = pg8::W1_SCALE; }
        else { t.dst = (bf16*)(base + (size_t)e * 2 * MiB) + (size_t)drow * 1024 + kb * 64; t.ldd = 1024; t.f8scale = 0.0f; } }
    else { const int kb = (rr >> 5) & 7, nb = rr & 31;
        t.src = in[I_MD] + (size_t)le * 524288 + (size_t)(kb * 64) * 1024 + nb * 32; t.ldw = 1024;
        unsigned char* base = ws + WS_W_M2 + (size_t)layer * 16 * MiB;
        if (f8) { t.dst = (bf16*)(base + (size_t)e * 512 * KiB + (size_t)(nb * 32) * 512 + kb * 64); t.ldd = 512; t.f8scale = pg8::W2_SCALE; }
        else { t.dst = (bf16*)(base + (size_t)e * MiB) + (size_t)(nb * 32) * 512 + kb * 64; t.ldd = 512; t.f8scale = 0.0f; } }
    return t;
}
__device__ __forceinline__ TItem titem_decode(const float* const* in, unsigned char* ws, int r) {
    TItem t;
    if (r < TS0) { const int kb = r / 64, nb = r % 64; t.src = in[I_EWIN] + (size_t)(kb * 64) * 2048 + nb * 32; t.ldw = 2048; t.dst = (bf16*)(ws + WS_W_EIN) + (size_t)(nb * 32) * 1024 + kb * 64; t.ldd = 1024; t.f8scale = 0.0f; return t; } r -= TS0;
    if (r < TS1) { const int kb = r / 32, nb = r % 32; t.src = in[I_EWOUT] + (size_t)(kb * 64) * 1024 + nb * 32; t.ldw = 1024; t.dst = (bf16*)(ws + WS_W_EOUT) + (size_t)(nb * 32) * 1024 + kb * 64; t.ldd = 1024; t.f8scale = 0.0f; return t; } r -= TS1;
    if (r < TS2) { const int kb = r / 24, nb = 16 + r % 24; t.src = in[I_OWIN] + (size_t)(kb * 64) * 1280 + nb * 32; t.ldw = 1280; t.dst = (bf16*)(ws + WS_W_OIN) + (size_t)(nb * 32) * 1024 + kb * 64; t.ldd = 1024; t.f8scale = 0.0f; return t; } r -= TS2;
    if (r < TS3) { const int kb = r / 32, nb = r % 32; t.src = in[I_OWOUT] + (size_t)(kb * 64) * 1024 + nb * 32; t.ldw = 1024; t.dst = (bf16*)(ws + WS_W_OOUT) + (size_t)(nb * 32) * 1024 + kb * 64; t.ldd = 1024; t.f8scale = 0.0f; return t; } r -= TS3;
    if (r < TS5 + TS6 + TS7) return titem_moe(in, ws, r / 8192, (r % 8192) >> 8, r % 256);
    return t;
}
constexpr int NL1 = 12288;
__device__ __forceinline__ TItem titem_l1(const float* const* in, unsigned char* ws, int r) { return titem_moe(in, ws, r / 4096, 16 + ((r % 4096) >> 8), r % 256); }

constexpr size_t WS_CONVCTR = 20 * KiB;
__device__ __forceinline__ void convert_l1(Frame& F, int quota) {
    unsigned* ctr = (unsigned*)(F.ws + WS_CONVCTR);
    LAS float* scr = (LAS float*)(F.lds + F.wave * 17408);
    for (int ch = 0; ch < quota; ++ch) {
        const int c0 = __builtin_amdgcn_readfirstlane(F.lane == 0 ? (int)__hip_atomic_fetch_add(ctr, 4u, __ATOMIC_RELAXED, __HIP_MEMORY_SCOPE_AGENT) : 0);
        if (c0 >= NL1) break;
        f32x4 cur[8], nxt[8];
        TItem tc = titem_l1(F.in, F.ws, c0);
        titem_load(tc, nxt, F.lane);
#pragma unroll 1
        for (int i = 0; i < 4; ++i) {
#pragma unroll
            for (int j = 0; j < 8; ++j) cur[j] = nxt[j];
            const TItem tcur = tc;
            if (i < 3) { tc = titem_l1(F.in, F.ws, c0 + i + 1); titem_load(tc, nxt, F.lane); }
            titem_process(tcur, cur, scr, F.lane);
        }
    }
}
__device__ __forceinline__ void tail_fill(Frame& F, int nUnits, int quota) {
    const int rounds = (nUnits + F.G - 1) / F.G;
    if ((rounds - 1) * F.G + F.vcu >= nUnits) convert_l1(F, quota);
}

__device__ __forceinline__ void norm_mod_store(const f32x4 (&v)[4], const float* g, const float* shift, const float* scale, bf16* orow, int lane) {
    float s2 = 0.f;
#pragma unroll
    for (int j = 0; j < 4; ++j) s2 += (v[j].x * v[j].x + v[j].y * v[j].y) + (v[j].z * v[j].z + v[j].w * v[j].w);
    const float rstd = 1.0f / sqrtf(wave_sum(s2) * (1.0f / D) + EPS);
#pragma unroll
    for (int j = 0; j < 4; ++j) { const int c = 4 * lane + 256 * j;
        const f32x4 gg = *(const f32x4*)(g + c), sh = *(const f32x4*)(shift + c), sc = *(const f32x4*)(scale + c);
        const f32x4 y = v[j] * rstd * gg * (sc + 1.0f) + sh;
        u32x2 o; o.x = pk2(y.x, y.y); o.y = pk2(y.z, y.w);
        *(u32x2*)(orow + c) = o; }
}

template <int NQ> __device__ __forceinline__ void p1_tokens(Frame& F, int t) {
    const float* mods = (const float*)(F.ws + WS_MODS);
    bf16* A = (bf16*)(F.ws + WS_BUFA);
    f32x4 v[NQ][4];
#pragma unroll
    for (int q = 0; q < NQ; ++q) { const int tq = t + q; const float* xr = tq < TL ? F.in[I_X] + (size_t)tq * D : F.in[I_CTX] + (size_t)(tq - TL) * D;
#pragma unroll
        for (int j = 0; j < 4; ++j) v[q][j] = __builtin_nontemporal_load((const f32x4*)(xr + 4 * F.lane + 256 * j)); }
    const float* m = mods + (size_t)mod_row(t) * 6144;
#pragma unroll
    for (int q = 0; q < NQ; ++q) norm_mod_store(v[q], F.in[I_NMG], m, m + 1024, A + (size_t)(t + q) * D, F.lane);
}
__device__ __forceinline__ void phase_mods(Frame& F) {
    const float* const* in = F.in;
    LAS float* S = (LAS float*)F.lds;
    LAS float* red = S + 9 * 1024;
    for (int i = F.tid; i < 9 * 1024; i += 512) { const float v = (i < 8192) ? in[I_C][i] : in[I_CCTX][i - 8192]; S[i] = v / (1.0f + expf(-v)); }
    __syncthreads();
    const int bx = blockIdx.x, layer = bx >> 7, col0 = (bx & 127) * 48;
    const int j = F.tid % 12, rg = F.tid / 12;
    if (rg < 42) {
        const float* W = in[I_ADAW] + (size_t)layer * 1024 * 6144 + col0 + 4 * j;
        f32x4 w[25];
#pragma unroll
        for (int i = 0; i < 25; ++i) { const int k = rg + 42 * i; w[i] = (k < 1024) ? __builtin_nontemporal_load((const f32x4*)(W + (size_t)k * 6144)) : (f32x4){0.f, 0.f, 0.f, 0.f}; }
        f32x4 acc[9];
#pragma unroll
        for (int r = 0; r < 9; ++r) acc[r] = (f32x4){0.f, 0.f, 0.f, 0.f};
#pragma unroll
        for (int i = 0; i < 25; ++i) { const int k = min(rg + 42 * i, 1023);
#pragma unroll
            for (int r = 0; r < 9; ++r) acc[r] += w[i] * S[r * 1024 + k]; }
#pragma unroll
        for (int r = 0; r < 9; ++r) *(LAS f32x4*)(red + (rg * 9 + r) * 48 + 4 * j) = acc[r];
    }
    __syncthreads();
    for (int i = F.tid; i < 432; i += 512) { const int r = i / 48, c = i % 48; float sum = in[I_ADAB][layer * 6144 + col0 + c];
        for (int g = 0; g < 42; ++g) sum += red[(g * 9 + r) * 48 + c];
        ((float*)(F.ws + WS_MODS))[(layer * 9 + r) * 6144 + col0 + c] = sum; }
}

__device__ __forceinline__ void phase_prologue_a(Frame& F) {
    const float* const* in = F.in;
    unsigned char* ws = F.ws;
    LAS float* ldsf = (LAS float*)F.lds;
    __syncthreads();
    {
        const int gt = blockIdx.x * 512 + F.tid, NT = F.G * 512;
        float* rope = (float*)(ws + WS_ROPE);
        for (int i = gt; i < 1024; i += NT) { const int coord = i >> 4, q = i & 15; const float inv = powf(10000.0f, -(float)q / 16.0f); const float ang = (float)coord * inv;
            rope[i] = cosf(ang); rope[1024 + i] = sinf(ang); }
        bf16* WA = (bf16*)(ws + WS_WA);
        for (int i = gt; i < 128 * 128; i += NT) { const int m = i >> 7, k = i & 127, rp = m >> 6, j1 = m & 63, ri = k >> 6, n1 = k & 63;
            const float a = 2.0f * (float)((j1 * n1) & 63) / 64.0f; const float c = cospif(a), s = sinpif(a);
            const float v = (rp == 0) ? (ri == 0 ? c : s) : (ri == 0 ? -s : c); WA[i] = (bf16)f2bf(v); }
        bf16* WAC = (bf16*)(ws + WS_WAC);
        for (int i = gt; i < 32 * 32; i += NT) { const int m = i >> 5, k = i & 31, rp = m >> 4, j1 = m & 15, ri = k >> 4, n1 = k & 15;
            const float a = 2.0f * (float)((j1 * n1) & 15) / 16.0f; const float c = cospif(a), s = sinpif(a);
            const float v = (rp == 0) ? (ri == 0 ? c : s) : (ri == 0 ? -s : c); WAC[i] = (bf16)f2bf(v); }
        bf16* WC = (bf16*)(ws + WS_WC);
        for (int i = gt; i < 64 * 64 * 128; i += NT) { const int j1 = i >> 13, j2 = (i >> 7) & 63, k = i & 127, ri = k >> 6, n2 = k & 63;
            const float a = 2.0f * (float)((n2 * (j1 + 64 * j2)) & 4095) / 4096.0f; const float v = (ri == 0 ? cospif(a) : sinpif(a)) * (1.0f / 64.0f); WC[i] = (bf16)f2bf(v); }
        bf16* FD = (bf16*)(ws + WS_FD);
        for (int i = gt; i < 256 * 128; i += NT) { const int col = i >> 7, c = i & 127, ri = col >> 7, k2 = col & 127;
            const float a = 2.0f * (float)((c * k2) & 127) / 128.0f; const float v = (ri == 0 ? cospif(a) : -sinpif(a)) * 0.08838834764831845f; FD[i] = (bf16)f2bf(v); }
        bf16* WCC = (bf16*)(ws + WS_WCC);
        for (int i = gt; i < 16 * 16 * 32; i += NT) { const int j1 = i >> 9, j2 = (i >> 5) & 15, k = i & 31, ri = k >> 4, n2 = k & 15;
            const float a = 2.0f * (float)((n2 * (j1 + 16 * j2)) & 255) / 256.0f; const float v = (ri == 0 ? cospif(a) : sinpif(a)) * (1.0f / 16.0f); WCC[i] = (bf16)f2bf(v); }
    }
    LAS float* tw = (LAS float*)(F.lds + 139264);
    if (F.tid < 128) { const float a = 2.0f * (float)F.tid / 128.0f; tw[F.tid] = cospif(a); tw[128 + F.tid] = sinpif(a); }
    __syncthreads();
    LAS float* scr = (LAS float*)(F.lds + F.wave * 17408);
    const int gw = F.vcu * NWAVES + F.wave, NGW = F.G * NWAVES;
    const int fid = F.vcu * 2 + F.wave;
    if (F.wave < 2) { const int r = fid;
        const int g = r >> 7, db = (r >> 5) & 3, kb = r & 31, k0 = kb * 32, d0 = db * 32;
        const float* Wp = in[I_OWIN] + (size_t)k0 * 1280 + g * 128;
        { float tl[32][2];
#pragma unroll
          for (int rr = 0; rr < 32; ++rr) { tl[rr][0] = Wp[(size_t)rr * 1280 + F.lane]; tl[rr][1] = Wp[(size_t)rr * 1280 + 64 + F.lane]; }
#pragma unroll
          for (int rr = 0; rr < 32; ++rr) { scr[rr * 129 + F.lane] = tl[rr][0]; scr[rr * 129 + 64 + F.lane] = tl[rr][1]; } }
        LDS_WAIT(); asm volatile("" ::: "memory");
        const int k = F.lane & 31, oh = F.lane >> 5;
        const float* pw = in[I_OPOOLW] + (size_t)g * 16384 + d0 + 16 * oh;
        float acc[16];
#pragma unroll
        for (int t = 0; t < 16; ++t) acc[t] = 0.f;
        for (int c0 = 0; c0 < 128; c0 += 8) {
            f32x4 p[8][4];
#pragma unroll
            for (int cc = 0; cc < 8; ++cc)
#pragma unroll
                for (int j = 0; j < 4; ++j) p[cc][j] = *(const f32x4*)(pw + (c0 + cc) * 128 + 4 * j);
#pragma unroll
            for (int cc = 0; cc < 8; ++cc) { const float w = scr[k * 129 + c0 + cc];
#pragma unroll
                for (int j = 0; j < 4; ++j) { acc[4 * j] += w * p[cc][j].x; acc[4 * j + 1] += w * p[cc][j].y; acc[4 * j + 2] += w * p[cc][j].z; acc[4 * j + 3] += w * p[cc][j].w; } }
        }
        const float* psc = in[I_OPOOLS] + g * 128 + d0 + 16 * oh;
        bf16* dst = (bf16*)(ws + WS_W_OIN) + (size_t)(g * 128 + d0 + 16 * oh) * 1024 + k0 + k;
#pragma unroll
        for (int t = 0; t < 16; ++t) dst[(size_t)t * 1024] = (bf16)f2bf(acc[t] * psc[t]);
        LDS_WAIT(); asm volatile("" ::: "memory");
    }
    {
        LAS unsigned* ctr = (LAS unsigned*)(F.lds + LDS_CTL + 32);
        constexpr int PER = (TNITEMS + 255) / 256;
        const int base = F.vcu * PER, lim = min(PER, TNITEMS - base);
        f32x4 cur[8], nxt[8];
        int it = __builtin_amdgcn_readfirstlane(F.lane == 0 ? (int)atomicAdd((unsigned*)ctr, 1u) : 0);
        TItem tc = titem_decode(in, ws, base + (it < lim ? it : 0));
        if (it < lim) titem_load(tc, nxt, F.lane);
        while (it < lim) {
#pragma unroll
            for (int i = 0; i < 8; ++i) cur[i] = nxt[i];
            const TItem tcur = tc;
            const int itn = __builtin_amdgcn_readfirstlane(F.lane == 0 ? (int)atomicAdd((unsigned*)ctr, 1u) : 0);
            if (itn < lim) { tc = titem_decode(in, ws, base + itn); titem_load(tc, nxt, F.lane); }
            titem_process(tcur, cur, scr, F.lane);
            it = itn;
        }
    }
    {
        LAS unsigned* ctr2 = (LAS unsigned*)(F.lds + LDS_CTL + 36);
        for (;;) {
            const int it = __builtin_amdgcn_readfirstlane(F.lane == 0 ? (int)atomicAdd((unsigned*)ctr2, 1u) : 0);
            if (it >= 40) break;
            if (it < 32) p1_tokens<4>(F, 4 * (32 * (int)blockIdx.x + it)); else p1_tokens<1>(F, TL + 8 * (int)blockIdx.x + (it - 32));
        }
    }
}

struct DftP { const bf16* dbase; size_t dstride; const bf16* W; bf16* obase; size_t ostride; };
template <int MODE> __device__ __forceinline__ DftP dft_params(const Frame& F, int u) {
    const bf16* P = (const bf16*)(F.ws + WS_BUFP); bf16* Z = (bf16*)(F.ws + WS_BUFZ); bf16* MIX = (bf16*)(F.ws + WS_BUFA);
    DftP p;
    if constexpr (MODE == 0) { const int chunk = u & 3, n2 = (u >> 2) & 63, b = u >> 8;
        p.dbase = P + (size_t)(b * 4096 + n2) * EIN + chunk * 128; p.dstride = (size_t)64 * EIN; p.W = (const bf16*)(F.ws + WS_WA);
        p.obase = Z + (size_t)((b * 64) * 64 + n2) * 1024 + chunk * 128; p.ostride = (size_t)64 * 1024; }
    if constexpr (MODE == 1) { const int chunk = u & 3, n2 = (u >> 2) & 15, b = u >> 6;
        p.dbase = P + (size_t)(TL + b * 256 + n2) * EIN + chunk * 128; p.dstride = (size_t)16 * EIN; p.W = (const bf16*)(F.ws + WS_WAC);
        p.obase = Z + (size_t)(TL + (b * 16) * 16 + n2) * 1024 + chunk * 128; p.ostride = (size_t)16 * 1024; }
    if constexpr (MODE == 2) { const int chunk = u & 3, j1 = (u >> 2) & 63, b = u >> 8;
        p.dbase = Z + (size_t)((b * 64 + j1) * 64) * 1024 + chunk * 128; p.dstride = (size_t)1024; p.W = (const bf16*)(F.ws + WS_WC) + (size_t)j1 * 64 * 128;
        p.obase = MIX + (size_t)(b * 4096 + j1) * D + chunk * 128; p.ostride = (size_t)64 * D; }
    if constexpr (MODE == 3) { const int chunk = u & 3, j1 = (u >> 2) & 15, b = u >> 6;
        p.dbase = Z + (size_t)(TL + (b * 16 + j1) * 16) * 1024 + chunk * 128; p.dstride = (size_t)1024; p.W = (const bf16*)(F.ws + WS_WCC) + (size_t)j1 * 16 * 32;
        p.obase = MIX + (size_t)(TL + b * 256 + j1) * D + chunk * 128; p.ostride = (size_t)16 * D; }
    return p;
}
template <int MODE, int KD, int MD, int J>
__device__ __forceinline__ void dft_units(Frame& F, int nunits) {
    constexpr int LD = KD + 8;
    constexpr int NP = (KD * 16 + 511) / 512;
    constexpr int GM = KD / 8 - 1;
    LAS bf16* DT = (LAS bf16*)F.lds;
    u32x4 pre[NP];
    int u = F.vcu;
    if (u < nunits) { const DftP p = dft_params<MODE>(F, u);
#pragma unroll
        for (int i = 0; i < NP; ++i) { const int pc = F.tid + 512 * i; if (pc < KD * 16) { const int k = pc >> 4, c8 = pc & 15, ri = k / (KD / 2), nn = k % (KD / 2);
            pre[i] = __builtin_nontemporal_load((const u32x4*)(p.dbase + (size_t)nn * p.dstride + ri * 512 + c8 * 8)); } } }
    const int a = F.lane & 15, q = F.lane >> 4;
    for (; u < nunits; u += F.G) {
        const DftP p = dft_params<MODE>(F, u);
#pragma unroll
        for (int i = 0; i < NP; ++i) { const int pc = F.tid + 512 * i; if (pc < KD * 16) { const int k = pc >> 4, c8 = pc & 15; const u32x4 v = pre[i];
            LAS bf16* d = DT + (c8 * 8) * LD + (k ^ ((c8 & GM) << 3));
            d[0 * LD] = (bf16)(v.x & 0xffff); d[1 * LD] = (bf16)(v.x >> 16); d[2 * LD] = (bf16)(v.y & 0xffff); d[3 * LD] = (bf16)(v.y >> 16);
            d[4 * LD] = (bf16)(v.z & 0xffff); d[5 * LD] = (bf16)(v.z >> 16); d[6 * LD] = (bf16)(v.w & 0xffff); d[7 * LD] = (bf16)(v.w >> 16); } }
        __syncthreads();
        if (u + F.G < nunits) { const DftP pn = dft_params<MODE>(F, u + F.G);
#pragma unroll
            for (int i = 0; i < NP; ++i) { const int pc = F.tid + 512 * i; if (pc < KD * 16) { const int k = pc >> 4, c8 = pc & 15, ri = k / (KD / 2), nn = k % (KD / 2);
                pre[i] = __builtin_nontemporal_load((const u32x4*)(pn.dbase + (size_t)nn * pn.dstride + ri * 512 + c8 * 8)); } } }
        for (int task = F.wave; task < (MD / 16) * 2; task += NWAVES) {
            const int mt = task >> 1, cht = task & 1;
            f32x4 acc[4];
#pragma unroll
            for (int ct = 0; ct < 4; ++ct) acc[ct] = (f32x4){0.f, 0.f, 0.f, 0.f};
#pragma unroll
            for (int ks = 0; ks < KD / 32; ++ks) {
                const bf16x8 bw = *(const bf16x8*)(p.W + (size_t)(mt * 16 + a) * KD + ks * 32 + 8 * q);
#pragma unroll
                for (int ct = 0; ct < 4; ++ct) {
                    const int ch = cht * 64 + 16 * (a >> 2) + 4 * ct + (a & 3);
                    const bf16x8 av = *(const LAS bf16x8*)(DT + ch * LD + ((ks * 32 + 8 * q) ^ (((ch >> 3) & GM) << 3)));
                    acc[ct] = __builtin_amdgcn_mfma_f32_16x16x32_bf16(av, bw, acc[ct], 0, 0, 0);
                }
            }
            const int m = mt * 16 + a, rm = m / J, j = m % J;
            bf16* o = p.obase + (size_t)j * p.ostride + rm * 512 + cht * 64 + 16 * q;
            u32x4 w0, w1;
            w0.x = pk2(acc[0][0], acc[0][1]); w0.y = pk2(acc[0][2], acc[0][3]); w0.z = pk2(acc[1][0], acc[1][1]); w0.w = pk2(acc[1][2], acc[1][3]);
            w1.x = pk2(acc[2][0], acc[2][1]); w1.y = pk2(acc[2][2], acc[2][3]); w1.z = pk2(acc[3][0], acc[3][1]); w1.w = pk2(acc[3][2], acc[3][3]);
            *(u32x4*)o = w0; *(u32x4*)(o + 8) = w1;
        }
        __syncthreads();
    }
}

template <int MODE, int NR>
__device__ __forceinline__ void dft_units_a(Frame& F, int nunits) {
    constexpr int KD = 2 * NR, MD = 2 * NR, J = NR, LD = KD + 8, GM = KD / 8 - 1, ULD = 136;
    constexpr int NP = (NR * 16 + 511) / 512;
    LAS bf16* FDl = (LAS bf16*)F.lds; LAS bf16* U = (LAS bf16*)(F.lds + 69632); LAS bf16* DT = (LAS bf16*)(F.lds + 69632 + 64 * ULD * 2);
    { const bf16* FD = (const bf16*)(F.ws + WS_FD);
      for (int p = F.tid; p < 256 * 16; p += 512) { const int r = p >> 4, c8 = p & 15; *(LAS u32x4*)(FDl + r * ULD + 8 * c8) = *(const u32x4*)(FD + r * 128 + 8 * c8); } }
    u32x4 pre[NP];
    int u = F.vcu;
    if (u < nunits) { const DftP p = dft_params<MODE>(F, u);
#pragma unroll
        for (int i = 0; i < NP; ++i) { const int pc = F.tid + 512 * i; if (pc < NR * 16) pre[i] = __builtin_nontemporal_load((const u32x4*)(p.dbase + (size_t)(pc >> 4) * p.dstride + (pc & 15) * 8)); } }
    const int a = F.lane & 15, q = F.lane >> 4;
    for (; u < nunits; u += F.G) {
        const DftP p = dft_params<MODE>(F, u);
#pragma unroll
        for (int i = 0; i < NP; ++i) { const int pc = F.tid + 512 * i; if (pc < NR * 16) *(LAS u32x4*)(U + (pc >> 4) * ULD + (pc & 15) * 8) = pre[i]; }
        __syncthreads();
        if (u + F.G < nunits) { const DftP pn = dft_params<MODE>(F, u + F.G);
#pragma unroll
            for (int i = 0; i < NP; ++i) { const int pc = F.tid + 512 * i; if (pc < NR * 16) pre[i] = __builtin_nontemporal_load((const u32x4*)(pn.dbase + (size_t)(pc >> 4) * pn.dstride + (pc & 15) * 8)); } }
        {
            f32x4 acc[NR / 16][2];
#pragma unroll
            for (int mt = 0; mt < NR / 16; ++mt) { acc[mt][0] = (f32x4){0.f, 0.f, 0.f, 0.f}; acc[mt][1] = (f32x4){0.f, 0.f, 0.f, 0.f}; }
#pragma unroll
            for (int ks = 0; ks < 4; ++ks) {
                const bf16x8 b0 = *(const LAS bf16x8*)(FDl + ((2 * F.wave) * 16 + a) * ULD + ks * 32 + 8 * q), b1 = *(const LAS bf16x8*)(FDl + ((2 * F.wave + 1) * 16 + a) * ULD + ks * 32 + 8 * q);
#pragma unroll
                for (int mt = 0; mt < NR / 16; ++mt) { const bf16x8 av = *(const LAS bf16x8*)(U + (mt * 16 + a) * ULD + ks * 32 + 8 * q);
                    acc[mt][0] = __builtin_amdgcn_mfma_f32_16x16x32_bf16(av, b0, acc[mt][0], 0, 0, 0); acc[mt][1] = __builtin_amdgcn_mfma_f32_16x16x32_bf16(av, b1, acc[mt][1], 0, 0, 0); }
            }
#pragma unroll
            for (int t = 0; t < 2; ++t) { const int col = (2 * F.wave + t) * 16 + a, ri = col >> 7, k2 = col & 127;
#pragma unroll
                for (int mt = 0; mt < NR / 16; ++mt) { const int k0 = ri * NR + 16 * mt + 4 * q;
                    u32x2 w; w.x = pk2(acc[mt][t][0], acc[mt][t][1]); w.y = pk2(acc[mt][t][2], acc[mt][t][3]);
                    *(LAS u32x2*)(DT + k2 * LD + (k0 ^ (((k2 >> 3) & GM) << 3))) = w; } }
        }
        __syncthreads();
        for (int task = F.wave; task < (MD / 16) * 2; task += NWAVES) {
            const int mt = task >> 1, cht = task & 1;
            f32x4 acc[4];
#pragma unroll
            for (int ct = 0; ct < 4; ++ct) acc[ct] = (f32x4){0.f, 0.f, 0.f, 0.f};
#pragma unroll
            for (int ks = 0; ks < KD / 32; ++ks) {
                const bf16x8 bw = *(const bf16x8*)(p.W + (size_t)(mt * 16 + a) * KD + ks * 32 + 8 * q);
#pragma unroll
                for (int ct = 0; ct < 4; ++ct) {
                    const int ch = cht * 64 + 16 * (a >> 2) + 4 * ct + (a & 3);
                    const bf16x8 av = *(const LAS bf16x8*)(DT + ch * LD + ((ks * 32 + 8 * q) ^ (((ch >> 3) & GM) << 3)));
                    acc[ct] = __builtin_amdgcn_mfma_f32_16x16x32_bf16(av, bw, acc[ct], 0, 0, 0);
                }
            }
            const int m = mt * 16 + a, rm = m / J, j = m % J;
            bf16* o = p.obase + (size_t)j * p.ostride + rm * 512 + cht * 64 + 16 * q;
            u32x4 w0, w1;
            w0.x = pk2(acc[0][0], acc[0][1]); w0.y = pk2(acc[0][2], acc[0][3]); w0.z = pk2(acc[1][0], acc[1][1]); w0.w = pk2(acc[1][2], acc[1][3]);
            w1.x = pk2(acc[2][0], acc[2][1]); w1.y = pk2(acc[2][2], acc[2][3]); w1.z = pk2(acc[3][0], acc[3][1]); w1.w = pk2(acc[3][2], acc[3][3]);
            *(u32x4*)o = w0; *(u32x4*)(o + 8) = w1;
        }
        __syncthreads();
    }
}

__device__ __forceinline__ void phase_fourier_a_conv(Frame& F) {
    const bf16* P = (const bf16*)(F.ws + WS_BUFP);
    dft_units_a<0, 64>(F, 2048);
    __syncthreads();
    dft_units_a<1, 16>(F, 512);
    bf16* MIX = (bf16*)(F.ws + WS_BUFA);
    const float* cw = F.in[I_ECONV];
    float w0[8], w1[8], w2[8];
#pragma unroll
    for (int i = 0; i < 8; ++i) { w0[i] = cw[8 * F.lane + i]; w1[i] = cw[512 + 8 * F.lane + i]; w2[i] = cw[1024 + 8 * F.lane + i]; }
    const int gw = F.vcu * NWAVES + F.wave, NGW = F.G * NWAVES;
    auto conv_tokens = [&](int t, auto ntc) {
        constexpr int NT = decltype(ntc)::value;
        int pos, len; if (t < TL) { pos = t & 4095; len = 4096; } else { pos = (t - TL) & 255; len = 256; }
        const bf16* row = P + (size_t)t * EIN + 8 * F.lane;
        u32x4 gb[NT], gc[NT + 2], uc[NT + 2];
#pragma unroll
        for (int d = 0; d < NT + 2; ++d) { const int pp = pos + d - 1;
            if (pp >= 0 && pp < len) { gc[d] = *(const u32x4*)(row + (ptrdiff_t)(d - 1) * EIN + 1024); uc[d] = *(const u32x4*)(row + (ptrdiff_t)(d - 1) * EIN + 1536); }
            else { gc[d] = (u32x4){0u, 0u, 0u, 0u}; uc[d] = (u32x4){0u, 0u, 0u, 0u}; } }
#pragma unroll
        for (int q = 0; q < NT; ++q) gb[q] = __builtin_nontemporal_load((const u32x4*)(row + (size_t)q * EIN + 512));
        float pl[NT + 2][8];
#pragma unroll
        for (int d = 0; d < NT + 2; ++d)
#pragma unroll
            for (int i = 0; i < 4; ++i) { pl[d][2 * i] = bflo(gc[d][i]) * bflo(uc[d][i]); pl[d][2 * i + 1] = bfhi(gc[d][i]) * bfhi(uc[d][i]); }
#pragma unroll
        for (int q = 0; q < NT; ++q) {
            float y[8];
#pragma unroll
            for (int i = 0; i < 4; ++i) {
                y[2 * i] = bflo(gb[q][i]) * (w0[2 * i] * pl[q][2 * i] + w1[2 * i] * pl[q + 1][2 * i] + w2[2 * i] * pl[q + 2][2 * i]);
                y[2 * i + 1] = bfhi(gb[q][i]) * (w0[2 * i + 1] * pl[q][2 * i + 1] + w1[2 * i + 1] * pl[q + 1][2 * i + 1] + w2[2 * i + 1] * pl[q + 2][2 * i + 1]);
            }
            u32x4 o; o.x = pk2(y[0], y[1]); o.y = pk2(y[2], y[3]); o.z = pk2(y[4], y[5]); o.w = pk2(y[6], y[7]);
            *(u32x4*)(MIX + (size_t)(t + q) * D + 512 + 8 * F.lane) = o;
        }
    };
    for (int t = 4 * gw; t < TL; t += 4 * NGW) conv_tokens(t, std::integral_constant<int, 4>{});
    for (int t = TL + gw; t < T; t += NGW) conv_tokens(t, std::integral_constant<int, 1>{});
}

__device__ __forceinline__ void phase_fourier_c(Frame& F) {
    dft_units<2, 128, 64, 64>(F, 2048);
    dft_units<3, 32, 16, 16>(F, 512);
}

constexpr int RW_LD = 1032;
__device__ __forceinline__ void phase_route(Frame& F, int layer, int ntok) {
    LAS bf16* rwh = (LAS bf16*)F.lds;
    LAS bf16* rwl = (LAS bf16*)(F.lds + 33024);
    LAS unsigned* cnt = (LAS unsigned*)(F.lds + 66048);
    LAS int* gb = (LAS int*)(F.lds + 66048 + 128);
    LAS float* lgs = (LAS float*)(F.lds + 66048 + 256) + F.wave * 256;
    LAS int* tinfo = (LAS int*)(F.lds + 66048 + 256 + 8192);
    LAS float* GS = (LAS float*)(F.lds + 81920);
    LAS float* SH = GS + 2048;
    const float* RW = F.in[I_RW];
    const int per = ntok / F.G, t0 = blockIdx.x * per, r0 = mod_row(t0);
    const float* mods = (const float*)(F.ws + WS_MODS) + (size_t)layer * 9 * 6144;
    const float* g = F.in[I_NFG] + layer * 1024;
    for (int i = F.tid; i < 16384; i += 512) { const int k = i >> 4, e = i & 15; const float w = RW[i]; const unsigned hi = f2bf(w); const float wl = w - __builtin_bit_cast(float, hi << 16);
        rwh[e * RW_LD + k] = (bf16)hi; rwl[e * RW_LD + k] = (bf16)f2bf(wl); }
    for (int i = F.tid; i < 2048; i += 512) { const int sl = i >> 10, c = i & 1023; const int rr = min(r0 + sl, 8); const float* m = mods + (size_t)rr * 6144;
        GS[i] = g[c] * (m[4 * 1024 + c] + 1.0f); SH[i] = m[3 * 1024 + c]; }
    if (F.tid < 16) cnt[F.tid] = 0u;
    __syncthreads();
    bf16* FB = (bf16*)(F.ws + WS_BUFA);
    const bool f8 = layer ? (FP8_G1_L1 != 0) : (FP8_G1_L0 != 0);
    int* route = (int*)(F.ws + WS_ROUTE);
    const int tk = F.lane & 15, kg = F.lane >> 4;
    for (int g0 = 16 * F.wave; g0 < per; g0 += 16 * NWAVES) {
        const int nv = min(16, per - g0);
        const int tq = t0 + g0 + (tk < nv ? tk : 0);
        const bf16* hr = h_row(F, tq) + 8 * kg;
        float s2 = 0.f;
        {
            u32x4 raw[32];
#pragma unroll
            for (int ks = 0; ks < 32; ++ks) raw[ks] = *(const u32x4*)(hr + 32 * ks);
#pragma unroll
            for (int ks = 0; ks < 32; ++ks)
#pragma unroll
                for (int i = 0; i < 4; ++i) { const float a = bflo(raw[ks][i]), b2 = bfhi(raw[ks][i]); s2 += a * a + b2 * b2; }
        }
        s2 += __shfl_xor(s2, 16); s2 += __shfl_xor(s2, 32);
        const float rstd = 1.0f / sqrtf(s2 * (1.0f / D) + EPS);
        const int sl = (mod_row(tq) != r0) ? 1024 : 0;
        const LAS float* gsp = GS + sl + 8 * kg; const LAS float* shp = SH + sl + 8 * kg;
        unsigned char* fb8 = (unsigned char*)FB + (size_t)tq * D + 8 * kg;
        bf16* fb16 = FB + (size_t)tq * D + 8 * kg;
        f32x4 acc = (f32x4){0.f, 0.f, 0.f, 0.f};
        u32x4 nx[8];
#pragma unroll
        for (int j = 0; j < 8; ++j) nx[j] = *(const u32x4*)(hr + 32 * j);
#pragma unroll 1
        for (int k4 = 0; k4 < 4; ++k4) {
            u32x4 cu[8];
#pragma unroll
            for (int j = 0; j < 8; ++j) cu[j] = nx[j];
            if (k4 < 3) {
#pragma unroll
                for (int j = 0; j < 8; ++j) nx[j] = *(const u32x4*)(hr + 32 * (8 * k4 + 8 + j)); }
#pragma unroll
            for (int j = 0; j < 8; ++j) {
                const int ks = 8 * k4 + j;
                const f32x4 g0v = *(const LAS f32x4*)(gsp + 32 * ks), g1v = *(const LAS f32x4*)(gsp + 32 * ks + 4), s0v = *(const LAS f32x4*)(shp + 32 * ks), s1v = *(const LAS f32x4*)(shp + 32 * ks + 4);
                float f[8];
                f[0] = bflo(cu[j].x) * rstd * g0v.x + s0v.x; f[1] = bfhi(cu[j].x) * rstd * g0v.y + s0v.y; f[2] = bflo(cu[j].y) * rstd * g0v.z + s0v.z; f[3] = bfhi(cu[j].y) * rstd * g0v.w + s0v.w;
                f[4] = bflo(cu[j].z) * rstd * g1v.x + s1v.x; f[5] = bfhi(cu[j].z) * rstd * g1v.y + s1v.y; f[6] = bflo(cu[j].w) * rstd * g1v.z + s1v.z; f[7] = bfhi(cu[j].w) * rstd * g1v.w + s1v.w;
                u32x4 hi, lo;
#pragma unroll
                for (int i = 0; i < 4; ++i) { const unsigned h0 = f2bf(f[2 * i]), h1 = f2bf(f[2 * i + 1]); hi[i] = h0 | (h1 << 16);
                    lo[i] = pk2(f[2 * i] - __builtin_bit_cast(float, h0 << 16), f[2 * i + 1] - __builtin_bit_cast(float, h1 << 16)); }
                if (tk < nv) {
                    if (f8) { u32x2 o; o.x = pg8::pk4_fp8(f[0], f[1], f[2], f[3]); o.y = pg8::pk4_fp8(f[4], f[5], f[6], f[7]); *(u32x2*)(fb8 + 32 * ks) = o; }
                    else *(u32x4*)(fb16 + 32 * ks) = hi;
                }
                const bf16x8 bh = *(const LAS bf16x8*)(rwh + tk * RW_LD + 32 * ks + 8 * kg), bl = *(const LAS bf16x8*)(rwl + tk * RW_LD + 32 * ks + 8 * kg);
                const bf16x8 ah = __builtin_bit_cast(bf16x8, hi), al = __builtin_bit_cast(bf16x8, lo);
                acc = __builtin_amdgcn_mfma_f32_16x16x32_bf16(ah, bh, acc, 0, 0, 0);
                acc = __builtin_amdgcn_mfma_f32_16x16x32_bf16(ah, bl, acc, 0, 0, 0);
                acc = __builtin_amdgcn_mfma_f32_16x16x32_bf16(al, bh, acc, 0, 0, 0);
            }
        }
#pragma unroll
        for (int j = 0; j < 4; ++j) lgs[(4 * kg + j) * 16 + tk] = acc[j];
        LDS_WAIT(); asm volatile("" ::: "memory");
        if (F.lane < nv) {
            const int tqq = t0 + g0 + F.lane;
            float aff[16], sel[16];
#pragma unroll
            for (int e4 = 0; e4 < 4; ++e4) { const f32x4 l4 = *(const LAS f32x4*)(lgs + F.lane * 16 + 4 * e4); const f32x4 b4 = *(const f32x4*)(F.in[I_RB] + 4 * e4);
                aff[4 * e4] = 1.0f / (1.0f + expf(-l4.x)); aff[4 * e4 + 1] = 1.0f / (1.0f + expf(-l4.y)); aff[4 * e4 + 2] = 1.0f / (1.0f + expf(-l4.z)); aff[4 * e4 + 3] = 1.0f / (1.0f + expf(-l4.w));
                sel[4 * e4] = aff[4 * e4] + b4.x; sel[4 * e4 + 1] = aff[4 * e4 + 1] + b4.y; sel[4 * e4 + 2] = aff[4 * e4 + 2] + b4.z; sel[4 * e4 + 3] = aff[4 * e4 + 3] + b4.w; }
            int best = 0; float bs = -1e30f;
#pragma unroll
            for (int gq = 0; gq < 4; ++gq) { const float a = sel[4 * gq], b = sel[4 * gq + 1], c = sel[4 * gq + 2], d = sel[4 * gq + 3];
                const float s = fmaxf(fmaxf(fmaxf(a + b, a + c), fmaxf(a + d, b + c)), fmaxf(b + d, c + d));
                if (s > bs) { bs = s; best = gq; } }
            float sv[4], av[4];
#pragma unroll
            for (int i = 0; i < 4; ++i) { sv[i] = sel[i]; av[i] = aff[i]; }
#pragma unroll
            for (int gq = 1; gq < 4; ++gq) if (best == gq) {
#pragma unroll
                for (int i = 0; i < 4; ++i) { sv[i] = sel[4 * gq + i]; av[i] = aff[4 * gq + i]; } }
            int i1 = 0; float s1 = sv[0], a1 = av[0];
#pragma unroll
            for (int i = 1; i < 4; ++i) if (sv[i] > s1) { s1 = sv[i]; a1 = av[i]; i1 = i; }
            int i2 = -1; float s2v = -1e30f, a2 = 0.f;
#pragma unroll
            for (int i = 0; i < 4; ++i) if (i != i1 && sv[i] > s2v) { s2v = sv[i]; a2 = av[i]; i2 = i; }
            const int e1 = 4 * best + i1, e2 = 4 * best + i2;
            const float wsum = a1 + a2, w1 = a1 / wsum, w2 = a2 / wsum;
            const unsigned r1 = atomicAdd((unsigned*)(cnt + e1), 1u), r2 = atomicAdd((unsigned*)(cnt + e2), 1u);
            int* ro = route + (size_t)tqq * 8;
            ro[0] = e1; ro[1] = e2; ro[4] = __builtin_bit_cast(int, w1); ro[5] = __builtin_bit_cast(int, w2);
            tinfo[4 * (tqq - t0) + 0] = e1; tinfo[4 * (tqq - t0) + 1] = e2; tinfo[4 * (tqq - t0) + 2] = (int)r1; tinfo[4 * (tqq - t0) + 3] = (int)r2;
        }
        LDS_WAIT(); asm volatile("" ::: "memory");
    }
    __syncthreads();
    if (F.tid < 16) gb[F.tid] = (int)__hip_atomic_fetch_add((unsigned*)(F.ws + WS_GCNT) + layer * 16 + F.tid, cnt[F.tid], __ATOMIC_RELAXED, __HIP_MEMORY_SCOPE_AGENT);
    __syncthreads();
    int* tokmap = (int*)(F.ws + WS_TOKMAP);
    for (int i = F.tid; i < per; i += 512) {
        const int e1 = tinfo[4 * i], e2 = tinfo[4 * i + 1], p1 = gb[e1] + tinfo[4 * i + 2], p2 = gb[e2] + tinfo[4 * i + 3];
        tokmap[(size_t)e1 * T + p1] = t0 + i; tokmap[(size_t)e2 * T + p2] = t0 + i;
        int* ro = route + (size_t)(t0 + i) * 8; ro[2] = p1; ro[3] = p2;
    }
}

__device__ __forceinline__ int moe_tables(Frame& F, int layer) {
    LAS int* tb = (LAS int*)(F.lds + LDS_CTL + 64); LAS int* cn = (LAS int*)(F.lds + LDS_CTL + 192);
    __syncthreads();
    if (F.tid < 16) cn[F.tid] = ld_coh((const int*)(F.ws + WS_GCNT) + layer * 16 + F.tid);
    __syncthreads();
    if (F.tid == 0) { int b = 0; for (int e = 0; e < 16; ++e) { tb[e] = b; b += (cn[e] + 255) >> 8; } tb[16] = b; }
    __syncthreads();
    return __builtin_amdgcn_readfirstlane(tb[16]);
}

template <int NQ> __device__ __forceinline__ void combine_tokens(Frame& F, int layer, int t) {
    const float* mods = (const float*)(F.ws + WS_MODS);
    const bf16* OS = (const bf16*)(F.ws + WS_BUFP);
    const int* route = (const int*)(F.ws + WS_ROUTE);
    const LAS int* tb = (const LAS int*)(F.lds + LDS_CTL + 64);
    bf16* A = (bf16*)(F.ws + WS_BUFA);
    {
        int rc[NQ][4]; float w0[NQ], w1[NQ];
#pragma unroll
        for (int q = 0; q < NQ; ++q) { const int* ro = route + (size_t)(t + q) * 8;
#pragma unroll
            for (int i = 0; i < 4; ++i) rc[q][i] = ld_coh(ro + i);
            w0[q] = ld_cohf((const float*)(ro + 4)); w1[q] = ld_cohf((const float*)(ro + 5)); }
        f32x4 v[NQ][4]; u32x2 oa[NQ][4], ob[NQ][4];
#pragma unroll
        for (int q = 0; q < NQ; ++q) { const bf16* hr = h_row(F, t + q);
            const size_t s0 = (size_t)(tb[rc[q][0]] * 256 + rc[q][2]) * D, s1 = (size_t)(tb[rc[q][1]] * 256 + rc[q][3]) * D;
#pragma unroll
            for (int j = 0; j < 4; ++j) { const int c = 4 * F.lane + 256 * j; { const u32x2 hv = *(const u32x2*)(hr + c); v[q][j] = (f32x4){bflo(hv.x), bfhi(hv.x), bflo(hv.y), bfhi(hv.y)}; } oa[q][j] = __builtin_nontemporal_load((const u32x2*)(OS + s0 + c)); ob[q][j] = __builtin_nontemporal_load((const u32x2*)(OS + s1 + c)); } }
        const int mr = mod_row(t);
        const float* m5 = mods + (size_t)(layer * 9 + mr) * 6144 + 5 * 1024;
#pragma unroll
        for (int j = 0; j < 4; ++j) { const f32x4 g5 = *(const f32x4*)(m5 + 4 * F.lane + 256 * j);
#pragma unroll
            for (int q = 0; q < NQ; ++q) { const u32x2 a = oa[q][j], b2 = ob[q][j];
                const f32x4 o = (f32x4){w0[q] * bflo(a.x) + w1[q] * bflo(b2.x), w0[q] * bfhi(a.x) + w1[q] * bfhi(b2.x), w0[q] * bflo(a.y) + w1[q] * bflo(b2.y), w0[q] * bfhi(a.y) + w1[q] * bfhi(b2.y)};
                v[q][j] = v[q][j] + g5 * o; } }
#pragma unroll
        for (int q = 0; q < NQ; ++q) {
            if (layer == 0) {
                bf16* hr = h_row(F, t + q);
#pragma unroll
                for (int j = 0; j < 4; ++j) { u32x2 o; o.x = pk2(v[q][j].x, v[q][j].y); o.y = pk2(v[q][j].z, v[q][j].w); *(u32x2*)(hr + 4 * F.lane + 256 * j) = o; }
                const float* m = mods + (size_t)(9 + mr) * 6144;
                norm_mod_store(v[q], F.in[I_NMG] + 1024, m, m + 1024, A + (size_t)(t + q) * D, F.lane);
            } else {
                float s2 = 0.f;
#pragma unroll
                for (int j = 0; j < 4; ++j) s2 += (v[q][j].x * v[q][j].x + v[q][j].y * v[q][j].y) + (v[q][j].z * v[q][j].z + v[q][j].w * v[q][j].w);
                const float rstd = 1.0f / sqrtf(wave_sum(s2) * (1.0f / D) + EPS);
                float* orow = F.out + (size_t)(t + q) * D;
#pragma unroll
                for (int j = 0; j < 4; ++j) { const int c = 4 * F.lane + 256 * j; __builtin_nontemporal_store(v[q][j] * rstd * *(const f32x4*)(F.in[I_FG] + c), (f32x4*)(orow + c)); }
            }
        }
    }
}
__device__ __forceinline__ void phase_combine(Frame& F, int layer, int ntok) {
    const int gw = F.vcu * NWAVES + F.wave, NGW = F.G * NWAVES;
    if (layer == 0) { for (int t = 2 * gw; t < TL; t += 2 * NGW) combine_tokens<2>(F, 0, t); for (int t = TL + gw; t < ntok; t += NGW) combine_tokens<1>(F, 0, t); }
    else { for (int t = 4 * gw; t < TL; t += 4 * NGW) combine_tokens<4>(F, 1, t); }
}

constexpr int KV_LD = 72, VL_OFF = 384 * KV_LD * 2, ROPE_LDS = 131072;
typedef short v4i16_t __attribute__((ext_vector_type(4)));

__device__ __forceinline__ bf16x8 rope_pack(const u32x4 x1, const u32x4 x2, const LAS float* cs, const LAS float* sn, float scale, bool second) {
    const f32x4 c0 = *(const LAS f32x4*)cs, c1 = *(const LAS f32x4*)(cs + 4), s0 = *(const LAS f32x4*)sn, s1 = *(const LAS f32x4*)(sn + 4);
    float c[8] = {c0.x, c0.y, c0.z, c0.w, c1.x, c1.y, c1.z, c1.w}, s[8] = {s0.x, s0.y, s0.z, s0.w, s1.x, s1.y, s1.z, s1.w};
    float a[8], b[8];
#pragma unroll
    for (int i = 0; i < 4; ++i) { a[2 * i] = bflo(x1[i]); a[2 * i + 1] = bfhi(x1[i]); b[2 * i] = bflo(x2[i]); b[2 * i + 1] = bfhi(x2[i]); }
    float o[8];
#pragma unroll
    for (int i = 0; i < 8; ++i) o[i] = (second ? (b[i] * c[i] + a[i] * s[i]) : (a[i] * c[i] - b[i] * s[i])) * scale;
    u32x4 w; w.x = pk2(o[0], o[1]); w.y = pk2(o[2], o[3]); w.z = pk2(o[4], o[5]); w.w = pk2(o[6], o[7]);
    return __builtin_bit_cast(bf16x8, w);
}

struct AttnU { int b, qb, kvh; };
__device__ __forceinline__ AttnU attn_unit_of(int u) { AttnU r; r.kvh = u & 1; r.qb = (u >> 1) & 31; r.b = u >> 6; return r; }

__device__ __forceinline__ void attn_load_latk(Frame& F, const bf16* P1, AttnU u, u32x4 (&lk)[2][4]) {
    const u32x4 z = (u32x4){0u, 0u, 0u, 0u};
#pragma unroll
    for (int it = 0; it < 2; ++it) { const int task = F.tid + 512 * it, kidx = task >> 1, hh = task & 1, pos = u.qb * 128 - 128 + kidx;
        const bool ok = task < 768 && pos >= 0 && pos < NSEQ;
        const bf16* row = P1 + (size_t)(u.b * NSEQ + (ok ? pos : 0)) * OIN + 1024 + u.kvh * 64 + 8 * hh;
#pragma unroll
        for (int st = 0; st < 4; ++st) lk[it][st] = ok ? *(const u32x4*)(row + 16 * st) : z; }
}
__device__ __forceinline__ void attn_load_latv(Frame& F, const bf16* P1, AttnU u, u32x4 (&lv)[6]) {
    const u32x4 z = (u32x4){0u, 0u, 0u, 0u};
#pragma unroll
    for (int it = 0; it < 6; ++it) { const int task = F.tid + 512 * it, kidx = task >> 3, c8 = task & 7, pos = u.qb * 128 - 128 + kidx;
        const bool ok = pos >= 0 && pos < NSEQ;
        lv[it] = ok ? *(const u32x4*)(P1 + (size_t)(u.b * NSEQ + (ok ? pos : 0)) * OIN + 1152 + u.kvh * 64 + 8 * c8) : z; }
}
__device__ __forceinline__ void attn_write_lat(Frame& F, AttnU u, const u32x4 (&lk)[2][4], const u32x4 (&lv)[6]) {
    LAS bf16* KL = (LAS bf16*)F.lds; LAS bf16* VL = (LAS bf16*)(F.lds + VL_OFF); const LAS float* rope = (const LAS float*)(F.lds + ROPE_LDS);
#pragma unroll
    for (int it = 0; it < 2; ++it) { const int task = F.tid + 512 * it, kidx = task >> 1, hh = task & 1; int pos = u.qb * 128 - 128 + kidx; pos = pos < 0 ? 0 : (pos > NSEQ - 1 ? NSEQ - 1 : pos);
        if (task < 768) {
            LAS bf16* d = KL + kidx * KV_LD + 8 * hh;
            const LAS float* c0 = rope + (pos >> 6) * 16 + 8 * hh; const LAS float* c1 = rope + (pos & 63) * 16 + 8 * hh;
            *(LAS bf16x8*)(d) = rope_pack(lk[it][0], lk[it][1], c0, c0 + 1024, 1.0f, false);
            *(LAS bf16x8*)(d + 16) = rope_pack(lk[it][0], lk[it][1], c0, c0 + 1024, 1.0f, true);
            *(LAS bf16x8*)(d + 32) = rope_pack(lk[it][2], lk[it][3], c1, c1 + 1024, 1.0f, false);
            *(LAS bf16x8*)(d + 48) = rope_pack(lk[it][2], lk[it][3], c1, c1 + 1024, 1.0f, true);
        } }
#pragma unroll
    for (int it = 0; it < 6; ++it) { const int task = F.tid + 512 * it, kidx = task >> 3, c8 = task & 7; *(LAS u32x4*)(VL + kidx * KV_LD + 8 * c8) = lv[it]; }
}
__device__ __forceinline__ void attn_load_ctx(Frame& F, const bf16* P1, AttnU u, u32x4 (&ck)[4], u32x4 (&cv)[4]) {
#pragma unroll
    for (int it = 0; it < 4; ++it) { const int task = F.tid + 512 * it, kidx = task >> 3, c8 = task & 7;
        const bf16* row = P1 + (size_t)(TL + u.b * LCTX + kidx) * OIN + 1024 + u.kvh * 64 + 8 * c8;
        ck[it] = *(const u32x4*)row; cv[it] = *(const u32x4*)(row + 128); }
}
__device__ __forceinline__ void attn_write_ctx(Frame& F, const u32x4 (&ck)[4], const u32x4 (&cv)[4]) {
    LAS bf16* KL = (LAS bf16*)F.lds; LAS bf16* VL = (LAS bf16*)(F.lds + VL_OFF);
#pragma unroll
    for (int it = 0; it < 4; ++it) { const int task = F.tid + 512 * it, kidx = task >> 3, c8 = task & 7;
        *(LAS u32x4*)(KL + kidx * KV_LD + 8 * c8) = ck[it]; *(LAS u32x4*)(VL + kidx * KV_LD + 8 * c8) = cv[it]; }
}

__device__ __forceinline__ unsigned cvtpk(float lo, float hi) { unsigned r; asm volatile("v_cvt_pk_bf16_f32 %0, %1, %2" : "=v"(r) : "v"(lo), "v"(hi)); return r; }
__device__ __forceinline__ float xhalf_max(float x) { const auto r = __builtin_amdgcn_permlane32_swap(__builtin_bit_cast(unsigned, x), __builtin_bit_cast(unsigned, x), false, false);
    return fmaxf(__builtin_bit_cast(float, r[0]), __builtin_bit_cast(float, r[1])); }
__device__ __forceinline__ float xhalf_sum(float x) { const auto r = __builtin_amdgcn_permlane32_swap(__builtin_bit_cast(unsigned, x), __builtin_bit_cast(unsigned, x), false, false);
    return __builtin_bit_cast(float, r[0]) + __builtin_bit_cast(float, r[1]); }
__device__ __forceinline__ void attn_tiles(Frame& F, int kt0, int kt1, int mk0, int mk1, const bf16x8 (&qf)[4], f32x16 (&O)[2], float& mrun, float& lrun, int qrel) {
    if (kt0 > kt1) return;
    const LAS bf16* KL = (const LAS bf16*)F.lds; const LAS bf16* VL = (const LAS bf16*)(F.lds + VL_OFF);
    const int r32 = F.lane & 31, hh = F.lane >> 5;
    const int q4 = (F.lane & 15) >> 2, p4 = F.lane & 3, blk = (F.lane >> 4) & 1;
    const LAS bf16* kp = KL + (kt0 * 32 + r32) * KV_LD + 8 * hh;
    const LAS bf16* vp = VL + (kt0 * 32 + 4 * hh + q4) * KV_LD + 16 * blk + 4 * p4;
    bf16x8 kn[4];
#pragma unroll
    for (int st = 0; st < 4; ++st) kn[st] = *(const LAS bf16x8*)(kp + 16 * st);
    for (int kt = kt0; kt <= kt1; ++kt) {
        bf16x8 kf[4];
#pragma unroll
        for (int st = 0; st < 4; ++st) kf[st] = kn[st];
        v4i16_t vlo[2][2], vhi[2][2];
#pragma unroll
        for (int dt = 0; dt < 2; ++dt)
#pragma unroll
            for (int s2 = 0; s2 < 2; ++s2) { vlo[dt][s2] = __builtin_amdgcn_ds_read_tr16_b64_v4i16((LAS v4i16_t*)(vp + (16 * s2) * KV_LD + dt * 32));
                vhi[dt][s2] = __builtin_amdgcn_ds_read_tr16_b64_v4i16((LAS v4i16_t*)(vp + (16 * s2 + 8) * KV_LD + dt * 32)); }
        kp += 32 * KV_LD; vp += 32 * KV_LD;
        if (kt < kt1) {
#pragma unroll
            for (int st = 0; st < 4; ++st) kn[st] = *(const LAS bf16x8*)(kp + 16 * st); }
        __builtin_amdgcn_sched_barrier(0);
        f32x16 s;
#pragma unroll
        for (int r = 0; r < 16; ++r) s[r] = 0.f;
#pragma unroll
        for (int st = 0; st < 4; ++st) s = __builtin_amdgcn_mfma_f32_32x32x16_bf16(kf[st], qf[st], s, 0, 0, 0);
        if (kt == mk0 || kt == mk1) {
#pragma unroll
            for (int r = 0; r < 16; ++r) { const int dlt = kt * 32 + (r & 3) + 8 * (r >> 2) + 4 * hh - qrel; s[r] = (dlt <= 128 && dlt >= -128) ? s[r] : -INFINITY; } }
        float mx = fmaxf(fmaxf(s[0], s[1]), fmaxf(s[2], s[3]));
#pragma unroll
        for (int r = 4; r < 16; r += 4) mx = fmaxf(mx, fmaxf(fmaxf(s[r], s[r + 1]), fmaxf(s[r + 2], s[r + 3])));
        mx = xhalf_max(mx);
        const float mnew = fmaxf(mrun, mx);
        float ps0 = 0.f, ps1 = 0.f;
#pragma unroll
        for (int r = 0; r < 16; r += 2) { s[r] = __builtin_amdgcn_exp2f(s[r] - mnew); s[r + 1] = __builtin_amdgcn_exp2f(s[r + 1] - mnew); ps0 += s[r]; ps1 += s[r + 1]; }
        const float ps = xhalf_sum(ps0 + ps1);
        if (__any(mnew > mrun)) {
            const float alpha = __builtin_amdgcn_exp2f(mrun - mnew);
            lrun *= alpha;
#pragma unroll
            for (int dt = 0; dt < 2; ++dt)
#pragma unroll
                for (int r = 0; r < 16; ++r) O[dt][r] *= alpha;
        }
        lrun += ps; mrun = mnew;
        bf16x8 pb[2];
#pragma unroll
        for (int s2 = 0; s2 < 2; ++s2) { u32x4 w; w.x = cvtpk(s[8 * s2 + 0], s[8 * s2 + 1]); w.y = cvtpk(s[8 * s2 + 2], s[8 * s2 + 3]); w.z = cvtpk(s[8 * s2 + 4], s[8 * s2 + 5]); w.w = cvtpk(s[8 * s2 + 6], s[8 * s2 + 7]);
            pb[s2] = __builtin_bit_cast(bf16x8, w); }
#pragma unroll
        for (int dt = 0; dt < 2; ++dt)
#pragma unroll
            for (int s2 = 0; s2 < 2; ++s2) {
                const bf16x8 va = (bf16x8){vlo[dt][s2][0], vlo[dt][s2][1], vlo[dt][s2][2], vlo[dt][s2][3], vhi[dt][s2][0], vhi[dt][s2][1], vhi[dt][s2][2], vhi[dt][s2][3]};
                O[dt] = __builtin_amdgcn_mfma_f32_32x32x16_bf16(va, pb[s2], O[dt], 0, 0, 0);
            }
    }
}

__device__ __forceinline__ void phase_attn(Frame& F) {
    const bf16* P1 = (const bf16*)(F.ws + WS_BUFP);
    bf16* MIX = (bf16*)(F.ws + WS_BUFA);
    const int r32 = F.lane & 31, hh = F.lane >> 5;
    constexpr float QSC = 0.125f * 1.4426950408889634f;
    LAS float* ropel = (LAS float*)(F.lds + ROPE_LDS);
    for (int i = F.tid; i < 2048; i += 512) ropel[i] = ((const float*)(F.ws + WS_ROPE))[i];
    u32x4 lk[2][4], lv[6], ck[4], cv[4];
    const int nu = (512 - F.vcu + F.G - 1) / F.G;
    if (nu > 0) attn_load_latk(F, P1, attn_unit_of(F.vcu), lk);
    for (int ui = 0; ui < nu; ++ui) {
        const AttnU u = attn_unit_of(F.vcu + ui * F.G);
        u32x4 qr[2][4];
#pragma unroll
        for (int i = 0; i < 2; ++i) { const int task = F.wave + 8 * i, g = task & 3, sub = task >> 2, head = u.kvh * 4 + g, pos = u.qb * 128 + 32 * sub + r32;
            const bf16* row = P1 + (size_t)(u.b * NSEQ + pos) * OIN + 512 + head * 64 + 8 * hh;
#pragma unroll
            for (int st = 0; st < 4; ++st) qr[i][st] = __builtin_nontemporal_load((const u32x4*)(row + 16 * st)); }
        attn_load_latv(F, P1, u, lv);
        __syncthreads();
        attn_write_lat(F, u, lk, lv);
        bf16x8 qf[2][4]; f32x16 O[2][2]; float mrun[2], lrun[2];
#pragma unroll
        for (int i = 0; i < 2; ++i) { const int task = F.wave + 8 * i, g = task & 3, sub = task >> 2, head = u.kvh * 4 + g, pos = u.qb * 128 + 32 * sub + r32;
            const LAS float* c0 = ropel + (pos >> 6) * 16 + 8 * hh; const LAS float* c1 = ropel + (pos & 63) * 16 + 8 * hh;
            qf[i][0] = rope_pack(qr[i][0], qr[i][1], c0, c0 + 1024, QSC, false); qf[i][1] = rope_pack(qr[i][0], qr[i][1], c0, c0 + 1024, QSC, true);
            qf[i][2] = rope_pack(qr[i][2], qr[i][3], c1, c1 + 1024, QSC, false); qf[i][3] = rope_pack(qr[i][2], qr[i][3], c1, c1 + 1024, QSC, true);
            mrun[i] = F.in[I_OSINK][head] * 1.4426950408889634f; lrun[i] = 1.0f;
#pragma unroll
            for (int dt = 0; dt < 2; ++dt)
#pragma unroll
                for (int r = 0; r < 16; ++r) O[i][dt][r] = 0.f; }
        __syncthreads();
        const int kt_lo = (u.qb == 0) ? 4 : 0, kt_hi = (u.qb == 31) ? 7 : 11;
#pragma unroll
        for (int i = 0; i < 2; ++i) { const int sub = (F.wave + 8 * i) >> 2, qrel = 128 + 32 * sub + r32;
            attn_tiles(F, max(sub, kt_lo), min(sub + 8, kt_hi), sub, sub + 8, qf[i], O[i], mrun[i], lrun[i], qrel); }
        attn_load_ctx(F, P1, u, ck, cv);
        __syncthreads();
        attn_write_ctx(F, ck, cv);
        __syncthreads();
        if (ui + 1 < nu) attn_load_latk(F, P1, attn_unit_of(F.vcu + (ui + 1) * F.G), lk);
#pragma unroll
        for (int i = 0; i < 2; ++i) {
            attn_tiles(F, 0, 7, -1, -1, qf[i], O[i], mrun[i], lrun[i], 0);
            const int task = F.wave + 8 * i, g = task & 3, sub = task >> 2, head = u.kvh * 4 + g, pos = u.qb * 128 + 32 * sub + r32;
            const float inv = 1.0f / lrun[i];
            bf16* o = MIX + (size_t)(u.b * NSEQ + pos) * D + 512 + head * 64 + 4 * hh;
#pragma unroll
            for (int dt = 0; dt < 2; ++dt)
#pragma unroll
                for (int rg = 0; rg < 4; ++rg) { u32x2 w; w.x = pk2(O[i][dt][4 * rg] * inv, O[i][dt][4 * rg + 1] * inv); w.y = pk2(O[i][dt][4 * rg + 2] * inv, O[i][dt][4 * rg + 3] * inv);
                    *(u32x2*)(o + dt * 32 + 8 * rg) = w; }
        }
    }
    __syncthreads();
}

__device__ __forceinline__ void phase_pool_stencil(Frame& F) {
    const bf16* P1 = (const bf16*)(F.ws + WS_BUFP);
    bf16* MIX = (bf16*)(F.ws + WS_BUFA);
    const int gw = F.vcu * NWAVES + F.wave, NGW = F.G * NWAVES;
    const int r = 1 << (F.lane >> 4);
    constexpr int NT = 8, NR = NT + 16;
    for (int t = NT * gw; t < TL; t += NT * NGW) {
        const int pos = t & 4095;
        const bf16* base = P1 + (size_t)t * OIN + 8 * F.lane;
        u32x4 v[NR];
#pragma unroll
        for (int jj = 0; jj < NR; ++jj) { const int pj = pos + jj - 8; const bool ok = pj >= 0 && pj < NSEQ; v[jj] = ok ? *(const u32x4*)(base + (ptrdiff_t)(jj - 8) * OIN) : (u32x4){0u, 0u, 0u, 0u}; }
        float acc[NT][8];
#pragma unroll
        for (int q = 0; q < NT; ++q)
#pragma unroll
            for (int i = 0; i < 8; ++i) acc[q][i] = 0.f;
#pragma unroll
        for (int jj = 0; jj < NR; ++jj) {
            float x[8];
#pragma unroll
            for (int i = 0; i < 4; ++i) { x[2 * i] = bflo(v[jj][i]); x[2 * i + 1] = bfhi(v[jj][i]); }
#pragma unroll
            for (int q = 0; q < NT; ++q) { const int dd = jj - 8 - q; if (dd >= -8 && dd <= 8) { const float w = (dd <= r && dd >= -r) ? 1.0f : 0.0f;
#pragma unroll
                for (int i = 0; i < 8; ++i) acc[q][i] += w * x[i]; } }
        }
#pragma unroll
        for (int q = 0; q < NT; ++q) {
            const int pq = pos + q, lo = max(pq - r, 0), hi = min(pq + r + 1, NSEQ);
            const float ic = 1.0f / (float)(hi - lo);
            const u32x4 sv = v[q + 8];
            u32x4 o;
#pragma unroll
            for (int i = 0; i < 4; ++i) o[i] = pk2(acc[q][2 * i] * ic - bflo(sv[i]), acc[q][2 * i + 1] * ic - bfhi(sv[i]));
            *(u32x4*)(MIX + (size_t)(t + q) * D + 8 * F.lane) = o;
        }
    }
}

__device__ __forceinline__ void phase_attn_pool(Frame& F) {
    phase_attn(F);
#ifdef DBG_ATTN2
    phase_attn(F);
#endif
    phase_pool_stencil(F);
}

constexpr int NPHASE = 20;
__global__ void __launch_bounds__(NWAVES * 64, 2) mk_fwd(Args args) {
    extern __shared__ __attribute__((aligned(16))) unsigned char lds_raw[];
    Frame F;
    F.lds = (LAS unsigned char*)lds_raw;
    F.tid = threadIdx.x; F.lane = F.tid & 63; F.wave = __builtin_amdgcn_readfirstlane(F.tid >> 6);
    F.G = gridDim.x; { const int bx = blockIdx.x; F.vcu = (F.G % 8 == 0) ? (bx % 8) * (F.G / 8) + bx / 8 : bx; }
    F.ws = args.ws; F.in = args.in; F.out = args.out;
    for (int u = F.tid; u < (LDS_BYTES - LDS_CTL) / 4; u += NWAVES * 64) ((LAS unsigned*)(F.lds + LDS_CTL))[u] = 0u;
    __syncthreads();
    const int lo = args.ph_lo, hi = args.ph_hi;
    XcdBarrier bar; bar.bar = (unsigned*)(F.ws + WS_CTL); bar.x = 0; bar.st = nullptr;
    if (hi - lo > 1) bar = xcd_barrier_post((unsigned*)(F.ws + WS_CTL), (volatile LAS unsigned*)(F.lds + LDS_CTL));
#define IN(k) (lo <= (k) && (k) < hi)
#ifndef PHASE_MASK
#define PHASE_MASK 0xffffffffu
#endif
#define PH(k, ...) if constexpr (((PHASE_MASK >> (k)) & 1u) != 0u) if (IN(k)) { __VA_ARGS__ if constexpr (((DBG_DOUBLE >> (k)) & 1u) != 0u) { __VA_ARGS__ } }
#define SEAM(k) do { if (IN(k) && IN((k) + 1)) xcd_barrier(bar); } while (0)
    unsigned char* ws = F.ws;
    const float* mods = (const float*)(ws + WS_MODS);

    PH(0, { phase_mods(F); }) SEAM(0);
    PH(1, { phase_prologue_a(F); }) SEAM(1);
    PH(2, {
        pg8::SchedDense S{(const char*)(ws + WS_BUFA), (const char*)(ws + WS_W_EIN), 1024, 8, 136, 0, 1088, F.vcu, F.G};
        pg8::EpiStore E{(bf16*)(ws + WS_BUFP), EIN};
        pg8::gemm_phase<pg8::EpiStore, pg8::SchedDense>(F.lds, 1024, S, E);
    }) SEAM(2);
    PH(3, { phase_fourier_a_conv(F); }) SEAM(3);
    PH(4, { phase_fourier_c(F); }) SEAM(4);
    PH(5, {
        pg8::SchedDense S{(const char*)(ws + WS_BUFA), (const char*)(ws + WS_W_EOUT), 1024, 4, 136, 0, 544, F.vcu, F.G};
        pg8::EpiResid<true> E{F.in[I_X], F.in[I_CTX], (bf16*)(ws + WS_HB), mods + 2 * 1024};
        pg8::gemm_phase<pg8::EpiResid<true>, pg8::SchedDense>(F.lds, 1024, S, E);
    }) SEAM(5);
    PH(6, { phase_route(F, 0, T); }) SEAM(6);
    PH(7, {
        const int ntile = moe_tables(F, 0);
        if constexpr (FP8_G1_L0) {
            pg8::SchedMoe<true> S{(const char*)(ws + WS_BUFA), (const char*)(ws + WS_W_M1) + (size_t)0 * 32 * MiB, (const int*)(ws + WS_TOKMAP), (const LAS int*)(F.lds + LDS_CTL + 64), (const LAS int*)(F.lds + LDS_CTL + 192), 512, (size_t)MiB, ntile * 4, F.vcu, F.G};
            pg8::EpiSwiglu8 E{(unsigned char*)(ws + WS_BUFZ), pg8::W1_SCALE};
            pg8::gemm_phase<pg8::EpiSwiglu8, pg8::SchedMoe<true>, true>(F.lds, 512, S, E);
        } else {
            pg8::SchedMoe<true> S{(const char*)(ws + WS_BUFA), (const char*)(ws + WS_W_M1) + (size_t)0 * 32 * MiB, (const int*)(ws + WS_TOKMAP), (const LAS int*)(F.lds + LDS_CTL + 64), (const LAS int*)(F.lds + LDS_CTL + 192), 1024, (size_t)2 * MiB, ntile * 4, F.vcu, F.G};
            if constexpr (FP8_G2_L0) { pg8::EpiSwiglu8 E{(unsigned char*)(ws + WS_BUFZ), 1.0f}; pg8::gemm_phase<pg8::EpiSwiglu8, pg8::SchedMoe<true>>(F.lds, 1024, S, E); }
            else { pg8::EpiSwiglu E{(bf16*)(ws + WS_BUFZ)}; pg8::gemm_phase<pg8::EpiSwiglu, pg8::SchedMoe<true>>(F.lds, 1024, S, E); }
        }
    }) SEAM(7);
    PH(8, {
        const int ntile = moe_tables(F, 0);
        if constexpr (FP8_G2_L0) {
            pg8::SchedMoe<false> S{(const char*)(ws + WS_BUFZ), (const char*)(ws + WS_W_M2) + (size_t)0 * 16 * MiB, nullptr, (const LAS int*)(F.lds + LDS_CTL + 64), (const LAS int*)(F.lds + LDS_CTL + 192), 256, (size_t)512 * KiB, ntile * 4, F.vcu, F.G};
            pg8::EpiStoreS E{(bf16*)(ws + WS_BUFP), 1024, 1.0f / (pg8::HID_SCALE * pg8::W2_SCALE)};
            pg8::gemm_phase<pg8::EpiStoreS, pg8::SchedMoe<false>, true>(F.lds, 256, S, E);
        } else {
            pg8::SchedMoe<false> S{(const char*)(ws + WS_BUFZ), (const char*)(ws + WS_W_M2) + (size_t)0 * 16 * MiB, nullptr, (const LAS int*)(F.lds + LDS_CTL + 64), (const LAS int*)(F.lds + LDS_CTL + 192), 512, (size_t)MiB, ntile * 4, F.vcu, F.G};
            pg8::EpiStore E{(bf16*)(ws + WS_BUFP), 1024};
            pg8::gemm_phase<pg8::EpiStore, pg8::SchedMoe<false>>(F.lds, 512, S, E);
        }
    }) SEAM(8);
    PH(9, { (void)moe_tables(F, 0); phase_combine(F, 0, T); }) SEAM(9);
    PH(10, {
        pg8::SchedDense S{(const char*)(ws + WS_BUFA), (const char*)(ws + WS_W_OIN), 1024, 5, 128, 4, 648, F.vcu, F.G};
        pg8::EpiStore E{(bf16*)(ws + WS_BUFP), OIN};
        pg8::gemm_phase<pg8::EpiStore, pg8::SchedDense>(F.lds, 1024, S, E);
    }) SEAM(10);
    PH(11, { phase_attn_pool(F); }) SEAM(11);
    PH(12, {
        pg8::SchedDense S{(const char*)(ws + WS_BUFA), (const char*)(ws + WS_W_OOUT), 1024, 4, 128, 0, 512, F.vcu, F.G};
        pg8::EpiResid<false> E{nullptr, nullptr, (bf16*)(ws + WS_HB), mods + 9 * 6144 + 2 * 1024};
        pg8::gemm_phase<pg8::EpiResid<false>, pg8::SchedDense>(F.lds, 1024, S, E);
    }) SEAM(12);
    PH(13, { phase_route(F, 1, TL); }) SEAM(13);
    PH(14, {
        const int ntile = moe_tables(F, 1);
        if constexpr (FP8_G1_L1) {
            pg8::SchedMoe<true> S{(const char*)(ws + WS_BUFA), (const char*)(ws + WS_W_M1) + (size_t)1 * 32 * MiB, (const int*)(ws + WS_TOKMAP), (const LAS int*)(F.lds + LDS_CTL + 64), (const LAS int*)(F.lds + LDS_CTL + 192), 512, (size_t)MiB, ntile * 4, F.vcu, F.G};
            pg8::EpiSwiglu8 E{(unsigned char*)(ws + WS_BUFZ), pg8::W1_SCALE};
            pg8::gemm_phase<pg8::EpiSwiglu8, pg8::SchedMoe<true>, true>(F.lds, 512, S, E);
        } else {
            pg8::SchedMoe<true> S{(const char*)(ws + WS_BUFA), (const char*)(ws + WS_W_M1) + (size_t)1 * 32 * MiB, (const int*)(ws + WS_TOKMAP), (const LAS int*)(F.lds + LDS_CTL + 64), (const LAS int*)(F.lds + LDS_CTL + 192), 1024, (size_t)2 * MiB, ntile * 4, F.vcu, F.G};
            if constexpr (FP8_G2_L1) { pg8::EpiSwiglu8 E{(unsigned char*)(ws + WS_BUFZ), 1.0f}; pg8::gemm_phase<pg8::EpiSwiglu8, pg8::SchedMoe<true>>(F.lds, 1024, S, E); }
            else { pg8::EpiSwiglu E{(bf16*)(ws + WS_BUFZ)}; pg8::gemm_phase<pg8::EpiSwiglu, pg8::SchedMoe<true>>(F.lds, 1024, S, E); }
        }
    }) SEAM(14);
    PH(15, {
        const int ntile = moe_tables(F, 1);
        if constexpr (FP8_G2_L1) {
            pg8::SchedMoe<false> S{(const char*)(ws + WS_BUFZ), (const char*)(ws + WS_W_M2) + (size_t)1 * 16 * MiB, nullptr, (const LAS int*)(F.lds + LDS_CTL + 64), (const LAS int*)(F.lds + LDS_CTL + 192), 256, (size_t)512 * KiB, ntile * 4, F.vcu, F.G};
            pg8::EpiStoreS E{(bf16*)(ws + WS_BUFP), 1024, 1.0f / (pg8::HID_SCALE * pg8::W2_SCALE)};
            pg8::gemm_phase<pg8::EpiStoreS, pg8::SchedMoe<false>, true>(F.lds, 256, S, E);
        } else {
            pg8::SchedMoe<false> S{(const char*)(ws + WS_BUFZ), (const char*)(ws + WS_W_M2) + (size_t)1 * 16 * MiB, nullptr, (const LAS int*)(F.lds + LDS_CTL + 64), (const LAS int*)(F.lds + LDS_CTL + 192), 512, (size_t)MiB, ntile * 4, F.vcu, F.G};
            pg8::EpiStore E{(bf16*)(ws + WS_BUFP), 1024};
            pg8::gemm_phase<pg8::EpiStore, pg8::SchedMoe<false>>(F.lds, 512, S, E);
        }
    }) SEAM(15);
    PH(16, { (void)moe_tables(F, 1); phase_combine(F, 1, TL); }) SEAM(16);
#ifdef DBG_XBAR
    if (hi - lo > 1) { for (int xb = 0; xb < DBG_XBAR; ++xb) xcd_barrier(bar); }
#endif
#undef IN
#undef SEAM
}

extern "C" void kernel_launch(void* const* d_in, const int* in_sizes, int n_in, void* d_out, int out_size, void* d_ws, size_t ws_size, hipStream_t stream) {
    static int grid = 0;
    if (grid == 0) {
        if (n_in != 22 || ws_size < WS_END) { fprintf(stderr, "kernel_launch: unexpected inputs (n_in %d, ws %zu)\n", n_in, ws_size); grid = -1; return; }
        int dev = 0, cus = 0, per_cu = 0;
        if (hipGetDevice(&dev) != hipSuccess || hipDeviceGetAttribute(&cus, hipDeviceAttributeMultiprocessorCount, dev) != hipSuccess) { grid = -1; return; }
        if (hipFuncSetAttribute((const void*)mk_fwd, hipFuncAttributeMaxDynamicSharedMemorySize, LDS_BYTES) != hipSuccess) { fprintf(stderr, "kernel_launch: hipFuncSetAttribute failed\n"); grid = -1; return; }
        if (hipOccupancyMaxActiveBlocksPerMultiprocessor(&per_cu, (const void*)mk_fwd, NWAVES * 64, LDS_BYTES) != hipSuccess || per_cu < 1) { fprintf(stderr, "kernel_launch: occupancy query says %d\n", per_cu); }
        (void)hipGetLastError();
        grid = cus;
        if (grid != 256) { fprintf(stderr, "kernel_launch: %d CUs; this build assumes 256\n", grid); }
    }
    if (grid < 0) return;
    (void)hipMemsetAsync((char*)d_ws + WS_CTL, 0, CTL_ZERO_BYTES, stream);
    Args a{};
    for (int i = 0; i < 22; ++i) a.in[i] = (const float*)d_in[i];
    a.out = (float*)d_out; a.ws = (unsigned char*)d_ws;
#if MK_MULTI
    for (int p = 0; p <= DBG_STOP; ++p) { a.ph_lo = p; a.ph_hi = p + 1; hipLaunchKernelGGL(mk_fwd, dim3(grid), dim3(NWAVES * 64), LDS_BYTES, stream, a); }
    if (DBG_STOP < 16) { a.ph_lo = 17; a.ph_hi = 18; hipLaunchKernelGGL(mk_fwd, dim3(grid), dim3(NWAVES * 64), LDS_BYTES, stream, a); }
#else
    a.ph_lo = 0; a.ph_hi = 17;
    hipLaunchKernelGGL(mk_fwd, dim3(grid), dim3(NWAVES * 64), LDS_BYTES, stream, a);
#endif
}
```

```cpp
#include <hip/hip_runtime.h>
#include <cstdio>
#include <cstdint>
#include <type_traits>

#ifndef MK_MULTI
#define MK_MULTI 0
#endif
#ifndef DBG_STOP
#define DBG_STOP 16
#endif

#ifndef DBG_DOUBLE
#define DBG_DOUBLE 0u
#endif
#ifndef FP8_G1_L0
#define FP8_G1_L0 1
#endif
#ifndef FP8_G1_L1
#define FP8_G1_L1 1
#endif
#ifndef FP8_G2_L0
#define FP8_G2_L0 1
#endif
#ifndef FP8_G2_L1
#define FP8_G2_L1 1
#endif
#define LAS __attribute__((address_space(3)))
#define GAS __attribute__((address_space(1)))
typedef unsigned short bf16;
typedef short bf16x8 __attribute__((ext_vector_type(8)));
typedef short s16x4 __attribute__((ext_vector_type(4)));
typedef float f32x4 __attribute__((ext_vector_type(4)));
typedef float f32x16 __attribute__((ext_vector_type(16)));
typedef unsigned u32x4 __attribute__((ext_vector_type(4)));
typedef unsigned u32x2 __attribute__((ext_vector_type(2)));

constexpr int NB = 8, NSEQ = 4096, D = 1024, LCTX = 256;
constexpr int TL = NB * NSEQ, TC = NB * LCTX, T = TL + TC;
constexpr int EIN = 2048;
constexpr int OIN = 1280;
constexpr int NE = 16, DE = 512;
constexpr int MAXSLOT = 73728;
constexpr float EPS = 1e-6f;

constexpr size_t KiB = 1024, MiB = 1024 * 1024;
constexpr size_t WS_CTL = 0, CTL_ZERO_BYTES = 64 * KiB;
constexpr size_t WS_MODS = 64 * KiB;
constexpr size_t WS_ROPE = WS_MODS + 512 * KiB;
constexpr size_t WS_WA = WS_ROPE + 8 * KiB;
constexpr size_t WS_WAC = WS_WA + 32 * KiB;
constexpr size_t WS_WCC = WS_WAC + 2 * KiB;
constexpr size_t WS_FD = 3 * MiB - 64 * KiB;
constexpr size_t WS_BCNT = WS_WCC + 16 * KiB;
constexpr size_t WS_TILEMAP = WS_BCNT + 16 * KiB;
constexpr size_t WS_SLOT = WS_TILEMAP + 2 * KiB;
constexpr size_t WS_WROW = WS_SLOT + 288 * KiB;
constexpr size_t WS_ROUTE = WS_WROW + 288 * KiB;
constexpr size_t WS_WC = 3 * MiB;
constexpr size_t WS_W_EIN = 4 * MiB;
constexpr size_t WS_W_EOUT = 9 * MiB;
constexpr size_t WS_W_OIN = 11 * MiB;
constexpr size_t WS_W_OOUT = 14 * MiB;
constexpr size_t WS_W_POOL = 16 * MiB;
constexpr size_t WS_W_M1 = 17 * MiB;
constexpr size_t WS_W_M2 = 81 * MiB;
constexpr size_t WS_HC = 113 * MiB;
constexpr size_t WS_BUFA = 121 * MiB;
constexpr size_t WS_BUFP = 189 * MiB;
constexpr size_t WS_BUFZ = 360 * MiB;
constexpr size_t WS_TOKMAP = 432 * MiB;
constexpr size_t WS_HB = 435 * MiB;
constexpr size_t WS_END = 503 * MiB;
constexpr size_t WS_GCNT = 16 * KiB;
static_assert(WS_ROUTE + (size_t)T * 32 <= WS_WC, "small region");
static_assert((size_t)T * EIN * 2 <= WS_BUFZ - WS_BUFP && (size_t)MAXSLOT * 1024 * 2 <= WS_BUFZ - WS_BUFP, "BUFP");
static_assert((size_t)MAXSLOT * 512 * 2 <= WS_TOKMAP - WS_BUFZ && (size_t)T * 1024 * 2 <= WS_TOKMAP - WS_BUFZ, "BUFZ");
static_assert((size_t)16 * T * 4 <= WS_HB - WS_TOKMAP && (size_t)T * 1024 * 2 <= WS_END - WS_HB, "TOKMAP / HB");
static_assert((size_t)T * 1024 * 2 <= WS_BUFP - WS_BUFA, "BUFA");

constexpr int LDS_BYTES = 163840;
constexpr int LDS_GIDX = 147456;
constexpr int LDS_CTL = 146432;
constexpr int NWAVES = 8;

__device__ __forceinline__ unsigned f2bf(float f) { unsigned u = __builtin_bit_cast(unsigned, f); return (u + 0x7fffu + ((u >> 16) & 1u)) >> 16; }
__device__ __forceinline__ unsigned pk2(float lo, float hi) { return f2bf(lo) | (f2bf(hi) << 16); }
__device__ __forceinline__ float bflo(unsigned w) { return __builtin_bit_cast(float, w << 16); }
__device__ __forceinline__ float bfhi(unsigned w) { return __builtin_bit_cast(float, w & 0xffff0000u); }
__device__ __forceinline__ float wave_sum(float v) {
#pragma unroll
    for (int o = 1; o < 64; o <<= 1) v += __shfl_xor(v, o);
    return v;
}
__device__ __forceinline__ int ld_coh(const int* p) { return (int)__hip_atomic_load((const unsigned*)p, __ATOMIC_RELAXED, __HIP_MEMORY_SCOPE_AGENT); }
__device__ __forceinline__ float ld_cohf(const float* p) { return __builtin_bit_cast(float, __hip_atomic_load((const unsigned*)p, __ATOMIC_RELAXED, __HIP_MEMORY_SCOPE_AGENT)); }
#define LDS_WAIT() asm volatile("s_waitcnt lgkmcnt(0)" ::: "memory")

#define XB_TMO      128
#define XB_XCNT(j)  (256  + 64 * (j))
#define XB_XSUB(j)  (1280 + 64 * (j))
#define XB_XGEN(j)  (2304 + 64 * (j))
#define XB_TOP      3328
#define XB_TOPGEN   3392
#define XCD_BAR_WORDS 3456
#define XB_SPIN_CAP (1u << 18)
__device__ __forceinline__ unsigned xb_ld(unsigned* p)              { return __hip_atomic_load(p, __ATOMIC_RELAXED, __HIP_MEMORY_SCOPE_AGENT); }
__device__ __forceinline__ unsigned xb_add(unsigned* p, unsigned v) { return __hip_atomic_fetch_add(p, v, __ATOMIC_RELAXED, __HIP_MEMORY_SCOPE_AGENT); }
__device__ __forceinline__ unsigned xb_xcc_id() { return (unsigned)__builtin_amdgcn_s_getreg((3 << 11) | 20) & 0xFu; }
#define XB_SPIN(cond, bar) do { unsigned _sp = 0; while (cond) { __builtin_amdgcn_s_sleep(1); \
    if ((++_sp & 255u) == 0u) { if (xb_ld(&(bar)[XB_TMO])) break; if (_sp > XB_SPIN_CAP) { atomicAdd(&(bar)[XB_TMO], 1u); break; } } } } while (0)
struct XcdBarrier { unsigned* bar; unsigned x; volatile LAS unsigned* st; };
__device__ __forceinline__ XcdBarrier xcd_barrier_post(unsigned* bar, volatile LAS unsigned* st) {
    XcdBarrier b; b.bar = bar; b.x = xb_xcc_id(); b.st = st;
    if (threadIdx.x == 0) (void)xb_add(&bar[XB_XCNT(b.x)], 1u);
    return b;
}
__device__ __forceinline__ void xcd_barrier_complete(unsigned* bar, unsigned x, unsigned& nloc, unsigned& nx) {
    const unsigned G = gridDim.x * gridDim.y * gridDim.z;
    unsigned sum, cnt, mine, sp = 0u;
    for (;;) {
        sum = 0u; cnt = 0u; mine = 0u;
#pragma unroll
        for (unsigned j = 0; j < 16; ++j) { const unsigned c = xb_ld(&bar[XB_XCNT(j)]); sum += c; cnt += (c > 0u) ? 1u : 0u; mine = (j == x) ? c : mine; }
        if (sum == G) break;
        __builtin_amdgcn_s_sleep(1);
        if ((++sp & 255u) == 0u) { if (xb_ld(&bar[XB_TMO])) break; if (sp > XB_SPIN_CAP) { atomicAdd(&bar[XB_TMO], 1u); break; } }
    }
    nloc = mine > 0u ? mine : 1u; nx = cnt > 0u ? cnt : 1u;
}
__device__ __forceinline__ void xcd_barrier(const XcdBarrier& b) {
    asm volatile("s_waitcnt vmcnt(0)" ::: "memory");
    __syncthreads();
    if (threadIdx.x == 0) {
        unsigned* bar = b.bar;
        __builtin_amdgcn_s_waitcnt(0);
        unsigned nloc = b.st[0], nx = b.st[1];
        if (nloc == 0u) { xcd_barrier_complete(bar, b.x, nloc, nx); b.st[0] = nloc; b.st[1] = nx; }
        const unsigned old = xb_add(&bar[XB_XSUB(b.x)], 1u);
        const unsigned gen = old / nloc;
        if (old + 1u == (gen + 1u) * nloc) {
            __builtin_amdgcn_fence(__ATOMIC_RELEASE, "agent");
            asm volatile("s_waitcnt vmcnt(0)" ::: "memory");
            const unsigned og = xb_add(&bar[XB_TOP], 1u);
            const unsigned tg = og / nx;
            if (og + 1u == (tg + 1u) * nx) xb_add(&bar[XB_TOPGEN], 1u);
            else XB_SPIN(xb_ld(&bar[XB_TOPGEN]) == tg, bar);
            __builtin_amdgcn_fence(__ATOMIC_ACQUIRE, "agent");
            xb_add(&bar[XB_XGEN(b.x)], 1u);
            asm volatile("s_waitcnt vmcnt(0)" ::: "memory");
        } else {
            XB_SPIN(xb_ld(&bar[XB_XGEN(b.x)]) == gen, bar);
            __builtin_amdgcn_fence(__ATOMIC_ACQUIRE, "agent");
            asm volatile("s_waitcnt vmcnt(0)" ::: "memory");
        }
    }
    __syncthreads();
}

namespace pg8 {
constexpr int BM = 256, BK = 64, HALF = 128, HTB = HALF * BK * 2, STAGE_BYTES = 8 * HTB;
__host__ __device__ __forceinline__ int lds_byte(int r, int c) { const int st = (r >> 4) * 2 + (c >> 5), rr = r & 15, cc = c & 31, ob = rr * 64 + cc * 2; return st * 1024 + (ob ^ (((ob >> 9) & 1) << 5)); }
__host__ __device__ __forceinline__ void stage_rc(int b, int& R, int& C) { const int st = b / 1024, sb = b % 1024, swz = sb ^ (((sb >> 9) & 1) << 5); R = (st >> 1) * 16 + swz / 64; C = (st & 1) * 32 + (swz % 64) / 2; }
__host__ __device__ __forceinline__ int perm32(int rho) { const int n = rho >> 4, i = rho & 15; return 8 * (i >> 2) + 4 * n + (i & 3); }
struct Unit { int pm, pn, e; };
__device__ __forceinline__ unsigned cvt_pk_bf16(float lo, float hi) { unsigned r; asm volatile("v_cvt_pk_bf16_f32 %0, %1, %2" : "=v"(r) : "v"(lo), "v"(hi)); return r; }

typedef int v8i32 __attribute__((ext_vector_type(8)));
typedef int v4i32 __attribute__((ext_vector_type(4)));
__device__ __forceinline__ v8i32 cat16(const bf16x8 lo, const bf16x8 hi) { return __builtin_shufflevector(__builtin_bit_cast(v4i32, lo), __builtin_bit_cast(v4i32, hi), 0, 1, 2, 3, 4, 5, 6, 7); }
template <class Epi, class Sched, bool FP8 = false>
__device__ __forceinline__ void gemm_phase(LAS unsigned char* lds, const int K, const Sched& S, const Epi& E) {
    const int tid = threadIdx.x, wid = __builtin_amdgcn_readfirstlane(tid >> 6), lane = tid & 63, wr = wid >> 2, wc = wid & 3, fr = lane & 15, fq = lane >> 4;
    const int nt = K / BK;
    int tidv = tid;
#define PG8_VB(i) ([&]() -> unsigned { int R_, C_; stage_rc(tidv * 16 + (i) * 8192, R_, C_); const int Rb_ = Epi::PERM ? ((R_ & ~31) + perm32(R_ & 31)) : R_; return (unsigned)(Rb_ * K + C_) * 2u; }())
#define PG8_VA(h, i) ([&]() -> unsigned { int R_, C_; stage_rc(tidv * 16 + (i) * 8192, R_, C_); return (unsigned)((128 * (h) + R_) * K + C_) * 2u; }())
    const size_t kstep = (size_t)(BK * 2);
    const size_t hstep = (size_t)HALF * K * 2;
    const unsigned ldsw = (unsigned)wid * 1024u;
#define aoff (lds_byte(wr * 64 + (tidv & 15), ((tidv >> 4) & 3) * 8))
#define boff (lds_byte(wc * 32 + (tidv & 15), ((tidv >> 4) & 3) * 8))
#define PG8_SA(b, h) (((b) * 2 + (h)) * HTB)
#define PG8_SB(b, h) ((4 + (b) * 2 + (h)) * HTB)
#define PG8_STAGEB(bufoff, gbase) do { _Pragma("unroll") for (int _i = 0; _i < 2; ++_i) \
        __builtin_amdgcn_global_load_lds((const unsigned*)((const char*)(gbase) + PG8_VB(_i)), (LAS unsigned*)(lds + (bufoff) + ldsw + _i * 8192), 16, 0, 0); } while (0)
#define PG8_STAGEA(bufoff, gbase, h, NEXT) do { _Pragma("unroll") for (int _i = 0; _i < 2; ++_i) { unsigned vo_; \
        if constexpr (Sched::GATHER) { int R_, C_; stage_rc(tidv * 16 + _i * 8192, R_, C_); const unsigned raw_ = gidx[((((NEXT) && usen) ? (gslot ^ 1u) : gslot) * 4u + (h) * 2 + _i) * 512u + tid]; vo_ = (raw_ * (unsigned)K + (unsigned)C_) * 2u; } \
        else vo_ = PG8_VA(h, _i); \
        __builtin_amdgcn_global_load_lds((const unsigned*)((const char*)(gbase) + vo_), (LAS unsigned*)(lds + (bufoff) + ldsw + _i * 8192), 16, 0, 0); } } while (0)
#define PG8_LDA(dst, b, h) do { _Pragma("unroll") for (int m = 0; m < 4; ++m) _Pragma("unroll") for (int k = 0; k < 2; ++k) dst[m][k] = *(const LAS bf16x8*)(lds + PG8_SA(b, h) + aoff + m * 2048 + k * 1024); } while (0)
#define PG8_LDB(dst, b, h) do { _Pragma("unroll") for (int n = 0; n < 2; ++n) _Pragma("unroll") for (int k = 0; k < 2; ++k) dst[n][k] = *(const LAS bf16x8*)(lds + PG8_SB(b, h) + boff + n * 2048 + k * 1024); } while (0)
#define PG8_MMA(ai, bj, At, Bt) do { __builtin_amdgcn_s_setprio(1); _Pragma("unroll") for (int m = 0; m < 4; ++m) _Pragma("unroll") for (int n = 0; n < 2; ++n) { \
        if constexpr (FP8) acc[ai][bj][m][n] = __builtin_amdgcn_mfma_scale_f32_16x16x128_f8f6f4(cat16(Bt[n][0], Bt[n][1]), cat16(At[m][0], At[m][1]), acc[ai][bj][m][n], 0, 0, 0, 0x7f7f7f7f, 0, 0x7f7f7f7f); \
        else { _Pragma("unroll") for (int k = 0; k < 2; ++k) acc[ai][bj][m][n] = __builtin_amdgcn_mfma_f32_16x16x32_bf16(Bt[n][k], At[m][k], acc[ai][bj][m][n], 0, 0, 0); } } \
        __builtin_amdgcn_s_setprio(0); } while (0)
#define PG8_WAIT_V(n) asm volatile("s_waitcnt vmcnt(" #n ")" ::: "memory")
#define PG8_WAIT_L(n) asm volatile("s_waitcnt lgkmcnt(" #n ")" ::: "memory")
#define PG8_BAR __builtin_amdgcn_s_barrier()
#define PG8_SCHED __builtin_amdgcn_sched_barrier(0)
#define PG8_ITER(A1, A2, A3, B2, B3) do { \
            PG8_LDB(B0, 0, 0); PG8_LDB(B1, 0, 1); PG8_SCHED; PG8_LDA(At, 0, 0); PG8_STAGEA(PG8_SA(1, 1), A1, 1, 0); \
            PG8_WAIT_V(8); PG8_WAIT_L(0); PG8_BAR; PG8_MMA(0, 0, At, B0); PG8_MMA(0, 1, At, B1); PG8_BAR; PG8_SCHED; \
            PG8_LDA(At, 0, 1); PG8_STAGEB(PG8_SB(0, 0), B2); PG8_STAGEB(PG8_SB(0, 1), (B2) + hstep); PG8_STAGEA(PG8_SA(0, 0), A2, 0, 1); \
            PG8_WAIT_V(8); PG8_WAIT_L(0); PG8_BAR; PG8_MMA(1, 0, At, B0); PG8_MMA(1, 1, At, B1); PG8_BAR; PG8_SCHED; \
            PG8_LDB(B0, 1, 0); PG8_LDB(B1, 1, 1); PG8_SCHED; PG8_LDA(At, 1, 0); PG8_STAGEA(PG8_SA(0, 1), A2, 1, 1); \
            PG8_WAIT_V(8); PG8_WAIT_L(0); PG8_BAR; PG8_MMA(0, 0, At, B0); PG8_MMA(0, 1, At, B1); PG8_BAR; PG8_SCHED; \
            PG8_LDA(At, 1, 1); PG8_STAGEB(PG8_SB(1, 0), B3); PG8_STAGEB(PG8_SB(1, 1), (B3) + hstep); PG8_STAGEA(PG8_SA(1, 0), A3, 0, 1); \
            PG8_WAIT_V(8); PG8_WAIT_L(0); PG8_BAR; PG8_MMA(1, 0, At, B0); PG8_MMA(1, 1, At, B1); PG8_BAR; PG8_SCHED; } while (0)
    Unit cur, nxt; int ui = 0;
    if (!S.next(0, cur)) return;
    f32x4 acc[2][2][4][2];
#pragma unroll
    for (int a = 0; a < 2; ++a)
#pragma unroll
        for (int b = 0; b < 2; ++b)
#pragma unroll
            for (int m = 0; m < 4; ++m)
#pragma unroll
                for (int n = 0; n < 2; ++n) acc[a][b][m][n] = (f32x4){0.f, 0.f, 0.f, 0.f};
    bf16x8 At[4][2], B0[2][2], B1[2][2];
    const LAS unsigned* gidx = (const LAS unsigned*)(lds + LDS_GIDX); unsigned gslot = 0u;
    if constexpr (Sched::GATHER) { S.idx_dma(cur, (LAS unsigned*)(lds + LDS_GIDX), tidv, wid); asm volatile("s_waitcnt vmcnt(0)" ::: "memory"); }
    const char* cA = S.a_base(cur); const char* cB = S.b_base(cur);
    constexpr bool usen = false;
    PG8_STAGEB(PG8_SB(0, 0), cB); PG8_STAGEB(PG8_SB(0, 1), cB + hstep); PG8_STAGEA(PG8_SA(0, 0), cA, 0, 0); PG8_STAGEA(PG8_SA(0, 1), cA, 1, 0);
    if (wr == 1) PG8_BAR;
    PG8_WAIT_V(2); PG8_BAR;
    PG8_STAGEB(PG8_SB(1, 0), cB + kstep); PG8_STAGEA(PG8_SA(1, 0), cA + kstep, 0, 0); PG8_STAGEB(PG8_SB(1, 1), cB + hstep + kstep);
    PG8_WAIT_V(6); PG8_BAR;
    for (;;) {
        const bool has_next = S.next(ui + 1, nxt);
        const char* nA = has_next ? S.a_base(nxt) : cA; const char* nB = has_next ? S.b_base(nxt) : cB;
#pragma unroll 1
        for (int t = 0; t < nt; t += 2) {
            const bool last = (t == nt - 2);
            const char* a1 = cA + (size_t)(t + 1) * kstep;
            const char* a2 = last ? nA : cA + (size_t)(t + 2) * kstep; const char* b2 = last ? nB : cB + (size_t)(t + 2) * kstep;
            tidv = tid; asm volatile("" : "+v"(tidv));
            if constexpr (Sched::GATHER) {
                if (t == nt - 4 && has_next) S.idx_dma(nxt, (LAS unsigned*)(lds + LDS_GIDX) + (gslot ^ 1u) * 2048u, tidv, wid);
            }
            const bool usen = last && has_next;
            PG8_ITER(a1, a2, a2 + kstep, b2, b2 + kstep);
        }
        if (wr == 0) PG8_BAR;
        E(acc, cur, wr, wc, fr, fq);
        if (!has_next) break;
#pragma unroll
        for (int a = 0; a < 2; ++a)
#pragma unroll
            for (int b = 0; b < 2; ++b)
#pragma unroll
                for (int m = 0; m < 4; ++m)
#pragma unroll
                    for (int n = 0; n < 2; ++n) acc[a][b][m][n] = (f32x4){0.f, 0.f, 0.f, 0.f};
        cur = nxt; cA = nA; cB = nB; ++ui;
        if constexpr (Sched::GATHER) gslot ^= 1u;
        if (wr == 1) PG8_BAR;
    }
    PG8_WAIT_V(0);
    PG8_BAR;
#undef PG8_ITER
#undef aoff
#undef boff
#undef PG8_SA
#undef PG8_SB
#undef PG8_STAGEA
#undef PG8_STAGEB
#undef PG8_VA
#undef PG8_VB
#undef PG8_LDA
#undef PG8_LDB
#undef PG8_MMA
#undef PG8_WAIT_V
#undef PG8_WAIT_L
#undef PG8_BAR
#undef PG8_SCHED
}

struct SchedDense {
    static constexpr bool GATHER = false;
    const char* A; const char* Bt; int K, nN, nMfull, pnx, nUnits, c, G;
    __device__ __forceinline__ bool next(int i, Unit& u) const {
        const int L = i * G + c; if (L >= nUnits) return false;
        const int full = nMfull * nN;
        if (L < full) { u.pm = L / nN; u.pn = L - u.pm * nN; } else { u.pm = nMfull + (L - full); u.pn = pnx; }
        u.e = 0; return true;
    }
    __device__ __forceinline__ const char* a_base(const Unit& u) const { return A + (size_t)u.pm * 256 * K * 2; }
    __device__ __forceinline__ const char* b_base(const Unit& u) const { return Bt + (size_t)u.pn * 256 * K * 2; }
};
template <bool GATHER_> struct SchedMoe {
    static constexpr bool GATHER = GATHER_, gather = GATHER_;
    const char* A; const char* W; const int* tokmap; const LAS int* tb; const LAS int* cn; int K; size_t wstride; int nUnits, c, G;
    __device__ __forceinline__ bool next(int i, Unit& u) const {
        const int L = i * G + c; if (L >= nUnits) return false;
        u.pm = L >> 2; u.pn = L & 3; int e = 0;
#pragma unroll
        for (int q = 1; q < 16; ++q) if (u.pm >= __builtin_amdgcn_readfirstlane(tb[q])) e = q;
        u.e = __builtin_amdgcn_readfirstlane(e); return true;
    }
    __device__ __forceinline__ const char* a_base(const Unit& u) const { return gather ? A : A + (size_t)u.pm * 256 * K * 2; }
    __device__ __forceinline__ const char* b_base(const Unit& u) const { return W + (size_t)u.e * wstride + (size_t)u.pn * 256 * K * 2; }
    __device__ __forceinline__ void idx_dma(const Unit& u, LAS unsigned* slot, int tidv, int wid) const {
        const int p0 = (u.pm - __builtin_amdgcn_readfirstlane(tb[u.e])) * 256, last = __builtin_amdgcn_readfirstlane(cn[u.e]) - 1; const int* tm = tokmap + (size_t)u.e * T;
#pragma unroll
        for (int h = 0; h < 2; ++h)
#pragma unroll
            for (int i = 0; i < 2; ++i) { int R_, C_; stage_rc(tidv * 16 + i * 8192, R_, C_); int pos = p0 + 128 * h + R_; pos = pos < last ? pos : last;
                __builtin_amdgcn_global_load_lds((const unsigned*)(tm + pos), slot + (h * 2 + i) * 512 + wid * 64, 4, 0, 0); }
    }
};

struct EpiStore {
    static constexpr bool PERM = true;
    bf16* O; int ldc;
    __device__ __forceinline__ void operator()(const f32x4 (&acc)[2][2][4][2], const Unit& u, int wr, int wc, int fr, int fq) const {
        const int row0 = u.pm * BM + wr * 64 + fr, col0 = u.pn * BM + wc * 32 + 8 * fq;
#pragma unroll
        for (int ai = 0; ai < 2; ++ai)
#pragma unroll
            for (int m = 0; m < 4; ++m) { bf16* rowp = O + (size_t)(row0 + ai * HALF + m * 16) * ldc + col0;
#pragma unroll
                for (int bj = 0; bj < 2; ++bj) { const f32x4 v0 = acc[ai][bj][m][0], v1 = acc[ai][bj][m][1];
                    u32x4 w; w.x = cvt_pk_bf16(v0[0], v0[1]); w.y = cvt_pk_bf16(v0[2], v0[3]); w.z = cvt_pk_bf16(v1[0], v1[1]); w.w = cvt_pk_bf16(v1[2], v1[3]);
                    *(u32x4*)(rowp + bj * HALF) = w; } }
    }
};
template <bool SRC_F32> struct EpiResid {
    static constexpr bool PERM = true;
    const float* srcL; const float* srcC; bf16* H; const float* gate;
    __device__ __forceinline__ void operator()(const f32x4 (&acc)[2][2][4][2], const Unit& u, int wr, int wc, int fr, int fq) const {
        const float* g = gate + (u.pm < 128 ? (u.pm >> 4) : 8) * 6144;
        const float* src = (u.pm < 128) ? srcL + (size_t)u.pm * 256 * 1024 : srcC + (size_t)(u.pm - 128) * 256 * 1024;
        bf16* dst = H + (size_t)u.pm * 256 * 1024;
        const int row0 = wr * 64 + fr, col0 = u.pn * BM + wc * 32 + 8 * fq;
        f32x4 gv[2][2];
#pragma unroll
        for (int bj = 0; bj < 2; ++bj)
#pragma unroll
            for (int n = 0; n < 2; ++n) gv[bj][n] = *(const f32x4*)(g + col0 + bj * HALF + 4 * n);
#pragma unroll
        for (int ai = 0; ai < 2; ++ai)
#pragma unroll
            for (int m = 0; m < 4; ++m) { const size_t ro = (size_t)(row0 + ai * HALF + m * 16) * 1024 + col0;
#pragma unroll
                for (int bj = 0; bj < 2; ++bj) {
                    f32x4 s0, s1;
                    if constexpr (SRC_F32) { s0 = __builtin_nontemporal_load((const f32x4*)(src + ro + bj * HALF)); s1 = __builtin_nontemporal_load((const f32x4*)(src + ro + bj * HALF + 4)); }
                    else { const u32x4 hv = *(const u32x4*)(dst + ro + bj * HALF); s0 = (f32x4){bflo(hv.x), bfhi(hv.x), bflo(hv.y), bfhi(hv.y)}; s1 = (f32x4){bflo(hv.z), bfhi(hv.z), bflo(hv.w), bfhi(hv.w)}; }
                    const f32x4 v0 = s0 + gv[bj][0] * acc[ai][bj][m][0], v1 = s1 + gv[bj][1] * acc[ai][bj][m][1];
                    u32x4 w; w.x = cvt_pk_bf16(v0[0], v0[1]); w.y = cvt_pk_bf16(v0[2], v0[3]); w.z = cvt_pk_bf16(v1[0], v1[1]); w.w = cvt_pk_bf16(v1[2], v1[3]);
                    *(u32x4*)(dst + ro + bj * HALF) = w; } }
    }
};
__device__ __forceinline__ float silu_f(float x) { return x * __builtin_amdgcn_rcpf(1.0f + __expf(-x)); }
struct EpiSwiglu {
    static constexpr bool PERM = true;
    bf16* H;
    __device__ __forceinline__ void operator()(const f32x4 (&acc)[2][2][4][2], const Unit& u, int wr, int wc, int fr, int fq) const {
        const int row0 = u.pm * BM + wr * 64 + fr, col0 = u.pn * 128 + wc * 32 + 8 * fq;
#pragma unroll
        for (int ai = 0; ai < 2; ++ai)
#pragma unroll
            for (int m = 0; m < 4; ++m) { bf16* p = H + (size_t)(row0 + ai * HALF + m * 16) * 512 + col0;
                const f32x4 g0 = acc[ai][0][m][0], g1 = acc[ai][0][m][1], u0 = acc[ai][1][m][0], u1 = acc[ai][1][m][1];
                u32x4 w; w.x = cvt_pk_bf16(silu_f(g0[0]) * u0[0], silu_f(g0[1]) * u0[1]); w.y = cvt_pk_bf16(silu_f(g0[2]) * u0[2], silu_f(g0[3]) * u0[3]);
                w.z = cvt_pk_bf16(silu_f(g1[0]) * u1[0], silu_f(g1[1]) * u1[1]); w.w = cvt_pk_bf16(silu_f(g1[2]) * u1[2], silu_f(g1[3]) * u1[3]);
                *(u32x4*)p = w; }
    }
};
__device__ __forceinline__ unsigned pk4_fp8(float a, float b, float c, float d) { int p = __builtin_amdgcn_cvt_pk_fp8_f32(a, b, 0, false); p = __builtin_amdgcn_cvt_pk_fp8_f32(c, d, p, true); return (unsigned)p; }
constexpr float W1_SCALE = 32.0f, W2_SCALE = 16.0f, HID_SCALE = 4.0f;
struct EpiSwiglu8 {
    static constexpr bool PERM = true;
    unsigned char* H; float in_scale;
    __device__ __forceinline__ void operator()(const f32x4 (&acc)[2][2][4][2], const Unit& u, int wr, int wc, int fr, int fq) const {
        const int row0 = u.pm * BM + wr * 64 + fr, col0 = u.pn * 128 + wc * 32 + 8 * fq;
        const float IS = 1.0f / in_scale, OS = HID_SCALE / in_scale;
#pragma unroll
        for (int ai = 0; ai < 2; ++ai)
#pragma unroll
            for (int m = 0; m < 4; ++m) { unsigned char* p = H + (size_t)(row0 + ai * HALF + m * 16) * 512 + col0;
                const f32x4 g0 = acc[ai][0][m][0] * IS, g1 = acc[ai][0][m][1] * IS, u0 = acc[ai][1][m][0] * OS, u1 = acc[ai][1][m][1] * OS;
#define HC8(x) __builtin_fminf(__builtin_fmaxf((x), -448.0f), 448.0f)
                u32x2 w; w.x = pk4_fp8(HC8(silu_f(g0[0]) * u0[0]), HC8(silu_f(g0[1]) * u0[1]), HC8(silu_f(g0[2]) * u0[2]), HC8(silu_f(g0[3]) * u0[3]));
                w.y = pk4_fp8(HC8(silu_f(g1[0]) * u1[0]), HC8(silu_f(g1[1]) * u1[1]), HC8(silu_f(g1[2]) * u1[2]), HC8(silu_f(g1[3]) * u1[3]));
#undef HC8
                *(u32x2*)p = w; }
    }
};
struct EpiStoreS {
    static constexpr bool PERM = true;
    bf16* O; int ldc; float scale;
    __device__ __forceinline__ void operator()(const f32x4 (&acc)[2][2][4][2], const Unit& u, int wr, int wc, int fr, int fq) const {
        const int row0 = u.pm * BM + wr * 64 + fr, col0 = u.pn * BM + wc * 32 + 8 * fq;
#pragma unroll
        for (int ai = 0; ai < 2; ++ai)
#pragma unroll
            for (int m = 0; m < 4; ++m) { bf16* rowp = O + (size_t)(row0 + ai * HALF + m * 16) * ldc + col0;
#pragma unroll
                for (int bj = 0; bj < 2; ++bj) { const f32x4 v0 = acc[ai][bj][m][0] * scale, v1 = acc[ai][bj][m][1] * scale;
                    u32x4 w; w.x = cvt_pk_bf16(v0[0], v0[1]); w.y = cvt_pk_bf16(v0[2], v0[3]); w.z = cvt_pk_bf16(v1[0], v1[1]); w.w = cvt_pk_bf16(v1[2], v1[3]);
                    *(u32x4*)(rowp + bj * HALF) = w; } }
    }
};
struct EpiScaleRow {
    static constexpr bool PERM = true;
    bf16* O; const float* wrow;
    __device__ __forceinline__ void operator()(const f32x4 (&acc)[2][2][4][2], const Unit& u, int wr, int wc, int fr, int fq) const {
        const int row0 = u.pm * BM + wr * 64 + fr, col0 = u.pn * BM + wc * 32 + 8 * fq;
#pragma unroll
        for (int ai = 0; ai < 2; ++ai)
#pragma unroll
            for (int m = 0; m < 4; ++m) { const int row = row0 + ai * HALF + m * 16; const float s = wrow[row]; bf16* rowp = O + (size_t)row * 1024 + col0;
#pragma unroll
                for (int bj = 0; bj < 2; ++bj) { const f32x4 v0 = acc[ai][bj][m][0] * s, v1 = acc[ai][bj][m][1] * s;
                    u32x4 w; w.x = cvt_pk_bf16(v0[0], v0[1]); w.y = cvt_pk_bf16(v0[2], v0[3]); w.z = cvt_pk_bf16(v1[0], v1[1]); w.w = cvt_pk_bf16(v1[2], v1[3]);
                    *(u32x4*)(rowp + bj * HALF) = w; } }
    }
};
}

struct Args { const float* in[22]; float* out; unsigned char* ws; int ph_lo, ph_hi; };
enum { I_X = 0, I_C, I_CTX, I_CCTX, I_ADAW, I_ADAB, I_NMG, I_NFG, I_EWIN, I_ECONV, I_EWOUT, I_OWIN, I_OPOOLW, I_OPOOLS, I_OSINK, I_OWOUT, I_RW, I_RB, I_MG, I_MU, I_MD, I_FG };

struct Frame {
    LAS unsigned char* lds;
    int tid, lane, wave, vcu, G;
    unsigned char* ws; const float* const* in; float* out;
};
__device__ __forceinline__ bf16* h_row(const Frame& F, int t) { return (bf16*)(F.ws + WS_HB) + (size_t)t * D; }
__device__ __forceinline__ int mod_row(int t) { return t < TL ? (t >> 12) : 8; }

struct TItem { const float* src; bf16* dst; int ldw, ldd; float f8scale; };
__device__ __forceinline__ void titem_load(const TItem& t, f32x4 (&r)[8], int lane) {
#pragma unroll
    for (int i = 0; i < 8; ++i) r[i] = __builtin_nontemporal_load((const f32x4*)(t.src + (size_t)((lane >> 3) + 8 * i) * t.ldw + 4 * (lane & 7)));
}
__device__ __forceinline__ void titem_process(const TItem& t, const f32x4 (&r)[8], LAS float* scr, int lane) {
#pragma unroll
    for (int i = 0; i < 8; ++i) { LAS float* d = scr + ((lane >> 3) + 8 * i) * 33 + 4 * (lane & 7); d[0] = r[i].x; d[1] = r[i].y; d[2] = r[i].z; d[3] = r[i].w; }
    LDS_WAIT(); asm volatile("" ::: "memory");
    const int c = lane & 7;
    if (t.f8scale != 0.0f) {
        const float sc = t.f8scale; unsigned char* d8 = (unsigned char*)t.dst;
#pragma unroll
        for (int j = 0; j < 4; ++j) { const int n = (lane >> 3) + 8 * j; const LAS float* s = scr + (8 * c) * 33 + n;
            u32x2 o; o.x = pg8::pk4_fp8(s[0 * 33] * sc, s[1 * 33] * sc, s[2 * 33] * sc, s[3 * 33] * sc); o.y = pg8::pk4_fp8(s[4 * 33] * sc, s[5 * 33] * sc, s[6 * 33] * sc, s[7 * 33] * sc);
            *(u32x2*)(d8 + (size_t)n * t.ldd + 8 * c) = o; }
    } else {
#pragma unroll
        for (int j = 0; j < 4; ++j) { const int n = (lane >> 3) + 8 * j; const LAS float* s = scr + (8 * c) * 33 + n;
            u32x4 o; o.x = pk2(s[0 * 33], s[1 * 33]); o.y = pk2(s[2 * 33], s[3 * 33]); o.z = pk2(s[4 * 33], s[5 * 33]); o.w = pk2(s[6 * 33], s[7 * 33]);
            *(u32x4*)(t.dst + (size_t)n * t.ldd + 8 * c) = o; }
    }
    LDS_WAIT(); asm volatile("" ::: "memory");
}
constexpr int TS0 = 1024, TS1 = 512, TS2 = 384, TS3 = 512, TS4 = 0, TS5 = 4096, TS6 = 4096, TS7 = 4096, TNITEMS = TS0 + TS1 + TS2 + TS3 + TS4 + TS5 + TS6 + TS7;
__device__ __forceinline__ TItem titem_moe(const float* const* in, unsigned char* ws, int kind, int le, int rr) {
    TItem t; const int layer = le >> 4, e = le & 15; const bool f8 = (kind < 2) ? (layer ? (FP8_G1_L1 != 0) : (FP8_G1_L0 != 0)) : (layer ? (FP8_G2_L1 != 0) : (FP8_G2_L0 != 0));
    if (kind < 2) { const int kb = (rr >> 4) & 15, nb = rr & 15, n0 = nb * 32; const int drow = (n0 >> 7) * 256 + (n0 & 127) + kind * 128;
        t.src = in[kind ? I_MU : I_MG] + (size_t)le * 524288 + (size_t)(kb * 64) * 512 + n0; t.ldw = 512;
        unsigned char* base = ws + WS_W_M1 + (size_t)layer * 32 * MiB;
        if (f8) { t.dst = (bf16*)(base + (size_t)e * MiB + (size_t)drow * 1024 + kb * 64); t.ldd = 1024; t.f8scale = pg8::W1_SCALE; }
        else { t.dst = (bf16*)(base + (size_t)e * 2 * MiB) + (size_t)drow * 1024 + kb * 64; t.ldd = 1024; t.f8scale = 0.0f; } }
    else { const int kb = (rr >> 5) & 7, nb = rr & 31;
        t.src = in[I_MD] + (size_t)le * 524288 + (size_t)(kb * 64) * 1024 + nb * 32; t.ldw = 1024;
        unsigned char* base = ws + WS_W_M2 + (size_t)layer * 16 * MiB;
        if (f8) { t.dst = (bf16*)(base + (size_t)e * 512 * KiB + (size_t)(nb * 32) * 512 + kb * 64); t.ldd = 512; t.f8scale = pg8::W2_SCALE; }
        else { t.dst = (bf16*)(base + (size_t)e * MiB) + (size_t)(nb * 32) * 512 + kb * 64; t.ldd = 512; t.f8scale = 0.0f; } }
    return t;
}
__device__ __forceinline__ TItem titem_decode(const float* const* in, unsigned char* ws, int r) {
    TItem t;
    if (r < TS0) { const int kb = r / 64, nb = r % 64; t.src = in[I_EWIN] + (size_t)(kb * 64) * 2048 + nb * 32; t.ldw = 2048; t.dst = (bf16*)(ws + WS_W_EIN) + (size_t)(nb * 32) * 1024 + kb * 64; t.ldd = 1024; t.f8scale = 0.0f; return t; } r -= TS0;
    if (r < TS1) { const int kb = r / 32, nb = r % 32; t.src = in[I_EWOUT] + (size_t)(kb * 64) * 1024 + nb * 32; t.ldw = 1024; t.dst = (bf16*)(ws + WS_W_EOUT) + (size_t)(nb * 32) * 1024 + kb * 64; t.ldd = 1024; t.f8scale = 0.0f; return t; } r -= TS1;
    if (r < TS2) { const int kb = r / 24, nb = 16 + r % 24; t.src = in[I_OWIN] + (size_t)(kb * 64) * 1280 + nb * 32; t.ldw = 1280; t.dst = (bf16*)(ws + WS_W_OIN) + (size_t)(nb * 32) * 1024 + kb * 64; t.ldd = 1024; t.f8scale = 0.0f; return t; } r -= TS2;
    if (r < TS3) { const int kb = r / 32, nb = r % 32; t.src = in[I_OWOUT] + (size_t)(kb * 64) * 1024 + nb * 32; t.ldw = 1024; t.dst = (bf16*)(ws + WS_W_OOUT) + (size_t)(nb * 32) * 1024 + kb * 64; t.ldd = 1024; t.f8scale = 0.0f; return t; } r -= TS3;
    if (r < TS5 + TS6 + TS7) return titem_moe(in, ws, r / 4096, (r % 4096) >> 8, r % 256);
    return t;
}
constexpr int NL1 = 12288;
__device__ __forceinline__ TItem titem_l1(const float* const* in, unsigned char* ws, int r) { return titem_moe(in, ws, r / 4096, 16 + ((r % 4096) >> 8), r % 256); }

constexpr size_t WS_CONVCTR = 20 * KiB;
__device__ __forceinline__ void convert_l1(Frame& F, int quota) {
    unsigned* ctr = (unsigned*)(F.ws + WS_CONVCTR);
    LAS float* scr = (LAS float*)(F.lds + F.wave * 17408);
    for (int ch = 0; ch < quota; ++ch) {
        const int c0 = __builtin_amdgcn_readfirstlane(F.lane == 0 ? (int)__hip_atomic_fetch_add(ctr, 4u, __ATOMIC_RELAXED, __HIP_MEMORY_SCOPE_AGENT) : 0);
        if (c0 >= NL1) break;
        f32x4 cur[8], nxt[8];
        TItem tc = titem_l1(F.in, F.ws, c0);
        titem_load(tc, nxt, F.lane);
#pragma unroll 1
        for (int i = 0; i < 4; ++i) {
#pragma unroll
            for (int j = 0; j < 8; ++j) cur[j] = nxt[j];
            const TItem tcur = tc;
            if (i < 3) { tc = titem_l1(F.in, F.ws, c0 + i + 1); titem_load(tc, nxt, F.lane); }
            titem_process(tcur, cur, scr, F.lane);
        }
    }
}
__device__ __forceinline__ void convert_l1_static(Frame& F) {
    LAS unsigned* ctr = (LAS unsigned*)(F.lds + LDS_CTL + 40);
    LAS float* scr = (LAS float*)(F.lds + F.wave * 17408);
    const int base = F.vcu * 48;
    f32x4 cur[8], nxt[8];
    int it = __builtin_amdgcn_readfirstlane(F.lane == 0 ? (int)atomicAdd((unsigned*)ctr, 1u) : 0);
    TItem tc = titem_l1(F.in, F.ws, base + (it < 48 ? it : 0));
    if (it < 48) titem_load(tc, nxt, F.lane);
    while (it < 48) {
#pragma unroll
        for (int i = 0; i < 8; ++i) cur[i] = nxt[i];
        const TItem tcur = tc;
        const int itn = __builtin_amdgcn_readfirstlane(F.lane == 0 ? (int)atomicAdd((unsigned*)ctr, 1u) : 0);
        if (itn < 48) { tc = titem_l1(F.in, F.ws, base + itn); titem_load(tc, nxt, F.lane); }
        titem_process(tcur, cur, scr, F.lane);
        it = itn;
    }
}
__device__ __forceinline__ void tail_fill(Frame& F, int nUnits, int quota) {
    const int rounds = (nUnits + F.G - 1) / F.G;
    if ((rounds - 1) * F.G + F.vcu >= nUnits) convert_l1(F, quota);
}

__device__ __forceinline__ void norm_mod_store(const f32x4 (&v)[4], const float* g, const float* shift, const float* scale, bf16* orow, int lane) {
    float s2 = 0.f;
#pragma unroll
    for (int j = 0; j < 4; ++j) s2 += (v[j].x * v[j].x + v[j].y * v[j].y) + (v[j].z * v[j].z + v[j].w * v[j].w);
    const float rstd = 1.0f / sqrtf(wave_sum(s2) * (1.0f / D) + EPS);
#pragma unroll
    for (int j = 0; j < 4; ++j) { const int c = 4 * lane + 256 * j;
        const f32x4 gg = *(const f32x4*)(g + c), sh = *(const f32x4*)(shift + c), sc = *(const f32x4*)(scale + c);
        const f32x4 y = v[j] * rstd * gg * (sc + 1.0f) + sh;
        u32x2 o; o.x = pk2(y.x, y.y); o.y = pk2(y.z, y.w);
        *(u32x2*)(orow + c) = o; }
}

template <int NQ> __device__ __forceinline__ void p1_tokens(Frame& F, int t) {
    const float* mods = (const float*)(F.ws + WS_MODS);
    bf16* A = (bf16*)(F.ws + WS_BUFA);
    f32x4 v[NQ][4];
#pragma unroll
    for (int q = 0; q < NQ; ++q) { const int tq = t + q; const float* xr = tq < TL ? F.in[I_X] + (size_t)tq * D : F.in[I_CTX] + (size_t)(tq - TL) * D;
#pragma unroll
        for (int j = 0; j < 4; ++j) v[q][j] = __builtin_nontemporal_load((const f32x4*)(xr + 4 * F.lane + 256 * j)); }
    const float* m = mods + (size_t)mod_row(t) * 6144;
#pragma unroll
    for (int q = 0; q < NQ; ++q) norm_mod_store(v[q], F.in[I_NMG], m, m + 1024, A + (size_t)(t + q) * D, F.lane);
}
__device__ __forceinline__ void phase_mods(Frame& F) {
    const float* const* in = F.in;
    LAS float* S = (LAS float*)F.lds;
    LAS float* red = S + 9 * 1024;
    for (int i = F.tid; i < 9 * 1024; i += 512) { const float v = (i < 8192) ? in[I_C][i] : in[I_CCTX][i - 8192]; S[i] = v / (1.0f + expf(-v)); }
    __syncthreads();
    const int bx = blockIdx.x, layer = bx >> 7, col0 = (bx & 127) * 48;
    const int j = F.tid % 12, rg = F.tid / 12;
    if (rg < 42) {
        const float* W = in[I_ADAW] + (size_t)layer * 1024 * 6144 + col0 + 4 * j;
        f32x4 w[25];
#pragma unroll
        for (int i = 0; i < 25; ++i) { const int k = rg + 42 * i; w[i] = (k < 1024) ? __builtin_nontemporal_load((const f32x4*)(W + (size_t)k * 6144)) : (f32x4){0.f, 0.f, 0.f, 0.f}; }
        f32x4 acc[9];
#pragma unroll
        for (int r = 0; r < 9; ++r) acc[r] = (f32x4){0.f, 0.f, 0.f, 0.f};
#pragma unroll
        for (int i = 0; i < 25; ++i) { const int k = min(rg + 42 * i, 1023);
#pragma unroll
            for (int r = 0; r < 9; ++r) acc[r] += w[i] * S[r * 1024 + k]; }
#pragma unroll
        for (int r = 0; r < 9; ++r) *(LAS f32x4*)(red + (rg * 9 + r) * 48 + 4 * j) = acc[r];
    }
    __syncthreads();
    for (int i = F.tid; i < 432; i += 512) { const int r = i / 48, c = i % 48; float sum = in[I_ADAB][layer * 6144 + col0 + c];
        for (int g = 0; g < 42; ++g) sum += red[(g * 9 + r) * 48 + c];
        ((float*)(F.ws + WS_MODS))[(layer * 9 + r) * 6144 + col0 + c] = sum; }
}

__device__ __forceinline__ void phase_prologue_a(Frame& F) {
    const float* const* in = F.in;
    unsigned char* ws = F.ws;
    LAS float* ldsf = (LAS float*)F.lds;
    __syncthreads();
    {
        const int gt = blockIdx.x * 512 + F.tid, NT = F.G * 512;
        float* rope = (float*)(ws + WS_ROPE);
        for (int i = gt; i < 1024; i += NT) { const int coord = i >> 4, q = i & 15; const float inv = powf(10000.0f, -(float)q / 16.0f); const float ang = (float)coord * inv;
            rope[i] = cosf(ang); rope[1024 + i] = sinf(ang); }
        bf16* WA = (bf16*)(ws + WS_WA);
        for (int i = gt; i < 128 * 128; i += NT) { const int m = i >> 7, k = i & 127, rp = m >> 6, j1 = m & 63, ri = k >> 6, n1 = k & 63;
            const float a = 2.0f * (float)((j1 * n1) & 63) / 64.0f; const float c = cospif(a), s = sinpif(a);
            const float v = (rp == 0) ? (ri == 0 ? c : s) : (ri == 0 ? -s : c); WA[i] = (bf16)f2bf(v); }
        bf16* WAC = (bf16*)(ws + WS_WAC);
        for (int i = gt; i < 32 * 32; i += NT) { const int m = i >> 5, k = i & 31, rp = m >> 4, j1 = m & 15, ri = k >> 4, n1 = k & 15;
            const float a = 2.0f * (float)((j1 * n1) & 15) / 16.0f; const float c = cospif(a), s = sinpif(a);
            const float v = (rp == 0) ? (ri == 0 ? c : s) : (ri == 0 ? -s : c); WAC[i] = (bf16)f2bf(v); }
        bf16* WC = (bf16*)(ws + WS_WC);
        for (int i = gt; i < 64 * 64 * 128; i += NT) { const int j1 = i >> 13, j2 = (i >> 7) & 63, k = i & 127, ri = k >> 6, n2 = k & 63;
            const float a = 2.0f * (float)((n2 * (j1 + 64 * j2)) & 4095) / 4096.0f; const float v = (ri == 0 ? cospif(a) : sinpif(a)) * (1.0f / 64.0f); WC[i] = (bf16)f2bf(v); }
        bf16* FD = (bf16*)(ws + WS_FD);
        for (int i = gt; i < 256 * 128; i += NT) { const int col = i >> 7, c = i & 127, ri = col >> 7, k2 = col & 127;
            const float a = 2.0f * (float)((c * k2) & 127) / 128.0f; const float v = (ri == 0 ? cospif(a) : -sinpif(a)) * 0.08838834764831845f; FD[i] = (bf16)f2bf(v); }
        bf16* WCC = (bf16*)(ws + WS_WCC);
        for (int i = gt; i < 16 * 16 * 32; i += NT) { const int j1 = i >> 9, j2 = (i >> 5) & 15, k = i & 31, ri = k >> 4, n2 = k & 15;
            const float a = 2.0f * (float)((n2 * (j1 + 16 * j2)) & 255) / 256.0f; const float v = (ri == 0 ? cospif(a) : sinpif(a)) * (1.0f / 16.0f); WCC[i] = (bf16)f2bf(v); }
    }
    LAS float* tw = (LAS float*)(F.lds + 139264);
    if (F.tid < 128) { const float a = 2.0f * (float)F.tid / 128.0f; tw[F.tid] = cospif(a); tw[128 + F.tid] = sinpif(a); }
    __syncthreads();
    LAS float* scr = (LAS float*)(F.lds + F.wave * 17408);
    const int gw = F.vcu * NWAVES + F.wave, NGW = F.G * NWAVES;
    const int fid = F.vcu * 2 + F.wave;
    if (F.wave < 2) { const int r = fid;
        const int g = r >> 7, db = (r >> 5) & 3, kb = r & 31, k0 = kb * 32, d0 = db * 32;
        const float* Wp = in[I_OWIN] + (size_t)k0 * 1280 + g * 128;
        { float tl[32][2];
#pragma unroll
          for (int rr = 0; rr < 32; ++rr) { tl[rr][0] = Wp[(size_t)rr * 1280 + F.lane]; tl[rr][1] = Wp[(size_t)rr * 1280 + 64 + F.lane]; }
#pragma unroll
          for (int rr = 0; rr < 32; ++rr) { scr[rr * 129 + F.lane] = tl[rr][0]; scr[rr * 129 + 64 + F.lane] = tl[rr][1]; } }
        LDS_WAIT(); asm volatile("" ::: "memory");
        const int k = F.lane & 31, oh = F.lane >> 5;
        const float* pw = in[I_OPOOLW] + (size_t)g * 16384 + d0 + 16 * oh;
        float acc[16];
#pragma unroll
        for (int t = 0; t < 16; ++t) acc[t] = 0.f;
        for (int c0 = 0; c0 < 128; c0 += 8) {
            f32x4 p[8][4];
#pragma unroll
            for (int cc = 0; cc < 8; ++cc)
#pragma unroll
                for (int j = 0; j < 4; ++j) p[cc][j] = *(const f32x4*)(pw + (c0 + cc) * 128 + 4 * j);
#pragma unroll
            for (int cc = 0; cc < 8; ++cc) { const float w = scr[k * 129 + c0 + cc];
#pragma unroll
                for (int j = 0; j < 4; ++j) { acc[4 * j] += w * p[cc][j].x; acc[4 * j + 1] += w * p[cc][j].y; acc[4 * j + 2] += w * p[cc][j].z; acc[4 * j + 3] += w * p[cc][j].w; } }
        }
        const float* psc = in[I_OPOOLS] + g * 128 + d0 + 16 * oh;
        bf16* dst = (bf16*)(ws + WS_W_OIN) + (size_t)(g * 128 + d0 + 16 * oh) * 1024 + k0 + k;
#pragma unroll
        for (int t = 0; t < 16; ++t) dst[(size_t)t * 1024] = (bf16)f2bf(acc[t] * psc[t]);
        LDS_WAIT(); asm volatile("" ::: "memory");
    }
    {
        LAS unsigned* ctr = (LAS unsigned*)(F.lds + LDS_CTL + 32);
        constexpr int PER = (TNITEMS + 255) / 256;
        const int base = F.vcu * PER, lim = min(PER, TNITEMS - base);
        f32x4 cur[8], nxt[8];
        int it = __builtin_amdgcn_readfirstlane(F.lane == 0 ? (int)atomicAdd((unsigned*)ctr, 1u) : 0);
        TItem tc = titem_decode(in, ws, base + (it < lim ? it : 0));
        if (it < lim) titem_load(tc, nxt, F.lane);
        while (it < lim) {
#pragma unroll
            for (int i = 0; i < 8; ++i) cur[i] = nxt[i];
            const TItem tcur = tc;
            const int itn = __builtin_amdgcn_readfirstlane(F.lane == 0 ? (int)atomicAdd((unsigned*)ctr, 1u) : 0);
            if (itn < lim) { tc = titem_decode(in, ws, base + itn); titem_load(tc, nxt, F.lane); }
            titem_process(tcur, cur, scr, F.lane);
            it = itn;
        }
    }
    {
        LAS unsigned* ctr2 = (LAS unsigned*)(F.lds + LDS_CTL + 36);
        for (;;) {
            const int it = __builtin_amdgcn_readfirstlane(F.lane == 0 ? (int)atomicAdd((unsigned*)ctr2, 1u) : 0);
            if (it >= 40) break;
            if (it < 32) p1_tokens<4>(F, 4 * (32 * (int)blockIdx.x + it)); else p1_tokens<1>(F, TL + 8 * (int)blockIdx.x + (it - 32));
        }
    }
}

struct DftP { const bf16* dbase; size_t dstride; const bf16* W; bf16* obase; size_t ostride; };
template <int MODE> __device__ __forceinline__ DftP dft_params(const Frame& F, int u) {
    const bf16* P = (const bf16*)(F.ws + WS_BUFP); bf16* Z = (bf16*)(F.ws + WS_BUFZ); bf16* MIX = (bf16*)(F.ws + WS_BUFA);
    DftP p;
    if constexpr (MODE == 0) { const int chunk = u & 3, n2 = (u >> 2) & 63, b = u >> 8;
        p.dbase = P + (size_t)(b * 4096 + n2) * EIN + chunk * 128; p.dstride = (size_t)64 * EIN; p.W = (const bf16*)(F.ws + WS_WA);
        p.obase = Z + (size_t)((b * 64) * 64 + n2) * 1024 + chunk * 128; p.ostride = (size_t)64 * 1024; }
    if constexpr (MODE == 1) { const int chunk = u & 3, n2 = (u >> 2) & 15, b = u >> 6;
        p.dbase = P + (size_t)(TL + b * 256 + n2) * EIN + chunk * 128; p.dstride = (size_t)16 * EIN; p.W = (const bf16*)(F.ws + WS_WAC);
        p.obase = Z + (size_t)(TL + (b * 16) * 16 + n2) * 1024 + chunk * 128; p.ostride = (size_t)16 * 1024; }
    if constexpr (MODE == 2) { const int chunk = u & 3, j1 = (u >> 2) & 63, b = u >> 8;
        p.dbase = Z + (size_t)((b * 64 + j1) * 64) * 1024 + chunk * 128; p.dstride = (size_t)1024; p.W = (const bf16*)(F.ws + WS_WC) + (size_t)j1 * 64 * 128;
        p.obase = MIX + (size_t)(b * 4096 + j1) * D + chunk * 128; p.ostride = (size_t)64 * D; }
    if constexpr (MODE == 3) { const int chunk = u & 3, j1 = (u >> 2) & 15, b = u >> 6;
        p.dbase = Z + (size_t)(TL + (b * 16 + j1) * 16) * 1024 + chunk * 128; p.dstride = (size_t)1024; p.W = (const bf16*)(F.ws + WS_WCC) + (size_t)j1 * 16 * 32;
        p.obase = MIX + (size_t)(TL + b * 256 + j1) * D + chunk * 128; p.ostride = (size_t)16 * D; }
    return p;
}
template <int MODE, int KD, int MD, int J>
__device__ __forceinline__ void dft_units(Frame& F, int nunits) {
    constexpr int LD = KD + 8;
    constexpr int NP = (KD * 16 + 511) / 512;
    constexpr int GM = KD / 8 - 1;
    LAS bf16* DT = (LAS bf16*)F.lds;
    u32x4 pre[NP];
    int u = F.vcu;
    if (u < nunits) { const DftP p = dft_params<MODE>(F, u);
#pragma unroll
        for (int i = 0; i < NP; ++i) { const int pc = F.tid + 512 * i; if (pc < KD * 16) { const int k = pc >> 4, c8 = pc & 15, ri = k / (KD / 2), nn = k % (KD / 2);
            pre[i] = __builtin_nontemporal_load((const u32x4*)(p.dbase + (size_t)nn * p.dstride + ri * 512 + c8 * 8)); } } }
    const int a = F.lane & 15, q = F.lane >> 4;
    for (; u < nunits; u += F.G) {
        const DftP p = dft_params<MODE>(F, u);
#pragma unroll
        for (int i = 0; i < NP; ++i) { const int pc = F.tid + 512 * i; if (pc < KD * 16) { const int k = pc >> 4, c8 = pc & 15; const u32x4 v = pre[i];
            LAS bf16* d = DT + (c8 * 8) * LD + (k ^ ((c8 & GM) << 3));
            d[0 * LD] = (bf16)(v.x & 0xffff); d[1 * LD] = (bf16)(v.x >> 16); d[2 * LD] = (bf16)(v.y & 0xffff); d[3 * LD] = (bf16)(v.y >> 16);
            d[4 * LD] = (bf16)(v.z & 0xffff); d[5 * LD] = (bf16)(v.z >> 16); d[6 * LD] = (bf16)(v.w & 0xffff); d[7 * LD] = (bf16)(v.w >> 16); } }
        __syncthreads();
        if (u + F.G < nunits) { const DftP pn = dft_params<MODE>(F, u + F.G);
#pragma unroll
            for (int i = 0; i < NP; ++i) { const int pc = F.tid + 512 * i; if (pc < KD * 16) { const int k = pc >> 4, c8 = pc & 15, ri = k / (KD / 2), nn = k % (KD / 2);
                pre[i] = __builtin_nontemporal_load((const u32x4*)(pn.dbase + (size_t)nn * pn.dstride + ri * 512 + c8 * 8)); } } }
        for (int task = F.wave; task < (MD / 16) * 2; task += NWAVES) {
            const int mt = task >> 1, cht = task & 1;
            f32x4 acc[4];
#pragma unroll
            for (int ct = 0; ct < 4; ++ct) acc[ct] = (f32x4){0.f, 0.f, 0.f, 0.f};
#pragma unroll
            for (int ks = 0; ks < KD / 32; ++ks) {
                const bf16x8 bw = *(const bf16x8*)(p.W + (size_t)(mt * 16 + a) * KD + ks * 32 + 8 * q);
#pragma unroll
                for (int ct = 0; ct < 4; ++ct) {
                    const int ch = cht * 64 + 16 * (a >> 2) + 4 * ct + (a & 3);
                    const bf16x8 av = *(const LAS bf16x8*)(DT + ch * LD + ((ks * 32 + 8 * q) ^ (((ch >> 3) & GM) << 3)));
                    acc[ct] = __builtin_amdgcn_mfma_f32_16x16x32_bf16(av, bw, acc[ct], 0, 0, 0);
                }
            }
            const int m = mt * 16 + a, rm = m / J, j = m % J;
            bf16* o = p.obase + (size_t)j * p.ostride + rm * 512 + cht * 64 + 16 * q;
            u32x4 w0, w1;
            w0.x = pk2(acc[0][0], acc[0][1]); w0.y = pk2(acc[0][2], acc[0][3]); w0.z = pk2(acc[1][0], acc[1][1]); w0.w = pk2(acc[1][2], acc[1][3]);
            w1.x = pk2(acc[2][0], acc[2][1]); w1.y = pk2(acc[2][2], acc[2][3]); w1.z = pk2(acc[3][0], acc[3][1]); w1.w = pk2(acc[3][2], acc[3][3]);
            *(u32x4*)o = w0; *(u32x4*)(o + 8) = w1;
        }
        __syncthreads();
    }
}

template <int MODE, int NR>
__device__ __forceinline__ void dft_units_a(Frame& F, int nunits) {
    constexpr int KD = 2 * NR, MD = 2 * NR, J = NR, LD = KD + 8, GM = KD / 8 - 1, ULD = 136;
    constexpr int NP = (NR * 16 + 511) / 512;
    LAS bf16* FDl = (LAS bf16*)F.lds; LAS bf16* U = (LAS bf16*)(F.lds + 69632); LAS bf16* DT = (LAS bf16*)(F.lds + 69632 + 64 * ULD * 2);
    { const bf16* FD = (const bf16*)(F.ws + WS_FD);
      for (int p = F.tid; p < 256 * 16; p += 512) { const int r = p >> 4, c8 = p & 15; *(LAS u32x4*)(FDl + r * ULD + 8 * c8) = *(const u32x4*)(FD + r * 128 + 8 * c8); } }
    u32x4 pre[NP];
    int u = F.vcu;
    if (u < nunits) { const DftP p = dft_params<MODE>(F, u);
#pragma unroll
        for (int i = 0; i < NP; ++i) { const int pc = F.tid + 512 * i; if (pc < NR * 16) pre[i] = __builtin_nontemporal_load((const u32x4*)(p.dbase + (size_t)(pc >> 4) * p.dstride + (pc & 15) * 8)); } }
    const int a = F.lane & 15, q = F.lane >> 4;
    for (; u < nunits; u += F.G) {
        const DftP p = dft_params<MODE>(F, u);
#pragma unroll
        for (int i = 0; i < NP; ++i) { const int pc = F.tid + 512 * i; if (pc < NR * 16) *(LAS u32x4*)(U + (pc >> 4) * ULD + (pc & 15) * 8) = pre[i]; }
        __syncthreads();
        if (u + F.G < nunits) { const DftP pn = dft_params<MODE>(F, u + F.G);
#pragma unroll
            for (int i = 0; i < NP; ++i) { const int pc = F.tid + 512 * i; if (pc < NR * 16) pre[i] = __builtin_nontemporal_load((const u32x4*)(pn.dbase + (size_t)(pc >> 4) * pn.dstride + (pc & 15) * 8)); } }
        {
            f32x4 acc[NR / 16][2];
#pragma unroll
            for (int mt = 0; mt < NR / 16; ++mt) { acc[mt][0] = (f32x4){0.f, 0.f, 0.f, 0.f}; acc[mt][1] = (f32x4){0.f, 0.f, 0.f, 0.f}; }
#pragma unroll
            for (int ks = 0; ks < 4; ++ks) {
                const bf16x8 b0 = *(const LAS bf16x8*)(FDl + ((2 * F.wave) * 16 + a) * ULD + ks * 32 + 8 * q), b1 = *(const LAS bf16x8*)(FDl + ((2 * F.wave + 1) * 16 + a) * ULD + ks * 32 + 8 * q);
#pragma unroll
                for (int mt = 0; mt < NR / 16; ++mt) { const bf16x8 av = *(const LAS bf16x8*)(U + (mt * 16 + a) * ULD + ks * 32 + 8 * q);
                    acc[mt][0] = __builtin_amdgcn_mfma_f32_16x16x32_bf16(av, b0, acc[mt][0], 0, 0, 0); acc[mt][1] = __builtin_amdgcn_mfma_f32_16x16x32_bf16(av, b1, acc[mt][1], 0, 0, 0); }
            }
#pragma unroll
            for (int t = 0; t < 2; ++t) { const int col = (2 * F.wave + t) * 16 + a, ri = col >> 7, k2 = col & 127;
#pragma unroll
                for (int mt = 0; mt < NR / 16; ++mt) { const int k0 = ri * NR + 16 * mt + 4 * q;
                    u32x2 w; w.x = pk2(acc[mt][t][0], acc[mt][t][1]); w.y = pk2(acc[mt][t][2], acc[mt][t][3]);
                    *(LAS u32x2*)(DT + k2 * LD + (k0 ^ (((k2 >> 3) & GM) << 3))) = w; } }
        }
        __syncthreads();
        for (int task = F.wave; task < (MD / 16) * 2; task += NWAVES) {
            const int mt = task >> 1, cht = task & 1;
            f32x4 acc[4];
#pragma unroll
            for (int ct = 0; ct < 4; ++ct) acc[ct] = (f32x4){0.f, 0.f, 0.f, 0.f};
#pragma unroll
            for (int ks = 0; ks < KD / 32; ++ks) {
                const bf16x8 bw = *(const bf16x8*)(p.W + (size_t)(mt * 16 + a) * KD + ks * 32 + 8 * q);
#pragma unroll
                for (int ct = 0; ct < 4; ++ct) {
                    const int ch = cht * 64 + 16 * (a >> 2) + 4 * ct + (a & 3);
                    const bf16x8 av = *(const LAS bf16x8*)(DT + ch * LD + ((ks * 32 + 8 * q) ^ (((ch >> 3) & GM) << 3)));
                    acc[ct] = __builtin_amdgcn_mfma_f32_16x16x32_bf16(av, bw, acc[ct], 0, 0, 0);
                }
            }
            const int m = mt * 16 + a, rm = m / J, j = m % J;
            bf16* o = p.obase + (size_t)j * p.ostride + rm * 512 + cht * 64 + 16 * q;
            u32x4 w0, w1;
            w0.x = pk2(acc[0][0], acc[0][1]); w0.y = pk2(acc[0][2], acc[0][3]); w0.z = pk2(acc[1][0], acc[1][1]); w0.w = pk2(acc[1][2], acc[1][3]);
            w1.x = pk2(acc[2][0], acc[2][1]); w1.y = pk2(acc[2][2], acc[2][3]); w1.z = pk2(acc[3][0], acc[3][1]); w1.w = pk2(acc[3][2], acc[3][3]);
            *(u32x4*)o = w0; *(u32x4*)(o + 8) = w1;
        }
        __syncthreads();
    }
}

__device__ __forceinline__ void phase_fourier_a_conv(Frame& F) {
    const bf16* P = (const bf16*)(F.ws + WS_BUFP);
    dft_units_a<0, 64>(F, 2048);
    __syncthreads();
    dft_units_a<1, 16>(F, 512);
    bf16* MIX = (bf16*)(F.ws + WS_BUFA);
    const float* cw = F.in[I_ECONV];
    float w0[8], w1[8], w2[8];
#pragma unroll
    for (int i = 0; i < 8; ++i) { w0[i] = cw[8 * F.lane + i]; w1[i] = cw[512 + 8 * F.lane + i]; w2[i] = cw[1024 + 8 * F.lane + i]; }
    const int gw = F.vcu * NWAVES + F.wave, NGW = F.G * NWAVES;
    auto conv_tokens = [&](int t, auto ntc) {
        constexpr int NT = decltype(ntc)::value;
        int pos, len; if (t < TL) { pos = t & 4095; len = 4096; } else { pos = (t - TL) & 255; len = 256; }
        const bf16* row = P + (size_t)t * EIN + 8 * F.lane;
        u32x4 gb[NT], gc[NT + 2], uc[NT + 2];
#pragma unroll
        for (int d = 0; d < NT + 2; ++d) { const int pp = pos + d - 1;
            if (pp >= 0 && pp < len) { gc[d] = *(const u32x4*)(row + (ptrdiff_t)(d - 1) * EIN + 1024); uc[d] = *(const u32x4*)(row + (ptrdiff_t)(d - 1) * EIN + 1536); }
            else { gc[d] = (u32x4){0u, 0u, 0u, 0u}; uc[d] = (u32x4){0u, 0u, 0u, 0u}; } }
#pragma unroll
        for (int q = 0; q < NT; ++q) gb[q] = __builtin_nontemporal_load((const u32x4*)(row + (size_t)q * EIN + 512));
        float pl[NT + 2][8];
#pragma unroll
        for (int d = 0; d < NT + 2; ++d)
#pragma unroll
            for (int i = 0; i < 4; ++i) { pl[d][2 * i] = bflo(gc[d][i]) * bflo(uc[d][i]); pl[d][2 * i + 1] = bfhi(gc[d][i]) * bfhi(uc[d][i]); }
#pragma unroll
        for (int q = 0; q < NT; ++q) {
            float y[8];
#pragma unroll
            for (int i = 0; i < 4; ++i) {
                y[2 * i] = bflo(gb[q][i]) * (w0[2 * i] * pl[q][2 * i] + w1[2 * i] * pl[q + 1][2 * i] + w2[2 * i] * pl[q + 2][2 * i]);
                y[2 * i + 1] = bfhi(gb[q][i]) * (w0[2 * i + 1] * pl[q][2 * i + 1] + w1[2 * i + 1] * pl[q + 1][2 * i + 1] + w2[2 * i + 1] * pl[q + 2][2 * i + 1]);
            }
            u32x4 o; o.x = pk2(y[0], y[1]); o.y = pk2(y[2], y[3]); o.z = pk2(y[4], y[5]); o.w = pk2(y[6], y[7]);
            *(u32x4*)(MIX + (size_t)(t + q) * D + 512 + 8 * F.lane) = o;
        }
    };
    for (int t = 4 * gw; t < TL; t += 4 * NGW) conv_tokens(t, std::integral_constant<int, 4>{});
    for (int t = TL + gw; t < T; t += NGW) conv_tokens(t, std::integral_constant<int, 1>{});
}

__device__ __forceinline__ void phase_fourier_c(Frame& F) {
    dft_units<2, 128, 64, 64>(F, 2048);
    dft_units<3, 32, 16, 16>(F, 512);
}

constexpr int RW_LD = 1032;
__device__ __forceinline__ void phase_route(Frame& F, int layer, int ntok) {
    LAS bf16* rwh = (LAS bf16*)F.lds;
    LAS bf16* rwl = (LAS bf16*)(F.lds + 33024);
    LAS unsigned* cnt = (LAS unsigned*)(F.lds + 66048);
    LAS int* gb = (LAS int*)(F.lds + 66048 + 128);
    LAS float* lgs = (LAS float*)(F.lds + 66048 + 256) + F.wave * 256;
    LAS int* tinfo = (LAS int*)(F.lds + 66048 + 256 + 8192);
    LAS float* GS = (LAS float*)(F.lds + 81920);
    LAS float* SH = GS + 2048;
    const float* RW = F.in[I_RW];
    const int per = ntok / F.G, t0 = blockIdx.x * per, r0 = mod_row(t0);
    const float* mods = (const float*)(F.ws + WS_MODS) + (size_t)layer * 9 * 6144;
    const float* g = F.in[I_NFG] + layer * 1024;
    for (int i = F.tid; i < 16384; i += 512) { const int k = i >> 4, e = i & 15; const float w = RW[i]; const unsigned hi = f2bf(w); const float wl = w - __builtin_bit_cast(float, hi << 16);
        rwh[e * RW_LD + k] = (bf16)hi; rwl[e * RW_LD + k] = (bf16)f2bf(wl); }
    for (int i = F.tid; i < 2048; i += 512) { const int sl = i >> 10, c = i & 1023; const int rr = min(r0 + sl, 8); const float* m = mods + (size_t)rr * 6144;
        GS[i] = g[c] * (m[4 * 1024 + c] + 1.0f); SH[i] = m[3 * 1024 + c]; }
    if (F.tid < 16) cnt[F.tid] = 0u;
    __syncthreads();
    bf16* FB = (bf16*)(F.ws + WS_BUFA);
    const bool f8 = layer ? (FP8_G1_L1 != 0) : (FP8_G1_L0 != 0);
    int* route = (int*)(F.ws + WS_ROUTE);
    const int tk = F.lane & 15, kg = F.lane >> 4;
    for (int g0 = 16 * F.wave; g0 < per; g0 += 16 * NWAVES) {
        const int nv = min(16, per - g0);
        const int tq = t0 + g0 + (tk < nv ? tk : 0);
        const bf16* hr = h_row(F, tq) + 8 * kg;
        float s2 = 0.f;
        {
            u32x4 raw[32];
#pragma unroll
            for (int ks = 0; ks < 32; ++ks) raw[ks] = *(const u32x4*)(hr + 32 * ks);
#pragma unroll
            for (int ks = 0; ks < 32; ++ks)
#pragma unroll
                for (int i = 0; i < 4; ++i) { const float a = bflo(raw[ks][i]), b2 = bfhi(raw[ks][i]); s2 += a * a + b2 * b2; }
        }
        s2 += __shfl_xor(s2, 16); s2 += __shfl_xor(s2, 32);
        const float rstd = 1.0f / sqrtf(s2 * (1.0f / D) + EPS);
        const int sl = (mod_row(tq) != r0) ? 1024 : 0;
        const LAS float* gsp = GS + sl + 8 * kg; const LAS float* shp = SH + sl + 8 * kg;
        unsigned char* fb8 = (unsigned char*)FB + (size_t)tq * D + 8 * kg;
        bf16* fb16 = FB + (size_t)tq * D + 8 * kg;
        f32x4 acc = (f32x4){0.f, 0.f, 0.f, 0.f};
        u32x4 nx[8];
#pragma unroll
        for (int j = 0; j < 8; ++j) nx[j] = *(const u32x4*)(hr + 32 * j);
#pragma unroll 1
        for (int k4 = 0; k4 < 4; ++k4) {
            u32x4 cu[8];
#pragma unroll
            for (int j = 0; j < 8; ++j) cu[j] = nx[j];
            if (k4 < 3) {
#pragma unroll
                for (int j = 0; j < 8; ++j) nx[j] = *(const u32x4*)(hr + 32 * (8 * k4 + 8 + j)); }
#pragma unroll
            for (int j = 0; j < 8; ++j) {
                const int ks = 8 * k4 + j;
                const f32x4 g0v = *(const LAS f32x4*)(gsp + 32 * ks), g1v = *(const LAS f32x4*)(gsp + 32 * ks + 4), s0v = *(const LAS f32x4*)(shp + 32 * ks), s1v = *(const LAS f32x4*)(shp + 32 * ks + 4);
                float f[8];
                f[0] = bflo(cu[j].x) * rstd * g0v.x + s0v.x; f[1] = bfhi(cu[j].x) * rstd * g0v.y + s0v.y; f[2] = bflo(cu[j].y) * rstd * g0v.z + s0v.z; f[3] = bfhi(cu[j].y) * rstd * g0v.w + s0v.w;
                f[4] = bflo(cu[j].z) * rstd * g1v.x + s1v.x; f[5] = bfhi(cu[j].z) * rstd * g1v.y + s1v.y; f[6] = bflo(cu[j].w) * rstd * g1v.z + s1v.z; f[7] = bfhi(cu[j].w) * rstd * g1v.w + s1v.w;
                u32x4 hi, lo;
#pragma unroll
                for (int i = 0; i < 4; ++i) { const unsigned h0 = f2bf(f[2 * i]), h1 = f2bf(f[2 * i + 1]); hi[i] = h0 | (h1 << 16);
                    lo[i] = pk2(f[2 * i] - __builtin_bit_cast(float, h0 << 16), f[2 * i + 1] - __builtin_bit_cast(float, h1 << 16)); }
                if (tk < nv) {
                    if (f8) { u32x2 o; o.x = pg8::pk4_fp8(f[0], f[1], f[2], f[3]); o.y = pg8::pk4_fp8(f[4], f[5], f[6], f[7]); *(u32x2*)(fb8 + 32 * ks) = o; }
                    else *(u32x4*)(fb16 + 32 * ks) = hi;
                }
                const bf16x8 bh = *(const LAS bf16x8*)(rwh + tk * RW_LD + 32 * ks + 8 * kg), bl = *(const LAS bf16x8*)(rwl + tk * RW_LD + 32 * ks + 8 * kg);
                const bf16x8 ah = __builtin_bit_cast(bf16x8, hi), al = __builtin_bit_cast(bf16x8, lo);
                acc = __builtin_amdgcn_mfma_f32_16x16x32_bf16(ah, bh, acc, 0, 0, 0);
                acc = __builtin_amdgcn_mfma_f32_16x16x32_bf16(ah, bl, acc, 0, 0, 0);
                acc = __builtin_amdgcn_mfma_f32_16x16x32_bf16(al, bh, acc, 0, 0, 0);
            }
        }
#pragma unroll
        for (int j = 0; j < 4; ++j) lgs[(4 * kg + j) * 16 + tk] = acc[j];
        LDS_WAIT(); asm volatile("" ::: "memory");
        if (F.lane < nv) {
            const int tqq = t0 + g0 + F.lane;
            float aff[16], sel[16];
#pragma unroll
            for (int e4 = 0; e4 < 4; ++e4) { const f32x4 l4 = *(const LAS f32x4*)(lgs + F.lane * 16 + 4 * e4); const f32x4 b4 = *(const f32x4*)(F.in[I_RB] + 4 * e4);
                aff[4 * e4] = 1.0f / (1.0f + expf(-l4.x)); aff[4 * e4 + 1] = 1.0f / (1.0f + expf(-l4.y)); aff[4 * e4 + 2] = 1.0f / (1.0f + expf(-l4.z)); aff[4 * e4 + 3] = 1.0f / (1.0f + expf(-l4.w));
                sel[4 * e4] = aff[4 * e4] + b4.x; sel[4 * e4 + 1] = aff[4 * e4 + 1] + b4.y; sel[4 * e4 + 2] = aff[4 * e4 + 2] + b4.z; sel[4 * e4 + 3] = aff[4 * e4 + 3] + b4.w; }
            int best = 0; float bs = -1e30f;
#pragma unroll
            for (int gq = 0; gq < 4; ++gq) { const float a = sel[4 * gq], b = sel[4 * gq + 1], c = sel[4 * gq + 2], d = sel[4 * gq + 3];
                const float s = fmaxf(fmaxf(fmaxf(a + b, a + c), fmaxf(a + d, b + c)), fmaxf(b + d, c + d));
                if (s > bs) { bs = s; best = gq; } }
            float sv[4], av[4];
#pragma unroll
            for (int i = 0; i < 4; ++i) { sv[i] = sel[i]; av[i] = aff[i]; }
#pragma unroll
            for (int gq = 1; gq < 4; ++gq) if (best == gq) {
#pragma unroll
                for (int i = 0; i < 4; ++i) { sv[i] = sel[4 * gq + i]; av[i] = aff[4 * gq + i]; } }
            int i1 = 0; float s1 = sv[0], a1 = av[0];
#pragma unroll
            for (int i = 1; i < 4; ++i) if (sv[i] > s1) { s1 = sv[i]; a1 = av[i]; i1 = i; }
            int i2 = -1; float s2v = -1e30f, a2 = 0.f;
#pragma unroll
            for (int i = 0; i < 4; ++i) if (i != i1 && sv[i] > s2v) { s2v = sv[i]; a2 = av[i]; i2 = i; }
            const int e1 = 4 * best + i1, e2 = 4 * best + i2;
            const float wsum = a1 + a2, w1 = a1 / wsum, w2 = a2 / wsum;
            const unsigned r1 = atomicAdd((unsigned*)(cnt + e1), 1u), r2 = atomicAdd((unsigned*)(cnt + e2), 1u);
            int* ro = route + (size_t)tqq * 8;
            ro[0] = e1; ro[1] = e2; ro[4] = __builtin_bit_cast(int, w1); ro[5] = __builtin_bit_cast(int, w2);
            tinfo[4 * (tqq - t0) + 0] = e1; tinfo[4 * (tqq - t0) + 1] = e2; tinfo[4 * (tqq - t0) + 2] = (int)r1; tinfo[4 * (tqq - t0) + 3] = (int)r2;
        }
        LDS_WAIT(); asm volatile("" ::: "memory");
    }
    __syncthreads();
    if (F.tid < 16) gb[F.tid] = (int)__hip_atomic_fetch_add((unsigned*)(F.ws + WS_GCNT) + layer * 16 + F.tid, cnt[F.tid], __ATOMIC_RELAXED, __HIP_MEMORY_SCOPE_AGENT);
    __syncthreads();
    int* tokmap = (int*)(F.ws + WS_TOKMAP);
    for (int i = F.tid; i < per; i += 512) {
        const int e1 = tinfo[4 * i], e2 = tinfo[4 * i + 1], p1 = gb[e1] + tinfo[4 * i + 2], p2 = gb[e2] + tinfo[4 * i + 3];
        tokmap[(size_t)e1 * T + p1] = t0 + i; tokmap[(size_t)e2 * T + p2] = t0 + i;
        int* ro = route + (size_t)(t0 + i) * 8; ro[2] = p1; ro[3] = p2;
    }
}

__device__ __forceinline__ int moe_tables(Frame& F, int layer) {
    LAS int* tb = (LAS int*)(F.lds + LDS_CTL + 64); LAS int* cn = (LAS int*)(F.lds + LDS_CTL + 192);
    __syncthreads();
    if (F.tid < 16) cn[F.tid] = ld_coh((const int*)(F.ws + WS_GCNT) + layer * 16 + F.tid);
    __syncthreads();
    if (F.tid == 0) { int b = 0; for (int e = 0; e < 16; ++e) { tb[e] = b; b += (cn[e] + 255) >> 8; } tb[16] = b; }
    __syncthreads();
    return __builtin_amdgcn_readfirstlane(tb[16]);
}

template <int NQ> __device__ __forceinline__ void combine_tokens(Frame& F, int layer, int t) {
    const float* mods = (const float*)(F.ws + WS_MODS);
    const bf16* OS = (const bf16*)(F.ws + WS_BUFP);
    const int* route = (const int*)(F.ws + WS_ROUTE);
    const LAS int* tb = (const LAS int*)(F.lds + LDS_CTL + 64);
    bf16* A = (bf16*)(F.ws + WS_BUFA);
    {
        int rc[NQ][4]; float w0[NQ], w1[NQ];
#pragma unroll
        for (int q = 0; q < NQ; ++q) { const int* ro = route + (size_t)(t + q) * 8;
#pragma unroll
            for (int i = 0; i < 4; ++i) rc[q][i] = ld_coh(ro + i);
            w0[q] = ld_cohf((const float*)(ro + 4)); w1[q] = ld_cohf((const float*)(ro + 5)); }
        f32x4 v[NQ][4]; u32x2 oa[NQ][4], ob[NQ][4];
#pragma unroll
        for (int q = 0; q < NQ; ++q) { const bf16* hr = h_row(F, t + q);
            const size_t s0 = (size_t)(tb[rc[q][0]] * 256 + rc[q][2]) * D, s1 = (size_t)(tb[rc[q][1]] * 256 + rc[q][3]) * D;
#pragma unroll
            for (int j = 0; j < 4; ++j) { const int c = 4 * F.lane + 256 * j; { const u32x2 hv = *(const u32x2*)(hr + c); v[q][j] = (f32x4){bflo(hv.x), bfhi(hv.x), bflo(hv.y), bfhi(hv.y)}; } oa[q][j] = __builtin_nontemporal_load((const u32x2*)(OS + s0 + c)); ob[q][j] = __builtin_nontemporal_load((const u32x2*)(OS + s1 + c)); } }
        const int mr = mod_row(t);
        const float* m5 = mods + (size_t)(layer * 9 + mr) * 6144 + 5 * 1024;
#pragma unroll
        for (int j = 0; j < 4; ++j) { const f32x4 g5 = *(const f32x4*)(m5 + 4 * F.lane + 256 * j);
#pragma unroll
            for (int q = 0; q < NQ; ++q) { const u32x2 a = oa[q][j], b2 = ob[q][j];
                const f32x4 o = (f32x4){w0[q] * bflo(a.x) + w1[q] * bflo(b2.x), w0[q] * bfhi(a.x) + w1[q] * bfhi(b2.x), w0[q] * bflo(a.y) + w1[q] * bflo(b2.y), w0[q] * bfhi(a.y) + w1[q] * bfhi(b2.y)};
                v[q][j] = v[q][j] + g5 * o; } }
#pragma unroll
        for (int q = 0; q < NQ; ++q) {
            if (layer == 0) {
                bf16* hr = h_row(F, t + q);
#pragma unroll
                for (int j = 0; j < 4; ++j) { u32x2 o; o.x = pk2(v[q][j].x, v[q][j].y); o.y = pk2(v[q][j].z, v[q][j].w); *(u32x2*)(hr + 4 * F.lane + 256 * j) = o; }
                const float* m = mods + (size_t)(9 + mr) * 6144;
                norm_mod_store(v[q], F.in[I_NMG] + 1024, m, m + 1024, A + (size_t)(t + q) * D, F.lane);
            } else {
                float s2 = 0.f;
#pragma unroll
                for (int j = 0; j < 4; ++j) s2 += (v[q][j].x * v[q][j].x + v[q][j].y * v[q][j].y) + (v[q][j].z * v[q][j].z + v[q][j].w * v[q][j].w);
                const float rstd = 1.0f / sqrtf(wave_sum(s2) * (1.0f / D) + EPS);
                float* orow = F.out + (size_t)(t + q) * D;
#pragma unroll
                for (int j = 0; j < 4; ++j) { const int c = 4 * F.lane + 256 * j; __builtin_nontemporal_store(v[q][j] * rstd * *(const f32x4*)(F.in[I_FG] + c), (f32x4*)(orow + c)); }
            }
        }
    }
}
__device__ __forceinline__ void phase_combine(Frame& F, int layer, int ntok) {
    const int gw = F.vcu * NWAVES + F.wave, NGW = F.G * NWAVES;
    if (layer == 0) { for (int t = 2 * gw; t < TL; t += 2 * NGW) combine_tokens<2>(F, 0, t); for (int t = TL + gw; t < ntok; t += NGW) combine_tokens<1>(F, 0, t); }
    else { for (int t = 4 * gw; t < TL; t += 4 * NGW) combine_tokens<4>(F, 1, t); }
}

constexpr int KV_LD = 72, VL_OFF = 384 * KV_LD * 2, ROPE_LDS = 131072;
typedef short v4i16_t __attribute__((ext_vector_type(4)));

__device__ __forceinline__ bf16x8 rope_pack(const u32x4 x1, const u32x4 x2, const LAS float* cs, const LAS float* sn, float scale, bool second) {
    const f32x4 c0 = *(const LAS f32x4*)cs, c1 = *(const LAS f32x4*)(cs + 4), s0 = *(const LAS f32x4*)sn, s1 = *(const LAS f32x4*)(sn + 4);
    float c[8] = {c0.x, c0.y, c0.z, c0.w, c1.x, c1.y, c1.z, c1.w}, s[8] = {s0.x, s0.y, s0.z, s0.w, s1.x, s1.y, s1.z, s1.w};
    float a[8], b[8];
#pragma unroll
    for (int i = 0; i < 4; ++i) { a[2 * i] = bflo(x1[i]); a[2 * i + 1] = bfhi(x1[i]); b[2 * i] = bflo(x2[i]); b[2 * i + 1] = bfhi(x2[i]); }
    float o[8];
#pragma unroll
    for (int i = 0; i < 8; ++i) o[i] = (second ? (b[i] * c[i] + a[i] * s[i]) : (a[i] * c[i] - b[i] * s[i])) * scale;
    u32x4 w; w.x = pk2(o[0], o[1]); w.y = pk2(o[2], o[3]); w.z = pk2(o[4], o[5]); w.w = pk2(o[6], o[7]);
    return __builtin_bit_cast(bf16x8, w);
}

struct AttnU { int b, qb, kvh; };
__device__ __forceinline__ AttnU attn_unit_of(int u) { AttnU r; r.kvh = u & 1; r.qb = (u >> 1) & 31; r.b = u >> 6; return r; }

__device__ __forceinline__ void attn_load_latk(Frame& F, const bf16* P1, AttnU u, u32x4 (&lk)[2][4]) {
    const u32x4 z = (u32x4){0u, 0u, 0u, 0u};
#pragma unroll
    for (int it = 0; it < 2; ++it) { const int task = F.tid + 512 * it, kidx = task >> 1, hh = task & 1, pos = u.qb * 128 - 128 + kidx;
        const bool ok = task < 768 && pos >= 0 && pos < NSEQ;
        const bf16* row = P1 + (size_t)(u.b * NSEQ + (ok ? pos : 0)) * OIN + 1024 + u.kvh * 64 + 8 * hh;
#pragma unroll
        for (int st = 0; st < 4; ++st) lk[it][st] = ok ? *(const u32x4*)(row + 16 * st) : z; }
}
__device__ __forceinline__ void attn_load_latv(Frame& F, const bf16* P1, AttnU u, u32x4 (&lv)[6]) {
    const u32x4 z = (u32x4){0u, 0u, 0u, 0u};
#pragma unroll
    for (int it = 0; it < 6; ++it) { const int task = F.tid + 512 * it, kidx = task >> 3, c8 = task & 7, pos = u.qb * 128 - 128 + kidx;
        const bool ok = pos >= 0 && pos < NSEQ;
        lv[it] = ok ? *(const u32x4*)(P1 + (size_t)(u.b * NSEQ + (ok ? pos : 0)) * OIN + 1152 + u.kvh * 64 + 8 * c8) : z; }
}
__device__ __forceinline__ void attn_write_lat(Frame& F, AttnU u, const u32x4 (&lk)[2][4], const u32x4 (&lv)[6]) {
    LAS bf16* KL = (LAS bf16*)F.lds; LAS bf16* VL = (LAS bf16*)(F.lds + VL_OFF); const LAS float* rope = (const LAS float*)(F.lds + ROPE_LDS);
#pragma unroll
    for (int it = 0; it < 2; ++it) { const int task = F.tid + 512 * it, kidx = task >> 1, hh = task & 1; int pos = u.qb * 128 - 128 + kidx; pos = pos < 0 ? 0 : (pos > NSEQ - 1 ? NSEQ - 1 : pos);
        if (task < 768) {
            LAS bf16* d = KL + kidx * KV_LD + 8 * hh;
            const LAS float* c0 = rope + (pos >> 6) * 16 + 8 * hh; const LAS float* c1 = rope + (pos & 63) * 16 + 8 * hh;
            *(LAS bf16x8*)(d) = rope_pack(lk[it][0], lk[it][1], c0, c0 + 1024, 1.0f, false);
            *(LAS bf16x8*)(d + 16) = rope_pack(lk[it][0], lk[it][1], c0, c0 + 1024, 1.0f, true);
            *(LAS bf16x8*)(d + 32) = rope_pack(lk[it][2], lk[it][3], c1, c1 + 1024, 1.0f, false);
            *(LAS bf16x8*)(d + 48) = rope_pack(lk[it][2], lk[it][3], c1, c1 + 1024, 1.0f, true);
        } }
#pragma unroll
    for (int it = 0; it < 6; ++it) { const int task = F.tid + 512 * it, kidx = task >> 3, c8 = task & 7; *(LAS u32x4*)(VL + kidx * KV_LD + 8 * c8) = lv[it]; }
}
__device__ __forceinline__ void attn_load_ctx(Frame& F, const bf16* P1, AttnU u, u32x4 (&ck)[4], u32x4 (&cv)[4]) {
#pragma unroll
    for (int it = 0; it < 4; ++it) { const int task = F.tid + 512 * it, kidx = task >> 3, c8 = task & 7;
        const bf16* row = P1 + (size_t)(TL + u.b * LCTX + kidx) * OIN + 1024 + u.kvh * 64 + 8 * c8;
        ck[it] = *(const u32x4*)row; cv[it] = *(const u32x4*)(row + 128); }
}
__device__ __forceinline__ void attn_write_ctx(Frame& F, const u32x4 (&ck)[4], const u32x4 (&cv)[4]) {
    LAS bf16* KL = (LAS bf16*)F.lds; LAS bf16* VL = (LAS bf16*)(F.lds + VL_OFF);
#pragma unroll
    for (int it = 0; it < 4; ++it) { const int task = F.tid + 512 * it, kidx = task >> 3, c8 = task & 7;
        *(LAS u32x4*)(KL + kidx * KV_LD + 8 * c8) = ck[it]; *(LAS u32x4*)(VL + kidx * KV_LD + 8 * c8) = cv[it]; }
}

__device__ __forceinline__ unsigned cvtpk(float lo, float hi) { unsigned r; asm volatile("v_cvt_pk_bf16_f32 %0, %1, %2" : "=v"(r) : "v"(lo), "v"(hi)); return r; }
__device__ __forceinline__ float xhalf_max(float x) { const auto r = __builtin_amdgcn_permlane32_swap(__builtin_bit_cast(unsigned, x), __builtin_bit_cast(unsigned, x), false, false);
    return fmaxf(__builtin_bit_cast(float, r[0]), __builtin_bit_cast(float, r[1])); }
__device__ __forceinline__ float xhalf_sum(float x) { const auto r = __builtin_amdgcn_permlane32_swap(__builtin_bit_cast(unsigned, x), __builtin_bit_cast(unsigned, x), false, false);
    return __builtin_bit_cast(float, r[0]) + __builtin_bit_cast(float, r[1]); }
__device__ __forceinline__ void attn_tiles(Frame& F, int kt0, int kt1, int mk0, int mk1, const bf16x8 (&qf)[4], f32x16 (&O)[2], float& mrun, float& lrun, int qrel) {
    if (kt0 > kt1) return;
    const LAS bf16* KL = (const LAS bf16*)F.lds; const LAS bf16* VL = (const LAS bf16*)(F.lds + VL_OFF);
    const int r32 = F.lane & 31, hh = F.lane >> 5;
    const int q4 = (F.lane & 15) >> 2, p4 = F.lane & 3, blk = (F.lane >> 4) & 1;
    const LAS bf16* kp = KL + (kt0 * 32 + r32) * KV_LD + 8 * hh;
    const LAS bf16* vp = VL + (kt0 * 32 + 4 * hh + q4) * KV_LD + 16 * blk + 4 * p4;
    bf16x8 kn[4];
#pragma unroll
    for (int st = 0; st < 4; ++st) kn[st] = *(const LAS bf16x8*)(kp + 16 * st);
    for (int kt = kt0; kt <= kt1; ++kt) {
        bf16x8 kf[4];
#pragma unroll
        for (int st = 0; st < 4; ++st) kf[st] = kn[st];
        v4i16_t vlo[2][2], vhi[2][2];
#pragma unroll
        for (int dt = 0; dt < 2; ++dt)
#pragma unroll
            for (int s2 = 0; s2 < 2; ++s2) { vlo[dt][s2] = __builtin_amdgcn_ds_read_tr16_b64_v4i16((LAS v4i16_t*)(vp + (16 * s2) * KV_LD + dt * 32));
                vhi[dt][s2] = __builtin_amdgcn_ds_read_tr16_b64_v4i16((LAS v4i16_t*)(vp + (16 * s2 + 8) * KV_LD + dt * 32)); }
        kp += 32 * KV_LD; vp += 32 * KV_LD;
        if (kt < kt1) {
#pragma unroll
            for (int st = 0; st < 4; ++st) kn[st] = *(const LAS bf16x8*)(kp + 16 * st); }
        __builtin_amdgcn_sched_barrier(0);
        f32x16 s;
#pragma unroll
        for (int r = 0; r < 16; ++r) s[r] = 0.f;
#pragma unroll
        for (int st = 0; st < 4; ++st) s = __builtin_amdgcn_mfma_f32_32x32x16_bf16(kf[st], qf[st], s, 0, 0, 0);
        if (kt == mk0 || kt == mk1) {
#pragma unroll
            for (int r = 0; r < 16; ++r) { const int dlt = kt * 32 + (r & 3) + 8 * (r >> 2) + 4 * hh - qrel; s[r] = (dlt <= 128 && dlt >= -128) ? s[r] : -INFINITY; } }
        float mx = fmaxf(fmaxf(s[0], s[1]), fmaxf(s[2], s[3]));
#pragma unroll
        for (int r = 4; r < 16; r += 4) mx = fmaxf(mx, fmaxf(fmaxf(s[r], s[r + 1]), fmaxf(s[r + 2], s[r + 3])));
        mx = xhalf_max(mx);
        const float mnew = fmaxf(mrun, mx);
        float ps0 = 0.f, ps1 = 0.f;
#pragma unroll
        for (int r = 0; r < 16; r += 2) { s[r] = __builtin_amdgcn_exp2f(s[r] - mnew); s[r + 1] = __builtin_amdgcn_exp2f(s[r + 1] - mnew); ps0 += s[r]; ps1 += s[r + 1]; }
        const float ps = xhalf_sum(ps0 + ps1);
        if (__any(mnew > mrun)) {
            const float alpha = __builtin_amdgcn_exp2f(mrun - mnew);
            lrun *= alpha;
#pragma unroll
            for (int dt = 0; dt < 2; ++dt)
#pragma unroll
                for (int r = 0; r < 16; ++r) O[dt][r] *= alpha;
        }
        lrun += ps; mrun = mnew;
        bf16x8 pb[2];
#pragma unroll
        for (int s2 = 0; s2 < 2; ++s2) { u32x4 w; w.x = cvtpk(s[8 * s2 + 0], s[8 * s2 + 1]); w.y = cvtpk(s[8 * s2 + 2], s[8 * s2 + 3]); w.z = cvtpk(s[8 * s2 + 4], s[8 * s2 + 5]); w.w = cvtpk(s[8 * s2 + 6], s[8 * s2 + 7]);
            pb[s2] = __builtin_bit_cast(bf16x8, w); }
#pragma unroll
        for (int dt = 0; dt < 2; ++dt)
#pragma unroll
            for (int s2 = 0; s2 < 2; ++s2) {
                const bf16x8 va = (bf16x8){vlo[dt][s2][0], vlo[dt][s2][1], vlo[dt][s2][2], vlo[dt][s2][3], vhi[dt][s2][0], vhi[dt][s2][1], vhi[dt][s2][2], vhi[dt][s2][3]};
                O[dt] = __builtin_amdgcn_mfma_f32_32x32x16_bf16(va, pb[s2], O[dt], 0, 0, 0);
            }
    }
}

__device__ __forceinline__ void phase_attn(Frame& F) {
    const bf16* P1 = (const bf16*)(F.ws + WS_BUFP);
    bf16* MIX = (bf16*)(F.ws + WS_BUFA);
    const int r32 = F.lane & 31, hh = F.lane >> 5;
    constexpr float QSC = 0.125f * 1.4426950408889634f;
    LAS float* ropel = (LAS float*)(F.lds + ROPE_LDS);
    for (int i = F.tid; i < 2048; i += 512) ropel[i] = ((const float*)(F.ws + WS_ROPE))[i];
    u32x4 lk[2][4], lv[6], ck[4], cv[4];
    const int nu = (512 - F.vcu + F.G - 1) / F.G;
    if (nu > 0) attn_load_latk(F, P1, attn_unit_of(F.vcu), lk);
    for (int ui = 0; ui < nu; ++ui) {
        const AttnU u = attn_unit_of(F.vcu + ui * F.G);
        u32x4 qr[2][4];
#pragma unroll
        for (int i = 0; i < 2; ++i) { const int task = F.wave + 8 * i, g = task & 3, sub = task >> 2, head = u.kvh * 4 + g, pos = u.qb * 128 + 32 * sub + r32;
            const bf16* row = P1 + (size_t)(u.b * NSEQ + pos) * OIN + 512 + head * 64 + 8 * hh;
#pragma unroll
            for (int st = 0; st < 4; ++st) qr[i][st] = __builtin_nontemporal_load((const u32x4*)(row + 16 * st)); }
        attn_load_latv(F, P1, u, lv);
        __syncthreads();
        attn_write_lat(F, u, lk, lv);
        bf16x8 qf[2][4]; f32x16 O[2][2]; float mrun[2], lrun[2];
#pragma unroll
        for (int i = 0; i < 2; ++i) { const int task = F.wave + 8 * i, g = task & 3, sub = task >> 2, head = u.kvh * 4 + g, pos = u.qb * 128 + 32 * sub + r32;
            const LAS float* c0 = ropel + (pos >> 6) * 16 + 8 * hh; const LAS float* c1 = ropel + (pos & 63) * 16 + 8 * hh;
            qf[i][0] = rope_pack(qr[i][0], qr[i][1], c0, c0 + 1024, QSC, false); qf[i][1] = rope_pack(qr[i][0], qr[i][1], c0, c0 + 1024, QSC, true);
            qf[i][2] = rope_pack(qr[i][2], qr[i][3], c1, c1 + 1024, QSC, false); qf[i][3] = rope_pack(qr[i][2], qr[i][3], c1, c1 + 1024, QSC, true);
            mrun[i] = F.in[I_OSINK][head] * 1.4426950408889634f; lrun[i] = 1.0f;
#pragma unroll
            for (int dt = 0; dt < 2; ++dt)
#pragma unroll
                for (int r = 0; r < 16; ++r) O[i][dt][r] = 0.f; }
        __syncthreads();
        const int kt_lo = (u.qb == 0) ? 4 : 0, kt_hi = (u.qb == 31) ? 7 : 11;
#pragma unroll
        for (int i = 0; i < 2; ++i) { const int sub = (F.wave + 8 * i) >> 2, qrel = 128 + 32 * sub + r32;
            attn_tiles(F, max(sub, kt_lo), min(sub + 8, kt_hi), sub, sub + 8, qf[i], O[i], mrun[i], lrun[i], qrel); }
        attn_load_ctx(F, P1, u, ck, cv);
        __syncthreads();
        attn_write_ctx(F, ck, cv);
        __syncthreads();
        if (ui + 1 < nu) attn_load_latk(F, P1, attn_unit_of(F.vcu + (ui + 1) * F.G), lk);
#pragma unroll
        for (int i = 0; i < 2; ++i) {
            attn_tiles(F, 0, 7, -1, -1, qf[i], O[i], mrun[i], lrun[i], 0);
            const int task = F.wave + 8 * i, g = task & 3, sub = task >> 2, head = u.kvh * 4 + g, pos = u.qb * 128 + 32 * sub + r32;
            const float inv = 1.0f / lrun[i];
            bf16* o = MIX + (size_t)(u.b * NSEQ + pos) * D + 512 + head * 64 + 4 * hh;
#pragma unroll
            for (int dt = 0; dt < 2; ++dt)
#pragma unroll
                for (int rg = 0; rg < 4; ++rg) { u32x2 w; w.x = pk2(O[i][dt][4 * rg] * inv, O[i][dt][4 * rg + 1] * inv); w.y = pk2(O[i][dt][4 * rg + 2] * inv, O[i][dt][4 * rg + 3] * inv);
                    *(u32x2*)(o + dt * 32 + 8 * rg) = w; }
        }
    }
    __syncthreads();
}

__device__ __forceinline__ void phase_pool_stencil(Frame& F) {
    const bf16* P1 = (const bf16*)(F.ws + WS_BUFP);
    bf16* MIX = (bf16*)(F.ws + WS_BUFA);
    const int gw = F.vcu * NWAVES + F.wave, NGW = F.G * NWAVES;
    const int r = 1 << (F.lane >> 4);
    constexpr int NT = 8, NR = NT + 16;
    for (int t = NT * gw; t < TL; t += NT * NGW) {
        const int pos = t & 4095;
        const bf16* base = P1 + (size_t)t * OIN + 8 * F.lane;
        u32x4 v[NR];
#pragma unroll
        for (int jj = 0; jj < NR; ++jj) { const int pj = pos + jj - 8; const bool ok = pj >= 0 && pj < NSEQ; v[jj] = ok ? *(const u32x4*)(base + (ptrdiff_t)(jj - 8) * OIN) : (u32x4){0u, 0u, 0u, 0u}; }
        float acc[NT][8];
#pragma unroll
        for (int q = 0; q < NT; ++q)
#pragma unroll
            for (int i = 0; i < 8; ++i) acc[q][i] = 0.f;
#pragma unroll
        for (int jj = 0; jj < NR; ++jj) {
            float x[8];
#pragma unroll
            for (int i = 0; i < 4; ++i) { x[2 * i] = bflo(v[jj][i]); x[2 * i + 1] = bfhi(v[jj][i]); }
#pragma unroll
            for (int q = 0; q < NT; ++q) { const int dd = jj - 8 - q; if (dd >= -8 && dd <= 8) { const float w = (dd <= r && dd >= -r) ? 1.0f : 0.0f;
#pragma unroll
                for (int i = 0; i < 8; ++i) acc[q][i] += w * x[i]; } }
        }
#pragma unroll
        for (int q = 0; q < NT; ++q) {
            const int pq = pos + q, lo = max(pq - r, 0), hi = min(pq + r + 1, NSEQ);
            const float ic = 1.0f / (float)(hi - lo);
            const u32x4 sv = v[q + 8];
            u32x4 o;
#pragma unroll
            for (int i = 0; i < 4; ++i) o[i] = pk2(acc[q][2 * i] * ic - bflo(sv[i]), acc[q][2 * i + 1] * ic - bfhi(sv[i]));
            *(u32x4*)(MIX + (size_t)(t + q) * D + 8 * F.lane) = o;
        }
    }
}

__device__ __forceinline__ void phase_attn_pool(Frame& F) {
    phase_attn(F);
#ifdef DBG_ATTN2
    phase_attn(F);
#endif
    phase_pool_stencil(F);
    __syncthreads();
    convert_l1_static(F);
}

constexpr int NPHASE = 20;
__global__ void __launch_bounds__(NWAVES * 64, 2) mk_fwd(Args args) {
    extern __shared__ __attribute__((aligned(16))) unsigned char lds_raw[];
    Frame F;
    F.lds = (LAS unsigned char*)lds_raw;
    F.tid = threadIdx.x; F.lane = F.tid & 63; F.wave = __builtin_amdgcn_readfirstlane(F.tid >> 6);
    F.G = gridDim.x; { const int bx = blockIdx.x; F.vcu = (F.G % 8 == 0) ? (bx % 8) * (F.G / 8) + bx / 8 : bx; }
    F.ws = args.ws; F.in = args.in; F.out = args.out;
    for (int u = F.tid; u < (LDS_BYTES - LDS_CTL) / 4; u += NWAVES * 64) ((LAS unsigned*)(F.lds + LDS_CTL))[u] = 0u;
    __syncthreads();
    const int lo = args.ph_lo, hi = args.ph_hi;
    XcdBarrier bar; bar.bar = (unsigned*)(F.ws + WS_CTL); bar.x = 0; bar.st = nullptr;
    if (hi - lo > 1) bar = xcd_barrier_post((unsigned*)(F.ws + WS_CTL), (volatile LAS unsigned*)(F.lds + LDS_CTL));
#define IN(k) (lo <= (k) && (k) < hi)
#ifndef PHASE_MASK
#define PHASE_MASK 0xffffffffu
#endif
#define PH(k, ...) if constexpr (((PHASE_MASK >> (k)) & 1u) != 0u) if (IN(k)) { __VA_ARGS__ if constexpr (((DBG_DOUBLE >> (k)) & 1u) != 0u) { __VA_ARGS__ } }
#define SEAM(k) do { if (IN(k) && IN((k) + 1)) xcd_barrier(bar); } while (0)
    unsigned char* ws = F.ws;
    const float* mods = (const float*)(ws + WS_MODS);

    PH(0, { phase_mods(F); }) SEAM(0);
    PH(1, { phase_prologue_a(F); }) SEAM(1);
    PH(2, {
        pg8::SchedDense S{(const char*)(ws + WS_BUFA), (const char*)(ws + WS_W_EIN), 1024, 8, 136, 0, 1088, F.vcu, F.G};
        pg8::EpiStore E{(bf16*)(ws + WS_BUFP), EIN};
        pg8::gemm_phase<pg8::EpiStore, pg8::SchedDense>(F.lds, 1024, S, E);
    }) SEAM(2);
    PH(3, { phase_fourier_a_conv(F); }) SEAM(3);
    PH(4, { phase_fourier_c(F); }) SEAM(4);
    PH(5, {
        pg8::SchedDense S{(const char*)(ws + WS_BUFA), (const char*)(ws + WS_W_EOUT), 1024, 4, 136, 0, 544, F.vcu, F.G};
        pg8::EpiResid<true> E{F.in[I_X], F.in[I_CTX], (bf16*)(ws + WS_HB), mods + 2 * 1024};
        pg8::gemm_phase<pg8::EpiResid<true>, pg8::SchedDense>(F.lds, 1024, S, E);
    }) SEAM(5);
    PH(6, { phase_route(F, 0, T); }) SEAM(6);
    PH(7, {
        const int ntile = moe_tables(F, 0);
        if constexpr (FP8_G1_L0) {
            pg8::SchedMoe<true> S{(const char*)(ws + WS_BUFA), (const char*)(ws + WS_W_M1) + (size_t)0 * 32 * MiB, (const int*)(ws + WS_TOKMAP), (const LAS int*)(F.lds + LDS_CTL + 64), (const LAS int*)(F.lds + LDS_CTL + 192), 512, (size_t)MiB, ntile * 4, F.vcu, F.G};
            pg8::EpiSwiglu8 E{(unsigned char*)(ws + WS_BUFZ), pg8::W1_SCALE};
            pg8::gemm_phase<pg8::EpiSwiglu8, pg8::SchedMoe<true>, true>(F.lds, 512, S, E);
        } else {
            pg8::SchedMoe<true> S{(const char*)(ws + WS_BUFA), (const char*)(ws + WS_W_M1) + (size_t)0 * 32 * MiB, (const int*)(ws + WS_TOKMAP), (const LAS int*)(F.lds + LDS_CTL + 64), (const LAS int*)(F.lds + LDS_CTL + 192), 1024, (size_t)2 * MiB, ntile * 4, F.vcu, F.G};
            if constexpr (FP8_G2_L0) { pg8::EpiSwiglu8 E{(unsigned char*)(ws + WS_BUFZ), 1.0f}; pg8::gemm_phase<pg8::EpiSwiglu8, pg8::SchedMoe<true>>(F.lds, 1024, S, E); }
            else { pg8::EpiSwiglu E{(bf16*)(ws + WS_BUFZ)}; pg8::gemm_phase<pg8::EpiSwiglu, pg8::SchedMoe<true>>(F.lds, 1024, S, E); }
        }
    }) SEAM(7);
    PH(8, {
        const int ntile = moe_tables(F, 0);
        if constexpr (FP8_G2_L0) {
            pg8::SchedMoe<false> S{(const char*)(ws + WS_BUFZ), (const char*)(ws + WS_W_M2) + (size_t)0 * 16 * MiB, nullptr, (const LAS int*)(F.lds + LDS_CTL + 64), (const LAS int*)(F.lds + LDS_CTL + 192), 256, (size_t)512 * KiB, ntile * 4, F.vcu, F.G};
            pg8::EpiStoreS E{(bf16*)(ws + WS_BUFP), 1024, 1.0f / (pg8::HID_SCALE * pg8::W2_SCALE)};
            pg8::gemm_phase<pg8::EpiStoreS, pg8::SchedMoe<false>, true>(F.lds, 256, S, E);
        } else {
            pg8::SchedMoe<false> S{(const char*)(ws + WS_BUFZ), (const char*)(ws + WS_W_M2) + (size_t)0 * 16 * MiB, nullptr, (const LAS int*)(F.lds + LDS_CTL + 64), (const LAS int*)(F.lds + LDS_CTL + 192), 512, (size_t)MiB, ntile * 4, F.vcu, F.G};
            pg8::EpiStore E{(bf16*)(ws + WS_BUFP), 1024};
            pg8::gemm_phase<pg8::EpiStore, pg8::SchedMoe<false>>(F.lds, 512, S, E);
        }
    }) SEAM(8);
    PH(9, { (void)moe_tables(F, 0); phase_combine(F, 0, T); }) SEAM(9);
    PH(10, {
        pg8::SchedDense S{(const char*)(ws + WS_BUFA), (const char*)(ws + WS_W_OIN), 1024, 5, 128, 4, 648, F.vcu, F.G};
        pg8::EpiStore E{(bf16*)(ws + WS_BUFP), OIN};
        pg8::gemm_phase<pg8::EpiStore, pg8::SchedDense>(F.lds, 1024, S, E);
    }) SEAM(10);
    PH(11, { phase_attn_pool(F); }) SEAM(11);
    PH(12, {
        pg8::SchedDense S{(const char*)(ws + WS_BUFA), (const char*)(ws + WS_W_OOUT), 1024, 4, 128, 0, 512, F.vcu, F.G};
        pg8::EpiResid<false> E{nullptr, nullptr, (bf16*)(ws + WS_HB), mods + 9 * 6144 + 2 * 1024};
        pg8::gemm_phase<pg8::EpiResid<false>, pg8::SchedDense>(F.lds, 1024, S, E);
    }) SEAM(12);
    PH(13, { phase_route(F, 1, TL); }) SEAM(13);
    PH(14, {
        const int ntile = moe_tables(F, 1);
        if constexpr (FP8_G1_L1) {
            pg8::SchedMoe<true> S{(const char*)(ws + WS_BUFA), (const char*)(ws + WS_W_M1) + (size_t)1 * 32 * MiB, (const int*)(ws + WS_TOKMAP), (const LAS int*)(F.lds + LDS_CTL + 64), (const LAS int*)(F.lds + LDS_CTL + 192), 512, (size_t)MiB, ntile * 4, F.vcu, F.G};
            pg8::EpiSwiglu8 E{(unsigned char*)(ws + WS_BUFZ), pg8::W1_SCALE};
            pg8::gemm_phase<pg8::EpiSwiglu8, pg8::SchedMoe<true>, true>(F.lds, 512, S, E);
        } else {
            pg8::SchedMoe<true> S{(const char*)(ws + WS_BUFA), (const char*)(ws + WS_W_M1) + (size_t)1 * 32 * MiB, (const int*)(ws + WS_TOKMAP), (const LAS int*)(F.lds + LDS_CTL + 64), (const LAS int*)(F.lds + LDS_CTL + 192), 1024, (size_t)2 * MiB, ntile * 4, F.vcu, F.G};
            if constexpr (FP8_G2_L1) { pg8::EpiSwiglu8 E{(unsigned char*)(ws + WS_BUFZ), 1.0f}; pg8::gemm_phase<pg8::EpiSwiglu8, pg8::SchedMoe<true>>(F.lds, 1024, S, E); }
            else { pg8::EpiSwiglu E{(bf16*)(ws + WS_BUFZ)}; pg8::gemm_phase<pg8::EpiSwiglu, pg8::SchedMoe<true>>(F.lds, 1024, S, E); }
        }
    }) SEAM(14);
    PH(15, {
        const int ntile = moe_tables(F, 1);
        if constexpr (FP8_G2_L1) {
            pg8::SchedMoe<false> S{(const char*)(ws + WS_BUFZ), (const char*)(ws + WS_W_M2) + (size_t)1 * 16 * MiB, nullptr, (const LAS int*)(F.lds + LDS_CTL + 64), (const LAS int*)(F.lds + LDS_CTL + 192), 256, (size_t)512 * KiB, ntile * 4, F.vcu, F.G};
            pg8::EpiStoreS E{(bf16*)(ws + WS_BUFP), 1024, 1.0f / (pg8::HID_SCALE * pg8::W2_SCALE)};
            pg8::gemm_phase<pg8::EpiStoreS, pg8::SchedMoe<false>, true>(F.lds, 256, S, E);
        } else {
            pg8::SchedMoe<false> S{(const char*)(ws + WS_BUFZ), (const char*)(ws + WS_W_M2) + (size_t)1 * 16 * MiB, nullptr, (const LAS int*)(F.lds + LDS_CTL + 64), (const LAS int*)(F.lds + LDS_CTL + 192), 512, (size_t)MiB, ntile * 4, F.vcu, F.G};
            pg8::EpiStore E{(bf16*)(ws + WS_BUFP), 1024};
            pg8::gemm_phase<pg8::EpiStore, pg8::SchedMoe<false>>(F.lds, 512, S, E);
        }
    }) SEAM(15);
    PH(16, { (void)moe_tables(F, 1); phase_combine(F, 1, TL); }) SEAM(16);
#ifdef DBG_XBAR
    if (hi - lo > 1) { for (int xb = 0; xb < DBG_XBAR; ++xb) xcd_barrier(bar); }
#endif
#undef IN
#undef SEAM
}

extern "C" void kernel_launch(void* const* d_in, const int* in_sizes, int n_in, void* d_out, int out_size, void* d_ws, size_t ws_size, hipStream_t stream) {
    static int grid = 0;
    if (grid == 0) {
        if (n_in != 22 || ws_size < WS_END) { fprintf(stderr, "kernel_launch: unexpected inputs (n_in %d, ws %zu)\n", n_in, ws_size); grid = -1; return; }
        int dev = 0, cus = 0, per_cu = 0;
        if (hipGetDevice(&dev) != hipSuccess || hipDeviceGetAttribute(&cus, hipDeviceAttributeMultiprocessorCount, dev) != hipSuccess) { grid = -1; return; }
        if (hipFuncSetAttribute((const void*)mk_fwd, hipFuncAttributeMaxDynamicSharedMemorySize, LDS_BYTES) != hipSuccess) { fprintf(stderr, "kernel_launch: hipFuncSetAttribute failed\n"); grid = -1; return; }
        if (hipOccupancyMaxActiveBlocksPerMultiprocessor(&per_cu, (const void*)mk_fwd, NWAVES * 64, LDS_BYTES) != hipSuccess || per_cu < 1) { fprintf(stderr, "kernel_launch: occupancy query says %d\n", per_cu); }
        (void)hipGetLastError();
        grid = cus;
        if (grid != 256) { fprintf(stderr, "kernel_launch: %d CUs; this build assumes 256\n", grid); }
    }
    if (grid < 0) return;
    (void)hipMemsetAsync((char*)d_ws + WS_CTL, 0, CTL_ZERO_BYTES, stream);
    Args a{};
    for (int i = 0; i < 22; ++i) a.in[i] = (const float*)d_in[i];
    a.out = (float*)d_out; a.ws = (unsigned char*)d_ws;
#if MK_MULTI
    for (int p = 0; p <= DBG_STOP; ++p) { a.ph_lo = p; a.ph_hi = p + 1; hipLaunchKernelGGL(mk_fwd, dim3(grid), dim3(NWAVES * 64), LDS_BYTES, stream, a); }
    if (DBG_STOP < 16) { a.ph_lo = 17; a.ph_hi = 18; hipLaunchKernelGGL(mk_fwd, dim3(grid), dim3(NWAVES * 64), LDS_BYTES, stream, a); }
#else
    a.ph_lo = 0; a.ph_hi = 17;
    hipLaunchKernelGGL(mk_fwd, dim3(grid), dim3(NWAVES * 64), LDS_BYTES, stream, a);
#endif
}
```

```cpp
#include <hip/hip_runtime.h>
#include <cstdio>
#include <cstdint>
#include <type_traits>

#ifndef MK_MULTI
#define MK_MULTI 0
#endif
#ifndef DBG_STOP
#define DBG_STOP 16
#endif

#ifndef DBG_DOUBLE
#define DBG_DOUBLE 0u
#endif
#ifndef FP8_G1_L0
#define FP8_G1_L0 1
#endif
#ifndef FP8_G1_L1
#define FP8_G1_L1 1
#endif
#ifndef FP8_G2_L0
#define FP8_G2_L0 1
#endif
#ifndef FP8_G2_L1
#define FP8_G2_L1 1
#endif
#define LAS __attribute__((address_space(3)))
#define GAS __attribute__((address_space(1)))
typedef unsigned short bf16;
typedef short bf16x8 __attribute__((ext_vector_type(8)));
typedef short s16x4 __attribute__((ext_vector_type(4)));
typedef float f32x4 __attribute__((ext_vector_type(4)));
typedef float f32x16 __attribute__((ext_vector_type(16)));
typedef unsigned u32x4 __attribute__((ext_vector_type(4)));
typedef unsigned u32x2 __attribute__((ext_vector_type(2)));

constexpr int NB = 8, NSEQ = 4096, D = 1024, LCTX = 256;
constexpr int TL = NB * NSEQ, TC = NB * LCTX, T = TL + TC;
constexpr int EIN = 2048;
constexpr int OIN = 1280;
constexpr int NE = 16, DE = 512;
constexpr int MAXSLOT = 73728;
constexpr float EPS = 1e-6f;

constexpr size_t KiB = 1024, MiB = 1024 * 1024;
constexpr size_t WS_CTL = 0, CTL_ZERO_BYTES = 64 * KiB;
constexpr size_t WS_MODS = 64 * KiB;
constexpr size_t WS_ROPE = WS_MODS + 512 * KiB;
constexpr size_t WS_WA = WS_ROPE + 8 * KiB;
constexpr size_t WS_WAC = WS_WA + 32 * KiB;
constexpr size_t WS_WCC = WS_WAC + 2 * KiB;
constexpr size_t WS_FD = 3 * MiB - 64 * KiB;
constexpr size_t WS_BCNT = WS_WCC + 16 * KiB;
constexpr size_t WS_TILEMAP = WS_BCNT + 16 * KiB;
constexpr size_t WS_SLOT = WS_TILEMAP + 2 * KiB;
constexpr size_t WS_WROW = WS_SLOT + 288 * KiB;
constexpr size_t WS_ROUTE = WS_WROW + 288 * KiB;
constexpr size_t WS_WC = 3 * MiB;
constexpr size_t WS_W_EIN = 4 * MiB;
constexpr size_t WS_W_EOUT = 9 * MiB;
constexpr size_t WS_W_OIN = 11 * MiB;
constexpr size_t WS_W_OOUT = 14 * MiB;
constexpr size_t WS_W_POOL = 16 * MiB;
constexpr size_t WS_W_M1 = 17 * MiB;
constexpr size_t WS_W_M2 = 81 * MiB;
constexpr size_t WS_HC = 113 * MiB;
constexpr size_t WS_BUFA = 121 * MiB;
constexpr size_t WS_BUFP = 189 * MiB;
constexpr size_t WS_BUFZ = 360 * MiB;
constexpr size_t WS_TOKMAP = 432 * MiB;
constexpr size_t WS_HB = 435 * MiB;
constexpr size_t WS_END = 503 * MiB;
constexpr size_t WS_MODSDONE = 24 * KiB;
constexpr size_t WS_GCNT = 16 * KiB;
static_assert(WS_ROUTE + (size_t)T * 32 <= WS_WC, "small region");
static_assert((size_t)T * EIN * 2 <= WS_BUFZ - WS_BUFP && (size_t)MAXSLOT * 1024 * 2 <= WS_BUFZ - WS_BUFP, "BUFP");
static_assert((size_t)MAXSLOT * 512 * 2 <= WS_TOKMAP - WS_BUFZ && (size_t)T * 1024 * 2 <= WS_TOKMAP - WS_BUFZ, "BUFZ");
static_assert((size_t)16 * T * 4 <= WS_HB - WS_TOKMAP && (size_t)T * 1024 * 2 <= WS_END - WS_HB, "TOKMAP / HB");
static_assert((size_t)T * 1024 * 2 <= WS_BUFP - WS_BUFA, "BUFA");

constexpr int LDS_BYTES = 163840;
constexpr int LDS_GIDX = 147456;
constexpr int LDS_CTL = 146432;
constexpr int NWAVES = 8;

__device__ __forceinline__ unsigned f2bf(float f) { unsigned u = __builtin_bit_cast(unsigned, f); return (u + 0x7fffu + ((u >> 16) & 1u)) >> 16; }
__device__ __forceinline__ unsigned pk2(float lo, float hi) { return f2bf(lo) | (f2bf(hi) << 16); }
__device__ __forceinline__ float bflo(unsigned w) { return __builtin_bit_cast(float, w << 16); }
__device__ __forceinline__ float bfhi(unsigned w) { return __builtin_bit_cast(float, w & 0xffff0000u); }
__device__ __forceinline__ float wave_sum(float v) {
#pragma unroll
    for (int o = 1; o < 64; o <<= 1) v += __shfl_xor(v, o);
    return v;
}
__device__ __forceinline__ int ld_coh(const int* p) { return (int)__hip_atomic_load((const unsigned*)p, __ATOMIC_RELAXED, __HIP_MEMORY_SCOPE_AGENT); }
__device__ __forceinline__ float ld_cohf(const float* p) { return __builtin_bit_cast(float, __hip_atomic_load((const unsigned*)p, __ATOMIC_RELAXED, __HIP_MEMORY_SCOPE_AGENT)); }
#define LDS_WAIT() asm volatile("s_waitcnt lgkmcnt(0)" ::: "memory")

#define XB_TMO      128
#define XB_XCNT(j)  (256  + 64 * (j))
#define XB_XSUB(j)  (1280 + 64 * (j))
#define XB_XGEN(j)  (2304 + 64 * (j))
#define XB_TOP      3328
#define XB_TOPGEN   3392
#define XCD_BAR_WORDS 3456
#define XB_SPIN_CAP (1u << 18)
__device__ __forceinline__ unsigned xb_ld(unsigned* p)              { return __hip_atomic_load(p, __ATOMIC_RELAXED, __HIP_MEMORY_SCOPE_AGENT); }
__device__ __forceinline__ unsigned xb_add(unsigned* p, unsigned v) { return __hip_atomic_fetch_add(p, v, __ATOMIC_RELAXED, __HIP_MEMORY_SCOPE_AGENT); }
__device__ __forceinline__ unsigned xb_xcc_id() { return (unsigned)__builtin_amdgcn_s_getreg((3 << 11) | 20) & 0xFu; }
#define XB_SPIN(cond, bar) do { unsigned _sp = 0; while (cond) { __builtin_amdgcn_s_sleep(1); \
    if ((++_sp & 255u) == 0u) { if (xb_ld(&(bar)[XB_TMO])) break; if (_sp > XB_SPIN_CAP) { atomicAdd(&(bar)[XB_TMO], 1u); break; } } } } while (0)
struct XcdBarrier { unsigned* bar; unsigned x; volatile LAS unsigned* st; };
__device__ __forceinline__ XcdBarrier xcd_barrier_post(unsigned* bar, volatile LAS unsigned* st) {
    XcdBarrier b; b.bar = bar; b.x = xb_xcc_id(); b.st = st;
    if (threadIdx.x == 0) (void)xb_add(&bar[XB_XCNT(b.x)], 1u);
    return b;
}
__device__ __forceinline__ void xcd_barrier_complete(unsigned* bar, unsigned x, unsigned& nloc, unsigned& nx) {
    const unsigned G = gridDim.x * gridDim.y * gridDim.z;
    unsigned sum, cnt, mine, sp = 0u;
    for (;;) {
        sum = 0u; cnt = 0u; mine = 0u;
#pragma unroll
        for (unsigned j = 0; j < 16; ++j) { const unsigned c = xb_ld(&bar[XB_XCNT(j)]); sum += c; cnt += (c > 0u) ? 1u : 0u; mine = (j == x) ? c : mine; }
        if (sum == G) break;
        __builtin_amdgcn_s_sleep(1);
        if ((++sp & 255u) == 0u) { if (xb_ld(&bar[XB_TMO])) break; if (sp > XB_SPIN_CAP) { atomicAdd(&bar[XB_TMO], 1u); break; } }
    }
    nloc = mine > 0u ? mine : 1u; nx = cnt > 0u ? cnt : 1u;
}
__device__ __forceinline__ void xcd_barrier(const XcdBarrier& b) {
    asm volatile("s_waitcnt vmcnt(0)" ::: "memory");
    __syncthreads();
    if (threadIdx.x == 0) {
        unsigned* bar = b.bar;
        __builtin_amdgcn_s_waitcnt(0);
        unsigned nloc = b.st[0], nx = b.st[1];
        if (nloc == 0u) { xcd_barrier_complete(bar, b.x, nloc, nx); b.st[0] = nloc; b.st[1] = nx; }
        const unsigned old = xb_add(&bar[XB_XSUB(b.x)], 1u);
        const unsigned gen = old / nloc;
        if (old + 1u == (gen + 1u) * nloc) {
            __builtin_amdgcn_fence(__ATOMIC_RELEASE, "agent");
            asm volatile("s_waitcnt vmcnt(0)" ::: "memory");
            const unsigned og = xb_add(&bar[XB_TOP], 1u);
            const unsigned tg = og / nx;
            if (og + 1u == (tg + 1u) * nx) xb_add(&bar[XB_TOPGEN], 1u);
            else XB_SPIN(xb_ld(&bar[XB_TOPGEN]) == tg, bar);
            __builtin_amdgcn_fence(__ATOMIC_ACQUIRE, "agent");
            xb_add(&bar[XB_XGEN(b.x)], 1u);
            asm volatile("s_waitcnt vmcnt(0)" ::: "memory");
        } else {
            XB_SPIN(xb_ld(&bar[XB_XGEN(b.x)]) == gen, bar);
            __builtin_amdgcn_fence(__ATOMIC_ACQUIRE, "agent");
            asm volatile("s_waitcnt vmcnt(0)" ::: "memory");
        }
    }
    __syncthreads();
}

namespace pg8 {
constexpr int BM = 256, BK = 64, HALF = 128, HTB = HALF * BK * 2, STAGE_BYTES = 8 * HTB;
__host__ __device__ __forceinline__ int lds_byte(int r, int c) { const int st = (r >> 4) * 2 + (c >> 5), rr = r & 15, cc = c & 31, ob = rr * 64 + cc * 2; return st * 1024 + (ob ^ (((ob >> 9) & 1) << 5)); }
__host__ __device__ __forceinline__ void stage_rc(int b, int& R, int& C) { const int st = b / 1024, sb = b % 1024, swz = sb ^ (((sb >> 9) & 1) << 5); R = (st >> 1) * 16 + swz / 64; C = (st & 1) * 32 + (swz % 64) / 2; }
__host__ __device__ __forceinline__ int perm32(int rho) { const int n = rho >> 4, i = rho & 15; return 8 * (i >> 2) + 4 * n + (i & 3); }
struct Unit { int pm, pn, e; };
__device__ __forceinline__ unsigned cvt_pk_bf16(float lo, float hi) { unsigned r; asm volatile("v_cvt_pk_bf16_f32 %0, %1, %2" : "=v"(r) : "v"(lo), "v"(hi)); return r; }

typedef int v8i32 __attribute__((ext_vector_type(8)));
typedef int v4i32 __attribute__((ext_vector_type(4)));
__device__ __forceinline__ v8i32 cat16(const bf16x8 lo, const bf16x8 hi) { return __builtin_shufflevector(__builtin_bit_cast(v4i32, lo), __builtin_bit_cast(v4i32, hi), 0, 1, 2, 3, 4, 5, 6, 7); }
template <class Epi, class Sched, bool FP8 = false>
__device__ __forceinline__ void gemm_phase(LAS unsigned char* lds, const int K, const Sched& S, const Epi& E) {
    const int tid = threadIdx.x, wid = __builtin_amdgcn_readfirstlane(tid >> 6), lane = tid & 63, wr = wid >> 2, wc = wid & 3, fr = lane & 15, fq = lane >> 4;
    const int nt = K / BK;
    int tidv = tid;
#define PG8_VB(i) ([&]() -> unsigned { int R_, C_; stage_rc(tidv * 16 + (i) * 8192, R_, C_); const int Rb_ = Epi::PERM ? ((R_ & ~31) + perm32(R_ & 31)) : R_; return (unsigned)(Rb_ * K + C_) * 2u; }())
#define PG8_VA(h, i) ([&]() -> unsigned { int R_, C_; stage_rc(tidv * 16 + (i) * 8192, R_, C_); return (unsigned)((128 * (h) + R_) * K + C_) * 2u; }())
    const size_t kstep = (size_t)(BK * 2);
    const size_t hstep = (size_t)HALF * K * 2;
    const unsigned ldsw = (unsigned)wid * 1024u;
#define aoff (lds_byte(wr * 64 + (tidv & 15), ((tidv >> 4) & 3) * 8))
#define boff (lds_byte(wc * 32 + (tidv & 15), ((tidv >> 4) & 3) * 8))
#define PG8_SA(b, h) (((b) * 2 + (h)) * HTB)
#define PG8_SB(b, h) ((4 + (b) * 2 + (h)) * HTB)
#define PG8_STAGEB(bufoff, gbase) do { _Pragma("unroll") for (int _i = 0; _i < 2; ++_i) \
        __builtin_amdgcn_global_load_lds((const unsigned*)((const char*)(gbase) + PG8_VB(_i)), (LAS unsigned*)(lds + (bufoff) + ldsw + _i * 8192), 16, 0, 0); } while (0)
#define PG8_STAGEA(bufoff, gbase, h, NEXT) do { _Pragma("unroll") for (int _i = 0; _i < 2; ++_i) { unsigned vo_; \
        if constexpr (Sched::GATHER) { int R_, C_; stage_rc(tidv * 16 + _i * 8192, R_, C_); const unsigned raw_ = gidx[((((NEXT) && usen) ? (gslot ^ 1u) : gslot) * 4u + (h) * 2 + _i) * 512u + tid]; vo_ = (raw_ * (unsigned)K + (unsigned)C_) * 2u; } \
        else vo_ = PG8_VA(h, _i); \
        __builtin_amdgcn_global_load_lds((const unsigned*)((const char*)(gbase) + vo_), (LAS unsigned*)(lds + (bufoff) + ldsw + _i * 8192), 16, 0, 0); } } while (0)
#define PG8_LDA(dst, b, h) do { _Pragma("unroll") for (int m = 0; m < 4; ++m) _Pragma("unroll") for (int k = 0; k < 2; ++k) dst[m][k] = *(const LAS bf16x8*)(lds + PG8_SA(b, h) + aoff + m * 2048 + k * 1024); } while (0)
#define PG8_LDB(dst, b, h) do { _Pragma("unroll") for (int n = 0; n < 2; ++n) _Pragma("unroll") for (int k = 0; k < 2; ++k) dst[n][k] = *(const LAS bf16x8*)(lds + PG8_SB(b, h) + boff + n * 2048 + k * 1024); } while (0)
#define PG8_MMA(ai, bj, At, Bt) do { __builtin_amdgcn_s_setprio(1); _Pragma("unroll") for (int m = 0; m < 4; ++m) _Pragma("unroll") for (int n = 0; n < 2; ++n) { \
        if constexpr (FP8) acc[ai][bj][m][n] = __builtin_amdgcn_mfma_scale_f32_16x16x128_f8f6f4(cat16(Bt[n][0], Bt[n][1]), cat16(At[m][0], At[m][1]), acc[ai][bj][m][n], 0, 0, 0, 0x7f7f7f7f, 0, 0x7f7f7f7f); \
        else { _Pragma("unroll") for (int k = 0; k < 2; ++k) acc[ai][bj][m][n] = __builtin_amdgcn_mfma_f32_16x16x32_bf16(Bt[n][k], At[m][k], acc[ai][bj][m][n], 0, 0, 0); } } \
        __builtin_amdgcn_s_setprio(0); } while (0)
#define PG8_WAIT_V(n) asm volatile("s_waitcnt vmcnt(" #n ")" ::: "memory")
#define PG8_WAIT_L(n) asm volatile("s_waitcnt lgkmcnt(" #n ")" ::: "memory")
#define PG8_BAR __builtin_amdgcn_s_barrier()
#define PG8_SCHED __builtin_amdgcn_sched_barrier(0)
#define PG8_ITER(A1, A2, A3, B2, B3) do { \
            PG8_LDB(B0, 0, 0); PG8_LDB(B1, 0, 1); PG8_SCHED; PG8_LDA(At, 0, 0); PG8_STAGEA(PG8_SA(1, 1), A1, 1, 0); \
            PG8_WAIT_V(8); PG8_WAIT_L(0); PG8_BAR; PG8_MMA(0, 0, At, B0); PG8_MMA(0, 1, At, B1); PG8_BAR; PG8_SCHED; \
            PG8_LDA(At, 0, 1); PG8_STAGEB(PG8_SB(0, 0), B2); PG8_STAGEB(PG8_SB(0, 1), (B2) + hstep); PG8_STAGEA(PG8_SA(0, 0), A2, 0, 1); \
            PG8_WAIT_V(8); PG8_WAIT_L(0); PG8_BAR; PG8_MMA(1, 0, At, B0); PG8_MMA(1, 1, At, B1); PG8_BAR; PG8_SCHED; \
            PG8_LDB(B0, 1, 0); PG8_LDB(B1, 1, 1); PG8_SCHED; PG8_LDA(At, 1, 0); PG8_STAGEA(PG8_SA(0, 1), A2, 1, 1); \
            PG8_WAIT_V(8); PG8_WAIT_L(0); PG8_BAR; PG8_MMA(0, 0, At, B0); PG8_MMA(0, 1, At, B1); PG8_BAR; PG8_SCHED; \
            PG8_LDA(At, 1, 1); PG8_STAGEB(PG8_SB(1, 0), B3); PG8_STAGEB(PG8_SB(1, 1), (B3) + hstep); PG8_STAGEA(PG8_SA(1, 0), A3, 0, 1); \
            PG8_WAIT_V(8); PG8_WAIT_L(0); PG8_BAR; PG8_MMA(1, 0, At, B0); PG8_MMA(1, 1, At, B1); PG8_BAR; PG8_SCHED; } while (0)
    Unit cur, nxt; int ui = 0;
    if (!S.next(0, cur)) return;
    f32x4 acc[2][2][4][2];
#pragma unroll
    for (int a = 0; a < 2; ++a)
#pragma unroll
        for (int b = 0; b < 2; ++b)
#pragma unroll
            for (int m = 0; m < 4; ++m)
#pragma unroll
                for (int n = 0; n < 2; ++n) acc[a][b][m][n] = (f32x4){0.f, 0.f, 0.f, 0.f};
    bf16x8 At[4][2], B0[2][2], B1[2][2];
    const LAS unsigned* gidx = (const LAS unsigned*)(lds + LDS_GIDX); unsigned gslot = 0u;
    if constexpr (Sched::GATHER) { S.idx_dma(cur, (LAS unsigned*)(lds + LDS_GIDX), tidv, wid); asm volatile("s_waitcnt vmcnt(0)" ::: "memory"); }
    const char* cA = S.a_base(cur); const char* cB = S.b_base(cur);
    constexpr bool usen = false;
    PG8_STAGEB(PG8_SB(0, 0), cB); PG8_STAGEB(PG8_SB(0, 1), cB + hstep); PG8_STAGEA(PG8_SA(0, 0), cA, 0, 0); PG8_STAGEA(PG8_SA(0, 1), cA, 1, 0);
    if (wr == 1) PG8_BAR;
    PG8_WAIT_V(2); PG8_BAR;
    PG8_STAGEB(PG8_SB(1, 0), cB + kstep); PG8_STAGEA(PG8_SA(1, 0), cA + kstep, 0, 0); PG8_STAGEB(PG8_SB(1, 1), cB + hstep + kstep);
    PG8_WAIT_V(6); PG8_BAR;
    for (;;) {
        const bool has_next = S.next(ui + 1, nxt);
        const char* nA = has_next ? S.a_base(nxt) : cA; const char* nB = has_next ? S.b_base(nxt) : cB;
#pragma unroll 1
        for (int t = 0; t < nt; t += 2) {
            const bool last = (t == nt - 2);
            const char* a1 = cA + (size_t)(t + 1) * kstep;
            const char* a2 = last ? nA : cA + (size_t)(t + 2) * kstep; const char* b2 = last ? nB : cB + (size_t)(t + 2) * kstep;
            tidv = tid; asm volatile("" : "+v"(tidv));
            if constexpr (Sched::GATHER) {
                if (t == nt - 4 && has_next) S.idx_dma(nxt, (LAS unsigned*)(lds + LDS_GIDX) + (gslot ^ 1u) * 2048u, tidv, wid);
            }
            const bool usen = last && has_next;
            PG8_ITER(a1, a2, a2 + kstep, b2, b2 + kstep);
        }
        if (wr == 0) PG8_BAR;
        E(acc, cur, wr, wc, fr, fq);
        if (!has_next) break;
#pragma unroll
        for (int a = 0; a < 2; ++a)
#pragma unroll
            for (int b = 0; b < 2; ++b)
#pragma unroll
                for (int m = 0; m < 4; ++m)
#pragma unroll
                    for (int n = 0; n < 2; ++n) acc[a][b][m][n] = (f32x4){0.f, 0.f, 0.f, 0.f};
        cur = nxt; cA = nA; cB = nB; ++ui;
        if constexpr (Sched::GATHER) gslot ^= 1u;
        if (wr == 1) PG8_BAR;
    }
    PG8_WAIT_V(0);
    PG8_BAR;
#undef PG8_ITER
#undef aoff
#undef boff
#undef PG8_SA
#undef PG8_SB
#undef PG8_STAGEA
#undef PG8_STAGEB
#undef PG8_VA
#undef PG8_VB
#undef PG8_LDA
#undef PG8_LDB
#undef PG8_MMA
#undef PG8_WAIT_V
#undef PG8_WAIT_L
#undef PG8_BAR
#undef PG8_SCHED
}

struct SchedDense {
    static constexpr bool GATHER = false;
    const char* A; const char* Bt; int K, nN, nMfull, pnx, nUnits, c, G;
    __device__ __forceinline__ bool next(int i, Unit& u) const {
        const int L = i * G + c; if (L >= nUnits) return false;
        const int full = nMfull * nN;
        if (L < full) { u.pm = L / nN; u.pn = L - u.pm * nN; } else { u.pm = nMfull + (L - full); u.pn = pnx; }
        u.e = 0; return true;
    }
    __device__ __forceinline__ const char* a_base(const Unit& u) const { return A + (size_t)u.pm * 256 * K * 2; }
    __device__ __forceinline__ const char* b_base(const Unit& u) const { return Bt + (size_t)u.pn * 256 * K * 2; }
};
template <bool GATHER_> struct SchedMoe {
    static constexpr bool GATHER = GATHER_, gather = GATHER_;
    const char* A; const char* W; const int* tokmap; const LAS int* tb; const LAS int* cn; int K; size_t wstride; int nUnits, c, G;
    __device__ __forceinline__ bool next(int i, Unit& u) const {
        const int L = i * G + c; if (L >= nUnits) return false;
        u.pm = L >> 2; u.pn = L & 3; int e = 0;
#pragma unroll
        for (int q = 1; q < 16; ++q) if (u.pm >= __builtin_amdgcn_readfirstlane(tb[q])) e = q;
        u.e = __builtin_amdgcn_readfirstlane(e); return true;
    }
    __device__ __forceinline__ const char* a_base(const Unit& u) const { return gather ? A : A + (size_t)u.pm * 256 * K * 2; }
    __device__ __forceinline__ const char* b_base(const Unit& u) const { return W + (size_t)u.e * wstride + (size_t)u.pn * 256 * K * 2; }
    __device__ __forceinline__ void idx_dma(const Unit& u, LAS unsigned* slot, int tidv, int wid) const {
        const int p0 = (u.pm - __builtin_amdgcn_readfirstlane(tb[u.e])) * 256, last = __builtin_amdgcn_readfirstlane(cn[u.e]) - 1; const int* tm = tokmap + (size_t)u.e * T;
#pragma unroll
        for (int h = 0; h < 2; ++h)
#pragma unroll
            for (int i = 0; i < 2; ++i) { int R_, C_; stage_rc(tidv * 16 + i * 8192, R_, C_); int pos = p0 + 128 * h + R_; pos = pos < last ? pos : last;
                __builtin_amdgcn_global_load_lds((const unsigned*)(tm + pos), slot + (h * 2 + i) * 512 + wid * 64, 4, 0, 0); }
    }
};

struct EpiStore {
    static constexpr bool PERM = true;
    bf16* O; int ldc;
    __device__ __forceinline__ void operator()(const f32x4 (&acc)[2][2][4][2], const Unit& u, int wr, int wc, int fr, int fq) const {
        const int row0 = u.pm * BM + wr * 64 + fr, col0 = u.pn * BM + wc * 32 + 8 * fq;
#pragma unroll
        for (int ai = 0; ai < 2; ++ai)
#pragma unroll
            for (int m = 0; m < 4; ++m) { bf16* rowp = O + (size_t)(row0 + ai * HALF + m * 16) * ldc + col0;
#pragma unroll
                for (int bj = 0; bj < 2; ++bj) { const f32x4 v0 = acc[ai][bj][m][0], v1 = acc[ai][bj][m][1];
                    u32x4 w; w.x = cvt_pk_bf16(v0[0], v0[1]); w.y = cvt_pk_bf16(v0[2], v0[3]); w.z = cvt_pk_bf16(v1[0], v1[1]); w.w = cvt_pk_bf16(v1[2], v1[3]);
                    *(u32x4*)(rowp + bj * HALF) = w; } }
    }
};
template <bool SRC_F32> struct EpiResid {
    static constexpr bool PERM = true;
    const float* srcL; const float* srcC; bf16* H; const float* gate;
    __device__ __forceinline__ void operator()(const f32x4 (&acc)[2][2][4][2], const Unit& u, int wr, int wc, int fr, int fq) const {
        const float* g = gate + (u.pm < 128 ? (u.pm >> 4) : 8) * 6144;
        const float* src = (u.pm < 128) ? srcL + (size_t)u.pm * 256 * 1024 : srcC + (size_t)(u.pm - 128) * 256 * 1024;
        bf16* dst = H + (size_t)u.pm * 256 * 1024;
        const int row0 = wr * 64 + fr, col0 = u.pn * BM + wc * 32 + 8 * fq;
        f32x4 gv[2][2];
#pragma unroll
        for (int bj = 0; bj < 2; ++bj)
#pragma unroll
            for (int n = 0; n < 2; ++n) gv[bj][n] = *(const f32x4*)(g + col0 + bj * HALF + 4 * n);
#pragma unroll
        for (int ai = 0; ai < 2; ++ai)
#pragma unroll
            for (int m = 0; m < 4; ++m) { const size_t ro = (size_t)(row0 + ai * HALF + m * 16) * 1024 + col0;
#pragma unroll
                for (int bj = 0; bj < 2; ++bj) {
                    f32x4 s0, s1;
                    if constexpr (SRC_F32) { s0 = __builtin_nontemporal_load((const f32x4*)(src + ro + bj * HALF)); s1 = __builtin_nontemporal_load((const f32x4*)(src + ro + bj * HALF + 4)); }
                    else { const u32x4 hv = *(const u32x4*)(dst + ro + bj * HALF); s0 = (f32x4){bflo(hv.x), bfhi(hv.x), bflo(hv.y), bfhi(hv.y)}; s1 = (f32x4){bflo(hv.z), bfhi(hv.z), bflo(hv.w), bfhi(hv.w)}; }
                    const f32x4 v0 = s0 + gv[bj][0] * acc[ai][bj][m][0], v1 = s1 + gv[bj][1] * acc[ai][bj][m][1];
                    u32x4 w; w.x = cvt_pk_bf16(v0[0], v0[1]); w.y = cvt_pk_bf16(v0[2], v0[3]); w.z = cvt_pk_bf16(v1[0], v1[1]); w.w = cvt_pk_bf16(v1[2], v1[3]);
                    *(u32x4*)(dst + ro + bj * HALF) = w; } }
    }
};
__device__ __forceinline__ float silu_f(float x) { return x * __builtin_amdgcn_rcpf(1.0f + __expf(-x)); }
struct EpiSwiglu {
    static constexpr bool PERM = true;
    bf16* H;
    __device__ __forceinline__ void operator()(const f32x4 (&acc)[2][2][4][2], const Unit& u, int wr, int wc, int fr, int fq) const {
        const int row0 = u.pm * BM + wr * 64 + fr, col0 = u.pn * 128 + wc * 32 + 8 * fq;
#pragma unroll
        for (int ai = 0; ai < 2; ++ai)
#pragma unroll
            for (int m = 0; m < 4; ++m) { bf16* p = H + (size_t)(row0 + ai * HALF + m * 16) * 512 + col0;
                const f32x4 g0 = acc[ai][0][m][0], g1 = acc[ai][0][m][1], u0 = acc[ai][1][m][0], u1 = acc[ai][1][m][1];
                u32x4 w; w.x = cvt_pk_bf16(silu_f(g0[0]) * u0[0], silu_f(g0[1]) * u0[1]); w.y = cvt_pk_bf16(silu_f(g0[2]) * u0[2], silu_f(g0[3]) * u0[3]);
                w.z = cvt_pk_bf16(silu_f(g1[0]) * u1[0], silu_f(g1[1]) * u1[1]); w.w = cvt_pk_bf16(silu_f(g1[2]) * u1[2], silu_f(g1[3]) * u1[3]);
                *(u32x4*)p = w; }
    }
};
__device__ __forceinline__ unsigned pk4_fp8(float a, float b, float c, float d) { int p = __builtin_amdgcn_cvt_pk_fp8_f32(a, b, 0, false); p = __builtin_amdgcn_cvt_pk_fp8_f32(c, d, p, true); return (unsigned)p; }
constexpr float W1_SCALE = 32.0f, W2_SCALE = 16.0f, HID_SCALE = 4.0f;
struct EpiSwiglu8 {
    static constexpr bool PERM = true;
    unsigned char* H; float in_scale;
    __device__ __forceinline__ void operator()(const f32x4 (&acc)[2][2][4][2], const Unit& u, int wr, int wc, int fr, int fq) const {
        const int row0 = u.pm * BM + wr * 64 + fr, col0 = u.pn * 128 + wc * 32 + 8 * fq;
        const float IS = 1.0f / in_scale, OS = HID_SCALE / in_scale;
#pragma unroll
        for (int ai = 0; ai < 2; ++ai)
#pragma unroll
            for (int m = 0; m < 4; ++m) { unsigned char* p = H + (size_t)(row0 + ai * HALF + m * 16) * 512 + col0;
                const f32x4 g0 = acc[ai][0][m][0] * IS, g1 = acc[ai][0][m][1] * IS, u0 = acc[ai][1][m][0] * OS, u1 = acc[ai][1][m][1] * OS;
#define HC8(x) __builtin_fminf(__builtin_fmaxf((x), -448.0f), 448.0f)
                u32x2 w; w.x = pk4_fp8(HC8(silu_f(g0[0]) * u0[0]), HC8(silu_f(g0[1]) * u0[1]), HC8(silu_f(g0[2]) * u0[2]), HC8(silu_f(g0[3]) * u0[3]));
                w.y = pk4_fp8(HC8(silu_f(g1[0]) * u1[0]), HC8(silu_f(g1[1]) * u1[1]), HC8(silu_f(g1[2]) * u1[2]), HC8(silu_f(g1[3]) * u1[3]));
#undef HC8
                *(u32x2*)p = w; }
    }
};
struct EpiStoreS {
    static constexpr bool PERM = true;
    bf16* O; int ldc; float scale;
    __device__ __forceinline__ void operator()(const f32x4 (&acc)[2][2][4][2], const Unit& u, int wr, int wc, int fr, int fq) const {
        const int row0 = u.pm * BM + wr * 64 + fr, col0 = u.pn * BM + wc * 32 + 8 * fq;
#pragma unroll
        for (int ai = 0; ai < 2; ++ai)
#pragma unroll
            for (int m = 0; m < 4; ++m) { bf16* rowp = O + (size_t)(row0 + ai * HALF + m * 16) * ldc + col0;
#pragma unroll
                for (int bj = 0; bj < 2; ++bj) { const f32x4 v0 = acc[ai][bj][m][0] * scale, v1 = acc[ai][bj][m][1] * scale;
                    u32x4 w; w.x = cvt_pk_bf16(v0[0], v0[1]); w.y = cvt_pk_bf16(v0[2], v0[3]); w.z = cvt_pk_bf16(v1[0], v1[1]); w.w = cvt_pk_bf16(v1[2], v1[3]);
                    *(u32x4*)(rowp + bj * HALF) = w; } }
    }
};
struct EpiScaleRow {
    static constexpr bool PERM = true;
    bf16* O; const float* wrow;
    __device__ __forceinline__ void operator()(const f32x4 (&acc)[2][2][4][2], const Unit& u, int wr, int wc, int fr, int fq) const {
        const int row0 = u.pm * BM + wr * 64 + fr, col0 = u.pn * BM + wc * 32 + 8 * fq;
#pragma unroll
        for (int ai = 0; ai < 2; ++ai)
#pragma unroll
            for (int m = 0; m < 4; ++m) { const int row = row0 + ai * HALF + m * 16; const float s = wrow[row]; bf16* rowp = O + (size_t)row * 1024 + col0;
#pragma unroll
                for (int bj = 0; bj < 2; ++bj) { const f32x4 v0 = acc[ai][bj][m][0] * s, v1 = acc[ai][bj][m][1] * s;
                    u32x4 w; w.x = cvt_pk_bf16(v0[0], v0[1]); w.y = cvt_pk_bf16(v0[2], v0[3]); w.z = cvt_pk_bf16(v1[0], v1[1]); w.w = cvt_pk_bf16(v1[2], v1[3]);
                    *(u32x4*)(rowp + bj * HALF) = w; } }
    }
};
}

struct Args { const float* in[22]; float* out; unsigned char* ws; int ph_lo, ph_hi; };
enum { I_X = 0, I_C, I_CTX, I_CCTX, I_ADAW, I_ADAB, I_NMG, I_NFG, I_EWIN, I_ECONV, I_EWOUT, I_OWIN, I_OPOOLW, I_OPOOLS, I_OSINK, I_OWOUT, I_RW, I_RB, I_MG, I_MU, I_MD, I_FG };

struct Frame {
    LAS unsigned char* lds;
    int tid, lane, wave, vcu, G;
    unsigned char* ws; const float* const* in; float* out;
};
__device__ __forceinline__ bf16* h_row(const Frame& F, int t) { return (bf16*)(F.ws + WS_HB) + (size_t)t * D; }
__device__ __forceinline__ int mod_row(int t) { return t < TL ? (t >> 12) : 8; }

struct TItem { const float* src; bf16* dst; int ldw, ldd; float f8scale; };
__device__ __forceinline__ void titem_load(const TItem& t, f32x4 (&r)[8], int lane) {
#pragma unroll
    for (int i = 0; i < 8; ++i) r[i] = __builtin_nontemporal_load((const f32x4*)(t.src + (size_t)((lane >> 3) + 8 * i) * t.ldw + 4 * (lane & 7)));
}
__device__ __forceinline__ void titem_process(const TItem& t, const f32x4 (&r)[8], LAS float* scr, int lane) {
#pragma unroll
    for (int i = 0; i < 8; ++i) { LAS float* d = scr + ((lane >> 3) + 8 * i) * 33 + 4 * (lane & 7); d[0] = r[i].x; d[1] = r[i].y; d[2] = r[i].z; d[3] = r[i].w; }
    LDS_WAIT(); asm volatile("" ::: "memory");
    const int c = lane & 7;
    if (t.f8scale != 0.0f) {
        const float sc = t.f8scale; unsigned char* d8 = (unsigned char*)t.dst;
#pragma unroll
        for (int j = 0; j < 4; ++j) { const int n = (lane >> 3) + 8 * j; const LAS float* s = scr + (8 * c) * 33 + n;
            u32x2 o; o.x = pg8::pk4_fp8(s[0 * 33] * sc, s[1 * 33] * sc, s[2 * 33] * sc, s[3 * 33] * sc); o.y = pg8::pk4_fp8(s[4 * 33] * sc, s[5 * 33] * sc, s[6 * 33] * sc, s[7 * 33] * sc);
            *(u32x2*)(d8 + (size_t)n * t.ldd + 8 * c) = o; }
    } else {
#pragma unroll
        for (int j = 0; j < 4; ++j) { const int n = (lane >> 3) + 8 * j; const LAS float* s = scr + (8 * c) * 33 + n;
            u32x4 o; o.x = pk2(s[0 * 33], s[1 * 33]); o.y = pk2(s[2 * 33], s[3 * 33]); o.z = pk2(s[4 * 33], s[5 * 33]); o.w = pk2(s[6 * 33], s[7 * 33]);
            *(u32x4*)(t.dst + (size_t)n * t.ldd + 8 * c) = o; }
    }
    LDS_WAIT(); asm volatile("" ::: "memory");
}
constexpr int TS0 = 1024, TS1 = 512, TS2 = 384, TS3 = 512, TS4 = 0, TS5 = 4096, TS6 = 4096, TS7 = 4096, TNITEMS = TS0 + TS1 + TS2 + TS3 + TS4 + TS5 + TS6 + TS7;
__device__ __forceinline__ TItem titem_moe(const float* const* in, unsigned char* ws, int kind, int le, int rr) {
    TItem t; const int layer = le >> 4, e = le & 15; const bool f8 = (kind < 2) ? (layer ? (FP8_G1_L1 != 0) : (FP8_G1_L0 != 0)) : (layer ? (FP8_G2_L1 != 0) : (FP8_G2_L0 != 0));
    if (kind < 2) { const int kb = (rr >> 4) & 15, nb = rr & 15, n0 = nb * 32; const int drow = (n0 >> 7) * 256 + (n0 & 127) + kind * 128;
        t.src = in[kind ? I_MU : I_MG] + (size_t)le * 524288 + (size_t)(kb * 64) * 512 + n0; t.ldw = 512;
        unsigned char* base = ws + WS_W_M1 + (size_t)layer * 32 * MiB;
        if (f8) { t.dst = (bf16*)(base + (size_t)e * MiB + (size_t)drow * 1024 + kb * 64); t.ldd = 1024; t.f8scale = pg8::W1_SCALE; }
        else { t.dst = (bf16*)(base + (size_t)e * 2 * MiB) + (size_t)drow * 1024 + kb * 64; t.ldd = 1024; t.f8scale = 0.0f; } }
    else { const int kb = (rr >> 5) & 7, nb = rr & 31;
        t.src = in[I_MD] + (size_t)le * 524288 + (size_t)(kb * 64) * 1024 + nb * 32; t.ldw = 1024;
        unsigned char* base = ws + WS_W_M2 + (size_t)layer * 16 * MiB;
        if (f8) { t.dst = (bf16*)(base + (size_t)e * 512 * KiB + (size_t)(nb * 32) * 512 + kb * 64); t.ldd = 512; t.f8scale = pg8::W2_SCALE; }
        else { t.dst = (bf16*)(base + (size_t)e * MiB) + (size_t)(nb * 32) * 512 + kb * 64; t.ldd = 512; t.f8scale = 0.0f; } }
    return t;
}
__device__ __forceinline__ TItem titem_decode(const float* const* in, unsigned char* ws, int r) {
    TItem t;
    if (r < TS0) { const int kb = r / 64, nb = r % 64; t.src = in[I_EWIN] + (size_t)(kb * 64) * 2048 + nb * 32; t.ldw = 2048; t.dst = (bf16*)(ws + WS_W_EIN) + (size_t)(nb * 32) * 1024 + kb * 64; t.ldd = 1024; t.f8scale = 0.0f; return t; } r -= TS0;
    if (r < TS1) { const int kb = r / 32, nb = r % 32; t.src = in[I_EWOUT] + (size_t)(kb * 64) * 1024 + nb * 32; t.ldw = 1024; t.dst = (bf16*)(ws + WS_W_EOUT) + (size_t)(nb * 32) * 1024 + kb * 64; t.ldd = 1024; t.f8scale = 0.0f; return t; } r -= TS1;
    if (r < TS2) { const int kb = r / 24, nb = 16 + r % 24; t.src = in[I_OWIN] + (size_t)(kb * 64) * 1280 + nb * 32; t.ldw = 1280; t.dst = (bf16*)(ws + WS_W_OIN) + (size_t)(nb * 32) * 1024 + kb * 64; t.ldd = 1024; t.f8scale = 0.0f; return t; } r -= TS2;
    if (r < TS3) { const int kb = r / 32, nb = r % 32; t.src = in[I_OWOUT] + (size_t)(kb * 64) * 1024 + nb * 32; t.ldw = 1024; t.dst = (bf16*)(ws + WS_W_OOUT) + (size_t)(nb * 32) * 1024 + kb * 64; t.ldd = 1024; t.f8scale = 0.0f; return t; } r -= TS3;
    if (r < TS5 + TS6 + TS7) return titem_moe(in, ws, r / 4096, (r % 4096) >> 8, r % 256);
    return t;
}
constexpr int NL1 = 12288;
__device__ __forceinline__ TItem titem_l1(const float* const* in, unsigned char* ws, int r) { return titem_moe(in, ws, r / 4096, 16 + ((r % 4096) >> 8), r % 256); }

constexpr size_t WS_CONVCTR = 20 * KiB;
__device__ __forceinline__ void convert_l1(Frame& F, int quota) {
    unsigned* ctr = (unsigned*)(F.ws + WS_CONVCTR);
    LAS float* scr = (LAS float*)(F.lds + F.wave * 17408);
    for (int ch = 0; ch < quota; ++ch) {
        const int c0 = __builtin_amdgcn_readfirstlane(F.lane == 0 ? (int)__hip_atomic_fetch_add(ctr, 4u, __ATOMIC_RELAXED, __HIP_MEMORY_SCOPE_AGENT) : 0);
        if (c0 >= NL1) break;
        f32x4 cur[8], nxt[8];
        TItem tc = titem_l1(F.in, F.ws, c0);
        titem_load(tc, nxt, F.lane);
#pragma unroll 1
        for (int i = 0; i < 4; ++i) {
#pragma unroll
            for (int j = 0; j < 8; ++j) cur[j] = nxt[j];
            const TItem tcur = tc;
            if (i < 3) { tc = titem_l1(F.in, F.ws, c0 + i + 1); titem_load(tc, nxt, F.lane); }
            titem_process(tcur, cur, scr, F.lane);
        }
    }
}
__device__ __forceinline__ void convert_l1_static(Frame& F) {
    LAS unsigned* ctr = (LAS unsigned*)(F.lds + LDS_CTL + 40);
    LAS float* scr = (LAS float*)(F.lds + F.wave * 17408);
    const int base = F.vcu * 48;
    f32x4 cur[8], nxt[8];
    int it = __builtin_amdgcn_readfirstlane(F.lane == 0 ? (int)atomicAdd((unsigned*)ctr, 1u) : 0);
    TItem tc = titem_l1(F.in, F.ws, base + (it < 48 ? it : 0));
    if (it < 48) titem_load(tc, nxt, F.lane);
    while (it < 48) {
#pragma unroll
        for (int i = 0; i < 8; ++i) cur[i] = nxt[i];
        const TItem tcur = tc;
        const int itn = __builtin_amdgcn_readfirstlane(F.lane == 0 ? (int)atomicAdd((unsigned*)ctr, 1u) : 0);
        if (itn < 48) { tc = titem_l1(F.in, F.ws, base + itn); titem_load(tc, nxt, F.lane); }
        titem_process(tcur, cur, scr, F.lane);
        it = itn;
    }
}
__device__ __forceinline__ void tail_fill(Frame& F, int nUnits, int quota) {
    const int rounds = (nUnits + F.G - 1) / F.G;
    if ((rounds - 1) * F.G + F.vcu >= nUnits) convert_l1(F, quota);
}

__device__ __forceinline__ void norm_mod_store(const f32x4 (&v)[4], const float* g, const float* shift, const float* scale, bf16* orow, int lane) {
    float s2 = 0.f;
#pragma unroll
    for (int j = 0; j < 4; ++j) s2 += (v[j].x * v[j].x + v[j].y * v[j].y) + (v[j].z * v[j].z + v[j].w * v[j].w);
    const float rstd = 1.0f / sqrtf(wave_sum(s2) * (1.0f / D) + EPS);
#pragma unroll
    for (int j = 0; j < 4; ++j) { const int c = 4 * lane + 256 * j;
        const f32x4 gg = *(const f32x4*)(g + c), sh = *(const f32x4*)(shift + c), sc = *(const f32x4*)(scale + c);
        const f32x4 y = v[j] * rstd * gg * (sc + 1.0f) + sh;
        u32x2 o; o.x = pk2(y.x, y.y); o.y = pk2(y.z, y.w);
        *(u32x2*)(orow + c) = o; }
}

template <int NQ> __device__ __forceinline__ void p1_tokens(Frame& F, int t) {
    const float* mods = (const float*)(F.ws + WS_MODS);
    bf16* A = (bf16*)(F.ws + WS_BUFA);
    f32x4 v[NQ][4];
#pragma unroll
    for (int q = 0; q < NQ; ++q) { const int tq = t + q; const float* xr = tq < TL ? F.in[I_X] + (size_t)tq * D : F.in[I_CTX] + (size_t)(tq - TL) * D;
#pragma unroll
        for (int j = 0; j < 4; ++j) v[q][j] = __builtin_nontemporal_load((const f32x4*)(xr + 4 * F.lane + 256 * j)); }
    const float* m = mods + (size_t)mod_row(t) * 6144;
#pragma unroll
    for (int q = 0; q < NQ; ++q) norm_mod_store(v[q], F.in[I_NMG], m, m + 1024, A + (size_t)(t + q) * D, F.lane);
}
__device__ __forceinline__ void phase_mods(Frame& F) {
    const float* const* in = F.in;
    LAS float* S = (LAS float*)F.lds;
    LAS float* red = S + 9 * 1024;
    for (int i = F.tid; i < 9 * 1024; i += 512) { const float v = (i < 8192) ? in[I_C][i] : in[I_CCTX][i - 8192]; S[i] = v / (1.0f + expf(-v)); }
    __syncthreads();
    const int bx = blockIdx.x, layer = bx >> 7, col0 = (bx & 127) * 48;
    const int j = F.tid % 12, rg = F.tid / 12;
    if (rg < 42) {
        const float* W = in[I_ADAW] + (size_t)layer * 1024 * 6144 + col0 + 4 * j;
        f32x4 w[25];
#pragma unroll
        for (int i = 0; i < 25; ++i) { const int k = rg + 42 * i; w[i] = (k < 1024) ? __builtin_nontemporal_load((const f32x4*)(W + (size_t)k * 6144)) : (f32x4){0.f, 0.f, 0.f, 0.f}; }
        f32x4 acc[9];
#pragma unroll
        for (int r = 0; r < 9; ++r) acc[r] = (f32x4){0.f, 0.f, 0.f, 0.f};
#pragma unroll
        for (int i = 0; i < 25; ++i) { const int k = min(rg + 42 * i, 1023);
#pragma unroll
            for (int r = 0; r < 9; ++r) acc[r] += w[i] * S[r * 1024 + k]; }
#pragma unroll
        for (int r = 0; r < 9; ++r) *(LAS f32x4*)(red + (rg * 9 + r) * 48 + 4 * j) = acc[r];
    }
    __syncthreads();
    for (int i = F.tid; i < 432; i += 512) { const int r = i / 48, c = i % 48; float sum = in[I_ADAB][layer * 6144 + col0 + c];
        for (int g = 0; g < 42; ++g) sum += red[(g * 9 + r) * 48 + c];
        __hip_atomic_store((unsigned*)(F.ws + WS_MODS) + (layer * 9 + r) * 6144 + col0 + c, __builtin_bit_cast(unsigned, sum), __ATOMIC_RELAXED, __HIP_MEMORY_SCOPE_AGENT); }
    asm volatile("s_waitcnt vmcnt(0)" ::: "memory");
    __syncthreads();
    if (F.tid == 0) __hip_atomic_fetch_add((unsigned*)(F.ws + WS_MODSDONE), 1u, __ATOMIC_RELAXED, __HIP_MEMORY_SCOPE_AGENT);
}
__device__ __forceinline__ void mods_wait(Frame& F) {
    if (F.tid < 64) {
        unsigned* cnt = (unsigned*)(F.ws + WS_MODSDONE); unsigned spins = 0;
        while ((unsigned)__builtin_amdgcn_readfirstlane(__hip_atomic_load(cnt, __ATOMIC_RELAXED, __HIP_MEMORY_SCOPE_AGENT)) < (unsigned)F.G) {
            __builtin_amdgcn_s_sleep(2); if (++spins > (1u << 22)) break; }
        __builtin_amdgcn_fence(__ATOMIC_ACQUIRE, "agent");
        asm volatile("s_waitcnt vmcnt(0)" ::: "memory");
    }
    __syncthreads();
}

__device__ __forceinline__ void phase_prologue_a(Frame& F) {
    const float* const* in = F.in;
    unsigned char* ws = F.ws;
    LAS float* ldsf = (LAS float*)F.lds;
    phase_mods(F);
    __syncthreads();
    {
        const int gt = blockIdx.x * 512 + F.tid, NT = F.G * 512;
        float* rope = (float*)(ws + WS_ROPE);
        for (int i = gt; i < 1024; i += NT) { const int coord = i >> 4, q = i & 15; const float inv = powf(10000.0f, -(float)q / 16.0f); const float ang = (float)coord * inv;
            rope[i] = cosf(ang); rope[1024 + i] = sinf(ang); }
        bf16* WA = (bf16*)(ws + WS_WA);
        for (int i = gt; i < 128 * 128; i += NT) { const int m = i >> 7, k = i & 127, rp = m >> 6, j1 = m & 63, ri = k >> 6, n1 = k & 63;
            const float a = 2.0f * (float)((j1 * n1) & 63) / 64.0f; const float c = cospif(a), s = sinpif(a);
            const float v = (rp == 0) ? (ri == 0 ? c : s) : (ri == 0 ? -s : c); WA[i] = (bf16)f2bf(v); }
        bf16* WAC = (bf16*)(ws + WS_WAC);
        for (int i = gt; i < 32 * 32; i += NT) { const int m = i >> 5, k = i & 31, rp = m >> 4, j1 = m & 15, ri = k >> 4, n1 = k & 15;
            const float a = 2.0f * (float)((j1 * n1) & 15) / 16.0f; const float c = cospif(a), s = sinpif(a);
            const float v = (rp == 0) ? (ri == 0 ? c : s) : (ri == 0 ? -s : c); WAC[i] = (bf16)f2bf(v); }
        bf16* WC = (bf16*)(ws + WS_WC);
        for (int i = gt; i < 64 * 64 * 128; i += NT) { const int j1 = i >> 13, j2 = (i >> 7) & 63, k = i & 127, ri = k >> 6, n2 = k & 63;
            const float a = 2.0f * (float)((n2 * (j1 + 64 * j2)) & 4095) / 4096.0f; const float v = (ri == 0 ? cospif(a) : sinpif(a)) * (1.0f / 64.0f); WC[i] = (bf16)f2bf(v); }
        bf16* FD = (bf16*)(ws + WS_FD);
        for (int i = gt; i < 256 * 128; i += NT) { const int col = i >> 7, c = i & 127, ri = col >> 7, k2 = col & 127;
            const float a = 2.0f * (float)((c * k2) & 127) / 128.0f; const float v = (ri == 0 ? cospif(a) : -sinpif(a)) * 0.08838834764831845f; FD[i] = (bf16)f2bf(v); }
        bf16* WCC = (bf16*)(ws + WS_WCC);
        for (int i = gt; i < 16 * 16 * 32; i += NT) { const int j1 = i >> 9, j2 = (i >> 5) & 15, k = i & 31, ri = k >> 4, n2 = k & 15;
            const float a = 2.0f * (float)((n2 * (j1 + 16 * j2)) & 255) / 256.0f; const float v = (ri == 0 ? cospif(a) : sinpif(a)) * (1.0f / 16.0f); WCC[i] = (bf16)f2bf(v); }
    }
    LAS float* tw = (LAS float*)(F.lds + 139264);
    if (F.tid < 128) { const float a = 2.0f * (float)F.tid / 128.0f; tw[F.tid] = cospif(a); tw[128 + F.tid] = sinpif(a); }
    __syncthreads();
    LAS float* scr = (LAS float*)(F.lds + F.wave * 17408);
    const int gw = F.vcu * NWAVES + F.wave, NGW = F.G * NWAVES;
    const int fid = F.vcu * 2 + F.wave;
    if (F.wave < 2) { const int r = fid;
        const int g = r >> 7, db = (r >> 5) & 3, kb = r & 31, k0 = kb * 32, d0 = db * 32;
        const float* Wp = in[I_OWIN] + (size_t)k0 * 1280 + g * 128;
        { float tl[32][2];
#pragma unroll
          for (int rr = 0; rr < 32; ++rr) { tl[rr][0] = Wp[(size_t)rr * 1280 + F.lane]; tl[rr][1] = Wp[(size_t)rr * 1280 + 64 + F.lane]; }
#pragma unroll
          for (int rr = 0; rr < 32; ++rr) { scr[rr * 129 + F.lane] = tl[rr][0]; scr[rr * 129 + 64 + F.lane] = tl[rr][1]; } }
        LDS_WAIT(); asm volatile("" ::: "memory");
        const int k = F.lane & 31, oh = F.lane >> 5;
        const float* pw = in[I_OPOOLW] + (size_t)g * 16384 + d0 + 16 * oh;
        float acc[16];
#pragma unroll
        for (int t = 0; t < 16; ++t) acc[t] = 0.f;
        for (int c0 = 0; c0 < 128; c0 += 8) {
            f32x4 p[8][4];
#pragma unroll
            for (int cc = 0; cc < 8; ++cc)
#pragma unroll
                for (int j = 0; j < 4; ++j) p[cc][j] = *(const f32x4*)(pw + (c0 + cc) * 128 + 4 * j);
#pragma unroll
            for (int cc = 0; cc < 8; ++cc) { const float w = scr[k * 129 + c0 + cc];
#pragma unroll
                for (int j = 0; j < 4; ++j) { acc[4 * j] += w * p[cc][j].x; acc[4 * j + 1] += w * p[cc][j].y; acc[4 * j + 2] += w * p[cc][j].z; acc[4 * j + 3] += w * p[cc][j].w; } }
        }
        const float* psc = in[I_OPOOLS] + g * 128 + d0 + 16 * oh;
        bf16* dst = (bf16*)(ws + WS_W_OIN) + (size_t)(g * 128 + d0 + 16 * oh) * 1024 + k0 + k;
#pragma unroll
        for (int t = 0; t < 16; ++t) dst[(size_t)t * 1024] = (bf16)f2bf(acc[t] * psc[t]);
        LDS_WAIT(); asm volatile("" ::: "memory");
    }
    {
        LAS unsigned* ctr = (LAS unsigned*)(F.lds + LDS_CTL + 32);
        constexpr int PER = (TNITEMS + 255) / 256;
        const int base = F.vcu * PER, lim = min(PER, TNITEMS - base);
        f32x4 cur[8], nxt[8];
        int it = __builtin_amdgcn_readfirstlane(F.lane == 0 ? (int)atomicAdd((unsigned*)ctr, 1u) : 0);
        TItem tc = titem_decode(in, ws, base + (it < lim ? it : 0));
        if (it < lim) titem_load(tc, nxt, F.lane);
        while (it < lim) {
#pragma unroll
            for (int i = 0; i < 8; ++i) cur[i] = nxt[i];
            const TItem tcur = tc;
            const int itn = __builtin_amdgcn_readfirstlane(F.lane == 0 ? (int)atomicAdd((unsigned*)ctr, 1u) : 0);
            if (itn < lim) { tc = titem_decode(in, ws, base + itn); titem_load(tc, nxt, F.lane); }
            titem_process(tcur, cur, scr, F.lane);
            it = itn;
        }
    }
    mods_wait(F);
    {
        LAS unsigned* ctr2 = (LAS unsigned*)(F.lds + LDS_CTL + 36);
        for (;;) {
            const int it = __builtin_amdgcn_readfirstlane(F.lane == 0 ? (int)atomicAdd((unsigned*)ctr2, 1u) : 0);
            if (it >= 40) break;
            if (it < 32) p1_tokens<4>(F, 4 * (32 * (int)blockIdx.x + it)); else p1_tokens<1>(F, TL + 8 * (int)blockIdx.x + (it - 32));
        }
    }
}

struct DftP { const bf16* dbase; size_t dstride; const bf16* W; bf16* obase; size_t ostride; };
template <int MODE> __device__ __forceinline__ DftP dft_params(const Frame& F, int u) {
    const bf16* P = (const bf16*)(F.ws + WS_BUFP); bf16* Z = (bf16*)(F.ws + WS_BUFZ); bf16* MIX = (bf16*)(F.ws + WS_BUFA);
    DftP p;
    if constexpr (MODE == 0) { const int chunk = u & 3, n2 = (u >> 2) & 63, b = u >> 8;
        p.dbase = P + (size_t)(b * 4096 + n2) * EIN + chunk * 128; p.dstride = (size_t)64 * EIN; p.W = (const bf16*)(F.ws + WS_WA);
        p.obase = Z + (size_t)((b * 64) * 64 + n2) * 1024 + chunk * 128; p.ostride = (size_t)64 * 1024; }
    if constexpr (MODE == 1) { const int chunk = u & 3, n2 = (u >> 2) & 15, b = u >> 6;
        p.dbase = P + (size_t)(TL + b * 256 + n2) * EIN + chunk * 128; p.dstride = (size_t)16 * EIN; p.W = (const bf16*)(F.ws + WS_WAC);
        p.obase = Z + (size_t)(TL + (b * 16) * 16 + n2) * 1024 + chunk * 128; p.ostride = (size_t)16 * 1024; }
    if constexpr (MODE == 2) { const int chunk = u & 3, j1 = (u >> 2) & 63, b = u >> 8;
        p.dbase = Z + (size_t)((b * 64 + j1) * 64) * 1024 + chunk * 128; p.dstride = (size_t)1024; p.W = (const bf16*)(F.ws + WS_WC) + (size_t)j1 * 64 * 128;
        p.obase = MIX + (size_t)(b * 4096 + j1) * D + chunk * 128; p.ostride = (size_t)64 * D; }
    if constexpr (MODE == 3) { const int chunk = u & 3, j1 = (u >> 2) & 15, b = u >> 6;
        p.dbase = Z + (size_t)(TL + (b * 16 + j1) * 16) * 1024 + chunk * 128; p.dstride = (size_t)1024; p.W = (const bf16*)(F.ws + WS_WCC) + (size_t)j1 * 16 * 32;
        p.obase = MIX + (size_t)(TL + b * 256 + j1) * D + chunk * 128; p.ostride = (size_t)16 * D; }
    return p;
}
template <int MODE, int KD, int MD, int J>
__device__ __forceinline__ void dft_units(Frame& F, int nunits) {
    constexpr int LD = KD + 8;
    constexpr int NP = (KD * 16 + 511) / 512;
    constexpr int GM = KD / 8 - 1;
    LAS bf16* DT = (LAS bf16*)F.lds;
    u32x4 pre[NP];
    int u = F.vcu;
    if (u < nunits) { const DftP p = dft_params<MODE>(F, u);
#pragma unroll
        for (int i = 0; i < NP; ++i) { const int pc = F.tid + 512 * i; if (pc < KD * 16) { const int k = pc >> 4, c8 = pc & 15, ri = k / (KD / 2), nn = k % (KD / 2);
            pre[i] = __builtin_nontemporal_load((const u32x4*)(p.dbase + (size_t)nn * p.dstride + ri * 512 + c8 * 8)); } } }
    const int a = F.lane & 15, q = F.lane >> 4;
    for (; u < nunits; u += F.G) {
        const DftP p = dft_params<MODE>(F, u);
#pragma unroll
        for (int i = 0; i < NP; ++i) { const int pc = F.tid + 512 * i; if (pc < KD * 16) { const int k = pc >> 4, c8 = pc & 15; const u32x4 v = pre[i];
            LAS bf16* d = DT + (c8 * 8) * LD + (k ^ ((c8 & GM) << 3));
            d[0 * LD] = (bf16)(v.x & 0xffff); d[1 * LD] = (bf16)(v.x >> 16); d[2 * LD] = (bf16)(v.y & 0xffff); d[3 * LD] = (bf16)(v.y >> 16);
            d[4 * LD] = (bf16)(v.z & 0xffff); d[5 * LD] = (bf16)(v.z >> 16); d[6 * LD] = (bf16)(v.w & 0xffff); d[7 * LD] = (bf16)(v.w >> 16); } }
        __syncthreads();
        if (u + F.G < nunits) { const DftP pn = dft_params<MODE>(F, u + F.G);
#pragma unroll
            for (int i = 0; i < NP; ++i) { const int pc = F.tid + 512 * i; if (pc < KD * 16) { const int k = pc >> 4, c8 = pc & 15, ri = k / (KD / 2), nn = k % (KD / 2);
                pre[i] = __builtin_nontemporal_load((const u32x4*)(pn.dbase + (size_t)nn * pn.dstride + ri * 512 + c8 * 8)); } } }
        for (int task = F.wave; task < (MD / 16) * 2; task += NWAVES) {
            const int mt = task >> 1, cht = task & 1;
            f32x4 acc[4];
#pragma unroll
            for (int ct = 0; ct < 4; ++ct) acc[ct] = (f32x4){0.f, 0.f, 0.f, 0.f};
#pragma unroll
            for (int ks = 0; ks < KD / 32; ++ks) {
                const bf16x8 bw = *(const bf16x8*)(p.W + (size_t)(mt * 16 + a) * KD + ks * 32 + 8 * q);
#pragma unroll
                for (int ct = 0; ct < 4; ++ct) {
                    const int ch = cht * 64 + 16 * (a >> 2) + 4 * ct + (a & 3);
                    const bf16x8 av = *(const LAS bf16x8*)(DT + ch * LD + ((ks * 32 + 8 * q) ^ (((ch >> 3) & GM) << 3)));
                    acc[ct] = __builtin_amdgcn_mfma_f32_16x16x32_bf16(av, bw, acc[ct], 0, 0, 0);
                }
            }
            const int m = mt * 16 + a, rm = m / J, j = m % J;
            bf16* o = p.obase + (size_t)j * p.ostride + rm * 512 + cht * 64 + 16 * q;
            u32x4 w0, w1;
            w0.x = pk2(acc[0][0], acc[0][1]); w0.y = pk2(acc[0][2], acc[0][3]); w0.z = pk2(acc[1][0], acc[1][1]); w0.w = pk2(acc[1][2], acc[1][3]);
            w1.x = pk2(acc[2][0], acc[2][1]); w1.y = pk2(acc[2][2], acc[2][3]); w1.z = pk2(acc[3][0], acc[3][1]); w1.w = pk2(acc[3][2], acc[3][3]);
            *(u32x4*)o = w0; *(u32x4*)(o + 8) = w1;
        }
        __syncthreads();
    }
}

template <int MODE, int NR>
__device__ __forceinline__ void dft_units_a(Frame& F, int nunits) {
    constexpr int KD = 2 * NR, MD = 2 * NR, J = NR, LD = KD + 8, GM = KD / 8 - 1, ULD = 136;
    constexpr int NP = (NR * 16 + 511) / 512;
    LAS bf16* FDl = (LAS bf16*)F.lds; LAS bf16* U = (LAS bf16*)(F.lds + 69632); LAS bf16* DT = (LAS bf16*)(F.lds + 69632 + 64 * ULD * 2);
    { const bf16* FD = (const bf16*)(F.ws + WS_FD);
      for (int p = F.tid; p < 256 * 16; p += 512) { const int r = p >> 4, c8 = p & 15; *(LAS u32x4*)(FDl + r * ULD + 8 * c8) = *(const u32x4*)(FD + r * 128 + 8 * c8); } }
    u32x4 pre[NP];
    int u = F.vcu;
    if (u < nunits) { const DftP p = dft_params<MODE>(F, u);
#pragma unroll
        for (int i = 0; i < NP; ++i) { const int pc = F.tid + 512 * i; if (pc < NR * 16) pre[i] = __builtin_nontemporal_load((const u32x4*)(p.dbase + (size_t)(pc >> 4) * p.dstride + (pc & 15) * 8)); } }
    const int a = F.lane & 15, q = F.lane >> 4;
    for (; u < nunits; u += F.G) {
        const DftP p = dft_params<MODE>(F, u);
#pragma unroll
        for (int i = 0; i < NP; ++i) { const int pc = F.tid + 512 * i; if (pc < NR * 16) *(LAS u32x4*)(U + (pc >> 4) * ULD + (pc & 15) * 8) = pre[i]; }
        __syncthreads();
        if (u + F.G < nunits) { const DftP pn = dft_params<MODE>(F, u + F.G);
#pragma unroll
            for (int i = 0; i < NP; ++i) { const int pc = F.tid + 512 * i; if (pc < NR * 16) pre[i] = __builtin_nontemporal_load((const u32x4*)(pn.dbase + (size_t)(pc >> 4) * pn.dstride + (pc & 15) * 8)); } }
        {
            f32x4 acc[NR / 16][2];
#pragma unroll
            for (int mt = 0; mt < NR / 16; ++mt) { acc[mt][0] = (f32x4){0.f, 0.f, 0.f, 0.f}; acc[mt][1] = (f32x4){0.f, 0.f, 0.f, 0.f}; }
#pragma unroll
            for (int ks = 0; ks < 4; ++ks) {
                const bf16x8 b0 = *(const LAS bf16x8*)(FDl + ((2 * F.wave) * 16 + a) * ULD + ks * 32 + 8 * q), b1 = *(const LAS bf16x8*)(FDl + ((2 * F.wave + 1) * 16 + a) * ULD + ks * 32 + 8 * q);
#pragma unroll
                for (int mt = 0; mt < NR / 16; ++mt) { const bf16x8 av = *(const LAS bf16x8*)(U + (mt * 16 + a) * ULD + ks * 32 + 8 * q);
                    acc[mt][0] = __builtin_amdgcn_mfma_f32_16x16x32_bf16(av, b0, acc[mt][0], 0, 0, 0); acc[mt][1] = __builtin_amdgcn_mfma_f32_16x16x32_bf16(av, b1, acc[mt][1], 0, 0, 0); }
            }
#pragma unroll
            for (int t = 0; t < 2; ++t) { const int col = (2 * F.wave + t) * 16 + a, ri = col >> 7, k2 = col & 127;
#pragma unroll
                for (int mt = 0; mt < NR / 16; ++mt) { const int k0 = ri * NR + 16 * mt + 4 * q;
                    u32x2 w; w.x = pk2(acc[mt][t][0], acc[mt][t][1]); w.y = pk2(acc[mt][t][2], acc[mt][t][3]);
                    *(LAS u32x2*)(DT + k2 * LD + (k0 ^ (((k2 >> 3) & GM) << 3))) = w; } }
        }
        __syncthreads();
        for (int task = F.wave; task < (MD / 16) * 2; task += NWAVES) {
            const int mt = task >> 1, cht = task & 1;
            f32x4 acc[4];
#pragma unroll
            for (int ct = 0; ct < 4; ++ct) acc[ct] = (f32x4){0.f, 0.f, 0.f, 0.f};
#pragma unroll
            for (int ks = 0; ks < KD / 32; ++ks) {
                const bf16x8 bw = *(const bf16x8*)(p.W + (size_t)(mt * 16 + a) * KD + ks * 32 + 8 * q);
#pragma unroll
                for (int ct = 0; ct < 4; ++ct) {
                    const int ch = cht * 64 + 16 * (a >> 2) + 4 * ct + (a & 3);
                    const bf16x8 av = *(const LAS bf16x8*)(DT + ch * LD + ((ks * 32 + 8 * q) ^ (((ch >> 3) & GM) << 3)));
                    acc[ct] = __builtin_amdgcn_mfma_f32_16x16x32_bf16(av, bw, acc[ct], 0, 0, 0);
                }
            }
            const int m = mt * 16 + a, rm = m / J, j = m % J;
            bf16* o = p.obase + (size_t)j * p.ostride + rm * 512 + cht * 64 + 16 * q;
            u32x4 w0, w1;
            w0.x = pk2(acc[0][0], acc[0][1]); w0.y = pk2(acc[0][2], acc[0][3]); w0.z = pk2(acc[1][0], acc[1][1]); w0.w = pk2(acc[1][2], acc[1][3]);
            w1.x = pk2(acc[2][0], acc[2][1]); w1.y = pk2(acc[2][2], acc[2][3]); w1.z = pk2(acc[3][0], acc[3][1]); w1.w = pk2(acc[3][2], acc[3][3]);
            *(u32x4*)o = w0; *(u32x4*)(o + 8) = w1;
        }
        __syncthreads();
    }
}

__device__ __forceinline__ void phase_fourier_a_conv(Frame& F) {
    const bf16* P = (const bf16*)(F.ws + WS_BUFP);
    dft_units_a<0, 64>(F, 2048);
    __syncthreads();
    dft_units_a<1, 16>(F, 512);
    bf16* MIX = (bf16*)(F.ws + WS_BUFA);
    const float* cw = F.in[I_ECONV];
    float w0[8], w1[8], w2[8];
#pragma unroll
    for (int i = 0; i < 8; ++i) { w0[i] = cw[8 * F.lane + i]; w1[i] = cw[512 + 8 * F.lane + i]; w2[i] = cw[1024 + 8 * F.lane + i]; }
    const int gw = F.vcu * NWAVES + F.wave, NGW = F.G * NWAVES;
    auto conv_tokens = [&](int t, auto ntc) {
        constexpr int NT = decltype(ntc)::value;
        int pos, len; if (t < TL) { pos = t & 4095; len = 4096; } else { pos = (t - TL) & 255; len = 256; }
        const bf16* row = P + (size_t)t * EIN + 8 * F.lane;
        u32x4 gb[NT], gc[NT + 2], uc[NT + 2];
#pragma unroll
        for (int d = 0; d < NT + 2; ++d) { const int pp = pos + d - 1;
            if (pp >= 0 && pp < len) { gc[d] = *(const u32x4*)(row + (ptrdiff_t)(d - 1) * EIN + 1024); uc[d] = *(const u32x4*)(row + (ptrdiff_t)(d - 1) * EIN + 1536); }
            else { gc[d] = (u32x4){0u, 0u, 0u, 0u}; uc[d] = (u32x4){0u, 0u, 0u, 0u}; } }
#pragma unroll
        for (int q = 0; q < NT; ++q) gb[q] = __builtin_nontemporal_load((const u32x4*)(row + (size_t)q * EIN + 512));
        float pl[NT + 2][8];
#pragma unroll
        for (int d = 0; d < NT + 2; ++d)
#pragma unroll
            for (int i = 0; i < 4; ++i) { pl[d][2 * i] = bflo(gc[d][i]) * bflo(uc[d][i]); pl[d][2 * i + 1] = bfhi(gc[d][i]) * bfhi(uc[d][i]); }
#pragma unroll
        for (int q = 0; q < NT; ++q) {
            float y[8];
#pragma unroll
            for (int i = 0; i < 4; ++i) {
                y[2 * i] = bflo(gb[q][i]) * (w0[2 * i] * pl[q][2 * i] + w1[2 * i] * pl[q + 1][2 * i] + w2[2 * i] * pl[q + 2][2 * i]);
                y[2 * i + 1] = bfhi(gb[q][i]) * (w0[2 * i + 1] * pl[q][2 * i + 1] + w1[2 * i + 1] * pl[q + 1][2 * i + 1] + w2[2 * i + 1] * pl[q + 2][2 * i + 1]);
            }
            u32x4 o; o.x = pk2(y[0], y[1]); o.y = pk2(y[2], y[3]); o.z = pk2(y[4], y[5]); o.w = pk2(y[6], y[7]);
            *(u32x4*)(MIX + (size_t)(t + q) * D + 512 + 8 * F.lane) = o;
        }
    };
    for (int t = 4 * gw; t < TL; t += 4 * NGW) conv_tokens(t, std::integral_constant<int, 4>{});
    for (int t = TL + gw; t < T; t += NGW) conv_tokens(t, std::integral_constant<int, 1>{});
}

__device__ __forceinline__ void phase_fourier_c(Frame& F) {
    dft_units<2, 128, 64, 64>(F, 2048);
    dft_units<3, 32, 16, 16>(F, 512);
}

constexpr int RW_LD = 1032;
__device__ __forceinline__ void phase_route(Frame& F, int layer, int ntok) {
    LAS bf16* rwh = (LAS bf16*)F.lds;
    LAS bf16* rwl = (LAS bf16*)(F.lds + 33024);
    LAS unsigned* cnt = (LAS unsigned*)(F.lds + 66048);
    LAS int* gb = (LAS int*)(F.lds + 66048 + 128);
    LAS float* lgs = (LAS float*)(F.lds + 66048 + 256) + F.wave * 256;
    LAS int* tinfo = (LAS int*)(F.lds + 66048 + 256 + 8192);
    LAS float* GS = (LAS float*)(F.lds + 81920);
    LAS float* SH = GS + 2048;
    const float* RW = F.in[I_RW];
    const int per = ntok / F.G, t0 = blockIdx.x * per, r0 = mod_row(t0);
    const float* mods = (const float*)(F.ws + WS_MODS) + (size_t)layer * 9 * 6144;
    const float* g = F.in[I_NFG] + layer * 1024;
    for (int i = F.tid; i < 16384; i += 512) { const int k = i >> 4, e = i & 15; const float w = RW[i]; const unsigned hi = f2bf(w); const float wl = w - __builtin_bit_cast(float, hi << 16);
        rwh[e * RW_LD + k] = (bf16)hi; rwl[e * RW_LD + k] = (bf16)f2bf(wl); }
    for (int i = F.tid; i < 2048; i += 512) { const int sl = i >> 10, c = i & 1023; const int rr = min(r0 + sl, 8); const float* m = mods + (size_t)rr * 6144;
        GS[i] = g[c] * (m[4 * 1024 + c] + 1.0f); SH[i] = m[3 * 1024 + c]; }
    if (F.tid < 16) cnt[F.tid] = 0u;
    __syncthreads();
    bf16* FB = (bf16*)(F.ws + WS_BUFA);
    const bool f8 = layer ? (FP8_G1_L1 != 0) : (FP8_G1_L0 != 0);
    int* route = (int*)(F.ws + WS_ROUTE);
    const int tk = F.lane & 15, kg = F.lane >> 4;
    for (int g0 = 16 * F.wave; g0 < per; g0 += 16 * NWAVES) {
        const int nv = min(16, per - g0);
        const int tq = t0 + g0 + (tk < nv ? tk : 0);
        const bf16* hr = h_row(F, tq) + 8 * kg;
        float s2 = 0.f;
        {
            u32x4 raw[32];
#pragma unroll
            for (int ks = 0; ks < 32; ++ks) raw[ks] = *(const u32x4*)(hr + 32 * ks);
#pragma unroll
            for (int ks = 0; ks < 32; ++ks)
#pragma unroll
                for (int i = 0; i < 4; ++i) { const float a = bflo(raw[ks][i]), b2 = bfhi(raw[ks][i]); s2 += a * a + b2 * b2; }
        }
        s2 += __shfl_xor(s2, 16); s2 += __shfl_xor(s2, 32);
        const float rstd = 1.0f / sqrtf(s2 * (1.0f / D) + EPS);
        const int sl = (mod_row(tq) != r0) ? 1024 : 0;
        const LAS float* gsp = GS + sl + 8 * kg; const LAS float* shp = SH + sl + 8 * kg;
        unsigned char* fb8 = (unsigned char*)FB + (size_t)tq * D + 8 * kg;
        bf16* fb16 = FB + (size_t)tq * D + 8 * kg;
        f32x4 acc = (f32x4){0.f, 0.f, 0.f, 0.f};
        u32x4 nx[8];
#pragma unroll
        for (int j = 0; j < 8; ++j) nx[j] = *(const u32x4*)(hr + 32 * j);
#pragma unroll 1
        for (int k4 = 0; k4 < 4; ++k4) {
            u32x4 cu[8];
#pragma unroll
            for (int j = 0; j < 8; ++j) cu[j] = nx[j];
            if (k4 < 3) {
#pragma unroll
                for (int j = 0; j < 8; ++j) nx[j] = *(const u32x4*)(hr + 32 * (8 * k4 + 8 + j)); }
#pragma unroll
            for (int j = 0; j < 8; ++j) {
                const int ks = 8 * k4 + j;
                const f32x4 g0v = *(const LAS f32x4*)(gsp + 32 * ks), g1v = *(const LAS f32x4*)(gsp + 32 * ks + 4), s0v = *(const LAS f32x4*)(shp + 32 * ks), s1v = *(const LAS f32x4*)(shp + 32 * ks + 4);
                float f[8];
                f[0] = bflo(cu[j].x) * rstd * g0v.x + s0v.x; f[1] = bfhi(cu[j].x) * rstd * g0v.y + s0v.y; f[2] = bflo(cu[j].y) * rstd * g0v.z + s0v.z; f[3] = bfhi(cu[j].y) * rstd * g0v.w + s0v.w;
                f[4] = bflo(cu[j].z) * rstd * g1v.x + s1v.x; f[5] = bfhi(cu[j].z) * rstd * g1v.y + s1v.y; f[6] = bflo(cu[j].w) * rstd * g1v.z + s1v.z; f[7] = bfhi(cu[j].w) * rstd * g1v.w + s1v.w;
                u32x4 hi, lo;
#pragma unroll
                for (int i = 0; i < 4; ++i) { const unsigned h0 = f2bf(f[2 * i]), h1 = f2bf(f[2 * i + 1]); hi[i] = h0 | (h1 << 16);
                    lo[i] = pk2(f[2 * i] - __builtin_bit_cast(float, h0 << 16), f[2 * i + 1] - __builtin_bit_cast(float, h1 << 16)); }
                if (tk < nv) {
                    if (f8) { u32x2 o; o.x = pg8::pk4_fp8(f[0], f[1], f[2], f[3]); o.y = pg8::pk4_fp8(f[4], f[5], f[6], f[7]); *(u32x2*)(fb8 + 32 * ks) = o; }
                    else *(u32x4*)(fb16 + 32 * ks) = hi;
                }
                const bf16x8 bh = *(const LAS bf16x8*)(rwh + tk * RW_LD + 32 * ks + 8 * kg), bl = *(const LAS bf16x8*)(rwl + tk * RW_LD + 32 * ks + 8 * kg);
                const bf16x8 ah = __builtin_bit_cast(bf16x8, hi), al = __builtin_bit_cast(bf16x8, lo);
                acc = __builtin_amdgcn_mfma_f32_16x16x32_bf16(ah, bh, acc, 0, 0, 0);
                acc = __builtin_amdgcn_mfma_f32_16x16x32_bf16(ah, bl, acc, 0, 0, 0);
                acc = __builtin_amdgcn_mfma_f32_16x16x32_bf16(al, bh, acc, 0, 0, 0);
            }
        }
#pragma unroll
        for (int j = 0; j < 4; ++j) lgs[(4 * kg + j) * 16 + tk] = acc[j];
        LDS_WAIT(); asm volatile("" ::: "memory");
        if (F.lane < nv) {
            const int tqq = t0 + g0 + F.lane;
            float aff[16], sel[16];
#pragma unroll
            for (int e4 = 0; e4 < 4; ++e4) { const f32x4 l4 = *(const LAS f32x4*)(lgs + F.lane * 16 + 4 * e4); const f32x4 b4 = *(const f32x4*)(F.in[I_RB] + 4 * e4);
                aff[4 * e4] = 1.0f / (1.0f + expf(-l4.x)); aff[4 * e4 + 1] = 1.0f / (1.0f + expf(-l4.y)); aff[4 * e4 + 2] = 1.0f / (1.0f + expf(-l4.z)); aff[4 * e4 + 3] = 1.0f / (1.0f + expf(-l4.w));
                sel[4 * e4] = aff[4 * e4] + b4.x; sel[4 * e4 + 1] = aff[4 * e4 + 1] + b4.y; sel[4 * e4 + 2] = aff[4 * e4 + 2] + b4.z; sel[4 * e4 + 3] = aff[4 * e4 + 3] + b4.w; }
            int best = 0; float bs = -1e30f;
#pragma unroll
            for (int gq = 0; gq < 4; ++gq) { const float a = sel[4 * gq], b = sel[4 * gq + 1], c = sel[4 * gq + 2], d = sel[4 * gq + 3];
                const float s = fmaxf(fmaxf(fmaxf(a + b, a + c), fmaxf(a + d, b + c)), fmaxf(b + d, c + d));
                if (s > bs) { bs = s; best = gq; } }
            float sv[4], av[4];
#pragma unroll
            for (int i = 0; i < 4; ++i) { sv[i] = sel[i]; av[i] = aff[i]; }
#pragma unroll
            for (int gq = 1; gq < 4; ++gq) if (best == gq) {
#pragma unroll
                for (int i = 0; i < 4; ++i) { sv[i] = sel[4 * gq + i]; av[i] = aff[4 * gq + i]; } }
            int i1 = 0; float s1 = sv[0], a1 = av[0];
#pragma unroll
            for (int i = 1; i < 4; ++i) if (sv[i] > s1) { s1 = sv[i]; a1 = av[i]; i1 = i; }
            int i2 = -1; float s2v = -1e30f, a2 = 0.f;
#pragma unroll
            for (int i = 0; i < 4; ++i) if (i != i1 && sv[i] > s2v) { s2v = sv[i]; a2 = av[i]; i2 = i; }
            const int e1 = 4 * best + i1, e2 = 4 * best + i2;
            const float wsum = a1 + a2, w1 = a1 / wsum, w2 = a2 / wsum;
            const unsigned r1 = atomicAdd((unsigned*)(cnt + e1), 1u), r2 = atomicAdd((unsigned*)(cnt + e2), 1u);
            int* ro = route + (size_t)tqq * 8;
            ro[0] = e1; ro[1] = e2; ro[4] = __builtin_bit_cast(int, w1); ro[5] = __builtin_bit_cast(int, w2);
            tinfo[4 * (tqq - t0) + 0] = e1; tinfo[4 * (tqq - t0) + 1] = e2; tinfo[4 * (tqq - t0) + 2] = (int)r1; tinfo[4 * (tqq - t0) + 3] = (int)r2;
        }
        LDS_WAIT(); asm volatile("" ::: "memory");
    }
    __syncthreads();
    if (F.tid < 16) gb[F.tid] = (int)__hip_atomic_fetch_add((unsigned*)(F.ws + WS_GCNT) + layer * 16 + F.tid, cnt[F.tid], __ATOMIC_RELAXED, __HIP_MEMORY_SCOPE_AGENT);
    __syncthreads();
    int* tokmap = (int*)(F.ws + WS_TOKMAP);
    for (int i = F.tid; i < per; i += 512) {
        const int e1 = tinfo[4 * i], e2 = tinfo[4 * i + 1], p1 = gb[e1] + tinfo[4 * i + 2], p2 = gb[e2] + tinfo[4 * i + 3];
        tokmap[(size_t)e1 * T + p1] = t0 + i; tokmap[(size_t)e2 * T + p2] = t0 + i;
        int* ro = route + (size_t)(t0 + i) * 8; ro[2] = p1; ro[3] = p2;
    }
}

__device__ __forceinline__ int moe_tables(Frame& F, int layer) {
    LAS int* tb = (LAS int*)(F.lds + LDS_CTL + 64); LAS int* cn = (LAS int*)(F.lds + LDS_CTL + 192);
    __syncthreads();
    if (F.tid < 16) cn[F.tid] = ld_coh((const int*)(F.ws + WS_GCNT) + layer * 16 + F.tid);
    __syncthreads();
    if (F.tid == 0) { int b = 0; for (int e = 0; e < 16; ++e) { tb[e] = b; b += (cn[e] + 255) >> 8; } tb[16] = b; }
    __syncthreads();
    return __builtin_amdgcn_readfirstlane(tb[16]);
}

template <int NQ> __device__ __forceinline__ void combine_tokens(Frame& F, int layer, int t) {
    const float* mods = (const float*)(F.ws + WS_MODS);
    const bf16* OS = (const bf16*)(F.ws + WS_BUFP);
    const int* route = (const int*)(F.ws + WS_ROUTE);
    const LAS int* tb = (const LAS int*)(F.lds + LDS_CTL + 64);
    bf16* A = (bf16*)(F.ws + WS_BUFA);
    {
        int rc[NQ][4]; float w0[NQ], w1[NQ];
#pragma unroll
        for (int q = 0; q < NQ; ++q) { const int* ro = route + (size_t)(t + q) * 8;
#pragma unroll
            for (int i = 0; i < 4; ++i) rc[q][i] = ld_coh(ro + i);
            w0[q] = ld_cohf((const float*)(ro + 4)); w1[q] = ld_cohf((const float*)(ro + 5)); }
        f32x4 v[NQ][4]; u32x2 oa[NQ][4], ob[NQ][4];
#pragma unroll
        for (int q = 0; q < NQ; ++q) { const bf16* hr = h_row(F, t + q);
            const size_t s0 = (size_t)(tb[rc[q][0]] * 256 + rc[q][2]) * D, s1 = (size_t)(tb[rc[q][1]] * 256 + rc[q][3]) * D;
#pragma unroll
            for (int j = 0; j < 4; ++j) { const int c = 4 * F.lane + 256 * j; { const u32x2 hv = *(const u32x2*)(hr + c); v[q][j] = (f32x4){bflo(hv.x), bfhi(hv.x), bflo(hv.y), bfhi(hv.y)}; } oa[q][j] = __builtin_nontemporal_load((const u32x2*)(OS + s0 + c)); ob[q][j] = __builtin_nontemporal_load((const u32x2*)(OS + s1 + c)); } }
        const int mr = mod_row(t);
        const float* m5 = mods + (size_t)(layer * 9 + mr) * 6144 + 5 * 1024;
#pragma unroll
        for (int j = 0; j < 4; ++j) { const f32x4 g5 = *(const f32x4*)(m5 + 4 * F.lane + 256 * j);
#pragma unroll
            for (int q = 0; q < NQ; ++q) { const u32x2 a = oa[q][j], b2 = ob[q][j];
                const f32x4 o = (f32x4){w0[q] * bflo(a.x) + w1[q] * bflo(b2.x), w0[q] * bfhi(a.x) + w1[q] * bfhi(b2.x), w0[q] * bflo(a.y) + w1[q] * bflo(b2.y), w0[q] * bfhi(a.y) + w1[q] * bfhi(b2.y)};
                v[q][j] = v[q][j] + g5 * o; } }
#pragma unroll
        for (int q = 0; q < NQ; ++q) {
            if (layer == 0) {
                bf16* hr = h_row(F, t + q);
#pragma unroll
                for (int j = 0; j < 4; ++j) { u32x2 o; o.x = pk2(v[q][j].x, v[q][j].y); o.y = pk2(v[q][j].z, v[q][j].w); *(u32x2*)(hr + 4 * F.lane + 256 * j) = o; }
                const float* m = mods + (size_t)(9 + mr) * 6144;
                norm_mod_store(v[q], F.in[I_NMG] + 1024, m, m + 1024, A + (size_t)(t + q) * D, F.lane);
            } else {
                float s2 = 0.f;
#pragma unroll
                for (int j = 0; j < 4; ++j) s2 += (v[q][j].x * v[q][j].x + v[q][j].y * v[q][j].y) + (v[q][j].z * v[q][j].z + v[q][j].w * v[q][j].w);
                const float rstd = 1.0f / sqrtf(wave_sum(s2) * (1.0f / D) + EPS);
                float* orow = F.out + (size_t)(t + q) * D;
#pragma unroll
                for (int j = 0; j < 4; ++j) { const int c = 4 * F.lane + 256 * j; __builtin_nontemporal_store(v[q][j] * rstd * *(const f32x4*)(F.in[I_FG] + c), (f32x4*)(orow + c)); }
            }
        }
    }
}
__device__ __forceinline__ void phase_combine(Frame& F, int layer, int ntok) {
    const int gw = F.vcu * NWAVES + F.wave, NGW = F.G * NWAVES;
    if (layer == 0) { for (int t = 2 * gw; t < TL; t += 2 * NGW) combine_tokens<2>(F, 0, t); for (int t = TL + gw; t < ntok; t += NGW) combine_tokens<1>(F, 0, t); }
    else { for (int t = 4 * gw; t < TL; t += 4 * NGW) combine_tokens<4>(F, 1, t); }
}

constexpr int KV_LD = 72, VL_OFF = 384 * KV_LD * 2, ROPE_LDS = 131072;
typedef short v4i16_t __attribute__((ext_vector_type(4)));

__device__ __forceinline__ bf16x8 rope_pack(const u32x4 x1, const u32x4 x2, const LAS float* cs, const LAS float* sn, float scale, bool second) {
    const f32x4 c0 = *(const LAS f32x4*)cs, c1 = *(const LAS f32x4*)(cs + 4), s0 = *(const LAS f32x4*)sn, s1 = *(const LAS f32x4*)(sn + 4);
    float c[8] = {c0.x, c0.y, c0.z, c0.w, c1.x, c1.y, c1.z, c1.w}, s[8] = {s0.x, s0.y, s0.z, s0.w, s1.x, s1.y, s1.z, s1.w};
    float a[8], b[8];
#pragma unroll
    for (int i = 0; i < 4; ++i) { a[2 * i] = bflo(x1[i]); a[2 * i + 1] = bfhi(x1[i]); b[2 * i] = bflo(x2[i]); b[2 * i + 1] = bfhi(x2[i]); }
    float o[8];
#pragma unroll
    for (int i = 0; i < 8; ++i) o[i] = (second ? (b[i] * c[i] + a[i] * s[i]) : (a[i] * c[i] - b[i] * s[i])) * scale;
    u32x4 w; w.x = pk2(o[0], o[1]); w.y = pk2(o[2], o[3]); w.z = pk2(o[4], o[5]); w.w = pk2(o[6], o[7]);
    return __builtin_bit_cast(bf16x8, w);
}

struct AttnU { int b, qb, kvh; };
__device__ __forceinline__ AttnU attn_unit_of(int u) { AttnU r; r.kvh = u & 1; r.qb = (u >> 1) & 31; r.b = u >> 6; return r; }

__device__ __forceinline__ void attn_load_latk(Frame& F, const bf16* P1, AttnU u, u32x4 (&lk)[2][4]) {
    const u32x4 z = (u32x4){0u, 0u, 0u, 0u};
#pragma unroll
    for (int it = 0; it < 2; ++it) { const int task = F.tid + 512 * it, kidx = task >> 1, hh = task & 1, pos = u.qb * 128 - 128 + kidx;
        const bool ok = task < 768 && pos >= 0 && pos < NSEQ;
        const bf16* row = P1 + (size_t)(u.b * NSEQ + (ok ? pos : 0)) * OIN + 1024 + u.kvh * 64 + 8 * hh;
#pragma unroll
        for (int st = 0; st < 4; ++st) lk[it][st] = ok ? *(const u32x4*)(row + 16 * st) : z; }
}
__device__ __forceinline__ void attn_load_latv(Frame& F, const bf16* P1, AttnU u, u32x4 (&lv)[6]) {
    const u32x4 z = (u32x4){0u, 0u, 0u, 0u};
#pragma unroll
    for (int it = 0; it < 6; ++it) { const int task = F.tid + 512 * it, kidx = task >> 3, c8 = task & 7, pos = u.qb * 128 - 128 + kidx;
        const bool ok = pos >= 0 && pos < NSEQ;
        lv[it] = ok ? *(const u32x4*)(P1 + (size_t)(u.b * NSEQ + (ok ? pos : 0)) * OIN + 1152 + u.kvh * 64 + 8 * c8) : z; }
}
__device__ __forceinline__ void attn_write_lat(Frame& F, AttnU u, const u32x4 (&lk)[2][4], const u32x4 (&lv)[6]) {
    LAS bf16* KL = (LAS bf16*)F.lds; LAS bf16* VL = (LAS bf16*)(F.lds + VL_OFF); const LAS float* rope = (const LAS float*)(F.lds + ROPE_LDS);
#pragma unroll
    for (int it = 0; it < 2; ++it) { const int task = F.tid + 512 * it, kidx = task >> 1, hh = task & 1; int pos = u.qb * 128 - 128 + kidx; pos = pos < 0 ? 0 : (pos > NSEQ - 1 ? NSEQ - 1 : pos);
        if (task < 768) {
            LAS bf16* d = KL + kidx * KV_LD + 8 * hh;
            const LAS float* c0 = rope + (pos >> 6) * 16 + 8 * hh; const LAS float* c1 = rope + (pos & 63) * 16 + 8 * hh;
            *(LAS bf16x8*)(d) = rope_pack(lk[it][0], lk[it][1], c0, c0 + 1024, 1.0f, false);
            *(LAS bf16x8*)(d + 16) = rope_pack(lk[it][0], lk[it][1], c0, c0 + 1024, 1.0f, true);
            *(LAS bf16x8*)(d + 32) = rope_pack(lk[it][2], lk[it][3], c1, c1 + 1024, 1.0f, false);
            *(LAS bf16x8*)(d + 48) = rope_pack(lk[it][2], lk[it][3], c1, c1 + 1024, 1.0f, true);
        } }
#pragma unroll
    for (int it = 0; it < 6; ++it) { const int task = F.tid + 512 * it, kidx = task >> 3, c8 = task & 7; *(LAS u32x4*)(VL + kidx * KV_LD + 8 * c8) = lv[it]; }
}
__device__ __forceinline__ void attn_load_ctx(Frame& F, const bf16* P1, AttnU u, u32x4 (&ck)[4], u32x4 (&cv)[4]) {
#pragma unroll
    for (int it = 0; it < 4; ++it) { const int task = F.tid + 512 * it, kidx = task >> 3, c8 = task & 7;
        const bf16* row = P1 + (size_t)(TL + u.b * LCTX + kidx) * OIN + 1024 + u.kvh * 64 + 8 * c8;
        ck[it] = *(const u32x4*)row; cv[it] = *(const u32x4*)(row + 128); }
}
__device__ __forceinline__ void attn_write_ctx(Frame& F, const u32x4 (&ck)[4], const u32x4 (&cv)[4]) {
    LAS bf16* KL = (LAS bf16*)F.lds; LAS bf16* VL = (LAS bf16*)(F.lds + VL_OFF);
#pragma unroll
    for (int it = 0; it < 4; ++it) { const int task = F.tid + 512 * it, kidx = task >> 3, c8 = task & 7;
        *(LAS u32x4*)(KL + kidx * KV_LD + 8 * c8) = ck[it]; *(LAS u32x4*)(VL + kidx * KV_LD + 8 * c8) = cv[it]; }
}

__device__ __forceinline__ unsigned cvtpk(float lo, float hi) { unsigned r; asm volatile("v_cvt_pk_bf16_f32 %0, %1, %2" : "=v"(r) : "v"(lo), "v"(hi)); return r; }
__device__ __forceinline__ float xhalf_max(float x) { const auto r = __builtin_amdgcn_permlane32_swap(__builtin_bit_cast(unsigned, x), __builtin_bit_cast(unsigned, x), false, false);
    return fmaxf(__builtin_bit_cast(float, r[0]), __builtin_bit_cast(float, r[1])); }
__device__ __forceinline__ float xhalf_sum(float x) { const auto r = __builtin_amdgcn_permlane32_swap(__builtin_bit_cast(unsigned, x), __builtin_bit_cast(unsigned, x), false, false);
    return __builtin_bit_cast(float, r[0]) + __builtin_bit_cast(float, r[1]); }
__device__ __forceinline__ void attn_tiles(Frame& F, int kt0, int kt1, int mk0, int mk1, const bf16x8 (&qf)[4], f32x16 (&O)[2], float& mrun, float& lrun, int qrel) {
    if (kt0 > kt1) return;
    const LAS bf16* KL = (const LAS bf16*)F.lds; const LAS bf16* VL = (const LAS bf16*)(F.lds + VL_OFF);
    const int r32 = F.lane & 31, hh = F.lane >> 5;
    const int q4 = (F.lane & 15) >> 2, p4 = F.lane & 3, blk = (F.lane >> 4) & 1;
    const LAS bf16* kp = KL + (kt0 * 32 + r32) * KV_LD + 8 * hh;
    const LAS bf16* vp = VL + (kt0 * 32 + 4 * hh + q4) * KV_LD + 16 * blk + 4 * p4;
    bf16x8 kn[4];
#pragma unroll
    for (int st = 0; st < 4; ++st) kn[st] = *(const LAS bf16x8*)(kp + 16 * st);
    for (int kt = kt0; kt <= kt1; ++kt) {
        bf16x8 kf[4];
#pragma unroll
        for (int st = 0; st < 4; ++st) kf[st] = kn[st];
        v4i16_t vlo[2][2], vhi[2][2];
#pragma unroll
        for (int dt = 0; dt < 2; ++dt)
#pragma unroll
            for (int s2 = 0; s2 < 2; ++s2) { vlo[dt][s2] = __builtin_amdgcn_ds_read_tr16_b64_v4i16((LAS v4i16_t*)(vp + (16 * s2) * KV_LD + dt * 32));
                vhi[dt][s2] = __builtin_amdgcn_ds_read_tr16_b64_v4i16((LAS v4i16_t*)(vp + (16 * s2 + 8) * KV_LD + dt * 32)); }
        kp += 32 * KV_LD; vp += 32 * KV_LD;
        if (kt < kt1) {
#pragma unroll
            for (int st = 0; st < 4; ++st) kn[st] = *(const LAS bf16x8*)(kp + 16 * st); }
        __builtin_amdgcn_sched_barrier(0);
        f32x16 s;
#pragma unroll
        for (int r = 0; r < 16; ++r) s[r] = 0.f;
#pragma unroll
        for (int st = 0; st < 4; ++st) s = __builtin_amdgcn_mfma_f32_32x32x16_bf16(kf[st], qf[st], s, 0, 0, 0);
        if (kt == mk0 || kt == mk1) {
#pragma unroll
            for (int r = 0; r < 16; ++r) { const int dlt = kt * 32 + (r & 3) + 8 * (r >> 2) + 4 * hh - qrel; s[r] = (dlt <= 128 && dlt >= -128) ? s[r] : -INFINITY; } }
        float mx = fmaxf(fmaxf(s[0], s[1]), fmaxf(s[2], s[3]));
#pragma unroll
        for (int r = 4; r < 16; r += 4) mx = fmaxf(mx, fmaxf(fmaxf(s[r], s[r + 1]), fmaxf(s[r + 2], s[r + 3])));
        mx = xhalf_max(mx);
        const float mnew = fmaxf(mrun, mx);
        float ps0 = 0.f, ps1 = 0.f;
#pragma unroll
        for (int r = 0; r < 16; r += 2) { s[r] = __builtin_amdgcn_exp2f(s[r] - mnew); s[r + 1] = __builtin_amdgcn_exp2f(s[r + 1] - mnew); ps0 += s[r]; ps1 += s[r + 1]; }
        const float ps = xhalf_sum(ps0 + ps1);
        if (__any(mnew > mrun)) {
            const float alpha = __builtin_amdgcn_exp2f(mrun - mnew);
            lrun *= alpha;
#pragma unroll
            for (int dt = 0; dt < 2; ++dt)
#pragma unroll
                for (int r = 0; r < 16; ++r) O[dt][r] *= alpha;
        }
        lrun += ps; mrun = mnew;
        bf16x8 pb[2];
#pragma unroll
        for (int s2 = 0; s2 < 2; ++s2) { u32x4 w; w.x = cvtpk(s[8 * s2 + 0], s[8 * s2 + 1]); w.y = cvtpk(s[8 * s2 + 2], s[8 * s2 + 3]); w.z = cvtpk(s[8 * s2 + 4], s[8 * s2 + 5]); w.w = cvtpk(s[8 * s2 + 6], s[8 * s2 + 7]);
            pb[s2] = __builtin_bit_cast(bf16x8, w); }
#pragma unroll
        for (int dt = 0; dt < 2; ++dt)
#pragma unroll
            for (int s2 = 0; s2 < 2; ++s2) {
                const bf16x8 va = (bf16x8){vlo[dt][s2][0], vlo[dt][s2][1], vlo[dt][s2][2], vlo[dt][s2][3], vhi[dt][s2][0], vhi[dt][s2][1], vhi[dt][s2][2], vhi[dt][s2][3]};
                O[dt] = __builtin_amdgcn_mfma_f32_32x32x16_bf16(va, pb[s2], O[dt], 0, 0, 0);
            }
    }
}

__device__ __forceinline__ void phase_attn(Frame& F) {
    const bf16* P1 = (const bf16*)(F.ws + WS_BUFP);
    bf16* MIX = (bf16*)(F.ws + WS_BUFA);
    const int r32 = F.lane & 31, hh = F.lane >> 5;
    constexpr float QSC = 0.125f * 1.4426950408889634f;
    LAS float* ropel = (LAS float*)(F.lds + ROPE_LDS);
    for (int i = F.tid; i < 2048; i += 512) ropel[i] = ((const float*)(F.ws + WS_ROPE))[i];
    u32x4 lk[2][4], lv[6], ck[4], cv[4];
    const int nu = (512 - F.vcu + F.G - 1) / F.G;
    if (nu > 0) attn_load_latk(F, P1, attn_unit_of(F.vcu), lk);
    for (int ui = 0; ui < nu; ++ui) {
        const AttnU u = attn_unit_of(F.vcu + ui * F.G);
        u32x4 qr[2][4];
#pragma unroll
        for (int i = 0; i < 2; ++i) { const int task = F.wave + 8 * i, g = task & 3, sub = task >> 2, head = u.kvh * 4 + g, pos = u.qb * 128 + 32 * sub + r32;
            const bf16* row = P1 + (size_t)(u.b * NSEQ + pos) * OIN + 512 + head * 64 + 8 * hh;
#pragma unroll
            for (int st = 0; st < 4; ++st) qr[i][st] = __builtin_nontemporal_load((const u32x4*)(row + 16 * st)); }
        attn_load_latv(F, P1, u, lv);
        __syncthreads();
        attn_write_lat(F, u, lk, lv);
        bf16x8 qf[2][4]; f32x16 O[2][2]; float mrun[2], lrun[2];
#pragma unroll
        for (int i = 0; i < 2; ++i) { const int task = F.wave + 8 * i, g = task & 3, sub = task >> 2, head = u.kvh * 4 + g, pos = u.qb * 128 + 32 * sub + r32;
            const LAS float* c0 = ropel + (pos >> 6) * 16 + 8 * hh; const LAS float* c1 = ropel + (pos & 63) * 16 + 8 * hh;
            qf[i][0] = rope_pack(qr[i][0], qr[i][1], c0, c0 + 1024, QSC, false); qf[i][1] = rope_pack(qr[i][0], qr[i][1], c0, c0 + 1024, QSC, true);
            qf[i][2] = rope_pack(qr[i][2], qr[i][3], c1, c1 + 1024, QSC, false); qf[i][3] = rope_pack(qr[i][2], qr[i][3], c1, c1 + 1024, QSC, true);
            mrun[i] = F.in[I_OSINK][head] * 1.4426950408889634f; lrun[i] = 1.0f;
#pragma unroll
            for (int dt = 0; dt < 2; ++dt)
#pragma unroll
                for (int r = 0; r < 16; ++r) O[i][dt][r] = 0.f; }
        __syncthreads();
        const int kt_lo = (u.qb == 0) ? 4 : 0, kt_hi = (u.qb == 31) ? 7 : 11;
#pragma unroll
        for (int i = 0; i < 2; ++i) { const int sub = (F.wave + 8 * i) >> 2, qrel = 128 + 32 * sub + r32;
            attn_tiles(F, max(sub, kt_lo), min(sub + 8, kt_hi), sub, sub + 8, qf[i], O[i], mrun[i], lrun[i], qrel); }
        attn_load_ctx(F, P1, u, ck, cv);
        __syncthreads();
        attn_write_ctx(F, ck, cv);
        __syncthreads();
        if (ui + 1 < nu) attn_load_latk(F, P1, attn_unit_of(F.vcu + (ui + 1) * F.G), lk);
#pragma unroll
        for (int i = 0; i < 2; ++i) {
            attn_tiles(F, 0, 7, -1, -1, qf[i], O[i], mrun[i], lrun[i], 0);
            const int task = F.wave + 8 * i, g = task & 3, sub = task >> 2, head = u.kvh * 4 + g, pos = u.qb * 128 + 32 * sub + r32;
            const float inv = 1.0f / lrun[i];
            bf16* o = MIX + (size_t)(u.b * NSEQ + pos) * D + 512 + head * 64 + 4 * hh;
#pragma unroll
            for (int dt = 0; dt < 2; ++dt)
#pragma unroll
                for (int rg = 0; rg < 4; ++rg) { u32x2 w; w.x = pk2(O[i][dt][4 * rg] * inv, O[i][dt][4 * rg + 1] * inv); w.y = pk2(O[i][dt][4 * rg + 2] * inv, O[i][dt][4 * rg + 3] * inv);
                    *(u32x2*)(o + dt * 32 + 8 * rg) = w; }
        }
    }
    __syncthreads();
}

__device__ __forceinline__ void phase_pool_stencil(Frame& F) {
    const bf16* P1 = (const bf16*)(F.ws + WS_BUFP);
    bf16* MIX = (bf16*)(F.ws + WS_BUFA);
    const int gw = F.vcu * NWAVES + F.wave, NGW = F.G * NWAVES;
    const int r = 1 << (F.lane >> 4);
    constexpr int NT = 8, NR = NT + 16;
    for (int t = NT * gw; t < TL; t += NT * NGW) {
        const int pos = t & 4095;
        const bf16* base = P1 + (size_t)t * OIN + 8 * F.lane;
        u32x4 v[NR];
#pragma unroll
        for (int jj = 0; jj < NR; ++jj) { const int pj = pos + jj - 8; const bool ok = pj >= 0 && pj < NSEQ; v[jj] = ok ? *(const u32x4*)(base + (ptrdiff_t)(jj - 8) * OIN) : (u32x4){0u, 0u, 0u, 0u}; }
        float acc[NT][8];
#pragma unroll
        for (int q = 0; q < NT; ++q)
#pragma unroll
            for (int i = 0; i < 8; ++i) acc[q][i] = 0.f;
#pragma unroll
        for (int jj = 0; jj < NR; ++jj) {
            float x[8];
#pragma unroll
            for (int i = 0; i < 4; ++i) { x[2 * i] = bflo(v[jj][i]); x[2 * i + 1] = bfhi(v[jj][i]); }
#pragma unroll
            for (int q = 0; q < NT; ++q) { const int dd = jj - 8 - q; if (dd >= -8 && dd <= 8) { const float w = (dd <= r && dd >= -r) ? 1.0f : 0.0f;
#pragma unroll
                for (int i = 0; i < 8; ++i) acc[q][i] += w * x[i]; } }
        }
#pragma unroll
        for (int q = 0; q < NT; ++q) {
            const int pq = pos + q, lo = max(pq - r, 0), hi = min(pq + r + 1, NSEQ);
            const float ic = 1.0f / (float)(hi - lo);
            const u32x4 sv = v[q + 8];
            u32x4 o;
#pragma unroll
            for (int i = 0; i < 4; ++i) o[i] = pk2(acc[q][2 * i] * ic - bflo(sv[i]), acc[q][2 * i + 1] * ic - bfhi(sv[i]));
            *(u32x4*)(MIX + (size_t)(t + q) * D + 8 * F.lane) = o;
        }
    }
}

__device__ __forceinline__ void phase_attn_pool(Frame& F) {
    phase_attn(F);
#ifdef DBG_ATTN2
    phase_attn(F);
#endif
    phase_pool_stencil(F);
    __syncthreads();
    convert_l1_static(F);
}

constexpr int NPHASE = 20;
__global__ void __launch_bounds__(NWAVES * 64, 2) mk_fwd(Args args) {
    extern __shared__ __attribute__((aligned(16))) unsigned char lds_raw[];
    Frame F;
    F.lds = (LAS unsigned char*)lds_raw;
    F.tid = threadIdx.x; F.lane = F.tid & 63; F.wave = __builtin_amdgcn_readfirstlane(F.tid >> 6);
    F.G = gridDim.x; { const int bx = blockIdx.x; F.vcu = (F.G % 8 == 0) ? (bx % 8) * (F.G / 8) + bx / 8 : bx; }
    F.ws = args.ws; F.in = args.in; F.out = args.out;
    for (int u = F.tid; u < (LDS_BYTES - LDS_CTL) / 4; u += NWAVES * 64) ((LAS unsigned*)(F.lds + LDS_CTL))[u] = 0u;
    __syncthreads();
    const int lo = args.ph_lo, hi = args.ph_hi;
    XcdBarrier bar; bar.bar = (unsigned*)(F.ws + WS_CTL); bar.x = 0; bar.st = nullptr;
    if (hi - lo > 1) bar = xcd_barrier_post((unsigned*)(F.ws + WS_CTL), (volatile LAS unsigned*)(F.lds + LDS_CTL));
#define IN(k) (lo <= (k) && (k) < hi)
#ifndef PHASE_MASK
#define PHASE_MASK 0xffffffffu
#endif
#define PH(k, ...) if constexpr (((PHASE_MASK >> (k)) & 1u) != 0u) if (IN(k)) { __VA_ARGS__ if constexpr (((DBG_DOUBLE >> (k)) & 1u) != 0u) { __VA_ARGS__ } }
#define SEAM(k) do { if (IN(k) && IN((k) + 1)) xcd_barrier(bar); } while (0)
    unsigned char* ws = F.ws;
    const float* mods = (const float*)(ws + WS_MODS);

    PH(1, { phase_prologue_a(F); }) SEAM(1);
    PH(2, {
        pg8::SchedDense S{(const char*)(ws + WS_BUFA), (const char*)(ws + WS_W_EIN), 1024, 8, 136, 0, 1088, F.vcu, F.G};
        pg8::EpiStore E{(bf16*)(ws + WS_BUFP), EIN};
        pg8::gemm_phase<pg8::EpiStore, pg8::SchedDense>(F.lds, 1024, S, E);
    }) SEAM(2);
    PH(3, { phase_fourier_a_conv(F); }) SEAM(3);
    PH(4, { phase_fourier_c(F); }) SEAM(4);
    PH(5, {
        pg8::SchedDense S{(const char*)(ws + WS_BUFA), (const char*)(ws + WS_W_EOUT), 1024, 4, 136, 0, 544, F.vcu, F.G};
        pg8::EpiResid<true> E{F.in[I_X], F.in[I_CTX], (bf16*)(ws + WS_HB), mods + 2 * 1024};
        pg8::gemm_phase<pg8::EpiResid<true>, pg8::SchedDense>(F.lds, 1024, S, E);
    }) SEAM(5);
    PH(6, { phase_route(F, 0, T); }) SEAM(6);
    PH(7, {
        const int ntile = moe_tables(F, 0);
        if constexpr (FP8_G1_L0) {
            pg8::SchedMoe<true> S{(const char*)(ws + WS_BUFA), (const char*)(ws + WS_W_M1) + (size_t)0 * 32 * MiB, (const int*)(ws + WS_TOKMAP), (const LAS int*)(F.lds + LDS_CTL + 64), (const LAS int*)(F.lds + LDS_CTL + 192), 512, (size_t)MiB, ntile * 4, F.vcu, F.G};
            pg8::EpiSwiglu8 E{(unsigned char*)(ws + WS_BUFZ), pg8::W1_SCALE};
            pg8::gemm_phase<pg8::EpiSwiglu8, pg8::SchedMoe<true>, true>(F.lds, 512, S, E);
        } else {
            pg8::SchedMoe<true> S{(const char*)(ws + WS_BUFA), (const char*)(ws + WS_W_M1) + (size_t)0 * 32 * MiB, (const int*)(ws + WS_TOKMAP), (const LAS int*)(F.lds + LDS_CTL + 64), (const LAS int*)(F.lds + LDS_CTL + 192), 1024, (size_t)2 * MiB, ntile * 4, F.vcu, F.G};
            if constexpr (FP8_G2_L0) { pg8::EpiSwiglu8 E{(unsigned char*)(ws + WS_BUFZ), 1.0f}; pg8::gemm_phase<pg8::EpiSwiglu8, pg8::SchedMoe<true>>(F.lds, 1024, S, E); }
            else { pg8::EpiSwiglu E{(bf16*)(ws + WS_BUFZ)}; pg8::gemm_phase<pg8::EpiSwiglu, pg8::SchedMoe<true>>(F.lds, 1024, S, E); }
        }
    }) SEAM(7);
    PH(8, {
        const int ntile = moe_tables(F, 0);
        if constexpr (FP8_G2_L0) {
            pg8::SchedMoe<false> S{(const char*)(ws + WS_BUFZ), (const char*)(ws + WS_W_M2) + (size_t)0 * 16 * MiB, nullptr, (const LAS int*)(F.lds + LDS_CTL + 64), (const LAS int*)(F.lds + LDS_CTL + 192), 256, (size_t)512 * KiB, ntile * 4, F.vcu, F.G};
            pg8::EpiStoreS E{(bf16*)(ws + WS_BUFP), 1024, 1.0f / (pg8::HID_SCALE * pg8::W2_SCALE)};
            pg8::gemm_phase<pg8::EpiStoreS, pg8::SchedMoe<false>, true>(F.lds, 256, S, E);
        } else {
            pg8::SchedMoe<false> S{(const char*)(ws + WS_BUFZ), (const char*)(ws + WS_W_M2) + (size_t)0 * 16 * MiB, nullptr, (const LAS int*)(F.lds + LDS_CTL + 64), (const LAS int*)(F.lds + LDS_CTL + 192), 512, (size_t)MiB, ntile * 4, F.vcu, F.G};
            pg8::EpiStore E{(bf16*)(ws + WS_BUFP), 1024};
            pg8::gemm_phase<pg8::EpiStore, pg8::SchedMoe<false>>(F.lds, 512, S, E);
        }
    }) SEAM(8);
    PH(9, { (void)moe_tables(F, 0); phase_combine(F, 0, T); }) SEAM(9);
    PH(10, {
        pg8::SchedDense S{(const char*)(ws + WS_BUFA), (const char*)(ws + WS_W_OIN), 1024, 5, 128, 4, 648, F.vcu, F.G};
        pg8::EpiStore E{(bf16*)(ws + WS_BUFP), OIN};
        pg8::gemm_phase<pg8::EpiStore, pg8::SchedDense>(F.lds, 1024, S, E);
    }) SEAM(10);
    PH(11, { phase_attn_pool(F); }) SEAM(11);
    PH(12, {
        pg8::SchedDense S{(const char*)(ws + WS_BUFA), (const char*)(ws + WS_W_OOUT), 1024, 4, 128, 0, 512, F.vcu, F.G};
        pg8::EpiResid<false> E{nullptr, nullptr, (bf16*)(ws + WS_HB), mods + 9 * 6144 + 2 * 1024};
        pg8::gemm_phase<pg8::EpiResid<false>, pg8::SchedDense>(F.lds, 1024, S, E);
    }) SEAM(12);
    PH(13, { phase_route(F, 1, TL); }) SEAM(13);
    PH(14, {
        const int ntile = moe_tables(F, 1);
        if constexpr (FP8_G1_L1) {
            pg8::SchedMoe<true> S{(const char*)(ws + WS_BUFA), (const char*)(ws + WS_W_M1) + (size_t)1 * 32 * MiB, (const int*)(ws + WS_TOKMAP), (const LAS int*)(F.lds + LDS_CTL + 64), (const LAS int*)(F.lds + LDS_CTL + 192), 512, (size_t)MiB, ntile * 4, F.vcu, F.G};
            pg8::EpiSwiglu8 E{(unsigned char*)(ws + WS_BUFZ), pg8::W1_SCALE};
            pg8::gemm_phase<pg8::EpiSwiglu8, pg8::SchedMoe<true>, true>(F.lds, 512, S, E);
        } else {
            pg8::SchedMoe<true> S{(const char*)(ws + WS_BUFA), (const char*)(ws + WS_W_M1) + (size_t)1 * 32 * MiB, (const int*)(ws + WS_TOKMAP), (const LAS int*)(F.lds + LDS_CTL + 64), (const LAS int*)(F.lds + LDS_CTL + 192), 1024, (size_t)2 * MiB, ntile * 4, F.vcu, F.G};
            if constexpr (FP8_G2_L1) { pg8::EpiSwiglu8 E{(unsigned char*)(ws + WS_BUFZ), 1.0f}; pg8::gemm_phase<pg8::EpiSwiglu8, pg8::SchedMoe<true>>(F.lds, 1024, S, E); }
            else { pg8::EpiSwiglu E{(bf16*)(ws + WS_BUFZ)}; pg8::gemm_phase<pg8::EpiSwiglu, pg8::SchedMoe<true>>(F.lds, 1024, S, E); }
        }
    }) SEAM(14);
    PH(15, {
        const int ntile = moe_tables(F, 1);
        if constexpr (FP8_G2_L1) {
            pg8::SchedMoe<false> S{(const char*)(ws + WS_BUFZ), (const char*)(ws + WS_W_M2) + (size_t)1 * 16 * MiB, nullptr, (const LAS int*)(F.lds + LDS_CTL + 64), (const LAS int*)(F.lds + LDS_CTL + 192), 256, (size_t)512 * KiB, ntile * 4, F.vcu, F.G};
            pg8::EpiStoreS E{(bf16*)(ws + WS_BUFP), 1024, 1.0f / (pg8::HID_SCALE * pg8::W2_SCALE)};
            pg8::gemm_phase<pg8::EpiStoreS, pg8::SchedMoe<false>, true>(F.lds, 256, S, E);
        } else {
            pg8::SchedMoe<false> S{(const char*)(ws + WS_BUFZ), (const char*)(ws + WS_W_M2) + (size_t)1 * 16 * MiB, nullptr, (const LAS int*)(F.lds + LDS_CTL + 64), (const LAS int*)(F.lds + LDS_CTL + 192), 512, (size_t)MiB, ntile * 4, F.vcu, F.G};
            pg8::EpiStore E{(bf16*)(ws + WS_BUFP), 1024};
            pg8::gemm_phase<pg8::EpiStore, pg8::SchedMoe<false>>(F.lds, 512, S, E);
        }
    }) SEAM(15);
    PH(16, { (void)moe_tables(F, 1); phase_combine(F, 1, TL); }) SEAM(16);
#ifdef DBG_XBAR
    if (hi - lo > 1) { for (int xb = 0; xb < DBG_XBAR; ++xb) xcd_barrier(bar); }
#endif
#undef IN
#undef SEAM
}

extern "C" void kernel_launch(void* const* d_in, const int* in_sizes, int n_in, void* d_out, int out_size, void* d_ws, size_t ws_size, hipStream_t stream) {
    static int grid = 0;
    if (grid == 0) {
        if (n_in != 22 || ws_size < WS_END) { fprintf(stderr, "kernel_launch: unexpected inputs (n_in %d, ws %zu)\n", n_in, ws_size); grid = -1; return; }
        int dev = 0, cus = 0, per_cu = 0;
        if (hipGetDevice(&dev) != hipSuccess || hipDeviceGetAttribute(&cus, hipDeviceAttributeMultiprocessorCount, dev) != hipSuccess) { grid = -1; return; }
        if (hipFuncSetAttribute((const void*)mk_fwd, hipFuncAttributeMaxDynamicSharedMemorySize, LDS_BYTES) != hipSuccess) { fprintf(stderr, "kernel_launch: hipFuncSetAttribute failed\n"); grid = -1; return; }
        if (hipOccupancyMaxActiveBlocksPerMultiprocessor(&per_cu, (const void*)mk_fwd, NWAVES * 64, LDS_BYTES) != hipSuccess || per_cu < 1) { fprintf(stderr, "kernel_launch: occupancy query says %d\n", per_cu); }
        (void)hipGetLastError();
        grid = cus;
        if (grid != 256) { fprintf(stderr, "kernel_launch: %d CUs; this build assumes 256\n", grid); }
    }
    if (grid < 0) return;
    (void)hipMemsetAsync((char*)d_ws + WS_CTL, 0, CTL_ZERO_BYTES, stream);
    Args a{};
    for (int i = 0; i < 22; ++i) a.in[i] = (const float*)d_in[i];
    a.out = (float*)d_out; a.ws = (unsigned char*)d_ws;
#if MK_MULTI
    for (int p = 0; p <= DBG_STOP; ++p) { a.ph_lo = p; a.ph_hi = p + 1; hipLaunchKernelGGL(mk_fwd, dim3(grid), dim3(NWAVES * 64), LDS_BYTES, stream, a); }
    if (DBG_STOP < 16) { a.ph_lo = 17; a.ph_hi = 18; hipLaunchKernelGGL(mk_fwd, dim3(grid), dim3(NWAVES * 64), LDS_BYTES, stream, a); }
#else
    a.ph_lo = 0; a.ph_hi = 17;
    hipLaunchKernelGGL(mk_fwd, dim3(grid), dim3(NWAVES * 64), LDS_BYTES, stream, a);
#endif
}
```

```cpp
#include <hip/hip_runtime.h>
#include <cstdio>
#include <cstdint>
#include <type_traits>

#ifndef MK_MULTI
#define MK_MULTI 0
#endif
#ifndef DBG_STOP
#define DBG_STOP 16
#endif

#ifndef DBG_DOUBLE
#define DBG_DOUBLE 0u
#endif
#ifndef FP8_G1_L0
#define FP8_G1_L0 1
#endif
#ifndef FP8_G1_L1
#define FP8_G1_L1 1
#endif
#ifndef FP8_G2_L0
#define FP8_G2_L0 1
#endif
#ifndef FP8_G2_L1
#define FP8_G2_L1 1
#endif
#define LAS __attribute__((address_space(3)))
#define GAS __attribute__((address_space(1)))
typedef unsigned short bf16;
typedef short bf16x8 __attribute__((ext_vector_type(8)));
typedef short s16x4 __attribute__((ext_vector_type(4)));
typedef float f32x4 __attribute__((ext_vector_type(4)));
typedef float f32x16 __attribute__((ext_vector_type(16)));
typedef unsigned u32x4 __attribute__((ext_vector_type(4)));
typedef unsigned u32x2 __attribute__((ext_vector_type(2)));

constexpr int NB = 8, NSEQ = 4096, D = 1024, LCTX = 256;
constexpr int TL = NB * NSEQ, TC = NB * LCTX, T = TL + TC;
constexpr int EIN = 2048;
constexpr int OIN = 1280;
constexpr int NE = 16, DE = 512;
constexpr int MAXSLOT = 73728;
constexpr float EPS = 1e-6f;

constexpr size_t KiB = 1024, MiB = 1024 * 1024;
constexpr size_t WS_CTL = 0, CTL_ZERO_BYTES = 64 * KiB;
constexpr size_t WS_MODS = 64 * KiB;
constexpr size_t WS_ROPE = WS_MODS + 512 * KiB;
constexpr size_t WS_WA = WS_ROPE + 8 * KiB;
constexpr size_t WS_WAC = WS_WA + 32 * KiB;
constexpr size_t WS_WCC = WS_WAC + 2 * KiB;
constexpr size_t WS_FD = 3 * MiB - 64 * KiB;
constexpr size_t WS_BCNT = WS_WCC + 16 * KiB;
constexpr size_t WS_TILEMAP = WS_BCNT + 16 * KiB;
constexpr size_t WS_SLOT = WS_TILEMAP + 2 * KiB;
constexpr size_t WS_WROW = WS_SLOT + 288 * KiB;
constexpr size_t WS_ROUTE = WS_WROW + 288 * KiB;
constexpr size_t WS_WC = 3 * MiB;
constexpr size_t WS_W_EIN = 4 * MiB;
constexpr size_t WS_W_EOUT = 9 * MiB;
constexpr size_t WS_W_OIN = 11 * MiB;
constexpr size_t WS_W_OOUT = 14 * MiB;
constexpr size_t WS_W_POOL = 16 * MiB;
constexpr size_t WS_W_M1 = 17 * MiB;
constexpr size_t WS_W_M2 = 81 * MiB;
constexpr size_t WS_HC = 113 * MiB;
constexpr size_t WS_BUFA = 121 * MiB;
constexpr size_t WS_BUFP = 189 * MiB;
constexpr size_t WS_BUFZ = 360 * MiB;
constexpr size_t WS_TOKMAP = 432 * MiB;
constexpr size_t WS_HB = 435 * MiB;
constexpr size_t WS_END = 503 * MiB;
constexpr size_t WS_MODSDONE = 24 * KiB;
constexpr size_t WS_P5F = 28 * KiB, WS_P5C = 28 * KiB + 256;
constexpr size_t WS_GCNT = 16 * KiB;
static_assert(WS_ROUTE + (size_t)T * 32 <= WS_WC, "small region");
static_assert((size_t)T * EIN * 2 <= WS_BUFZ - WS_BUFP && (size_t)MAXSLOT * 1024 * 2 <= WS_BUFZ - WS_BUFP, "BUFP");
static_assert((size_t)MAXSLOT * 512 * 2 <= WS_TOKMAP - WS_BUFZ && (size_t)T * 1024 * 2 <= WS_TOKMAP - WS_BUFZ, "BUFZ");
static_assert((size_t)16 * T * 4 <= WS_HB - WS_TOKMAP && (size_t)T * 1024 * 2 <= WS_END - WS_HB, "TOKMAP / HB");
static_assert((size_t)T * 1024 * 2 <= WS_BUFP - WS_BUFA, "BUFA");

constexpr int LDS_BYTES = 163840;
constexpr int LDS_GIDX = 147456;
constexpr int LDS_CTL = 146432;
constexpr int NWAVES = 8;

__device__ __forceinline__ unsigned f2bf(float f) { unsigned u = __builtin_bit_cast(unsigned, f); return (u + 0x7fffu + ((u >> 16) & 1u)) >> 16; }
__device__ __forceinline__ unsigned pk2(float lo, float hi) { return f2bf(lo) | (f2bf(hi) << 16); }
__device__ __forceinline__ float bflo(unsigned w) { return __builtin_bit_cast(float, w << 16); }
__device__ __forceinline__ float bfhi(unsigned w) { return __builtin_bit_cast(float, w & 0xffff0000u); }
__device__ __forceinline__ float wave_sum(float v) {
#pragma unroll
    for (int o = 1; o < 64; o <<= 1) v += __shfl_xor(v, o);
    return v;
}
__device__ __forceinline__ int ld_coh(const int* p) { return (int)__hip_atomic_load((const unsigned*)p, __ATOMIC_RELAXED, __HIP_MEMORY_SCOPE_AGENT); }
__device__ __forceinline__ float ld_cohf(const float* p) { return __builtin_bit_cast(float, __hip_atomic_load((const unsigned*)p, __ATOMIC_RELAXED, __HIP_MEMORY_SCOPE_AGENT)); }
#define LDS_WAIT() asm volatile("s_waitcnt lgkmcnt(0)" ::: "memory")

#define XB_TMO      128
#define XB_XCNT(j)  (256  + 64 * (j))
#define XB_XSUB(j)  (1280 + 64 * (j))
#define XB_XGEN(j)  (2304 + 64 * (j))
#define XB_TOP      3328
#define XB_TOPGEN   3392
#define XCD_BAR_WORDS 3456
#define XB_SPIN_CAP (1u << 18)
__device__ __forceinline__ unsigned xb_ld(unsigned* p)              { return __hip_atomic_load(p, __ATOMIC_RELAXED, __HIP_MEMORY_SCOPE_AGENT); }
__device__ __forceinline__ unsigned xb_add(unsigned* p, unsigned v) { return __hip_atomic_fetch_add(p, v, __ATOMIC_RELAXED, __HIP_MEMORY_SCOPE_AGENT); }
__device__ __forceinline__ unsigned xb_xcc_id() { return (unsigned)__builtin_amdgcn_s_getreg((3 << 11) | 20) & 0xFu; }
#define XB_SPIN(cond, bar) do { unsigned _sp = 0; while (cond) { __builtin_amdgcn_s_sleep(1); \
    if ((++_sp & 255u) == 0u) { if (xb_ld(&(bar)[XB_TMO])) break; if (_sp > XB_SPIN_CAP) { atomicAdd(&(bar)[XB_TMO], 1u); break; } } } } while (0)
struct XcdBarrier { unsigned* bar; unsigned x; volatile LAS unsigned* st; };
__device__ __forceinline__ XcdBarrier xcd_barrier_post(unsigned* bar, volatile LAS unsigned* st) {
    XcdBarrier b; b.bar = bar; b.x = xb_xcc_id(); b.st = st;
    if (threadIdx.x == 0) (void)xb_add(&bar[XB_XCNT(b.x)], 1u);
    return b;
}
__device__ __forceinline__ void xcd_barrier_complete(unsigned* bar, unsigned x, unsigned& nloc, unsigned& nx) {
    const unsigned G = gridDim.x * gridDim.y * gridDim.z;
    unsigned sum, cnt, mine, sp = 0u;
    for (;;) {
        sum = 0u; cnt = 0u; mine = 0u;
#pragma unroll
        for (unsigned j = 0; j < 16; ++j) { const unsigned c = xb_ld(&bar[XB_XCNT(j)]); sum += c; cnt += (c > 0u) ? 1u : 0u; mine = (j == x) ? c : mine; }
        if (sum == G) break;
        __builtin_amdgcn_s_sleep(1);
        if ((++sp & 255u) == 0u) { if (xb_ld(&bar[XB_TMO])) break; if (sp > XB_SPIN_CAP) { atomicAdd(&bar[XB_TMO], 1u); break; } }
    }
    nloc = mine > 0u ? mine : 1u; nx = cnt > 0u ? cnt : 1u;
}
__device__ __forceinline__ void xcd_barrier(const XcdBarrier& b) {
    asm volatile("s_waitcnt vmcnt(0)" ::: "memory");
    __syncthreads();
    if (threadIdx.x == 0) {
        unsigned* bar = b.bar;
        __builtin_amdgcn_s_waitcnt(0);
        unsigned nloc = b.st[0], nx = b.st[1];
        if (nloc == 0u) { xcd_barrier_complete(bar, b.x, nloc, nx); b.st[0] = nloc; b.st[1] = nx; }
        const unsigned old = xb_add(&bar[XB_XSUB(b.x)], 1u);
        const unsigned gen = old / nloc;
        if (old + 1u == (gen + 1u) * nloc) {
            __builtin_amdgcn_fence(__ATOMIC_RELEASE, "agent");
            asm volatile("s_waitcnt vmcnt(0)" ::: "memory");
            const unsigned og = xb_add(&bar[XB_TOP], 1u);
            const unsigned tg = og / nx;
            if (og + 1u == (tg + 1u) * nx) xb_add(&bar[XB_TOPGEN], 1u);
            else XB_SPIN(xb_ld(&bar[XB_TOPGEN]) == tg, bar);
            __builtin_amdgcn_fence(__ATOMIC_ACQUIRE, "agent");
            xb_add(&bar[XB_XGEN(b.x)], 1u);
            asm volatile("s_waitcnt vmcnt(0)" ::: "memory");
        } else {
            XB_SPIN(xb_ld(&bar[XB_XGEN(b.x)]) == gen, bar);
            __builtin_amdgcn_fence(__ATOMIC_ACQUIRE, "agent");
            asm volatile("s_waitcnt vmcnt(0)" ::: "memory");
        }
    }
    __syncthreads();
}

namespace pg8 {
constexpr int BM = 256, BK = 64, HALF = 128, HTB = HALF * BK * 2, STAGE_BYTES = 8 * HTB;
__host__ __device__ __forceinline__ int lds_byte(int r, int c) { const int st = (r >> 4) * 2 + (c >> 5), rr = r & 15, cc = c & 31, ob = rr * 64 + cc * 2; return st * 1024 + (ob ^ (((ob >> 9) & 1) << 5)); }
__host__ __device__ __forceinline__ void stage_rc(int b, int& R, int& C) { const int st = b / 1024, sb = b % 1024, swz = sb ^ (((sb >> 9) & 1) << 5); R = (st >> 1) * 16 + swz / 64; C = (st & 1) * 32 + (swz % 64) / 2; }
__host__ __device__ __forceinline__ int perm32(int rho) { const int n = rho >> 4, i = rho & 15; return 8 * (i >> 2) + 4 * n + (i & 3); }
struct Unit { int pm, pn, e; };
__device__ __forceinline__ unsigned cvt_pk_bf16(float lo, float hi) { unsigned r; asm volatile("v_cvt_pk_bf16_f32 %0, %1, %2" : "=v"(r) : "v"(lo), "v"(hi)); return r; }

typedef int v8i32 __attribute__((ext_vector_type(8)));
typedef int v4i32 __attribute__((ext_vector_type(4)));
__device__ __forceinline__ v8i32 cat16(const bf16x8 lo, const bf16x8 hi) { return __builtin_shufflevector(__builtin_bit_cast(v4i32, lo), __builtin_bit_cast(v4i32, hi), 0, 1, 2, 3, 4, 5, 6, 7); }
template <class Epi, class Sched, bool FP8 = false>
__device__ __forceinline__ void gemm_phase(LAS unsigned char* lds, const int K, const Sched& S, const Epi& E) {
    const int tid = threadIdx.x, wid = __builtin_amdgcn_readfirstlane(tid >> 6), lane = tid & 63, wr = wid >> 2, wc = wid & 3, fr = lane & 15, fq = lane >> 4;
    const int nt = K / BK;
    int tidv = tid;
#define PG8_VB(i) ([&]() -> unsigned { int R_, C_; stage_rc(tidv * 16 + (i) * 8192, R_, C_); const int Rb_ = Epi::PERM ? ((R_ & ~31) + perm32(R_ & 31)) : R_; return (unsigned)(Rb_ * K + C_) * 2u; }())
#define PG8_VA(h, i) ([&]() -> unsigned { int R_, C_; stage_rc(tidv * 16 + (i) * 8192, R_, C_); return (unsigned)((128 * (h) + R_) * K + C_) * 2u; }())
    const size_t kstep = (size_t)(BK * 2);
    const size_t hstep = (size_t)HALF * K * 2;
    const unsigned ldsw = (unsigned)wid * 1024u;
#define aoff (lds_byte(wr * 64 + (tidv & 15), ((tidv >> 4) & 3) * 8))
#define boff (lds_byte(wc * 32 + (tidv & 15), ((tidv >> 4) & 3) * 8))
#define PG8_SA(b, h) (((b) * 2 + (h)) * HTB)
#define PG8_SB(b, h) ((4 + (b) * 2 + (h)) * HTB)
#define PG8_STAGEB(bufoff, gbase) do { _Pragma("unroll") for (int _i = 0; _i < 2; ++_i) \
        __builtin_amdgcn_global_load_lds((const unsigned*)((const char*)(gbase) + PG8_VB(_i)), (LAS unsigned*)(lds + (bufoff) + ldsw + _i * 8192), 16, 0, 0); } while (0)
#define PG8_STAGEA(bufoff, gbase, h, NEXT) do { _Pragma("unroll") for (int _i = 0; _i < 2; ++_i) { unsigned vo_; \
        if constexpr (Sched::GATHER) { int R_, C_; stage_rc(tidv * 16 + _i * 8192, R_, C_); const unsigned raw_ = gidx[((((NEXT) && usen) ? (gslot ^ 1u) : gslot) * 4u + (h) * 2 + _i) * 512u + tid]; vo_ = (raw_ * (unsigned)K + (unsigned)C_) * 2u; } \
        else vo_ = PG8_VA(h, _i); \
        __builtin_amdgcn_global_load_lds((const unsigned*)((const char*)(gbase) + vo_), (LAS unsigned*)(lds + (bufoff) + ldsw + _i * 8192), 16, 0, 0); } } while (0)
#define PG8_LDA(dst, b, h) do { _Pragma("unroll") for (int m = 0; m < 4; ++m) _Pragma("unroll") for (int k = 0; k < 2; ++k) dst[m][k] = *(const LAS bf16x8*)(lds + PG8_SA(b, h) + aoff + m * 2048 + k * 1024); } while (0)
#define PG8_LDB(dst, b, h) do { _Pragma("unroll") for (int n = 0; n < 2; ++n) _Pragma("unroll") for (int k = 0; k < 2; ++k) dst[n][k] = *(const LAS bf16x8*)(lds + PG8_SB(b, h) + boff + n * 2048 + k * 1024); } while (0)
#define PG8_MMA(ai, bj, At, Bt) do { __builtin_amdgcn_s_setprio(1); _Pragma("unroll") for (int m = 0; m < 4; ++m) _Pragma("unroll") for (int n = 0; n < 2; ++n) { \
        if constexpr (FP8) acc[ai][bj][m][n] = __builtin_amdgcn_mfma_scale_f32_16x16x128_f8f6f4(cat16(Bt[n][0], Bt[n][1]), cat16(At[m][0], At[m][1]), acc[ai][bj][m][n], 0, 0, 0, 0x7f7f7f7f, 0, 0x7f7f7f7f); \
        else { _Pragma("unroll") for (int k = 0; k < 2; ++k) acc[ai][bj][m][n] = __builtin_amdgcn_mfma_f32_16x16x32_bf16(Bt[n][k], At[m][k], acc[ai][bj][m][n], 0, 0, 0); } } \
        __builtin_amdgcn_s_setprio(0); } while (0)
#define PG8_WAIT_V(n) asm volatile("s_waitcnt vmcnt(" #n ")" ::: "memory")
#define PG8_WAIT_L(n) asm volatile("s_waitcnt lgkmcnt(" #n ")" ::: "memory")
#define PG8_BAR __builtin_amdgcn_s_barrier()
#define PG8_SCHED __builtin_amdgcn_sched_barrier(0)
#define PG8_ITER(A1, A2, A3, B2, B3) do { \
            PG8_LDB(B0, 0, 0); PG8_LDB(B1, 0, 1); PG8_SCHED; PG8_LDA(At, 0, 0); PG8_STAGEA(PG8_SA(1, 1), A1, 1, 0); \
            PG8_WAIT_V(8); PG8_WAIT_L(0); PG8_BAR; PG8_MMA(0, 0, At, B0); PG8_MMA(0, 1, At, B1); PG8_BAR; PG8_SCHED; \
            PG8_LDA(At, 0, 1); PG8_STAGEB(PG8_SB(0, 0), B2); PG8_STAGEB(PG8_SB(0, 1), (B2) + hstep); PG8_STAGEA(PG8_SA(0, 0), A2, 0, 1); \
            PG8_WAIT_V(8); PG8_WAIT_L(0); PG8_BAR; PG8_MMA(1, 0, At, B0); PG8_MMA(1, 1, At, B1); PG8_BAR; PG8_SCHED; \
            PG8_LDB(B0, 1, 0); PG8_LDB(B1, 1, 1); PG8_SCHED; PG8_LDA(At, 1, 0); PG8_STAGEA(PG8_SA(0, 1), A2, 1, 1); \
            PG8_WAIT_V(8); PG8_WAIT_L(0); PG8_BAR; PG8_MMA(0, 0, At, B0); PG8_MMA(0, 1, At, B1); PG8_BAR; PG8_SCHED; \
            PG8_LDA(At, 1, 1); PG8_STAGEB(PG8_SB(1, 0), B3); PG8_STAGEB(PG8_SB(1, 1), (B3) + hstep); PG8_STAGEA(PG8_SA(1, 0), A3, 0, 1); \
            PG8_WAIT_V(8); PG8_WAIT_L(0); PG8_BAR; PG8_MMA(1, 0, At, B0); PG8_MMA(1, 1, At, B1); PG8_BAR; PG8_SCHED; } while (0)
    Unit cur, nxt; int ui = 0;
    if (!S.next(0, cur)) return;
    f32x4 acc[2][2][4][2];
#pragma unroll
    for (int a = 0; a < 2; ++a)
#pragma unroll
        for (int b = 0; b < 2; ++b)
#pragma unroll
            for (int m = 0; m < 4; ++m)
#pragma unroll
                for (int n = 0; n < 2; ++n) acc[a][b][m][n] = (f32x4){0.f, 0.f, 0.f, 0.f};
    bf16x8 At[4][2], B0[2][2], B1[2][2];
    const LAS unsigned* gidx = (const LAS unsigned*)(lds + LDS_GIDX); unsigned gslot = 0u;
    if constexpr (Sched::GATHER) { S.idx_dma(cur, (LAS unsigned*)(lds + LDS_GIDX), tidv, wid); asm volatile("s_waitcnt vmcnt(0)" ::: "memory"); }
    const char* cA = S.a_base(cur); const char* cB = S.b_base(cur);
    constexpr bool usen = false;
    PG8_STAGEB(PG8_SB(0, 0), cB); PG8_STAGEB(PG8_SB(0, 1), cB + hstep); PG8_STAGEA(PG8_SA(0, 0), cA, 0, 0); PG8_STAGEA(PG8_SA(0, 1), cA, 1, 0);
    if (wr == 1) PG8_BAR;
    PG8_WAIT_V(2); PG8_BAR;
    PG8_STAGEB(PG8_SB(1, 0), cB + kstep); PG8_STAGEA(PG8_SA(1, 0), cA + kstep, 0, 0); PG8_STAGEB(PG8_SB(1, 1), cB + hstep + kstep);
    PG8_WAIT_V(6); PG8_BAR;
    for (;;) {
        const bool has_next = S.next(ui + 1, nxt);
        const char* nA = has_next ? S.a_base(nxt) : cA; const char* nB = has_next ? S.b_base(nxt) : cB;
#pragma unroll 1
        for (int t = 0; t < nt; t += 2) {
            const bool last = (t == nt - 2);
            const char* a1 = cA + (size_t)(t + 1) * kstep;
            const char* a2 = last ? nA : cA + (size_t)(t + 2) * kstep; const char* b2 = last ? nB : cB + (size_t)(t + 2) * kstep;
            tidv = tid; asm volatile("" : "+v"(tidv));
            if constexpr (Sched::GATHER) {
                if (t == nt - 4 && has_next) S.idx_dma(nxt, (LAS unsigned*)(lds + LDS_GIDX) + (gslot ^ 1u) * 2048u, tidv, wid);
            }
            const bool usen = last && has_next;
            PG8_ITER(a1, a2, a2 + kstep, b2, b2 + kstep);
        }
        if (wr == 0) PG8_BAR;
        E(acc, cur, wr, wc, fr, fq);
        if (!has_next) break;
#pragma unroll
        for (int a = 0; a < 2; ++a)
#pragma unroll
            for (int b = 0; b < 2; ++b)
#pragma unroll
                for (int m = 0; m < 4; ++m)
#pragma unroll
                    for (int n = 0; n < 2; ++n) acc[a][b][m][n] = (f32x4){0.f, 0.f, 0.f, 0.f};
        cur = nxt; cA = nA; cB = nB; ++ui;
        if constexpr (Sched::GATHER) gslot ^= 1u;
        if (wr == 1) PG8_BAR;
    }
    PG8_WAIT_V(0);
    PG8_BAR;
#undef PG8_ITER
#undef aoff
#undef boff
#undef PG8_SA
#undef PG8_SB
#undef PG8_STAGEA
#undef PG8_STAGEB
#undef PG8_VA
#undef PG8_VB
#undef PG8_LDA
#undef PG8_LDB
#undef PG8_MMA
#undef PG8_WAIT_V
#undef PG8_WAIT_L
#undef PG8_BAR
#undef PG8_SCHED
}

struct SchedDense {
    static constexpr bool GATHER = false;
    const char* A; const char* Bt; int K, nN, nMfull, pnx, nUnits, c, G;
    __device__ __forceinline__ bool next(int i, Unit& u) const {
        const int L = i * G + c; if (L >= nUnits) return false;
        const int full = nMfull * nN;
        if (L < full) { u.pm = L / nN; u.pn = L - u.pm * nN; } else { u.pm = nMfull + (L - full); u.pn = pnx; }
        u.e = 0; return true;
    }
    __device__ __forceinline__ const char* a_base(const Unit& u) const { return A + (size_t)u.pm * 256 * K * 2; }
    __device__ __forceinline__ const char* b_base(const Unit& u) const { return Bt + (size_t)u.pn * 256 * K * 2; }
};
struct SchedSplit {
    static constexpr bool GATHER = false;
    const char* A; const char* Bt; int K, base, stride, n;
    __device__ __forceinline__ bool next(int i, Unit& u) const {
        if (i >= n) return false;
        const int L = base + i * stride; u.pm = L >> 2; u.pn = L & 3; u.e = 0; return true;
    }
    __device__ __forceinline__ const char* a_base(const Unit& u) const { return A + (size_t)u.pm * 256 * K * 2; }
    __device__ __forceinline__ const char* b_base(const Unit& u) const { return Bt + (size_t)u.pn * 256 * K * 2; }
};
template <bool GATHER_> struct SchedMoe {
    static constexpr bool GATHER = GATHER_, gather = GATHER_;
    const char* A; const char* W; const int* tokmap; const LAS int* tb; const LAS int* cn; int K; size_t wstride; int nUnits, c, G;
    __device__ __forceinline__ bool next(int i, Unit& u) const {
        const int L = i * G + c; if (L >= nUnits) return false;
        u.pm = L >> 2; u.pn = L & 3; int e = 0;
#pragma unroll
        for (int q = 1; q < 16; ++q) if (u.pm >= __builtin_amdgcn_readfirstlane(tb[q])) e = q;
        u.e = __builtin_amdgcn_readfirstlane(e); return true;
    }
    __device__ __forceinline__ const char* a_base(const Unit& u) const { return gather ? A : A + (size_t)u.pm * 256 * K * 2; }
    __device__ __forceinline__ const char* b_base(const Unit& u) const { return W + (size_t)u.e * wstride + (size_t)u.pn * 256 * K * 2; }
    __device__ __forceinline__ void idx_dma(const Unit& u, LAS unsigned* slot, int tidv, int wid) const {
        const int p0 = (u.pm - __builtin_amdgcn_readfirstlane(tb[u.e])) * 256, last = __builtin_amdgcn_readfirstlane(cn[u.e]) - 1; const int* tm = tokmap + (size_t)u.e * T;
#pragma unroll
        for (int h = 0; h < 2; ++h)
#pragma unroll
            for (int i = 0; i < 2; ++i) { int R_, C_; stage_rc(tidv * 16 + i * 8192, R_, C_); int pos = p0 + 128 * h + R_; pos = pos < last ? pos : last;
                __builtin_amdgcn_global_load_lds((const unsigned*)(tm + pos), slot + (h * 2 + i) * 512 + wid * 64, 4, 0, 0); }
    }
};

struct EpiStore {
    static constexpr bool PERM = true;
    bf16* O; int ldc;
    __device__ __forceinline__ void operator()(const f32x4 (&acc)[2][2][4][2], const Unit& u, int wr, int wc, int fr, int fq) const {
        const int row0 = u.pm * BM + wr * 64 + fr, col0 = u.pn * BM + wc * 32 + 8 * fq;
#pragma unroll
        for (int ai = 0; ai < 2; ++ai)
#pragma unroll
            for (int m = 0; m < 4; ++m) { bf16* rowp = O + (size_t)(row0 + ai * HALF + m * 16) * ldc + col0;
#pragma unroll
                for (int bj = 0; bj < 2; ++bj) { const f32x4 v0 = acc[ai][bj][m][0], v1 = acc[ai][bj][m][1];
                    u32x4 w; w.x = cvt_pk_bf16(v0[0], v0[1]); w.y = cvt_pk_bf16(v0[2], v0[3]); w.z = cvt_pk_bf16(v1[0], v1[1]); w.w = cvt_pk_bf16(v1[2], v1[3]);
                    *(u32x4*)(rowp + bj * HALF) = w; } }
    }
};
template <bool SRC_F32> struct EpiResid {
    static constexpr bool PERM = true;
    const float* srcL; const float* srcC; bf16* H; const float* gate;
    __device__ __forceinline__ void operator()(const f32x4 (&acc)[2][2][4][2], const Unit& u, int wr, int wc, int fr, int fq) const {
        const float* g = gate + (u.pm < 128 ? (u.pm >> 4) : 8) * 6144;
        const float* src = (u.pm < 128) ? srcL + (size_t)u.pm * 256 * 1024 : srcC + (size_t)(u.pm - 128) * 256 * 1024;
        bf16* dst = H + (size_t)u.pm * 256 * 1024;
        const int row0 = wr * 64 + fr, col0 = u.pn * BM + wc * 32 + 8 * fq;
        f32x4 gv[2][2];
#pragma unroll
        for (int bj = 0; bj < 2; ++bj)
#pragma unroll
            for (int n = 0; n < 2; ++n) gv[bj][n] = *(const f32x4*)(g + col0 + bj * HALF + 4 * n);
#pragma unroll
        for (int ai = 0; ai < 2; ++ai)
#pragma unroll
            for (int m = 0; m < 4; ++m) { const size_t ro = (size_t)(row0 + ai * HALF + m * 16) * 1024 + col0;
#pragma unroll
                for (int bj = 0; bj < 2; ++bj) {
                    f32x4 s0, s1;
                    if constexpr (SRC_F32) { s0 = __builtin_nontemporal_load((const f32x4*)(src + ro + bj * HALF)); s1 = __builtin_nontemporal_load((const f32x4*)(src + ro + bj * HALF + 4)); }
                    else { const u32x4 hv = *(const u32x4*)(dst + ro + bj * HALF); s0 = (f32x4){bflo(hv.x), bfhi(hv.x), bflo(hv.y), bfhi(hv.y)}; s1 = (f32x4){bflo(hv.z), bfhi(hv.z), bflo(hv.w), bfhi(hv.w)}; }
                    const f32x4 v0 = s0 + gv[bj][0] * acc[ai][bj][m][0], v1 = s1 + gv[bj][1] * acc[ai][bj][m][1];
                    u32x4 w; w.x = cvt_pk_bf16(v0[0], v0[1]); w.y = cvt_pk_bf16(v0[2], v0[3]); w.z = cvt_pk_bf16(v1[0], v1[1]); w.w = cvt_pk_bf16(v1[2], v1[3]);
                    *(u32x4*)(dst + ro + bj * HALF) = w; } }
    }
};
__device__ __forceinline__ float silu_f(float x) { return x * __builtin_amdgcn_rcpf(1.0f + __expf(-x)); }
struct EpiSwiglu {
    static constexpr bool PERM = true;
    bf16* H;
    __device__ __forceinline__ void operator()(const f32x4 (&acc)[2][2][4][2], const Unit& u, int wr, int wc, int fr, int fq) const {
        const int row0 = u.pm * BM + wr * 64 + fr, col0 = u.pn * 128 + wc * 32 + 8 * fq;
#pragma unroll
        for (int ai = 0; ai < 2; ++ai)
#pragma unroll
            for (int m = 0; m < 4; ++m) { bf16* p = H + (size_t)(row0 + ai * HALF + m * 16) * 512 + col0;
                const f32x4 g0 = acc[ai][0][m][0], g1 = acc[ai][0][m][1], u0 = acc[ai][1][m][0], u1 = acc[ai][1][m][1];
                u32x4 w; w.x = cvt_pk_bf16(silu_f(g0[0]) * u0[0], silu_f(g0[1]) * u0[1]); w.y = cvt_pk_bf16(silu_f(g0[2]) * u0[2], silu_f(g0[3]) * u0[3]);
                w.z = cvt_pk_bf16(silu_f(g1[0]) * u1[0], silu_f(g1[1]) * u1[1]); w.w = cvt_pk_bf16(silu_f(g1[2]) * u1[2], silu_f(g1[3]) * u1[3]);
                *(u32x4*)p = w; }
    }
};
__device__ __forceinline__ unsigned pk4_fp8(float a, float b, float c, float d) { int p = __builtin_amdgcn_cvt_pk_fp8_f32(a, b, 0, false); p = __builtin_amdgcn_cvt_pk_fp8_f32(c, d, p, true); return (unsigned)p; }
constexpr float W1_SCALE = 32.0f, W2_SCALE = 16.0f, HID_SCALE = 4.0f;
struct EpiSwiglu8 {
    static constexpr bool PERM = true;
    unsigned char* H; float in_scale;
    __device__ __forceinline__ void operator()(const f32x4 (&acc)[2][2][4][2], const Unit& u, int wr, int wc, int fr, int fq) const {
        const int row0 = u.pm * BM + wr * 64 + fr, col0 = u.pn * 128 + wc * 32 + 8 * fq;
        const float IS = 1.0f / in_scale, OS = HID_SCALE / in_scale;
#pragma unroll
        for (int ai = 0; ai < 2; ++ai)
#pragma unroll
            for (int m = 0; m < 4; ++m) { unsigned char* p = H + (size_t)(row0 + ai * HALF + m * 16) * 512 + col0;
                const f32x4 g0 = acc[ai][0][m][0] * IS, g1 = acc[ai][0][m][1] * IS, u0 = acc[ai][1][m][0] * OS, u1 = acc[ai][1][m][1] * OS;
#define HC8(x) __builtin_fminf(__builtin_fmaxf((x), -448.0f), 448.0f)
                u32x2 w; w.x = pk4_fp8(HC8(silu_f(g0[0]) * u0[0]), HC8(silu_f(g0[1]) * u0[1]), HC8(silu_f(g0[2]) * u0[2]), HC8(silu_f(g0[3]) * u0[3]));
                w.y = pk4_fp8(HC8(silu_f(g1[0]) * u1[0]), HC8(silu_f(g1[1]) * u1[1]), HC8(silu_f(g1[2]) * u1[2]), HC8(silu_f(g1[3]) * u1[3]));
#undef HC8
                *(u32x2*)p = w; }
    }
};
struct EpiStoreS {
    static constexpr bool PERM = true;
    bf16* O; int ldc; float scale;
    __device__ __forceinline__ void operator()(const f32x4 (&acc)[2][2][4][2], const Unit& u, int wr, int wc, int fr, int fq) const {
        const int row0 = u.pm * BM + wr * 64 + fr, col0 = u.pn * BM + wc * 32 + 8 * fq;
#pragma unroll
        for (int ai = 0; ai < 2; ++ai)
#pragma unroll
            for (int m = 0; m < 4; ++m) { bf16* rowp = O + (size_t)(row0 + ai * HALF + m * 16) * ldc + col0;
#pragma unroll
                for (int bj = 0; bj < 2; ++bj) { const f32x4 v0 = acc[ai][bj][m][0] * scale, v1 = acc[ai][bj][m][1] * scale;
                    u32x4 w; w.x = cvt_pk_bf16(v0[0], v0[1]); w.y = cvt_pk_bf16(v0[2], v0[3]); w.z = cvt_pk_bf16(v1[0], v1[1]); w.w = cvt_pk_bf16(v1[2], v1[3]);
                    *(u32x4*)(rowp + bj * HALF) = w; } }
    }
};
struct EpiScaleRow {
    static constexpr bool PERM = true;
    bf16* O; const float* wrow;
    __device__ __forceinline__ void operator()(const f32x4 (&acc)[2][2][4][2], const Unit& u, int wr, int wc, int fr, int fq) const {
        const int row0 = u.pm * BM + wr * 64 + fr, col0 = u.pn * BM + wc * 32 + 8 * fq;
#pragma unroll
        for (int ai = 0; ai < 2; ++ai)
#pragma unroll
            for (int m = 0; m < 4; ++m) { const int row = row0 + ai * HALF + m * 16; const float s = wrow[row]; bf16* rowp = O + (size_t)row * 1024 + col0;
#pragma unroll
                for (int bj = 0; bj < 2; ++bj) { const f32x4 v0 = acc[ai][bj][m][0] * s, v1 = acc[ai][bj][m][1] * s;
                    u32x4 w; w.x = cvt_pk_bf16(v0[0], v0[1]); w.y = cvt_pk_bf16(v0[2], v0[3]); w.z = cvt_pk_bf16(v1[0], v1[1]); w.w = cvt_pk_bf16(v1[2], v1[3]);
                    *(u32x4*)(rowp + bj * HALF) = w; } }
    }
};
}

struct Args { const float* in[22]; float* out; unsigned char* ws; int ph_lo, ph_hi; };
enum { I_X = 0, I_C, I_CTX, I_CCTX, I_ADAW, I_ADAB, I_NMG, I_NFG, I_EWIN, I_ECONV, I_EWOUT, I_OWIN, I_OPOOLW, I_OPOOLS, I_OSINK, I_OWOUT, I_RW, I_RB, I_MG, I_MU, I_MD, I_FG };

struct Frame {
    LAS unsigned char* lds;
    int tid, lane, wave, vcu, G;
    unsigned char* ws; const float* const* in; float* out;
};
__device__ __forceinline__ bf16* h_row(const Frame& F, int t) { return (bf16*)(F.ws + WS_HB) + (size_t)t * D; }
__device__ __forceinline__ int mod_row(int t) { return t < TL ? (t >> 12) : 8; }

struct TItem { const float* src; bf16* dst; int ldw, ldd; float f8scale; };
__device__ __forceinline__ void titem_load(const TItem& t, f32x4 (&r)[8], int lane) {
#pragma unroll
    for (int i = 0; i < 8; ++i) r[i] = __builtin_nontemporal_load((const f32x4*)(t.src + (size_t)((lane >> 3) + 8 * i) * t.ldw + 4 * (lane & 7)));
}
__device__ __forceinline__ void titem_process(const TItem& t, const f32x4 (&r)[8], LAS float* scr, int lane) {
#pragma unroll
    for (int i = 0; i < 8; ++i) { LAS float* d = scr + ((lane >> 3) + 8 * i) * 33 + 4 * (lane & 7); d[0] = r[i].x; d[1] = r[i].y; d[2] = r[i].z; d[3] = r[i].w; }
    LDS_WAIT(); asm volatile("" ::: "memory");
    const int c = lane & 7;
    if (t.f8scale != 0.0f) {
        const float sc = t.f8scale; unsigned char* d8 = (unsigned char*)t.dst;
#pragma unroll
        for (int j = 0; j < 4; ++j) { const int n = (lane >> 3) + 8 * j; const LAS float* s = scr + (8 * c) * 33 + n;
            u32x2 o; o.x = pg8::pk4_fp8(s[0 * 33] * sc, s[1 * 33] * sc, s[2 * 33] * sc, s[3 * 33] * sc); o.y = pg8::pk4_fp8(s[4 * 33] * sc, s[5 * 33] * sc, s[6 * 33] * sc, s[7 * 33] * sc);
            *(u32x2*)(d8 + (size_t)n * t.ldd + 8 * c) = o; }
    } else {
#pragma unroll
        for (int j = 0; j < 4; ++j) { const int n = (lane >> 3) + 8 * j; const LAS float* s = scr + (8 * c) * 33 + n;
            u32x4 o; o.x = pk2(s[0 * 33], s[1 * 33]); o.y = pk2(s[2 * 33], s[3 * 33]); o.z = pk2(s[4 * 33], s[5 * 33]); o.w = pk2(s[6 * 33], s[7 * 33]);
            *(u32x4*)(t.dst + (size_t)n * t.ldd + 8 * c) = o; }
    }
    LDS_WAIT(); asm volatile("" ::: "memory");
}
constexpr int TS0 = 1024, TS1 = 512, TS2 = 384, TS3 = 512, TS4 = 0, TS5 = 4096, TS6 = 4096, TS7 = 4096, TNITEMS = TS0 + TS1 + TS2 + TS3 + TS4 + TS5 + TS6 + TS7;
__device__ __forceinline__ TItem titem_moe(const float* const* in, unsigned char* ws, int kind, int le, int rr) {
    TItem t; const int layer = le >> 4, e = le & 15; const bool f8 = (kind < 2) ? (layer ? (FP8_G1_L1 != 0) : (FP8_G1_L0 != 0)) : (layer ? (FP8_G2_L1 != 0) : (FP8_G2_L0 != 0));
    if (kind < 2) { const int kb = (rr >> 4) & 15, nb = rr & 15, n0 = nb * 32; const int drow = (n0 >> 7) * 256 + (n0 & 127) + kind * 128;
        t.src = in[kind ? I_MU : I_MG] + (size_t)le * 524288 + (size_t)(kb * 64) * 512 + n0; t.ldw = 512;
        unsigned char* base = ws + WS_W_M1 + (size_t)layer * 32 * MiB;
        if (f8) { t.dst = (bf16*)(base + (size_t)e * MiB + (size_t)drow * 1024 + kb * 64); t.ldd = 1024; t.f8scale = pg8::W1_SCALE; }
        else { t.dst = (bf16*)(base + (size_t)e * 2 * MiB) + (size_t)drow * 1024 + kb * 64; t.ldd = 1024; t.f8scale = 0.0f; } }
    else { const int kb = (rr >> 5) & 7, nb = rr & 31;
        t.src = in[I_MD] + (size_t)le * 524288 + (size_t)(kb * 64) * 1024 + nb * 32; t.ldw = 1024;
        unsigned char* base = ws + WS_W_M2 + (size_t)layer * 16 * MiB;
        if (f8) { t.dst = (bf16*)(base + (size_t)e * 512 * KiB + (size_t)(nb * 32) * 512 + kb * 64); t.ldd = 512; t.f8scale = pg8::W2_SCALE; }
        else { t.dst = (bf16*)(base + (size_t)e * MiB) + (size_t)(nb * 32) * 512 + kb * 64; t.ldd = 512; t.f8scale = 0.0f; } }
    return t;
}
__device__ __forceinline__ TItem titem_decode(const float* const* in, unsigned char* ws, int r) {
    TItem t;
    if (r < TS0) { const int kb = r / 64, nb = r % 64; t.src = in[I_EWIN] + (size_t)(kb * 64) * 2048 + nb * 32; t.ldw = 2048; t.dst = (bf16*)(ws + WS_W_EIN) + (size_t)(nb * 32) * 1024 + kb * 64; t.ldd = 1024; t.f8scale = 0.0f; return t; } r -= TS0;
    if (r < TS1) { const int kb = r / 32, nb = r % 32; t.src = in[I_EWOUT] + (size_t)(kb * 64) * 1024 + nb * 32; t.ldw = 1024; t.dst = (bf16*)(ws + WS_W_EOUT) + (size_t)(nb * 32) * 1024 + kb * 64; t.ldd = 1024; t.f8scale = 0.0f; return t; } r -= TS1;
    if (r < TS2) { const int kb = r / 24, nb = 16 + r % 24; t.src = in[I_OWIN] + (size_t)(kb * 64) * 1280 + nb * 32; t.ldw = 1280; t.dst = (bf16*)(ws + WS_W_OIN) + (size_t)(nb * 32) * 1024 + kb * 64; t.ldd = 1024; t.f8scale = 0.0f; return t; } r -= TS2;
    if (r < TS3) { const int kb = r / 32, nb = r % 32; t.src = in[I_OWOUT] + (size_t)(kb * 64) * 1024 + nb * 32; t.ldw = 1024; t.dst = (bf16*)(ws + WS_W_OOUT) + (size_t)(nb * 32) * 1024 + kb * 64; t.ldd = 1024; t.f8scale = 0.0f; return t; } r -= TS3;
    if (r < TS5 + TS6 + TS7) return titem_moe(in, ws, r / 4096, (r % 4096) >> 8, r % 256);
    return t;
}
constexpr int NL1 = 12288;
__device__ __forceinline__ TItem titem_l1(const float* const* in, unsigned char* ws, int r) { return titem_moe(in, ws, r / 4096, 16 + ((r % 4096) >> 8), r % 256); }

constexpr size_t WS_CONVCTR = 20 * KiB;
__device__ __forceinline__ void convert_l1(Frame& F, int quota) {
    unsigned* ctr = (unsigned*)(F.ws + WS_CONVCTR);
    LAS float* scr = (LAS float*)(F.lds + F.wave * 17408);
    for (int ch = 0; ch < quota; ++ch) {
        const int c0 = __builtin_amdgcn_readfirstlane(F.lane == 0 ? (int)__hip_atomic_fetch_add(ctr, 4u, __ATOMIC_RELAXED, __HIP_MEMORY_SCOPE_AGENT) : 0);
        if (c0 >= NL1) break;
        f32x4 cur[8], nxt[8];
        TItem tc = titem_l1(F.in, F.ws, c0);
        titem_load(tc, nxt, F.lane);
#pragma unroll 1
        for (int i = 0; i < 4; ++i) {
#pragma unroll
            for (int j = 0; j < 8; ++j) cur[j] = nxt[j];
            const TItem tcur = tc;
            if (i < 3) { tc = titem_l1(F.in, F.ws, c0 + i + 1); titem_load(tc, nxt, F.lane); }
            titem_process(tcur, cur, scr, F.lane);
        }
    }
}
__device__ __forceinline__ void convert_l1_static(Frame& F) {
    LAS unsigned* ctr = (LAS unsigned*)(F.lds + LDS_CTL + 40);
    LAS float* scr = (LAS float*)(F.lds + F.wave * 17408);
    const int base = F.vcu * 48;
    f32x4 cur[8], nxt[8];
    int it = __builtin_amdgcn_readfirstlane(F.lane == 0 ? (int)atomicAdd((unsigned*)ctr, 1u) : 0);
    TItem tc = titem_l1(F.in, F.ws, base + (it < 48 ? it : 0));
    if (it < 48) titem_load(tc, nxt, F.lane);
    while (it < 48) {
#pragma unroll
        for (int i = 0; i < 8; ++i) cur[i] = nxt[i];
        const TItem tcur = tc;
        const int itn = __builtin_amdgcn_readfirstlane(F.lane == 0 ? (int)atomicAdd((unsigned*)ctr, 1u) : 0);
        if (itn < 48) { tc = titem_l1(F.in, F.ws, base + itn); titem_load(tc, nxt, F.lane); }
        titem_process(tcur, cur, scr, F.lane);
        it = itn;
    }
}
__device__ __forceinline__ void tail_fill(Frame& F, int nUnits, int quota) {
    const int rounds = (nUnits + F.G - 1) / F.G;
    if ((rounds - 1) * F.G + F.vcu >= nUnits) convert_l1(F, quota);
}

__device__ __forceinline__ void norm_mod_store(const f32x4 (&v)[4], const float* g, const float* shift, const float* scale, bf16* orow, int lane) {
    float s2 = 0.f;
#pragma unroll
    for (int j = 0; j < 4; ++j) s2 += (v[j].x * v[j].x + v[j].y * v[j].y) + (v[j].z * v[j].z + v[j].w * v[j].w);
    const float rstd = 1.0f / sqrtf(wave_sum(s2) * (1.0f / D) + EPS);
#pragma unroll
    for (int j = 0; j < 4; ++j) { const int c = 4 * lane + 256 * j;
        const f32x4 gg = *(const f32x4*)(g + c), sh = *(const f32x4*)(shift + c), sc = *(const f32x4*)(scale + c);
        const f32x4 y = v[j] * rstd * gg * (sc + 1.0f) + sh;
        u32x2 o; o.x = pk2(y.x, y.y); o.y = pk2(y.z, y.w);
        *(u32x2*)(orow + c) = o; }
}

template <int NQ> __device__ __forceinline__ void p1_tokens(Frame& F, int t) {
    const float* mods = (const float*)(F.ws + WS_MODS);
    bf16* A = (bf16*)(F.ws + WS_BUFA);
    f32x4 v[NQ][4];
#pragma unroll
    for (int q = 0; q < NQ; ++q) { const int tq = t + q; const float* xr = tq < TL ? F.in[I_X] + (size_t)tq * D : F.in[I_CTX] + (size_t)(tq - TL) * D;
#pragma unroll
        for (int j = 0; j < 4; ++j) v[q][j] = __builtin_nontemporal_load((const f32x4*)(xr + 4 * F.lane + 256 * j)); }
    const float* m = mods + (size_t)mod_row(t) * 6144;
#pragma unroll
    for (int q = 0; q < NQ; ++q) norm_mod_store(v[q], F.in[I_NMG], m, m + 1024, A + (size_t)(t + q) * D, F.lane);
}
__device__ __forceinline__ void phase_mods(Frame& F) {
    const float* const* in = F.in;
    LAS float* S = (LAS float*)F.lds;
    LAS float* red = S + 9 * 1024;
    for (int i = F.tid; i < 9 * 1024; i += 512) { const float v = (i < 8192) ? in[I_C][i] : in[I_CCTX][i - 8192]; S[i] = v / (1.0f + expf(-v)); }
    __syncthreads();
    const int bx = blockIdx.x, layer = bx >> 7, col0 = (bx & 127) * 48;
    const int j = F.tid % 12, rg = F.tid / 12;
    if (rg < 42) {
        const float* W = in[I_ADAW] + (size_t)layer * 1024 * 6144 + col0 + 4 * j;
        f32x4 w[25];
#pragma unroll
        for (int i = 0; i < 25; ++i) { const int k = rg + 42 * i; w[i] = (k < 1024) ? __builtin_nontemporal_load((const f32x4*)(W + (size_t)k * 6144)) : (f32x4){0.f, 0.f, 0.f, 0.f}; }
        f32x4 acc[9];
#pragma unroll
        for (int r = 0; r < 9; ++r) acc[r] = (f32x4){0.f, 0.f, 0.f, 0.f};
#pragma unroll
        for (int i = 0; i < 25; ++i) { const int k = min(rg + 42 * i, 1023);
#pragma unroll
            for (int r = 0; r < 9; ++r) acc[r] += w[i] * S[r * 1024 + k]; }
#pragma unroll
        for (int r = 0; r < 9; ++r) *(LAS f32x4*)(red + (rg * 9 + r) * 48 + 4 * j) = acc[r];
    }
    __syncthreads();
    for (int i = F.tid; i < 432; i += 512) { const int r = i / 48, c = i % 48; float sum = in[I_ADAB][layer * 6144 + col0 + c];
        for (int g = 0; g < 42; ++g) sum += red[(g * 9 + r) * 48 + c];
        __hip_atomic_store((unsigned*)(F.ws + WS_MODS) + (layer * 9 + r) * 6144 + col0 + c, __builtin_bit_cast(unsigned, sum), __ATOMIC_RELAXED, __HIP_MEMORY_SCOPE_AGENT); }
    asm volatile("s_waitcnt vmcnt(0)" ::: "memory");
    __syncthreads();
    if (F.tid == 0) __hip_atomic_fetch_add((unsigned*)(F.ws + WS_MODSDONE), 1u, __ATOMIC_RELAXED, __HIP_MEMORY_SCOPE_AGENT);
}
__device__ __forceinline__ void mods_wait(Frame& F) {
    if (F.tid < 64) {
        unsigned* cnt = (unsigned*)(F.ws + WS_MODSDONE); unsigned spins = 0;
        while ((unsigned)__builtin_amdgcn_readfirstlane(__hip_atomic_load(cnt, __ATOMIC_RELAXED, __HIP_MEMORY_SCOPE_AGENT)) < (unsigned)F.G) {
            __builtin_amdgcn_s_sleep(2); if (++spins > (1u << 22)) break; }
        __builtin_amdgcn_fence(__ATOMIC_ACQUIRE, "agent");
        asm volatile("s_waitcnt vmcnt(0)" ::: "memory");
    }
    __syncthreads();
}

__device__ __forceinline__ void ctr_publish(Frame& F, size_t off) {
    asm volatile("s_waitcnt vmcnt(0)" ::: "memory");
    __syncthreads();
    if (F.tid == 0) { __builtin_amdgcn_fence(__ATOMIC_RELEASE, "agent"); asm volatile("s_waitcnt vmcnt(0)" ::: "memory");
        __hip_atomic_fetch_add((unsigned*)(F.ws + off), 1u, __ATOMIC_RELAXED, __HIP_MEMORY_SCOPE_AGENT); }
}
__device__ __forceinline__ void ctr_wait(Frame& F, size_t off, unsigned need) {
    if (F.tid < 64) {
        unsigned* cnt = (unsigned*)(F.ws + off); unsigned spins = 0;
        while ((unsigned)__builtin_amdgcn_readfirstlane(__hip_atomic_load(cnt, __ATOMIC_RELAXED, __HIP_MEMORY_SCOPE_AGENT)) < need) {
            __builtin_amdgcn_s_sleep(2); if (++spins > (1u << 22)) break; }
        __builtin_amdgcn_fence(__ATOMIC_ACQUIRE, "agent");
        asm volatile("s_waitcnt vmcnt(0)" ::: "memory");
    }
    __syncthreads();
}

__device__ __forceinline__ void phase_prologue_a(Frame& F) {
    const float* const* in = F.in;
    unsigned char* ws = F.ws;
    LAS float* ldsf = (LAS float*)F.lds;
    phase_mods(F);
    __syncthreads();
    {
        const int gt = blockIdx.x * 512 + F.tid, NT = F.G * 512;
        float* rope = (float*)(ws + WS_ROPE);
        for (int i = gt; i < 1024; i += NT) { const int coord = i >> 4, q = i & 15; const float inv = powf(10000.0f, -(float)q / 16.0f); const float ang = (float)coord * inv;
            rope[i] = cosf(ang); rope[1024 + i] = sinf(ang); }
        bf16* WA = (bf16*)(ws + WS_WA);
        for (int i = gt; i < 128 * 128; i += NT) { const int m = i >> 7, k = i & 127, rp = m >> 6, j1 = m & 63, ri = k >> 6, n1 = k & 63;
            const float a = 2.0f * (float)((j1 * n1) & 63) / 64.0f; const float c = cospif(a), s = sinpif(a);
            const float v = (rp == 0) ? (ri == 0 ? c : s) : (ri == 0 ? -s : c); WA[i] = (bf16)f2bf(v); }
        bf16* WAC = (bf16*)(ws + WS_WAC);
        for (int i = gt; i < 32 * 32; i += NT) { const int m = i >> 5, k = i & 31, rp = m >> 4, j1 = m & 15, ri = k >> 4, n1 = k & 15;
            const float a = 2.0f * (float)((j1 * n1) & 15) / 16.0f; const float c = cospif(a), s = sinpif(a);
            const float v = (rp == 0) ? (ri == 0 ? c : s) : (ri == 0 ? -s : c); WAC[i] = (bf16)f2bf(v); }
        bf16* WC = (bf16*)(ws + WS_WC);
        for (int i = gt; i < 64 * 64 * 128; i += NT) { const int j1 = i >> 13, j2 = (i >> 7) & 63, k = i & 127, ri = k >> 6, n2 = k & 63;
            const float a = 2.0f * (float)((n2 * (j1 + 64 * j2)) & 4095) / 4096.0f; const float v = (ri == 0 ? cospif(a) : sinpif(a)) * (1.0f / 64.0f); WC[i] = (bf16)f2bf(v); }
        bf16* FD = (bf16*)(ws + WS_FD);
        for (int i = gt; i < 256 * 128; i += NT) { const int col = i >> 7, c = i & 127, ri = col >> 7, k2 = col & 127;
            const float a = 2.0f * (float)((c * k2) & 127) / 128.0f; const float v = (ri == 0 ? cospif(a) : -sinpif(a)) * 0.08838834764831845f; FD[i] = (bf16)f2bf(v); }
        bf16* WCC = (bf16*)(ws + WS_WCC);
        for (int i = gt; i < 16 * 16 * 32; i += NT) { const int j1 = i >> 9, j2 = (i >> 5) & 15, k = i & 31, ri = k >> 4, n2 = k & 15;
            const float a = 2.0f * (float)((n2 * (j1 + 16 * j2)) & 255) / 256.0f; const float v = (ri == 0 ? cospif(a) : sinpif(a)) * (1.0f / 16.0f); WCC[i] = (bf16)f2bf(v); }
    }
    LAS float* tw = (LAS float*)(F.lds + 139264);
    if (F.tid < 128) { const float a = 2.0f * (float)F.tid / 128.0f; tw[F.tid] = cospif(a); tw[128 + F.tid] = sinpif(a); }
    __syncthreads();
    LAS float* scr = (LAS float*)(F.lds + F.wave * 17408);
    const int gw = F.vcu * NWAVES + F.wave, NGW = F.G * NWAVES;
    const int fid = F.vcu * 2 + F.wave;
    if (F.wave < 2) { const int r = fid;
        const int g = r >> 7, db = (r >> 5) & 3, kb = r & 31, k0 = kb * 32, d0 = db * 32;
        const float* Wp = in[I_OWIN] + (size_t)k0 * 1280 + g * 128;
        { float tl[32][2];
#pragma unroll
          for (int rr = 0; rr < 32; ++rr) { tl[rr][0] = Wp[(size_t)rr * 1280 + F.lane]; tl[rr][1] = Wp[(size_t)rr * 1280 + 64 + F.lane]; }
#pragma unroll
          for (int rr = 0; rr < 32; ++rr) { scr[rr * 129 + F.lane] = tl[rr][0]; scr[rr * 129 + 64 + F.lane] = tl[rr][1]; } }
        LDS_WAIT(); asm volatile("" ::: "memory");
        const int k = F.lane & 31, oh = F.lane >> 5;
        const float* pw = in[I_OPOOLW] + (size_t)g * 16384 + d0 + 16 * oh;
        float acc[16];
#pragma unroll
        for (int t = 0; t < 16; ++t) acc[t] = 0.f;
        for (int c0 = 0; c0 < 128; c0 += 8) {
            f32x4 p[8][4];
#pragma unroll
            for (int cc = 0; cc < 8; ++cc)
#pragma unroll
                for (int j = 0; j < 4; ++j) p[cc][j] = *(const f32x4*)(pw + (c0 + cc) * 128 + 4 * j);
#pragma unroll
            for (int cc = 0; cc < 8; ++cc) { const float w = scr[k * 129 + c0 + cc];
#pragma unroll
                for (int j = 0; j < 4; ++j) { acc[4 * j] += w * p[cc][j].x; acc[4 * j + 1] += w * p[cc][j].y; acc[4 * j + 2] += w * p[cc][j].z; acc[4 * j + 3] += w * p[cc][j].w; } }
        }
        const float* psc = in[I_OPOOLS] + g * 128 + d0 + 16 * oh;
        bf16* dst = (bf16*)(ws + WS_W_OIN) + (size_t)(g * 128 + d0 + 16 * oh) * 1024 + k0 + k;
#pragma unroll
        for (int t = 0; t < 16; ++t) dst[(size_t)t * 1024] = (bf16)f2bf(acc[t] * psc[t]);
        LDS_WAIT(); asm volatile("" ::: "memory");
    }
    {
        LAS unsigned* ctr = (LAS unsigned*)(F.lds + LDS_CTL + 32);
        constexpr int PER = (TNITEMS + 255) / 256;
        const int base = F.vcu * PER, lim = min(PER, TNITEMS - base);
        f32x4 cur[8], nxt[8];
        int it = __builtin_amdgcn_readfirstlane(F.lane == 0 ? (int)atomicAdd((unsigned*)ctr, 1u) : 0);
        TItem tc = titem_decode(in, ws, base + (it < lim ? it : 0));
        if (it < lim) titem_load(tc, nxt, F.lane);
        while (it < lim) {
#pragma unroll
            for (int i = 0; i < 8; ++i) cur[i] = nxt[i];
            const TItem tcur = tc;
            const int itn = __builtin_amdgcn_readfirstlane(F.lane == 0 ? (int)atomicAdd((unsigned*)ctr, 1u) : 0);
            if (itn < lim) { tc = titem_decode(in, ws, base + itn); titem_load(tc, nxt, F.lane); }
            titem_process(tcur, cur, scr, F.lane);
            it = itn;
        }
    }
    mods_wait(F);
    {
        LAS unsigned* ctr2 = (LAS unsigned*)(F.lds + LDS_CTL + 36);
        for (;;) {
            const int it = __builtin_amdgcn_readfirstlane(F.lane == 0 ? (int)atomicAdd((unsigned*)ctr2, 1u) : 0);
            if (it >= 40) break;
            if (it < 32) p1_tokens<4>(F, 4 * (32 * (int)blockIdx.x + it)); else p1_tokens<1>(F, TL + 8 * (int)blockIdx.x + (it - 32));
        }
    }
}

struct DftP { const bf16* dbase; size_t dstride; const bf16* W; bf16* obase; size_t ostride; };
template <int MODE> __device__ __forceinline__ DftP dft_params(const Frame& F, int u) {
    const bf16* P = (const bf16*)(F.ws + WS_BUFP); bf16* Z = (bf16*)(F.ws + WS_BUFZ); bf16* MIX = (bf16*)(F.ws + WS_BUFA);
    DftP p;
    if constexpr (MODE == 0) { const int chunk = u & 3, n2 = (u >> 2) & 63, b = u >> 8;
        p.dbase = P + (size_t)(b * 4096 + n2) * EIN + chunk * 128; p.dstride = (size_t)64 * EIN; p.W = (const bf16*)(F.ws + WS_WA);
        p.obase = Z + (size_t)((b * 64) * 64 + n2) * 1024 + chunk * 128; p.ostride = (size_t)64 * 1024; }
    if constexpr (MODE == 1) { const int chunk = u & 3, n2 = (u >> 2) & 15, b = u >> 6;
        p.dbase = P + (size_t)(TL + b * 256 + n2) * EIN + chunk * 128; p.dstride = (size_t)16 * EIN; p.W = (const bf16*)(F.ws + WS_WAC);
        p.obase = Z + (size_t)(TL + (b * 16) * 16 + n2) * 1024 + chunk * 128; p.ostride = (size_t)16 * 1024; }
    if constexpr (MODE == 2) { const int chunk = u & 3, j1 = (u >> 2) & 63, b = u >> 8;
        p.dbase = Z + (size_t)((b * 64 + j1) * 64) * 1024 + chunk * 128; p.dstride = (size_t)1024; p.W = (const bf16*)(F.ws + WS_WC) + (size_t)j1 * 64 * 128;
        p.obase = MIX + (size_t)(b * 4096 + j1) * D + chunk * 128; p.ostride = (size_t)64 * D; }
    if constexpr (MODE == 3) { const int chunk = u & 3, j1 = (u >> 2) & 15, b = u >> 6;
        p.dbase = Z + (size_t)(TL + (b * 16 + j1) * 16) * 1024 + chunk * 128; p.dstride = (size_t)1024; p.W = (const bf16*)(F.ws + WS_WCC) + (size_t)j1 * 16 * 32;
        p.obase = MIX + (size_t)(TL + b * 256 + j1) * D + chunk * 128; p.ostride = (size_t)16 * D; }
    return p;
}
template <int MODE, int KD, int MD, int J>
__device__ __forceinline__ void dft_units(Frame& F, int nunits) {
    constexpr int LD = KD + 8;
    constexpr int NP = (KD * 16 + 511) / 512;
    constexpr int GM = KD / 8 - 1;
    LAS bf16* DT = (LAS bf16*)F.lds;
    u32x4 pre[NP];
    int u = F.vcu;
    if (u < nunits) { const DftP p = dft_params<MODE>(F, u);
#pragma unroll
        for (int i = 0; i < NP; ++i) { const int pc = F.tid + 512 * i; if (pc < KD * 16) { const int k = pc >> 4, c8 = pc & 15, ri = k / (KD / 2), nn = k % (KD / 2);
            pre[i] = __builtin_nontemporal_load((const u32x4*)(p.dbase + (size_t)nn * p.dstride + ri * 512 + c8 * 8)); } } }
    const int a = F.lane & 15, q = F.lane >> 4;
    for (; u < nunits; u += F.G) {
        const DftP p = dft_params<MODE>(F, u);
#pragma unroll
        for (int i = 0; i < NP; ++i) { const int pc = F.tid + 512 * i; if (pc < KD * 16) { const int k = pc >> 4, c8 = pc & 15; const u32x4 v = pre[i];
            LAS bf16* d = DT + (c8 * 8) * LD + (k ^ ((c8 & GM) << 3));
            d[0 * LD] = (bf16)(v.x & 0xffff); d[1 * LD] = (bf16)(v.x >> 16); d[2 * LD] = (bf16)(v.y & 0xffff); d[3 * LD] = (bf16)(v.y >> 16);
            d[4 * LD] = (bf16)(v.z & 0xffff); d[5 * LD] = (bf16)(v.z >> 16); d[6 * LD] = (bf16)(v.w & 0xffff); d[7 * LD] = (bf16)(v.w >> 16); } }
        __syncthreads();
        if (u + F.G < nunits) { const DftP pn = dft_params<MODE>(F, u + F.G);
#pragma unroll
            for (int i = 0; i < NP; ++i) { const int pc = F.tid + 512 * i; if (pc < KD * 16) { const int k = pc >> 4, c8 = pc & 15, ri = k / (KD / 2), nn = k % (KD / 2);
                pre[i] = __builtin_nontemporal_load((const u32x4*)(pn.dbase + (size_t)nn * pn.dstride + ri * 512 + c8 * 8)); } } }
        for (int task = F.wave; task < (MD / 16) * 2; task += NWAVES) {
            const int mt = task >> 1, cht = task & 1;
            f32x4 acc[4];
#pragma unroll
            for (int ct = 0; ct < 4; ++ct) acc[ct] = (f32x4){0.f, 0.f, 0.f, 0.f};
#pragma unroll
            for (int ks = 0; ks < KD / 32; ++ks) {
                const bf16x8 bw = *(const bf16x8*)(p.W + (size_t)(mt * 16 + a) * KD + ks * 32 + 8 * q);
#pragma unroll
                for (int ct = 0; ct < 4; ++ct) {
                    const int ch = cht * 64 + 16 * (a >> 2) + 4 * ct + (a & 3);
                    const bf16x8 av = *(const LAS bf16x8*)(DT + ch * LD + ((ks * 32 + 8 * q) ^ (((ch >> 3) & GM) << 3)));
                    acc[ct] = __builtin_amdgcn_mfma_f32_16x16x32_bf16(av, bw, acc[ct], 0, 0, 0);
                }
            }
            const int m = mt * 16 + a, rm = m / J, j = m % J;
            bf16* o = p.obase + (size_t)j * p.ostride + rm * 512 + cht * 64 + 16 * q;
            u32x4 w0, w1;
            w0.x = pk2(acc[0][0], acc[0][1]); w0.y = pk2(acc[0][2], acc[0][3]); w0.z = pk2(acc[1][0], acc[1][1]); w0.w = pk2(acc[1][2], acc[1][3]);
            w1.x = pk2(acc[2][0], acc[2][1]); w1.y = pk2(acc[2][2], acc[2][3]); w1.z = pk2(acc[3][0], acc[3][1]); w1.w = pk2(acc[3][2], acc[3][3]);
            *(u32x4*)o = w0; *(u32x4*)(o + 8) = w1;
        }
        __syncthreads();
    }
}

template <int MODE, int NR>
__device__ __forceinline__ void dft_units_a(Frame& F, int nunits) {
    constexpr int KD = 2 * NR, MD = 2 * NR, J = NR, LD = KD + 8, GM = KD / 8 - 1, ULD = 136;
    constexpr int NP = (NR * 16 + 511) / 512;
    LAS bf16* FDl = (LAS bf16*)F.lds; LAS bf16* U = (LAS bf16*)(F.lds + 69632); LAS bf16* DT = (LAS bf16*)(F.lds + 69632 + 64 * ULD * 2);
    { const bf16* FD = (const bf16*)(F.ws + WS_FD);
      for (int p = F.tid; p < 256 * 16; p += 512) { const int r = p >> 4, c8 = p & 15; *(LAS u32x4*)(FDl + r * ULD + 8 * c8) = *(const u32x4*)(FD + r * 128 + 8 * c8); } }
    u32x4 pre[NP];
    int u = F.vcu;
    if (u < nunits) { const DftP p = dft_params<MODE>(F, u);
#pragma unroll
        for (int i = 0; i < NP; ++i) { const int pc = F.tid + 512 * i; if (pc < NR * 16) pre[i] = __builtin_nontemporal_load((const u32x4*)(p.dbase + (size_t)(pc >> 4) * p.dstride + (pc & 15) * 8)); } }
    const int a = F.lane & 15, q = F.lane >> 4;
    for (; u < nunits; u += F.G) {
        const DftP p = dft_params<MODE>(F, u);
#pragma unroll
        for (int i = 0; i < NP; ++i) { const int pc = F.tid + 512 * i; if (pc < NR * 16) *(LAS u32x4*)(U + (pc >> 4) * ULD + (pc & 15) * 8) = pre[i]; }
        __syncthreads();
        if (u + F.G < nunits) { const DftP pn = dft_params<MODE>(F, u + F.G);
#pragma unroll
            for (int i = 0; i < NP; ++i) { const int pc = F.tid + 512 * i; if (pc < NR * 16) pre[i] = __builtin_nontemporal_load((const u32x4*)(pn.dbase + (size_t)(pc >> 4) * pn.dstride + (pc & 15) * 8)); } }
        {
            f32x4 acc[NR / 16][2];
#pragma unroll
            for (int mt = 0; mt < NR / 16; ++mt) { acc[mt][0] = (f32x4){0.f, 0.f, 0.f, 0.f}; acc[mt][1] = (f32x4){0.f, 0.f, 0.f, 0.f}; }
#pragma unroll
            for (int ks = 0; ks < 4; ++ks) {
                const bf16x8 b0 = *(const LAS bf16x8*)(FDl + ((2 * F.wave) * 16 + a) * ULD + ks * 32 + 8 * q), b1 = *(const LAS bf16x8*)(FDl + ((2 * F.wave + 1) * 16 + a) * ULD + ks * 32 + 8 * q);
#pragma unroll
                for (int mt = 0; mt < NR / 16; ++mt) { const bf16x8 av = *(const LAS bf16x8*)(U + (mt * 16 + a) * ULD + ks * 32 + 8 * q);
                    acc[mt][0] = __builtin_amdgcn_mfma_f32_16x16x32_bf16(av, b0, acc[mt][0], 0, 0, 0); acc[mt][1] = __builtin_amdgcn_mfma_f32_16x16x32_bf16(av, b1, acc[mt][1], 0, 0, 0); }
            }
#pragma unroll
            for (int t = 0; t < 2; ++t) { const int col = (2 * F.wave + t) * 16 + a, ri = col >> 7, k2 = col & 127;
#pragma unroll
                for (int mt = 0; mt < NR / 16; ++mt) { const int k0 = ri * NR + 16 * mt + 4 * q;
                    u32x2 w; w.x = pk2(acc[mt][t][0], acc[mt][t][1]); w.y = pk2(acc[mt][t][2], acc[mt][t][3]);
                    *(LAS u32x2*)(DT + k2 * LD + (k0 ^ (((k2 >> 3) & GM) << 3))) = w; } }
        }
        __syncthreads();
        for (int task = F.wave; task < (MD / 16) * 2; task += NWAVES) {
            const int mt = task >> 1, cht = task & 1;
            f32x4 acc[4];
#pragma unroll
            for (int ct = 0; ct < 4; ++ct) acc[ct] = (f32x4){0.f, 0.f, 0.f, 0.f};
#pragma unroll
            for (int ks = 0; ks < KD / 32; ++ks) {
                const bf16x8 bw = *(const bf16x8*)(p.W + (size_t)(mt * 16 + a) * KD + ks * 32 + 8 * q);
#pragma unroll
                for (int ct = 0; ct < 4; ++ct) {
                    const int ch = cht * 64 + 16 * (a >> 2) + 4 * ct + (a & 3);
                    const bf16x8 av = *(const LAS bf16x8*)(DT + ch * LD + ((ks * 32 + 8 * q) ^ (((ch >> 3) & GM) << 3)));
                    acc[ct] = __builtin_amdgcn_mfma_f32_16x16x32_bf16(av, bw, acc[ct], 0, 0, 0);
                }
            }
            const int m = mt * 16 + a, rm = m / J, j = m % J;
            bf16* o = p.obase + (size_t)j * p.ostride + rm * 512 + cht * 64 + 16 * q;
            u32x4 w0, w1;
            w0.x = pk2(acc[0][0], acc[0][1]); w0.y = pk2(acc[0][2], acc[0][3]); w0.z = pk2(acc[1][0], acc[1][1]); w0.w = pk2(acc[1][2], acc[1][3]);
            w1.x = pk2(acc[2][0], acc[2][1]); w1.y = pk2(acc[2][2], acc[2][3]); w1.z = pk2(acc[3][0], acc[3][1]); w1.w = pk2(acc[3][2], acc[3][3]);
            *(u32x4*)o = w0; *(u32x4*)(o + 8) = w1;
        }
        __syncthreads();
    }
}

__device__ __forceinline__ void phase_fourier_a_conv(Frame& F) {
    const bf16* P = (const bf16*)(F.ws + WS_BUFP);
    dft_units_a<0, 64>(F, 2048);
    __syncthreads();
    dft_units_a<1, 16>(F, 512);
    bf16* MIX = (bf16*)(F.ws + WS_BUFA);
    const float* cw = F.in[I_ECONV];
    float w0[8], w1[8], w2[8];
#pragma unroll
    for (int i = 0; i < 8; ++i) { w0[i] = cw[8 * F.lane + i]; w1[i] = cw[512 + 8 * F.lane + i]; w2[i] = cw[1024 + 8 * F.lane + i]; }
    const int gw = F.vcu * NWAVES + F.wave, NGW = F.G * NWAVES;
    auto conv_tokens = [&](int t, auto ntc) {
        constexpr int NT = decltype(ntc)::value;
        int pos, len; if (t < TL) { pos = t & 4095; len = 4096; } else { pos = (t - TL) & 255; len = 256; }
        const bf16* row = P + (size_t)t * EIN + 8 * F.lane;
        u32x4 gb[NT], gc[NT + 2], uc[NT + 2];
#pragma unroll
        for (int d = 0; d < NT + 2; ++d) { const int pp = pos + d - 1;
            if (pp >= 0 && pp < len) { gc[d] = *(const u32x4*)(row + (ptrdiff_t)(d - 1) * EIN + 1024); uc[d] = *(const u32x4*)(row + (ptrdiff_t)(d - 1) * EIN + 1536); }
            else { gc[d] = (u32x4){0u, 0u, 0u, 0u}; uc[d] = (u32x4){0u, 0u, 0u, 0u}; } }
#pragma unroll
        for (int q = 0; q < NT; ++q) gb[q] = __builtin_nontemporal_load((const u32x4*)(row + (size_t)q * EIN + 512));
        float pl[NT + 2][8];
#pragma unroll
        for (int d = 0; d < NT + 2; ++d)
#pragma unroll
            for (int i = 0; i < 4; ++i) { pl[d][2 * i] = bflo(gc[d][i]) * bflo(uc[d][i]); pl[d][2 * i + 1] = bfhi(gc[d][i]) * bfhi(uc[d][i]); }
#pragma unroll
        for (int q = 0; q < NT; ++q) {
            float y[8];
#pragma unroll
            for (int i = 0; i < 4; ++i) {
                y[2 * i] = bflo(gb[q][i]) * (w0[2 * i] * pl[q][2 * i] + w1[2 * i] * pl[q + 1][2 * i] + w2[2 * i] * pl[q + 2][2 * i]);
                y[2 * i + 1] = bfhi(gb[q][i]) * (w0[2 * i + 1] * pl[q][2 * i + 1] + w1[2 * i + 1] * pl[q + 1][2 * i + 1] + w2[2 * i + 1] * pl[q + 2][2 * i + 1]);
            }
            u32x4 o; o.x = pk2(y[0], y[1]); o.y = pk2(y[2], y[3]); o.z = pk2(y[4], y[5]); o.w = pk2(y[6], y[7]);
            *(u32x4*)(MIX + (size_t)(t + q) * D + 512 + 8 * F.lane) = o;
        }
    };
    for (int t = 4 * gw; t < TL; t += 4 * NGW) conv_tokens(t, std::integral_constant<int, 4>{});
    for (int t = TL + gw; t < T; t += NGW) conv_tokens(t, std::integral_constant<int, 1>{});
}

__device__ __forceinline__ void phase_fourier_c(Frame& F) {
    dft_units<2, 128, 64, 64>(F, 2048);
    dft_units<3, 32, 16, 16>(F, 512);
}

constexpr int RW_LD = 1032;
template <bool SPLIT>
__device__ __forceinline__ void phase_route(Frame& F, int layer, int ntok) {
    LAS bf16* rwh = (LAS bf16*)F.lds;
    LAS bf16* rwl = (LAS bf16*)(F.lds + 33024);
    LAS unsigned* cnt = (LAS unsigned*)(F.lds + 66048);
    LAS int* gb = (LAS int*)(F.lds + 66048 + 128);
    LAS float* lgs = (LAS float*)(F.lds + 66048 + 256) + F.wave * 256;
    LAS int* tinfo = (LAS int*)(F.lds + 66048 + 256 + 8192);
    LAS float* GS = (LAS float*)(F.lds + 81920);
    LAS float* SH = GS + 2048;
    const float* RW = F.in[I_RW];
    int tA, nA, tB, nB;
    if constexpr (SPLIT) {
        const int xs = F.vcu >> 5, rs = F.vcu & 31;
        if (rs >= 28) return;
        const int j = 28 * xs + rs;
        tA = 128 * j; nA = 128; tB = 28672 + 32 * j; nB = (j < 192) ? 32 : 0;
    } else { const int per_ = ntok / F.G; tA = blockIdx.x * per_; nA = per_; tB = 0; nB = 0; }
    const int r0 = mod_row(tA), mr1 = SPLIT ? mod_row(tB) : min(r0 + 1, 8);
    const float* mods = (const float*)(F.ws + WS_MODS) + (size_t)layer * 9 * 6144;
    const float* g = F.in[I_NFG] + layer * 1024;
    for (int i = F.tid; i < 16384; i += 512) { const int k = i >> 4, e = i & 15; const float w = RW[i]; const unsigned hi = f2bf(w); const float wl = w - __builtin_bit_cast(float, hi << 16);
        rwh[e * RW_LD + k] = (bf16)hi; rwl[e * RW_LD + k] = (bf16)f2bf(wl); }
    for (int i = F.tid; i < 2048; i += 512) { const int sl = i >> 10, c = i & 1023; const int rr = sl ? mr1 : r0; const float* m = mods + (size_t)rr * 6144;
        GS[i] = g[c] * (m[4 * 1024 + c] + 1.0f); SH[i] = m[3 * 1024 + c]; }
    if (F.tid < 16) cnt[F.tid] = 0u;
    __syncthreads();
    bf16* FB = (bf16*)(F.ws + WS_BUFA);
    const bool f8 = layer ? (FP8_G1_L1 != 0) : (FP8_G1_L0 != 0);
    int* route = (int*)(F.ws + WS_ROUTE);
    const int tk = F.lane & 15, kg = F.lane >> 4;
    for (int st = 0; st < 2; ++st) {
    const int t0 = st ? tB : tA, per = st ? nB : nA, li0 = st ? nA : 0;
    if (per == 0) break;
    if constexpr (SPLIT) { if (st == 0) ctr_wait(F, WS_P5F, 224u); else ctr_wait(F, WS_P5C, 32u); }
    for (int g0 = 16 * F.wave; g0 < per; g0 += 16 * NWAVES) {
        const int nv = min(16, per - g0);
        const int tq = t0 + g0 + (tk < nv ? tk : 0);
        const bf16* hr = h_row(F, tq) + 8 * kg;
        float s2 = 0.f;
        {
            u32x4 raw[32];
#pragma unroll
            for (int ks = 0; ks < 32; ++ks) raw[ks] = *(const u32x4*)(hr + 32 * ks);
#pragma unroll
            for (int ks = 0; ks < 32; ++ks)
#pragma unroll
                for (int i = 0; i < 4; ++i) { const float a = bflo(raw[ks][i]), b2 = bfhi(raw[ks][i]); s2 += a * a + b2 * b2; }
        }
        s2 += __shfl_xor(s2, 16); s2 += __shfl_xor(s2, 32);
        const float rstd = 1.0f / sqrtf(s2 * (1.0f / D) + EPS);
        const int sl = (mod_row(tq) != r0) ? 1024 : 0;
        const LAS float* gsp = GS + sl + 8 * kg; const LAS float* shp = SH + sl + 8 * kg;
        unsigned char* fb8 = (unsigned char*)FB + (size_t)tq * D + 8 * kg;
        bf16* fb16 = FB + (size_t)tq * D + 8 * kg;
        f32x4 acc = (f32x4){0.f, 0.f, 0.f, 0.f};
        u32x4 nx[8];
#pragma unroll
        for (int j = 0; j < 8; ++j) nx[j] = *(const u32x4*)(hr + 32 * j);
#pragma unroll 1
        for (int k4 = 0; k4 < 4; ++k4) {
            u32x4 cu[8];
#pragma unroll
            for (int j = 0; j < 8; ++j) cu[j] = nx[j];
            if (k4 < 3) {
#pragma unroll
                for (int j = 0; j < 8; ++j) nx[j] = *(const u32x4*)(hr + 32 * (8 * k4 + 8 + j)); }
#pragma unroll
            for (int j = 0; j < 8; ++j) {
                const int ks = 8 * k4 + j;
                const f32x4 g0v = *(const LAS f32x4*)(gsp + 32 * ks), g1v = *(const LAS f32x4*)(gsp + 32 * ks + 4), s0v = *(const LAS f32x4*)(shp + 32 * ks), s1v = *(const LAS f32x4*)(shp + 32 * ks + 4);
                float f[8];
                f[0] = bflo(cu[j].x) * rstd * g0v.x + s0v.x; f[1] = bfhi(cu[j].x) * rstd * g0v.y + s0v.y; f[2] = bflo(cu[j].y) * rstd * g0v.z + s0v.z; f[3] = bfhi(cu[j].y) * rstd * g0v.w + s0v.w;
                f[4] = bflo(cu[j].z) * rstd * g1v.x + s1v.x; f[5] = bfhi(cu[j].z) * rstd * g1v.y + s1v.y; f[6] = bflo(cu[j].w) * rstd * g1v.z + s1v.z; f[7] = bfhi(cu[j].w) * rstd * g1v.w + s1v.w;
                u32x4 hi, lo;
#pragma unroll
                for (int i = 0; i < 4; ++i) { const unsigned h0 = f2bf(f[2 * i]), h1 = f2bf(f[2 * i + 1]); hi[i] = h0 | (h1 << 16);
                    lo[i] = pk2(f[2 * i] - __builtin_bit_cast(float, h0 << 16), f[2 * i + 1] - __builtin_bit_cast(float, h1 << 16)); }
                if (tk < nv) {
                    if (f8) { u32x2 o; o.x = pg8::pk4_fp8(f[0], f[1], f[2], f[3]); o.y = pg8::pk4_fp8(f[4], f[5], f[6], f[7]); *(u32x2*)(fb8 + 32 * ks) = o; }
                    else *(u32x4*)(fb16 + 32 * ks) = hi;
                }
                const bf16x8 bh = *(const LAS bf16x8*)(rwh + tk * RW_LD + 32 * ks + 8 * kg), bl = *(const LAS bf16x8*)(rwl + tk * RW_LD + 32 * ks + 8 * kg);
                const bf16x8 ah = __builtin_bit_cast(bf16x8, hi), al = __builtin_bit_cast(bf16x8, lo);
                acc = __builtin_amdgcn_mfma_f32_16x16x32_bf16(ah, bh, acc, 0, 0, 0);
                acc = __builtin_amdgcn_mfma_f32_16x16x32_bf16(ah, bl, acc, 0, 0, 0);
                acc = __builtin_amdgcn_mfma_f32_16x16x32_bf16(al, bh, acc, 0, 0, 0);
            }
        }
#pragma unroll
        for (int j = 0; j < 4; ++j) lgs[(4 * kg + j) * 16 + tk] = acc[j];
        LDS_WAIT(); asm volatile("" ::: "memory");
        if (F.lane < nv) {
            const int tqq = t0 + g0 + F.lane;
            float aff[16], sel[16];
#pragma unroll
            for (int e4 = 0; e4 < 4; ++e4) { const f32x4 l4 = *(const LAS f32x4*)(lgs + F.lane * 16 + 4 * e4); const f32x4 b4 = *(const f32x4*)(F.in[I_RB] + 4 * e4);
                aff[4 * e4] = 1.0f / (1.0f + expf(-l4.x)); aff[4 * e4 + 1] = 1.0f / (1.0f + expf(-l4.y)); aff[4 * e4 + 2] = 1.0f / (1.0f + expf(-l4.z)); aff[4 * e4 + 3] = 1.0f / (1.0f + expf(-l4.w));
                sel[4 * e4] = aff[4 * e4] + b4.x; sel[4 * e4 + 1] = aff[4 * e4 + 1] + b4.y; sel[4 * e4 + 2] = aff[4 * e4 + 2] + b4.z; sel[4 * e4 + 3] = aff[4 * e4 + 3] + b4.w; }
            int best = 0; float bs = -1e30f;
#pragma unroll
            for (int gq = 0; gq < 4; ++gq) { const float a = sel[4 * gq], b = sel[4 * gq + 1], c = sel[4 * gq + 2], d = sel[4 * gq + 3];
                const float s = fmaxf(fmaxf(fmaxf(a + b, a + c), fmaxf(a + d, b + c)), fmaxf(b + d, c + d));
                if (s > bs) { bs = s; best = gq; } }
            float sv[4], av[4];
#pragma unroll
            for (int i = 0; i < 4; ++i) { sv[i] = sel[i]; av[i] = aff[i]; }
#pragma unroll
            for (int gq = 1; gq < 4; ++gq) if (best == gq) {
#pragma unroll
                for (int i = 0; i < 4; ++i) { sv[i] = sel[4 * gq + i]; av[i] = aff[4 * gq + i]; } }
            int i1 = 0; float s1 = sv[0], a1 = av[0];
#pragma unroll
            for (int i = 1; i < 4; ++i) if (sv[i] > s1) { s1 = sv[i]; a1 = av[i]; i1 = i; }
            int i2 = -1; float s2v = -1e30f, a2 = 0.f;
#pragma unroll
            for (int i = 0; i < 4; ++i) if (i != i1 && sv[i] > s2v) { s2v = sv[i]; a2 = av[i]; i2 = i; }
            const int e1 = 4 * best + i1, e2 = 4 * best + i2;
            const float wsum = a1 + a2, w1 = a1 / wsum, w2 = a2 / wsum;
            const unsigned r1 = atomicAdd((unsigned*)(cnt + e1), 1u), r2 = atomicAdd((unsigned*)(cnt + e2), 1u);
            int* ro = route + (size_t)tqq * 8;
            ro[0] = e1; ro[1] = e2; ro[4] = __builtin_bit_cast(int, w1); ro[5] = __builtin_bit_cast(int, w2);
            const int li = li0 + g0 + F.lane;
            tinfo[4 * li + 0] = e1; tinfo[4 * li + 1] = e2; tinfo[4 * li + 2] = (int)r1; tinfo[4 * li + 3] = (int)r2;
        }
        LDS_WAIT(); asm volatile("" ::: "memory");
    }
    }
    __syncthreads();
    if (F.tid < 16) gb[F.tid] = (int)__hip_atomic_fetch_add((unsigned*)(F.ws + WS_GCNT) + layer * 16 + F.tid, cnt[F.tid], __ATOMIC_RELAXED, __HIP_MEMORY_SCOPE_AGENT);
    __syncthreads();
    int* tokmap = (int*)(F.ws + WS_TOKMAP);
    for (int i = F.tid; i < nA + nB; i += 512) {
        const int tok = (i < nA) ? tA + i : tB + (i - nA);
        const int e1 = tinfo[4 * i], e2 = tinfo[4 * i + 1], p1 = gb[e1] + tinfo[4 * i + 2], p2 = gb[e2] + tinfo[4 * i + 3];
        tokmap[(size_t)e1 * T + p1] = tok; tokmap[(size_t)e2 * T + p2] = tok;
        int* ro = route + (size_t)tok * 8; ro[2] = p1; ro[3] = p2;
    }
}

__device__ __forceinline__ int moe_tables(Frame& F, int layer) {
    LAS int* tb = (LAS int*)(F.lds + LDS_CTL + 64); LAS int* cn = (LAS int*)(F.lds + LDS_CTL + 192);
    __syncthreads();
    if (F.tid < 16) cn[F.tid] = ld_coh((const int*)(F.ws + WS_GCNT) + layer * 16 + F.tid);
    __syncthreads();
    if (F.tid == 0) { int b = 0; for (int e = 0; e < 16; ++e) { tb[e] = b; b += (cn[e] + 255) >> 8; } tb[16] = b; }
    __syncthreads();
    return __builtin_amdgcn_readfirstlane(tb[16]);
}

template <int NQ> __device__ __forceinline__ void combine_tokens(Frame& F, int layer, int t) {
    const float* mods = (const float*)(F.ws + WS_MODS);
    const bf16* OS = (const bf16*)(F.ws + WS_BUFP);
    const int* route = (const int*)(F.ws + WS_ROUTE);
    const LAS int* tb = (const LAS int*)(F.lds + LDS_CTL + 64);
    bf16* A = (bf16*)(F.ws + WS_BUFA);
    {
        int rc[NQ][4]; float w0[NQ], w1[NQ];
#pragma unroll
        for (int q = 0; q < NQ; ++q) { const int* ro = route + (size_t)(t + q) * 8;
#pragma unroll
            for (int i = 0; i < 4; ++i) rc[q][i] = ld_coh(ro + i);
            w0[q] = ld_cohf((const float*)(ro + 4)); w1[q] = ld_cohf((const float*)(ro + 5)); }
        f32x4 v[NQ][4]; u32x2 oa[NQ][4], ob[NQ][4];
#pragma unroll
        for (int q = 0; q < NQ; ++q) { const bf16* hr = h_row(F, t + q);
            const size_t s0 = (size_t)(tb[rc[q][0]] * 256 + rc[q][2]) * D, s1 = (size_t)(tb[rc[q][1]] * 256 + rc[q][3]) * D;
#pragma unroll
            for (int j = 0; j < 4; ++j) { const int c = 4 * F.lane + 256 * j; { const u32x2 hv = *(const u32x2*)(hr + c); v[q][j] = (f32x4){bflo(hv.x), bfhi(hv.x), bflo(hv.y), bfhi(hv.y)}; } oa[q][j] = __builtin_nontemporal_load((const u32x2*)(OS + s0 + c)); ob[q][j] = __builtin_nontemporal_load((const u32x2*)(OS + s1 + c)); } }
        const int mr = mod_row(t);
        const float* m5 = mods + (size_t)(layer * 9 + mr) * 6144 + 5 * 1024;
#pragma unroll
        for (int j = 0; j < 4; ++j) { const f32x4 g5 = *(const f32x4*)(m5 + 4 * F.lane + 256 * j);
#pragma unroll
            for (int q = 0; q < NQ; ++q) { const u32x2 a = oa[q][j], b2 = ob[q][j];
                const f32x4 o = (f32x4){w0[q] * bflo(a.x) + w1[q] * bflo(b2.x), w0[q] * bfhi(a.x) + w1[q] * bfhi(b2.x), w0[q] * bflo(a.y) + w1[q] * bflo(b2.y), w0[q] * bfhi(a.y) + w1[q] * bfhi(b2.y)};
                v[q][j] = v[q][j] + g5 * o; } }
#pragma unroll
        for (int q = 0; q < NQ; ++q) {
            if (layer == 0) {
                bf16* hr = h_row(F, t + q);
#pragma unroll
                for (int j = 0; j < 4; ++j) { u32x2 o; o.x = pk2(v[q][j].x, v[q][j].y); o.y = pk2(v[q][j].z, v[q][j].w); *(u32x2*)(hr + 4 * F.lane + 256 * j) = o; }
                const float* m = mods + (size_t)(9 + mr) * 6144;
                norm_mod_store(v[q], F.in[I_NMG] + 1024, m, m + 1024, A + (size_t)(t + q) * D, F.lane);
            } else {
                float s2 = 0.f;
#pragma unroll
                for (int j = 0; j < 4; ++j) s2 += (v[q][j].x * v[q][j].x + v[q][j].y * v[q][j].y) + (v[q][j].z * v[q][j].z + v[q][j].w * v[q][j].w);
                const float rstd = 1.0f / sqrtf(wave_sum(s2) * (1.0f / D) + EPS);
                float* orow = F.out + (size_t)(t + q) * D;
#pragma unroll
                for (int j = 0; j < 4; ++j) { const int c = 4 * F.lane + 256 * j; __builtin_nontemporal_store(v[q][j] * rstd * *(const f32x4*)(F.in[I_FG] + c), (f32x4*)(orow + c)); }
            }
        }
    }
}
__device__ __forceinline__ void phase_combine(Frame& F, int layer, int ntok) {
    const int gw = F.vcu * NWAVES + F.wave, NGW = F.G * NWAVES;
    if (layer == 0) { for (int t = 2 * gw; t < TL; t += 2 * NGW) combine_tokens<2>(F, 0, t); for (int t = TL + gw; t < ntok; t += NGW) combine_tokens<1>(F, 0, t); }
    else { for (int t = 4 * gw; t < TL; t += 4 * NGW) combine_tokens<4>(F, 1, t); }
}

constexpr int KV_LD = 72, VL_OFF = 384 * KV_LD * 2, ROPE_LDS = 131072;
typedef short v4i16_t __attribute__((ext_vector_type(4)));

__device__ __forceinline__ bf16x8 rope_pack(const u32x4 x1, const u32x4 x2, const LAS float* cs, const LAS float* sn, float scale, bool second) {
    const f32x4 c0 = *(const LAS f32x4*)cs, c1 = *(const LAS f32x4*)(cs + 4), s0 = *(const LAS f32x4*)sn, s1 = *(const LAS f32x4*)(sn + 4);
    float c[8] = {c0.x, c0.y, c0.z, c0.w, c1.x, c1.y, c1.z, c1.w}, s[8] = {s0.x, s0.y, s0.z, s0.w, s1.x, s1.y, s1.z, s1.w};
    float a[8], b[8];
#pragma unroll
    for (int i = 0; i < 4; ++i) { a[2 * i] = bflo(x1[i]); a[2 * i + 1] = bfhi(x1[i]); b[2 * i] = bflo(x2[i]); b[2 * i + 1] = bfhi(x2[i]); }
    float o[8];
#pragma unroll
    for (int i = 0; i < 8; ++i) o[i] = (second ? (b[i] * c[i] + a[i] * s[i]) : (a[i] * c[i] - b[i] * s[i])) * scale;
    u32x4 w; w.x = pk2(o[0], o[1]); w.y = pk2(o[2], o[3]); w.z = pk2(o[4], o[5]); w.w = pk2(o[6], o[7]);
    return __builtin_bit_cast(bf16x8, w);
}

struct AttnU { int b, qb, kvh; };
__device__ __forceinline__ AttnU attn_unit_of(int u) { AttnU r; r.kvh = u & 1; r.qb = (u >> 1) & 31; r.b = u >> 6; return r; }

__device__ __forceinline__ void attn_load_latk(Frame& F, const bf16* P1, AttnU u, u32x4 (&lk)[2][4]) {
    const u32x4 z = (u32x4){0u, 0u, 0u, 0u};
#pragma unroll
    for (int it = 0; it < 2; ++it) { const int task = F.tid + 512 * it, kidx = task >> 1, hh = task & 1, pos = u.qb * 128 - 128 + kidx;
        const bool ok = task < 768 && pos >= 0 && pos < NSEQ;
        const bf16* row = P1 + (size_t)(u.b * NSEQ + (ok ? pos : 0)) * OIN + 1024 + u.kvh * 64 + 8 * hh;
#pragma unroll
        for (int st = 0; st < 4; ++st) lk[it][st] = ok ? *(const u32x4*)(row + 16 * st) : z; }
}
__device__ __forceinline__ void attn_load_latv(Frame& F, const bf16* P1, AttnU u, u32x4 (&lv)[6]) {
    const u32x4 z = (u32x4){0u, 0u, 0u, 0u};
#pragma unroll
    for (int it = 0; it < 6; ++it) { const int task = F.tid + 512 * it, kidx = task >> 3, c8 = task & 7, pos = u.qb * 128 - 128 + kidx;
        const bool ok = pos >= 0 && pos < NSEQ;
        lv[it] = ok ? *(const u32x4*)(P1 + (size_t)(u.b * NSEQ + (ok ? pos : 0)) * OIN + 1152 + u.kvh * 64 + 8 * c8) : z; }
}
__device__ __forceinline__ void attn_write_lat(Frame& F, AttnU u, const u32x4 (&lk)[2][4], const u32x4 (&lv)[6]) {
    LAS bf16* KL = (LAS bf16*)F.lds; LAS bf16* VL = (LAS bf16*)(F.lds + VL_OFF); const LAS float* rope = (const LAS float*)(F.lds + ROPE_LDS);
#pragma unroll
    for (int it = 0; it < 2; ++it) { const int task = F.tid + 512 * it, kidx = task >> 1, hh = task & 1; int pos = u.qb * 128 - 128 + kidx; pos = pos < 0 ? 0 : (pos > NSEQ - 1 ? NSEQ - 1 : pos);
        if (task < 768) {
            LAS bf16* d = KL + kidx * KV_LD + 8 * hh;
            const LAS float* c0 = rope + (pos >> 6) * 16 + 8 * hh; const LAS float* c1 = rope + (pos & 63) * 16 + 8 * hh;
            *(LAS bf16x8*)(d) = rope_pack(lk[it][0], lk[it][1], c0, c0 + 1024, 1.0f, false);
            *(LAS bf16x8*)(d + 16) = rope_pack(lk[it][0], lk[it][1], c0, c0 + 1024, 1.0f, true);
            *(LAS bf16x8*)(d + 32) = rope_pack(lk[it][2], lk[it][3], c1, c1 + 1024, 1.0f, false);
            *(LAS bf16x8*)(d + 48) = rope_pack(lk[it][2], lk[it][3], c1, c1 + 1024, 1.0f, true);
        } }
#pragma unroll
    for (int it = 0; it < 6; ++it) { const int task = F.tid + 512 * it, kidx = task >> 3, c8 = task & 7; *(LAS u32x4*)(VL + kidx * KV_LD + 8 * c8) = lv[it]; }
}
__device__ __forceinline__ void attn_load_ctx(Frame& F, const bf16* P1, AttnU u, u32x4 (&ck)[4], u32x4 (&cv)[4]) {
#pragma unroll
    for (int it = 0; it < 4; ++it) { const int task = F.tid + 512 * it, kidx = task >> 3, c8 = task & 7;
        const bf16* row = P1 + (size_t)(TL + u.b * LCTX + kidx) * OIN + 1024 + u.kvh * 64 + 8 * c8;
        ck[it] = *(const u32x4*)row; cv[it] = *(const u32x4*)(row + 128); }
}
__device__ __forceinline__ void attn_write_ctx(Frame& F, const u32x4 (&ck)[4], const u32x4 (&cv)[4]) {
    LAS bf16* KL = (LAS bf16*)F.lds; LAS bf16* VL = (LAS bf16*)(F.lds + VL_OFF);
#pragma unroll
    for (int it = 0; it < 4; ++it) { const int task = F.tid + 512 * it, kidx = task >> 3, c8 = task & 7;
        *(LAS u32x4*)(KL + kidx * KV_LD + 8 * c8) = ck[it]; *(LAS u32x4*)(VL + kidx * KV_LD + 8 * c8) = cv[it]; }
}

__device__ __forceinline__ unsigned cvtpk(float lo, float hi) { unsigned r; asm volatile("v_cvt_pk_bf16_f32 %0, %1, %2" : "=v"(r) : "v"(lo), "v"(hi)); return r; }
__device__ __forceinline__ float xhalf_max(float x) { const auto r = __builtin_amdgcn_permlane32_swap(__builtin_bit_cast(unsigned, x), __builtin_bit_cast(unsigned, x), false, false);
    return fmaxf(__builtin_bit_cast(float, r[0]), __builtin_bit_cast(float, r[1])); }
__device__ __forceinline__ float xhalf_sum(float x) { const auto r = __builtin_amdgcn_permlane32_swap(__builtin_bit_cast(unsigned, x), __builtin_bit_cast(unsigned, x), false, false);
    return __builtin_bit_cast(float, r[0]) + __builtin_bit_cast(float, r[1]); }
__device__ __forceinline__ void attn_tiles(Frame& F, int kt0, int kt1, int mk0, int mk1, const bf16x8 (&qf)[4], f32x16 (&O)[2], float& mrun, float& lrun, int qrel) {
    if (kt0 > kt1) return;
    const LAS bf16* KL = (const LAS bf16*)F.lds; const LAS bf16* VL = (const LAS bf16*)(F.lds + VL_OFF);
    const int r32 = F.lane & 31, hh = F.lane >> 5;
    const int q4 = (F.lane & 15) >> 2, p4 = F.lane & 3, blk = (F.lane >> 4) & 1;
    const LAS bf16* kp = KL + (kt0 * 32 + r32) * KV_LD + 8 * hh;
    const LAS bf16* vp = VL + (kt0 * 32 + 4 * hh + q4) * KV_LD + 16 * blk + 4 * p4;
    bf16x8 kn[4];
#pragma unroll
    for (int st = 0; st < 4; ++st) kn[st] = *(const LAS bf16x8*)(kp + 16 * st);
    for (int kt = kt0; kt <= kt1; ++kt) {
        bf16x8 kf[4];
#pragma unroll
        for (int st = 0; st < 4; ++st) kf[st] = kn[st];
        v4i16_t vlo[2][2], vhi[2][2];
#pragma unroll
        for (int dt = 0; dt < 2; ++dt)
#pragma unroll
            for (int s2 = 0; s2 < 2; ++s2) { vlo[dt][s2] = __builtin_amdgcn_ds_read_tr16_b64_v4i16((LAS v4i16_t*)(vp + (16 * s2) * KV_LD + dt * 32));
                vhi[dt][s2] = __builtin_amdgcn_ds_read_tr16_b64_v4i16((LAS v4i16_t*)(vp + (16 * s2 + 8) * KV_LD + dt * 32)); }
        kp += 32 * KV_LD; vp += 32 * KV_LD;
        if (kt < kt1) {
#pragma unroll
            for (int st = 0; st < 4; ++st) kn[st] = *(const LAS bf16x8*)(kp + 16 * st); }
        __builtin_amdgcn_sched_barrier(0);
        f32x16 s;
#pragma unroll
        for (int r = 0; r < 16; ++r) s[r] = 0.f;
#pragma unroll
        for (int st = 0; st < 4; ++st) s = __builtin_amdgcn_mfma_f32_32x32x16_bf16(kf[st], qf[st], s, 0, 0, 0);
        if (kt == mk0 || kt == mk1) {
#pragma unroll
            for (int r = 0; r < 16; ++r) { const int dlt = kt * 32 + (r & 3) + 8 * (r >> 2) + 4 * hh - qrel; s[r] = (dlt <= 128 && dlt >= -128) ? s[r] : -INFINITY; } }
        float mx = fmaxf(fmaxf(s[0], s[1]), fmaxf(s[2], s[3]));
#pragma unroll
        for (int r = 4; r < 16; r += 4) mx = fmaxf(mx, fmaxf(fmaxf(s[r], s[r + 1]), fmaxf(s[r + 2], s[r + 3])));
        mx = xhalf_max(mx);
        const float mnew = fmaxf(mrun, mx);
        float ps0 = 0.f, ps1 = 0.f;
#pragma unroll
        for (int r = 0; r < 16; r += 2) { s[r] = __builtin_amdgcn_exp2f(s[r] - mnew); s[r + 1] = __builtin_amdgcn_exp2f(s[r + 1] - mnew); ps0 += s[r]; ps1 += s[r + 1]; }
        const float ps = xhalf_sum(ps0 + ps1);
        if (__any(mnew > mrun)) {
            const float alpha = __builtin_amdgcn_exp2f(mrun - mnew);
            lrun *= alpha;
#pragma unroll
            for (int dt = 0; dt < 2; ++dt)
#pragma unroll
                for (int r = 0; r < 16; ++r) O[dt][r] *= alpha;
        }
        lrun += ps; mrun = mnew;
        bf16x8 pb[2];
#pragma unroll
        for (int s2 = 0; s2 < 2; ++s2) { u32x4 w; w.x = cvtpk(s[8 * s2 + 0], s[8 * s2 + 1]); w.y = cvtpk(s[8 * s2 + 2], s[8 * s2 + 3]); w.z = cvtpk(s[8 * s2 + 4], s[8 * s2 + 5]); w.w = cvtpk(s[8 * s2 + 6], s[8 * s2 + 7]);
            pb[s2] = __builtin_bit_cast(bf16x8, w); }
#pragma unroll
        for (int dt = 0; dt < 2; ++dt)
#pragma unroll
            for (int s2 = 0; s2 < 2; ++s2) {
                const bf16x8 va = (bf16x8){vlo[dt][s2][0], vlo[dt][s2][1], vlo[dt][s2][2], vlo[dt][s2][3], vhi[dt][s2][0], vhi[dt][s2][1], vhi[dt][s2][2], vhi[dt][s2][3]};
                O[dt] = __builtin_amdgcn_mfma_f32_32x32x16_bf16(va, pb[s2], O[dt], 0, 0, 0);
            }
    }
}

__device__ __forceinline__ void phase_attn(Frame& F) {
    const bf16* P1 = (const bf16*)(F.ws + WS_BUFP);
    bf16* MIX = (bf16*)(F.ws + WS_BUFA);
    const int r32 = F.lane & 31, hh = F.lane >> 5;
    constexpr float QSC = 0.125f * 1.4426950408889634f;
    LAS float* ropel = (LAS float*)(F.lds + ROPE_LDS);
    for (int i = F.tid; i < 2048; i += 512) ropel[i] = ((const float*)(F.ws + WS_ROPE))[i];
    u32x4 lk[2][4], lv[6], ck[4], cv[4];
    const int nu = (512 - F.vcu + F.G - 1) / F.G;
    if (nu > 0) attn_load_latk(F, P1, attn_unit_of(F.vcu), lk);
    for (int ui = 0; ui < nu; ++ui) {
        const AttnU u = attn_unit_of(F.vcu + ui * F.G);
        u32x4 qr[2][4];
#pragma unroll
        for (int i = 0; i < 2; ++i) { const int task = F.wave + 8 * i, g = task & 3, sub = task >> 2, head = u.kvh * 4 + g, pos = u.qb * 128 + 32 * sub + r32;
            const bf16* row = P1 + (size_t)(u.b * NSEQ + pos) * OIN + 512 + head * 64 + 8 * hh;
#pragma unroll
            for (int st = 0; st < 4; ++st) qr[i][st] = __builtin_nontemporal_load((const u32x4*)(row + 16 * st)); }
        attn_load_latv(F, P1, u, lv);
        __syncthreads();
        attn_write_lat(F, u, lk, lv);
        bf16x8 qf[2][4]; f32x16 O[2][2]; float mrun[2], lrun[2];
#pragma unroll
        for (int i = 0; i < 2; ++i) { const int task = F.wave + 8 * i, g = task & 3, sub = task >> 2, head = u.kvh * 4 + g, pos = u.qb * 128 + 32 * sub + r32;
            const LAS float* c0 = ropel + (pos >> 6) * 16 + 8 * hh; const LAS float* c1 = ropel + (pos & 63) * 16 + 8 * hh;
            qf[i][0] = rope_pack(qr[i][0], qr[i][1], c0, c0 + 1024, QSC, false); qf[i][1] = rope_pack(qr[i][0], qr[i][1], c0, c0 + 1024, QSC, true);
            qf[i][2] = rope_pack(qr[i][2], qr[i][3], c1, c1 + 1024, QSC, false); qf[i][3] = rope_pack(qr[i][2], qr[i][3], c1, c1 + 1024, QSC, true);
            mrun[i] = F.in[I_OSINK][head] * 1.4426950408889634f; lrun[i] = 1.0f;
#pragma unroll
            for (int dt = 0; dt < 2; ++dt)
#pragma unroll
                for (int r = 0; r < 16; ++r) O[i][dt][r] = 0.f; }
        __syncthreads();
        const int kt_lo = (u.qb == 0) ? 4 : 0, kt_hi = (u.qb == 31) ? 7 : 11;
#pragma unroll
        for (int i = 0; i < 2; ++i) { const int sub = (F.wave + 8 * i) >> 2, qrel = 128 + 32 * sub + r32;
            attn_tiles(F, max(sub, kt_lo), min(sub + 8, kt_hi), sub, sub + 8, qf[i], O[i], mrun[i], lrun[i], qrel); }
        attn_load_ctx(F, P1, u, ck, cv);
        __syncthreads();
        attn_write_ctx(F, ck, cv);
        __syncthreads();
        if (ui + 1 < nu) attn_load_latk(F, P1, attn_unit_of(F.vcu + (ui + 1) * F.G), lk);
#pragma unroll
        for (int i = 0; i < 2; ++i) {
            attn_tiles(F, 0, 7, -1, -1, qf[i], O[i], mrun[i], lrun[i], 0);
            const int task = F.wave + 8 * i, g = task & 3, sub = task >> 2, head = u.kvh * 4 + g, pos = u.qb * 128 + 32 * sub + r32;
            const float inv = 1.0f / lrun[i];
            bf16* o = MIX + (size_t)(u.b * NSEQ + pos) * D + 512 + head * 64 + 4 * hh;
#pragma unroll
            for (int dt = 0; dt < 2; ++dt)
#pragma unroll
                for (int rg = 0; rg < 4; ++rg) { u32x2 w; w.x = pk2(O[i][dt][4 * rg] * inv, O[i][dt][4 * rg + 1] * inv); w.y = pk2(O[i][dt][4 * rg + 2] * inv, O[i][dt][4 * rg + 3] * inv);
                    *(u32x2*)(o + dt * 32 + 8 * rg) = w; }
        }
    }
    __syncthreads();
}

__device__ __forceinline__ void phase_pool_stencil(Frame& F) {
    const bf16* P1 = (const bf16*)(F.ws + WS_BUFP);
    bf16* MIX = (bf16*)(F.ws + WS_BUFA);
    const int gw = F.vcu * NWAVES + F.wave, NGW = F.G * NWAVES;
    const int r = 1 << (F.lane >> 4);
    constexpr int NT = 8, NR = NT + 16;
    for (int t = NT * gw; t < TL; t += NT * NGW) {
        const int pos = t & 4095;
        const bf16* base = P1 + (size_t)t * OIN + 8 * F.lane;
        u32x4 v[NR];
#pragma unroll
        for (int jj = 0; jj < NR; ++jj) { const int pj = pos + jj - 8; const bool ok = pj >= 0 && pj < NSEQ; v[jj] = ok ? *(const u32x4*)(base + (ptrdiff_t)(jj - 8) * OIN) : (u32x4){0u, 0u, 0u, 0u}; }
        float acc[NT][8];
#pragma unroll
        for (int q = 0; q < NT; ++q)
#pragma unroll
            for (int i = 0; i < 8; ++i) acc[q][i] = 0.f;
#pragma unroll
        for (int jj = 0; jj < NR; ++jj) {
            float x[8];
#pragma unroll
            for (int i = 0; i < 4; ++i) { x[2 * i] = bflo(v[jj][i]); x[2 * i + 1] = bfhi(v[jj][i]); }
#pragma unroll
            for (int q = 0; q < NT; ++q) { const int dd = jj - 8 - q; if (dd >= -8 && dd <= 8) { const float w = (dd <= r && dd >= -r) ? 1.0f : 0.0f;
#pragma unroll
                for (int i = 0; i < 8; ++i) acc[q][i] += w * x[i]; } }
        }
#pragma unroll
        for (int q = 0; q < NT; ++q) {
            const int pq = pos + q, lo = max(pq - r, 0), hi = min(pq + r + 1, NSEQ);
            const float ic = 1.0f / (float)(hi - lo);
            const u32x4 sv = v[q + 8];
            u32x4 o;
#pragma unroll
            for (int i = 0; i < 4; ++i) o[i] = pk2(acc[q][2 * i] * ic - bflo(sv[i]), acc[q][2 * i + 1] * ic - bfhi(sv[i]));
            *(u32x4*)(MIX + (size_t)(t + q) * D + 8 * F.lane) = o;
        }
    }
}

__device__ __forceinline__ void phase_attn_pool(Frame& F) {
    phase_attn(F);
#ifdef DBG_ATTN2
    phase_attn(F);
#endif
    phase_pool_stencil(F);
    __syncthreads();
    convert_l1_static(F);
}

constexpr int NPHASE = 20;
__global__ void __launch_bounds__(NWAVES * 64, 2) mk_fwd(Args args) {
    extern __shared__ __attribute__((aligned(16))) unsigned char lds_raw[];
    Frame F;
    F.lds = (LAS unsigned char*)lds_raw;
    F.tid = threadIdx.x; F.lane = F.tid & 63; F.wave = __builtin_amdgcn_readfirstlane(F.tid >> 6);
    F.G = gridDim.x; { const int bx = blockIdx.x; F.vcu = (F.G % 8 == 0) ? (bx % 8) * (F.G / 8) + bx / 8 : bx; }
    F.ws = args.ws; F.in = args.in; F.out = args.out;
    for (int u = F.tid; u < (LDS_BYTES - LDS_CTL) / 4; u += NWAVES * 64) ((LAS unsigned*)(F.lds + LDS_CTL))[u] = 0u;
    __syncthreads();
    const int lo = args.ph_lo, hi = args.ph_hi;
    XcdBarrier bar; bar.bar = (unsigned*)(F.ws + WS_CTL); bar.x = 0; bar.st = nullptr;
    if (hi - lo > 1) bar = xcd_barrier_post((unsigned*)(F.ws + WS_CTL), (volatile LAS unsigned*)(F.lds + LDS_CTL));
#define IN(k) (lo <= (k) && (k) < hi)
#ifndef PHASE_MASK
#define PHASE_MASK 0xffffffffu
#endif
#define PH(k, ...) if constexpr (((PHASE_MASK >> (k)) & 1u) != 0u) if (IN(k)) { __VA_ARGS__ if constexpr (((DBG_DOUBLE >> (k)) & 1u) != 0u) { __VA_ARGS__ } }
#define SEAM(k) do { if (IN(k) && IN((k) + 1)) xcd_barrier(bar); } while (0)
    unsigned char* ws = F.ws;
    const float* mods = (const float*)(ws + WS_MODS);

    PH(1, { phase_prologue_a(F); }) SEAM(1);
    PH(2, {
        pg8::SchedDense S{(const char*)(ws + WS_BUFA), (const char*)(ws + WS_W_EIN), 1024, 8, 136, 0, 1088, F.vcu, F.G};
        pg8::EpiStore E{(bf16*)(ws + WS_BUFP), EIN};
        pg8::gemm_phase<pg8::EpiStore, pg8::SchedDense>(F.lds, 1024, S, E);
    }) SEAM(2);
    PH(3, { phase_fourier_a_conv(F); }) SEAM(3);
    PH(4, { phase_fourier_c(F); }) SEAM(4);
    PH(5, {
        const int xs = F.vcu >> 5, rs = F.vcu & 31; const bool heavy = rs >= 28;
        pg8::SchedSplit S{(const char*)(ws + WS_BUFA), (const char*)(ws + WS_W_EOUT), 1024, heavy ? 448 + 4 * xs + (rs - 28) : 28 * xs + rs, heavy ? 32 : 224, heavy ? 3 : 2};
        pg8::EpiResid<true> E{F.in[I_X], F.in[I_CTX], (bf16*)(ws + WS_HB), mods + 2 * 1024};
        pg8::gemm_phase<pg8::EpiResid<true>, pg8::SchedSplit>(F.lds, 1024, S, E);
        ctr_publish(F, heavy ? WS_P5C : WS_P5F);
    })
    PH(6, { phase_route<true>(F, 0, T); }) SEAM(6);
    PH(7, {
        const int ntile = moe_tables(F, 0);
        if constexpr (FP8_G1_L0) {
            pg8::SchedMoe<true> S{(const char*)(ws + WS_BUFA), (const char*)(ws + WS_W_M1) + (size_t)0 * 32 * MiB, (const int*)(ws + WS_TOKMAP), (const LAS int*)(F.lds + LDS_CTL + 64), (const LAS int*)(F.lds + LDS_CTL + 192), 512, (size_t)MiB, ntile * 4, F.vcu, F.G};
            pg8::EpiSwiglu8 E{(unsigned char*)(ws + WS_BUFZ), pg8::W1_SCALE};
            pg8::gemm_phase<pg8::EpiSwiglu8, pg8::SchedMoe<true>, true>(F.lds, 512, S, E);
        } else {
            pg8::SchedMoe<true> S{(const char*)(ws + WS_BUFA), (const char*)(ws + WS_W_M1) + (size_t)0 * 32 * MiB, (const int*)(ws + WS_TOKMAP), (const LAS int*)(F.lds + LDS_CTL + 64), (const LAS int*)(F.lds + LDS_CTL + 192), 1024, (size_t)2 * MiB, ntile * 4, F.vcu, F.G};
            if constexpr (FP8_G2_L0) { pg8::EpiSwiglu8 E{(unsigned char*)(ws + WS_BUFZ), 1.0f}; pg8::gemm_phase<pg8::EpiSwiglu8, pg8::SchedMoe<true>>(F.lds, 1024, S, E); }
            else { pg8::EpiSwiglu E{(bf16*)(ws + WS_BUFZ)}; pg8::gemm_phase<pg8::EpiSwiglu, pg8::SchedMoe<true>>(F.lds, 1024, S, E); }
        }
    }) SEAM(7);
    PH(8, {
        const int ntile = moe_tables(F, 0);
        if constexpr (FP8_G2_L0) {
            pg8::SchedMoe<false> S{(const char*)(ws + WS_BUFZ), (const char*)(ws + WS_W_M2) + (size_t)0 * 16 * MiB, nullptr, (const LAS int*)(F.lds + LDS_CTL + 64), (const LAS int*)(F.lds + LDS_CTL + 192), 256, (size_t)512 * KiB, ntile * 4, F.vcu, F.G};
            pg8::EpiStoreS E{(bf16*)(ws + WS_BUFP), 1024, 1.0f / (pg8::HID_SCALE * pg8::W2_SCALE)};
            pg8::gemm_phase<pg8::EpiStoreS, pg8::SchedMoe<false>, true>(F.lds, 256, S, E);
        } else {
            pg8::SchedMoe<false> S{(const char*)(ws + WS_BUFZ), (const char*)(ws + WS_W_M2) + (size_t)0 * 16 * MiB, nullptr, (const LAS int*)(F.lds + LDS_CTL + 64), (const LAS int*)(F.lds + LDS_CTL + 192), 512, (size_t)MiB, ntile * 4, F.vcu, F.G};
            pg8::EpiStore E{(bf16*)(ws + WS_BUFP), 1024};
            pg8::gemm_phase<pg8::EpiStore, pg8::SchedMoe<false>>(F.lds, 512, S, E);
        }
    }) SEAM(8);
    PH(9, { (void)moe_tables(F, 0); phase_combine(F, 0, T); }) SEAM(9);
    PH(10, {
        pg8::SchedDense S{(const char*)(ws + WS_BUFA), (const char*)(ws + WS_W_OIN), 1024, 5, 128, 4, 648, F.vcu, F.G};
        pg8::EpiStore E{(bf16*)(ws + WS_BUFP), OIN};
        pg8::gemm_phase<pg8::EpiStore, pg8::SchedDense>(F.lds, 1024, S, E);
    }) SEAM(10);
    PH(11, { phase_attn_pool(F); }) SEAM(11);
    PH(12, {
        pg8::SchedDense S{(const char*)(ws + WS_BUFA), (const char*)(ws + WS_W_OOUT), 1024, 4, 128, 0, 512, F.vcu, F.G};
        pg8::EpiResid<false> E{nullptr, nullptr, (bf16*)(ws + WS_HB), mods + 9 * 6144 + 2 * 1024};
        pg8::gemm_phase<pg8::EpiResid<false>, pg8::SchedDense>(F.lds, 1024, S, E);
    }) SEAM(12);
    PH(13, { phase_route<false>(F, 1, TL); }) SEAM(13);
    PH(14, {
        const int ntile = moe_tables(F, 1);
        if constexpr (FP8_G1_L1) {
            pg8::SchedMoe<true> S{(const char*)(ws + WS_BUFA), (const char*)(ws + WS_W_M1) + (size_t)1 * 32 * MiB, (const int*)(ws + WS_TOKMAP), (const LAS int*)(F.lds + LDS_CTL + 64), (const LAS int*)(F.lds + LDS_CTL + 192), 512, (size_t)MiB, ntile * 4, F.vcu, F.G};
            pg8::EpiSwiglu8 E{(unsigned char*)(ws + WS_BUFZ), pg8::W1_SCALE};
            pg8::gemm_phase<pg8::EpiSwiglu8, pg8::SchedMoe<true>, true>(F.lds, 512, S, E);
        } else {
            pg8::SchedMoe<true> S{(const char*)(ws + WS_BUFA), (const char*)(ws + WS_W_M1) + (size_t)1 * 32 * MiB, (const int*)(ws + WS_TOKMAP), (const LAS int*)(F.lds + LDS_CTL + 64), (const LAS int*)(F.lds + LDS_CTL + 192), 1024, (size_t)2 * MiB, ntile * 4, F.vcu, F.G};
            if constexpr (FP8_G2_L1) { pg8::EpiSwiglu8 E{(unsigned char*)(ws + WS_BUFZ), 1.0f}; pg8::gemm_phase<pg8::EpiSwiglu8, pg8::SchedMoe<true>>(F.lds, 1024, S, E); }
            else { pg8::EpiSwiglu E{(bf16*)(ws + WS_BUFZ)}; pg8::gemm_phase<pg8::EpiSwiglu, pg8::SchedMoe<true>>(F.lds, 1024, S, E); }
        }
    }) SEAM(14);
    PH(15, {
        const int ntile = moe_tables(F, 1);
        if constexpr (FP8_G2_L1) {
            pg8::SchedMoe<false> S{(const char*)(ws + WS_BUFZ), (const char*)(ws + WS_W_M2) + (size_t)1 * 16 * MiB, nullptr, (const LAS int*)(F.lds + LDS_CTL + 64), (const LAS int*)(F.lds + LDS_CTL + 192), 256, (size_t)512 * KiB, ntile * 4, F.vcu, F.G};
            pg8::EpiStoreS E{(bf16*)(ws + WS_BUFP), 1024, 1.0f / (pg8::HID_SCALE * pg8::W2_SCALE)};
            pg8::gemm_phase<pg8::EpiStoreS, pg8::SchedMoe<false>, true>(F.lds, 256, S, E);
        } else {
            pg8::SchedMoe<false> S{(const char*)(ws + WS_BUFZ), (const char*)(ws + WS_W_M2) + (size_t)1 * 16 * MiB, nullptr, (const LAS int*)(F.lds + LDS_CTL + 64), (const LAS int*)(F.lds + LDS_CTL + 192), 512, (size_t)MiB, ntile * 4, F.vcu, F.G};
            pg8::EpiStore E{(bf16*)(ws + WS_BUFP), 1024};
            pg8::gemm_phase<pg8::EpiStore, pg8::SchedMoe<false>>(F.lds, 512, S, E);
        }
    }) SEAM(15);
    PH(16, { (void)moe_tables(F, 1); phase_combine(F, 1, TL); }) SEAM(16);
#ifdef DBG_XBAR
    if (hi - lo > 1) { for (int xb = 0; xb < DBG_XBAR; ++xb) xcd_barrier(bar); }
#endif
#undef IN
#undef SEAM
}

extern "C" void kernel_launch(void* const* d_in, const int* in_sizes, int n_in, void* d_out, int out_size, void* d_ws, size_t ws_size, hipStream_t stream) {
    static int grid = 0;
    if (grid == 0) {
        if (n_in != 22 || ws_size < WS_END) { fprintf(stderr, "kernel_launch: unexpected inputs (n_in %d, ws %zu)\n", n_in, ws_size); grid = -1; return; }
        int dev = 0, cus = 0, per_cu = 0;
        if (hipGetDevice(&dev) != hipSuccess || hipDeviceGetAttribute(&cus, hipDeviceAttributeMultiprocessorCount, dev) != hipSuccess) { grid = -1; return; }
        if (hipFuncSetAttribute((const void*)mk_fwd, hipFuncAttributeMaxDynamicSharedMemorySize, LDS_BYTES) != hipSuccess) { fprintf(stderr, "kernel_launch: hipFuncSetAttribute failed\n"); grid = -1; return; }
        if (hipOccupancyMaxActiveBlocksPerMultiprocessor(&per_cu, (const void*)mk_fwd, NWAVES * 64, LDS_BYTES) != hipSuccess || per_cu < 1) { fprintf(stderr, "kernel_launch: occupancy query says %d\n", per_cu); }
        (void)hipGetLastError();
        grid = cus;
        if (grid != 256) { fprintf(stderr, "kernel_launch: %d CUs; this build assumes 256\n", grid); }
    }
    if (grid < 0) return;
    (void)hipMemsetAsync((char*)d_ws + WS_CTL, 0, CTL_ZERO_BYTES, stream);
    Args a{};
    for (int i = 0; i < 22; ++i) a.in[i] = (const float*)d_in[i];
    a.out = (float*)d_out; a.ws = (unsigned char*)d_ws;
#if MK_MULTI
    for (int p = 0; p <= DBG_STOP; ++p) { a.ph_lo = p; a.ph_hi = p + 1; hipLaunchKernelGGL(mk_fwd, dim3(grid), dim3(NWAVES * 64), LDS_BYTES, stream, a); }
    if (DBG_STOP < 16) { a.ph_lo = 17; a.ph_hi = 18; hipLaunchKernelGGL(mk_fwd, dim3(grid), dim3(NWAVES * 64), LDS_BYTES, stream, a); }
#else
    a.ph_lo = 0; a.ph_hi = 17;
    hipLaunchKernelGGL(mk_fwd, dim3(grid), dim3(NWAVES * 64), LDS_BYTES, stream, a);
#endif
}
```

```cpp
#include <hip/hip_runtime.h>
#include <cstdio>
#include <cstdint>
#include <type_traits>

#ifndef MK_MULTI
#define MK_MULTI 0
#endif
#ifndef DBG_STOP
#define DBG_STOP 16
#endif

#ifndef DBG_DOUBLE
#define DBG_DOUBLE 0u
#endif
#ifndef FP8_G1_L0
#define FP8_G1_L0 1
#endif
#ifndef FP8_G1_L1
#define FP8_G1_L1 1
#endif
#ifndef FP8_G2_L0
#define FP8_G2_L0 1
#endif
#ifndef FP8_G2_L1
#define FP8_G2_L1 1
#endif
#define LAS __attribute__((address_space(3)))
#define GAS __attribute__((address_space(1)))
typedef unsigned short bf16;
typedef short bf16x8 __attribute__((ext_vector_type(8)));
typedef short s16x4 __attribute__((ext_vector_type(4)));
typedef float f32x4 __attribute__((ext_vector_type(4)));
typedef float f32x16 __attribute__((ext_vector_type(16)));
typedef unsigned u32x4 __attribute__((ext_vector_type(4)));
typedef unsigned u32x2 __attribute__((ext_vector_type(2)));

constexpr int NB = 8, NSEQ = 4096, D = 1024, LCTX = 256;
constexpr int TL = NB * NSEQ, TC = NB * LCTX, T = TL + TC;
constexpr int EIN = 2048;
constexpr int OIN = 1280;
constexpr int NE = 16, DE = 512;
constexpr int MAXSLOT = 73728;
constexpr float EPS = 1e-6f;

constexpr size_t KiB = 1024, MiB = 1024 * 1024;
constexpr size_t WS_CTL = 0, CTL_ZERO_BYTES = 64 * KiB;
constexpr size_t WS_MODS = 64 * KiB;
constexpr size_t WS_ROPE = WS_MODS + 512 * KiB;
constexpr size_t WS_WA = WS_ROPE + 8 * KiB;
constexpr size_t WS_WAC = WS_WA + 32 * KiB;
constexpr size_t WS_WCC = WS_WAC + 2 * KiB;
constexpr size_t WS_FD = 3 * MiB - 64 * KiB;
constexpr size_t WS_BCNT = WS_WCC + 16 * KiB;
constexpr size_t WS_TILEMAP = WS_BCNT + 16 * KiB;
constexpr size_t WS_SLOT = WS_TILEMAP + 2 * KiB;
constexpr size_t WS_WROW = WS_SLOT + 288 * KiB;
constexpr size_t WS_ROUTE = WS_WROW + 288 * KiB;
constexpr size_t WS_WC = 3 * MiB;
constexpr size_t WS_W_EIN = 4 * MiB;
constexpr size_t WS_W_EOUT = 9 * MiB;
constexpr size_t WS_W_OIN = 11 * MiB;
constexpr size_t WS_W_OOUT = 14 * MiB;
constexpr size_t WS_W_POOL = 16 * MiB;
constexpr size_t WS_W_M1 = 17 * MiB;
constexpr size_t WS_W_M2 = 81 * MiB;
constexpr size_t WS_HC = 113 * MiB;
constexpr size_t WS_BUFA = 121 * MiB;
constexpr size_t WS_BUFP = 189 * MiB;
constexpr size_t WS_BUFZ = 360 * MiB;
constexpr size_t WS_TOKMAP = 432 * MiB;
constexpr size_t WS_HB = 435 * MiB;
constexpr size_t WS_END = 503 * MiB;
constexpr size_t WS_MODSDONE = 24 * KiB;
constexpr size_t WS_P5F = 28 * KiB, WS_P5C = 28 * KiB + 256;
constexpr size_t WS_GCNT = 16 * KiB;
static_assert(WS_ROUTE + (size_t)T * 32 <= WS_WC, "small region");
static_assert((size_t)T * EIN * 2 <= WS_BUFZ - WS_BUFP && (size_t)MAXSLOT * 1024 * 2 <= WS_BUFZ - WS_BUFP, "BUFP");
static_assert((size_t)MAXSLOT * 512 * 2 <= WS_TOKMAP - WS_BUFZ && (size_t)T * 1024 * 2 <= WS_TOKMAP - WS_BUFZ, "BUFZ");
static_assert((size_t)16 * T * 4 <= WS_HB - WS_TOKMAP && (size_t)T * 1024 * 2 <= WS_END - WS_HB, "TOKMAP / HB");
static_assert((size_t)T * 1024 * 2 <= WS_BUFP - WS_BUFA, "BUFA");

constexpr int LDS_BYTES = 163840;
constexpr int LDS_GIDX = 147456;
constexpr int LDS_CTL = 146432;
constexpr int NWAVES = 8;

__device__ __forceinline__ unsigned f2bf(float f) { unsigned u = __builtin_bit_cast(unsigned, f); return (u + 0x7fffu + ((u >> 16) & 1u)) >> 16; }
__device__ __forceinline__ unsigned pk2(float lo, float hi) { return f2bf(lo) | (f2bf(hi) << 16); }
__device__ __forceinline__ float bflo(unsigned w) { return __builtin_bit_cast(float, w << 16); }
__device__ __forceinline__ float bfhi(unsigned w) { return __builtin_bit_cast(float, w & 0xffff0000u); }
__device__ __forceinline__ float wave_sum(float v) {
#pragma unroll
    for (int o = 1; o < 64; o <<= 1) v += __shfl_xor(v, o);
    return v;
}
__device__ __forceinline__ int ld_coh(const int* p) { return (int)__hip_atomic_load((const unsigned*)p, __ATOMIC_RELAXED, __HIP_MEMORY_SCOPE_AGENT); }
__device__ __forceinline__ float ld_cohf(const float* p) { return __builtin_bit_cast(float, __hip_atomic_load((const unsigned*)p, __ATOMIC_RELAXED, __HIP_MEMORY_SCOPE_AGENT)); }
#define LDS_WAIT() asm volatile("s_waitcnt lgkmcnt(0)" ::: "memory")

#define XB_TMO      128
#define XB_XCNT(j)  (256  + 64 * (j))
#define XB_XSUB(j)  (1280 + 64 * (j))
#define XB_XGEN(j)  (2304 + 64 * (j))
#define XB_TOP      3328
#define XB_TOPGEN   3392
#define XCD_BAR_WORDS 3456
#define XB_SPIN_CAP (1u << 18)
__device__ __forceinline__ unsigned xb_ld(unsigned* p)              { return __hip_atomic_load(p, __ATOMIC_RELAXED, __HIP_MEMORY_SCOPE_AGENT); }
__device__ __forceinline__ unsigned xb_add(unsigned* p, unsigned v) { return __hip_atomic_fetch_add(p, v, __ATOMIC_RELAXED, __HIP_MEMORY_SCOPE_AGENT); }
__device__ __forceinline__ unsigned xb_xcc_id() { return (unsigned)__builtin_amdgcn_s_getreg((3 << 11) | 20) & 0xFu; }
#define XB_SPIN(cond, bar) do { unsigned _sp = 0; while (cond) { __builtin_amdgcn_s_sleep(1); \
    if ((++_sp & 255u) == 0u) { if (xb_ld(&(bar)[XB_TMO])) break; if (_sp > XB_SPIN_CAP) { atomicAdd(&(bar)[XB_TMO], 1u); break; } } } } while (0)
struct XcdBarrier { unsigned* bar; unsigned x; volatile LAS unsigned* st; };
__device__ __forceinline__ XcdBarrier xcd_barrier_post(unsigned* bar, volatile LAS unsigned* st) {
    XcdBarrier b; b.bar = bar; b.x = xb_xcc_id(); b.st = st;
    if (threadIdx.x == 0) (void)xb_add(&bar[XB_XCNT(b.x)], 1u);
    return b;
}
__device__ __forceinline__ void xcd_barrier_complete(unsigned* bar, unsigned x, unsigned& nloc, unsigned& nx) {
    const unsigned G = gridDim.x * gridDim.y * gridDim.z;
    unsigned sum, cnt, mine, sp = 0u;
    for (;;) {
        sum = 0u; cnt = 0u; mine = 0u;
#pragma unroll
        for (unsigned j = 0; j < 16; ++j) { const unsigned c = xb_ld(&bar[XB_XCNT(j)]); sum += c; cnt += (c > 0u) ? 1u : 0u; mine = (j == x) ? c : mine; }
        if (sum == G) break;
        __builtin_amdgcn_s_sleep(1);
        if ((++sp & 255u) == 0u) { if (xb_ld(&bar[XB_TMO])) break; if (sp > XB_SPIN_CAP) { atomicAdd(&bar[XB_TMO], 1u); break; } }
    }
    nloc = mine > 0u ? mine : 1u; nx = cnt > 0u ? cnt : 1u;
}
__device__ __forceinline__ void xcd_barrier(const XcdBarrier& b) {
    asm volatile("s_waitcnt vmcnt(0)" ::: "memory");
    __syncthreads();
    if (threadIdx.x == 0) {
        unsigned* bar = b.bar;
        __builtin_amdgcn_s_waitcnt(0);
        unsigned nloc = b.st[0], nx = b.st[1];
        if (nloc == 0u) { xcd_barrier_complete(bar, b.x, nloc, nx); b.st[0] = nloc; b.st[1] = nx; }
        const unsigned old = xb_add(&bar[XB_XSUB(b.x)], 1u);
        const unsigned gen = old / nloc;
        if (old + 1u == (gen + 1u) * nloc) {
            __builtin_amdgcn_fence(__ATOMIC_RELEASE, "agent");
            asm volatile("s_waitcnt vmcnt(0)" ::: "memory");
            const unsigned og = xb_add(&bar[XB_TOP], 1u);
            const unsigned tg = og / nx;
            if (og + 1u == (tg + 1u) * nx) xb_add(&bar[XB_TOPGEN], 1u);
            else XB_SPIN(xb_ld(&bar[XB_TOPGEN]) == tg, bar);
            __builtin_amdgcn_fence(__ATOMIC_ACQUIRE, "agent");
            xb_add(&bar[XB_XGEN(b.x)], 1u);
            asm volatile("s_waitcnt vmcnt(0)" ::: "memory");
        } else {
            XB_SPIN(xb_ld(&bar[XB_XGEN(b.x)]) == gen, bar);
            __builtin_amdgcn_fence(__ATOMIC_ACQUIRE, "agent");
            asm volatile("s_waitcnt vmcnt(0)" ::: "memory");
        }
    }
    __syncthreads();
}

namespace pg8 {
constexpr int BM = 256, BK = 64, HALF = 128, HTB = HALF * BK * 2, STAGE_BYTES = 8 * HTB;
__host__ __device__ __forceinline__ int lds_byte(int r, int c) { const int st = (r >> 4) * 2 + (c >> 5), rr = r & 15, cc = c & 31, ob = rr * 64 + cc * 2; return st * 1024 + (ob ^ (((ob >> 9) & 1) << 5)); }
__host__ __device__ __forceinline__ void stage_rc(int b, int& R, int& C) { const int st = b / 1024, sb = b % 1024, swz = sb ^ (((sb >> 9) & 1) << 5); R = (st >> 1) * 16 + swz / 64; C = (st & 1) * 32 + (swz % 64) / 2; }
__host__ __device__ __forceinline__ int perm32(int rho) { const int n = rho >> 4, i = rho & 15; return 8 * (i >> 2) + 4 * n + (i & 3); }
struct Unit { int pm, pn, e; };
__device__ __forceinline__ unsigned cvt_pk_bf16(float lo, float hi) { unsigned r; asm volatile("v_cvt_pk_bf16_f32 %0, %1, %2" : "=v"(r) : "v"(lo), "v"(hi)); return r; }

typedef int v8i32 __attribute__((ext_vector_type(8)));
typedef int v4i32 __attribute__((ext_vector_type(4)));
__device__ __forceinline__ v8i32 cat16(const bf16x8 lo, const bf16x8 hi) { return __builtin_shufflevector(__builtin_bit_cast(v4i32, lo), __builtin_bit_cast(v4i32, hi), 0, 1, 2, 3, 4, 5, 6, 7); }
template <class Epi, class Sched, bool FP8 = false>
__device__ __forceinline__ void gemm_phase(LAS unsigned char* lds, const int K, const Sched& S, const Epi& E) {
    const int tid = threadIdx.x, wid = __builtin_amdgcn_readfirstlane(tid >> 6), lane = tid & 63, wr = wid >> 2, wc = wid & 3, fr = lane & 15, fq = lane >> 4;
    const int nt = K / BK;
    int tidv = tid;
#define PG8_VB(i) ([&]() -> unsigned { int R_, C_; stage_rc(tidv * 16 + (i) * 8192, R_, C_); const int Rb_ = Epi::PERM ? ((R_ & ~31) + perm32(R_ & 31)) : R_; return (unsigned)(Rb_ * K + C_) * 2u; }())
#define PG8_VA(h, i) ([&]() -> unsigned { int R_, C_; stage_rc(tidv * 16 + (i) * 8192, R_, C_); return (unsigned)((128 * (h) + R_) * K + C_) * 2u; }())
    const size_t kstep = (size_t)(BK * 2);
    const size_t hstep = (size_t)HALF * K * 2;
    const unsigned ldsw = (unsigned)wid * 1024u;
#define aoff (lds_byte(wr * 64 + (tidv & 15), ((tidv >> 4) & 3) * 8))
#define boff (lds_byte(wc * 32 + (tidv & 15), ((tidv >> 4) & 3) * 8))
#define PG8_SA(b, h) (((b) * 2 + (h)) * HTB)
#define PG8_SB(b, h) ((4 + (b) * 2 + (h)) * HTB)
#define PG8_STAGEB(bufoff, gbase) do { _Pragma("unroll") for (int _i = 0; _i < 2; ++_i) \
        __builtin_amdgcn_global_load_lds((const unsigned*)((const char*)(gbase) + PG8_VB(_i)), (LAS unsigned*)(lds + (bufoff) + ldsw + _i * 8192), 16, 0, 0); } while (0)
#define PG8_STAGEA(bufoff, gbase, h, NEXT) do { _Pragma("unroll") for (int _i = 0; _i < 2; ++_i) { unsigned vo_; \
        if constexpr (Sched::GATHER) { int R_, C_; stage_rc(tidv * 16 + _i * 8192, R_, C_); const unsigned raw_ = gidx[((((NEXT) && usen) ? (gslot ^ 1u) : gslot) * 4u + (h) * 2 + _i) * 512u + tid]; vo_ = (raw_ * (unsigned)K + (unsigned)C_) * 2u; } \
        else vo_ = PG8_VA(h, _i); \
        __builtin_amdgcn_global_load_lds((const unsigned*)((const char*)(gbase) + vo_), (LAS unsigned*)(lds + (bufoff) + ldsw + _i * 8192), 16, 0, 0); } } while (0)
#define PG8_LDA(dst, b, h) do { _Pragma("unroll") for (int m = 0; m < 4; ++m) _Pragma("unroll") for (int k = 0; k < 2; ++k) dst[m][k] = *(const LAS bf16x8*)(lds + PG8_SA(b, h) + aoff + m * 2048 + k * 1024); } while (0)
#define PG8_LDB(dst, b, h) do { _Pragma("unroll") for (int n = 0; n < 2; ++n) _Pragma("unroll") for (int k = 0; k < 2; ++k) dst[n][k] = *(const LAS bf16x8*)(lds + PG8_SB(b, h) + boff + n * 2048 + k * 1024); } while (0)
#define PG8_MMA(ai, bj, At, Bt) do { __builtin_amdgcn_s_setprio(1); _Pragma("unroll") for (int m = 0; m < 4; ++m) _Pragma("unroll") for (int n = 0; n < 2; ++n) { \
        if constexpr (FP8) acc[ai][bj][m][n] = __builtin_amdgcn_mfma_scale_f32_16x16x128_f8f6f4(cat16(Bt[n][0], Bt[n][1]), cat16(At[m][0], At[m][1]), acc[ai][bj][m][n], 0, 0, 0, 0x7f7f7f7f, 0, 0x7f7f7f7f); \
        else { _Pragma("unroll") for (int k = 0; k < 2; ++k) acc[ai][bj][m][n] = __builtin_amdgcn_mfma_f32_16x16x32_bf16(Bt[n][k], At[m][k], acc[ai][bj][m][n], 0, 0, 0); } } \
        __builtin_amdgcn_s_setprio(0); } while (0)
#define PG8_WAIT_V(n) asm volatile("s_waitcnt vmcnt(" #n ")" ::: "memory")
#define PG8_WAIT_L(n) asm volatile("s_waitcnt lgkmcnt(" #n ")" ::: "memory")
#define PG8_BAR __builtin_amdgcn_s_barrier()
#define PG8_SCHED __builtin_amdgcn_sched_barrier(0)
#define PG8_ITER(A1, A2, A3, B2, B3) do { \
            PG8_LDB(B0, 0, 0); PG8_LDB(B1, 0, 1); PG8_SCHED; PG8_LDA(At, 0, 0); PG8_STAGEA(PG8_SA(1, 1), A1, 1, 0); \
            PG8_WAIT_V(8); PG8_WAIT_L(0); PG8_BAR; PG8_MMA(0, 0, At, B0); PG8_MMA(0, 1, At, B1); PG8_BAR; PG8_SCHED; \
            PG8_LDA(At, 0, 1); PG8_STAGEB(PG8_SB(0, 0), B2); PG8_STAGEB(PG8_SB(0, 1), (B2) + hstep); PG8_STAGEA(PG8_SA(0, 0), A2, 0, 1); \
            PG8_WAIT_V(8); PG8_WAIT_L(0); PG8_BAR; PG8_MMA(1, 0, At, B0); PG8_MMA(1, 1, At, B1); PG8_BAR; PG8_SCHED; \
            PG8_LDB(B0, 1, 0); PG8_LDB(B1, 1, 1); PG8_SCHED; PG8_LDA(At, 1, 0); PG8_STAGEA(PG8_SA(0, 1), A2, 1, 1); \
            PG8_WAIT_V(8); PG8_WAIT_L(0); PG8_BAR; PG8_MMA(0, 0, At, B0); PG8_MMA(0, 1, At, B1); PG8_BAR; PG8_SCHED; \
            PG8_LDA(At, 1, 1); PG8_STAGEB(PG8_SB(1, 0), B3); PG8_STAGEB(PG8_SB(1, 1), (B3) + hstep); PG8_STAGEA(PG8_SA(1, 0), A3, 0, 1); \
            PG8_WAIT_V(8); PG8_WAIT_L(0); PG8_BAR; PG8_MMA(1, 0, At, B0); PG8_MMA(1, 1, At, B1); PG8_BAR; PG8_SCHED; } while (0)
    Unit cur, nxt; int ui = 0;
    if (!S.next(0, cur)) return;
    f32x4 acc[2][2][4][2];
#pragma unroll
    for (int a = 0; a < 2; ++a)
#pragma unroll
        for (int b = 0; b < 2; ++b)
#pragma unroll
            for (int m = 0; m < 4; ++m)
#pragma unroll
                for (int n = 0; n < 2; ++n) acc[a][b][m][n] = (f32x4){0.f, 0.f, 0.f, 0.f};
    bf16x8 At[4][2], B0[2][2], B1[2][2];
    const LAS unsigned* gidx = (const LAS unsigned*)(lds + LDS_GIDX); unsigned gslot = 0u;
    if constexpr (Sched::GATHER) { S.idx_dma(cur, (LAS unsigned*)(lds + LDS_GIDX), tidv, wid); asm volatile("s_waitcnt vmcnt(0)" ::: "memory"); }
    const char* cA = S.a_base(cur); const char* cB = S.b_base(cur);
    constexpr bool usen = false;
    PG8_STAGEB(PG8_SB(0, 0), cB); PG8_STAGEB(PG8_SB(0, 1), cB + hstep); PG8_STAGEA(PG8_SA(0, 0), cA, 0, 0); PG8_STAGEA(PG8_SA(0, 1), cA, 1, 0);
    if (wr == 1) PG8_BAR;
    PG8_WAIT_V(2); PG8_BAR;
    PG8_STAGEB(PG8_SB(1, 0), cB + kstep); PG8_STAGEA(PG8_SA(1, 0), cA + kstep, 0, 0); PG8_STAGEB(PG8_SB(1, 1), cB + hstep + kstep);
    PG8_WAIT_V(6); PG8_BAR;
    for (;;) {
        const bool has_next = S.next(ui + 1, nxt);
        const char* nA = has_next ? S.a_base(nxt) : cA; const char* nB = has_next ? S.b_base(nxt) : cB;
#pragma unroll 1
        for (int t = 0; t < nt; t += 2) {
            const bool last = (t == nt - 2);
            const char* a1 = cA + (size_t)(t + 1) * kstep;
            const char* a2 = last ? nA : cA + (size_t)(t + 2) * kstep; const char* b2 = last ? nB : cB + (size_t)(t + 2) * kstep;
            tidv = tid; asm volatile("" : "+v"(tidv));
            if constexpr (Sched::GATHER) {
                if (t == nt - 4 && has_next) S.idx_dma(nxt, (LAS unsigned*)(lds + LDS_GIDX) + (gslot ^ 1u) * 2048u, tidv, wid);
            }
            const bool usen = last && has_next;
            PG8_ITER(a1, a2, a2 + kstep, b2, b2 + kstep);
        }
        if (wr == 0) PG8_BAR;
        E(acc, cur, wr, wc, fr, fq);
        if (!has_next) break;
#pragma unroll
        for (int a = 0; a < 2; ++a)
#pragma unroll
            for (int b = 0; b < 2; ++b)
#pragma unroll
                for (int m = 0; m < 4; ++m)
#pragma unroll
                    for (int n = 0; n < 2; ++n) acc[a][b][m][n] = (f32x4){0.f, 0.f, 0.f, 0.f};
        cur = nxt; cA = nA; cB = nB; ++ui;
        if constexpr (Sched::GATHER) gslot ^= 1u;
        if (wr == 1) PG8_BAR;
    }
    PG8_WAIT_V(0);
    PG8_BAR;
#undef PG8_ITER
#undef aoff
#undef boff
#undef PG8_SA
#undef PG8_SB
#undef PG8_STAGEA
#undef PG8_STAGEB
#undef PG8_VA
#undef PG8_VB
#undef PG8_LDA
#undef PG8_LDB
#undef PG8_MMA
#undef PG8_WAIT_V
#undef PG8_WAIT_L
#undef PG8_BAR
#undef PG8_SCHED
}

struct SchedDense {
    static constexpr bool GATHER = false;
    const char* A; const char* Bt; int K, nN, nMfull, pnx, nUnits, c, G;
    __device__ __forceinline__ bool next(int i, Unit& u) const {
        const int L = i * G + c; if (L >= nUnits) return false;
        const int full = nMfull * nN;
        if (L < full) { u.pm = L / nN; u.pn = L - u.pm * nN; } else { u.pm = nMfull + (L - full); u.pn = pnx; }
        u.e = 0; return true;
    }
    __device__ __forceinline__ const char* a_base(const Unit& u) const { return A + (size_t)u.pm * 256 * K * 2; }
    __device__ __forceinline__ const char* b_base(const Unit& u) const { return Bt + (size_t)u.pn * 256 * K * 2; }
};
struct SchedSplit {
    static constexpr bool GATHER = false;
    const char* A; const char* Bt; int K, base, stride, n;
    __device__ __forceinline__ bool next(int i, Unit& u) const {
        if (i >= n) return false;
        const int L = base + i * stride; u.pm = L >> 2; u.pn = L & 3; u.e = 0; return true;
    }
    __device__ __forceinline__ const char* a_base(const Unit& u) const { return A + (size_t)u.pm * 256 * K * 2; }
    __device__ __forceinline__ const char* b_base(const Unit& u) const { return Bt + (size_t)u.pn * 256 * K * 2; }
};
template <bool GATHER_> struct SchedMoe {
    static constexpr bool GATHER = GATHER_, gather = GATHER_;
    const char* A; const char* W; const int* tokmap; const LAS int* tb; const LAS int* cn; int K; size_t wstride; int nUnits, c, G;
    __device__ __forceinline__ bool next(int i, Unit& u) const {
        const int L = i * G + c; if (L >= nUnits) return false;
        u.pm = L >> 2; u.pn = L & 3; int e = 0;
#pragma unroll
        for (int q = 1; q < 16; ++q) if (u.pm >= __builtin_amdgcn_readfirstlane(tb[q])) e = q;
        u.e = __builtin_amdgcn_readfirstlane(e); return true;
    }
    __device__ __forceinline__ const char* a_base(const Unit& u) const { return gather ? A : A + (size_t)u.pm * 256 * K * 2; }
    __device__ __forceinline__ const char* b_base(const Unit& u) const { return W + (size_t)u.e * wstride + (size_t)u.pn * 256 * K * 2; }
    __device__ __forceinline__ void idx_dma(const Unit& u, LAS unsigned* slot, int tidv, int wid) const {
        const int p0 = (u.pm - __builtin_amdgcn_readfirstlane(tb[u.e])) * 256, last = __builtin_amdgcn_readfirstlane(cn[u.e]) - 1; const int* tm = tokmap + (size_t)u.e * T;
#pragma unroll
        for (int h = 0; h < 2; ++h)
#pragma unroll
            for (int i = 0; i < 2; ++i) { int R_, C_; stage_rc(tidv * 16 + i * 8192, R_, C_); int pos = p0 + 128 * h + R_; pos = pos < last ? pos : last;
                __builtin_amdgcn_global_load_lds((const unsigned*)(tm + pos), slot + (h * 2 + i) * 512 + wid * 64, 4, 0, 0); }
    }
};

struct EpiStore {
    static constexpr bool PERM = true;
    bf16* O; int ldc;
    __device__ __forceinline__ void operator()(const f32x4 (&acc)[2][2][4][2], const Unit& u, int wr, int wc, int fr, int fq) const {
        const int row0 = u.pm * BM + wr * 64 + fr, col0 = u.pn * BM + wc * 32 + 8 * fq;
#pragma unroll
        for (int ai = 0; ai < 2; ++ai)
#pragma unroll
            for (int m = 0; m < 4; ++m) { bf16* rowp = O + (size_t)(row0 + ai * HALF + m * 16) * ldc + col0;
#pragma unroll
                for (int bj = 0; bj < 2; ++bj) { const f32x4 v0 = acc[ai][bj][m][0], v1 = acc[ai][bj][m][1];
                    u32x4 w; w.x = cvt_pk_bf16(v0[0], v0[1]); w.y = cvt_pk_bf16(v0[2], v0[3]); w.z = cvt_pk_bf16(v1[0], v1[1]); w.w = cvt_pk_bf16(v1[2], v1[3]);
                    *(u32x4*)(rowp + bj * HALF) = w; } }
    }
};
template <bool SRC_F32> struct EpiResid {
    static constexpr bool PERM = true;
    const float* srcL; const float* srcC; bf16* H; const float* gate;
    __device__ __forceinline__ void operator()(const f32x4 (&acc)[2][2][4][2], const Unit& u, int wr, int wc, int fr, int fq) const {
        const float* g = gate + (u.pm < 128 ? (u.pm >> 4) : 8) * 6144;
        const float* src = (u.pm < 128) ? srcL + (size_t)u.pm * 256 * 1024 : srcC + (size_t)(u.pm - 128) * 256 * 1024;
        bf16* dst = H + (size_t)u.pm * 256 * 1024;
        const int row0 = wr * 64 + fr, col0 = u.pn * BM + wc * 32 + 8 * fq;
        f32x4 gv[2][2];
#pragma unroll
        for (int bj = 0; bj < 2; ++bj)
#pragma unroll
            for (int n = 0; n < 2; ++n) gv[bj][n] = *(const f32x4*)(g + col0 + bj * HALF + 4 * n);
#pragma unroll
        for (int ai = 0; ai < 2; ++ai)
#pragma unroll
            for (int m = 0; m < 4; ++m) { const size_t ro = (size_t)(row0 + ai * HALF + m * 16) * 1024 + col0;
#pragma unroll
                for (int bj = 0; bj < 2; ++bj) {
                    f32x4 s0, s1;
                    if constexpr (SRC_F32) { s0 = __builtin_nontemporal_load((const f32x4*)(src + ro + bj * HALF)); s1 = __builtin_nontemporal_load((const f32x4*)(src + ro + bj * HALF + 4)); }
                    else { const u32x4 hv = *(const u32x4*)(dst + ro + bj * HALF); s0 = (f32x4){bflo(hv.x), bfhi(hv.x), bflo(hv.y), bfhi(hv.y)}; s1 = (f32x4){bflo(hv.z), bfhi(hv.z), bflo(hv.w), bfhi(hv.w)}; }
                    const f32x4 v0 = s0 + gv[bj][0] * acc[ai][bj][m][0], v1 = s1 + gv[bj][1] * acc[ai][bj][m][1];
                    u32x4 w; w.x = cvt_pk_bf16(v0[0], v0[1]); w.y = cvt_pk_bf16(v0[2], v0[3]); w.z = cvt_pk_bf16(v1[0], v1[1]); w.w = cvt_pk_bf16(v1[2], v1[3]);
                    *(u32x4*)(dst + ro + bj * HALF) = w; } }
    }
};
__device__ __forceinline__ float silu_f(float x) { return x * __builtin_amdgcn_rcpf(1.0f + __expf(-x)); }
struct EpiSwiglu {
    static constexpr bool PERM = true;
    bf16* H;
    __device__ __forceinline__ void operator()(const f32x4 (&acc)[2][2][4][2], const Unit& u, int wr, int wc, int fr, int fq) const {
        const int row0 = u.pm * BM + wr * 64 + fr, col0 = u.pn * 128 + wc * 32 + 8 * fq;
#pragma unroll
        for (int ai = 0; ai < 2; ++ai)
#pragma unroll
            for (int m = 0; m < 4; ++m) { bf16* p = H + (size_t)(row0 + ai * HALF + m * 16) * 512 + col0;
                const f32x4 g0 = acc[ai][0][m][0], g1 = acc[ai][0][m][1], u0 = acc[ai][1][m][0], u1 = acc[ai][1][m][1];
                u32x4 w; w.x = cvt_pk_bf16(silu_f(g0[0]) * u0[0], silu_f(g0[1]) * u0[1]); w.y = cvt_pk_bf16(silu_f(g0[2]) * u0[2], silu_f(g0[3]) * u0[3]);
                w.z = cvt_pk_bf16(silu_f(g1[0]) * u1[0], silu_f(g1[1]) * u1[1]); w.w = cvt_pk_bf16(silu_f(g1[2]) * u1[2], silu_f(g1[3]) * u1[3]);
                *(u32x4*)p = w; }
    }
};
__device__ __forceinline__ unsigned pk4_fp8(float a, float b, float c, float d) { int p = __builtin_amdgcn_cvt_pk_fp8_f32(a, b, 0, false); p = __builtin_amdgcn_cvt_pk_fp8_f32(c, d, p, true); return (unsigned)p; }
constexpr float W1_SCALE = 32.0f, W2_SCALE = 16.0f, HID_SCALE = 4.0f;
struct EpiSwiglu8 {
    static constexpr bool PERM = true;
    unsigned char* H; float in_scale;
    __device__ __forceinline__ void operator()(const f32x4 (&acc)[2][2][4][2], const Unit& u, int wr, int wc, int fr, int fq) const {
        const int row0 = u.pm * BM + wr * 64 + fr, col0 = u.pn * 128 + wc * 32 + 8 * fq;
        const float IS = 1.0f / in_scale, OS = HID_SCALE / in_scale;
#pragma unroll
        for (int ai = 0; ai < 2; ++ai)
#pragma unroll
            for (int m = 0; m < 4; ++m) { unsigned char* p = H + (size_t)(row0 + ai * HALF + m * 16) * 512 + col0;
                const f32x4 g0 = acc[ai][0][m][0] * IS, g1 = acc[ai][0][m][1] * IS, u0 = acc[ai][1][m][0] * OS, u1 = acc[ai][1][m][1] * OS;
#define HC8(x) __builtin_fminf(__builtin_fmaxf((x), -448.0f), 448.0f)
                u32x2 w; w.x = pk4_fp8(HC8(silu_f(g0[0]) * u0[0]), HC8(silu_f(g0[1]) * u0[1]), HC8(silu_f(g0[2]) * u0[2]), HC8(silu_f(g0[3]) * u0[3]));
                w.y = pk4_fp8(HC8(silu_f(g1[0]) * u1[0]), HC8(silu_f(g1[1]) * u1[1]), HC8(silu_f(g1[2]) * u1[2]), HC8(silu_f(g1[3]) * u1[3]));
#undef HC8
                *(u32x2*)p = w; }
    }
};
struct EpiStoreS {
    static constexpr bool PERM = true;
    bf16* O; int ldc; float scale;
    __device__ __forceinline__ void operator()(const f32x4 (&acc)[2][2][4][2], const Unit& u, int wr, int wc, int fr, int fq) const {
        const int row0 = u.pm * BM + wr * 64 + fr, col0 = u.pn * BM + wc * 32 + 8 * fq;
#pragma unroll
        for (int ai = 0; ai < 2; ++ai)
#pragma unroll
            for (int m = 0; m < 4; ++m) { bf16* rowp = O + (size_t)(row0 + ai * HALF + m * 16) * ldc + col0;
#pragma unroll
                for (int bj = 0; bj < 2; ++bj) { const f32x4 v0 = acc[ai][bj][m][0] * scale, v1 = acc[ai][bj][m][1] * scale;
                    u32x4 w; w.x = cvt_pk_bf16(v0[0], v0[1]); w.y = cvt_pk_bf16(v0[2], v0[3]); w.z = cvt_pk_bf16(v1[0], v1[1]); w.w = cvt_pk_bf16(v1[2], v1[3]);
                    *(u32x4*)(rowp + bj * HALF) = w; } }
    }
};
struct EpiScaleRow {
    static constexpr bool PERM = true;
    bf16* O; const float* wrow;
    __device__ __forceinline__ void operator()(const f32x4 (&acc)[2][2][4][2], const Unit& u, int wr, int wc, int fr, int fq) const {
        const int row0 = u.pm * BM + wr * 64 + fr, col0 = u.pn * BM + wc * 32 + 8 * fq;
#pragma unroll
        for (int ai = 0; ai < 2; ++ai)
#pragma unroll
            for (int m = 0; m < 4; ++m) { const int row = row0 + ai * HALF + m * 16; const float s = wrow[row]; bf16* rowp = O + (size_t)row * 1024 + col0;
#pragma unroll
                for (int bj = 0; bj < 2; ++bj) { const f32x4 v0 = acc[ai][bj][m][0] * s, v1 = acc[ai][bj][m][1] * s;
                    u32x4 w; w.x = cvt_pk_bf16(v0[0], v0[1]); w.y = cvt_pk_bf16(v0[2], v0[3]); w.z = cvt_pk_bf16(v1[0], v1[1]); w.w = cvt_pk_bf16(v1[2], v1[3]);
                    *(u32x4*)(rowp + bj * HALF) = w; } }
    }
};
}

struct Args { const float* in[22]; float* out; unsigned char* ws; int ph_lo, ph_hi; };
enum { I_X = 0, I_C, I_CTX, I_CCTX, I_ADAW, I_ADAB, I_NMG, I_NFG, I_EWIN, I_ECONV, I_EWOUT, I_OWIN, I_OPOOLW, I_OPOOLS, I_OSINK, I_OWOUT, I_RW, I_RB, I_MG, I_MU, I_MD, I_FG };

struct Frame {
    LAS unsigned char* lds;
    int tid, lane, wave, vcu, G;
    unsigned char* ws; const float* const* in; float* out;
};
__device__ __forceinline__ bf16* h_row(const Frame& F, int t) { return (bf16*)(F.ws + WS_HB) + (size_t)t * D; }
__device__ __forceinline__ int mod_row(int t) { return t < TL ? (t >> 12) : 8; }

struct TItem { const float* src; bf16* dst; int ldw, ldd; float f8scale; };
__device__ __forceinline__ void titem_load(const TItem& t, f32x4 (&r)[8], int lane) {
#pragma unroll
    for (int i = 0; i < 8; ++i) r[i] = __builtin_nontemporal_load((const f32x4*)(t.src + (size_t)((lane >> 3) + 8 * i) * t.ldw + 4 * (lane & 7)));
}
__device__ __forceinline__ void titem_process(const TItem& t, const f32x4 (&r)[8], LAS float* scr, int lane) {
#pragma unroll
    for (int i = 0; i < 8; ++i) { LAS float* d = scr + ((lane >> 3) + 8 * i) * 33 + 4 * (lane & 7); d[0] = r[i].x; d[1] = r[i].y; d[2] = r[i].z; d[3] = r[i].w; }
    LDS_WAIT(); asm volatile("" ::: "memory");
    const int c = lane & 7;
    if (t.f8scale != 0.0f) {
        const float sc = t.f8scale; unsigned char* d8 = (unsigned char*)t.dst;
#pragma unroll
        for (int j = 0; j < 4; ++j) { const int n = (lane >> 3) + 8 * j; const LAS float* s = scr + (8 * c) * 33 + n;
            u32x2 o; o.x = pg8::pk4_fp8(s[0 * 33] * sc, s[1 * 33] * sc, s[2 * 33] * sc, s[3 * 33] * sc); o.y = pg8::pk4_fp8(s[4 * 33] * sc, s[5 * 33] * sc, s[6 * 33] * sc, s[7 * 33] * sc);
            *(u32x2*)(d8 + (size_t)n * t.ldd + 8 * c) = o; }
    } else {
#pragma unroll
        for (int j = 0; j < 4; ++j) { const int n = (lane >> 3) + 8 * j; const LAS float* s = scr + (8 * c) * 33 + n;
            u32x4 o; o.x = pk2(s[0 * 33], s[1 * 33]); o.y = pk2(s[2 * 33], s[3 * 33]); o.z = pk2(s[4 * 33], s[5 * 33]); o.w = pk2(s[6 * 33], s[7 * 33]);
            *(u32x4*)(t.dst + (size_t)n * t.ldd + 8 * c) = o; }
    }
    LDS_WAIT(); asm volatile("" ::: "memory");
}
constexpr int TS0 = 1024, TS1 = 512, TS2 = 384, TS3 = 512, TS4 = 0, TS5 = 4096, TS6 = 4096, TS7 = 4096, TNITEMS = TS0 + TS1 + TS2 + TS3 + TS4 + TS5 + TS6 + TS7;
__device__ __forceinline__ TItem titem_moe(const float* const* in, unsigned char* ws, int kind, int le, int rr) {
    TItem t; const int layer = le >> 4, e = le & 15; const bool f8 = (kind < 2) ? (layer ? (FP8_G1_L1 != 0) : (FP8_G1_L0 != 0)) : (layer ? (FP8_G2_L1 != 0) : (FP8_G2_L0 != 0));
    if (kind < 2) { const int kb = (rr >> 4) & 15, nb = rr & 15, n0 = nb * 32; const int drow = (n0 >> 7) * 256 + (n0 & 127) + kind * 128;
        t.src = in[kind ? I_MU : I_MG] + (size_t)le * 524288 + (size_t)(kb * 64) * 512 + n0; t.ldw = 512;
        unsigned char* base = ws + WS_W_M1 + (size_t)layer * 32 * MiB;
        if (f8) { t.dst = (bf16*)(base + (size_t)e * MiB + (size_t)drow * 1024 + kb * 64); t.ldd = 1024; t.f8scale = pg8::W1_SCALE; }
        else { t.dst = (bf16*)(base + (size_t)e * 2 * MiB) + (size_t)drow * 1024 + kb * 64; t.ldd = 1024; t.f8scale = 0.0f; } }
    else { const int kb = (rr >> 5) & 7, nb = rr & 31;
        t.src = in[I_MD] + (size_t)le * 524288 + (size_t)(kb * 64) * 1024 + nb * 32; t.ldw = 1024;
        unsigned char* base = ws + WS_W_M2 + (size_t)layer * 16 * MiB;
        if (f8) { t.dst = (bf16*)(base + (size_t)e * 512 * KiB + (size_t)(nb * 32) * 512 + kb * 64); t.ldd = 512; t.f8scale = pg8::W2_SCALE; }
        else { t.dst = (bf16*)(base + (size_t)e * MiB) + (size_t)(nb * 32) * 512 + kb * 64; t.ldd = 512; t.f8scale = 0.0f; } }
    return t;
}
__device__ __forceinline__ TItem titem_decode(const float* const* in, unsigned char* ws, int r) {
    TItem t;
    if (r < TS0) { const int kb = r / 64, nb = r % 64; t.src = in[I_EWIN] + (size_t)(kb * 64) * 2048 + nb * 32; t.ldw = 2048; t.dst = (bf16*)(ws + WS_W_EIN) + (size_t)(nb * 32) * 1024 + kb * 64; t.ldd = 1024; t.f8scale = 0.0f; return t; } r -= TS0;
    if (r < TS1) { const int kb = r / 32, nb = r % 32; t.src = in[I_EWOUT] + (size_t)(kb * 64) * 1024 + nb * 32; t.ldw = 1024; t.dst = (bf16*)(ws + WS_W_EOUT) + (size_t)(nb * 32) * 1024 + kb * 64; t.ldd = 1024; t.f8scale = 0.0f; return t; } r -= TS1;
    if (r < TS2) { const int kb = r / 24, nb = 16 + r % 24; t.src = in[I_OWIN] + (size_t)(kb * 64) * 1280 + nb * 32; t.ldw = 1280; t.dst = (bf16*)(ws + WS_W_OIN) + (size_t)(nb * 32) * 1024 + kb * 64; t.ldd = 1024; t.f8scale = 0.0f; return t; } r -= TS2;
    if (r < TS3) { const int kb = r / 32, nb = r % 32; t.src = in[I_OWOUT] + (size_t)(kb * 64) * 1024 + nb * 32; t.ldw = 1024; t.dst = (bf16*)(ws + WS_W_OOUT) + (size_t)(nb * 32) * 1024 + kb * 64; t.ldd = 1024; t.f8scale = 0.0f; return t; } r -= TS3;
    if (r < TS5 + TS6 + TS7) return titem_moe(in, ws, r / 4096, (r % 4096) >> 8, r % 256);
    return t;
}
constexpr int NL1 = 12288;
__device__ __forceinline__ TItem titem_l1(const float* const* in, unsigned char* ws, int r) { return titem_moe(in, ws, r / 4096, 16 + ((r % 4096) >> 8), r % 256); }

constexpr size_t WS_CONVCTR = 20 * KiB;
__device__ __forceinline__ void convert_l1(Frame& F, int quota) {
    unsigned* ctr = (unsigned*)(F.ws + WS_CONVCTR);
    LAS float* scr = (LAS float*)(F.lds + F.wave * 17408);
    for (int ch = 0; ch < quota; ++ch) {
        const int c0 = __builtin_amdgcn_readfirstlane(F.lane == 0 ? (int)__hip_atomic_fetch_add(ctr, 4u, __ATOMIC_RELAXED, __HIP_MEMORY_SCOPE_AGENT) : 0);
        if (c0 >= NL1) break;
        f32x4 cur[8], nxt[8];
        TItem tc = titem_l1(F.in, F.ws, c0);
        titem_load(tc, nxt, F.lane);
#pragma unroll 1
        for (int i = 0; i < 4; ++i) {
#pragma unroll
            for (int j = 0; j < 8; ++j) cur[j] = nxt[j];
            const TItem tcur = tc;
            if (i < 3) { tc = titem_l1(F.in, F.ws, c0 + i + 1); titem_load(tc, nxt, F.lane); }
            titem_process(tcur, cur, scr, F.lane);
        }
    }
}
__device__ __forceinline__ void convert_l1_range(Frame& F, const int base, const int cnt, const int ctr_off) {
    LAS unsigned* ctr = (LAS unsigned*)(F.lds + LDS_CTL + ctr_off);
    LAS float* scr = (LAS float*)(F.lds + F.wave * 17408);
    f32x4 cur[8], nxt[8];
    int it = __builtin_amdgcn_readfirstlane(F.lane == 0 ? (int)atomicAdd((unsigned*)ctr, 1u) : 0);
    TItem tc = titem_l1(F.in, F.ws, base + (it < cnt ? it : 0));
    if (it < cnt) titem_load(tc, nxt, F.lane);
    while (it < cnt) {
#pragma unroll
        for (int i = 0; i < 8; ++i) cur[i] = nxt[i];
        const TItem tcur = tc;
        const int itn = __builtin_amdgcn_readfirstlane(F.lane == 0 ? (int)atomicAdd((unsigned*)ctr, 1u) : 0);
        if (itn < cnt) { tc = titem_l1(F.in, F.ws, base + itn); titem_load(tc, nxt, F.lane); }
        titem_process(tcur, cur, scr, F.lane);
        it = itn;
    }
}
constexpr int L1T_N = 64, L1A_N = 18;
static_assert(120 * L1T_N + 256 * L1A_N == NL1, "layer-1 conversion split");
__device__ __forceinline__ void tail_fill(Frame& F, int nUnits, int quota) {
    const int rounds = (nUnits + F.G - 1) / F.G;
    if ((rounds - 1) * F.G + F.vcu >= nUnits) convert_l1(F, quota);
}

__device__ __forceinline__ void norm_mod_store(const f32x4 (&v)[4], const float* g, const float* shift, const float* scale, bf16* orow, int lane) {
    float s2 = 0.f;
#pragma unroll
    for (int j = 0; j < 4; ++j) s2 += (v[j].x * v[j].x + v[j].y * v[j].y) + (v[j].z * v[j].z + v[j].w * v[j].w);
    const float rstd = 1.0f / sqrtf(wave_sum(s2) * (1.0f / D) + EPS);
#pragma unroll
    for (int j = 0; j < 4; ++j) { const int c = 4 * lane + 256 * j;
        const f32x4 gg = *(const f32x4*)(g + c), sh = *(const f32x4*)(shift + c), sc = *(const f32x4*)(scale + c);
        const f32x4 y = v[j] * rstd * gg * (sc + 1.0f) + sh;
        u32x2 o; o.x = pk2(y.x, y.y); o.y = pk2(y.z, y.w);
        *(u32x2*)(orow + c) = o; }
}

template <int NQ> __device__ __forceinline__ void p1_tokens(Frame& F, int t) {
    const float* mods = (const float*)(F.ws + WS_MODS);
    bf16* A = (bf16*)(F.ws + WS_BUFA);
    f32x4 v[NQ][4];
#pragma unroll
    for (int q = 0; q < NQ; ++q) { const int tq = t + q; const float* xr = tq < TL ? F.in[I_X] + (size_t)tq * D : F.in[I_CTX] + (size_t)(tq - TL) * D;
#pragma unroll
        for (int j = 0; j < 4; ++j) v[q][j] = __builtin_nontemporal_load((const f32x4*)(xr + 4 * F.lane + 256 * j)); }
    const float* m = mods + (size_t)mod_row(t) * 6144;
#pragma unroll
    for (int q = 0; q < NQ; ++q) norm_mod_store(v[q], F.in[I_NMG], m, m + 1024, A + (size_t)(t + q) * D, F.lane);
}
__device__ __forceinline__ void phase_mods(Frame& F) {
    const float* const* in = F.in;
    LAS float* S = (LAS float*)F.lds;
    LAS float* red = S + 9 * 1024;
    for (int i = F.tid; i < 9 * 1024; i += 512) { const float v = (i < 8192) ? in[I_C][i] : in[I_CCTX][i - 8192]; S[i] = v / (1.0f + expf(-v)); }
    __syncthreads();
    const int bx = blockIdx.x, layer = bx >> 7, col0 = (bx & 127) * 48;
    const int j = F.tid % 12, rg = F.tid / 12;
    if (rg < 42) {
        const float* W = in[I_ADAW] + (size_t)layer * 1024 * 6144 + col0 + 4 * j;
        f32x4 w[25];
#pragma unroll
        for (int i = 0; i < 25; ++i) { const int k = rg + 42 * i; w[i] = (k < 1024) ? __builtin_nontemporal_load((const f32x4*)(W + (size_t)k * 6144)) : (f32x4){0.f, 0.f, 0.f, 0.f}; }
        f32x4 acc[9];
#pragma unroll
        for (int r = 0; r < 9; ++r) acc[r] = (f32x4){0.f, 0.f, 0.f, 0.f};
#pragma unroll
        for (int i = 0; i < 25; ++i) { const int k = min(rg + 42 * i, 1023);
#pragma unroll
            for (int r = 0; r < 9; ++r) acc[r] += w[i] * S[r * 1024 + k]; }
#pragma unroll
        for (int r = 0; r < 9; ++r) *(LAS f32x4*)(red + (rg * 9 + r) * 48 + 4 * j) = acc[r];
    }
    __syncthreads();
    for (int i = F.tid; i < 432; i += 512) { const int r = i / 48, c = i % 48; float sum = in[I_ADAB][layer * 6144 + col0 + c];
        for (int g = 0; g < 42; ++g) sum += red[(g * 9 + r) * 48 + c];
        __hip_atomic_store((unsigned*)(F.ws + WS_MODS) + (layer * 9 + r) * 6144 + col0 + c, __builtin_bit_cast(unsigned, sum), __ATOMIC_RELAXED, __HIP_MEMORY_SCOPE_AGENT); }
    asm volatile("s_waitcnt vmcnt(0)" ::: "memory");
    __syncthreads();
    if (F.tid == 0) __hip_atomic_fetch_add((unsigned*)(F.ws + WS_MODSDONE), 1u, __ATOMIC_RELAXED, __HIP_MEMORY_SCOPE_AGENT);
}
__device__ __forceinline__ void mods_wait(Frame& F) {
    if (F.tid < 64) {
        unsigned* cnt = (unsigned*)(F.ws + WS_MODSDONE); unsigned spins = 0;
        while ((unsigned)__builtin_amdgcn_readfirstlane(__hip_atomic_load(cnt, __ATOMIC_RELAXED, __HIP_MEMORY_SCOPE_AGENT)) < (unsigned)F.G) {
            __builtin_amdgcn_s_sleep(2); if (++spins > (1u << 22)) break; }
        __builtin_amdgcn_fence(__ATOMIC_ACQUIRE, "agent");
        asm volatile("s_waitcnt vmcnt(0)" ::: "memory");
    }
    __syncthreads();
}

__device__ __forceinline__ void ctr_publish(Frame& F, size_t off) {
    asm volatile("s_waitcnt vmcnt(0)" ::: "memory");
    __syncthreads();
    if (F.tid == 0) { __builtin_amdgcn_fence(__ATOMIC_RELEASE, "agent"); asm volatile("s_waitcnt vmcnt(0)" ::: "memory");
        __hip_atomic_fetch_add((unsigned*)(F.ws + off), 1u, __ATOMIC_RELAXED, __HIP_MEMORY_SCOPE_AGENT); }
}
__device__ __forceinline__ void ctr_wait(Frame& F, size_t off, unsigned need) {
    if (F.tid < 64) {
        unsigned* cnt = (unsigned*)(F.ws + off); unsigned spins = 0;
        while ((unsigned)__builtin_amdgcn_readfirstlane(__hip_atomic_load(cnt, __ATOMIC_RELAXED, __HIP_MEMORY_SCOPE_AGENT)) < need) {
            __builtin_amdgcn_s_sleep(2); if (++spins > (1u << 22)) break; }
        __builtin_amdgcn_fence(__ATOMIC_ACQUIRE, "agent");
        asm volatile("s_waitcnt vmcnt(0)" ::: "memory");
    }
    __syncthreads();
}

__device__ __forceinline__ void phase_prologue_a(Frame& F) {
    const float* const* in = F.in;
    unsigned char* ws = F.ws;
    LAS float* ldsf = (LAS float*)F.lds;
    phase_mods(F);
    __syncthreads();
    {
        const int gt = blockIdx.x * 512 + F.tid, NT = F.G * 512;
        float* rope = (float*)(ws + WS_ROPE);
        for (int i = gt; i < 1024; i += NT) { const int coord = i >> 4, q = i & 15; const float inv = powf(10000.0f, -(float)q / 16.0f); const float ang = (float)coord * inv;
            rope[i] = cosf(ang); rope[1024 + i] = sinf(ang); }
        bf16* WA = (bf16*)(ws + WS_WA);
        for (int i = gt; i < 128 * 128; i += NT) { const int m = i >> 7, k = i & 127, rp = m >> 6, j1 = m & 63, ri = k >> 6, n1 = k & 63;
            const float a = 2.0f * (float)((j1 * n1) & 63) / 64.0f; const float c = cospif(a), s = sinpif(a);
            const float v = (rp == 0) ? (ri == 0 ? c : s) : (ri == 0 ? -s : c); WA[i] = (bf16)f2bf(v); }
        bf16* WAC = (bf16*)(ws + WS_WAC);
        for (int i = gt; i < 32 * 32; i += NT) { const int m = i >> 5, k = i & 31, rp = m >> 4, j1 = m & 15, ri = k >> 4, n1 = k & 15;
            const float a = 2.0f * (float)((j1 * n1) & 15) / 16.0f; const float c = cospif(a), s = sinpif(a);
            const float v = (rp == 0) ? (ri == 0 ? c : s) : (ri == 0 ? -s : c); WAC[i] = (bf16)f2bf(v); }
        bf16* WC = (bf16*)(ws + WS_WC);
        for (int i = gt; i < 64 * 64 * 128; i += NT) { const int j1 = i >> 13, j2 = (i >> 7) & 63, k = i & 127, ri = k >> 6, n2 = k & 63;
            const float a = 2.0f * (float)((n2 * (j1 + 64 * j2)) & 4095) / 4096.0f; const float v = (ri == 0 ? cospif(a) : sinpif(a)) * (1.0f / 64.0f); WC[i] = (bf16)f2bf(v); }
        bf16* FD = (bf16*)(ws + WS_FD);
        for (int i = gt; i < 256 * 128; i += NT) { const int col = i >> 7, c = i & 127, ri = col >> 7, k2 = col & 127;
            const float a = 2.0f * (float)((c * k2) & 127) / 128.0f; const float v = (ri == 0 ? cospif(a) : -sinpif(a)) * 0.08838834764831845f; FD[i] = (bf16)f2bf(v); }
        bf16* WCC = (bf16*)(ws + WS_WCC);
        for (int i = gt; i < 16 * 16 * 32; i += NT) { const int j1 = i >> 9, j2 = (i >> 5) & 15, k = i & 31, ri = k >> 4, n2 = k & 15;
            const float a = 2.0f * (float)((n2 * (j1 + 16 * j2)) & 255) / 256.0f; const float v = (ri == 0 ? cospif(a) : sinpif(a)) * (1.0f / 16.0f); WCC[i] = (bf16)f2bf(v); }
    }
    LAS float* tw = (LAS float*)(F.lds + 139264);
    if (F.tid < 128) { const float a = 2.0f * (float)F.tid / 128.0f; tw[F.tid] = cospif(a); tw[128 + F.tid] = sinpif(a); }
    __syncthreads();
    LAS float* scr = (LAS float*)(F.lds + F.wave * 17408);
    const int gw = F.vcu * NWAVES + F.wave, NGW = F.G * NWAVES;
    const int fid = F.vcu * 2 + F.wave;
    if (F.wave < 2) { const int r = fid;
        const int g = r >> 7, db = (r >> 5) & 3, kb = r & 31, k0 = kb * 32, d0 = db * 32;
        const float* Wp = in[I_OWIN] + (size_t)k0 * 1280 + g * 128;
        { float tl[32][2];
#pragma unroll
          for (int rr = 0; rr < 32; ++rr) { tl[rr][0] = Wp[(size_t)rr * 1280 + F.lane]; tl[rr][1] = Wp[(size_t)rr * 1280 + 64 + F.lane]; }
#pragma unroll
          for (int rr = 0; rr < 32; ++rr) { scr[rr * 129 + F.lane] = tl[rr][0]; scr[rr * 129 + 64 + F.lane] = tl[rr][1]; } }
        LDS_WAIT(); asm volatile("" ::: "memory");
        const int k = F.lane & 31, oh = F.lane >> 5;
        const float* pw = in[I_OPOOLW] + (size_t)g * 16384 + d0 + 16 * oh;
        float acc[16];
#pragma unroll
        for (int t = 0; t < 16; ++t) acc[t] = 0.f;
        for (int c0 = 0; c0 < 128; c0 += 8) {
            f32x4 p[8][4];
#pragma unroll
            for (int cc = 0; cc < 8; ++cc)
#pragma unroll
                for (int j = 0; j < 4; ++j) p[cc][j] = *(const f32x4*)(pw + (c0 + cc) * 128 + 4 * j);
#pragma unroll
            for (int cc = 0; cc < 8; ++cc) { const float w = scr[k * 129 + c0 + cc];
#pragma unroll
                for (int j = 0; j < 4; ++j) { acc[4 * j] += w * p[cc][j].x; acc[4 * j + 1] += w * p[cc][j].y; acc[4 * j + 2] += w * p[cc][j].z; acc[4 * j + 3] += w * p[cc][j].w; } }
        }
        const float* psc = in[I_OPOOLS] + g * 128 + d0 + 16 * oh;
        bf16* dst = (bf16*)(ws + WS_W_OIN) + (size_t)(g * 128 + d0 + 16 * oh) * 1024 + k0 + k;
#pragma unroll
        for (int t = 0; t < 16; ++t) dst[(size_t)t * 1024] = (bf16)f2bf(acc[t] * psc[t]);
        LDS_WAIT(); asm volatile("" ::: "memory");
    }
    {
        LAS unsigned* ctr = (LAS unsigned*)(F.lds + LDS_CTL + 32);
        constexpr int PER = (TNITEMS + 255) / 256;
        const int base = F.vcu * PER, lim = min(PER, TNITEMS - base);
        f32x4 cur[8], nxt[8];
        int it = __builtin_amdgcn_readfirstlane(F.lane == 0 ? (int)atomicAdd((unsigned*)ctr, 1u) : 0);
        TItem tc = titem_decode(in, ws, base + (it < lim ? it : 0));
        if (it < lim) titem_load(tc, nxt, F.lane);
        while (it < lim) {
#pragma unroll
            for (int i = 0; i < 8; ++i) cur[i] = nxt[i];
            const TItem tcur = tc;
            const int itn = __builtin_amdgcn_readfirstlane(F.lane == 0 ? (int)atomicAdd((unsigned*)ctr, 1u) : 0);
            if (itn < lim) { tc = titem_decode(in, ws, base + itn); titem_load(tc, nxt, F.lane); }
            titem_process(tcur, cur, scr, F.lane);
            it = itn;
        }
    }
    mods_wait(F);
    {
        LAS unsigned* ctr2 = (LAS unsigned*)(F.lds + LDS_CTL + 36);
        for (;;) {
            const int it = __builtin_amdgcn_readfirstlane(F.lane == 0 ? (int)atomicAdd((unsigned*)ctr2, 1u) : 0);
            if (it >= 40) break;
            if (it < 32) p1_tokens<4>(F, 4 * (32 * (int)blockIdx.x + it)); else p1_tokens<1>(F, TL + 8 * (int)blockIdx.x + (it - 32));
        }
    }
}

struct DftP { const bf16* dbase; size_t dstride; const bf16* W; bf16* obase; size_t ostride; };
template <int MODE> __device__ __forceinline__ DftP dft_params(const Frame& F, int u) {
    const bf16* P = (const bf16*)(F.ws + WS_BUFP); bf16* Z = (bf16*)(F.ws + WS_BUFZ); bf16* MIX = (bf16*)(F.ws + WS_BUFA);
    DftP p;
    if constexpr (MODE == 0) { const int chunk = u & 3, n2 = (u >> 2) & 63, b = u >> 8;
        p.dbase = P + (size_t)(b * 4096 + n2) * EIN + chunk * 128; p.dstride = (size_t)64 * EIN; p.W = (const bf16*)(F.ws + WS_WA);
        p.obase = Z + (size_t)((b * 64) * 64 + n2) * 1024 + chunk * 128; p.ostride = (size_t)64 * 1024; }
    if constexpr (MODE == 1) { const int chunk = u & 3, n2 = (u >> 2) & 15, b = u >> 6;
        p.dbase = P + (size_t)(TL + b * 256 + n2) * EIN + chunk * 128; p.dstride = (size_t)16 * EIN; p.W = (const bf16*)(F.ws + WS_WAC);
        p.obase = Z + (size_t)(TL + (b * 16) * 16 + n2) * 1024 + chunk * 128; p.ostride = (size_t)16 * 1024; }
    if constexpr (MODE == 2) { const int chunk = u & 3, j1 = (u >> 2) & 63, b = u >> 8;
        p.dbase = Z + (size_t)((b * 64 + j1) * 64) * 1024 + chunk * 128; p.dstride = (size_t)1024; p.W = (const bf16*)(F.ws + WS_WC) + (size_t)j1 * 64 * 128;
        p.obase = MIX + (size_t)(b * 4096 + j1) * D + chunk * 128; p.ostride = (size_t)64 * D; }
    if constexpr (MODE == 3) { const int chunk = u & 3, j1 = (u >> 2) & 15, b = u >> 6;
        p.dbase = Z + (size_t)(TL + (b * 16 + j1) * 16) * 1024 + chunk * 128; p.dstride = (size_t)1024; p.W = (const bf16*)(F.ws + WS_WCC) + (size_t)j1 * 16 * 32;
        p.obase = MIX + (size_t)(TL + b * 256 + j1) * D + chunk * 128; p.ostride = (size_t)16 * D; }
    return p;
}
template <int MODE, int KD, int MD, int J>
__device__ __forceinline__ void dft_units(Frame& F, int nunits) {
    constexpr int LD = KD + 8;
    constexpr int NP = (KD * 16 + 511) / 512;
    constexpr int GM = KD / 8 - 1;
    LAS bf16* DT = (LAS bf16*)F.lds;
    u32x4 pre[NP];
    int u = F.vcu;
    if (u < nunits) { const DftP p = dft_params<MODE>(F, u);
#pragma unroll
        for (int i = 0; i < NP; ++i) { const int pc = F.tid + 512 * i; if (pc < KD * 16) { const int k = pc >> 4, c8 = pc & 15, ri = k / (KD / 2), nn = k % (KD / 2);
            pre[i] = __builtin_nontemporal_load((const u32x4*)(p.dbase + (size_t)nn * p.dstride + ri * 512 + c8 * 8)); } } }
    const int a = F.lane & 15, q = F.lane >> 4;
    for (; u < nunits; u += F.G) {
        const DftP p = dft_params<MODE>(F, u);
#pragma unroll
        for (int i = 0; i < NP; ++i) { const int pc = F.tid + 512 * i; if (pc < KD * 16) { const int k = pc >> 4, c8 = pc & 15; const u32x4 v = pre[i];
            LAS bf16* d = DT + (c8 * 8) * LD + (k ^ ((c8 & GM) << 3));
            d[0 * LD] = (bf16)(v.x & 0xffff); d[1 * LD] = (bf16)(v.x >> 16); d[2 * LD] = (bf16)(v.y & 0xffff); d[3 * LD] = (bf16)(v.y >> 16);
            d[4 * LD] = (bf16)(v.z & 0xffff); d[5 * LD] = (bf16)(v.z >> 16); d[6 * LD] = (bf16)(v.w & 0xffff); d[7 * LD] = (bf16)(v.w >> 16); } }
        __syncthreads();
        if (u + F.G < nunits) { const DftP pn = dft_params<MODE>(F, u + F.G);
#pragma unroll
            for (int i = 0; i < NP; ++i) { const int pc = F.tid + 512 * i; if (pc < KD * 16) { const int k = pc >> 4, c8 = pc & 15, ri = k / (KD / 2), nn = k % (KD / 2);
                pre[i] = __builtin_nontemporal_load((const u32x4*)(pn.dbase + (size_t)nn * pn.dstride + ri * 512 + c8 * 8)); } } }
        for (int task = F.wave; task < (MD / 16) * 2; task += NWAVES) {
            const int mt = task >> 1, cht = task & 1;
            f32x4 acc[4];
#pragma unroll
            for (int ct = 0; ct < 4; ++ct) acc[ct] = (f32x4){0.f, 0.f, 0.f, 0.f};
#pragma unroll
            for (int ks = 0; ks < KD / 32; ++ks) {
                const bf16x8 bw = *(const bf16x8*)(p.W + (size_t)(mt * 16 + a) * KD + ks * 32 + 8 * q);
#pragma unroll
                for (int ct = 0; ct < 4; ++ct) {
                    const int ch = cht * 64 + 16 * (a >> 2) + 4 * ct + (a & 3);
                    const bf16x8 av = *(const LAS bf16x8*)(DT + ch * LD + ((ks * 32 + 8 * q) ^ (((ch >> 3) & GM) << 3)));
                    acc[ct] = __builtin_amdgcn_mfma_f32_16x16x32_bf16(av, bw, acc[ct], 0, 0, 0);
                }
            }
            const int m = mt * 16 + a, rm = m / J, j = m % J;
            bf16* o = p.obase + (size_t)j * p.ostride + rm * 512 + cht * 64 + 16 * q;
            u32x4 w0, w1;
            w0.x = pk2(acc[0][0], acc[0][1]); w0.y = pk2(acc[0][2], acc[0][3]); w0.z = pk2(acc[1][0], acc[1][1]); w0.w = pk2(acc[1][2], acc[1][3]);
            w1.x = pk2(acc[2][0], acc[2][1]); w1.y = pk2(acc[2][2], acc[2][3]); w1.z = pk2(acc[3][0], acc[3][1]); w1.w = pk2(acc[3][2], acc[3][3]);
            *(u32x4*)o = w0; *(u32x4*)(o + 8) = w1;
        }
        __syncthreads();
    }
}

template <int MODE, int NR>
__device__ __forceinline__ void dft_units_a(Frame& F, int nunits) {
    constexpr int KD = 2 * NR, MD = 2 * NR, J = NR, LD = KD + 8, GM = KD / 8 - 1, ULD = 136;
    constexpr int NP = (NR * 16 + 511) / 512;
    LAS bf16* FDl = (LAS bf16*)F.lds; LAS bf16* U = (LAS bf16*)(F.lds + 69632); LAS bf16* DT = (LAS bf16*)(F.lds + 69632 + 64 * ULD * 2);
    { const bf16* FD = (const bf16*)(F.ws + WS_FD);
      for (int p = F.tid; p < 256 * 16; p += 512) { const int r = p >> 4, c8 = p & 15; *(LAS u32x4*)(FDl + r * ULD + 8 * c8) = *(const u32x4*)(FD + r * 128 + 8 * c8); } }
    u32x4 pre[NP];
    int u = F.vcu;
    if (u < nunits) { const DftP p = dft_params<MODE>(F, u);
#pragma unroll
        for (int i = 0; i < NP; ++i) { const int pc = F.tid + 512 * i; if (pc < NR * 16) pre[i] = __builtin_nontemporal_load((const u32x4*)(p.dbase + (size_t)(pc >> 4) * p.dstride + (pc & 15) * 8)); } }
    const int a = F.lane & 15, q = F.lane >> 4;
    for (; u < nunits; u += F.G) {
        const DftP p = dft_params<MODE>(F, u);
#pragma unroll
        for (int i = 0; i < NP; ++i) { const int pc = F.tid + 512 * i; if (pc < NR * 16) *(LAS u32x4*)(U + (pc >> 4) * ULD + (pc & 15) * 8) = pre[i]; }
        __syncthreads();
        if (u + F.G < nunits) { const DftP pn = dft_params<MODE>(F, u + F.G);
#pragma unroll
            for (int i = 0; i < NP; ++i) { const int pc = F.tid + 512 * i; if (pc < NR * 16) pre[i] = __builtin_nontemporal_load((const u32x4*)(pn.dbase + (size_t)(pc >> 4) * pn.dstride + (pc & 15) * 8)); } }
        {
            f32x4 acc[NR / 16][2];
#pragma unroll
            for (int mt = 0; mt < NR / 16; ++mt) { acc[mt][0] = (f32x4){0.f, 0.f, 0.f, 0.f}; acc[mt][1] = (f32x4){0.f, 0.f, 0.f, 0.f}; }
#pragma unroll
            for (int ks = 0; ks < 4; ++ks) {
                const bf16x8 b0 = *(const LAS bf16x8*)(FDl + ((2 * F.wave) * 16 + a) * ULD + ks * 32 + 8 * q), b1 = *(const LAS bf16x8*)(FDl + ((2 * F.wave + 1) * 16 + a) * ULD + ks * 32 + 8 * q);
#pragma unroll
                for (int mt = 0; mt < NR / 16; ++mt) { const bf16x8 av = *(const LAS bf16x8*)(U + (mt * 16 + a) * ULD + ks * 32 + 8 * q);
                    acc[mt][0] = __builtin_amdgcn_mfma_f32_16x16x32_bf16(av, b0, acc[mt][0], 0, 0, 0); acc[mt][1] = __builtin_amdgcn_mfma_f32_16x16x32_bf16(av, b1, acc[mt][1], 0, 0, 0); }
            }
#pragma unroll
            for (int t = 0; t < 2; ++t) { const int col = (2 * F.wave + t) * 16 + a, ri = col >> 7, k2 = col & 127;
#pragma unroll
                for (int mt = 0; mt < NR / 16; ++mt) { const int k0 = ri * NR + 16 * mt + 4 * q;
                    u32x2 w; w.x = pk2(acc[mt][t][0], acc[mt][t][1]); w.y = pk2(acc[mt][t][2], acc[mt][t][3]);
                    *(LAS u32x2*)(DT + k2 * LD + (k0 ^ (((k2 >> 3) & GM) << 3))) = w; } }
        }
        __syncthreads();
        for (int task = F.wave; task < (MD / 16) * 2; task += NWAVES) {
            const int mt = task >> 1, cht = task & 1;
            f32x4 acc[4];
#pragma unroll
            for (int ct = 0; ct < 4; ++ct) acc[ct] = (f32x4){0.f, 0.f, 0.f, 0.f};
#pragma unroll
            for (int ks = 0; ks < KD / 32; ++ks) {
                const bf16x8 bw = *(const bf16x8*)(p.W + (size_t)(mt * 16 + a) * KD + ks * 32 + 8 * q);
#pragma unroll
                for (int ct = 0; ct < 4; ++ct) {
                    const int ch = cht * 64 + 16 * (a >> 2) + 4 * ct + (a & 3);
                    const bf16x8 av = *(const LAS bf16x8*)(DT + ch * LD + ((ks * 32 + 8 * q) ^ (((ch >> 3) & GM) << 3)));
                    acc[ct] = __builtin_amdgcn_mfma_f32_16x16x32_bf16(av, bw, acc[ct], 0, 0, 0);
                }
            }
            const int m = mt * 16 + a, rm = m / J, j = m % J;
            bf16* o = p.obase + (size_t)j * p.ostride + rm * 512 + cht * 64 + 16 * q;
            u32x4 w0, w1;
            w0.x = pk2(acc[0][0], acc[0][1]); w0.y = pk2(acc[0][2], acc[0][3]); w0.z = pk2(acc[1][0], acc[1][1]); w0.w = pk2(acc[1][2], acc[1][3]);
            w1.x = pk2(acc[2][0], acc[2][1]); w1.y = pk2(acc[2][2], acc[2][3]); w1.z = pk2(acc[3][0], acc[3][1]); w1.w = pk2(acc[3][2], acc[3][3]);
            *(u32x4*)o = w0; *(u32x4*)(o + 8) = w1;
        }
        __syncthreads();
    }
}

__device__ __forceinline__ void phase_fourier_a_conv(Frame& F) {
    const bf16* P = (const bf16*)(F.ws + WS_BUFP);
    dft_units_a<0, 64>(F, 2048);
    __syncthreads();
    dft_units_a<1, 16>(F, 512);
    bf16* MIX = (bf16*)(F.ws + WS_BUFA);
    const float* cw = F.in[I_ECONV];
    float w0[8], w1[8], w2[8];
#pragma unroll
    for (int i = 0; i < 8; ++i) { w0[i] = cw[8 * F.lane + i]; w1[i] = cw[512 + 8 * F.lane + i]; w2[i] = cw[1024 + 8 * F.lane + i]; }
    const int gw = F.vcu * NWAVES + F.wave, NGW = F.G * NWAVES;
    auto conv_tokens = [&](int t, auto ntc) {
        constexpr int NT = decltype(ntc)::value;
        int pos, len; if (t < TL) { pos = t & 4095; len = 4096; } else { pos = (t - TL) & 255; len = 256; }
        const bf16* row = P + (size_t)t * EIN + 8 * F.lane;
        u32x4 gb[NT], gc[NT + 2], uc[NT + 2];
#pragma unroll
        for (int d = 0; d < NT + 2; ++d) { const int pp = pos + d - 1;
            if (pp >= 0 && pp < len) { gc[d] = *(const u32x4*)(row + (ptrdiff_t)(d - 1) * EIN + 1024); uc[d] = *(const u32x4*)(row + (ptrdiff_t)(d - 1) * EIN + 1536); }
            else { gc[d] = (u32x4){0u, 0u, 0u, 0u}; uc[d] = (u32x4){0u, 0u, 0u, 0u}; } }
#pragma unroll
        for (int q = 0; q < NT; ++q) gb[q] = __builtin_nontemporal_load((const u32x4*)(row + (size_t)q * EIN + 512));
        float pl[NT + 2][8];
#pragma unroll
        for (int d = 0; d < NT + 2; ++d)
#pragma unroll
            for (int i = 0; i < 4; ++i) { pl[d][2 * i] = bflo(gc[d][i]) * bflo(uc[d][i]); pl[d][2 * i + 1] = bfhi(gc[d][i]) * bfhi(uc[d][i]); }
#pragma unroll
        for (int q = 0; q < NT; ++q) {
            float y[8];
#pragma unroll
            for (int i = 0; i < 4; ++i) {
                y[2 * i] = bflo(gb[q][i]) * (w0[2 * i] * pl[q][2 * i] + w1[2 * i] * pl[q + 1][2 * i] + w2[2 * i] * pl[q + 2][2 * i]);
                y[2 * i + 1] = bfhi(gb[q][i]) * (w0[2 * i + 1] * pl[q][2 * i + 1] + w1[2 * i + 1] * pl[q + 1][2 * i + 1] + w2[2 * i + 1] * pl[q + 2][2 * i + 1]);
            }
            u32x4 o; o.x = pk2(y[0], y[1]); o.y = pk2(y[2], y[3]); o.z = pk2(y[4], y[5]); o.w = pk2(y[6], y[7]);
            *(u32x4*)(MIX + (size_t)(t + q) * D + 512 + 8 * F.lane) = o;
        }
    };
    for (int t = 4 * gw; t < TL; t += 4 * NGW) conv_tokens(t, std::integral_constant<int, 4>{});
    for (int t = TL + gw; t < T; t += NGW) conv_tokens(t, std::integral_constant<int, 1>{});
}

__device__ __forceinline__ void phase_fourier_c(Frame& F) {
    dft_units<2, 128, 64, 64>(F, 2048);
    dft_units<3, 32, 16, 16>(F, 512);
}

constexpr int RW_LD = 1032;
template <bool SPLIT>
__device__ __forceinline__ void phase_route(Frame& F, int layer, int ntok) {
    LAS bf16* rwh = (LAS bf16*)F.lds;
    LAS bf16* rwl = (LAS bf16*)(F.lds + 33024);
    LAS unsigned* cnt = (LAS unsigned*)(F.lds + 66048);
    LAS int* gb = (LAS int*)(F.lds + 66048 + 128);
    LAS float* lgs = (LAS float*)(F.lds + 66048 + 256) + F.wave * 256;
    LAS int* tinfo = (LAS int*)(F.lds + 66048 + 256 + 8192);
    LAS float* GS = (LAS float*)(F.lds + 81920);
    LAS float* SH = GS + 2048;
    const float* RW = F.in[I_RW];
    int tA, nA, tB, nB;
    if constexpr (SPLIT) {
        const int xs = F.vcu >> 5, rs = F.vcu & 31;
        if (rs >= 28) return;
        const int j = 28 * xs + rs;
        tA = 128 * j; nA = 128; tB = 28672 + 32 * j; nB = (j < 192) ? 32 : 0;
    } else { const int per_ = ntok / F.G; tA = blockIdx.x * per_; nA = per_; tB = 0; nB = 0; }
    const int r0 = mod_row(tA), mr1 = SPLIT ? mod_row(tB) : min(r0 + 1, 8);
    const float* mods = (const float*)(F.ws + WS_MODS) + (size_t)layer * 9 * 6144;
    const float* g = F.in[I_NFG] + layer * 1024;
    for (int i = F.tid; i < 16384; i += 512) { const int k = i >> 4, e = i & 15; const float w = RW[i]; const unsigned hi = f2bf(w); const float wl = w - __builtin_bit_cast(float, hi << 16);
        rwh[e * RW_LD + k] = (bf16)hi; rwl[e * RW_LD + k] = (bf16)f2bf(wl); }
    for (int i = F.tid; i < 2048; i += 512) { const int sl = i >> 10, c = i & 1023; const int rr = sl ? mr1 : r0; const float* m = mods + (size_t)rr * 6144;
        GS[i] = g[c] * (m[4 * 1024 + c] + 1.0f); SH[i] = m[3 * 1024 + c]; }
    if (F.tid < 16) cnt[F.tid] = 0u;
    __syncthreads();
    bf16* FB = (bf16*)(F.ws + WS_BUFA);
    const bool f8 = layer ? (FP8_G1_L1 != 0) : (FP8_G1_L0 != 0);
    int* route = (int*)(F.ws + WS_ROUTE);
    const int tk = F.lane & 15, kg = F.lane >> 4;
    for (int st = 0; st < 2; ++st) {
    const int t0 = st ? tB : tA, per = st ? nB : nA, li0 = st ? nA : 0;
    if (per == 0) break;
    if constexpr (SPLIT) { if (st == 0) ctr_wait(F, WS_P5F, 224u); else ctr_wait(F, WS_P5C, 32u); }
    for (int g0 = 16 * F.wave; g0 < per; g0 += 16 * NWAVES) {
        const int nv = min(16, per - g0);
        const int tq = t0 + g0 + (tk < nv ? tk : 0);
        const bf16* hr = h_row(F, tq) + 8 * kg;
        float s2 = 0.f;
        {
            u32x4 raw[32];
#pragma unroll
            for (int ks = 0; ks < 32; ++ks) raw[ks] = *(const u32x4*)(hr + 32 * ks);
#pragma unroll
            for (int ks = 0; ks < 32; ++ks)
#pragma unroll
                for (int i = 0; i < 4; ++i) { const float a = bflo(raw[ks][i]), b2 = bfhi(raw[ks][i]); s2 += a * a + b2 * b2; }
        }
        s2 += __shfl_xor(s2, 16); s2 += __shfl_xor(s2, 32);
        const float rstd = 1.0f / sqrtf(s2 * (1.0f / D) + EPS);
        const int sl = (mod_row(tq) != r0) ? 1024 : 0;
        const LAS float* gsp = GS + sl + 8 * kg; const LAS float* shp = SH + sl + 8 * kg;
        unsigned char* fb8 = (unsigned char*)FB + (size_t)tq * D + 8 * kg;
        bf16* fb16 = FB + (size_t)tq * D + 8 * kg;
        f32x4 acc = (f32x4){0.f, 0.f, 0.f, 0.f};
        u32x4 nx[8];
#pragma unroll
        for (int j = 0; j < 8; ++j) nx[j] = *(const u32x4*)(hr + 32 * j);
#pragma unroll 1
        for (int k4 = 0; k4 < 4; ++k4) {
            u32x4 cu[8];
#pragma unroll
            for (int j = 0; j < 8; ++j) cu[j] = nx[j];
            if (k4 < 3) {
#pragma unroll
                for (int j = 0; j < 8; ++j) nx[j] = *(const u32x4*)(hr + 32 * (8 * k4 + 8 + j)); }
#pragma unroll
            for (int j = 0; j < 8; ++j) {
                const int ks = 8 * k4 + j;
                const f32x4 g0v = *(const LAS f32x4*)(gsp + 32 * ks), g1v = *(const LAS f32x4*)(gsp + 32 * ks + 4), s0v = *(const LAS f32x4*)(shp + 32 * ks), s1v = *(const LAS f32x4*)(shp + 32 * ks + 4);
                float f[8];
                f[0] = bflo(cu[j].x) * rstd * g0v.x + s0v.x; f[1] = bfhi(cu[j].x) * rstd * g0v.y + s0v.y; f[2] = bflo(cu[j].y) * rstd * g0v.z + s0v.z; f[3] = bfhi(cu[j].y) * rstd * g0v.w + s0v.w;
                f[4] = bflo(cu[j].z) * rstd * g1v.x + s1v.x; f[5] = bfhi(cu[j].z) * rstd * g1v.y + s1v.y; f[6] = bflo(cu[j].w) * rstd * g1v.z + s1v.z; f[7] = bfhi(cu[j].w) * rstd * g1v.w + s1v.w;
                u32x4 hi, lo;
#pragma unroll
                for (int i = 0; i < 4; ++i) { const unsigned h0 = f2bf(f[2 * i]), h1 = f2bf(f[2 * i + 1]); hi[i] = h0 | (h1 << 16);
                    lo[i] = pk2(f[2 * i] - __builtin_bit_cast(float, h0 << 16), f[2 * i + 1] - __builtin_bit_cast(float, h1 << 16)); }
                if (tk < nv) {
                    if (f8) { u32x2 o; o.x = pg8::pk4_fp8(f[0], f[1], f[2], f[3]); o.y = pg8::pk4_fp8(f[4], f[5], f[6], f[7]); *(u32x2*)(fb8 + 32 * ks) = o; }
                    else *(u32x4*)(fb16 + 32 * ks) = hi;
                }
                const bf16x8 bh = *(const LAS bf16x8*)(rwh + tk * RW_LD + 32 * ks + 8 * kg), bl = *(const LAS bf16x8*)(rwl + tk * RW_LD + 32 * ks + 8 * kg);
                const bf16x8 ah = __builtin_bit_cast(bf16x8, hi), al = __builtin_bit_cast(bf16x8, lo);
                acc = __builtin_amdgcn_mfma_f32_16x16x32_bf16(ah, bh, acc, 0, 0, 0);
                acc = __builtin_amdgcn_mfma_f32_16x16x32_bf16(ah, bl, acc, 0, 0, 0);
                acc = __builtin_amdgcn_mfma_f32_16x16x32_bf16(al, bh, acc, 0, 0, 0);
            }
        }
#pragma unroll
        for (int j = 0; j < 4; ++j) lgs[(4 * kg + j) * 16 + tk] = acc[j];
        LDS_WAIT(); asm volatile("" ::: "memory");
        if (F.lane < nv) {
            const int tqq = t0 + g0 + F.lane;
            float aff[16], sel[16];
#pragma unroll
            for (int e4 = 0; e4 < 4; ++e4) { const f32x4 l4 = *(const LAS f32x4*)(lgs + F.lane * 16 + 4 * e4); const f32x4 b4 = *(const f32x4*)(F.in[I_RB] + 4 * e4);
                aff[4 * e4] = 1.0f / (1.0f + expf(-l4.x)); aff[4 * e4 + 1] = 1.0f / (1.0f + expf(-l4.y)); aff[4 * e4 + 2] = 1.0f / (1.0f + expf(-l4.z)); aff[4 * e4 + 3] = 1.0f / (1.0f + expf(-l4.w));
                sel[4 * e4] = aff[4 * e4] + b4.x; sel[4 * e4 + 1] = aff[4 * e4 + 1] + b4.y; sel[4 * e4 + 2] = aff[4 * e4 + 2] + b4.z; sel[4 * e4 + 3] = aff[4 * e4 + 3] + b4.w; }
            int best = 0; float bs = -1e30f;
#pragma unroll
            for (int gq = 0; gq < 4; ++gq) { const float a = sel[4 * gq], b = sel[4 * gq + 1], c = sel[4 * gq + 2], d = sel[4 * gq + 3];
                const float s = fmaxf(fmaxf(fmaxf(a + b, a + c), fmaxf(a + d, b + c)), fmaxf(b + d, c + d));
                if (s > bs) { bs = s; best = gq; } }
            float sv[4], av[4];
#pragma unroll
            for (int i = 0; i < 4; ++i) { sv[i] = sel[i]; av[i] = aff[i]; }
#pragma unroll
            for (int gq = 1; gq < 4; ++gq) if (best == gq) {
#pragma unroll
                for (int i = 0; i < 4; ++i) { sv[i] = sel[4 * gq + i]; av[i] = aff[4 * gq + i]; } }
            int i1 = 0; float s1 = sv[0], a1 = av[0];
#pragma unroll
            for (int i = 1; i < 4; ++i) if (sv[i] > s1) { s1 = sv[i]; a1 = av[i]; i1 = i; }
            int i2 = -1; float s2v = -1e30f, a2 = 0.f;
#pragma unroll
            for (int i = 0; i < 4; ++i) if (i != i1 && sv[i] > s2v) { s2v = sv[i]; a2 = av[i]; i2 = i; }
            const int e1 = 4 * best + i1, e2 = 4 * best + i2;
            const float wsum = a1 + a2, w1 = a1 / wsum, w2 = a2 / wsum;
            const unsigned r1 = atomicAdd((unsigned*)(cnt + e1), 1u), r2 = atomicAdd((unsigned*)(cnt + e2), 1u);
            int* ro = route + (size_t)tqq * 8;
            ro[0] = e1; ro[1] = e2; ro[4] = __builtin_bit_cast(int, w1); ro[5] = __builtin_bit_cast(int, w2);
            const int li = li0 + g0 + F.lane;
            tinfo[4 * li + 0] = e1; tinfo[4 * li + 1] = e2; tinfo[4 * li + 2] = (int)r1; tinfo[4 * li + 3] = (int)r2;
        }
        LDS_WAIT(); asm volatile("" ::: "memory");
    }
    }
    __syncthreads();
    if (F.tid < 16) gb[F.tid] = (int)__hip_atomic_fetch_add((unsigned*)(F.ws + WS_GCNT) + layer * 16 + F.tid, cnt[F.tid], __ATOMIC_RELAXED, __HIP_MEMORY_SCOPE_AGENT);
    __syncthreads();
    int* tokmap = (int*)(F.ws + WS_TOKMAP);
    for (int i = F.tid; i < nA + nB; i += 512) {
        const int tok = (i < nA) ? tA + i : tB + (i - nA);
        const int e1 = tinfo[4 * i], e2 = tinfo[4 * i + 1], p1 = gb[e1] + tinfo[4 * i + 2], p2 = gb[e2] + tinfo[4 * i + 3];
        tokmap[(size_t)e1 * T + p1] = tok; tokmap[(size_t)e2 * T + p2] = tok;
        int* ro = route + (size_t)tok * 8; ro[2] = p1; ro[3] = p2;
    }
}

__device__ __forceinline__ int moe_tables(Frame& F, int layer) {
    LAS int* tb = (LAS int*)(F.lds + LDS_CTL + 64); LAS int* cn = (LAS int*)(F.lds + LDS_CTL + 192);
    __syncthreads();
    if (F.tid < 16) cn[F.tid] = ld_coh((const int*)(F.ws + WS_GCNT) + layer * 16 + F.tid);
    __syncthreads();
    if (F.tid == 0) { int b = 0; for (int e = 0; e < 16; ++e) { tb[e] = b; b += (cn[e] + 255) >> 8; } tb[16] = b; }
    __syncthreads();
    return __builtin_amdgcn_readfirstlane(tb[16]);
}

template <int NQ> __device__ __forceinline__ void combine_tokens(Frame& F, int layer, int t) {
    const float* mods = (const float*)(F.ws + WS_MODS);
    const bf16* OS = (const bf16*)(F.ws + WS_BUFP);
    const int* route = (const int*)(F.ws + WS_ROUTE);
    const LAS int* tb = (const LAS int*)(F.lds + LDS_CTL + 64);
    bf16* A = (bf16*)(F.ws + WS_BUFA);
    {
        int rc[NQ][4]; float w0[NQ], w1[NQ];
#pragma unroll
        for (int q = 0; q < NQ; ++q) { const int* ro = route + (size_t)(t + q) * 8;
#pragma unroll
            for (int i = 0; i < 4; ++i) rc[q][i] = ld_coh(ro + i);
            w0[q] = ld_cohf((const float*)(ro + 4)); w1[q] = ld_cohf((const float*)(ro + 5)); }
        f32x4 v[NQ][4]; u32x2 oa[NQ][4], ob[NQ][4];
#pragma unroll
        for (int q = 0; q < NQ; ++q) { const bf16* hr = h_row(F, t + q);
            const size_t s0 = (size_t)(tb[rc[q][0]] * 256 + rc[q][2]) * D, s1 = (size_t)(tb[rc[q][1]] * 256 + rc[q][3]) * D;
#pragma unroll
            for (int j = 0; j < 4; ++j) { const int c = 4 * F.lane + 256 * j; { const u32x2 hv = *(const u32x2*)(hr + c); v[q][j] = (f32x4){bflo(hv.x), bfhi(hv.x), bflo(hv.y), bfhi(hv.y)}; } oa[q][j] = __builtin_nontemporal_load((const u32x2*)(OS + s0 + c)); ob[q][j] = __builtin_nontemporal_load((const u32x2*)(OS + s1 + c)); } }
        const int mr = mod_row(t);
        const float* m5 = mods + (size_t)(layer * 9 + mr) * 6144 + 5 * 1024;
#pragma unroll
        for (int j = 0; j < 4; ++j) { const f32x4 g5 = *(const f32x4*)(m5 + 4 * F.lane + 256 * j);
#pragma unroll
            for (int q = 0; q < NQ; ++q) { const u32x2 a = oa[q][j], b2 = ob[q][j];
                const f32x4 o = (f32x4){w0[q] * bflo(a.x) + w1[q] * bflo(b2.x), w0[q] * bfhi(a.x) + w1[q] * bfhi(b2.x), w0[q] * bflo(a.y) + w1[q] * bflo(b2.y), w0[q] * bfhi(a.y) + w1[q] * bfhi(b2.y)};
                v[q][j] = v[q][j] + g5 * o; } }
#pragma unroll
        for (int q = 0; q < NQ; ++q) {
            if (layer == 0) {
                bf16* hr = h_row(F, t + q);
#pragma unroll
                for (int j = 0; j < 4; ++j) { u32x2 o; o.x = pk2(v[q][j].x, v[q][j].y); o.y = pk2(v[q][j].z, v[q][j].w); *(u32x2*)(hr + 4 * F.lane + 256 * j) = o; }
                const float* m = mods + (size_t)(9 + mr) * 6144;
                norm_mod_store(v[q], F.in[I_NMG] + 1024, m, m + 1024, A + (size_t)(t + q) * D, F.lane);
            } else {
                float s2 = 0.f;
#pragma unroll
                for (int j = 0; j < 4; ++j) s2 += (v[q][j].x * v[q][j].x + v[q][j].y * v[q][j].y) + (v[q][j].z * v[q][j].z + v[q][j].w * v[q][j].w);
                const float rstd = 1.0f / sqrtf(wave_sum(s2) * (1.0f / D) + EPS);
                float* orow = F.out + (size_t)(t + q) * D;
#pragma unroll
                for (int j = 0; j < 4; ++j) { const int c = 4 * F.lane + 256 * j; __builtin_nontemporal_store(v[q][j] * rstd * *(const f32x4*)(F.in[I_FG] + c), (f32x4*)(orow + c)); }
            }
        }
    }
}
__device__ __forceinline__ void phase_combine(Frame& F, int layer, int ntok) {
    const int gw = F.vcu * NWAVES + F.wave, NGW = F.G * NWAVES;
    if (layer == 0) { for (int t = 2 * gw; t < TL; t += 2 * NGW) combine_tokens<2>(F, 0, t); for (int t = TL + gw; t < ntok; t += NGW) combine_tokens<1>(F, 0, t); }
    else { for (int t = 4 * gw; t < TL; t += 4 * NGW) combine_tokens<4>(F, 1, t); }
}

constexpr int KV_LD = 72, VL_OFF = 384 * KV_LD * 2, ROPE_LDS = 131072;
typedef short v4i16_t __attribute__((ext_vector_type(4)));

__device__ __forceinline__ bf16x8 rope_pack(const u32x4 x1, const u32x4 x2, const LAS float* cs, const LAS float* sn, float scale, bool second) {
    const f32x4 c0 = *(const LAS f32x4*)cs, c1 = *(const LAS f32x4*)(cs + 4), s0 = *(const LAS f32x4*)sn, s1 = *(const LAS f32x4*)(sn + 4);
    float c[8] = {c0.x, c0.y, c0.z, c0.w, c1.x, c1.y, c1.z, c1.w}, s[8] = {s0.x, s0.y, s0.z, s0.w, s1.x, s1.y, s1.z, s1.w};
    float a[8], b[8];
#pragma unroll
    for (int i = 0; i < 4; ++i) { a[2 * i] = bflo(x1[i]); a[2 * i + 1] = bfhi(x1[i]); b[2 * i] = bflo(x2[i]); b[2 * i + 1] = bfhi(x2[i]); }
    float o[8];
#pragma unroll
    for (int i = 0; i < 8; ++i) o[i] = (second ? (b[i] * c[i] + a[i] * s[i]) : (a[i] * c[i] - b[i] * s[i])) * scale;
    u32x4 w; w.x = pk2(o[0], o[1]); w.y = pk2(o[2], o[3]); w.z = pk2(o[4], o[5]); w.w = pk2(o[6], o[7]);
    return __builtin_bit_cast(bf16x8, w);
}

struct AttnU { int b, qb, kvh; };
__device__ __forceinline__ AttnU attn_unit_of(int u) { AttnU r; r.kvh = u & 1; r.qb = (u >> 1) & 31; r.b = u >> 6; return r; }

__device__ __forceinline__ void attn_load_latk(Frame& F, const bf16* P1, AttnU u, u32x4 (&lk)[2][4]) {
    const u32x4 z = (u32x4){0u, 0u, 0u, 0u};
#pragma unroll
    for (int it = 0; it < 2; ++it) { const int task = F.tid + 512 * it, kidx = task >> 1, hh = task & 1, pos = u.qb * 128 - 128 + kidx;
        const bool ok = task < 768 && pos >= 0 && pos < NSEQ;
        const bf16* row = P1 + (size_t)(u.b * NSEQ + (ok ? pos : 0)) * OIN + 1024 + u.kvh * 64 + 8 * hh;
#pragma unroll
        for (int st = 0; st < 4; ++st) lk[it][st] = ok ? *(const u32x4*)(row + 16 * st) : z; }
}
__device__ __forceinline__ void attn_load_latv(Frame& F, const bf16* P1, AttnU u, u32x4 (&lv)[6]) {
    const u32x4 z = (u32x4){0u, 0u, 0u, 0u};
#pragma unroll
    for (int it = 0; it < 6; ++it) { const int task = F.tid + 512 * it, kidx = task >> 3, c8 = task & 7, pos = u.qb * 128 - 128 + kidx;
        const bool ok = pos >= 0 && pos < NSEQ;
        lv[it] = ok ? *(const u32x4*)(P1 + (size_t)(u.b * NSEQ + (ok ? pos : 0)) * OIN + 1152 + u.kvh * 64 + 8 * c8) : z; }
}
__device__ __forceinline__ void attn_write_lat(Frame& F, AttnU u, const u32x4 (&lk)[2][4], const u32x4 (&lv)[6]) {
    LAS bf16* KL = (LAS bf16*)F.lds; LAS bf16* VL = (LAS bf16*)(F.lds + VL_OFF); const LAS float* rope = (const LAS float*)(F.lds + ROPE_LDS);
#pragma unroll
    for (int it = 0; it < 2; ++it) { const int task = F.tid + 512 * it, kidx = task >> 1, hh = task & 1; int pos = u.qb * 128 - 128 + kidx; pos = pos < 0 ? 0 : (pos > NSEQ - 1 ? NSEQ - 1 : pos);
        if (task < 768) {
            LAS bf16* d = KL + kidx * KV_LD + 8 * hh;
            const LAS float* c0 = rope + (pos >> 6) * 16 + 8 * hh; const LAS float* c1 = rope + (pos & 63) * 16 + 8 * hh;
            *(LAS bf16x8*)(d) = rope_pack(lk[it][0], lk[it][1], c0, c0 + 1024, 1.0f, false);
            *(LAS bf16x8*)(d + 16) = rope_pack(lk[it][0], lk[it][1], c0, c0 + 1024, 1.0f, true);
            *(LAS bf16x8*)(d + 32) = rope_pack(lk[it][2], lk[it][3], c1, c1 + 1024, 1.0f, false);
            *(LAS bf16x8*)(d + 48) = rope_pack(lk[it][2], lk[it][3], c1, c1 + 1024, 1.0f, true);
        } }
#pragma unroll
    for (int it = 0; it < 6; ++it) { const int task = F.tid + 512 * it, kidx = task >> 3, c8 = task & 7; *(LAS u32x4*)(VL + kidx * KV_LD + 8 * c8) = lv[it]; }
}
__device__ __forceinline__ void attn_load_ctx(Frame& F, const bf16* P1, AttnU u, u32x4 (&ck)[4], u32x4 (&cv)[4]) {
#pragma unroll
    for (int it = 0; it < 4; ++it) { const int task = F.tid + 512 * it, kidx = task >> 3, c8 = task & 7;
        const bf16* row = P1 + (size_t)(TL + u.b * LCTX + kidx) * OIN + 1024 + u.kvh * 64 + 8 * c8;
        ck[it] = *(const u32x4*)row; cv[it] = *(const u32x4*)(row + 128); }
}
__device__ __forceinline__ void attn_write_ctx(Frame& F, const u32x4 (&ck)[4], const u32x4 (&cv)[4]) {
    LAS bf16* KL = (LAS bf16*)F.lds; LAS bf16* VL = (LAS bf16*)(F.lds + VL_OFF);
#pragma unroll
    for (int it = 0; it < 4; ++it) { const int task = F.tid + 512 * it, kidx = task >> 3, c8 = task & 7;
        *(LAS u32x4*)(KL + kidx * KV_LD + 8 * c8) = ck[it]; *(LAS u32x4*)(VL + kidx * KV_LD + 8 * c8) = cv[it]; }
}

__device__ __forceinline__ unsigned cvtpk(float lo, float hi) { unsigned r; asm volatile("v_cvt_pk_bf16_f32 %0, %1, %2" : "=v"(r) : "v"(lo), "v"(hi)); return r; }
__device__ __forceinline__ float xhalf_max(float x) { const auto r = __builtin_amdgcn_permlane32_swap(__builtin_bit_cast(unsigned, x), __builtin_bit_cast(unsigned, x), false, false);
    return fmaxf(__builtin_bit_cast(float, r[0]), __builtin_bit_cast(float, r[1])); }
__device__ __forceinline__ float xhalf_sum(float x) { const auto r = __builtin_amdgcn_permlane32_swap(__builtin_bit_cast(unsigned, x), __builtin_bit_cast(unsigned, x), false, false);
    return __builtin_bit_cast(float, r[0]) + __builtin_bit_cast(float, r[1]); }
__device__ __forceinline__ void attn_tiles(Frame& F, int kt0, int kt1, int mk0, int mk1, const bf16x8 (&qf)[4], f32x16 (&O)[2], float& mrun, float& lrun, int qrel) {
    if (kt0 > kt1) return;
    const LAS bf16* KL = (const LAS bf16*)F.lds; const LAS bf16* VL = (const LAS bf16*)(F.lds + VL_OFF);
    const int r32 = F.lane & 31, hh = F.lane >> 5;
    const int q4 = (F.lane & 15) >> 2, p4 = F.lane & 3, blk = (F.lane >> 4) & 1;
    const LAS bf16* kp = KL + (kt0 * 32 + r32) * KV_LD + 8 * hh;
    const LAS bf16* vp = VL + (kt0 * 32 + 4 * hh + q4) * KV_LD + 16 * blk + 4 * p4;
    bf16x8 kn[4];
#pragma unroll
    for (int st = 0; st < 4; ++st) kn[st] = *(const LAS bf16x8*)(kp + 16 * st);
    for (int kt = kt0; kt <= kt1; ++kt) {
        bf16x8 kf[4];
#pragma unroll
        for (int st = 0; st < 4; ++st) kf[st] = kn[st];
        v4i16_t vlo[2][2], vhi[2][2];
#pragma unroll
        for (int dt = 0; dt < 2; ++dt)
#pragma unroll
            for (int s2 = 0; s2 < 2; ++s2) { vlo[dt][s2] = __builtin_amdgcn_ds_read_tr16_b64_v4i16((LAS v4i16_t*)(vp + (16 * s2) * KV_LD + dt * 32));
                vhi[dt][s2] = __builtin_amdgcn_ds_read_tr16_b64_v4i16((LAS v4i16_t*)(vp + (16 * s2 + 8) * KV_LD + dt * 32)); }
        kp += 32 * KV_LD; vp += 32 * KV_LD;
        if (kt < kt1) {
#pragma unroll
            for (int st = 0; st < 4; ++st) kn[st] = *(const LAS bf16x8*)(kp + 16 * st); }
        __builtin_amdgcn_sched_barrier(0);
        f32x16 s;
#pragma unroll
        for (int r = 0; r < 16; ++r) s[r] = 0.f;
#pragma unroll
        for (int st = 0; st < 4; ++st) s = __builtin_amdgcn_mfma_f32_32x32x16_bf16(kf[st], qf[st], s, 0, 0, 0);
        if (kt == mk0 || kt == mk1) {
#pragma unroll
            for (int r = 0; r < 16; ++r) { const int dlt = kt * 32 + (r & 3) + 8 * (r >> 2) + 4 * hh - qrel; s[r] = (dlt <= 128 && dlt >= -128) ? s[r] : -INFINITY; } }
        float mx = fmaxf(fmaxf(s[0], s[1]), fmaxf(s[2], s[3]));
#pragma unroll
        for (int r = 4; r < 16; r += 4) mx = fmaxf(mx, fmaxf(fmaxf(s[r], s[r + 1]), fmaxf(s[r + 2], s[r + 3])));
        mx = xhalf_max(mx);
        const float mnew = fmaxf(mrun, mx);
        float ps0 = 0.f, ps1 = 0.f;
#pragma unroll
        for (int r = 0; r < 16; r += 2) { s[r] = __builtin_amdgcn_exp2f(s[r] - mnew); s[r + 1] = __builtin_amdgcn_exp2f(s[r + 1] - mnew); ps0 += s[r]; ps1 += s[r + 1]; }
        const float ps = xhalf_sum(ps0 + ps1);
        if (__any(mnew > mrun)) {
            const float alpha = __builtin_amdgcn_exp2f(mrun - mnew);
            lrun *= alpha;
#pragma unroll
            for (int dt = 0; dt < 2; ++dt)
#pragma unroll
                for (int r = 0; r < 16; ++r) O[dt][r] *= alpha;
        }
        lrun += ps; mrun = mnew;
        bf16x8 pb[2];
#pragma unroll
        for (int s2 = 0; s2 < 2; ++s2) { u32x4 w; w.x = cvtpk(s[8 * s2 + 0], s[8 * s2 + 1]); w.y = cvtpk(s[8 * s2 + 2], s[8 * s2 + 3]); w.z = cvtpk(s[8 * s2 + 4], s[8 * s2 + 5]); w.w = cvtpk(s[8 * s2 + 6], s[8 * s2 + 7]);
            pb[s2] = __builtin_bit_cast(bf16x8, w); }
#pragma unroll
        for (int dt = 0; dt < 2; ++dt)
#pragma unroll
            for (int s2 = 0; s2 < 2; ++s2) {
                const bf16x8 va = (bf16x8){vlo[dt][s2][0], vlo[dt][s2][1], vlo[dt][s2][2], vlo[dt][s2][3], vhi[dt][s2][0], vhi[dt][s2][1], vhi[dt][s2][2], vhi[dt][s2][3]};
                O[dt] = __builtin_amdgcn_mfma_f32_32x32x16_bf16(va, pb[s2], O[dt], 0, 0, 0);
            }
    }
}

__device__ __forceinline__ void phase_attn(Frame& F) {
    const bf16* P1 = (const bf16*)(F.ws + WS_BUFP);
    bf16* MIX = (bf16*)(F.ws + WS_BUFA);
    const int r32 = F.lane & 31, hh = F.lane >> 5;
    constexpr float QSC = 0.125f * 1.4426950408889634f;
    LAS float* ropel = (LAS float*)(F.lds + ROPE_LDS);
    for (int i = F.tid; i < 2048; i += 512) ropel[i] = ((const float*)(F.ws + WS_ROPE))[i];
    u32x4 lk[2][4], lv[6], ck[4], cv[4];
    const int nu = (512 - F.vcu + F.G - 1) / F.G;
    if (nu > 0) attn_load_latk(F, P1, attn_unit_of(F.vcu), lk);
    for (int ui = 0; ui < nu; ++ui) {
        const AttnU u = attn_unit_of(F.vcu + ui * F.G);
        u32x4 qr[2][4];
#pragma unroll
        for (int i = 0; i < 2; ++i) { const int task = F.wave + 8 * i, g = task & 3, sub = task >> 2, head = u.kvh * 4 + g, pos = u.qb * 128 + 32 * sub + r32;
            const bf16* row = P1 + (size_t)(u.b * NSEQ + pos) * OIN + 512 + head * 64 + 8 * hh;
#pragma unroll
            for (int st = 0; st < 4; ++st) qr[i][st] = __builtin_nontemporal_load((const u32x4*)(row + 16 * st)); }
        attn_load_latv(F, P1, u, lv);
        __syncthreads();
        attn_write_lat(F, u, lk, lv);
        bf16x8 qf[2][4]; f32x16 O[2][2]; float mrun[2], lrun[2];
#pragma unroll
        for (int i = 0; i < 2; ++i) { const int task = F.wave + 8 * i, g = task & 3, sub = task >> 2, head = u.kvh * 4 + g, pos = u.qb * 128 + 32 * sub + r32;
            const LAS float* c0 = ropel + (pos >> 6) * 16 + 8 * hh; const LAS float* c1 = ropel + (pos & 63) * 16 + 8 * hh;
            qf[i][0] = rope_pack(qr[i][0], qr[i][1], c0, c0 + 1024, QSC, false); qf[i][1] = rope_pack(qr[i][0], qr[i][1], c0, c0 + 1024, QSC, true);
            qf[i][2] = rope_pack(qr[i][2], qr[i][3], c1, c1 + 1024, QSC, false); qf[i][3] = rope_pack(qr[i][2], qr[i][3], c1, c1 + 1024, QSC, true);
            mrun[i] = F.in[I_OSINK][head] * 1.4426950408889634f; lrun[i] = 1.0f;
#pragma unroll
            for (int dt = 0; dt < 2; ++dt)
#pragma unroll
                for (int r = 0; r < 16; ++r) O[i][dt][r] = 0.f; }
        __syncthreads();
        const int kt_lo = (u.qb == 0) ? 4 : 0, kt_hi = (u.qb == 31) ? 7 : 11;
#pragma unroll
        for (int i = 0; i < 2; ++i) { const int sub = (F.wave + 8 * i) >> 2, qrel = 128 + 32 * sub + r32;
            attn_tiles(F, max(sub, kt_lo), min(sub + 8, kt_hi), sub, sub + 8, qf[i], O[i], mrun[i], lrun[i], qrel); }
        attn_load_ctx(F, P1, u, ck, cv);
        __syncthreads();
        attn_write_ctx(F, ck, cv);
        __syncthreads();
        if (ui + 1 < nu) attn_load_latk(F, P1, attn_unit_of(F.vcu + (ui + 1) * F.G), lk);
#pragma unroll
        for (int i = 0; i < 2; ++i) {
            attn_tiles(F, 0, 7, -1, -1, qf[i], O[i], mrun[i], lrun[i], 0);
            const int task = F.wave + 8 * i, g = task & 3, sub = task >> 2, head = u.kvh * 4 + g, pos = u.qb * 128 + 32 * sub + r32;
            const float inv = 1.0f / lrun[i];
            bf16* o = MIX + (size_t)(u.b * NSEQ + pos) * D + 512 + head * 64 + 4 * hh;
#pragma unroll
            for (int dt = 0; dt < 2; ++dt)
#pragma unroll
                for (int rg = 0; rg < 4; ++rg) { u32x2 w; w.x = pk2(O[i][dt][4 * rg] * inv, O[i][dt][4 * rg + 1] * inv); w.y = pk2(O[i][dt][4 * rg + 2] * inv, O[i][dt][4 * rg + 3] * inv);
                    *(u32x2*)(o + dt * 32 + 8 * rg) = w; }
        }
    }
    __syncthreads();
}

__device__ __forceinline__ void phase_pool_stencil(Frame& F) {
    const bf16* P1 = (const bf16*)(F.ws + WS_BUFP);
    bf16* MIX = (bf16*)(F.ws + WS_BUFA);
    const int gw = F.vcu * NWAVES + F.wave, NGW = F.G * NWAVES;
    const int r = 1 << (F.lane >> 4);
    constexpr int NT = 8, NR = NT + 16;
    for (int t = NT * gw; t < TL; t += NT * NGW) {
        const int pos = t & 4095;
        const bf16* base = P1 + (size_t)t * OIN + 8 * F.lane;
        u32x4 v[NR];
#pragma unroll
        for (int jj = 0; jj < NR; ++jj) { const int pj = pos + jj - 8; const bool ok = pj >= 0 && pj < NSEQ; v[jj] = ok ? *(const u32x4*)(base + (ptrdiff_t)(jj - 8) * OIN) : (u32x4){0u, 0u, 0u, 0u}; }
        float acc[NT][8];
#pragma unroll
        for (int q = 0; q < NT; ++q)
#pragma unroll
            for (int i = 0; i < 8; ++i) acc[q][i] = 0.f;
#pragma unroll
        for (int jj = 0; jj < NR; ++jj) {
            float x[8];
#pragma unroll
            for (int i = 0; i < 4; ++i) { x[2 * i] = bflo(v[jj][i]); x[2 * i + 1] = bfhi(v[jj][i]); }
#pragma unroll
            for (int q = 0; q < NT; ++q) { const int dd = jj - 8 - q; if (dd >= -8 && dd <= 8) { const float w = (dd <= r && dd >= -r) ? 1.0f : 0.0f;
#pragma unroll
                for (int i = 0; i < 8; ++i) acc[q][i] += w * x[i]; } }
        }
#pragma unroll
        for (int q = 0; q < NT; ++q) {
            const int pq = pos + q, lo = max(pq - r, 0), hi = min(pq + r + 1, NSEQ);
            const float ic = 1.0f / (float)(hi - lo);
            const u32x4 sv = v[q + 8];
            u32x4 o;
#pragma unroll
            for (int i = 0; i < 4; ++i) o[i] = pk2(acc[q][2 * i] * ic - bflo(sv[i]), acc[q][2 * i + 1] * ic - bfhi(sv[i]));
            *(u32x4*)(MIX + (size_t)(t + q) * D + 8 * F.lane) = o;
        }
    }
}

__device__ __forceinline__ void phase_attn_pool(Frame& F) {
    phase_attn(F);
#ifdef DBG_ATTN2
    phase_attn(F);
#endif
    phase_pool_stencil(F);
    __syncthreads();
    convert_l1_range(F, 120 * L1T_N + F.vcu * L1A_N, L1A_N, 40);
}

constexpr int NPHASE = 20;
__global__ void __launch_bounds__(NWAVES * 64, 2) mk_fwd(Args args) {
    extern __shared__ __attribute__((aligned(16))) unsigned char lds_raw[];
    Frame F;
    F.lds = (LAS unsigned char*)lds_raw;
    F.tid = threadIdx.x; F.lane = F.tid & 63; F.wave = __builtin_amdgcn_readfirstlane(F.tid >> 6);
    F.G = gridDim.x; { const int bx = blockIdx.x; F.vcu = (F.G % 8 == 0) ? (bx % 8) * (F.G / 8) + bx / 8 : bx; }
    F.ws = args.ws; F.in = args.in; F.out = args.out;
    for (int u = F.tid; u < (LDS_BYTES - LDS_CTL) / 4; u += NWAVES * 64) ((LAS unsigned*)(F.lds + LDS_CTL))[u] = 0u;
    __syncthreads();
    const int lo = args.ph_lo, hi = args.ph_hi;
    XcdBarrier bar; bar.bar = (unsigned*)(F.ws + WS_CTL); bar.x = 0; bar.st = nullptr;
    if (hi - lo > 1) bar = xcd_barrier_post((unsigned*)(F.ws + WS_CTL), (volatile LAS unsigned*)(F.lds + LDS_CTL));
#define IN(k) (lo <= (k) && (k) < hi)
#ifndef PHASE_MASK
#define PHASE_MASK 0xffffffffu
#endif
#define PH(k, ...) if constexpr (((PHASE_MASK >> (k)) & 1u) != 0u) if (IN(k)) { __VA_ARGS__ if constexpr (((DBG_DOUBLE >> (k)) & 1u) != 0u) { __VA_ARGS__ } }
#define SEAM(k) do { if (IN(k) && IN((k) + 1)) xcd_barrier(bar); } while (0)
    unsigned char* ws = F.ws;
    const float* mods = (const float*)(ws + WS_MODS);

    PH(1, { phase_prologue_a(F); }) SEAM(1);
    PH(2, {
        pg8::SchedDense S{(const char*)(ws + WS_BUFA), (const char*)(ws + WS_W_EIN), 1024, 8, 136, 0, 1088, F.vcu, F.G};
        pg8::EpiStore E{(bf16*)(ws + WS_BUFP), EIN};
        pg8::gemm_phase<pg8::EpiStore, pg8::SchedDense>(F.lds, 1024, S, E);
    }) SEAM(2);
    PH(3, { phase_fourier_a_conv(F); }) SEAM(3);
    PH(4, { phase_fourier_c(F); }) SEAM(4);
    PH(5, {
        const int xs = F.vcu >> 5, rs = F.vcu & 31; const bool heavy = rs >= 28;
        pg8::SchedSplit S{(const char*)(ws + WS_BUFA), (const char*)(ws + WS_W_EOUT), 1024, heavy ? 448 + 4 * xs + (rs - 28) : 28 * xs + rs, heavy ? 32 : 224, heavy ? 3 : 2};
        pg8::EpiResid<true> E{F.in[I_X], F.in[I_CTX], (bf16*)(ws + WS_HB), mods + 2 * 1024};
        pg8::gemm_phase<pg8::EpiResid<true>, pg8::SchedSplit>(F.lds, 1024, S, E);
        ctr_publish(F, heavy ? WS_P5C : WS_P5F);
    })
    PH(6, { phase_route<true>(F, 0, T); }) SEAM(6);
    PH(7, {
        const int ntile = moe_tables(F, 0);
        if constexpr (FP8_G1_L0) {
            pg8::SchedMoe<true> S{(const char*)(ws + WS_BUFA), (const char*)(ws + WS_W_M1) + (size_t)0 * 32 * MiB, (const int*)(ws + WS_TOKMAP), (const LAS int*)(F.lds + LDS_CTL + 64), (const LAS int*)(F.lds + LDS_CTL + 192), 512, (size_t)MiB, ntile * 4, F.vcu, F.G};
            pg8::EpiSwiglu8 E{(unsigned char*)(ws + WS_BUFZ), pg8::W1_SCALE};
            pg8::gemm_phase<pg8::EpiSwiglu8, pg8::SchedMoe<true>, true>(F.lds, 512, S, E);
        } else {
            pg8::SchedMoe<true> S{(const char*)(ws + WS_BUFA), (const char*)(ws + WS_W_M1) + (size_t)0 * 32 * MiB, (const int*)(ws + WS_TOKMAP), (const LAS int*)(F.lds + LDS_CTL + 64), (const LAS int*)(F.lds + LDS_CTL + 192), 1024, (size_t)2 * MiB, ntile * 4, F.vcu, F.G};
            if constexpr (FP8_G2_L0) { pg8::EpiSwiglu8 E{(unsigned char*)(ws + WS_BUFZ), 1.0f}; pg8::gemm_phase<pg8::EpiSwiglu8, pg8::SchedMoe<true>>(F.lds, 1024, S, E); }
            else { pg8::EpiSwiglu E{(bf16*)(ws + WS_BUFZ)}; pg8::gemm_phase<pg8::EpiSwiglu, pg8::SchedMoe<true>>(F.lds, 1024, S, E); }
        }
    }) SEAM(7);
    PH(8, {
        const int ntile = moe_tables(F, 0);
        if constexpr (FP8_G2_L0) {
            pg8::SchedMoe<false> S{(const char*)(ws + WS_BUFZ), (const char*)(ws + WS_W_M2) + (size_t)0 * 16 * MiB, nullptr, (const LAS int*)(F.lds + LDS_CTL + 64), (const LAS int*)(F.lds + LDS_CTL + 192), 256, (size_t)512 * KiB, ntile * 4, F.vcu, F.G};
            pg8::EpiStoreS E{(bf16*)(ws + WS_BUFP), 1024, 1.0f / (pg8::HID_SCALE * pg8::W2_SCALE)};
            pg8::gemm_phase<pg8::EpiStoreS, pg8::SchedMoe<false>, true>(F.lds, 256, S, E);
        } else {
            pg8::SchedMoe<false> S{(const char*)(ws + WS_BUFZ), (const char*)(ws + WS_W_M2) + (size_t)0 * 16 * MiB, nullptr, (const LAS int*)(F.lds + LDS_CTL + 64), (const LAS int*)(F.lds + LDS_CTL + 192), 512, (size_t)MiB, ntile * 4, F.vcu, F.G};
            pg8::EpiStore E{(bf16*)(ws + WS_BUFP), 1024};
            pg8::gemm_phase<pg8::EpiStore, pg8::SchedMoe<false>>(F.lds, 512, S, E);
        }
    }) SEAM(8);
    PH(9, { (void)moe_tables(F, 0); phase_combine(F, 0, T); }) SEAM(9);
    PH(10, {
        pg8::SchedDense S{(const char*)(ws + WS_BUFA), (const char*)(ws + WS_W_OIN), 1024, 5, 128, 4, 648, F.vcu, F.G};
        pg8::EpiStore E{(bf16*)(ws + WS_BUFP), OIN};
        pg8::gemm_phase<pg8::EpiStore, pg8::SchedDense>(F.lds, 1024, S, E);
        if (F.vcu >= 136) { __syncthreads(); convert_l1_range(F, (F.vcu - 136) * L1T_N, L1T_N, 44); }
    }) SEAM(10);
    PH(11, { phase_attn_pool(F); }) SEAM(11);
    PH(12, {
        pg8::SchedDense S{(const char*)(ws + WS_BUFA), (const char*)(ws + WS_W_OOUT), 1024, 4, 128, 0, 512, F.vcu, F.G};
        pg8::EpiResid<false> E{nullptr, nullptr, (bf16*)(ws + WS_HB), mods + 9 * 6144 + 2 * 1024};
        pg8::gemm_phase<pg8::EpiResid<false>, pg8::SchedDense>(F.lds, 1024, S, E);
    }) SEAM(12);
    PH(13, { phase_route<false>(F, 1, TL); }) SEAM(13);
    PH(14, {
        const int ntile = moe_tables(F, 1);
        if constexpr (FP8_G1_L1) {
            pg8::SchedMoe<true> S{(const char*)(ws + WS_BUFA), (const char*)(ws + WS_W_M1) + (size_t)1 * 32 * MiB, (const int*)(ws + WS_TOKMAP), (const LAS int*)(F.lds + LDS_CTL + 64), (const LAS int*)(F.lds + LDS_CTL + 192), 512, (size_t)MiB, ntile * 4, F.vcu, F.G};
            pg8::EpiSwiglu8 E{(unsigned char*)(ws + WS_BUFZ), pg8::W1_SCALE};
            pg8::gemm_phase<pg8::EpiSwiglu8, pg8::SchedMoe<true>, true>(F.lds, 512, S, E);
        } else {
            pg8::SchedMoe<true> S{(const char*)(ws + WS_BUFA), (const char*)(ws + WS_W_M1) + (size_t)1 * 32 * MiB, (const int*)(ws + WS_TOKMAP), (const LAS int*)(F.lds + LDS_CTL + 64), (const LAS int*)(F.lds + LDS_CTL + 192), 1024, (size_t)2 * MiB, ntile * 4, F.vcu, F.G};
            if constexpr (FP8_G2_L1) { pg8::EpiSwiglu8 E{(unsigned char*)(ws + WS_BUFZ), 1.0f}; pg8::gemm_phase<pg8::EpiSwiglu8, pg8::SchedMoe<true>>(F.lds, 1024, S, E); }
            else { pg8::EpiSwiglu E{(bf16*)(ws + WS_BUFZ)}; pg8::gemm_phase<pg8::EpiSwiglu, pg8::SchedMoe<true>>(F.lds, 1024, S, E); }
        }
    }) SEAM(14);
    PH(15, {
        const int ntile = moe_tables(F, 1);
        if constexpr (FP8_G2_L1) {
            pg8::SchedMoe<false> S{(const char*)(ws + WS_BUFZ), (const char*)(ws + WS_W_M2) + (size_t)1 * 16 * MiB, nullptr, (const LAS int*)(F.lds + LDS_CTL + 64), (const LAS int*)(F.lds + LDS_CTL + 192), 256, (size_t)512 * KiB, ntile * 4, F.vcu, F.G};
            pg8::EpiStoreS E{(bf16*)(ws + WS_BUFP), 1024, 1.0f / (pg8::HID_SCALE * pg8::W2_SCALE)};
            pg8::gemm_phase<pg8::EpiStoreS, pg8::SchedMoe<false>, true>(F.lds, 256, S, E);
        } else {
            pg8::SchedMoe<false> S{(const char*)(ws + WS_BUFZ), (const char*)(ws + WS_W_M2) + (size_t)1 * 16 * MiB, nullptr, (const LAS int*)(F.lds + LDS_CTL + 64), (const LAS int*)(F.lds + LDS_CTL + 192), 512, (size_t)MiB, ntile * 4, F.vcu, F.G};
            pg8::EpiStore E{(bf16*)(ws + WS_BUFP), 1024};
            pg8::gemm_phase<pg8::EpiStore, pg8::SchedMoe<false>>(F.lds, 512, S, E);
        }
    }) SEAM(15);
    PH(16, { (void)moe_tables(F, 1); phase_combine(F, 1, TL); }) SEAM(16);
#ifdef DBG_XBAR
    if (hi - lo > 1) { for (int xb = 0; xb < DBG_XBAR; ++xb) xcd_barrier(bar); }
#endif
#undef IN
#undef SEAM
}

extern "C" void kernel_launch(void* const* d_in, const int* in_sizes, int n_in, void* d_out, int out_size, void* d_ws, size_t ws_size, hipStream_t stream) {
    static int grid = 0;
    if (grid == 0) {
        if (n_in != 22 || ws_size < WS_END) { fprintf(stderr, "kernel_launch: unexpected inputs (n_in %d, ws %zu)\n", n_in, ws_size); grid = -1; return; }
        int dev = 0, cus = 0, per_cu = 0;
        if (hipGetDevice(&dev) != hipSuccess || hipDeviceGetAttribute(&cus, hipDeviceAttributeMultiprocessorCount, dev) != hipSuccess) { grid = -1; return; }
        if (hipFuncSetAttribute((const void*)mk_fwd, hipFuncAttributeMaxDynamicSharedMemorySize, LDS_BYTES) != hipSuccess) { fprintf(stderr, "kernel_launch: hipFuncSetAttribute failed\n"); grid = -1; return; }
        if (hipOccupancyMaxActiveBlocksPerMultiprocessor(&per_cu, (const void*)mk_fwd, NWAVES * 64, LDS_BYTES) != hipSuccess || per_cu < 1) { fprintf(stderr, "kernel_launch: occupancy query says %d\n", per_cu); }
        (void)hipGetLastError();
        grid = cus;
        if (grid != 256) { fprintf(stderr, "kernel_launch: %d CUs; this build assumes 256\n", grid); }
    }
    if (grid < 0) return;
    (void)hipMemsetAsync((char*)d_ws + WS_CTL, 0, CTL_ZERO_BYTES, stream);
    Args a{};
    for (int i = 0; i < 22; ++i) a.in[i] = (const float*)d_in[i];
    a.out = (float*)d_out; a.ws = (unsigned char*)d_ws;
#if MK_MULTI
    for (int p = 0; p <= DBG_STOP; ++p) { a.ph_lo = p; a.ph_hi = p + 1; hipLaunchKernelGGL(mk_fwd, dim3(grid), dim3(NWAVES * 64), LDS_BYTES, stream, a); }
    if (DBG_STOP < 16) { a.ph_lo = 17; a.ph_hi = 18; hipLaunchKernelGGL(mk_fwd, dim3(grid), dim3(NWAVES * 64), LDS_BYTES, stream, a); }
#else
    a.ph_lo = 0; a.ph_hi = 17;
    hipLaunchKernelGGL(mk_fwd, dim3(grid), dim3(NWAVES * 64), LDS_BYTES, stream, a);
#endif
}
```

```cpp
#include <hip/hip_runtime.h>
#include <cstdio>
#include <cstdint>
#include <type_traits>

#ifndef MK_MULTI
#define MK_MULTI 0
#endif
#ifndef DBG_STOP
#define DBG_STOP 16
#endif

#ifndef DBG_DOUBLE
#define DBG_DOUBLE 0u
#endif
#ifndef FP8_G1_L0
#define FP8_G1_L0 1
#endif
#ifndef FP8_G1_L1
#define FP8_G1_L1 1
#endif
#ifndef FP8_G2_L0
#define FP8_G2_L0 1
#endif
#ifndef FP8_G2_L1
#define FP8_G2_L1 1
#endif
#define LAS __attribute__((address_space(3)))
#define GAS __attribute__((address_space(1)))
typedef unsigned short bf16;
typedef short bf16x8 __attribute__((ext_vector_type(8)));
typedef short s16x4 __attribute__((ext_vector_type(4)));
typedef float f32x4 __attribute__((ext_vector_type(4)));
typedef float f32x16 __attribute__((ext_vector_type(16)));
typedef unsigned u32x4 __attribute__((ext_vector_type(4)));
typedef unsigned u32x2 __attribute__((ext_vector_type(2)));

constexpr int NB = 8, NSEQ = 4096, D = 1024, LCTX = 256;
constexpr int TL = NB * NSEQ, TC = NB * LCTX, T = TL + TC;
constexpr int EIN = 2048;
constexpr int OIN = 1280;
constexpr int NE = 16, DE = 512;
constexpr int MAXSLOT = 73728;
constexpr float EPS = 1e-6f;

constexpr size_t KiB = 1024, MiB = 1024 * 1024;
constexpr size_t WS_CTL = 0, CTL_ZERO_BYTES = 64 * KiB;
constexpr size_t WS_MODS = 64 * KiB;
constexpr size_t WS_ROPE = WS_MODS + 512 * KiB;
constexpr size_t WS_WA = WS_ROPE + 8 * KiB;
constexpr size_t WS_WAC = WS_WA + 32 * KiB;
constexpr size_t WS_WCC = WS_WAC + 2 * KiB;
constexpr size_t WS_FD = 3 * MiB - 64 * KiB;
constexpr size_t WS_BCNT = WS_WCC + 16 * KiB;
constexpr size_t WS_TILEMAP = WS_BCNT + 16 * KiB;
constexpr size_t WS_SLOT = WS_TILEMAP + 2 * KiB;
constexpr size_t WS_WROW = WS_SLOT + 288 * KiB;
constexpr size_t WS_ROUTE = WS_WROW + 288 * KiB;
constexpr size_t WS_WC = 3 * MiB;
constexpr size_t WS_W_EIN = 4 * MiB;
constexpr size_t WS_W_EOUT = 9 * MiB;
constexpr size_t WS_W_OIN = 11 * MiB;
constexpr size_t WS_W_OOUT = 14 * MiB;
constexpr size_t WS_W_POOL = 16 * MiB;
constexpr size_t WS_W_M1 = 17 * MiB;
constexpr size_t WS_W_M2 = 81 * MiB;
constexpr size_t WS_HC = 113 * MiB;
constexpr size_t WS_BUFA = 121 * MiB;
constexpr size_t WS_BUFP = 189 * MiB;
constexpr size_t WS_BUFZ = 360 * MiB;
constexpr size_t WS_TOKMAP = 432 * MiB;
constexpr size_t WS_HB = 435 * MiB;
constexpr size_t WS_END = 503 * MiB;
constexpr size_t WS_MODSDONE = 24 * KiB;
constexpr size_t WS_P5F = 28 * KiB, WS_P5C = 28 * KiB + 256;
constexpr size_t WS_GCNT = 16 * KiB;
static_assert(WS_ROUTE + (size_t)T * 32 <= WS_WC, "small region");
static_assert((size_t)T * EIN * 2 <= WS_BUFZ - WS_BUFP && (size_t)MAXSLOT * 1024 * 2 <= WS_BUFZ - WS_BUFP, "BUFP");
static_assert((size_t)MAXSLOT * 512 * 2 <= WS_TOKMAP - WS_BUFZ && (size_t)T * 1024 * 2 <= WS_TOKMAP - WS_BUFZ, "BUFZ");
static_assert((size_t)16 * T * 4 <= WS_HB - WS_TOKMAP && (size_t)T * 1024 * 2 <= WS_END - WS_HB, "TOKMAP / HB");
static_assert((size_t)T * 1024 * 2 <= WS_BUFP - WS_BUFA, "BUFA");

constexpr int LDS_BYTES = 163840;
constexpr int LDS_GIDX = 147456;
constexpr int LDS_CTL = 146432;
constexpr int NWAVES = 8;

__device__ __forceinline__ unsigned f2bf(float f) { unsigned u = __builtin_bit_cast(unsigned, f); return (u + 0x7fffu + ((u >> 16) & 1u)) >> 16; }
__device__ __forceinline__ unsigned pk2(float lo, float hi) { return f2bf(lo) | (f2bf(hi) << 16); }
__device__ __forceinline__ float bflo(unsigned w) { return __builtin_bit_cast(float, w << 16); }
__device__ __forceinline__ float bfhi(unsigned w) { return __builtin_bit_cast(float, w & 0xffff0000u); }
__device__ __forceinline__ float wave_sum(float v) {
#pragma unroll
    for (int o = 1; o < 64; o <<= 1) v += __shfl_xor(v, o);
    return v;
}
__device__ __forceinline__ int ld_coh(const int* p) { return (int)__hip_atomic_load((const unsigned*)p, __ATOMIC_RELAXED, __HIP_MEMORY_SCOPE_AGENT); }
__device__ __forceinline__ float ld_cohf(const float* p) { return __builtin_bit_cast(float, __hip_atomic_load((const unsigned*)p, __ATOMIC_RELAXED, __HIP_MEMORY_SCOPE_AGENT)); }
#define LDS_WAIT() asm volatile("s_waitcnt lgkmcnt(0)" ::: "memory")

#define XB_TMO      128
#define XB_XCNT(j)  (256  + 64 * (j))
#define XB_XSUB(j)  (1280 + 64 * (j))
#define XB_XGEN(j)  (2304 + 64 * (j))
#define XB_TOP      3328
#define XB_TOPGEN   3392
#define XCD_BAR_WORDS 3456
#define XB_SPIN_CAP (1u << 18)
__device__ __forceinline__ unsigned xb_ld(unsigned* p)              { return __hip_atomic_load(p, __ATOMIC_RELAXED, __HIP_MEMORY_SCOPE_AGENT); }
__device__ __forceinline__ unsigned xb_add(unsigned* p, unsigned v) { return __hip_atomic_fetch_add(p, v, __ATOMIC_RELAXED, __HIP_MEMORY_SCOPE_AGENT); }
__device__ __forceinline__ unsigned xb_xcc_id() { return (unsigned)__builtin_amdgcn_s_getreg((3 << 11) | 20) & 0xFu; }
#define XB_SPIN(cond, bar) do { unsigned _sp = 0; while (cond) { __builtin_amdgcn_s_sleep(1); \
    if ((++_sp & 255u) == 0u) { if (xb_ld(&(bar)[XB_TMO])) break; if (_sp > XB_SPIN_CAP) { atomicAdd(&(bar)[XB_TMO], 1u); break; } } } } while (0)
struct XcdBarrier { unsigned* bar; unsigned x; volatile LAS unsigned* st; };
__device__ __forceinline__ XcdBarrier xcd_barrier_post(unsigned* bar, volatile LAS unsigned* st) {
    XcdBarrier b; b.bar = bar; b.x = xb_xcc_id(); b.st = st;
    if (threadIdx.x == 0) (void)xb_add(&bar[XB_XCNT(b.x)], 1u);
    return b;
}
__device__ __forceinline__ void xcd_barrier_complete(unsigned* bar, unsigned x, unsigned& nloc, unsigned& nx) {
    const unsigned G = gridDim.x * gridDim.y * gridDim.z;
    unsigned sum, cnt, mine, sp = 0u;
    for (;;) {
        sum = 0u; cnt = 0u; mine = 0u;
#pragma unroll
        for (unsigned j = 0; j < 16; ++j) { const unsigned c = xb_ld(&bar[XB_XCNT(j)]); sum += c; cnt += (c > 0u) ? 1u : 0u; mine = (j == x) ? c : mine; }
        if (sum == G) break;
        __builtin_amdgcn_s_sleep(1);
        if ((++sp & 255u) == 0u) { if (xb_ld(&bar[XB_TMO])) break; if (sp > XB_SPIN_CAP) { atomicAdd(&bar[XB_TMO], 1u); break; } }
    }
    nloc = mine > 0u ? mine : 1u; nx = cnt > 0u ? cnt : 1u;
}
__device__ __forceinline__ void xcd_barrier(const XcdBarrier& b) {
    asm volatile("s_waitcnt vmcnt(0)" ::: "memory");
    __syncthreads();
    if (threadIdx.x == 0) {
        unsigned* bar = b.bar;
        __builtin_amdgcn_s_waitcnt(0);
        unsigned nloc = b.st[0], nx = b.st[1];
        if (nloc == 0u) { xcd_barrier_complete(bar, b.x, nloc, nx); b.st[0] = nloc; b.st[1] = nx; }
        const unsigned old = xb_add(&bar[XB_XSUB(b.x)], 1u);
        const unsigned gen = old / nloc;
        if (old + 1u == (gen + 1u) * nloc) {
            __builtin_amdgcn_fence(__ATOMIC_RELEASE, "agent");
            asm volatile("s_waitcnt vmcnt(0)" ::: "memory");
            const unsigned og = xb_add(&bar[XB_TOP], 1u);
            const unsigned tg = og / nx;
            if (og + 1u == (tg + 1u) * nx) xb_add(&bar[XB_TOPGEN], 1u);
            else XB_SPIN(xb_ld(&bar[XB_TOPGEN]) == tg, bar);
            __builtin_amdgcn_fence(__ATOMIC_ACQUIRE, "agent");
            xb_add(&bar[XB_XGEN(b.x)], 1u);
            asm volatile("s_waitcnt vmcnt(0)" ::: "memory");
        } else {
            XB_SPIN(xb_ld(&bar[XB_XGEN(b.x)]) == gen, bar);
            __builtin_amdgcn_fence(__ATOMIC_ACQUIRE, "agent");
            asm volatile("s_waitcnt vmcnt(0)" ::: "memory");
        }
    }
    __syncthreads();
}

namespace pg8 {
constexpr int BM = 256, BK = 64, HALF = 128, HTB = HALF * BK * 2, STAGE_BYTES = 8 * HTB;
__host__ __device__ __forceinline__ int lds_byte(int r, int c) { const int st = (r >> 4) * 2 + (c >> 5), rr = r & 15, cc = c & 31, ob = rr * 64 + cc * 2; return st * 1024 + (ob ^ (((ob >> 9) & 1) << 5)); }
__host__ __device__ __forceinline__ void stage_rc(int b, int& R, int& C) { const int st = b / 1024, sb = b % 1024, swz = sb ^ (((sb >> 9) & 1) << 5); R = (st >> 1) * 16 + swz / 64; C = (st & 1) * 32 + (swz % 64) / 2; }
__host__ __device__ __forceinline__ int perm32(int rho) { const int n = rho >> 4, i = rho & 15; return 8 * (i >> 2) + 4 * n + (i & 3); }
struct Unit { int pm, pn, e; };
__device__ __forceinline__ unsigned cvt_pk_bf16(float lo, float hi) { unsigned r; asm volatile("v_cvt_pk_bf16_f32 %0, %1, %2" : "=v"(r) : "v"(lo), "v"(hi)); return r; }

typedef int v8i32 __attribute__((ext_vector_type(8)));
typedef int v4i32 __attribute__((ext_vector_type(4)));
__device__ __forceinline__ v8i32 cat16(const bf16x8 lo, const bf16x8 hi) { return __builtin_shufflevector(__builtin_bit_cast(v4i32, lo), __builtin_bit_cast(v4i32, hi), 0, 1, 2, 3, 4, 5, 6, 7); }
template <class Epi, class Sched, bool FP8 = false>
__device__ __forceinline__ void gemm_phase(LAS unsigned char* lds, const int K, const Sched& S, const Epi& E) {
    const int tid = threadIdx.x, wid = __builtin_amdgcn_readfirstlane(tid >> 6), lane = tid & 63, wr = wid >> 2, wc = wid & 3, fr = lane & 15, fq = lane >> 4;
    const int nt = K / BK;
    int tidv = tid;
#define PG8_VB(i) ([&]() -> unsigned { int R_, C_; stage_rc(tidv * 16 + (i) * 8192, R_, C_); const int Rb_ = Epi::PERM ? ((R_ & ~31) + perm32(R_ & 31)) : R_; return (unsigned)(Rb_ * K + C_) * 2u; }())
#define PG8_VA(h, i) ([&]() -> unsigned { int R_, C_; stage_rc(tidv * 16 + (i) * 8192, R_, C_); return (unsigned)((128 * (h) + R_) * K + C_) * 2u; }())
    const size_t kstep = (size_t)(BK * 2);
    const size_t hstep = (size_t)HALF * K * 2;
    const unsigned ldsw = (unsigned)wid * 1024u;
#define aoff (lds_byte(wr * 64 + (tidv & 15), ((tidv >> 4) & 3) * 8))
#define boff (lds_byte(wc * 32 + (tidv & 15), ((tidv >> 4) & 3) * 8))
#define PG8_SA(b, h) (((b) * 2 + (h)) * HTB)
#define PG8_SB(b, h) ((4 + (b) * 2 + (h)) * HTB)
#define PG8_STAGEB(bufoff, gbase) do { _Pragma("unroll") for (int _i = 0; _i < 2; ++_i) \
        __builtin_amdgcn_global_load_lds((const unsigned*)((const char*)(gbase) + PG8_VB(_i)), (LAS unsigned*)(lds + (bufoff) + ldsw + _i * 8192), 16, 0, 0); } while (0)
#define PG8_STAGEA(bufoff, gbase, h, NEXT) do { _Pragma("unroll") for (int _i = 0; _i < 2; ++_i) { unsigned vo_; \
        if constexpr (Sched::GATHER) { int R_, C_; stage_rc(tidv * 16 + _i * 8192, R_, C_); const unsigned raw_ = gidx[((((NEXT) && usen) ? (gslot ^ 1u) : gslot) * 4u + (h) * 2 + _i) * 512u + tid]; vo_ = (raw_ * (unsigned)K + (unsigned)C_) * 2u; } \
        else vo_ = PG8_VA(h, _i); \
        __builtin_amdgcn_global_load_lds((const unsigned*)((const char*)(gbase) + vo_), (LAS unsigned*)(lds + (bufoff) + ldsw + _i * 8192), 16, 0, 0); } } while (0)
#define PG8_LDA(dst, b, h) do { _Pragma("unroll") for (int m = 0; m < 4; ++m) _Pragma("unroll") for (int k = 0; k < 2; ++k) dst[m][k] = *(const LAS bf16x8*)(lds + PG8_SA(b, h) + aoff + m * 2048 + k * 1024); } while (0)
#define PG8_LDB(dst, b, h) do { _Pragma("unroll") for (int n = 0; n < 2; ++n) _Pragma("unroll") for (int k = 0; k < 2; ++k) dst[n][k] = *(const LAS bf16x8*)(lds + PG8_SB(b, h) + boff + n * 2048 + k * 1024); } while (0)
#define PG8_MMA(ai, bj, At, Bt) do { __builtin_amdgcn_s_setprio(1); _Pragma("unroll") for (int m = 0; m < 4; ++m) _Pragma("unroll") for (int n = 0; n < 2; ++n) { \
        if constexpr (FP8) acc[ai][bj][m][n] = __builtin_amdgcn_mfma_scale_f32_16x16x128_f8f6f4(cat16(Bt[n][0], Bt[n][1]), cat16(At[m][0], At[m][1]), acc[ai][bj][m][n], 0, 0, 0, 0x7f7f7f7f, 0, 0x7f7f7f7f); \
        else { _Pragma("unroll") for (int k = 0; k < 2; ++k) acc[ai][bj][m][n] = __builtin_amdgcn_mfma_f32_16x16x32_bf16(Bt[n][k], At[m][k], acc[ai][bj][m][n], 0, 0, 0); } } \
        __builtin_amdgcn_s_setprio(0); } while (0)
#define PG8_WAIT_V(n) asm volatile("s_waitcnt vmcnt(" #n ")" ::: "memory")
#define PG8_WAIT_L(n) asm volatile("s_waitcnt lgkmcnt(" #n ")" ::: "memory")
#define PG8_BAR __builtin_amdgcn_s_barrier()
#define PG8_SCHED __builtin_amdgcn_sched_barrier(0)
#define PG8_ITER(A1, A2, A3, B2, B3) do { \
            PG8_LDB(B0, 0, 0); PG8_LDB(B1, 0, 1); PG8_SCHED; PG8_LDA(At, 0, 0); PG8_STAGEA(PG8_SA(1, 1), A1, 1, 0); \
            PG8_WAIT_V(8); PG8_WAIT_L(0); PG8_BAR; PG8_MMA(0, 0, At, B0); PG8_MMA(0, 1, At, B1); PG8_BAR; PG8_SCHED; \
            PG8_LDA(At, 0, 1); PG8_STAGEB(PG8_SB(0, 0), B2); PG8_STAGEB(PG8_SB(0, 1), (B2) + hstep); PG8_STAGEA(PG8_SA(0, 0), A2, 0, 1); \
            PG8_WAIT_V(8); PG8_WAIT_L(0); PG8_BAR; PG8_MMA(1, 0, At, B0); PG8_MMA(1, 1, At, B1); PG8_BAR; PG8_SCHED; \
            PG8_LDB(B0, 1, 0); PG8_LDB(B1, 1, 1); PG8_SCHED; PG8_LDA(At, 1, 0); PG8_STAGEA(PG8_SA(0, 1), A2, 1, 1); \
            PG8_WAIT_V(8); PG8_WAIT_L(0); PG8_BAR; PG8_MMA(0, 0, At, B0); PG8_MMA(0, 1, At, B1); PG8_BAR; PG8_SCHED; \
            PG8_LDA(At, 1, 1); PG8_STAGEB(PG8_SB(1, 0), B3); PG8_STAGEB(PG8_SB(1, 1), (B3) + hstep); PG8_STAGEA(PG8_SA(1, 0), A3, 0, 1); \
            PG8_WAIT_V(8); PG8_WAIT_L(0); PG8_BAR; PG8_MMA(1, 0, At, B0); PG8_MMA(1, 1, At, B1); PG8_BAR; PG8_SCHED; } while (0)
    Unit cur, nxt; int ui = 0;
    if (!S.next(0, cur)) return;
    f32x4 acc[2][2][4][2];
#pragma unroll
    for (int a = 0; a < 2; ++a)
#pragma unroll
        for (int b = 0; b < 2; ++b)
#pragma unroll
            for (int m = 0; m < 4; ++m)
#pragma unroll
                for (int n = 0; n < 2; ++n) acc[a][b][m][n] = (f32x4){0.f, 0.f, 0.f, 0.f};
    bf16x8 At[4][2], B0[2][2], B1[2][2];
    const LAS unsigned* gidx = (const LAS unsigned*)(lds + LDS_GIDX); unsigned gslot = 0u;
    if constexpr (Sched::GATHER) { S.idx_dma(cur, (LAS unsigned*)(lds + LDS_GIDX), tidv, wid); asm volatile("s_waitcnt vmcnt(0)" ::: "memory"); }
    const char* cA = S.a_base(cur); const char* cB = S.b_base(cur);
    constexpr bool usen = false;
    PG8_STAGEB(PG8_SB(0, 0), cB); PG8_STAGEB(PG8_SB(0, 1), cB + hstep); PG8_STAGEA(PG8_SA(0, 0), cA, 0, 0); PG8_STAGEA(PG8_SA(0, 1), cA, 1, 0);
    if (wr == 1) PG8_BAR;
    PG8_WAIT_V(2); PG8_BAR;
    PG8_STAGEB(PG8_SB(1, 0), cB + kstep); PG8_STAGEA(PG8_SA(1, 0), cA + kstep, 0, 0); PG8_STAGEB(PG8_SB(1, 1), cB + hstep + kstep);
    PG8_WAIT_V(6); PG8_BAR;
    for (;;) {
        const bool has_next = S.next(ui + 1, nxt);
        const char* nA = has_next ? S.a_base(nxt) : cA; const char* nB = has_next ? S.b_base(nxt) : cB;
#pragma unroll 1
        for (int t = 0; t < nt; t += 2) {
            const bool last = (t == nt - 2);
            const char* a1 = cA + (size_t)(t + 1) * kstep;
            const char* a2 = last ? nA : cA + (size_t)(t + 2) * kstep; const char* b2 = last ? nB : cB + (size_t)(t + 2) * kstep;
            tidv = tid; asm volatile("" : "+v"(tidv));
            if constexpr (Sched::GATHER) {
                if (t == nt - 4 && has_next) S.idx_dma(nxt, (LAS unsigned*)(lds + LDS_GIDX) + (gslot ^ 1u) * 2048u, tidv, wid);
            }
            const bool usen = last && has_next;
            PG8_ITER(a1, a2, a2 + kstep, b2, b2 + kstep);
        }
        if (wr == 0) PG8_BAR;
        E(acc, cur, wr, wc, fr, fq);
        if (!has_next) break;
#pragma unroll
        for (int a = 0; a < 2; ++a)
#pragma unroll
            for (int b = 0; b < 2; ++b)
#pragma unroll
                for (int m = 0; m < 4; ++m)
#pragma unroll
                    for (int n = 0; n < 2; ++n) acc[a][b][m][n] = (f32x4){0.f, 0.f, 0.f, 0.f};
        cur = nxt; cA = nA; cB = nB; ++ui;
        if constexpr (Sched::GATHER) gslot ^= 1u;
        if (wr == 1) PG8_BAR;
    }
    PG8_WAIT_V(0);
    PG8_BAR;
#undef PG8_ITER
#undef aoff
#undef boff
#undef PG8_SA
#undef PG8_SB
#undef PG8_STAGEA
#undef PG8_STAGEB
#undef PG8_VA
#undef PG8_VB
#undef PG8_LDA
#undef PG8_LDB
#undef PG8_MMA
#undef PG8_WAIT_V
#undef PG8_WAIT_L
#undef PG8_BAR
#undef PG8_SCHED
}

struct SchedDense {
    static constexpr bool GATHER = false;
    const char* A; const char* Bt; int K, nN, nMfull, pnx, nUnits, c, G;
    __device__ __forceinline__ bool next(int i, Unit& u) const {
        const int L = i * G + c; if (L >= nUnits) return false;
        const int full = nMfull * nN;
        if (L < full) { u.pm = L / nN; u.pn = L - u.pm * nN; } else { u.pm = nMfull + (L - full); u.pn = pnx; }
        u.e = 0; return true;
    }
    __device__ __forceinline__ const char* a_base(const Unit& u) const { return A + (size_t)u.pm * 256 * K * 2; }
    __device__ __forceinline__ const char* b_base(const Unit& u) const { return Bt + (size_t)u.pn * 256 * K * 2; }
};
struct SchedSplit {
    static constexpr bool GATHER = false;
    const char* A; const char* Bt; int K, base, stride, n;
    __device__ __forceinline__ bool next(int i, Unit& u) const {
        if (i >= n) return false;
        const int L = base + i * stride; u.pm = L >> 2; u.pn = L & 3; u.e = 0; return true;
    }
    __device__ __forceinline__ const char* a_base(const Unit& u) const { return A + (size_t)u.pm * 256 * K * 2; }
    __device__ __forceinline__ const char* b_base(const Unit& u) const { return Bt + (size_t)u.pn * 256 * K * 2; }
};
template <bool GATHER_> struct SchedMoe {
    static constexpr bool GATHER = GATHER_, gather = GATHER_;
    const char* A; const char* W; const int* tokmap; const LAS int* tb; const LAS int* cn; int K; size_t wstride; int nUnits, c, G;
    __device__ __forceinline__ bool next(int i, Unit& u) const {
        const int L = i * G + c; if (L >= nUnits) return false;
        u.pm = L >> 2; u.pn = L & 3; int e = 0;
#pragma unroll
        for (int q = 1; q < 16; ++q) if (u.pm >= __builtin_amdgcn_readfirstlane(tb[q])) e = q;
        u.e = __builtin_amdgcn_readfirstlane(e); return true;
    }
    __device__ __forceinline__ const char* a_base(const Unit& u) const { return gather ? A : A + (size_t)u.pm * 256 * K * 2; }
    __device__ __forceinline__ const char* b_base(const Unit& u) const { return W + (size_t)u.e * wstride + (size_t)u.pn * 256 * K * 2; }
    __device__ __forceinline__ void idx_dma(const Unit& u, LAS unsigned* slot, int tidv, int wid) const {
        const int p0 = (u.pm - __builtin_amdgcn_readfirstlane(tb[u.e])) * 256, last = __builtin_amdgcn_readfirstlane(cn[u.e]) - 1; const int* tm = tokmap + (size_t)u.e * T;
#pragma unroll
        for (int h = 0; h < 2; ++h)
#pragma unroll
            for (int i = 0; i < 2; ++i) { int R_, C_; stage_rc(tidv * 16 + i * 8192, R_, C_); int pos = p0 + 128 * h + R_; pos = pos < last ? pos : last;
                __builtin_amdgcn_global_load_lds((const unsigned*)(tm + pos), slot + (h * 2 + i) * 512 + wid * 64, 4, 0, 0); }
    }
};

struct EpiStore {
    static constexpr bool PERM = true;
    bf16* O; int ldc;
    __device__ __forceinline__ void operator()(const f32x4 (&acc)[2][2][4][2], const Unit& u, int wr, int wc, int fr, int fq) const {
        const int row0 = u.pm * BM + wr * 64 + fr, col0 = u.pn * BM + wc * 32 + 8 * fq;
#pragma unroll
        for (int ai = 0; ai < 2; ++ai)
#pragma unroll
            for (int m = 0; m < 4; ++m) { bf16* rowp = O + (size_t)(row0 + ai * HALF + m * 16) * ldc + col0;
#pragma unroll
                for (int bj = 0; bj < 2; ++bj) { const f32x4 v0 = acc[ai][bj][m][0], v1 = acc[ai][bj][m][1];
                    u32x4 w; w.x = cvt_pk_bf16(v0[0], v0[1]); w.y = cvt_pk_bf16(v0[2], v0[3]); w.z = cvt_pk_bf16(v1[0], v1[1]); w.w = cvt_pk_bf16(v1[2], v1[3]);
                    *(u32x4*)(rowp + bj * HALF) = w; } }
    }
};
template <bool SRC_F32> struct EpiResid {
    static constexpr bool PERM = true;
    const float* srcL; const float* srcC; bf16* H; const float* gate;
    __device__ __forceinline__ void operator()(const f32x4 (&acc)[2][2][4][2], const Unit& u, int wr, int wc, int fr, int fq) const {
        const float* g = gate + (u.pm < 128 ? (u.pm >> 4) : 8) * 6144;
        const float* src = (u.pm < 128) ? srcL + (size_t)u.pm * 256 * 1024 : srcC + (size_t)(u.pm - 128) * 256 * 1024;
        bf16* dst = H + (size_t)u.pm * 256 * 1024;
        const int row0 = wr * 64 + fr, col0 = u.pn * BM + wc * 32 + 8 * fq;
        f32x4 gv[2][2];
#pragma unroll
        for (int bj = 0; bj < 2; ++bj)
#pragma unroll
            for (int n = 0; n < 2; ++n) gv[bj][n] = *(const f32x4*)(g + col0 + bj * HALF + 4 * n);
#pragma unroll
        for (int ai = 0; ai < 2; ++ai)
#pragma unroll
            for (int m = 0; m < 4; ++m) { const size_t ro = (size_t)(row0 + ai * HALF + m * 16) * 1024 + col0;
#pragma unroll
                for (int bj = 0; bj < 2; ++bj) {
                    f32x4 s0, s1;
                    if constexpr (SRC_F32) { s0 = __builtin_nontemporal_load((const f32x4*)(src + ro + bj * HALF)); s1 = __builtin_nontemporal_load((const f32x4*)(src + ro + bj * HALF + 4)); }
                    else { const u32x4 hv = *(const u32x4*)(dst + ro + bj * HALF); s0 = (f32x4){bflo(hv.x), bfhi(hv.x), bflo(hv.y), bfhi(hv.y)}; s1 = (f32x4){bflo(hv.z), bfhi(hv.z), bflo(hv.w), bfhi(hv.w)}; }
                    const f32x4 v0 = s0 + gv[bj][0] * acc[ai][bj][m][0], v1 = s1 + gv[bj][1] * acc[ai][bj][m][1];
                    u32x4 w; w.x = cvt_pk_bf16(v0[0], v0[1]); w.y = cvt_pk_bf16(v0[2], v0[3]); w.z = cvt_pk_bf16(v1[0], v1[1]); w.w = cvt_pk_bf16(v1[2], v1[3]);
                    *(u32x4*)(dst + ro + bj * HALF) = w; } }
    }
};
__device__ __forceinline__ float silu_f(float x) { return x * __builtin_amdgcn_rcpf(1.0f + __expf(-x)); }
struct EpiSwiglu {
    static constexpr bool PERM = true;
    bf16* H;
    __device__ __forceinline__ void operator()(const f32x4 (&acc)[2][2][4][2], const Unit& u, int wr, int wc, int fr, int fq) const {
        const int row0 = u.pm * BM + wr * 64 + fr, col0 = u.pn * 128 + wc * 32 + 8 * fq;
#pragma unroll
        for (int ai = 0; ai < 2; ++ai)
#pragma unroll
            for (int m = 0; m < 4; ++m) { bf16* p = H + (size_t)(row0 + ai * HALF + m * 16) * 512 + col0;
                const f32x4 g0 = acc[ai][0][m][0], g1 = acc[ai][0][m][1], u0 = acc[ai][1][m][0], u1 = acc[ai][1][m][1];
                u32x4 w; w.x = cvt_pk_bf16(silu_f(g0[0]) * u0[0], silu_f(g0[1]) * u0[1]); w.y = cvt_pk_bf16(silu_f(g0[2]) * u0[2], silu_f(g0[3]) * u0[3]);
                w.z = cvt_pk_bf16(silu_f(g1[0]) * u1[0], silu_f(g1[1]) * u1[1]); w.w = cvt_pk_bf16(silu_f(g1[2]) * u1[2], silu_f(g1[3]) * u1[3]);
                *(u32x4*)p = w; }
    }
};
__device__ __forceinline__ unsigned pk4_fp8(float a, float b, float c, float d) { int p = __builtin_amdgcn_cvt_pk_fp8_f32(a, b, 0, false); p = __builtin_amdgcn_cvt_pk_fp8_f32(c, d, p, true); return (unsigned)p; }
constexpr float W1_SCALE = 32.0f, W2_SCALE = 16.0f, HID_SCALE = 4.0f;
struct EpiSwiglu8 {
    static constexpr bool PERM = true;
    unsigned char* H; float in_scale;
    __device__ __forceinline__ void operator()(const f32x4 (&acc)[2][2][4][2], const Unit& u, int wr, int wc, int fr, int fq) const {
        const int row0 = u.pm * BM + wr * 64 + fr, col0 = u.pn * 128 + wc * 32 + 8 * fq;
        const float IS = 1.0f / in_scale, OS = HID_SCALE / in_scale;
#pragma unroll
        for (int ai = 0; ai < 2; ++ai)
#pragma unroll
            for (int m = 0; m < 4; ++m) { unsigned char* p = H + (size_t)(row0 + ai * HALF + m * 16) * 512 + col0;
                const f32x4 g0 = acc[ai][0][m][0] * IS, g1 = acc[ai][0][m][1] * IS, u0 = acc[ai][1][m][0] * OS, u1 = acc[ai][1][m][1] * OS;
#define HC8(x) __builtin_fminf(__builtin_fmaxf((x), -448.0f), 448.0f)
                u32x2 w; w.x = pk4_fp8(HC8(silu_f(g0[0]) * u0[0]), HC8(silu_f(g0[1]) * u0[1]), HC8(silu_f(g0[2]) * u0[2]), HC8(silu_f(g0[3]) * u0[3]));
                w.y = pk4_fp8(HC8(silu_f(g1[0]) * u1[0]), HC8(silu_f(g1[1]) * u1[1]), HC8(silu_f(g1[2]) * u1[2]), HC8(silu_f(g1[3]) * u1[3]));
#undef HC8
                *(u32x2*)p = w; }
    }
};
struct EpiStoreS {
    static constexpr bool PERM = true;
    bf16* O; int ldc; float scale;
    __device__ __forceinline__ void operator()(const f32x4 (&acc)[2][2][4][2], const Unit& u, int wr, int wc, int fr, int fq) const {
        const int row0 = u.pm * BM + wr * 64 + fr, col0 = u.pn * BM + wc * 32 + 8 * fq;
#pragma unroll
        for (int ai = 0; ai < 2; ++ai)
#pragma unroll
            for (int m = 0; m < 4; ++m) { bf16* rowp = O + (size_t)(row0 + ai * HALF + m * 16) * ldc + col0;
#pragma unroll
                for (int bj = 0; bj < 2; ++bj) { const f32x4 v0 = acc[ai][bj][m][0] * scale, v1 = acc[ai][bj][m][1] * scale;
                    u32x4 w; w.x = cvt_pk_bf16(v0[0], v0[1]); w.y = cvt_pk_bf16(v0[2], v0[3]); w.z = cvt_pk_bf16(v1[0], v1[1]); w.w = cvt_pk_bf16(v1[2], v1[3]);
                    *(u32x4*)(rowp + bj * HALF) = w; } }
    }
};
struct EpiScaleRow {
    static constexpr bool PERM = true;
    bf16* O; const float* wrow;
    __device__ __forceinline__ void operator()(const f32x4 (&acc)[2][2][4][2], const Unit& u, int wr, int wc, int fr, int fq) const {
        const int row0 = u.pm * BM + wr * 64 + fr, col0 = u.pn * BM + wc * 32 + 8 * fq;
#pragma unroll
        for (int ai = 0; ai < 2; ++ai)
#pragma unroll
            for (int m = 0; m < 4; ++m) { const int row = row0 + ai * HALF + m * 16; const float s = wrow[row]; bf16* rowp = O + (size_t)row * 1024 + col0;
#pragma unroll
                for (int bj = 0; bj < 2; ++bj) { const f32x4 v0 = acc[ai][bj][m][0] * s, v1 = acc[ai][bj][m][1] * s;
                    u32x4 w; w.x = cvt_pk_bf16(v0[0], v0[1]); w.y = cvt_pk_bf16(v0[2], v0[3]); w.z = cvt_pk_bf16(v1[0], v1[1]); w.w = cvt_pk_bf16(v1[2], v1[3]);
                    *(u32x4*)(rowp + bj * HALF) = w; } }
    }
};
}

struct Args { const float* in[22]; float* out; unsigned char* ws; int ph_lo, ph_hi; };
enum { I_X = 0, I_C, I_CTX, I_CCTX, I_ADAW, I_ADAB, I_NMG, I_NFG, I_EWIN, I_ECONV, I_EWOUT, I_OWIN, I_OPOOLW, I_OPOOLS, I_OSINK, I_OWOUT, I_RW, I_RB, I_MG, I_MU, I_MD, I_FG };

struct Frame {
    LAS unsigned char* lds;
    int tid, lane, wave, vcu, G;
    unsigned char* ws; const float* const* in; float* out;
};
__device__ __forceinline__ bf16* h_row(const Frame& F, int t) { return (bf16*)(F.ws + WS_HB) + (size_t)t * D; }
__device__ __forceinline__ int mod_row(int t) { return t < TL ? (t >> 12) : 8; }

struct TItem { const float* src; bf16* dst; int ldw, ldd; float f8scale; };
__device__ __forceinline__ void titem_load(const TItem& t, f32x4 (&r)[8], int lane) {
#pragma unroll
    for (int i = 0; i < 8; ++i) r[i] = __builtin_nontemporal_load((const f32x4*)(t.src + (size_t)((lane >> 3) + 8 * i) * t.ldw + 4 * (lane & 7)));
}
__device__ __forceinline__ void titem_process(const TItem& t, const f32x4 (&r)[8], LAS float* scr, int lane) {
#pragma unroll
    for (int i = 0; i < 8; ++i) { LAS float* d = scr + ((lane >> 3) + 8 * i) * 33 + 4 * (lane & 7); d[0] = r[i].x; d[1] = r[i].y; d[2] = r[i].z; d[3] = r[i].w; }
    LDS_WAIT(); asm volatile("" ::: "memory");
    const int c = lane & 7;
    if (t.f8scale != 0.0f) {
        const float sc = t.f8scale; unsigned char* d8 = (unsigned char*)t.dst;
#pragma unroll
        for (int j = 0; j < 4; ++j) { const int n = (lane >> 3) + 8 * j; const LAS float* s = scr + (8 * c) * 33 + n;
            u32x2 o; o.x = pg8::pk4_fp8(s[0 * 33] * sc, s[1 * 33] * sc, s[2 * 33] * sc, s[3 * 33] * sc); o.y = pg8::pk4_fp8(s[4 * 33] * sc, s[5 * 33] * sc, s[6 * 33] * sc, s[7 * 33] * sc);
            *(u32x2*)(d8 + (size_t)n * t.ldd + 8 * c) = o; }
    } else {
#pragma unroll
        for (int j = 0; j < 4; ++j) { const int n = (lane >> 3) + 8 * j; const LAS float* s = scr + (8 * c) * 33 + n;
            u32x4 o; o.x = pk2(s[0 * 33], s[1 * 33]); o.y = pk2(s[2 * 33], s[3 * 33]); o.z = pk2(s[4 * 33], s[5 * 33]); o.w = pk2(s[6 * 33], s[7 * 33]);
            *(u32x4*)(t.dst + (size_t)n * t.ldd + 8 * c) = o; }
    }
    LDS_WAIT(); asm volatile("" ::: "memory");
}
constexpr int L0T_N = 32;
constexpr int TS0 = 1024, TS1 = 512, TS2 = 384, TS3 = 512, TS4 = 0, TS5 = 4096, TS6 = 4096, TS7 = 4096, TNITEMS = TS0 + TS1 + TS2 + TS3 + TS4 + TS5 + TS6 + TS7;
__device__ __forceinline__ TItem titem_moe(const float* const* in, unsigned char* ws, int kind, int le, int rr) {
    TItem t; const int layer = le >> 4, e = le & 15; const bool f8 = (kind < 2) ? (layer ? (FP8_G1_L1 != 0) : (FP8_G1_L0 != 0)) : (layer ? (FP8_G2_L1 != 0) : (FP8_G2_L0 != 0));
    if (kind < 2) { const int kb = (rr >> 4) & 15, nb = rr & 15, n0 = nb * 32; const int drow = (n0 >> 7) * 256 + (n0 & 127) + kind * 128;
        t.src = in[kind ? I_MU : I_MG] + (size_t)le * 524288 + (size_t)(kb * 64) * 512 + n0; t.ldw = 512;
        unsigned char* base = ws + WS_W_M1 + (size_t)layer * 32 * MiB;
        if (f8) { t.dst = (bf16*)(base + (size_t)e * MiB + (size_t)drow * 1024 + kb * 64); t.ldd = 1024; t.f8scale = pg8::W1_SCALE; }
        else { t.dst = (bf16*)(base + (size_t)e * 2 * MiB) + (size_t)drow * 1024 + kb * 64; t.ldd = 1024; t.f8scale = 0.0f; } }
    else { const int kb = (rr >> 5) & 7, nb = rr & 31;
        t.src = in[I_MD] + (size_t)le * 524288 + (size_t)(kb * 64) * 1024 + nb * 32; t.ldw = 1024;
        unsigned char* base = ws + WS_W_M2 + (size_t)layer * 16 * MiB;
        if (f8) { t.dst = (bf16*)(base + (size_t)e * 512 * KiB + (size_t)(nb * 32) * 512 + kb * 64); t.ldd = 512; t.f8scale = pg8::W2_SCALE; }
        else { t.dst = (bf16*)(base + (size_t)e * MiB) + (size_t)(nb * 32) * 512 + kb * 64; t.ldd = 512; t.f8scale = 0.0f; } }
    return t;
}
__device__ __forceinline__ TItem titem_decode(const float* const* in, unsigned char* ws, int r) {
    TItem t;
    if (r < TS0) { const int kb = r / 64, nb = r % 64; t.src = in[I_EWIN] + (size_t)(kb * 64) * 2048 + nb * 32; t.ldw = 2048; t.dst = (bf16*)(ws + WS_W_EIN) + (size_t)(nb * 32) * 1024 + kb * 64; t.ldd = 1024; t.f8scale = 0.0f; return t; } r -= TS0;
    if (r < TS1) { const int kb = r / 32, nb = r % 32; t.src = in[I_EWOUT] + (size_t)(kb * 64) * 1024 + nb * 32; t.ldw = 1024; t.dst = (bf16*)(ws + WS_W_EOUT) + (size_t)(nb * 32) * 1024 + kb * 64; t.ldd = 1024; t.f8scale = 0.0f; return t; } r -= TS1;
    if (r < TS2) { const int kb = r / 24, nb = 16 + r % 24; t.src = in[I_OWIN] + (size_t)(kb * 64) * 1280 + nb * 32; t.ldw = 1280; t.dst = (bf16*)(ws + WS_W_OIN) + (size_t)(nb * 32) * 1024 + kb * 64; t.ldd = 1024; t.f8scale = 0.0f; return t; } r -= TS2;
    if (r < TS3) { const int kb = r / 32, nb = r % 32; t.src = in[I_OWOUT] + (size_t)(kb * 64) * 1024 + nb * 32; t.ldw = 1024; t.dst = (bf16*)(ws + WS_W_OOUT) + (size_t)(nb * 32) * 1024 + kb * 64; t.ldd = 1024; t.f8scale = 0.0f; return t; } r -= TS3;
    r += 192 * L0T_N;
    if (r < TS5 + TS6 + TS7) return titem_moe(in, ws, r / 4096, (r % 4096) >> 8, r % 256);
    return t;
}
constexpr int NL1 = 12288;
__device__ __forceinline__ TItem titem_l1(const float* const* in, unsigned char* ws, int r) { return titem_moe(in, ws, r / 4096, 16 + ((r % 4096) >> 8), r % 256); }
__device__ __forceinline__ TItem titem_lx(const float* const* in, unsigned char* ws, int layer, int r) { return titem_moe(in, ws, r / 4096, layer * 16 + ((r % 4096) >> 8), r % 256); }

constexpr size_t WS_CONVCTR = 20 * KiB;
__device__ __forceinline__ void convert_l1(Frame& F, int quota) {
    unsigned* ctr = (unsigned*)(F.ws + WS_CONVCTR);
    LAS float* scr = (LAS float*)(F.lds + F.wave * 17408);
    for (int ch = 0; ch < quota; ++ch) {
        const int c0 = __builtin_amdgcn_readfirstlane(F.lane == 0 ? (int)__hip_atomic_fetch_add(ctr, 4u, __ATOMIC_RELAXED, __HIP_MEMORY_SCOPE_AGENT) : 0);
        if (c0 >= NL1) break;
        f32x4 cur[8], nxt[8];
        TItem tc = titem_l1(F.in, F.ws, c0);
        titem_load(tc, nxt, F.lane);
#pragma unroll 1
        for (int i = 0; i < 4; ++i) {
#pragma unroll
            for (int j = 0; j < 8; ++j) cur[j] = nxt[j];
            const TItem tcur = tc;
            if (i < 3) { tc = titem_l1(F.in, F.ws, c0 + i + 1); titem_load(tc, nxt, F.lane); }
            titem_process(tcur, cur, scr, F.lane);
        }
    }
}
__device__ __forceinline__ void convert_l1_range(Frame& F, const int base, const int cnt, const int ctr_off, const int layer = 1) {
    LAS unsigned* ctr = (LAS unsigned*)(F.lds + LDS_CTL + ctr_off);
    LAS float* scr = (LAS float*)(F.lds + F.wave * 17408);
    f32x4 cur[8], nxt[8];
    int it = __builtin_amdgcn_readfirstlane(F.lane == 0 ? (int)atomicAdd((unsigned*)ctr, 1u) : 0);
    TItem tc = titem_lx(F.in, F.ws, layer, base + (it < cnt ? it : 0));
    if (it < cnt) titem_load(tc, nxt, F.lane);
    while (it < cnt) {
#pragma unroll
        for (int i = 0; i < 8; ++i) cur[i] = nxt[i];
        const TItem tcur = tc;
        const int itn = __builtin_amdgcn_readfirstlane(F.lane == 0 ? (int)atomicAdd((unsigned*)ctr, 1u) : 0);
        if (itn < cnt) { tc = titem_lx(F.in, F.ws, layer, base + itn); titem_load(tc, nxt, F.lane); }
        titem_process(tcur, cur, scr, F.lane);
        it = itn;
    }
}
constexpr int L1T_N = 64, L1A_N = 18;
static_assert(120 * L1T_N + 256 * L1A_N == NL1, "layer-1 conversion split");
__device__ __forceinline__ void tail_fill(Frame& F, int nUnits, int quota) {
    const int rounds = (nUnits + F.G - 1) / F.G;
    if ((rounds - 1) * F.G + F.vcu >= nUnits) convert_l1(F, quota);
}

__device__ __forceinline__ void norm_mod_store(const f32x4 (&v)[4], const float* g, const float* shift, const float* scale, bf16* orow, int lane) {
    float s2 = 0.f;
#pragma unroll
    for (int j = 0; j < 4; ++j) s2 += (v[j].x * v[j].x + v[j].y * v[j].y) + (v[j].z * v[j].z + v[j].w * v[j].w);
    const float rstd = 1.0f / sqrtf(wave_sum(s2) * (1.0f / D) + EPS);
#pragma unroll
    for (int j = 0; j < 4; ++j) { const int c = 4 * lane + 256 * j;
        const f32x4 gg = *(const f32x4*)(g + c), sh = *(const f32x4*)(shift + c), sc = *(const f32x4*)(scale + c);
        const f32x4 y = v[j] * rstd * gg * (sc + 1.0f) + sh;
        u32x2 o; o.x = pk2(y.x, y.y); o.y = pk2(y.z, y.w);
        *(u32x2*)(orow + c) = o; }
}

template <int NQ> __device__ __forceinline__ void p1_tokens(Frame& F, int t) {
    const float* mods = (const float*)(F.ws + WS_MODS);
    bf16* A = (bf16*)(F.ws + WS_BUFA);
    f32x4 v[NQ][4];
#pragma unroll
    for (int q = 0; q < NQ; ++q) { const int tq = t + q; const float* xr = tq < TL ? F.in[I_X] + (size_t)tq * D : F.in[I_CTX] + (size_t)(tq - TL) * D;
#pragma unroll
        for (int j = 0; j < 4; ++j) v[q][j] = __builtin_nontemporal_load((const f32x4*)(xr + 4 * F.lane + 256 * j)); }
    const float* m = mods + (size_t)mod_row(t) * 6144;
#pragma unroll
    for (int q = 0; q < NQ; ++q) norm_mod_store(v[q], F.in[I_NMG], m, m + 1024, A + (size_t)(t + q) * D, F.lane);
}
__device__ __forceinline__ void phase_mods(Frame& F) {
    const float* const* in = F.in;
    LAS float* S = (LAS float*)F.lds;
    LAS float* red = S + 9 * 1024;
    for (int i = F.tid; i < 9 * 1024; i += 512) { const float v = (i < 8192) ? in[I_C][i] : in[I_CCTX][i - 8192]; S[i] = v / (1.0f + expf(-v)); }
    __syncthreads();
    const int bx = blockIdx.x, layer = bx >> 7, col0 = (bx & 127) * 48;
    const int j = F.tid % 12, rg = F.tid / 12;
    if (rg < 42) {
        const float* W = in[I_ADAW] + (size_t)layer * 1024 * 6144 + col0 + 4 * j;
        f32x4 w[25];
#pragma unroll
        for (int i = 0; i < 25; ++i) { const int k = rg + 42 * i; w[i] = (k < 1024) ? __builtin_nontemporal_load((const f32x4*)(W + (size_t)k * 6144)) : (f32x4){0.f, 0.f, 0.f, 0.f}; }
        f32x4 acc[9];
#pragma unroll
        for (int r = 0; r < 9; ++r) acc[r] = (f32x4){0.f, 0.f, 0.f, 0.f};
#pragma unroll
        for (int i = 0; i < 25; ++i) { const int k = min(rg + 42 * i, 1023);
#pragma unroll
            for (int r = 0; r < 9; ++r) acc[r] += w[i] * S[r * 1024 + k]; }
#pragma unroll
        for (int r = 0; r < 9; ++r) *(LAS f32x4*)(red + (rg * 9 + r) * 48 + 4 * j) = acc[r];
    }
    __syncthreads();
    for (int i = F.tid; i < 432; i += 512) { const int r = i / 48, c = i % 48; float sum = in[I_ADAB][layer * 6144 + col0 + c];
        for (int g = 0; g < 42; ++g) sum += red[(g * 9 + r) * 48 + c];
        __hip_atomic_store((unsigned*)(F.ws + WS_MODS) + (layer * 9 + r) * 6144 + col0 + c, __builtin_bit_cast(unsigned, sum), __ATOMIC_RELAXED, __HIP_MEMORY_SCOPE_AGENT); }
    asm volatile("s_waitcnt vmcnt(0)" ::: "memory");
    __syncthreads();
    if (F.tid == 0) __hip_atomic_fetch_add((unsigned*)(F.ws + WS_MODSDONE), 1u, __ATOMIC_RELAXED, __HIP_MEMORY_SCOPE_AGENT);
}
__device__ __forceinline__ void mods_wait(Frame& F) {
    if (F.tid < 64) {
        unsigned* cnt = (unsigned*)(F.ws + WS_MODSDONE); unsigned spins = 0;
        while ((unsigned)__builtin_amdgcn_readfirstlane(__hip_atomic_load(cnt, __ATOMIC_RELAXED, __HIP_MEMORY_SCOPE_AGENT)) < (unsigned)F.G) {
            __builtin_amdgcn_s_sleep(2); if (++spins > (1u << 22)) break; }
        __builtin_amdgcn_fence(__ATOMIC_ACQUIRE, "agent");
        asm volatile("s_waitcnt vmcnt(0)" ::: "memory");
    }
    __syncthreads();
}

__device__ __forceinline__ void ctr_publish(Frame& F, size_t off) {
    asm volatile("s_waitcnt vmcnt(0)" ::: "memory");
    __syncthreads();
    if (F.tid == 0) { __builtin_amdgcn_fence(__ATOMIC_RELEASE, "agent"); asm volatile("s_waitcnt vmcnt(0)" ::: "memory");
        __hip_atomic_fetch_add((unsigned*)(F.ws + off), 1u, __ATOMIC_RELAXED, __HIP_MEMORY_SCOPE_AGENT); }
}
__device__ __forceinline__ void ctr_wait(Frame& F, size_t off, unsigned need) {
    if (F.tid < 64) {
        unsigned* cnt = (unsigned*)(F.ws + off); unsigned spins = 0;
        while ((unsigned)__builtin_amdgcn_readfirstlane(__hip_atomic_load(cnt, __ATOMIC_RELAXED, __HIP_MEMORY_SCOPE_AGENT)) < need) {
            __builtin_amdgcn_s_sleep(2); if (++spins > (1u << 22)) break; }
        __builtin_amdgcn_fence(__ATOMIC_ACQUIRE, "agent");
        asm volatile("s_waitcnt vmcnt(0)" ::: "memory");
    }
    __syncthreads();
}

__device__ __forceinline__ void phase_prologue_a(Frame& F) {
    const float* const* in = F.in;
    unsigned char* ws = F.ws;
    LAS float* ldsf = (LAS float*)F.lds;
    phase_mods(F);
    __syncthreads();
    {
        const int gt = blockIdx.x * 512 + F.tid, NT = F.G * 512;
        float* rope = (float*)(ws + WS_ROPE);
        for (int i = gt; i < 1024; i += NT) { const int coord = i >> 4, q = i & 15; const float inv = powf(10000.0f, -(float)q / 16.0f); const float ang = (float)coord * inv;
            rope[i] = cosf(ang); rope[1024 + i] = sinf(ang); }
        bf16* WA = (bf16*)(ws + WS_WA);
        for (int i = gt; i < 128 * 128; i += NT) { const int m = i >> 7, k = i & 127, rp = m >> 6, j1 = m & 63, ri = k >> 6, n1 = k & 63;
            const float a = 2.0f * (float)((j1 * n1) & 63) / 64.0f; const float c = cospif(a), s = sinpif(a);
            const float v = (rp == 0) ? (ri == 0 ? c : s) : (ri == 0 ? -s : c); WA[i] = (bf16)f2bf(v); }
        bf16* WAC = (bf16*)(ws + WS_WAC);
        for (int i = gt; i < 32 * 32; i += NT) { const int m = i >> 5, k = i & 31, rp = m >> 4, j1 = m & 15, ri = k >> 4, n1 = k & 15;
            const float a = 2.0f * (float)((j1 * n1) & 15) / 16.0f; const float c = cospif(a), s = sinpif(a);
            const float v = (rp == 0) ? (ri == 0 ? c : s) : (ri == 0 ? -s : c); WAC[i] = (bf16)f2bf(v); }
        bf16* WC = (bf16*)(ws + WS_WC);
        for (int i = gt; i < 64 * 64 * 128; i += NT) { const int j1 = i >> 13, j2 = (i >> 7) & 63, k = i & 127, ri = k >> 6, n2 = k & 63;
            const float a = 2.0f * (float)((n2 * (j1 + 64 * j2)) & 4095) / 4096.0f; const float v = (ri == 0 ? cospif(a) : sinpif(a)) * (1.0f / 64.0f); WC[i] = (bf16)f2bf(v); }
        bf16* FD = (bf16*)(ws + WS_FD);
        for (int i = gt; i < 256 * 128; i += NT) { const int col = i >> 7, c = i & 127, ri = col >> 7, k2 = col & 127;
            const float a = 2.0f * (float)((c * k2) & 127) / 128.0f; const float v = (ri == 0 ? cospif(a) : -sinpif(a)) * 0.08838834764831845f; FD[i] = (bf16)f2bf(v); }
        bf16* WCC = (bf16*)(ws + WS_WCC);
        for (int i = gt; i < 16 * 16 * 32; i += NT) { const int j1 = i >> 9, j2 = (i >> 5) & 15, k = i & 31, ri = k >> 4, n2 = k & 15;
            const float a = 2.0f * (float)((n2 * (j1 + 16 * j2)) & 255) / 256.0f; const float v = (ri == 0 ? cospif(a) : sinpif(a)) * (1.0f / 16.0f); WCC[i] = (bf16)f2bf(v); }
    }
    LAS float* tw = (LAS float*)(F.lds + 139264);
    if (F.tid < 128) { const float a = 2.0f * (float)F.tid / 128.0f; tw[F.tid] = cospif(a); tw[128 + F.tid] = sinpif(a); }
    __syncthreads();
    LAS float* scr = (LAS float*)(F.lds + F.wave * 17408);
    const int gw = F.vcu * NWAVES + F.wave, NGW = F.G * NWAVES;
    const int fid = F.vcu * 2 + F.wave;
    if (F.wave < 2) { const int r = fid;
        const int g = r >> 7, db = (r >> 5) & 3, kb = r & 31, k0 = kb * 32, d0 = db * 32;
        const float* Wp = in[I_OWIN] + (size_t)k0 * 1280 + g * 128;
        { float tl[32][2];
#pragma unroll
          for (int rr = 0; rr < 32; ++rr) { tl[rr][0] = Wp[(size_t)rr * 1280 + F.lane]; tl[rr][1] = Wp[(size_t)rr * 1280 + 64 + F.lane]; }
#pragma unroll
          for (int rr = 0; rr < 32; ++rr) { scr[rr * 129 + F.lane] = tl[rr][0]; scr[rr * 129 + 64 + F.lane] = tl[rr][1]; } }
        LDS_WAIT(); asm volatile("" ::: "memory");
        const int k = F.lane & 31, oh = F.lane >> 5;
        const float* pw = in[I_OPOOLW] + (size_t)g * 16384 + d0 + 16 * oh;
        float acc[16];
#pragma unroll
        for (int t = 0; t < 16; ++t) acc[t] = 0.f;
        for (int c0 = 0; c0 < 128; c0 += 8) {
            f32x4 p[8][4];
#pragma unroll
            for (int cc = 0; cc < 8; ++cc)
#pragma unroll
                for (int j = 0; j < 4; ++j) p[cc][j] = *(const f32x4*)(pw + (c0 + cc) * 128 + 4 * j);
#pragma unroll
            for (int cc = 0; cc < 8; ++cc) { const float w = scr[k * 129 + c0 + cc];
#pragma unroll
                for (int j = 0; j < 4; ++j) { acc[4 * j] += w * p[cc][j].x; acc[4 * j + 1] += w * p[cc][j].y; acc[4 * j + 2] += w * p[cc][j].z; acc[4 * j + 3] += w * p[cc][j].w; } }
        }
        const float* psc = in[I_OPOOLS] + g * 128 + d0 + 16 * oh;
        bf16* dst = (bf16*)(ws + WS_W_OIN) + (size_t)(g * 128 + d0 + 16 * oh) * 1024 + k0 + k;
#pragma unroll
        for (int t = 0; t < 16; ++t) dst[(size_t)t * 1024] = (bf16)f2bf(acc[t] * psc[t]);
        LDS_WAIT(); asm volatile("" ::: "memory");
    }
    {
        LAS unsigned* ctr = (LAS unsigned*)(F.lds + LDS_CTL + 32);
        constexpr int TP1 = TS0 + TS1 + TS2 + TS3 + (12288 - 192 * L0T_N), PER = (TP1 + 255) / 256;
        const int base = F.vcu * PER, lim = max(0, min(PER, TP1 - base));
        f32x4 cur[8], nxt[8];
        int it = __builtin_amdgcn_readfirstlane(F.lane == 0 ? (int)atomicAdd((unsigned*)ctr, 1u) : 0);
        TItem tc = titem_decode(in, ws, base + (it < lim ? it : 0));
        if (it < lim) titem_load(tc, nxt, F.lane);
        while (it < lim) {
#pragma unroll
            for (int i = 0; i < 8; ++i) cur[i] = nxt[i];
            const TItem tcur = tc;
            const int itn = __builtin_amdgcn_readfirstlane(F.lane == 0 ? (int)atomicAdd((unsigned*)ctr, 1u) : 0);
            if (itn < lim) { tc = titem_decode(in, ws, base + itn); titem_load(tc, nxt, F.lane); }
            titem_process(tcur, cur, scr, F.lane);
            it = itn;
        }
    }
    mods_wait(F);
    {
        LAS unsigned* ctr2 = (LAS unsigned*)(F.lds + LDS_CTL + 36);
        for (;;) {
            const int it = __builtin_amdgcn_readfirstlane(F.lane == 0 ? (int)atomicAdd((unsigned*)ctr2, 1u) : 0);
            if (it >= 40) break;
            if (it < 32) p1_tokens<4>(F, 4 * (32 * (int)blockIdx.x + it)); else p1_tokens<1>(F, TL + 8 * (int)blockIdx.x + (it - 32));
        }
    }
}

struct DftP { const bf16* dbase; size_t dstride; const bf16* W; bf16* obase; size_t ostride; };
template <int MODE> __device__ __forceinline__ DftP dft_params(const Frame& F, int u) {
    const bf16* P = (const bf16*)(F.ws + WS_BUFP); bf16* Z = (bf16*)(F.ws + WS_BUFZ); bf16* MIX = (bf16*)(F.ws + WS_BUFA);
    DftP p;
    if constexpr (MODE == 0) { const int chunk = u & 3, n2 = (u >> 2) & 63, b = u >> 8;
        p.dbase = P + (size_t)(b * 4096 + n2) * EIN + chunk * 128; p.dstride = (size_t)64 * EIN; p.W = (const bf16*)(F.ws + WS_WA);
        p.obase = Z + (size_t)((b * 64) * 64 + n2) * 1024 + chunk * 128; p.ostride = (size_t)64 * 1024; }
    if constexpr (MODE == 1) { const int chunk = u & 3, n2 = (u >> 2) & 15, b = u >> 6;
        p.dbase = P + (size_t)(TL + b * 256 + n2) * EIN + chunk * 128; p.dstride = (size_t)16 * EIN; p.W = (const bf16*)(F.ws + WS_WAC);
        p.obase = Z + (size_t)(TL + (b * 16) * 16 + n2) * 1024 + chunk * 128; p.ostride = (size_t)16 * 1024; }
    if constexpr (MODE == 2) { const int chunk = u & 3, j1 = (u >> 2) & 63, b = u >> 8;
        p.dbase = Z + (size_t)((b * 64 + j1) * 64) * 1024 + chunk * 128; p.dstride = (size_t)1024; p.W = (const bf16*)(F.ws + WS_WC) + (size_t)j1 * 64 * 128;
        p.obase = MIX + (size_t)(b * 4096 + j1) * D + chunk * 128; p.ostride = (size_t)64 * D; }
    if constexpr (MODE == 3) { const int chunk = u & 3, j1 = (u >> 2) & 15, b = u >> 6;
        p.dbase = Z + (size_t)(TL + (b * 16 + j1) * 16) * 1024 + chunk * 128; p.dstride = (size_t)1024; p.W = (const bf16*)(F.ws + WS_WCC) + (size_t)j1 * 16 * 32;
        p.obase = MIX + (size_t)(TL + b * 256 + j1) * D + chunk * 128; p.ostride = (size_t)16 * D; }
    return p;
}
template <int MODE, int KD, int MD, int J>
__device__ __forceinline__ void dft_units(Frame& F, int nunits) {
    constexpr int LD = KD + 8;
    constexpr int NP = (KD * 16 + 511) / 512;
    constexpr int GM = KD / 8 - 1;
    LAS bf16* DT = (LAS bf16*)F.lds;
    u32x4 pre[NP];
    int u = F.vcu;
    if (u < nunits) { const DftP p = dft_params<MODE>(F, u);
#pragma unroll
        for (int i = 0; i < NP; ++i) { const int pc = F.tid + 512 * i; if (pc < KD * 16) { const int k = pc >> 4, c8 = pc & 15, ri = k / (KD / 2), nn = k % (KD / 2);
            pre[i] = __builtin_nontemporal_load((const u32x4*)(p.dbase + (size_t)nn * p.dstride + ri * 512 + c8 * 8)); } } }
    const int a = F.lane & 15, q = F.lane >> 4;
    for (; u < nunits; u += F.G) {
        const DftP p = dft_params<MODE>(F, u);
#pragma unroll
        for (int i = 0; i < NP; ++i) { const int pc = F.tid + 512 * i; if (pc < KD * 16) { const int k = pc >> 4, c8 = pc & 15; const u32x4 v = pre[i];
            LAS bf16* d = DT + (c8 * 8) * LD + (k ^ ((c8 & GM) << 3));
            d[0 * LD] = (bf16)(v.x & 0xffff); d[1 * LD] = (bf16)(v.x >> 16); d[2 * LD] = (bf16)(v.y & 0xffff); d[3 * LD] = (bf16)(v.y >> 16);
            d[4 * LD] = (bf16)(v.z & 0xffff); d[5 * LD] = (bf16)(v.z >> 16); d[6 * LD] = (bf16)(v.w & 0xffff); d[7 * LD] = (bf16)(v.w >> 16); } }
        __syncthreads();
        if (u + F.G < nunits) { const DftP pn = dft_params<MODE>(F, u + F.G);
#pragma unroll
            for (int i = 0; i < NP; ++i) { const int pc = F.tid + 512 * i; if (pc < KD * 16) { const int k = pc >> 4, c8 = pc & 15, ri = k / (KD / 2), nn = k % (KD / 2);
                pre[i] = __builtin_nontemporal_load((const u32x4*)(pn.dbase + (size_t)nn * pn.dstride + ri * 512 + c8 * 8)); } } }
        for (int task = F.wave; task < (MD / 16) * 2; task += NWAVES) {
            const int mt = task >> 1, cht = task & 1;
            f32x4 acc[4];
#pragma unroll
            for (int ct = 0; ct < 4; ++ct) acc[ct] = (f32x4){0.f, 0.f, 0.f, 0.f};
#pragma unroll
            for (int ks = 0; ks < KD / 32; ++ks) {
                const bf16x8 bw = *(const bf16x8*)(p.W + (size_t)(mt * 16 + a) * KD + ks * 32 + 8 * q);
#pragma unroll
                for (int ct = 0; ct < 4; ++ct) {
                    const int ch = cht * 64 + 16 * (a >> 2) + 4 * ct + (a & 3);
                    const bf16x8 av = *(const LAS bf16x8*)(DT + ch * LD + ((ks * 32 + 8 * q) ^ (((ch >> 3) & GM) << 3)));
                    acc[ct] = __builtin_amdgcn_mfma_f32_16x16x32_bf16(av, bw, acc[ct], 0, 0, 0);
                }
            }
            const int m = mt * 16 + a, rm = m / J, j = m % J;
            bf16* o = p.obase + (size_t)j * p.ostride + rm * 512 + cht * 64 + 16 * q;
            u32x4 w0, w1;
            w0.x = pk2(acc[0][0], acc[0][1]); w0.y = pk2(acc[0][2], acc[0][3]); w0.z = pk2(acc[1][0], acc[1][1]); w0.w = pk2(acc[1][2], acc[1][3]);
            w1.x = pk2(acc[2][0], acc[2][1]); w1.y = pk2(acc[2][2], acc[2][3]); w1.z = pk2(acc[3][0], acc[3][1]); w1.w = pk2(acc[3][2], acc[3][3]);
            *(u32x4*)o = w0; *(u32x4*)(o + 8) = w1;
        }
        __syncthreads();
    }
}

template <int MODE, int NR>
__device__ __forceinline__ void dft_units_a(Frame& F, int nunits) {
    constexpr int KD = 2 * NR, MD = 2 * NR, J = NR, LD = KD + 8, GM = KD / 8 - 1, ULD = 136;
    constexpr int NP = (NR * 16 + 511) / 512;
    LAS bf16* FDl = (LAS bf16*)F.lds; LAS bf16* U = (LAS bf16*)(F.lds + 69632); LAS bf16* DT = (LAS bf16*)(F.lds + 69632 + 64 * ULD * 2);
    { const bf16* FD = (const bf16*)(F.ws + WS_FD);
      for (int p = F.tid; p < 256 * 16; p += 512) { const int r = p >> 4, c8 = p & 15; *(LAS u32x4*)(FDl + r * ULD + 8 * c8) = *(const u32x4*)(FD + r * 128 + 8 * c8); } }
    u32x4 pre[NP];
    int u = F.vcu;
    if (u < nunits) { const DftP p = dft_params<MODE>(F, u);
#pragma unroll
        for (int i = 0; i < NP; ++i) { const int pc = F.tid + 512 * i; if (pc < NR * 16) pre[i] = __builtin_nontemporal_load((const u32x4*)(p.dbase + (size_t)(pc >> 4) * p.dstride + (pc & 15) * 8)); } }
    const int a = F.lane & 15, q = F.lane >> 4;
    for (; u < nunits; u += F.G) {
        const DftP p = dft_params<MODE>(F, u);
#pragma unroll
        for (int i = 0; i < NP; ++i) { const int pc = F.tid + 512 * i; if (pc < NR * 16) *(LAS u32x4*)(U + (pc >> 4) * ULD + (pc & 15) * 8) = pre[i]; }
        __syncthreads();
        if (u + F.G < nunits) { const DftP pn = dft_params<MODE>(F, u + F.G);
#pragma unroll
            for (int i = 0; i < NP; ++i) { const int pc = F.tid + 512 * i; if (pc < NR * 16) pre[i] = __builtin_nontemporal_load((const u32x4*)(pn.dbase + (size_t)(pc >> 4) * pn.dstride + (pc & 15) * 8)); } }
        {
            f32x4 acc[NR / 16][2];
#pragma unroll
            for (int mt = 0; mt < NR / 16; ++mt) { acc[mt][0] = (f32x4){0.f, 0.f, 0.f, 0.f}; acc[mt][1] = (f32x4){0.f, 0.f, 0.f, 0.f}; }
#pragma unroll
            for (int ks = 0; ks < 4; ++ks) {
                const bf16x8 b0 = *(const LAS bf16x8*)(FDl + ((2 * F.wave) * 16 + a) * ULD + ks * 32 + 8 * q), b1 = *(const LAS bf16x8*)(FDl + ((2 * F.wave + 1) * 16 + a) * ULD + ks * 32 + 8 * q);
#pragma unroll
                for (int mt = 0; mt < NR / 16; ++mt) { const bf16x8 av = *(const LAS bf16x8*)(U + (mt * 16 + a) * ULD + ks * 32 + 8 * q);
                    acc[mt][0] = __builtin_amdgcn_mfma_f32_16x16x32_bf16(av, b0, acc[mt][0], 0, 0, 0); acc[mt][1] = __builtin_amdgcn_mfma_f32_16x16x32_bf16(av, b1, acc[mt][1], 0, 0, 0); }
            }
#pragma unroll
            for (int t = 0; t < 2; ++t) { const int col = (2 * F.wave + t) * 16 + a, ri = col >> 7, k2 = col & 127;
#pragma unroll
                for (int mt = 0; mt < NR / 16; ++mt) { const int k0 = ri * NR + 16 * mt + 4 * q;
                    u32x2 w; w.x = pk2(acc[mt][t][0], acc[mt][t][1]); w.y = pk2(acc[mt][t][2], acc[mt][t][3]);
                    *(LAS u32x2*)(DT + k2 * LD + (k0 ^ (((k2 >> 3) & GM) << 3))) = w; } }
        }
        __syncthreads();
        for (int task = F.wave; task < (MD / 16) * 2; task += NWAVES) {
            const int mt = task >> 1, cht = task & 1;
            f32x4 acc[4];
#pragma unroll
            for (int ct = 0; ct < 4; ++ct) acc[ct] = (f32x4){0.f, 0.f, 0.f, 0.f};
#pragma unroll
            for (int ks = 0; ks < KD / 32; ++ks) {
                const bf16x8 bw = *(const bf16x8*)(p.W + (size_t)(mt * 16 + a) * KD + ks * 32 + 8 * q);
#pragma unroll
                for (int ct = 0; ct < 4; ++ct) {
                    const int ch = cht * 64 + 16 * (a >> 2) + 4 * ct + (a & 3);
                    const bf16x8 av = *(const LAS bf16x8*)(DT + ch * LD + ((ks * 32 + 8 * q) ^ (((ch >> 3) & GM) << 3)));
                    acc[ct] = __builtin_amdgcn_mfma_f32_16x16x32_bf16(av, bw, acc[ct], 0, 0, 0);
                }
            }
            const int m = mt * 16 + a, rm = m / J, j = m % J;
            bf16* o = p.obase + (size_t)j * p.ostride + rm * 512 + cht * 64 + 16 * q;
            u32x4 w0, w1;
            w0.x = pk2(acc[0][0], acc[0][1]); w0.y = pk2(acc[0][2], acc[0][3]); w0.z = pk2(acc[1][0], acc[1][1]); w0.w = pk2(acc[1][2], acc[1][3]);
            w1.x = pk2(acc[2][0], acc[2][1]); w1.y = pk2(acc[2][2], acc[2][3]); w1.z = pk2(acc[3][0], acc[3][1]); w1.w = pk2(acc[3][2], acc[3][3]);
            *(u32x4*)o = w0; *(u32x4*)(o + 8) = w1;
        }
        __syncthreads();
    }
}

__device__ __forceinline__ void phase_fourier_a_conv(Frame& F) {
    const bf16* P = (const bf16*)(F.ws + WS_BUFP);
    dft_units_a<0, 64>(F, 2048);
    __syncthreads();
    dft_units_a<1, 16>(F, 512);
    bf16* MIX = (bf16*)(F.ws + WS_BUFA);
    const float* cw = F.in[I_ECONV];
    float w0[8], w1[8], w2[8];
#pragma unroll
    for (int i = 0; i < 8; ++i) { w0[i] = cw[8 * F.lane + i]; w1[i] = cw[512 + 8 * F.lane + i]; w2[i] = cw[1024 + 8 * F.lane + i]; }
    const int gw = F.vcu * NWAVES + F.wave, NGW = F.G * NWAVES;
    auto conv_tokens = [&](int t, auto ntc) {
        constexpr int NT = decltype(ntc)::value;
        int pos, len; if (t < TL) { pos = t & 4095; len = 4096; } else { pos = (t - TL) & 255; len = 256; }
        const bf16* row = P + (size_t)t * EIN + 8 * F.lane;
        u32x4 gb[NT], gc[NT + 2], uc[NT + 2];
#pragma unroll
        for (int d = 0; d < NT + 2; ++d) { const int pp = pos + d - 1;
            if (pp >= 0 && pp < len) { gc[d] = *(const u32x4*)(row + (ptrdiff_t)(d - 1) * EIN + 1024); uc[d] = *(const u32x4*)(row + (ptrdiff_t)(d - 1) * EIN + 1536); }
            else { gc[d] = (u32x4){0u, 0u, 0u, 0u}; uc[d] = (u32x4){0u, 0u, 0u, 0u}; } }
#pragma unroll
        for (int q = 0; q < NT; ++q) gb[q] = __builtin_nontemporal_load((const u32x4*)(row + (size_t)q * EIN + 512));
        float pl[NT + 2][8];
#pragma unroll
        for (int d = 0; d < NT + 2; ++d)
#pragma unroll
            for (int i = 0; i < 4; ++i) { pl[d][2 * i] = bflo(gc[d][i]) * bflo(uc[d][i]); pl[d][2 * i + 1] = bfhi(gc[d][i]) * bfhi(uc[d][i]); }
#pragma unroll
        for (int q = 0; q < NT; ++q) {
            float y[8];
#pragma unroll
            for (int i = 0; i < 4; ++i) {
                y[2 * i] = bflo(gb[q][i]) * (w0[2 * i] * pl[q][2 * i] + w1[2 * i] * pl[q + 1][2 * i] + w2[2 * i] * pl[q + 2][2 * i]);
                y[2 * i + 1] = bfhi(gb[q][i]) * (w0[2 * i + 1] * pl[q][2 * i + 1] + w1[2 * i + 1] * pl[q + 1][2 * i + 1] + w2[2 * i + 1] * pl[q + 2][2 * i + 1]);
            }
            u32x4 o; o.x = pk2(y[0], y[1]); o.y = pk2(y[2], y[3]); o.z = pk2(y[4], y[5]); o.w = pk2(y[6], y[7]);
            *(u32x4*)(MIX + (size_t)(t + q) * D + 512 + 8 * F.lane) = o;
        }
    };
    for (int t = 4 * gw; t < TL; t += 4 * NGW) conv_tokens(t, std::integral_constant<int, 4>{});
    for (int t = TL + gw; t < T; t += NGW) conv_tokens(t, std::integral_constant<int, 1>{});
}

__device__ __forceinline__ void phase_fourier_c(Frame& F) {
    dft_units<2, 128, 64, 64>(F, 2048);
    dft_units<3, 32, 16, 16>(F, 512);
}

constexpr int RW_LD = 1032;
template <bool SPLIT>
__device__ __forceinline__ void phase_route(Frame& F, int layer, int ntok) {
    LAS bf16* rwh = (LAS bf16*)F.lds;
    LAS bf16* rwl = (LAS bf16*)(F.lds + 33024);
    LAS unsigned* cnt = (LAS unsigned*)(F.lds + 66048);
    LAS int* gb = (LAS int*)(F.lds + 66048 + 128);
    LAS float* lgs = (LAS float*)(F.lds + 66048 + 256) + F.wave * 256;
    LAS int* tinfo = (LAS int*)(F.lds + 66048 + 256 + 8192);
    LAS float* GS = (LAS float*)(F.lds + 81920);
    LAS float* SH = GS + 2048;
    const float* RW = F.in[I_RW];
    int tA, nA, tB, nB;
    if constexpr (SPLIT) {
        const int xs = F.vcu >> 5, rs = F.vcu & 31;
        if (rs >= 28) return;
        const int j = 28 * xs + rs;
        tA = 128 * j; nA = 128; tB = 28672 + 32 * j; nB = (j < 192) ? 32 : 0;
    } else { const int per_ = ntok / F.G; tA = blockIdx.x * per_; nA = per_; tB = 0; nB = 0; }
    const int r0 = mod_row(tA), mr1 = SPLIT ? mod_row(tB) : min(r0 + 1, 8);
    const float* mods = (const float*)(F.ws + WS_MODS) + (size_t)layer * 9 * 6144;
    const float* g = F.in[I_NFG] + layer * 1024;
    for (int i = F.tid; i < 16384; i += 512) { const int k = i >> 4, e = i & 15; const float w = RW[i]; const unsigned hi = f2bf(w); const float wl = w - __builtin_bit_cast(float, hi << 16);
        rwh[e * RW_LD + k] = (bf16)hi; rwl[e * RW_LD + k] = (bf16)f2bf(wl); }
    for (int i = F.tid; i < 2048; i += 512) { const int sl = i >> 10, c = i & 1023; const int rr = sl ? mr1 : r0; const float* m = mods + (size_t)rr * 6144;
        GS[i] = g[c] * (m[4 * 1024 + c] + 1.0f); SH[i] = m[3 * 1024 + c]; }
    if (F.tid < 16) cnt[F.tid] = 0u;
    __syncthreads();
    bf16* FB = (bf16*)(F.ws + WS_BUFA);
    const bool f8 = layer ? (FP8_G1_L1 != 0) : (FP8_G1_L0 != 0);
    int* route = (int*)(F.ws + WS_ROUTE);
    const int tk = F.lane & 15, kg = F.lane >> 4;
    for (int st = 0; st < 2; ++st) {
    const int t0 = st ? tB : tA, per = st ? nB : nA, li0 = st ? nA : 0;
    if (per == 0) break;
    if constexpr (SPLIT) { if (st == 0) ctr_wait(F, WS_P5F, 224u); else ctr_wait(F, WS_P5C, 32u); }
    for (int g0 = 16 * F.wave; g0 < per; g0 += 16 * NWAVES) {
        const int nv = min(16, per - g0);
        const int tq = t0 + g0 + (tk < nv ? tk : 0);
        const bf16* hr = h_row(F, tq) + 8 * kg;
        float s2 = 0.f;
        {
            u32x4 raw[32];
#pragma unroll
            for (int ks = 0; ks < 32; ++ks) raw[ks] = *(const u32x4*)(hr + 32 * ks);
#pragma unroll
            for (int ks = 0; ks < 32; ++ks)
#pragma unroll
                for (int i = 0; i < 4; ++i) { const float a = bflo(raw[ks][i]), b2 = bfhi(raw[ks][i]); s2 += a * a + b2 * b2; }
        }
        s2 += __shfl_xor(s2, 16); s2 += __shfl_xor(s2, 32);
        const float rstd = 1.0f / sqrtf(s2 * (1.0f / D) + EPS);
        const int sl = (mod_row(tq) != r0) ? 1024 : 0;
        const LAS float* gsp = GS + sl + 8 * kg; const LAS float* shp = SH + sl + 8 * kg;
        unsigned char* fb8 = (unsigned char*)FB + (size_t)tq * D + 8 * kg;
        bf16* fb16 = FB + (size_t)tq * D + 8 * kg;
        f32x4 acc = (f32x4){0.f, 0.f, 0.f, 0.f};
        u32x4 nx[8];
#pragma unroll
        for (int j = 0; j < 8; ++j) nx[j] = *(const u32x4*)(hr + 32 * j);
#pragma unroll 1
        for (int k4 = 0; k4 < 4; ++k4) {
            u32x4 cu[8];
#pragma unroll
            for (int j = 0; j < 8; ++j) cu[j] = nx[j];
            if (k4 < 3) {
#pragma unroll
                for (int j = 0; j < 8; ++j) nx[j] = *(const u32x4*)(hr + 32 * (8 * k4 + 8 + j)); }
#pragma unroll
            for (int j = 0; j < 8; ++j) {
                const int ks = 8 * k4 + j;
                const f32x4 g0v = *(const LAS f32x4*)(gsp + 32 * ks), g1v = *(const LAS f32x4*)(gsp + 32 * ks + 4), s0v = *(const LAS f32x4*)(shp + 32 * ks), s1v = *(const LAS f32x4*)(shp + 32 * ks + 4);
                float f[8];
                f[0] = bflo(cu[j].x) * rstd * g0v.x + s0v.x; f[1] = bfhi(cu[j].x) * rstd * g0v.y + s0v.y; f[2] = bflo(cu[j].y) * rstd * g0v.z + s0v.z; f[3] = bfhi(cu[j].y) * rstd * g0v.w + s0v.w;
                f[4] = bflo(cu[j].z) * rstd * g1v.x + s1v.x; f[5] = bfhi(cu[j].z) * rstd * g1v.y + s1v.y; f[6] = bflo(cu[j].w) * rstd * g1v.z + s1v.z; f[7] = bfhi(cu[j].w) * rstd * g1v.w + s1v.w;
                u32x4 hi, lo;
#pragma unroll
                for (int i = 0; i < 4; ++i) { const unsigned h0 = f2bf(f[2 * i]), h1 = f2bf(f[2 * i + 1]); hi[i] = h0 | (h1 << 16);
                    lo[i] = pk2(f[2 * i] - __builtin_bit_cast(float, h0 << 16), f[2 * i + 1] - __builtin_bit_cast(float, h1 << 16)); }
                if (tk < nv) {
                    if (f8) { u32x2 o; o.x = pg8::pk4_fp8(f[0], f[1], f[2], f[3]); o.y = pg8::pk4_fp8(f[4], f[5], f[6], f[7]); *(u32x2*)(fb8 + 32 * ks) = o; }
                    else *(u32x4*)(fb16 + 32 * ks) = hi;
                }
                const bf16x8 bh = *(const LAS bf16x8*)(rwh + tk * RW_LD + 32 * ks + 8 * kg), bl = *(const LAS bf16x8*)(rwl + tk * RW_LD + 32 * ks + 8 * kg);
                const bf16x8 ah = __builtin_bit_cast(bf16x8, hi), al = __builtin_bit_cast(bf16x8, lo);
                acc = __builtin_amdgcn_mfma_f32_16x16x32_bf16(ah, bh, acc, 0, 0, 0);
                acc = __builtin_amdgcn_mfma_f32_16x16x32_bf16(ah, bl, acc, 0, 0, 0);
                acc = __builtin_amdgcn_mfma_f32_16x16x32_bf16(al, bh, acc, 0, 0, 0);
            }
        }
#pragma unroll
        for (int j = 0; j < 4; ++j) lgs[(4 * kg + j) * 16 + tk] = acc[j];
        LDS_WAIT(); asm volatile("" ::: "memory");
        if (F.lane < nv) {
            const int tqq = t0 + g0 + F.lane;
            float aff[16], sel[16];
#pragma unroll
            for (int e4 = 0; e4 < 4; ++e4) { const f32x4 l4 = *(const LAS f32x4*)(lgs + F.lane * 16 + 4 * e4); const f32x4 b4 = *(const f32x4*)(F.in[I_RB] + 4 * e4);
                aff[4 * e4] = 1.0f / (1.0f + expf(-l4.x)); aff[4 * e4 + 1] = 1.0f / (1.0f + expf(-l4.y)); aff[4 * e4 + 2] = 1.0f / (1.0f + expf(-l4.z)); aff[4 * e4 + 3] = 1.0f / (1.0f + expf(-l4.w));
                sel[4 * e4] = aff[4 * e4] + b4.x; sel[4 * e4 + 1] = aff[4 * e4 + 1] + b4.y; sel[4 * e4 + 2] = aff[4 * e4 + 2] + b4.z; sel[4 * e4 + 3] = aff[4 * e4 + 3] + b4.w; }
            int best = 0; float bs = -1e30f;
#pragma unroll
            for (int gq = 0; gq < 4; ++gq) { const float a = sel[4 * gq], b = sel[4 * gq + 1], c = sel[4 * gq + 2], d = sel[4 * gq + 3];
                const float s = fmaxf(fmaxf(fmaxf(a + b, a + c), fmaxf(a + d, b + c)), fmaxf(b + d, c + d));
                if (s > bs) { bs = s; best = gq; } }
            float sv[4], av[4];
#pragma unroll
            for (int i = 0; i < 4; ++i) { sv[i] = sel[i]; av[i] = aff[i]; }
#pragma unroll
            for (int gq = 1; gq < 4; ++gq) if (best == gq) {
#pragma unroll
                for (int i = 0; i < 4; ++i) { sv[i] = sel[4 * gq + i]; av[i] = aff[4 * gq + i]; } }
            int i1 = 0; float s1 = sv[0], a1 = av[0];
#pragma unroll
            for (int i = 1; i < 4; ++i) if (sv[i] > s1) { s1 = sv[i]; a1 = av[i]; i1 = i; }
            int i2 = -1; float s2v = -1e30f, a2 = 0.f;
#pragma unroll
            for (int i = 0; i < 4; ++i) if (i != i1 && sv[i] > s2v) { s2v = sv[i]; a2 = av[i]; i2 = i; }
            const int e1 = 4 * best + i1, e2 = 4 * best + i2;
            const float wsum = a1 + a2, w1 = a1 / wsum, w2 = a2 / wsum;
            const unsigned r1 = atomicAdd((unsigned*)(cnt + e1), 1u), r2 = atomicAdd((unsigned*)(cnt + e2), 1u);
            int* ro = route + (size_t)tqq * 8;
            ro[0] = e1; ro[1] = e2; ro[4] = __builtin_bit_cast(int, w1); ro[5] = __builtin_bit_cast(int, w2);
            const int li = li0 + g0 + F.lane;
            tinfo[4 * li + 0] = e1; tinfo[4 * li + 1] = e2; tinfo[4 * li + 2] = (int)r1; tinfo[4 * li + 3] = (int)r2;
        }
        LDS_WAIT(); asm volatile("" ::: "memory");
    }
    }
    __syncthreads();
    if (F.tid < 16) gb[F.tid] = (int)__hip_atomic_fetch_add((unsigned*)(F.ws + WS_GCNT) + layer * 16 + F.tid, cnt[F.tid], __ATOMIC_RELAXED, __HIP_MEMORY_SCOPE_AGENT);
    __syncthreads();
    int* tokmap = (int*)(F.ws + WS_TOKMAP);
    for (int i = F.tid; i < nA + nB; i += 512) {
        const int tok = (i < nA) ? tA + i : tB + (i - nA);
        const int e1 = tinfo[4 * i], e2 = tinfo[4 * i + 1], p1 = gb[e1] + tinfo[4 * i + 2], p2 = gb[e2] + tinfo[4 * i + 3];
        tokmap[(size_t)e1 * T + p1] = tok; tokmap[(size_t)e2 * T + p2] = tok;
        int* ro = route + (size_t)tok * 8; ro[2] = p1; ro[3] = p2;
    }
}

__device__ __forceinline__ int moe_tables(Frame& F, int layer) {
    LAS int* tb = (LAS int*)(F.lds + LDS_CTL + 64); LAS int* cn = (LAS int*)(F.lds + LDS_CTL + 192);
    __syncthreads();
    if (F.tid < 16) cn[F.tid] = ld_coh((const int*)(F.ws + WS_GCNT) + layer * 16 + F.tid);
    __syncthreads();
    if (F.tid == 0) { int b = 0; for (int e = 0; e < 16; ++e) { tb[e] = b; b += (cn[e] + 255) >> 8; } tb[16] = b; }
    __syncthreads();
    return __builtin_amdgcn_readfirstlane(tb[16]);
}

template <int NQ> __device__ __forceinline__ void combine_tokens(Frame& F, int layer, int t) {
    const float* mods = (const float*)(F.ws + WS_MODS);
    const bf16* OS = (const bf16*)(F.ws + WS_BUFP);
    const int* route = (const int*)(F.ws + WS_ROUTE);
    const LAS int* tb = (const LAS int*)(F.lds + LDS_CTL + 64);
    bf16* A = (bf16*)(F.ws + WS_BUFA);
    {
        int rc[NQ][4]; float w0[NQ], w1[NQ];
#pragma unroll
        for (int q = 0; q < NQ; ++q) { const int* ro = route + (size_t)(t + q) * 8;
#pragma unroll
            for (int i = 0; i < 4; ++i) rc[q][i] = ld_coh(ro + i);
            w0[q] = ld_cohf((const float*)(ro + 4)); w1[q] = ld_cohf((const float*)(ro + 5)); }
        f32x4 v[NQ][4]; u32x2 oa[NQ][4], ob[NQ][4];
#pragma unroll
        for (int q = 0; q < NQ; ++q) { const bf16* hr = h_row(F, t + q);
            const size_t s0 = (size_t)(tb[rc[q][0]] * 256 + rc[q][2]) * D, s1 = (size_t)(tb[rc[q][1]] * 256 + rc[q][3]) * D;
#pragma unroll
            for (int j = 0; j < 4; ++j) { const int c = 4 * F.lane + 256 * j; { const u32x2 hv = *(const u32x2*)(hr + c); v[q][j] = (f32x4){bflo(hv.x), bfhi(hv.x), bflo(hv.y), bfhi(hv.y)}; } oa[q][j] = __builtin_nontemporal_load((const u32x2*)(OS + s0 + c)); ob[q][j] = __builtin_nontemporal_load((const u32x2*)(OS + s1 + c)); } }
        const int mr = mod_row(t);
        const float* m5 = mods + (size_t)(layer * 9 + mr) * 6144 + 5 * 1024;
#pragma unroll
        for (int j = 0; j < 4; ++j) { const f32x4 g5 = *(const f32x4*)(m5 + 4 * F.lane + 256 * j);
#pragma unroll
            for (int q = 0; q < NQ; ++q) { const u32x2 a = oa[q][j], b2 = ob[q][j];
                const f32x4 o = (f32x4){w0[q] * bflo(a.x) + w1[q] * bflo(b2.x), w0[q] * bfhi(a.x) + w1[q] * bfhi(b2.x), w0[q] * bflo(a.y) + w1[q] * bflo(b2.y), w0[q] * bfhi(a.y) + w1[q] * bfhi(b2.y)};
                v[q][j] = v[q][j] + g5 * o; } }
#pragma unroll
        for (int q = 0; q < NQ; ++q) {
            if (layer == 0) {
                bf16* hr = h_row(F, t + q);
#pragma unroll
                for (int j = 0; j < 4; ++j) { u32x2 o; o.x = pk2(v[q][j].x, v[q][j].y); o.y = pk2(v[q][j].z, v[q][j].w); *(u32x2*)(hr + 4 * F.lane + 256 * j) = o; }
                const float* m = mods + (size_t)(9 + mr) * 6144;
                norm_mod_store(v[q], F.in[I_NMG] + 1024, m, m + 1024, A + (size_t)(t + q) * D, F.lane);
            } else {
                float s2 = 0.f;
#pragma unroll
                for (int j = 0; j < 4; ++j) s2 += (v[q][j].x * v[q][j].x + v[q][j].y * v[q][j].y) + (v[q][j].z * v[q][j].z + v[q][j].w * v[q][j].w);
                const float rstd = 1.0f / sqrtf(wave_sum(s2) * (1.0f / D) + EPS);
                float* orow = F.out + (size_t)(t + q) * D;
#pragma unroll
                for (int j = 0; j < 4; ++j) { const int c = 4 * F.lane + 256 * j; __builtin_nontemporal_store(v[q][j] * rstd * *(const f32x4*)(F.in[I_FG] + c), (f32x4*)(orow + c)); }
            }
        }
    }
}
__device__ __forceinline__ void phase_combine(Frame& F, int layer, int ntok) {
    const int gw = F.vcu * NWAVES + F.wave, NGW = F.G * NWAVES;
    if (layer == 0) { for (int t = 2 * gw; t < TL; t += 2 * NGW) combine_tokens<2>(F, 0, t); for (int t = TL + gw; t < ntok; t += NGW) combine_tokens<1>(F, 0, t); }
    else { for (int t = 4 * gw; t < TL; t += 4 * NGW) combine_tokens<4>(F, 1, t); }
}

constexpr int KV_LD = 72, VL_OFF = 384 * KV_LD * 2, ROPE_LDS = 131072;
typedef short v4i16_t __attribute__((ext_vector_type(4)));

__device__ __forceinline__ bf16x8 rope_pack(const u32x4 x1, const u32x4 x2, const LAS float* cs, const LAS float* sn, float scale, bool second) {
    const f32x4 c0 = *(const LAS f32x4*)cs, c1 = *(const LAS f32x4*)(cs + 4), s0 = *(const LAS f32x4*)sn, s1 = *(const LAS f32x4*)(sn + 4);
    float c[8] = {c0.x, c0.y, c0.z, c0.w, c1.x, c1.y, c1.z, c1.w}, s[8] = {s0.x, s0.y, s0.z, s0.w, s1.x, s1.y, s1.z, s1.w};
    float a[8], b[8];
#pragma unroll
    for (int i = 0; i < 4; ++i) { a[2 * i] = bflo(x1[i]); a[2 * i + 1] = bfhi(x1[i]); b[2 * i] = bflo(x2[i]); b[2 * i + 1] = bfhi(x2[i]); }
    float o[8];
#pragma unroll
    for (int i = 0; i < 8; ++i) o[i] = (second ? (b[i] * c[i] + a[i] * s[i]) : (a[i] * c[i] - b[i] * s[i])) * scale;
    u32x4 w; w.x = pk2(o[0], o[1]); w.y = pk2(o[2], o[3]); w.z = pk2(o[4], o[5]); w.w = pk2(o[6], o[7]);
    return __builtin_bit_cast(bf16x8, w);
}

struct AttnU { int b, qb, kvh; };
__device__ __forceinline__ AttnU attn_unit_of(int u) { AttnU r; r.kvh = u & 1; r.qb = (u >> 1) & 31; r.b = u >> 6; return r; }

__device__ __forceinline__ void attn_load_latk(Frame& F, const bf16* P1, AttnU u, u32x4 (&lk)[2][4]) {
    const u32x4 z = (u32x4){0u, 0u, 0u, 0u};
#pragma unroll
    for (int it = 0; it < 2; ++it) { const int task = F.tid + 512 * it, kidx = task >> 1, hh = task & 1, pos = u.qb * 128 - 128 + kidx;
        const bool ok = task < 768 && pos >= 0 && pos < NSEQ;
        const bf16* row = P1 + (size_t)(u.b * NSEQ + (ok ? pos : 0)) * OIN + 1024 + u.kvh * 64 + 8 * hh;
#pragma unroll
        for (int st = 0; st < 4; ++st) lk[it][st] = ok ? *(const u32x4*)(row + 16 * st) : z; }
}
__device__ __forceinline__ void attn_load_latv(Frame& F, const bf16* P1, AttnU u, u32x4 (&lv)[6]) {
    const u32x4 z = (u32x4){0u, 0u, 0u, 0u};
#pragma unroll
    for (int it = 0; it < 6; ++it) { const int task = F.tid + 512 * it, kidx = task >> 3, c8 = task & 7, pos = u.qb * 128 - 128 + kidx;
        const bool ok = pos >= 0 && pos < NSEQ;
        lv[it] = ok ? *(const u32x4*)(P1 + (size_t)(u.b * NSEQ + (ok ? pos : 0)) * OIN + 1152 + u.kvh * 64 + 8 * c8) : z; }
}
__device__ __forceinline__ void attn_write_lat(Frame& F, AttnU u, const u32x4 (&lk)[2][4], const u32x4 (&lv)[6]) {
    LAS bf16* KL = (LAS bf16*)F.lds; LAS bf16* VL = (LAS bf16*)(F.lds + VL_OFF); const LAS float* rope = (const LAS float*)(F.lds + ROPE_LDS);
#pragma unroll
    for (int it = 0; it < 2; ++it) { const int task = F.tid + 512 * it, kidx = task >> 1, hh = task & 1; int pos = u.qb * 128 - 128 + kidx; pos = pos < 0 ? 0 : (pos > NSEQ - 1 ? NSEQ - 1 : pos);
        if (task < 768) {
            LAS bf16* d = KL + kidx * KV_LD + 8 * hh;
            const LAS float* c0 = rope + (pos >> 6) * 16 + 8 * hh; const LAS float* c1 = rope + (pos & 63) * 16 + 8 * hh;
            *(LAS bf16x8*)(d) = rope_pack(lk[it][0], lk[it][1], c0, c0 + 1024, 1.0f, false);
            *(LAS bf16x8*)(d + 16) = rope_pack(lk[it][0], lk[it][1], c0, c0 + 1024, 1.0f, true);
            *(LAS bf16x8*)(d + 32) = rope_pack(lk[it][2], lk[it][3], c1, c1 + 1024, 1.0f, false);
            *(LAS bf16x8*)(d + 48) = rope_pack(lk[it][2], lk[it][3], c1, c1 + 1024, 1.0f, true);
        } }
#pragma unroll
    for (int it = 0; it < 6; ++it) { const int task = F.tid + 512 * it, kidx = task >> 3, c8 = task & 7; *(LAS u32x4*)(VL + kidx * KV_LD + 8 * c8) = lv[it]; }
}
__device__ __forceinline__ void attn_load_ctx(Frame& F, const bf16* P1, AttnU u, u32x4 (&ck)[4], u32x4 (&cv)[4]) {
#pragma unroll
    for (int it = 0; it < 4; ++it) { const int task = F.tid + 512 * it, kidx = task >> 3, c8 = task & 7;
        const bf16* row = P1 + (size_t)(TL + u.b * LCTX + kidx) * OIN + 1024 + u.kvh * 64 + 8 * c8;
        ck[it] = *(const u32x4*)row; cv[it] = *(const u32x4*)(row + 128); }
}
__device__ __forceinline__ void attn_write_ctx(Frame& F, const u32x4 (&ck)[4], const u32x4 (&cv)[4]) {
    LAS bf16* KL = (LAS bf16*)F.lds; LAS bf16* VL = (LAS bf16*)(F.lds + VL_OFF);
#pragma unroll
    for (int it = 0; it < 4; ++it) { const int task = F.tid + 512 * it, kidx = task >> 3, c8 = task & 7;
        *(LAS u32x4*)(KL + kidx * KV_LD + 8 * c8) = ck[it]; *(LAS u32x4*)(VL + kidx * KV_LD + 8 * c8) = cv[it]; }
}

__device__ __forceinline__ unsigned cvtpk(float lo, float hi) { unsigned r; asm volatile("v_cvt_pk_bf16_f32 %0, %1, %2" : "=v"(r) : "v"(lo), "v"(hi)); return r; }
__device__ __forceinline__ float xhalf_max(float x) { const auto r = __builtin_amdgcn_permlane32_swap(__builtin_bit_cast(unsigned, x), __builtin_bit_cast(unsigned, x), false, false);
    return fmaxf(__builtin_bit_cast(float, r[0]), __builtin_bit_cast(float, r[1])); }
__device__ __forceinline__ float xhalf_sum(float x) { const auto r = __builtin_amdgcn_permlane32_swap(__builtin_bit_cast(unsigned, x), __builtin_bit_cast(unsigned, x), false, false);
    return __builtin_bit_cast(float, r[0]) + __builtin_bit_cast(float, r[1]); }
__device__ __forceinline__ void attn_tiles(Frame& F, int kt0, int kt1, int mk0, int mk1, const bf16x8 (&qf)[4], f32x16 (&O)[2], float& mrun, float& lrun, int qrel) {
    if (kt0 > kt1) return;
    const LAS bf16* KL = (const LAS bf16*)F.lds; const LAS bf16* VL = (const LAS bf16*)(F.lds + VL_OFF);
    const int r32 = F.lane & 31, hh = F.lane >> 5;
    const int q4 = (F.lane & 15) >> 2, p4 = F.lane & 3, blk = (F.lane >> 4) & 1;
    const LAS bf16* kp = KL + (kt0 * 32 + r32) * KV_LD + 8 * hh;
    const LAS bf16* vp = VL + (kt0 * 32 + 4 * hh + q4) * KV_LD + 16 * blk + 4 * p4;
    bf16x8 kn[4];
#pragma unroll
    for (int st = 0; st < 4; ++st) kn[st] = *(const LAS bf16x8*)(kp + 16 * st);
    for (int kt = kt0; kt <= kt1; ++kt) {
        bf16x8 kf[4];
#pragma unroll
        for (int st = 0; st < 4; ++st) kf[st] = kn[st];
        v4i16_t vlo[2][2], vhi[2][2];
#pragma unroll
        for (int dt = 0; dt < 2; ++dt)
#pragma unroll
            for (int s2 = 0; s2 < 2; ++s2) { vlo[dt][s2] = __builtin_amdgcn_ds_read_tr16_b64_v4i16((LAS v4i16_t*)(vp + (16 * s2) * KV_LD + dt * 32));
                vhi[dt][s2] = __builtin_amdgcn_ds_read_tr16_b64_v4i16((LAS v4i16_t*)(vp + (16 * s2 + 8) * KV_LD + dt * 32)); }
        kp += 32 * KV_LD; vp += 32 * KV_LD;
        if (kt < kt1) {
#pragma unroll
            for (int st = 0; st < 4; ++st) kn[st] = *(const LAS bf16x8*)(kp + 16 * st); }
        __builtin_amdgcn_sched_barrier(0);
        f32x16 s;
#pragma unroll
        for (int r = 0; r < 16; ++r) s[r] = 0.f;
#pragma unroll
        for (int st = 0; st < 4; ++st) s = __builtin_amdgcn_mfma_f32_32x32x16_bf16(kf[st], qf[st], s, 0, 0, 0);
        if (kt == mk0 || kt == mk1) {
#pragma unroll
            for (int r = 0; r < 16; ++r) { const int dlt = kt * 32 + (r & 3) + 8 * (r >> 2) + 4 * hh - qrel; s[r] = (dlt <= 128 && dlt >= -128) ? s[r] : -INFINITY; } }
        float mx = fmaxf(fmaxf(s[0], s[1]), fmaxf(s[2], s[3]));
#pragma unroll
        for (int r = 4; r < 16; r += 4) mx = fmaxf(mx, fmaxf(fmaxf(s[r], s[r + 1]), fmaxf(s[r + 2], s[r + 3])));
        mx = xhalf_max(mx);
        const float mnew = fmaxf(mrun, mx);
        float ps0 = 0.f, ps1 = 0.f;
#pragma unroll
        for (int r = 0; r < 16; r += 2) { s[r] = __builtin_amdgcn_exp2f(s[r] - mnew); s[r + 1] = __builtin_amdgcn_exp2f(s[r + 1] - mnew); ps0 += s[r]; ps1 += s[r + 1]; }
        const float ps = xhalf_sum(ps0 + ps1);
        if (__any(mnew > mrun)) {
            const float alpha = __builtin_amdgcn_exp2f(mrun - mnew);
            lrun *= alpha;
#pragma unroll
            for (int dt = 0; dt < 2; ++dt)
#pragma unroll
                for (int r = 0; r < 16; ++r) O[dt][r] *= alpha;
        }
        lrun += ps; mrun = mnew;
        bf16x8 pb[2];
#pragma unroll
        for (int s2 = 0; s2 < 2; ++s2) { u32x4 w; w.x = cvtpk(s[8 * s2 + 0], s[8 * s2 + 1]); w.y = cvtpk(s[8 * s2 + 2], s[8 * s2 + 3]); w.z = cvtpk(s[8 * s2 + 4], s[8 * s2 + 5]); w.w = cvtpk(s[8 * s2 + 6], s[8 * s2 + 7]);
            pb[s2] = __builtin_bit_cast(bf16x8, w); }
#pragma unroll
        for (int dt = 0; dt < 2; ++dt)
#pragma unroll
            for (int s2 = 0; s2 < 2; ++s2) {
                const bf16x8 va = (bf16x8){vlo[dt][s2][0], vlo[dt][s2][1], vlo[dt][s2][2], vlo[dt][s2][3], vhi[dt][s2][0], vhi[dt][s2][1], vhi[dt][s2][2], vhi[dt][s2][3]};
                O[dt] = __builtin_amdgcn_mfma_f32_32x32x16_bf16(va, pb[s2], O[dt], 0, 0, 0);
            }
    }
}

__device__ __forceinline__ void phase_attn(Frame& F) {
    const bf16* P1 = (const bf16*)(F.ws + WS_BUFP);
    bf16* MIX = (bf16*)(F.ws + WS_BUFA);
    const int r32 = F.lane & 31, hh = F.lane >> 5;
    constexpr float QSC = 0.125f * 1.4426950408889634f;
    LAS float* ropel = (LAS float*)(F.lds + ROPE_LDS);
    for (int i = F.tid; i < 2048; i += 512) ropel[i] = ((const float*)(F.ws + WS_ROPE))[i];
    u32x4 lk[2][4], lv[6], ck[4], cv[4];
    const int nu = (512 - F.vcu + F.G - 1) / F.G;
    if (nu > 0) attn_load_latk(F, P1, attn_unit_of(F.vcu), lk);
    for (int ui = 0; ui < nu; ++ui) {
        const AttnU u = attn_unit_of(F.vcu + ui * F.G);
        u32x4 qr[2][4];
#pragma unroll
        for (int i = 0; i < 2; ++i) { const int task = F.wave + 8 * i, g = task & 3, sub = task >> 2, head = u.kvh * 4 + g, pos = u.qb * 128 + 32 * sub + r32;
            const bf16* row = P1 + (size_t)(u.b * NSEQ + pos) * OIN + 512 + head * 64 + 8 * hh;
#pragma unroll
            for (int st = 0; st < 4; ++st) qr[i][st] = __builtin_nontemporal_load((const u32x4*)(row + 16 * st)); }
        attn_load_latv(F, P1, u, lv);
        __syncthreads();
        attn_write_lat(F, u, lk, lv);
        bf16x8 qf[2][4]; f32x16 O[2][2]; float mrun[2], lrun[2];
#pragma unroll
        for (int i = 0; i < 2; ++i) { const int task = F.wave + 8 * i, g = task & 3, sub = task >> 2, head = u.kvh * 4 + g, pos = u.qb * 128 + 32 * sub + r32;
            const LAS float* c0 = ropel + (pos >> 6) * 16 + 8 * hh; const LAS float* c1 = ropel + (pos & 63) * 16 + 8 * hh;
            qf[i][0] = rope_pack(qr[i][0], qr[i][1], c0, c0 + 1024, QSC, false); qf[i][1] = rope_pack(qr[i][0], qr[i][1], c0, c0 + 1024, QSC, true);
            qf[i][2] = rope_pack(qr[i][2], qr[i][3], c1, c1 + 1024, QSC, false); qf[i][3] = rope_pack(qr[i][2], qr[i][3], c1, c1 + 1024, QSC, true);
            mrun[i] = F.in[I_OSINK][head] * 1.4426950408889634f; lrun[i] = 1.0f;
#pragma unroll
            for (int dt = 0; dt < 2; ++dt)
#pragma unroll
                for (int r = 0; r < 16; ++r) O[i][dt][r] = 0.f; }
        __syncthreads();
        const int kt_lo = (u.qb == 0) ? 4 : 0, kt_hi = (u.qb == 31) ? 7 : 11;
#pragma unroll
        for (int i = 0; i < 2; ++i) { const int sub = (F.wave + 8 * i) >> 2, qrel = 128 + 32 * sub + r32;
            attn_tiles(F, max(sub, kt_lo), min(sub + 8, kt_hi), sub, sub + 8, qf[i], O[i], mrun[i], lrun[i], qrel); }
        attn_load_ctx(F, P1, u, ck, cv);
        __syncthreads();
        attn_write_ctx(F, ck, cv);
        __syncthreads();
        if (ui + 1 < nu) attn_load_latk(F, P1, attn_unit_of(F.vcu + (ui + 1) * F.G), lk);
#pragma unroll
        for (int i = 0; i < 2; ++i) {
            attn_tiles(F, 0, 7, -1, -1, qf[i], O[i], mrun[i], lrun[i], 0);
            const int task = F.wave + 8 * i, g = task & 3, sub = task >> 2, head = u.kvh * 4 + g, pos = u.qb * 128 + 32 * sub + r32;
            const float inv = 1.0f / lrun[i];
            bf16* o = MIX + (size_t)(u.b * NSEQ + pos) * D + 512 + head * 64 + 4 * hh;
#pragma unroll
            for (int dt = 0; dt < 2; ++dt)
#pragma unroll
                for (int rg = 0; rg < 4; ++rg) { u32x2 w; w.x = pk2(O[i][dt][4 * rg] * inv, O[i][dt][4 * rg + 1] * inv); w.y = pk2(O[i][dt][4 * rg + 2] * inv, O[i][dt][4 * rg + 3] * inv);
                    *(u32x2*)(o + dt * 32 + 8 * rg) = w; }
        }
    }
    __syncthreads();
}

__device__ __forceinline__ void phase_pool_stencil(Frame& F) {
    const bf16* P1 = (const bf16*)(F.ws + WS_BUFP);
    bf16* MIX = (bf16*)(F.ws + WS_BUFA);
    const int gw = F.vcu * NWAVES + F.wave, NGW = F.G * NWAVES;
    const int r = 1 << (F.lane >> 4);
    constexpr int NT = 8, NR = NT + 16;
    for (int t = NT * gw; t < TL; t += NT * NGW) {
        const int pos = t & 4095;
        const bf16* base = P1 + (size_t)t * OIN + 8 * F.lane;
        u32x4 v[NR];
#pragma unroll
        for (int jj = 0; jj < NR; ++jj) { const int pj = pos + jj - 8; const bool ok = pj >= 0 && pj < NSEQ; v[jj] = ok ? *(const u32x4*)(base + (ptrdiff_t)(jj - 8) * OIN) : (u32x4){0u, 0u, 0u, 0u}; }
        float acc[NT][8];
#pragma unroll
        for (int q = 0; q < NT; ++q)
#pragma unroll
            for (int i = 0; i < 8; ++i) acc[q][i] = 0.f;
#pragma unroll
        for (int jj = 0; jj < NR; ++jj) {
            float x[8];
#pragma unroll
            for (int i = 0; i < 4; ++i) { x[2 * i] = bflo(v[jj][i]); x[2 * i + 1] = bfhi(v[jj][i]); }
#pragma unroll
            for (int q = 0; q < NT; ++q) { const int dd = jj - 8 - q; if (dd >= -8 && dd <= 8) { const float w = (dd <= r && dd >= -r) ? 1.0f : 0.0f;
#pragma unroll
                for (int i = 0; i < 8; ++i) acc[q][i] += w * x[i]; } }
        }
#pragma unroll
        for (int q = 0; q < NT; ++q) {
            const int pq = pos + q, lo = max(pq - r, 0), hi = min(pq + r + 1, NSEQ);
            const float ic = 1.0f / (float)(hi - lo);
            const u32x4 sv = v[q + 8];
            u32x4 o;
#pragma unroll
            for (int i = 0; i < 4; ++i) o[i] = pk2(acc[q][2 * i] * ic - bflo(sv[i]), acc[q][2 * i + 1] * ic - bfhi(sv[i]));
            *(u32x4*)(MIX + (size_t)(t + q) * D + 8 * F.lane) = o;
        }
    }
}

__device__ __forceinline__ void phase_attn_pool(Frame& F) {
    phase_attn(F);
#ifdef DBG_ATTN2
    phase_attn(F);
#endif
    phase_pool_stencil(F);
    __syncthreads();
    convert_l1_range(F, 120 * L1T_N + F.vcu * L1A_N, L1A_N, 40);
}

constexpr int NPHASE = 20;
__global__ void __launch_bounds__(NWAVES * 64, 2) mk_fwd(Args args) {
    extern __shared__ __attribute__((aligned(16))) unsigned char lds_raw[];
    Frame F;
    F.lds = (LAS unsigned char*)lds_raw;
    F.tid = threadIdx.x; F.lane = F.tid & 63; F.wave = __builtin_amdgcn_readfirstlane(F.tid >> 6);
    F.G = gridDim.x; { const int bx = blockIdx.x; F.vcu = (F.G % 8 == 0) ? (bx % 8) * (F.G / 8) + bx / 8 : bx; }
    F.ws = args.ws; F.in = args.in; F.out = args.out;
    for (int u = F.tid; u < (LDS_BYTES - LDS_CTL) / 4; u += NWAVES * 64) ((LAS unsigned*)(F.lds + LDS_CTL))[u] = 0u;
    __syncthreads();
    const int lo = args.ph_lo, hi = args.ph_hi;
    XcdBarrier bar; bar.bar = (unsigned*)(F.ws + WS_CTL); bar.x = 0; bar.st = nullptr;
    if (hi - lo > 1) bar = xcd_barrier_post((unsigned*)(F.ws + WS_CTL), (volatile LAS unsigned*)(F.lds + LDS_CTL));
#define IN(k) (lo <= (k) && (k) < hi)
#ifndef PHASE_MASK
#define PHASE_MASK 0xffffffffu
#endif
#define PH(k, ...) if constexpr (((PHASE_MASK >> (k)) & 1u) != 0u) if (IN(k)) { __VA_ARGS__ if constexpr (((DBG_DOUBLE >> (k)) & 1u) != 0u) { __VA_ARGS__ } }
#define SEAM(k) do { if (IN(k) && IN((k) + 1)) xcd_barrier(bar); } while (0)
    unsigned char* ws = F.ws;
    const float* mods = (const float*)(ws + WS_MODS);

    PH(1, { phase_prologue_a(F); }) SEAM(1);
    PH(2, {
        pg8::SchedDense S{(const char*)(ws + WS_BUFA), (const char*)(ws + WS_W_EIN), 1024, 8, 136, 0, 1088, F.vcu, F.G};
        pg8::EpiStore E{(bf16*)(ws + WS_BUFP), EIN};
        pg8::gemm_phase<pg8::EpiStore, pg8::SchedDense>(F.lds, 1024, S, E);
        if (F.vcu >= 64) { __syncthreads(); convert_l1_range(F, (F.vcu - 64) * L0T_N, L0T_N, 48, 0); }
    }) SEAM(2);
    PH(3, { phase_fourier_a_conv(F); }) SEAM(3);
    PH(4, { phase_fourier_c(F); }) SEAM(4);
    PH(5, {
        const int xs = F.vcu >> 5, rs = F.vcu & 31; const bool heavy = rs >= 28;
        pg8::SchedSplit S{(const char*)(ws + WS_BUFA), (const char*)(ws + WS_W_EOUT), 1024, heavy ? 448 + 4 * xs + (rs - 28) : 28 * xs + rs, heavy ? 32 : 224, heavy ? 3 : 2};
        pg8::EpiResid<true> E{F.in[I_X], F.in[I_CTX], (bf16*)(ws + WS_HB), mods + 2 * 1024};
        pg8::gemm_phase<pg8::EpiResid<true>, pg8::SchedSplit>(F.lds, 1024, S, E);
        ctr_publish(F, heavy ? WS_P5C : WS_P5F);
    })
    PH(6, { phase_route<true>(F, 0, T); }) SEAM(6);
    PH(7, {
        const int ntile = moe_tables(F, 0);
        if constexpr (FP8_G1_L0) {
            pg8::SchedMoe<true> S{(const char*)(ws + WS_BUFA), (const char*)(ws + WS_W_M1) + (size_t)0 * 32 * MiB, (const int*)(ws + WS_TOKMAP), (const LAS int*)(F.lds + LDS_CTL + 64), (const LAS int*)(F.lds + LDS_CTL + 192), 512, (size_t)MiB, ntile * 4, F.vcu, F.G};
            pg8::EpiSwiglu8 E{(unsigned char*)(ws + WS_BUFZ), pg8::W1_SCALE};
            pg8::gemm_phase<pg8::EpiSwiglu8, pg8::SchedMoe<true>, true>(F.lds, 512, S, E);
        } else {
            pg8::SchedMoe<true> S{(const char*)(ws + WS_BUFA), (const char*)(ws + WS_W_M1) + (size_t)0 * 32 * MiB, (const int*)(ws + WS_TOKMAP), (const LAS int*)(F.lds + LDS_CTL + 64), (const LAS int*)(F.lds + LDS_CTL + 192), 1024, (size_t)2 * MiB, ntile * 4, F.vcu, F.G};
            if constexpr (FP8_G2_L0) { pg8::EpiSwiglu8 E{(unsigned char*)(ws + WS_BUFZ), 1.0f}; pg8::gemm_phase<pg8::EpiSwiglu8, pg8::SchedMoe<true>>(F.lds, 1024, S, E); }
            else { pg8::EpiSwiglu E{(bf16*)(ws + WS_BUFZ)}; pg8::gemm_phase<pg8::EpiSwiglu, pg8::SchedMoe<true>>(F.lds, 1024, S, E); }
        }
    }) SEAM(7);
    PH(8, {
        const int ntile = moe_tables(F, 0);
        if constexpr (FP8_G2_L0) {
            pg8::SchedMoe<false> S{(const char*)(ws + WS_BUFZ), (const char*)(ws + WS_W_M2) + (size_t)0 * 16 * MiB, nullptr, (const LAS int*)(F.lds + LDS_CTL + 64), (const LAS int*)(F.lds + LDS_CTL + 192), 256, (size_t)512 * KiB, ntile * 4, F.vcu, F.G};
            pg8::EpiStoreS E{(bf16*)(ws + WS_BUFP), 1024, 1.0f / (pg8::HID_SCALE * pg8::W2_SCALE)};
            pg8::gemm_phase<pg8::EpiStoreS, pg8::SchedMoe<false>, true>(F.lds, 256, S, E);
        } else {
            pg8::SchedMoe<false> S{(const char*)(ws + WS_BUFZ), (const char*)(ws + WS_W_M2) + (size_t)0 * 16 * MiB, nullptr, (const LAS int*)(F.lds + LDS_CTL + 64), (const LAS int*)(F.lds + LDS_CTL + 192), 512, (size_t)MiB, ntile * 4, F.vcu, F.G};
            pg8::EpiStore E{(bf16*)(ws + WS_BUFP), 1024};
            pg8::gemm_phase<pg8::EpiStore, pg8::SchedMoe<false>>(F.lds, 512, S, E);
        }
    }) SEAM(8);
    PH(9, { (void)moe_tables(F, 0); phase_combine(F, 0, T); }) SEAM(9);
    PH(10, {
        pg8::SchedDense S{(const char*)(ws + WS_BUFA), (const char*)(ws + WS_W_OIN), 1024, 5, 128, 4, 648, F.vcu, F.G};
        pg8::EpiStore E{(bf16*)(ws + WS_BUFP), OIN};
        pg8::gemm_phase<pg8::EpiStore, pg8::SchedDense>(F.lds, 1024, S, E);
        if (F.vcu >= 136) { __syncthreads(); convert_l1_range(F, (F.vcu - 136) * L1T_N, L1T_N, 44); }
    }) SEAM(10);
    PH(11, { phase_attn_pool(F); }) SEAM(11);
    PH(12, {
        pg8::SchedDense S{(const char*)(ws + WS_BUFA), (const char*)(ws + WS_W_OOUT), 1024, 4, 128, 0, 512, F.vcu, F.G};
        pg8::EpiResid<false> E{nullptr, nullptr, (bf16*)(ws + WS_HB), mods + 9 * 6144 + 2 * 1024};
        pg8::gemm_phase<pg8::EpiResid<false>, pg8::SchedDense>(F.lds, 1024, S, E);
    }) SEAM(12);
    PH(13, { phase_route<false>(F, 1, TL); }) SEAM(13);
    PH(14, {
        const int ntile = moe_tables(F, 1);
        if constexpr (FP8_G1_L1) {
            pg8::SchedMoe<true> S{(const char*)(ws + WS_BUFA), (const char*)(ws + WS_W_M1) + (size_t)1 * 32 * MiB, (const int*)(ws + WS_TOKMAP), (const LAS int*)(F.lds + LDS_CTL + 64), (const LAS int*)(F.lds + LDS_CTL + 192), 512, (size_t)MiB, ntile * 4, F.vcu, F.G};
            pg8::EpiSwiglu8 E{(unsigned char*)(ws + WS_BUFZ), pg8::W1_SCALE};
            pg8::gemm_phase<pg8::EpiSwiglu8, pg8::SchedMoe<true>, true>(F.lds, 512, S, E);
        } else {
            pg8::SchedMoe<true> S{(const char*)(ws + WS_BUFA), (const char*)(ws + WS_W_M1) + (size_t)1 * 32 * MiB, (const int*)(ws + WS_TOKMAP), (const LAS int*)(F.lds + LDS_CTL + 64), (const LAS int*)(F.lds + LDS_CTL + 192), 1024, (size_t)2 * MiB, ntile * 4, F.vcu, F.G};
            if constexpr (FP8_G2_L1) { pg8::EpiSwiglu8 E{(unsigned char*)(ws + WS_BUFZ), 1.0f}; pg8::gemm_phase<pg8::EpiSwiglu8, pg8::SchedMoe<true>>(F.lds, 1024, S, E); }
            else { pg8::EpiSwiglu E{(bf16*)(ws + WS_BUFZ)}; pg8::gemm_phase<pg8::EpiSwiglu, pg8::SchedMoe<true>>(F.lds, 1024, S, E); }
        }
    }) SEAM(14);
    PH(15, {
        const int ntile = moe_tables(F, 1);
        if constexpr (FP8_G2_L1) {
            pg8::SchedMoe<false> S{(const char*)(ws + WS_BUFZ), (const char*)(ws + WS_W_M2) + (size_t)1 * 16 * MiB, nullptr, (const LAS int*)(F.lds + LDS_CTL + 64), (const LAS int*)(F.lds + LDS_CTL + 192), 256, (size_t)512 * KiB, ntile * 4, F.vcu, F.G};
            pg8::EpiStoreS E{(bf16*)(ws + WS_BUFP), 1024, 1.0f / (pg8::HID_SCALE * pg8::W2_SCALE)};
            pg8::gemm_phase<pg8::EpiStoreS, pg8::SchedMoe<false>, true>(F.lds, 256, S, E);
        } else {
            pg8::SchedMoe<false> S{(const char*)(ws + WS_BUFZ), (const char*)(ws + WS_W_M2) + (size_t)1 * 16 * MiB, nullptr, (const LAS int*)(F.lds + LDS_CTL + 64), (const LAS int*)(F.lds + LDS_CTL + 192), 512, (size_t)MiB, ntile * 4, F.vcu, F.G};
            pg8::EpiStore E{(bf16*)(ws + WS_BUFP), 1024};
            pg8::gemm_phase<pg8::EpiStore, pg8::SchedMoe<false>>(F.lds, 512, S, E);
        }
    }) SEAM(15);
    PH(16, { (void)moe_tables(F, 1); phase_combine(F, 1, TL); }) SEAM(16);
#ifdef DBG_XBAR
    if (hi - lo > 1) { for (int xb = 0; xb < DBG_XBAR; ++xb) xcd_barrier(bar); }
#endif
#undef IN
#undef SEAM
}

extern "C" void kernel_launch(void* const* d_in, const int* in_sizes, int n_in, void* d_out, int out_size, void* d_ws, size_t ws_size, hipStream_t stream) {
    static int grid = 0;
    if (grid == 0) {
        if (n_in != 22 || ws_size < WS_END) { fprintf(stderr, "kernel_launch: unexpected inputs (n_in %d, ws %zu)\n", n_in, ws_size); grid = -1; return; }
        int dev = 0, cus = 0, per_cu = 0;
        if (hipGetDevice(&dev) != hipSuccess || hipDeviceGetAttribute(&cus, hipDeviceAttributeMultiprocessorCount, dev) != hipSuccess) { grid = -1; return; }
        if (hipFuncSetAttribute((const void*)mk_fwd, hipFuncAttributeMaxDynamicSharedMemorySize, LDS_BYTES) != hipSuccess) { fprintf(stderr, "kernel_launch: hipFuncSetAttribute failed\n"); grid = -1; return; }
        if (hipOccupancyMaxActiveBlocksPerMultiprocessor(&per_cu, (const void*)mk_fwd, NWAVES * 64, LDS_BYTES) != hipSuccess || per_cu < 1) { fprintf(stderr, "kernel_launch: occupancy query says %d\n", per_cu); }
        (void)hipGetLastError();
        grid = cus;
        if (grid != 256) { fprintf(stderr, "kernel_launch: %d CUs; this build assumes 256\n", grid); }
    }
    if (grid < 0) return;
    (void)hipMemsetAsync((char*)d_ws + WS_CTL, 0, CTL_ZERO_BYTES, stream);
    Args a{};
    for (int i = 0; i < 22; ++i) a.in[i] = (const float*)d_in[i];
    a.out = (float*)d_out; a.ws = (unsigned char*)d_ws;
#if MK_MULTI
    for (int p = 0; p <= DBG_STOP; ++p) { a.ph_lo = p; a.ph_hi = p + 1; hipLaunchKernelGGL(mk_fwd, dim3(grid), dim3(NWAVES * 64), LDS_BYTES, stream, a); }
    if (DBG_STOP < 16) { a.ph_lo = 17; a.ph_hi = 18; hipLaunchKernelGGL(mk_fwd, dim3(grid), dim3(NWAVES * 64), LDS_BYTES, stream, a); }
#else
    a.ph_lo = 0; a.ph_hi = 17;
    hipLaunchKernelGGL(mk_fwd, dim3(grid), dim3(NWAVES * 64), LDS_BYTES, stream, a);
#endif
}
```

```cpp
#include <hip/hip_runtime.h>
#include <cstdio>
#include <cstdint>
#include <type_traits>

#ifndef MK_MULTI
#define MK_MULTI 0
#endif
#ifndef DBG_STOP
#define DBG_STOP 16
#endif

#ifndef DBG_DOUBLE
#define DBG_DOUBLE 0u
#endif
#ifndef FP8_G1_L0
#define FP8_G1_L0 1
#endif
#ifndef FP8_G1_L1
#define FP8_G1_L1 1
#endif
#ifndef FP8_G2_L0
#define FP8_G2_L0 1
#endif
#ifndef FP8_G2_L1
#define FP8_G2_L1 1
#endif
#define LAS __attribute__((address_space(3)))
#define GAS __attribute__((address_space(1)))
typedef unsigned short bf16;
typedef short bf16x8 __attribute__((ext_vector_type(8)));
typedef short s16x4 __attribute__((ext_vector_type(4)));
typedef float f32x4 __attribute__((ext_vector_type(4)));
typedef float f32x16 __attribute__((ext_vector_type(16)));
typedef unsigned u32x4 __attribute__((ext_vector_type(4)));
typedef unsigned u32x2 __attribute__((ext_vector_type(2)));

constexpr int NB = 8, NSEQ = 4096, D = 1024, LCTX = 256;
constexpr int TL = NB * NSEQ, TC = NB * LCTX, T = TL + TC;
constexpr int EIN = 2048;
constexpr int OIN = 1280;
constexpr int NE = 16, DE = 512;
constexpr int MAXSLOT = 73728;
constexpr float EPS = 1e-6f;

constexpr size_t KiB = 1024, MiB = 1024 * 1024;
constexpr size_t WS_CTL = 0, CTL_ZERO_BYTES = 64 * KiB;
constexpr size_t WS_MODS = 64 * KiB;
constexpr size_t WS_ROPE = WS_MODS + 512 * KiB;
constexpr size_t WS_WA = WS_ROPE + 8 * KiB;
constexpr size_t WS_WAC = WS_WA + 32 * KiB;
constexpr size_t WS_WCC = WS_WAC + 2 * KiB;
constexpr size_t WS_FD = 3 * MiB - 64 * KiB;
constexpr size_t WS_BCNT = WS_WCC + 16 * KiB;
constexpr size_t WS_TILEMAP = WS_BCNT + 16 * KiB;
constexpr size_t WS_SLOT = WS_TILEMAP + 2 * KiB;
constexpr size_t WS_WROW = WS_SLOT + 288 * KiB;
constexpr size_t WS_ROUTE = WS_WROW + 288 * KiB;
constexpr size_t WS_WC = 3 * MiB;
constexpr size_t WS_W_EIN = 4 * MiB;
constexpr size_t WS_W_EOUT = 9 * MiB;
constexpr size_t WS_W_OIN = 11 * MiB;
constexpr size_t WS_W_OOUT = 14 * MiB;
constexpr size_t WS_W_POOL = 16 * MiB;
constexpr size_t WS_W_M1 = 17 * MiB;
constexpr size_t WS_W_M2 = 81 * MiB;
constexpr size_t WS_HC = 113 * MiB;
constexpr size_t WS_BUFA = 121 * MiB;
constexpr size_t WS_BUFP = 189 * MiB;
constexpr size_t WS_BUFZ = 360 * MiB;
constexpr size_t WS_TOKMAP = 432 * MiB;
constexpr size_t WS_HB = 435 * MiB;
constexpr size_t WS_END = 503 * MiB;
constexpr size_t WS_MODSDONE = 24 * KiB;
constexpr size_t WS_FAF = 28 * KiB + 512;
constexpr size_t WS_P5F = 28 * KiB, WS_P5C = 28 * KiB + 256;
constexpr size_t WS_CENSUS = 28 * KiB + 768;
constexpr size_t WS_XARR = 32 * KiB;
constexpr size_t WS_GCNT = 16 * KiB;
static_assert(WS_ROUTE + (size_t)T * 32 <= WS_WC, "small region");
static_assert((size_t)T * EIN * 2 <= WS_BUFZ - WS_BUFP && (size_t)MAXSLOT * 1024 * 2 <= WS_BUFZ - WS_BUFP, "BUFP");
static_assert((size_t)MAXSLOT * 512 * 2 <= WS_TOKMAP - WS_BUFZ && (size_t)T * 1024 * 2 <= WS_TOKMAP - WS_BUFZ, "BUFZ");
static_assert((size_t)16 * T * 4 <= WS_HB - WS_TOKMAP && (size_t)T * 1024 * 2 <= WS_END - WS_HB, "TOKMAP / HB");
static_assert((size_t)T * 1024 * 2 <= WS_BUFP - WS_BUFA, "BUFA");

constexpr int LDS_BYTES = 163840;
constexpr int LDS_GIDX = 147456;
constexpr int LDS_CTL = 146432;
constexpr int NWAVES = 8;

__device__ __forceinline__ unsigned f2bf(float f) { unsigned u = __builtin_bit_cast(unsigned, f); return (u + 0x7fffu + ((u >> 16) & 1u)) >> 16; }
__device__ __forceinline__ unsigned pk2(float lo, float hi) { return f2bf(lo) | (f2bf(hi) << 16); }
__device__ __forceinline__ float bflo(unsigned w) { return __builtin_bit_cast(float, w << 16); }
__device__ __forceinline__ float bfhi(unsigned w) { return __builtin_bit_cast(float, w & 0xffff0000u); }
__device__ __forceinline__ float wave_sum(float v) {
#pragma unroll
    for (int o = 1; o < 64; o <<= 1) v += __shfl_xor(v, o);
    return v;
}
__device__ __forceinline__ int ld_coh(const int* p) { return (int)__hip_atomic_load((const unsigned*)p, __ATOMIC_RELAXED, __HIP_MEMORY_SCOPE_AGENT); }
__device__ __forceinline__ float ld_cohf(const float* p) { return __builtin_bit_cast(float, __hip_atomic_load((const unsigned*)p, __ATOMIC_RELAXED, __HIP_MEMORY_SCOPE_AGENT)); }
#define LDS_WAIT() asm volatile("s_waitcnt lgkmcnt(0)" ::: "memory")

#define XB_TMO      128
#define XB_XCNT(j)  (256  + 64 * (j))
#define XB_XSUB(j)  (1280 + 64 * (j))
#define XB_XGEN(j)  (2304 + 64 * (j))
#define XB_TOP      3328
#define XB_TOPGEN   3392
#define XCD_BAR_WORDS 3456
#define XB_SPIN_CAP (1u << 18)
__device__ __forceinline__ unsigned xb_ld(unsigned* p)              { return __hip_atomic_load(p, __ATOMIC_RELAXED, __HIP_MEMORY_SCOPE_AGENT); }
__device__ __forceinline__ unsigned xb_add(unsigned* p, unsigned v) { return __hip_atomic_fetch_add(p, v, __ATOMIC_RELAXED, __HIP_MEMORY_SCOPE_AGENT); }
__device__ __forceinline__ unsigned xb_xcc_id() { return (unsigned)__builtin_amdgcn_s_getreg((3 << 11) | 20) & 0xFu; }
#define XB_SPIN(cond, bar) do { unsigned _sp = 0; while (cond) { __builtin_amdgcn_s_sleep(1); \
    if ((++_sp & 255u) == 0u) { if (xb_ld(&(bar)[XB_TMO])) break; if (_sp > XB_SPIN_CAP) { atomicAdd(&(bar)[XB_TMO], 1u); break; } } } } while (0)
struct XcdBarrier { unsigned* bar; unsigned x; volatile LAS unsigned* st; };
__device__ __forceinline__ XcdBarrier xcd_barrier_post(unsigned* bar, volatile LAS unsigned* st) {
    XcdBarrier b; b.bar = bar; b.x = xb_xcc_id(); b.st = st;
    if (threadIdx.x == 0) (void)xb_add(&bar[XB_XCNT(b.x)], 1u);
    return b;
}
__device__ __forceinline__ void xcd_barrier_complete(unsigned* bar, unsigned x, unsigned& nloc, unsigned& nx) {
    const unsigned G = gridDim.x * gridDim.y * gridDim.z;
    unsigned sum, cnt, mine, sp = 0u;
    for (;;) {
        sum = 0u; cnt = 0u; mine = 0u;
#pragma unroll
        for (unsigned j = 0; j < 16; ++j) { const unsigned c = xb_ld(&bar[XB_XCNT(j)]); sum += c; cnt += (c > 0u) ? 1u : 0u; mine = (j == x) ? c : mine; }
        if (sum == G) break;
        __builtin_amdgcn_s_sleep(1);
        if ((++sp & 255u) == 0u) { if (xb_ld(&bar[XB_TMO])) break; if (sp > XB_SPIN_CAP) { atomicAdd(&bar[XB_TMO], 1u); break; } }
    }
    nloc = mine > 0u ? mine : 1u; nx = cnt > 0u ? cnt : 1u;
}
__device__ __forceinline__ void xcd_barrier(const XcdBarrier& b) {
    asm volatile("s_waitcnt vmcnt(0)" ::: "memory");
    __syncthreads();
    if (threadIdx.x == 0) {
        unsigned* bar = b.bar;
        __builtin_amdgcn_s_waitcnt(0);
        unsigned nloc = b.st[0], nx = b.st[1];
        if (nloc == 0u) { xcd_barrier_complete(bar, b.x, nloc, nx); b.st[0] = nloc; b.st[1] = nx; }
        const unsigned old = xb_add(&bar[XB_XSUB(b.x)], 1u);
        const unsigned gen = old / nloc;
        if (old + 1u == (gen + 1u) * nloc) {
            __builtin_amdgcn_fence(__ATOMIC_RELEASE, "agent");
            asm volatile("s_waitcnt vmcnt(0)" ::: "memory");
            const unsigned og = xb_add(&bar[XB_TOP], 1u);
            const unsigned tg = og / nx;
            if (og + 1u == (tg + 1u) * nx) xb_add(&bar[XB_TOPGEN], 1u);
            else XB_SPIN(xb_ld(&bar[XB_TOPGEN]) == tg, bar);
            __builtin_amdgcn_fence(__ATOMIC_ACQUIRE, "agent");
            xb_add(&bar[XB_XGEN(b.x)], 1u);
            asm volatile("s_waitcnt vmcnt(0)" ::: "memory");
        } else {
            XB_SPIN(xb_ld(&bar[XB_XGEN(b.x)]) == gen, bar);
            __builtin_amdgcn_fence(__ATOMIC_ACQUIRE, "agent");
            asm volatile("s_waitcnt vmcnt(0)" ::: "memory");
        }
    }
    __syncthreads();
}

namespace pg8 {
constexpr int BM = 256, BK = 64, HALF = 128, HTB = HALF * BK * 2, STAGE_BYTES = 8 * HTB;
__host__ __device__ __forceinline__ int lds_byte(int r, int c) { const int st = (r >> 4) * 2 + (c >> 5), rr = r & 15, cc = c & 31, ob = rr * 64 + cc * 2; return st * 1024 + (ob ^ (((ob >> 9) & 1) << 5)); }
__host__ __device__ __forceinline__ void stage_rc(int b, int& R, int& C) { const int st = b / 1024, sb = b % 1024, swz = sb ^ (((sb >> 9) & 1) << 5); R = (st >> 1) * 16 + swz / 64; C = (st & 1) * 32 + (swz % 64) / 2; }
__host__ __device__ __forceinline__ int perm32(int rho) { const int n = rho >> 4, i = rho & 15; return 8 * (i >> 2) + 4 * n + (i & 3); }
struct Unit { int pm, pn, e; };
__device__ __forceinline__ unsigned cvt_pk_bf16(float lo, float hi) { unsigned r; asm volatile("v_cvt_pk_bf16_f32 %0, %1, %2" : "=v"(r) : "v"(lo), "v"(hi)); return r; }

typedef int v8i32 __attribute__((ext_vector_type(8)));
typedef int v4i32 __attribute__((ext_vector_type(4)));
__device__ __forceinline__ v8i32 cat16(const bf16x8 lo, const bf16x8 hi) { return __builtin_shufflevector(__builtin_bit_cast(v4i32, lo), __builtin_bit_cast(v4i32, hi), 0, 1, 2, 3, 4, 5, 6, 7); }
template <class Epi, class Sched, bool FP8 = false>
__device__ __forceinline__ void gemm_phase(LAS unsigned char* lds, const int K, const Sched& S, const Epi& E) {
    const int tid = threadIdx.x, wid = __builtin_amdgcn_readfirstlane(tid >> 6), lane = tid & 63, wr = wid >> 2, wc = wid & 3, fr = lane & 15, fq = lane >> 4;
    const int nt = K / BK;
    int tidv = tid;
#define PG8_VB(i) ([&]() -> unsigned { int R_, C_; stage_rc(tidv * 16 + (i) * 8192, R_, C_); const int Rb_ = Epi::PERM ? ((R_ & ~31) + perm32(R_ & 31)) : R_; return (unsigned)(Rb_ * K + C_) * 2u; }())
#define PG8_VA(h, i) ([&]() -> unsigned { int R_, C_; stage_rc(tidv * 16 + (i) * 8192, R_, C_); return (unsigned)((128 * (h) + R_) * K + C_) * 2u; }())
    const size_t kstep = (size_t)(BK * 2);
    const size_t hstep = (size_t)HALF * K * 2;
    const unsigned ldsw = (unsigned)wid * 1024u;
#define aoff (lds_byte(wr * 64 + (tidv & 15), ((tidv >> 4) & 3) * 8))
#define boff (lds_byte(wc * 32 + (tidv & 15), ((tidv >> 4) & 3) * 8))
#define PG8_SA(b, h) (((b) * 2 + (h)) * HTB)
#define PG8_SB(b, h) ((4 + (b) * 2 + (h)) * HTB)
#define PG8_STAGEB(bufoff, gbase) do { _Pragma("unroll") for (int _i = 0; _i < 2; ++_i) \
        __builtin_amdgcn_global_load_lds((const unsigned*)((const char*)(gbase) + PG8_VB(_i)), (LAS unsigned*)(lds + (bufoff) + ldsw + _i * 8192), 16, 0, 0); } while (0)
#define PG8_STAGEA(bufoff, gbase, h, NEXT) do { _Pragma("unroll") for (int _i = 0; _i < 2; ++_i) { unsigned vo_; \
        if constexpr (Sched::GATHER) { int R_, C_; stage_rc(tidv * 16 + _i * 8192, R_, C_); const unsigned raw_ = gidx[((((NEXT) && usen) ? (gslot ^ 1u) : gslot) * 4u + (h) * 2 + _i) * 512u + tid]; vo_ = (raw_ * (unsigned)K + (unsigned)C_) * 2u; } \
        else vo_ = PG8_VA(h, _i); \
        __builtin_amdgcn_global_load_lds((const unsigned*)((const char*)(gbase) + vo_), (LAS unsigned*)(lds + (bufoff) + ldsw + _i * 8192), 16, 0, 0); } } while (0)
#define PG8_LDA(dst, b, h) do { _Pragma("unroll") for (int m = 0; m < 4; ++m) _Pragma("unroll") for (int k = 0; k < 2; ++k) dst[m][k] = *(const LAS bf16x8*)(lds + PG8_SA(b, h) + aoff + m * 2048 + k * 1024); } while (0)
#define PG8_LDB(dst, b, h) do { _Pragma("unroll") for (int n = 0; n < 2; ++n) _Pragma("unroll") for (int k = 0; k < 2; ++k) dst[n][k] = *(const LAS bf16x8*)(lds + PG8_SB(b, h) + boff + n * 2048 + k * 1024); } while (0)
#define PG8_MMA(ai, bj, At, Bt) do { __builtin_amdgcn_s_setprio(1); _Pragma("unroll") for (int m = 0; m < 4; ++m) _Pragma("unroll") for (int n = 0; n < 2; ++n) { \
        if constexpr (FP8) acc[ai][bj][m][n] = __builtin_amdgcn_mfma_scale_f32_16x16x128_f8f6f4(cat16(Bt[n][0], Bt[n][1]), cat16(At[m][0], At[m][1]), acc[ai][bj][m][n], 0, 0, 0, 0x7f7f7f7f, 0, 0x7f7f7f7f); \
        else { _Pragma("unroll") for (int k = 0; k < 2; ++k) acc[ai][bj][m][n] = __builtin_amdgcn_mfma_f32_16x16x32_bf16(Bt[n][k], At[m][k], acc[ai][bj][m][n], 0, 0, 0); } } \
        __builtin_amdgcn_s_setprio(0); } while (0)
#define PG8_WAIT_V(n) asm volatile("s_waitcnt vmcnt(" #n ")" ::: "memory")
#define PG8_WAIT_L(n) asm volatile("s_waitcnt lgkmcnt(" #n ")" ::: "memory")
#define PG8_BAR __builtin_amdgcn_s_barrier()
#define PG8_SCHED __builtin_amdgcn_sched_barrier(0)
#define PG8_ITER(A1, A2, A3, B2, B3) do { \
            PG8_LDB(B0, 0, 0); PG8_LDB(B1, 0, 1); PG8_SCHED; PG8_LDA(At, 0, 0); PG8_STAGEA(PG8_SA(1, 1), A1, 1, 0); \
            PG8_WAIT_V(8); PG8_WAIT_L(0); PG8_BAR; PG8_MMA(0, 0, At, B0); PG8_MMA(0, 1, At, B1); PG8_BAR; PG8_SCHED; \
            PG8_LDA(At, 0, 1); PG8_STAGEB(PG8_SB(0, 0), B2); PG8_STAGEB(PG8_SB(0, 1), (B2) + hstep); PG8_STAGEA(PG8_SA(0, 0), A2, 0, 1); \
            PG8_WAIT_V(8); PG8_WAIT_L(0); PG8_BAR; PG8_MMA(1, 0, At, B0); PG8_MMA(1, 1, At, B1); PG8_BAR; PG8_SCHED; \
            PG8_LDB(B0, 1, 0); PG8_LDB(B1, 1, 1); PG8_SCHED; PG8_LDA(At, 1, 0); PG8_STAGEA(PG8_SA(0, 1), A2, 1, 1); \
            PG8_WAIT_V(8); PG8_WAIT_L(0); PG8_BAR; PG8_MMA(0, 0, At, B0); PG8_MMA(0, 1, At, B1); PG8_BAR; PG8_SCHED; \
            PG8_LDA(At, 1, 1); PG8_STAGEB(PG8_SB(1, 0), B3); PG8_STAGEB(PG8_SB(1, 1), (B3) + hstep); PG8_STAGEA(PG8_SA(1, 0), A3, 0, 1); \
            PG8_WAIT_V(8); PG8_WAIT_L(0); PG8_BAR; PG8_MMA(1, 0, At, B0); PG8_MMA(1, 1, At, B1); PG8_BAR; PG8_SCHED; } while (0)
    Unit cur, nxt; int ui = 0;
    if (!S.next(0, cur)) return;
    f32x4 acc[2][2][4][2];
#pragma unroll
    for (int a = 0; a < 2; ++a)
#pragma unroll
        for (int b = 0; b < 2; ++b)
#pragma unroll
            for (int m = 0; m < 4; ++m)
#pragma unroll
                for (int n = 0; n < 2; ++n) acc[a][b][m][n] = (f32x4){0.f, 0.f, 0.f, 0.f};
    bf16x8 At[4][2], B0[2][2], B1[2][2];
    const LAS unsigned* gidx = (const LAS unsigned*)(lds + LDS_GIDX); unsigned gslot = 0u;
    if constexpr (Sched::GATHER) { S.idx_dma(cur, (LAS unsigned*)(lds + LDS_GIDX), tidv, wid); asm volatile("s_waitcnt vmcnt(0)" ::: "memory"); }
    const char* cA = S.a_base(cur); const char* cB = S.b_base(cur);
    constexpr bool usen = false;
    PG8_STAGEB(PG8_SB(0, 0), cB); PG8_STAGEB(PG8_SB(0, 1), cB + hstep); PG8_STAGEA(PG8_SA(0, 0), cA, 0, 0); PG8_STAGEA(PG8_SA(0, 1), cA, 1, 0);
    if (wr == 1) PG8_BAR;
    PG8_WAIT_V(2); PG8_BAR;
    PG8_STAGEB(PG8_SB(1, 0), cB + kstep); PG8_STAGEA(PG8_SA(1, 0), cA + kstep, 0, 0); PG8_STAGEB(PG8_SB(1, 1), cB + hstep + kstep);
    PG8_WAIT_V(6); PG8_BAR;
    for (;;) {
        const bool has_next = S.next(ui + 1, nxt);
        const char* nA = has_next ? S.a_base(nxt) : cA; const char* nB = has_next ? S.b_base(nxt) : cB;
#pragma unroll 1
        for (int t = 0; t < nt; t += 2) {
            const bool last = (t == nt - 2);
            const char* a1 = cA + (size_t)(t + 1) * kstep;
            const char* a2 = last ? nA : cA + (size_t)(t + 2) * kstep; const char* b2 = last ? nB : cB + (size_t)(t + 2) * kstep;
            tidv = tid; asm volatile("" : "+v"(tidv));
            if constexpr (Sched::GATHER) {
                if (t == nt - 4 && has_next) S.idx_dma(nxt, (LAS unsigned*)(lds + LDS_GIDX) + (gslot ^ 1u) * 2048u, tidv, wid);
            }
            const bool usen = last && has_next;
            PG8_ITER(a1, a2, a2 + kstep, b2, b2 + kstep);
        }
        if (wr == 0) PG8_BAR;
        E(acc, cur, wr, wc, fr, fq);
        if (!has_next) break;
#pragma unroll
        for (int a = 0; a < 2; ++a)
#pragma unroll
            for (int b = 0; b < 2; ++b)
#pragma unroll
                for (int m = 0; m < 4; ++m)
#pragma unroll
                    for (int n = 0; n < 2; ++n) acc[a][b][m][n] = (f32x4){0.f, 0.f, 0.f, 0.f};
        cur = nxt; cA = nA; cB = nB; ++ui;
        if constexpr (Sched::GATHER) gslot ^= 1u;
        if (wr == 1) PG8_BAR;
    }
    PG8_WAIT_V(0);
    PG8_BAR;
#undef PG8_ITER
#undef aoff
#undef boff
#undef PG8_SA
#undef PG8_SB
#undef PG8_STAGEA
#undef PG8_STAGEB
#undef PG8_VA
#undef PG8_VB
#undef PG8_LDA
#undef PG8_LDB
#undef PG8_MMA
#undef PG8_WAIT_V
#undef PG8_WAIT_L
#undef PG8_BAR
#undef PG8_SCHED
}

struct SchedDense {
    static constexpr bool GATHER = false;
    const char* A; const char* Bt; int K, nN, nMfull, pnx, nUnits, c, G;
    __device__ __forceinline__ bool next(int i, Unit& u) const {
        const int L = i * G + c; if (L >= nUnits) return false;
        const int full = nMfull * nN;
        if (L < full) { u.pm = L / nN; u.pn = L - u.pm * nN; } else { u.pm = nMfull + (L - full); u.pn = pnx; }
        u.e = 0; return true;
    }
    __device__ __forceinline__ const char* a_base(const Unit& u) const { return A + (size_t)u.pm * 256 * K * 2; }
    __device__ __forceinline__ const char* b_base(const Unit& u) const { return Bt + (size_t)u.pn * 256 * K * 2; }
};
struct SchedSplit {
    static constexpr bool GATHER = false;
    const char* A; const char* Bt; int K, base, stride, n;
    __device__ __forceinline__ bool next(int i, Unit& u) const {
        if (i >= n) return false;
        const int L = base + i * stride; u.pm = L >> 2; u.pn = L & 3; u.e = 0; return true;
    }
    __device__ __forceinline__ const char* a_base(const Unit& u) const { return A + (size_t)u.pm * 256 * K * 2; }
    __device__ __forceinline__ const char* b_base(const Unit& u) const { return Bt + (size_t)u.pn * 256 * K * 2; }
};
template <bool GATHER_> struct SchedMoe {
    static constexpr bool GATHER = GATHER_, gather = GATHER_;
    const char* A; const char* W; const int* tokmap; const LAS int* tb; const LAS int* cn; int K; size_t wstride; int nUnits, c, G;
    __device__ __forceinline__ bool next(int i, Unit& u) const {
        const int L = i * G + c; if (L >= nUnits) return false;
        u.pm = L >> 2; u.pn = L & 3; int e = 0;
#pragma unroll
        for (int q = 1; q < 16; ++q) if (u.pm >= __builtin_amdgcn_readfirstlane(tb[q])) e = q;
        u.e = __builtin_amdgcn_readfirstlane(e); return true;
    }
    __device__ __forceinline__ const char* a_base(const Unit& u) const { return gather ? A : A + (size_t)u.pm * 256 * K * 2; }
    __device__ __forceinline__ const char* b_base(const Unit& u) const { return W + (size_t)u.e * wstride + (size_t)u.pn * 256 * K * 2; }
    __device__ __forceinline__ void idx_dma(const Unit& u, LAS unsigned* slot, int tidv, int wid) const {
        const int p0 = (u.pm - __builtin_amdgcn_readfirstlane(tb[u.e])) * 256, last = __builtin_amdgcn_readfirstlane(cn[u.e]) - 1; const int* tm = tokmap + (size_t)u.e * T;
#pragma unroll
        for (int h = 0; h < 2; ++h)
#pragma unroll
            for (int i = 0; i < 2; ++i) { int R_, C_; stage_rc(tidv * 16 + i * 8192, R_, C_); int pos = p0 + 128 * h + R_; pos = pos < last ? pos : last;
                __builtin_amdgcn_global_load_lds((const unsigned*)(tm + pos), slot + (h * 2 + i) * 512 + wid * 64, 4, 0, 0); }
    }
};

struct EpiStore {
    static constexpr bool PERM = true;
    bf16* O; int ldc;
    __device__ __forceinline__ void operator()(const f32x4 (&acc)[2][2][4][2], const Unit& u, int wr, int wc, int fr, int fq) const {
        const int row0 = u.pm * BM + wr * 64 + fr, col0 = u.pn * BM + wc * 32 + 8 * fq;
#pragma unroll
        for (int ai = 0; ai < 2; ++ai)
#pragma unroll
            for (int m = 0; m < 4; ++m) { bf16* rowp = O + (size_t)(row0 + ai * HALF + m * 16) * ldc + col0;
#pragma unroll
                for (int bj = 0; bj < 2; ++bj) { const f32x4 v0 = acc[ai][bj][m][0], v1 = acc[ai][bj][m][1];
                    u32x4 w; w.x = cvt_pk_bf16(v0[0], v0[1]); w.y = cvt_pk_bf16(v0[2], v0[3]); w.z = cvt_pk_bf16(v1[0], v1[1]); w.w = cvt_pk_bf16(v1[2], v1[3]);
                    *(u32x4*)(rowp + bj * HALF) = w; } }
    }
};
template <bool SRC_F32> struct EpiResid {
    static constexpr bool PERM = true;
    const float* srcL; const float* srcC; bf16* H; const float* gate;
    __device__ __forceinline__ void operator()(const f32x4 (&acc)[2][2][4][2], const Unit& u, int wr, int wc, int fr, int fq) const {
        const float* g = gate + (u.pm < 128 ? (u.pm >> 4) : 8) * 6144;
        const float* src = (u.pm < 128) ? srcL + (size_t)u.pm * 256 * 1024 : srcC + (size_t)(u.pm - 128) * 256 * 1024;
        bf16* dst = H + (size_t)u.pm * 256 * 1024;
        const int row0 = wr * 64 + fr, col0 = u.pn * BM + wc * 32 + 8 * fq;
        f32x4 gv[2][2];
#pragma unroll
        for (int bj = 0; bj < 2; ++bj)
#pragma unroll
            for (int n = 0; n < 2; ++n) gv[bj][n] = *(const f32x4*)(g + col0 + bj * HALF + 4 * n);
#pragma unroll
        for (int ai = 0; ai < 2; ++ai)
#pragma unroll
            for (int m = 0; m < 4; ++m) { const size_t ro = (size_t)(row0 + ai * HALF + m * 16) * 1024 + col0;
#pragma unroll
                for (int bj = 0; bj < 2; ++bj) {
                    f32x4 s0, s1;
                    if constexpr (SRC_F32) { s0 = __builtin_nontemporal_load((const f32x4*)(src + ro + bj * HALF)); s1 = __builtin_nontemporal_load((const f32x4*)(src + ro + bj * HALF + 4)); }
                    else { const u32x4 hv = *(const u32x4*)(dst + ro + bj * HALF); s0 = (f32x4){bflo(hv.x), bfhi(hv.x), bflo(hv.y), bfhi(hv.y)}; s1 = (f32x4){bflo(hv.z), bfhi(hv.z), bflo(hv.w), bfhi(hv.w)}; }
                    const f32x4 v0 = s0 + gv[bj][0] * acc[ai][bj][m][0], v1 = s1 + gv[bj][1] * acc[ai][bj][m][1];
                    u32x4 w; w.x = cvt_pk_bf16(v0[0], v0[1]); w.y = cvt_pk_bf16(v0[2], v0[3]); w.z = cvt_pk_bf16(v1[0], v1[1]); w.w = cvt_pk_bf16(v1[2], v1[3]);
                    *(u32x4*)(dst + ro + bj * HALF) = w; } }
    }
};
__device__ __forceinline__ float silu_f(float x) { return x * __builtin_amdgcn_rcpf(1.0f + __expf(-x)); }
struct EpiSwiglu {
    static constexpr bool PERM = true;
    bf16* H;
    __device__ __forceinline__ void operator()(const f32x4 (&acc)[2][2][4][2], const Unit& u, int wr, int wc, int fr, int fq) const {
        const int row0 = u.pm * BM + wr * 64 + fr, col0 = u.pn * 128 + wc * 32 + 8 * fq;
#pragma unroll
        for (int ai = 0; ai < 2; ++ai)
#pragma unroll
            for (int m = 0; m < 4; ++m) { bf16* p = H + (size_t)(row0 + ai * HALF + m * 16) * 512 + col0;
                const f32x4 g0 = acc[ai][0][m][0], g1 = acc[ai][0][m][1], u0 = acc[ai][1][m][0], u1 = acc[ai][1][m][1];
                u32x4 w; w.x = cvt_pk_bf16(silu_f(g0[0]) * u0[0], silu_f(g0[1]) * u0[1]); w.y = cvt_pk_bf16(silu_f(g0[2]) * u0[2], silu_f(g0[3]) * u0[3]);
                w.z = cvt_pk_bf16(silu_f(g1[0]) * u1[0], silu_f(g1[1]) * u1[1]); w.w = cvt_pk_bf16(silu_f(g1[2]) * u1[2], silu_f(g1[3]) * u1[3]);
                *(u32x4*)p = w; }
    }
};
__device__ __forceinline__ unsigned pk4_fp8(float a, float b, float c, float d) { int p = __builtin_amdgcn_cvt_pk_fp8_f32(a, b, 0, false); p = __builtin_amdgcn_cvt_pk_fp8_f32(c, d, p, true); return (unsigned)p; }
constexpr float W1_SCALE = 32.0f, W2_SCALE = 16.0f, HID_SCALE = 4.0f;
struct EpiSwiglu8 {
    static constexpr bool PERM = true;
    unsigned char* H; float in_scale;
    __device__ __forceinline__ void operator()(const f32x4 (&acc)[2][2][4][2], const Unit& u, int wr, int wc, int fr, int fq) const {
        const int row0 = u.pm * BM + wr * 64 + fr, col0 = u.pn * 128 + wc * 32 + 8 * fq;
        const float IS = 1.0f / in_scale, OS = HID_SCALE / in_scale;
#pragma unroll
        for (int ai = 0; ai < 2; ++ai)
#pragma unroll
            for (int m = 0; m < 4; ++m) { unsigned char* p = H + (size_t)(row0 + ai * HALF + m * 16) * 512 + col0;
                const f32x4 g0 = acc[ai][0][m][0] * IS, g1 = acc[ai][0][m][1] * IS, u0 = acc[ai][1][m][0] * OS, u1 = acc[ai][1][m][1] * OS;
#define HC8(x) __builtin_fminf(__builtin_fmaxf((x), -448.0f), 448.0f)
                u32x2 w; w.x = pk4_fp8(HC8(silu_f(g0[0]) * u0[0]), HC8(silu_f(g0[1]) * u0[1]), HC8(silu_f(g0[2]) * u0[2]), HC8(silu_f(g0[3]) * u0[3]));
                w.y = pk4_fp8(HC8(silu_f(g1[0]) * u1[0]), HC8(silu_f(g1[1]) * u1[1]), HC8(silu_f(g1[2]) * u1[2]), HC8(silu_f(g1[3]) * u1[3]));
#undef HC8
                *(u32x2*)p = w; }
    }
};
struct EpiStoreS {
    static constexpr bool PERM = true;
    bf16* O; int ldc; float scale;
    __device__ __forceinline__ void operator()(const f32x4 (&acc)[2][2][4][2], const Unit& u, int wr, int wc, int fr, int fq) const {
        const int row0 = u.pm * BM + wr * 64 + fr, col0 = u.pn * BM + wc * 32 + 8 * fq;
#pragma unroll
        for (int ai = 0; ai < 2; ++ai)
#pragma unroll
            for (int m = 0; m < 4; ++m) { bf16* rowp = O + (size_t)(row0 + ai * HALF + m * 16) * ldc + col0;
#pragma unroll
                for (int bj = 0; bj < 2; ++bj) { const f32x4 v0 = acc[ai][bj][m][0] * scale, v1 = acc[ai][bj][m][1] * scale;
                    u32x4 w; w.x = cvt_pk_bf16(v0[0], v0[1]); w.y = cvt_pk_bf16(v0[2], v0[3]); w.z = cvt_pk_bf16(v1[0], v1[1]); w.w = cvt_pk_bf16(v1[2], v1[3]);
                    *(u32x4*)(rowp + bj * HALF) = w; } }
    }
};
struct EpiScaleRow {
    static constexpr bool PERM = true;
    bf16* O; const float* wrow;
    __device__ __forceinline__ void operator()(const f32x4 (&acc)[2][2][4][2], const Unit& u, int wr, int wc, int fr, int fq) const {
        const int row0 = u.pm * BM + wr * 64 + fr, col0 = u.pn * BM + wc * 32 + 8 * fq;
#pragma unroll
        for (int ai = 0; ai < 2; ++ai)
#pragma unroll
            for (int m = 0; m < 4; ++m) { const int row = row0 + ai * HALF + m * 16; const float s = wrow[row]; bf16* rowp = O + (size_t)row * 1024 + col0;
#pragma unroll
                for (int bj = 0; bj < 2; ++bj) { const f32x4 v0 = acc[ai][bj][m][0] * s, v1 = acc[ai][bj][m][1] * s;
                    u32x4 w; w.x = cvt_pk_bf16(v0[0], v0[1]); w.y = cvt_pk_bf16(v0[2], v0[3]); w.z = cvt_pk_bf16(v1[0], v1[1]); w.w = cvt_pk_bf16(v1[2], v1[3]);
                    *(u32x4*)(rowp + bj * HALF) = w; } }
    }
};
}

struct Args { const float* in[22]; float* out; unsigned char* ws; int ph_lo, ph_hi; };
enum { I_X = 0, I_C, I_CTX, I_CCTX, I_ADAW, I_ADAB, I_NMG, I_NFG, I_EWIN, I_ECONV, I_EWOUT, I_OWIN, I_OPOOLW, I_OPOOLS, I_OSINK, I_OWOUT, I_RW, I_RB, I_MG, I_MU, I_MD, I_FG };

struct Frame {
    LAS unsigned char* lds;
    int tid, lane, wave, vcu, G;
    unsigned nxl, nxh;
    unsigned char* ws; const float* const* in; float* out;
};
__device__ __forceinline__ bf16* h_row(const Frame& F, int t) { return (bf16*)(F.ws + WS_HB) + (size_t)t * D; }
__device__ __forceinline__ int mod_row(int t) { return t < TL ? (t >> 12) : 8; }

struct TItem { const float* src; bf16* dst; int ldw, ldd; float f8scale; };
__device__ __forceinline__ void titem_load(const TItem& t, f32x4 (&r)[8], int lane) {
#pragma unroll
    for (int i = 0; i < 8; ++i) r[i] = __builtin_nontemporal_load((const f32x4*)(t.src + (size_t)((lane >> 3) + 8 * i) * t.ldw + 4 * (lane & 7)));
}
__device__ __forceinline__ void titem_process(const TItem& t, const f32x4 (&r)[8], LAS float* scr, int lane) {
#pragma unroll
    for (int i = 0; i < 8; ++i) { LAS float* d = scr + ((lane >> 3) + 8 * i) * 33 + 4 * (lane & 7); d[0] = r[i].x; d[1] = r[i].y; d[2] = r[i].z; d[3] = r[i].w; }
    LDS_WAIT(); asm volatile("" ::: "memory");
    const int c = lane & 7;
    if (t.f8scale != 0.0f) {
        const float sc = t.f8scale; unsigned char* d8 = (unsigned char*)t.dst;
#pragma unroll
        for (int j = 0; j < 4; ++j) { const int n = (lane >> 3) + 8 * j; const LAS float* s = scr + (8 * c) * 33 + n;
            u32x2 o; o.x = pg8::pk4_fp8(s[0 * 33] * sc, s[1 * 33] * sc, s[2 * 33] * sc, s[3 * 33] * sc); o.y = pg8::pk4_fp8(s[4 * 33] * sc, s[5 * 33] * sc, s[6 * 33] * sc, s[7 * 33] * sc);
            *(u32x2*)(d8 + (size_t)n * t.ldd + 8 * c) = o; }
    } else {
#pragma unroll
        for (int j = 0; j < 4; ++j) { const int n = (lane >> 3) + 8 * j; const LAS float* s = scr + (8 * c) * 33 + n;
            u32x4 o; o.x = pk2(s[0 * 33], s[1 * 33]); o.y = pk2(s[2 * 33], s[3 * 33]); o.z = pk2(s[4 * 33], s[5 * 33]); o.w = pk2(s[6 * 33], s[7 * 33]);
            *(u32x4*)(t.dst + (size_t)n * t.ldd + 8 * c) = o; }
    }
    LDS_WAIT(); asm volatile("" ::: "memory");
}
constexpr int L0T_N = 32;
constexpr int TS0 = 1024, TS1 = 512, TS2 = 384, TS3 = 512, TS4 = 0, TS5 = 4096, TS6 = 4096, TS7 = 4096, TNITEMS = TS0 + TS1 + TS2 + TS3 + TS4 + TS5 + TS6 + TS7;
__device__ __forceinline__ TItem titem_moe(const float* const* in, unsigned char* ws, int kind, int le, int rr) {
    TItem t; const int layer = le >> 4, e = le & 15; const bool f8 = (kind < 2) ? (layer ? (FP8_G1_L1 != 0) : (FP8_G1_L0 != 0)) : (layer ? (FP8_G2_L1 != 0) : (FP8_G2_L0 != 0));
    if (kind < 2) { const int kb = (rr >> 4) & 15, nb = rr & 15, n0 = nb * 32; const int drow = (n0 >> 7) * 256 + (n0 & 127) + kind * 128;
        t.src = in[kind ? I_MU : I_MG] + (size_t)le * 524288 + (size_t)(kb * 64) * 512 + n0; t.ldw = 512;
        unsigned char* base = ws + WS_W_M1 + (size_t)layer * 32 * MiB;
        if (f8) { t.dst = (bf16*)(base + (size_t)e * MiB + (size_t)drow * 1024 + kb * 64); t.ldd = 1024; t.f8scale = pg8::W1_SCALE; }
        else { t.dst = (bf16*)(base + (size_t)e * 2 * MiB) + (size_t)drow * 1024 + kb * 64; t.ldd = 1024; t.f8scale = 0.0f; } }
    else { const int kb = (rr >> 5) & 7, nb = rr & 31;
        t.src = in[I_MD] + (size_t)le * 524288 + (size_t)(kb * 64) * 1024 + nb * 32; t.ldw = 1024;
        unsigned char* base = ws + WS_W_M2 + (size_t)layer * 16 * MiB;
        if (f8) { t.dst = (bf16*)(base + (size_t)e * 512 * KiB + (size_t)(nb * 32) * 512 + kb * 64); t.ldd = 512; t.f8scale = pg8::W2_SCALE; }
        else { t.dst = (bf16*)(base + (size_t)e * MiB) + (size_t)(nb * 32) * 512 + kb * 64; t.ldd = 512; t.f8scale = 0.0f; } }
    return t;
}
__device__ __forceinline__ TItem titem_decode(const float* const* in, unsigned char* ws, int r) {
    TItem t;
    if (r < TS0) { const int kb = r / 64, nb = r % 64; t.src = in[I_EWIN] + (size_t)(kb * 64) * 2048 + nb * 32; t.ldw = 2048; t.dst = (bf16*)(ws + WS_W_EIN) + (size_t)(nb * 32) * 1024 + kb * 64; t.ldd = 1024; t.f8scale = 0.0f; return t; } r -= TS0;
    if (r < TS1) { const int kb = r / 32, nb = r % 32; t.src = in[I_EWOUT] + (size_t)(kb * 64) * 1024 + nb * 32; t.ldw = 1024; t.dst = (bf16*)(ws + WS_W_EOUT) + (size_t)(nb * 32) * 1024 + kb * 64; t.ldd = 1024; t.f8scale = 0.0f; return t; } r -= TS1;
    if (r < TS2) { const int kb = r / 24, nb = 16 + r % 24; t.src = in[I_OWIN] + (size_t)(kb * 64) * 1280 + nb * 32; t.ldw = 1280; t.dst = (bf16*)(ws + WS_W_OIN) + (size_t)(nb * 32) * 1024 + kb * 64; t.ldd = 1024; t.f8scale = 0.0f; return t; } r -= TS2;
    if (r < TS3) { const int kb = r / 32, nb = r % 32; t.src = in[I_OWOUT] + (size_t)(kb * 64) * 1024 + nb * 32; t.ldw = 1024; t.dst = (bf16*)(ws + WS_W_OOUT) + (size_t)(nb * 32) * 1024 + kb * 64; t.ldd = 1024; t.f8scale = 0.0f; return t; } r -= TS3;
    r += 192 * L0T_N;
    if (r < TS5 + TS6 + TS7) return titem_moe(in, ws, r / 4096, (r % 4096) >> 8, r % 256);
    return t;
}
constexpr int NL1 = 12288;
__device__ __forceinline__ TItem titem_l1(const float* const* in, unsigned char* ws, int r) { return titem_moe(in, ws, r / 4096, 16 + ((r % 4096) >> 8), r % 256); }
__device__ __forceinline__ TItem titem_lx(const float* const* in, unsigned char* ws, int layer, int r) { return titem_moe(in, ws, r / 4096, layer * 16 + ((r % 4096) >> 8), r % 256); }

constexpr size_t WS_CONVCTR = 20 * KiB;
__device__ __forceinline__ void convert_l1(Frame& F, int quota) {
    unsigned* ctr = (unsigned*)(F.ws + WS_CONVCTR);
    LAS float* scr = (LAS float*)(F.lds + F.wave * 17408);
    for (int ch = 0; ch < quota; ++ch) {
        const int c0 = __builtin_amdgcn_readfirstlane(F.lane == 0 ? (int)__hip_atomic_fetch_add(ctr, 4u, __ATOMIC_RELAXED, __HIP_MEMORY_SCOPE_AGENT) : 0);
        if (c0 >= NL1) break;
        f32x4 cur[8], nxt[8];
        TItem tc = titem_l1(F.in, F.ws, c0);
        titem_load(tc, nxt, F.lane);
#pragma unroll 1
        for (int i = 0; i < 4; ++i) {
#pragma unroll
            for (int j = 0; j < 8; ++j) cur[j] = nxt[j];
            const TItem tcur = tc;
            if (i < 3) { tc = titem_l1(F.in, F.ws, c0 + i + 1); titem_load(tc, nxt, F.lane); }
            titem_process(tcur, cur, scr, F.lane);
        }
    }
}
__device__ __forceinline__ void convert_l1_range(Frame& F, const int base, const int cnt, const int ctr_off, const int layer = 1) {
    LAS unsigned* ctr = (LAS unsigned*)(F.lds + LDS_CTL + ctr_off);
    LAS float* scr = (LAS float*)(F.lds + F.wave * 17408);
    f32x4 cur[8], nxt[8];
    int it = __builtin_amdgcn_readfirstlane(F.lane == 0 ? (int)atomicAdd((unsigned*)ctr, 1u) : 0);
    TItem tc = titem_lx(F.in, F.ws, layer, base + (it < cnt ? it : 0));
    if (it < cnt) titem_load(tc, nxt, F.lane);
    while (it < cnt) {
#pragma unroll
        for (int i = 0; i < 8; ++i) cur[i] = nxt[i];
        const TItem tcur = tc;
        const int itn = __builtin_amdgcn_readfirstlane(F.lane == 0 ? (int)atomicAdd((unsigned*)ctr, 1u) : 0);
        if (itn < cnt) { tc = titem_lx(F.in, F.ws, layer, base + itn); titem_load(tc, nxt, F.lane); }
        titem_process(tcur, cur, scr, F.lane);
        it = itn;
    }
}
constexpr int L1T_N = 64, L1A_N = 18;
static_assert(120 * L1T_N + 256 * L1A_N == NL1, "layer-1 conversion split");
__device__ __forceinline__ void tail_fill(Frame& F, int nUnits, int quota) {
    const int rounds = (nUnits + F.G - 1) / F.G;
    if ((rounds - 1) * F.G + F.vcu >= nUnits) convert_l1(F, quota);
}

__device__ __forceinline__ void norm_mod_store(const f32x4 (&v)[4], const float* g, const float* shift, const float* scale, bf16* orow, int lane) {
    float s2 = 0.f;
#pragma unroll
    for (int j = 0; j < 4; ++j) s2 += (v[j].x * v[j].x + v[j].y * v[j].y) + (v[j].z * v[j].z + v[j].w * v[j].w);
    const float rstd = 1.0f / sqrtf(wave_sum(s2) * (1.0f / D) + EPS);
#pragma unroll
    for (int j = 0; j < 4; ++j) { const int c = 4 * lane + 256 * j;
        const f32x4 gg = *(const f32x4*)(g + c), sh = *(const f32x4*)(shift + c), sc = *(const f32x4*)(scale + c);
        const f32x4 y = v[j] * rstd * gg * (sc + 1.0f) + sh;
        u32x2 o; o.x = pk2(y.x, y.y); o.y = pk2(y.z, y.w);
        *(u32x2*)(orow + c) = o; }
}

template <int NQ> __device__ __forceinline__ void p1_tokens(Frame& F, int t) {
    const float* mods = (const float*)(F.ws + WS_MODS);
    bf16* A = (bf16*)(F.ws + WS_BUFA);
    f32x4 v[NQ][4];
#pragma unroll
    for (int q = 0; q < NQ; ++q) { const int tq = t + q; const float* xr = tq < TL ? F.in[I_X] + (size_t)tq * D : F.in[I_CTX] + (size_t)(tq - TL) * D;
#pragma unroll
        for (int j = 0; j < 4; ++j) v[q][j] = __builtin_nontemporal_load((const f32x4*)(xr + 4 * F.lane + 256 * j)); }
    const float* m = mods + (size_t)mod_row(t) * 6144;
#pragma unroll
    for (int q = 0; q < NQ; ++q) norm_mod_store(v[q], F.in[I_NMG], m, m + 1024, A + (size_t)(t + q) * D, F.lane);
}
__device__ __forceinline__ void phase_mods(Frame& F) {
    const float* const* in = F.in;
    LAS float* S = (LAS float*)F.lds;
    LAS float* red = S + 9 * 1024;
    for (int i = F.tid; i < 9 * 1024; i += 512) { const float v = (i < 8192) ? in[I_C][i] : in[I_CCTX][i - 8192]; S[i] = v / (1.0f + expf(-v)); }
    __syncthreads();
    const int bx = blockIdx.x, layer = bx >> 7, col0 = (bx & 127) * 48;
    const int j = F.tid % 12, rg = F.tid / 12;
    if (rg < 42) {
        const float* W = in[I_ADAW] + (size_t)layer * 1024 * 6144 + col0 + 4 * j;
        f32x4 w[25];
#pragma unroll
        for (int i = 0; i < 25; ++i) { const int k = rg + 42 * i; w[i] = (k < 1024) ? __builtin_nontemporal_load((const f32x4*)(W + (size_t)k * 6144)) : (f32x4){0.f, 0.f, 0.f, 0.f}; }
        f32x4 acc[9];
#pragma unroll
        for (int r = 0; r < 9; ++r) acc[r] = (f32x4){0.f, 0.f, 0.f, 0.f};
#pragma unroll
        for (int i = 0; i < 25; ++i) { const int k = min(rg + 42 * i, 1023);
#pragma unroll
            for (int r = 0; r < 9; ++r) acc[r] += w[i] * S[r * 1024 + k]; }
#pragma unroll
        for (int r = 0; r < 9; ++r) *(LAS f32x4*)(red + (rg * 9 + r) * 48 + 4 * j) = acc[r];
    }
    __syncthreads();
    for (int i = F.tid; i < 432; i += 512) { const int r = i / 48, c = i % 48; float sum = in[I_ADAB][layer * 6144 + col0 + c];
        for (int g = 0; g < 42; ++g) sum += red[(g * 9 + r) * 48 + c];
        __hip_atomic_store((unsigned*)(F.ws + WS_MODS) + (layer * 9 + r) * 6144 + col0 + c, __builtin_bit_cast(unsigned, sum), __ATOMIC_RELAXED, __HIP_MEMORY_SCOPE_AGENT); }
    asm volatile("s_waitcnt vmcnt(0)" ::: "memory");
    __syncthreads();
    if (F.tid == 0) __hip_atomic_fetch_add((unsigned*)(F.ws + WS_MODSDONE), 1u, __ATOMIC_RELAXED, __HIP_MEMORY_SCOPE_AGENT);
}
__device__ __forceinline__ void mods_wait(Frame& F) {
    if (F.tid < 64) {
        unsigned* cnt = (unsigned*)(F.ws + WS_MODSDONE); unsigned spins = 0;
        while ((unsigned)__builtin_amdgcn_readfirstlane(__hip_atomic_load(cnt, __ATOMIC_RELAXED, __HIP_MEMORY_SCOPE_AGENT)) < (unsigned)F.G) {
            __builtin_amdgcn_s_sleep(2); if (++spins > (1u << 22)) break; }
        __builtin_amdgcn_fence(__ATOMIC_ACQUIRE, "agent");
        asm volatile("s_waitcnt vmcnt(0)" ::: "memory");
    }
    __syncthreads();
}

__device__ __forceinline__ void ctr_publish(Frame& F, size_t off, int slot, unsigned nx) {
    asm volatile("s_waitcnt vmcnt(0)" ::: "memory");
    __syncthreads();
    if (F.tid == 0) {
        unsigned* top = (unsigned*)(F.ws + off);
        if (nx == 0u) { __builtin_amdgcn_fence(__ATOMIC_RELEASE, "agent"); asm volatile("s_waitcnt vmcnt(0)" ::: "memory"); __hip_atomic_fetch_add(top, 1u, __ATOMIC_RELAXED, __HIP_MEMORY_SCOPE_AGENT); }
        else {
            unsigned* xw = (unsigned*)(F.ws + WS_XARR) + ((size_t)slot * 16 + xb_xcc_id()) * 64;
            const unsigned old = __hip_atomic_fetch_add(xw, 1u, __ATOMIC_RELAXED, __HIP_MEMORY_SCOPE_AGENT);
            if (old + 1u == nx) { __builtin_amdgcn_fence(__ATOMIC_RELEASE, "agent"); asm volatile("s_waitcnt vmcnt(0)" ::: "memory"); __hip_atomic_fetch_add(top, nx, __ATOMIC_RELAXED, __HIP_MEMORY_SCOPE_AGENT); }
        }
    }
}
__device__ __forceinline__ void ctr_wait(Frame& F, size_t off, unsigned need) {
    if (F.tid < 64) {
        unsigned* cnt = (unsigned*)(F.ws + off); unsigned spins = 0;
        while ((unsigned)__builtin_amdgcn_readfirstlane(__hip_atomic_load(cnt, __ATOMIC_RELAXED, __HIP_MEMORY_SCOPE_AGENT)) < need) {
            __builtin_amdgcn_s_sleep(2); if (++spins > (1u << 22)) break; }
        __builtin_amdgcn_fence(__ATOMIC_ACQUIRE, "agent");
        asm volatile("s_waitcnt vmcnt(0)" ::: "memory");
    }
    __syncthreads();
}

__device__ __forceinline__ void phase_prologue_a(Frame& F) {
    const float* const* in = F.in;
    unsigned char* ws = F.ws;
    LAS float* ldsf = (LAS float*)F.lds;
    phase_mods(F);
    __syncthreads();
    {
        const int gt = blockIdx.x * 512 + F.tid, NT = F.G * 512;
        float* rope = (float*)(ws + WS_ROPE);
        for (int i = gt; i < 1024; i += NT) { const int coord = i >> 4, q = i & 15; const float inv = powf(10000.0f, -(float)q / 16.0f); const float ang = (float)coord * inv;
            rope[i] = cosf(ang); rope[1024 + i] = sinf(ang); }
        bf16* WA = (bf16*)(ws + WS_WA);
        for (int i = gt; i < 128 * 128; i += NT) { const int m = i >> 7, k = i & 127, rp = m >> 6, j1 = m & 63, ri = k >> 6, n1 = k & 63;
            const float a = 2.0f * (float)((j1 * n1) & 63) / 64.0f; const float c = cospif(a), s = sinpif(a);
            const float v = (rp == 0) ? (ri == 0 ? c : s) : (ri == 0 ? -s : c); WA[i] = (bf16)f2bf(v); }
        bf16* WAC = (bf16*)(ws + WS_WAC);
        for (int i = gt; i < 32 * 32; i += NT) { const int m = i >> 5, k = i & 31, rp = m >> 4, j1 = m & 15, ri = k >> 4, n1 = k & 15;
            const float a = 2.0f * (float)((j1 * n1) & 15) / 16.0f; const float c = cospif(a), s = sinpif(a);
            const float v = (rp == 0) ? (ri == 0 ? c : s) : (ri == 0 ? -s : c); WAC[i] = (bf16)f2bf(v); }
        bf16* WC = (bf16*)(ws + WS_WC);
        for (int i = gt; i < 64 * 64 * 128; i += NT) { const int j1 = i >> 13, j2 = (i >> 7) & 63, k = i & 127, ri = k >> 6, n2 = k & 63;
            const float a = 2.0f * (float)((n2 * (j1 + 64 * j2)) & 4095) / 4096.0f; const float v = (ri == 0 ? cospif(a) : sinpif(a)) * (1.0f / 64.0f); WC[i] = (bf16)f2bf(v); }
        bf16* FD = (bf16*)(ws + WS_FD);
        for (int i = gt; i < 256 * 128; i += NT) { const int col = i >> 7, c = i & 127, ri = col >> 7, k2 = col & 127;
            const float a = 2.0f * (float)((c * k2) & 127) / 128.0f; const float v = (ri == 0 ? cospif(a) : -sinpif(a)) * 0.08838834764831845f; FD[i] = (bf16)f2bf(v); }
        bf16* WCC = (bf16*)(ws + WS_WCC);
        for (int i = gt; i < 16 * 16 * 32; i += NT) { const int j1 = i >> 9, j2 = (i >> 5) & 15, k = i & 31, ri = k >> 4, n2 = k & 15;
            const float a = 2.0f * (float)((n2 * (j1 + 16 * j2)) & 255) / 256.0f; const float v = (ri == 0 ? cospif(a) : sinpif(a)) * (1.0f / 16.0f); WCC[i] = (bf16)f2bf(v); }
    }
    LAS float* tw = (LAS float*)(F.lds + 139264);
    if (F.tid < 128) { const float a = 2.0f * (float)F.tid / 128.0f; tw[F.tid] = cospif(a); tw[128 + F.tid] = sinpif(a); }
    __syncthreads();
    LAS float* scr = (LAS float*)(F.lds + F.wave * 17408);
    const int gw = F.vcu * NWAVES + F.wave, NGW = F.G * NWAVES;
    const int fid = F.vcu * 2 + F.wave;
    if (F.wave < 2) { const int r = fid;
        const int g = r >> 7, db = (r >> 5) & 3, kb = r & 31, k0 = kb * 32, d0 = db * 32;
        const float* Wp = in[I_OWIN] + (size_t)k0 * 1280 + g * 128;
        { float tl[32][2];
#pragma unroll
          for (int rr = 0; rr < 32; ++rr) { tl[rr][0] = Wp[(size_t)rr * 1280 + F.lane]; tl[rr][1] = Wp[(size_t)rr * 1280 + 64 + F.lane]; }
#pragma unroll
          for (int rr = 0; rr < 32; ++rr) { scr[rr * 129 + F.lane] = tl[rr][0]; scr[rr * 129 + 64 + F.lane] = tl[rr][1]; } }
        LDS_WAIT(); asm volatile("" ::: "memory");
        const int k = F.lane & 31, oh = F.lane >> 5;
        const float* pw = in[I_OPOOLW] + (size_t)g * 16384 + d0 + 16 * oh;
        float acc[16];
#pragma unroll
        for (int t = 0; t < 16; ++t) acc[t] = 0.f;
        for (int c0 = 0; c0 < 128; c0 += 8) {
            f32x4 p[8][4];
#pragma unroll
            for (int cc = 0; cc < 8; ++cc)
#pragma unroll
                for (int j = 0; j < 4; ++j) p[cc][j] = *(const f32x4*)(pw + (c0 + cc) * 128 + 4 * j);
#pragma unroll
            for (int cc = 0; cc < 8; ++cc) { const float w = scr[k * 129 + c0 + cc];
#pragma unroll
                for (int j = 0; j < 4; ++j) { acc[4 * j] += w * p[cc][j].x; acc[4 * j + 1] += w * p[cc][j].y; acc[4 * j + 2] += w * p[cc][j].z; acc[4 * j + 3] += w * p[cc][j].w; } }
        }
        const float* psc = in[I_OPOOLS] + g * 128 + d0 + 16 * oh;
        bf16* dst = (bf16*)(ws + WS_W_OIN) + (size_t)(g * 128 + d0 + 16 * oh) * 1024 + k0 + k;
#pragma unroll
        for (int t = 0; t < 16; ++t) dst[(size_t)t * 1024] = (bf16)f2bf(acc[t] * psc[t]);
        LDS_WAIT(); asm volatile("" ::: "memory");
    }
    {
        LAS unsigned* ctr = (LAS unsigned*)(F.lds + LDS_CTL + 32);
        constexpr int TP1 = TS0 + TS1 + TS2 + TS3 + (12288 - 192 * L0T_N), PER = (TP1 + 255) / 256;
        const int base = F.vcu * PER, lim = max(0, min(PER, TP1 - base));
        f32x4 cur[8], nxt[8];
        int it = __builtin_amdgcn_readfirstlane(F.lane == 0 ? (int)atomicAdd((unsigned*)ctr, 1u) : 0);
        TItem tc = titem_decode(in, ws, base + (it < lim ? it : 0));
        if (it < lim) titem_load(tc, nxt, F.lane);
        while (it < lim) {
#pragma unroll
            for (int i = 0; i < 8; ++i) cur[i] = nxt[i];
            const TItem tcur = tc;
            const int itn = __builtin_amdgcn_readfirstlane(F.lane == 0 ? (int)atomicAdd((unsigned*)ctr, 1u) : 0);
            if (itn < lim) { tc = titem_decode(in, ws, base + itn); titem_load(tc, nxt, F.lane); }
            titem_process(tcur, cur, scr, F.lane);
            it = itn;
        }
    }
    mods_wait(F);
    {
        LAS unsigned* ctr2 = (LAS unsigned*)(F.lds + LDS_CTL + 36);
        for (;;) {
            const int it = __builtin_amdgcn_readfirstlane(F.lane == 0 ? (int)atomicAdd((unsigned*)ctr2, 1u) : 0);
            if (it >= 40) break;
            if (it < 32) p1_tokens<4>(F, 4 * (32 * (int)blockIdx.x + it)); else p1_tokens<1>(F, TL + 8 * (int)blockIdx.x + (it - 32));
        }
    }
}

struct DftP { const bf16* dbase; size_t dstride; const bf16* W; bf16* obase; size_t ostride; };
template <int MODE> __device__ __forceinline__ DftP dft_params(const Frame& F, int u) {
    const bf16* P = (const bf16*)(F.ws + WS_BUFP); bf16* Z = (bf16*)(F.ws + WS_BUFZ); bf16* MIX = (bf16*)(F.ws + WS_BUFA);
    DftP p;
    if constexpr (MODE == 0) { const int chunk = u & 3, n2 = (u >> 2) & 63, b = u >> 8;
        p.dbase = P + (size_t)(b * 4096 + n2) * EIN + chunk * 128; p.dstride = (size_t)64 * EIN; p.W = (const bf16*)(F.ws + WS_WA);
        p.obase = Z + (size_t)((b * 64) * 64 + n2) * 1024 + chunk * 128; p.ostride = (size_t)64 * 1024; }
    if constexpr (MODE == 1) { const int chunk = u & 3, n2 = (u >> 2) & 15, b = u >> 6;
        p.dbase = P + (size_t)(TL + b * 256 + n2) * EIN + chunk * 128; p.dstride = (size_t)16 * EIN; p.W = (const bf16*)(F.ws + WS_WAC);
        p.obase = Z + (size_t)(TL + (b * 16) * 16 + n2) * 1024 + chunk * 128; p.ostride = (size_t)16 * 1024; }
    if constexpr (MODE == 2) { const int chunk = u & 3, j1 = (u >> 2) & 63, b = u >> 8;
        p.dbase = Z + (size_t)((b * 64 + j1) * 64) * 1024 + chunk * 128; p.dstride = (size_t)1024; p.W = (const bf16*)(F.ws + WS_WC) + (size_t)j1 * 64 * 128;
        p.obase = MIX + (size_t)(b * 4096 + j1) * D + chunk * 128; p.ostride = (size_t)64 * D; }
    if constexpr (MODE == 3) { const int chunk = u & 3, j1 = (u >> 2) & 15, b = u >> 6;
        p.dbase = Z + (size_t)(TL + (b * 16 + j1) * 16) * 1024 + chunk * 128; p.dstride = (size_t)1024; p.W = (const bf16*)(F.ws + WS_WCC) + (size_t)j1 * 16 * 32;
        p.obase = MIX + (size_t)(TL + b * 256 + j1) * D + chunk * 128; p.ostride = (size_t)16 * D; }
    return p;
}
template <int MODE, int KD, int MD, int J>
__device__ __forceinline__ void dft_units(Frame& F, int nunits) {
    constexpr int LD = KD + 8;
    constexpr int NP = (KD * 16 + 511) / 512;
    constexpr int GM = KD / 8 - 1;
    LAS bf16* DT = (LAS bf16*)F.lds;
    u32x4 pre[NP];
    int u = F.vcu;
    if (u < nunits) { const DftP p = dft_params<MODE>(F, u);
#pragma unroll
        for (int i = 0; i < NP; ++i) { const int pc = F.tid + 512 * i; if (pc < KD * 16) { const int k = pc >> 4, c8 = pc & 15, ri = k / (KD / 2), nn = k % (KD / 2);
            pre[i] = __builtin_nontemporal_load((const u32x4*)(p.dbase + (size_t)nn * p.dstride + ri * 512 + c8 * 8)); } } }
    const int a = F.lane & 15, q = F.lane >> 4;
    for (; u < nunits; u += F.G) {
        const DftP p = dft_params<MODE>(F, u);
#pragma unroll
        for (int i = 0; i < NP; ++i) { const int pc = F.tid + 512 * i; if (pc < KD * 16) { const int k = pc >> 4, c8 = pc & 15; const u32x4 v = pre[i];
            LAS bf16* d = DT + (c8 * 8) * LD + (k ^ ((c8 & GM) << 3));
            d[0 * LD] = (bf16)(v.x & 0xffff); d[1 * LD] = (bf16)(v.x >> 16); d[2 * LD] = (bf16)(v.y & 0xffff); d[3 * LD] = (bf16)(v.y >> 16);
            d[4 * LD] = (bf16)(v.z & 0xffff); d[5 * LD] = (bf16)(v.z >> 16); d[6 * LD] = (bf16)(v.w & 0xffff); d[7 * LD] = (bf16)(v.w >> 16); } }
        __syncthreads();
        if (u + F.G < nunits) { const DftP pn = dft_params<MODE>(F, u + F.G);
#pragma unroll
            for (int i = 0; i < NP; ++i) { const int pc = F.tid + 512 * i; if (pc < KD * 16) { const int k = pc >> 4, c8 = pc & 15, ri = k / (KD / 2), nn = k % (KD / 2);
                pre[i] = __builtin_nontemporal_load((const u32x4*)(pn.dbase + (size_t)nn * pn.dstride + ri * 512 + c8 * 8)); } } }
        for (int task = F.wave; task < (MD / 16) * 2; task += NWAVES) {
            const int mt = task >> 1, cht = task & 1;
            f32x4 acc[4];
#pragma unroll
            for (int ct = 0; ct < 4; ++ct) acc[ct] = (f32x4){0.f, 0.f, 0.f, 0.f};
#pragma unroll
            for (int ks = 0; ks < KD / 32; ++ks) {
                const bf16x8 bw = *(const bf16x8*)(p.W + (size_t)(mt * 16 + a) * KD + ks * 32 + 8 * q);
#pragma unroll
                for (int ct = 0; ct < 4; ++ct) {
                    const int ch = cht * 64 + 16 * (a >> 2) + 4 * ct + (a & 3);
                    const bf16x8 av = *(const LAS bf16x8*)(DT + ch * LD + ((ks * 32 + 8 * q) ^ (((ch >> 3) & GM) << 3)));
                    acc[ct] = __builtin_amdgcn_mfma_f32_16x16x32_bf16(av, bw, acc[ct], 0, 0, 0);
                }
            }
            const int m = mt * 16 + a, rm = m / J, j = m % J;
            bf16* o = p.obase + (size_t)j * p.ostride + rm * 512 + cht * 64 + 16 * q;
            u32x4 w0, w1;
            w0.x = pk2(acc[0][0], acc[0][1]); w0.y = pk2(acc[0][2], acc[0][3]); w0.z = pk2(acc[1][0], acc[1][1]); w0.w = pk2(acc[1][2], acc[1][3]);
            w1.x = pk2(acc[2][0], acc[2][1]); w1.y = pk2(acc[2][2], acc[2][3]); w1.z = pk2(acc[3][0], acc[3][1]); w1.w = pk2(acc[3][2], acc[3][3]);
            *(u32x4*)o = w0; *(u32x4*)(o + 8) = w1;
        }
        __syncthreads();
    }
}

template <int MODE, int NR>
__device__ __forceinline__ void dft_units_a(Frame& F, int nunits) {
    constexpr int KD = 2 * NR, MD = 2 * NR, J = NR, LD = KD + 8, GM = KD / 8 - 1, ULD = 136;
    constexpr int NP = (NR * 16 + 511) / 512;
    LAS bf16* FDl = (LAS bf16*)F.lds; LAS bf16* U = (LAS bf16*)(F.lds + 69632); LAS bf16* DT = (LAS bf16*)(F.lds + 69632 + 64 * ULD * 2);
    { const bf16* FD = (const bf16*)(F.ws + WS_FD);
      for (int p = F.tid; p < 256 * 16; p += 512) { const int r = p >> 4, c8 = p & 15; *(LAS u32x4*)(FDl + r * ULD + 8 * c8) = *(const u32x4*)(FD + r * 128 + 8 * c8); } }
    u32x4 pre[NP];
    int u = F.vcu;
    if (u < nunits) { const DftP p = dft_params<MODE>(F, u);
#pragma unroll
        for (int i = 0; i < NP; ++i) { const int pc = F.tid + 512 * i; if (pc < NR * 16) pre[i] = __builtin_nontemporal_load((const u32x4*)(p.dbase + (size_t)(pc >> 4) * p.dstride + (pc & 15) * 8)); } }
    const int a = F.lane & 15, q = F.lane >> 4;
    for (; u < nunits; u += F.G) {
        const DftP p = dft_params<MODE>(F, u);
#pragma unroll
        for (int i = 0; i < NP; ++i) { const int pc = F.tid + 512 * i; if (pc < NR * 16) *(LAS u32x4*)(U + (pc >> 4) * ULD + (pc & 15) * 8) = pre[i]; }
        __syncthreads();
        if (u + F.G < nunits) { const DftP pn = dft_params<MODE>(F, u + F.G);
#pragma unroll
            for (int i = 0; i < NP; ++i) { const int pc = F.tid + 512 * i; if (pc < NR * 16) pre[i] = __builtin_nontemporal_load((const u32x4*)(pn.dbase + (size_t)(pc >> 4) * pn.dstride + (pc & 15) * 8)); } }
        {
            f32x4 acc[NR / 16][2];
#pragma unroll
            for (int mt = 0; mt < NR / 16; ++mt) { acc[mt][0] = (f32x4){0.f, 0.f, 0.f, 0.f}; acc[mt][1] = (f32x4){0.f, 0.f, 0.f, 0.f}; }
#pragma unroll
            for (int ks = 0; ks < 4; ++ks) {
                const bf16x8 b0 = *(const LAS bf16x8*)(FDl + ((2 * F.wave) * 16 + a) * ULD + ks * 32 + 8 * q), b1 = *(const LAS bf16x8*)(FDl + ((2 * F.wave + 1) * 16 + a) * ULD + ks * 32 + 8 * q);
#pragma unroll
                for (int mt = 0; mt < NR / 16; ++mt) { const bf16x8 av = *(const LAS bf16x8*)(U + (mt * 16 + a) * ULD + ks * 32 + 8 * q);
                    acc[mt][0] = __builtin_amdgcn_mfma_f32_16x16x32_bf16(av, b0, acc[mt][0], 0, 0, 0); acc[mt][1] = __builtin_amdgcn_mfma_f32_16x16x32_bf16(av, b1, acc[mt][1], 0, 0, 0); }
            }
#pragma unroll
            for (int t = 0; t < 2; ++t) { const int col = (2 * F.wave + t) * 16 + a, ri = col >> 7, k2 = col & 127;
#pragma unroll
                for (int mt = 0; mt < NR / 16; ++mt) { const int k0 = ri * NR + 16 * mt + 4 * q;
                    u32x2 w; w.x = pk2(acc[mt][t][0], acc[mt][t][1]); w.y = pk2(acc[mt][t][2], acc[mt][t][3]);
                    *(LAS u32x2*)(DT + k2 * LD + (k0 ^ (((k2 >> 3) & GM) << 3))) = w; } }
        }
        __syncthreads();
        for (int task = F.wave; task < (MD / 16) * 2; task += NWAVES) {
            const int mt = task >> 1, cht = task & 1;
            f32x4 acc[4];
#pragma unroll
            for (int ct = 0; ct < 4; ++ct) acc[ct] = (f32x4){0.f, 0.f, 0.f, 0.f};
#pragma unroll
            for (int ks = 0; ks < KD / 32; ++ks) {
                const bf16x8 bw = *(const bf16x8*)(p.W + (size_t)(mt * 16 + a) * KD + ks * 32 + 8 * q);
#pragma unroll
                for (int ct = 0; ct < 4; ++ct) {
                    const int ch = cht * 64 + 16 * (a >> 2) + 4 * ct + (a & 3);
                    const bf16x8 av = *(const LAS bf16x8*)(DT + ch * LD + ((ks * 32 + 8 * q) ^ (((ch >> 3) & GM) << 3)));
                    acc[ct] = __builtin_amdgcn_mfma_f32_16x16x32_bf16(av, bw, acc[ct], 0, 0, 0);
                }
            }
            const int m = mt * 16 + a, rm = m / J, j = m % J;
            bf16* o = p.obase + (size_t)j * p.ostride + rm * 512 + cht * 64 + 16 * q;
            u32x4 w0, w1;
            w0.x = pk2(acc[0][0], acc[0][1]); w0.y = pk2(acc[0][2], acc[0][3]); w0.z = pk2(acc[1][0], acc[1][1]); w0.w = pk2(acc[1][2], acc[1][3]);
            w1.x = pk2(acc[2][0], acc[2][1]); w1.y = pk2(acc[2][2], acc[2][3]); w1.z = pk2(acc[3][0], acc[3][1]); w1.w = pk2(acc[3][2], acc[3][3]);
            *(u32x4*)o = w0; *(u32x4*)(o + 8) = w1;
        }
        __syncthreads();
    }
}

__device__ __forceinline__ void phase_fourier_a_conv(Frame& F) {
    const bf16* P = (const bf16*)(F.ws + WS_BUFP);
    dft_units_a<0, 64>(F, 2048);
    __syncthreads();
    dft_units_a<1, 16>(F, 512);
    ctr_publish(F, WS_FAF, 0, F.nxl + F.nxh);
    bf16* MIX = (bf16*)(F.ws + WS_BUFA);
    const float* cw = F.in[I_ECONV];
    float w0[8], w1[8], w2[8];
#pragma unroll
    for (int i = 0; i < 8; ++i) { w0[i] = cw[8 * F.lane + i]; w1[i] = cw[512 + 8 * F.lane + i]; w2[i] = cw[1024 + 8 * F.lane + i]; }
    const int gw = F.vcu * NWAVES + F.wave, NGW = F.G * NWAVES;
    auto conv_tokens = [&](int t, auto ntc) {
        constexpr int NT = decltype(ntc)::value;
        int pos, len; if (t < TL) { pos = t & 4095; len = 4096; } else { pos = (t - TL) & 255; len = 256; }
        const bf16* row = P + (size_t)t * EIN + 8 * F.lane;
        u32x4 gb[NT], gc[NT + 2], uc[NT + 2];
#pragma unroll
        for (int d = 0; d < NT + 2; ++d) { const int pp = pos + d - 1;
            if (pp >= 0 && pp < len) { gc[d] = *(const u32x4*)(row + (ptrdiff_t)(d - 1) * EIN + 1024); uc[d] = *(const u32x4*)(row + (ptrdiff_t)(d - 1) * EIN + 1536); }
            else { gc[d] = (u32x4){0u, 0u, 0u, 0u}; uc[d] = (u32x4){0u, 0u, 0u, 0u}; } }
#pragma unroll
        for (int q = 0; q < NT; ++q) gb[q] = __builtin_nontemporal_load((const u32x4*)(row + (size_t)q * EIN + 512));
        float pl[NT + 2][8];
#pragma unroll
        for (int d = 0; d < NT + 2; ++d)
#pragma unroll
            for (int i = 0; i < 4; ++i) { pl[d][2 * i] = bflo(gc[d][i]) * bflo(uc[d][i]); pl[d][2 * i + 1] = bfhi(gc[d][i]) * bfhi(uc[d][i]); }
#pragma unroll
        for (int q = 0; q < NT; ++q) {
            float y[8];
#pragma unroll
            for (int i = 0; i < 4; ++i) {
                y[2 * i] = bflo(gb[q][i]) * (w0[2 * i] * pl[q][2 * i] + w1[2 * i] * pl[q + 1][2 * i] + w2[2 * i] * pl[q + 2][2 * i]);
                y[2 * i + 1] = bfhi(gb[q][i]) * (w0[2 * i + 1] * pl[q][2 * i + 1] + w1[2 * i + 1] * pl[q + 1][2 * i + 1] + w2[2 * i + 1] * pl[q + 2][2 * i + 1]);
            }
            u32x4 o; o.x = pk2(y[0], y[1]); o.y = pk2(y[2], y[3]); o.z = pk2(y[4], y[5]); o.w = pk2(y[6], y[7]);
            *(u32x4*)(MIX + (size_t)(t + q) * D + 512 + 8 * F.lane) = o;
        }
    };
    for (int t = 4 * gw; t < TL; t += 4 * NGW) conv_tokens(t, std::integral_constant<int, 4>{});
    for (int t = TL + gw; t < T; t += NGW) conv_tokens(t, std::integral_constant<int, 1>{});
}

__device__ __forceinline__ void phase_fourier_c(Frame& F) {
    ctr_wait(F, WS_FAF, (unsigned)F.G);
    dft_units<2, 128, 64, 64>(F, 2048);
    dft_units<3, 32, 16, 16>(F, 512);
}

constexpr int RW_LD = 1032;
template <bool SPLIT>
__device__ __forceinline__ void phase_route(Frame& F, int layer, int ntok) {
    LAS bf16* rwh = (LAS bf16*)F.lds;
    LAS bf16* rwl = (LAS bf16*)(F.lds + 33024);
    LAS unsigned* cnt = (LAS unsigned*)(F.lds + 66048);
    LAS int* gb = (LAS int*)(F.lds + 66048 + 128);
    LAS float* lgs = (LAS float*)(F.lds + 66048 + 256) + F.wave * 256;
    LAS int* tinfo = (LAS int*)(F.lds + 66048 + 256 + 8192);
    LAS float* GS = (LAS float*)(F.lds + 81920);
    LAS float* SH = GS + 2048;
    const float* RW = F.in[I_RW];
    int tA, nA, tB, nB;
    if constexpr (SPLIT) {
        const int xs = F.vcu >> 5, rs = F.vcu & 31;
        if (rs >= 28) return;
        const int j = 28 * xs + rs;
        tA = 128 * j; nA = 128; tB = 28672 + 32 * j; nB = (j < 192) ? 32 : 0;
    } else { const int per_ = ntok / F.G; tA = blockIdx.x * per_; nA = per_; tB = 0; nB = 0; }
    const int r0 = mod_row(tA), mr1 = SPLIT ? mod_row(tB) : min(r0 + 1, 8);
    const float* mods = (const float*)(F.ws + WS_MODS) + (size_t)layer * 9 * 6144;
    const float* g = F.in[I_NFG] + layer * 1024;
    for (int i = F.tid; i < 16384; i += 512) { const int k = i >> 4, e = i & 15; const float w = RW[i]; const unsigned hi = f2bf(w); const float wl = w - __builtin_bit_cast(float, hi << 16);
        rwh[e * RW_LD + k] = (bf16)hi; rwl[e * RW_LD + k] = (bf16)f2bf(wl); }
    for (int i = F.tid; i < 2048; i += 512) { const int sl = i >> 10, c = i & 1023; const int rr = sl ? mr1 : r0; const float* m = mods + (size_t)rr * 6144;
        GS[i] = g[c] * (m[4 * 1024 + c] + 1.0f); SH[i] = m[3 * 1024 + c]; }
    if (F.tid < 16) cnt[F.tid] = 0u;
    __syncthreads();
    bf16* FB = (bf16*)(F.ws + WS_BUFA);
    const bool f8 = layer ? (FP8_G1_L1 != 0) : (FP8_G1_L0 != 0);
    int* route = (int*)(F.ws + WS_ROUTE);
    const int tk = F.lane & 15, kg = F.lane >> 4;
    for (int st = 0; st < 2; ++st) {
    const int t0 = st ? tB : tA, per = st ? nB : nA, li0 = st ? nA : 0;
    if (per == 0) break;
    if constexpr (SPLIT) { if (st == 0) ctr_wait(F, WS_P5F, 224u); else ctr_wait(F, WS_P5C, 32u); }
    for (int g0 = 16 * F.wave; g0 < per; g0 += 16 * NWAVES) {
        const int nv = min(16, per - g0);
        const int tq = t0 + g0 + (tk < nv ? tk : 0);
        const bf16* hr = h_row(F, tq) + 8 * kg;
        float s2 = 0.f;
        {
            u32x4 raw[32];
#pragma unroll
            for (int ks = 0; ks < 32; ++ks) raw[ks] = *(const u32x4*)(hr + 32 * ks);
#pragma unroll
            for (int ks = 0; ks < 32; ++ks)
#pragma unroll
                for (int i = 0; i < 4; ++i) { const float a = bflo(raw[ks][i]), b2 = bfhi(raw[ks][i]); s2 += a * a + b2 * b2; }
        }
        s2 += __shfl_xor(s2, 16); s2 += __shfl_xor(s2, 32);
        const float rstd = 1.0f / sqrtf(s2 * (1.0f / D) + EPS);
        const int sl = (mod_row(tq) != r0) ? 1024 : 0;
        const LAS float* gsp = GS + sl + 8 * kg; const LAS float* shp = SH + sl + 8 * kg;
        unsigned char* fb8 = (unsigned char*)FB + (size_t)tq * D + 8 * kg;
        bf16* fb16 = FB + (size_t)tq * D + 8 * kg;
        f32x4 acc = (f32x4){0.f, 0.f, 0.f, 0.f};
        u32x4 nx[8];
#pragma unroll
        for (int j = 0; j < 8; ++j) nx[j] = *(const u32x4*)(hr + 32 * j);
#pragma unroll 1
        for (int k4 = 0; k4 < 4; ++k4) {
            u32x4 cu[8];
#pragma unroll
            for (int j = 0; j < 8; ++j) cu[j] = nx[j];
            if (k4 < 3) {
#pragma unroll
                for (int j = 0; j < 8; ++j) nx[j] = *(const u32x4*)(hr + 32 * (8 * k4 + 8 + j)); }
#pragma unroll
            for (int j = 0; j < 8; ++j) {
                const int ks = 8 * k4 + j;
                const f32x4 g0v = *(const LAS f32x4*)(gsp + 32 * ks), g1v = *(const LAS f32x4*)(gsp + 32 * ks + 4), s0v = *(const LAS f32x4*)(shp + 32 * ks), s1v = *(const LAS f32x4*)(shp + 32 * ks + 4);
                float f[8];
                f[0] = bflo(cu[j].x) * rstd * g0v.x + s0v.x; f[1] = bfhi(cu[j].x) * rstd * g0v.y + s0v.y; f[2] = bflo(cu[j].y) * rstd * g0v.z + s0v.z; f[3] = bfhi(cu[j].y) * rstd * g0v.w + s0v.w;
                f[4] = bflo(cu[j].z) * rstd * g1v.x + s1v.x; f[5] = bfhi(cu[j].z) * rstd * g1v.y + s1v.y; f[6] = bflo(cu[j].w) * rstd * g1v.z + s1v.z; f[7] = bfhi(cu[j].w) * rstd * g1v.w + s1v.w;
                u32x4 hi, lo;
#pragma unroll
                for (int i = 0; i < 4; ++i) { const unsigned h0 = f2bf(f[2 * i]), h1 = f2bf(f[2 * i + 1]); hi[i] = h0 | (h1 << 16);
                    lo[i] = pk2(f[2 * i] - __builtin_bit_cast(float, h0 << 16), f[2 * i + 1] - __builtin_bit_cast(float, h1 << 16)); }
                if (tk < nv) {
                    if (f8) { u32x2 o; o.x = pg8::pk4_fp8(f[0], f[1], f[2], f[3]); o.y = pg8::pk4_fp8(f[4], f[5], f[6], f[7]); *(u32x2*)(fb8 + 32 * ks) = o; }
                    else *(u32x4*)(fb16 + 32 * ks) = hi;
                }
                const bf16x8 bh = *(const LAS bf16x8*)(rwh + tk * RW_LD + 32 * ks + 8 * kg), bl = *(const LAS bf16x8*)(rwl + tk * RW_LD + 32 * ks + 8 * kg);
                const bf16x8 ah = __builtin_bit_cast(bf16x8, hi), al = __builtin_bit_cast(bf16x8, lo);
                acc = __builtin_amdgcn_mfma_f32_16x16x32_bf16(ah, bh, acc, 0, 0, 0);
                acc = __builtin_amdgcn_mfma_f32_16x16x32_bf16(ah, bl, acc, 0, 0, 0);
                acc = __builtin_amdgcn_mfma_f32_16x16x32_bf16(al, bh, acc, 0, 0, 0);
            }
        }
#pragma unroll
        for (int j = 0; j < 4; ++j) lgs[(4 * kg + j) * 16 + tk] = acc[j];
        LDS_WAIT(); asm volatile("" ::: "memory");
        if (F.lane < nv) {
            const int tqq = t0 + g0 + F.lane;
            float aff[16], sel[16];
#pragma unroll
            for (int e4 = 0; e4 < 4; ++e4) { const f32x4 l4 = *(const LAS f32x4*)(lgs + F.lane * 16 + 4 * e4); const f32x4 b4 = *(const f32x4*)(F.in[I_RB] + 4 * e4);
                aff[4 * e4] = 1.0f / (1.0f + expf(-l4.x)); aff[4 * e4 + 1] = 1.0f / (1.0f + expf(-l4.y)); aff[4 * e4 + 2] = 1.0f / (1.0f + expf(-l4.z)); aff[4 * e4 + 3] = 1.0f / (1.0f + expf(-l4.w));
                sel[4 * e4] = aff[4 * e4] + b4.x; sel[4 * e4 + 1] = aff[4 * e4 + 1] + b4.y; sel[4 * e4 + 2] = aff[4 * e4 + 2] + b4.z; sel[4 * e4 + 3] = aff[4 * e4 + 3] + b4.w; }
            int best = 0; float bs = -1e30f;
#pragma unroll
            for (int gq = 0; gq < 4; ++gq) { const float a = sel[4 * gq], b = sel[4 * gq + 1], c = sel[4 * gq + 2], d = sel[4 * gq + 3];
                const float s = fmaxf(fmaxf(fmaxf(a + b, a + c), fmaxf(a + d, b + c)), fmaxf(b + d, c + d));
                if (s > bs) { bs = s; best = gq; } }
            float sv[4], av[4];
#pragma unroll
            for (int i = 0; i < 4; ++i) { sv[i] = sel[i]; av[i] = aff[i]; }
#pragma unroll
            for (int gq = 1; gq < 4; ++gq) if (best == gq) {
#pragma unroll
                for (int i = 0; i < 4; ++i) { sv[i] = sel[4 * gq + i]; av[i] = aff[4 * gq + i]; } }
            int i1 = 0; float s1 = sv[0], a1 = av[0];
#pragma unroll
            for (int i = 1; i < 4; ++i) if (sv[i] > s1) { s1 = sv[i]; a1 = av[i]; i1 = i; }
            int i2 = -1; float s2v = -1e30f, a2 = 0.f;
#pragma unroll
            for (int i = 0; i < 4; ++i) if (i != i1 && sv[i] > s2v) { s2v = sv[i]; a2 = av[i]; i2 = i; }
            const int e1 = 4 * best + i1, e2 = 4 * best + i2;
            const float wsum = a1 + a2, w1 = a1 / wsum, w2 = a2 / wsum;
            const unsigned r1 = atomicAdd((unsigned*)(cnt + e1), 1u), r2 = atomicAdd((unsigned*)(cnt + e2), 1u);
            int* ro = route + (size_t)tqq * 8;
            ro[0] = e1; ro[1] = e2; ro[4] = __builtin_bit_cast(int, w1); ro[5] = __builtin_bit_cast(int, w2);
            const int li = li0 + g0 + F.lane;
            tinfo[4 * li + 0] = e1; tinfo[4 * li + 1] = e2; tinfo[4 * li + 2] = (int)r1; tinfo[4 * li + 3] = (int)r2;
        }
        LDS_WAIT(); asm volatile("" ::: "memory");
    }
    }
    __syncthreads();
    if (F.tid < 16) gb[F.tid] = (int)__hip_atomic_fetch_add((unsigned*)(F.ws + WS_GCNT) + layer * 16 + F.tid, cnt[F.tid], __ATOMIC_RELAXED, __HIP_MEMORY_SCOPE_AGENT);
    __syncthreads();
    int* tokmap = (int*)(F.ws + WS_TOKMAP);
    for (int i = F.tid; i < nA + nB; i += 512) {
        const int tok = (i < nA) ? tA + i : tB + (i - nA);
        const int e1 = tinfo[4 * i], e2 = tinfo[4 * i + 1], p1 = gb[e1] + tinfo[4 * i + 2], p2 = gb[e2] + tinfo[4 * i + 3];
        tokmap[(size_t)e1 * T + p1] = tok; tokmap[(size_t)e2 * T + p2] = tok;
        int* ro = route + (size_t)tok * 8; ro[2] = p1; ro[3] = p2;
    }
}

__device__ __forceinline__ int moe_tables(Frame& F, int layer) {
    LAS int* tb = (LAS int*)(F.lds + LDS_CTL + 64); LAS int* cn = (LAS int*)(F.lds + LDS_CTL + 192);
    __syncthreads();
    if (F.tid < 16) cn[F.tid] = ld_coh((const int*)(F.ws + WS_GCNT) + layer * 16 + F.tid);
    __syncthreads();
    if (F.tid == 0) { int b = 0; for (int e = 0; e < 16; ++e) { tb[e] = b; b += (cn[e] + 255) >> 8; } tb[16] = b; }
    __syncthreads();
    return __builtin_amdgcn_readfirstlane(tb[16]);
}

template <int NQ> __device__ __forceinline__ void combine_tokens(Frame& F, int layer, int t) {
    const float* mods = (const float*)(F.ws + WS_MODS);
    const bf16* OS = (const bf16*)(F.ws + WS_BUFP);
    const int* route = (const int*)(F.ws + WS_ROUTE);
    const LAS int* tb = (const LAS int*)(F.lds + LDS_CTL + 64);
    bf16* A = (bf16*)(F.ws + WS_BUFA);
    {
        int rc[NQ][4]; float w0[NQ], w1[NQ];
#pragma unroll
        for (int q = 0; q < NQ; ++q) { const int* ro = route + (size_t)(t + q) * 8;
#pragma unroll
            for (int i = 0; i < 4; ++i) rc[q][i] = ld_coh(ro + i);
            w0[q] = ld_cohf((const float*)(ro + 4)); w1[q] = ld_cohf((const float*)(ro + 5)); }
        f32x4 v[NQ][4]; u32x2 oa[NQ][4], ob[NQ][4];
#pragma unroll
        for (int q = 0; q < NQ; ++q) { const bf16* hr = h_row(F, t + q);
            const size_t s0 = (size_t)(tb[rc[q][0]] * 256 + rc[q][2]) * D, s1 = (size_t)(tb[rc[q][1]] * 256 + rc[q][3]) * D;
#pragma unroll
            for (int j = 0; j < 4; ++j) { const int c = 4 * F.lane + 256 * j; { const u32x2 hv = *(const u32x2*)(hr + c); v[q][j] = (f32x4){bflo(hv.x), bfhi(hv.x), bflo(hv.y), bfhi(hv.y)}; } oa[q][j] = __builtin_nontemporal_load((const u32x2*)(OS + s0 + c)); ob[q][j] = __builtin_nontemporal_load((const u32x2*)(OS + s1 + c)); } }
        const int mr = mod_row(t);
        const float* m5 = mods + (size_t)(layer * 9 + mr) * 6144 + 5 * 1024;
#pragma unroll
        for (int j = 0; j < 4; ++j) { const f32x4 g5 = *(const f32x4*)(m5 + 4 * F.lane + 256 * j);
#pragma unroll
            for (int q = 0; q < NQ; ++q) { const u32x2 a = oa[q][j], b2 = ob[q][j];
                const f32x4 o = (f32x4){w0[q] * bflo(a.x) + w1[q] * bflo(b2.x), w0[q] * bfhi(a.x) + w1[q] * bfhi(b2.x), w0[q] * bflo(a.y) + w1[q] * bflo(b2.y), w0[q] * bfhi(a.y) + w1[q] * bfhi(b2.y)};
                v[q][j] = v[q][j] + g5 * o; } }
#pragma unroll
        for (int q = 0; q < NQ; ++q) {
            if (layer == 0) {
                bf16* hr = h_row(F, t + q);
#pragma unroll
                for (int j = 0; j < 4; ++j) { u32x2 o; o.x = pk2(v[q][j].x, v[q][j].y); o.y = pk2(v[q][j].z, v[q][j].w); *(u32x2*)(hr + 4 * F.lane + 256 * j) = o; }
                const float* m = mods + (size_t)(9 + mr) * 6144;
                norm_mod_store(v[q], F.in[I_NMG] + 1024, m, m + 1024, A + (size_t)(t + q) * D, F.lane);
            } else {
                float s2 = 0.f;
#pragma unroll
                for (int j = 0; j < 4; ++j) s2 += (v[q][j].x * v[q][j].x + v[q][j].y * v[q][j].y) + (v[q][j].z * v[q][j].z + v[q][j].w * v[q][j].w);
                const float rstd = 1.0f / sqrtf(wave_sum(s2) * (1.0f / D) + EPS);
                float* orow = F.out + (size_t)(t + q) * D;
#pragma unroll
                for (int j = 0; j < 4; ++j) { const int c = 4 * F.lane + 256 * j; __builtin_nontemporal_store(v[q][j] * rstd * *(const f32x4*)(F.in[I_FG] + c), (f32x4*)(orow + c)); }
            }
        }
    }
}
__device__ __forceinline__ void phase_combine(Frame& F, int layer, int ntok) {
    const int gw = F.vcu * NWAVES + F.wave, NGW = F.G * NWAVES;
    if (layer == 0) { for (int t = 2 * gw; t < TL; t += 2 * NGW) combine_tokens<2>(F, 0, t); for (int t = TL + gw; t < ntok; t += NGW) combine_tokens<1>(F, 0, t); }
    else { for (int t = 4 * gw; t < TL; t += 4 * NGW) combine_tokens<4>(F, 1, t); }
}

constexpr int KV_LD = 72, VL_OFF = 384 * KV_LD * 2, ROPE_LDS = 131072;
typedef short v4i16_t __attribute__((ext_vector_type(4)));

__device__ __forceinline__ bf16x8 rope_pack(const u32x4 x1, const u32x4 x2, const LAS float* cs, const LAS float* sn, float scale, bool second) {
    const f32x4 c0 = *(const LAS f32x4*)cs, c1 = *(const LAS f32x4*)(cs + 4), s0 = *(const LAS f32x4*)sn, s1 = *(const LAS f32x4*)(sn + 4);
    float c[8] = {c0.x, c0.y, c0.z, c0.w, c1.x, c1.y, c1.z, c1.w}, s[8] = {s0.x, s0.y, s0.z, s0.w, s1.x, s1.y, s1.z, s1.w};
    float a[8], b[8];
#pragma unroll
    for (int i = 0; i < 4; ++i) { a[2 * i] = bflo(x1[i]); a[2 * i + 1] = bfhi(x1[i]); b[2 * i] = bflo(x2[i]); b[2 * i + 1] = bfhi(x2[i]); }
    float o[8];
#pragma unroll
    for (int i = 0; i < 8; ++i) o[i] = (second ? (b[i] * c[i] + a[i] * s[i]) : (a[i] * c[i] - b[i] * s[i])) * scale;
    u32x4 w; w.x = pk2(o[0], o[1]); w.y = pk2(o[2], o[3]); w.z = pk2(o[4], o[5]); w.w = pk2(o[6], o[7]);
    return __builtin_bit_cast(bf16x8, w);
}

struct AttnU { int b, qb, kvh; };
__device__ __forceinline__ AttnU attn_unit_of(int u) { AttnU r; r.kvh = u & 1; r.qb = (u >> 1) & 31; r.b = u >> 6; return r; }

__device__ __forceinline__ void attn_load_latk(Frame& F, const bf16* P1, AttnU u, u32x4 (&lk)[2][4]) {
    const u32x4 z = (u32x4){0u, 0u, 0u, 0u};
#pragma unroll
    for (int it = 0; it < 2; ++it) { const int task = F.tid + 512 * it, kidx = task >> 1, hh = task & 1, pos = u.qb * 128 - 128 + kidx;
        const bool ok = task < 768 && pos >= 0 && pos < NSEQ;
        const bf16* row = P1 + (size_t)(u.b * NSEQ + (ok ? pos : 0)) * OIN + 1024 + u.kvh * 64 + 8 * hh;
#pragma unroll
        for (int st = 0; st < 4; ++st) lk[it][st] = ok ? *(const u32x4*)(row + 16 * st) : z; }
}
__device__ __forceinline__ void attn_load_latv(Frame& F, const bf16* P1, AttnU u, u32x4 (&lv)[6]) {
    const u32x4 z = (u32x4){0u, 0u, 0u, 0u};
#pragma unroll
    for (int it = 0; it < 6; ++it) { const int task = F.tid + 512 * it, kidx = task >> 3, c8 = task & 7, pos = u.qb * 128 - 128 + kidx;
        const bool ok = pos >= 0 && pos < NSEQ;
        lv[it] = ok ? *(const u32x4*)(P1 + (size_t)(u.b * NSEQ + (ok ? pos : 0)) * OIN + 1152 + u.kvh * 64 + 8 * c8) : z; }
}
__device__ __forceinline__ void attn_write_lat(Frame& F, AttnU u, const u32x4 (&lk)[2][4], const u32x4 (&lv)[6]) {
    LAS bf16* KL = (LAS bf16*)F.lds; LAS bf16* VL = (LAS bf16*)(F.lds + VL_OFF); const LAS float* rope = (const LAS float*)(F.lds + ROPE_LDS);
#pragma unroll
    for (int it = 0; it < 2; ++it) { const int task = F.tid + 512 * it, kidx = task >> 1, hh = task & 1; int pos = u.qb * 128 - 128 + kidx; pos = pos < 0 ? 0 : (pos > NSEQ - 1 ? NSEQ - 1 : pos);
        if (task < 768) {
            LAS bf16* d = KL + kidx * KV_LD + 8 * hh;
            const LAS float* c0 = rope + (pos >> 6) * 16 + 8 * hh; const LAS float* c1 = rope + (pos & 63) * 16 + 8 * hh;
            *(LAS bf16x8*)(d) = rope_pack(lk[it][0], lk[it][1], c0, c0 + 1024, 1.0f, false);
            *(LAS bf16x8*)(d + 16) = rope_pack(lk[it][0], lk[it][1], c0, c0 + 1024, 1.0f, true);
            *(LAS bf16x8*)(d + 32) = rope_pack(lk[it][2], lk[it][3], c1, c1 + 1024, 1.0f, false);
            *(LAS bf16x8*)(d + 48) = rope_pack(lk[it][2], lk[it][3], c1, c1 + 1024, 1.0f, true);
        } }
#pragma unroll
    for (int it = 0; it < 6; ++it) { const int task = F.tid + 512 * it, kidx = task >> 3, c8 = task & 7; *(LAS u32x4*)(VL + kidx * KV_LD + 8 * c8) = lv[it]; }
}
__device__ __forceinline__ void attn_load_ctx(Frame& F, const bf16* P1, AttnU u, u32x4 (&ck)[4], u32x4 (&cv)[4]) {
#pragma unroll
    for (int it = 0; it < 4; ++it) { const int task = F.tid + 512 * it, kidx = task >> 3, c8 = task & 7;
        const bf16* row = P1 + (size_t)(TL + u.b * LCTX + kidx) * OIN + 1024 + u.kvh * 64 + 8 * c8;
        ck[it] = *(const u32x4*)row; cv[it] = *(const u32x4*)(row + 128); }
}
__device__ __forceinline__ void attn_write_ctx(Frame& F, const u32x4 (&ck)[4], const u32x4 (&cv)[4]) {
    LAS bf16* KL = (LAS bf16*)F.lds; LAS bf16* VL = (LAS bf16*)(F.lds + VL_OFF);
#pragma unroll
    for (int it = 0; it < 4; ++it) { const int task = F.tid + 512 * it, kidx = task >> 3, c8 = task & 7;
        *(LAS u32x4*)(KL + kidx * KV_LD + 8 * c8) = ck[it]; *(LAS u32x4*)(VL + kidx * KV_LD + 8 * c8) = cv[it]; }
}

__device__ __forceinline__ unsigned cvtpk(float lo, float hi) { unsigned r; asm volatile("v_cvt_pk_bf16_f32 %0, %1, %2" : "=v"(r) : "v"(lo), "v"(hi)); return r; }
__device__ __forceinline__ float xhalf_max(float x) { const auto r = __builtin_amdgcn_permlane32_swap(__builtin_bit_cast(unsigned, x), __builtin_bit_cast(unsigned, x), false, false);
    return fmaxf(__builtin_bit_cast(float, r[0]), __builtin_bit_cast(float, r[1])); }
__device__ __forceinline__ float xhalf_sum(float x) { const auto r = __builtin_amdgcn_permlane32_swap(__builtin_bit_cast(unsigned, x), __builtin_bit_cast(unsigned, x), false, false);
    return __builtin_bit_cast(float, r[0]) + __builtin_bit_cast(float, r[1]); }
__device__ __forceinline__ void attn_tiles(Frame& F, int kt0, int kt1, int mk0, int mk1, const bf16x8 (&qf)[4], f32x16 (&O)[2], float& mrun, float& lrun, int qrel) {
    if (kt0 > kt1) return;
    const LAS bf16* KL = (const LAS bf16*)F.lds; const LAS bf16* VL = (const LAS bf16*)(F.lds + VL_OFF);
    const int r32 = F.lane & 31, hh = F.lane >> 5;
    const int q4 = (F.lane & 15) >> 2, p4 = F.lane & 3, blk = (F.lane >> 4) & 1;
    const LAS bf16* kp = KL + (kt0 * 32 + r32) * KV_LD + 8 * hh;
    const LAS bf16* vp = VL + (kt0 * 32 + 4 * hh + q4) * KV_LD + 16 * blk + 4 * p4;
    bf16x8 kn[4];
#pragma unroll
    for (int st = 0; st < 4; ++st) kn[st] = *(const LAS bf16x8*)(kp + 16 * st);
    for (int kt = kt0; kt <= kt1; ++kt) {
        bf16x8 kf[4];
#pragma unroll
        for (int st = 0; st < 4; ++st) kf[st] = kn[st];
        v4i16_t vlo[2][2], vhi[2][2];
#pragma unroll
        for (int dt = 0; dt < 2; ++dt)
#pragma unroll
            for (int s2 = 0; s2 < 2; ++s2) { vlo[dt][s2] = __builtin_amdgcn_ds_read_tr16_b64_v4i16((LAS v4i16_t*)(vp + (16 * s2) * KV_LD + dt * 32));
                vhi[dt][s2] = __builtin_amdgcn_ds_read_tr16_b64_v4i16((LAS v4i16_t*)(vp + (16 * s2 + 8) * KV_LD + dt * 32)); }
        kp += 32 * KV_LD; vp += 32 * KV_LD;
        if (kt < kt1) {
#pragma unroll
            for (int st = 0; st < 4; ++st) kn[st] = *(const LAS bf16x8*)(kp + 16 * st); }
        __builtin_amdgcn_sched_barrier(0);
        f32x16 s;
#pragma unroll
        for (int r = 0; r < 16; ++r) s[r] = 0.f;
#pragma unroll
        for (int st = 0; st < 4; ++st) s = __builtin_amdgcn_mfma_f32_32x32x16_bf16(kf[st], qf[st], s, 0, 0, 0);
        if (kt == mk0 || kt == mk1) {
#pragma unroll
            for (int r = 0; r < 16; ++r) { const int dlt = kt * 32 + (r & 3) + 8 * (r >> 2) + 4 * hh - qrel; s[r] = (dlt <= 128 && dlt >= -128) ? s[r] : -INFINITY; } }
        float mx = fmaxf(fmaxf(s[0], s[1]), fmaxf(s[2], s[3]));
#pragma unroll
        for (int r = 4; r < 16; r += 4) mx = fmaxf(mx, fmaxf(fmaxf(s[r], s[r + 1]), fmaxf(s[r + 2], s[r + 3])));
        mx = xhalf_max(mx);
        const float mnew = fmaxf(mrun, mx);
        float ps0 = 0.f, ps1 = 0.f;
#pragma unroll
        for (int r = 0; r < 16; r += 2) { s[r] = __builtin_amdgcn_exp2f(s[r] - mnew); s[r + 1] = __builtin_amdgcn_exp2f(s[r + 1] - mnew); ps0 += s[r]; ps1 += s[r + 1]; }
        const float ps = xhalf_sum(ps0 + ps1);
        if (__any(mnew > mrun)) {
            const float alpha = __builtin_amdgcn_exp2f(mrun - mnew);
            lrun *= alpha;
#pragma unroll
            for (int dt = 0; dt < 2; ++dt)
#pragma unroll
                for (int r = 0; r < 16; ++r) O[dt][r] *= alpha;
        }
        lrun += ps; mrun = mnew;
        bf16x8 pb[2];
#pragma unroll
        for (int s2 = 0; s2 < 2; ++s2) { u32x4 w; w.x = cvtpk(s[8 * s2 + 0], s[8 * s2 + 1]); w.y = cvtpk(s[8 * s2 + 2], s[8 * s2 + 3]); w.z = cvtpk(s[8 * s2 + 4], s[8 * s2 + 5]); w.w = cvtpk(s[8 * s2 + 6], s[8 * s2 + 7]);
            pb[s2] = __builtin_bit_cast(bf16x8, w); }
#pragma unroll
        for (int dt = 0; dt < 2; ++dt)
#pragma unroll
            for (int s2 = 0; s2 < 2; ++s2) {
                const bf16x8 va = (bf16x8){vlo[dt][s2][0], vlo[dt][s2][1], vlo[dt][s2][2], vlo[dt][s2][3], vhi[dt][s2][0], vhi[dt][s2][1], vhi[dt][s2][2], vhi[dt][s2][3]};
                O[dt] = __builtin_amdgcn_mfma_f32_32x32x16_bf16(va, pb[s2], O[dt], 0, 0, 0);
            }
    }
}

__device__ __forceinline__ void phase_attn(Frame& F) {
    const bf16* P1 = (const bf16*)(F.ws + WS_BUFP);
    bf16* MIX = (bf16*)(F.ws + WS_BUFA);
    const int r32 = F.lane & 31, hh = F.lane >> 5;
    constexpr float QSC = 0.125f * 1.4426950408889634f;
    LAS float* ropel = (LAS float*)(F.lds + ROPE_LDS);
    for (int i = F.tid; i < 2048; i += 512) ropel[i] = ((const float*)(F.ws + WS_ROPE))[i];
    u32x4 lk[2][4], lv[6], ck[4], cv[4];
    const int nu = (512 - F.vcu + F.G - 1) / F.G;
    if (nu > 0) attn_load_latk(F, P1, attn_unit_of(F.vcu), lk);
    for (int ui = 0; ui < nu; ++ui) {
        const AttnU u = attn_unit_of(F.vcu + ui * F.G);
        u32x4 qr[2][4];
#pragma unroll
        for (int i = 0; i < 2; ++i) { const int task = F.wave + 8 * i, g = task & 3, sub = task >> 2, head = u.kvh * 4 + g, pos = u.qb * 128 + 32 * sub + r32;
            const bf16* row = P1 + (size_t)(u.b * NSEQ + pos) * OIN + 512 + head * 64 + 8 * hh;
#pragma unroll
            for (int st = 0; st < 4; ++st) qr[i][st] = __builtin_nontemporal_load((const u32x4*)(row + 16 * st)); }
        attn_load_latv(F, P1, u, lv);
        __syncthreads();
        attn_write_lat(F, u, lk, lv);
        bf16x8 qf[2][4]; f32x16 O[2][2]; float mrun[2], lrun[2];
#pragma unroll
        for (int i = 0; i < 2; ++i) { const int task = F.wave + 8 * i, g = task & 3, sub = task >> 2, head = u.kvh * 4 + g, pos = u.qb * 128 + 32 * sub + r32;
            const LAS float* c0 = ropel + (pos >> 6) * 16 + 8 * hh; const LAS float* c1 = ropel + (pos & 63) * 16 + 8 * hh;
            qf[i][0] = rope_pack(qr[i][0], qr[i][1], c0, c0 + 1024, QSC, false); qf[i][1] = rope_pack(qr[i][0], qr[i][1], c0, c0 + 1024, QSC, true);
            qf[i][2] = rope_pack(qr[i][2], qr[i][3], c1, c1 + 1024, QSC, false); qf[i][3] = rope_pack(qr[i][2], qr[i][3], c1, c1 + 1024, QSC, true);
            mrun[i] = F.in[I_OSINK][head] * 1.4426950408889634f; lrun[i] = 1.0f;
#pragma unroll
            for (int dt = 0; dt < 2; ++dt)
#pragma unroll
                for (int r = 0; r < 16; ++r) O[i][dt][r] = 0.f; }
        __syncthreads();
        const int kt_lo = (u.qb == 0) ? 4 : 0, kt_hi = (u.qb == 31) ? 7 : 11;
#pragma unroll
        for (int i = 0; i < 2; ++i) { const int sub = (F.wave + 8 * i) >> 2, qrel = 128 + 32 * sub + r32;
            attn_tiles(F, max(sub, kt_lo), min(sub + 8, kt_hi), sub, sub + 8, qf[i], O[i], mrun[i], lrun[i], qrel); }
        attn_load_ctx(F, P1, u, ck, cv);
        __syncthreads();
        attn_write_ctx(F, ck, cv);
        __syncthreads();
        if (ui + 1 < nu) attn_load_latk(F, P1, attn_unit_of(F.vcu + (ui + 1) * F.G), lk);
#pragma unroll
        for (int i = 0; i < 2; ++i) {
            attn_tiles(F, 0, 7, -1, -1, qf[i], O[i], mrun[i], lrun[i], 0);
            const int task = F.wave + 8 * i, g = task & 3, sub = task >> 2, head = u.kvh * 4 + g, pos = u.qb * 128 + 32 * sub + r32;
            const float inv = 1.0f / lrun[i];
            bf16* o = MIX + (size_t)(u.b * NSEQ + pos) * D + 512 + head * 64 + 4 * hh;
#pragma unroll
            for (int dt = 0; dt < 2; ++dt)
#pragma unroll
                for (int rg = 0; rg < 4; ++rg) { u32x2 w; w.x = pk2(O[i][dt][4 * rg] * inv, O[i][dt][4 * rg + 1] * inv); w.y = pk2(O[i][dt][4 * rg + 2] * inv, O[i][dt][4 * rg + 3] * inv);
                    *(u32x2*)(o + dt * 32 + 8 * rg) = w; }
        }
    }
    __syncthreads();
}

__device__ __forceinline__ void phase_pool_stencil(Frame& F) {
    const bf16* P1 = (const bf16*)(F.ws + WS_BUFP);
    bf16* MIX = (bf16*)(F.ws + WS_BUFA);
    const int gw = F.vcu * NWAVES + F.wave, NGW = F.G * NWAVES;
    const int r = 1 << (F.lane >> 4);
    constexpr int NT = 8, NR = NT + 16;
    for (int t = NT * gw; t < TL; t += NT * NGW) {
        const int pos = t & 4095;
        const bf16* base = P1 + (size_t)t * OIN + 8 * F.lane;
        u32x4 v[NR];
#pragma unroll
        for (int jj = 0; jj < NR; ++jj) { const int pj = pos + jj - 8; const bool ok = pj >= 0 && pj < NSEQ; v[jj] = ok ? *(const u32x4*)(base + (ptrdiff_t)(jj - 8) * OIN) : (u32x4){0u, 0u, 0u, 0u}; }
        float acc[NT][8];
#pragma unroll
        for (int q = 0; q < NT; ++q)
#pragma unroll
            for (int i = 0; i < 8; ++i) acc[q][i] = 0.f;
#pragma unroll
        for (int jj = 0; jj < NR; ++jj) {
            float x[8];
#pragma unroll
            for (int i = 0; i < 4; ++i) { x[2 * i] = bflo(v[jj][i]); x[2 * i + 1] = bfhi(v[jj][i]); }
#pragma unroll
            for (int q = 0; q < NT; ++q) { const int dd = jj - 8 - q; if (dd >= -8 && dd <= 8) { const float w = (dd <= r && dd >= -r) ? 1.0f : 0.0f;
#pragma unroll
                for (int i = 0; i < 8; ++i) acc[q][i] += w * x[i]; } }
        }
#pragma unroll
        for (int q = 0; q < NT; ++q) {
            const int pq = pos + q, lo = max(pq - r, 0), hi = min(pq + r + 1, NSEQ);
            const float ic = 1.0f / (float)(hi - lo);
            const u32x4 sv = v[q + 8];
            u32x4 o;
#pragma unroll
            for (int i = 0; i < 4; ++i) o[i] = pk2(acc[q][2 * i] * ic - bflo(sv[i]), acc[q][2 * i + 1] * ic - bfhi(sv[i]));
            *(u32x4*)(MIX + (size_t)(t + q) * D + 8 * F.lane) = o;
        }
    }
}

__device__ __forceinline__ void phase_attn_pool(Frame& F) {
    phase_attn(F);
#ifdef DBG_ATTN2
    phase_attn(F);
#endif
    phase_pool_stencil(F);
    __syncthreads();
    convert_l1_range(F, 120 * L1T_N + F.vcu * L1A_N, L1A_N, 40);
}

constexpr int NPHASE = 20;
__global__ void __launch_bounds__(NWAVES * 64, 2) mk_fwd(Args args) {
    extern __shared__ __attribute__((aligned(16))) unsigned char lds_raw[];
    Frame F;
    F.lds = (LAS unsigned char*)lds_raw;
    F.tid = threadIdx.x; F.lane = F.tid & 63; F.wave = __builtin_amdgcn_readfirstlane(F.tid >> 6);
    F.G = gridDim.x; { const int bx = blockIdx.x; F.vcu = (F.G % 8 == 0) ? (bx % 8) * (F.G / 8) + bx / 8 : bx; }
    F.ws = args.ws; F.in = args.in; F.out = args.out;
    for (int u = F.tid; u < (LDS_BYTES - LDS_CTL) / 4; u += NWAVES * 64) ((LAS unsigned*)(F.lds + LDS_CTL))[u] = 0u;
    __syncthreads();
    const int lo = args.ph_lo, hi = args.ph_hi;
    XcdBarrier bar; bar.bar = (unsigned*)(F.ws + WS_CTL); bar.x = 0; bar.st = nullptr;
    if (hi - lo > 1) bar = xcd_barrier_post((unsigned*)(F.ws + WS_CTL), (volatile LAS unsigned*)(F.lds + LDS_CTL));
    F.nxl = 0u; F.nxh = 0u;
    const unsigned myx = xb_xcc_id();
    if (hi - lo > 1 && F.tid == 0) (void)xb_add((unsigned*)(F.ws + WS_CENSUS) + myx * 2 + ((F.vcu & 31) >= 28 ? 1 : 0), 1u);
#define IN(k) (lo <= (k) && (k) < hi)
#ifndef PHASE_MASK
#define PHASE_MASK 0xffffffffu
#endif
#define PH(k, ...) if constexpr (((PHASE_MASK >> (k)) & 1u) != 0u) if (IN(k)) { __VA_ARGS__ if constexpr (((DBG_DOUBLE >> (k)) & 1u) != 0u) { __VA_ARGS__ } }
#define SEAM(k) do { if (IN(k) && IN((k) + 1)) xcd_barrier(bar); } while (0)
    unsigned char* ws = F.ws;
    const float* mods = (const float*)(ws + WS_MODS);

    PH(1, { phase_prologue_a(F); }) SEAM(1);
    if (hi - lo > 1) { F.nxl = (unsigned)__builtin_amdgcn_readfirstlane((int)xb_ld((unsigned*)(F.ws + WS_CENSUS) + myx * 2)); F.nxh = (unsigned)__builtin_amdgcn_readfirstlane((int)xb_ld((unsigned*)(F.ws + WS_CENSUS) + myx * 2 + 1)); }
    PH(2, {
        pg8::SchedDense S{(const char*)(ws + WS_BUFA), (const char*)(ws + WS_W_EIN), 1024, 8, 136, 0, 1088, F.vcu, F.G};
        pg8::EpiStore E{(bf16*)(ws + WS_BUFP), EIN};
        pg8::gemm_phase<pg8::EpiStore, pg8::SchedDense>(F.lds, 1024, S, E);
        if (F.vcu >= 64) { __syncthreads(); convert_l1_range(F, (F.vcu - 64) * L0T_N, L0T_N, 48, 0); }
    }) SEAM(2);
    PH(3, { phase_fourier_a_conv(F); })
    PH(4, { phase_fourier_c(F); }) SEAM(4);
    PH(5, {
        const int xs = F.vcu >> 5, rs = F.vcu & 31; const bool heavy = rs >= 28;
        pg8::SchedSplit S{(const char*)(ws + WS_BUFA), (const char*)(ws + WS_W_EOUT), 1024, heavy ? 448 + 4 * xs + (rs - 28) : 28 * xs + rs, heavy ? 32 : 224, heavy ? 3 : 2};
        pg8::EpiResid<true> E{F.in[I_X], F.in[I_CTX], (bf16*)(ws + WS_HB), mods + 2 * 1024};
        pg8::gemm_phase<pg8::EpiResid<true>, pg8::SchedSplit>(F.lds, 1024, S, E);
        ctr_publish(F, heavy ? WS_P5C : WS_P5F, heavy ? 2 : 1, heavy ? F.nxh : F.nxl);
    })
    PH(6, { phase_route<true>(F, 0, T); }) SEAM(6);
    PH(7, {
        const int ntile = moe_tables(F, 0);
        if constexpr (FP8_G1_L0) {
            pg8::SchedMoe<true> S{(const char*)(ws + WS_BUFA), (const char*)(ws + WS_W_M1) + (size_t)0 * 32 * MiB, (const int*)(ws + WS_TOKMAP), (const LAS int*)(F.lds + LDS_CTL + 64), (const LAS int*)(F.lds + LDS_CTL + 192), 512, (size_t)MiB, ntile * 4, F.vcu, F.G};
            pg8::EpiSwiglu8 E{(unsigned char*)(ws + WS_BUFZ), pg8::W1_SCALE};
            pg8::gemm_phase<pg8::EpiSwiglu8, pg8::SchedMoe<true>, true>(F.lds, 512, S, E);
        } else {
            pg8::SchedMoe<true> S{(const char*)(ws + WS_BUFA), (const char*)(ws + WS_W_M1) + (size_t)0 * 32 * MiB, (const int*)(ws + WS_TOKMAP), (const LAS int*)(F.lds + LDS_CTL + 64), (const LAS int*)(F.lds + LDS_CTL + 192), 1024, (size_t)2 * MiB, ntile * 4, F.vcu, F.G};
            if constexpr (FP8_G2_L0) { pg8::EpiSwiglu8 E{(unsigned char*)(ws + WS_BUFZ), 1.0f}; pg8::gemm_phase<pg8::EpiSwiglu8, pg8::SchedMoe<true>>(F.lds, 1024, S, E); }
            else { pg8::EpiSwiglu E{(bf16*)(ws + WS_BUFZ)}; pg8::gemm_phase<pg8::EpiSwiglu, pg8::SchedMoe<true>>(F.lds, 1024, S, E); }
        }
    }) SEAM(7);
    PH(8, {
        const int ntile = moe_tables(F, 0);
        if constexpr (FP8_G2_L0) {
            pg8::SchedMoe<false> S{(const char*)(ws + WS_BUFZ), (const char*)(ws + WS_W_M2) + (size_t)0 * 16 * MiB, nullptr, (const LAS int*)(F.lds + LDS_CTL + 64), (const LAS int*)(F.lds + LDS_CTL + 192), 256, (size_t)512 * KiB, ntile * 4, F.vcu, F.G};
            pg8::EpiStoreS E{(bf16*)(ws + WS_BUFP), 1024, 1.0f / (pg8::HID_SCALE * pg8::W2_SCALE)};
            pg8::gemm_phase<pg8::EpiStoreS, pg8::SchedMoe<false>, true>(F.lds, 256, S, E);
        } else {
            pg8::SchedMoe<false> S{(const char*)(ws + WS_BUFZ), (const char*)(ws + WS_W_M2) + (size_t)0 * 16 * MiB, nullptr, (const LAS int*)(F.lds + LDS_CTL + 64), (const LAS int*)(F.lds + LDS_CTL + 192), 512, (size_t)MiB, ntile * 4, F.vcu, F.G};
            pg8::EpiStore E{(bf16*)(ws + WS_BUFP), 1024};
            pg8::gemm_phase<pg8::EpiStore, pg8::SchedMoe<false>>(F.lds, 512, S, E);
        }
    }) SEAM(8);
    PH(9, { (void)moe_tables(F, 0); phase_combine(F, 0, T); }) SEAM(9);
    PH(10, {
        pg8::SchedDense S{(const char*)(ws + WS_BUFA), (const char*)(ws + WS_W_OIN), 1024, 5, 128, 4, 648, F.vcu, F.G};
        pg8::EpiStore E{(bf16*)(ws + WS_BUFP), OIN};
        pg8::gemm_phase<pg8::EpiStore, pg8::SchedDense>(F.lds, 1024, S, E);
        if (F.vcu >= 136) { __syncthreads(); convert_l1_range(F, (F.vcu - 136) * L1T_N, L1T_N, 44); }
    }) SEAM(10);
    PH(11, { phase_attn_pool(F); }) SEAM(11);
    PH(12, {
        pg8::SchedDense S{(const char*)(ws + WS_BUFA), (const char*)(ws + WS_W_OOUT), 1024, 4, 128, 0, 512, F.vcu, F.G};
        pg8::EpiResid<false> E{nullptr, nullptr, (bf16*)(ws + WS_HB), mods + 9 * 6144 + 2 * 1024};
        pg8::gemm_phase<pg8::EpiResid<false>, pg8::SchedDense>(F.lds, 1024, S, E);
    }) SEAM(12);
    PH(13, { phase_route<false>(F, 1, TL); }) SEAM(13);
    PH(14, {
        const int ntile = moe_tables(F, 1);
        if constexpr (FP8_G1_L1) {
            pg8::SchedMoe<true> S{(const char*)(ws + WS_BUFA), (const char*)(ws + WS_W_M1) + (size_t)1 * 32 * MiB, (const int*)(ws + WS_TOKMAP), (const LAS int*)(F.lds + LDS_CTL + 64), (const LAS int*)(F.lds + LDS_CTL + 192), 512, (size_t)MiB, ntile * 4, F.vcu, F.G};
            pg8::EpiSwiglu8 E{(unsigned char*)(ws + WS_BUFZ), pg8::W1_SCALE};
            pg8::gemm_phase<pg8::EpiSwiglu8, pg8::SchedMoe<true>, true>(F.lds, 512, S, E);
        } else {
            pg8::SchedMoe<true> S{(const char*)(ws + WS_BUFA), (const char*)(ws + WS_W_M1) + (size_t)1 * 32 * MiB, (const int*)(ws + WS_TOKMAP), (const LAS int*)(F.lds + LDS_CTL + 64), (const LAS int*)(F.lds + LDS_CTL + 192), 1024, (size_t)2 * MiB, ntile * 4, F.vcu, F.G};
            if constexpr (FP8_G2_L1) { pg8::EpiSwiglu8 E{(unsigned char*)(ws + WS_BUFZ), 1.0f}; pg8::gemm_phase<pg8::EpiSwiglu8, pg8::SchedMoe<true>>(F.lds, 1024, S, E); }
            else { pg8::EpiSwiglu E{(bf16*)(ws + WS_BUFZ)}; pg8::gemm_phase<pg8::EpiSwiglu, pg8::SchedMoe<true>>(F.lds, 1024, S, E); }
        }
    }) SEAM(14);
    PH(15, {
        const int ntile = moe_tables(F, 1);
        if constexpr (FP8_G2_L1) {
            pg8::SchedMoe<false> S{(const char*)(ws + WS_BUFZ), (const char*)(ws + WS_W_M2) + (size_t)1 * 16 * MiB, nullptr, (const LAS int*)(F.lds + LDS_CTL + 64), (const LAS int*)(F.lds + LDS_CTL + 192), 256, (size_t)512 * KiB, ntile * 4, F.vcu, F.G};
            pg8::EpiStoreS E{(bf16*)(ws + WS_BUFP), 1024, 1.0f / (pg8::HID_SCALE * pg8::W2_SCALE)};
            pg8::gemm_phase<pg8::EpiStoreS, pg8::SchedMoe<false>, true>(F.lds, 256, S, E);
        } else {
            pg8::SchedMoe<false> S{(const char*)(ws + WS_BUFZ), (const char*)(ws + WS_W_M2) + (size_t)1 * 16 * MiB, nullptr, (const LAS int*)(F.lds + LDS_CTL + 64), (const LAS int*)(F.lds + LDS_CTL + 192), 512, (size_t)MiB, ntile * 4, F.vcu, F.G};
            pg8::EpiStore E{(bf16*)(ws + WS_BUFP), 1024};
            pg8::gemm_phase<pg8::EpiStore, pg8::SchedMoe<false>>(F.lds, 512, S, E);
        }
    }) SEAM(15);
    PH(16, { (void)moe_tables(F, 1); phase_combine(F, 1, TL); }) SEAM(16);
#ifdef DBG_XBAR
    if (hi - lo > 1) { for (int xb = 0; xb < DBG_XBAR; ++xb) xcd_barrier(bar); }
#endif
#undef IN
#undef SEAM
}

extern "C" void kernel_launch(void* const* d_in, const int* in_sizes, int n_in, void* d_out, int out_size, void* d_ws, size_t ws_size, hipStream_t stream) {
    static int grid = 0;
    if (grid == 0) {
        if (n_in != 22 || ws_size < WS_END) { fprintf(stderr, "kernel_launch: unexpected inputs (n_in %d, ws %zu)\n", n_in, ws_size); grid = -1; return; }
        int dev = 0, cus = 0, per_cu = 0;
        if (hipGetDevice(&dev) != hipSuccess || hipDeviceGetAttribute(&cus, hipDeviceAttributeMultiprocessorCount, dev) != hipSuccess) { grid = -1; return; }
        if (hipFuncSetAttribute((const void*)mk_fwd, hipFuncAttributeMaxDynamicSharedMemorySize, LDS_BYTES) != hipSuccess) { fprintf(stderr, "kernel_launch: hipFuncSetAttribute failed\n"); grid = -1; return; }
        if (hipOccupancyMaxActiveBlocksPerMultiprocessor(&per_cu, (const void*)mk_fwd, NWAVES * 64, LDS_BYTES) != hipSuccess || per_cu < 1) { fprintf(stderr, "kernel_launch: occupancy query says %d\n", per_cu); }
        (void)hipGetLastError();
        grid = cus;
        if (grid != 256) { fprintf(stderr, "kernel_launch: %d CUs; this build assumes 256\n", grid); }
    }
    if (grid < 0) return;
    (void)hipMemsetAsync((char*)d_ws + WS_CTL, 0, CTL_ZERO_BYTES, stream);
    Args a{};
    for (int i = 0; i < 22; ++i) a.in[i] = (const float*)d_in[i];
    a.out = (float*)d_out; a.ws = (unsigned char*)d_ws;
#if MK_MULTI
    for (int p = 0; p <= DBG_STOP; ++p) { a.ph_lo = p; a.ph_hi = p + 1; hipLaunchKernelGGL(mk_fwd, dim3(grid), dim3(NWAVES * 64), LDS_BYTES, stream, a); }
    if (DBG_STOP < 16) { a.ph_lo = 17; a.ph_hi = 18; hipLaunchKernelGGL(mk_fwd, dim3(grid), dim3(NWAVES * 64), LDS_BYTES, stream, a); }
#else
    a.ph_lo = 0; a.ph_hi = 17;
    hipLaunchKernelGGL(mk_fwd, dim3(grid), dim3(NWAVES * 64), LDS_BYTES, stream, a);
#endif
}
```

```cpp
#include <hip/hip_runtime.h>
#include <cstdio>
#include <cstdint>
#include <type_traits>

#ifndef MK_MULTI
#define MK_MULTI 0
#endif
#ifndef DBG_STOP
#define DBG_STOP 16
#endif

#ifndef DBG_DOUBLE
#define DBG_DOUBLE 0u
#endif
#ifndef FP8_G1_L0
#define FP8_G1_L0 1
#endif
#ifndef FP8_G1_L1
#define FP8_G1_L1 1
#endif
#ifndef FP8_G2_L0
#define FP8_G2_L0 1
#endif
#ifndef FP8_G2_L1
#define FP8_G2_L1 1
#endif
#define LAS __attribute__((address_space(3)))
#define GAS __attribute__((address_space(1)))
typedef unsigned short bf16;
typedef short bf16x8 __attribute__((ext_vector_type(8)));
typedef short s16x4 __attribute__((ext_vector_type(4)));
typedef float f32x4 __attribute__((ext_vector_type(4)));
typedef float f32x16 __attribute__((ext_vector_type(16)));
typedef unsigned u32x4 __attribute__((ext_vector_type(4)));
typedef unsigned u32x2 __attribute__((ext_vector_type(2)));

constexpr int NB = 8, NSEQ = 4096, D = 1024, LCTX = 256;
constexpr int TL = NB * NSEQ, TC = NB * LCTX, T = TL + TC;
constexpr int EIN = 2048;
constexpr int OIN = 1280;
constexpr int NE = 16, DE = 512;
constexpr int MAXSLOT = 73728;
constexpr float EPS = 1e-6f;

constexpr size_t KiB = 1024, MiB = 1024 * 1024;
constexpr size_t WS_CTL = 0, CTL_ZERO_BYTES = 64 * KiB;
constexpr size_t WS_MODS = 64 * KiB;
constexpr size_t WS_ROPE = WS_MODS + 512 * KiB;
constexpr size_t WS_WA = WS_ROPE + 8 * KiB;
constexpr size_t WS_WAC = WS_WA + 32 * KiB;
constexpr size_t WS_WCC = WS_WAC + 2 * KiB;
constexpr size_t WS_FD = 3 * MiB - 64 * KiB;
constexpr size_t WS_BCNT = WS_WCC + 16 * KiB;
constexpr size_t WS_TILEMAP = WS_BCNT + 16 * KiB;
constexpr size_t WS_SLOT = WS_TILEMAP + 2 * KiB;
constexpr size_t WS_WROW = WS_SLOT + 288 * KiB;
constexpr size_t WS_ROUTE = WS_WROW + 288 * KiB;
constexpr size_t WS_WC = 3 * MiB;
constexpr size_t WS_W_EIN = 4 * MiB;
constexpr size_t WS_W_EOUT = 9 * MiB;
constexpr size_t WS_W_OIN = 11 * MiB;
constexpr size_t WS_W_OOUT = 14 * MiB;
constexpr size_t WS_W_POOL = 16 * MiB;
constexpr size_t WS_W_M1 = 17 * MiB;
constexpr size_t WS_W_M2 = 81 * MiB;
constexpr size_t WS_HC = 113 * MiB;
constexpr size_t WS_BUFA = 121 * MiB;
constexpr size_t WS_BUFP = 189 * MiB;
constexpr size_t WS_BUFZ = 360 * MiB;
constexpr size_t WS_TOKMAP = 432 * MiB;
constexpr size_t WS_HB = 435 * MiB;
constexpr size_t WS_END = 503 * MiB;
constexpr size_t WS_MODSDONE = 24 * KiB;
constexpr size_t WS_FAF = 28 * KiB + 512;
constexpr size_t WS_P5F = 28 * KiB, WS_P5C = 28 * KiB + 256;
constexpr size_t WS_CENSUS = 28 * KiB + 768;
constexpr size_t WS_XCDOF = 60 * KiB;
constexpr size_t WS_G1CNT = 61 * KiB;
constexpr size_t WS_XARR = 32 * KiB;
constexpr size_t WS_GCNT = 16 * KiB;
static_assert(WS_ROUTE + (size_t)T * 32 <= WS_WC, "small region");
static_assert((size_t)T * EIN * 2 <= WS_BUFZ - WS_BUFP && (size_t)MAXSLOT * 1024 * 2 <= WS_BUFZ - WS_BUFP, "BUFP");
static_assert((size_t)MAXSLOT * 512 * 2 <= WS_TOKMAP - WS_BUFZ && (size_t)T * 1024 * 2 <= WS_TOKMAP - WS_BUFZ, "BUFZ");
static_assert((size_t)16 * T * 4 <= WS_HB - WS_TOKMAP && (size_t)T * 1024 * 2 <= WS_END - WS_HB, "TOKMAP / HB");
static_assert((size_t)T * 1024 * 2 <= WS_BUFP - WS_BUFA, "BUFA");

constexpr int LDS_BYTES = 163840;
constexpr int LDS_GIDX = 147456;
constexpr int LDS_CTL = 146432;
constexpr int NWAVES = 8;

__device__ __forceinline__ unsigned f2bf(float f) { unsigned u = __builtin_bit_cast(unsigned, f); return (u + 0x7fffu + ((u >> 16) & 1u)) >> 16; }
__device__ __forceinline__ unsigned pk2(float lo, float hi) { return f2bf(lo) | (f2bf(hi) << 16); }
__device__ __forceinline__ float bflo(unsigned w) { return __builtin_bit_cast(float, w << 16); }
__device__ __forceinline__ float bfhi(unsigned w) { return __builtin_bit_cast(float, w & 0xffff0000u); }
__device__ __forceinline__ float wave_sum(float v) {
#pragma unroll
    for (int o = 1; o < 64; o <<= 1) v += __shfl_xor(v, o);
    return v;
}
__device__ __forceinline__ int ld_coh(const int* p) { return (int)__hip_atomic_load((const unsigned*)p, __ATOMIC_RELAXED, __HIP_MEMORY_SCOPE_AGENT); }
__device__ __forceinline__ float ld_cohf(const float* p) { return __builtin_bit_cast(float, __hip_atomic_load((const unsigned*)p, __ATOMIC_RELAXED, __HIP_MEMORY_SCOPE_AGENT)); }
#define LDS_WAIT() asm volatile("s_waitcnt lgkmcnt(0)" ::: "memory")

#define XB_TMO      128
#define XB_XCNT(j)  (256  + 64 * (j))
#define XB_XSUB(j)  (1280 + 64 * (j))
#define XB_XGEN(j)  (2304 + 64 * (j))
#define XB_TOP      3328
#define XB_TOPGEN   3392
#define XCD_BAR_WORDS 3456
#define XB_SPIN_CAP (1u << 18)
__device__ __forceinline__ unsigned xb_ld(unsigned* p)              { return __hip_atomic_load(p, __ATOMIC_RELAXED, __HIP_MEMORY_SCOPE_AGENT); }
__device__ __forceinline__ unsigned xb_add(unsigned* p, unsigned v) { return __hip_atomic_fetch_add(p, v, __ATOMIC_RELAXED, __HIP_MEMORY_SCOPE_AGENT); }
__device__ __forceinline__ unsigned xb_xcc_id() { return (unsigned)__builtin_amdgcn_s_getreg((3 << 11) | 20) & 0xFu; }
#define XB_SPIN(cond, bar) do { unsigned _sp = 0; while (cond) { __builtin_amdgcn_s_sleep(1); \
    if ((++_sp & 255u) == 0u) { if (xb_ld(&(bar)[XB_TMO])) break; if (_sp > XB_SPIN_CAP) { atomicAdd(&(bar)[XB_TMO], 1u); break; } } } } while (0)
struct XcdBarrier { unsigned* bar; unsigned x; volatile LAS unsigned* st; };
__device__ __forceinline__ XcdBarrier xcd_barrier_post(unsigned* bar, volatile LAS unsigned* st) {
    XcdBarrier b; b.bar = bar; b.x = xb_xcc_id(); b.st = st;
    if (threadIdx.x == 0) (void)xb_add(&bar[XB_XCNT(b.x)], 1u);
    return b;
}
__device__ __forceinline__ void xcd_barrier_complete(unsigned* bar, unsigned x, unsigned& nloc, unsigned& nx) {
    const unsigned G = gridDim.x * gridDim.y * gridDim.z;
    unsigned sum, cnt, mine, sp = 0u;
    for (;;) {
        sum = 0u; cnt = 0u; mine = 0u;
#pragma unroll
        for (unsigned j = 0; j < 16; ++j) { const unsigned c = xb_ld(&bar[XB_XCNT(j)]); sum += c; cnt += (c > 0u) ? 1u : 0u; mine = (j == x) ? c : mine; }
        if (sum == G) break;
        __builtin_amdgcn_s_sleep(1);
        if ((++sp & 255u) == 0u) { if (xb_ld(&bar[XB_TMO])) break; if (sp > XB_SPIN_CAP) { atomicAdd(&bar[XB_TMO], 1u); break; } }
    }
    nloc = mine > 0u ? mine : 1u; nx = cnt > 0u ? cnt : 1u;
}
__device__ __forceinline__ void xcd_barrier(const XcdBarrier& b) {
    asm volatile("s_waitcnt vmcnt(0)" ::: "memory");
    __syncthreads();
    if (threadIdx.x == 0) {
        unsigned* bar = b.bar;
        __builtin_amdgcn_s_waitcnt(0);
        unsigned nloc = b.st[0], nx = b.st[1];
        if (nloc == 0u) { xcd_barrier_complete(bar, b.x, nloc, nx); b.st[0] = nloc; b.st[1] = nx; }
        const unsigned old = xb_add(&bar[XB_XSUB(b.x)], 1u);
        const unsigned gen = old / nloc;
        if (old + 1u == (gen + 1u) * nloc) {
            __builtin_amdgcn_fence(__ATOMIC_RELEASE, "agent");
            asm volatile("s_waitcnt vmcnt(0)" ::: "memory");
            const unsigned og = xb_add(&bar[XB_TOP], 1u);
            const unsigned tg = og / nx;
            if (og + 1u == (tg + 1u) * nx) xb_add(&bar[XB_TOPGEN], 1u);
            else XB_SPIN(xb_ld(&bar[XB_TOPGEN]) == tg, bar);
            __builtin_amdgcn_fence(__ATOMIC_ACQUIRE, "agent");
            xb_add(&bar[XB_XGEN(b.x)], 1u);
            asm volatile("s_waitcnt vmcnt(0)" ::: "memory");
        } else {
            XB_SPIN(xb_ld(&bar[XB_XGEN(b.x)]) == gen, bar);
            __builtin_amdgcn_fence(__ATOMIC_ACQUIRE, "agent");
            asm volatile("s_waitcnt vmcnt(0)" ::: "memory");
        }
    }
    __syncthreads();
}

namespace pg8 {
constexpr int BM = 256, BK = 64, HALF = 128, HTB = HALF * BK * 2, STAGE_BYTES = 8 * HTB;
__host__ __device__ __forceinline__ int lds_byte(int r, int c) { const int st = (r >> 4) * 2 + (c >> 5), rr = r & 15, cc = c & 31, ob = rr * 64 + cc * 2; return st * 1024 + (ob ^ (((ob >> 9) & 1) << 5)); }
__host__ __device__ __forceinline__ void stage_rc(int b, int& R, int& C) { const int st = b / 1024, sb = b % 1024, swz = sb ^ (((sb >> 9) & 1) << 5); R = (st >> 1) * 16 + swz / 64; C = (st & 1) * 32 + (swz % 64) / 2; }
__host__ __device__ __forceinline__ int perm32(int rho) { const int n = rho >> 4, i = rho & 15; return 8 * (i >> 2) + 4 * n + (i & 3); }
struct Unit { int pm, pn, e; };
__device__ __forceinline__ unsigned cvt_pk_bf16(float lo, float hi) { unsigned r; asm volatile("v_cvt_pk_bf16_f32 %0, %1, %2" : "=v"(r) : "v"(lo), "v"(hi)); return r; }

typedef int v8i32 __attribute__((ext_vector_type(8)));
typedef int v4i32 __attribute__((ext_vector_type(4)));
__device__ __forceinline__ v8i32 cat16(const bf16x8 lo, const bf16x8 hi) { return __builtin_shufflevector(__builtin_bit_cast(v4i32, lo), __builtin_bit_cast(v4i32, hi), 0, 1, 2, 3, 4, 5, 6, 7); }
template <class Epi, class Sched, bool FP8 = false>
__device__ __forceinline__ void gemm_phase(LAS unsigned char* lds, const int K, const Sched& S, const Epi& E) {
    const int tid = threadIdx.x, wid = __builtin_amdgcn_readfirstlane(tid >> 6), lane = tid & 63, wr = wid >> 2, wc = wid & 3, fr = lane & 15, fq = lane >> 4;
    const int nt = K / BK;
    int tidv = tid;
#define PG8_VB(i) ([&]() -> unsigned { int R_, C_; stage_rc(tidv * 16 + (i) * 8192, R_, C_); const int Rb_ = Epi::PERM ? ((R_ & ~31) + perm32(R_ & 31)) : R_; return (unsigned)(Rb_ * K + C_) * 2u; }())
#define PG8_VA(h, i) ([&]() -> unsigned { int R_, C_; stage_rc(tidv * 16 + (i) * 8192, R_, C_); return (unsigned)((128 * (h) + R_) * K + C_) * 2u; }())
    const size_t kstep = (size_t)(BK * 2);
    const size_t hstep = (size_t)HALF * K * 2;
    const unsigned ldsw = (unsigned)wid * 1024u;
#define aoff (lds_byte(wr * 64 + (tidv & 15), ((tidv >> 4) & 3) * 8))
#define boff (lds_byte(wc * 32 + (tidv & 15), ((tidv >> 4) & 3) * 8))
#define PG8_SA(b, h) (((b) * 2 + (h)) * HTB)
#define PG8_SB(b, h) ((4 + (b) * 2 + (h)) * HTB)
#define PG8_STAGEB(bufoff, gbase) do { _Pragma("unroll") for (int _i = 0; _i < 2; ++_i) \
        __builtin_amdgcn_global_load_lds((const unsigned*)((const char*)(gbase) + PG8_VB(_i)), (LAS unsigned*)(lds + (bufoff) + ldsw + _i * 8192), 16, 0, 0); } while (0)
#define PG8_STAGEA(bufoff, gbase, h, NEXT) do { _Pragma("unroll") for (int _i = 0; _i < 2; ++_i) { unsigned vo_; \
        if constexpr (Sched::GATHER) { int R_, C_; stage_rc(tidv * 16 + _i * 8192, R_, C_); const unsigned raw_ = gidx[((((NEXT) && usen) ? (gslot ^ 1u) : gslot) * 4u + (h) * 2 + _i) * 512u + tid]; vo_ = (raw_ * (unsigned)K + (unsigned)C_) * 2u; } \
        else vo_ = PG8_VA(h, _i); \
        __builtin_amdgcn_global_load_lds((const unsigned*)((const char*)(gbase) + vo_), (LAS unsigned*)(lds + (bufoff) + ldsw + _i * 8192), 16, 0, 0); } } while (0)
#define PG8_LDA(dst, b, h) do { _Pragma("unroll") for (int m = 0; m < 4; ++m) _Pragma("unroll") for (int k = 0; k < 2; ++k) dst[m][k] = *(const LAS bf16x8*)(lds + PG8_SA(b, h) + aoff + m * 2048 + k * 1024); } while (0)
#define PG8_LDB(dst, b, h) do { _Pragma("unroll") for (int n = 0; n < 2; ++n) _Pragma("unroll") for (int k = 0; k < 2; ++k) dst[n][k] = *(const LAS bf16x8*)(lds + PG8_SB(b, h) + boff + n * 2048 + k * 1024); } while (0)
#define PG8_MMA(ai, bj, At, Bt) do { __builtin_amdgcn_s_setprio(1); _Pragma("unroll") for (int m = 0; m < 4; ++m) _Pragma("unroll") for (int n = 0; n < 2; ++n) { \
        if constexpr (FP8) acc[ai][bj][m][n] = __builtin_amdgcn_mfma_scale_f32_16x16x128_f8f6f4(cat16(Bt[n][0], Bt[n][1]), cat16(At[m][0], At[m][1]), acc[ai][bj][m][n], 0, 0, 0, 0x7f7f7f7f, 0, 0x7f7f7f7f); \
        else { _Pragma("unroll") for (int k = 0; k < 2; ++k) acc[ai][bj][m][n] = __builtin_amdgcn_mfma_f32_16x16x32_bf16(Bt[n][k], At[m][k], acc[ai][bj][m][n], 0, 0, 0); } } \
        __builtin_amdgcn_s_setprio(0); } while (0)
#define PG8_WAIT_V(n) asm volatile("s_waitcnt vmcnt(" #n ")" ::: "memory")
#define PG8_WAIT_L(n) asm volatile("s_waitcnt lgkmcnt(" #n ")" ::: "memory")
#define PG8_BAR __builtin_amdgcn_s_barrier()
#define PG8_SCHED __builtin_amdgcn_sched_barrier(0)
#define PG8_ITER(A1, A2, A3, B2, B3) do { \
            PG8_LDB(B0, 0, 0); PG8_LDB(B1, 0, 1); PG8_SCHED; PG8_LDA(At, 0, 0); PG8_STAGEA(PG8_SA(1, 1), A1, 1, 0); \
            PG8_WAIT_V(8); PG8_WAIT_L(0); PG8_BAR; PG8_MMA(0, 0, At, B0); PG8_MMA(0, 1, At, B1); PG8_BAR; PG8_SCHED; \
            PG8_LDA(At, 0, 1); PG8_STAGEB(PG8_SB(0, 0), B2); PG8_STAGEB(PG8_SB(0, 1), (B2) + hstep); PG8_STAGEA(PG8_SA(0, 0), A2, 0, 1); \
            PG8_WAIT_V(8); PG8_WAIT_L(0); PG8_BAR; PG8_MMA(1, 0, At, B0); PG8_MMA(1, 1, At, B1); PG8_BAR; PG8_SCHED; \
            PG8_LDB(B0, 1, 0); PG8_LDB(B1, 1, 1); PG8_SCHED; PG8_LDA(At, 1, 0); PG8_STAGEA(PG8_SA(0, 1), A2, 1, 1); \
            PG8_WAIT_V(8); PG8_WAIT_L(0); PG8_BAR; PG8_MMA(0, 0, At, B0); PG8_MMA(0, 1, At, B1); PG8_BAR; PG8_SCHED; \
            PG8_LDA(At, 1, 1); PG8_STAGEB(PG8_SB(1, 0), B3); PG8_STAGEB(PG8_SB(1, 1), (B3) + hstep); PG8_STAGEA(PG8_SA(1, 0), A3, 0, 1); \
            PG8_WAIT_V(8); PG8_WAIT_L(0); PG8_BAR; PG8_MMA(1, 0, At, B0); PG8_MMA(1, 1, At, B1); PG8_BAR; PG8_SCHED; } while (0)
    Unit cur, nxt; int ui = 0;
    if (!S.next(0, cur)) return;
    f32x4 acc[2][2][4][2];
#pragma unroll
    for (int a = 0; a < 2; ++a)
#pragma unroll
        for (int b = 0; b < 2; ++b)
#pragma unroll
            for (int m = 0; m < 4; ++m)
#pragma unroll
                for (int n = 0; n < 2; ++n) acc[a][b][m][n] = (f32x4){0.f, 0.f, 0.f, 0.f};
    bf16x8 At[4][2], B0[2][2], B1[2][2];
    const LAS unsigned* gidx = (const LAS unsigned*)(lds + LDS_GIDX); unsigned gslot = 0u;
    if constexpr (Sched::GATHER) { S.idx_dma(cur, (LAS unsigned*)(lds + LDS_GIDX), tidv, wid); asm volatile("s_waitcnt vmcnt(0)" ::: "memory"); }
    const char* cA = S.a_base(cur); const char* cB = S.b_base(cur);
    constexpr bool usen = false;
    PG8_STAGEB(PG8_SB(0, 0), cB); PG8_STAGEB(PG8_SB(0, 1), cB + hstep); PG8_STAGEA(PG8_SA(0, 0), cA, 0, 0); PG8_STAGEA(PG8_SA(0, 1), cA, 1, 0);
    if (wr == 1) PG8_BAR;
    PG8_WAIT_V(2); PG8_BAR;
    PG8_STAGEB(PG8_SB(1, 0), cB + kstep); PG8_STAGEA(PG8_SA(1, 0), cA + kstep, 0, 0); PG8_STAGEB(PG8_SB(1, 1), cB + hstep + kstep);
    PG8_WAIT_V(6); PG8_BAR;
    for (;;) {
        const bool has_next = S.next(ui + 1, nxt);
        const char* nA = has_next ? S.a_base(nxt) : cA; const char* nB = has_next ? S.b_base(nxt) : cB;
#pragma unroll 1
        for (int t = 0; t < nt; t += 2) {
            const bool last = (t == nt - 2);
            const char* a1 = cA + (size_t)(t + 1) * kstep;
            const char* a2 = last ? nA : cA + (size_t)(t + 2) * kstep; const char* b2 = last ? nB : cB + (size_t)(t + 2) * kstep;
            tidv = tid; asm volatile("" : "+v"(tidv));
            if constexpr (Sched::GATHER) {
                if (t == nt - 4 && has_next) S.idx_dma(nxt, (LAS unsigned*)(lds + LDS_GIDX) + (gslot ^ 1u) * 2048u, tidv, wid);
            }
            const bool usen = last && has_next;
            PG8_ITER(a1, a2, a2 + kstep, b2, b2 + kstep);
        }
        if (wr == 0) PG8_BAR;
        E(acc, cur, wr, wc, fr, fq);
        if (!has_next) break;
#pragma unroll
        for (int a = 0; a < 2; ++a)
#pragma unroll
            for (int b = 0; b < 2; ++b)
#pragma unroll
                for (int m = 0; m < 4; ++m)
#pragma unroll
                    for (int n = 0; n < 2; ++n) acc[a][b][m][n] = (f32x4){0.f, 0.f, 0.f, 0.f};
        cur = nxt; cA = nA; cB = nB; ++ui;
        if constexpr (Sched::GATHER) gslot ^= 1u;
        if (wr == 1) PG8_BAR;
    }
    PG8_WAIT_V(0);
    PG8_BAR;
#undef PG8_ITER
#undef aoff
#undef boff
#undef PG8_SA
#undef PG8_SB
#undef PG8_STAGEA
#undef PG8_STAGEB
#undef PG8_VA
#undef PG8_VB
#undef PG8_LDA
#undef PG8_LDB
#undef PG8_MMA
#undef PG8_WAIT_V
#undef PG8_WAIT_L
#undef PG8_BAR
#undef PG8_SCHED
}

struct SchedDense {
    static constexpr bool GATHER = false;
    const char* A; const char* Bt; int K, nN, nMfull, pnx, nUnits, c, G;
    __device__ __forceinline__ bool next(int i, Unit& u) const {
        const int L = i * G + c; if (L >= nUnits) return false;
        const int full = nMfull * nN;
        if (L < full) { u.pm = L / nN; u.pn = L - u.pm * nN; } else { u.pm = nMfull + (L - full); u.pn = pnx; }
        u.e = 0; return true;
    }
    __device__ __forceinline__ const char* a_base(const Unit& u) const { return A + (size_t)u.pm * 256 * K * 2; }
    __device__ __forceinline__ const char* b_base(const Unit& u) const { return Bt + (size_t)u.pn * 256 * K * 2; }
};
struct SchedSplit {
    static constexpr bool GATHER = false;
    const char* A; const char* Bt; int K, base, stride, n;
    __device__ __forceinline__ bool next(int i, Unit& u) const {
        if (i >= n) return false;
        const int L = base + i * stride; u.pm = L >> 2; u.pn = L & 3; u.e = 0; return true;
    }
    __device__ __forceinline__ const char* a_base(const Unit& u) const { return A + (size_t)u.pm * 256 * K * 2; }
    __device__ __forceinline__ const char* b_base(const Unit& u) const { return Bt + (size_t)u.pn * 256 * K * 2; }
};
template <bool GATHER_> struct SchedMoe {
    static constexpr bool GATHER = GATHER_, gather = GATHER_;
    const char* A; const char* W; const int* tokmap; const LAS int* tb; const LAS int* cn; int K; size_t wstride; int nUnits, c, G;
    __device__ __forceinline__ bool next(int i, Unit& u) const {
        const int L = i * G + c; if (L >= nUnits) return false;
        u.pm = L >> 2; u.pn = L & 3; int e = 0;
#pragma unroll
        for (int q = 1; q < 16; ++q) if (u.pm >= __builtin_amdgcn_readfirstlane(tb[q])) e = q;
        u.e = __builtin_amdgcn_readfirstlane(e); return true;
    }
    __device__ __forceinline__ const char* a_base(const Unit& u) const { return gather ? A : A + (size_t)u.pm * 256 * K * 2; }
    __device__ __forceinline__ const char* b_base(const Unit& u) const { return W + (size_t)u.e * wstride + (size_t)u.pn * 256 * K * 2; }
    __device__ __forceinline__ void idx_dma(const Unit& u, LAS unsigned* slot, int tidv, int wid) const {
        const int p0 = (u.pm - __builtin_amdgcn_readfirstlane(tb[u.e])) * 256, last = __builtin_amdgcn_readfirstlane(cn[u.e]) - 1; const int* tm = tokmap + (size_t)u.e * T;
#pragma unroll
        for (int h = 0; h < 2; ++h)
#pragma unroll
            for (int i = 0; i < 2; ++i) { int R_, C_; stage_rc(tidv * 16 + i * 8192, R_, C_); int pos = p0 + 128 * h + R_; pos = pos < last ? pos : last;
                __builtin_amdgcn_global_load_lds((const unsigned*)(tm + pos), slot + (h * 2 + i) * 512 + wid * 64, 4, 0, 0); }
    }
};

struct EpiStore {
    static constexpr bool PERM = true;
    bf16* O; int ldc;
    __device__ __forceinline__ void operator()(const f32x4 (&acc)[2][2][4][2], const Unit& u, int wr, int wc, int fr, int fq) const {
        const int row0 = u.pm * BM + wr * 64 + fr, col0 = u.pn * BM + wc * 32 + 8 * fq;
#pragma unroll
        for (int ai = 0; ai < 2; ++ai)
#pragma unroll
            for (int m = 0; m < 4; ++m) { bf16* rowp = O + (size_t)(row0 + ai * HALF + m * 16) * ldc + col0;
#pragma unroll
                for (int bj = 0; bj < 2; ++bj) { const f32x4 v0 = acc[ai][bj][m][0], v1 = acc[ai][bj][m][1];
                    u32x4 w; w.x = cvt_pk_bf16(v0[0], v0[1]); w.y = cvt_pk_bf16(v0[2], v0[3]); w.z = cvt_pk_bf16(v1[0], v1[1]); w.w = cvt_pk_bf16(v1[2], v1[3]);
                    *(u32x4*)(rowp + bj * HALF) = w; } }
    }
};
template <bool SRC_F32> struct EpiResid {
    static constexpr bool PERM = true;
    const float* srcL; const float* srcC; bf16* H; const float* gate;
    __device__ __forceinline__ void operator()(const f32x4 (&acc)[2][2][4][2], const Unit& u, int wr, int wc, int fr, int fq) const {
        const float* g = gate + (u.pm < 128 ? (u.pm >> 4) : 8) * 6144;
        const float* src = (u.pm < 128) ? srcL + (size_t)u.pm * 256 * 1024 : srcC + (size_t)(u.pm - 128) * 256 * 1024;
        bf16* dst = H + (size_t)u.pm * 256 * 1024;
        const int row0 = wr * 64 + fr, col0 = u.pn * BM + wc * 32 + 8 * fq;
        f32x4 gv[2][2];
#pragma unroll
        for (int bj = 0; bj < 2; ++bj)
#pragma unroll
            for (int n = 0; n < 2; ++n) gv[bj][n] = *(const f32x4*)(g + col0 + bj * HALF + 4 * n);
#pragma unroll
        for (int ai = 0; ai < 2; ++ai)
#pragma unroll
            for (int m = 0; m < 4; ++m) { const size_t ro = (size_t)(row0 + ai * HALF + m * 16) * 1024 + col0;
#pragma unroll
                for (int bj = 0; bj < 2; ++bj) {
                    f32x4 s0, s1;
                    if constexpr (SRC_F32) { s0 = __builtin_nontemporal_load((const f32x4*)(src + ro + bj * HALF)); s1 = __builtin_nontemporal_load((const f32x4*)(src + ro + bj * HALF + 4)); }
                    else { const u32x4 hv = *(const u32x4*)(dst + ro + bj * HALF); s0 = (f32x4){bflo(hv.x), bfhi(hv.x), bflo(hv.y), bfhi(hv.y)}; s1 = (f32x4){bflo(hv.z), bfhi(hv.z), bflo(hv.w), bfhi(hv.w)}; }
                    const f32x4 v0 = s0 + gv[bj][0] * acc[ai][bj][m][0], v1 = s1 + gv[bj][1] * acc[ai][bj][m][1];
                    u32x4 w; w.x = cvt_pk_bf16(v0[0], v0[1]); w.y = cvt_pk_bf16(v0[2], v0[3]); w.z = cvt_pk_bf16(v1[0], v1[1]); w.w = cvt_pk_bf16(v1[2], v1[3]);
                    *(u32x4*)(dst + ro + bj * HALF) = w; } }
    }
};
__device__ __forceinline__ float silu_f(float x) { return x * __builtin_amdgcn_rcpf(1.0f + __expf(-x)); }
struct EpiSwiglu {
    static constexpr bool PERM = true;
    bf16* H;
    __device__ __forceinline__ void operator()(const f32x4 (&acc)[2][2][4][2], const Unit& u, int wr, int wc, int fr, int fq) const {
        const int row0 = u.pm * BM + wr * 64 + fr, col0 = u.pn * 128 + wc * 32 + 8 * fq;
#pragma unroll
        for (int ai = 0; ai < 2; ++ai)
#pragma unroll
            for (int m = 0; m < 4; ++m) { bf16* p = H + (size_t)(row0 + ai * HALF + m * 16) * 512 + col0;
                const f32x4 g0 = acc[ai][0][m][0], g1 = acc[ai][0][m][1], u0 = acc[ai][1][m][0], u1 = acc[ai][1][m][1];
                u32x4 w; w.x = cvt_pk_bf16(silu_f(g0[0]) * u0[0], silu_f(g0[1]) * u0[1]); w.y = cvt_pk_bf16(silu_f(g0[2]) * u0[2], silu_f(g0[3]) * u0[3]);
                w.z = cvt_pk_bf16(silu_f(g1[0]) * u1[0], silu_f(g1[1]) * u1[1]); w.w = cvt_pk_bf16(silu_f(g1[2]) * u1[2], silu_f(g1[3]) * u1[3]);
                *(u32x4*)p = w; }
    }
};
__device__ __forceinline__ unsigned pk4_fp8(float a, float b, float c, float d) { int p = __builtin_amdgcn_cvt_pk_fp8_f32(a, b, 0, false); p = __builtin_amdgcn_cvt_pk_fp8_f32(c, d, p, true); return (unsigned)p; }
constexpr float W1_SCALE = 32.0f, W2_SCALE = 16.0f, HID_SCALE = 4.0f;
struct EpiSwiglu8 {
    static constexpr bool PERM = true;
    unsigned char* H; float in_scale;
    __device__ __forceinline__ void operator()(const f32x4 (&acc)[2][2][4][2], const Unit& u, int wr, int wc, int fr, int fq) const {
        const int row0 = u.pm * BM + wr * 64 + fr, col0 = u.pn * 128 + wc * 32 + 8 * fq;
        const float IS = 1.0f / in_scale, OS = HID_SCALE / in_scale;
#pragma unroll
        for (int ai = 0; ai < 2; ++ai)
#pragma unroll
            for (int m = 0; m < 4; ++m) { unsigned char* p = H + (size_t)(row0 + ai * HALF + m * 16) * 512 + col0;
                const f32x4 g0 = acc[ai][0][m][0] * IS, g1 = acc[ai][0][m][1] * IS, u0 = acc[ai][1][m][0] * OS, u1 = acc[ai][1][m][1] * OS;
#define HC8(x) __builtin_fminf(__builtin_fmaxf((x), -448.0f), 448.0f)
                u32x2 w; w.x = pk4_fp8(HC8(silu_f(g0[0]) * u0[0]), HC8(silu_f(g0[1]) * u0[1]), HC8(silu_f(g0[2]) * u0[2]), HC8(silu_f(g0[3]) * u0[3]));
                w.y = pk4_fp8(HC8(silu_f(g1[0]) * u1[0]), HC8(silu_f(g1[1]) * u1[1]), HC8(silu_f(g1[2]) * u1[2]), HC8(silu_f(g1[3]) * u1[3]));
#undef HC8
                *(u32x2*)p = w; }
    }
};
struct EpiStoreS {
    static constexpr bool PERM = true;
    bf16* O; int ldc; float scale;
    __device__ __forceinline__ void operator()(const f32x4 (&acc)[2][2][4][2], const Unit& u, int wr, int wc, int fr, int fq) const {
        const int row0 = u.pm * BM + wr * 64 + fr, col0 = u.pn * BM + wc * 32 + 8 * fq;
#pragma unroll
        for (int ai = 0; ai < 2; ++ai)
#pragma unroll
            for (int m = 0; m < 4; ++m) { bf16* rowp = O + (size_t)(row0 + ai * HALF + m * 16) * ldc + col0;
#pragma unroll
                for (int bj = 0; bj < 2; ++bj) { const f32x4 v0 = acc[ai][bj][m][0] * scale, v1 = acc[ai][bj][m][1] * scale;
                    u32x4 w; w.x = cvt_pk_bf16(v0[0], v0[1]); w.y = cvt_pk_bf16(v0[2], v0[3]); w.z = cvt_pk_bf16(v1[0], v1[1]); w.w = cvt_pk_bf16(v1[2], v1[3]);
                    *(u32x4*)(rowp + bj * HALF) = w; } }
    }
};
struct EpiScaleRow {
    static constexpr bool PERM = true;
    bf16* O; const float* wrow;
    __device__ __forceinline__ void operator()(const f32x4 (&acc)[2][2][4][2], const Unit& u, int wr, int wc, int fr, int fq) const {
        const int row0 = u.pm * BM + wr * 64 + fr, col0 = u.pn * BM + wc * 32 + 8 * fq;
#pragma unroll
        for (int ai = 0; ai < 2; ++ai)
#pragma unroll
            for (int m = 0; m < 4; ++m) { const int row = row0 + ai * HALF + m * 16; const float s = wrow[row]; bf16* rowp = O + (size_t)row * 1024 + col0;
#pragma unroll
                for (int bj = 0; bj < 2; ++bj) { const f32x4 v0 = acc[ai][bj][m][0] * s, v1 = acc[ai][bj][m][1] * s;
                    u32x4 w; w.x = cvt_pk_bf16(v0[0], v0[1]); w.y = cvt_pk_bf16(v0[2], v0[3]); w.z = cvt_pk_bf16(v1[0], v1[1]); w.w = cvt_pk_bf16(v1[2], v1[3]);
                    *(u32x4*)(rowp + bj * HALF) = w; } }
    }
};
}

struct Args { const float* in[22]; float* out; unsigned char* ws; int ph_lo, ph_hi; };
enum { I_X = 0, I_C, I_CTX, I_CCTX, I_ADAW, I_ADAB, I_NMG, I_NFG, I_EWIN, I_ECONV, I_EWOUT, I_OWIN, I_OPOOLW, I_OPOOLS, I_OSINK, I_OWOUT, I_RW, I_RB, I_MG, I_MU, I_MD, I_FG };

struct Frame {
    LAS unsigned char* lds;
    int tid, lane, wave, vcu, G;
    unsigned char* ws; const float* const* in; float* out;
};
__device__ __forceinline__ bf16* h_row(const Frame& F, int t) { return (bf16*)(F.ws + WS_HB) + (size_t)t * D; }
__device__ __forceinline__ int mod_row(int t) { return t < TL ? (t >> 12) : 8; }

struct TItem { const float* src; bf16* dst; int ldw, ldd; float f8scale; };
__device__ __forceinline__ void titem_load(const TItem& t, f32x4 (&r)[8], int lane) {
#pragma unroll
    for (int i = 0; i < 8; ++i) r[i] = __builtin_nontemporal_load((const f32x4*)(t.src + (size_t)((lane >> 3) + 8 * i) * t.ldw + 4 * (lane & 7)));
}
__device__ __forceinline__ void titem_process(const TItem& t, const f32x4 (&r)[8], LAS float* scr, int lane) {
#pragma unroll
    for (int i = 0; i < 8; ++i) { LAS float* d = scr + ((lane >> 3) + 8 * i) * 33 + 4 * (lane & 7); d[0] = r[i].x; d[1] = r[i].y; d[2] = r[i].z; d[3] = r[i].w; }
    LDS_WAIT(); asm volatile("" ::: "memory");
    const int c = lane & 7;
    if (t.f8scale != 0.0f) {
        const float sc = t.f8scale; unsigned char* d8 = (unsigned char*)t.dst;
#pragma unroll
        for (int j = 0; j < 4; ++j) { const int n = (lane >> 3) + 8 * j; const LAS float* s = scr + (8 * c) * 33 + n;
            u32x2 o; o.x = pg8::pk4_fp8(s[0 * 33] * sc, s[1 * 33] * sc, s[2 * 33] * sc, s[3 * 33] * sc); o.y = pg8::pk4_fp8(s[4 * 33] * sc, s[5 * 33] * sc, s[6 * 33] * sc, s[7 * 33] * sc);
            *(u32x2*)(d8 + (size_t)n * t.ldd + 8 * c) = o; }
    } else {
#pragma unroll
        for (int j = 0; j < 4; ++j) { const int n = (lane >> 3) + 8 * j; const LAS float* s = scr + (8 * c) * 33 + n;
            u32x4 o; o.x = pk2(s[0 * 33], s[1 * 33]); o.y = pk2(s[2 * 33], s[3 * 33]); o.z = pk2(s[4 * 33], s[5 * 33]); o.w = pk2(s[6 * 33], s[7 * 33]);
            *(u32x4*)(t.dst + (size_t)n * t.ldd + 8 * c) = o; }
    }
    LDS_WAIT(); asm volatile("" ::: "memory");
}
constexpr int L0T_N = 32;
constexpr int TS0 = 1024, TS1 = 512, TS2 = 384, TS3 = 512, TS4 = 0, TS5 = 4096, TS6 = 4096, TS7 = 4096, TNITEMS = TS0 + TS1 + TS2 + TS3 + TS4 + TS5 + TS6 + TS7;
__device__ __forceinline__ TItem titem_moe(const float* const* in, unsigned char* ws, int kind, int le, int rr) {
    TItem t; const int layer = le >> 4, e = le & 15; const bool f8 = (kind < 2) ? (layer ? (FP8_G1_L1 != 0) : (FP8_G1_L0 != 0)) : (layer ? (FP8_G2_L1 != 0) : (FP8_G2_L0 != 0));
    if (kind < 2) { const int kb = (rr >> 4) & 15, nb = rr & 15, n0 = nb * 32; const int drow = (n0 >> 7) * 256 + (n0 & 127) + kind * 128;
        t.src = in[kind ? I_MU : I_MG] + (size_t)le * 524288 + (size_t)(kb * 64) * 512 + n0; t.ldw = 512;
        unsigned char* base = ws + WS_W_M1 + (size_t)layer * 32 * MiB;
        if (f8) { t.dst = (bf16*)(base + (size_t)e * MiB + (size_t)drow * 1024 + kb * 64); t.ldd = 1024; t.f8scale = pg8::W1_SCALE; }
        else { t.dst = (bf16*)(base + (size_t)e * 2 * MiB) + (size_t)drow * 1024 + kb * 64; t.ldd = 1024; t.f8scale = 0.0f; } }
    else { const int kb = (rr >> 5) & 7, nb = rr & 31;
        t.src = in[I_MD] + (size_t)le * 524288 + (size_t)(kb * 64) * 1024 + nb * 32; t.ldw = 1024;
        unsigned char* base = ws + WS_W_M2 + (size_t)layer * 16 * MiB;
        if (f8) { t.dst = (bf16*)(base + (size_t)e * 512 * KiB + (size_t)(nb * 32) * 512 + kb * 64); t.ldd = 512; t.f8scale = pg8::W2_SCALE; }
        else { t.dst = (bf16*)(base + (size_t)e * MiB) + (size_t)(nb * 32) * 512 + kb * 64; t.ldd = 512; t.f8scale = 0.0f; } }
    return t;
}
__device__ __forceinline__ TItem titem_decode(const float* const* in, unsigned char* ws, int r) {
    TItem t;
    if (r < TS0) { const int kb = r / 64, nb = r % 64; t.src = in[I_EWIN] + (size_t)(kb * 64) * 2048 + nb * 32; t.ldw = 2048; t.dst = (bf16*)(ws + WS_W_EIN) + (size_t)(nb * 32) * 1024 + kb * 64; t.ldd = 1024; t.f8scale = 0.0f; return t; } r -= TS0;
    if (r < TS1) { const int kb = r / 32, nb = r % 32; t.src = in[I_EWOUT] + (size_t)(kb * 64) * 1024 + nb * 32; t.ldw = 1024; t.dst = (bf16*)(ws + WS_W_EOUT) + (size_t)(nb * 32) * 1024 + kb * 64; t.ldd = 1024; t.f8scale = 0.0f; return t; } r -= TS1;
    if (r < TS2) { const int kb = r / 24, nb = 16 + r % 24; t.src = in[I_OWIN] + (size_t)(kb * 64) * 1280 + nb * 32; t.ldw = 1280; t.dst = (bf16*)(ws + WS_W_OIN) + (size_t)(nb * 32) * 1024 + kb * 64; t.ldd = 1024; t.f8scale = 0.0f; return t; } r -= TS2;
    if (r < TS3) { const int kb = r / 32, nb = r % 32; t.src = in[I_OWOUT] + (size_t)(kb * 64) * 1024 + nb * 32; t.ldw = 1024; t.dst = (bf16*)(ws + WS_W_OOUT) + (size_t)(nb * 32) * 1024 + kb * 64; t.ldd = 1024; t.f8scale = 0.0f; return t; } r -= TS3;
    r += 192 * L0T_N;
    if (r < TS5 + TS6 + TS7) return titem_moe(in, ws, r / 4096, (r % 4096) >> 8, r % 256);
    return t;
}
constexpr int NL1 = 12288;
__device__ __forceinline__ TItem titem_l1(const float* const* in, unsigned char* ws, int r) { return titem_moe(in, ws, r / 4096, 16 + ((r % 4096) >> 8), r % 256); }
__device__ __forceinline__ TItem titem_lx(const float* const* in, unsigned char* ws, int layer, int r) { return titem_moe(in, ws, r / 4096, layer * 16 + ((r % 4096) >> 8), r % 256); }

constexpr size_t WS_CONVCTR = 20 * KiB;
__device__ __forceinline__ void convert_l1(Frame& F, int quota) {
    unsigned* ctr = (unsigned*)(F.ws + WS_CONVCTR);
    LAS float* scr = (LAS float*)(F.lds + F.wave * 17408);
    for (int ch = 0; ch < quota; ++ch) {
        const int c0 = __builtin_amdgcn_readfirstlane(F.lane == 0 ? (int)__hip_atomic_fetch_add(ctr, 4u, __ATOMIC_RELAXED, __HIP_MEMORY_SCOPE_AGENT) : 0);
        if (c0 >= NL1) break;
        f32x4 cur[8], nxt[8];
        TItem tc = titem_l1(F.in, F.ws, c0);
        titem_load(tc, nxt, F.lane);
#pragma unroll 1
        for (int i = 0; i < 4; ++i) {
#pragma unroll
            for (int j = 0; j < 8; ++j) cur[j] = nxt[j];
            const TItem tcur = tc;
            if (i < 3) { tc = titem_l1(F.in, F.ws, c0 + i + 1); titem_load(tc, nxt, F.lane); }
            titem_process(tcur, cur, scr, F.lane);
        }
    }
}
__device__ __forceinline__ void convert_l1_range(Frame& F, const int base, const int cnt, const int ctr_off, const int layer = 1) {
    LAS unsigned* ctr = (LAS unsigned*)(F.lds + LDS_CTL + ctr_off);
    LAS float* scr = (LAS float*)(F.lds + F.wave * 17408);
    f32x4 cur[8], nxt[8];
    int it = __builtin_amdgcn_readfirstlane(F.lane == 0 ? (int)atomicAdd((unsigned*)ctr, 1u) : 0);
    TItem tc = titem_lx(F.in, F.ws, layer, base + (it < cnt ? it : 0));
    if (it < cnt) titem_load(tc, nxt, F.lane);
    while (it < cnt) {
#pragma unroll
        for (int i = 0; i < 8; ++i) cur[i] = nxt[i];
        const TItem tcur = tc;
        const int itn = __builtin_amdgcn_readfirstlane(F.lane == 0 ? (int)atomicAdd((unsigned*)ctr, 1u) : 0);
        if (itn < cnt) { tc = titem_lx(F.in, F.ws, layer, base + itn); titem_load(tc, nxt, F.lane); }
        titem_process(tcur, cur, scr, F.lane);
        it = itn;
    }
}
constexpr int L1T_N = 64, L1A_N = 18;
static_assert(120 * L1T_N + 256 * L1A_N == NL1, "layer-1 conversion split");
__device__ __forceinline__ void tail_fill(Frame& F, int nUnits, int quota) {
    const int rounds = (nUnits + F.G - 1) / F.G;
    if ((rounds - 1) * F.G + F.vcu >= nUnits) convert_l1(F, quota);
}

__device__ __forceinline__ void norm_mod_store(const f32x4 (&v)[4], const float* g, const float* shift, const float* scale, bf16* orow, int lane) {
    float s2 = 0.f;
#pragma unroll
    for (int j = 0; j < 4; ++j) s2 += (v[j].x * v[j].x + v[j].y * v[j].y) + (v[j].z * v[j].z + v[j].w * v[j].w);
    const float rstd = 1.0f / sqrtf(wave_sum(s2) * (1.0f / D) + EPS);
#pragma unroll
    for (int j = 0; j < 4; ++j) { const int c = 4 * lane + 256 * j;
        const f32x4 gg = *(const f32x4*)(g + c), sh = *(const f32x4*)(shift + c), sc = *(const f32x4*)(scale + c);
        const f32x4 y = v[j] * rstd * gg * (sc + 1.0f) + sh;
        u32x2 o; o.x = pk2(y.x, y.y); o.y = pk2(y.z, y.w);
        *(u32x2*)(orow + c) = o; }
}

template <int NQ> __device__ __forceinline__ void p1_tokens(Frame& F, int t) {
    const float* mods = (const float*)(F.ws + WS_MODS);
    bf16* A = (bf16*)(F.ws + WS_BUFA);
    f32x4 v[NQ][4];
#pragma unroll
    for (int q = 0; q < NQ; ++q) { const int tq = t + q; const float* xr = tq < TL ? F.in[I_X] + (size_t)tq * D : F.in[I_CTX] + (size_t)(tq - TL) * D;
#pragma unroll
        for (int j = 0; j < 4; ++j) v[q][j] = __builtin_nontemporal_load((const f32x4*)(xr + 4 * F.lane + 256 * j)); }
    const float* m = mods + (size_t)mod_row(t) * 6144;
#pragma unroll
    for (int q = 0; q < NQ; ++q) norm_mod_store(v[q], F.in[I_NMG], m, m + 1024, A + (size_t)(t + q) * D, F.lane);
}
__device__ __forceinline__ void phase_mods(Frame& F) {
    const float* const* in = F.in;
    LAS float* S = (LAS float*)F.lds;
    LAS float* red = S + 9 * 1024;
    for (int i = F.tid; i < 9 * 1024; i += 512) { const float v = (i < 8192) ? in[I_C][i] : in[I_CCTX][i - 8192]; S[i] = v / (1.0f + expf(-v)); }
    __syncthreads();
    const int bx = blockIdx.x, layer = bx >> 7, col0 = (bx & 127) * 48;
    const int j = F.tid % 12, rg = F.tid / 12;
    if (rg < 42) {
        const float* W = in[I_ADAW] + (size_t)layer * 1024 * 6144 + col0 + 4 * j;
        f32x4 w[25];
#pragma unroll
        for (int i = 0; i < 25; ++i) { const int k = rg + 42 * i; w[i] = (k < 1024) ? __builtin_nontemporal_load((const f32x4*)(W + (size_t)k * 6144)) : (f32x4){0.f, 0.f, 0.f, 0.f}; }
        f32x4 acc[9];
#pragma unroll
        for (int r = 0; r < 9; ++r) acc[r] = (f32x4){0.f, 0.f, 0.f, 0.f};
#pragma unroll
        for (int i = 0; i < 25; ++i) { const int k = min(rg + 42 * i, 1023);
#pragma unroll
            for (int r = 0; r < 9; ++r) acc[r] += w[i] * S[r * 1024 + k]; }
#pragma unroll
        for (int r = 0; r < 9; ++r) *(LAS f32x4*)(red + (rg * 9 + r) * 48 + 4 * j) = acc[r];
    }
    __syncthreads();
    for (int i = F.tid; i < 432; i += 512) { const int r = i / 48, c = i % 48; float sum = in[I_ADAB][layer * 6144 + col0 + c];
        for (int g = 0; g < 42; ++g) sum += red[(g * 9 + r) * 48 + c];
        __hip_atomic_store((unsigned*)(F.ws + WS_MODS) + (layer * 9 + r) * 6144 + col0 + c, __builtin_bit_cast(unsigned, sum), __ATOMIC_RELAXED, __HIP_MEMORY_SCOPE_AGENT); }
    asm volatile("s_waitcnt vmcnt(0)" ::: "memory");
    __syncthreads();
    if (F.tid == 0) __hip_atomic_fetch_add((unsigned*)(F.ws + WS_MODSDONE), 1u, __ATOMIC_RELAXED, __HIP_MEMORY_SCOPE_AGENT);
}
__device__ __forceinline__ void mods_wait(Frame& F) {
    if (F.tid < 64) {
        unsigned* cnt = (unsigned*)(F.ws + WS_MODSDONE); unsigned spins = 0;
        while ((unsigned)__builtin_amdgcn_readfirstlane(__hip_atomic_load(cnt, __ATOMIC_RELAXED, __HIP_MEMORY_SCOPE_AGENT)) < (unsigned)F.G) {
            __builtin_amdgcn_s_sleep(2); if (++spins > (1u << 22)) break; }
        __builtin_amdgcn_fence(__ATOMIC_ACQUIRE, "agent");
        asm volatile("s_waitcnt vmcnt(0)" ::: "memory");
    }
    __syncthreads();
}

__device__ __forceinline__ void ctr_publish(Frame& F, size_t off, int slot, unsigned nx) {
    asm volatile("s_waitcnt vmcnt(0)" ::: "memory");
    __syncthreads();
    if (F.tid == 0) {
        unsigned* top = (unsigned*)(F.ws + off);
        if (nx == 0u) { __builtin_amdgcn_fence(__ATOMIC_RELEASE, "agent"); asm volatile("s_waitcnt vmcnt(0)" ::: "memory"); __hip_atomic_fetch_add(top, 1u, __ATOMIC_RELAXED, __HIP_MEMORY_SCOPE_AGENT); }
        else {
            unsigned* xw = (unsigned*)(F.ws + WS_XARR) + ((size_t)slot * 16 + xb_xcc_id()) * 64;
            const unsigned old = __hip_atomic_fetch_add(xw, 1u, __ATOMIC_RELAXED, __HIP_MEMORY_SCOPE_AGENT);
            if (old + 1u == nx) { __builtin_amdgcn_fence(__ATOMIC_RELEASE, "agent"); asm volatile("s_waitcnt vmcnt(0)" ::: "memory"); __hip_atomic_fetch_add(top, nx, __ATOMIC_RELAXED, __HIP_MEMORY_SCOPE_AGENT); }
        }
    }
}
__device__ __forceinline__ void ctr_wait(Frame& F, size_t off, unsigned need) {
    if (F.tid < 64) {
        unsigned* cnt = (unsigned*)(F.ws + off); unsigned spins = 0;
        while ((unsigned)__builtin_amdgcn_readfirstlane(__hip_atomic_load(cnt, __ATOMIC_RELAXED, __HIP_MEMORY_SCOPE_AGENT)) < need) {
            __builtin_amdgcn_s_sleep(2); if (++spins > (1u << 22)) break; }
        __builtin_amdgcn_fence(__ATOMIC_ACQUIRE, "agent");
        asm volatile("s_waitcnt vmcnt(0)" ::: "memory");
    }
    __syncthreads();
}

template <class P> __device__ __forceinline__ unsigned xcd_census(const Frame& F, P pred) {
    if (__builtin_amdgcn_readfirstlane(*(const LAS int*)(F.lds + LDS_CTL + 52)) == 0) return 0u;
    const unsigned myx = xb_xcc_id();
    unsigned c = 0;
#pragma unroll
    for (int k = 0; k < 4; ++k) { const int v = F.lane + 64 * k; const unsigned x = (unsigned)ld_coh((const int*)(F.ws + WS_XCDOF) + v);
        c += (unsigned)__builtin_popcountll(__builtin_amdgcn_ballot_w64(x == myx && pred(v))); }
    return c;
}

__device__ __forceinline__ void phase_prologue_a(Frame& F) {
    const float* const* in = F.in;
    unsigned char* ws = F.ws;
    LAS float* ldsf = (LAS float*)F.lds;
    phase_mods(F);
    __syncthreads();
    {
        const int gt = blockIdx.x * 512 + F.tid, NT = F.G * 512;
        float* rope = (float*)(ws + WS_ROPE);
        for (int i = gt; i < 1024; i += NT) { const int coord = i >> 4, q = i & 15; const float inv = powf(10000.0f, -(float)q / 16.0f); const float ang = (float)coord * inv;
            rope[i] = cosf(ang); rope[1024 + i] = sinf(ang); }
        bf16* WA = (bf16*)(ws + WS_WA);
        for (int i = gt; i < 128 * 128; i += NT) { const int m = i >> 7, k = i & 127, rp = m >> 6, j1 = m & 63, ri = k >> 6, n1 = k & 63;
            const float a = 2.0f * (float)((j1 * n1) & 63) / 64.0f; const float c = cospif(a), s = sinpif(a);
            const float v = (rp == 0) ? (ri == 0 ? c : s) : (ri == 0 ? -s : c); WA[i] = (bf16)f2bf(v); }
        bf16* WAC = (bf16*)(ws + WS_WAC);
        for (int i = gt; i < 32 * 32; i += NT) { const int m = i >> 5, k = i & 31, rp = m >> 4, j1 = m & 15, ri = k >> 4, n1 = k & 15;
            const float a = 2.0f * (float)((j1 * n1) & 15) / 16.0f; const float c = cospif(a), s = sinpif(a);
            const float v = (rp == 0) ? (ri == 0 ? c : s) : (ri == 0 ? -s : c); WAC[i] = (bf16)f2bf(v); }
        bf16* WC = (bf16*)(ws + WS_WC);
        for (int i = gt; i < 64 * 64 * 128; i += NT) { const int j1 = i >> 13, j2 = (i >> 7) & 63, k = i & 127, ri = k >> 6, n2 = k & 63;
            const float a = 2.0f * (float)((n2 * (j1 + 64 * j2)) & 4095) / 4096.0f; const float v = (ri == 0 ? cospif(a) : sinpif(a)) * (1.0f / 64.0f); WC[i] = (bf16)f2bf(v); }
        bf16* FD = (bf16*)(ws + WS_FD);
        for (int i = gt; i < 256 * 128; i += NT) { const int col = i >> 7, c = i & 127, ri = col >> 7, k2 = col & 127;
            const float a = 2.0f * (float)((c * k2) & 127) / 128.0f; const float v = (ri == 0 ? cospif(a) : -sinpif(a)) * 0.08838834764831845f; FD[i] = (bf16)f2bf(v); }
        bf16* WCC = (bf16*)(ws + WS_WCC);
        for (int i = gt; i < 16 * 16 * 32; i += NT) { const int j1 = i >> 9, j2 = (i >> 5) & 15, k = i & 31, ri = k >> 4, n2 = k & 15;
            const float a = 2.0f * (float)((n2 * (j1 + 16 * j2)) & 255) / 256.0f; const float v = (ri == 0 ? cospif(a) : sinpif(a)) * (1.0f / 16.0f); WCC[i] = (bf16)f2bf(v); }
    }
    LAS float* tw = (LAS float*)(F.lds + 139264);
    if (F.tid < 128) { const float a = 2.0f * (float)F.tid / 128.0f; tw[F.tid] = cospif(a); tw[128 + F.tid] = sinpif(a); }
    __syncthreads();
    LAS float* scr = (LAS float*)(F.lds + F.wave * 17408);
    const int gw = F.vcu * NWAVES + F.wave, NGW = F.G * NWAVES;
    const int fid = F.vcu * 2 + F.wave;
    if (F.wave < 2) { const int r = fid;
        const int g = r >> 7, db = (r >> 5) & 3, kb = r & 31, k0 = kb * 32, d0 = db * 32;
        const float* Wp = in[I_OWIN] + (size_t)k0 * 1280 + g * 128;
        { float tl[32][2];
#pragma unroll
          for (int rr = 0; rr < 32; ++rr) { tl[rr][0] = Wp[(size_t)rr * 1280 + F.lane]; tl[rr][1] = Wp[(size_t)rr * 1280 + 64 + F.lane]; }
#pragma unroll
          for (int rr = 0; rr < 32; ++rr) { scr[rr * 129 + F.lane] = tl[rr][0]; scr[rr * 129 + 64 + F.lane] = tl[rr][1]; } }
        LDS_WAIT(); asm volatile("" ::: "memory");
        const int k = F.lane & 31, oh = F.lane >> 5;
        const float* pw = in[I_OPOOLW] + (size_t)g * 16384 + d0 + 16 * oh;
        float acc[16];
#pragma unroll
        for (int t = 0; t < 16; ++t) acc[t] = 0.f;
        for (int c0 = 0; c0 < 128; c0 += 8) {
            f32x4 p[8][4];
#pragma unroll
            for (int cc = 0; cc < 8; ++cc)
#pragma unroll
                for (int j = 0; j < 4; ++j) p[cc][j] = *(const f32x4*)(pw + (c0 + cc) * 128 + 4 * j);
#pragma unroll
            for (int cc = 0; cc < 8; ++cc) { const float w = scr[k * 129 + c0 + cc];
#pragma unroll
                for (int j = 0; j < 4; ++j) { acc[4 * j] += w * p[cc][j].x; acc[4 * j + 1] += w * p[cc][j].y; acc[4 * j + 2] += w * p[cc][j].z; acc[4 * j + 3] += w * p[cc][j].w; } }
        }
        const float* psc = in[I_OPOOLS] + g * 128 + d0 + 16 * oh;
        bf16* dst = (bf16*)(ws + WS_W_OIN) + (size_t)(g * 128 + d0 + 16 * oh) * 1024 + k0 + k;
#pragma unroll
        for (int t = 0; t < 16; ++t) dst[(size_t)t * 1024] = (bf16)f2bf(acc[t] * psc[t]);
        LDS_WAIT(); asm volatile("" ::: "memory");
    }
    {
        LAS unsigned* ctr = (LAS unsigned*)(F.lds + LDS_CTL + 32);
        constexpr int TP1 = TS0 + TS1 + TS2 + TS3 + (12288 - 192 * L0T_N), PER = (TP1 + 255) / 256;
        const int base = F.vcu * PER, lim = max(0, min(PER, TP1 - base));
        f32x4 cur[8], nxt[8];
        int it = __builtin_amdgcn_readfirstlane(F.lane == 0 ? (int)atomicAdd((unsigned*)ctr, 1u) : 0);
        TItem tc = titem_decode(in, ws, base + (it < lim ? it : 0));
        if (it < lim) titem_load(tc, nxt, F.lane);
        while (it < lim) {
#pragma unroll
            for (int i = 0; i < 8; ++i) cur[i] = nxt[i];
            const TItem tcur = tc;
            const int itn = __builtin_amdgcn_readfirstlane(F.lane == 0 ? (int)atomicAdd((unsigned*)ctr, 1u) : 0);
            if (itn < lim) { tc = titem_decode(in, ws, base + itn); titem_load(tc, nxt, F.lane); }
            titem_process(tcur, cur, scr, F.lane);
            it = itn;
        }
    }
    mods_wait(F);
    {
        LAS unsigned* ctr2 = (LAS unsigned*)(F.lds + LDS_CTL + 36);
        for (;;) {
            const int it = __builtin_amdgcn_readfirstlane(F.lane == 0 ? (int)atomicAdd((unsigned*)ctr2, 1u) : 0);
            if (it >= 40) break;
            if (it < 32) p1_tokens<4>(F, 4 * (32 * (int)blockIdx.x + it)); else p1_tokens<1>(F, TL + 8 * (int)blockIdx.x + (it - 32));
        }
    }
}

struct DftP { const bf16* dbase; size_t dstride; const bf16* W; bf16* obase; size_t ostride; };
template <int MODE> __device__ __forceinline__ DftP dft_params(const Frame& F, int u) {
    const bf16* P = (const bf16*)(F.ws + WS_BUFP); bf16* Z = (bf16*)(F.ws + WS_BUFZ); bf16* MIX = (bf16*)(F.ws + WS_BUFA);
    DftP p;
    if constexpr (MODE == 0) { const int chunk = u & 3, n2 = (u >> 2) & 63, b = u >> 8;
        p.dbase = P + (size_t)(b * 4096 + n2) * EIN + chunk * 128; p.dstride = (size_t)64 * EIN; p.W = (const bf16*)(F.ws + WS_WA);
        p.obase = Z + (size_t)((b * 64) * 64 + n2) * 1024 + chunk * 128; p.ostride = (size_t)64 * 1024; }
    if constexpr (MODE == 1) { const int chunk = u & 3, n2 = (u >> 2) & 15, b = u >> 6;
        p.dbase = P + (size_t)(TL + b * 256 + n2) * EIN + chunk * 128; p.dstride = (size_t)16 * EIN; p.W = (const bf16*)(F.ws + WS_WAC);
        p.obase = Z + (size_t)(TL + (b * 16) * 16 + n2) * 1024 + chunk * 128; p.ostride = (size_t)16 * 1024; }
    if constexpr (MODE == 2) { const int chunk = u & 3, j1 = (u >> 2) & 63, b = u >> 8;
        p.dbase = Z + (size_t)((b * 64 + j1) * 64) * 1024 + chunk * 128; p.dstride = (size_t)1024; p.W = (const bf16*)(F.ws + WS_WC) + (size_t)j1 * 64 * 128;
        p.obase = MIX + (size_t)(b * 4096 + j1) * D + chunk * 128; p.ostride = (size_t)64 * D; }
    if constexpr (MODE == 3) { const int chunk = u & 3, j1 = (u >> 2) & 15, b = u >> 6;
        p.dbase = Z + (size_t)(TL + (b * 16 + j1) * 16) * 1024 + chunk * 128; p.dstride = (size_t)1024; p.W = (const bf16*)(F.ws + WS_WCC) + (size_t)j1 * 16 * 32;
        p.obase = MIX + (size_t)(TL + b * 256 + j1) * D + chunk * 128; p.ostride = (size_t)16 * D; }
    return p;
}
template <int MODE, int KD, int MD, int J>
__device__ __forceinline__ void dft_units(Frame& F, int nunits) {
    constexpr int LD = KD + 8;
    constexpr int NP = (KD * 16 + 511) / 512;
    constexpr int GM = KD / 8 - 1;
    LAS bf16* DT = (LAS bf16*)F.lds;
    u32x4 pre[NP];
    int u = F.vcu;
    if (u < nunits) { const DftP p = dft_params<MODE>(F, u);
#pragma unroll
        for (int i = 0; i < NP; ++i) { const int pc = F.tid + 512 * i; if (pc < KD * 16) { const int k = pc >> 4, c8 = pc & 15, ri = k / (KD / 2), nn = k % (KD / 2);
            pre[i] = __builtin_nontemporal_load((const u32x4*)(p.dbase + (size_t)nn * p.dstride + ri * 512 + c8 * 8)); } } }
    const int a = F.lane & 15, q = F.lane >> 4;
    for (; u < nunits; u += F.G) {
        const DftP p = dft_params<MODE>(F, u);
#pragma unroll
        for (int i = 0; i < NP; ++i) { const int pc = F.tid + 512 * i; if (pc < KD * 16) { const int k = pc >> 4, c8 = pc & 15; const u32x4 v = pre[i];
            LAS bf16* d = DT + (c8 * 8) * LD + (k ^ ((c8 & GM) << 3));
            d[0 * LD] = (bf16)(v.x & 0xffff); d[1 * LD] = (bf16)(v.x >> 16); d[2 * LD] = (bf16)(v.y & 0xffff); d[3 * LD] = (bf16)(v.y >> 16);
            d[4 * LD] = (bf16)(v.z & 0xffff); d[5 * LD] = (bf16)(v.z >> 16); d[6 * LD] = (bf16)(v.w & 0xffff); d[7 * LD] = (bf16)(v.w >> 16); } }
        __syncthreads();
        if (u + F.G < nunits) { const DftP pn = dft_params<MODE>(F, u + F.G);
#pragma unroll
            for (int i = 0; i < NP; ++i) { const int pc = F.tid + 512 * i; if (pc < KD * 16) { const int k = pc >> 4, c8 = pc & 15, ri = k / (KD / 2), nn = k % (KD / 2);
                pre[i] = __builtin_nontemporal_load((const u32x4*)(pn.dbase + (size_t)nn * pn.dstride + ri * 512 + c8 * 8)); } } }
        for (int task = F.wave; task < (MD / 16) * 2; task += NWAVES) {
            const int mt = task >> 1, cht = task & 1;
            f32x4 acc[4];
#pragma unroll
            for (int ct = 0; ct < 4; ++ct) acc[ct] = (f32x4){0.f, 0.f, 0.f, 0.f};
#pragma unroll
            for (int ks = 0; ks < KD / 32; ++ks) {
                const bf16x8 bw = *(const bf16x8*)(p.W + (size_t)(mt * 16 + a) * KD + ks * 32 + 8 * q);
#pragma unroll
                for (int ct = 0; ct < 4; ++ct) {
                    const int ch = cht * 64 + 16 * (a >> 2) + 4 * ct + (a & 3);
                    const bf16x8 av = *(const LAS bf16x8*)(DT + ch * LD + ((ks * 32 + 8 * q) ^ (((ch >> 3) & GM) << 3)));
                    acc[ct] = __builtin_amdgcn_mfma_f32_16x16x32_bf16(av, bw, acc[ct], 0, 0, 0);
                }
            }
            const int m = mt * 16 + a, rm = m / J, j = m % J;
            bf16* o = p.obase + (size_t)j * p.ostride + rm * 512 + cht * 64 + 16 * q;
            u32x4 w0, w1;
            w0.x = pk2(acc[0][0], acc[0][1]); w0.y = pk2(acc[0][2], acc[0][3]); w0.z = pk2(acc[1][0], acc[1][1]); w0.w = pk2(acc[1][2], acc[1][3]);
            w1.x = pk2(acc[2][0], acc[2][1]); w1.y = pk2(acc[2][2], acc[2][3]); w1.z = pk2(acc[3][0], acc[3][1]); w1.w = pk2(acc[3][2], acc[3][3]);
            *(u32x4*)o = w0; *(u32x4*)(o + 8) = w1;
        }
        __syncthreads();
    }
}

template <int MODE, int NR>
__device__ __forceinline__ void dft_units_a(Frame& F, int nunits) {
    constexpr int KD = 2 * NR, MD = 2 * NR, J = NR, LD = KD + 8, GM = KD / 8 - 1, ULD = 136;
    constexpr int NP = (NR * 16 + 511) / 512;
    LAS bf16* FDl = (LAS bf16*)F.lds; LAS bf16* U = (LAS bf16*)(F.lds + 69632); LAS bf16* DT = (LAS bf16*)(F.lds + 69632 + 64 * ULD * 2);
    { const bf16* FD = (const bf16*)(F.ws + WS_FD);
      for (int p = F.tid; p < 256 * 16; p += 512) { const int r = p >> 4, c8 = p & 15; *(LAS u32x4*)(FDl + r * ULD + 8 * c8) = *(const u32x4*)(FD + r * 128 + 8 * c8); } }
    u32x4 pre[NP];
    int u = F.vcu;
    if (u < nunits) { const DftP p = dft_params<MODE>(F, u);
#pragma unroll
        for (int i = 0; i < NP; ++i) { const int pc = F.tid + 512 * i; if (pc < NR * 16) pre[i] = __builtin_nontemporal_load((const u32x4*)(p.dbase + (size_t)(pc >> 4) * p.dstride + (pc & 15) * 8)); } }
    const int a = F.lane & 15, q = F.lane >> 4;
    for (; u < nunits; u += F.G) {
        const DftP p = dft_params<MODE>(F, u);
#pragma unroll
        for (int i = 0; i < NP; ++i) { const int pc = F.tid + 512 * i; if (pc < NR * 16) *(LAS u32x4*)(U + (pc >> 4) * ULD + (pc & 15) * 8) = pre[i]; }
        __syncthreads();
        if (u + F.G < nunits) { const DftP pn = dft_params<MODE>(F, u + F.G);
#pragma unroll
            for (int i = 0; i < NP; ++i) { const int pc = F.tid + 512 * i; if (pc < NR * 16) pre[i] = __builtin_nontemporal_load((const u32x4*)(pn.dbase + (size_t)(pc >> 4) * pn.dstride + (pc & 15) * 8)); } }
        {
            f32x4 acc[NR / 16][2];
#pragma unroll
            for (int mt = 0; mt < NR / 16; ++mt) { acc[mt][0] = (f32x4){0.f, 0.f, 0.f, 0.f}; acc[mt][1] = (f32x4){0.f, 0.f, 0.f, 0.f}; }
#pragma unroll
            for (int ks = 0; ks < 4; ++ks) {
                const bf16x8 b0 = *(const LAS bf16x8*)(FDl + ((2 * F.wave) * 16 + a) * ULD + ks * 32 + 8 * q), b1 = *(const LAS bf16x8*)(FDl + ((2 * F.wave + 1) * 16 + a) * ULD + ks * 32 + 8 * q);
#pragma unroll
                for (int mt = 0; mt < NR / 16; ++mt) { const bf16x8 av = *(const LAS bf16x8*)(U + (mt * 16 + a) * ULD + ks * 32 + 8 * q);
                    acc[mt][0] = __builtin_amdgcn_mfma_f32_16x16x32_bf16(av, b0, acc[mt][0], 0, 0, 0); acc[mt][1] = __builtin_amdgcn_mfma_f32_16x16x32_bf16(av, b1, acc[mt][1], 0, 0, 0); }
            }
#pragma unroll
            for (int t = 0; t < 2; ++t) { const int col = (2 * F.wave + t) * 16 + a, ri = col >> 7, k2 = col & 127;
#pragma unroll
                for (int mt = 0; mt < NR / 16; ++mt) { const int k0 = ri * NR + 16 * mt + 4 * q;
                    u32x2 w; w.x = pk2(acc[mt][t][0], acc[mt][t][1]); w.y = pk2(acc[mt][t][2], acc[mt][t][3]);
                    *(LAS u32x2*)(DT + k2 * LD + (k0 ^ (((k2 >> 3) & GM) << 3))) = w; } }
        }
        __syncthreads();
        for (int task = F.wave; task < (MD / 16) * 2; task += NWAVES) {
            const int mt = task >> 1, cht = task & 1;
            f32x4 acc[4];
#pragma unroll
            for (int ct = 0; ct < 4; ++ct) acc[ct] = (f32x4){0.f, 0.f, 0.f, 0.f};
#pragma unroll
            for (int ks = 0; ks < KD / 32; ++ks) {
                const bf16x8 bw = *(const bf16x8*)(p.W + (size_t)(mt * 16 + a) * KD + ks * 32 + 8 * q);
#pragma unroll
                for (int ct = 0; ct < 4; ++ct) {
                    const int ch = cht * 64 + 16 * (a >> 2) + 4 * ct + (a & 3);
                    const bf16x8 av = *(const LAS bf16x8*)(DT + ch * LD + ((ks * 32 + 8 * q) ^ (((ch >> 3) & GM) << 3)));
                    acc[ct] = __builtin_amdgcn_mfma_f32_16x16x32_bf16(av, bw, acc[ct], 0, 0, 0);
                }
            }
            const int m = mt * 16 + a, rm = m / J, j = m % J;
            bf16* o = p.obase + (size_t)j * p.ostride + rm * 512 + cht * 64 + 16 * q;
            u32x4 w0, w1;
            w0.x = pk2(acc[0][0], acc[0][1]); w0.y = pk2(acc[0][2], acc[0][3]); w0.z = pk2(acc[1][0], acc[1][1]); w0.w = pk2(acc[1][2], acc[1][3]);
            w1.x = pk2(acc[2][0], acc[2][1]); w1.y = pk2(acc[2][2], acc[2][3]); w1.z = pk2(acc[3][0], acc[3][1]); w1.w = pk2(acc[3][2], acc[3][3]);
            *(u32x4*)o = w0; *(u32x4*)(o + 8) = w1;
        }
        __syncthreads();
    }
}

__device__ __forceinline__ void phase_fourier_a_conv(Frame& F) {
    const bf16* P = (const bf16*)(F.ws + WS_BUFP);
    dft_units_a<0, 64>(F, 2048);
    __syncthreads();
    dft_units_a<1, 16>(F, 512);
    ctr_publish(F, WS_FAF, 0, xcd_census(F, [](int) { return true; }));
    bf16* MIX = (bf16*)(F.ws + WS_BUFA);
    const float* cw = F.in[I_ECONV];
    float w0[8], w1[8], w2[8];
#pragma unroll
    for (int i = 0; i < 8; ++i) { w0[i] = cw[8 * F.lane + i]; w1[i] = cw[512 + 8 * F.lane + i]; w2[i] = cw[1024 + 8 * F.lane + i]; }
    const int gw = F.vcu * NWAVES + F.wave, NGW = F.G * NWAVES;
    auto conv_tokens = [&](int t, auto ntc) {
        constexpr int NT = decltype(ntc)::value;
        int pos, len; if (t < TL) { pos = t & 4095; len = 4096; } else { pos = (t - TL) & 255; len = 256; }
        const bf16* row = P + (size_t)t * EIN + 8 * F.lane;
        u32x4 gb[NT], gc[NT + 2], uc[NT + 2];
#pragma unroll
        for (int d = 0; d < NT + 2; ++d) { const int pp = pos + d - 1;
            if (pp >= 0 && pp < len) { gc[d] = *(const u32x4*)(row + (ptrdiff_t)(d - 1) * EIN + 1024); uc[d] = *(const u32x4*)(row + (ptrdiff_t)(d - 1) * EIN + 1536); }
            else { gc[d] = (u32x4){0u, 0u, 0u, 0u}; uc[d] = (u32x4){0u, 0u, 0u, 0u}; } }
#pragma unroll
        for (int q = 0; q < NT; ++q) gb[q] = __builtin_nontemporal_load((const u32x4*)(row + (size_t)q * EIN + 512));
        float pl[NT + 2][8];
#pragma unroll
        for (int d = 0; d < NT + 2; ++d)
#pragma unroll
            for (int i = 0; i < 4; ++i) { pl[d][2 * i] = bflo(gc[d][i]) * bflo(uc[d][i]); pl[d][2 * i + 1] = bfhi(gc[d][i]) * bfhi(uc[d][i]); }
#pragma unroll
        for (int q = 0; q < NT; ++q) {
            float y[8];
#pragma unroll
            for (int i = 0; i < 4; ++i) {
                y[2 * i] = bflo(gb[q][i]) * (w0[2 * i] * pl[q][2 * i] + w1[2 * i] * pl[q + 1][2 * i] + w2[2 * i] * pl[q + 2][2 * i]);
                y[2 * i + 1] = bfhi(gb[q][i]) * (w0[2 * i + 1] * pl[q][2 * i + 1] + w1[2 * i + 1] * pl[q + 1][2 * i + 1] + w2[2 * i + 1] * pl[q + 2][2 * i + 1]);
            }
            u32x4 o; o.x = pk2(y[0], y[1]); o.y = pk2(y[2], y[3]); o.z = pk2(y[4], y[5]); o.w = pk2(y[6], y[7]);
            *(u32x4*)(MIX + (size_t)(t + q) * D + 512 + 8 * F.lane) = o;
        }
    };
    for (int t = 4 * gw; t < TL; t += 4 * NGW) conv_tokens(t, std::integral_constant<int, 4>{});
    for (int t = TL + gw; t < T; t += NGW) conv_tokens(t, std::integral_constant<int, 1>{});
}

__device__ __forceinline__ void phase_fourier_c(Frame& F) {
    ctr_wait(F, WS_FAF, (unsigned)F.G);
    dft_units<2, 128, 64, 64>(F, 2048);
    dft_units<3, 32, 16, 16>(F, 512);
}

constexpr int RW_LD = 1032;
template <bool SPLIT>
__device__ __forceinline__ void phase_route(Frame& F, int layer, int ntok) {
    LAS bf16* rwh = (LAS bf16*)F.lds;
    LAS bf16* rwl = (LAS bf16*)(F.lds + 33024);
    LAS unsigned* cnt = (LAS unsigned*)(F.lds + 66048);
    LAS int* gb = (LAS int*)(F.lds + 66048 + 128);
    LAS float* lgs = (LAS float*)(F.lds + 66048 + 256) + F.wave * 256;
    LAS int* tinfo = (LAS int*)(F.lds + 66048 + 256 + 8192);
    LAS float* GS = (LAS float*)(F.lds + 81920);
    LAS float* SH = GS + 2048;
    const float* RW = F.in[I_RW];
    int tA, nA, tB, nB;
    if constexpr (SPLIT) {
        const int xs = F.vcu >> 5, rs = F.vcu & 31;
        if (rs >= 28) return;
        const int j = 28 * xs + rs;
        tA = 128 * j; nA = 128; tB = 28672 + 32 * j; nB = (j < 192) ? 32 : 0;
    } else { const int per_ = ntok / F.G; tA = blockIdx.x * per_; nA = per_; tB = 0; nB = 0; }
    const int r0 = mod_row(tA), mr1 = SPLIT ? mod_row(tB) : min(r0 + 1, 8);
    const float* mods = (const float*)(F.ws + WS_MODS) + (size_t)layer * 9 * 6144;
    const float* g = F.in[I_NFG] + layer * 1024;
    for (int i = F.tid; i < 16384; i += 512) { const int k = i >> 4, e = i & 15; const float w = RW[i]; const unsigned hi = f2bf(w); const float wl = w - __builtin_bit_cast(float, hi << 16);
        rwh[e * RW_LD + k] = (bf16)hi; rwl[e * RW_LD + k] = (bf16)f2bf(wl); }
    for (int i = F.tid; i < 2048; i += 512) { const int sl = i >> 10, c = i & 1023; const int rr = sl ? mr1 : r0; const float* m = mods + (size_t)rr * 6144;
        GS[i] = g[c] * (m[4 * 1024 + c] + 1.0f); SH[i] = m[3 * 1024 + c]; }
    if (F.tid < 16) cnt[F.tid] = 0u;
    __syncthreads();
    bf16* FB = (bf16*)(F.ws + WS_BUFA);
    const bool f8 = layer ? (FP8_G1_L1 != 0) : (FP8_G1_L0 != 0);
    int* route = (int*)(F.ws + WS_ROUTE);
    const int tk = F.lane & 15, kg = F.lane >> 4;
    for (int st = 0; st < 2; ++st) {
    const int t0 = st ? tB : tA, per = st ? nB : nA, li0 = st ? nA : 0;
    if (per == 0) break;
    if constexpr (SPLIT) { if (st == 0) ctr_wait(F, WS_P5F, 224u); else ctr_wait(F, WS_P5C, 32u); }
    for (int g0 = 16 * F.wave; g0 < per; g0 += 16 * NWAVES) {
        const int nv = min(16, per - g0);
        const int tq = t0 + g0 + (tk < nv ? tk : 0);
        const bf16* hr = h_row(F, tq) + 8 * kg;
        float s2 = 0.f;
        {
            u32x4 raw[32];
#pragma unroll
            for (int ks = 0; ks < 32; ++ks) raw[ks] = *(const u32x4*)(hr + 32 * ks);
#pragma unroll
            for (int ks = 0; ks < 32; ++ks)
#pragma unroll
                for (int i = 0; i < 4; ++i) { const float a = bflo(raw[ks][i]), b2 = bfhi(raw[ks][i]); s2 += a * a + b2 * b2; }
        }
        s2 += __shfl_xor(s2, 16); s2 += __shfl_xor(s2, 32);
        const float rstd = 1.0f / sqrtf(s2 * (1.0f / D) + EPS);
        const int sl = (mod_row(tq) != r0) ? 1024 : 0;
        const LAS float* gsp = GS + sl + 8 * kg; const LAS float* shp = SH + sl + 8 * kg;
        unsigned char* fb8 = (unsigned char*)FB + (size_t)tq * D + 8 * kg;
        bf16* fb16 = FB + (size_t)tq * D + 8 * kg;
        f32x4 acc = (f32x4){0.f, 0.f, 0.f, 0.f};
        u32x4 nx[8];
#pragma unroll
        for (int j = 0; j < 8; ++j) nx[j] = *(const u32x4*)(hr + 32 * j);
#pragma unroll 1
        for (int k4 = 0; k4 < 4; ++k4) {
            u32x4 cu[8];
#pragma unroll
            for (int j = 0; j < 8; ++j) cu[j] = nx[j];
            if (k4 < 3) {
#pragma unroll
                for (int j = 0; j < 8; ++j) nx[j] = *(const u32x4*)(hr + 32 * (8 * k4 + 8 + j)); }
#pragma unroll
            for (int j = 0; j < 8; ++j) {
                const int ks = 8 * k4 + j;
                const f32x4 g0v = *(const LAS f32x4*)(gsp + 32 * ks), g1v = *(const LAS f32x4*)(gsp + 32 * ks + 4), s0v = *(const LAS f32x4*)(shp + 32 * ks), s1v = *(const LAS f32x4*)(shp + 32 * ks + 4);
                float f[8];
                f[0] = bflo(cu[j].x) * rstd * g0v.x + s0v.x; f[1] = bfhi(cu[j].x) * rstd * g0v.y + s0v.y; f[2] = bflo(cu[j].y) * rstd * g0v.z + s0v.z; f[3] = bfhi(cu[j].y) * rstd * g0v.w + s0v.w;
                f[4] = bflo(cu[j].z) * rstd * g1v.x + s1v.x; f[5] = bfhi(cu[j].z) * rstd * g1v.y + s1v.y; f[6] = bflo(cu[j].w) * rstd * g1v.z + s1v.z; f[7] = bfhi(cu[j].w) * rstd * g1v.w + s1v.w;
                u32x4 hi, lo;
#pragma unroll
                for (int i = 0; i < 4; ++i) { const unsigned h0 = f2bf(f[2 * i]), h1 = f2bf(f[2 * i + 1]); hi[i] = h0 | (h1 << 16);
                    lo[i] = pk2(f[2 * i] - __builtin_bit_cast(float, h0 << 16), f[2 * i + 1] - __builtin_bit_cast(float, h1 << 16)); }
                if (tk < nv) {
                    if (f8) { u32x2 o; o.x = pg8::pk4_fp8(f[0], f[1], f[2], f[3]); o.y = pg8::pk4_fp8(f[4], f[5], f[6], f[7]); *(u32x2*)(fb8 + 32 * ks) = o; }
                    else *(u32x4*)(fb16 + 32 * ks) = hi;
                }
                const bf16x8 bh = *(const LAS bf16x8*)(rwh + tk * RW_LD + 32 * ks + 8 * kg), bl = *(const LAS bf16x8*)(rwl + tk * RW_LD + 32 * ks + 8 * kg);
                const bf16x8 ah = __builtin_bit_cast(bf16x8, hi), al = __builtin_bit_cast(bf16x8, lo);
                acc = __builtin_amdgcn_mfma_f32_16x16x32_bf16(ah, bh, acc, 0, 0, 0);
                acc = __builtin_amdgcn_mfma_f32_16x16x32_bf16(ah, bl, acc, 0, 0, 0);
                acc = __builtin_amdgcn_mfma_f32_16x16x32_bf16(al, bh, acc, 0, 0, 0);
            }
        }
#pragma unroll
        for (int j = 0; j < 4; ++j) lgs[(4 * kg + j) * 16 + tk] = acc[j];
        LDS_WAIT(); asm volatile("" ::: "memory");
        if (F.lane < nv) {
            const int tqq = t0 + g0 + F.lane;
            float aff[16], sel[16];
#pragma unroll
            for (int e4 = 0; e4 < 4; ++e4) { const f32x4 l4 = *(const LAS f32x4*)(lgs + F.lane * 16 + 4 * e4); const f32x4 b4 = *(const f32x4*)(F.in[I_RB] + 4 * e4);
                aff[4 * e4] = 1.0f / (1.0f + expf(-l4.x)); aff[4 * e4 + 1] = 1.0f / (1.0f + expf(-l4.y)); aff[4 * e4 + 2] = 1.0f / (1.0f + expf(-l4.z)); aff[4 * e4 + 3] = 1.0f / (1.0f + expf(-l4.w));
                sel[4 * e4] = aff[4 * e4] + b4.x; sel[4 * e4 + 1] = aff[4 * e4 + 1] + b4.y; sel[4 * e4 + 2] = aff[4 * e4 + 2] + b4.z; sel[4 * e4 + 3] = aff[4 * e4 + 3] + b4.w; }
            int best = 0; float bs = -1e30f;
#pragma unroll
            for (int gq = 0; gq < 4; ++gq) { const float a = sel[4 * gq], b = sel[4 * gq + 1], c = sel[4 * gq + 2], d = sel[4 * gq + 3];
                const float s = fmaxf(fmaxf(fmaxf(a + b, a + c), fmaxf(a + d, b + c)), fmaxf(b + d, c + d));
                if (s > bs) { bs = s; best = gq; } }
            float sv[4], av[4];
#pragma unroll
            for (int i = 0; i < 4; ++i) { sv[i] = sel[i]; av[i] = aff[i]; }
#pragma unroll
            for (int gq = 1; gq < 4; ++gq) if (best == gq) {
#pragma unroll
                for (int i = 0; i < 4; ++i) { sv[i] = sel[4 * gq + i]; av[i] = aff[4 * gq + i]; } }
            int i1 = 0; float s1 = sv[0], a1 = av[0];
#pragma unroll
            for (int i = 1; i < 4; ++i) if (sv[i] > s1) { s1 = sv[i]; a1 = av[i]; i1 = i; }
            int i2 = -1; float s2v = -1e30f, a2 = 0.f;
#pragma unroll
            for (int i = 0; i < 4; ++i) if (i != i1 && sv[i] > s2v) { s2v = sv[i]; a2 = av[i]; i2 = i; }
            const int e1 = 4 * best + i1, e2 = 4 * best + i2;
            const float wsum = a1 + a2, w1 = a1 / wsum, w2 = a2 / wsum;
            const unsigned r1 = atomicAdd((unsigned*)(cnt + e1), 1u), r2 = atomicAdd((unsigned*)(cnt + e2), 1u);
            int* ro = route + (size_t)tqq * 8;
            ro[0] = e1; ro[1] = e2; ro[4] = __builtin_bit_cast(int, w1); ro[5] = __builtin_bit_cast(int, w2);
            const int li = li0 + g0 + F.lane;
            tinfo[4 * li + 0] = e1; tinfo[4 * li + 1] = e2; tinfo[4 * li + 2] = (int)r1; tinfo[4 * li + 3] = (int)r2;
        }
        LDS_WAIT(); asm volatile("" ::: "memory");
    }
    }
    __syncthreads();
    if (F.tid < 16) gb[F.tid] = (int)__hip_atomic_fetch_add((unsigned*)(F.ws + WS_GCNT) + layer * 16 + F.tid, cnt[F.tid], __ATOMIC_RELAXED, __HIP_MEMORY_SCOPE_AGENT);
    __syncthreads();
    int* tokmap = (int*)(F.ws + WS_TOKMAP);
    for (int i = F.tid; i < nA + nB; i += 512) {
        const int tok = (i < nA) ? tA + i : tB + (i - nA);
        const int e1 = tinfo[4 * i], e2 = tinfo[4 * i + 1], p1 = gb[e1] + tinfo[4 * i + 2], p2 = gb[e2] + tinfo[4 * i + 3];
        tokmap[(size_t)e1 * T + p1] = tok; tokmap[(size_t)e2 * T + p2] = tok;
        int* ro = route + (size_t)tok * 8; ro[2] = p1; ro[3] = p2;
    }
}

__device__ __forceinline__ int moe_tables(Frame& F, int layer) {
    LAS int* tb = (LAS int*)(F.lds + LDS_CTL + 64); LAS int* cn = (LAS int*)(F.lds + LDS_CTL + 192);
    __syncthreads();
    if (F.tid < 16) cn[F.tid] = ld_coh((const int*)(F.ws + WS_GCNT) + layer * 16 + F.tid);
    __syncthreads();
    if (F.tid == 0) { int b = 0; for (int e = 0; e < 16; ++e) { tb[e] = b; b += (cn[e] + 255) >> 8; } tb[16] = b; }
    __syncthreads();
    return __builtin_amdgcn_readfirstlane(tb[16]);
}

template <int NQ> __device__ __forceinline__ void combine_tokens(Frame& F, int layer, int t) {
    const float* mods = (const float*)(F.ws + WS_MODS);
    const bf16* OS = (const bf16*)(F.ws + WS_BUFP);
    const int* route = (const int*)(F.ws + WS_ROUTE);
    const LAS int* tb = (const LAS int*)(F.lds + LDS_CTL + 64);
    bf16* A = (bf16*)(F.ws + WS_BUFA);
    {
        int rc[NQ][4]; float w0[NQ], w1[NQ];
#pragma unroll
        for (int q = 0; q < NQ; ++q) { const int* ro = route + (size_t)(t + q) * 8;
#pragma unroll
            for (int i = 0; i < 4; ++i) rc[q][i] = ld_coh(ro + i);
            w0[q] = ld_cohf((const float*)(ro + 4)); w1[q] = ld_cohf((const float*)(ro + 5)); }
        f32x4 v[NQ][4]; u32x2 oa[NQ][4], ob[NQ][4];
#pragma unroll
        for (int q = 0; q < NQ; ++q) { const bf16* hr = h_row(F, t + q);
            const size_t s0 = (size_t)(tb[rc[q][0]] * 256 + rc[q][2]) * D, s1 = (size_t)(tb[rc[q][1]] * 256 + rc[q][3]) * D;
#pragma unroll
            for (int j = 0; j < 4; ++j) { const int c = 4 * F.lane + 256 * j; { const u32x2 hv = *(const u32x2*)(hr + c); v[q][j] = (f32x4){bflo(hv.x), bfhi(hv.x), bflo(hv.y), bfhi(hv.y)}; } oa[q][j] = __builtin_nontemporal_load((const u32x2*)(OS + s0 + c)); ob[q][j] = __builtin_nontemporal_load((const u32x2*)(OS + s1 + c)); } }
        const int mr = mod_row(t);
        const float* m5 = mods + (size_t)(layer * 9 + mr) * 6144 + 5 * 1024;
#pragma unroll
        for (int j = 0; j < 4; ++j) { const f32x4 g5 = *(const f32x4*)(m5 + 4 * F.lane + 256 * j);
#pragma unroll
            for (int q = 0; q < NQ; ++q) { const u32x2 a = oa[q][j], b2 = ob[q][j];
                const f32x4 o = (f32x4){w0[q] * bflo(a.x) + w1[q] * bflo(b2.x), w0[q] * bfhi(a.x) + w1[q] * bfhi(b2.x), w0[q] * bflo(a.y) + w1[q] * bflo(b2.y), w0[q] * bfhi(a.y) + w1[q] * bfhi(b2.y)};
                v[q][j] = v[q][j] + g5 * o; } }
#pragma unroll
        for (int q = 0; q < NQ; ++q) {
            if (layer == 0) {
                bf16* hr = h_row(F, t + q);
#pragma unroll
                for (int j = 0; j < 4; ++j) { u32x2 o; o.x = pk2(v[q][j].x, v[q][j].y); o.y = pk2(v[q][j].z, v[q][j].w); *(u32x2*)(hr + 4 * F.lane + 256 * j) = o; }
                const float* m = mods + (size_t)(9 + mr) * 6144;
                norm_mod_store(v[q], F.in[I_NMG] + 1024, m, m + 1024, A + (size_t)(t + q) * D, F.lane);
            } else {
                float s2 = 0.f;
#pragma unroll
                for (int j = 0; j < 4; ++j) s2 += (v[q][j].x * v[q][j].x + v[q][j].y * v[q][j].y) + (v[q][j].z * v[q][j].z + v[q][j].w * v[q][j].w);
                const float rstd = 1.0f / sqrtf(wave_sum(s2) * (1.0f / D) + EPS);
                float* orow = F.out + (size_t)(t + q) * D;
#pragma unroll
                for (int j = 0; j < 4; ++j) { const int c = 4 * F.lane + 256 * j; __builtin_nontemporal_store(v[q][j] * rstd * *(const f32x4*)(F.in[I_FG] + c), (f32x4*)(orow + c)); }
            }
        }
    }
}
__device__ __forceinline__ void phase_combine(Frame& F, int layer, int ntok) {
    const int gw = F.vcu * NWAVES + F.wave, NGW = F.G * NWAVES;
    if (layer == 0) { for (int t = 2 * gw; t < TL; t += 2 * NGW) combine_tokens<2>(F, 0, t); for (int t = TL + gw; t < ntok; t += NGW) combine_tokens<1>(F, 0, t); }
    else { for (int t = 4 * gw; t < TL; t += 4 * NGW) combine_tokens<4>(F, 1, t); }
}

constexpr int KV_LD = 72, VL_OFF = 384 * KV_LD * 2, ROPE_LDS = 131072;
typedef short v4i16_t __attribute__((ext_vector_type(4)));

__device__ __forceinline__ bf16x8 rope_pack(const u32x4 x1, const u32x4 x2, const LAS float* cs, const LAS float* sn, float scale, bool second) {
    const f32x4 c0 = *(const LAS f32x4*)cs, c1 = *(const LAS f32x4*)(cs + 4), s0 = *(const LAS f32x4*)sn, s1 = *(const LAS f32x4*)(sn + 4);
    float c[8] = {c0.x, c0.y, c0.z, c0.w, c1.x, c1.y, c1.z, c1.w}, s[8] = {s0.x, s0.y, s0.z, s0.w, s1.x, s1.y, s1.z, s1.w};
    float a[8], b[8];
#pragma unroll
    for (int i = 0; i < 4; ++i) { a[2 * i] = bflo(x1[i]); a[2 * i + 1] = bfhi(x1[i]); b[2 * i] = bflo(x2[i]); b[2 * i + 1] = bfhi(x2[i]); }
    float o[8];
#pragma unroll
    for (int i = 0; i < 8; ++i) o[i] = (second ? (b[i] * c[i] + a[i] * s[i]) : (a[i] * c[i] - b[i] * s[i])) * scale;
    u32x4 w; w.x = pk2(o[0], o[1]); w.y = pk2(o[2], o[3]); w.z = pk2(o[4], o[5]); w.w = pk2(o[6], o[7]);
    return __builtin_bit_cast(bf16x8, w);
}

struct AttnU { int b, qb, kvh; };
__device__ __forceinline__ AttnU attn_unit_of(int u) { AttnU r; r.kvh = u & 1; r.qb = (u >> 1) & 31; r.b = u >> 6; return r; }

__device__ __forceinline__ void attn_load_latk(Frame& F, const bf16* P1, AttnU u, u32x4 (&lk)[2][4]) {
    const u32x4 z = (u32x4){0u, 0u, 0u, 0u};
#pragma unroll
    for (int it = 0; it < 2; ++it) { const int task = F.tid + 512 * it, kidx = task >> 1, hh = task & 1, pos = u.qb * 128 - 128 + kidx;
        const bool ok = task < 768 && pos >= 0 && pos < NSEQ;
        const bf16* row = P1 + (size_t)(u.b * NSEQ + (ok ? pos : 0)) * OIN + 1024 + u.kvh * 64 + 8 * hh;
#pragma unroll
        for (int st = 0; st < 4; ++st) lk[it][st] = ok ? *(const u32x4*)(row + 16 * st) : z; }
}
__device__ __forceinline__ void attn_load_latv(Frame& F, const bf16* P1, AttnU u, u32x4 (&lv)[6]) {
    const u32x4 z = (u32x4){0u, 0u, 0u, 0u};
#pragma unroll
    for (int it = 0; it < 6; ++it) { const int task = F.tid + 512 * it, kidx = task >> 3, c8 = task & 7, pos = u.qb * 128 - 128 + kidx;
        const bool ok = pos >= 0 && pos < NSEQ;
        lv[it] = ok ? *(const u32x4*)(P1 + (size_t)(u.b * NSEQ + (ok ? pos : 0)) * OIN + 1152 + u.kvh * 64 + 8 * c8) : z; }
}
__device__ __forceinline__ void attn_write_lat(Frame& F, AttnU u, const u32x4 (&lk)[2][4], const u32x4 (&lv)[6]) {
    LAS bf16* KL = (LAS bf16*)F.lds; LAS bf16* VL = (LAS bf16*)(F.lds + VL_OFF); const LAS float* rope = (const LAS float*)(F.lds + ROPE_LDS);
#pragma unroll
    for (int it = 0; it < 2; ++it) { const int task = F.tid + 512 * it, kidx = task >> 1, hh = task & 1; int pos = u.qb * 128 - 128 + kidx; pos = pos < 0 ? 0 : (pos > NSEQ - 1 ? NSEQ - 1 : pos);
        if (task < 768) {
            LAS bf16* d = KL + kidx * KV_LD + 8 * hh;
            const LAS float* c0 = rope + (pos >> 6) * 16 + 8 * hh; const LAS float* c1 = rope + (pos & 63) * 16 + 8 * hh;
            *(LAS bf16x8*)(d) = rope_pack(lk[it][0], lk[it][1], c0, c0 + 1024, 1.0f, false);
            *(LAS bf16x8*)(d + 16) = rope_pack(lk[it][0], lk[it][1], c0, c0 + 1024, 1.0f, true);
            *(LAS bf16x8*)(d + 32) = rope_pack(lk[it][2], lk[it][3], c1, c1 + 1024, 1.0f, false);
            *(LAS bf16x8*)(d + 48) = rope_pack(lk[it][2], lk[it][3], c1, c1 + 1024, 1.0f, true);
        } }
#pragma unroll
    for (int it = 0; it < 6; ++it) { const int task = F.tid + 512 * it, kidx = task >> 3, c8 = task & 7; *(LAS u32x4*)(VL + kidx * KV_LD + 8 * c8) = lv[it]; }
}
__device__ __forceinline__ void attn_load_ctx(Frame& F, const bf16* P1, AttnU u, u32x4 (&ck)[4], u32x4 (&cv)[4]) {
#pragma unroll
    for (int it = 0; it < 4; ++it) { const int task = F.tid + 512 * it, kidx = task >> 3, c8 = task & 7;
        const bf16* row = P1 + (size_t)(TL + u.b * LCTX + kidx) * OIN + 1024 + u.kvh * 64 + 8 * c8;
        ck[it] = *(const u32x4*)row; cv[it] = *(const u32x4*)(row + 128); }
}
__device__ __forceinline__ void attn_write_ctx(Frame& F, const u32x4 (&ck)[4], const u32x4 (&cv)[4]) {
    LAS bf16* KL = (LAS bf16*)F.lds; LAS bf16* VL = (LAS bf16*)(F.lds + VL_OFF);
#pragma unroll
    for (int it = 0; it < 4; ++it) { const int task = F.tid + 512 * it, kidx = task >> 3, c8 = task & 7;
        *(LAS u32x4*)(KL + kidx * KV_LD + 8 * c8) = ck[it]; *(LAS u32x4*)(VL + kidx * KV_LD + 8 * c8) = cv[it]; }
}

__device__ __forceinline__ unsigned cvtpk(float lo, float hi) { unsigned r; asm volatile("v_cvt_pk_bf16_f32 %0, %1, %2" : "=v"(r) : "v"(lo), "v"(hi)); return r; }
__device__ __forceinline__ float xhalf_max(float x) { const auto r = __builtin_amdgcn_permlane32_swap(__builtin_bit_cast(unsigned, x), __builtin_bit_cast(unsigned, x), false, false);
    return fmaxf(__builtin_bit_cast(float, r[0]), __builtin_bit_cast(float, r[1])); }
__device__ __forceinline__ float xhalf_sum(float x) { const auto r = __builtin_amdgcn_permlane32_swap(__builtin_bit_cast(unsigned, x), __builtin_bit_cast(unsigned, x), false, false);
    return __builtin_bit_cast(float, r[0]) + __builtin_bit_cast(float, r[1]); }
__device__ __forceinline__ void attn_tiles(Frame& F, int kt0, int kt1, int mk0, int mk1, const bf16x8 (&qf)[4], f32x16 (&O)[2], float& mrun, float& lrun, int qrel) {
    if (kt0 > kt1) return;
    const LAS bf16* KL = (const LAS bf16*)F.lds; const LAS bf16* VL = (const LAS bf16*)(F.lds + VL_OFF);
    const int r32 = F.lane & 31, hh = F.lane >> 5;
    const int q4 = (F.lane & 15) >> 2, p4 = F.lane & 3, blk = (F.lane >> 4) & 1;
    const LAS bf16* kp = KL + (kt0 * 32 + r32) * KV_LD + 8 * hh;
    const LAS bf16* vp = VL + (kt0 * 32 + 4 * hh + q4) * KV_LD + 16 * blk + 4 * p4;
    bf16x8 kn[4];
#pragma unroll
    for (int st = 0; st < 4; ++st) kn[st] = *(const LAS bf16x8*)(kp + 16 * st);
    for (int kt = kt0; kt <= kt1; ++kt) {
        bf16x8 kf[4];
#pragma unroll
        for (int st = 0; st < 4; ++st) kf[st] = kn[st];
        v4i16_t vlo[2][2], vhi[2][2];
#pragma unroll
        for (int dt = 0; dt < 2; ++dt)
#pragma unroll
            for (int s2 = 0; s2 < 2; ++s2) { vlo[dt][s2] = __builtin_amdgcn_ds_read_tr16_b64_v4i16((LAS v4i16_t*)(vp + (16 * s2) * KV_LD + dt * 32));
                vhi[dt][s2] = __builtin_amdgcn_ds_read_tr16_b64_v4i16((LAS v4i16_t*)(vp + (16 * s2 + 8) * KV_LD + dt * 32)); }
        kp += 32 * KV_LD; vp += 32 * KV_LD;
        if (kt < kt1) {
#pragma unroll
            for (int st = 0; st < 4; ++st) kn[st] = *(const LAS bf16x8*)(kp + 16 * st); }
        __builtin_amdgcn_sched_barrier(0);
        f32x16 s;
#pragma unroll
        for (int r = 0; r < 16; ++r) s[r] = 0.f;
#pragma unroll
        for (int st = 0; st < 4; ++st) s = __builtin_amdgcn_mfma_f32_32x32x16_bf16(kf[st], qf[st], s, 0, 0, 0);
        if (kt == mk0 || kt == mk1) {
#pragma unroll
            for (int r = 0; r < 16; ++r) { const int dlt = kt * 32 + (r & 3) + 8 * (r >> 2) + 4 * hh - qrel; s[r] = (dlt <= 128 && dlt >= -128) ? s[r] : -INFINITY; } }
        float mx = fmaxf(fmaxf(s[0], s[1]), fmaxf(s[2], s[3]));
#pragma unroll
        for (int r = 4; r < 16; r += 4) mx = fmaxf(mx, fmaxf(fmaxf(s[r], s[r + 1]), fmaxf(s[r + 2], s[r + 3])));
        mx = xhalf_max(mx);
        const float mnew = fmaxf(mrun, mx);
        float ps0 = 0.f, ps1 = 0.f;
#pragma unroll
        for (int r = 0; r < 16; r += 2) { s[r] = __builtin_amdgcn_exp2f(s[r] - mnew); s[r + 1] = __builtin_amdgcn_exp2f(s[r + 1] - mnew); ps0 += s[r]; ps1 += s[r + 1]; }
        const float ps = xhalf_sum(ps0 + ps1);
        if (__any(mnew > mrun)) {
            const float alpha = __builtin_amdgcn_exp2f(mrun - mnew);
            lrun *= alpha;
#pragma unroll
            for (int dt = 0; dt < 2; ++dt)
#pragma unroll
                for (int r = 0; r < 16; ++r) O[dt][r] *= alpha;
        }
        lrun += ps; mrun = mnew;
        bf16x8 pb[2];
#pragma unroll
        for (int s2 = 0; s2 < 2; ++s2) { u32x4 w; w.x = cvtpk(s[8 * s2 + 0], s[8 * s2 + 1]); w.y = cvtpk(s[8 * s2 + 2], s[8 * s2 + 3]); w.z = cvtpk(s[8 * s2 + 4], s[8 * s2 + 5]); w.w = cvtpk(s[8 * s2 + 6], s[8 * s2 + 7]);
            pb[s2] = __builtin_bit_cast(bf16x8, w); }
#pragma unroll
        for (int dt = 0; dt < 2; ++dt)
#pragma unroll
            for (int s2 = 0; s2 < 2; ++s2) {
                const bf16x8 va = (bf16x8){vlo[dt][s2][0], vlo[dt][s2][1], vlo[dt][s2][2], vlo[dt][s2][3], vhi[dt][s2][0], vhi[dt][s2][1], vhi[dt][s2][2], vhi[dt][s2][3]};
                O[dt] = __builtin_amdgcn_mfma_f32_32x32x16_bf16(va, pb[s2], O[dt], 0, 0, 0);
            }
    }
}

__device__ __forceinline__ void phase_attn(Frame& F) {
    const bf16* P1 = (const bf16*)(F.ws + WS_BUFP);
    bf16* MIX = (bf16*)(F.ws + WS_BUFA);
    const int r32 = F.lane & 31, hh = F.lane >> 5;
    constexpr float QSC = 0.125f * 1.4426950408889634f;
    LAS float* ropel = (LAS float*)(F.lds + ROPE_LDS);
    for (int i = F.tid; i < 2048; i += 512) ropel[i] = ((const float*)(F.ws + WS_ROPE))[i];
    u32x4 lk[2][4], lv[6], ck[4], cv[4];
    const int nu = (512 - F.vcu + F.G - 1) / F.G;
    if (nu > 0) attn_load_latk(F, P1, attn_unit_of(F.vcu), lk);
    for (int ui = 0; ui < nu; ++ui) {
        const AttnU u = attn_unit_of(F.vcu + ui * F.G);
        u32x4 qr[2][4];
#pragma unroll
        for (int i = 0; i < 2; ++i) { const int task = F.wave + 8 * i, g = task & 3, sub = task >> 2, head = u.kvh * 4 + g, pos = u.qb * 128 + 32 * sub + r32;
            const bf16* row = P1 + (size_t)(u.b * NSEQ + pos) * OIN + 512 + head * 64 + 8 * hh;
#pragma unroll
            for (int st = 0; st < 4; ++st) qr[i][st] = __builtin_nontemporal_load((const u32x4*)(row + 16 * st)); }
        attn_load_latv(F, P1, u, lv);
        __syncthreads();
        attn_write_lat(F, u, lk, lv);
        bf16x8 qf[2][4]; f32x16 O[2][2]; float mrun[2], lrun[2];
#pragma unroll
        for (int i = 0; i < 2; ++i) { const int task = F.wave + 8 * i, g = task & 3, sub = task >> 2, head = u.kvh * 4 + g, pos = u.qb * 128 + 32 * sub + r32;
            const LAS float* c0 = ropel + (pos >> 6) * 16 + 8 * hh; const LAS float* c1 = ropel + (pos & 63) * 16 + 8 * hh;
            qf[i][0] = rope_pack(qr[i][0], qr[i][1], c0, c0 + 1024, QSC, false); qf[i][1] = rope_pack(qr[i][0], qr[i][1], c0, c0 + 1024, QSC, true);
            qf[i][2] = rope_pack(qr[i][2], qr[i][3], c1, c1 + 1024, QSC, false); qf[i][3] = rope_pack(qr[i][2], qr[i][3], c1, c1 + 1024, QSC, true);
            mrun[i] = F.in[I_OSINK][head] * 1.4426950408889634f; lrun[i] = 1.0f;
#pragma unroll
            for (int dt = 0; dt < 2; ++dt)
#pragma unroll
                for (int r = 0; r < 16; ++r) O[i][dt][r] = 0.f; }
        __syncthreads();
        const int kt_lo = (u.qb == 0) ? 4 : 0, kt_hi = (u.qb == 31) ? 7 : 11;
#pragma unroll
        for (int i = 0; i < 2; ++i) { const int sub = (F.wave + 8 * i) >> 2, qrel = 128 + 32 * sub + r32;
            attn_tiles(F, max(sub, kt_lo), min(sub + 8, kt_hi), sub, sub + 8, qf[i], O[i], mrun[i], lrun[i], qrel); }
        attn_load_ctx(F, P1, u, ck, cv);
        __syncthreads();
        attn_write_ctx(F, ck, cv);
        __syncthreads();
        if (ui + 1 < nu) attn_load_latk(F, P1, attn_unit_of(F.vcu + (ui + 1) * F.G), lk);
#pragma unroll
        for (int i = 0; i < 2; ++i) {
            attn_tiles(F, 0, 7, -1, -1, qf[i], O[i], mrun[i], lrun[i], 0);
            const int task = F.wave + 8 * i, g = task & 3, sub = task >> 2, head = u.kvh * 4 + g, pos = u.qb * 128 + 32 * sub + r32;
            const float inv = 1.0f / lrun[i];
            bf16* o = MIX + (size_t)(u.b * NSEQ + pos) * D + 512 + head * 64 + 4 * hh;
#pragma unroll
            for (int dt = 0; dt < 2; ++dt)
#pragma unroll
                for (int rg = 0; rg < 4; ++rg) { u32x2 w; w.x = pk2(O[i][dt][4 * rg] * inv, O[i][dt][4 * rg + 1] * inv); w.y = pk2(O[i][dt][4 * rg + 2] * inv, O[i][dt][4 * rg + 3] * inv);
                    *(u32x2*)(o + dt * 32 + 8 * rg) = w; }
        }
    }
    __syncthreads();
}

__device__ __forceinline__ void phase_pool_stencil(Frame& F) {
    const bf16* P1 = (const bf16*)(F.ws + WS_BUFP);
    bf16* MIX = (bf16*)(F.ws + WS_BUFA);
    const int gw = F.vcu * NWAVES + F.wave, NGW = F.G * NWAVES;
    const int r = 1 << (F.lane >> 4);
    constexpr int NT = 8, NR = NT + 16;
    for (int t = NT * gw; t < TL; t += NT * NGW) {
        const int pos = t & 4095;
        const bf16* base = P1 + (size_t)t * OIN + 8 * F.lane;
        u32x4 v[NR];
#pragma unroll
        for (int jj = 0; jj < NR; ++jj) { const int pj = pos + jj - 8; const bool ok = pj >= 0 && pj < NSEQ; v[jj] = ok ? *(const u32x4*)(base + (ptrdiff_t)(jj - 8) * OIN) : (u32x4){0u, 0u, 0u, 0u}; }
        float acc[NT][8];
#pragma unroll
        for (int q = 0; q < NT; ++q)
#pragma unroll
            for (int i = 0; i < 8; ++i) acc[q][i] = 0.f;
#pragma unroll
        for (int jj = 0; jj < NR; ++jj) {
            float x[8];
#pragma unroll
            for (int i = 0; i < 4; ++i) { x[2 * i] = bflo(v[jj][i]); x[2 * i + 1] = bfhi(v[jj][i]); }
#pragma unroll
            for (int q = 0; q < NT; ++q) { const int dd = jj - 8 - q; if (dd >= -8 && dd <= 8) { const float w = (dd <= r && dd >= -r) ? 1.0f : 0.0f;
#pragma unroll
                for (int i = 0; i < 8; ++i) acc[q][i] += w * x[i]; } }
        }
#pragma unroll
        for (int q = 0; q < NT; ++q) {
            const int pq = pos + q, lo = max(pq - r, 0), hi = min(pq + r + 1, NSEQ);
            const float ic = 1.0f / (float)(hi - lo);
            const u32x4 sv = v[q + 8];
            u32x4 o;
#pragma unroll
            for (int i = 0; i < 4; ++i) o[i] = pk2(acc[q][2 * i] * ic - bflo(sv[i]), acc[q][2 * i + 1] * ic - bfhi(sv[i]));
            *(u32x4*)(MIX + (size_t)(t + q) * D + 8 * F.lane) = o;
        }
    }
}

__device__ __forceinline__ void phase_attn_pool(Frame& F) {
    phase_attn(F);
#ifdef DBG_ATTN2
    phase_attn(F);
#endif
    phase_pool_stencil(F);
    __syncthreads();
    convert_l1_range(F, 120 * L1T_N + F.vcu * L1A_N, L1A_N, 40);
}

constexpr int NPHASE = 20;
__global__ void __launch_bounds__(NWAVES * 64, 2) mk_fwd(Args args) {
    extern __shared__ __attribute__((aligned(16))) unsigned char lds_raw[];
    Frame F;
    F.lds = (LAS unsigned char*)lds_raw;
    F.tid = threadIdx.x; F.lane = F.tid & 63; F.wave = __builtin_amdgcn_readfirstlane(F.tid >> 6);
    F.G = gridDim.x; { const int bx = blockIdx.x; F.vcu = (F.G % 8 == 0) ? (bx % 8) * (F.G / 8) + bx / 8 : bx; }
    F.ws = args.ws; F.in = args.in; F.out = args.out;
    for (int u = F.tid; u < (LDS_BYTES - LDS_CTL) / 4; u += NWAVES * 64) ((LAS unsigned*)(F.lds + LDS_CTL))[u] = 0u;
    __syncthreads();
    const int lo = args.ph_lo, hi = args.ph_hi;
    XcdBarrier bar; bar.bar = (unsigned*)(F.ws + WS_CTL); bar.x = 0; bar.st = nullptr;
    if (hi - lo > 1) bar = xcd_barrier_post((unsigned*)(F.ws + WS_CTL), (volatile LAS unsigned*)(F.lds + LDS_CTL));
    if (F.tid == 0) { *((unsigned*)(F.ws + WS_XCDOF) + F.vcu) = xb_xcc_id(); *(LAS int*)(F.lds + LDS_CTL + 52) = (hi - lo > 1) ? 1 : 0; }
#define IN(k) (lo <= (k) && (k) < hi)
#ifndef PHASE_MASK
#define PHASE_MASK 0xffffffffu
#endif
#define PH(k, ...) if constexpr (((PHASE_MASK >> (k)) & 1u) != 0u) if (IN(k)) { { int t_ = F.tid; asm volatile("" : "+v"(t_)); F.tid = t_; F.lane = t_ & 63; } __VA_ARGS__ if constexpr (((DBG_DOUBLE >> (k)) & 1u) != 0u) { __VA_ARGS__ } }
#define SEAM(k) do { if (IN(k) && IN((k) + 1)) xcd_barrier(bar); } while (0)
    unsigned char* ws = F.ws;
    const float* mods = (const float*)(ws + WS_MODS);

    PH(1, { phase_prologue_a(F); }) SEAM(1);
    PH(2, {
        pg8::SchedDense S{(const char*)(ws + WS_BUFA), (const char*)(ws + WS_W_EIN), 1024, 8, 136, 0, 1088, F.vcu, F.G};
        pg8::EpiStore E{(bf16*)(ws + WS_BUFP), EIN};
        pg8::gemm_phase<pg8::EpiStore, pg8::SchedDense>(F.lds, 1024, S, E);
        if (F.vcu >= 64) { __syncthreads(); convert_l1_range(F, (F.vcu - 64) * L0T_N, L0T_N, 48, 0); }
    }) SEAM(2);
    PH(3, { phase_fourier_a_conv(F); })
    PH(4, { phase_fourier_c(F); }) SEAM(4);
    PH(5, {
        const int xs = F.vcu >> 5, rs = F.vcu & 31; const bool heavy = rs >= 28;
        pg8::SchedSplit S{(const char*)(ws + WS_BUFA), (const char*)(ws + WS_W_EOUT), 1024, heavy ? 448 + 4 * xs + (rs - 28) : 28 * xs + rs, heavy ? 32 : 224, heavy ? 3 : 2};
        pg8::EpiResid<true> E{F.in[I_X], F.in[I_CTX], (bf16*)(ws + WS_HB), mods + 2 * 1024};
        pg8::gemm_phase<pg8::EpiResid<true>, pg8::SchedSplit>(F.lds, 1024, S, E);
        ctr_publish(F, heavy ? WS_P5C : WS_P5F, heavy ? 2 : 1, xcd_census(F, [&](int v) { return ((v & 31) >= 28) == heavy; }));
    })
    PH(6, { phase_route<true>(F, 0, T); }) SEAM(6);
    PH(7, {
        const int ntile = moe_tables(F, 0);
        const int Lg = ntile & 63; const bool isLong = (F.vcu >> 2) < Lg;
        const unsigned nxc = xcd_census(F, [&](int v) { return ((v >> 2) < Lg) == isLong; });
        if constexpr (FP8_G1_L0) {
            pg8::SchedMoe<true> S{(const char*)(ws + WS_BUFA), (const char*)(ws + WS_W_M1) + (size_t)0 * 32 * MiB, (const int*)(ws + WS_TOKMAP), (const LAS int*)(F.lds + LDS_CTL + 64), (const LAS int*)(F.lds + LDS_CTL + 192), 512, (size_t)MiB, ntile * 4, F.vcu, F.G};
            pg8::EpiSwiglu8 E{(unsigned char*)(ws + WS_BUFZ), pg8::W1_SCALE};
            pg8::gemm_phase<pg8::EpiSwiglu8, pg8::SchedMoe<true>, true>(F.lds, 512, S, E);
        } else {
            pg8::SchedMoe<true> S{(const char*)(ws + WS_BUFA), (const char*)(ws + WS_W_M1) + (size_t)0 * 32 * MiB, (const int*)(ws + WS_TOKMAP), (const LAS int*)(F.lds + LDS_CTL + 64), (const LAS int*)(F.lds + LDS_CTL + 192), 1024, (size_t)2 * MiB, ntile * 4, F.vcu, F.G};
            if constexpr (FP8_G2_L0) { pg8::EpiSwiglu8 E{(unsigned char*)(ws + WS_BUFZ), 1.0f}; pg8::gemm_phase<pg8::EpiSwiglu8, pg8::SchedMoe<true>>(F.lds, 1024, S, E); }
            else { pg8::EpiSwiglu E{(bf16*)(ws + WS_BUFZ)}; pg8::gemm_phase<pg8::EpiSwiglu, pg8::SchedMoe<true>>(F.lds, 1024, S, E); }
        }
        ctr_publish(F, WS_G1CNT + (size_t)(0 * 2 + (isLong ? 1 : 0)) * 256, 3 + 0 * 2 + (isLong ? 1 : 0), nxc);
    })
    PH(8, {
        const int ntile = moe_tables(F, 0);
        const int Rp = ntile >> 6, Lg = ntile & 63, grp = F.vcu >> 2; const bool isLong = grp < Lg;
        const size_t cnt0 = WS_G1CNT + (size_t)(0 * 2) * 256;
        ctr_wait(F, cnt0 + (isLong ? 256 : 0), (unsigned)(isLong ? 4 * Lg : 256 - 4 * Lg));
        if constexpr (FP8_G2_L0) {
            { pg8::EpiStoreS E{(bf16*)(ws + WS_BUFP), 1024, 1.0f / (pg8::HID_SCALE * pg8::W2_SCALE)};
              pg8::SchedMoe<false> S{(const char*)(ws + WS_BUFZ), (const char*)(ws + WS_W_M2) + (size_t)0 * 16 * MiB, nullptr, (const LAS int*)(F.lds + LDS_CTL + 64), (const LAS int*)(F.lds + LDS_CTL + 192), 256, (size_t)512 * KiB, Rp * 256, F.vcu, F.G};
              pg8::gemm_phase<pg8::EpiStoreS, pg8::SchedMoe<false>, true>(F.lds, 256, S, E); }
            const int nt2 = __builtin_amdgcn_readfirstlane(*(const LAS int*)(F.lds + LDS_CTL + 64 + 64)), Lg2 = nt2 & 63, grp2 = F.vcu >> 2;
            int xc = -1;
            if (grp2 < Lg2) { if (63 - grp2 < Lg2) xc = F.vcu; }
            else if (63 - grp2 < Lg2) xc = 4 * (63 - grp2) + (F.vcu & 3);
            if (xc >= 0) {
                if (grp2 >= Lg2) ctr_wait(F, WS_G1CNT + (size_t)(0 * 2 + 1) * 256, (unsigned)(4 * Lg2));
                pg8::EpiStoreS E{(bf16*)(ws + WS_BUFP), 1024, 1.0f / (pg8::HID_SCALE * pg8::W2_SCALE)};
                pg8::SchedMoe<false> S{(const char*)(ws + WS_BUFZ), (const char*)(ws + WS_W_M2) + (size_t)0 * 16 * MiB, nullptr, (const LAS int*)(F.lds + LDS_CTL + 64), (const LAS int*)(F.lds + LDS_CTL + 192), 256, (size_t)512 * KiB, nt2 * 4, (nt2 >> 6) * 256 + xc, 1 << 20};
                pg8::gemm_phase<pg8::EpiStoreS, pg8::SchedMoe<false>, true>(F.lds, 256, S, E);
            }
        } else {
            if (Lg > 0 && Lg < 64) ctr_wait(F, cnt0 + (isLong ? 0 : 256), (unsigned)(isLong ? 256 - 4 * Lg : 4 * Lg));
            pg8::SchedMoe<false> S{(const char*)(ws + WS_BUFZ), (const char*)(ws + WS_W_M2) + (size_t)0 * 16 * MiB, nullptr, (const LAS int*)(F.lds + LDS_CTL + 64), (const LAS int*)(F.lds + LDS_CTL + 192), 512, (size_t)MiB, ntile * 4, F.vcu, F.G};
            pg8::EpiStore E{(bf16*)(ws + WS_BUFP), 1024};
            pg8::gemm_phase<pg8::EpiStore, pg8::SchedMoe<false>>(F.lds, 512, S, E);
        }
    }) SEAM(8);
    PH(9, { (void)moe_tables(F, 0); phase_combine(F, 0, T); }) SEAM(9);
    PH(10, {
        pg8::SchedDense S{(const char*)(ws + WS_BUFA), (const char*)(ws + WS_W_OIN), 1024, 5, 128, 4, 648, F.vcu, F.G};
        pg8::EpiStore E{(bf16*)(ws + WS_BUFP), OIN};
        pg8::gemm_phase<pg8::EpiStore, pg8::SchedDense>(F.lds, 1024, S, E);
        if (F.vcu >= 136) { __syncthreads(); convert_l1_range(F, (F.vcu - 136) * L1T_N, L1T_N, 44); }
    }) SEAM(10);
    PH(11, { phase_attn_pool(F); }) SEAM(11);
    PH(12, {
        pg8::SchedDense S{(const char*)(ws + WS_BUFA), (const char*)(ws + WS_W_OOUT), 1024, 4, 128, 0, 512, F.vcu, F.G};
        pg8::EpiResid<false> E{nullptr, nullptr, (bf16*)(ws + WS_HB), mods + 9 * 6144 + 2 * 1024};
        pg8::gemm_phase<pg8::EpiResid<false>, pg8::SchedDense>(F.lds, 1024, S, E);
    }) SEAM(12);
    PH(13, { phase_route<false>(F, 1, TL); }) SEAM(13);
    PH(14, {
        const int ntile = moe_tables(F, 1);
        const int Lg = ntile & 63; const bool isLong = (F.vcu >> 2) < Lg;
        const unsigned nxc = xcd_census(F, [&](int v) { return ((v >> 2) < Lg) == isLong; });
        if constexpr (FP8_G1_L1) {
            pg8::SchedMoe<true> S{(const char*)(ws + WS_BUFA), (const char*)(ws + WS_W_M1) + (size_t)1 * 32 * MiB, (const int*)(ws + WS_TOKMAP), (const LAS int*)(F.lds + LDS_CTL + 64), (const LAS int*)(F.lds + LDS_CTL + 192), 512, (size_t)MiB, ntile * 4, F.vcu, F.G};
            pg8::EpiSwiglu8 E{(unsigned char*)(ws + WS_BUFZ), pg8::W1_SCALE};
            pg8::gemm_phase<pg8::EpiSwiglu8, pg8::SchedMoe<true>, true>(F.lds, 512, S, E);
        } else {
            pg8::SchedMoe<true> S{(const char*)(ws + WS_BUFA), (const char*)(ws + WS_W_M1) + (size_t)1 * 32 * MiB, (const int*)(ws + WS_TOKMAP), (const LAS int*)(F.lds + LDS_CTL + 64), (const LAS int*)(F.lds + LDS_CTL + 192), 1024, (size_t)2 * MiB, ntile * 4, F.vcu, F.G};
            if constexpr (FP8_G2_L1) { pg8::EpiSwiglu8 E{(unsigned char*)(ws + WS_BUFZ), 1.0f}; pg8::gemm_phase<pg8::EpiSwiglu8, pg8::SchedMoe<true>>(F.lds, 1024, S, E); }
            else { pg8::EpiSwiglu E{(bf16*)(ws + WS_BUFZ)}; pg8::gemm_phase<pg8::EpiSwiglu, pg8::SchedMoe<true>>(F.lds, 1024, S, E); }
        }
        ctr_publish(F, WS_G1CNT + (size_t)(1 * 2 + (isLong ? 1 : 0)) * 256, 3 + 1 * 2 + (isLong ? 1 : 0), nxc);
    })
    PH(15, {
        const int ntile = moe_tables(F, 1);
        const int Rp = ntile >> 6, Lg = ntile & 63, grp = F.vcu >> 2; const bool isLong = grp < Lg;
        const size_t cnt0 = WS_G1CNT + (size_t)(1 * 2) * 256;
        ctr_wait(F, cnt0 + (isLong ? 256 : 0), (unsigned)(isLong ? 4 * Lg : 256 - 4 * Lg));
        if constexpr (FP8_G2_L1) {
            { pg8::EpiStoreS E{(bf16*)(ws + WS_BUFP), 1024, 1.0f / (pg8::HID_SCALE * pg8::W2_SCALE)};
              pg8::SchedMoe<false> S{(const char*)(ws + WS_BUFZ), (const char*)(ws + WS_W_M2) + (size_t)1 * 16 * MiB, nullptr, (const LAS int*)(F.lds + LDS_CTL + 64), (const LAS int*)(F.lds + LDS_CTL + 192), 256, (size_t)512 * KiB, Rp * 256, F.vcu, F.G};
              pg8::gemm_phase<pg8::EpiStoreS, pg8::SchedMoe<false>, true>(F.lds, 256, S, E); }
            const int nt2 = __builtin_amdgcn_readfirstlane(*(const LAS int*)(F.lds + LDS_CTL + 64 + 64)), Lg2 = nt2 & 63, grp2 = F.vcu >> 2;
            int xc = -1;
            if (grp2 < Lg2) { if (63 - grp2 < Lg2) xc = F.vcu; }
            else if (63 - grp2 < Lg2) xc = 4 * (63 - grp2) + (F.vcu & 3);
            if (xc >= 0) {
                if (grp2 >= Lg2) ctr_wait(F, WS_G1CNT + (size_t)(1 * 2 + 1) * 256, (unsigned)(4 * Lg2));
                pg8::EpiStoreS E{(bf16*)(ws + WS_BUFP), 1024, 1.0f / (pg8::HID_SCALE * pg8::W2_SCALE)};
                pg8::SchedMoe<false> S{(const char*)(ws + WS_BUFZ), (const char*)(ws + WS_W_M2) + (size_t)1 * 16 * MiB, nullptr, (const LAS int*)(F.lds + LDS_CTL + 64), (const LAS int*)(F.lds + LDS_CTL + 192), 256, (size_t)512 * KiB, nt2 * 4, (nt2 >> 6) * 256 + xc, 1 << 20};
                pg8::gemm_phase<pg8::EpiStoreS, pg8::SchedMoe<false>, true>(F.lds, 256, S, E);
            }
        } else {
            if (Lg > 0 && Lg < 64) ctr_wait(F, cnt0 + (isLong ? 0 : 256), (unsigned)(isLong ? 256 - 4 * Lg : 4 * Lg));
            pg8::SchedMoe<false> S{(const char*)(ws + WS_BUFZ), (const char*)(ws + WS_W_M2) + (size_t)1 * 16 * MiB, nullptr, (const LAS int*)(F.lds + LDS_CTL + 64), (const LAS int*)(F.lds + LDS_CTL + 192), 512, (size_t)MiB, ntile * 4, F.vcu, F.G};
            pg8::EpiStore E{(bf16*)(ws + WS_BUFP), 1024};
            pg8::gemm_phase<pg8::EpiStore, pg8::SchedMoe<false>>(F.lds, 512, S, E);
        }
    }) SEAM(15);
    PH(16, { (void)moe_tables(F, 1); phase_combine(F, 1, TL); }) SEAM(16);
#ifdef DBG_XBAR
    if (hi - lo > 1) { for (int xb = 0; xb < DBG_XBAR; ++xb) xcd_barrier(bar); }
#endif
#undef IN
#undef SEAM
}

extern "C" void kernel_launch(void* const* d_in, const int* in_sizes, int n_in, void* d_out, int out_size, void* d_ws, size_t ws_size, hipStream_t stream) {
    static int grid = 0;
    if (grid == 0) {
        if (n_in != 22 || ws_size < WS_END) { fprintf(stderr, "kernel_launch: unexpected inputs (n_in %d, ws %zu)\n", n_in, ws_size); grid = -1; return; }
        int dev = 0, cus = 0, per_cu = 0;
        if (hipGetDevice(&dev) != hipSuccess || hipDeviceGetAttribute(&cus, hipDeviceAttributeMultiprocessorCount, dev) != hipSuccess) { grid = -1; return; }
        if (hipFuncSetAttribute((const void*)mk_fwd, hipFuncAttributeMaxDynamicSharedMemorySize, LDS_BYTES) != hipSuccess) { fprintf(stderr, "kernel_launch: hipFuncSetAttribute failed\n"); grid = -1; return; }
        if (hipOccupancyMaxActiveBlocksPerMultiprocessor(&per_cu, (const void*)mk_fwd, NWAVES * 64, LDS_BYTES) != hipSuccess || per_cu < 1) { fprintf(stderr, "kernel_launch: occupancy query says %d\n", per_cu); }
        (void)hipGetLastError();
        grid = cus;
        if (grid != 256) { fprintf(stderr, "kernel_launch: %d CUs; this build assumes 256\n", grid); }
    }
    if (grid < 0) return;
    (void)hipMemsetAsync((char*)d_ws + WS_CTL, 0, CTL_ZERO_BYTES, stream);
    Args a{};
    for (int i = 0; i < 22; ++i) a.in[i] = (const float*)d_in[i];
    a.out = (float*)d_out; a.ws = (unsigned char*)d_ws;
#if MK_MULTI
    for (int p = 0; p <= DBG_STOP; ++p) { a.ph_lo = p; a.ph_hi = p + 1; hipLaunchKernelGGL(mk_fwd, dim3(grid), dim3(NWAVES * 64), LDS_BYTES, stream, a); }
    if (DBG_STOP < 16) { a.ph_lo = 17; a.ph_hi = 18; hipLaunchKernelGGL(mk_fwd, dim3(grid), dim3(NWAVES * 64), LDS_BYTES, stream, a); }
#else
    a.ph_lo = 0; a.ph_hi = 17;
    hipLaunchKernelGGL(mk_fwd, dim3(grid), dim3(NWAVES * 64), LDS_BYTES, stream, a);
#endif
}
```

```cpp
#include <hip/hip_runtime.h>
#include <cstdio>
#include <cstdint>
#include <type_traits>

#ifndef MK_MULTI
#define MK_MULTI 0
#endif
#ifndef DBG_STOP
#define DBG_STOP 16
#endif

#ifndef DBG_DOUBLE
#define DBG_DOUBLE 0u
#endif
#ifndef FP8_G1_L0
#define FP8_G1_L0 1
#endif
#ifndef FP8_G1_L1
#define FP8_G1_L1 1
#endif
#ifndef FP8_G2_L0
#define FP8_G2_L0 1
#endif
#ifndef FP8_G2_L1
#define FP8_G2_L1 1
#endif
#define LAS __attribute__((address_space(3)))
#define GAS __attribute__((address_space(1)))
typedef unsigned short bf16;
typedef short bf16x8 __attribute__((ext_vector_type(8)));
typedef short s16x4 __attribute__((ext_vector_type(4)));
typedef float f32x4 __attribute__((ext_vector_type(4)));
typedef float f32x16 __attribute__((ext_vector_type(16)));
typedef unsigned u32x4 __attribute__((ext_vector_type(4)));
typedef unsigned u32x2 __attribute__((ext_vector_type(2)));

constexpr int NB = 8, NSEQ = 4096, D = 1024, LCTX = 256;
constexpr int TL = NB * NSEQ, TC = NB * LCTX, T = TL + TC;
constexpr int EIN = 2048;
constexpr int OIN = 1280;
constexpr int NE = 16, DE = 512;
constexpr int MAXSLOT = 73728;
constexpr float EPS = 1e-6f;

constexpr size_t KiB = 1024, MiB = 1024 * 1024;
constexpr size_t WS_CTL = 0, CTL_ZERO_BYTES = 64 * KiB;
constexpr size_t WS_MODS = 64 * KiB;
constexpr size_t WS_ROPE = WS_MODS + 512 * KiB;
constexpr size_t WS_WA = WS_ROPE + 8 * KiB;
constexpr size_t WS_WAC = WS_WA + 32 * KiB;
constexpr size_t WS_WCC = WS_WAC + 2 * KiB;
constexpr size_t WS_FD = 3 * MiB - 64 * KiB;
constexpr size_t WS_BCNT = WS_WCC + 16 * KiB;
constexpr size_t WS_TILEMAP = WS_BCNT + 16 * KiB;
constexpr size_t WS_SLOT = WS_TILEMAP + 2 * KiB;
constexpr size_t WS_WROW = WS_SLOT + 288 * KiB;
constexpr size_t WS_ROUTE = WS_WROW + 288 * KiB;
constexpr size_t WS_WC = 3 * MiB;
constexpr size_t WS_W_EIN = 4 * MiB;
constexpr size_t WS_W_EOUT = 9 * MiB;
constexpr size_t WS_W_OIN = 11 * MiB;
constexpr size_t WS_W_OOUT = 14 * MiB;
constexpr size_t WS_W_POOL = 16 * MiB;
constexpr size_t WS_W_M1 = 17 * MiB;
constexpr size_t WS_W_M2 = 81 * MiB;
constexpr size_t WS_HC = 113 * MiB;
constexpr size_t WS_BUFA = 121 * MiB;
constexpr size_t WS_BUFP = 189 * MiB;
constexpr size_t WS_BUFZ = 360 * MiB;
constexpr size_t WS_TOKMAP = 432 * MiB;
constexpr size_t WS_HB = 435 * MiB;
constexpr size_t WS_END = 503 * MiB;
constexpr size_t WS_MODSDONE = 24 * KiB;
constexpr size_t WS_FAF = 28 * KiB + 512;
constexpr size_t WS_P5F = 28 * KiB, WS_P5C = 28 * KiB + 256;
constexpr size_t WS_CENSUS = 28 * KiB + 768;
constexpr size_t WS_XCDOF = 60 * KiB;
constexpr size_t WS_G1CNT = 61 * KiB;
constexpr size_t WS_XARR = 32 * KiB;
constexpr size_t WS_GCNT = 16 * KiB;
static_assert(WS_ROUTE + (size_t)T * 32 <= WS_WC, "small region");
static_assert((size_t)T * EIN * 2 <= WS_BUFZ - WS_BUFP && (size_t)MAXSLOT * 1024 * 2 <= WS_BUFZ - WS_BUFP, "BUFP");
static_assert((size_t)MAXSLOT * 512 * 2 <= WS_TOKMAP - WS_BUFZ && (size_t)T * 1024 * 2 <= WS_TOKMAP - WS_BUFZ, "BUFZ");
static_assert((size_t)16 * T * 4 <= WS_HB - WS_TOKMAP && (size_t)T * 1024 * 2 <= WS_END - WS_HB, "TOKMAP / HB");
static_assert((size_t)T * 1024 * 2 <= WS_BUFP - WS_BUFA, "BUFA");

constexpr int LDS_BYTES = 163840;
constexpr int LDS_GIDX = 147456;
constexpr int LDS_CTL = 146432;
constexpr int NWAVES = 8;

__device__ __forceinline__ unsigned f2bf(float f) { unsigned u = __builtin_bit_cast(unsigned, f); return (u + 0x7fffu + ((u >> 16) & 1u)) >> 16; }
__device__ __forceinline__ unsigned pk2(float lo, float hi) { return f2bf(lo) | (f2bf(hi) << 16); }
__device__ __forceinline__ float bflo(unsigned w) { return __builtin_bit_cast(float, w << 16); }
__device__ __forceinline__ float bfhi(unsigned w) { return __builtin_bit_cast(float, w & 0xffff0000u); }
__device__ __forceinline__ float wave_sum(float v) {
#pragma unroll
    for (int o = 1; o < 64; o <<= 1) v += __shfl_xor(v, o);
    return v;
}
__device__ __forceinline__ int ld_coh(const int* p) { return (int)__hip_atomic_load((const unsigned*)p, __ATOMIC_RELAXED, __HIP_MEMORY_SCOPE_AGENT); }
__device__ __forceinline__ float ld_cohf(const float* p) { return __builtin_bit_cast(float, __hip_atomic_load((const unsigned*)p, __ATOMIC_RELAXED, __HIP_MEMORY_SCOPE_AGENT)); }
#define LDS_WAIT() asm volatile("s_waitcnt lgkmcnt(0)" ::: "memory")

#define XB_TMO      128
#define XB_XCNT(j)  (256  + 64 * (j))
#define XB_XSUB(j)  (1280 + 64 * (j))
#define XB_XGEN(j)  (2304 + 64 * (j))
#define XB_TOP      3328
#define XB_TOPGEN   3392
#define XCD_BAR_WORDS 3456
#define XB_SPIN_CAP (1u << 18)
__device__ __forceinline__ unsigned xb_ld(unsigned* p)              { return __hip_atomic_load(p, __ATOMIC_RELAXED, __HIP_MEMORY_SCOPE_AGENT); }
__device__ __forceinline__ unsigned xb_add(unsigned* p, unsigned v) { return __hip_atomic_fetch_add(p, v, __ATOMIC_RELAXED, __HIP_MEMORY_SCOPE_AGENT); }
__device__ __forceinline__ unsigned xb_xcc_id() { return (unsigned)__builtin_amdgcn_s_getreg((3 << 11) | 20) & 0xFu; }
#define XB_SPIN(cond, bar) do { unsigned _sp = 0; while (cond) { __builtin_amdgcn_s_sleep(1); \
    if ((++_sp & 255u) == 0u) { if (xb_ld(&(bar)[XB_TMO])) break; if (_sp > XB_SPIN_CAP) { atomicAdd(&(bar)[XB_TMO], 1u); break; } } } } while (0)
struct XcdBarrier { unsigned* bar; unsigned x; volatile LAS unsigned* st; };
__device__ __forceinline__ XcdBarrier xcd_barrier_post(unsigned* bar, volatile LAS unsigned* st) {
    XcdBarrier b; b.bar = bar; b.x = xb_xcc_id(); b.st = st;
    if (threadIdx.x == 0) (void)xb_add(&bar[XB_XCNT(b.x)], 1u);
    return b;
}
__device__ __forceinline__ void xcd_barrier_complete(unsigned* bar, unsigned x, unsigned& nloc, unsigned& nx) {
    const unsigned G = gridDim.x * gridDim.y * gridDim.z;
    unsigned sum, cnt, mine, sp = 0u;
    for (;;) {
        sum = 0u; cnt = 0u; mine = 0u;
#pragma unroll
        for (unsigned j = 0; j < 16; ++j) { const unsigned c = xb_ld(&bar[XB_XCNT(j)]); sum += c; cnt += (c > 0u) ? 1u : 0u; mine = (j == x) ? c : mine; }
        if (sum == G) break;
        __builtin_amdgcn_s_sleep(1);
        if ((++sp & 255u) == 0u) { if (xb_ld(&bar[XB_TMO])) break; if (sp > XB_SPIN_CAP) { atomicAdd(&bar[XB_TMO], 1u); break; } }
    }
    nloc = mine > 0u ? mine : 1u; nx = cnt > 0u ? cnt : 1u;
}
__device__ __forceinline__ void xcd_barrier(const XcdBarrier& b) {
    asm volatile("s_waitcnt vmcnt(0)" ::: "memory");
    __syncthreads();
    if (threadIdx.x == 0) {
        unsigned* bar = b.bar;
        __builtin_amdgcn_s_waitcnt(0);
        unsigned nloc = b.st[0], nx = b.st[1];
        if (nloc == 0u) { xcd_barrier_complete(bar, b.x, nloc, nx); b.st[0] = nloc; b.st[1] = nx; }
        const unsigned old = xb_add(&bar[XB_XSUB(b.x)], 1u);
        const unsigned gen = old / nloc;
        if (old + 1u == (gen + 1u) * nloc) {
            __builtin_amdgcn_fence(__ATOMIC_RELEASE, "agent");
            asm volatile("s_waitcnt vmcnt(0)" ::: "memory");
            const unsigned og = xb_add(&bar[XB_TOP], 1u);
            const unsigned tg = og / nx;
            if (og + 1u == (tg + 1u) * nx) xb_add(&bar[XB_TOPGEN], 1u);
            else XB_SPIN(xb_ld(&bar[XB_TOPGEN]) == tg, bar);
            __builtin_amdgcn_fence(__ATOMIC_ACQUIRE, "agent");
            xb_add(&bar[XB_XGEN(b.x)], 1u);
            asm volatile("s_waitcnt vmcnt(0)" ::: "memory");
        } else {
            XB_SPIN(xb_ld(&bar[XB_XGEN(b.x)]) == gen, bar);
            __builtin_amdgcn_fence(__ATOMIC_ACQUIRE, "agent");
            asm volatile("s_waitcnt vmcnt(0)" ::: "memory");
        }
    }
    __syncthreads();
}

namespace pg8 {
constexpr int BM = 256, BK = 64, HALF = 128, HTB = HALF * BK * 2, STAGE_BYTES = 8 * HTB;
__host__ __device__ __forceinline__ int lds_byte(int r, int c) { const int st = (r >> 4) * 2 + (c >> 5), rr = r & 15, cc = c & 31, ob = rr * 64 + cc * 2; return st * 1024 + (ob ^ (((ob >> 9) & 1) << 5)); }
__host__ __device__ __forceinline__ void stage_rc(int b, int& R, int& C) { const int st = b / 1024, sb = b % 1024, swz = sb ^ (((sb >> 9) & 1) << 5); R = (st >> 1) * 16 + swz / 64; C = (st & 1) * 32 + (swz % 64) / 2; }
__host__ __device__ __forceinline__ int perm32(int rho) { const int n = rho >> 4, i = rho & 15; return 8 * (i >> 2) + 4 * n + (i & 3); }
struct Unit { int pm, pn, e; };
__device__ __forceinline__ unsigned cvt_pk_bf16(float lo, float hi) { unsigned r; asm volatile("v_cvt_pk_bf16_f32 %0, %1, %2" : "=v"(r) : "v"(lo), "v"(hi)); return r; }

typedef int v8i32 __attribute__((ext_vector_type(8)));
static_assert(FP8_G2_L0 && FP8_G2_L1, "the combine phases read the expert outputs as e4m3 bytes, which only the fp8 down GEMM writes");
typedef int v4i32 __attribute__((ext_vector_type(4)));
__device__ __forceinline__ v8i32 cat16(const bf16x8 lo, const bf16x8 hi) { return __builtin_shufflevector(__builtin_bit_cast(v4i32, lo), __builtin_bit_cast(v4i32, hi), 0, 1, 2, 3, 4, 5, 6, 7); }
template <class Epi, class Sched, bool FP8 = false>
__device__ __forceinline__ void gemm_phase(LAS unsigned char* lds, const int K, const Sched& S, const Epi& E) {
    const int tid = threadIdx.x, wid = __builtin_amdgcn_readfirstlane(tid >> 6), lane = tid & 63, wr = wid >> 2, wc = wid & 3, fr = lane & 15, fq = lane >> 4;
    const int nt = K / BK;
    int tidv = tid;
#define PG8_VB(i) ([&]() -> unsigned { int R_, C_; stage_rc(tidv * 16 + (i) * 8192, R_, C_); const int Rb_ = Epi::PERM ? ((R_ & ~31) + perm32(R_ & 31)) : R_; return (unsigned)(Rb_ * K + C_) * 2u; }())
#define PG8_VA(h, i) ([&]() -> unsigned { int R_, C_; stage_rc(tidv * 16 + (i) * 8192, R_, C_); return (unsigned)((128 * (h) + R_) * K + C_) * 2u; }())
    const size_t kstep = (size_t)(BK * 2);
    const size_t hstep = (size_t)HALF * K * 2;
    const unsigned ldsw = (unsigned)wid * 1024u;
#define aoff (lds_byte(wr * 64 + (tidv & 15), ((tidv >> 4) & 3) * 8))
#define boff (lds_byte(wc * 32 + (tidv & 15), ((tidv >> 4) & 3) * 8))
#define PG8_SA(b, h) (((b) * 2 + (h)) * HTB)
#define PG8_SB(b, h) ((4 + (b) * 2 + (h)) * HTB)
#define PG8_STAGEB(bufoff, gbase) do { _Pragma("unroll") for (int _i = 0; _i < 2; ++_i) \
        __builtin_amdgcn_global_load_lds((const unsigned*)((const char*)(gbase) + PG8_VB(_i)), (LAS unsigned*)(lds + (bufoff) + ldsw + _i * 8192), 16, 0, 0); } while (0)
#define PG8_STAGEA(bufoff, gbase, h, NEXT) do { _Pragma("unroll") for (int _i = 0; _i < 2; ++_i) { unsigned vo_; \
        if constexpr (Sched::GATHER) { int R_, C_; stage_rc(tidv * 16 + _i * 8192, R_, C_); const unsigned raw_ = gidx[((((NEXT) && usen) ? (gslot ^ 1u) : gslot) * 4u + (h) * 2 + _i) * 512u + tid]; vo_ = (raw_ * (unsigned)K + (unsigned)C_) * 2u; } \
        else vo_ = PG8_VA(h, _i); \
        __builtin_amdgcn_global_load_lds((const unsigned*)((const char*)(gbase) + vo_), (LAS unsigned*)(lds + (bufoff) + ldsw + _i * 8192), 16, 0, 0); } } while (0)
#define PG8_LDA(dst, b, h) do { _Pragma("unroll") for (int m = 0; m < 4; ++m) _Pragma("unroll") for (int k = 0; k < 2; ++k) dst[m][k] = *(const LAS bf16x8*)(lds + PG8_SA(b, h) + aoff + m * 2048 + k * 1024); } while (0)
#define PG8_LDB(dst, b, h) do { _Pragma("unroll") for (int n = 0; n < 2; ++n) _Pragma("unroll") for (int k = 0; k < 2; ++k) dst[n][k] = *(const LAS bf16x8*)(lds + PG8_SB(b, h) + boff + n * 2048 + k * 1024); } while (0)
#define PG8_MMA(ai, bj, At, Bt) do { __builtin_amdgcn_s_setprio(1); _Pragma("unroll") for (int m = 0; m < 4; ++m) _Pragma("unroll") for (int n = 0; n < 2; ++n) { \
        if constexpr (FP8) acc[ai][bj][m][n] = __builtin_amdgcn_mfma_scale_f32_16x16x128_f8f6f4(cat16(Bt[n][0], Bt[n][1]), cat16(At[m][0], At[m][1]), acc[ai][bj][m][n], 0, 0, 0, 0x7f7f7f7f, 0, 0x7f7f7f7f); \
        else { _Pragma("unroll") for (int k = 0; k < 2; ++k) acc[ai][bj][m][n] = __builtin_amdgcn_mfma_f32_16x16x32_bf16(Bt[n][k], At[m][k], acc[ai][bj][m][n], 0, 0, 0); } } \
        __builtin_amdgcn_s_setprio(0); } while (0)
#define PG8_WAIT_V(n) asm volatile("s_waitcnt vmcnt(" #n ")" ::: "memory")
#define PG8_WAIT_L(n) asm volatile("s_waitcnt lgkmcnt(" #n ")" ::: "memory")
#define PG8_BAR __builtin_amdgcn_s_barrier()
#define PG8_SCHED __builtin_amdgcn_sched_barrier(0)
#define PG8_ITER(A1, A2, A3, B2, B3) do { \
            PG8_LDB(B0, 0, 0); PG8_LDB(B1, 0, 1); PG8_SCHED; PG8_LDA(At, 0, 0); PG8_STAGEA(PG8_SA(1, 1), A1, 1, 0); \
            PG8_WAIT_V(8); PG8_WAIT_L(0); PG8_BAR; PG8_MMA(0, 0, At, B0); PG8_MMA(0, 1, At, B1); PG8_BAR; PG8_SCHED; \
            PG8_LDA(At, 0, 1); PG8_STAGEB(PG8_SB(0, 0), B2); PG8_STAGEB(PG8_SB(0, 1), (B2) + hstep); PG8_STAGEA(PG8_SA(0, 0), A2, 0, 1); \
            PG8_WAIT_V(8); PG8_WAIT_L(0); PG8_BAR; PG8_MMA(1, 0, At, B0); PG8_MMA(1, 1, At, B1); PG8_BAR; PG8_SCHED; \
            PG8_LDB(B0, 1, 0); PG8_LDB(B1, 1, 1); PG8_SCHED; PG8_LDA(At, 1, 0); PG8_STAGEA(PG8_SA(0, 1), A2, 1, 1); \
            PG8_WAIT_V(8); PG8_WAIT_L(0); PG8_BAR; PG8_MMA(0, 0, At, B0); PG8_MMA(0, 1, At, B1); PG8_BAR; PG8_SCHED; \
            PG8_LDA(At, 1, 1); PG8_STAGEB(PG8_SB(1, 0), B3); PG8_STAGEB(PG8_SB(1, 1), (B3) + hstep); PG8_STAGEA(PG8_SA(1, 0), A3, 0, 1); \
            PG8_WAIT_V(8); PG8_WAIT_L(0); PG8_BAR; PG8_MMA(1, 0, At, B0); PG8_MMA(1, 1, At, B1); PG8_BAR; PG8_SCHED; } while (0)
    Unit cur, nxt; int ui = 0;
    if (!S.next(0, cur)) return;
    f32x4 acc[2][2][4][2];
#pragma unroll
    for (int a = 0; a < 2; ++a)
#pragma unroll
        for (int b = 0; b < 2; ++b)
#pragma unroll
            for (int m = 0; m < 4; ++m)
#pragma unroll
                for (int n = 0; n < 2; ++n) acc[a][b][m][n] = (f32x4){0.f, 0.f, 0.f, 0.f};
    bf16x8 At[4][2], B0[2][2], B1[2][2];
    const LAS unsigned* gidx = (const LAS unsigned*)(lds + LDS_GIDX); unsigned gslot = 0u;
    if constexpr (Sched::GATHER) { S.idx_dma(cur, (LAS unsigned*)(lds + LDS_GIDX), tidv, wid); asm volatile("s_waitcnt vmcnt(0)" ::: "memory"); }
    const char* cA = S.a_base(cur); const char* cB = S.b_base(cur);
    constexpr bool usen = false;
    PG8_STAGEB(PG8_SB(0, 0), cB); PG8_STAGEB(PG8_SB(0, 1), cB + hstep); PG8_STAGEA(PG8_SA(0, 0), cA, 0, 0); PG8_STAGEA(PG8_SA(0, 1), cA, 1, 0);
    if (wr == 1) PG8_BAR;
    PG8_WAIT_V(2); PG8_BAR;
    PG8_STAGEB(PG8_SB(1, 0), cB + kstep); PG8_STAGEA(PG8_SA(1, 0), cA + kstep, 0, 0); PG8_STAGEB(PG8_SB(1, 1), cB + hstep + kstep);
    PG8_WAIT_V(6); PG8_BAR;
    for (;;) {
        const bool has_next = S.next(ui + 1, nxt);
        const char* nA = has_next ? S.a_base(nxt) : cA; const char* nB = has_next ? S.b_base(nxt) : cB;
#pragma unroll 1
        for (int t = 0; t < nt; t += 2) {
            const bool last = (t == nt - 2);
            const char* a1 = cA + (size_t)(t + 1) * kstep;
            const char* a2 = last ? nA : cA + (size_t)(t + 2) * kstep; const char* b2 = last ? nB : cB + (size_t)(t + 2) * kstep;
            tidv = tid; asm volatile("" : "+v"(tidv));
            if constexpr (Sched::GATHER) {
                if (t == nt - 4 && has_next) S.idx_dma(nxt, (LAS unsigned*)(lds + LDS_GIDX) + (gslot ^ 1u) * 2048u, tidv, wid);
            }
            const bool usen = last && has_next;
            PG8_ITER(a1, a2, a2 + kstep, b2, b2 + kstep);
        }
        if (wr == 0) PG8_BAR;
        E(acc, cur, wr, wc, fr, fq);
        if (!has_next) break;
#pragma unroll
        for (int a = 0; a < 2; ++a)
#pragma unroll
            for (int b = 0; b < 2; ++b)
#pragma unroll
                for (int m = 0; m < 4; ++m)
#pragma unroll
                    for (int n = 0; n < 2; ++n) acc[a][b][m][n] = (f32x4){0.f, 0.f, 0.f, 0.f};
        cur = nxt; cA = nA; cB = nB; ++ui;
        if constexpr (Sched::GATHER) gslot ^= 1u;
        if (wr == 1) PG8_BAR;
    }
    PG8_WAIT_V(0);
    PG8_BAR;
#undef PG8_ITER
#undef aoff
#undef boff
#undef PG8_SA
#undef PG8_SB
#undef PG8_STAGEA
#undef PG8_STAGEB
#undef PG8_VA
#undef PG8_VB
#undef PG8_LDA
#undef PG8_LDB
#undef PG8_MMA
#undef PG8_WAIT_V
#undef PG8_WAIT_L
#undef PG8_BAR
#undef PG8_SCHED
}

struct SchedDense {
    static constexpr bool GATHER = false;
    const char* A; const char* Bt; int K, nN, nMfull, pnx, nUnits, c, G;
    __device__ __forceinline__ bool next(int i, Unit& u) const {
        const int L = i * G + c; if (L >= nUnits) return false;
        const int full = nMfull * nN;
        if (L < full) { u.pm = L / nN; u.pn = L - u.pm * nN; } else { u.pm = nMfull + (L - full); u.pn = pnx; }
        u.e = 0; return true;
    }
    __device__ __forceinline__ const char* a_base(const Unit& u) const { return A + (size_t)u.pm * 256 * K * 2; }
    __device__ __forceinline__ const char* b_base(const Unit& u) const { return Bt + (size_t)u.pn * 256 * K * 2; }
};
struct SchedSplit {
    static constexpr bool GATHER = false;
    const char* A; const char* Bt; int K, base, stride, n;
    __device__ __forceinline__ bool next(int i, Unit& u) const {
        if (i >= n) return false;
        const int L = base + i * stride; u.pm = L >> 2; u.pn = L & 3; u.e = 0; return true;
    }
    __device__ __forceinline__ const char* a_base(const Unit& u) const { return A + (size_t)u.pm * 256 * K * 2; }
    __device__ __forceinline__ const char* b_base(const Unit& u) const { return Bt + (size_t)u.pn * 256 * K * 2; }
};
template <bool GATHER_> struct SchedMoe {
    static constexpr bool GATHER = GATHER_, gather = GATHER_;
    const char* A; const char* W; const int* tokmap; const LAS int* tb; const LAS int* cn; int K; size_t wstride; int nUnits, c, G;
    __device__ __forceinline__ bool next(int i, Unit& u) const {
        const int L = i * G + c; if (L >= nUnits) return false;
        u.pm = L >> 2; u.pn = L & 3; int e = 0;
#pragma unroll
        for (int q = 1; q < 16; ++q) if (u.pm >= __builtin_amdgcn_readfirstlane(tb[q])) e = q;
        u.e = __builtin_amdgcn_readfirstlane(e); return true;
    }
    __device__ __forceinline__ const char* a_base(const Unit& u) const { return gather ? A : A + (size_t)u.pm * 256 * K * 2; }
    __device__ __forceinline__ const char* b_base(const Unit& u) const { return W + (size_t)u.e * wstride + (size_t)u.pn * 256 * K * 2; }
    __device__ __forceinline__ void idx_dma(const Unit& u, LAS unsigned* slot, int tidv, int wid) const {
        const int p0 = (u.pm - __builtin_amdgcn_readfirstlane(tb[u.e])) * 256, last = __builtin_amdgcn_readfirstlane(cn[u.e]) - 1; const int* tm = tokmap + (size_t)u.e * T;
#pragma unroll
        for (int h = 0; h < 2; ++h)
#pragma unroll
            for (int i = 0; i < 2; ++i) { int R_, C_; stage_rc(tidv * 16 + i * 8192, R_, C_); int pos = p0 + 128 * h + R_; pos = pos < last ? pos : last;
                __builtin_amdgcn_global_load_lds((const unsigned*)(tm + pos), slot + (h * 2 + i) * 512 + wid * 64, 4, 0, 0); }
    }
};

struct EpiStore {
    static constexpr bool PERM = true;
    bf16* O; int ldc;
    __device__ __forceinline__ void operator()(const f32x4 (&acc)[2][2][4][2], const Unit& u, int wr, int wc, int fr, int fq) const {
        const int row0 = u.pm * BM + wr * 64 + fr, col0 = u.pn * BM + wc * 32 + 8 * fq;
#pragma unroll
        for (int ai = 0; ai < 2; ++ai)
#pragma unroll
            for (int m = 0; m < 4; ++m) { bf16* rowp = O + (size_t)(row0 + ai * HALF + m * 16) * ldc + col0;
#pragma unroll
                for (int bj = 0; bj < 2; ++bj) { const f32x4 v0 = acc[ai][bj][m][0], v1 = acc[ai][bj][m][1];
                    u32x4 w; w.x = cvt_pk_bf16(v0[0], v0[1]); w.y = cvt_pk_bf16(v0[2], v0[3]); w.z = cvt_pk_bf16(v1[0], v1[1]); w.w = cvt_pk_bf16(v1[2], v1[3]);
                    *(u32x4*)(rowp + bj * HALF) = w; } }
    }
};
template <bool SRC_F32> struct EpiResid {
    static constexpr bool PERM = true;
    const float* srcL; const float* srcC; bf16* H; const float* gate;
    __device__ __forceinline__ void operator()(const f32x4 (&acc)[2][2][4][2], const Unit& u, int wr, int wc, int fr, int fq) const {
        const float* g = gate + (u.pm < 128 ? (u.pm >> 4) : 8) * 6144;
        const float* src = (u.pm < 128) ? srcL + (size_t)u.pm * 256 * 1024 : srcC + (size_t)(u.pm - 128) * 256 * 1024;
        bf16* dst = H + (size_t)u.pm * 256 * 1024;
        const int row0 = wr * 64 + fr, col0 = u.pn * BM + wc * 32 + 8 * fq;
        f32x4 gv[2][2];
#pragma unroll
        for (int bj = 0; bj < 2; ++bj)
#pragma unroll
            for (int n = 0; n < 2; ++n) gv[bj][n] = *(const f32x4*)(g + col0 + bj * HALF + 4 * n);
#pragma unroll
        for (int ai = 0; ai < 2; ++ai)
#pragma unroll
            for (int m = 0; m < 4; ++m) { const size_t ro = (size_t)(row0 + ai * HALF + m * 16) * 1024 + col0;
#pragma unroll
                for (int bj = 0; bj < 2; ++bj) {
                    f32x4 s0, s1;
                    if constexpr (SRC_F32) { s0 = __builtin_nontemporal_load((const f32x4*)(src + ro + bj * HALF)); s1 = __builtin_nontemporal_load((const f32x4*)(src + ro + bj * HALF + 4)); }
                    else { const u32x4 hv = *(const u32x4*)(dst + ro + bj * HALF); s0 = (f32x4){bflo(hv.x), bfhi(hv.x), bflo(hv.y), bfhi(hv.y)}; s1 = (f32x4){bflo(hv.z), bfhi(hv.z), bflo(hv.w), bfhi(hv.w)}; }
                    const f32x4 v0 = s0 + gv[bj][0] * acc[ai][bj][m][0], v1 = s1 + gv[bj][1] * acc[ai][bj][m][1];
                    u32x4 w; w.x = cvt_pk_bf16(v0[0], v0[1]); w.y = cvt_pk_bf16(v0[2], v0[3]); w.z = cvt_pk_bf16(v1[0], v1[1]); w.w = cvt_pk_bf16(v1[2], v1[3]);
                    *(u32x4*)(dst + ro + bj * HALF) = w; } }
    }
};
__device__ __forceinline__ float silu_f(float x) { return x * __builtin_amdgcn_rcpf(1.0f + __expf(-x)); }
struct EpiSwiglu {
    static constexpr bool PERM = true;
    bf16* H;
    __device__ __forceinline__ void operator()(const f32x4 (&acc)[2][2][4][2], const Unit& u, int wr, int wc, int fr, int fq) const {
        const int row0 = u.pm * BM + wr * 64 + fr, col0 = u.pn * 128 + wc * 32 + 8 * fq;
#pragma unroll
        for (int ai = 0; ai < 2; ++ai)
#pragma unroll
            for (int m = 0; m < 4; ++m) { bf16* p = H + (size_t)(row0 + ai * HALF + m * 16) * 512 + col0;
                const f32x4 g0 = acc[ai][0][m][0], g1 = acc[ai][0][m][1], u0 = acc[ai][1][m][0], u1 = acc[ai][1][m][1];
                u32x4 w; w.x = cvt_pk_bf16(silu_f(g0[0]) * u0[0], silu_f(g0[1]) * u0[1]); w.y = cvt_pk_bf16(silu_f(g0[2]) * u0[2], silu_f(g0[3]) * u0[3]);
                w.z = cvt_pk_bf16(silu_f(g1[0]) * u1[0], silu_f(g1[1]) * u1[1]); w.w = cvt_pk_bf16(silu_f(g1[2]) * u1[2], silu_f(g1[3]) * u1[3]);
                *(u32x4*)p = w; }
    }
};
__device__ __forceinline__ unsigned pk4_fp8(float a, float b, float c, float d) { int p = __builtin_amdgcn_cvt_pk_fp8_f32(a, b, 0, false); p = __builtin_amdgcn_cvt_pk_fp8_f32(c, d, p, true); return (unsigned)p; }
constexpr float W1_SCALE = 32.0f, W2_SCALE = 16.0f, HID_SCALE = 4.0f;
struct EpiSwiglu8 {
    static constexpr bool PERM = true;
    unsigned char* H; float in_scale;
    __device__ __forceinline__ void operator()(const f32x4 (&acc)[2][2][4][2], const Unit& u, int wr, int wc, int fr, int fq) const {
        const int row0 = u.pm * BM + wr * 64 + fr, col0 = u.pn * 128 + wc * 32 + 8 * fq;
        const float IS = 1.0f / in_scale, OS = HID_SCALE / in_scale;
#pragma unroll
        for (int ai = 0; ai < 2; ++ai)
#pragma unroll
            for (int m = 0; m < 4; ++m) { unsigned char* p = H + (size_t)(row0 + ai * HALF + m * 16) * 512 + col0;
                const f32x4 g0 = acc[ai][0][m][0] * IS, g1 = acc[ai][0][m][1] * IS, u0 = acc[ai][1][m][0] * OS, u1 = acc[ai][1][m][1] * OS;
#define HC8(x) __builtin_fminf(__builtin_fmaxf((x), -448.0f), 448.0f)
                u32x2 w; w.x = pk4_fp8(HC8(silu_f(g0[0]) * u0[0]), HC8(silu_f(g0[1]) * u0[1]), HC8(silu_f(g0[2]) * u0[2]), HC8(silu_f(g0[3]) * u0[3]));
                w.y = pk4_fp8(HC8(silu_f(g1[0]) * u1[0]), HC8(silu_f(g1[1]) * u1[1]), HC8(silu_f(g1[2]) * u1[2]), HC8(silu_f(g1[3]) * u1[3]));
#undef HC8
                *(u32x2*)p = w; }
    }
};
constexpr float OS_SCALE = 16.0f;
struct EpiStoreF8 {
    static constexpr bool PERM = true;
    unsigned char* O; int ldc; float scale;
    __device__ __forceinline__ void operator()(const f32x4 (&acc)[2][2][4][2], const Unit& u, int wr, int wc, int fr, int fq) const {
        const int row0 = u.pm * BM + wr * 64 + fr, col0 = u.pn * BM + wc * 32 + 8 * fq;
#pragma unroll
        for (int ai = 0; ai < 2; ++ai)
#pragma unroll
            for (int m = 0; m < 4; ++m) { unsigned char* rowp = O + (size_t)(row0 + ai * HALF + m * 16) * ldc + col0;
#pragma unroll
                for (int bj = 0; bj < 2; ++bj) { const f32x4 v0 = acc[ai][bj][m][0] * scale, v1 = acc[ai][bj][m][1] * scale;
#define HC8(x) __builtin_fminf(__builtin_fmaxf((x), -448.0f), 448.0f)
                    u32x2 w; w.x = pk4_fp8(HC8(v0[0]), HC8(v0[1]), HC8(v0[2]), HC8(v0[3])); w.y = pk4_fp8(HC8(v1[0]), HC8(v1[1]), HC8(v1[2]), HC8(v1[3]));
#undef HC8
                    *(u32x2*)(rowp + bj * HALF) = w; } }
    }
};
struct EpiStoreS {
    static constexpr bool PERM = true;
    bf16* O; int ldc; float scale;
    __device__ __forceinline__ void operator()(const f32x4 (&acc)[2][2][4][2], const Unit& u, int wr, int wc, int fr, int fq) const {
        const int row0 = u.pm * BM + wr * 64 + fr, col0 = u.pn * BM + wc * 32 + 8 * fq;
#pragma unroll
        for (int ai = 0; ai < 2; ++ai)
#pragma unroll
            for (int m = 0; m < 4; ++m) { bf16* rowp = O + (size_t)(row0 + ai * HALF + m * 16) * ldc + col0;
#pragma unroll
                for (int bj = 0; bj < 2; ++bj) { const f32x4 v0 = acc[ai][bj][m][0] * scale, v1 = acc[ai][bj][m][1] * scale;
                    u32x4 w; w.x = cvt_pk_bf16(v0[0], v0[1]); w.y = cvt_pk_bf16(v0[2], v0[3]); w.z = cvt_pk_bf16(v1[0], v1[1]); w.w = cvt_pk_bf16(v1[2], v1[3]);
                    *(u32x4*)(rowp + bj * HALF) = w; } }
    }
};
struct EpiScaleRow {
    static constexpr bool PERM = true;
    bf16* O; const float* wrow;
    __device__ __forceinline__ void operator()(const f32x4 (&acc)[2][2][4][2], const Unit& u, int wr, int wc, int fr, int fq) const {
        const int row0 = u.pm * BM + wr * 64 + fr, col0 = u.pn * BM + wc * 32 + 8 * fq;
#pragma unroll
        for (int ai = 0; ai < 2; ++ai)
#pragma unroll
            for (int m = 0; m < 4; ++m) { const int row = row0 + ai * HALF + m * 16; const float s = wrow[row]; bf16* rowp = O + (size_t)row * 1024 + col0;
#pragma unroll
                for (int bj = 0; bj < 2; ++bj) { const f32x4 v0 = acc[ai][bj][m][0] * s, v1 = acc[ai][bj][m][1] * s;
                    u32x4 w; w.x = cvt_pk_bf16(v0[0], v0[1]); w.y = cvt_pk_bf16(v0[2], v0[3]); w.z = cvt_pk_bf16(v1[0], v1[1]); w.w = cvt_pk_bf16(v1[2], v1[3]);
                    *(u32x4*)(rowp + bj * HALF) = w; } }
    }
};
}

struct Args { const float* in[22]; float* out; unsigned char* ws; int ph_lo, ph_hi; };
enum { I_X = 0, I_C, I_CTX, I_CCTX, I_ADAW, I_ADAB, I_NMG, I_NFG, I_EWIN, I_ECONV, I_EWOUT, I_OWIN, I_OPOOLW, I_OPOOLS, I_OSINK, I_OWOUT, I_RW, I_RB, I_MG, I_MU, I_MD, I_FG };

struct Frame {
    LAS unsigned char* lds;
    int tid, lane, wave, vcu, G;
    unsigned char* ws; const float* const* in; float* out;
};
__device__ __forceinline__ bf16* h_row(const Frame& F, int t) { return (bf16*)(F.ws + WS_HB) + (size_t)t * D; }
__device__ __forceinline__ int mod_row(int t) { return t < TL ? (t >> 12) : 8; }

struct TItem { const float* src; bf16* dst; int ldw, ldd; float f8scale; };
__device__ __forceinline__ void titem_load(const TItem& t, f32x4 (&r)[8], int lane) {
#pragma unroll
    for (int i = 0; i < 8; ++i) r[i] = __builtin_nontemporal_load((const f32x4*)(t.src + (size_t)((lane >> 3) + 8 * i) * t.ldw + 4 * (lane & 7)));
}
__device__ __forceinline__ void titem_process(const TItem& t, const f32x4 (&r)[8], LAS float* scr, int lane) {
#pragma unroll
    for (int i = 0; i < 8; ++i) { LAS float* d = scr + ((lane >> 3) + 8 * i) * 33 + 4 * (lane & 7); d[0] = r[i].x; d[1] = r[i].y; d[2] = r[i].z; d[3] = r[i].w; }
    LDS_WAIT(); asm volatile("" ::: "memory");
    const int c = lane & 7;
    if (t.f8scale != 0.0f) {
        const float sc = t.f8scale; unsigned char* d8 = (unsigned char*)t.dst;
#pragma unroll
        for (int j = 0; j < 4; ++j) { const int n = (lane >> 3) + 8 * j; const LAS float* s = scr + (8 * c) * 33 + n;
            u32x2 o; o.x = pg8::pk4_fp8(s[0 * 33] * sc, s[1 * 33] * sc, s[2 * 33] * sc, s[3 * 33] * sc); o.y = pg8::pk4_fp8(s[4 * 33] * sc, s[5 * 33] * sc, s[6 * 33] * sc, s[7 * 33] * sc);
            *(u32x2*)(d8 + (size_t)n * t.ldd + 8 * c) = o; }
    } else {
#pragma unroll
        for (int j = 0; j < 4; ++j) { const int n = (lane >> 3) + 8 * j; const LAS float* s = scr + (8 * c) * 33 + n;
            u32x4 o; o.x = pk2(s[0 * 33], s[1 * 33]); o.y = pk2(s[2 * 33], s[3 * 33]); o.z = pk2(s[4 * 33], s[5 * 33]); o.w = pk2(s[6 * 33], s[7 * 33]);
            *(u32x4*)(t.dst + (size_t)n * t.ldd + 8 * c) = o; }
    }
    LDS_WAIT(); asm volatile("" ::: "memory");
}
constexpr int L0T_N = 32;
constexpr int TS0 = 1024, TS1 = 512, TS2 = 384, TS3 = 512, TS4 = 0, TS5 = 4096, TS6 = 4096, TS7 = 4096, TNITEMS = TS0 + TS1 + TS2 + TS3 + TS4 + TS5 + TS6 + TS7;
__device__ __forceinline__ TItem titem_moe(const float* const* in, unsigned char* ws, int kind, int le, int rr) {
    TItem t; const int layer = le >> 4, e = le & 15; const bool f8 = (kind < 2) ? (layer ? (FP8_G1_L1 != 0) : (FP8_G1_L0 != 0)) : (layer ? (FP8_G2_L1 != 0) : (FP8_G2_L0 != 0));
    if (kind < 2) { const int kb = (rr >> 4) & 15, nb = rr & 15, n0 = nb * 32; const int drow = (n0 >> 7) * 256 + (n0 & 127) + kind * 128;
        t.src = in[kind ? I_MU : I_MG] + (size_t)le * 524288 + (size_t)(kb * 64) * 512 + n0; t.ldw = 512;
        unsigned char* base = ws + WS_W_M1 + (size_t)layer * 32 * MiB;
        if (f8) { t.dst = (bf16*)(base + (size_t)e * MiB + (size_t)drow * 1024 + kb * 64); t.ldd = 1024; t.f8scale = pg8::W1_SCALE; }
        else { t.dst = (bf16*)(base + (size_t)e * 2 * MiB) + (size_t)drow * 1024 + kb * 64; t.ldd = 1024; t.f8scale = 0.0f; } }
    else { const int kb = (rr >> 5) & 7, nb = rr & 31;
        t.src = in[I_MD] + (size_t)le * 524288 + (size_t)(kb * 64) * 1024 + nb * 32; t.ldw = 1024;
        unsigned char* base = ws + WS_W_M2 + (size_t)layer * 16 * MiB;
        if (f8) { t.dst = (bf16*)(base + (size_t)e * 512 * KiB + (size_t)(nb * 32) * 512 + kb * 64); t.ldd = 512; t.f8scale = pg8::W2_SCALE; }
        else { t.dst = (bf16*)(base + (size_t)e * MiB) + (size_t)(nb * 32) * 512 + kb * 64; t.ldd = 512; t.f8scale = 0.0f; } }
    return t;
}
__device__ __forceinline__ TItem titem_decode(const float* const* in, unsigned char* ws, int r) {
    TItem t;
    if (r < TS0) { const int kb = r / 64, nb = r % 64; t.src = in[I_EWIN] + (size_t)(kb * 64) * 2048 + nb * 32; t.ldw = 2048; t.dst = (bf16*)(ws + WS_W_EIN) + (size_t)(nb * 32) * 1024 + kb * 64; t.ldd = 1024; t.f8scale = 0.0f; return t; } r -= TS0;
    if (r < TS1) { const int kb = r / 32, nb = r % 32; t.src = in[I_EWOUT] + (size_t)(kb * 64) * 1024 + nb * 32; t.ldw = 1024; t.dst = (bf16*)(ws + WS_W_EOUT) + (size_t)(nb * 32) * 1024 + kb * 64; t.ldd = 1024; t.f8scale = 0.0f; return t; } r -= TS1;
    if (r < TS2) { const int kb = r / 24, nb = 16 + r % 24; t.src = in[I_OWIN] + (size_t)(kb * 64) * 1280 + nb * 32; t.ldw = 1280; t.dst = (bf16*)(ws + WS_W_OIN) + (size_t)(nb * 32) * 1024 + kb * 64; t.ldd = 1024; t.f8scale = 0.0f; return t; } r -= TS2;
    if (r < TS3) { const int kb = r / 32, nb = r % 32; t.src = in[I_OWOUT] + (size_t)(kb * 64) * 1024 + nb * 32; t.ldw = 1024; t.dst = (bf16*)(ws + WS_W_OOUT) + (size_t)(nb * 32) * 1024 + kb * 64; t.ldd = 1024; t.f8scale = 0.0f; return t; } r -= TS3;
    r += 192 * L0T_N;
    if (r < TS5 + TS6 + TS7) return titem_moe(in, ws, r / 4096, (r % 4096) >> 8, r % 256);
    return t;
}
constexpr int NL1 = 12288;
__device__ __forceinline__ TItem titem_l1(const float* const* in, unsigned char* ws, int r) { return titem_moe(in, ws, r / 4096, 16 + ((r % 4096) >> 8), r % 256); }
__device__ __forceinline__ TItem titem_lx(const float* const* in, unsigned char* ws, int layer, int r) { return titem_moe(in, ws, r / 4096, layer * 16 + ((r % 4096) >> 8), r % 256); }

constexpr size_t WS_CONVCTR = 20 * KiB;
__device__ __forceinline__ void convert_l1(Frame& F, int quota) {
    unsigned* ctr = (unsigned*)(F.ws + WS_CONVCTR);
    LAS float* scr = (LAS float*)(F.lds + F.wave * 17408);
    for (int ch = 0; ch < quota; ++ch) {
        const int c0 = __builtin_amdgcn_readfirstlane(F.lane == 0 ? (int)__hip_atomic_fetch_add(ctr, 4u, __ATOMIC_RELAXED, __HIP_MEMORY_SCOPE_AGENT) : 0);
        if (c0 >= NL1) break;
        f32x4 cur[8], nxt[8];
        TItem tc = titem_l1(F.in, F.ws, c0);
        titem_load(tc, nxt, F.lane);
#pragma unroll 1
        for (int i = 0; i < 4; ++i) {
#pragma unroll
            for (int j = 0; j < 8; ++j) cur[j] = nxt[j];
            const TItem tcur = tc;
            if (i < 3) { tc = titem_l1(F.in, F.ws, c0 + i + 1); titem_load(tc, nxt, F.lane); }
            titem_process(tcur, cur, scr, F.lane);
        }
    }
}
__device__ __forceinline__ void convert_l1_range(Frame& F, const int base, const int cnt, const int ctr_off, const int layer = 1) {
    LAS unsigned* ctr = (LAS unsigned*)(F.lds + LDS_CTL + ctr_off);
    LAS float* scr = (LAS float*)(F.lds + F.wave * 17408);
    f32x4 cur[8], nxt[8];
    int it = __builtin_amdgcn_readfirstlane(F.lane == 0 ? (int)atomicAdd((unsigned*)ctr, 1u) : 0);
    TItem tc = titem_lx(F.in, F.ws, layer, base + (it < cnt ? it : 0));
    if (it < cnt) titem_load(tc, nxt, F.lane);
    while (it < cnt) {
#pragma unroll
        for (int i = 0; i < 8; ++i) cur[i] = nxt[i];
        const TItem tcur = tc;
        const int itn = __builtin_amdgcn_readfirstlane(F.lane == 0 ? (int)atomicAdd((unsigned*)ctr, 1u) : 0);
        if (itn < cnt) { tc = titem_lx(F.in, F.ws, layer, base + itn); titem_load(tc, nxt, F.lane); }
        titem_process(tcur, cur, scr, F.lane);
        it = itn;
    }
}
constexpr int L1T_N = 64, L1A_N = 18;
static_assert(120 * L1T_N + 256 * L1A_N == NL1, "layer-1 conversion split");
__device__ __forceinline__ void tail_fill(Frame& F, int nUnits, int quota) {
    const int rounds = (nUnits + F.G - 1) / F.G;
    if ((rounds - 1) * F.G + F.vcu >= nUnits) convert_l1(F, quota);
}

__device__ __forceinline__ void norm_mod_store(const f32x4 (&v)[4], const float* g, const float* shift, const float* scale, bf16* orow, int lane) {
    float s2 = 0.f;
#pragma unroll
    for (int j = 0; j < 4; ++j) s2 += (v[j].x * v[j].x + v[j].y * v[j].y) + (v[j].z * v[j].z + v[j].w * v[j].w);
    const float rstd = 1.0f / sqrtf(wave_sum(s2) * (1.0f / D) + EPS);
#pragma unroll
    for (int j = 0; j < 4; ++j) { const int c = 4 * lane + 256 * j;
        const f32x4 gg = *(const f32x4*)(g + c), sh = *(const f32x4*)(shift + c), sc = *(const f32x4*)(scale + c);
        const f32x4 y = v[j] * rstd * gg * (sc + 1.0f) + sh;
        u32x2 o; o.x = pk2(y.x, y.y); o.y = pk2(y.z, y.w);
        *(u32x2*)(orow + c) = o; }
}

template <int NQ> __device__ __forceinline__ void p1_tokens(Frame& F, int t) {
    const float* mods = (const float*)(F.ws + WS_MODS);
    bf16* A = (bf16*)(F.ws + WS_BUFA);
    f32x4 v[NQ][4];
#pragma unroll
    for (int q = 0; q < NQ; ++q) { const int tq = t + q; const float* xr = tq < TL ? F.in[I_X] + (size_t)tq * D : F.in[I_CTX] + (size_t)(tq - TL) * D;
#pragma unroll
        for (int j = 0; j < 4; ++j) v[q][j] = __builtin_nontemporal_load((const f32x4*)(xr + 4 * F.lane + 256 * j)); }
    const float* m = mods + (size_t)mod_row(t) * 6144;
#pragma unroll
    for (int q = 0; q < NQ; ++q) norm_mod_store(v[q], F.in[I_NMG], m, m + 1024, A + (size_t)(t + q) * D, F.lane);
}
__device__ __forceinline__ void phase_mods(Frame& F) {
    const float* const* in = F.in;
    LAS float* S = (LAS float*)F.lds;
    LAS float* red = S + 9 * 1024;
    for (int i = F.tid; i < 9 * 1024; i += 512) { const float v = (i < 8192) ? in[I_C][i] : in[I_CCTX][i - 8192]; S[i] = v / (1.0f + expf(-v)); }
    __syncthreads();
    const int bx = blockIdx.x, layer = bx >> 7, col0 = (bx & 127) * 48;
    const int j = F.tid % 12, rg = F.tid / 12;
    if (rg < 42) {
        const float* W = in[I_ADAW] + (size_t)layer * 1024 * 6144 + col0 + 4 * j;
        f32x4 w[25];
#pragma unroll
        for (int i = 0; i < 25; ++i) { const int k = rg + 42 * i; w[i] = (k < 1024) ? __builtin_nontemporal_load((const f32x4*)(W + (size_t)k * 6144)) : (f32x4){0.f, 0.f, 0.f, 0.f}; }
        f32x4 acc[9];
#pragma unroll
        for (int r = 0; r < 9; ++r) acc[r] = (f32x4){0.f, 0.f, 0.f, 0.f};
#pragma unroll
        for (int i = 0; i < 25; ++i) { const int k = min(rg + 42 * i, 1023);
#pragma unroll
            for (int r = 0; r < 9; ++r) acc[r] += w[i] * S[r * 1024 + k]; }
#pragma unroll
        for (int r = 0; r < 9; ++r) *(LAS f32x4*)(red + (rg * 9 + r) * 48 + 4 * j) = acc[r];
    }
    __syncthreads();
    for (int i = F.tid; i < 432; i += 512) { const int r = i / 48, c = i % 48; float sum = in[I_ADAB][layer * 6144 + col0 + c];
        for (int g = 0; g < 42; ++g) sum += red[(g * 9 + r) * 48 + c];
        __hip_atomic_store((unsigned*)(F.ws + WS_MODS) + (layer * 9 + r) * 6144 + col0 + c, __builtin_bit_cast(unsigned, sum), __ATOMIC_RELAXED, __HIP_MEMORY_SCOPE_AGENT); }
    asm volatile("s_waitcnt vmcnt(0)" ::: "memory");
    __syncthreads();
    if (F.tid == 0) __hip_atomic_fetch_add((unsigned*)(F.ws + WS_MODSDONE), 1u, __ATOMIC_RELAXED, __HIP_MEMORY_SCOPE_AGENT);
}
__device__ __forceinline__ void mods_wait(Frame& F) {
    if (F.tid < 64) {
        unsigned* cnt = (unsigned*)(F.ws + WS_MODSDONE); unsigned spins = 0;
        while ((unsigned)__builtin_amdgcn_readfirstlane(__hip_atomic_load(cnt, __ATOMIC_RELAXED, __HIP_MEMORY_SCOPE_AGENT)) < (unsigned)F.G) {
            __builtin_amdgcn_s_sleep(2); if (++spins > (1u << 22)) break; }
        __builtin_amdgcn_fence(__ATOMIC_ACQUIRE, "agent");
        asm volatile("s_waitcnt vmcnt(0)" ::: "memory");
    }
    __syncthreads();
}

__device__ __forceinline__ void ctr_publish(Frame& F, size_t off, int slot, unsigned nx) {
    asm volatile("s_waitcnt vmcnt(0)" ::: "memory");
    __syncthreads();
    if (F.tid == 0) {
        unsigned* top = (unsigned*)(F.ws + off);
        if (nx == 0u) { __builtin_amdgcn_fence(__ATOMIC_RELEASE, "agent"); asm volatile("s_waitcnt vmcnt(0)" ::: "memory"); __hip_atomic_fetch_add(top, 1u, __ATOMIC_RELAXED, __HIP_MEMORY_SCOPE_AGENT); }
        else {
            unsigned* xw = (unsigned*)(F.ws + WS_XARR) + ((size_t)slot * 16 + xb_xcc_id()) * 64;
            const unsigned old = __hip_atomic_fetch_add(xw, 1u, __ATOMIC_RELAXED, __HIP_MEMORY_SCOPE_AGENT);
            if (old + 1u == nx) { __builtin_amdgcn_fence(__ATOMIC_RELEASE, "agent"); asm volatile("s_waitcnt vmcnt(0)" ::: "memory"); __hip_atomic_fetch_add(top, nx, __ATOMIC_RELAXED, __HIP_MEMORY_SCOPE_AGENT); }
        }
    }
}
__device__ __forceinline__ void ctr_wait(Frame& F, size_t off, unsigned need) {
    if (F.tid < 64) {
        unsigned* cnt = (unsigned*)(F.ws + off); unsigned spins = 0;
        while ((unsigned)__builtin_amdgcn_readfirstlane(__hip_atomic_load(cnt, __ATOMIC_RELAXED, __HIP_MEMORY_SCOPE_AGENT)) < need) {
            __builtin_amdgcn_s_sleep(2); if (++spins > (1u << 22)) break; }
        __builtin_amdgcn_fence(__ATOMIC_ACQUIRE, "agent");
        asm volatile("s_waitcnt vmcnt(0)" ::: "memory");
    }
    __syncthreads();
}

template <class P> __device__ __forceinline__ unsigned xcd_census(const Frame& F, P pred) {
    if (__builtin_amdgcn_readfirstlane(*(const LAS int*)(F.lds + LDS_CTL + 52)) == 0) return 0u;
    const unsigned myx = xb_xcc_id();
    unsigned c = 0;
#pragma unroll
    for (int k = 0; k < 4; ++k) { const int v = F.lane + 64 * k; const unsigned x = (unsigned)ld_coh((const int*)(F.ws + WS_XCDOF) + v);
        c += (unsigned)__builtin_popcountll(__builtin_amdgcn_ballot_w64(x == myx && pred(v))); }
    return c;
}

__device__ __forceinline__ void phase_prologue_a(Frame& F) {
    const float* const* in = F.in;
    unsigned char* ws = F.ws;
    LAS float* ldsf = (LAS float*)F.lds;
    phase_mods(F);
    __syncthreads();
    {
        const int gt = blockIdx.x * 512 + F.tid, NT = F.G * 512;
        float* rope = (float*)(ws + WS_ROPE);
        for (int i = gt; i < 1024; i += NT) { const int coord = i >> 4, q = i & 15; const float inv = powf(10000.0f, -(float)q / 16.0f); const float ang = (float)coord * inv;
            rope[i] = cosf(ang); rope[1024 + i] = sinf(ang); }
        bf16* WA = (bf16*)(ws + WS_WA);
        for (int i = gt; i < 128 * 128; i += NT) { const int m = i >> 7, k = i & 127, rp = m >> 6, j1 = m & 63, ri = k >> 6, n1 = k & 63;
            const float a = 2.0f * (float)((j1 * n1) & 63) / 64.0f; const float c = cospif(a), s = sinpif(a);
            const float v = (rp == 0) ? (ri == 0 ? c : s) : (ri == 0 ? -s : c); WA[i] = (bf16)f2bf(v); }
        bf16* WAC = (bf16*)(ws + WS_WAC);
        for (int i = gt; i < 32 * 32; i += NT) { const int m = i >> 5, k = i & 31, rp = m >> 4, j1 = m & 15, ri = k >> 4, n1 = k & 15;
            const float a = 2.0f * (float)((j1 * n1) & 15) / 16.0f; const float c = cospif(a), s = sinpif(a);
            const float v = (rp == 0) ? (ri == 0 ? c : s) : (ri == 0 ? -s : c); WAC[i] = (bf16)f2bf(v); }
        bf16* WC = (bf16*)(ws + WS_WC);
        for (int i = gt; i < 64 * 64 * 128; i += NT) { const int j1 = i >> 13, j2 = (i >> 7) & 63, k = i & 127, ri = k >> 6, n2 = k & 63;
            const float a = 2.0f * (float)((n2 * (j1 + 64 * j2)) & 4095) / 4096.0f; const float v = (ri == 0 ? cospif(a) : sinpif(a)) * (1.0f / 64.0f); WC[i] = (bf16)f2bf(v); }
        bf16* FD = (bf16*)(ws + WS_FD);
        for (int i = gt; i < 256 * 128; i += NT) { const int col = i >> 7, c = i & 127, ri = col >> 7, k2 = col & 127;
            const float a = 2.0f * (float)((c * k2) & 127) / 128.0f; const float v = (ri == 0 ? cospif(a) : -sinpif(a)) * 0.08838834764831845f; FD[i] = (bf16)f2bf(v); }
        bf16* WCC = (bf16*)(ws + WS_WCC);
        for (int i = gt; i < 16 * 16 * 32; i += NT) { const int j1 = i >> 9, j2 = (i >> 5) & 15, k = i & 31, ri = k >> 4, n2 = k & 15;
            const float a = 2.0f * (float)((n2 * (j1 + 16 * j2)) & 255) / 256.0f; const float v = (ri == 0 ? cospif(a) : sinpif(a)) * (1.0f / 16.0f); WCC[i] = (bf16)f2bf(v); }
    }
    LAS float* tw = (LAS float*)(F.lds + 139264);
    if (F.tid < 128) { const float a = 2.0f * (float)F.tid / 128.0f; tw[F.tid] = cospif(a); tw[128 + F.tid] = sinpif(a); }
    __syncthreads();
    LAS float* scr = (LAS float*)(F.lds + F.wave * 17408);
    const int gw = F.vcu * NWAVES + F.wave, NGW = F.G * NWAVES;
    const int fid = F.vcu * 2 + F.wave;
    if (F.wave < 2) { const int r = fid;
        const int g = r >> 7, db = (r >> 5) & 3, kb = r & 31, k0 = kb * 32, d0 = db * 32;
        const float* Wp = in[I_OWIN] + (size_t)k0 * 1280 + g * 128;
        { float tl[32][2];
#pragma unroll
          for (int rr = 0; rr < 32; ++rr) { tl[rr][0] = Wp[(size_t)rr * 1280 + F.lane]; tl[rr][1] = Wp[(size_t)rr * 1280 + 64 + F.lane]; }
#pragma unroll
          for (int rr = 0; rr < 32; ++rr) { scr[rr * 129 + F.lane] = tl[rr][0]; scr[rr * 129 + 64 + F.lane] = tl[rr][1]; } }
        LDS_WAIT(); asm volatile("" ::: "memory");
        const int k = F.lane & 31, oh = F.lane >> 5;
        const float* pw = in[I_OPOOLW] + (size_t)g * 16384 + d0 + 16 * oh;
        float acc[16];
#pragma unroll
        for (int t = 0; t < 16; ++t) acc[t] = 0.f;
        for (int c0 = 0; c0 < 128; c0 += 8) {
            f32x4 p[8][4];
#pragma unroll
            for (int cc = 0; cc < 8; ++cc)
#pragma unroll
                for (int j = 0; j < 4; ++j) p[cc][j] = *(const f32x4*)(pw + (c0 + cc) * 128 + 4 * j);
#pragma unroll
            for (int cc = 0; cc < 8; ++cc) { const float w = scr[k * 129 + c0 + cc];
#pragma unroll
                for (int j = 0; j < 4; ++j) { acc[4 * j] += w * p[cc][j].x; acc[4 * j + 1] += w * p[cc][j].y; acc[4 * j + 2] += w * p[cc][j].z; acc[4 * j + 3] += w * p[cc][j].w; } }
        }
        const float* psc = in[I_OPOOLS] + g * 128 + d0 + 16 * oh;
        bf16* dst = (bf16*)(ws + WS_W_OIN) + (size_t)(g * 128 + d0 + 16 * oh) * 1024 + k0 + k;
#pragma unroll
        for (int t = 0; t < 16; ++t) dst[(size_t)t * 1024] = (bf16)f2bf(acc[t] * psc[t]);
        LDS_WAIT(); asm volatile("" ::: "memory");
    }
    {
        LAS unsigned* ctr = (LAS unsigned*)(F.lds + LDS_CTL + 32);
        constexpr int TP1 = TS0 + TS1 + TS2 + TS3 + (12288 - 192 * L0T_N), PER = (TP1 + 255) / 256;
        const int base = F.vcu * PER, lim = max(0, min(PER, TP1 - base));
        f32x4 cur[8], nxt[8];
        int it = __builtin_amdgcn_readfirstlane(F.lane == 0 ? (int)atomicAdd((unsigned*)ctr, 1u) : 0);
        TItem tc = titem_decode(in, ws, base + (it < lim ? it : 0));
        if (it < lim) titem_load(tc, nxt, F.lane);
        while (it < lim) {
#pragma unroll
            for (int i = 0; i < 8; ++i) cur[i] = nxt[i];
            const TItem tcur = tc;
            const int itn = __builtin_amdgcn_readfirstlane(F.lane == 0 ? (int)atomicAdd((unsigned*)ctr, 1u) : 0);
            if (itn < lim) { tc = titem_decode(in, ws, base + itn); titem_load(tc, nxt, F.lane); }
            titem_process(tcur, cur, scr, F.lane);
            it = itn;
        }
    }
    mods_wait(F);
    {
        LAS unsigned* ctr2 = (LAS unsigned*)(F.lds + LDS_CTL + 36);
        for (;;) {
            const int it = __builtin_amdgcn_readfirstlane(F.lane == 0 ? (int)atomicAdd((unsigned*)ctr2, 1u) : 0);
            if (it >= 40) break;
            if (it < 32) p1_tokens<4>(F, 4 * (32 * (int)blockIdx.x + it)); else p1_tokens<1>(F, TL + 8 * (int)blockIdx.x + (it - 32));
        }
    }
}

struct DftP { const bf16* dbase; size_t dstride; const bf16* W; bf16* obase; size_t ostride; };
template <int MODE> __device__ __forceinline__ DftP dft_params(const Frame& F, int u) {
    const bf16* P = (const bf16*)(F.ws + WS_BUFP); bf16* Z = (bf16*)(F.ws + WS_BUFZ); bf16* MIX = (bf16*)(F.ws + WS_BUFA);
    DftP p;
    if constexpr (MODE == 0) { const int chunk = u & 3, n2 = (u >> 2) & 63, b = u >> 8;
        p.dbase = P + (size_t)(b * 4096 + n2) * EIN + chunk * 128; p.dstride = (size_t)64 * EIN; p.W = (const bf16*)(F.ws + WS_WA);
        p.obase = Z + (size_t)((b * 64) * 64 + n2) * 1024 + chunk * 128; p.ostride = (size_t)64 * 1024; }
    if constexpr (MODE == 1) { const int chunk = u & 3, n2 = (u >> 2) & 15, b = u >> 6;
        p.dbase = P + (size_t)(TL + b * 256 + n2) * EIN + chunk * 128; p.dstride = (size_t)16 * EIN; p.W = (const bf16*)(F.ws + WS_WAC);
        p.obase = Z + (size_t)(TL + (b * 16) * 16 + n2) * 1024 + chunk * 128; p.ostride = (size_t)16 * 1024; }
    if constexpr (MODE == 2) { const int chunk = u & 3, j1 = (u >> 2) & 63, b = u >> 8;
        p.dbase = Z + (size_t)((b * 64 + j1) * 64) * 1024 + chunk * 128; p.dstride = (size_t)1024; p.W = (const bf16*)(F.ws + WS_WC) + (size_t)j1 * 64 * 128;
        p.obase = MIX + (size_t)(b * 4096 + j1) * D + chunk * 128; p.ostride = (size_t)64 * D; }
    if constexpr (MODE == 3) { const int chunk = u & 3, j1 = (u >> 2) & 15, b = u >> 6;
        p.dbase = Z + (size_t)(TL + (b * 16 + j1) * 16) * 1024 + chunk * 128; p.dstride = (size_t)1024; p.W = (const bf16*)(F.ws + WS_WCC) + (size_t)j1 * 16 * 32;
        p.obase = MIX + (size_t)(TL + b * 256 + j1) * D + chunk * 128; p.ostride = (size_t)16 * D; }
    return p;
}
template <int MODE, int KD, int MD, int J>
__device__ __forceinline__ void dft_units(Frame& F, int nunits) {
    constexpr int LD = KD + 8;
    constexpr int NP = (KD * 16 + 511) / 512;
    constexpr int GM = KD / 8 - 1;
    LAS bf16* DT = (LAS bf16*)F.lds;
    u32x4 pre[NP];
    int u = F.vcu;
    if (u < nunits) { const DftP p = dft_params<MODE>(F, u);
#pragma unroll
        for (int i = 0; i < NP; ++i) { const int pc = F.tid + 512 * i; if (pc < KD * 16) { const int k = pc >> 4, c8 = pc & 15, ri = k / (KD / 2), nn = k % (KD / 2);
            pre[i] = __builtin_nontemporal_load((const u32x4*)(p.dbase + (size_t)nn * p.dstride + ri * 512 + c8 * 8)); } } }
    const int a = F.lane & 15, q = F.lane >> 4;
    for (; u < nunits; u += F.G) {
        const DftP p = dft_params<MODE>(F, u);
#pragma unroll
        for (int i = 0; i < NP; ++i) { const int pc = F.tid + 512 * i; if (pc < KD * 16) { const int k = pc >> 4, c8 = pc & 15; const u32x4 v = pre[i];
            LAS bf16* d = DT + (c8 * 8) * LD + (k ^ ((c8 & GM) << 3));
            d[0 * LD] = (bf16)(v.x & 0xffff); d[1 * LD] = (bf16)(v.x >> 16); d[2 * LD] = (bf16)(v.y & 0xffff); d[3 * LD] = (bf16)(v.y >> 16);
            d[4 * LD] = (bf16)(v.z & 0xffff); d[5 * LD] = (bf16)(v.z >> 16); d[6 * LD] = (bf16)(v.w & 0xffff); d[7 * LD] = (bf16)(v.w >> 16); } }
        __syncthreads();
        if (u + F.G < nunits) { const DftP pn = dft_params<MODE>(F, u + F.G);
#pragma unroll
            for (int i = 0; i < NP; ++i) { const int pc = F.tid + 512 * i; if (pc < KD * 16) { const int k = pc >> 4, c8 = pc & 15, ri = k / (KD / 2), nn = k % (KD / 2);
                pre[i] = __builtin_nontemporal_load((const u32x4*)(pn.dbase + (size_t)nn * pn.dstride + ri * 512 + c8 * 8)); } } }
        for (int task = F.wave; task < (MD / 16) * 2; task += NWAVES) {
            const int mt = task >> 1, cht = task & 1;
            f32x4 acc[4];
#pragma unroll
            for (int ct = 0; ct < 4; ++ct) acc[ct] = (f32x4){0.f, 0.f, 0.f, 0.f};
#pragma unroll
            for (int ks = 0; ks < KD / 32; ++ks) {
                const bf16x8 bw = *(const bf16x8*)(p.W + (size_t)(mt * 16 + a) * KD + ks * 32 + 8 * q);
#pragma unroll
                for (int ct = 0; ct < 4; ++ct) {
                    const int ch = cht * 64 + 16 * (a >> 2) + 4 * ct + (a & 3);
                    const bf16x8 av = *(const LAS bf16x8*)(DT + ch * LD + ((ks * 32 + 8 * q) ^ (((ch >> 3) & GM) << 3)));
                    acc[ct] = __builtin_amdgcn_mfma_f32_16x16x32_bf16(av, bw, acc[ct], 0, 0, 0);
                }
            }
            const int m = mt * 16 + a, rm = m / J, j = m % J;
            bf16* o = p.obase + (size_t)j * p.ostride + rm * 512 + cht * 64 + 16 * q;
            u32x4 w0, w1;
            w0.x = pk2(acc[0][0], acc[0][1]); w0.y = pk2(acc[0][2], acc[0][3]); w0.z = pk2(acc[1][0], acc[1][1]); w0.w = pk2(acc[1][2], acc[1][3]);
            w1.x = pk2(acc[2][0], acc[2][1]); w1.y = pk2(acc[2][2], acc[2][3]); w1.z = pk2(acc[3][0], acc[3][1]); w1.w = pk2(acc[3][2], acc[3][3]);
            *(u32x4*)o = w0; *(u32x4*)(o + 8) = w1;
        }
        __syncthreads();
    }
}

template <int MODE, int NR>
__device__ __forceinline__ void dft_units_a(Frame& F, int nunits) {
    constexpr int KD = 2 * NR, MD = 2 * NR, J = NR, LD = KD + 8, GM = KD / 8 - 1, ULD = 136;
    constexpr int NP = (NR * 16 + 511) / 512;
    LAS bf16* FDl = (LAS bf16*)F.lds; LAS bf16* U = (LAS bf16*)(F.lds + 69632); LAS bf16* DT = (LAS bf16*)(F.lds + 69632 + 64 * ULD * 2);
    { const bf16* FD = (const bf16*)(F.ws + WS_FD);
      for (int p = F.tid; p < 256 * 16; p += 512) { const int r = p >> 4, c8 = p & 15; *(LAS u32x4*)(FDl + r * ULD + 8 * c8) = *(const u32x4*)(FD + r * 128 + 8 * c8); } }
    u32x4 pre[NP];
    int u = F.vcu;
    if (u < nunits) { const DftP p = dft_params<MODE>(F, u);
#pragma unroll
        for (int i = 0; i < NP; ++i) { const int pc = F.tid + 512 * i; if (pc < NR * 16) pre[i] = __builtin_nontemporal_load((const u32x4*)(p.dbase + (size_t)(pc >> 4) * p.dstride + (pc & 15) * 8)); } }
    const int a = F.lane & 15, q = F.lane >> 4;
    for (; u < nunits; u += F.G) {
        const DftP p = dft_params<MODE>(F, u);
#pragma unroll
        for (int i = 0; i < NP; ++i) { const int pc = F.tid + 512 * i; if (pc < NR * 16) *(LAS u32x4*)(U + (pc >> 4) * ULD + (pc & 15) * 8) = pre[i]; }
        __syncthreads();
        if (u + F.G < nunits) { const DftP pn = dft_params<MODE>(F, u + F.G);
#pragma unroll
            for (int i = 0; i < NP; ++i) { const int pc = F.tid + 512 * i; if (pc < NR * 16) pre[i] = __builtin_nontemporal_load((const u32x4*)(pn.dbase + (size_t)(pc >> 4) * pn.dstride + (pc & 15) * 8)); } }
        {
            f32x4 acc[NR / 16][2];
#pragma unroll
            for (int mt = 0; mt < NR / 16; ++mt) { acc[mt][0] = (f32x4){0.f, 0.f, 0.f, 0.f}; acc[mt][1] = (f32x4){0.f, 0.f, 0.f, 0.f}; }
#pragma unroll
            for (int ks = 0; ks < 4; ++ks) {
                const bf16x8 b0 = *(const LAS bf16x8*)(FDl + ((2 * F.wave) * 16 + a) * ULD + ks * 32 + 8 * q), b1 = *(const LAS bf16x8*)(FDl + ((2 * F.wave + 1) * 16 + a) * ULD + ks * 32 + 8 * q);
#pragma unroll
                for (int mt = 0; mt < NR / 16; ++mt) { const bf16x8 av = *(const LAS bf16x8*)(U + (mt * 16 + a) * ULD + ks * 32 + 8 * q);
                    acc[mt][0] = __builtin_amdgcn_mfma_f32_16x16x32_bf16(av, b0, acc[mt][0], 0, 0, 0); acc[mt][1] = __builtin_amdgcn_mfma_f32_16x16x32_bf16(av, b1, acc[mt][1], 0, 0, 0); }
            }
#pragma unroll
            for (int t = 0; t < 2; ++t) { const int col = (2 * F.wave + t) * 16 + a, ri = col >> 7, k2 = col & 127;
#pragma unroll
                for (int mt = 0; mt < NR / 16; ++mt) { const int k0 = ri * NR + 16 * mt + 4 * q;
                    u32x2 w; w.x = pk2(acc[mt][t][0], acc[mt][t][1]); w.y = pk2(acc[mt][t][2], acc[mt][t][3]);
                    *(LAS u32x2*)(DT + k2 * LD + (k0 ^ (((k2 >> 3) & GM) << 3))) = w; } }
        }
        __syncthreads();
        for (int task = F.wave; task < (MD / 16) * 2; task += NWAVES) {
            const int mt = task >> 1, cht = task & 1;
            f32x4 acc[4];
#pragma unroll
            for (int ct = 0; ct < 4; ++ct) acc[ct] = (f32x4){0.f, 0.f, 0.f, 0.f};
#pragma unroll
            for (int ks = 0; ks < KD / 32; ++ks) {
                const bf16x8 bw = *(const bf16x8*)(p.W + (size_t)(mt * 16 + a) * KD + ks * 32 + 8 * q);
#pragma unroll
                for (int ct = 0; ct < 4; ++ct) {
                    const int ch = cht * 64 + 16 * (a >> 2) + 4 * ct + (a & 3);
                    const bf16x8 av = *(const LAS bf16x8*)(DT + ch * LD + ((ks * 32 + 8 * q) ^ (((ch >> 3) & GM) << 3)));
                    acc[ct] = __builtin_amdgcn_mfma_f32_16x16x32_bf16(av, bw, acc[ct], 0, 0, 0);
                }
            }
            const int m = mt * 16 + a, rm = m / J, j = m % J;
            bf16* o = p.obase + (size_t)j * p.ostride + rm * 512 + cht * 64 + 16 * q;
            u32x4 w0, w1;
            w0.x = pk2(acc[0][0], acc[0][1]); w0.y = pk2(acc[0][2], acc[0][3]); w0.z = pk2(acc[1][0], acc[1][1]); w0.w = pk2(acc[1][2], acc[1][3]);
            w1.x = pk2(acc[2][0], acc[2][1]); w1.y = pk2(acc[2][2], acc[2][3]); w1.z = pk2(acc[3][0], acc[3][1]); w1.w = pk2(acc[3][2], acc[3][3]);
            *(u32x4*)o = w0; *(u32x4*)(o + 8) = w1;
        }
        __syncthreads();
    }
}

__device__ __forceinline__ void phase_fourier_a_conv(Frame& F) {
    const bf16* P = (const bf16*)(F.ws + WS_BUFP);
    dft_units_a<0, 64>(F, 2048);
    __syncthreads();
    dft_units_a<1, 16>(F, 512);
    ctr_publish(F, WS_FAF, 0, xcd_census(F, [](int) { return true; }));
    bf16* MIX = (bf16*)(F.ws + WS_BUFA);
    const float* cw = F.in[I_ECONV];
    float w0[8], w1[8], w2[8];
#pragma unroll
    for (int i = 0; i < 8; ++i) { w0[i] = cw[8 * F.lane + i]; w1[i] = cw[512 + 8 * F.lane + i]; w2[i] = cw[1024 + 8 * F.lane + i]; }
    const int gw = F.vcu * NWAVES + F.wave, NGW = F.G * NWAVES;
    auto conv_tokens = [&](int t, auto ntc) {
        constexpr int NT = decltype(ntc)::value;
        int pos, len; if (t < TL) { pos = t & 4095; len = 4096; } else { pos = (t - TL) & 255; len = 256; }
        const bf16* row = P + (size_t)t * EIN + 8 * F.lane;
        u32x4 gb[NT], gc[NT + 2], uc[NT + 2];
#pragma unroll
        for (int d = 0; d < NT + 2; ++d) { const int pp = pos + d - 1;
            if (pp >= 0 && pp < len) { gc[d] = *(const u32x4*)(row + (ptrdiff_t)(d - 1) * EIN + 1024); uc[d] = *(const u32x4*)(row + (ptrdiff_t)(d - 1) * EIN + 1536); }
            else { gc[d] = (u32x4){0u, 0u, 0u, 0u}; uc[d] = (u32x4){0u, 0u, 0u, 0u}; } }
#pragma unroll
        for (int q = 0; q < NT; ++q) gb[q] = __builtin_nontemporal_load((const u32x4*)(row + (size_t)q * EIN + 512));
        float pl[NT + 2][8];
#pragma unroll
        for (int d = 0; d < NT + 2; ++d)
#pragma unroll
            for (int i = 0; i < 4; ++i) { pl[d][2 * i] = bflo(gc[d][i]) * bflo(uc[d][i]); pl[d][2 * i + 1] = bfhi(gc[d][i]) * bfhi(uc[d][i]); }
#pragma unroll
        for (int q = 0; q < NT; ++q) {
            float y[8];
#pragma unroll
            for (int i = 0; i < 4; ++i) {
                y[2 * i] = bflo(gb[q][i]) * (w0[2 * i] * pl[q][2 * i] + w1[2 * i] * pl[q + 1][2 * i] + w2[2 * i] * pl[q + 2][2 * i]);
                y[2 * i + 1] = bfhi(gb[q][i]) * (w0[2 * i + 1] * pl[q][2 * i + 1] + w1[2 * i + 1] * pl[q + 1][2 * i + 1] + w2[2 * i + 1] * pl[q + 2][2 * i + 1]);
            }
            u32x4 o; o.x = pk2(y[0], y[1]); o.y = pk2(y[2], y[3]); o.z = pk2(y[4], y[5]); o.w = pk2(y[6], y[7]);
            *(u32x4*)(MIX + (size_t)(t + q) * D + 512 + 8 * F.lane) = o;
        }
    };
    for (int t = 4 * gw; t < TL; t += 4 * NGW) conv_tokens(t, std::integral_constant<int, 4>{});
    for (int t = TL + gw; t < T; t += NGW) conv_tokens(t, std::integral_constant<int, 1>{});
}

__device__ __forceinline__ void phase_fourier_c(Frame& F) {
    ctr_wait(F, WS_FAF, (unsigned)F.G);
    dft_units<2, 128, 64, 64>(F, 2048);
    dft_units<3, 32, 16, 16>(F, 512);
}

constexpr int RW_LD = 1032;
template <bool SPLIT>
__device__ __forceinline__ void phase_route(Frame& F, int layer, int ntok) {
    LAS bf16* rwh = (LAS bf16*)F.lds;
    LAS bf16* rwl = (LAS bf16*)(F.lds + 33024);
    LAS unsigned* cnt = (LAS unsigned*)(F.lds + 66048);
    LAS int* gb = (LAS int*)(F.lds + 66048 + 128);
    LAS float* lgs = (LAS float*)(F.lds + 66048 + 256) + F.wave * 256;
    LAS int* tinfo = (LAS int*)(F.lds + 66048 + 256 + 8192);
    LAS float* GS = (LAS float*)(F.lds + 81920);
    LAS float* SH = GS + 2048;
    const float* RW = F.in[I_RW];
    int tA, nA, tB, nB;
    if constexpr (SPLIT) {
        const int xs = F.vcu >> 5, rs = F.vcu & 31;
        if (rs >= 28) return;
        const int j = 28 * xs + rs;
        tA = 128 * j; nA = 128; tB = 28672 + 32 * j; nB = (j < 192) ? 32 : 0;
    } else { const int per_ = ntok / F.G; tA = blockIdx.x * per_; nA = per_; tB = 0; nB = 0; }
    const int r0 = mod_row(tA), mr1 = SPLIT ? mod_row(tB) : min(r0 + 1, 8);
    const float* mods = (const float*)(F.ws + WS_MODS) + (size_t)layer * 9 * 6144;
    const float* g = F.in[I_NFG] + layer * 1024;
    for (int i = F.tid; i < 16384; i += 512) { const int k = i >> 4, e = i & 15; const float w = RW[i]; const unsigned hi = f2bf(w); const float wl = w - __builtin_bit_cast(float, hi << 16);
        rwh[e * RW_LD + k] = (bf16)hi; rwl[e * RW_LD + k] = (bf16)f2bf(wl); }
    for (int i = F.tid; i < 2048; i += 512) { const int sl = i >> 10, c = i & 1023; const int rr = sl ? mr1 : r0; const float* m = mods + (size_t)rr * 6144;
        GS[i] = g[c] * (m[4 * 1024 + c] + 1.0f); SH[i] = m[3 * 1024 + c]; }
    if (F.tid < 16) cnt[F.tid] = 0u;
    __syncthreads();
    bf16* FB = (bf16*)(F.ws + WS_BUFA);
    const bool f8 = layer ? (FP8_G1_L1 != 0) : (FP8_G1_L0 != 0);
    int* route = (int*)(F.ws + WS_ROUTE);
    const int tk = F.lane & 15, kg = F.lane >> 4;
    for (int st = 0; st < 2; ++st) {
    const int t0 = st ? tB : tA, per = st ? nB : nA, li0 = st ? nA : 0;
    if (per == 0) break;
    if constexpr (SPLIT) { if (st == 0) ctr_wait(F, WS_P5F, 224u); else ctr_wait(F, WS_P5C, 32u); }
    for (int g0 = 16 * F.wave; g0 < per; g0 += 16 * NWAVES) {
        const int nv = min(16, per - g0);
        const int tq = t0 + g0 + (tk < nv ? tk : 0);
        const bf16* hr = h_row(F, tq) + 8 * kg;
        float s2 = 0.f;
        {
            u32x4 raw[32];
#pragma unroll
            for (int ks = 0; ks < 32; ++ks) raw[ks] = *(const u32x4*)(hr + 32 * ks);
#pragma unroll
            for (int ks = 0; ks < 32; ++ks)
#pragma unroll
                for (int i = 0; i < 4; ++i) { const float a = bflo(raw[ks][i]), b2 = bfhi(raw[ks][i]); s2 += a * a + b2 * b2; }
        }
        s2 += __shfl_xor(s2, 16); s2 += __shfl_xor(s2, 32);
        const float rstd = 1.0f / sqrtf(s2 * (1.0f / D) + EPS);
        const int sl = (mod_row(tq) != r0) ? 1024 : 0;
        const LAS float* gsp = GS + sl + 8 * kg; const LAS float* shp = SH + sl + 8 * kg;
        unsigned char* fb8 = (unsigned char*)FB + (size_t)tq * D + 8 * kg;
        bf16* fb16 = FB + (size_t)tq * D + 8 * kg;
        f32x4 acc = (f32x4){0.f, 0.f, 0.f, 0.f};
        u32x4 nx[8];
#pragma unroll
        for (int j = 0; j < 8; ++j) nx[j] = *(const u32x4*)(hr + 32 * j);
#pragma unroll 1
        for (int k4 = 0; k4 < 4; ++k4) {
            u32x4 cu[8];
#pragma unroll
            for (int j = 0; j < 8; ++j) cu[j] = nx[j];
            if (k4 < 3) {
#pragma unroll
                for (int j = 0; j < 8; ++j) nx[j] = *(const u32x4*)(hr + 32 * (8 * k4 + 8 + j)); }
#pragma unroll
            for (int j = 0; j < 8; ++j) {
                const int ks = 8 * k4 + j;
                const f32x4 g0v = *(const LAS f32x4*)(gsp + 32 * ks), g1v = *(const LAS f32x4*)(gsp + 32 * ks + 4), s0v = *(const LAS f32x4*)(shp + 32 * ks), s1v = *(const LAS f32x4*)(shp + 32 * ks + 4);
                float f[8];
                f[0] = bflo(cu[j].x) * rstd * g0v.x + s0v.x; f[1] = bfhi(cu[j].x) * rstd * g0v.y + s0v.y; f[2] = bflo(cu[j].y) * rstd * g0v.z + s0v.z; f[3] = bfhi(cu[j].y) * rstd * g0v.w + s0v.w;
                f[4] = bflo(cu[j].z) * rstd * g1v.x + s1v.x; f[5] = bfhi(cu[j].z) * rstd * g1v.y + s1v.y; f[6] = bflo(cu[j].w) * rstd * g1v.z + s1v.z; f[7] = bfhi(cu[j].w) * rstd * g1v.w + s1v.w;
                u32x4 hi, lo;
#pragma unroll
                for (int i = 0; i < 4; ++i) { const unsigned h0 = f2bf(f[2 * i]), h1 = f2bf(f[2 * i + 1]); hi[i] = h0 | (h1 << 16);
                    lo[i] = pk2(f[2 * i] - __builtin_bit_cast(float, h0 << 16), f[2 * i + 1] - __builtin_bit_cast(float, h1 << 16)); }
                if (tk < nv) {
                    if (f8) { u32x2 o; o.x = pg8::pk4_fp8(f[0], f[1], f[2], f[3]); o.y = pg8::pk4_fp8(f[4], f[5], f[6], f[7]); *(u32x2*)(fb8 + 32 * ks) = o; }
                    else *(u32x4*)(fb16 + 32 * ks) = hi;
                }
                const bf16x8 bh = *(const LAS bf16x8*)(rwh + tk * RW_LD + 32 * ks + 8 * kg), bl = *(const LAS bf16x8*)(rwl + tk * RW_LD + 32 * ks + 8 * kg);
                const bf16x8 ah = __builtin_bit_cast(bf16x8, hi), al = __builtin_bit_cast(bf16x8, lo);
                acc = __builtin_amdgcn_mfma_f32_16x16x32_bf16(ah, bh, acc, 0, 0, 0);
                acc = __builtin_amdgcn_mfma_f32_16x16x32_bf16(ah, bl, acc, 0, 0, 0);
                acc = __builtin_amdgcn_mfma_f32_16x16x32_bf16(al, bh, acc, 0, 0, 0);
            }
        }
#pragma unroll
        for (int j = 0; j < 4; ++j) lgs[(4 * kg + j) * 16 + tk] = acc[j];
        LDS_WAIT(); asm volatile("" ::: "memory");
        if (F.lane < nv) {
            const int tqq = t0 + g0 + F.lane;
            float aff[16], sel[16];
#pragma unroll
            for (int e4 = 0; e4 < 4; ++e4) { const f32x4 l4 = *(const LAS f32x4*)(lgs + F.lane * 16 + 4 * e4); const f32x4 b4 = *(const f32x4*)(F.in[I_RB] + 4 * e4);
                aff[4 * e4] = 1.0f / (1.0f + expf(-l4.x)); aff[4 * e4 + 1] = 1.0f / (1.0f + expf(-l4.y)); aff[4 * e4 + 2] = 1.0f / (1.0f + expf(-l4.z)); aff[4 * e4 + 3] = 1.0f / (1.0f + expf(-l4.w));
                sel[4 * e4] = aff[4 * e4] + b4.x; sel[4 * e4 + 1] = aff[4 * e4 + 1] + b4.y; sel[4 * e4 + 2] = aff[4 * e4 + 2] + b4.z; sel[4 * e4 + 3] = aff[4 * e4 + 3] + b4.w; }
            int best = 0; float bs = -1e30f;
#pragma unroll
            for (int gq = 0; gq < 4; ++gq) { const float a = sel[4 * gq], b = sel[4 * gq + 1], c = sel[4 * gq + 2], d = sel[4 * gq + 3];
                const float s = fmaxf(fmaxf(fmaxf(a + b, a + c), fmaxf(a + d, b + c)), fmaxf(b + d, c + d));
                if (s > bs) { bs = s; best = gq; } }
            float sv[4], av[4];
#pragma unroll
            for (int i = 0; i < 4; ++i) { sv[i] = sel[i]; av[i] = aff[i]; }
#pragma unroll
            for (int gq = 1; gq < 4; ++gq) if (best == gq) {
#pragma unroll
                for (int i = 0; i < 4; ++i) { sv[i] = sel[4 * gq + i]; av[i] = aff[4 * gq + i]; } }
            int i1 = 0; float s1 = sv[0], a1 = av[0];
#pragma unroll
            for (int i = 1; i < 4; ++i) if (sv[i] > s1) { s1 = sv[i]; a1 = av[i]; i1 = i; }
            int i2 = -1; float s2v = -1e30f, a2 = 0.f;
#pragma unroll
            for (int i = 0; i < 4; ++i) if (i != i1 && sv[i] > s2v) { s2v = sv[i]; a2 = av[i]; i2 = i; }
            const int e1 = 4 * best + i1, e2 = 4 * best + i2;
            const float wsum = a1 + a2, w1 = a1 / wsum, w2 = a2 / wsum;
            const unsigned r1 = atomicAdd((unsigned*)(cnt + e1), 1u), r2 = atomicAdd((unsigned*)(cnt + e2), 1u);
            int* ro = route + (size_t)tqq * 8;
            ro[0] = e1; ro[1] = e2; ro[4] = __builtin_bit_cast(int, w1); ro[5] = __builtin_bit_cast(int, w2);
            const int li = li0 + g0 + F.lane;
            tinfo[4 * li + 0] = e1; tinfo[4 * li + 1] = e2; tinfo[4 * li + 2] = (int)r1; tinfo[4 * li + 3] = (int)r2;
        }
        LDS_WAIT(); asm volatile("" ::: "memory");
    }
    }
    __syncthreads();
    if (F.tid < 16) gb[F.tid] = (int)__hip_atomic_fetch_add((unsigned*)(F.ws + WS_GCNT) + layer * 16 + F.tid, cnt[F.tid], __ATOMIC_RELAXED, __HIP_MEMORY_SCOPE_AGENT);
    __syncthreads();
    int* tokmap = (int*)(F.ws + WS_TOKMAP);
    for (int i = F.tid; i < nA + nB; i += 512) {
        const int tok = (i < nA) ? tA + i : tB + (i - nA);
        const int e1 = tinfo[4 * i], e2 = tinfo[4 * i + 1], p1 = gb[e1] + tinfo[4 * i + 2], p2 = gb[e2] + tinfo[4 * i + 3];
        tokmap[(size_t)e1 * T + p1] = tok; tokmap[(size_t)e2 * T + p2] = tok;
        int* ro = route + (size_t)tok * 8; ro[2] = p1; ro[3] = p2;
    }
}

__device__ __forceinline__ int moe_tables(Frame& F, int layer) {
    LAS int* tb = (LAS int*)(F.lds + LDS_CTL + 64); LAS int* cn = (LAS int*)(F.lds + LDS_CTL + 192);
    __syncthreads();
    if (F.tid < 16) cn[F.tid] = ld_coh((const int*)(F.ws + WS_GCNT) + layer * 16 + F.tid);
    __syncthreads();
    if (F.tid == 0) { int b = 0; for (int e = 0; e < 16; ++e) { tb[e] = b; b += (cn[e] + 255) >> 8; } tb[16] = b; }
    __syncthreads();
    return __builtin_amdgcn_readfirstlane(tb[16]);
}

typedef float f32x2 __attribute__((ext_vector_type(2)));
template <int NQ> __device__ __forceinline__ void combine_tokens(Frame& F, int layer, int t) {
    const float* mods = (const float*)(F.ws + WS_MODS);
    const unsigned char* OS = (const unsigned char*)(F.ws + WS_BUFP);
    const int* route = (const int*)(F.ws + WS_ROUTE);
    const LAS int* tb = (const LAS int*)(F.lds + LDS_CTL + 64);
    bf16* A = (bf16*)(F.ws + WS_BUFA);
    {
        int rc[NQ][4]; float w0[NQ], w1[NQ];
#pragma unroll
        for (int q = 0; q < NQ; ++q) { const int* ro = route + (size_t)(t + q) * 8;
#pragma unroll
            for (int i = 0; i < 4; ++i) rc[q][i] = ld_coh(ro + i);
            w0[q] = ld_cohf((const float*)(ro + 4)) * (1.0f / pg8::OS_SCALE); w1[q] = ld_cohf((const float*)(ro + 5)) * (1.0f / pg8::OS_SCALE); }
        f32x4 v[NQ][4]; unsigned oa[NQ][4], ob[NQ][4];
#pragma unroll
        for (int q = 0; q < NQ; ++q) { const bf16* hr = h_row(F, t + q);
            const size_t s0 = (size_t)(tb[rc[q][0]] * 256 + rc[q][2]) * D, s1 = (size_t)(tb[rc[q][1]] * 256 + rc[q][3]) * D;
#pragma unroll
            for (int j = 0; j < 4; ++j) { const int c = 4 * F.lane + 256 * j; { const u32x2 hv = *(const u32x2*)(hr + c); v[q][j] = (f32x4){bflo(hv.x), bfhi(hv.x), bflo(hv.y), bfhi(hv.y)}; } oa[q][j] = __builtin_nontemporal_load((const unsigned*)(OS + s0 + c)); ob[q][j] = __builtin_nontemporal_load((const unsigned*)(OS + s1 + c)); } }
        const int mr = mod_row(t);
        const float* m5 = mods + (size_t)(layer * 9 + mr) * 6144 + 5 * 1024;
#pragma unroll
        for (int j = 0; j < 4; ++j) { const f32x4 g5 = *(const f32x4*)(m5 + 4 * F.lane + 256 * j);
#pragma unroll
            for (int q = 0; q < NQ; ++q) { const f32x2 a0 = __builtin_amdgcn_cvt_pk_f32_fp8((int)oa[q][j], false), a1 = __builtin_amdgcn_cvt_pk_f32_fp8((int)oa[q][j], true), b0 = __builtin_amdgcn_cvt_pk_f32_fp8((int)ob[q][j], false), b1 = __builtin_amdgcn_cvt_pk_f32_fp8((int)ob[q][j], true);
                const f32x4 o = (f32x4){w0[q] * a0[0] + w1[q] * b0[0], w0[q] * a0[1] + w1[q] * b0[1], w0[q] * a1[0] + w1[q] * b1[0], w0[q] * a1[1] + w1[q] * b1[1]};
                v[q][j] = v[q][j] + g5 * o; } }
#pragma unroll
        for (int q = 0; q < NQ; ++q) {
            if (layer == 0) {
                bf16* hr = h_row(F, t + q);
#pragma unroll
                for (int j = 0; j < 4; ++j) { u32x2 o; o.x = pk2(v[q][j].x, v[q][j].y); o.y = pk2(v[q][j].z, v[q][j].w); *(u32x2*)(hr + 4 * F.lane + 256 * j) = o; }
                const float* m = mods + (size_t)(9 + mr) * 6144;
                norm_mod_store(v[q], F.in[I_NMG] + 1024, m, m + 1024, A + (size_t)(t + q) * D, F.lane);
            } else {
                float s2 = 0.f;
#pragma unroll
                for (int j = 0; j < 4; ++j) s2 += (v[q][j].x * v[q][j].x + v[q][j].y * v[q][j].y) + (v[q][j].z * v[q][j].z + v[q][j].w * v[q][j].w);
                const float rstd = 1.0f / sqrtf(wave_sum(s2) * (1.0f / D) + EPS);
                float* orow = F.out + (size_t)(t + q) * D;
#pragma unroll
                for (int j = 0; j < 4; ++j) { const int c = 4 * F.lane + 256 * j; __builtin_nontemporal_store(v[q][j] * rstd * *(const f32x4*)(F.in[I_FG] + c), (f32x4*)(orow + c)); }
            }
        }
    }
}
__device__ __forceinline__ void phase_combine(Frame& F, int layer, int ntok) {
    const int gw = F.vcu * NWAVES + F.wave, NGW = F.G * NWAVES;
    if (layer == 0) { for (int t = 2 * gw; t < TL; t += 2 * NGW) combine_tokens<2>(F, 0, t); for (int t = TL + gw; t < ntok; t += NGW) combine_tokens<1>(F, 0, t); }
    else { for (int t = 4 * gw; t < TL; t += 4 * NGW) combine_tokens<4>(F, 1, t); }
}

constexpr int KV_LD = 72, VL_OFF = 384 * KV_LD * 2, ROPE_LDS = 131072;
typedef short v4i16_t __attribute__((ext_vector_type(4)));

__device__ __forceinline__ bf16x8 rope_pack(const u32x4 x1, const u32x4 x2, const LAS float* cs, const LAS float* sn, float scale, bool second) {
    const f32x4 c0 = *(const LAS f32x4*)cs, c1 = *(const LAS f32x4*)(cs + 4), s0 = *(const LAS f32x4*)sn, s1 = *(const LAS f32x4*)(sn + 4);
    float c[8] = {c0.x, c0.y, c0.z, c0.w, c1.x, c1.y, c1.z, c1.w}, s[8] = {s0.x, s0.y, s0.z, s0.w, s1.x, s1.y, s1.z, s1.w};
    float a[8], b[8];
#pragma unroll
    for (int i = 0; i < 4; ++i) { a[2 * i] = bflo(x1[i]); a[2 * i + 1] = bfhi(x1[i]); b[2 * i] = bflo(x2[i]); b[2 * i + 1] = bfhi(x2[i]); }
    float o[8];
#pragma unroll
    for (int i = 0; i < 8; ++i) o[i] = (second ? (b[i] * c[i] + a[i] * s[i]) : (a[i] * c[i] - b[i] * s[i])) * scale;
    u32x4 w; w.x = pk2(o[0], o[1]); w.y = pk2(o[2], o[3]); w.z = pk2(o[4], o[5]); w.w = pk2(o[6], o[7]);
    return __builtin_bit_cast(bf16x8, w);
}

struct AttnU { int b, qb, kvh; };
__device__ __forceinline__ AttnU attn_unit_of(int u) { AttnU r; r.kvh = u & 1; r.qb = (u >> 1) & 31; r.b = u >> 6; return r; }

__device__ __forceinline__ void attn_load_latk(Frame& F, const bf16* P1, AttnU u, u32x4 (&lk)[2][4]) {
    const u32x4 z = (u32x4){0u, 0u, 0u, 0u};
#pragma unroll
    for (int it = 0; it < 2; ++it) { const int task = F.tid + 512 * it, kidx = task >> 1, hh = task & 1, pos = u.qb * 128 - 128 + kidx;
        const bool ok = task < 768 && pos >= 0 && pos < NSEQ;
        const bf16* row = P1 + (size_t)(u.b * NSEQ + (ok ? pos : 0)) * OIN + 1024 + u.kvh * 64 + 8 * hh;
#pragma unroll
        for (int st = 0; st < 4; ++st) lk[it][st] = ok ? *(const u32x4*)(row + 16 * st) : z; }
}
__device__ __forceinline__ void attn_load_latv(Frame& F, const bf16* P1, AttnU u, u32x4 (&lv)[6]) {
    const u32x4 z = (u32x4){0u, 0u, 0u, 0u};
#pragma unroll
    for (int it = 0; it < 6; ++it) { const int task = F.tid + 512 * it, kidx = task >> 3, c8 = task & 7, pos = u.qb * 128 - 128 + kidx;
        const bool ok = pos >= 0 && pos < NSEQ;
        lv[it] = ok ? *(const u32x4*)(P1 + (size_t)(u.b * NSEQ + (ok ? pos : 0)) * OIN + 1152 + u.kvh * 64 + 8 * c8) : z; }
}
__device__ __forceinline__ void attn_write_lat(Frame& F, AttnU u, const u32x4 (&lk)[2][4], const u32x4 (&lv)[6]) {
    LAS bf16* KL = (LAS bf16*)F.lds; LAS bf16* VL = (LAS bf16*)(F.lds + VL_OFF); const LAS float* rope = (const LAS float*)(F.lds + ROPE_LDS);
#pragma unroll
    for (int it = 0; it < 2; ++it) { const int task = F.tid + 512 * it, kidx = task >> 1, hh = task & 1; int pos = u.qb * 128 - 128 + kidx; pos = pos < 0 ? 0 : (pos > NSEQ - 1 ? NSEQ - 1 : pos);
        if (task < 768) {
            LAS bf16* d = KL + kidx * KV_LD + 8 * hh;
            const LAS float* c0 = rope + (pos >> 6) * 16 + 8 * hh; const LAS float* c1 = rope + (pos & 63) * 16 + 8 * hh;
            *(LAS bf16x8*)(d) = rope_pack(lk[it][0], lk[it][1], c0, c0 + 1024, 1.0f, false);
            *(LAS bf16x8*)(d + 16) = rope_pack(lk[it][0], lk[it][1], c0, c0 + 1024, 1.0f, true);
            *(LAS bf16x8*)(d + 32) = rope_pack(lk[it][2], lk[it][3], c1, c1 + 1024, 1.0f, false);
            *(LAS bf16x8*)(d + 48) = rope_pack(lk[it][2], lk[it][3], c1, c1 + 1024, 1.0f, true);
        } }
#pragma unroll
    for (int it = 0; it < 6; ++it) { const int task = F.tid + 512 * it, kidx = task >> 3, c8 = task & 7; *(LAS u32x4*)(VL + kidx * KV_LD + 8 * c8) = lv[it]; }
}
__device__ __forceinline__ void attn_load_ctx(Frame& F, const bf16* P1, AttnU u, u32x4 (&ck)[4], u32x4 (&cv)[4]) {
#pragma unroll
    for (int it = 0; it < 4; ++it) { const int task = F.tid + 512 * it, kidx = task >> 3, c8 = task & 7;
        const bf16* row = P1 + (size_t)(TL + u.b * LCTX + kidx) * OIN + 1024 + u.kvh * 64 + 8 * c8;
        ck[it] = *(const u32x4*)row; cv[it] = *(const u32x4*)(row + 128); }
}
__device__ __forceinline__ void attn_write_ctx(Frame& F, const u32x4 (&ck)[4], const u32x4 (&cv)[4]) {
    LAS bf16* KL = (LAS bf16*)F.lds; LAS bf16* VL = (LAS bf16*)(F.lds + VL_OFF);
#pragma unroll
    for (int it = 0; it < 4; ++it) { const int task = F.tid + 512 * it, kidx = task >> 3, c8 = task & 7;
        *(LAS u32x4*)(KL + kidx * KV_LD + 8 * c8) = ck[it]; *(LAS u32x4*)(VL + kidx * KV_LD + 8 * c8) = cv[it]; }
}

__device__ __forceinline__ unsigned cvtpk(float lo, float hi) { unsigned r; asm volatile("v_cvt_pk_bf16_f32 %0, %1, %2" : "=v"(r) : "v"(lo), "v"(hi)); return r; }
__device__ __forceinline__ float xhalf_max(float x) { const auto r = __builtin_amdgcn_permlane32_swap(__builtin_bit_cast(unsigned, x), __builtin_bit_cast(unsigned, x), false, false);
    return fmaxf(__builtin_bit_cast(float, r[0]), __builtin_bit_cast(float, r[1])); }
__device__ __forceinline__ float xhalf_sum(float x) { const auto r = __builtin_amdgcn_permlane32_swap(__builtin_bit_cast(unsigned, x), __builtin_bit_cast(unsigned, x), false, false);
    return __builtin_bit_cast(float, r[0]) + __builtin_bit_cast(float, r[1]); }
__device__ __forceinline__ void attn_tiles(Frame& F, int kt0, int kt1, int mk0, int mk1, const bf16x8 (&qf)[4], f32x16 (&O)[2], float& mrun, float& lrun, int qrel) {
    if (kt0 > kt1) return;
    const LAS bf16* KL = (const LAS bf16*)F.lds; const LAS bf16* VL = (const LAS bf16*)(F.lds + VL_OFF);
    const int r32 = F.lane & 31, hh = F.lane >> 5;
    const int q4 = (F.lane & 15) >> 2, p4 = F.lane & 3, blk = (F.lane >> 4) & 1;
    const LAS bf16* kp = KL + (kt0 * 32 + r32) * KV_LD + 8 * hh;
    const LAS bf16* vp = VL + (kt0 * 32 + 4 * hh + q4) * KV_LD + 16 * blk + 4 * p4;
    bf16x8 kn[4];
#pragma unroll
    for (int st = 0; st < 4; ++st) kn[st] = *(const LAS bf16x8*)(kp + 16 * st);
    for (int kt = kt0; kt <= kt1; ++kt) {
        bf16x8 kf[4];
#pragma unroll
        for (int st = 0; st < 4; ++st) kf[st] = kn[st];
        v4i16_t vlo[2][2], vhi[2][2];
#pragma unroll
        for (int dt = 0; dt < 2; ++dt)
#pragma unroll
            for (int s2 = 0; s2 < 2; ++s2) { vlo[dt][s2] = __builtin_amdgcn_ds_read_tr16_b64_v4i16((LAS v4i16_t*)(vp + (16 * s2) * KV_LD + dt * 32));
                vhi[dt][s2] = __builtin_amdgcn_ds_read_tr16_b64_v4i16((LAS v4i16_t*)(vp + (16 * s2 + 8) * KV_LD + dt * 32)); }
        kp += 32 * KV_LD; vp += 32 * KV_LD;
        if (kt < kt1) {
#pragma unroll
            for (int st = 0; st < 4; ++st) kn[st] = *(const LAS bf16x8*)(kp + 16 * st); }
        __builtin_amdgcn_sched_barrier(0);
        f32x16 s;
#pragma unroll
        for (int r = 0; r < 16; ++r) s[r] = 0.f;
#pragma unroll
        for (int st = 0; st < 4; ++st) s = __builtin_amdgcn_mfma_f32_32x32x16_bf16(kf[st], qf[st], s, 0, 0, 0);
        if (kt == mk0 || kt == mk1) {
#pragma unroll
            for (int r = 0; r < 16; ++r) { const int dlt = kt * 32 + (r & 3) + 8 * (r >> 2) + 4 * hh - qrel; s[r] = (dlt <= 128 && dlt >= -128) ? s[r] : -INFINITY; } }
        float mx = fmaxf(fmaxf(s[0], s[1]), fmaxf(s[2], s[3]));
#pragma unroll
        for (int r = 4; r < 16; r += 4) mx = fmaxf(mx, fmaxf(fmaxf(s[r], s[r + 1]), fmaxf(s[r + 2], s[r + 3])));
        mx = xhalf_max(mx);
        const float mnew = fmaxf(mrun, mx);
        float ps0 = 0.f, ps1 = 0.f;
#pragma unroll
        for (int r = 0; r < 16; r += 2) { s[r] = __builtin_amdgcn_exp2f(s[r] - mnew); s[r + 1] = __builtin_amdgcn_exp2f(s[r + 1] - mnew); ps0 += s[r]; ps1 += s[r + 1]; }
        const float ps = xhalf_sum(ps0 + ps1);
        if (__any(mnew > mrun)) {
            const float alpha = __builtin_amdgcn_exp2f(mrun - mnew);
            lrun *= alpha;
#pragma unroll
            for (int dt = 0; dt < 2; ++dt)
#pragma unroll
                for (int r = 0; r < 16; ++r) O[dt][r] *= alpha;
        }
        lrun += ps; mrun = mnew;
        bf16x8 pb[2];
#pragma unroll
        for (int s2 = 0; s2 < 2; ++s2) { u32x4 w; w.x = cvtpk(s[8 * s2 + 0], s[8 * s2 + 1]); w.y = cvtpk(s[8 * s2 + 2], s[8 * s2 + 3]); w.z = cvtpk(s[8 * s2 + 4], s[8 * s2 + 5]); w.w = cvtpk(s[8 * s2 + 6], s[8 * s2 + 7]);
            pb[s2] = __builtin_bit_cast(bf16x8, w); }
#pragma unroll
        for (int dt = 0; dt < 2; ++dt)
#pragma unroll
            for (int s2 = 0; s2 < 2; ++s2) {
                const bf16x8 va = (bf16x8){vlo[dt][s2][0], vlo[dt][s2][1], vlo[dt][s2][2], vlo[dt][s2][3], vhi[dt][s2][0], vhi[dt][s2][1], vhi[dt][s2][2], vhi[dt][s2][3]};
                O[dt] = __builtin_amdgcn_mfma_f32_32x32x16_bf16(va, pb[s2], O[dt], 0, 0, 0);
            }
    }
}

__device__ __forceinline__ void phase_attn(Frame& F) {
    const bf16* P1 = (const bf16*)(F.ws + WS_BUFP);
    bf16* MIX = (bf16*)(F.ws + WS_BUFA);
    const int r32 = F.lane & 31, hh = F.lane >> 5;
    constexpr float QSC = 0.125f * 1.4426950408889634f;
    LAS float* ropel = (LAS float*)(F.lds + ROPE_LDS);
    for (int i = F.tid; i < 2048; i += 512) ropel[i] = ((const float*)(F.ws + WS_ROPE))[i];
    u32x4 lk[2][4], lv[6], ck[4], cv[4];
    const int nu = (512 - F.vcu + F.G - 1) / F.G;
    if (nu > 0) attn_load_latk(F, P1, attn_unit_of(F.vcu), lk);
    for (int ui = 0; ui < nu; ++ui) {
        const AttnU u = attn_unit_of(F.vcu + ui * F.G);
        u32x4 qr[2][4];
#pragma unroll
        for (int i = 0; i < 2; ++i) { const int task = F.wave + 8 * i, g = task & 3, sub = task >> 2, head = u.kvh * 4 + g, pos = u.qb * 128 + 32 * sub + r32;
            const bf16* row = P1 + (size_t)(u.b * NSEQ + pos) * OIN + 512 + head * 64 + 8 * hh;
#pragma unroll
            for (int st = 0; st < 4; ++st) qr[i][st] = __builtin_nontemporal_load((const u32x4*)(row + 16 * st)); }
        attn_load_latv(F, P1, u, lv);
        __syncthreads();
        attn_write_lat(F, u, lk, lv);
        bf16x8 qf[2][4]; f32x16 O[2][2]; float mrun[2], lrun[2];
#pragma unroll
        for (int i = 0; i < 2; ++i) { const int task = F.wave + 8 * i, g = task & 3, sub = task >> 2, head = u.kvh * 4 + g, pos = u.qb * 128 + 32 * sub + r32;
            const LAS float* c0 = ropel + (pos >> 6) * 16 + 8 * hh; const LAS float* c1 = ropel + (pos & 63) * 16 + 8 * hh;
            qf[i][0] = rope_pack(qr[i][0], qr[i][1], c0, c0 + 1024, QSC, false); qf[i][1] = rope_pack(qr[i][0], qr[i][1], c0, c0 + 1024, QSC, true);
            qf[i][2] = rope_pack(qr[i][2], qr[i][3], c1, c1 + 1024, QSC, false); qf[i][3] = rope_pack(qr[i][2], qr[i][3], c1, c1 + 1024, QSC, true);
            mrun[i] = F.in[I_OSINK][head] * 1.4426950408889634f; lrun[i] = 1.0f;
#pragma unroll
            for (int dt = 0; dt < 2; ++dt)
#pragma unroll
                for (int r = 0; r < 16; ++r) O[i][dt][r] = 0.f; }
        __syncthreads();
        const int kt_lo = (u.qb == 0) ? 4 : 0, kt_hi = (u.qb == 31) ? 7 : 11;
#pragma unroll
        for (int i = 0; i < 2; ++i) { const int sub = (F.wave + 8 * i) >> 2, qrel = 128 + 32 * sub + r32;
            attn_tiles(F, max(sub, kt_lo), min(sub + 8, kt_hi), sub, sub + 8, qf[i], O[i], mrun[i], lrun[i], qrel); }
        attn_load_ctx(F, P1, u, ck, cv);
        __syncthreads();
        attn_write_ctx(F, ck, cv);
        __syncthreads();
        if (ui + 1 < nu) attn_load_latk(F, P1, attn_unit_of(F.vcu + (ui + 1) * F.G), lk);
#pragma unroll
        for (int i = 0; i < 2; ++i) {
            attn_tiles(F, 0, 7, -1, -1, qf[i], O[i], mrun[i], lrun[i], 0);
            const int task = F.wave + 8 * i, g = task & 3, sub = task >> 2, head = u.kvh * 4 + g, pos = u.qb * 128 + 32 * sub + r32;
            const float inv = 1.0f / lrun[i];
            bf16* o = MIX + (size_t)(u.b * NSEQ + pos) * D + 512 + head * 64 + 4 * hh;
#pragma unroll
            for (int dt = 0; dt < 2; ++dt)
#pragma unroll
                for (int rg = 0; rg < 4; ++rg) { u32x2 w; w.x = pk2(O[i][dt][4 * rg] * inv, O[i][dt][4 * rg + 1] * inv); w.y = pk2(O[i][dt][4 * rg + 2] * inv, O[i][dt][4 * rg + 3] * inv);
                    *(u32x2*)(o + dt * 32 + 8 * rg) = w; }
        }
    }
    __syncthreads();
}

__device__ __forceinline__ void phase_pool_stencil(Frame& F) {
    const bf16* P1 = (const bf16*)(F.ws + WS_BUFP);
    bf16* MIX = (bf16*)(F.ws + WS_BUFA);
    const int gw = F.vcu * NWAVES + F.wave, NGW = F.G * NWAVES;
    const int r = 1 << (F.lane >> 4);
    constexpr int NT = 8, NR = NT + 16;
    for (int t = NT * gw; t < TL; t += NT * NGW) {
        const int pos = t & 4095;
        const bf16* base = P1 + (size_t)t * OIN + 8 * F.lane;
        u32x4 v[NR];
#pragma unroll
        for (int jj = 0; jj < NR; ++jj) { const int pj = pos + jj - 8; const bool ok = pj >= 0 && pj < NSEQ; v[jj] = ok ? *(const u32x4*)(base + (ptrdiff_t)(jj - 8) * OIN) : (u32x4){0u, 0u, 0u, 0u}; }
        float acc[NT][8];
#pragma unroll
        for (int q = 0; q < NT; ++q)
#pragma unroll
            for (int i = 0; i < 8; ++i) acc[q][i] = 0.f;
#pragma unroll
        for (int jj = 0; jj < NR; ++jj) {
            float x[8];
#pragma unroll
            for (int i = 0; i < 4; ++i) { x[2 * i] = bflo(v[jj][i]); x[2 * i + 1] = bfhi(v[jj][i]); }
#pragma unroll
            for (int q = 0; q < NT; ++q) { const int dd = jj - 8 - q; if (dd >= -8 && dd <= 8) { const float w = (dd <= r && dd >= -r) ? 1.0f : 0.0f;
#pragma unroll
                for (int i = 0; i < 8; ++i) acc[q][i] += w * x[i]; } }
        }
#pragma unroll
        for (int q = 0; q < NT; ++q) {
            const int pq = pos + q, lo = max(pq - r, 0), hi = min(pq + r + 1, NSEQ);
            const float ic = 1.0f / (float)(hi - lo);
            const u32x4 sv = v[q + 8];
            u32x4 o;
#pragma unroll
            for (int i = 0; i < 4; ++i) o[i] = pk2(acc[q][2 * i] * ic - bflo(sv[i]), acc[q][2 * i + 1] * ic - bfhi(sv[i]));
            *(u32x4*)(MIX + (size_t)(t + q) * D + 8 * F.lane) = o;
        }
    }
}

__device__ __forceinline__ void phase_attn_pool(Frame& F) {
    phase_attn(F);
#ifdef DBG_ATTN2
    phase_attn(F);
#endif
    phase_pool_stencil(F);
    __syncthreads();
    convert_l1_range(F, 120 * L1T_N + F.vcu * L1A_N, L1A_N, 40);
}

constexpr int NPHASE = 20;
__global__ void __launch_bounds__(NWAVES * 64, 2) mk_fwd(Args args) {
    extern __shared__ __attribute__((aligned(16))) unsigned char lds_raw[];
    Frame F;
    F.lds = (LAS unsigned char*)lds_raw;
    F.tid = threadIdx.x; F.lane = F.tid & 63; F.wave = __builtin_amdgcn_readfirstlane(F.tid >> 6);
    F.G = gridDim.x; { const int bx = blockIdx.x; F.vcu = (F.G % 8 == 0) ? (bx % 8) * (F.G / 8) + bx / 8 : bx; }
    F.ws = args.ws; F.in = args.in; F.out = args.out;
    for (int u = F.tid; u < (LDS_BYTES - LDS_CTL) / 4; u += NWAVES * 64) ((LAS unsigned*)(F.lds + LDS_CTL))[u] = 0u;
    __syncthreads();
    const int lo = args.ph_lo, hi = args.ph_hi;
    XcdBarrier bar; bar.bar = (unsigned*)(F.ws + WS_CTL); bar.x = 0; bar.st = nullptr;
    if (hi - lo > 1) bar = xcd_barrier_post((unsigned*)(F.ws + WS_CTL), (volatile LAS unsigned*)(F.lds + LDS_CTL));
    if (F.tid == 0) { *((unsigned*)(F.ws + WS_XCDOF) + F.vcu) = xb_xcc_id(); *(LAS int*)(F.lds + LDS_CTL + 52) = (hi - lo > 1) ? 1 : 0; }
#define IN(k) (lo <= (k) && (k) < hi)
#ifndef PHASE_MASK
#define PHASE_MASK 0xffffffffu
#endif
#define PH(k, ...) if constexpr (((PHASE_MASK >> (k)) & 1u) != 0u) if (IN(k)) { { int t_ = F.tid; asm volatile("" : "+v"(t_)); F.tid = t_; F.lane = t_ & 63; } __VA_ARGS__ if constexpr (((DBG_DOUBLE >> (k)) & 1u) != 0u) { __VA_ARGS__ } }
#define SEAM(k) do { if (IN(k) && IN((k) + 1)) xcd_barrier(bar); } while (0)
    unsigned char* ws = F.ws;
    const float* mods = (const float*)(ws + WS_MODS);

    PH(1, { phase_prologue_a(F); }) SEAM(1);
    PH(2, {
        pg8::SchedDense S{(const char*)(ws + WS_BUFA), (const char*)(ws + WS_W_EIN), 1024, 8, 136, 0, 1088, F.vcu, F.G};
        pg8::EpiStore E{(bf16*)(ws + WS_BUFP), EIN};
        pg8::gemm_phase<pg8::EpiStore, pg8::SchedDense>(F.lds, 1024, S, E);
        if (F.vcu >= 64) { __syncthreads(); convert_l1_range(F, (F.vcu - 64) * L0T_N, L0T_N, 48, 0); }
    }) SEAM(2);
    PH(3, { phase_fourier_a_conv(F); })
    PH(4, { phase_fourier_c(F); }) SEAM(4);
    PH(5, {
        const int xs = F.vcu >> 5, rs = F.vcu & 31; const bool heavy = rs >= 28;
        pg8::SchedSplit S{(const char*)(ws + WS_BUFA), (const char*)(ws + WS_W_EOUT), 1024, heavy ? 448 + 4 * xs + (rs - 28) : 28 * xs + rs, heavy ? 32 : 224, heavy ? 3 : 2};
        pg8::EpiResid<true> E{F.in[I_X], F.in[I_CTX], (bf16*)(ws + WS_HB), mods + 2 * 1024};
        pg8::gemm_phase<pg8::EpiResid<true>, pg8::SchedSplit>(F.lds, 1024, S, E);
        ctr_publish(F, heavy ? WS_P5C : WS_P5F, heavy ? 2 : 1, xcd_census(F, [&](int v) { return ((v & 31) >= 28) == heavy; }));
    })
    PH(6, { phase_route<true>(F, 0, T); }) SEAM(6);
    PH(7, {
        const int ntile = moe_tables(F, 0);
        const int Lg = ntile & 63; const bool isLong = (F.vcu >> 2) < Lg;
        const unsigned nxc = xcd_census(F, [&](int v) { return ((v >> 2) < Lg) == isLong; });
        if constexpr (FP8_G1_L0) {
            pg8::SchedMoe<true> S{(const char*)(ws + WS_BUFA), (const char*)(ws + WS_W_M1) + (size_t)0 * 32 * MiB, (const int*)(ws + WS_TOKMAP), (const LAS int*)(F.lds + LDS_CTL + 64), (const LAS int*)(F.lds + LDS_CTL + 192), 512, (size_t)MiB, ntile * 4, F.vcu, F.G};
            pg8::EpiSwiglu8 E{(unsigned char*)(ws + WS_BUFZ), pg8::W1_SCALE};
            pg8::gemm_phase<pg8::EpiSwiglu8, pg8::SchedMoe<true>, true>(F.lds, 512, S, E);
        } else {
            pg8::SchedMoe<true> S{(const char*)(ws + WS_BUFA), (const char*)(ws + WS_W_M1) + (size_t)0 * 32 * MiB, (const int*)(ws + WS_TOKMAP), (const LAS int*)(F.lds + LDS_CTL + 64), (const LAS int*)(F.lds + LDS_CTL + 192), 1024, (size_t)2 * MiB, ntile * 4, F.vcu, F.G};
            if constexpr (FP8_G2_L0) { pg8::EpiSwiglu8 E{(unsigned char*)(ws + WS_BUFZ), 1.0f}; pg8::gemm_phase<pg8::EpiSwiglu8, pg8::SchedMoe<true>>(F.lds, 1024, S, E); }
            else { pg8::EpiSwiglu E{(bf16*)(ws + WS_BUFZ)}; pg8::gemm_phase<pg8::EpiSwiglu, pg8::SchedMoe<true>>(F.lds, 1024, S, E); }
        }
        ctr_publish(F, WS_G1CNT + (size_t)(0 * 2 + (isLong ? 1 : 0)) * 256, 3 + 0 * 2 + (isLong ? 1 : 0), nxc);
    })
    PH(8, {
        const int ntile = moe_tables(F, 0);
        const int Rp = ntile >> 6, Lg = ntile & 63, grp = F.vcu >> 2; const bool isLong = grp < Lg;
        const size_t cnt0 = WS_G1CNT + (size_t)(0 * 2) * 256;
        ctr_wait(F, cnt0 + (isLong ? 256 : 0), (unsigned)(isLong ? 4 * Lg : 256 - 4 * Lg));
        if constexpr (FP8_G2_L0) {
            { pg8::EpiStoreF8 E{(unsigned char*)(ws + WS_BUFP), 1024, pg8::OS_SCALE / (pg8::HID_SCALE * pg8::W2_SCALE)};
              pg8::SchedMoe<false> S{(const char*)(ws + WS_BUFZ), (const char*)(ws + WS_W_M2) + (size_t)0 * 16 * MiB, nullptr, (const LAS int*)(F.lds + LDS_CTL + 64), (const LAS int*)(F.lds + LDS_CTL + 192), 256, (size_t)512 * KiB, Rp * 256, F.vcu, F.G};
              pg8::gemm_phase<pg8::EpiStoreF8, pg8::SchedMoe<false>, true>(F.lds, 256, S, E); }
            const int nt2 = __builtin_amdgcn_readfirstlane(*(const LAS int*)(F.lds + LDS_CTL + 64 + 64)), Lg2 = nt2 & 63, grp2 = F.vcu >> 2;
            int xc = -1;
            if (grp2 < Lg2) { if (63 - grp2 < Lg2) xc = F.vcu; }
            else if (63 - grp2 < Lg2) xc = 4 * (63 - grp2) + (F.vcu & 3);
            if (xc >= 0) {
                if (grp2 >= Lg2) ctr_wait(F, WS_G1CNT + (size_t)(0 * 2 + 1) * 256, (unsigned)(4 * Lg2));
                pg8::EpiStoreF8 E{(unsigned char*)(ws + WS_BUFP), 1024, pg8::OS_SCALE / (pg8::HID_SCALE * pg8::W2_SCALE)};
                pg8::SchedMoe<false> S{(const char*)(ws + WS_BUFZ), (const char*)(ws + WS_W_M2) + (size_t)0 * 16 * MiB, nullptr, (const LAS int*)(F.lds + LDS_CTL + 64), (const LAS int*)(F.lds + LDS_CTL + 192), 256, (size_t)512 * KiB, nt2 * 4, (nt2 >> 6) * 256 + xc, 1 << 20};
                pg8::gemm_phase<pg8::EpiStoreF8, pg8::SchedMoe<false>, true>(F.lds, 256, S, E);
            }
        } else {
            if (Lg > 0 && Lg < 64) ctr_wait(F, cnt0 + (isLong ? 0 : 256), (unsigned)(isLong ? 256 - 4 * Lg : 4 * Lg));
            pg8::SchedMoe<false> S{(const char*)(ws + WS_BUFZ), (const char*)(ws + WS_W_M2) + (size_t)0 * 16 * MiB, nullptr, (const LAS int*)(F.lds + LDS_CTL + 64), (const LAS int*)(F.lds + LDS_CTL + 192), 512, (size_t)MiB, ntile * 4, F.vcu, F.G};
            pg8::EpiStore E{(bf16*)(ws + WS_BUFP), 1024};
            pg8::gemm_phase<pg8::EpiStore, pg8::SchedMoe<false>>(F.lds, 512, S, E);
        }
    }) SEAM(8);
    PH(9, { (void)moe_tables(F, 0); phase_combine(F, 0, T); }) SEAM(9);
    PH(10, {
        pg8::SchedDense S{(const char*)(ws + WS_BUFA), (const char*)(ws + WS_W_OIN), 1024, 5, 128, 4, 648, F.vcu, F.G};
        pg8::EpiStore E{(bf16*)(ws + WS_BUFP), OIN};
        pg8::gemm_phase<pg8::EpiStore, pg8::SchedDense>(F.lds, 1024, S, E);
        if (F.vcu >= 136) { __syncthreads(); convert_l1_range(F, (F.vcu - 136) * L1T_N, L1T_N, 44); }
    }) SEAM(10);
    PH(11, { phase_attn_pool(F); }) SEAM(11);
    PH(12, {
        pg8::SchedDense S{(const char*)(ws + WS_BUFA), (const char*)(ws + WS_W_OOUT), 1024, 4, 128, 0, 512, F.vcu, F.G};
        pg8::EpiResid<false> E{nullptr, nullptr, (bf16*)(ws + WS_HB), mods + 9 * 6144 + 2 * 1024};
        pg8::gemm_phase<pg8::EpiResid<false>, pg8::SchedDense>(F.lds, 1024, S, E);
    }) SEAM(12);
    PH(13, { phase_route<false>(F, 1, TL); }) SEAM(13);
    PH(14, {
        const int ntile = moe_tables(F, 1);
        const int Lg = ntile & 63; const bool isLong = (F.vcu >> 2) < Lg;
        const unsigned nxc = xcd_census(F, [&](int v) { return ((v >> 2) < Lg) == isLong; });
        if constexpr (FP8_G1_L1) {
            pg8::SchedMoe<true> S{(const char*)(ws + WS_BUFA), (const char*)(ws + WS_W_M1) + (size_t)1 * 32 * MiB, (const int*)(ws + WS_TOKMAP), (const LAS int*)(F.lds + LDS_CTL + 64), (const LAS int*)(F.lds + LDS_CTL + 192), 512, (size_t)MiB, ntile * 4, F.vcu, F.G};
            pg8::EpiSwiglu8 E{(unsigned char*)(ws + WS_BUFZ), pg8::W1_SCALE};
            pg8::gemm_phase<pg8::EpiSwiglu8, pg8::SchedMoe<true>, true>(F.lds, 512, S, E);
        } else {
            pg8::SchedMoe<true> S{(const char*)(ws + WS_BUFA), (const char*)(ws + WS_W_M1) + (size_t)1 * 32 * MiB, (const int*)(ws + WS_TOKMAP), (const LAS int*)(F.lds + LDS_CTL + 64), (const LAS int*)(F.lds + LDS_CTL + 192), 1024, (size_t)2 * MiB, ntile * 4, F.vcu, F.G};
            if constexpr (FP8_G2_L1) { pg8::EpiSwiglu8 E{(unsigned char*)(ws + WS_BUFZ), 1.0f}; pg8::gemm_phase<pg8::EpiSwiglu8, pg8::SchedMoe<true>>(F.lds, 1024, S, E); }
            else { pg8::EpiSwiglu E{(bf16*)(ws + WS_BUFZ)}; pg8::gemm_phase<pg8::EpiSwiglu, pg8::SchedMoe<true>>(F.lds, 1024, S, E); }
        }
        ctr_publish(F, WS_G1CNT + (size_t)(1 * 2 + (isLong ? 1 : 0)) * 256, 3 + 1 * 2 + (isLong ? 1 : 0), nxc);
    })
    PH(15, {
        const int ntile = moe_tables(F, 1);
        const int Rp = ntile >> 6, Lg = ntile & 63, grp = F.vcu >> 2; const bool isLong = grp < Lg;
        const size_t cnt0 = WS_G1CNT + (size_t)(1 * 2) * 256;
        ctr_wait(F, cnt0 + (isLong ? 256 : 0), (unsigned)(isLong ? 4 * Lg : 256 - 4 * Lg));
        if constexpr (FP8_G2_L1) {
            { pg8::EpiStoreF8 E{(unsigned char*)(ws + WS_BUFP), 1024, pg8::OS_SCALE / (pg8::HID_SCALE * pg8::W2_SCALE)};
              pg8::SchedMoe<false> S{(const char*)(ws + WS_BUFZ), (const char*)(ws + WS_W_M2) + (size_t)1 * 16 * MiB, nullptr, (const LAS int*)(F.lds + LDS_CTL + 64), (const LAS int*)(F.lds + LDS_CTL + 192), 256, (size_t)512 * KiB, Rp * 256, F.vcu, F.G};
              pg8::gemm_phase<pg8::EpiStoreF8, pg8::SchedMoe<false>, true>(F.lds, 256, S, E); }
            const int nt2 = __builtin_amdgcn_readfirstlane(*(const LAS int*)(F.lds + LDS_CTL + 64 + 64)), Lg2 = nt2 & 63, grp2 = F.vcu >> 2;
            int xc = -1;
            if (grp2 < Lg2) { if (63 - grp2 < Lg2) xc = F.vcu; }
            else if (63 - grp2 < Lg2) xc = 4 * (63 - grp2) + (F.vcu & 3);
            if (xc >= 0) {
                if (grp2 >= Lg2) ctr_wait(F, WS_G1CNT + (size_t)(1 * 2 + 1) * 256, (unsigned)(4 * Lg2));
                pg8::EpiStoreF8 E{(unsigned char*)(ws + WS_BUFP), 1024, pg8::OS_SCALE / (pg8::HID_SCALE * pg8::W2_SCALE)};
                pg8::SchedMoe<false> S{(const char*)(ws + WS_BUFZ), (const char*)(ws + WS_W_M2) + (size_t)1 * 16 * MiB, nullptr, (const LAS int*)(F.lds + LDS_CTL + 64), (const LAS int*)(F.lds + LDS_CTL + 192), 256, (size_t)512 * KiB, nt2 * 4, (nt2 >> 6) * 256 + xc, 1 << 20};
                pg8::gemm_phase<pg8::EpiStoreF8, pg8::SchedMoe<false>, true>(F.lds, 256, S, E);
            }
        } else {
            if (Lg > 0 && Lg < 64) ctr_wait(F, cnt0 + (isLong ? 0 : 256), (unsigned)(isLong ? 256 - 4 * Lg : 4 * Lg));
            pg8::SchedMoe<false> S{(const char*)(ws + WS_BUFZ), (const char*)(ws + WS_W_M2) + (size_t)1 * 16 * MiB, nullptr, (const LAS int*)(F.lds + LDS_CTL + 64), (const LAS int*)(F.lds + LDS_CTL + 192), 512, (size_t)MiB, ntile * 4, F.vcu, F.G};
            pg8::EpiStore E{(bf16*)(ws + WS_BUFP), 1024};
            pg8::gemm_phase<pg8::EpiStore, pg8::SchedMoe<false>>(F.lds, 512, S, E);
        }
    }) SEAM(15);
    PH(16, { (void)moe_tables(F, 1); phase_combine(F, 1, TL); }) SEAM(16);
#ifdef DBG_XBAR
    if (hi - lo > 1) { for (int xb = 0; xb < DBG_XBAR; ++xb) xcd_barrier(bar); }
#endif
#undef IN
#undef SEAM
}

extern "C" void kernel_launch(void* const* d_in, const int* in_sizes, int n_in, void* d_out, int out_size, void* d_ws, size_t ws_size, hipStream_t stream) {
    static int grid = 0;
    if (grid == 0) {
        if (n_in != 22 || ws_size < WS_END) { fprintf(stderr, "kernel_launch: unexpected inputs (n_in %d, ws %zu)\n", n_in, ws_size); grid = -1; return; }
        int dev = 0, cus = 0, per_cu = 0;
        if (hipGetDevice(&dev) != hipSuccess || hipDeviceGetAttribute(&cus, hipDeviceAttributeMultiprocessorCount, dev) != hipSuccess) { grid = -1; return; }
        if (hipFuncSetAttribute((const void*)mk_fwd, hipFuncAttributeMaxDynamicSharedMemorySize, LDS_BYTES) != hipSuccess) { fprintf(stderr, "kernel_launch: hipFuncSetAttribute failed\n"); grid = -1; return; }
        if (hipOccupancyMaxActiveBlocksPerMultiprocessor(&per_cu, (const void*)mk_fwd, NWAVES * 64, LDS_BYTES) != hipSuccess || per_cu < 1) { fprintf(stderr, "kernel_launch: occupancy query says %d\n", per_cu); }
        (void)hipGetLastError();
        grid = cus;
        if (grid != 256) { fprintf(stderr, "kernel_launch: %d CUs; this build assumes 256\n", grid); }
    }
    if (grid < 0) return;
    (void)hipMemsetAsync((char*)d_ws + WS_CTL, 0, CTL_ZERO_BYTES, stream);
    Args a{};
    for (int i = 0; i < 22; ++i) a.in[i] = (const float*)d_in[i];
    a.out = (float*)d_out; a.ws = (unsigned char*)d_ws;
#if MK_MULTI
    for (int p = 0; p <= DBG_STOP; ++p) { a.ph_lo = p; a.ph_hi = p + 1; hipLaunchKernelGGL(mk_fwd, dim3(grid), dim3(NWAVES * 64), LDS_BYTES, stream, a); }
    if (DBG_STOP < 16) { a.ph_lo = 17; a.ph_hi = 18; hipLaunchKernelGGL(mk_fwd, dim3(grid), dim3(NWAVES * 64), LDS_BYTES, stream, a); }
#else
    a.ph_lo = 0; a.ph_hi = 17;
    hipLaunchKernelGGL(mk_fwd, dim3(grid), dim3(NWAVES * 64), LDS_BYTES, stream, a);
#endif
}
```

```cpp
#include <hip/hip_runtime.h>
#include <cstdio>
#include <cstdint>
#include <type_traits>

#ifndef FP8_IN1
#define FP8_IN1 1
#endif
#ifndef MK_MULTI
#define MK_MULTI 0
#endif
#ifndef DBG_STOP
#define DBG_STOP 16
#endif

#ifndef DBG_DOUBLE
#define DBG_DOUBLE 0u
#endif
#ifndef FP8_G1_L0
#define FP8_G1_L0 1
#endif
#ifndef FP8_G1_L1
#define FP8_G1_L1 1
#endif
#ifndef FP8_G2_L0
#define FP8_G2_L0 1
#endif
#ifndef FP8_G2_L1
#define FP8_G2_L1 1
#endif
#define LAS __attribute__((address_space(3)))
#define GAS __attribute__((address_space(1)))
typedef unsigned short bf16;
typedef short bf16x8 __attribute__((ext_vector_type(8)));
typedef short s16x4 __attribute__((ext_vector_type(4)));
typedef float f32x4 __attribute__((ext_vector_type(4)));
typedef float f32x16 __attribute__((ext_vector_type(16)));
typedef unsigned u32x4 __attribute__((ext_vector_type(4)));
typedef unsigned u32x2 __attribute__((ext_vector_type(2)));

constexpr int NB = 8, NSEQ = 4096, D = 1024, LCTX = 256;
constexpr int TL = NB * NSEQ, TC = NB * LCTX, T = TL + TC;
constexpr int EIN = 2048;
constexpr int OIN = 1280;
constexpr int NE = 16, DE = 512;
constexpr int MAXSLOT = 73728;
constexpr float EPS = 1e-6f;

constexpr size_t KiB = 1024, MiB = 1024 * 1024;
constexpr size_t WS_CTL = 0, CTL_ZERO_BYTES = 64 * KiB;
constexpr size_t WS_MODS = 64 * KiB;
constexpr size_t WS_ROPE = WS_MODS + 512 * KiB;
constexpr size_t WS_WA = WS_ROPE + 8 * KiB;
constexpr size_t WS_WAC = WS_WA + 32 * KiB;
constexpr size_t WS_WCC = WS_WAC + 2 * KiB;
constexpr size_t WS_FD = 3 * MiB - 64 * KiB;
constexpr size_t WS_BCNT = WS_WCC + 16 * KiB;
constexpr size_t WS_TILEMAP = WS_BCNT + 16 * KiB;
constexpr size_t WS_SLOT = WS_TILEMAP + 2 * KiB;
constexpr size_t WS_WROW = WS_SLOT + 288 * KiB;
constexpr size_t WS_ROUTE = WS_WROW + 288 * KiB;
constexpr size_t WS_WC = 3 * MiB;
constexpr size_t WS_W_EIN = 4 * MiB;
constexpr size_t WS_W_EOUT = 9 * MiB;
constexpr size_t WS_W_OIN = 11 * MiB;
constexpr size_t WS_W_OOUT = 14 * MiB;
constexpr size_t WS_W_POOL = 16 * MiB;
constexpr size_t WS_W_M1 = 17 * MiB;
constexpr size_t WS_W_M2 = 81 * MiB;
constexpr size_t WS_HC = 113 * MiB;
constexpr size_t WS_BUFA = 121 * MiB;
constexpr size_t WS_BUFP = 189 * MiB;
constexpr size_t WS_BUFZ = 360 * MiB;
constexpr size_t WS_TOKMAP = 432 * MiB;
constexpr size_t WS_HB = 435 * MiB;
constexpr size_t WS_END = 503 * MiB;
constexpr size_t WS_MODSDONE = 24 * KiB;
constexpr size_t WS_FAF = 28 * KiB + 512;
constexpr size_t WS_P5F = 28 * KiB, WS_P5C = 28 * KiB + 256;
constexpr size_t WS_CENSUS = 28 * KiB + 768;
constexpr size_t WS_XCDOF = 60 * KiB;
constexpr size_t WS_G1CNT = 61 * KiB;
constexpr size_t WS_XARR = 32 * KiB;
constexpr size_t WS_GCNT = 16 * KiB;
static_assert(WS_ROUTE + (size_t)T * 32 <= WS_WC, "small region");
static_assert((size_t)T * EIN * 2 <= WS_BUFZ - WS_BUFP && (size_t)MAXSLOT * 1024 * 2 <= WS_BUFZ - WS_BUFP, "BUFP");
static_assert((size_t)MAXSLOT * 512 * 2 <= WS_TOKMAP - WS_BUFZ && (size_t)T * 1024 * 2 <= WS_TOKMAP - WS_BUFZ, "BUFZ");
static_assert((size_t)16 * T * 4 <= WS_HB - WS_TOKMAP && (size_t)T * 1024 * 2 <= WS_END - WS_HB, "TOKMAP / HB");
static_assert((size_t)T * 1024 * 2 <= WS_BUFP - WS_BUFA, "BUFA");

constexpr int LDS_BYTES = 163840;
constexpr int LDS_GIDX = 147456;
constexpr int LDS_CTL = 146432;
constexpr int NWAVES = 8;

__device__ __forceinline__ unsigned f2bf(float f) { unsigned u = __builtin_bit_cast(unsigned, f); return (u + 0x7fffu + ((u >> 16) & 1u)) >> 16; }
__device__ __forceinline__ unsigned pk2(float lo, float hi) { return f2bf(lo) | (f2bf(hi) << 16); }
__device__ __forceinline__ float bflo(unsigned w) { return __builtin_bit_cast(float, w << 16); }
__device__ __forceinline__ float bfhi(unsigned w) { return __builtin_bit_cast(float, w & 0xffff0000u); }
__device__ __forceinline__ float wave_sum(float v) {
#pragma unroll
    for (int o = 1; o < 64; o <<= 1) v += __shfl_xor(v, o);
    return v;
}
__device__ __forceinline__ int ld_coh(const int* p) { return (int)__hip_atomic_load((const unsigned*)p, __ATOMIC_RELAXED, __HIP_MEMORY_SCOPE_AGENT); }
__device__ __forceinline__ float ld_cohf(const float* p) { return __builtin_bit_cast(float, __hip_atomic_load((const unsigned*)p, __ATOMIC_RELAXED, __HIP_MEMORY_SCOPE_AGENT)); }
#define LDS_WAIT() asm volatile("s_waitcnt lgkmcnt(0)" ::: "memory")

#define XB_TMO      128
#define XB_XCNT(j)  (256  + 64 * (j))
#define XB_XSUB(j)  (1280 + 64 * (j))
#define XB_XGEN(j)  (2304 + 64 * (j))
#define XB_TOP      3328
#define XB_TOPGEN   3392
#define XCD_BAR_WORDS 3456
#define XB_SPIN_CAP (1u << 18)
__device__ __forceinline__ unsigned xb_ld(unsigned* p)              { return __hip_atomic_load(p, __ATOMIC_RELAXED, __HIP_MEMORY_SCOPE_AGENT); }
__device__ __forceinline__ unsigned xb_add(unsigned* p, unsigned v) { return __hip_atomic_fetch_add(p, v, __ATOMIC_RELAXED, __HIP_MEMORY_SCOPE_AGENT); }
__device__ __forceinline__ unsigned xb_xcc_id() { return (unsigned)__builtin_amdgcn_s_getreg((3 << 11) | 20) & 0xFu; }
#define XB_SPIN(cond, bar) do { unsigned _sp = 0; while (cond) { __builtin_amdgcn_s_sleep(1); \
    if ((++_sp & 255u) == 0u) { if (xb_ld(&(bar)[XB_TMO])) break; if (_sp > XB_SPIN_CAP) { atomicAdd(&(bar)[XB_TMO], 1u); break; } } } } while (0)
struct XcdBarrier { unsigned* bar; unsigned x; volatile LAS unsigned* st; };
__device__ __forceinline__ XcdBarrier xcd_barrier_post(unsigned* bar, volatile LAS unsigned* st) {
    XcdBarrier b; b.bar = bar; b.x = xb_xcc_id(); b.st = st;
    if (threadIdx.x == 0) (void)xb_add(&bar[XB_XCNT(b.x)], 1u);
    return b;
}
__device__ __forceinline__ void xcd_barrier_complete(unsigned* bar, unsigned x, unsigned& nloc, unsigned& nx) {
    const unsigned G = gridDim.x * gridDim.y * gridDim.z;
    unsigned sum, cnt, mine, sp = 0u;
    for (;;) {
        sum = 0u; cnt = 0u; mine = 0u;
#pragma unroll
        for (unsigned j = 0; j < 16; ++j) { const unsigned c = xb_ld(&bar[XB_XCNT(j)]); sum += c; cnt += (c > 0u) ? 1u : 0u; mine = (j == x) ? c : mine; }
        if (sum == G) break;
        __builtin_amdgcn_s_sleep(1);
        if ((++sp & 255u) == 0u) { if (xb_ld(&bar[XB_TMO])) break; if (sp > XB_SPIN_CAP) { atomicAdd(&bar[XB_TMO], 1u); break; } }
    }
    nloc = mine > 0u ? mine : 1u; nx = cnt > 0u ? cnt : 1u;
}
__device__ __forceinline__ void xcd_barrier(const XcdBarrier& b) {
    asm volatile("s_waitcnt vmcnt(0)" ::: "memory");
    __syncthreads();
    if (threadIdx.x == 0) {
        unsigned* bar = b.bar;
        __builtin_amdgcn_s_waitcnt(0);
        unsigned nloc = b.st[0], nx = b.st[1];
        if (nloc == 0u) { xcd_barrier_complete(bar, b.x, nloc, nx); b.st[0] = nloc; b.st[1] = nx; }
        const unsigned old = xb_add(&bar[XB_XSUB(b.x)], 1u);
        const unsigned gen = old / nloc;
        if (old + 1u == (gen + 1u) * nloc) {
            __builtin_amdgcn_fence(__ATOMIC_RELEASE, "agent");
            asm volatile("s_waitcnt vmcnt(0)" ::: "memory");
            const unsigned og = xb_add(&bar[XB_TOP], 1u);
            const unsigned tg = og / nx;
            if (og + 1u == (tg + 1u) * nx) xb_add(&bar[XB_TOPGEN], 1u);
            else XB_SPIN(xb_ld(&bar[XB_TOPGEN]) == tg, bar);
            __builtin_amdgcn_fence(__ATOMIC_ACQUIRE, "agent");
            xb_add(&bar[XB_XGEN(b.x)], 1u);
            asm volatile("s_waitcnt vmcnt(0)" ::: "memory");
        } else {
            XB_SPIN(xb_ld(&bar[XB_XGEN(b.x)]) == gen, bar);
            __builtin_amdgcn_fence(__ATOMIC_ACQUIRE, "agent");
            asm volatile("s_waitcnt vmcnt(0)" ::: "memory");
        }
    }
    __syncthreads();
}

namespace pg8 {
constexpr int BM = 256, BK = 64, HALF = 128, HTB = HALF * BK * 2, STAGE_BYTES = 8 * HTB;
__host__ __device__ __forceinline__ int lds_byte(int r, int c) { const int st = (r >> 4) * 2 + (c >> 5), rr = r & 15, cc = c & 31, ob = rr * 64 + cc * 2; return st * 1024 + (ob ^ (((ob >> 9) & 1) << 5)); }
__host__ __device__ __forceinline__ void stage_rc(int b, int& R, int& C) { const int st = b / 1024, sb = b % 1024, swz = sb ^ (((sb >> 9) & 1) << 5); R = (st >> 1) * 16 + swz / 64; C = (st & 1) * 32 + (swz % 64) / 2; }
__host__ __device__ __forceinline__ int perm32(int rho) { const int n = rho >> 4, i = rho & 15; return 8 * (i >> 2) + 4 * n + (i & 3); }
struct Unit { int pm, pn, e; };
__device__ __forceinline__ unsigned cvt_pk_bf16(float lo, float hi) { unsigned r; asm volatile("v_cvt_pk_bf16_f32 %0, %1, %2" : "=v"(r) : "v"(lo), "v"(hi)); return r; }

typedef int v8i32 __attribute__((ext_vector_type(8)));
static_assert(FP8_G2_L0 && FP8_G2_L1, "the combine phases read the expert outputs as e4m3 bytes, which only the fp8 down GEMM writes");
typedef int v4i32 __attribute__((ext_vector_type(4)));
__device__ __forceinline__ v8i32 cat16(const bf16x8 lo, const bf16x8 hi) { return __builtin_shufflevector(__builtin_bit_cast(v4i32, lo), __builtin_bit_cast(v4i32, hi), 0, 1, 2, 3, 4, 5, 6, 7); }
template <class Epi, class Sched, bool FP8 = false>
__device__ __forceinline__ void gemm_phase(LAS unsigned char* lds, const int K, const Sched& S, const Epi& E) {
    const int tid = threadIdx.x, wid = __builtin_amdgcn_readfirstlane(tid >> 6), lane = tid & 63, wr = wid >> 2, wc = wid & 3, fr = lane & 15, fq = lane >> 4;
    const int nt = K / BK;
    int tidv = tid;
#define PG8_VB(i) ([&]() -> unsigned { int R_, C_; stage_rc(tidv * 16 + (i) * 8192, R_, C_); const int Rb_ = Epi::PERM ? ((R_ & ~31) + perm32(R_ & 31)) : R_; return (unsigned)(Rb_ * K + C_) * 2u; }())
#define PG8_VA(h, i) ([&]() -> unsigned { int R_, C_; stage_rc(tidv * 16 + (i) * 8192, R_, C_); return (unsigned)((128 * (h) + R_) * K + C_) * 2u; }())
    const size_t kstep = (size_t)(BK * 2);
    const size_t hstep = (size_t)HALF * K * 2;
    const unsigned ldsw = (unsigned)wid * 1024u;
#define aoff (lds_byte(wr * 64 + (tidv & 15), ((tidv >> 4) & 3) * 8))
#define boff (lds_byte(wc * 32 + (tidv & 15), ((tidv >> 4) & 3) * 8))
#define PG8_SA(b, h) (((b) * 2 + (h)) * HTB)
#define PG8_SB(b, h) ((4 + (b) * 2 + (h)) * HTB)
#define PG8_STAGEB(bufoff, gbase) do { _Pragma("unroll") for (int _i = 0; _i < 2; ++_i) \
        __builtin_amdgcn_global_load_lds((const unsigned*)((const char*)(gbase) + PG8_VB(_i)), (LAS unsigned*)(lds + (bufoff) + ldsw + _i * 8192), 16, 0, 0); } while (0)
#define PG8_STAGEA(bufoff, gbase, h, NEXT) do { _Pragma("unroll") for (int _i = 0; _i < 2; ++_i) { unsigned vo_; \
        if constexpr (Sched::GATHER) { int R_, C_; stage_rc(tidv * 16 + _i * 8192, R_, C_); const unsigned raw_ = gidx[((((NEXT) && usen) ? (gslot ^ 1u) : gslot) * 4u + (h) * 2 + _i) * 512u + tid]; vo_ = (raw_ * (unsigned)K + (unsigned)C_) * 2u; } \
        else vo_ = PG8_VA(h, _i); \
        __builtin_amdgcn_global_load_lds((const unsigned*)((const char*)(gbase) + vo_), (LAS unsigned*)(lds + (bufoff) + ldsw + _i * 8192), 16, 0, 0); } } while (0)
#define PG8_LDA(dst, b, h) do { _Pragma("unroll") for (int m = 0; m < 4; ++m) _Pragma("unroll") for (int k = 0; k < 2; ++k) dst[m][k] = *(const LAS bf16x8*)(lds + PG8_SA(b, h) + aoff + m * 2048 + k * 1024); } while (0)
#define PG8_LDB(dst, b, h) do { _Pragma("unroll") for (int n = 0; n < 2; ++n) _Pragma("unroll") for (int k = 0; k < 2; ++k) dst[n][k] = *(const LAS bf16x8*)(lds + PG8_SB(b, h) + boff + n * 2048 + k * 1024); } while (0)
#define PG8_MMA(ai, bj, At, Bt) do { __builtin_amdgcn_s_setprio(1); _Pragma("unroll") for (int m = 0; m < 4; ++m) _Pragma("unroll") for (int n = 0; n < 2; ++n) { \
        if constexpr (FP8) acc[ai][bj][m][n] = __builtin_amdgcn_mfma_scale_f32_16x16x128_f8f6f4(cat16(Bt[n][0], Bt[n][1]), cat16(At[m][0], At[m][1]), acc[ai][bj][m][n], 0, 0, 0, 0x7f7f7f7f, 0, 0x7f7f7f7f); \
        else { _Pragma("unroll") for (int k = 0; k < 2; ++k) acc[ai][bj][m][n] = __builtin_amdgcn_mfma_f32_16x16x32_bf16(Bt[n][k], At[m][k], acc[ai][bj][m][n], 0, 0, 0); } } \
        __builtin_amdgcn_s_setprio(0); } while (0)
#define PG8_WAIT_V(n) asm volatile("s_waitcnt vmcnt(" #n ")" ::: "memory")
#define PG8_WAIT_L(n) asm volatile("s_waitcnt lgkmcnt(" #n ")" ::: "memory")
#define PG8_BAR __builtin_amdgcn_s_barrier()
#define PG8_SCHED __builtin_amdgcn_sched_barrier(0)
#define PG8_ITER(A1, A2, A3, B2, B3) do { \
            PG8_LDB(B0, 0, 0); PG8_LDB(B1, 0, 1); PG8_SCHED; PG8_LDA(At, 0, 0); PG8_STAGEA(PG8_SA(1, 1), A1, 1, 0); \
            PG8_WAIT_V(8); PG8_WAIT_L(0); PG8_BAR; PG8_MMA(0, 0, At, B0); PG8_MMA(0, 1, At, B1); PG8_BAR; PG8_SCHED; \
            PG8_LDA(At, 0, 1); PG8_STAGEB(PG8_SB(0, 0), B2); PG8_STAGEB(PG8_SB(0, 1), (B2) + hstep); PG8_STAGEA(PG8_SA(0, 0), A2, 0, 1); \
            PG8_WAIT_V(8); PG8_WAIT_L(0); PG8_BAR; PG8_MMA(1, 0, At, B0); PG8_MMA(1, 1, At, B1); PG8_BAR; PG8_SCHED; \
            PG8_LDB(B0, 1, 0); PG8_LDB(B1, 1, 1); PG8_SCHED; PG8_LDA(At, 1, 0); PG8_STAGEA(PG8_SA(0, 1), A2, 1, 1); \
            PG8_WAIT_V(8); PG8_WAIT_L(0); PG8_BAR; PG8_MMA(0, 0, At, B0); PG8_MMA(0, 1, At, B1); PG8_BAR; PG8_SCHED; \
            PG8_LDA(At, 1, 1); PG8_STAGEB(PG8_SB(1, 0), B3); PG8_STAGEB(PG8_SB(1, 1), (B3) + hstep); PG8_STAGEA(PG8_SA(1, 0), A3, 0, 1); \
            PG8_WAIT_V(8); PG8_WAIT_L(0); PG8_BAR; PG8_MMA(1, 0, At, B0); PG8_MMA(1, 1, At, B1); PG8_BAR; PG8_SCHED; } while (0)
    Unit cur, nxt; int ui = 0;
    if (!S.next(0, cur)) return;
    f32x4 acc[2][2][4][2];
#pragma unroll
    for (int a = 0; a < 2; ++a)
#pragma unroll
        for (int b = 0; b < 2; ++b)
#pragma unroll
            for (int m = 0; m < 4; ++m)
#pragma unroll
                for (int n = 0; n < 2; ++n) acc[a][b][m][n] = (f32x4){0.f, 0.f, 0.f, 0.f};
    bf16x8 At[4][2], B0[2][2], B1[2][2];
    const LAS unsigned* gidx = (const LAS unsigned*)(lds + LDS_GIDX); unsigned gslot = 0u;
    if constexpr (Sched::GATHER) { S.idx_dma(cur, (LAS unsigned*)(lds + LDS_GIDX), tidv, wid); asm volatile("s_waitcnt vmcnt(0)" ::: "memory"); }
    const char* cA = S.a_base(cur); const char* cB = S.b_base(cur);
    constexpr bool usen = false;
    PG8_STAGEB(PG8_SB(0, 0), cB); PG8_STAGEB(PG8_SB(0, 1), cB + hstep); PG8_STAGEA(PG8_SA(0, 0), cA, 0, 0); PG8_STAGEA(PG8_SA(0, 1), cA, 1, 0);
    if (wr == 1) PG8_BAR;
    PG8_WAIT_V(2); PG8_BAR;
    PG8_STAGEB(PG8_SB(1, 0), cB + kstep); PG8_STAGEA(PG8_SA(1, 0), cA + kstep, 0, 0); PG8_STAGEB(PG8_SB(1, 1), cB + hstep + kstep);
    PG8_WAIT_V(6); PG8_BAR;
    for (;;) {
        const bool has_next = S.next(ui + 1, nxt);
        const char* nA = has_next ? S.a_base(nxt) : cA; const char* nB = has_next ? S.b_base(nxt) : cB;
#pragma unroll 1
        for (int t = 0; t < nt; t += 2) {
            const bool last = (t == nt - 2);
            const char* a1 = cA + (size_t)(t + 1) * kstep;
            const char* a2 = last ? nA : cA + (size_t)(t + 2) * kstep; const char* b2 = last ? nB : cB + (size_t)(t + 2) * kstep;
            tidv = tid; asm volatile("" : "+v"(tidv));
            if constexpr (Sched::GATHER) {
                if (t == nt - 4 && has_next) S.idx_dma(nxt, (LAS unsigned*)(lds + LDS_GIDX) + (gslot ^ 1u) * 2048u, tidv, wid);
            }
            const bool usen = last && has_next;
            PG8_ITER(a1, a2, a2 + kstep, b2, b2 + kstep);
        }
        if (wr == 0) PG8_BAR;
        E(acc, cur, wr, wc, fr, fq);
        if (!has_next) break;
#pragma unroll
        for (int a = 0; a < 2; ++a)
#pragma unroll
            for (int b = 0; b < 2; ++b)
#pragma unroll
                for (int m = 0; m < 4; ++m)
#pragma unroll
                    for (int n = 0; n < 2; ++n) acc[a][b][m][n] = (f32x4){0.f, 0.f, 0.f, 0.f};
        cur = nxt; cA = nA; cB = nB; ++ui;
        if constexpr (Sched::GATHER) gslot ^= 1u;
        if (wr == 1) PG8_BAR;
    }
    PG8_WAIT_V(0);
    PG8_BAR;
#undef PG8_ITER
#undef aoff
#undef boff
#undef PG8_SA
#undef PG8_SB
#undef PG8_STAGEA
#undef PG8_STAGEB
#undef PG8_VA
#undef PG8_VB
#undef PG8_LDA
#undef PG8_LDB
#undef PG8_MMA
#undef PG8_WAIT_V
#undef PG8_WAIT_L
#undef PG8_BAR
#undef PG8_SCHED
}

struct SchedDense {
    static constexpr bool GATHER = false;
    const char* A; const char* Bt; int K, nN, nMfull, pnx, nUnits, c, G;
    __device__ __forceinline__ bool next(int i, Unit& u) const {
        const int L = i * G + c; if (L >= nUnits) return false;
        const int full = nMfull * nN;
        if (L < full) { u.pm = L / nN; u.pn = L - u.pm * nN; } else { u.pm = nMfull + (L - full); u.pn = pnx; }
        u.e = 0; return true;
    }
    __device__ __forceinline__ const char* a_base(const Unit& u) const { return A + (size_t)u.pm * 256 * K * 2; }
    __device__ __forceinline__ const char* b_base(const Unit& u) const { return Bt + (size_t)u.pn * 256 * K * 2; }
};
struct SchedSplit {
    static constexpr bool GATHER = false;
    const char* A; const char* Bt; int K, base, stride, n;
    __device__ __forceinline__ bool next(int i, Unit& u) const {
        if (i >= n) return false;
        const int L = base + i * stride; u.pm = L >> 2; u.pn = L & 3; u.e = 0; return true;
    }
    __device__ __forceinline__ const char* a_base(const Unit& u) const { return A + (size_t)u.pm * 256 * K * 2; }
    __device__ __forceinline__ const char* b_base(const Unit& u) const { return Bt + (size_t)u.pn * 256 * K * 2; }
};
template <bool GATHER_> struct SchedMoe {
    static constexpr bool GATHER = GATHER_, gather = GATHER_;
    const char* A; const char* W; const int* tokmap; const LAS int* tb; const LAS int* cn; int K; size_t wstride; int nUnits, c, G;
    __device__ __forceinline__ bool next(int i, Unit& u) const {
        const int L = i * G + c; if (L >= nUnits) return false;
        u.pm = L >> 2; u.pn = L & 3; int e = 0;
#pragma unroll
        for (int q = 1; q < 16; ++q) if (u.pm >= __builtin_amdgcn_readfirstlane(tb[q])) e = q;
        u.e = __builtin_amdgcn_readfirstlane(e); return true;
    }
    __device__ __forceinline__ const char* a_base(const Unit& u) const { return gather ? A : A + (size_t)u.pm * 256 * K * 2; }
    __device__ __forceinline__ const char* b_base(const Unit& u) const { return W + (size_t)u.e * wstride + (size_t)u.pn * 256 * K * 2; }
    __device__ __forceinline__ void idx_dma(const Unit& u, LAS unsigned* slot, int tidv, int wid) const {
        const int p0 = (u.pm - __builtin_amdgcn_readfirstlane(tb[u.e])) * 256, last = __builtin_amdgcn_readfirstlane(cn[u.e]) - 1; const int* tm = tokmap + (size_t)u.e * T;
#pragma unroll
        for (int h = 0; h < 2; ++h)
#pragma unroll
            for (int i = 0; i < 2; ++i) { int R_, C_; stage_rc(tidv * 16 + i * 8192, R_, C_); int pos = p0 + 128 * h + R_; pos = pos < last ? pos : last;
                __builtin_amdgcn_global_load_lds((const unsigned*)(tm + pos), slot + (h * 2 + i) * 512 + wid * 64, 4, 0, 0); }
    }
};

struct EpiStore {
    static constexpr bool PERM = true;
    bf16* O; int ldc;
    __device__ __forceinline__ void operator()(const f32x4 (&acc)[2][2][4][2], const Unit& u, int wr, int wc, int fr, int fq) const {
        const int row0 = u.pm * BM + wr * 64 + fr, col0 = u.pn * BM + wc * 32 + 8 * fq;
#pragma unroll
        for (int ai = 0; ai < 2; ++ai)
#pragma unroll
            for (int m = 0; m < 4; ++m) { bf16* rowp = O + (size_t)(row0 + ai * HALF + m * 16) * ldc + col0;
#pragma unroll
                for (int bj = 0; bj < 2; ++bj) { const f32x4 v0 = acc[ai][bj][m][0], v1 = acc[ai][bj][m][1];
                    u32x4 w; w.x = cvt_pk_bf16(v0[0], v0[1]); w.y = cvt_pk_bf16(v0[2], v0[3]); w.z = cvt_pk_bf16(v1[0], v1[1]); w.w = cvt_pk_bf16(v1[2], v1[3]);
                    *(u32x4*)(rowp + bj * HALF) = w; } }
    }
};
template <bool SRC_F32> struct EpiResid {
    static constexpr bool PERM = true;
    const float* srcL; const float* srcC; bf16* H; const float* gate;
    __device__ __forceinline__ void operator()(const f32x4 (&acc)[2][2][4][2], const Unit& u, int wr, int wc, int fr, int fq) const {
        const float* g = gate + (u.pm < 128 ? (u.pm >> 4) : 8) * 6144;
        const float* src = (u.pm < 128) ? srcL + (size_t)u.pm * 256 * 1024 : srcC + (size_t)(u.pm - 128) * 256 * 1024;
        bf16* dst = H + (size_t)u.pm * 256 * 1024;
        const int row0 = wr * 64 + fr, col0 = u.pn * BM + wc * 32 + 8 * fq;
        f32x4 gv[2][2];
#pragma unroll
        for (int bj = 0; bj < 2; ++bj)
#pragma unroll
            for (int n = 0; n < 2; ++n) gv[bj][n] = *(const f32x4*)(g + col0 + bj * HALF + 4 * n);
#pragma unroll
        for (int ai = 0; ai < 2; ++ai)
#pragma unroll
            for (int m = 0; m < 4; ++m) { const size_t ro = (size_t)(row0 + ai * HALF + m * 16) * 1024 + col0;
#pragma unroll
                for (int bj = 0; bj < 2; ++bj) {
                    f32x4 s0, s1;
                    if constexpr (SRC_F32) { s0 = __builtin_nontemporal_load((const f32x4*)(src + ro + bj * HALF)); s1 = __builtin_nontemporal_load((const f32x4*)(src + ro + bj * HALF + 4)); }
                    else { const u32x4 hv = *(const u32x4*)(dst + ro + bj * HALF); s0 = (f32x4){bflo(hv.x), bfhi(hv.x), bflo(hv.y), bfhi(hv.y)}; s1 = (f32x4){bflo(hv.z), bfhi(hv.z), bflo(hv.w), bfhi(hv.w)}; }
                    const f32x4 v0 = s0 + gv[bj][0] * acc[ai][bj][m][0], v1 = s1 + gv[bj][1] * acc[ai][bj][m][1];
                    u32x4 w; w.x = cvt_pk_bf16(v0[0], v0[1]); w.y = cvt_pk_bf16(v0[2], v0[3]); w.z = cvt_pk_bf16(v1[0], v1[1]); w.w = cvt_pk_bf16(v1[2], v1[3]);
                    *(u32x4*)(dst + ro + bj * HALF) = w; } }
    }
};
__device__ __forceinline__ float silu_f(float x) { return x * __builtin_amdgcn_rcpf(1.0f + __expf(-x)); }
struct EpiSwiglu {
    static constexpr bool PERM = true;
    bf16* H;
    __device__ __forceinline__ void operator()(const f32x4 (&acc)[2][2][4][2], const Unit& u, int wr, int wc, int fr, int fq) const {
        const int row0 = u.pm * BM + wr * 64 + fr, col0 = u.pn * 128 + wc * 32 + 8 * fq;
#pragma unroll
        for (int ai = 0; ai < 2; ++ai)
#pragma unroll
            for (int m = 0; m < 4; ++m) { bf16* p = H + (size_t)(row0 + ai * HALF + m * 16) * 512 + col0;
                const f32x4 g0 = acc[ai][0][m][0], g1 = acc[ai][0][m][1], u0 = acc[ai][1][m][0], u1 = acc[ai][1][m][1];
                u32x4 w; w.x = cvt_pk_bf16(silu_f(g0[0]) * u0[0], silu_f(g0[1]) * u0[1]); w.y = cvt_pk_bf16(silu_f(g0[2]) * u0[2], silu_f(g0[3]) * u0[3]);
                w.z = cvt_pk_bf16(silu_f(g1[0]) * u1[0], silu_f(g1[1]) * u1[1]); w.w = cvt_pk_bf16(silu_f(g1[2]) * u1[2], silu_f(g1[3]) * u1[3]);
                *(u32x4*)p = w; }
    }
};
__device__ __forceinline__ unsigned pk4_fp8(float a, float b, float c, float d) { int p = __builtin_amdgcn_cvt_pk_fp8_f32(a, b, 0, false); p = __builtin_amdgcn_cvt_pk_fp8_f32(c, d, p, true); return (unsigned)p; }
constexpr float W1_SCALE = 32.0f, W2_SCALE = 16.0f, HID_SCALE = 4.0f;
struct EpiSwiglu8 {
    static constexpr bool PERM = true;
    unsigned char* H; float in_scale;
    __device__ __forceinline__ void operator()(const f32x4 (&acc)[2][2][4][2], const Unit& u, int wr, int wc, int fr, int fq) const {
        const int row0 = u.pm * BM + wr * 64 + fr, col0 = u.pn * 128 + wc * 32 + 8 * fq;
        const float IS = 1.0f / in_scale, OS = HID_SCALE / in_scale;
#pragma unroll
        for (int ai = 0; ai < 2; ++ai)
#pragma unroll
            for (int m = 0; m < 4; ++m) { unsigned char* p = H + (size_t)(row0 + ai * HALF + m * 16) * 512 + col0;
                const f32x4 g0 = acc[ai][0][m][0] * IS, g1 = acc[ai][0][m][1] * IS, u0 = acc[ai][1][m][0] * OS, u1 = acc[ai][1][m][1] * OS;
#define HC8(x) __builtin_fminf(__builtin_fmaxf((x), -448.0f), 448.0f)
                u32x2 w; w.x = pk4_fp8(HC8(silu_f(g0[0]) * u0[0]), HC8(silu_f(g0[1]) * u0[1]), HC8(silu_f(g0[2]) * u0[2]), HC8(silu_f(g0[3]) * u0[3]));
                w.y = pk4_fp8(HC8(silu_f(g1[0]) * u1[0]), HC8(silu_f(g1[1]) * u1[1]), HC8(silu_f(g1[2]) * u1[2]), HC8(silu_f(g1[3]) * u1[3]));
#undef HC8
                *(u32x2*)p = w; }
    }
};
constexpr float OS_SCALE = 16.0f;
struct EpiStoreF8 {
    static constexpr bool PERM = true;
    unsigned char* O; int ldc; float scale;
    __device__ __forceinline__ void operator()(const f32x4 (&acc)[2][2][4][2], const Unit& u, int wr, int wc, int fr, int fq) const {
        const int row0 = u.pm * BM + wr * 64 + fr, col0 = u.pn * BM + wc * 32 + 8 * fq;
#pragma unroll
        for (int ai = 0; ai < 2; ++ai)
#pragma unroll
            for (int m = 0; m < 4; ++m) { unsigned char* rowp = O + (size_t)(row0 + ai * HALF + m * 16) * ldc + col0;
#pragma unroll
                for (int bj = 0; bj < 2; ++bj) { const f32x4 v0 = acc[ai][bj][m][0] * scale, v1 = acc[ai][bj][m][1] * scale;
#define HC8(x) __builtin_fminf(__builtin_fmaxf((x), -448.0f), 448.0f)
                    u32x2 w; w.x = pk4_fp8(HC8(v0[0]), HC8(v0[1]), HC8(v0[2]), HC8(v0[3])); w.y = pk4_fp8(HC8(v1[0]), HC8(v1[1]), HC8(v1[2]), HC8(v1[3]));
#undef HC8
                    *(u32x2*)(rowp + bj * HALF) = w; } }
    }
};
struct EpiStoreS {
    static constexpr bool PERM = true;
    bf16* O; int ldc; float scale;
    __device__ __forceinline__ void operator()(const f32x4 (&acc)[2][2][4][2], const Unit& u, int wr, int wc, int fr, int fq) const {
        const int row0 = u.pm * BM + wr * 64 + fr, col0 = u.pn * BM + wc * 32 + 8 * fq;
#pragma unroll
        for (int ai = 0; ai < 2; ++ai)
#pragma unroll
            for (int m = 0; m < 4; ++m) { bf16* rowp = O + (size_t)(row0 + ai * HALF + m * 16) * ldc + col0;
#pragma unroll
                for (int bj = 0; bj < 2; ++bj) { const f32x4 v0 = acc[ai][bj][m][0] * scale, v1 = acc[ai][bj][m][1] * scale;
                    u32x4 w; w.x = cvt_pk_bf16(v0[0], v0[1]); w.y = cvt_pk_bf16(v0[2], v0[3]); w.z = cvt_pk_bf16(v1[0], v1[1]); w.w = cvt_pk_bf16(v1[2], v1[3]);
                    *(u32x4*)(rowp + bj * HALF) = w; } }
    }
};
struct EpiScaleRow {
    static constexpr bool PERM = true;
    bf16* O; const float* wrow;
    __device__ __forceinline__ void operator()(const f32x4 (&acc)[2][2][4][2], const Unit& u, int wr, int wc, int fr, int fq) const {
        const int row0 = u.pm * BM + wr * 64 + fr, col0 = u.pn * BM + wc * 32 + 8 * fq;
#pragma unroll
        for (int ai = 0; ai < 2; ++ai)
#pragma unroll
            for (int m = 0; m < 4; ++m) { const int row = row0 + ai * HALF + m * 16; const float s = wrow[row]; bf16* rowp = O + (size_t)row * 1024 + col0;
#pragma unroll
                for (int bj = 0; bj < 2; ++bj) { const f32x4 v0 = acc[ai][bj][m][0] * s, v1 = acc[ai][bj][m][1] * s;
                    u32x4 w; w.x = cvt_pk_bf16(v0[0], v0[1]); w.y = cvt_pk_bf16(v0[2], v0[3]); w.z = cvt_pk_bf16(v1[0], v1[1]); w.w = cvt_pk_bf16(v1[2], v1[3]);
                    *(u32x4*)(rowp + bj * HALF) = w; } }
    }
};
}

struct Args { const float* in[22]; float* out; unsigned char* ws; int ph_lo, ph_hi; };
enum { I_X = 0, I_C, I_CTX, I_CCTX, I_ADAW, I_ADAB, I_NMG, I_NFG, I_EWIN, I_ECONV, I_EWOUT, I_OWIN, I_OPOOLW, I_OPOOLS, I_OSINK, I_OWOUT, I_RW, I_RB, I_MG, I_MU, I_MD, I_FG };

struct Frame {
    LAS unsigned char* lds;
    int tid, lane, wave, vcu, G;
    unsigned char* ws; const float* const* in; float* out;
};
__device__ __forceinline__ bf16* h_row(const Frame& F, int t) { return (bf16*)(F.ws + WS_HB) + (size_t)t * D; }
__device__ __forceinline__ int mod_row(int t) { return t < TL ? (t >> 12) : 8; }

struct TItem { const float* src; bf16* dst; int ldw, ldd; float f8scale; };
__device__ __forceinline__ void titem_load(const TItem& t, f32x4 (&r)[8], int lane) {
#pragma unroll
    for (int i = 0; i < 8; ++i) r[i] = __builtin_nontemporal_load((const f32x4*)(t.src + (size_t)((lane >> 3) + 8 * i) * t.ldw + 4 * (lane & 7)));
}
__device__ __forceinline__ void titem_process(const TItem& t, const f32x4 (&r)[8], LAS float* scr, int lane) {
#pragma unroll
    for (int i = 0; i < 8; ++i) { LAS float* d = scr + ((lane >> 3) + 8 * i) * 33 + 4 * (lane & 7); d[0] = r[i].x; d[1] = r[i].y; d[2] = r[i].z; d[3] = r[i].w; }
    LDS_WAIT(); asm volatile("" ::: "memory");
    const int c = lane & 7;
    if (t.f8scale != 0.0f) {
        const float sc = t.f8scale; unsigned char* d8 = (unsigned char*)t.dst;
#pragma unroll
        for (int j = 0; j < 4; ++j) { const int n = (lane >> 3) + 8 * j; const LAS float* s = scr + (8 * c) * 33 + n;
            u32x2 o; o.x = pg8::pk4_fp8(s[0 * 33] * sc, s[1 * 33] * sc, s[2 * 33] * sc, s[3 * 33] * sc); o.y = pg8::pk4_fp8(s[4 * 33] * sc, s[5 * 33] * sc, s[6 * 33] * sc, s[7 * 33] * sc);
            *(u32x2*)(d8 + (size_t)n * t.ldd + 8 * c) = o; }
    } else {
#pragma unroll
        for (int j = 0; j < 4; ++j) { const int n = (lane >> 3) + 8 * j; const LAS float* s = scr + (8 * c) * 33 + n;
            u32x4 o; o.x = pk2(s[0 * 33], s[1 * 33]); o.y = pk2(s[2 * 33], s[3 * 33]); o.z = pk2(s[4 * 33], s[5 * 33]); o.w = pk2(s[6 * 33], s[7 * 33]);
            *(u32x4*)(t.dst + (size_t)n * t.ldd + 8 * c) = o; }
    }
    LDS_WAIT(); asm volatile("" ::: "memory");
}
constexpr int L0T_N = 32;
constexpr int TS0 = 1024, TS1 = 512, TS2 = 384, TS3 = 512, TS4 = 0, TS5 = 4096, TS6 = 4096, TS7 = 4096, TNITEMS = TS0 + TS1 + TS2 + TS3 + TS4 + TS5 + TS6 + TS7;
__device__ __forceinline__ TItem titem_moe(const float* const* in, unsigned char* ws, int kind, int le, int rr) {
    TItem t; const int layer = le >> 4, e = le & 15; const bool f8 = (kind < 2) ? (layer ? (FP8_G1_L1 != 0) : (FP8_G1_L0 != 0)) : (layer ? (FP8_G2_L1 != 0) : (FP8_G2_L0 != 0));
    if (kind < 2) { const int kb = (rr >> 4) & 15, nb = rr & 15, n0 = nb * 32; const int drow = (n0 >> 7) * 256 + (n0 & 127) + kind * 128;
        t.src = in[kind ? I_MU : I_MG] + (size_t)le * 524288 + (size_t)(kb * 64) * 512 + n0; t.ldw = 512;
        unsigned char* base = ws + WS_W_M1 + (size_t)layer * 32 * MiB;
        if (f8) { t.dst = (bf16*)(base + (size_t)e * MiB + (size_t)drow * 1024 + kb * 64); t.ldd = 1024; t.f8scale = pg8::W1_SCALE; }
        else { t.dst = (bf16*)(base + (size_t)e * 2 * MiB) + (size_t)drow * 1024 + kb * 64; t.ldd = 1024; t.f8scale = 0.0f; } }
    else { const int kb = (rr >> 5) & 7, nb = rr & 31;
        t.src = in[I_MD] + (size_t)le * 524288 + (size_t)(kb * 64) * 1024 + nb * 32; t.ldw = 1024;
        unsigned char* base = ws + WS_W_M2 + (size_t)layer * 16 * MiB;
        if (f8) { t.dst = (bf16*)(base + (size_t)e * 512 * KiB + (size_t)(nb * 32) * 512 + kb * 64); t.ldd = 512; t.f8scale = pg8::W2_SCALE; }
        else { t.dst = (bf16*)(base + (size_t)e * MiB) + (size_t)(nb * 32) * 512 + kb * 64; t.ldd = 512; t.f8scale = 0.0f; } }
    return t;
}
__device__ __forceinline__ TItem titem_decode(const float* const* in, unsigned char* ws, int r) {
    TItem t;
    if (r < TS0) { const int kb = r / 64, nb = r % 64; t.src = in[I_EWIN] + (size_t)(kb * 64) * 2048 + nb * 32; t.ldw = 2048; t.dst = (bf16*)(ws + WS_W_EIN) + (size_t)(nb * 32) * 1024 + kb * 64; t.ldd = 1024; t.f8scale = 0.0f; return t; } r -= TS0;
    if (r < TS1) { const int kb = r / 32, nb = r % 32; t.src = in[I_EWOUT] + (size_t)(kb * 64) * 1024 + nb * 32; t.ldw = 1024; t.dst = (bf16*)(ws + WS_W_EOUT) + (size_t)(nb * 32) * 1024 + kb * 64; t.ldd = 1024; t.f8scale = 0.0f; return t; } r -= TS1;
    if (r < TS2) { const int kb = r / 24, nb = 16 + r % 24; t.src = in[I_OWIN] + (size_t)(kb * 64) * 1280 + nb * 32; t.ldw = 1280; if (FP8_IN1) { t.dst = (bf16*)(ws + WS_W_OIN + (size_t)(nb * 32) * 1024 + kb * 64); t.ldd = 1024; t.f8scale = pg8::W1_SCALE; } else { t.dst = (bf16*)(ws + WS_W_OIN) + (size_t)(nb * 32) * 1024 + kb * 64; t.ldd = 1024; t.f8scale = 0.0f; } return t; } r -= TS2;
    if (r < TS3) { const int kb = r / 32, nb = r % 32; t.src = in[I_OWOUT] + (size_t)(kb * 64) * 1024 + nb * 32; t.ldw = 1024; t.dst = (bf16*)(ws + WS_W_OOUT) + (size_t)(nb * 32) * 1024 + kb * 64; t.ldd = 1024; t.f8scale = 0.0f; return t; } r -= TS3;
    r += 192 * L0T_N;
    if (r < TS5 + TS6 + TS7) return titem_moe(in, ws, r / 4096, (r % 4096) >> 8, r % 256);
    return t;
}
constexpr int NL1 = 12288;
__device__ __forceinline__ TItem titem_l1(const float* const* in, unsigned char* ws, int r) { return titem_moe(in, ws, r / 4096, 16 + ((r % 4096) >> 8), r % 256); }
__device__ __forceinline__ TItem titem_lx(const float* const* in, unsigned char* ws, int layer, int r) { return titem_moe(in, ws, r / 4096, layer * 16 + ((r % 4096) >> 8), r % 256); }

constexpr size_t WS_CONVCTR = 20 * KiB;
__device__ __forceinline__ void convert_l1(Frame& F, int quota) {
    unsigned* ctr = (unsigned*)(F.ws + WS_CONVCTR);
    LAS float* scr = (LAS float*)(F.lds + F.wave * 17408);
    for (int ch = 0; ch < quota; ++ch) {
        const int c0 = __builtin_amdgcn_readfirstlane(F.lane == 0 ? (int)__hip_atomic_fetch_add(ctr, 4u, __ATOMIC_RELAXED, __HIP_MEMORY_SCOPE_AGENT) : 0);
        if (c0 >= NL1) break;
        f32x4 cur[8], nxt[8];
        TItem tc = titem_l1(F.in, F.ws, c0);
        titem_load(tc, nxt, F.lane);
#pragma unroll 1
        for (int i = 0; i < 4; ++i) {
#pragma unroll
            for (int j = 0; j < 8; ++j) cur[j] = nxt[j];
            const TItem tcur = tc;
            if (i < 3) { tc = titem_l1(F.in, F.ws, c0 + i + 1); titem_load(tc, nxt, F.lane); }
            titem_process(tcur, cur, scr, F.lane);
        }
    }
}
__device__ __forceinline__ void convert_l1_range(Frame& F, const int base, const int cnt, const int ctr_off, const int layer = 1) {
    LAS unsigned* ctr = (LAS unsigned*)(F.lds + LDS_CTL + ctr_off);
    LAS float* scr = (LAS float*)(F.lds + F.wave * 17408);
    f32x4 cur[8], nxt[8];
    int it = __builtin_amdgcn_readfirstlane(F.lane == 0 ? (int)atomicAdd((unsigned*)ctr, 1u) : 0);
    TItem tc = titem_lx(F.in, F.ws, layer, base + (it < cnt ? it : 0));
    if (it < cnt) titem_load(tc, nxt, F.lane);
    while (it < cnt) {
#pragma unroll
        for (int i = 0; i < 8; ++i) cur[i] = nxt[i];
        const TItem tcur = tc;
        const int itn = __builtin_amdgcn_readfirstlane(F.lane == 0 ? (int)atomicAdd((unsigned*)ctr, 1u) : 0);
        if (itn < cnt) { tc = titem_lx(F.in, F.ws, layer, base + itn); titem_load(tc, nxt, F.lane); }
        titem_process(tcur, cur, scr, F.lane);
        it = itn;
    }
}
constexpr int L1T_N = 64, L1A_N = 18;
static_assert(120 * L1T_N + 256 * L1A_N == NL1, "layer-1 conversion split");
__device__ __forceinline__ void tail_fill(Frame& F, int nUnits, int quota) {
    const int rounds = (nUnits + F.G - 1) / F.G;
    if ((rounds - 1) * F.G + F.vcu >= nUnits) convert_l1(F, quota);
}

template <bool F8 = false>
__device__ __forceinline__ void norm_mod_store(const f32x4 (&v)[4], const float* g, const float* shift, const float* scale, bf16* orow, int lane) {
    float s2 = 0.f;
#pragma unroll
    for (int j = 0; j < 4; ++j) s2 += (v[j].x * v[j].x + v[j].y * v[j].y) + (v[j].z * v[j].z + v[j].w * v[j].w);
    const float rstd = 1.0f / sqrtf(wave_sum(s2) * (1.0f / D) + EPS);
#pragma unroll
    for (int j = 0; j < 4; ++j) { const int c = 4 * lane + 256 * j;
        const f32x4 gg = *(const f32x4*)(g + c), sh = *(const f32x4*)(shift + c), sc = *(const f32x4*)(scale + c);
        const f32x4 y = v[j] * rstd * gg * (sc + 1.0f) + sh;
        if constexpr (F8) { *(unsigned*)((unsigned char*)orow + c) = pg8::pk4_fp8(__builtin_fminf(__builtin_fmaxf(y.x, -448.0f), 448.0f), __builtin_fminf(__builtin_fmaxf(y.y, -448.0f), 448.0f), __builtin_fminf(__builtin_fmaxf(y.z, -448.0f), 448.0f), __builtin_fminf(__builtin_fmaxf(y.w, -448.0f), 448.0f)); }
        else { u32x2 o; o.x = pk2(y.x, y.y); o.y = pk2(y.z, y.w);
        *(u32x2*)(orow + c) = o; } }
}

template <int NQ> __device__ __forceinline__ void p1_tokens(Frame& F, int t) {
    const float* mods = (const float*)(F.ws + WS_MODS);
    bf16* A = (bf16*)(F.ws + WS_BUFA);
    f32x4 v[NQ][4];
#pragma unroll
    for (int q = 0; q < NQ; ++q) { const int tq = t + q; const float* xr = tq < TL ? F.in[I_X] + (size_t)tq * D : F.in[I_CTX] + (size_t)(tq - TL) * D;
#pragma unroll
        for (int j = 0; j < 4; ++j) v[q][j] = __builtin_nontemporal_load((const f32x4*)(xr + 4 * F.lane + 256 * j)); }
    const float* m = mods + (size_t)mod_row(t) * 6144;
#pragma unroll
    for (int q = 0; q < NQ; ++q) norm_mod_store(v[q], F.in[I_NMG], m, m + 1024, A + (size_t)(t + q) * D, F.lane);
}
__device__ __forceinline__ void phase_mods(Frame& F) {
    const float* const* in = F.in;
    LAS float* S = (LAS float*)F.lds;
    LAS float* red = S + 9 * 1024;
    for (int i = F.tid; i < 9 * 1024; i += 512) { const float v = (i < 8192) ? in[I_C][i] : in[I_CCTX][i - 8192]; S[i] = v / (1.0f + expf(-v)); }
    __syncthreads();
    const int bx = blockIdx.x, layer = bx >> 7, col0 = (bx & 127) * 48;
    const int j = F.tid % 12, rg = F.tid / 12;
    if (rg < 42) {
        const float* W = in[I_ADAW] + (size_t)layer * 1024 * 6144 + col0 + 4 * j;
        f32x4 w[25];
#pragma unroll
        for (int i = 0; i < 25; ++i) { const int k = rg + 42 * i; w[i] = (k < 1024) ? __builtin_nontemporal_load((const f32x4*)(W + (size_t)k * 6144)) : (f32x4){0.f, 0.f, 0.f, 0.f}; }
        f32x4 acc[9];
#pragma unroll
        for (int r = 0; r < 9; ++r) acc[r] = (f32x4){0.f, 0.f, 0.f, 0.f};
#pragma unroll
        for (int i = 0; i < 25; ++i) { const int k = min(rg + 42 * i, 1023);
#pragma unroll
            for (int r = 0; r < 9; ++r) acc[r] += w[i] * S[r * 1024 + k]; }
#pragma unroll
        for (int r = 0; r < 9; ++r) *(LAS f32x4*)(red + (rg * 9 + r) * 48 + 4 * j) = acc[r];
    }
    __syncthreads();
    for (int i = F.tid; i < 432; i += 512) { const int r = i / 48, c = i % 48; float sum = in[I_ADAB][layer * 6144 + col0 + c];
        for (int g = 0; g < 42; ++g) sum += red[(g * 9 + r) * 48 + c];
        __hip_atomic_store((unsigned*)(F.ws + WS_MODS) + (layer * 9 + r) * 6144 + col0 + c, __builtin_bit_cast(unsigned, sum), __ATOMIC_RELAXED, __HIP_MEMORY_SCOPE_AGENT); }
    asm volatile("s_waitcnt vmcnt(0)" ::: "memory");
    __syncthreads();
    if (F.tid == 0) __hip_atomic_fetch_add((unsigned*)(F.ws + WS_MODSDONE), 1u, __ATOMIC_RELAXED, __HIP_MEMORY_SCOPE_AGENT);
}
__device__ __forceinline__ void mods_wait(Frame& F) {
    if (F.tid < 64) {
        unsigned* cnt = (unsigned*)(F.ws + WS_MODSDONE); unsigned spins = 0;
        while ((unsigned)__builtin_amdgcn_readfirstlane(__hip_atomic_load(cnt, __ATOMIC_RELAXED, __HIP_MEMORY_SCOPE_AGENT)) < (unsigned)F.G) {
            __builtin_amdgcn_s_sleep(2); if (++spins > (1u << 22)) break; }
        __builtin_amdgcn_fence(__ATOMIC_ACQUIRE, "agent");
        asm volatile("s_waitcnt vmcnt(0)" ::: "memory");
    }
    __syncthreads();
}

__device__ __forceinline__ void ctr_publish(Frame& F, size_t off, int slot, unsigned nx) {
    asm volatile("s_waitcnt vmcnt(0)" ::: "memory");
    __syncthreads();
    if (F.tid == 0) {
        unsigned* top = (unsigned*)(F.ws + off);
        if (nx == 0u) { __builtin_amdgcn_fence(__ATOMIC_RELEASE, "agent"); asm volatile("s_waitcnt vmcnt(0)" ::: "memory"); __hip_atomic_fetch_add(top, 1u, __ATOMIC_RELAXED, __HIP_MEMORY_SCOPE_AGENT); }
        else {
            unsigned* xw = (unsigned*)(F.ws + WS_XARR) + ((size_t)slot * 16 + xb_xcc_id()) * 64;
            const unsigned old = __hip_atomic_fetch_add(xw, 1u, __ATOMIC_RELAXED, __HIP_MEMORY_SCOPE_AGENT);
            if (old + 1u == nx) { __builtin_amdgcn_fence(__ATOMIC_RELEASE, "agent"); asm volatile("s_waitcnt vmcnt(0)" ::: "memory"); __hip_atomic_fetch_add(top, nx, __ATOMIC_RELAXED, __HIP_MEMORY_SCOPE_AGENT); }
        }
    }
}
__device__ __forceinline__ void ctr_wait(Frame& F, size_t off, unsigned need) {
    if (F.tid < 64) {
        unsigned* cnt = (unsigned*)(F.ws + off); unsigned spins = 0;
        while ((unsigned)__builtin_amdgcn_readfirstlane(__hip_atomic_load(cnt, __ATOMIC_RELAXED, __HIP_MEMORY_SCOPE_AGENT)) < need) {
            __builtin_amdgcn_s_sleep(2); if (++spins > (1u << 22)) break; }
        __builtin_amdgcn_fence(__ATOMIC_ACQUIRE, "agent");
        asm volatile("s_waitcnt vmcnt(0)" ::: "memory");
    }
    __syncthreads();
}

template <class P> __device__ __forceinline__ unsigned xcd_census(const Frame& F, P pred) {
    if (__builtin_amdgcn_readfirstlane(*(const LAS int*)(F.lds + LDS_CTL + 52)) == 0) return 0u;
    const unsigned myx = xb_xcc_id();
    unsigned c = 0;
#pragma unroll
    for (int k = 0; k < 4; ++k) { const int v = F.lane + 64 * k; const unsigned x = (unsigned)ld_coh((const int*)(F.ws + WS_XCDOF) + v);
        c += (unsigned)__builtin_popcountll(__builtin_amdgcn_ballot_w64(x == myx && pred(v))); }
    return c;
}

__device__ __forceinline__ void phase_prologue_a(Frame& F) {
    const float* const* in = F.in;
    unsigned char* ws = F.ws;
    LAS float* ldsf = (LAS float*)F.lds;
    phase_mods(F);
    __syncthreads();
    {
        const int gt = blockIdx.x * 512 + F.tid, NT = F.G * 512;
        float* rope = (float*)(ws + WS_ROPE);
        for (int i = gt; i < 1024; i += NT) { const int coord = i >> 4, q = i & 15; const float inv = powf(10000.0f, -(float)q / 16.0f); const float ang = (float)coord * inv;
            rope[i] = cosf(ang); rope[1024 + i] = sinf(ang); }
        bf16* WA = (bf16*)(ws + WS_WA);
        for (int i = gt; i < 128 * 128; i += NT) { const int m = i >> 7, k = i & 127, rp = m >> 6, j1 = m & 63, ri = k >> 6, n1 = k & 63;
            const float a = 2.0f * (float)((j1 * n1) & 63) / 64.0f; const float c = cospif(a), s = sinpif(a);
            const float v = (rp == 0) ? (ri == 0 ? c : s) : (ri == 0 ? -s : c); WA[i] = (bf16)f2bf(v); }
        bf16* WAC = (bf16*)(ws + WS_WAC);
        for (int i = gt; i < 32 * 32; i += NT) { const int m = i >> 5, k = i & 31, rp = m >> 4, j1 = m & 15, ri = k >> 4, n1 = k & 15;
            const float a = 2.0f * (float)((j1 * n1) & 15) / 16.0f; const float c = cospif(a), s = sinpif(a);
            const float v = (rp == 0) ? (ri == 0 ? c : s) : (ri == 0 ? -s : c); WAC[i] = (bf16)f2bf(v); }
        bf16* WC = (bf16*)(ws + WS_WC);
        for (int i = gt; i < 64 * 64 * 128; i += NT) { const int j1 = i >> 13, j2 = (i >> 7) & 63, k = i & 127, ri = k >> 6, n2 = k & 63;
            const float a = 2.0f * (float)((n2 * (j1 + 64 * j2)) & 4095) / 4096.0f; const float v = (ri == 0 ? cospif(a) : sinpif(a)) * (1.0f / 64.0f); WC[i] = (bf16)f2bf(v); }
        bf16* FD = (bf16*)(ws + WS_FD);
        for (int i = gt; i < 256 * 128; i += NT) { const int col = i >> 7, c = i & 127, ri = col >> 7, k2 = col & 127;
            const float a = 2.0f * (float)((c * k2) & 127) / 128.0f; const float v = (ri == 0 ? cospif(a) : -sinpif(a)) * 0.08838834764831845f; FD[i] = (bf16)f2bf(v); }
        bf16* WCC = (bf16*)(ws + WS_WCC);
        for (int i = gt; i < 16 * 16 * 32; i += NT) { const int j1 = i >> 9, j2 = (i >> 5) & 15, k = i & 31, ri = k >> 4, n2 = k & 15;
            const float a = 2.0f * (float)((n2 * (j1 + 16 * j2)) & 255) / 256.0f; const float v = (ri == 0 ? cospif(a) : sinpif(a)) * (1.0f / 16.0f); WCC[i] = (bf16)f2bf(v); }
    }
    LAS float* tw = (LAS float*)(F.lds + 139264);
    if (F.tid < 128) { const float a = 2.0f * (float)F.tid / 128.0f; tw[F.tid] = cospif(a); tw[128 + F.tid] = sinpif(a); }
    __syncthreads();
    LAS float* scr = (LAS float*)(F.lds + F.wave * 17408);
    const int gw = F.vcu * NWAVES + F.wave, NGW = F.G * NWAVES;
    const int fid = F.vcu * 2 + F.wave;
    if (F.wave < 2) { const int r = fid;
        const int g = r >> 7, db = (r >> 5) & 3, kb = r & 31, k0 = kb * 32, d0 = db * 32;
        const float* Wp = in[I_OWIN] + (size_t)k0 * 1280 + g * 128;
        { float tl[32][2];
#pragma unroll
          for (int rr = 0; rr < 32; ++rr) { tl[rr][0] = Wp[(size_t)rr * 1280 + F.lane]; tl[rr][1] = Wp[(size_t)rr * 1280 + 64 + F.lane]; }
#pragma unroll
          for (int rr = 0; rr < 32; ++rr) { scr[rr * 129 + F.lane] = tl[rr][0]; scr[rr * 129 + 64 + F.lane] = tl[rr][1]; } }
        LDS_WAIT(); asm volatile("" ::: "memory");
        const int k = F.lane & 31, oh = F.lane >> 5;
        const float* pw = in[I_OPOOLW] + (size_t)g * 16384 + d0 + 16 * oh;
        float acc[16];
#pragma unroll
        for (int t = 0; t < 16; ++t) acc[t] = 0.f;
        for (int c0 = 0; c0 < 128; c0 += 8) {
            f32x4 p[8][4];
#pragma unroll
            for (int cc = 0; cc < 8; ++cc)
#pragma unroll
                for (int j = 0; j < 4; ++j) p[cc][j] = *(const f32x4*)(pw + (c0 + cc) * 128 + 4 * j);
#pragma unroll
            for (int cc = 0; cc < 8; ++cc) { const float w = scr[k * 129 + c0 + cc];
#pragma unroll
                for (int j = 0; j < 4; ++j) { acc[4 * j] += w * p[cc][j].x; acc[4 * j + 1] += w * p[cc][j].y; acc[4 * j + 2] += w * p[cc][j].z; acc[4 * j + 3] += w * p[cc][j].w; } }
        }
        const float* psc = in[I_OPOOLS] + g * 128 + d0 + 16 * oh;
        if constexpr (FP8_IN1) { unsigned char* dst8 = ws + WS_W_OIN + (size_t)(g * 128 + d0 + 16 * oh) * 1024 + k0 + k;
#pragma unroll
            for (int t = 0; t < 16; ++t) { const float wv = acc[t] * psc[t] * pg8::W1_SCALE; dst8[(size_t)t * 1024] = (unsigned char)(__builtin_amdgcn_cvt_pk_fp8_f32(wv, wv, 0, false) & 0xff); } }
        else {
        bf16* dst = (bf16*)(ws + WS_W_OIN) + (size_t)(g * 128 + d0 + 16 * oh) * 1024 + k0 + k;
#pragma unroll
        for (int t = 0; t < 16; ++t) dst[(size_t)t * 1024] = (bf16)f2bf(acc[t] * psc[t]); }
        LDS_WAIT(); asm volatile("" ::: "memory");
    }
    {
        LAS unsigned* ctr = (LAS unsigned*)(F.lds + LDS_CTL + 32);
        constexpr int TP1 = TS0 + TS1 + TS2 + TS3 + (12288 - 192 * L0T_N), PER = (TP1 + 255) / 256;
        const int base = F.vcu * PER, lim = max(0, min(PER, TP1 - base));
        f32x4 cur[8], nxt[8];
        int it = __builtin_amdgcn_readfirstlane(F.lane == 0 ? (int)atomicAdd((unsigned*)ctr, 1u) : 0);
        TItem tc = titem_decode(in, ws, base + (it < lim ? it : 0));
        if (it < lim) titem_load(tc, nxt, F.lane);
        while (it < lim) {
#pragma unroll
            for (int i = 0; i < 8; ++i) cur[i] = nxt[i];
            const TItem tcur = tc;
            const int itn = __builtin_amdgcn_readfirstlane(F.lane == 0 ? (int)atomicAdd((unsigned*)ctr, 1u) : 0);
            if (itn < lim) { tc = titem_decode(in, ws, base + itn); titem_load(tc, nxt, F.lane); }
            titem_process(tcur, cur, scr, F.lane);
            it = itn;
        }
    }
    mods_wait(F);
    {
        LAS unsigned* ctr2 = (LAS unsigned*)(F.lds + LDS_CTL + 36);
        for (;;) {
            const int it = __builtin_amdgcn_readfirstlane(F.lane == 0 ? (int)atomicAdd((unsigned*)ctr2, 1u) : 0);
            if (it >= 40) break;
            if (it < 32) p1_tokens<4>(F, 4 * (32 * (int)blockIdx.x + it)); else p1_tokens<1>(F, TL + 8 * (int)blockIdx.x + (it - 32));
        }
    }
}

struct DftP { const bf16* dbase; size_t dstride; const bf16* W; bf16* obase; size_t ostride; };
template <int MODE> __device__ __forceinline__ DftP dft_params(const Frame& F, int u) {
    const bf16* P = (const bf16*)(F.ws + WS_BUFP); bf16* Z = (bf16*)(F.ws + WS_BUFZ); bf16* MIX = (bf16*)(F.ws + WS_BUFA);
    DftP p;
    if constexpr (MODE == 0) { const int chunk = u & 3, n2 = (u >> 2) & 63, b = u >> 8;
        p.dbase = P + (size_t)(b * 4096 + n2) * EIN + chunk * 128; p.dstride = (size_t)64 * EIN; p.W = (const bf16*)(F.ws + WS_WA);
        p.obase = Z + (size_t)((b * 64) * 64 + n2) * 1024 + chunk * 128; p.ostride = (size_t)64 * 1024; }
    if constexpr (MODE == 1) { const int chunk = u & 3, n2 = (u >> 2) & 15, b = u >> 6;
        p.dbase = P + (size_t)(TL + b * 256 + n2) * EIN + chunk * 128; p.dstride = (size_t)16 * EIN; p.W = (const bf16*)(F.ws + WS_WAC);
        p.obase = Z + (size_t)(TL + (b * 16) * 16 + n2) * 1024 + chunk * 128; p.ostride = (size_t)16 * 1024; }
    if constexpr (MODE == 2) { const int chunk = u & 3, j1 = (u >> 2) & 63, b = u >> 8;
        p.dbase = Z + (size_t)((b * 64 + j1) * 64) * 1024 + chunk * 128; p.dstride = (size_t)1024; p.W = (const bf16*)(F.ws + WS_WC) + (size_t)j1 * 64 * 128;
        p.obase = MIX + (size_t)(b * 4096 + j1) * D + chunk * 128; p.ostride = (size_t)64 * D; }
    if constexpr (MODE == 3) { const int chunk = u & 3, j1 = (u >> 2) & 15, b = u >> 6;
        p.dbase = Z + (size_t)(TL + (b * 16 + j1) * 16) * 1024 + chunk * 128; p.dstride = (size_t)1024; p.W = (const bf16*)(F.ws + WS_WCC) + (size_t)j1 * 16 * 32;
        p.obase = MIX + (size_t)(TL + b * 256 + j1) * D + chunk * 128; p.ostride = (size_t)16 * D; }
    return p;
}
template <int MODE, int KD, int MD, int J>
__device__ __forceinline__ void dft_units(Frame& F, int nunits) {
    constexpr int LD = KD + 8;
    constexpr int NP = (KD * 16 + 511) / 512;
    constexpr int GM = KD / 8 - 1;
    LAS bf16* DT = (LAS bf16*)F.lds;
    u32x4 pre[NP];
    int u = F.vcu;
    if (u < nunits) { const DftP p = dft_params<MODE>(F, u);
#pragma unroll
        for (int i = 0; i < NP; ++i) { const int pc = F.tid + 512 * i; if (pc < KD * 16) { const int k = pc >> 4, c8 = pc & 15, ri = k / (KD / 2), nn = k % (KD / 2);
            pre[i] = __builtin_nontemporal_load((const u32x4*)(p.dbase + (size_t)nn * p.dstride + ri * 512 + c8 * 8)); } } }
    const int a = F.lane & 15, q = F.lane >> 4;
    for (; u < nunits; u += F.G) {
        const DftP p = dft_params<MODE>(F, u);
#pragma unroll
        for (int i = 0; i < NP; ++i) { const int pc = F.tid + 512 * i; if (pc < KD * 16) { const int k = pc >> 4, c8 = pc & 15; const u32x4 v = pre[i];
            LAS bf16* d = DT + (c8 * 8) * LD + (k ^ ((c8 & GM) << 3));
            d[0 * LD] = (bf16)(v.x & 0xffff); d[1 * LD] = (bf16)(v.x >> 16); d[2 * LD] = (bf16)(v.y & 0xffff); d[3 * LD] = (bf16)(v.y >> 16);
            d[4 * LD] = (bf16)(v.z & 0xffff); d[5 * LD] = (bf16)(v.z >> 16); d[6 * LD] = (bf16)(v.w & 0xffff); d[7 * LD] = (bf16)(v.w >> 16); } }
        __syncthreads();
        if (u + F.G < nunits) { const DftP pn = dft_params<MODE>(F, u + F.G);
#pragma unroll
            for (int i = 0; i < NP; ++i) { const int pc = F.tid + 512 * i; if (pc < KD * 16) { const int k = pc >> 4, c8 = pc & 15, ri = k / (KD / 2), nn = k % (KD / 2);
                pre[i] = __builtin_nontemporal_load((const u32x4*)(pn.dbase + (size_t)nn * pn.dstride + ri * 512 + c8 * 8)); } } }
        for (int task = F.wave; task < (MD / 16) * 2; task += NWAVES) {
            const int mt = task >> 1, cht = task & 1;
            f32x4 acc[4];
#pragma unroll
            for (int ct = 0; ct < 4; ++ct) acc[ct] = (f32x4){0.f, 0.f, 0.f, 0.f};
#pragma unroll
            for (int ks = 0; ks < KD / 32; ++ks) {
                const bf16x8 bw = *(const bf16x8*)(p.W + (size_t)(mt * 16 + a) * KD + ks * 32 + 8 * q);
#pragma unroll
                for (int ct = 0; ct < 4; ++ct) {
                    const int ch = cht * 64 + 16 * (a >> 2) + 4 * ct + (a & 3);
                    const bf16x8 av = *(const LAS bf16x8*)(DT + ch * LD + ((ks * 32 + 8 * q) ^ (((ch >> 3) & GM) << 3)));
                    acc[ct] = __builtin_amdgcn_mfma_f32_16x16x32_bf16(av, bw, acc[ct], 0, 0, 0);
                }
            }
            const int m = mt * 16 + a, rm = m / J, j = m % J;
            bf16* o = p.obase + (size_t)j * p.ostride + rm * 512 + cht * 64 + 16 * q;
            u32x4 w0, w1;
            w0.x = pk2(acc[0][0], acc[0][1]); w0.y = pk2(acc[0][2], acc[0][3]); w0.z = pk2(acc[1][0], acc[1][1]); w0.w = pk2(acc[1][2], acc[1][3]);
            w1.x = pk2(acc[2][0], acc[2][1]); w1.y = pk2(acc[2][2], acc[2][3]); w1.z = pk2(acc[3][0], acc[3][1]); w1.w = pk2(acc[3][2], acc[3][3]);
            *(u32x4*)o = w0; *(u32x4*)(o + 8) = w1;
        }
        __syncthreads();
    }
}

template <int MODE, int NR>
__device__ __forceinline__ void dft_units_a(Frame& F, int nunits) {
    constexpr int KD = 2 * NR, MD = 2 * NR, J = NR, LD = KD + 8, GM = KD / 8 - 1, ULD = 136;
    constexpr int NP = (NR * 16 + 511) / 512;
    LAS bf16* FDl = (LAS bf16*)F.lds; LAS bf16* U = (LAS bf16*)(F.lds + 69632); LAS bf16* DT = (LAS bf16*)(F.lds + 69632 + 64 * ULD * 2);
    { const bf16* FD = (const bf16*)(F.ws + WS_FD);
      for (int p = F.tid; p < 256 * 16; p += 512) { const int r = p >> 4, c8 = p & 15; *(LAS u32x4*)(FDl + r * ULD + 8 * c8) = *(const u32x4*)(FD + r * 128 + 8 * c8); } }
    u32x4 pre[NP];
    int u = F.vcu;
    if (u < nunits) { const DftP p = dft_params<MODE>(F, u);
#pragma unroll
        for (int i = 0; i < NP; ++i) { const int pc = F.tid + 512 * i; if (pc < NR * 16) pre[i] = __builtin_nontemporal_load((const u32x4*)(p.dbase + (size_t)(pc >> 4) * p.dstride + (pc & 15) * 8)); } }
    const int a = F.lane & 15, q = F.lane >> 4;
    for (; u < nunits; u += F.G) {
        const DftP p = dft_params<MODE>(F, u);
#pragma unroll
        for (int i = 0; i < NP; ++i) { const int pc = F.tid + 512 * i; if (pc < NR * 16) *(LAS u32x4*)(U + (pc >> 4) * ULD + (pc & 15) * 8) = pre[i]; }
        __syncthreads();
        if (u + F.G < nunits) { const DftP pn = dft_params<MODE>(F, u + F.G);
#pragma unroll
            for (int i = 0; i < NP; ++i) { const int pc = F.tid + 512 * i; if (pc < NR * 16) pre[i] = __builtin_nontemporal_load((const u32x4*)(pn.dbase + (size_t)(pc >> 4) * pn.dstride + (pc & 15) * 8)); } }
        {
            f32x4 acc[NR / 16][2];
#pragma unroll
            for (int mt = 0; mt < NR / 16; ++mt) { acc[mt][0] = (f32x4){0.f, 0.f, 0.f, 0.f}; acc[mt][1] = (f32x4){0.f, 0.f, 0.f, 0.f}; }
#pragma unroll
            for (int ks = 0; ks < 4; ++ks) {
                const bf16x8 b0 = *(const LAS bf16x8*)(FDl + ((2 * F.wave) * 16 + a) * ULD + ks * 32 + 8 * q), b1 = *(const LAS bf16x8*)(FDl + ((2 * F.wave + 1) * 16 + a) * ULD + ks * 32 + 8 * q);
#pragma unroll
                for (int mt = 0; mt < NR / 16; ++mt) { const bf16x8 av = *(const LAS bf16x8*)(U + (mt * 16 + a) * ULD + ks * 32 + 8 * q);
                    acc[mt][0] = __builtin_amdgcn_mfma_f32_16x16x32_bf16(av, b0, acc[mt][0], 0, 0, 0); acc[mt][1] = __builtin_amdgcn_mfma_f32_16x16x32_bf16(av, b1, acc[mt][1], 0, 0, 0); }
            }
#pragma unroll
            for (int t = 0; t < 2; ++t) { const int col = (2 * F.wave + t) * 16 + a, ri = col >> 7, k2 = col & 127;
#pragma unroll
                for (int mt = 0; mt < NR / 16; ++mt) { const int k0 = ri * NR + 16 * mt + 4 * q;
                    u32x2 w; w.x = pk2(acc[mt][t][0], acc[mt][t][1]); w.y = pk2(acc[mt][t][2], acc[mt][t][3]);
                    *(LAS u32x2*)(DT + k2 * LD + (k0 ^ (((k2 >> 3) & GM) << 3))) = w; } }
        }
        __syncthreads();
        for (int task = F.wave; task < (MD / 16) * 2; task += NWAVES) {
            const int mt = task >> 1, cht = task & 1;
            f32x4 acc[4];
#pragma unroll
            for (int ct = 0; ct < 4; ++ct) acc[ct] = (f32x4){0.f, 0.f, 0.f, 0.f};
#pragma unroll
            for (int ks = 0; ks < KD / 32; ++ks) {
                const bf16x8 bw = *(const bf16x8*)(p.W + (size_t)(mt * 16 + a) * KD + ks * 32 + 8 * q);
#pragma unroll
                for (int ct = 0; ct < 4; ++ct) {
                    const int ch = cht * 64 + 16 * (a >> 2) + 4 * ct + (a & 3);
                    const bf16x8 av = *(const LAS bf16x8*)(DT + ch * LD + ((ks * 32 + 8 * q) ^ (((ch >> 3) & GM) << 3)));
                    acc[ct] = __builtin_amdgcn_mfma_f32_16x16x32_bf16(av, bw, acc[ct], 0, 0, 0);
                }
            }
            const int m = mt * 16 + a, rm = m / J, j = m % J;
            bf16* o = p.obase + (size_t)j * p.ostride + rm * 512 + cht * 64 + 16 * q;
            u32x4 w0, w1;
            w0.x = pk2(acc[0][0], acc[0][1]); w0.y = pk2(acc[0][2], acc[0][3]); w0.z = pk2(acc[1][0], acc[1][1]); w0.w = pk2(acc[1][2], acc[1][3]);
            w1.x = pk2(acc[2][0], acc[2][1]); w1.y = pk2(acc[2][2], acc[2][3]); w1.z = pk2(acc[3][0], acc[3][1]); w1.w = pk2(acc[3][2], acc[3][3]);
            *(u32x4*)o = w0; *(u32x4*)(o + 8) = w1;
        }
        __syncthreads();
    }
}

__device__ __forceinline__ void phase_fourier_a_conv(Frame& F) {
    const bf16* P = (const bf16*)(F.ws + WS_BUFP);
    dft_units_a<0, 64>(F, 2048);
    __syncthreads();
    dft_units_a<1, 16>(F, 512);
    ctr_publish(F, WS_FAF, 0, xcd_census(F, [](int) { return true; }));
    bf16* MIX = (bf16*)(F.ws + WS_BUFA);
    const float* cw = F.in[I_ECONV];
    float w0[8], w1[8], w2[8];
#pragma unroll
    for (int i = 0; i < 8; ++i) { w0[i] = cw[8 * F.lane + i]; w1[i] = cw[512 + 8 * F.lane + i]; w2[i] = cw[1024 + 8 * F.lane + i]; }
    const int gw = F.vcu * NWAVES + F.wave, NGW = F.G * NWAVES;
    auto conv_tokens = [&](int t, auto ntc) {
        constexpr int NT = decltype(ntc)::value;
        int pos, len; if (t < TL) { pos = t & 4095; len = 4096; } else { pos = (t - TL) & 255; len = 256; }
        const bf16* row = P + (size_t)t * EIN + 8 * F.lane;
        u32x4 gb[NT], gc[NT + 2], uc[NT + 2];
#pragma unroll
        for (int d = 0; d < NT + 2; ++d) { const int pp = pos + d - 1;
            if (pp >= 0 && pp < len) { gc[d] = *(const u32x4*)(row + (ptrdiff_t)(d - 1) * EIN + 1024); uc[d] = *(const u32x4*)(row + (ptrdiff_t)(d - 1) * EIN + 1536); }
            else { gc[d] = (u32x4){0u, 0u, 0u, 0u}; uc[d] = (u32x4){0u, 0u, 0u, 0u}; } }
#pragma unroll
        for (int q = 0; q < NT; ++q) gb[q] = __builtin_nontemporal_load((const u32x4*)(row + (size_t)q * EIN + 512));
        float pl[NT + 2][8];
#pragma unroll
        for (int d = 0; d < NT + 2; ++d)
#pragma unroll
            for (int i = 0; i < 4; ++i) { pl[d][2 * i] = bflo(gc[d][i]) * bflo(uc[d][i]); pl[d][2 * i + 1] = bfhi(gc[d][i]) * bfhi(uc[d][i]); }
#pragma unroll
        for (int q = 0; q < NT; ++q) {
            float y[8];
#pragma unroll
            for (int i = 0; i < 4; ++i) {
                y[2 * i] = bflo(gb[q][i]) * (w0[2 * i] * pl[q][2 * i] + w1[2 * i] * pl[q + 1][2 * i] + w2[2 * i] * pl[q + 2][2 * i]);
                y[2 * i + 1] = bfhi(gb[q][i]) * (w0[2 * i + 1] * pl[q][2 * i + 1] + w1[2 * i + 1] * pl[q + 1][2 * i + 1] + w2[2 * i + 1] * pl[q + 2][2 * i + 1]);
            }
            u32x4 o; o.x = pk2(y[0], y[1]); o.y = pk2(y[2], y[3]); o.z = pk2(y[4], y[5]); o.w = pk2(y[6], y[7]);
            *(u32x4*)(MIX + (size_t)(t + q) * D + 512 + 8 * F.lane) = o;
        }
    };
    for (int t = 4 * gw; t < TL; t += 4 * NGW) conv_tokens(t, std::integral_constant<int, 4>{});
    for (int t = TL + gw; t < T; t += NGW) conv_tokens(t, std::integral_constant<int, 1>{});
}

__device__ __forceinline__ void phase_fourier_c(Frame& F) {
    ctr_wait(F, WS_FAF, (unsigned)F.G);
    dft_units<2, 128, 64, 64>(F, 2048);
    dft_units<3, 32, 16, 16>(F, 512);
}

constexpr int RW_LD = 1032;
template <bool SPLIT>
__device__ __forceinline__ void phase_route(Frame& F, int layer, int ntok) {
    LAS bf16* rwh = (LAS bf16*)F.lds;
    LAS bf16* rwl = (LAS bf16*)(F.lds + 33024);
    LAS unsigned* cnt = (LAS unsigned*)(F.lds + 66048);
    LAS int* gb = (LAS int*)(F.lds + 66048 + 128);
    LAS float* lgs = (LAS float*)(F.lds + 66048 + 256) + F.wave * 256;
    LAS int* tinfo = (LAS int*)(F.lds + 66048 + 256 + 8192);
    LAS float* GS = (LAS float*)(F.lds + 81920);
    LAS float* SH = GS + 2048;
    const float* RW = F.in[I_RW];
    int tA, nA, tB, nB;
    if constexpr (SPLIT) {
        const int xs = F.vcu >> 5, rs = F.vcu & 31;
        if (rs >= 28) return;
        const int j = 28 * xs + rs;
        tA = 128 * j; nA = 128; tB = 28672 + 32 * j; nB = (j < 192) ? 32 : 0;
    } else { const int per_ = ntok / F.G; tA = blockIdx.x * per_; nA = per_; tB = 0; nB = 0; }
    const int r0 = mod_row(tA), mr1 = SPLIT ? mod_row(tB) : min(r0 + 1, 8);
    const float* mods = (const float*)(F.ws + WS_MODS) + (size_t)layer * 9 * 6144;
    const float* g = F.in[I_NFG] + layer * 1024;
    for (int i = F.tid; i < 16384; i += 512) { const int k = i >> 4, e = i & 15; const float w = RW[i]; const unsigned hi = f2bf(w); const float wl = w - __builtin_bit_cast(float, hi << 16);
        rwh[e * RW_LD + k] = (bf16)hi; rwl[e * RW_LD + k] = (bf16)f2bf(wl); }
    for (int i = F.tid; i < 2048; i += 512) { const int sl = i >> 10, c = i & 1023; const int rr = sl ? mr1 : r0; const float* m = mods + (size_t)rr * 6144;
        GS[i] = g[c] * (m[4 * 1024 + c] + 1.0f); SH[i] = m[3 * 1024 + c]; }
    if (F.tid < 16) cnt[F.tid] = 0u;
    __syncthreads();
    bf16* FB = (bf16*)(F.ws + WS_BUFA);
    const bool f8 = layer ? (FP8_G1_L1 != 0) : (FP8_G1_L0 != 0);
    int* route = (int*)(F.ws + WS_ROUTE);
    const int tk = F.lane & 15, kg = F.lane >> 4;
    for (int st = 0; st < 2; ++st) {
    const int t0 = st ? tB : tA, per = st ? nB : nA, li0 = st ? nA : 0;
    if (per == 0) break;
    if constexpr (SPLIT) { if (st == 0) ctr_wait(F, WS_P5F, 224u); else ctr_wait(F, WS_P5C, 32u); }
    for (int g0 = 16 * F.wave; g0 < per; g0 += 16 * NWAVES) {
        const int nv = min(16, per - g0);
        const int tq = t0 + g0 + (tk < nv ? tk : 0);
        const bf16* hr = h_row(F, tq) + 8 * kg;
        float s2 = 0.f;
        {
            u32x4 raw[32];
#pragma unroll
            for (int ks = 0; ks < 32; ++ks) raw[ks] = *(const u32x4*)(hr + 32 * ks);
#pragma unroll
            for (int ks = 0; ks < 32; ++ks)
#pragma unroll
                for (int i = 0; i < 4; ++i) { const float a = bflo(raw[ks][i]), b2 = bfhi(raw[ks][i]); s2 += a * a + b2 * b2; }
        }
        s2 += __shfl_xor(s2, 16); s2 += __shfl_xor(s2, 32);
        const float rstd = 1.0f / sqrtf(s2 * (1.0f / D) + EPS);
        const int sl = (mod_row(tq) != r0) ? 1024 : 0;
        const LAS float* gsp = GS + sl + 8 * kg; const LAS float* shp = SH + sl + 8 * kg;
        unsigned char* fb8 = (unsigned char*)FB + (size_t)tq * D + 8 * kg;
        bf16* fb16 = FB + (size_t)tq * D + 8 * kg;
        f32x4 acc = (f32x4){0.f, 0.f, 0.f, 0.f};
        u32x4 nx[8];
#pragma unroll
        for (int j = 0; j < 8; ++j) nx[j] = *(const u32x4*)(hr + 32 * j);
#pragma unroll 1
        for (int k4 = 0; k4 < 4; ++k4) {
            u32x4 cu[8];
#pragma unroll
            for (int j = 0; j < 8; ++j) cu[j] = nx[j];
            if (k4 < 3) {
#pragma unroll
                for (int j = 0; j < 8; ++j) nx[j] = *(const u32x4*)(hr + 32 * (8 * k4 + 8 + j)); }
#pragma unroll
            for (int j = 0; j < 8; ++j) {
                const int ks = 8 * k4 + j;
                const f32x4 g0v = *(const LAS f32x4*)(gsp + 32 * ks), g1v = *(const LAS f32x4*)(gsp + 32 * ks + 4), s0v = *(const LAS f32x4*)(shp + 32 * ks), s1v = *(const LAS f32x4*)(shp + 32 * ks + 4);
                float f[8];
                f[0] = bflo(cu[j].x) * rstd * g0v.x + s0v.x; f[1] = bfhi(cu[j].x) * rstd * g0v.y + s0v.y; f[2] = bflo(cu[j].y) * rstd * g0v.z + s0v.z; f[3] = bfhi(cu[j].y) * rstd * g0v.w + s0v.w;
                f[4] = bflo(cu[j].z) * rstd * g1v.x + s1v.x; f[5] = bfhi(cu[j].z) * rstd * g1v.y + s1v.y; f[6] = bflo(cu[j].w) * rstd * g1v.z + s1v.z; f[7] = bfhi(cu[j].w) * rstd * g1v.w + s1v.w;
                u32x4 hi, lo;
#pragma unroll
                for (int i = 0; i < 4; ++i) { const unsigned h0 = f2bf(f[2 * i]), h1 = f2bf(f[2 * i + 1]); hi[i] = h0 | (h1 << 16);
                    lo[i] = pk2(f[2 * i] - __builtin_bit_cast(float, h0 << 16), f[2 * i + 1] - __builtin_bit_cast(float, h1 << 16)); }
                if (tk < nv) {
                    if (f8) { u32x2 o; o.x = pg8::pk4_fp8(f[0], f[1], f[2], f[3]); o.y = pg8::pk4_fp8(f[4], f[5], f[6], f[7]); *(u32x2*)(fb8 + 32 * ks) = o; }
                    else *(u32x4*)(fb16 + 32 * ks) = hi;
                }
                const bf16x8 bh = *(const LAS bf16x8*)(rwh + tk * RW_LD + 32 * ks + 8 * kg), bl = *(const LAS bf16x8*)(rwl + tk * RW_LD + 32 * ks + 8 * kg);
                const bf16x8 ah = __builtin_bit_cast(bf16x8, hi), al = __builtin_bit_cast(bf16x8, lo);
                acc = __builtin_amdgcn_mfma_f32_16x16x32_bf16(ah, bh, acc, 0, 0, 0);
                acc = __builtin_amdgcn_mfma_f32_16x16x32_bf16(ah, bl, acc, 0, 0, 0);
                acc = __builtin_amdgcn_mfma_f32_16x16x32_bf16(al, bh, acc, 0, 0, 0);
            }
        }
#pragma unroll
        for (int j = 0; j < 4; ++j) lgs[(4 * kg + j) * 16 + tk] = acc[j];
        LDS_WAIT(); asm volatile("" ::: "memory");
        if (F.lane < nv) {
            const int tqq = t0 + g0 + F.lane;
            float aff[16], sel[16];
#pragma unroll
            for (int e4 = 0; e4 < 4; ++e4) { const f32x4 l4 = *(const LAS f32x4*)(lgs + F.lane * 16 + 4 * e4); const f32x4 b4 = *(const f32x4*)(F.in[I_RB] + 4 * e4);
                aff[4 * e4] = 1.0f / (1.0f + expf(-l4.x)); aff[4 * e4 + 1] = 1.0f / (1.0f + expf(-l4.y)); aff[4 * e4 + 2] = 1.0f / (1.0f + expf(-l4.z)); aff[4 * e4 + 3] = 1.0f / (1.0f + expf(-l4.w));
                sel[4 * e4] = aff[4 * e4] + b4.x; sel[4 * e4 + 1] = aff[4 * e4 + 1] + b4.y; sel[4 * e4 + 2] = aff[4 * e4 + 2] + b4.z; sel[4 * e4 + 3] = aff[4 * e4 + 3] + b4.w; }
            int best = 0; float bs = -1e30f;
#pragma unroll
            for (int gq = 0; gq < 4; ++gq) { const float a = sel[4 * gq], b = sel[4 * gq + 1], c = sel[4 * gq + 2], d = sel[4 * gq + 3];
                const float s = fmaxf(fmaxf(fmaxf(a + b, a + c), fmaxf(a + d, b + c)), fmaxf(b + d, c + d));
                if (s > bs) { bs = s; best = gq; } }
            float sv[4], av[4];
#pragma unroll
            for (int i = 0; i < 4; ++i) { sv[i] = sel[i]; av[i] = aff[i]; }
#pragma unroll
            for (int gq = 1; gq < 4; ++gq) if (best == gq) {
#pragma unroll
                for (int i = 0; i < 4; ++i) { sv[i] = sel[4 * gq + i]; av[i] = aff[4 * gq + i]; } }
            int i1 = 0; float s1 = sv[0], a1 = av[0];
#pragma unroll
            for (int i = 1; i < 4; ++i) if (sv[i] > s1) { s1 = sv[i]; a1 = av[i]; i1 = i; }
            int i2 = -1; float s2v = -1e30f, a2 = 0.f;
#pragma unroll
            for (int i = 0; i < 4; ++i) if (i != i1 && sv[i] > s2v) { s2v = sv[i]; a2 = av[i]; i2 = i; }
            const int e1 = 4 * best + i1, e2 = 4 * best + i2;
            const float wsum = a1 + a2, w1 = a1 / wsum, w2 = a2 / wsum;
            const unsigned r1 = atomicAdd((unsigned*)(cnt + e1), 1u), r2 = atomicAdd((unsigned*)(cnt + e2), 1u);
            int* ro = route + (size_t)tqq * 8;
            ro[0] = e1; ro[1] = e2; ro[4] = __builtin_bit_cast(int, w1); ro[5] = __builtin_bit_cast(int, w2);
            const int li = li0 + g0 + F.lane;
            tinfo[4 * li + 0] = e1; tinfo[4 * li + 1] = e2; tinfo[4 * li + 2] = (int)r1; tinfo[4 * li + 3] = (int)r2;
        }
        LDS_WAIT(); asm volatile("" ::: "memory");
    }
    }
    __syncthreads();
    if (F.tid < 16) gb[F.tid] = (int)__hip_atomic_fetch_add((unsigned*)(F.ws + WS_GCNT) + layer * 16 + F.tid, cnt[F.tid], __ATOMIC_RELAXED, __HIP_MEMORY_SCOPE_AGENT);
    __syncthreads();
    int* tokmap = (int*)(F.ws + WS_TOKMAP);
    for (int i = F.tid; i < nA + nB; i += 512) {
        const int tok = (i < nA) ? tA + i : tB + (i - nA);
        const int e1 = tinfo[4 * i], e2 = tinfo[4 * i + 1], p1 = gb[e1] + tinfo[4 * i + 2], p2 = gb[e2] + tinfo[4 * i + 3];
        tokmap[(size_t)e1 * T + p1] = tok; tokmap[(size_t)e2 * T + p2] = tok;
        int* ro = route + (size_t)tok * 8; ro[2] = p1; ro[3] = p2;
    }
}

__device__ __forceinline__ int moe_tables(Frame& F, int layer) {
    LAS int* tb = (LAS int*)(F.lds + LDS_CTL + 64); LAS int* cn = (LAS int*)(F.lds + LDS_CTL + 192);
    __syncthreads();
    if (F.tid < 16) cn[F.tid] = ld_coh((const int*)(F.ws + WS_GCNT) + layer * 16 + F.tid);
    __syncthreads();
    if (F.tid == 0) { int b = 0; for (int e = 0; e < 16; ++e) { tb[e] = b; b += (cn[e] + 255) >> 8; } tb[16] = b; }
    __syncthreads();
    return __builtin_amdgcn_readfirstlane(tb[16]);
}

typedef float f32x2 __attribute__((ext_vector_type(2)));
template <int NQ> __device__ __forceinline__ void combine_tokens(Frame& F, int layer, int t) {
    const float* mods = (const float*)(F.ws + WS_MODS);
    const unsigned char* OS = (const unsigned char*)(F.ws + WS_BUFP);
    const int* route = (const int*)(F.ws + WS_ROUTE);
    const LAS int* tb = (const LAS int*)(F.lds + LDS_CTL + 64);
    bf16* A = (bf16*)(F.ws + WS_BUFA);
    {
        int rc[NQ][4]; float w0[NQ], w1[NQ];
#pragma unroll
        for (int q = 0; q < NQ; ++q) { const int* ro = route + (size_t)(t + q) * 8;
#pragma unroll
            for (int i = 0; i < 4; ++i) rc[q][i] = ld_coh(ro + i);
            w0[q] = ld_cohf((const float*)(ro + 4)) * (1.0f / pg8::OS_SCALE); w1[q] = ld_cohf((const float*)(ro + 5)) * (1.0f / pg8::OS_SCALE); }
        f32x4 v[NQ][4]; unsigned oa[NQ][4], ob[NQ][4];
#pragma unroll
        for (int q = 0; q < NQ; ++q) { const bf16* hr = h_row(F, t + q);
            const size_t s0 = (size_t)(tb[rc[q][0]] * 256 + rc[q][2]) * D, s1 = (size_t)(tb[rc[q][1]] * 256 + rc[q][3]) * D;
#pragma unroll
            for (int j = 0; j < 4; ++j) { const int c = 4 * F.lane + 256 * j; { const u32x2 hv = *(const u32x2*)(hr + c); v[q][j] = (f32x4){bflo(hv.x), bfhi(hv.x), bflo(hv.y), bfhi(hv.y)}; } oa[q][j] = __builtin_nontemporal_load((const unsigned*)(OS + s0 + c)); ob[q][j] = __builtin_nontemporal_load((const unsigned*)(OS + s1 + c)); } }
        const int mr = mod_row(t);
        const float* m5 = mods + (size_t)(layer * 9 + mr) * 6144 + 5 * 1024;
#pragma unroll
        for (int j = 0; j < 4; ++j) { const f32x4 g5 = *(const f32x4*)(m5 + 4 * F.lane + 256 * j);
#pragma unroll
            for (int q = 0; q < NQ; ++q) { const f32x2 a0 = __builtin_amdgcn_cvt_pk_f32_fp8((int)oa[q][j], false), a1 = __builtin_amdgcn_cvt_pk_f32_fp8((int)oa[q][j], true), b0 = __builtin_amdgcn_cvt_pk_f32_fp8((int)ob[q][j], false), b1 = __builtin_amdgcn_cvt_pk_f32_fp8((int)ob[q][j], true);
                const f32x4 o = (f32x4){w0[q] * a0[0] + w1[q] * b0[0], w0[q] * a0[1] + w1[q] * b0[1], w0[q] * a1[0] + w1[q] * b1[0], w0[q] * a1[1] + w1[q] * b1[1]};
                v[q][j] = v[q][j] + g5 * o; } }
#pragma unroll
        for (int q = 0; q < NQ; ++q) {
            if (layer == 0) {
                bf16* hr = h_row(F, t + q);
#pragma unroll
                for (int j = 0; j < 4; ++j) { u32x2 o; o.x = pk2(v[q][j].x, v[q][j].y); o.y = pk2(v[q][j].z, v[q][j].w); *(u32x2*)(hr + 4 * F.lane + 256 * j) = o; }
                const float* m = mods + (size_t)(9 + mr) * 6144;
                if constexpr (FP8_IN1) norm_mod_store<true>(v[q], F.in[I_NMG] + 1024, m, m + 1024, (bf16*)((unsigned char*)A + (size_t)(t + q) * D), F.lane);
                else norm_mod_store(v[q], F.in[I_NMG] + 1024, m, m + 1024, A + (size_t)(t + q) * D, F.lane);
            } else {
                float s2 = 0.f;
#pragma unroll
                for (int j = 0; j < 4; ++j) s2 += (v[q][j].x * v[q][j].x + v[q][j].y * v[q][j].y) + (v[q][j].z * v[q][j].z + v[q][j].w * v[q][j].w);
                const float rstd = 1.0f / sqrtf(wave_sum(s2) * (1.0f / D) + EPS);
                float* orow = F.out + (size_t)(t + q) * D;
#pragma unroll
                for (int j = 0; j < 4; ++j) { const int c = 4 * F.lane + 256 * j; __builtin_nontemporal_store(v[q][j] * rstd * *(const f32x4*)(F.in[I_FG] + c), (f32x4*)(orow + c)); }
            }
        }
    }
}
__device__ __forceinline__ void phase_combine(Frame& F, int layer, int ntok) {
    const int gw = F.vcu * NWAVES + F.wave, NGW = F.G * NWAVES;
    if (layer == 0) { for (int t = 2 * gw; t < TL; t += 2 * NGW) combine_tokens<2>(F, 0, t); for (int t = TL + gw; t < ntok; t += NGW) combine_tokens<1>(F, 0, t); }
    else { for (int t = 4 * gw; t < TL; t += 4 * NGW) combine_tokens<4>(F, 1, t); }
}

constexpr int KV_LD = 72, VL_OFF = 384 * KV_LD * 2, ROPE_LDS = 131072;
typedef short v4i16_t __attribute__((ext_vector_type(4)));

__device__ __forceinline__ bf16x8 rope_pack(const u32x4 x1, const u32x4 x2, const LAS float* cs, const LAS float* sn, float scale, bool second) {
    const f32x4 c0 = *(const LAS f32x4*)cs, c1 = *(const LAS f32x4*)(cs + 4), s0 = *(const LAS f32x4*)sn, s1 = *(const LAS f32x4*)(sn + 4);
    float c[8] = {c0.x, c0.y, c0.z, c0.w, c1.x, c1.y, c1.z, c1.w}, s[8] = {s0.x, s0.y, s0.z, s0.w, s1.x, s1.y, s1.z, s1.w};
    float a[8], b[8];
#pragma unroll
    for (int i = 0; i < 4; ++i) { a[2 * i] = bflo(x1[i]); a[2 * i + 1] = bfhi(x1[i]); b[2 * i] = bflo(x2[i]); b[2 * i + 1] = bfhi(x2[i]); }
    float o[8];
#pragma unroll
    for (int i = 0; i < 8; ++i) o[i] = (second ? (b[i] * c[i] + a[i] * s[i]) : (a[i] * c[i] - b[i] * s[i])) * scale;
    u32x4 w; w.x = pk2(o[0], o[1]); w.y = pk2(o[2], o[3]); w.z = pk2(o[4], o[5]); w.w = pk2(o[6], o[7]);
    return __builtin_bit_cast(bf16x8, w);
}

struct AttnU { int b, qb, kvh; };
__device__ __forceinline__ AttnU attn_unit_of(int u) { AttnU r; r.kvh = u & 1; r.qb = (u >> 1) & 31; r.b = u >> 6; return r; }

__device__ __forceinline__ void attn_load_latk(Frame& F, const bf16* P1, AttnU u, u32x4 (&lk)[2][4]) {
    const u32x4 z = (u32x4){0u, 0u, 0u, 0u};
#pragma unroll
    for (int it = 0; it < 2; ++it) { const int task = F.tid + 512 * it, kidx = task >> 1, hh = task & 1, pos = u.qb * 128 - 128 + kidx;
        const bool ok = task < 768 && pos >= 0 && pos < NSEQ;
        const bf16* row = P1 + (size_t)(u.b * NSEQ + (ok ? pos : 0)) * OIN + 1024 + u.kvh * 64 + 8 * hh;
#pragma unroll
        for (int st = 0; st < 4; ++st) lk[it][st] = ok ? *(const u32x4*)(row + 16 * st) : z; }
}
__device__ __forceinline__ void attn_load_latv(Frame& F, const bf16* P1, AttnU u, u32x4 (&lv)[6]) {
    const u32x4 z = (u32x4){0u, 0u, 0u, 0u};
#pragma unroll
    for (int it = 0; it < 6; ++it) { const int task = F.tid + 512 * it, kidx = task >> 3, c8 = task & 7, pos = u.qb * 128 - 128 + kidx;
        const bool ok = pos >= 0 && pos < NSEQ;
        lv[it] = ok ? *(const u32x4*)(P1 + (size_t)(u.b * NSEQ + (ok ? pos : 0)) * OIN + 1152 + u.kvh * 64 + 8 * c8) : z; }
}
__device__ __forceinline__ void attn_write_lat(Frame& F, AttnU u, const u32x4 (&lk)[2][4], const u32x4 (&lv)[6]) {
    LAS bf16* KL = (LAS bf16*)F.lds; LAS bf16* VL = (LAS bf16*)(F.lds + VL_OFF); const LAS float* rope = (const LAS float*)(F.lds + ROPE_LDS);
#pragma unroll
    for (int it = 0; it < 2; ++it) { const int task = F.tid + 512 * it, kidx = task >> 1, hh = task & 1; int pos = u.qb * 128 - 128 + kidx; pos = pos < 0 ? 0 : (pos > NSEQ - 1 ? NSEQ - 1 : pos);
        if (task < 768) {
            LAS bf16* d = KL + kidx * KV_LD + 8 * hh;
            const LAS float* c0 = rope + (pos >> 6) * 16 + 8 * hh; const LAS float* c1 = rope + (pos & 63) * 16 + 8 * hh;
            *(LAS bf16x8*)(d) = rope_pack(lk[it][0], lk[it][1], c0, c0 + 1024, 1.0f, false);
            *(LAS bf16x8*)(d + 16) = rope_pack(lk[it][0], lk[it][1], c0, c0 + 1024, 1.0f, true);
            *(LAS bf16x8*)(d + 32) = rope_pack(lk[it][2], lk[it][3], c1, c1 + 1024, 1.0f, false);
            *(LAS bf16x8*)(d + 48) = rope_pack(lk[it][2], lk[it][3], c1, c1 + 1024, 1.0f, true);
        } }
#pragma unroll
    for (int it = 0; it < 6; ++it) { const int task = F.tid + 512 * it, kidx = task >> 3, c8 = task & 7; *(LAS u32x4*)(VL + kidx * KV_LD + 8 * c8) = lv[it]; }
}
__device__ __forceinline__ void attn_load_ctx(Frame& F, const bf16* P1, AttnU u, u32x4 (&ck)[4], u32x4 (&cv)[4]) {
#pragma unroll
    for (int it = 0; it < 4; ++it) { const int task = F.tid + 512 * it, kidx = task >> 3, c8 = task & 7;
        const bf16* row = P1 + (size_t)(TL + u.b * LCTX + kidx) * OIN + 1024 + u.kvh * 64 + 8 * c8;
        ck[it] = *(const u32x4*)row; cv[it] = *(const u32x4*)(row + 128); }
}
__device__ __forceinline__ void attn_write_ctx(Frame& F, const u32x4 (&ck)[4], const u32x4 (&cv)[4]) {
    LAS bf16* KL = (LAS bf16*)F.lds; LAS bf16* VL = (LAS bf16*)(F.lds + VL_OFF);
#pragma unroll
    for (int it = 0; it < 4; ++it) { const int task = F.tid + 512 * it, kidx = task >> 3, c8 = task & 7;
        *(LAS u32x4*)(KL + kidx * KV_LD + 8 * c8) = ck[it]; *(LAS u32x4*)(VL + kidx * KV_LD + 8 * c8) = cv[it]; }
}

__device__ __forceinline__ unsigned cvtpk(float lo, float hi) { unsigned r; asm volatile("v_cvt_pk_bf16_f32 %0, %1, %2" : "=v"(r) : "v"(lo), "v"(hi)); return r; }
__device__ __forceinline__ float xhalf_max(float x) { const auto r = __builtin_amdgcn_permlane32_swap(__builtin_bit_cast(unsigned, x), __builtin_bit_cast(unsigned, x), false, false);
    return fmaxf(__builtin_bit_cast(float, r[0]), __builtin_bit_cast(float, r[1])); }
__device__ __forceinline__ float xhalf_sum(float x) { const auto r = __builtin_amdgcn_permlane32_swap(__builtin_bit_cast(unsigned, x), __builtin_bit_cast(unsigned, x), false, false);
    return __builtin_bit_cast(float, r[0]) + __builtin_bit_cast(float, r[1]); }
__device__ __forceinline__ void attn_tiles(Frame& F, int kt0, int kt1, int mk0, int mk1, const bf16x8 (&qf)[4], f32x16 (&O)[2], float& mrun, float& lrun, int qrel) {
    if (kt0 > kt1) return;
    const LAS bf16* KL = (const LAS bf16*)F.lds; const LAS bf16* VL = (const LAS bf16*)(F.lds + VL_OFF);
    const int r32 = F.lane & 31, hh = F.lane >> 5;
    const int q4 = (F.lane & 15) >> 2, p4 = F.lane & 3, blk = (F.lane >> 4) & 1;
    const LAS bf16* kp = KL + (kt0 * 32 + r32) * KV_LD + 8 * hh;
    const LAS bf16* vp = VL + (kt0 * 32 + 4 * hh + q4) * KV_LD + 16 * blk + 4 * p4;
    bf16x8 kn[4];
#pragma unroll
    for (int st = 0; st < 4; ++st) kn[st] = *(const LAS bf16x8*)(kp + 16 * st);
    for (int kt = kt0; kt <= kt1; ++kt) {
        bf16x8 kf[4];
#pragma unroll
        for (int st = 0; st < 4; ++st) kf[st] = kn[st];
        v4i16_t vlo[2][2], vhi[2][2];
#pragma unroll
        for (int dt = 0; dt < 2; ++dt)
#pragma unroll
            for (int s2 = 0; s2 < 2; ++s2) { vlo[dt][s2] = __builtin_amdgcn_ds_read_tr16_b64_v4i16((LAS v4i16_t*)(vp + (16 * s2) * KV_LD + dt * 32));
                vhi[dt][s2] = __builtin_amdgcn_ds_read_tr16_b64_v4i16((LAS v4i16_t*)(vp + (16 * s2 + 8) * KV_LD + dt * 32)); }
        kp += 32 * KV_LD; vp += 32 * KV_LD;
        if (kt < kt1) {
#pragma unroll
            for (int st = 0; st < 4; ++st) kn[st] = *(const LAS bf16x8*)(kp + 16 * st); }
        __builtin_amdgcn_sched_barrier(0);
        f32x16 s;
#pragma unroll
        for (int r = 0; r < 16; ++r) s[r] = 0.f;
#pragma unroll
        for (int st = 0; st < 4; ++st) s = __builtin_amdgcn_mfma_f32_32x32x16_bf16(kf[st], qf[st], s, 0, 0, 0);
        if (kt == mk0 || kt == mk1) {
#pragma unroll
            for (int r = 0; r < 16; ++r) { const int dlt = kt * 32 + (r & 3) + 8 * (r >> 2) + 4 * hh - qrel; s[r] = (dlt <= 128 && dlt >= -128) ? s[r] : -INFINITY; } }
        float mx = fmaxf(fmaxf(s[0], s[1]), fmaxf(s[2], s[3]));
#pragma unroll
        for (int r = 4; r < 16; r += 4) mx = fmaxf(mx, fmaxf(fmaxf(s[r], s[r + 1]), fmaxf(s[r + 2], s[r + 3])));
        mx = xhalf_max(mx);
        const float mnew = fmaxf(mrun, mx);
        float ps0 = 0.f, ps1 = 0.f;
#pragma unroll
        for (int r = 0; r < 16; r += 2) { s[r] = __builtin_amdgcn_exp2f(s[r] - mnew); s[r + 1] = __builtin_amdgcn_exp2f(s[r + 1] - mnew); ps0 += s[r]; ps1 += s[r + 1]; }
        const float ps = xhalf_sum(ps0 + ps1);
        if (__any(mnew > mrun)) {
            const float alpha = __builtin_amdgcn_exp2f(mrun - mnew);
            lrun *= alpha;
#pragma unroll
            for (int dt = 0; dt < 2; ++dt)
#pragma unroll
                for (int r = 0; r < 16; ++r) O[dt][r] *= alpha;
        }
        lrun += ps; mrun = mnew;
        bf16x8 pb[2];
#pragma unroll
        for (int s2 = 0; s2 < 2; ++s2) { u32x4 w; w.x = cvtpk(s[8 * s2 + 0], s[8 * s2 + 1]); w.y = cvtpk(s[8 * s2 + 2], s[8 * s2 + 3]); w.z = cvtpk(s[8 * s2 + 4], s[8 * s2 + 5]); w.w = cvtpk(s[8 * s2 + 6], s[8 * s2 + 7]);
            pb[s2] = __builtin_bit_cast(bf16x8, w); }
#pragma unroll
        for (int dt = 0; dt < 2; ++dt)
#pragma unroll
            for (int s2 = 0; s2 < 2; ++s2) {
                const bf16x8 va = (bf16x8){vlo[dt][s2][0], vlo[dt][s2][1], vlo[dt][s2][2], vlo[dt][s2][3], vhi[dt][s2][0], vhi[dt][s2][1], vhi[dt][s2][2], vhi[dt][s2][3]};
                O[dt] = __builtin_amdgcn_mfma_f32_32x32x16_bf16(va, pb[s2], O[dt], 0, 0, 0);
            }
    }
}

__device__ __forceinline__ void phase_attn(Frame& F) {
    const bf16* P1 = (const bf16*)(F.ws + WS_BUFP);
    bf16* MIX = (bf16*)(F.ws + WS_BUFA);
    const int r32 = F.lane & 31, hh = F.lane >> 5;
    constexpr float QSC = 0.125f * 1.4426950408889634f;
    LAS float* ropel = (LAS float*)(F.lds + ROPE_LDS);
    for (int i = F.tid; i < 2048; i += 512) ropel[i] = ((const float*)(F.ws + WS_ROPE))[i];
    u32x4 lk[2][4], lv[6], ck[4], cv[4];
    const int nu = (512 - F.vcu + F.G - 1) / F.G;
    if (nu > 0) attn_load_latk(F, P1, attn_unit_of(F.vcu), lk);
    for (int ui = 0; ui < nu; ++ui) {
        const AttnU u = attn_unit_of(F.vcu + ui * F.G);
        u32x4 qr[2][4];
#pragma unroll
        for (int i = 0; i < 2; ++i) { const int task = F.wave + 8 * i, g = task & 3, sub = task >> 2, head = u.kvh * 4 + g, pos = u.qb * 128 + 32 * sub + r32;
            const bf16* row = P1 + (size_t)(u.b * NSEQ + pos) * OIN + 512 + head * 64 + 8 * hh;
#pragma unroll
            for (int st = 0; st < 4; ++st) qr[i][st] = __builtin_nontemporal_load((const u32x4*)(row + 16 * st)); }
        attn_load_latv(F, P1, u, lv);
        __syncthreads();
        attn_write_lat(F, u, lk, lv);
        bf16x8 qf[2][4]; f32x16 O[2][2]; float mrun[2], lrun[2];
#pragma unroll
        for (int i = 0; i < 2; ++i) { const int task = F.wave + 8 * i, g = task & 3, sub = task >> 2, head = u.kvh * 4 + g, pos = u.qb * 128 + 32 * sub + r32;
            const LAS float* c0 = ropel + (pos >> 6) * 16 + 8 * hh; const LAS float* c1 = ropel + (pos & 63) * 16 + 8 * hh;
            qf[i][0] = rope_pack(qr[i][0], qr[i][1], c0, c0 + 1024, QSC, false); qf[i][1] = rope_pack(qr[i][0], qr[i][1], c0, c0 + 1024, QSC, true);
            qf[i][2] = rope_pack(qr[i][2], qr[i][3], c1, c1 + 1024, QSC, false); qf[i][3] = rope_pack(qr[i][2], qr[i][3], c1, c1 + 1024, QSC, true);
            mrun[i] = F.in[I_OSINK][head] * 1.4426950408889634f; lrun[i] = 1.0f;
#pragma unroll
            for (int dt = 0; dt < 2; ++dt)
#pragma unroll
                for (int r = 0; r < 16; ++r) O[i][dt][r] = 0.f; }
        __syncthreads();
        const int kt_lo = (u.qb == 0) ? 4 : 0, kt_hi = (u.qb == 31) ? 7 : 11;
#pragma unroll
        for (int i = 0; i < 2; ++i) { const int sub = (F.wave + 8 * i) >> 2, qrel = 128 + 32 * sub + r32;
            attn_tiles(F, max(sub, kt_lo), min(sub + 8, kt_hi), sub, sub + 8, qf[i], O[i], mrun[i], lrun[i], qrel); }
        attn_load_ctx(F, P1, u, ck, cv);
        __syncthreads();
        attn_write_ctx(F, ck, cv);
        __syncthreads();
        if (ui + 1 < nu) attn_load_latk(F, P1, attn_unit_of(F.vcu + (ui + 1) * F.G), lk);
#pragma unroll
        for (int i = 0; i < 2; ++i) {
            attn_tiles(F, 0, 7, -1, -1, qf[i], O[i], mrun[i], lrun[i], 0);
            const int task = F.wave + 8 * i, g = task & 3, sub = task >> 2, head = u.kvh * 4 + g, pos = u.qb * 128 + 32 * sub + r32;
            const float inv = 1.0f / lrun[i];
            bf16* o = MIX + (size_t)(u.b * NSEQ + pos) * D + 512 + head * 64 + 4 * hh;
#pragma unroll
            for (int dt = 0; dt < 2; ++dt)
#pragma unroll
                for (int rg = 0; rg < 4; ++rg) { u32x2 w; w.x = pk2(O[i][dt][4 * rg] * inv, O[i][dt][4 * rg + 1] * inv); w.y = pk2(O[i][dt][4 * rg + 2] * inv, O[i][dt][4 * rg + 3] * inv);
                    *(u32x2*)(o + dt * 32 + 8 * rg) = w; }
        }
    }
    __syncthreads();
}

__device__ __forceinline__ void phase_pool_stencil(Frame& F) {
    const bf16* P1 = (const bf16*)(F.ws + WS_BUFP);
    bf16* MIX = (bf16*)(F.ws + WS_BUFA);
    const int gw = F.vcu * NWAVES + F.wave, NGW = F.G * NWAVES;
    const int r = 1 << (F.lane >> 4);
    constexpr int NT = 8, NR = NT + 16;
    for (int t = NT * gw; t < TL; t += NT * NGW) {
        const int pos = t & 4095;
        const bf16* base = P1 + (size_t)t * OIN + 8 * F.lane;
        u32x4 v[NR];
#pragma unroll
        for (int jj = 0; jj < NR; ++jj) { const int pj = pos + jj - 8; const bool ok = pj >= 0 && pj < NSEQ; v[jj] = ok ? *(const u32x4*)(base + (ptrdiff_t)(jj - 8) * OIN) : (u32x4){0u, 0u, 0u, 0u}; }
        float acc[NT][8];
#pragma unroll
        for (int q = 0; q < NT; ++q)
#pragma unroll
            for (int i = 0; i < 8; ++i) acc[q][i] = 0.f;
#pragma unroll
        for (int jj = 0; jj < NR; ++jj) {
            float x[8];
#pragma unroll
            for (int i = 0; i < 4; ++i) { x[2 * i] = bflo(v[jj][i]); x[2 * i + 1] = bfhi(v[jj][i]); }
#pragma unroll
            for (int q = 0; q < NT; ++q) { const int dd = jj - 8 - q; if (dd >= -8 && dd <= 8) { const float w = (dd <= r && dd >= -r) ? 1.0f : 0.0f;
#pragma unroll
                for (int i = 0; i < 8; ++i) acc[q][i] += w * x[i]; } }
        }
#pragma unroll
        for (int q = 0; q < NT; ++q) {
            const int pq = pos + q, lo = max(pq - r, 0), hi = min(pq + r + 1, NSEQ);
            const float ic = 1.0f / (float)(hi - lo);
            const u32x4 sv = v[q + 8];
            u32x4 o;
#pragma unroll
            for (int i = 0; i < 4; ++i) o[i] = pk2(acc[q][2 * i] * ic - bflo(sv[i]), acc[q][2 * i + 1] * ic - bfhi(sv[i]));
            *(u32x4*)(MIX + (size_t)(t + q) * D + 8 * F.lane) = o;
        }
    }
}

__device__ __forceinline__ void phase_attn_pool(Frame& F) {
    phase_attn(F);
#ifdef DBG_ATTN2
    phase_attn(F);
#endif
    phase_pool_stencil(F);
    __syncthreads();
    convert_l1_range(F, 120 * L1T_N + F.vcu * L1A_N, L1A_N, 40);
}

constexpr int NPHASE = 20;
__global__ void __launch_bounds__(NWAVES * 64, 2) mk_fwd(Args args) {
    extern __shared__ __attribute__((aligned(16))) unsigned char lds_raw[];
    Frame F;
    F.lds = (LAS unsigned char*)lds_raw;
    F.tid = threadIdx.x; F.lane = F.tid & 63; F.wave = __builtin_amdgcn_readfirstlane(F.tid >> 6);
    F.G = gridDim.x; { const int bx = blockIdx.x; F.vcu = (F.G % 8 == 0) ? (bx % 8) * (F.G / 8) + bx / 8 : bx; }
    F.ws = args.ws; F.in = args.in; F.out = args.out;
    for (int u = F.tid; u < (LDS_BYTES - LDS_CTL) / 4; u += NWAVES * 64) ((LAS unsigned*)(F.lds + LDS_CTL))[u] = 0u;
    __syncthreads();
    const int lo = args.ph_lo, hi = args.ph_hi;
    XcdBarrier bar; bar.bar = (unsigned*)(F.ws + WS_CTL); bar.x = 0; bar.st = nullptr;
    if (hi - lo > 1) bar = xcd_barrier_post((unsigned*)(F.ws + WS_CTL), (volatile LAS unsigned*)(F.lds + LDS_CTL));
    if (F.tid == 0) { *((unsigned*)(F.ws + WS_XCDOF) + F.vcu) = xb_xcc_id(); *(LAS int*)(F.lds + LDS_CTL + 52) = (hi - lo > 1) ? 1 : 0; }
#define IN(k) (lo <= (k) && (k) < hi)
#ifndef PHASE_MASK
#define PHASE_MASK 0xffffffffu
#endif
#define PH(k, ...) if constexpr (((PHASE_MASK >> (k)) & 1u) != 0u) if (IN(k)) { { int t_ = F.tid; asm volatile("" : "+v"(t_)); F.tid = t_; F.lane = t_ & 63; } __VA_ARGS__ if constexpr (((DBG_DOUBLE >> (k)) & 1u) != 0u) { __VA_ARGS__ } }
#define SEAM(k) do { if (IN(k) && IN((k) + 1)) xcd_barrier(bar); } while (0)
    unsigned char* ws = F.ws;
    const float* mods = (const float*)(ws + WS_MODS);

    PH(1, { phase_prologue_a(F); }) SEAM(1);
    PH(2, {
        pg8::SchedDense S{(const char*)(ws + WS_BUFA), (const char*)(ws + WS_W_EIN), 1024, 8, 136, 0, 1088, F.vcu, F.G};
        pg8::EpiStore E{(bf16*)(ws + WS_BUFP), EIN};
        pg8::gemm_phase<pg8::EpiStore, pg8::SchedDense>(F.lds, 1024, S, E);
        if (F.vcu >= 64) { __syncthreads(); convert_l1_range(F, (F.vcu - 64) * L0T_N, L0T_N, 48, 0); }
    }) SEAM(2);
    PH(3, { phase_fourier_a_conv(F); })
    PH(4, { phase_fourier_c(F); }) SEAM(4);
    PH(5, {
        const int xs = F.vcu >> 5, rs = F.vcu & 31; const bool heavy = rs >= 28;
        pg8::SchedSplit S{(const char*)(ws + WS_BUFA), (const char*)(ws + WS_W_EOUT), 1024, heavy ? 448 + 4 * xs + (rs - 28) : 28 * xs + rs, heavy ? 32 : 224, heavy ? 3 : 2};
        pg8::EpiResid<true> E{F.in[I_X], F.in[I_CTX], (bf16*)(ws + WS_HB), mods + 2 * 1024};
        pg8::gemm_phase<pg8::EpiResid<true>, pg8::SchedSplit>(F.lds, 1024, S, E);
        ctr_publish(F, heavy ? WS_P5C : WS_P5F, heavy ? 2 : 1, xcd_census(F, [&](int v) { return ((v & 31) >= 28) == heavy; }));
    })
    PH(6, { phase_route<true>(F, 0, T); }) SEAM(6);
    PH(7, {
        const int ntile = moe_tables(F, 0);
        const int Lg = ntile & 63; const bool isLong = (F.vcu >> 2) < Lg;
        const unsigned nxc = xcd_census(F, [&](int v) { return ((v >> 2) < Lg) == isLong; });
        if constexpr (FP8_G1_L0) {
            pg8::SchedMoe<true> S{(const char*)(ws + WS_BUFA), (const char*)(ws + WS_W_M1) + (size_t)0 * 32 * MiB, (const int*)(ws + WS_TOKMAP), (const LAS int*)(F.lds + LDS_CTL + 64), (const LAS int*)(F.lds + LDS_CTL + 192), 512, (size_t)MiB, ntile * 4, F.vcu, F.G};
            pg8::EpiSwiglu8 E{(unsigned char*)(ws + WS_BUFZ), pg8::W1_SCALE};
            pg8::gemm_phase<pg8::EpiSwiglu8, pg8::SchedMoe<true>, true>(F.lds, 512, S, E);
        } else {
            pg8::SchedMoe<true> S{(const char*)(ws + WS_BUFA), (const char*)(ws + WS_W_M1) + (size_t)0 * 32 * MiB, (const int*)(ws + WS_TOKMAP), (const LAS int*)(F.lds + LDS_CTL + 64), (const LAS int*)(F.lds + LDS_CTL + 192), 1024, (size_t)2 * MiB, ntile * 4, F.vcu, F.G};
            if constexpr (FP8_G2_L0) { pg8::EpiSwiglu8 E{(unsigned char*)(ws + WS_BUFZ), 1.0f}; pg8::gemm_phase<pg8::EpiSwiglu8, pg8::SchedMoe<true>>(F.lds, 1024, S, E); }
            else { pg8::EpiSwiglu E{(bf16*)(ws + WS_BUFZ)}; pg8::gemm_phase<pg8::EpiSwiglu, pg8::SchedMoe<true>>(F.lds, 1024, S, E); }
        }
        ctr_publish(F, WS_G1CNT + (size_t)(0 * 2 + (isLong ? 1 : 0)) * 256, 3 + 0 * 2 + (isLong ? 1 : 0), nxc);
    })
    PH(8, {
        const int ntile = moe_tables(F, 0);
        const int Rp = ntile >> 6, Lg = ntile & 63, grp = F.vcu >> 2; const bool isLong = grp < Lg;
        const size_t cnt0 = WS_G1CNT + (size_t)(0 * 2) * 256;
        ctr_wait(F, cnt0 + (isLong ? 256 : 0), (unsigned)(isLong ? 4 * Lg : 256 - 4 * Lg));
        if constexpr (FP8_G2_L0) {
            { pg8::EpiStoreF8 E{(unsigned char*)(ws + WS_BUFP), 1024, pg8::OS_SCALE / (pg8::HID_SCALE * pg8::W2_SCALE)};
              pg8::SchedMoe<false> S{(const char*)(ws + WS_BUFZ), (const char*)(ws + WS_W_M2) + (size_t)0 * 16 * MiB, nullptr, (const LAS int*)(F.lds + LDS_CTL + 64), (const LAS int*)(F.lds + LDS_CTL + 192), 256, (size_t)512 * KiB, Rp * 256, F.vcu, F.G};
              pg8::gemm_phase<pg8::EpiStoreF8, pg8::SchedMoe<false>, true>(F.lds, 256, S, E); }
            const int nt2 = __builtin_amdgcn_readfirstlane(*(const LAS int*)(F.lds + LDS_CTL + 64 + 64)), Lg2 = nt2 & 63, grp2 = F.vcu >> 2;
            int xc = -1;
            if (grp2 < Lg2) { if (63 - grp2 < Lg2) xc = F.vcu; }
            else if (63 - grp2 < Lg2) xc = 4 * (63 - grp2) + (F.vcu & 3);
            if (xc >= 0) {
                if (grp2 >= Lg2) ctr_wait(F, WS_G1CNT + (size_t)(0 * 2 + 1) * 256, (unsigned)(4 * Lg2));
                pg8::EpiStoreF8 E{(unsigned char*)(ws + WS_BUFP), 1024, pg8::OS_SCALE / (pg8::HID_SCALE * pg8::W2_SCALE)};
                pg8::SchedMoe<false> S{(const char*)(ws + WS_BUFZ), (const char*)(ws + WS_W_M2) + (size_t)0 * 16 * MiB, nullptr, (const LAS int*)(F.lds + LDS_CTL + 64), (const LAS int*)(F.lds + LDS_CTL + 192), 256, (size_t)512 * KiB, nt2 * 4, (nt2 >> 6) * 256 + xc, 1 << 20};
                pg8::gemm_phase<pg8::EpiStoreF8, pg8::SchedMoe<false>, true>(F.lds, 256, S, E);
            }
        } else {
            if (Lg > 0 && Lg < 64) ctr_wait(F, cnt0 + (isLong ? 0 : 256), (unsigned)(isLong ? 256 - 4 * Lg : 4 * Lg));
            pg8::SchedMoe<false> S{(const char*)(ws + WS_BUFZ), (const char*)(ws + WS_W_M2) + (size_t)0 * 16 * MiB, nullptr, (const LAS int*)(F.lds + LDS_CTL + 64), (const LAS int*)(F.lds + LDS_CTL + 192), 512, (size_t)MiB, ntile * 4, F.vcu, F.G};
            pg8::EpiStore E{(bf16*)(ws + WS_BUFP), 1024};
            pg8::gemm_phase<pg8::EpiStore, pg8::SchedMoe<false>>(F.lds, 512, S, E);
        }
    }) SEAM(8);
    PH(9, { (void)moe_tables(F, 0); phase_combine(F, 0, T); }) SEAM(9);
    PH(10, {
        if constexpr (FP8_IN1) {
            pg8::SchedDense S{(const char*)(ws + WS_BUFA), (const char*)(ws + WS_W_OIN), 512, 5, 128, 4, 648, F.vcu, F.G};
            pg8::EpiStoreS E{(bf16*)(ws + WS_BUFP), OIN, 1.0f / pg8::W1_SCALE};
            pg8::gemm_phase<pg8::EpiStoreS, pg8::SchedDense, true>(F.lds, 512, S, E);
        } else {
        pg8::SchedDense S{(const char*)(ws + WS_BUFA), (const char*)(ws + WS_W_OIN), 1024, 5, 128, 4, 648, F.vcu, F.G};
        pg8::EpiStore E{(bf16*)(ws + WS_BUFP), OIN};
        pg8::gemm_phase<pg8::EpiStore, pg8::SchedDense>(F.lds, 1024, S, E); }
        if (F.vcu >= 136) { __syncthreads(); convert_l1_range(F, (F.vcu - 136) * L1T_N, L1T_N, 44); }
    }) SEAM(10);
    PH(11, { phase_attn_pool(F); }) SEAM(11);
    PH(12, {
        pg8::SchedDense S{(const char*)(ws + WS_BUFA), (const char*)(ws + WS_W_OOUT), 1024, 4, 128, 0, 512, F.vcu, F.G};
        pg8::EpiResid<false> E{nullptr, nullptr, (bf16*)(ws + WS_HB), mods + 9 * 6144 + 2 * 1024};
        pg8::gemm_phase<pg8::EpiResid<false>, pg8::SchedDense>(F.lds, 1024, S, E);
    }) SEAM(12);
    PH(13, { phase_route<false>(F, 1, TL); }) SEAM(13);
    PH(14, {
        const int ntile = moe_tables(F, 1);
        const int Lg = ntile & 63; const bool isLong = (F.vcu >> 2) < Lg;
        const unsigned nxc = xcd_census(F, [&](int v) { return ((v >> 2) < Lg) == isLong; });
        if constexpr (FP8_G1_L1) {
            pg8::SchedMoe<true> S{(const char*)(ws + WS_BUFA), (const char*)(ws + WS_W_M1) + (size_t)1 * 32 * MiB, (const int*)(ws + WS_TOKMAP), (const LAS int*)(F.lds + LDS_CTL + 64), (const LAS int*)(F.lds + LDS_CTL + 192), 512, (size_t)MiB, ntile * 4, F.vcu, F.G};
            pg8::EpiSwiglu8 E{(unsigned char*)(ws + WS_BUFZ), pg8::W1_SCALE};
            pg8::gemm_phase<pg8::EpiSwiglu8, pg8::SchedMoe<true>, true>(F.lds, 512, S, E);
        } else {
            pg8::SchedMoe<true> S{(const char*)(ws + WS_BUFA), (const char*)(ws + WS_W_M1) + (size_t)1 * 32 * MiB, (const int*)(ws + WS_TOKMAP), (const LAS int*)(F.lds + LDS_CTL + 64), (const LAS int*)(F.lds + LDS_CTL + 192), 1024, (size_t)2 * MiB, ntile * 4, F.vcu, F.G};
            if constexpr (FP8_G2_L1) { pg8::EpiSwiglu8 E{(unsigned char*)(ws + WS_BUFZ), 1.0f}; pg8::gemm_phase<pg8::EpiSwiglu8, pg8::SchedMoe<true>>(F.lds, 1024, S, E); }
            else { pg8::EpiSwiglu E{(bf16*)(ws + WS_BUFZ)}; pg8::gemm_phase<pg8::EpiSwiglu, pg8::SchedMoe<true>>(F.lds, 1024, S, E); }
        }
        ctr_publish(F, WS_G1CNT + (size_t)(1 * 2 + (isLong ? 1 : 0)) * 256, 3 + 1 * 2 + (isLong ? 1 : 0), nxc);
    })
    PH(15, {
        const int ntile = moe_tables(F, 1);
        const int Rp = ntile >> 6, Lg = ntile & 63, grp = F.vcu >> 2; const bool isLong = grp < Lg;
        const size_t cnt0 = WS_G1CNT + (size_t)(1 * 2) * 256;
        ctr_wait(F, cnt0 + (isLong ? 256 : 0), (unsigned)(isLong ? 4 * Lg : 256 - 4 * Lg));
        if constexpr (FP8_G2_L1) {
            { pg8::EpiStoreF8 E{(unsigned char*)(ws + WS_BUFP), 1024, pg8::OS_SCALE / (pg8::HID_SCALE * pg8::W2_SCALE)};
              pg8::SchedMoe<false> S{(const char*)(ws + WS_BUFZ), (const char*)(ws + WS_W_M2) + (size_t)1 * 16 * MiB, nullptr, (const LAS int*)(F.lds + LDS_CTL + 64), (const LAS int*)(F.lds + LDS_CTL + 192), 256, (size_t)512 * KiB, Rp * 256, F.vcu, F.G};
              pg8::gemm_phase<pg8::EpiStoreF8, pg8::SchedMoe<false>, true>(F.lds, 256, S, E); }
            const int nt2 = __builtin_amdgcn_readfirstlane(*(const LAS int*)(F.lds + LDS_CTL + 64 + 64)), Lg2 = nt2 & 63, grp2 = F.vcu >> 2;
            int xc = -1;
            if (grp2 < Lg2) { if (63 - grp2 < Lg2) xc = F.vcu; }
            else if (63 - grp2 < Lg2) xc = 4 * (63 - grp2) + (F.vcu & 3);
            if (xc >= 0) {
                if (grp2 >= Lg2) ctr_wait(F, WS_G1CNT + (size_t)(1 * 2 + 1) * 256, (unsigned)(4 * Lg2));
                pg8::EpiStoreF8 E{(unsigned char*)(ws + WS_BUFP), 1024, pg8::OS_SCALE / (pg8::HID_SCALE * pg8::W2_SCALE)};
                pg8::SchedMoe<false> S{(const char*)(ws + WS_BUFZ), (const char*)(ws + WS_W_M2) + (size_t)1 * 16 * MiB, nullptr, (const LAS int*)(F.lds + LDS_CTL + 64), (const LAS int*)(F.lds + LDS_CTL + 192), 256, (size_t)512 * KiB, nt2 * 4, (nt2 >> 6) * 256 + xc, 1 << 20};
                pg8::gemm_phase<pg8::EpiStoreF8, pg8::SchedMoe<false>, true>(F.lds, 256, S, E);
            }
        } else {
            if (Lg > 0 && Lg < 64) ctr_wait(F, cnt0 + (isLong ? 0 : 256), (unsigned)(isLong ? 256 - 4 * Lg : 4 * Lg));
            pg8::SchedMoe<false> S{(const char*)(ws + WS_BUFZ), (const char*)(ws + WS_W_M2) + (size_t)1 * 16 * MiB, nullptr, (const LAS int*)(F.lds + LDS_CTL + 64), (const LAS int*)(F.lds + LDS_CTL + 192), 512, (size_t)MiB, ntile * 4, F.vcu, F.G};
            pg8::EpiStore E{(bf16*)(ws + WS_BUFP), 1024};
            pg8::gemm_phase<pg8::EpiStore, pg8::SchedMoe<false>>(F.lds, 512, S, E);
        }
    }) SEAM(15);
    PH(16, { (void)moe_tables(F, 1); phase_combine(F, 1, TL); }) SEAM(16);
#ifdef DBG_XBAR
    if (hi - lo > 1) { for (int xb = 0; xb < DBG_XBAR; ++xb) xcd_barrier(bar); }
#endif
#undef IN
#undef SEAM
}

extern "C" void kernel_launch(void* const* d_in, const int* in_sizes, int n_in, void* d_out, int out_size, void* d_ws, size_t ws_size, hipStream_t stream) {
    static int grid = 0;
    if (grid == 0) {
        if (n_in != 22 || ws_size < WS_END) { fprintf(stderr, "kernel_launch: unexpected inputs (n_in %d, ws %zu)\n", n_in, ws_size); grid = -1; return; }
        int dev = 0, cus = 0, per_cu = 0;
        if (hipGetDevice(&dev) != hipSuccess || hipDeviceGetAttribute(&cus, hipDeviceAttributeMultiprocessorCount, dev) != hipSuccess) { grid = -1; return; }
        if (hipFuncSetAttribute((const void*)mk_fwd, hipFuncAttributeMaxDynamicSharedMemorySize, LDS_BYTES) != hipSuccess) { fprintf(stderr, "kernel_launch: hipFuncSetAttribute failed\n"); grid = -1; return; }
        if (hipOccupancyMaxActiveBlocksPerMultiprocessor(&per_cu, (const void*)mk_fwd, NWAVES * 64, LDS_BYTES) != hipSuccess || per_cu < 1) { fprintf(stderr, "kernel_launch: occupancy query says %d\n", per_cu); }
        (void)hipGetLastError();
        grid = cus;
        if (grid != 256) { fprintf(stderr, "kernel_launch: %d CUs; this build assumes 256\n", grid); }
    }
    if (grid < 0) return;
    (void)hipMemsetAsync((char*)d_ws + WS_CTL, 0, CTL_ZERO_BYTES, stream);
    Args a{};
    for (int i = 0; i < 22; ++i) a.in[i] = (const float*)d_in[i];
    a.out = (float*)d_out; a.ws = (unsigned char*)d_ws;
#if MK_MULTI
    for (int p = 0; p <= DBG_STOP; ++p) { a.ph_lo = p; a.ph_hi = p + 1; hipLaunchKernelGGL(mk_fwd, dim3(grid), dim3(NWAVES * 64), LDS_BYTES, stream, a); }
    if (DBG_STOP < 16) { a.ph_lo = 17; a.ph_hi = 18; hipLaunchKernelGGL(mk_fwd, dim3(grid), dim3(NWAVES * 64), LDS_BYTES, stream, a); }
#else
    a.ph_lo = 0; a.ph_hi = 17;
    hipLaunchKernelGGL(mk_fwd, dim3(grid), dim3(NWAVES * 64), LDS_BYTES, stream, a);
#endif
}
```

```cpp
#include <hip/hip_runtime.h>
#include <cstdio>
#include <cstdint>
#include <type_traits>

#ifndef FP8_IN1
#define FP8_IN1 1
#endif
#ifndef FP8_OUT1
#define FP8_OUT1 1
#endif
#ifndef MK_MULTI
#define MK_MULTI 0
#endif
#ifndef DBG_STOP
#define DBG_STOP 16
#endif

#ifndef DBG_DOUBLE
#define DBG_DOUBLE 0u
#endif
#ifndef FP8_G1_L0
#define FP8_G1_L0 1
#endif
#ifndef FP8_G1_L1
#define FP8_G1_L1 1
#endif
#ifndef FP8_G2_L0
#define FP8_G2_L0 1
#endif
#ifndef FP8_G2_L1
#define FP8_G2_L1 1
#endif
#define LAS __attribute__((address_space(3)))
#define GAS __attribute__((address_space(1)))
typedef unsigned short bf16;
typedef short bf16x8 __attribute__((ext_vector_type(8)));
typedef short s16x4 __attribute__((ext_vector_type(4)));
typedef float f32x4 __attribute__((ext_vector_type(4)));
typedef float f32x16 __attribute__((ext_vector_type(16)));
typedef unsigned u32x4 __attribute__((ext_vector_type(4)));
typedef unsigned u32x2 __attribute__((ext_vector_type(2)));

constexpr int NB = 8, NSEQ = 4096, D = 1024, LCTX = 256;
constexpr int TL = NB * NSEQ, TC = NB * LCTX, T = TL + TC;
constexpr int EIN = 2048;
constexpr int OIN = 1280;
constexpr int NE = 16, DE = 512;
constexpr int MAXSLOT = 73728;
constexpr float EPS = 1e-6f;

constexpr size_t KiB = 1024, MiB = 1024 * 1024;
constexpr size_t WS_CTL = 0, CTL_ZERO_BYTES = 64 * KiB;
constexpr size_t WS_MODS = 64 * KiB;
constexpr size_t WS_ROPE = WS_MODS + 512 * KiB;
constexpr size_t WS_WA = WS_ROPE + 8 * KiB;
constexpr size_t WS_WAC = WS_WA + 32 * KiB;
constexpr size_t WS_WCC = WS_WAC + 2 * KiB;
constexpr size_t WS_FD = 3 * MiB - 64 * KiB;
constexpr size_t WS_BCNT = WS_WCC + 16 * KiB;
constexpr size_t WS_TILEMAP = WS_BCNT + 16 * KiB;
constexpr size_t WS_SLOT = WS_TILEMAP + 2 * KiB;
constexpr size_t WS_WROW = WS_SLOT + 288 * KiB;
constexpr size_t WS_ROUTE = WS_WROW + 288 * KiB;
constexpr size_t WS_WC = 3 * MiB;
constexpr size_t WS_W_EIN = 4 * MiB;
constexpr size_t WS_W_EOUT = 9 * MiB;
constexpr size_t WS_W_OIN = 11 * MiB;
constexpr size_t WS_W_OOUT = 14 * MiB;
constexpr size_t WS_W_POOL = 16 * MiB;
constexpr size_t WS_W_M1 = 17 * MiB;
constexpr size_t WS_W_M2 = 81 * MiB;
constexpr size_t WS_HC = 113 * MiB;
constexpr size_t WS_BUFA = 121 * MiB;
constexpr size_t WS_BUFP = 189 * MiB;
constexpr size_t WS_BUFZ = 360 * MiB;
constexpr size_t WS_TOKMAP = 432 * MiB;
constexpr size_t WS_HB = 435 * MiB;
constexpr size_t WS_END = 503 * MiB;
constexpr size_t WS_MODSDONE = 24 * KiB;
constexpr size_t WS_FAF = 28 * KiB + 512;
constexpr size_t WS_P5F = 28 * KiB, WS_P5C = 28 * KiB + 256;
constexpr size_t WS_CENSUS = 28 * KiB + 768;
constexpr size_t WS_XCDOF = 60 * KiB;
constexpr size_t WS_G1CNT = 61 * KiB;
constexpr size_t WS_XARR = 32 * KiB;
constexpr size_t WS_GCNT = 16 * KiB;
static_assert(WS_ROUTE + (size_t)T * 32 <= WS_WC, "small region");
static_assert((size_t)T * EIN * 2 <= WS_BUFZ - WS_BUFP && (size_t)MAXSLOT * 1024 * 2 <= WS_BUFZ - WS_BUFP, "BUFP");
static_assert((size_t)MAXSLOT * 512 * 2 <= WS_TOKMAP - WS_BUFZ && (size_t)T * 1024 * 2 <= WS_TOKMAP - WS_BUFZ, "BUFZ");
static_assert((size_t)16 * T * 4 <= WS_HB - WS_TOKMAP && (size_t)T * 1024 * 2 <= WS_END - WS_HB, "TOKMAP / HB");
static_assert((size_t)T * 1024 * 2 <= WS_BUFP - WS_BUFA, "BUFA");

constexpr int LDS_BYTES = 163840;
constexpr int LDS_GIDX = 147456;
constexpr int LDS_CTL = 146432;
constexpr int NWAVES = 8;

__device__ __forceinline__ unsigned f2bf(float f) { unsigned u = __builtin_bit_cast(unsigned, f); return (u + 0x7fffu + ((u >> 16) & 1u)) >> 16; }
__device__ __forceinline__ unsigned pk2(float lo, float hi) { return f2bf(lo) | (f2bf(hi) << 16); }
__device__ __forceinline__ float bflo(unsigned w) { return __builtin_bit_cast(float, w << 16); }
__device__ __forceinline__ float bfhi(unsigned w) { return __builtin_bit_cast(float, w & 0xffff0000u); }
__device__ __forceinline__ float wave_sum(float v) {
#pragma unroll
    for (int o = 1; o < 64; o <<= 1) v += __shfl_xor(v, o);
    return v;
}
__device__ __forceinline__ int ld_coh(const int* p) { return (int)__hip_atomic_load((const unsigned*)p, __ATOMIC_RELAXED, __HIP_MEMORY_SCOPE_AGENT); }
__device__ __forceinline__ float ld_cohf(const float* p) { return __builtin_bit_cast(float, __hip_atomic_load((const unsigned*)p, __ATOMIC_RELAXED, __HIP_MEMORY_SCOPE_AGENT)); }
#define LDS_WAIT() asm volatile("s_waitcnt lgkmcnt(0)" ::: "memory")

#define XB_TMO      128
#define XB_XCNT(j)  (256  + 64 * (j))
#define XB_XSUB(j)  (1280 + 64 * (j))
#define XB_XGEN(j)  (2304 + 64 * (j))
#define XB_TOP      3328
#define XB_TOPGEN   3392
#define XCD_BAR_WORDS 3456
#define XB_SPIN_CAP (1u << 18)
__device__ __forceinline__ unsigned xb_ld(unsigned* p)              { return __hip_atomic_load(p, __ATOMIC_RELAXED, __HIP_MEMORY_SCOPE_AGENT); }
__device__ __forceinline__ unsigned xb_add(unsigned* p, unsigned v) { return __hip_atomic_fetch_add(p, v, __ATOMIC_RELAXED, __HIP_MEMORY_SCOPE_AGENT); }
__device__ __forceinline__ unsigned xb_xcc_id() { return (unsigned)__builtin_amdgcn_s_getreg((3 << 11) | 20) & 0xFu; }
#define XB_SPIN(cond, bar) do { unsigned _sp = 0; while (cond) { __builtin_amdgcn_s_sleep(1); \
    if ((++_sp & 255u) == 0u) { if (xb_ld(&(bar)[XB_TMO])) break; if (_sp > XB_SPIN_CAP) { atomicAdd(&(bar)[XB_TMO], 1u); break; } } } } while (0)
struct XcdBarrier { unsigned* bar; unsigned x; volatile LAS unsigned* st; };
__device__ __forceinline__ XcdBarrier xcd_barrier_post(unsigned* bar, volatile LAS unsigned* st) {
    XcdBarrier b; b.bar = bar; b.x = xb_xcc_id(); b.st = st;
    if (threadIdx.x == 0) (void)xb_add(&bar[XB_XCNT(b.x)], 1u);
    return b;
}
__device__ __forceinline__ void xcd_barrier_complete(unsigned* bar, unsigned x, unsigned& nloc, unsigned& nx) {
    const unsigned G = gridDim.x * gridDim.y * gridDim.z;
    unsigned sum, cnt, mine, sp = 0u;
    for (;;) {
        sum = 0u; cnt = 0u; mine = 0u;
#pragma unroll
        for (unsigned j = 0; j < 16; ++j) { const unsigned c = xb_ld(&bar[XB_XCNT(j)]); sum += c; cnt += (c > 0u) ? 1u : 0u; mine = (j == x) ? c : mine; }
        if (sum == G) break;
        __builtin_amdgcn_s_sleep(1);
        if ((++sp & 255u) == 0u) { if (xb_ld(&bar[XB_TMO])) break; if (sp > XB_SPIN_CAP) { atomicAdd(&bar[XB_TMO], 1u); break; } }
    }
    nloc = mine > 0u ? mine : 1u; nx = cnt > 0u ? cnt : 1u;
}
__device__ __forceinline__ void xcd_barrier(const XcdBarrier& b) {
    asm volatile("s_waitcnt vmcnt(0)" ::: "memory");
    __syncthreads();
    if (threadIdx.x == 0) {
        unsigned* bar = b.bar;
        __builtin_amdgcn_s_waitcnt(0);
        unsigned nloc = b.st[0], nx = b.st[1];
        if (nloc == 0u) { xcd_barrier_complete(bar, b.x, nloc, nx); b.st[0] = nloc; b.st[1] = nx; }
        const unsigned old = xb_add(&bar[XB_XSUB(b.x)], 1u);
        const unsigned gen = old / nloc;
        if (old + 1u == (gen + 1u) * nloc) {
            __builtin_amdgcn_fence(__ATOMIC_RELEASE, "agent");
            asm volatile("s_waitcnt vmcnt(0)" ::: "memory");
            const unsigned og = xb_add(&bar[XB_TOP], 1u);
            const unsigned tg = og / nx;
            if (og + 1u == (tg + 1u) * nx) xb_add(&bar[XB_TOPGEN], 1u);
            else XB_SPIN(xb_ld(&bar[XB_TOPGEN]) == tg, bar);
            __builtin_amdgcn_fence(__ATOMIC_ACQUIRE, "agent");
            xb_add(&bar[XB_XGEN(b.x)], 1u);
            asm volatile("s_waitcnt vmcnt(0)" ::: "memory");
        } else {
            XB_SPIN(xb_ld(&bar[XB_XGEN(b.x)]) == gen, bar);
            __builtin_amdgcn_fence(__ATOMIC_ACQUIRE, "agent");
            asm volatile("s_waitcnt vmcnt(0)" ::: "memory");
        }
    }
    __syncthreads();
}

namespace pg8 {
constexpr int BM = 256, BK = 64, HALF = 128, HTB = HALF * BK * 2, STAGE_BYTES = 8 * HTB;
__host__ __device__ __forceinline__ int lds_byte(int r, int c) { const int st = (r >> 4) * 2 + (c >> 5), rr = r & 15, cc = c & 31, ob = rr * 64 + cc * 2; return st * 1024 + (ob ^ (((ob >> 9) & 1) << 5)); }
__host__ __device__ __forceinline__ void stage_rc(int b, int& R, int& C) { const int st = b / 1024, sb = b % 1024, swz = sb ^ (((sb >> 9) & 1) << 5); R = (st >> 1) * 16 + swz / 64; C = (st & 1) * 32 + (swz % 64) / 2; }
__host__ __device__ __forceinline__ int perm32(int rho) { const int n = rho >> 4, i = rho & 15; return 8 * (i >> 2) + 4 * n + (i & 3); }
struct Unit { int pm, pn, e; };
__device__ __forceinline__ unsigned cvt_pk_bf16(float lo, float hi) { unsigned r; asm volatile("v_cvt_pk_bf16_f32 %0, %1, %2" : "=v"(r) : "v"(lo), "v"(hi)); return r; }

typedef int v8i32 __attribute__((ext_vector_type(8)));
static_assert(FP8_G2_L0 && FP8_G2_L1, "the combine phases read the expert outputs as e4m3 bytes, which only the fp8 down GEMM writes");
typedef int v4i32 __attribute__((ext_vector_type(4)));
__device__ __forceinline__ v8i32 cat16(const bf16x8 lo, const bf16x8 hi) { return __builtin_shufflevector(__builtin_bit_cast(v4i32, lo), __builtin_bit_cast(v4i32, hi), 0, 1, 2, 3, 4, 5, 6, 7); }
template <class Epi, class Sched, bool FP8 = false>
__device__ __forceinline__ void gemm_phase(LAS unsigned char* lds, const int K, const Sched& S, const Epi& E) {
    const int tid = threadIdx.x, wid = __builtin_amdgcn_readfirstlane(tid >> 6), lane = tid & 63, wr = wid >> 2, wc = wid & 3, fr = lane & 15, fq = lane >> 4;
    const int nt = K / BK;
    int tidv = tid;
#define PG8_VB(i) ([&]() -> unsigned { int R_, C_; stage_rc(tidv * 16 + (i) * 8192, R_, C_); const int Rb_ = Epi::PERM ? ((R_ & ~31) + perm32(R_ & 31)) : R_; return (unsigned)(Rb_ * K + C_) * 2u; }())
#define PG8_VA(h, i) ([&]() -> unsigned { int R_, C_; stage_rc(tidv * 16 + (i) * 8192, R_, C_); return (unsigned)((128 * (h) + R_) * K + C_) * 2u; }())
    const size_t kstep = (size_t)(BK * 2);
    const size_t hstep = (size_t)HALF * K * 2;
    const unsigned ldsw = (unsigned)wid * 1024u;
#define aoff (lds_byte(wr * 64 + (tidv & 15), ((tidv >> 4) & 3) * 8))
#define boff (lds_byte(wc * 32 + (tidv & 15), ((tidv >> 4) & 3) * 8))
#define PG8_SA(b, h) (((b) * 2 + (h)) * HTB)
#define PG8_SB(b, h) ((4 + (b) * 2 + (h)) * HTB)
#define PG8_STAGEB(bufoff, gbase) do { _Pragma("unroll") for (int _i = 0; _i < 2; ++_i) \
        __builtin_amdgcn_global_load_lds((const unsigned*)((const char*)(gbase) + PG8_VB(_i)), (LAS unsigned*)(lds + (bufoff) + ldsw + _i * 8192), 16, 0, 0); } while (0)
#define PG8_STAGEA(bufoff, gbase, h, NEXT) do { _Pragma("unroll") for (int _i = 0; _i < 2; ++_i) { unsigned vo_; \
        if constexpr (Sched::GATHER) { int R_, C_; stage_rc(tidv * 16 + _i * 8192, R_, C_); const unsigned raw_ = gidx[((((NEXT) && usen) ? (gslot ^ 1u) : gslot) * 4u + (h) * 2 + _i) * 512u + tid]; vo_ = (raw_ * (unsigned)K + (unsigned)C_) * 2u; } \
        else vo_ = PG8_VA(h, _i); \
        __builtin_amdgcn_global_load_lds((const unsigned*)((const char*)(gbase) + vo_), (LAS unsigned*)(lds + (bufoff) + ldsw + _i * 8192), 16, 0, 0); } } while (0)
#define PG8_LDA(dst, b, h) do { _Pragma("unroll") for (int m = 0; m < 4; ++m) _Pragma("unroll") for (int k = 0; k < 2; ++k) dst[m][k] = *(const LAS bf16x8*)(lds + PG8_SA(b, h) + aoff + m * 2048 + k * 1024); } while (0)
#define PG8_LDB(dst, b, h) do { _Pragma("unroll") for (int n = 0; n < 2; ++n) _Pragma("unroll") for (int k = 0; k < 2; ++k) dst[n][k] = *(const LAS bf16x8*)(lds + PG8_SB(b, h) + boff + n * 2048 + k * 1024); } while (0)
#define PG8_MMA(ai, bj, At, Bt) do { __builtin_amdgcn_s_setprio(1); _Pragma("unroll") for (int m = 0; m < 4; ++m) _Pragma("unroll") for (int n = 0; n < 2; ++n) { \
        if constexpr (FP8) acc[ai][bj][m][n] = __builtin_amdgcn_mfma_scale_f32_16x16x128_f8f6f4(cat16(Bt[n][0], Bt[n][1]), cat16(At[m][0], At[m][1]), acc[ai][bj][m][n], 0, 0, 0, 0x7f7f7f7f, 0, 0x7f7f7f7f); \
        else { _Pragma("unroll") for (int k = 0; k < 2; ++k) acc[ai][bj][m][n] = __builtin_amdgcn_mfma_f32_16x16x32_bf16(Bt[n][k], At[m][k], acc[ai][bj][m][n], 0, 0, 0); } } \
        __builtin_amdgcn_s_setprio(0); } while (0)
#define PG8_WAIT_V(n) asm volatile("s_waitcnt vmcnt(" #n ")" ::: "memory")
#define PG8_WAIT_L(n) asm volatile("s_waitcnt lgkmcnt(" #n ")" ::: "memory")
#define PG8_BAR __builtin_amdgcn_s_barrier()
#define PG8_SCHED __builtin_amdgcn_sched_barrier(0)
#define PG8_ITER(A1, A2, A3, B2, B3) do { \
            PG8_LDB(B0, 0, 0); PG8_LDB(B1, 0, 1); PG8_SCHED; PG8_LDA(At, 0, 0); PG8_STAGEA(PG8_SA(1, 1), A1, 1, 0); \
            PG8_WAIT_V(8); PG8_WAIT_L(0); PG8_BAR; PG8_MMA(0, 0, At, B0); PG8_MMA(0, 1, At, B1); PG8_BAR; PG8_SCHED; \
            PG8_LDA(At, 0, 1); PG8_STAGEB(PG8_SB(0, 0), B2); PG8_STAGEB(PG8_SB(0, 1), (B2) + hstep); PG8_STAGEA(PG8_SA(0, 0), A2, 0, 1); \
            PG8_WAIT_V(8); PG8_WAIT_L(0); PG8_BAR; PG8_MMA(1, 0, At, B0); PG8_MMA(1, 1, At, B1); PG8_BAR; PG8_SCHED; \
            PG8_LDB(B0, 1, 0); PG8_LDB(B1, 1, 1); PG8_SCHED; PG8_LDA(At, 1, 0); PG8_STAGEA(PG8_SA(0, 1), A2, 1, 1); \
            PG8_WAIT_V(8); PG8_WAIT_L(0); PG8_BAR; PG8_MMA(0, 0, At, B0); PG8_MMA(0, 1, At, B1); PG8_BAR; PG8_SCHED; \
            PG8_LDA(At, 1, 1); PG8_STAGEB(PG8_SB(1, 0), B3); PG8_STAGEB(PG8_SB(1, 1), (B3) + hstep); PG8_STAGEA(PG8_SA(1, 0), A3, 0, 1); \
            PG8_WAIT_V(8); PG8_WAIT_L(0); PG8_BAR; PG8_MMA(1, 0, At, B0); PG8_MMA(1, 1, At, B1); PG8_BAR; PG8_SCHED; } while (0)
    Unit cur, nxt; int ui = 0;
    if (!S.next(0, cur)) return;
    f32x4 acc[2][2][4][2];
#pragma unroll
    for (int a = 0; a < 2; ++a)
#pragma unroll
        for (int b = 0; b < 2; ++b)
#pragma unroll
            for (int m = 0; m < 4; ++m)
#pragma unroll
                for (int n = 0; n < 2; ++n) acc[a][b][m][n] = (f32x4){0.f, 0.f, 0.f, 0.f};
    bf16x8 At[4][2], B0[2][2], B1[2][2];
    const LAS unsigned* gidx = (const LAS unsigned*)(lds + LDS_GIDX); unsigned gslot = 0u;
    if constexpr (Sched::GATHER) { S.idx_dma(cur, (LAS unsigned*)(lds + LDS_GIDX), tidv, wid); asm volatile("s_waitcnt vmcnt(0)" ::: "memory"); }
    const char* cA = S.a_base(cur); const char* cB = S.b_base(cur);
    constexpr bool usen = false;
    PG8_STAGEB(PG8_SB(0, 0), cB); PG8_STAGEB(PG8_SB(0, 1), cB + hstep); PG8_STAGEA(PG8_SA(0, 0), cA, 0, 0); PG8_STAGEA(PG8_SA(0, 1), cA, 1, 0);
    if (wr == 1) PG8_BAR;
    PG8_WAIT_V(2); PG8_BAR;
    PG8_STAGEB(PG8_SB(1, 0), cB + kstep); PG8_STAGEA(PG8_SA(1, 0), cA + kstep, 0, 0); PG8_STAGEB(PG8_SB(1, 1), cB + hstep + kstep);
    PG8_WAIT_V(6); PG8_BAR;
    for (;;) {
        const bool has_next = S.next(ui + 1, nxt);
        const char* nA = has_next ? S.a_base(nxt) : cA; const char* nB = has_next ? S.b_base(nxt) : cB;
#pragma unroll 1
        for (int t = 0; t < nt; t += 2) {
            const bool last = (t == nt - 2);
            const char* a1 = cA + (size_t)(t + 1) * kstep;
            const char* a2 = last ? nA : cA + (size_t)(t + 2) * kstep; const char* b2 = last ? nB : cB + (size_t)(t + 2) * kstep;
            tidv = tid; asm volatile("" : "+v"(tidv));
            if constexpr (Sched::GATHER) {
                if (t == nt - 4 && has_next) S.idx_dma(nxt, (LAS unsigned*)(lds + LDS_GIDX) + (gslot ^ 1u) * 2048u, tidv, wid);
            }
            const bool usen = last && has_next;
            PG8_ITER(a1, a2, a2 + kstep, b2, b2 + kstep);
        }
        if (wr == 0) PG8_BAR;
        E(acc, cur, wr, wc, fr, fq);
        if (!has_next) break;
#pragma unroll
        for (int a = 0; a < 2; ++a)
#pragma unroll
            for (int b = 0; b < 2; ++b)
#pragma unroll
                for (int m = 0; m < 4; ++m)
#pragma unroll
                    for (int n = 0; n < 2; ++n) acc[a][b][m][n] = (f32x4){0.f, 0.f, 0.f, 0.f};
        cur = nxt; cA = nA; cB = nB; ++ui;
        if constexpr (Sched::GATHER) gslot ^= 1u;
        if (wr == 1) PG8_BAR;
    }
    PG8_WAIT_V(0);
    PG8_BAR;
#undef PG8_ITER
#undef aoff
#undef boff
#undef PG8_SA
#undef PG8_SB
#undef PG8_STAGEA
#undef PG8_STAGEB
#undef PG8_VA
#undef PG8_VB
#undef PG8_LDA
#undef PG8_LDB
#undef PG8_MMA
#undef PG8_WAIT_V
#undef PG8_WAIT_L
#undef PG8_BAR
#undef PG8_SCHED
}

struct SchedDense {
    static constexpr bool GATHER = false;
    const char* A; const char* Bt; int K, nN, nMfull, pnx, nUnits, c, G;
    __device__ __forceinline__ bool next(int i, Unit& u) const {
        const int L = i * G + c; if (L >= nUnits) return false;
        const int full = nMfull * nN;
        if (L < full) { u.pm = L / nN; u.pn = L - u.pm * nN; } else { u.pm = nMfull + (L - full); u.pn = pnx; }
        u.e = 0; return true;
    }
    __device__ __forceinline__ const char* a_base(const Unit& u) const { return A + (size_t)u.pm * 256 * K * 2; }
    __device__ __forceinline__ const char* b_base(const Unit& u) const { return Bt + (size_t)u.pn * 256 * K * 2; }
};
struct SchedSplit {
    static constexpr bool GATHER = false;
    const char* A; const char* Bt; int K, base, stride, n;
    __device__ __forceinline__ bool next(int i, Unit& u) const {
        if (i >= n) return false;
        const int L = base + i * stride; u.pm = L >> 2; u.pn = L & 3; u.e = 0; return true;
    }
    __device__ __forceinline__ const char* a_base(const Unit& u) const { return A + (size_t)u.pm * 256 * K * 2; }
    __device__ __forceinline__ const char* b_base(const Unit& u) const { return Bt + (size_t)u.pn * 256 * K * 2; }
};
template <bool GATHER_> struct SchedMoe {
    static constexpr bool GATHER = GATHER_, gather = GATHER_;
    const char* A; const char* W; const int* tokmap; const LAS int* tb; const LAS int* cn; int K; size_t wstride; int nUnits, c, G;
    __device__ __forceinline__ bool next(int i, Unit& u) const {
        const int L = i * G + c; if (L >= nUnits) return false;
        u.pm = L >> 2; u.pn = L & 3; int e = 0;
#pragma unroll
        for (int q = 1; q < 16; ++q) if (u.pm >= __builtin_amdgcn_readfirstlane(tb[q])) e = q;
        u.e = __builtin_amdgcn_readfirstlane(e); return true;
    }
    __device__ __forceinline__ const char* a_base(const Unit& u) const { return gather ? A : A + (size_t)u.pm * 256 * K * 2; }
    __device__ __forceinline__ const char* b_base(const Unit& u) const { return W + (size_t)u.e * wstride + (size_t)u.pn * 256 * K * 2; }
    __device__ __forceinline__ void idx_dma(const Unit& u, LAS unsigned* slot, int tidv, int wid) const {
        const int p0 = (u.pm - __builtin_amdgcn_readfirstlane(tb[u.e])) * 256, last = __builtin_amdgcn_readfirstlane(cn[u.e]) - 1; const int* tm = tokmap + (size_t)u.e * T;
#pragma unroll
        for (int h = 0; h < 2; ++h)
#pragma unroll
            for (int i = 0; i < 2; ++i) { int R_, C_; stage_rc(tidv * 16 + i * 8192, R_, C_); int pos = p0 + 128 * h + R_; pos = pos < last ? pos : last;
                __builtin_amdgcn_global_load_lds((const unsigned*)(tm + pos), slot + (h * 2 + i) * 512 + wid * 64, 4, 0, 0); }
    }
};

struct EpiStore {
    static constexpr bool PERM = true;
    bf16* O; int ldc;
    __device__ __forceinline__ void operator()(const f32x4 (&acc)[2][2][4][2], const Unit& u, int wr, int wc, int fr, int fq) const {
        const int row0 = u.pm * BM + wr * 64 + fr, col0 = u.pn * BM + wc * 32 + 8 * fq;
#pragma unroll
        for (int ai = 0; ai < 2; ++ai)
#pragma unroll
            for (int m = 0; m < 4; ++m) { bf16* rowp = O + (size_t)(row0 + ai * HALF + m * 16) * ldc + col0;
#pragma unroll
                for (int bj = 0; bj < 2; ++bj) { const f32x4 v0 = acc[ai][bj][m][0], v1 = acc[ai][bj][m][1];
                    u32x4 w; w.x = cvt_pk_bf16(v0[0], v0[1]); w.y = cvt_pk_bf16(v0[2], v0[3]); w.z = cvt_pk_bf16(v1[0], v1[1]); w.w = cvt_pk_bf16(v1[2], v1[3]);
                    *(u32x4*)(rowp + bj * HALF) = w; } }
    }
};
template <bool SRC_F32> struct EpiResid {
    static constexpr bool PERM = true;
    const float* srcL; const float* srcC; bf16* H; const float* gate;
    float ascale = 1.0f;
    __device__ __forceinline__ void operator()(const f32x4 (&acc)[2][2][4][2], const Unit& u, int wr, int wc, int fr, int fq) const {
        const float* g = gate + (u.pm < 128 ? (u.pm >> 4) : 8) * 6144;
        const float* src = (u.pm < 128) ? srcL + (size_t)u.pm * 256 * 1024 : srcC + (size_t)(u.pm - 128) * 256 * 1024;
        bf16* dst = H + (size_t)u.pm * 256 * 1024;
        int frv = fr; asm volatile("" : "+v"(frv));
        const int row0 = wr * 64 + frv, col0 = u.pn * BM + wc * 32 + 8 * fq;
#pragma unroll
        for (int bj = 0; bj < 2; ++bj) {
            const f32x4 gv0 = *(const f32x4*)(g + col0 + bj * HALF) * ascale, gv1 = *(const f32x4*)(g + col0 + bj * HALF + 4) * ascale;
#pragma unroll
            for (int ai = 0; ai < 2; ++ai)
#pragma unroll
                for (int m = 0; m < 4; ++m) { const unsigned ro = (unsigned)(row0 + ai * HALF + m * 16) * 1024u + (unsigned)col0;
                    f32x4 s0, s1;
                    if constexpr (SRC_F32) { s0 = __builtin_nontemporal_load((const f32x4*)(src + ro + bj * HALF)); s1 = __builtin_nontemporal_load((const f32x4*)(src + ro + bj * HALF + 4)); }
                    else { const u32x4 hv = *(const u32x4*)(dst + ro + bj * HALF); s0 = (f32x4){bflo(hv.x), bfhi(hv.x), bflo(hv.y), bfhi(hv.y)}; s1 = (f32x4){bflo(hv.z), bfhi(hv.z), bflo(hv.w), bfhi(hv.w)}; }
                    const f32x4 v0 = s0 + gv0 * acc[ai][bj][m][0], v1 = s1 + gv1 * acc[ai][bj][m][1];
                    u32x4 w; w.x = cvt_pk_bf16(v0[0], v0[1]); w.y = cvt_pk_bf16(v0[2], v0[3]); w.z = cvt_pk_bf16(v1[0], v1[1]); w.w = cvt_pk_bf16(v1[2], v1[3]);
                    *(u32x4*)(dst + ro + bj * HALF) = w; }
        }
    }
};
__device__ __forceinline__ float silu_f(float x) { return x * __builtin_amdgcn_rcpf(1.0f + __expf(-x)); }
struct EpiSwiglu {
    static constexpr bool PERM = true;
    bf16* H;
    __device__ __forceinline__ void operator()(const f32x4 (&acc)[2][2][4][2], const Unit& u, int wr, int wc, int fr, int fq) const {
        const int row0 = u.pm * BM + wr * 64 + fr, col0 = u.pn * 128 + wc * 32 + 8 * fq;
#pragma unroll
        for (int ai = 0; ai < 2; ++ai)
#pragma unroll
            for (int m = 0; m < 4; ++m) { bf16* p = H + (size_t)(row0 + ai * HALF + m * 16) * 512 + col0;
                const f32x4 g0 = acc[ai][0][m][0], g1 = acc[ai][0][m][1], u0 = acc[ai][1][m][0], u1 = acc[ai][1][m][1];
                u32x4 w; w.x = cvt_pk_bf16(silu_f(g0[0]) * u0[0], silu_f(g0[1]) * u0[1]); w.y = cvt_pk_bf16(silu_f(g0[2]) * u0[2], silu_f(g0[3]) * u0[3]);
                w.z = cvt_pk_bf16(silu_f(g1[0]) * u1[0], silu_f(g1[1]) * u1[1]); w.w = cvt_pk_bf16(silu_f(g1[2]) * u1[2], silu_f(g1[3]) * u1[3]);
                *(u32x4*)p = w; }
    }
};
__device__ __forceinline__ unsigned pk4_fp8(float a, float b, float c, float d) { int p = __builtin_amdgcn_cvt_pk_fp8_f32(a, b, 0, false); p = __builtin_amdgcn_cvt_pk_fp8_f32(c, d, p, true); return (unsigned)p; }
constexpr float W1_SCALE = 32.0f, W2_SCALE = 16.0f, HID_SCALE = 4.0f;
struct EpiSwiglu8 {
    static constexpr bool PERM = true;
    unsigned char* H; float in_scale;
    __device__ __forceinline__ void operator()(const f32x4 (&acc)[2][2][4][2], const Unit& u, int wr, int wc, int fr, int fq) const {
        const int row0 = u.pm * BM + wr * 64 + fr, col0 = u.pn * 128 + wc * 32 + 8 * fq;
        const float IS = 1.0f / in_scale, OS = HID_SCALE / in_scale;
#pragma unroll
        for (int ai = 0; ai < 2; ++ai)
#pragma unroll
            for (int m = 0; m < 4; ++m) { unsigned char* p = H + (size_t)(row0 + ai * HALF + m * 16) * 512 + col0;
                const f32x4 g0 = acc[ai][0][m][0] * IS, g1 = acc[ai][0][m][1] * IS, u0 = acc[ai][1][m][0] * OS, u1 = acc[ai][1][m][1] * OS;
#define HC8(x) __builtin_fminf(__builtin_fmaxf((x), -448.0f), 448.0f)
                u32x2 w; w.x = pk4_fp8(HC8(silu_f(g0[0]) * u0[0]), HC8(silu_f(g0[1]) * u0[1]), HC8(silu_f(g0[2]) * u0[2]), HC8(silu_f(g0[3]) * u0[3]));
                w.y = pk4_fp8(HC8(silu_f(g1[0]) * u1[0]), HC8(silu_f(g1[1]) * u1[1]), HC8(silu_f(g1[2]) * u1[2]), HC8(silu_f(g1[3]) * u1[3]));
#undef HC8
                *(u32x2*)p = w; }
    }
};
constexpr float MIX1_SCALE = 4.0f;
constexpr float OS_SCALE = 16.0f;
struct EpiStoreF8 {
    static constexpr bool PERM = true;
    unsigned char* O; int ldc; float scale;
    __device__ __forceinline__ void operator()(const f32x4 (&acc)[2][2][4][2], const Unit& u, int wr, int wc, int fr, int fq) const {
        const int row0 = u.pm * BM + wr * 64 + fr, col0 = u.pn * BM + wc * 32 + 8 * fq;
#pragma unroll
        for (int ai = 0; ai < 2; ++ai)
#pragma unroll
            for (int m = 0; m < 4; ++m) { unsigned char* rowp = O + (size_t)(row0 + ai * HALF + m * 16) * ldc + col0;
#pragma unroll
                for (int bj = 0; bj < 2; ++bj) { const f32x4 v0 = acc[ai][bj][m][0] * scale, v1 = acc[ai][bj][m][1] * scale;
#define HC8(x) __builtin_fminf(__builtin_fmaxf((x), -448.0f), 448.0f)
                    u32x2 w; w.x = pk4_fp8(HC8(v0[0]), HC8(v0[1]), HC8(v0[2]), HC8(v0[3])); w.y = pk4_fp8(HC8(v1[0]), HC8(v1[1]), HC8(v1[2]), HC8(v1[3]));
#undef HC8
                    *(u32x2*)(rowp + bj * HALF) = w; } }
    }
};
struct EpiStoreS {
    static constexpr bool PERM = true;
    bf16* O; int ldc; float scale;
    __device__ __forceinline__ void operator()(const f32x4 (&acc)[2][2][4][2], const Unit& u, int wr, int wc, int fr, int fq) const {
        const int row0 = u.pm * BM + wr * 64 + fr, col0 = u.pn * BM + wc * 32 + 8 * fq;
#pragma unroll
        for (int ai = 0; ai < 2; ++ai)
#pragma unroll
            for (int m = 0; m < 4; ++m) { bf16* rowp = O + (size_t)(row0 + ai * HALF + m * 16) * ldc + col0;
#pragma unroll
                for (int bj = 0; bj < 2; ++bj) { const f32x4 v0 = acc[ai][bj][m][0] * scale, v1 = acc[ai][bj][m][1] * scale;
                    u32x4 w; w.x = cvt_pk_bf16(v0[0], v0[1]); w.y = cvt_pk_bf16(v0[2], v0[3]); w.z = cvt_pk_bf16(v1[0], v1[1]); w.w = cvt_pk_bf16(v1[2], v1[3]);
                    *(u32x4*)(rowp + bj * HALF) = w; } }
    }
};
struct EpiScaleRow {
    static constexpr bool PERM = true;
    bf16* O; const float* wrow;
    __device__ __forceinline__ void operator()(const f32x4 (&acc)[2][2][4][2], const Unit& u, int wr, int wc, int fr, int fq) const {
        const int row0 = u.pm * BM + wr * 64 + fr, col0 = u.pn * BM + wc * 32 + 8 * fq;
#pragma unroll
        for (int ai = 0; ai < 2; ++ai)
#pragma unroll
            for (int m = 0; m < 4; ++m) { const int row = row0 + ai * HALF + m * 16; const float s = wrow[row]; bf16* rowp = O + (size_t)row * 1024 + col0;
#pragma unroll
                for (int bj = 0; bj < 2; ++bj) { const f32x4 v0 = acc[ai][bj][m][0] * s, v1 = acc[ai][bj][m][1] * s;
                    u32x4 w; w.x = cvt_pk_bf16(v0[0], v0[1]); w.y = cvt_pk_bf16(v0[2], v0[3]); w.z = cvt_pk_bf16(v1[0], v1[1]); w.w = cvt_pk_bf16(v1[2], v1[3]);
                    *(u32x4*)(rowp + bj * HALF) = w; } }
    }
};
}

struct Args { const float* in[22]; float* out; unsigned char* ws; int ph_lo, ph_hi; };
enum { I_X = 0, I_C, I_CTX, I_CCTX, I_ADAW, I_ADAB, I_NMG, I_NFG, I_EWIN, I_ECONV, I_EWOUT, I_OWIN, I_OPOOLW, I_OPOOLS, I_OSINK, I_OWOUT, I_RW, I_RB, I_MG, I_MU, I_MD, I_FG };

struct Frame {
    LAS unsigned char* lds;
    int tid, lane, wave, vcu, G;
    unsigned char* ws; const float* const* in; float* out;
};
__device__ __forceinline__ bf16* h_row(const Frame& F, int t) { return (bf16*)(F.ws + WS_HB) + (size_t)t * D; }
__device__ __forceinline__ int mod_row(int t) { return t < TL ? (t >> 12) : 8; }

struct TItem { const float* src; bf16* dst; int ldw, ldd; float f8scale; };
__device__ __forceinline__ void titem_load(const TItem& t, f32x4 (&r)[8], int lane) {
#pragma unroll
    for (int i = 0; i < 8; ++i) r[i] = __builtin_nontemporal_load((const f32x4*)(t.src + (size_t)((lane >> 3) + 8 * i) * t.ldw + 4 * (lane & 7)));
}
__device__ __forceinline__ void titem_process(const TItem& t, const f32x4 (&r)[8], LAS float* scr, int lane) {
#pragma unroll
    for (int i = 0; i < 8; ++i) { LAS float* d = scr + ((lane >> 3) + 8 * i) * 33 + 4 * (lane & 7); d[0] = r[i].x; d[1] = r[i].y; d[2] = r[i].z; d[3] = r[i].w; }
    LDS_WAIT(); asm volatile("" ::: "memory");
    const int c = lane & 7;
    if (t.f8scale != 0.0f) {
        const float sc = t.f8scale; unsigned char* d8 = (unsigned char*)t.dst;
#pragma unroll
        for (int j = 0; j < 4; ++j) { const int n = (lane >> 3) + 8 * j; const LAS float* s = scr + (8 * c) * 33 + n;
            u32x2 o; o.x = pg8::pk4_fp8(s[0 * 33] * sc, s[1 * 33] * sc, s[2 * 33] * sc, s[3 * 33] * sc); o.y = pg8::pk4_fp8(s[4 * 33] * sc, s[5 * 33] * sc, s[6 * 33] * sc, s[7 * 33] * sc);
            *(u32x2*)(d8 + (size_t)n * t.ldd + 8 * c) = o; }
    } else {
#pragma unroll
        for (int j = 0; j < 4; ++j) { const int n = (lane >> 3) + 8 * j; const LAS float* s = scr + (8 * c) * 33 + n;
            u32x4 o; o.x = pk2(s[0 * 33], s[1 * 33]); o.y = pk2(s[2 * 33], s[3 * 33]); o.z = pk2(s[4 * 33], s[5 * 33]); o.w = pk2(s[6 * 33], s[7 * 33]);
            *(u32x4*)(t.dst + (size_t)n * t.ldd + 8 * c) = o; }
    }
    LDS_WAIT(); asm volatile("" ::: "memory");
}
constexpr int L0T_N = 32;
constexpr int TS0 = 1024, TS1 = 512, TS2 = 384, TS3 = 512, TS4 = 0, TS5 = 4096, TS6 = 4096, TS7 = 4096, TNITEMS = TS0 + TS1 + TS2 + TS3 + TS4 + TS5 + TS6 + TS7;
__device__ __forceinline__ TItem titem_moe(const float* const* in, unsigned char* ws, int kind, int le, int rr) {
    TItem t; const int layer = le >> 4, e = le & 15; const bool f8 = (kind < 2) ? (layer ? (FP8_G1_L1 != 0) : (FP8_G1_L0 != 0)) : (layer ? (FP8_G2_L1 != 0) : (FP8_G2_L0 != 0));
    if (kind < 2) { const int kb = (rr >> 4) & 15, nb = rr & 15, n0 = nb * 32; const int drow = (n0 >> 7) * 256 + (n0 & 127) + kind * 128;
        t.src = in[kind ? I_MU : I_MG] + (size_t)le * 524288 + (size_t)(kb * 64) * 512 + n0; t.ldw = 512;
        unsigned char* base = ws + WS_W_M1 + (size_t)layer * 32 * MiB;
        if (f8) { t.dst = (bf16*)(base + (size_t)e * MiB + (size_t)drow * 1024 + kb * 64); t.ldd = 1024; t.f8scale = pg8::W1_SCALE; }
        else { t.dst = (bf16*)(base + (size_t)e * 2 * MiB) + (size_t)drow * 1024 + kb * 64; t.ldd = 1024; t.f8scale = 0.0f; } }
    else { const int kb = (rr >> 5) & 7, nb = rr & 31;
        t.src = in[I_MD] + (size_t)le * 524288 + (size_t)(kb * 64) * 1024 + nb * 32; t.ldw = 1024;
        unsigned char* base = ws + WS_W_M2 + (size_t)layer * 16 * MiB;
        if (f8) { t.dst = (bf16*)(base + (size_t)e * 512 * KiB + (size_t)(nb * 32) * 512 + kb * 64); t.ldd = 512; t.f8scale = pg8::W2_SCALE; }
        else { t.dst = (bf16*)(base + (size_t)e * MiB) + (size_t)(nb * 32) * 512 + kb * 64; t.ldd = 512; t.f8scale = 0.0f; } }
    return t;
}
__device__ __forceinline__ TItem titem_decode(const float* const* in, unsigned char* ws, int r) {
    TItem t;
    if (r < TS0) { const int kb = r / 64, nb = r % 64; t.src = in[I_EWIN] + (size_t)(kb * 64) * 2048 + nb * 32; t.ldw = 2048; t.dst = (bf16*)(ws + WS_W_EIN) + (size_t)(nb * 32) * 1024 + kb * 64; t.ldd = 1024; t.f8scale = 0.0f; return t; } r -= TS0;
    if (r < TS1) { const int kb = r / 32, nb = r % 32; t.src = in[I_EWOUT] + (size_t)(kb * 64) * 1024 + nb * 32; t.ldw = 1024; t.dst = (bf16*)(ws + WS_W_EOUT) + (size_t)(nb * 32) * 1024 + kb * 64; t.ldd = 1024; t.f8scale = 0.0f; return t; } r -= TS1;
    if (r < TS2) { const int kb = r / 24, nb = 16 + r % 24; t.src = in[I_OWIN] + (size_t)(kb * 64) * 1280 + nb * 32; t.ldw = 1280; if (FP8_IN1) { t.dst = (bf16*)(ws + WS_W_OIN + (size_t)(nb * 32) * 1024 + kb * 64); t.ldd = 1024; t.f8scale = pg8::W1_SCALE; } else { t.dst = (bf16*)(ws + WS_W_OIN) + (size_t)(nb * 32) * 1024 + kb * 64; t.ldd = 1024; t.f8scale = 0.0f; } return t; } r -= TS2;
    if (r < TS3) { const int kb = r / 32, nb = r % 32; t.src = in[I_OWOUT] + (size_t)(kb * 64) * 1024 + nb * 32; t.ldw = 1024; if (FP8_OUT1) { t.dst = (bf16*)(ws + WS_W_OOUT + (size_t)(nb * 32) * 1024 + kb * 64); t.ldd = 1024; t.f8scale = pg8::W1_SCALE; } else { t.dst = (bf16*)(ws + WS_W_OOUT) + (size_t)(nb * 32) * 1024 + kb * 64; t.ldd = 1024; t.f8scale = 0.0f; } return t; } r -= TS3;
    r += 192 * L0T_N;
    if (r < TS5 + TS6 + TS7) return titem_moe(in, ws, r / 4096, (r % 4096) >> 8, r % 256);
    return t;
}
constexpr int NL1 = 12288;
__device__ __forceinline__ TItem titem_l1(const float* const* in, unsigned char* ws, int r) { return titem_moe(in, ws, r / 4096, 16 + ((r % 4096) >> 8), r % 256); }
__device__ __forceinline__ TItem titem_lx(const float* const* in, unsigned char* ws, int layer, int r) { return titem_moe(in, ws, r / 4096, layer * 16 + ((r % 4096) >> 8), r % 256); }

constexpr size_t WS_CONVCTR = 20 * KiB;
__device__ __forceinline__ void convert_l1(Frame& F, int quota) {
    unsigned* ctr = (unsigned*)(F.ws + WS_CONVCTR);
    LAS float* scr = (LAS float*)(F.lds + F.wave * 17408);
    for (int ch = 0; ch < quota; ++ch) {
        const int c0 = __builtin_amdgcn_readfirstlane(F.lane == 0 ? (int)__hip_atomic_fetch_add(ctr, 4u, __ATOMIC_RELAXED, __HIP_MEMORY_SCOPE_AGENT) : 0);
        if (c0 >= NL1) break;
        f32x4 cur[8], nxt[8];
        TItem tc = titem_l1(F.in, F.ws, c0);
        titem_load(tc, nxt, F.lane);
#pragma unroll 1
        for (int i = 0; i < 4; ++i) {
#pragma unroll
            for (int j = 0; j < 8; ++j) cur[j] = nxt[j];
            const TItem tcur = tc;
            if (i < 3) { tc = titem_l1(F.in, F.ws, c0 + i + 1); titem_load(tc, nxt, F.lane); }
            titem_process(tcur, cur, scr, F.lane);
        }
    }
}
__device__ __forceinline__ void convert_l1_range(Frame& F, const int base, const int cnt, const int ctr_off, const int layer = 1) {
    LAS unsigned* ctr = (LAS unsigned*)(F.lds + LDS_CTL + ctr_off);
    LAS float* scr = (LAS float*)(F.lds + F.wave * 17408);
    f32x4 cur[8], nxt[8];
    int it = __builtin_amdgcn_readfirstlane(F.lane == 0 ? (int)atomicAdd((unsigned*)ctr, 1u) : 0);
    TItem tc = titem_lx(F.in, F.ws, layer, base + (it < cnt ? it : 0));
    if (it < cnt) titem_load(tc, nxt, F.lane);
    while (it < cnt) {
#pragma unroll
        for (int i = 0; i < 8; ++i) cur[i] = nxt[i];
        const TItem tcur = tc;
        const int itn = __builtin_amdgcn_readfirstlane(F.lane == 0 ? (int)atomicAdd((unsigned*)ctr, 1u) : 0);
        if (itn < cnt) { tc = titem_lx(F.in, F.ws, layer, base + itn); titem_load(tc, nxt, F.lane); }
        titem_process(tcur, cur, scr, F.lane);
        it = itn;
    }
}
constexpr int L1T_N = 64, L1A_N = 18;
static_assert(120 * L1T_N + 256 * L1A_N == NL1, "layer-1 conversion split");
__device__ __forceinline__ void tail_fill(Frame& F, int nUnits, int quota) {
    const int rounds = (nUnits + F.G - 1) / F.G;
    if ((rounds - 1) * F.G + F.vcu >= nUnits) convert_l1(F, quota);
}

template <bool F8 = false>
__device__ __forceinline__ void norm_mod_store(const f32x4 (&v)[4], const float* g, const float* shift, const float* scale, bf16* orow, int lane) {
    float s2 = 0.f;
#pragma unroll
    for (int j = 0; j < 4; ++j) s2 += (v[j].x * v[j].x + v[j].y * v[j].y) + (v[j].z * v[j].z + v[j].w * v[j].w);
    const float rstd = 1.0f / sqrtf(wave_sum(s2) * (1.0f / D) + EPS);
#pragma unroll
    for (int j = 0; j < 4; ++j) { const int c = 4 * lane + 256 * j;
        const f32x4 gg = *(const f32x4*)(g + c), sh = *(const f32x4*)(shift + c), sc = *(const f32x4*)(scale + c);
        const f32x4 y = v[j] * rstd * gg * (sc + 1.0f) + sh;
        if constexpr (F8) { *(unsigned*)((unsigned char*)orow + c) = pg8::pk4_fp8(__builtin_fminf(__builtin_fmaxf(y.x, -448.0f), 448.0f), __builtin_fminf(__builtin_fmaxf(y.y, -448.0f), 448.0f), __builtin_fminf(__builtin_fmaxf(y.z, -448.0f), 448.0f), __builtin_fminf(__builtin_fmaxf(y.w, -448.0f), 448.0f)); }
        else { u32x2 o; o.x = pk2(y.x, y.y); o.y = pk2(y.z, y.w);
        *(u32x2*)(orow + c) = o; } }
}

template <int NQ> __device__ __forceinline__ void p1_tokens(Frame& F, int t) {
    const float* mods = (const float*)(F.ws + WS_MODS);
    bf16* A = (bf16*)(F.ws + WS_BUFA);
    f32x4 v[NQ][4];
#pragma unroll
    for (int q = 0; q < NQ; ++q) { const int tq = t + q; const float* xr = tq < TL ? F.in[I_X] + (size_t)tq * D : F.in[I_CTX] + (size_t)(tq - TL) * D;
#pragma unroll
        for (int j = 0; j < 4; ++j) v[q][j] = __builtin_nontemporal_load((const f32x4*)(xr + 4 * F.lane + 256 * j)); }
    const float* m = mods + (size_t)mod_row(t) * 6144;
#pragma unroll
    for (int q = 0; q < NQ; ++q) norm_mod_store(v[q], F.in[I_NMG], m, m + 1024, A + (size_t)(t + q) * D, F.lane);
}
__device__ __forceinline__ void phase_mods(Frame& F) {
    const float* const* in = F.in;
    LAS float* S = (LAS float*)F.lds;
    LAS float* red = S + 9 * 1024;
    for (int i = F.tid; i < 9 * 1024; i += 512) { const float v = (i < 8192) ? in[I_C][i] : in[I_CCTX][i - 8192]; S[i] = v / (1.0f + expf(-v)); }
    __syncthreads();
    const int bx = blockIdx.x, layer = bx >> 7, col0 = (bx & 127) * 48;
    const int j = F.tid % 12, rg = F.tid / 12;
    if (rg < 42) {
        const float* W = in[I_ADAW] + (size_t)layer * 1024 * 6144 + col0 + 4 * j;
        f32x4 w[25];
#pragma unroll
        for (int i = 0; i < 25; ++i) { const int k = rg + 42 * i; w[i] = (k < 1024) ? __builtin_nontemporal_load((const f32x4*)(W + (size_t)k * 6144)) : (f32x4){0.f, 0.f, 0.f, 0.f}; }
        f32x4 acc[9];
#pragma unroll
        for (int r = 0; r < 9; ++r) acc[r] = (f32x4){0.f, 0.f, 0.f, 0.f};
#pragma unroll
        for (int i = 0; i < 25; ++i) { const int k = min(rg + 42 * i, 1023);
#pragma unroll
            for (int r = 0; r < 9; ++r) acc[r] += w[i] * S[r * 1024 + k]; }
#pragma unroll
        for (int r = 0; r < 9; ++r) *(LAS f32x4*)(red + (rg * 9 + r) * 48 + 4 * j) = acc[r];
    }
    __syncthreads();
    for (int i = F.tid; i < 432; i += 512) { const int r = i / 48, c = i % 48; float sum = in[I_ADAB][layer * 6144 + col0 + c];
        for (int g = 0; g < 42; ++g) sum += red[(g * 9 + r) * 48 + c];
        __hip_atomic_store((unsigned*)(F.ws + WS_MODS) + (layer * 9 + r) * 6144 + col0 + c, __builtin_bit_cast(unsigned, sum), __ATOMIC_RELAXED, __HIP_MEMORY_SCOPE_AGENT); }
    asm volatile("s_waitcnt vmcnt(0)" ::: "memory");
    __syncthreads();
    if (F.tid == 0) __hip_atomic_fetch_add((unsigned*)(F.ws + WS_MODSDONE), 1u, __ATOMIC_RELAXED, __HIP_MEMORY_SCOPE_AGENT);
}
__device__ __forceinline__ void mods_wait(Frame& F) {
    if (F.tid < 64) {
        unsigned* cnt = (unsigned*)(F.ws + WS_MODSDONE); unsigned spins = 0;
        while ((unsigned)__builtin_amdgcn_readfirstlane(__hip_atomic_load(cnt, __ATOMIC_RELAXED, __HIP_MEMORY_SCOPE_AGENT)) < (unsigned)F.G) {
            __builtin_amdgcn_s_sleep(2); if (++spins > (1u << 22)) break; }
        __builtin_amdgcn_fence(__ATOMIC_ACQUIRE, "agent");
        asm volatile("s_waitcnt vmcnt(0)" ::: "memory");
    }
    __syncthreads();
}

__device__ __forceinline__ void ctr_publish(Frame& F, size_t off, int slot, unsigned nx) {
    asm volatile("s_waitcnt vmcnt(0)" ::: "memory");
    __syncthreads();
    if (F.tid == 0) {
        unsigned* top = (unsigned*)(F.ws + off);
        if (nx == 0u) { __builtin_amdgcn_fence(__ATOMIC_RELEASE, "agent"); asm volatile("s_waitcnt vmcnt(0)" ::: "memory"); __hip_atomic_fetch_add(top, 1u, __ATOMIC_RELAXED, __HIP_MEMORY_SCOPE_AGENT); }
        else {
            unsigned* xw = (unsigned*)(F.ws + WS_XARR) + ((size_t)slot * 16 + xb_xcc_id()) * 64;
            const unsigned old = __hip_atomic_fetch_add(xw, 1u, __ATOMIC_RELAXED, __HIP_MEMORY_SCOPE_AGENT);
            if (old + 1u == nx) { __builtin_amdgcn_fence(__ATOMIC_RELEASE, "agent"); asm volatile("s_waitcnt vmcnt(0)" ::: "memory"); __hip_atomic_fetch_add(top, nx, __ATOMIC_RELAXED, __HIP_MEMORY_SCOPE_AGENT); }
        }
    }
}
__device__ __forceinline__ void ctr_wait(Frame& F, size_t off, unsigned need) {
    if (F.tid < 64) {
        unsigned* cnt = (unsigned*)(F.ws + off); unsigned spins = 0;
        while ((unsigned)__builtin_amdgcn_readfirstlane(__hip_atomic_load(cnt, __ATOMIC_RELAXED, __HIP_MEMORY_SCOPE_AGENT)) < need) {
            __builtin_amdgcn_s_sleep(2); if (++spins > (1u << 22)) break; }
        __builtin_amdgcn_fence(__ATOMIC_ACQUIRE, "agent");
        asm volatile("s_waitcnt vmcnt(0)" ::: "memory");
    }
    __syncthreads();
}

template <class P> __device__ __forceinline__ unsigned xcd_census(const Frame& F, P pred) {
    if (__builtin_amdgcn_readfirstlane(*(const LAS int*)(F.lds + LDS_CTL + 52)) == 0) return 0u;
    const unsigned myx = xb_xcc_id();
    unsigned c = 0;
#pragma unroll
    for (int k = 0; k < 4; ++k) { const int v = F.lane + 64 * k; const unsigned x = (unsigned)ld_coh((const int*)(F.ws + WS_XCDOF) + v);
        c += (unsigned)__builtin_popcountll(__builtin_amdgcn_ballot_w64(x == myx && pred(v))); }
    return c;
}

__device__ __forceinline__ void phase_prologue_a(Frame& F) {
    const float* const* in = F.in;
    unsigned char* ws = F.ws;
    LAS float* ldsf = (LAS float*)F.lds;
    phase_mods(F);
    __syncthreads();
    {
        const int gt = blockIdx.x * 512 + F.tid, NT = F.G * 512;
        float* rope = (float*)(ws + WS_ROPE);
        for (int i = gt; i < 1024; i += NT) { const int coord = i >> 4, q = i & 15; const float inv = powf(10000.0f, -(float)q / 16.0f); const float ang = (float)coord * inv;
            rope[i] = cosf(ang); rope[1024 + i] = sinf(ang); }
        bf16* WA = (bf16*)(ws + WS_WA);
        for (int i = gt; i < 128 * 128; i += NT) { const int m = i >> 7, k = i & 127, rp = m >> 6, j1 = m & 63, ri = k >> 6, n1 = k & 63;
            const float a = 2.0f * (float)((j1 * n1) & 63) / 64.0f; const float c = cospif(a), s = sinpif(a);
            const float v = (rp == 0) ? (ri == 0 ? c : s) : (ri == 0 ? -s : c); WA[i] = (bf16)f2bf(v); }
        bf16* WAC = (bf16*)(ws + WS_WAC);
        for (int i = gt; i < 32 * 32; i += NT) { const int m = i >> 5, k = i & 31, rp = m >> 4, j1 = m & 15, ri = k >> 4, n1 = k & 15;
            const float a = 2.0f * (float)((j1 * n1) & 15) / 16.0f; const float c = cospif(a), s = sinpif(a);
            const float v = (rp == 0) ? (ri == 0 ? c : s) : (ri == 0 ? -s : c); WAC[i] = (bf16)f2bf(v); }
        bf16* WC = (bf16*)(ws + WS_WC);
        for (int i = gt; i < 64 * 64 * 128; i += NT) { const int j1 = i >> 13, j2 = (i >> 7) & 63, k = i & 127, ri = k >> 6, n2 = k & 63;
            const float a = 2.0f * (float)((n2 * (j1 + 64 * j2)) & 4095) / 4096.0f; const float v = (ri == 0 ? cospif(a) : sinpif(a)) * (1.0f / 64.0f); WC[i] = (bf16)f2bf(v); }
        bf16* FD = (bf16*)(ws + WS_FD);
        for (int i = gt; i < 256 * 128; i += NT) { const int col = i >> 7, c = i & 127, ri = col >> 7, k2 = col & 127;
            const float a = 2.0f * (float)((c * k2) & 127) / 128.0f; const float v = (ri == 0 ? cospif(a) : -sinpif(a)) * 0.08838834764831845f; FD[i] = (bf16)f2bf(v); }
        bf16* WCC = (bf16*)(ws + WS_WCC);
        for (int i = gt; i < 16 * 16 * 32; i += NT) { const int j1 = i >> 9, j2 = (i >> 5) & 15, k = i & 31, ri = k >> 4, n2 = k & 15;
            const float a = 2.0f * (float)((n2 * (j1 + 16 * j2)) & 255) / 256.0f; const float v = (ri == 0 ? cospif(a) : sinpif(a)) * (1.0f / 16.0f); WCC[i] = (bf16)f2bf(v); }
    }
    LAS float* tw = (LAS float*)(F.lds + 139264);
    if (F.tid < 128) { const float a = 2.0f * (float)F.tid / 128.0f; tw[F.tid] = cospif(a); tw[128 + F.tid] = sinpif(a); }
    __syncthreads();
    LAS float* scr = (LAS float*)(F.lds + F.wave * 17408);
    const int gw = F.vcu * NWAVES + F.wave, NGW = F.G * NWAVES;
    const int fid = F.vcu * 2 + F.wave;
    if (F.wave < 2) { const int r = fid;
        const int g = r >> 7, db = (r >> 5) & 3, kb = r & 31, k0 = kb * 32, d0 = db * 32;
        const float* Wp = in[I_OWIN] + (size_t)k0 * 1280 + g * 128;
        { float tl[32][2];
#pragma unroll
          for (int rr = 0; rr < 32; ++rr) { tl[rr][0] = Wp[(size_t)rr * 1280 + F.lane]; tl[rr][1] = Wp[(size_t)rr * 1280 + 64 + F.lane]; }
#pragma unroll
          for (int rr = 0; rr < 32; ++rr) { scr[rr * 129 + F.lane] = tl[rr][0]; scr[rr * 129 + 64 + F.lane] = tl[rr][1]; } }
        LDS_WAIT(); asm volatile("" ::: "memory");
        const int k = F.lane & 31, oh = F.lane >> 5;
        const float* pw = in[I_OPOOLW] + (size_t)g * 16384 + d0 + 16 * oh;
        float acc[16];
#pragma unroll
        for (int t = 0; t < 16; ++t) acc[t] = 0.f;
        for (int c0 = 0; c0 < 128; c0 += 8) {
            f32x4 p[8][4];
#pragma unroll
            for (int cc = 0; cc < 8; ++cc)
#pragma unroll
                for (int j = 0; j < 4; ++j) p[cc][j] = *(const f32x4*)(pw + (c0 + cc) * 128 + 4 * j);
#pragma unroll
            for (int cc = 0; cc < 8; ++cc) { const float w = scr[k * 129 + c0 + cc];
#pragma unroll
                for (int j = 0; j < 4; ++j) { acc[4 * j] += w * p[cc][j].x; acc[4 * j + 1] += w * p[cc][j].y; acc[4 * j + 2] += w * p[cc][j].z; acc[4 * j + 3] += w * p[cc][j].w; } }
        }
        const float* psc = in[I_OPOOLS] + g * 128 + d0 + 16 * oh;
        if constexpr (FP8_IN1) { unsigned char* dst8 = ws + WS_W_OIN + (size_t)(g * 128 + d0 + 16 * oh) * 1024 + k0 + k;
#pragma unroll
            for (int t = 0; t < 16; ++t) { const float wv = acc[t] * psc[t] * pg8::W1_SCALE; dst8[(size_t)t * 1024] = (unsigned char)(__builtin_amdgcn_cvt_pk_fp8_f32(wv, wv, 0, false) & 0xff); } }
        else {
        bf16* dst = (bf16*)(ws + WS_W_OIN) + (size_t)(g * 128 + d0 + 16 * oh) * 1024 + k0 + k;
#pragma unroll
        for (int t = 0; t < 16; ++t) dst[(size_t)t * 1024] = (bf16)f2bf(acc[t] * psc[t]); }
        LDS_WAIT(); asm volatile("" ::: "memory");
    }
    {
        LAS unsigned* ctr = (LAS unsigned*)(F.lds + LDS_CTL + 32);
        constexpr int TP1 = TS0 + TS1 + TS2 + TS3 + (12288 - 192 * L0T_N), PER = (TP1 + 255) / 256;
        const int base = F.vcu * PER, lim = max(0, min(PER, TP1 - base));
        f32x4 cur[8], nxt[8];
        int it = __builtin_amdgcn_readfirstlane(F.lane == 0 ? (int)atomicAdd((unsigned*)ctr, 1u) : 0);
        TItem tc = titem_decode(in, ws, base + (it < lim ? it : 0));
        if (it < lim) titem_load(tc, nxt, F.lane);
        while (it < lim) {
#pragma unroll
            for (int i = 0; i < 8; ++i) cur[i] = nxt[i];
            const TItem tcur = tc;
            const int itn = __builtin_amdgcn_readfirstlane(F.lane == 0 ? (int)atomicAdd((unsigned*)ctr, 1u) : 0);
            if (itn < lim) { tc = titem_decode(in, ws, base + itn); titem_load(tc, nxt, F.lane); }
            titem_process(tcur, cur, scr, F.lane);
            it = itn;
        }
    }
    mods_wait(F);
    {
        LAS unsigned* ctr2 = (LAS unsigned*)(F.lds + LDS_CTL + 36);
        for (;;) {
            const int it = __builtin_amdgcn_readfirstlane(F.lane == 0 ? (int)atomicAdd((unsigned*)ctr2, 1u) : 0);
            if (it >= 40) break;
            if (it < 32) p1_tokens<4>(F, 4 * (32 * (int)blockIdx.x + it)); else p1_tokens<1>(F, TL + 8 * (int)blockIdx.x + (it - 32));
        }
    }
}

struct DftP { const bf16* dbase; size_t dstride; const bf16* W; bf16* obase; size_t ostride; };
template <int MODE> __device__ __forceinline__ DftP dft_params(const Frame& F, int u) {
    const bf16* P = (const bf16*)(F.ws + WS_BUFP); bf16* Z = (bf16*)(F.ws + WS_BUFZ); bf16* MIX = (bf16*)(F.ws + WS_BUFA);
    DftP p;
    if constexpr (MODE == 0) { const int chunk = u & 3, n2 = (u >> 2) & 63, b = u >> 8;
        p.dbase = P + (size_t)(b * 4096 + n2) * EIN + chunk * 128; p.dstride = (size_t)64 * EIN; p.W = (const bf16*)(F.ws + WS_WA);
        p.obase = Z + (size_t)((b * 64) * 64 + n2) * 1024 + chunk * 128; p.ostride = (size_t)64 * 1024; }
    if constexpr (MODE == 1) { const int chunk = u & 3, n2 = (u >> 2) & 15, b = u >> 6;
        p.dbase = P + (size_t)(TL + b * 256 + n2) * EIN + chunk * 128; p.dstride = (size_t)16 * EIN; p.W = (const bf16*)(F.ws + WS_WAC);
        p.obase = Z + (size_t)(TL + (b * 16) * 16 + n2) * 1024 + chunk * 128; p.ostride = (size_t)16 * 1024; }
    if constexpr (MODE == 2) { const int chunk = u & 3, j1 = (u >> 2) & 63, b = u >> 8;
        p.dbase = Z + (size_t)((b * 64 + j1) * 64) * 1024 + chunk * 128; p.dstride = (size_t)1024; p.W = (const bf16*)(F.ws + WS_WC) + (size_t)j1 * 64 * 128;
        p.obase = MIX + (size_t)(b * 4096 + j1) * D + chunk * 128; p.ostride = (size_t)64 * D; }
    if constexpr (MODE == 3) { const int chunk = u & 3, j1 = (u >> 2) & 15, b = u >> 6;
        p.dbase = Z + (size_t)(TL + (b * 16 + j1) * 16) * 1024 + chunk * 128; p.dstride = (size_t)1024; p.W = (const bf16*)(F.ws + WS_WCC) + (size_t)j1 * 16 * 32;
        p.obase = MIX + (size_t)(TL + b * 256 + j1) * D + chunk * 128; p.ostride = (size_t)16 * D; }
    return p;
}
template <int MODE, int KD, int MD, int J>
__device__ __forceinline__ void dft_units(Frame& F, int nunits) {
    constexpr int LD = KD + 8;
    constexpr int NP = (KD * 16 + 511) / 512;
    constexpr int GM = KD / 8 - 1;
    LAS bf16* DT = (LAS bf16*)F.lds;
    u32x4 pre[NP];
    int u = F.vcu;
    if (u < nunits) { const DftP p = dft_params<MODE>(F, u);
#pragma unroll
        for (int i = 0; i < NP; ++i) { const int pc = F.tid + 512 * i; if (pc < KD * 16) { const int k = pc >> 4, c8 = pc & 15, ri = k / (KD / 2), nn = k % (KD / 2);
            pre[i] = __builtin_nontemporal_load((const u32x4*)(p.dbase + (size_t)nn * p.dstride + ri * 512 + c8 * 8)); } } }
    const int a = F.lane & 15, q = F.lane >> 4;
    for (; u < nunits; u += F.G) {
        const DftP p = dft_params<MODE>(F, u);
#pragma unroll
        for (int i = 0; i < NP; ++i) { const int pc = F.tid + 512 * i; if (pc < KD * 16) { const int k = pc >> 4, c8 = pc & 15; const u32x4 v = pre[i];
            LAS bf16* d = DT + (c8 * 8) * LD + (k ^ ((c8 & GM) << 3));
            d[0 * LD] = (bf16)(v.x & 0xffff); d[1 * LD] = (bf16)(v.x >> 16); d[2 * LD] = (bf16)(v.y & 0xffff); d[3 * LD] = (bf16)(v.y >> 16);
            d[4 * LD] = (bf16)(v.z & 0xffff); d[5 * LD] = (bf16)(v.z >> 16); d[6 * LD] = (bf16)(v.w & 0xffff); d[7 * LD] = (bf16)(v.w >> 16); } }
        __syncthreads();
        if (u + F.G < nunits) { const DftP pn = dft_params<MODE>(F, u + F.G);
#pragma unroll
            for (int i = 0; i < NP; ++i) { const int pc = F.tid + 512 * i; if (pc < KD * 16) { const int k = pc >> 4, c8 = pc & 15, ri = k / (KD / 2), nn = k % (KD / 2);
                pre[i] = __builtin_nontemporal_load((const u32x4*)(pn.dbase + (size_t)nn * pn.dstride + ri * 512 + c8 * 8)); } } }
        for (int task = F.wave; task < (MD / 16) * 2; task += NWAVES) {
            const int mt = task >> 1, cht = task & 1;
            f32x4 acc[4];
#pragma unroll
            for (int ct = 0; ct < 4; ++ct) acc[ct] = (f32x4){0.f, 0.f, 0.f, 0.f};
#pragma unroll
            for (int ks = 0; ks < KD / 32; ++ks) {
                const bf16x8 bw = *(const bf16x8*)(p.W + (size_t)(mt * 16 + a) * KD + ks * 32 + 8 * q);
#pragma unroll
                for (int ct = 0; ct < 4; ++ct) {
                    const int ch = cht * 64 + 16 * (a >> 2) + 4 * ct + (a & 3);
                    const bf16x8 av = *(const LAS bf16x8*)(DT + ch * LD + ((ks * 32 + 8 * q) ^ (((ch >> 3) & GM) << 3)));
                    acc[ct] = __builtin_amdgcn_mfma_f32_16x16x32_bf16(av, bw, acc[ct], 0, 0, 0);
                }
            }
            const int m = mt * 16 + a, rm = m / J, j = m % J;
            bf16* o = p.obase + (size_t)j * p.ostride + rm * 512 + cht * 64 + 16 * q;
            u32x4 w0, w1;
            w0.x = pk2(acc[0][0], acc[0][1]); w0.y = pk2(acc[0][2], acc[0][3]); w0.z = pk2(acc[1][0], acc[1][1]); w0.w = pk2(acc[1][2], acc[1][3]);
            w1.x = pk2(acc[2][0], acc[2][1]); w1.y = pk2(acc[2][2], acc[2][3]); w1.z = pk2(acc[3][0], acc[3][1]); w1.w = pk2(acc[3][2], acc[3][3]);
            *(u32x4*)o = w0; *(u32x4*)(o + 8) = w1;
        }
        __syncthreads();
    }
}

template <int MODE, int NR>
__device__ __forceinline__ void dft_units_a(Frame& F, int nunits) {
    constexpr int KD = 2 * NR, MD = 2 * NR, J = NR, LD = KD + 8, GM = KD / 8 - 1, ULD = 136;
    constexpr int NP = (NR * 16 + 511) / 512;
    LAS bf16* FDl = (LAS bf16*)F.lds; LAS bf16* U = (LAS bf16*)(F.lds + 69632); LAS bf16* DT = (LAS bf16*)(F.lds + 69632 + 64 * ULD * 2);
    { const bf16* FD = (const bf16*)(F.ws + WS_FD);
      for (int p = F.tid; p < 256 * 16; p += 512) { const int r = p >> 4, c8 = p & 15; *(LAS u32x4*)(FDl + r * ULD + 8 * c8) = *(const u32x4*)(FD + r * 128 + 8 * c8); } }
    u32x4 pre[NP];
    int u = F.vcu;
    if (u < nunits) { const DftP p = dft_params<MODE>(F, u);
#pragma unroll
        for (int i = 0; i < NP; ++i) { const int pc = F.tid + 512 * i; if (pc < NR * 16) pre[i] = __builtin_nontemporal_load((const u32x4*)(p.dbase + (size_t)(pc >> 4) * p.dstride + (pc & 15) * 8)); } }
    const int a = F.lane & 15, q = F.lane >> 4;
    for (; u < nunits; u += F.G) {
        const DftP p = dft_params<MODE>(F, u);
#pragma unroll
        for (int i = 0; i < NP; ++i) { const int pc = F.tid + 512 * i; if (pc < NR * 16) *(LAS u32x4*)(U + (pc >> 4) * ULD + (pc & 15) * 8) = pre[i]; }
        __syncthreads();
        if (u + F.G < nunits) { const DftP pn = dft_params<MODE>(F, u + F.G);
#pragma unroll
            for (int i = 0; i < NP; ++i) { const int pc = F.tid + 512 * i; if (pc < NR * 16) pre[i] = __builtin_nontemporal_load((const u32x4*)(pn.dbase + (size_t)(pc >> 4) * pn.dstride + (pc & 15) * 8)); } }
        {
            f32x4 acc[NR / 16][2];
#pragma unroll
            for (int mt = 0; mt < NR / 16; ++mt) { acc[mt][0] = (f32x4){0.f, 0.f, 0.f, 0.f}; acc[mt][1] = (f32x4){0.f, 0.f, 0.f, 0.f}; }
#pragma unroll
            for (int ks = 0; ks < 4; ++ks) {
                const bf16x8 b0 = *(const LAS bf16x8*)(FDl + ((2 * F.wave) * 16 + a) * ULD + ks * 32 + 8 * q), b1 = *(const LAS bf16x8*)(FDl + ((2 * F.wave + 1) * 16 + a) * ULD + ks * 32 + 8 * q);
#pragma unroll
                for (int mt = 0; mt < NR / 16; ++mt) { const bf16x8 av = *(const LAS bf16x8*)(U + (mt * 16 + a) * ULD + ks * 32 + 8 * q);
                    acc[mt][0] = __builtin_amdgcn_mfma_f32_16x16x32_bf16(av, b0, acc[mt][0], 0, 0, 0); acc[mt][1] = __builtin_amdgcn_mfma_f32_16x16x32_bf16(av, b1, acc[mt][1], 0, 0, 0); }
            }
#pragma unroll
            for (int t = 0; t < 2; ++t) { const int col = (2 * F.wave + t) * 16 + a, ri = col >> 7, k2 = col & 127;
#pragma unroll
                for (int mt = 0; mt < NR / 16; ++mt) { const int k0 = ri * NR + 16 * mt + 4 * q;
                    u32x2 w; w.x = pk2(acc[mt][t][0], acc[mt][t][1]); w.y = pk2(acc[mt][t][2], acc[mt][t][3]);
                    *(LAS u32x2*)(DT + k2 * LD + (k0 ^ (((k2 >> 3) & GM) << 3))) = w; } }
        }
        __syncthreads();
        for (int task = F.wave; task < (MD / 16) * 2; task += NWAVES) {
            const int mt = task >> 1, cht = task & 1;
            f32x4 acc[4];
#pragma unroll
            for (int ct = 0; ct < 4; ++ct) acc[ct] = (f32x4){0.f, 0.f, 0.f, 0.f};
#pragma unroll
            for (int ks = 0; ks < KD / 32; ++ks) {
                const bf16x8 bw = *(const bf16x8*)(p.W + (size_t)(mt * 16 + a) * KD + ks * 32 + 8 * q);
#pragma unroll
                for (int ct = 0; ct < 4; ++ct) {
                    const int ch = cht * 64 + 16 * (a >> 2) + 4 * ct + (a & 3);
                    const bf16x8 av = *(const LAS bf16x8*)(DT + ch * LD + ((ks * 32 + 8 * q) ^ (((ch >> 3) & GM) << 3)));
                    acc[ct] = __builtin_amdgcn_mfma_f32_16x16x32_bf16(av, bw, acc[ct], 0, 0, 0);
                }
            }
            const int m = mt * 16 + a, rm = m / J, j = m % J;
            bf16* o = p.obase + (size_t)j * p.ostride + rm * 512 + cht * 64 + 16 * q;
            u32x4 w0, w1;
            w0.x = pk2(acc[0][0], acc[0][1]); w0.y = pk2(acc[0][2], acc[0][3]); w0.z = pk2(acc[1][0], acc[1][1]); w0.w = pk2(acc[1][2], acc[1][3]);
            w1.x = pk2(acc[2][0], acc[2][1]); w1.y = pk2(acc[2][2], acc[2][3]); w1.z = pk2(acc[3][0], acc[3][1]); w1.w = pk2(acc[3][2], acc[3][3]);
            *(u32x4*)o = w0; *(u32x4*)(o + 8) = w1;
        }
        __syncthreads();
    }
}

__device__ __forceinline__ void phase_fourier_a_conv(Frame& F) {
    const bf16* P = (const bf16*)(F.ws + WS_BUFP);
    dft_units_a<0, 64>(F, 2048);
    __syncthreads();
    dft_units_a<1, 16>(F, 512);
    ctr_publish(F, WS_FAF, 0, xcd_census(F, [](int) { return true; }));
    bf16* MIX = (bf16*)(F.ws + WS_BUFA);
    const float* cw = F.in[I_ECONV];
    float w0[8], w1[8], w2[8];
#pragma unroll
    for (int i = 0; i < 8; ++i) { w0[i] = cw[8 * F.lane + i]; w1[i] = cw[512 + 8 * F.lane + i]; w2[i] = cw[1024 + 8 * F.lane + i]; }
    const int gw = F.vcu * NWAVES + F.wave, NGW = F.G * NWAVES;
    auto conv_tokens = [&](int t, auto ntc) {
        constexpr int NT = decltype(ntc)::value;
        int pos, len; if (t < TL) { pos = t & 4095; len = 4096; } else { pos = (t - TL) & 255; len = 256; }
        const bf16* row = P + (size_t)t * EIN + 8 * F.lane;
        u32x4 gb[NT], gc[NT + 2], uc[NT + 2];
#pragma unroll
        for (int d = 0; d < NT + 2; ++d) { const int pp = pos + d - 1;
            if (pp >= 0 && pp < len) { gc[d] = *(const u32x4*)(row + (ptrdiff_t)(d - 1) * EIN + 1024); uc[d] = *(const u32x4*)(row + (ptrdiff_t)(d - 1) * EIN + 1536); }
            else { gc[d] = (u32x4){0u, 0u, 0u, 0u}; uc[d] = (u32x4){0u, 0u, 0u, 0u}; } }
#pragma unroll
        for (int q = 0; q < NT; ++q) gb[q] = __builtin_nontemporal_load((const u32x4*)(row + (size_t)q * EIN + 512));
        float pl[NT + 2][8];
#pragma unroll
        for (int d = 0; d < NT + 2; ++d)
#pragma unroll
            for (int i = 0; i < 4; ++i) { pl[d][2 * i] = bflo(gc[d][i]) * bflo(uc[d][i]); pl[d][2 * i + 1] = bfhi(gc[d][i]) * bfhi(uc[d][i]); }
#pragma unroll
        for (int q = 0; q < NT; ++q) {
            float y[8];
#pragma unroll
            for (int i = 0; i < 4; ++i) {
                y[2 * i] = bflo(gb[q][i]) * (w0[2 * i] * pl[q][2 * i] + w1[2 * i] * pl[q + 1][2 * i] + w2[2 * i] * pl[q + 2][2 * i]);
                y[2 * i + 1] = bfhi(gb[q][i]) * (w0[2 * i + 1] * pl[q][2 * i + 1] + w1[2 * i + 1] * pl[q + 1][2 * i + 1] + w2[2 * i + 1] * pl[q + 2][2 * i + 1]);
            }
            u32x4 o; o.x = pk2(y[0], y[1]); o.y = pk2(y[2], y[3]); o.z = pk2(y[4], y[5]); o.w = pk2(y[6], y[7]);
            *(u32x4*)(MIX + (size_t)(t + q) * D + 512 + 8 * F.lane) = o;
        }
    };
    for (int t = 4 * gw; t < TL; t += 4 * NGW) conv_tokens(t, std::integral_constant<int, 4>{});
    for (int t = TL + gw; t < T; t += NGW) conv_tokens(t, std::integral_constant<int, 1>{});
}

__device__ __forceinline__ void phase_fourier_c(Frame& F) {
    ctr_wait(F, WS_FAF, (unsigned)F.G);
    dft_units<2, 128, 64, 64>(F, 2048);
    dft_units<3, 32, 16, 16>(F, 512);
}

constexpr int RW_LD = 1032;
template <bool SPLIT>
__device__ __forceinline__ void phase_route(Frame& F, int layer, int ntok) {
    LAS bf16* rwh = (LAS bf16*)F.lds;
    LAS bf16* rwl = (LAS bf16*)(F.lds + 33024);
    LAS unsigned* cnt = (LAS unsigned*)(F.lds + 66048);
    LAS int* gb = (LAS int*)(F.lds + 66048 + 128);
    LAS float* lgs = (LAS float*)(F.lds + 66048 + 256) + F.wave * 256;
    LAS int* tinfo = (LAS int*)(F.lds + 66048 + 256 + 8192);
    LAS float* GS = (LAS float*)(F.lds + 81920);
    LAS float* SH = GS + 2048;
    const float* RW = F.in[I_RW];
    int tA, nA, tB, nB;
    if constexpr (SPLIT) {
        const int xs = F.vcu >> 5, rs = F.vcu & 31;
        if (rs >= 28) return;
        const int j = 28 * xs + rs;
        tA = 128 * j; nA = 128; tB = 28672 + 32 * j; nB = (j < 192) ? 32 : 0;
    } else { const int per_ = ntok / F.G; tA = blockIdx.x * per_; nA = per_; tB = 0; nB = 0; }
    const int r0 = mod_row(tA), mr1 = SPLIT ? mod_row(tB) : min(r0 + 1, 8);
    const float* mods = (const float*)(F.ws + WS_MODS) + (size_t)layer * 9 * 6144;
    const float* g = F.in[I_NFG] + layer * 1024;
    for (int i = F.tid; i < 16384; i += 512) { const int k = i >> 4, e = i & 15; const float w = RW[i]; const unsigned hi = f2bf(w); const float wl = w - __builtin_bit_cast(float, hi << 16);
        rwh[e * RW_LD + k] = (bf16)hi; rwl[e * RW_LD + k] = (bf16)f2bf(wl); }
    for (int i = F.tid; i < 2048; i += 512) { const int sl = i >> 10, c = i & 1023; const int rr = sl ? mr1 : r0; const float* m = mods + (size_t)rr * 6144;
        GS[i] = g[c] * (m[4 * 1024 + c] + 1.0f); SH[i] = m[3 * 1024 + c]; }
    if (F.tid < 16) cnt[F.tid] = 0u;
    __syncthreads();
    bf16* FB = (bf16*)(F.ws + WS_BUFA);
    const bool f8 = layer ? (FP8_G1_L1 != 0) : (FP8_G1_L0 != 0);
    int* route = (int*)(F.ws + WS_ROUTE);
    const int tk = F.lane & 15, kg = F.lane >> 4;
    for (int st = 0; st < 2; ++st) {
    const int t0 = st ? tB : tA, per = st ? nB : nA, li0 = st ? nA : 0;
    if (per == 0) break;
    if constexpr (SPLIT) { if (st == 0) ctr_wait(F, WS_P5F, 224u); else ctr_wait(F, WS_P5C, 32u); }
    for (int g0 = 16 * F.wave; g0 < per; g0 += 16 * NWAVES) {
        const int nv = min(16, per - g0);
        const int tq = t0 + g0 + (tk < nv ? tk : 0);
        const bf16* hr = h_row(F, tq) + 8 * kg;
        float s2 = 0.f;
        {
            u32x4 raw[32];
#pragma unroll
            for (int ks = 0; ks < 32; ++ks) raw[ks] = *(const u32x4*)(hr + 32 * ks);
#pragma unroll
            for (int ks = 0; ks < 32; ++ks)
#pragma unroll
                for (int i = 0; i < 4; ++i) { const float a = bflo(raw[ks][i]), b2 = bfhi(raw[ks][i]); s2 += a * a + b2 * b2; }
        }
        s2 += __shfl_xor(s2, 16); s2 += __shfl_xor(s2, 32);
        const float rstd = 1.0f / sqrtf(s2 * (1.0f / D) + EPS);
        const int sl = (mod_row(tq) != r0) ? 1024 : 0;
        const LAS float* gsp = GS + sl + 8 * kg; const LAS float* shp = SH + sl + 8 * kg;
        unsigned char* fb8 = (unsigned char*)FB + (size_t)tq * D + 8 * kg;
        bf16* fb16 = FB + (size_t)tq * D + 8 * kg;
        f32x4 acc = (f32x4){0.f, 0.f, 0.f, 0.f};
        u32x4 nx[8];
#pragma unroll
        for (int j = 0; j < 8; ++j) nx[j] = *(const u32x4*)(hr + 32 * j);
#pragma unroll 1
        for (int k4 = 0; k4 < 4; ++k4) {
            u32x4 cu[8];
#pragma unroll
            for (int j = 0; j < 8; ++j) cu[j] = nx[j];
            if (k4 < 3) {
#pragma unroll
                for (int j = 0; j < 8; ++j) nx[j] = *(const u32x4*)(hr + 32 * (8 * k4 + 8 + j)); }
#pragma unroll
            for (int j = 0; j < 8; ++j) {
                const int ks = 8 * k4 + j;
                const f32x4 g0v = *(const LAS f32x4*)(gsp + 32 * ks), g1v = *(const LAS f32x4*)(gsp + 32 * ks + 4), s0v = *(const LAS f32x4*)(shp + 32 * ks), s1v = *(const LAS f32x4*)(shp + 32 * ks + 4);
                float f[8];
                f[0] = bflo(cu[j].x) * rstd * g0v.x + s0v.x; f[1] = bfhi(cu[j].x) * rstd * g0v.y + s0v.y; f[2] = bflo(cu[j].y) * rstd * g0v.z + s0v.z; f[3] = bfhi(cu[j].y) * rstd * g0v.w + s0v.w;
                f[4] = bflo(cu[j].z) * rstd * g1v.x + s1v.x; f[5] = bfhi(cu[j].z) * rstd * g1v.y + s1v.y; f[6] = bflo(cu[j].w) * rstd * g1v.z + s1v.z; f[7] = bfhi(cu[j].w) * rstd * g1v.w + s1v.w;
                u32x4 hi, lo;
#pragma unroll
                for (int i = 0; i < 4; ++i) { const unsigned h0 = f2bf(f[2 * i]), h1 = f2bf(f[2 * i + 1]); hi[i] = h0 | (h1 << 16);
                    lo[i] = pk2(f[2 * i] - __builtin_bit_cast(float, h0 << 16), f[2 * i + 1] - __builtin_bit_cast(float, h1 << 16)); }
                if (tk < nv) {
                    if (f8) { u32x2 o; o.x = pg8::pk4_fp8(f[0], f[1], f[2], f[3]); o.y = pg8::pk4_fp8(f[4], f[5], f[6], f[7]); *(u32x2*)(fb8 + 32 * ks) = o; }
                    else *(u32x4*)(fb16 + 32 * ks) = hi;
                }
                const bf16x8 bh = *(const LAS bf16x8*)(rwh + tk * RW_LD + 32 * ks + 8 * kg), bl = *(const LAS bf16x8*)(rwl + tk * RW_LD + 32 * ks + 8 * kg);
                const bf16x8 ah = __builtin_bit_cast(bf16x8, hi), al = __builtin_bit_cast(bf16x8, lo);
                acc = __builtin_amdgcn_mfma_f32_16x16x32_bf16(ah, bh, acc, 0, 0, 0);
                acc = __builtin_amdgcn_mfma_f32_16x16x32_bf16(ah, bl, acc, 0, 0, 0);
                acc = __builtin_amdgcn_mfma_f32_16x16x32_bf16(al, bh, acc, 0, 0, 0);
            }
        }
#pragma unroll
        for (int j = 0; j < 4; ++j) lgs[(4 * kg + j) * 16 + tk] = acc[j];
        LDS_WAIT(); asm volatile("" ::: "memory");
        if (F.lane < nv) {
            const int tqq = t0 + g0 + F.lane;
            float aff[16], sel[16];
#pragma unroll
            for (int e4 = 0; e4 < 4; ++e4) { const f32x4 l4 = *(const LAS f32x4*)(lgs + F.lane * 16 + 4 * e4); const f32x4 b4 = *(const f32x4*)(F.in[I_RB] + 4 * e4);
                aff[4 * e4] = 1.0f / (1.0f + expf(-l4.x)); aff[4 * e4 + 1] = 1.0f / (1.0f + expf(-l4.y)); aff[4 * e4 + 2] = 1.0f / (1.0f + expf(-l4.z)); aff[4 * e4 + 3] = 1.0f / (1.0f + expf(-l4.w));
                sel[4 * e4] = aff[4 * e4] + b4.x; sel[4 * e4 + 1] = aff[4 * e4 + 1] + b4.y; sel[4 * e4 + 2] = aff[4 * e4 + 2] + b4.z; sel[4 * e4 + 3] = aff[4 * e4 + 3] + b4.w; }
            int best = 0; float bs = -1e30f;
#pragma unroll
            for (int gq = 0; gq < 4; ++gq) { const float a = sel[4 * gq], b = sel[4 * gq + 1], c = sel[4 * gq + 2], d = sel[4 * gq + 3];
                const float s = fmaxf(fmaxf(fmaxf(a + b, a + c), fmaxf(a + d, b + c)), fmaxf(b + d, c + d));
                if (s > bs) { bs = s; best = gq; } }
            float sv[4], av[4];
#pragma unroll
            for (int i = 0; i < 4; ++i) { sv[i] = sel[i]; av[i] = aff[i]; }
#pragma unroll
            for (int gq = 1; gq < 4; ++gq) if (best == gq) {
#pragma unroll
                for (int i = 0; i < 4; ++i) { sv[i] = sel[4 * gq + i]; av[i] = aff[4 * gq + i]; } }
            int i1 = 0; float s1 = sv[0], a1 = av[0];
#pragma unroll
            for (int i = 1; i < 4; ++i) if (sv[i] > s1) { s1 = sv[i]; a1 = av[i]; i1 = i; }
            int i2 = -1; float s2v = -1e30f, a2 = 0.f;
#pragma unroll
            for (int i = 0; i < 4; ++i) if (i != i1 && sv[i] > s2v) { s2v = sv[i]; a2 = av[i]; i2 = i; }
            const int e1 = 4 * best + i1, e2 = 4 * best + i2;
            const float wsum = a1 + a2, w1 = a1 / wsum, w2 = a2 / wsum;
            const unsigned r1 = atomicAdd((unsigned*)(cnt + e1), 1u), r2 = atomicAdd((unsigned*)(cnt + e2), 1u);
            int* ro = route + (size_t)tqq * 8;
            ro[0] = e1; ro[1] = e2; ro[4] = __builtin_bit_cast(int, w1); ro[5] = __builtin_bit_cast(int, w2);
            const int li = li0 + g0 + F.lane;
            tinfo[4 * li + 0] = e1; tinfo[4 * li + 1] = e2; tinfo[4 * li + 2] = (int)r1; tinfo[4 * li + 3] = (int)r2;
        }
        LDS_WAIT(); asm volatile("" ::: "memory");
    }
    }
    __syncthreads();
    if (F.tid < 16) gb[F.tid] = (int)__hip_atomic_fetch_add((unsigned*)(F.ws + WS_GCNT) + layer * 16 + F.tid, cnt[F.tid], __ATOMIC_RELAXED, __HIP_MEMORY_SCOPE_AGENT);
    __syncthreads();
    int* tokmap = (int*)(F.ws + WS_TOKMAP);
    for (int i = F.tid; i < nA + nB; i += 512) {
        const int tok = (i < nA) ? tA + i : tB + (i - nA);
        const int e1 = tinfo[4 * i], e2 = tinfo[4 * i + 1], p1 = gb[e1] + tinfo[4 * i + 2], p2 = gb[e2] + tinfo[4 * i + 3];
        tokmap[(size_t)e1 * T + p1] = tok; tokmap[(size_t)e2 * T + p2] = tok;
        int* ro = route + (size_t)tok * 8; ro[2] = p1; ro[3] = p2;
    }
}

__device__ __forceinline__ int moe_tables(Frame& F, int layer) {
    LAS int* tb = (LAS int*)(F.lds + LDS_CTL + 64); LAS int* cn = (LAS int*)(F.lds + LDS_CTL + 192);
    __syncthreads();
    if (F.tid < 16) cn[F.tid] = ld_coh((const int*)(F.ws + WS_GCNT) + layer * 16 + F.tid);
    __syncthreads();
    if (F.tid == 0) { int b = 0; for (int e = 0; e < 16; ++e) { tb[e] = b; b += (cn[e] + 255) >> 8; } tb[16] = b; }
    __syncthreads();
    return __builtin_amdgcn_readfirstlane(tb[16]);
}

typedef float f32x2 __attribute__((ext_vector_type(2)));
template <int NQ> __device__ __forceinline__ void combine_tokens(Frame& F, int layer, int t) {
    const float* mods = (const float*)(F.ws + WS_MODS);
    const unsigned char* OS = (const unsigned char*)(F.ws + WS_BUFP);
    const int* route = (const int*)(F.ws + WS_ROUTE);
    const LAS int* tb = (const LAS int*)(F.lds + LDS_CTL + 64);
    bf16* A = (bf16*)(F.ws + WS_BUFA);
    {
        int rc[NQ][4]; float w0[NQ], w1[NQ];
#pragma unroll
        for (int q = 0; q < NQ; ++q) { const int* ro = route + (size_t)(t + q) * 8;
#pragma unroll
            for (int i = 0; i < 4; ++i) rc[q][i] = ld_coh(ro + i);
            w0[q] = ld_cohf((const float*)(ro + 4)) * (1.0f / pg8::OS_SCALE); w1[q] = ld_cohf((const float*)(ro + 5)) * (1.0f / pg8::OS_SCALE); }
        f32x4 v[NQ][4]; unsigned oa[NQ][4], ob[NQ][4];
#pragma unroll
        for (int q = 0; q < NQ; ++q) { const bf16* hr = h_row(F, t + q);
            const size_t s0 = (size_t)(tb[rc[q][0]] * 256 + rc[q][2]) * D, s1 = (size_t)(tb[rc[q][1]] * 256 + rc[q][3]) * D;
#pragma unroll
            for (int j = 0; j < 4; ++j) { const int c = 4 * F.lane + 256 * j; { const u32x2 hv = *(const u32x2*)(hr + c); v[q][j] = (f32x4){bflo(hv.x), bfhi(hv.x), bflo(hv.y), bfhi(hv.y)}; } oa[q][j] = __builtin_nontemporal_load((const unsigned*)(OS + s0 + c)); ob[q][j] = __builtin_nontemporal_load((const unsigned*)(OS + s1 + c)); } }
        const int mr = mod_row(t);
        const float* m5 = mods + (size_t)(layer * 9 + mr) * 6144 + 5 * 1024;
#pragma unroll
        for (int j = 0; j < 4; ++j) { const f32x4 g5 = *(const f32x4*)(m5 + 4 * F.lane + 256 * j);
#pragma unroll
            for (int q = 0; q < NQ; ++q) { const f32x2 a0 = __builtin_amdgcn_cvt_pk_f32_fp8((int)oa[q][j], false), a1 = __builtin_amdgcn_cvt_pk_f32_fp8((int)oa[q][j], true), b0 = __builtin_amdgcn_cvt_pk_f32_fp8((int)ob[q][j], false), b1 = __builtin_amdgcn_cvt_pk_f32_fp8((int)ob[q][j], true);
                const f32x4 o = (f32x4){w0[q] * a0[0] + w1[q] * b0[0], w0[q] * a0[1] + w1[q] * b0[1], w0[q] * a1[0] + w1[q] * b1[0], w0[q] * a1[1] + w1[q] * b1[1]};
                v[q][j] = v[q][j] + g5 * o; } }
#pragma unroll
        for (int q = 0; q < NQ; ++q) {
            if (layer == 0) {
                bf16* hr = h_row(F, t + q);
#pragma unroll
                for (int j = 0; j < 4; ++j) { u32x2 o; o.x = pk2(v[q][j].x, v[q][j].y); o.y = pk2(v[q][j].z, v[q][j].w); *(u32x2*)(hr + 4 * F.lane + 256 * j) = o; }
                const float* m = mods + (size_t)(9 + mr) * 6144;
                if constexpr (FP8_IN1) norm_mod_store<true>(v[q], F.in[I_NMG] + 1024, m, m + 1024, (bf16*)((unsigned char*)A + (size_t)(t + q) * D), F.lane);
                else norm_mod_store(v[q], F.in[I_NMG] + 1024, m, m + 1024, A + (size_t)(t + q) * D, F.lane);
            } else {
                float s2 = 0.f;
#pragma unroll
                for (int j = 0; j < 4; ++j) s2 += (v[q][j].x * v[q][j].x + v[q][j].y * v[q][j].y) + (v[q][j].z * v[q][j].z + v[q][j].w * v[q][j].w);
                const float rstd = 1.0f / sqrtf(wave_sum(s2) * (1.0f / D) + EPS);
                float* orow = F.out + (size_t)(t + q) * D;
#pragma unroll
                for (int j = 0; j < 4; ++j) { const int c = 4 * F.lane + 256 * j; __builtin_nontemporal_store(v[q][j] * rstd * *(const f32x4*)(F.in[I_FG] + c), (f32x4*)(orow + c)); }
            }
        }
    }
}
__device__ __forceinline__ void phase_combine(Frame& F, int layer, int ntok) {
    const int gw = F.vcu * NWAVES + F.wave, NGW = F.G * NWAVES;
    if (layer == 0) { for (int t = 2 * gw; t < TL; t += 2 * NGW) combine_tokens<2>(F, 0, t); for (int t = TL + gw; t < ntok; t += NGW) combine_tokens<1>(F, 0, t); }
    else { for (int t = 4 * gw; t < TL; t += 4 * NGW) combine_tokens<4>(F, 1, t); }
}

constexpr int KV_LD = 72, VL_OFF = 384 * KV_LD * 2, ROPE_LDS = 131072;
typedef short v4i16_t __attribute__((ext_vector_type(4)));

__device__ __forceinline__ bf16x8 rope_pack(const u32x4 x1, const u32x4 x2, const LAS float* cs, const LAS float* sn, float scale, bool second) {
    const f32x4 c0 = *(const LAS f32x4*)cs, c1 = *(const LAS f32x4*)(cs + 4), s0 = *(const LAS f32x4*)sn, s1 = *(const LAS f32x4*)(sn + 4);
    float c[8] = {c0.x, c0.y, c0.z, c0.w, c1.x, c1.y, c1.z, c1.w}, s[8] = {s0.x, s0.y, s0.z, s0.w, s1.x, s1.y, s1.z, s1.w};
    float a[8], b[8];
#pragma unroll
    for (int i = 0; i < 4; ++i) { a[2 * i] = bflo(x1[i]); a[2 * i + 1] = bfhi(x1[i]); b[2 * i] = bflo(x2[i]); b[2 * i + 1] = bfhi(x2[i]); }
    float o[8];
#pragma unroll
    for (int i = 0; i < 8; ++i) o[i] = (second ? (b[i] * c[i] + a[i] * s[i]) : (a[i] * c[i] - b[i] * s[i])) * scale;
    u32x4 w; w.x = pk2(o[0], o[1]); w.y = pk2(o[2], o[3]); w.z = pk2(o[4], o[5]); w.w = pk2(o[6], o[7]);
    return __builtin_bit_cast(bf16x8, w);
}

struct AttnU { int b, qb, kvh; };
__device__ __forceinline__ AttnU attn_unit_of(int u) { AttnU r; r.kvh = u & 1; r.qb = (u >> 1) & 31; r.b = u >> 6; return r; }

__device__ __forceinline__ void attn_load_latk(Frame& F, const bf16* P1, AttnU u, u32x4 (&lk)[2][4]) {
    const u32x4 z = (u32x4){0u, 0u, 0u, 0u};
#pragma unroll
    for (int it = 0; it < 2; ++it) { const int task = F.tid + 512 * it, kidx = task >> 1, hh = task & 1, pos = u.qb * 128 - 128 + kidx;
        const bool ok = task < 768 && pos >= 0 && pos < NSEQ;
        const bf16* row = P1 + (size_t)(u.b * NSEQ + (ok ? pos : 0)) * OIN + 1024 + u.kvh * 64 + 8 * hh;
#pragma unroll
        for (int st = 0; st < 4; ++st) lk[it][st] = ok ? *(const u32x4*)(row + 16 * st) : z; }
}
__device__ __forceinline__ void attn_load_latv(Frame& F, const bf16* P1, AttnU u, u32x4 (&lv)[6]) {
    const u32x4 z = (u32x4){0u, 0u, 0u, 0u};
#pragma unroll
    for (int it = 0; it < 6; ++it) { const int task = F.tid + 512 * it, kidx = task >> 3, c8 = task & 7, pos = u.qb * 128 - 128 + kidx;
        const bool ok = pos >= 0 && pos < NSEQ;
        lv[it] = ok ? *(const u32x4*)(P1 + (size_t)(u.b * NSEQ + (ok ? pos : 0)) * OIN + 1152 + u.kvh * 64 + 8 * c8) : z; }
}
__device__ __forceinline__ void attn_write_lat(Frame& F, AttnU u, const u32x4 (&lk)[2][4], const u32x4 (&lv)[6]) {
    LAS bf16* KL = (LAS bf16*)F.lds; LAS bf16* VL = (LAS bf16*)(F.lds + VL_OFF); const LAS float* rope = (const LAS float*)(F.lds + ROPE_LDS);
#pragma unroll
    for (int it = 0; it < 2; ++it) { const int task = F.tid + 512 * it, kidx = task >> 1, hh = task & 1; int pos = u.qb * 128 - 128 + kidx; pos = pos < 0 ? 0 : (pos > NSEQ - 1 ? NSEQ - 1 : pos);
        if (task < 768) {
            LAS bf16* d = KL + kidx * KV_LD + 8 * hh;
            const LAS float* c0 = rope + (pos >> 6) * 16 + 8 * hh; const LAS float* c1 = rope + (pos & 63) * 16 + 8 * hh;
            *(LAS bf16x8*)(d) = rope_pack(lk[it][0], lk[it][1], c0, c0 + 1024, 1.0f, false);
            *(LAS bf16x8*)(d + 16) = rope_pack(lk[it][0], lk[it][1], c0, c0 + 1024, 1.0f, true);
            *(LAS bf16x8*)(d + 32) = rope_pack(lk[it][2], lk[it][3], c1, c1 + 1024, 1.0f, false);
            *(LAS bf16x8*)(d + 48) = rope_pack(lk[it][2], lk[it][3], c1, c1 + 1024, 1.0f, true);
        } }
#pragma unroll
    for (int it = 0; it < 6; ++it) { const int task = F.tid + 512 * it, kidx = task >> 3, c8 = task & 7; *(LAS u32x4*)(VL + kidx * KV_LD + 8 * c8) = lv[it]; }
}
__device__ __forceinline__ void attn_load_ctx(Frame& F, const bf16* P1, AttnU u, u32x4 (&ck)[4], u32x4 (&cv)[4]) {
#pragma unroll
    for (int it = 0; it < 4; ++it) { const int task = F.tid + 512 * it, kidx = task >> 3, c8 = task & 7;
        const bf16* row = P1 + (size_t)(TL + u.b * LCTX + kidx) * OIN + 1024 + u.kvh * 64 + 8 * c8;
        ck[it] = *(const u32x4*)row; cv[it] = *(const u32x4*)(row + 128); }
}
__device__ __forceinline__ void attn_write_ctx(Frame& F, const u32x4 (&ck)[4], const u32x4 (&cv)[4]) {
    LAS bf16* KL = (LAS bf16*)F.lds; LAS bf16* VL = (LAS bf16*)(F.lds + VL_OFF);
#pragma unroll
    for (int it = 0; it < 4; ++it) { const int task = F.tid + 512 * it, kidx = task >> 3, c8 = task & 7;
        *(LAS u32x4*)(KL + kidx * KV_LD + 8 * c8) = ck[it]; *(LAS u32x4*)(VL + kidx * KV_LD + 8 * c8) = cv[it]; }
}

__device__ __forceinline__ unsigned cvtpk(float lo, float hi) { unsigned r; asm volatile("v_cvt_pk_bf16_f32 %0, %1, %2" : "=v"(r) : "v"(lo), "v"(hi)); return r; }
__device__ __forceinline__ float xhalf_max(float x) { const auto r = __builtin_amdgcn_permlane32_swap(__builtin_bit_cast(unsigned, x), __builtin_bit_cast(unsigned, x), false, false);
    return fmaxf(__builtin_bit_cast(float, r[0]), __builtin_bit_cast(float, r[1])); }
__device__ __forceinline__ float xhalf_sum(float x) { const auto r = __builtin_amdgcn_permlane32_swap(__builtin_bit_cast(unsigned, x), __builtin_bit_cast(unsigned, x), false, false);
    return __builtin_bit_cast(float, r[0]) + __builtin_bit_cast(float, r[1]); }
__device__ __forceinline__ void attn_tiles(Frame& F, int kt0, int kt1, int mk0, int mk1, const bf16x8 (&qf)[4], f32x16 (&O)[2], float& mrun, float& lrun, int qrel) {
    if (kt0 > kt1) return;
    const LAS bf16* KL = (const LAS bf16*)F.lds; const LAS bf16* VL = (const LAS bf16*)(F.lds + VL_OFF);
    const int r32 = F.lane & 31, hh = F.lane >> 5;
    const int q4 = (F.lane & 15) >> 2, p4 = F.lane & 3, blk = (F.lane >> 4) & 1;
    const LAS bf16* kp = KL + (kt0 * 32 + r32) * KV_LD + 8 * hh;
    const LAS bf16* vp = VL + (kt0 * 32 + 4 * hh + q4) * KV_LD + 16 * blk + 4 * p4;
    bf16x8 kn[4];
#pragma unroll
    for (int st = 0; st < 4; ++st) kn[st] = *(const LAS bf16x8*)(kp + 16 * st);
    for (int kt = kt0; kt <= kt1; ++kt) {
        bf16x8 kf[4];
#pragma unroll
        for (int st = 0; st < 4; ++st) kf[st] = kn[st];
        v4i16_t vlo[2][2], vhi[2][2];
#pragma unroll
        for (int dt = 0; dt < 2; ++dt)
#pragma unroll
            for (int s2 = 0; s2 < 2; ++s2) { vlo[dt][s2] = __builtin_amdgcn_ds_read_tr16_b64_v4i16((LAS v4i16_t*)(vp + (16 * s2) * KV_LD + dt * 32));
                vhi[dt][s2] = __builtin_amdgcn_ds_read_tr16_b64_v4i16((LAS v4i16_t*)(vp + (16 * s2 + 8) * KV_LD + dt * 32)); }
        kp += 32 * KV_LD; vp += 32 * KV_LD;
        if (kt < kt1) {
#pragma unroll
            for (int st = 0; st < 4; ++st) kn[st] = *(const LAS bf16x8*)(kp + 16 * st); }
        __builtin_amdgcn_sched_barrier(0);
        f32x16 s;
#pragma unroll
        for (int r = 0; r < 16; ++r) s[r] = 0.f;
#pragma unroll
        for (int st = 0; st < 4; ++st) s = __builtin_amdgcn_mfma_f32_32x32x16_bf16(kf[st], qf[st], s, 0, 0, 0);
        if (kt == mk0 || kt == mk1) {
#pragma unroll
            for (int r = 0; r < 16; ++r) { const int dlt = kt * 32 + (r & 3) + 8 * (r >> 2) + 4 * hh - qrel; s[r] = (dlt <= 128 && dlt >= -128) ? s[r] : -INFINITY; } }
        float mx = fmaxf(fmaxf(s[0], s[1]), fmaxf(s[2], s[3]));
#pragma unroll
        for (int r = 4; r < 16; r += 4) mx = fmaxf(mx, fmaxf(fmaxf(s[r], s[r + 1]), fmaxf(s[r + 2], s[r + 3])));
        mx = xhalf_max(mx);
        const float mnew = fmaxf(mrun, mx);
        float ps0 = 0.f, ps1 = 0.f;
#pragma unroll
        for (int r = 0; r < 16; r += 2) { s[r] = __builtin_amdgcn_exp2f(s[r] - mnew); s[r + 1] = __builtin_amdgcn_exp2f(s[r + 1] - mnew); ps0 += s[r]; ps1 += s[r + 1]; }
        const float ps = xhalf_sum(ps0 + ps1);
        if (__any(mnew > mrun)) {
            const float alpha = __builtin_amdgcn_exp2f(mrun - mnew);
            lrun *= alpha;
#pragma unroll
            for (int dt = 0; dt < 2; ++dt)
#pragma unroll
                for (int r = 0; r < 16; ++r) O[dt][r] *= alpha;
        }
        lrun += ps; mrun = mnew;
        bf16x8 pb[2];
#pragma unroll
        for (int s2 = 0; s2 < 2; ++s2) { u32x4 w; w.x = cvtpk(s[8 * s2 + 0], s[8 * s2 + 1]); w.y = cvtpk(s[8 * s2 + 2], s[8 * s2 + 3]); w.z = cvtpk(s[8 * s2 + 4], s[8 * s2 + 5]); w.w = cvtpk(s[8 * s2 + 6], s[8 * s2 + 7]);
            pb[s2] = __builtin_bit_cast(bf16x8, w); }
#pragma unroll
        for (int dt = 0; dt < 2; ++dt)
#pragma unroll
            for (int s2 = 0; s2 < 2; ++s2) {
                const bf16x8 va = (bf16x8){vlo[dt][s2][0], vlo[dt][s2][1], vlo[dt][s2][2], vlo[dt][s2][3], vhi[dt][s2][0], vhi[dt][s2][1], vhi[dt][s2][2], vhi[dt][s2][3]};
                O[dt] = __builtin_amdgcn_mfma_f32_32x32x16_bf16(va, pb[s2], O[dt], 0, 0, 0);
            }
    }
}

__device__ __forceinline__ void phase_attn(Frame& F) {
    const bf16* P1 = (const bf16*)(F.ws + WS_BUFP);
    bf16* MIX = (bf16*)(F.ws + WS_BUFA);
    const int r32 = F.lane & 31, hh = F.lane >> 5;
    constexpr float QSC = 0.125f * 1.4426950408889634f;
    LAS float* ropel = (LAS float*)(F.lds + ROPE_LDS);
    for (int i = F.tid; i < 2048; i += 512) ropel[i] = ((const float*)(F.ws + WS_ROPE))[i];
    u32x4 lk[2][4], lv[6], ck[4], cv[4];
    const int nu = (512 - F.vcu + F.G - 1) / F.G;
    if (nu > 0) attn_load_latk(F, P1, attn_unit_of(F.vcu), lk);
    for (int ui = 0; ui < nu; ++ui) {
        const AttnU u = attn_unit_of(F.vcu + ui * F.G);
        u32x4 qr[2][4];
#pragma unroll
        for (int i = 0; i < 2; ++i) { const int task = F.wave + 8 * i, g = task & 3, sub = task >> 2, head = u.kvh * 4 + g, pos = u.qb * 128 + 32 * sub + r32;
            const bf16* row = P1 + (size_t)(u.b * NSEQ + pos) * OIN + 512 + head * 64 + 8 * hh;
#pragma unroll
            for (int st = 0; st < 4; ++st) qr[i][st] = __builtin_nontemporal_load((const u32x4*)(row + 16 * st)); }
        attn_load_latv(F, P1, u, lv);
        __syncthreads();
        attn_write_lat(F, u, lk, lv);
        bf16x8 qf[2][4]; f32x16 O[2][2]; float mrun[2], lrun[2];
#pragma unroll
        for (int i = 0; i < 2; ++i) { const int task = F.wave + 8 * i, g = task & 3, sub = task >> 2, head = u.kvh * 4 + g, pos = u.qb * 128 + 32 * sub + r32;
            const LAS float* c0 = ropel + (pos >> 6) * 16 + 8 * hh; const LAS float* c1 = ropel + (pos & 63) * 16 + 8 * hh;
            qf[i][0] = rope_pack(qr[i][0], qr[i][1], c0, c0 + 1024, QSC, false); qf[i][1] = rope_pack(qr[i][0], qr[i][1], c0, c0 + 1024, QSC, true);
            qf[i][2] = rope_pack(qr[i][2], qr[i][3], c1, c1 + 1024, QSC, false); qf[i][3] = rope_pack(qr[i][2], qr[i][3], c1, c1 + 1024, QSC, true);
            mrun[i] = F.in[I_OSINK][head] * 1.4426950408889634f; lrun[i] = 1.0f;
#pragma unroll
            for (int dt = 0; dt < 2; ++dt)
#pragma unroll
                for (int r = 0; r < 16; ++r) O[i][dt][r] = 0.f; }
        __syncthreads();
        const int kt_lo = (u.qb == 0) ? 4 : 0, kt_hi = (u.qb == 31) ? 7 : 11;
#pragma unroll
        for (int i = 0; i < 2; ++i) { const int sub = (F.wave + 8 * i) >> 2, qrel = 128 + 32 * sub + r32;
            attn_tiles(F, max(sub, kt_lo), min(sub + 8, kt_hi), sub, sub + 8, qf[i], O[i], mrun[i], lrun[i], qrel); }
        attn_load_ctx(F, P1, u, ck, cv);
        __syncthreads();
        attn_write_ctx(F, ck, cv);
        __syncthreads();
        if (ui + 1 < nu) attn_load_latk(F, P1, attn_unit_of(F.vcu + (ui + 1) * F.G), lk);
#pragma unroll
        for (int i = 0; i < 2; ++i) {
            attn_tiles(F, 0, 7, -1, -1, qf[i], O[i], mrun[i], lrun[i], 0);
            const int task = F.wave + 8 * i, g = task & 3, sub = task >> 2, head = u.kvh * 4 + g, pos = u.qb * 128 + 32 * sub + r32;
            const float inv = 1.0f / lrun[i];
            bf16* o = MIX + (size_t)(u.b * NSEQ + pos) * D + 512 + head * 64 + 4 * hh;
#pragma unroll
            for (int dt = 0; dt < 2; ++dt)
#pragma unroll
                for (int rg = 0; rg < 4; ++rg) {
                    if constexpr (FP8_OUT1) { const float i4 = inv * pg8::MIX1_SCALE; unsigned char* o8 = (unsigned char*)MIX + (size_t)(u.b * NSEQ + pos) * D + 512 + head * 64 + 4 * hh;
                        *(unsigned*)(o8 + dt * 32 + 8 * rg) = pg8::pk4_fp8(O[i][dt][4 * rg] * i4, O[i][dt][4 * rg + 1] * i4, O[i][dt][4 * rg + 2] * i4, O[i][dt][4 * rg + 3] * i4); }
                    else { u32x2 w; w.x = pk2(O[i][dt][4 * rg] * inv, O[i][dt][4 * rg + 1] * inv); w.y = pk2(O[i][dt][4 * rg + 2] * inv, O[i][dt][4 * rg + 3] * inv);
                    *(u32x2*)(o + dt * 32 + 8 * rg) = w; } }
        }
    }
    __syncthreads();
}

__device__ __forceinline__ void phase_pool_stencil(Frame& F) {
    const bf16* P1 = (const bf16*)(F.ws + WS_BUFP);
    bf16* MIX = (bf16*)(F.ws + WS_BUFA);
    const int gw = F.vcu * NWAVES + F.wave, NGW = F.G * NWAVES;
    const int r = 1 << (F.lane >> 4);
    constexpr int NT = 8, NR = NT + 16;
    for (int t = NT * gw; t < TL; t += NT * NGW) {
        const int pos = t & 4095;
        const bf16* base = P1 + (size_t)t * OIN + 8 * F.lane;
        u32x4 v[NR];
#pragma unroll
        for (int jj = 0; jj < NR; ++jj) { const int pj = pos + jj - 8; const bool ok = pj >= 0 && pj < NSEQ; v[jj] = ok ? *(const u32x4*)(base + (ptrdiff_t)(jj - 8) * OIN) : (u32x4){0u, 0u, 0u, 0u}; }
        float acc[NT][8];
#pragma unroll
        for (int q = 0; q < NT; ++q)
#pragma unroll
            for (int i = 0; i < 8; ++i) acc[q][i] = 0.f;
#pragma unroll
        for (int jj = 0; jj < NR; ++jj) {
            float x[8];
#pragma unroll
            for (int i = 0; i < 4; ++i) { x[2 * i] = bflo(v[jj][i]); x[2 * i + 1] = bfhi(v[jj][i]); }
#pragma unroll
            for (int q = 0; q < NT; ++q) { const int dd = jj - 8 - q; if (dd >= -8 && dd <= 8) { const float w = (dd <= r && dd >= -r) ? 1.0f : 0.0f;
#pragma unroll
                for (int i = 0; i < 8; ++i) acc[q][i] += w * x[i]; } }
        }
#pragma unroll
        for (int q = 0; q < NT; ++q) {
            const int pq = pos + q, lo = max(pq - r, 0), hi = min(pq + r + 1, NSEQ);
            const float ic = 1.0f / (float)(hi - lo);
            const u32x4 sv = v[q + 8];
            if constexpr (FP8_OUT1) {
                float y[8];
#pragma unroll
                for (int i = 0; i < 4; ++i) { y[2 * i] = __builtin_fminf(__builtin_fmaxf((acc[q][2 * i] * ic - bflo(sv[i])) * pg8::MIX1_SCALE, -448.0f), 448.0f); y[2 * i + 1] = __builtin_fminf(__builtin_fmaxf((acc[q][2 * i + 1] * ic - bfhi(sv[i])) * pg8::MIX1_SCALE, -448.0f), 448.0f); }
                u32x2 o8; o8.x = pg8::pk4_fp8(y[0], y[1], y[2], y[3]); o8.y = pg8::pk4_fp8(y[4], y[5], y[6], y[7]);
                *(u32x2*)((unsigned char*)MIX + (size_t)(t + q) * D + 8 * F.lane) = o8;
            } else {
            u32x4 o;
#pragma unroll
            for (int i = 0; i < 4; ++i) o[i] = pk2(acc[q][2 * i] * ic - bflo(sv[i]), acc[q][2 * i + 1] * ic - bfhi(sv[i]));
            *(u32x4*)(MIX + (size_t)(t + q) * D + 8 * F.lane) = o; }
        }
    }
}

__device__ __forceinline__ void phase_attn_pool(Frame& F) {
    phase_attn(F);
#ifdef DBG_ATTN2
    phase_attn(F);
#endif
    phase_pool_stencil(F);
    __syncthreads();
    convert_l1_range(F, 120 * L1T_N + F.vcu * L1A_N, L1A_N, 40);
}

constexpr int NPHASE = 20;
__global__ void __launch_bounds__(NWAVES * 64, 2) mk_fwd(Args args) {
    extern __shared__ __attribute__((aligned(16))) unsigned char lds_raw[];
    Frame F;
    F.lds = (LAS unsigned char*)lds_raw;
    F.tid = threadIdx.x; F.lane = F.tid & 63; F.wave = __builtin_amdgcn_readfirstlane(F.tid >> 6);
    F.G = gridDim.x; { const int bx = blockIdx.x; F.vcu = (F.G % 8 == 0) ? (bx % 8) * (F.G / 8) + bx / 8 : bx; }
    F.ws = args.ws; F.in = args.in; F.out = args.out;
    for (int u = F.tid; u < (LDS_BYTES - LDS_CTL) / 4; u += NWAVES * 64) ((LAS unsigned*)(F.lds + LDS_CTL))[u] = 0u;
    __syncthreads();
    const int lo = args.ph_lo, hi = args.ph_hi;
    XcdBarrier bar; bar.bar = (unsigned*)(F.ws + WS_CTL); bar.x = 0; bar.st = nullptr;
    if (hi - lo > 1) bar = xcd_barrier_post((unsigned*)(F.ws + WS_CTL), (volatile LAS unsigned*)(F.lds + LDS_CTL));
    if (F.tid == 0) { *((unsigned*)(F.ws + WS_XCDOF) + F.vcu) = xb_xcc_id(); *(LAS int*)(F.lds + LDS_CTL + 52) = (hi - lo > 1) ? 1 : 0; }
#define IN(k) (lo <= (k) && (k) < hi)
#ifndef PHASE_MASK
#define PHASE_MASK 0xffffffffu
#endif
#define PH(k, ...) if constexpr (((PHASE_MASK >> (k)) & 1u) != 0u) if (IN(k)) { { int t_ = F.tid; asm volatile("" : "+v"(t_)); F.tid = t_; F.lane = t_ & 63; } __VA_ARGS__ if constexpr (((DBG_DOUBLE >> (k)) & 1u) != 0u) { __VA_ARGS__ } }
#define SEAM(k) do { if (IN(k) && IN((k) + 1)) xcd_barrier(bar); } while (0)
    unsigned char* ws = F.ws;
    const float* mods = (const float*)(ws + WS_MODS);

    PH(1, { phase_prologue_a(F); }) SEAM(1);
    PH(2, {
        pg8::SchedDense S{(const char*)(ws + WS_BUFA), (const char*)(ws + WS_W_EIN), 1024, 8, 136, 0, 1088, F.vcu, F.G};
        pg8::EpiStore E{(bf16*)(ws + WS_BUFP), EIN};
        pg8::gemm_phase<pg8::EpiStore, pg8::SchedDense>(F.lds, 1024, S, E);
        if (F.vcu >= 64) { __syncthreads(); convert_l1_range(F, (F.vcu - 64) * L0T_N, L0T_N, 48, 0); }
    }) SEAM(2);
    PH(3, { phase_fourier_a_conv(F); })
    PH(4, { phase_fourier_c(F); }) SEAM(4);
    PH(5, {
        const int xs = F.vcu >> 5, rs = F.vcu & 31; const bool heavy = rs >= 28;
        pg8::SchedSplit S{(const char*)(ws + WS_BUFA), (const char*)(ws + WS_W_EOUT), 1024, heavy ? 448 + 4 * xs + (rs - 28) : 28 * xs + rs, heavy ? 32 : 224, heavy ? 3 : 2};
        pg8::EpiResid<true> E{F.in[I_X], F.in[I_CTX], (bf16*)(ws + WS_HB), mods + 2 * 1024};
        pg8::gemm_phase<pg8::EpiResid<true>, pg8::SchedSplit>(F.lds, 1024, S, E);
        ctr_publish(F, heavy ? WS_P5C : WS_P5F, heavy ? 2 : 1, xcd_census(F, [&](int v) { return ((v & 31) >= 28) == heavy; }));
    })
    PH(6, { phase_route<true>(F, 0, T); }) SEAM(6);
    PH(7, {
        const int ntile = moe_tables(F, 0);
        const int Lg = ntile & 63; const bool isLong = (F.vcu >> 2) < Lg;
        const unsigned nxc = xcd_census(F, [&](int v) { return ((v >> 2) < Lg) == isLong; });
        if constexpr (FP8_G1_L0) {
            pg8::SchedMoe<true> S{(const char*)(ws + WS_BUFA), (const char*)(ws + WS_W_M1) + (size_t)0 * 32 * MiB, (const int*)(ws + WS_TOKMAP), (const LAS int*)(F.lds + LDS_CTL + 64), (const LAS int*)(F.lds + LDS_CTL + 192), 512, (size_t)MiB, ntile * 4, F.vcu, F.G};
            pg8::EpiSwiglu8 E{(unsigned char*)(ws + WS_BUFZ), pg8::W1_SCALE};
            pg8::gemm_phase<pg8::EpiSwiglu8, pg8::SchedMoe<true>, true>(F.lds, 512, S, E);
        } else {
            pg8::SchedMoe<true> S{(const char*)(ws + WS_BUFA), (const char*)(ws + WS_W_M1) + (size_t)0 * 32 * MiB, (const int*)(ws + WS_TOKMAP), (const LAS int*)(F.lds + LDS_CTL + 64), (const LAS int*)(F.lds + LDS_CTL + 192), 1024, (size_t)2 * MiB, ntile * 4, F.vcu, F.G};
            if constexpr (FP8_G2_L0) { pg8::EpiSwiglu8 E{(unsigned char*)(ws + WS_BUFZ), 1.0f}; pg8::gemm_phase<pg8::EpiSwiglu8, pg8::SchedMoe<true>>(F.lds, 1024, S, E); }
            else { pg8::EpiSwiglu E{(bf16*)(ws + WS_BUFZ)}; pg8::gemm_phase<pg8::EpiSwiglu, pg8::SchedMoe<true>>(F.lds, 1024, S, E); }
        }
        ctr_publish(F, WS_G1CNT + (size_t)(0 * 2 + (isLong ? 1 : 0)) * 256, 3 + 0 * 2 + (isLong ? 1 : 0), nxc);
    })
    PH(8, {
        const int ntile = moe_tables(F, 0);
        const int Rp = ntile >> 6, Lg = ntile & 63, grp = F.vcu >> 2; const bool isLong = grp < Lg;
        const size_t cnt0 = WS_G1CNT + (size_t)(0 * 2) * 256;
        ctr_wait(F, cnt0 + (isLong ? 256 : 0), (unsigned)(isLong ? 4 * Lg : 256 - 4 * Lg));
        if constexpr (FP8_G2_L0) {
            { pg8::EpiStoreF8 E{(unsigned char*)(ws + WS_BUFP), 1024, pg8::OS_SCALE / (pg8::HID_SCALE * pg8::W2_SCALE)};
              pg8::SchedMoe<false> S{(const char*)(ws + WS_BUFZ), (const char*)(ws + WS_W_M2) + (size_t)0 * 16 * MiB, nullptr, (const LAS int*)(F.lds + LDS_CTL + 64), (const LAS int*)(F.lds + LDS_CTL + 192), 256, (size_t)512 * KiB, Rp * 256, F.vcu, F.G};
              pg8::gemm_phase<pg8::EpiStoreF8, pg8::SchedMoe<false>, true>(F.lds, 256, S, E); }
            const int nt2 = __builtin_amdgcn_readfirstlane(*(const LAS int*)(F.lds + LDS_CTL + 64 + 64)), Lg2 = nt2 & 63, grp2 = F.vcu >> 2;
            int xc = -1;
            if (grp2 < Lg2) { if (63 - grp2 < Lg2) xc = F.vcu; }
            else if (63 - grp2 < Lg2) xc = 4 * (63 - grp2) + (F.vcu & 3);
            if (xc >= 0) {
                if (grp2 >= Lg2) ctr_wait(F, WS_G1CNT + (size_t)(0 * 2 + 1) * 256, (unsigned)(4 * Lg2));
                pg8::EpiStoreF8 E{(unsigned char*)(ws + WS_BUFP), 1024, pg8::OS_SCALE / (pg8::HID_SCALE * pg8::W2_SCALE)};
                pg8::SchedMoe<false> S{(const char*)(ws + WS_BUFZ), (const char*)(ws + WS_W_M2) + (size_t)0 * 16 * MiB, nullptr, (const LAS int*)(F.lds + LDS_CTL + 64), (const LAS int*)(F.lds + LDS_CTL + 192), 256, (size_t)512 * KiB, nt2 * 4, (nt2 >> 6) * 256 + xc, 1 << 20};
                pg8::gemm_phase<pg8::EpiStoreF8, pg8::SchedMoe<false>, true>(F.lds, 256, S, E);
            }
        } else {
            if (Lg > 0 && Lg < 64) ctr_wait(F, cnt0 + (isLong ? 0 : 256), (unsigned)(isLong ? 256 - 4 * Lg : 4 * Lg));
            pg8::SchedMoe<false> S{(const char*)(ws + WS_BUFZ), (const char*)(ws + WS_W_M2) + (size_t)0 * 16 * MiB, nullptr, (const LAS int*)(F.lds + LDS_CTL + 64), (const LAS int*)(F.lds + LDS_CTL + 192), 512, (size_t)MiB, ntile * 4, F.vcu, F.G};
            pg8::EpiStore E{(bf16*)(ws + WS_BUFP), 1024};
            pg8::gemm_phase<pg8::EpiStore, pg8::SchedMoe<false>>(F.lds, 512, S, E);
        }
    }) SEAM(8);
    PH(9, { (void)moe_tables(F, 0); phase_combine(F, 0, T); }) SEAM(9);
    PH(10, {
        if constexpr (FP8_IN1) {
            pg8::SchedDense S{(const char*)(ws + WS_BUFA), (const char*)(ws + WS_W_OIN), 512, 5, 128, 4, 648, F.vcu, F.G};
            pg8::EpiStoreS E{(bf16*)(ws + WS_BUFP), OIN, 1.0f / pg8::W1_SCALE};
            pg8::gemm_phase<pg8::EpiStoreS, pg8::SchedDense, true>(F.lds, 512, S, E);
        } else {
        pg8::SchedDense S{(const char*)(ws + WS_BUFA), (const char*)(ws + WS_W_OIN), 1024, 5, 128, 4, 648, F.vcu, F.G};
        pg8::EpiStore E{(bf16*)(ws + WS_BUFP), OIN};
        pg8::gemm_phase<pg8::EpiStore, pg8::SchedDense>(F.lds, 1024, S, E); }
        if (F.vcu >= 136) { __syncthreads(); convert_l1_range(F, (F.vcu - 136) * L1T_N, L1T_N, 44); }
    }) SEAM(10);
    PH(11, { phase_attn_pool(F); }) SEAM(11);
    PH(12, {
        if constexpr (FP8_OUT1) {
            pg8::SchedDense S{(const char*)(ws + WS_BUFA), (const char*)(ws + WS_W_OOUT), 512, 4, 128, 0, 512, F.vcu, F.G};
            pg8::EpiResid<false> E{nullptr, nullptr, (bf16*)(ws + WS_HB), mods + 9 * 6144 + 2 * 1024, 1.0f / (pg8::W1_SCALE * pg8::MIX1_SCALE)};
            pg8::gemm_phase<pg8::EpiResid<false>, pg8::SchedDense, true>(F.lds, 512, S, E);
        } else {
        pg8::SchedDense S{(const char*)(ws + WS_BUFA), (const char*)(ws + WS_W_OOUT), 1024, 4, 128, 0, 512, F.vcu, F.G};
        pg8::EpiResid<false> E{nullptr, nullptr, (bf16*)(ws + WS_HB), mods + 9 * 6144 + 2 * 1024};
        pg8::gemm_phase<pg8::EpiResid<false>, pg8::SchedDense>(F.lds, 1024, S, E); }
    }) SEAM(12);
    PH(13, { phase_route<false>(F, 1, TL); }) SEAM(13);
    PH(14, {
        const int ntile = moe_tables(F, 1);
        const int Lg = ntile & 63; const bool isLong = (F.vcu >> 2) < Lg;
        const unsigned nxc = xcd_census(F, [&](int v) { return ((v >> 2) < Lg) == isLong; });
        if constexpr (FP8_G1_L1) {
            pg8::SchedMoe<true> S{(const char*)(ws + WS_BUFA), (const char*)(ws + WS_W_M1) + (size_t)1 * 32 * MiB, (const int*)(ws + WS_TOKMAP), (const LAS int*)(F.lds + LDS_CTL + 64), (const LAS int*)(F.lds + LDS_CTL + 192), 512, (size_t)MiB, ntile * 4, F.vcu, F.G};
            pg8::EpiSwiglu8 E{(unsigned char*)(ws + WS_BUFZ), pg8::W1_SCALE};
            pg8::gemm_phase<pg8::EpiSwiglu8, pg8::SchedMoe<true>, true>(F.lds, 512, S, E);
        } else {
            pg8::SchedMoe<true> S{(const char*)(ws + WS_BUFA), (const char*)(ws + WS_W_M1) + (size_t)1 * 32 * MiB, (const int*)(ws + WS_TOKMAP), (const LAS int*)(F.lds + LDS_CTL + 64), (const LAS int*)(F.lds + LDS_CTL + 192), 1024, (size_t)2 * MiB, ntile * 4, F.vcu, F.G};
            if constexpr (FP8_G2_L1) { pg8::EpiSwiglu8 E{(unsigned char*)(ws + WS_BUFZ), 1.0f}; pg8::gemm_phase<pg8::EpiSwiglu8, pg8::SchedMoe<true>>(F.lds, 1024, S, E); }
            else { pg8::EpiSwiglu E{(bf16*)(ws + WS_BUFZ)}; pg8::gemm_phase<pg8::EpiSwiglu, pg8::SchedMoe<true>>(F.lds, 1024, S, E); }
        }
        ctr_publish(F, WS_G1CNT + (size_t)(1 * 2 + (isLong ? 1 : 0)) * 256, 3 + 1 * 2 + (isLong ? 1 : 0), nxc);
    })
    PH(15, {
        const int ntile = moe_tables(F, 1);
        const int Rp = ntile >> 6, Lg = ntile & 63, grp = F.vcu >> 2; const bool isLong = grp < Lg;
        const size_t cnt0 = WS_G1CNT + (size_t)(1 * 2) * 256;
        ctr_wait(F, cnt0 + (isLong ? 256 : 0), (unsigned)(isLong ? 4 * Lg : 256 - 4 * Lg));
        if constexpr (FP8_G2_L1) {
            { pg8::EpiStoreF8 E{(unsigned char*)(ws + WS_BUFP), 1024, pg8::OS_SCALE / (pg8::HID_SCALE * pg8::W2_SCALE)};
              pg8::SchedMoe<false> S{(const char*)(ws + WS_BUFZ), (const char*)(ws + WS_W_M2) + (size_t)1 * 16 * MiB, nullptr, (const LAS int*)(F.lds + LDS_CTL + 64), (const LAS int*)(F.lds + LDS_CTL + 192), 256, (size_t)512 * KiB, Rp * 256, F.vcu, F.G};
              pg8::gemm_phase<pg8::EpiStoreF8, pg8::SchedMoe<false>, true>(F.lds, 256, S, E); }
            const int nt2 = __builtin_amdgcn_readfirstlane(*(const LAS int*)(F.lds + LDS_CTL + 64 + 64)), Lg2 = nt2 & 63, grp2 = F.vcu >> 2;
            int xc = -1;
            if (grp2 < Lg2) { if (63 - grp2 < Lg2) xc = F.vcu; }
            else if (63 - grp2 < Lg2) xc = 4 * (63 - grp2) + (F.vcu & 3);
            if (xc >= 0) {
                if (grp2 >= Lg2) ctr_wait(F, WS_G1CNT + (size_t)(1 * 2 + 1) * 256, (unsigned)(4 * Lg2));
                pg8::EpiStoreF8 E{(unsigned char*)(ws + WS_BUFP), 1024, pg8::OS_SCALE / (pg8::HID_SCALE * pg8::W2_SCALE)};
                pg8::SchedMoe<false> S{(const char*)(ws + WS_BUFZ), (const char*)(ws + WS_W_M2) + (size_t)1 * 16 * MiB, nullptr, (const LAS int*)(F.lds + LDS_CTL + 64), (const LAS int*)(F.lds + LDS_CTL + 192), 256, (size_t)512 * KiB, nt2 * 4, (nt2 >> 6) * 256 + xc, 1 << 20};
                pg8::gemm_phase<pg8::EpiStoreF8, pg8::SchedMoe<false>, true>(F.lds, 256, S, E);
            }
        } else {
            if (Lg > 0 && Lg < 64) ctr_wait(F, cnt0 + (isLong ? 0 : 256), (unsigned)(isLong ? 256 - 4 * Lg : 4 * Lg));
            pg8::SchedMoe<false> S{(const char*)(ws + WS_BUFZ), (const char*)(ws + WS_W_M2) + (size_t)1 * 16 * MiB, nullptr, (const LAS int*)(F.lds + LDS_CTL + 64), (const LAS int*)(F.lds + LDS_CTL + 192), 512, (size_t)MiB, ntile * 4, F.vcu, F.G};
            pg8::EpiStore E{(bf16*)(ws + WS_BUFP), 1024};
            pg8::gemm_phase<pg8::EpiStore, pg8::SchedMoe<false>>(F.lds, 512, S, E);
        }
    }) SEAM(15);
    PH(16, { (void)moe_tables(F, 1); phase_combine(F, 1, TL); }) SEAM(16);
#ifdef DBG_XBAR
    if (hi - lo > 1) { for (int xb = 0; xb < DBG_XBAR; ++xb) xcd_barrier(bar); }
#endif
#undef IN
#undef SEAM
}

extern "C" void kernel_launch(void* const* d_in, const int* in_sizes, int n_in, void* d_out, int out_size, void* d_ws, size_t ws_size, hipStream_t stream) {
    static int grid = 0;
    if (grid == 0) {
        if (n_in != 22 || ws_size < WS_END) { fprintf(stderr, "kernel_launch: unexpected inputs (n_in %d, ws %zu)\n", n_in, ws_size); grid = -1; return; }
        int dev = 0, cus = 0, per_cu = 0;
        if (hipGetDevice(&dev) != hipSuccess || hipDeviceGetAttribute(&cus, hipDeviceAttributeMultiprocessorCount, dev) != hipSuccess) { grid = -1; return; }
        if (hipFuncSetAttribute((const void*)mk_fwd, hipFuncAttributeMaxDynamicSharedMemorySize, LDS_BYTES) != hipSuccess) { fprintf(stderr, "kernel_launch: hipFuncSetAttribute failed\n"); grid = -1; return; }
        if (hipOccupancyMaxActiveBlocksPerMultiprocessor(&per_cu, (const void*)mk_fwd, NWAVES * 64, LDS_BYTES) != hipSuccess || per_cu < 1) { fprintf(stderr, "kernel_launch: occupancy query says %d\n", per_cu); }
        (void)hipGetLastError();
        grid = cus;
        if (grid != 256) { fprintf(stderr, "kernel_launch: %d CUs; this build assumes 256\n", grid); }
    }
    if (grid < 0) return;
    (void)hipMemsetAsync((char*)d_ws + WS_CTL, 0, CTL_ZERO_BYTES, stream);
    Args a{};
    for (int i = 0; i < 22; ++i) a.in[i] = (const float*)d_in[i];
    a.out = (float*)d_out; a.ws = (unsigned char*)d_ws;
#if MK_MULTI
    for (int p = 0; p <= DBG_STOP; ++p) { a.ph_lo = p; a.ph_hi = p + 1; hipLaunchKernelGGL(mk_fwd, dim3(grid), dim3(NWAVES * 64), LDS_BYTES, stream, a); }
    if (DBG_STOP < 16) { a.ph_lo = 17; a.ph_hi = 18; hipLaunchKernelGGL(mk_fwd, dim3(grid), dim3(NWAVES * 64), LDS_BYTES, stream, a); }
#else
    a.ph_lo = 0; a.ph_hi = 17;
    hipLaunchKernelGGL(mk_fwd, dim3(grid), dim3(NWAVES * 64), LDS_BYTES, stream, a);
#endif
}
```

```cpp
#include <hip/hip_runtime.h>
#include <cstdio>
#include <cstdint>
#include <type_traits>

#ifndef FP8_IN1
#define FP8_IN1 1
#endif
#ifndef FP8_OUT1
#define FP8_OUT1 1
#endif
#ifndef FP8_OUT0
#define FP8_OUT0 1
#endif
#ifndef MK_MULTI
#define MK_MULTI 0
#endif
#ifndef DBG_STOP
#define DBG_STOP 16
#endif

#ifndef DBG_DOUBLE
#define DBG_DOUBLE 0u
#endif
#ifndef FP8_G1_L0
#define FP8_G1_L0 1
#endif
#ifndef FP8_G1_L1
#define FP8_G1_L1 1
#endif
#ifndef FP8_G2_L0
#define FP8_G2_L0 1
#endif
#ifndef FP8_G2_L1
#define FP8_G2_L1 1
#endif
#define LAS __attribute__((address_space(3)))
#define GAS __attribute__((address_space(1)))
typedef unsigned short bf16;
typedef short bf16x8 __attribute__((ext_vector_type(8)));
typedef short s16x4 __attribute__((ext_vector_type(4)));
typedef float f32x4 __attribute__((ext_vector_type(4)));
typedef float f32x16 __attribute__((ext_vector_type(16)));
typedef unsigned u32x4 __attribute__((ext_vector_type(4)));
typedef unsigned u32x2 __attribute__((ext_vector_type(2)));

constexpr int NB = 8, NSEQ = 4096, D = 1024, LCTX = 256;
constexpr int TL = NB * NSEQ, TC = NB * LCTX, T = TL + TC;
constexpr int EIN = 2048;
constexpr int OIN = 1280;
constexpr int NE = 16, DE = 512;
constexpr int MAXSLOT = 73728;
constexpr float EPS = 1e-6f;

constexpr size_t KiB = 1024, MiB = 1024 * 1024;
constexpr size_t WS_CTL = 0, CTL_ZERO_BYTES = 64 * KiB;
constexpr size_t WS_MODS = 64 * KiB;
constexpr size_t WS_ROPE = WS_MODS + 512 * KiB;
constexpr size_t WS_WA = WS_ROPE + 8 * KiB;
constexpr size_t WS_WAC = WS_WA + 32 * KiB;
constexpr size_t WS_WCC = WS_WAC + 2 * KiB;
constexpr size_t WS_FD = 3 * MiB - 64 * KiB;
constexpr size_t WS_BCNT = WS_WCC + 16 * KiB;
constexpr size_t WS_TILEMAP = WS_BCNT + 16 * KiB;
constexpr size_t WS_SLOT = WS_TILEMAP + 2 * KiB;
constexpr size_t WS_WROW = WS_SLOT + 288 * KiB;
constexpr size_t WS_ROUTE = WS_WROW + 288 * KiB;
constexpr size_t WS_WC = 3 * MiB;
constexpr size_t WS_W_EIN = 4 * MiB;
constexpr size_t WS_W_EOUT = 9 * MiB;
constexpr size_t WS_W_OIN = 11 * MiB;
constexpr size_t WS_W_OOUT = 14 * MiB;
constexpr size_t WS_W_POOL = 16 * MiB;
constexpr size_t WS_W_M1 = 17 * MiB;
constexpr size_t WS_W_M2 = 81 * MiB;
constexpr size_t WS_HC = 113 * MiB;
constexpr size_t WS_BUFA = 121 * MiB;
constexpr size_t WS_BUFP = 189 * MiB;
constexpr size_t WS_BUFZ = 360 * MiB;
constexpr size_t WS_TOKMAP = 432 * MiB;
constexpr size_t WS_HB = 435 * MiB;
constexpr size_t WS_END = 503 * MiB;
constexpr size_t WS_MODSDONE = 24 * KiB;
constexpr size_t WS_FAF = 28 * KiB + 512;
constexpr size_t WS_P5F = 28 * KiB, WS_P5C = 28 * KiB + 256;
constexpr size_t WS_CENSUS = 28 * KiB + 768;
constexpr size_t WS_XCDOF = 60 * KiB;
constexpr size_t WS_G1CNT = 61 * KiB;
constexpr size_t WS_XARR = 32 * KiB;
constexpr size_t WS_GCNT = 16 * KiB;
static_assert(WS_ROUTE + (size_t)T * 32 <= WS_WC, "small region");
static_assert((size_t)T * EIN * 2 <= WS_BUFZ - WS_BUFP && (size_t)MAXSLOT * 1024 * 2 <= WS_BUFZ - WS_BUFP, "BUFP");
static_assert((size_t)MAXSLOT * 512 * 2 <= WS_TOKMAP - WS_BUFZ && (size_t)T * 1024 * 2 <= WS_TOKMAP - WS_BUFZ, "BUFZ");
static_assert((size_t)16 * T * 4 <= WS_HB - WS_TOKMAP && (size_t)T * 1024 * 2 <= WS_END - WS_HB, "TOKMAP / HB");
static_assert((size_t)T * 1024 * 2 <= WS_BUFP - WS_BUFA, "BUFA");

constexpr int LDS_BYTES = 163840;
constexpr int LDS_GIDX = 147456;
constexpr int LDS_CTL = 146432;
constexpr int NWAVES = 8;

__device__ __forceinline__ unsigned f2bf(float f) { unsigned u = __builtin_bit_cast(unsigned, f); return (u + 0x7fffu + ((u >> 16) & 1u)) >> 16; }
__device__ __forceinline__ unsigned pk2(float lo, float hi) { return f2bf(lo) | (f2bf(hi) << 16); }
__device__ __forceinline__ float bflo(unsigned w) { return __builtin_bit_cast(float, w << 16); }
__device__ __forceinline__ float bfhi(unsigned w) { return __builtin_bit_cast(float, w & 0xffff0000u); }
__device__ __forceinline__ float wave_sum(float v) {
#pragma unroll
    for (int o = 1; o < 64; o <<= 1) v += __shfl_xor(v, o);
    return v;
}
__device__ __forceinline__ int ld_coh(const int* p) { return (int)__hip_atomic_load((const unsigned*)p, __ATOMIC_RELAXED, __HIP_MEMORY_SCOPE_AGENT); }
__device__ __forceinline__ float ld_cohf(const float* p) { return __builtin_bit_cast(float, __hip_atomic_load((const unsigned*)p, __ATOMIC_RELAXED, __HIP_MEMORY_SCOPE_AGENT)); }
#define LDS_WAIT() asm volatile("s_waitcnt lgkmcnt(0)" ::: "memory")

#define XB_TMO      128
#define XB_XCNT(j)  (256  + 64 * (j))
#define XB_XSUB(j)  (1280 + 64 * (j))
#define XB_XGEN(j)  (2304 + 64 * (j))
#define XB_TOP      3328
#define XB_TOPGEN   3392
#define XCD_BAR_WORDS 3456
#define XB_SPIN_CAP (1u << 18)
__device__ __forceinline__ unsigned xb_ld(unsigned* p)              { return __hip_atomic_load(p, __ATOMIC_RELAXED, __HIP_MEMORY_SCOPE_AGENT); }
__device__ __forceinline__ unsigned xb_add(unsigned* p, unsigned v) { return __hip_atomic_fetch_add(p, v, __ATOMIC_RELAXED, __HIP_MEMORY_SCOPE_AGENT); }
__device__ __forceinline__ unsigned xb_xcc_id() { return (unsigned)__builtin_amdgcn_s_getreg((3 << 11) | 20) & 0xFu; }
#define XB_SPIN(cond, bar) do { unsigned _sp = 0; while (cond) { __builtin_amdgcn_s_sleep(1); \
    if ((++_sp & 255u) == 0u) { if (xb_ld(&(bar)[XB_TMO])) break; if (_sp > XB_SPIN_CAP) { atomicAdd(&(bar)[XB_TMO], 1u); break; } } } } while (0)
struct XcdBarrier { unsigned* bar; unsigned x; volatile LAS unsigned* st; };
__device__ __forceinline__ XcdBarrier xcd_barrier_post(unsigned* bar, volatile LAS unsigned* st) {
    XcdBarrier b; b.bar = bar; b.x = xb_xcc_id(); b.st = st;
    if (threadIdx.x == 0) (void)xb_add(&bar[XB_XCNT(b.x)], 1u);
    return b;
}
__device__ __forceinline__ void xcd_barrier_complete(unsigned* bar, unsigned x, unsigned& nloc, unsigned& nx) {
    const unsigned G = gridDim.x * gridDim.y * gridDim.z;
    unsigned sum, cnt, mine, sp = 0u;
    for (;;) {
        sum = 0u; cnt = 0u; mine = 0u;
#pragma unroll
        for (unsigned j = 0; j < 16; ++j) { const unsigned c = xb_ld(&bar[XB_XCNT(j)]); sum += c; cnt += (c > 0u) ? 1u : 0u; mine = (j == x) ? c : mine; }
        if (sum == G) break;
        __builtin_amdgcn_s_sleep(1);
        if ((++sp & 255u) == 0u) { if (xb_ld(&bar[XB_TMO])) break; if (sp > XB_SPIN_CAP) { atomicAdd(&bar[XB_TMO], 1u); break; } }
    }
    nloc = mine > 0u ? mine : 1u; nx = cnt > 0u ? cnt : 1u;
}
__device__ __forceinline__ void xcd_barrier(const XcdBarrier& b) {
    asm volatile("s_waitcnt vmcnt(0)" ::: "memory");
    __syncthreads();
    if (threadIdx.x == 0) {
        unsigned* bar = b.bar;
        __builtin_amdgcn_s_waitcnt(0);
        unsigned nloc = b.st[0], nx = b.st[1];
        if (nloc == 0u) { xcd_barrier_complete(bar, b.x, nloc, nx); b.st[0] = nloc; b.st[1] = nx; }
        const unsigned old = xb_add(&bar[XB_XSUB(b.x)], 1u);
        const unsigned gen = old / nloc;
        if (old + 1u == (gen + 1u) * nloc) {
            __builtin_amdgcn_fence(__ATOMIC_RELEASE, "agent");
            asm volatile("s_waitcnt vmcnt(0)" ::: "memory");
            const unsigned og = xb_add(&bar[XB_TOP], 1u);
            const unsigned tg = og / nx;
            if (og + 1u == (tg + 1u) * nx) xb_add(&bar[XB_TOPGEN], 1u);
            else XB_SPIN(xb_ld(&bar[XB_TOPGEN]) == tg, bar);
            __builtin_amdgcn_fence(__ATOMIC_ACQUIRE, "agent");
            xb_add(&bar[XB_XGEN(b.x)], 1u);
            asm volatile("s_waitcnt vmcnt(0)" ::: "memory");
        } else {
            XB_SPIN(xb_ld(&bar[XB_XGEN(b.x)]) == gen, bar);
            __builtin_amdgcn_fence(__ATOMIC_ACQUIRE, "agent");
            asm volatile("s_waitcnt vmcnt(0)" ::: "memory");
        }
    }
    __syncthreads();
}

namespace pg8 {
constexpr int BM = 256, BK = 64, HALF = 128, HTB = HALF * BK * 2, STAGE_BYTES = 8 * HTB;
__host__ __device__ __forceinline__ int lds_byte(int r, int c) { const int st = (r >> 4) * 2 + (c >> 5), rr = r & 15, cc = c & 31, ob = rr * 64 + cc * 2; return st * 1024 + (ob ^ (((ob >> 9) & 1) << 5)); }
__host__ __device__ __forceinline__ void stage_rc(int b, int& R, int& C) { const int st = b / 1024, sb = b % 1024, swz = sb ^ (((sb >> 9) & 1) << 5); R = (st >> 1) * 16 + swz / 64; C = (st & 1) * 32 + (swz % 64) / 2; }
__host__ __device__ __forceinline__ int perm32(int rho) { const int n = rho >> 4, i = rho & 15; return 8 * (i >> 2) + 4 * n + (i & 3); }
struct Unit { int pm, pn, e; };
__device__ __forceinline__ unsigned cvt_pk_bf16(float lo, float hi) { unsigned r; asm volatile("v_cvt_pk_bf16_f32 %0, %1, %2" : "=v"(r) : "v"(lo), "v"(hi)); return r; }

typedef int v8i32 __attribute__((ext_vector_type(8)));
static_assert(FP8_G2_L0 && FP8_G2_L1, "the combine phases read the expert outputs as e4m3 bytes, which only the fp8 down GEMM writes");
typedef int v4i32 __attribute__((ext_vector_type(4)));
__device__ __forceinline__ v8i32 cat16(const bf16x8 lo, const bf16x8 hi) { return __builtin_shufflevector(__builtin_bit_cast(v4i32, lo), __builtin_bit_cast(v4i32, hi), 0, 1, 2, 3, 4, 5, 6, 7); }
template <class Epi, class Sched, bool FP8 = false>
__device__ __forceinline__ void gemm_phase(LAS unsigned char* lds, const int K, const Sched& S, const Epi& E) {
    const int tid = threadIdx.x, wid = __builtin_amdgcn_readfirstlane(tid >> 6), lane = tid & 63, wr = wid >> 2, wc = wid & 3, fr = lane & 15, fq = lane >> 4;
    const int nt = K / BK;
    int tidv = tid;
#define PG8_VB(i) ([&]() -> unsigned { int R_, C_; stage_rc(tidv * 16 + (i) * 8192, R_, C_); const int Rb_ = Epi::PERM ? ((R_ & ~31) + perm32(R_ & 31)) : R_; return (unsigned)(Rb_ * K + C_) * 2u; }())
#define PG8_VA(h, i) ([&]() -> unsigned { int R_, C_; stage_rc(tidv * 16 + (i) * 8192, R_, C_); return (unsigned)((128 * (h) + R_) * K + C_) * 2u; }())
    const size_t kstep = (size_t)(BK * 2);
    const size_t hstep = (size_t)HALF * K * 2;
    const unsigned ldsw = (unsigned)wid * 1024u;
#define aoff (lds_byte(wr * 64 + (tidv & 15), ((tidv >> 4) & 3) * 8))
#define boff (lds_byte(wc * 32 + (tidv & 15), ((tidv >> 4) & 3) * 8))
#define PG8_SA(b, h) (((b) * 2 + (h)) * HTB)
#define PG8_SB(b, h) ((4 + (b) * 2 + (h)) * HTB)
#define PG8_STAGEB(bufoff, gbase) do { _Pragma("unroll") for (int _i = 0; _i < 2; ++_i) \
        __builtin_amdgcn_global_load_lds((const unsigned*)((const char*)(gbase) + PG8_VB(_i)), (LAS unsigned*)(lds + (bufoff) + ldsw + _i * 8192), 16, 0, 0); } while (0)
#define PG8_STAGEA(bufoff, gbase, h, NEXT) do { _Pragma("unroll") for (int _i = 0; _i < 2; ++_i) { unsigned vo_; \
        if constexpr (Sched::GATHER) { int R_, C_; stage_rc(tidv * 16 + _i * 8192, R_, C_); const unsigned raw_ = gidx[((((NEXT) && usen) ? (gslot ^ 1u) : gslot) * 4u + (h) * 2 + _i) * 512u + tid]; vo_ = (raw_ * (unsigned)K + (unsigned)C_) * 2u; } \
        else vo_ = PG8_VA(h, _i); \
        __builtin_amdgcn_global_load_lds((const unsigned*)((const char*)(gbase) + vo_), (LAS unsigned*)(lds + (bufoff) + ldsw + _i * 8192), 16, 0, 0); } } while (0)
#define PG8_LDA(dst, b, h) do { _Pragma("unroll") for (int m = 0; m < 4; ++m) _Pragma("unroll") for (int k = 0; k < 2; ++k) dst[m][k] = *(const LAS bf16x8*)(lds + PG8_SA(b, h) + aoff + m * 2048 + k * 1024); } while (0)
#define PG8_LDB(dst, b, h) do { _Pragma("unroll") for (int n = 0; n < 2; ++n) _Pragma("unroll") for (int k = 0; k < 2; ++k) dst[n][k] = *(const LAS bf16x8*)(lds + PG8_SB(b, h) + boff + n * 2048 + k * 1024); } while (0)
#define PG8_MMA(ai, bj, At, Bt) do { __builtin_amdgcn_s_setprio(1); _Pragma("unroll") for (int m = 0; m < 4; ++m) _Pragma("unroll") for (int n = 0; n < 2; ++n) { \
        if constexpr (FP8) acc[ai][bj][m][n] = __builtin_amdgcn_mfma_scale_f32_16x16x128_f8f6f4(cat16(Bt[n][0], Bt[n][1]), cat16(At[m][0], At[m][1]), acc[ai][bj][m][n], 0, 0, 0, 0x7f7f7f7f, 0, 0x7f7f7f7f); \
        else { _Pragma("unroll") for (int k = 0; k < 2; ++k) acc[ai][bj][m][n] = __builtin_amdgcn_mfma_f32_16x16x32_bf16(Bt[n][k], At[m][k], acc[ai][bj][m][n], 0, 0, 0); } } \
        __builtin_amdgcn_s_setprio(0); } while (0)
#define PG8_WAIT_V(n) asm volatile("s_waitcnt vmcnt(" #n ")" ::: "memory")
#define PG8_WAIT_L(n) asm volatile("s_waitcnt lgkmcnt(" #n ")" ::: "memory")
#define PG8_BAR __builtin_amdgcn_s_barrier()
#define PG8_SCHED __builtin_amdgcn_sched_barrier(0)
#define PG8_ITER(A1, A2, A3, B2, B3) do { \
            PG8_LDB(B0, 0, 0); PG8_LDB(B1, 0, 1); PG8_SCHED; PG8_LDA(At, 0, 0); PG8_STAGEA(PG8_SA(1, 1), A1, 1, 0); \
            PG8_WAIT_V(8); PG8_WAIT_L(0); PG8_BAR; PG8_MMA(0, 0, At, B0); PG8_MMA(0, 1, At, B1); PG8_BAR; PG8_SCHED; \
            PG8_LDA(At, 0, 1); PG8_STAGEB(PG8_SB(0, 0), B2); PG8_STAGEB(PG8_SB(0, 1), (B2) + hstep); PG8_STAGEA(PG8_SA(0, 0), A2, 0, 1); \
            PG8_WAIT_V(8); PG8_WAIT_L(0); PG8_BAR; PG8_MMA(1, 0, At, B0); PG8_MMA(1, 1, At, B1); PG8_BAR; PG8_SCHED; \
            PG8_LDB(B0, 1, 0); PG8_LDB(B1, 1, 1); PG8_SCHED; PG8_LDA(At, 1, 0); PG8_STAGEA(PG8_SA(0, 1), A2, 1, 1); \
            PG8_WAIT_V(8); PG8_WAIT_L(0); PG8_BAR; PG8_MMA(0, 0, At, B0); PG8_MMA(0, 1, At, B1); PG8_BAR; PG8_SCHED; \
            PG8_LDA(At, 1, 1); PG8_STAGEB(PG8_SB(1, 0), B3); PG8_STAGEB(PG8_SB(1, 1), (B3) + hstep); PG8_STAGEA(PG8_SA(1, 0), A3, 0, 1); \
            PG8_WAIT_V(8); PG8_WAIT_L(0); PG8_BAR; PG8_MMA(1, 0, At, B0); PG8_MMA(1, 1, At, B1); PG8_BAR; PG8_SCHED; } while (0)
    Unit cur, nxt; int ui = 0;
    if (!S.next(0, cur)) return;
    f32x4 acc[2][2][4][2];
#pragma unroll
    for (int a = 0; a < 2; ++a)
#pragma unroll
        for (int b = 0; b < 2; ++b)
#pragma unroll
            for (int m = 0; m < 4; ++m)
#pragma unroll
                for (int n = 0; n < 2; ++n) acc[a][b][m][n] = (f32x4){0.f, 0.f, 0.f, 0.f};
    bf16x8 At[4][2], B0[2][2], B1[2][2];
    const LAS unsigned* gidx = (const LAS unsigned*)(lds + LDS_GIDX); unsigned gslot = 0u;
    if constexpr (Sched::GATHER) { S.idx_dma(cur, (LAS unsigned*)(lds + LDS_GIDX), tidv, wid); asm volatile("s_waitcnt vmcnt(0)" ::: "memory"); }
    const char* cA = S.a_base(cur); const char* cB = S.b_base(cur);
    constexpr bool usen = false;
    PG8_STAGEB(PG8_SB(0, 0), cB); PG8_STAGEB(PG8_SB(0, 1), cB + hstep); PG8_STAGEA(PG8_SA(0, 0), cA, 0, 0); PG8_STAGEA(PG8_SA(0, 1), cA, 1, 0);
    if (wr == 1) PG8_BAR;
    PG8_WAIT_V(2); PG8_BAR;
    PG8_STAGEB(PG8_SB(1, 0), cB + kstep); PG8_STAGEA(PG8_SA(1, 0), cA + kstep, 0, 0); PG8_STAGEB(PG8_SB(1, 1), cB + hstep + kstep);
    PG8_WAIT_V(6); PG8_BAR;
    for (;;) {
        const bool has_next = S.next(ui + 1, nxt);
        const char* nA = has_next ? S.a_base(nxt) : cA; const char* nB = has_next ? S.b_base(nxt) : cB;
#pragma unroll 1
        for (int t = 0; t < nt; t += 2) {
            const bool last = (t == nt - 2);
            const char* a1 = cA + (size_t)(t + 1) * kstep;
            const char* a2 = last ? nA : cA + (size_t)(t + 2) * kstep; const char* b2 = last ? nB : cB + (size_t)(t + 2) * kstep;
            tidv = tid; asm volatile("" : "+v"(tidv));
            if constexpr (Sched::GATHER) {
                if (t == nt - 4 && has_next) S.idx_dma(nxt, (LAS unsigned*)(lds + LDS_GIDX) + (gslot ^ 1u) * 2048u, tidv, wid);
            }
            const bool usen = last && has_next;
            PG8_ITER(a1, a2, a2 + kstep, b2, b2 + kstep);
        }
        if (wr == 0) PG8_BAR;
        E(acc, cur, wr, wc, fr, fq);
        if (!has_next) break;
#pragma unroll
        for (int a = 0; a < 2; ++a)
#pragma unroll
            for (int b = 0; b < 2; ++b)
#pragma unroll
                for (int m = 0; m < 4; ++m)
#pragma unroll
                    for (int n = 0; n < 2; ++n) acc[a][b][m][n] = (f32x4){0.f, 0.f, 0.f, 0.f};
        cur = nxt; cA = nA; cB = nB; ++ui;
        if constexpr (Sched::GATHER) gslot ^= 1u;
        if (wr == 1) PG8_BAR;
    }
    PG8_WAIT_V(0);
    PG8_BAR;
#undef PG8_ITER
#undef aoff
#undef boff
#undef PG8_SA
#undef PG8_SB
#undef PG8_STAGEA
#undef PG8_STAGEB
#undef PG8_VA
#undef PG8_VB
#undef PG8_LDA
#undef PG8_LDB
#undef PG8_MMA
#undef PG8_WAIT_V
#undef PG8_WAIT_L
#undef PG8_BAR
#undef PG8_SCHED
}

struct SchedDense {
    static constexpr bool GATHER = false;
    const char* A; const char* Bt; int K, nN, nMfull, pnx, nUnits, c, G;
    __device__ __forceinline__ bool next(int i, Unit& u) const {
        const int L = i * G + c; if (L >= nUnits) return false;
        const int full = nMfull * nN;
        if (L < full) { u.pm = L / nN; u.pn = L - u.pm * nN; } else { u.pm = nMfull + (L - full); u.pn = pnx; }
        u.e = 0; return true;
    }
    __device__ __forceinline__ const char* a_base(const Unit& u) const { return A + (size_t)u.pm * 256 * K * 2; }
    __device__ __forceinline__ const char* b_base(const Unit& u) const { return Bt + (size_t)u.pn * 256 * K * 2; }
};
struct SchedSplit {
    static constexpr bool GATHER = false;
    const char* A; const char* Bt; int K, base, stride, n;
    __device__ __forceinline__ bool next(int i, Unit& u) const {
        if (i >= n) return false;
        const int L = base + i * stride; u.pm = L >> 2; u.pn = L & 3; u.e = 0; return true;
    }
    __device__ __forceinline__ const char* a_base(const Unit& u) const { return A + (size_t)u.pm * 256 * K * 2; }
    __device__ __forceinline__ const char* b_base(const Unit& u) const { return Bt + (size_t)u.pn * 256 * K * 2; }
};
template <bool GATHER_> struct SchedMoe {
    static constexpr bool GATHER = GATHER_, gather = GATHER_;
    const char* A; const char* W; const int* tokmap; const LAS int* tb; const LAS int* cn; int K; size_t wstride; int nUnits, c, G;
    __device__ __forceinline__ bool next(int i, Unit& u) const {
        const int L = i * G + c; if (L >= nUnits) return false;
        u.pm = L >> 2; u.pn = L & 3; int e = 0;
#pragma unroll
        for (int q = 1; q < 16; ++q) if (u.pm >= __builtin_amdgcn_readfirstlane(tb[q])) e = q;
        u.e = __builtin_amdgcn_readfirstlane(e); return true;
    }
    __device__ __forceinline__ const char* a_base(const Unit& u) const { return gather ? A : A + (size_t)u.pm * 256 * K * 2; }
    __device__ __forceinline__ const char* b_base(const Unit& u) const { return W + (size_t)u.e * wstride + (size_t)u.pn * 256 * K * 2; }
    __device__ __forceinline__ void idx_dma(const Unit& u, LAS unsigned* slot, int tidv, int wid) const {
        const int p0 = (u.pm - __builtin_amdgcn_readfirstlane(tb[u.e])) * 256, last = __builtin_amdgcn_readfirstlane(cn[u.e]) - 1; const int* tm = tokmap + (size_t)u.e * T;
#pragma unroll
        for (int h = 0; h < 2; ++h)
#pragma unroll
            for (int i = 0; i < 2; ++i) { int R_, C_; stage_rc(tidv * 16 + i * 8192, R_, C_); int pos = p0 + 128 * h + R_; pos = pos < last ? pos : last;
                __builtin_amdgcn_global_load_lds((const unsigned*)(tm + pos), slot + (h * 2 + i) * 512 + wid * 64, 4, 0, 0); }
    }
};

struct EpiStore {
    static constexpr bool PERM = true;
    bf16* O; int ldc;
    __device__ __forceinline__ void operator()(const f32x4 (&acc)[2][2][4][2], const Unit& u, int wr, int wc, int fr, int fq) const {
        const int row0 = u.pm * BM + wr * 64 + fr, col0 = u.pn * BM + wc * 32 + 8 * fq;
#pragma unroll
        for (int ai = 0; ai < 2; ++ai)
#pragma unroll
            for (int m = 0; m < 4; ++m) { bf16* rowp = O + (size_t)(row0 + ai * HALF + m * 16) * ldc + col0;
#pragma unroll
                for (int bj = 0; bj < 2; ++bj) { const f32x4 v0 = acc[ai][bj][m][0], v1 = acc[ai][bj][m][1];
                    u32x4 w; w.x = cvt_pk_bf16(v0[0], v0[1]); w.y = cvt_pk_bf16(v0[2], v0[3]); w.z = cvt_pk_bf16(v1[0], v1[1]); w.w = cvt_pk_bf16(v1[2], v1[3]);
                    *(u32x4*)(rowp + bj * HALF) = w; } }
    }
};
template <bool SRC_F32> struct EpiResid {
    static constexpr bool PERM = true;
    const float* srcL; const float* srcC; bf16* H; const float* gate;
    float ascale = 1.0f;
    __device__ __forceinline__ void operator()(const f32x4 (&acc)[2][2][4][2], const Unit& u, int wr, int wc, int fr, int fq) const {
        const float* g = gate + (u.pm < 128 ? (u.pm >> 4) : 8) * 6144;
        const float* src = (u.pm < 128) ? srcL + (size_t)u.pm * 256 * 1024 : srcC + (size_t)(u.pm - 128) * 256 * 1024;
        bf16* dst = H + (size_t)u.pm * 256 * 1024;
        int frv = fr; asm volatile("" : "+v"(frv));
        const int row0 = wr * 64 + frv, col0 = u.pn * BM + wc * 32 + 8 * fq;
#pragma unroll
        for (int bj = 0; bj < 2; ++bj) {
            const f32x4 gv0 = *(const f32x4*)(g + col0 + bj * HALF) * ascale, gv1 = *(const f32x4*)(g + col0 + bj * HALF + 4) * ascale;
#pragma unroll
            for (int ai = 0; ai < 2; ++ai)
#pragma unroll
                for (int m = 0; m < 4; ++m) { const unsigned ro = (unsigned)(row0 + ai * HALF + m * 16) * 1024u + (unsigned)col0;
                    f32x4 s0, s1;
                    if constexpr (SRC_F32) { s0 = __builtin_nontemporal_load((const f32x4*)(src + ro + bj * HALF)); s1 = __builtin_nontemporal_load((const f32x4*)(src + ro + bj * HALF + 4)); }
                    else { const u32x4 hv = *(const u32x4*)(dst + ro + bj * HALF); s0 = (f32x4){bflo(hv.x), bfhi(hv.x), bflo(hv.y), bfhi(hv.y)}; s1 = (f32x4){bflo(hv.z), bfhi(hv.z), bflo(hv.w), bfhi(hv.w)}; }
                    const f32x4 v0 = s0 + gv0 * acc[ai][bj][m][0], v1 = s1 + gv1 * acc[ai][bj][m][1];
                    u32x4 w; w.x = cvt_pk_bf16(v0[0], v0[1]); w.y = cvt_pk_bf16(v0[2], v0[3]); w.z = cvt_pk_bf16(v1[0], v1[1]); w.w = cvt_pk_bf16(v1[2], v1[3]);
                    *(u32x4*)(dst + ro + bj * HALF) = w; }
        }
    }
};
__device__ __forceinline__ float silu_f(float x) { return x * __builtin_amdgcn_rcpf(1.0f + __expf(-x)); }
struct EpiSwiglu {
    static constexpr bool PERM = true;
    bf16* H;
    __device__ __forceinline__ void operator()(const f32x4 (&acc)[2][2][4][2], const Unit& u, int wr, int wc, int fr, int fq) const {
        const int row0 = u.pm * BM + wr * 64 + fr, col0 = u.pn * 128 + wc * 32 + 8 * fq;
#pragma unroll
        for (int ai = 0; ai < 2; ++ai)
#pragma unroll
            for (int m = 0; m < 4; ++m) { bf16* p = H + (size_t)(row0 + ai * HALF + m * 16) * 512 + col0;
                const f32x4 g0 = acc[ai][0][m][0], g1 = acc[ai][0][m][1], u0 = acc[ai][1][m][0], u1 = acc[ai][1][m][1];
                u32x4 w; w.x = cvt_pk_bf16(silu_f(g0[0]) * u0[0], silu_f(g0[1]) * u0[1]); w.y = cvt_pk_bf16(silu_f(g0[2]) * u0[2], silu_f(g0[3]) * u0[3]);
                w.z = cvt_pk_bf16(silu_f(g1[0]) * u1[0], silu_f(g1[1]) * u1[1]); w.w = cvt_pk_bf16(silu_f(g1[2]) * u1[2], silu_f(g1[3]) * u1[3]);
                *(u32x4*)p = w; }
    }
};
__device__ __forceinline__ unsigned pk4_fp8(float a, float b, float c, float d) { int p = __builtin_amdgcn_cvt_pk_fp8_f32(a, b, 0, false); p = __builtin_amdgcn_cvt_pk_fp8_f32(c, d, p, true); return (unsigned)p; }
constexpr float W1_SCALE = 32.0f, W2_SCALE = 16.0f, HID_SCALE = 4.0f;
struct EpiSwiglu8 {
    static constexpr bool PERM = true;
    unsigned char* H; float in_scale;
    __device__ __forceinline__ void operator()(const f32x4 (&acc)[2][2][4][2], const Unit& u, int wr, int wc, int fr, int fq) const {
        const int row0 = u.pm * BM + wr * 64 + fr, col0 = u.pn * 128 + wc * 32 + 8 * fq;
        const float IS = 1.0f / in_scale, OS = HID_SCALE / in_scale;
#pragma unroll
        for (int ai = 0; ai < 2; ++ai)
#pragma unroll
            for (int m = 0; m < 4; ++m) { unsigned char* p = H + (size_t)(row0 + ai * HALF + m * 16) * 512 + col0;
                const f32x4 g0 = acc[ai][0][m][0] * IS, g1 = acc[ai][0][m][1] * IS, u0 = acc[ai][1][m][0] * OS, u1 = acc[ai][1][m][1] * OS;
#define HC8(x) __builtin_fminf(__builtin_fmaxf((x), -448.0f), 448.0f)
                u32x2 w; w.x = pk4_fp8(HC8(silu_f(g0[0]) * u0[0]), HC8(silu_f(g0[1]) * u0[1]), HC8(silu_f(g0[2]) * u0[2]), HC8(silu_f(g0[3]) * u0[3]));
                w.y = pk4_fp8(HC8(silu_f(g1[0]) * u1[0]), HC8(silu_f(g1[1]) * u1[1]), HC8(silu_f(g1[2]) * u1[2]), HC8(silu_f(g1[3]) * u1[3]));
#undef HC8
                *(u32x2*)p = w; }
    }
};
constexpr float MIX0_SCALE = 4.0f;
constexpr float MIX1_SCALE = 4.0f;
constexpr float OS_SCALE = 16.0f;
struct EpiStoreF8 {
    static constexpr bool PERM = true;
    unsigned char* O; int ldc; float scale;
    __device__ __forceinline__ void operator()(const f32x4 (&acc)[2][2][4][2], const Unit& u, int wr, int wc, int fr, int fq) const {
        const int row0 = u.pm * BM + wr * 64 + fr, col0 = u.pn * BM + wc * 32 + 8 * fq;
#pragma unroll
        for (int ai = 0; ai < 2; ++ai)
#pragma unroll
            for (int m = 0; m < 4; ++m) { unsigned char* rowp = O + (size_t)(row0 + ai * HALF + m * 16) * ldc + col0;
#pragma unroll
                for (int bj = 0; bj < 2; ++bj) { const f32x4 v0 = acc[ai][bj][m][0] * scale, v1 = acc[ai][bj][m][1] * scale;
#define HC8(x) __builtin_fminf(__builtin_fmaxf((x), -448.0f), 448.0f)
                    u32x2 w; w.x = pk4_fp8(HC8(v0[0]), HC8(v0[1]), HC8(v0[2]), HC8(v0[3])); w.y = pk4_fp8(HC8(v1[0]), HC8(v1[1]), HC8(v1[2]), HC8(v1[3]));
#undef HC8
                    *(u32x2*)(rowp + bj * HALF) = w; } }
    }
};
struct EpiStoreS {
    static constexpr bool PERM = true;
    bf16* O; int ldc; float scale;
    __device__ __forceinline__ void operator()(const f32x4 (&acc)[2][2][4][2], const Unit& u, int wr, int wc, int fr, int fq) const {
        const int row0 = u.pm * BM + wr * 64 + fr, col0 = u.pn * BM + wc * 32 + 8 * fq;
#pragma unroll
        for (int ai = 0; ai < 2; ++ai)
#pragma unroll
            for (int m = 0; m < 4; ++m) { bf16* rowp = O + (size_t)(row0 + ai * HALF + m * 16) * ldc + col0;
#pragma unroll
                for (int bj = 0; bj < 2; ++bj) { const f32x4 v0 = acc[ai][bj][m][0] * scale, v1 = acc[ai][bj][m][1] * scale;
                    u32x4 w; w.x = cvt_pk_bf16(v0[0], v0[1]); w.y = cvt_pk_bf16(v0[2], v0[3]); w.z = cvt_pk_bf16(v1[0], v1[1]); w.w = cvt_pk_bf16(v1[2], v1[3]);
                    *(u32x4*)(rowp + bj * HALF) = w; } }
    }
};
struct EpiScaleRow {
    static constexpr bool PERM = true;
    bf16* O; const float* wrow;
    __device__ __forceinline__ void operator()(const f32x4 (&acc)[2][2][4][2], const Unit& u, int wr, int wc, int fr, int fq) const {
        const int row0 = u.pm * BM + wr * 64 + fr, col0 = u.pn * BM + wc * 32 + 8 * fq;
#pragma unroll
        for (int ai = 0; ai < 2; ++ai)
#pragma unroll
            for (int m = 0; m < 4; ++m) { const int row = row0 + ai * HALF + m * 16; const float s = wrow[row]; bf16* rowp = O + (size_t)row * 1024 + col0;
#pragma unroll
                for (int bj = 0; bj < 2; ++bj) { const f32x4 v0 = acc[ai][bj][m][0] * s, v1 = acc[ai][bj][m][1] * s;
                    u32x4 w; w.x = cvt_pk_bf16(v0[0], v0[1]); w.y = cvt_pk_bf16(v0[2], v0[3]); w.z = cvt_pk_bf16(v1[0], v1[1]); w.w = cvt_pk_bf16(v1[2], v1[3]);
                    *(u32x4*)(rowp + bj * HALF) = w; } }
    }
};
}

struct Args { const float* in[22]; float* out; unsigned char* ws; int ph_lo, ph_hi; };
enum { I_X = 0, I_C, I_CTX, I_CCTX, I_ADAW, I_ADAB, I_NMG, I_NFG, I_EWIN, I_ECONV, I_EWOUT, I_OWIN, I_OPOOLW, I_OPOOLS, I_OSINK, I_OWOUT, I_RW, I_RB, I_MG, I_MU, I_MD, I_FG };

struct Frame {
    LAS unsigned char* lds;
    int tid, lane, wave, vcu, G;
    unsigned char* ws; const float* const* in; float* out;
};
__device__ __forceinline__ bf16* h_row(const Frame& F, int t) { return (bf16*)(F.ws + WS_HB) + (size_t)t * D; }
__device__ __forceinline__ int mod_row(int t) { return t < TL ? (t >> 12) : 8; }

struct TItem { const float* src; bf16* dst; int ldw, ldd; float f8scale; };
__device__ __forceinline__ void titem_load(const TItem& t, f32x4 (&r)[8], int lane) {
#pragma unroll
    for (int i = 0; i < 8; ++i) r[i] = __builtin_nontemporal_load((const f32x4*)(t.src + (size_t)((lane >> 3) + 8 * i) * t.ldw + 4 * (lane & 7)));
}
__device__ __forceinline__ void titem_process(const TItem& t, const f32x4 (&r)[8], LAS float* scr, int lane) {
#pragma unroll
    for (int i = 0; i < 8; ++i) { LAS float* d = scr + ((lane >> 3) + 8 * i) * 33 + 4 * (lane & 7); d[0] = r[i].x; d[1] = r[i].y; d[2] = r[i].z; d[3] = r[i].w; }
    LDS_WAIT(); asm volatile("" ::: "memory");
    const int c = lane & 7;
    if (t.f8scale != 0.0f) {
        const float sc = t.f8scale; unsigned char* d8 = (unsigned char*)t.dst;
#pragma unroll
        for (int j = 0; j < 4; ++j) { const int n = (lane >> 3) + 8 * j; const LAS float* s = scr + (8 * c) * 33 + n;
            u32x2 o; o.x = pg8::pk4_fp8(s[0 * 33] * sc, s[1 * 33] * sc, s[2 * 33] * sc, s[3 * 33] * sc); o.y = pg8::pk4_fp8(s[4 * 33] * sc, s[5 * 33] * sc, s[6 * 33] * sc, s[7 * 33] * sc);
            *(u32x2*)(d8 + (size_t)n * t.ldd + 8 * c) = o; }
    } else {
#pragma unroll
        for (int j = 0; j < 4; ++j) { const int n = (lane >> 3) + 8 * j; const LAS float* s = scr + (8 * c) * 33 + n;
            u32x4 o; o.x = pk2(s[0 * 33], s[1 * 33]); o.y = pk2(s[2 * 33], s[3 * 33]); o.z = pk2(s[4 * 33], s[5 * 33]); o.w = pk2(s[6 * 33], s[7 * 33]);
            *(u32x4*)(t.dst + (size_t)n * t.ldd + 8 * c) = o; }
    }
    LDS_WAIT(); asm volatile("" ::: "memory");
}
constexpr int L0T_N = 32;
constexpr int TS0 = 1024, TS1 = 512, TS2 = 384, TS3 = 512, TS4 = 0, TS5 = 4096, TS6 = 4096, TS7 = 4096, TNITEMS = TS0 + TS1 + TS2 + TS3 + TS4 + TS5 + TS6 + TS7;
__device__ __forceinline__ TItem titem_moe(const float* const* in, unsigned char* ws, int kind, int le, int rr) {
    TItem t; const int layer = le >> 4, e = le & 15; const bool f8 = (kind < 2) ? (layer ? (FP8_G1_L1 != 0) : (FP8_G1_L0 != 0)) : (layer ? (FP8_G2_L1 != 0) : (FP8_G2_L0 != 0));
    if (kind < 2) { const int kb = (rr >> 4) & 15, nb = rr & 15, n0 = nb * 32; const int drow = (n0 >> 7) * 256 + (n0 & 127) + kind * 128;
        t.src = in[kind ? I_MU : I_MG] + (size_t)le * 524288 + (size_t)(kb * 64) * 512 + n0; t.ldw = 512;
        unsigned char* base = ws + WS_W_M1 + (size_t)layer * 32 * MiB;
        if (f8) { t.dst = (bf16*)(base + (size_t)e * MiB + (size_t)drow * 1024 + kb * 64); t.ldd = 1024; t.f8scale = pg8::W1_SCALE; }
        else { t.dst = (bf16*)(base + (size_t)e * 2 * MiB) + (size_t)drow * 1024 + kb * 64; t.ldd = 1024; t.f8scale = 0.0f; } }
    else { const int kb = (rr >> 5) & 7, nb = rr & 31;
        t.src = in[I_MD] + (size_t)le * 524288 + (size_t)(kb * 64) * 1024 + nb * 32; t.ldw = 1024;
        unsigned char* base = ws + WS_W_M2 + (size_t)layer * 16 * MiB;
        if (f8) { t.dst = (bf16*)(base + (size_t)e * 512 * KiB + (size_t)(nb * 32) * 512 + kb * 64); t.ldd = 512; t.f8scale = pg8::W2_SCALE; }
        else { t.dst = (bf16*)(base + (size_t)e * MiB) + (size_t)(nb * 32) * 512 + kb * 64; t.ldd = 512; t.f8scale = 0.0f; } }
    return t;
}
__device__ __forceinline__ TItem titem_decode(const float* const* in, unsigned char* ws, int r) {
    TItem t;
    if (r < TS0) { const int kb = r / 64, nb = r % 64; t.src = in[I_EWIN] + (size_t)(kb * 64) * 2048 + nb * 32; t.ldw = 2048; t.dst = (bf16*)(ws + WS_W_EIN) + (size_t)(nb * 32) * 1024 + kb * 64; t.ldd = 1024; t.f8scale = 0.0f; return t; } r -= TS0;
    if (r < TS1) { const int kb = r / 32, nb = r % 32; t.src = in[I_EWOUT] + (size_t)(kb * 64) * 1024 + nb * 32; t.ldw = 1024; if (FP8_OUT0) { t.dst = (bf16*)(ws + WS_W_EOUT + (size_t)(nb * 32) * 1024 + kb * 64); t.ldd = 1024; t.f8scale = pg8::W1_SCALE; } else { t.dst = (bf16*)(ws + WS_W_EOUT) + (size_t)(nb * 32) * 1024 + kb * 64; t.ldd = 1024; t.f8scale = 0.0f; } return t; } r -= TS1;
    if (r < TS2) { const int kb = r / 24, nb = 16 + r % 24; t.src = in[I_OWIN] + (size_t)(kb * 64) * 1280 + nb * 32; t.ldw = 1280; if (FP8_IN1) { t.dst = (bf16*)(ws + WS_W_OIN + (size_t)(nb * 32) * 1024 + kb * 64); t.ldd = 1024; t.f8scale = pg8::W1_SCALE; } else { t.dst = (bf16*)(ws + WS_W_OIN) + (size_t)(nb * 32) * 1024 + kb * 64; t.ldd = 1024; t.f8scale = 0.0f; } return t; } r -= TS2;
    if (r < TS3) { const int kb = r / 32, nb = r % 32; t.src = in[I_OWOUT] + (size_t)(kb * 64) * 1024 + nb * 32; t.ldw = 1024; if (FP8_OUT1) { t.dst = (bf16*)(ws + WS_W_OOUT + (size_t)(nb * 32) * 1024 + kb * 64); t.ldd = 1024; t.f8scale = pg8::W1_SCALE; } else { t.dst = (bf16*)(ws + WS_W_OOUT) + (size_t)(nb * 32) * 1024 + kb * 64; t.ldd = 1024; t.f8scale = 0.0f; } return t; } r -= TS3;
    r += 192 * L0T_N;
    if (r < TS5 + TS6 + TS7) return titem_moe(in, ws, r / 4096, (r % 4096) >> 8, r % 256);
    return t;
}
constexpr int NL1 = 12288;
__device__ __forceinline__ TItem titem_l1(const float* const* in, unsigned char* ws, int r) { return titem_moe(in, ws, r / 4096, 16 + ((r % 4096) >> 8), r % 256); }
__device__ __forceinline__ TItem titem_lx(const float* const* in, unsigned char* ws, int layer, int r) { return titem_moe(in, ws, r / 4096, layer * 16 + ((r % 4096) >> 8), r % 256); }

constexpr size_t WS_CONVCTR = 20 * KiB;
__device__ __forceinline__ void convert_l1(Frame& F, int quota) {
    unsigned* ctr = (unsigned*)(F.ws + WS_CONVCTR);
    LAS float* scr = (LAS float*)(F.lds + F.wave * 17408);
    for (int ch = 0; ch < quota; ++ch) {
        const int c0 = __builtin_amdgcn_readfirstlane(F.lane == 0 ? (int)__hip_atomic_fetch_add(ctr, 4u, __ATOMIC_RELAXED, __HIP_MEMORY_SCOPE_AGENT) : 0);
        if (c0 >= NL1) break;
        f32x4 cur[8], nxt[8];
        TItem tc = titem_l1(F.in, F.ws, c0);
        titem_load(tc, nxt, F.lane);
#pragma unroll 1
        for (int i = 0; i < 4; ++i) {
#pragma unroll
            for (int j = 0; j < 8; ++j) cur[j] = nxt[j];
            const TItem tcur = tc;
            if (i < 3) { tc = titem_l1(F.in, F.ws, c0 + i + 1); titem_load(tc, nxt, F.lane); }
            titem_process(tcur, cur, scr, F.lane);
        }
    }
}
__device__ __forceinline__ void convert_l1_range(Frame& F, const int base, const int cnt, const int ctr_off, const int layer = 1) {
    LAS unsigned* ctr = (LAS unsigned*)(F.lds + LDS_CTL + ctr_off);
    LAS float* scr = (LAS float*)(F.lds + F.wave * 17408);
    f32x4 cur[8], nxt[8];
    int it = __builtin_amdgcn_readfirstlane(F.lane == 0 ? (int)atomicAdd((unsigned*)ctr, 1u) : 0);
    TItem tc = titem_lx(F.in, F.ws, layer, base + (it < cnt ? it : 0));
    if (it < cnt) titem_load(tc, nxt, F.lane);
    while (it < cnt) {
#pragma unroll
        for (int i = 0; i < 8; ++i) cur[i] = nxt[i];
        const TItem tcur = tc;
        const int itn = __builtin_amdgcn_readfirstlane(F.lane == 0 ? (int)atomicAdd((unsigned*)ctr, 1u) : 0);
        if (itn < cnt) { tc = titem_lx(F.in, F.ws, layer, base + itn); titem_load(tc, nxt, F.lane); }
        titem_process(tcur, cur, scr, F.lane);
        it = itn;
    }
}
constexpr int L1T_N = 64, L1A_N = 18;
static_assert(120 * L1T_N + 256 * L1A_N == NL1, "layer-1 conversion split");
__device__ __forceinline__ void tail_fill(Frame& F, int nUnits, int quota) {
    const int rounds = (nUnits + F.G - 1) / F.G;
    if ((rounds - 1) * F.G + F.vcu >= nUnits) convert_l1(F, quota);
}

template <bool F8 = false>
__device__ __forceinline__ void norm_mod_store(const f32x4 (&v)[4], const float* g, const float* shift, const float* scale, bf16* orow, int lane) {
    float s2 = 0.f;
#pragma unroll
    for (int j = 0; j < 4; ++j) s2 += (v[j].x * v[j].x + v[j].y * v[j].y) + (v[j].z * v[j].z + v[j].w * v[j].w);
    const float rstd = 1.0f / sqrtf(wave_sum(s2) * (1.0f / D) + EPS);
#pragma unroll
    for (int j = 0; j < 4; ++j) { const int c = 4 * lane + 256 * j;
        const f32x4 gg = *(const f32x4*)(g + c), sh = *(const f32x4*)(shift + c), sc = *(const f32x4*)(scale + c);
        const f32x4 y = v[j] * rstd * gg * (sc + 1.0f) + sh;
        if constexpr (F8) { *(unsigned*)((unsigned char*)orow + c) = pg8::pk4_fp8(__builtin_fminf(__builtin_fmaxf(y.x, -448.0f), 448.0f), __builtin_fminf(__builtin_fmaxf(y.y, -448.0f), 448.0f), __builtin_fminf(__builtin_fmaxf(y.z, -448.0f), 448.0f), __builtin_fminf(__builtin_fmaxf(y.w, -448.0f), 448.0f)); }
        else { u32x2 o; o.x = pk2(y.x, y.y); o.y = pk2(y.z, y.w);
        *(u32x2*)(orow + c) = o; } }
}

template <int NQ> __device__ __forceinline__ void p1_tokens(Frame& F, int t) {
    const float* mods = (const float*)(F.ws + WS_MODS);
    bf16* A = (bf16*)(F.ws + WS_BUFA);
    f32x4 v[NQ][4];
#pragma unroll
    for (int q = 0; q < NQ; ++q) { const int tq = t + q; const float* xr = tq < TL ? F.in[I_X] + (size_t)tq * D : F.in[I_CTX] + (size_t)(tq - TL) * D;
#pragma unroll
        for (int j = 0; j < 4; ++j) v[q][j] = __builtin_nontemporal_load((const f32x4*)(xr + 4 * F.lane + 256 * j)); }
    const float* m = mods + (size_t)mod_row(t) * 6144;
#pragma unroll
    for (int q = 0; q < NQ; ++q) norm_mod_store(v[q], F.in[I_NMG], m, m + 1024, A + (size_t)(t + q) * D, F.lane);
}
__device__ __forceinline__ void phase_mods(Frame& F) {
    const float* const* in = F.in;
    LAS float* S = (LAS float*)F.lds;
    LAS float* red = S + 9 * 1024;
    for (int i = F.tid; i < 9 * 1024; i += 512) { const float v = (i < 8192) ? in[I_C][i] : in[I_CCTX][i - 8192]; S[i] = v / (1.0f + expf(-v)); }
    __syncthreads();
    const int bx = blockIdx.x, layer = bx >> 7, col0 = (bx & 127) * 48;
    const int j = F.tid % 12, rg = F.tid / 12;
    if (rg < 42) {
        const float* W = in[I_ADAW] + (size_t)layer * 1024 * 6144 + col0 + 4 * j;
        f32x4 w[25];
#pragma unroll
        for (int i = 0; i < 25; ++i) { const int k = rg + 42 * i; w[i] = (k < 1024) ? __builtin_nontemporal_load((const f32x4*)(W + (size_t)k * 6144)) : (f32x4){0.f, 0.f, 0.f, 0.f}; }
        f32x4 acc[9];
#pragma unroll
        for (int r = 0; r < 9; ++r) acc[r] = (f32x4){0.f, 0.f, 0.f, 0.f};
#pragma unroll
        for (int i = 0; i < 25; ++i) { const int k = min(rg + 42 * i, 1023);
#pragma unroll
            for (int r = 0; r < 9; ++r) acc[r] += w[i] * S[r * 1024 + k]; }
#pragma unroll
        for (int r = 0; r < 9; ++r) *(LAS f32x4*)(red + (rg * 9 + r) * 48 + 4 * j) = acc[r];
    }
    __syncthreads();
    for (int i = F.tid; i < 432; i += 512) { const int r = i / 48, c = i % 48; float sum = in[I_ADAB][layer * 6144 + col0 + c];
        for (int g = 0; g < 42; ++g) sum += red[(g * 9 + r) * 48 + c];
        __hip_atomic_store((unsigned*)(F.ws + WS_MODS) + (layer * 9 + r) * 6144 + col0 + c, __builtin_bit_cast(unsigned, sum), __ATOMIC_RELAXED, __HIP_MEMORY_SCOPE_AGENT); }
    asm volatile("s_waitcnt vmcnt(0)" ::: "memory");
    __syncthreads();
    if (F.tid == 0) __hip_atomic_fetch_add((unsigned*)(F.ws + WS_MODSDONE), 1u, __ATOMIC_RELAXED, __HIP_MEMORY_SCOPE_AGENT);
}
__device__ __forceinline__ void mods_wait(Frame& F) {
    if (F.tid < 64) {
        unsigned* cnt = (unsigned*)(F.ws + WS_MODSDONE); unsigned spins = 0;
        while ((unsigned)__builtin_amdgcn_readfirstlane(__hip_atomic_load(cnt, __ATOMIC_RELAXED, __HIP_MEMORY_SCOPE_AGENT)) < (unsigned)F.G) {
            __builtin_amdgcn_s_sleep(2); if (++spins > (1u << 22)) break; }
        __builtin_amdgcn_fence(__ATOMIC_ACQUIRE, "agent");
        asm volatile("s_waitcnt vmcnt(0)" ::: "memory");
    }
    __syncthreads();
}

__device__ __forceinline__ void ctr_publish(Frame& F, size_t off, int slot, unsigned nx) {
    asm volatile("s_waitcnt vmcnt(0)" ::: "memory");
    __syncthreads();
    if (F.tid == 0) {
        unsigned* top = (unsigned*)(F.ws + off);
        if (nx == 0u) { __builtin_amdgcn_fence(__ATOMIC_RELEASE, "agent"); asm volatile("s_waitcnt vmcnt(0)" ::: "memory"); __hip_atomic_fetch_add(top, 1u, __ATOMIC_RELAXED, __HIP_MEMORY_SCOPE_AGENT); }
        else {
            unsigned* xw = (unsigned*)(F.ws + WS_XARR) + ((size_t)slot * 16 + xb_xcc_id()) * 64;
            const unsigned old = __hip_atomic_fetch_add(xw, 1u, __ATOMIC_RELAXED, __HIP_MEMORY_SCOPE_AGENT);
            if (old + 1u == nx) { __builtin_amdgcn_fence(__ATOMIC_RELEASE, "agent"); asm volatile("s_waitcnt vmcnt(0)" ::: "memory"); __hip_atomic_fetch_add(top, nx, __ATOMIC_RELAXED, __HIP_MEMORY_SCOPE_AGENT); }
        }
    }
}
__device__ __forceinline__ void ctr_wait(Frame& F, size_t off, unsigned need) {
    if (F.tid < 64) {
        unsigned* cnt = (unsigned*)(F.ws + off); unsigned spins = 0;
        while ((unsigned)__builtin_amdgcn_readfirstlane(__hip_atomic_load(cnt, __ATOMIC_RELAXED, __HIP_MEMORY_SCOPE_AGENT)) < need) {
            __builtin_amdgcn_s_sleep(2); if (++spins > (1u << 22)) break; }
        __builtin_amdgcn_fence(__ATOMIC_ACQUIRE, "agent");
        asm volatile("s_waitcnt vmcnt(0)" ::: "memory");
    }
    __syncthreads();
}

template <class P> __device__ __forceinline__ unsigned xcd_census(const Frame& F, P pred) {
    if (__builtin_amdgcn_readfirstlane(*(const LAS int*)(F.lds + LDS_CTL + 52)) == 0) return 0u;
    const unsigned myx = xb_xcc_id();
    unsigned c = 0;
#pragma unroll
    for (int k = 0; k < 4; ++k) { const int v = F.lane + 64 * k; const unsigned x = (unsigned)ld_coh((const int*)(F.ws + WS_XCDOF) + v);
        c += (unsigned)__builtin_popcountll(__builtin_amdgcn_ballot_w64(x == myx && pred(v))); }
    return c;
}

__device__ __forceinline__ void phase_prologue_a(Frame& F) {
    const float* const* in = F.in;
    unsigned char* ws = F.ws;
    LAS float* ldsf = (LAS float*)F.lds;
    phase_mods(F);
    __syncthreads();
    {
        const int gt = blockIdx.x * 512 + F.tid, NT = F.G * 512;
        float* rope = (float*)(ws + WS_ROPE);
        for (int i = gt; i < 1024; i += NT) { const int coord = i >> 4, q = i & 15; const float inv = powf(10000.0f, -(float)q / 16.0f); const float ang = (float)coord * inv;
            rope[i] = cosf(ang); rope[1024 + i] = sinf(ang); }
        bf16* WA = (bf16*)(ws + WS_WA);
        for (int i = gt; i < 128 * 128; i += NT) { const int m = i >> 7, k = i & 127, rp = m >> 6, j1 = m & 63, ri = k >> 6, n1 = k & 63;
            const float a = 2.0f * (float)((j1 * n1) & 63) / 64.0f; const float c = cospif(a), s = sinpif(a);
            const float v = (rp == 0) ? (ri == 0 ? c : s) : (ri == 0 ? -s : c); WA[i] = (bf16)f2bf(v); }
        bf16* WAC = (bf16*)(ws + WS_WAC);
        for (int i = gt; i < 32 * 32; i += NT) { const int m = i >> 5, k = i & 31, rp = m >> 4, j1 = m & 15, ri = k >> 4, n1 = k & 15;
            const float a = 2.0f * (float)((j1 * n1) & 15) / 16.0f; const float c = cospif(a), s = sinpif(a);
            const float v = (rp == 0) ? (ri == 0 ? c : s) : (ri == 0 ? -s : c); WAC[i] = (bf16)f2bf(v); }
        bf16* WC = (bf16*)(ws + WS_WC);
        for (int i = gt; i < 64 * 64 * 128; i += NT) { const int j1 = i >> 13, j2 = (i >> 7) & 63, k = i & 127, ri = k >> 6, n2 = k & 63;
            const float a = 2.0f * (float)((n2 * (j1 + 64 * j2)) & 4095) / 4096.0f; const float v = (ri == 0 ? cospif(a) : sinpif(a)) * (1.0f / 64.0f); WC[i] = (bf16)f2bf(v); }
        bf16* FD = (bf16*)(ws + WS_FD);
        for (int i = gt; i < 256 * 128; i += NT) { const int col = i >> 7, c = i & 127, ri = col >> 7, k2 = col & 127;
            const float a = 2.0f * (float)((c * k2) & 127) / 128.0f; const float v = (ri == 0 ? cospif(a) : -sinpif(a)) * 0.08838834764831845f; FD[i] = (bf16)f2bf(v); }
        bf16* WCC = (bf16*)(ws + WS_WCC);
        for (int i = gt; i < 16 * 16 * 32; i += NT) { const int j1 = i >> 9, j2 = (i >> 5) & 15, k = i & 31, ri = k >> 4, n2 = k & 15;
            const float a = 2.0f * (float)((n2 * (j1 + 16 * j2)) & 255) / 256.0f; const float v = (ri == 0 ? cospif(a) : sinpif(a)) * (1.0f / 16.0f); WCC[i] = (bf16)f2bf(v); }
    }
    LAS float* tw = (LAS float*)(F.lds + 139264);
    if (F.tid < 128) { const float a = 2.0f * (float)F.tid / 128.0f; tw[F.tid] = cospif(a); tw[128 + F.tid] = sinpif(a); }
    __syncthreads();
    LAS float* scr = (LAS float*)(F.lds + F.wave * 17408);
    const int gw = F.vcu * NWAVES + F.wave, NGW = F.G * NWAVES;
    const int fid = F.vcu * 2 + F.wave;
    if (F.wave < 2) { const int r = fid;
        const int g = r >> 7, db = (r >> 5) & 3, kb = r & 31, k0 = kb * 32, d0 = db * 32;
        const float* Wp = in[I_OWIN] + (size_t)k0 * 1280 + g * 128;
        { float tl[32][2];
#pragma unroll
          for (int rr = 0; rr < 32; ++rr) { tl[rr][0] = Wp[(size_t)rr * 1280 + F.lane]; tl[rr][1] = Wp[(size_t)rr * 1280 + 64 + F.lane]; }
#pragma unroll
          for (int rr = 0; rr < 32; ++rr) { scr[rr * 129 + F.lane] = tl[rr][0]; scr[rr * 129 + 64 + F.lane] = tl[rr][1]; } }
        LDS_WAIT(); asm volatile("" ::: "memory");
        const int k = F.lane & 31, oh = F.lane >> 5;
        const float* pw = in[I_OPOOLW] + (size_t)g * 16384 + d0 + 16 * oh;
        float acc[16];
#pragma unroll
        for (int t = 0; t < 16; ++t) acc[t] = 0.f;
        for (int c0 = 0; c0 < 128; c0 += 8) {
            f32x4 p[8][4];
#pragma unroll
            for (int cc = 0; cc < 8; ++cc)
#pragma unroll
                for (int j = 0; j < 4; ++j) p[cc][j] = *(const f32x4*)(pw + (c0 + cc) * 128 + 4 * j);
#pragma unroll
            for (int cc = 0; cc < 8; ++cc) { const float w = scr[k * 129 + c0 + cc];
#pragma unroll
                for (int j = 0; j < 4; ++j) { acc[4 * j] += w * p[cc][j].x; acc[4 * j + 1] += w * p[cc][j].y; acc[4 * j + 2] += w * p[cc][j].z; acc[4 * j + 3] += w * p[cc][j].w; } }
        }
        const float* psc = in[I_OPOOLS] + g * 128 + d0 + 16 * oh;
        if constexpr (FP8_IN1) { unsigned char* dst8 = ws + WS_W_OIN + (size_t)(g * 128 + d0 + 16 * oh) * 1024 + k0 + k;
#pragma unroll
            for (int t = 0; t < 16; ++t) { const float wv = acc[t] * psc[t] * pg8::W1_SCALE; dst8[(size_t)t * 1024] = (unsigned char)(__builtin_amdgcn_cvt_pk_fp8_f32(wv, wv, 0, false) & 0xff); } }
        else {
        bf16* dst = (bf16*)(ws + WS_W_OIN) + (size_t)(g * 128 + d0 + 16 * oh) * 1024 + k0 + k;
#pragma unroll
        for (int t = 0; t < 16; ++t) dst[(size_t)t * 1024] = (bf16)f2bf(acc[t] * psc[t]); }
        LDS_WAIT(); asm volatile("" ::: "memory");
    }
    {
        LAS unsigned* ctr = (LAS unsigned*)(F.lds + LDS_CTL + 32);
        constexpr int TP1 = TS0 + TS1 + TS2 + TS3 + (12288 - 192 * L0T_N), PER = (TP1 + 255) / 256;
        const int base = F.vcu * PER, lim = max(0, min(PER, TP1 - base));
        f32x4 cur[8], nxt[8];
        int it = __builtin_amdgcn_readfirstlane(F.lane == 0 ? (int)atomicAdd((unsigned*)ctr, 1u) : 0);
        TItem tc = titem_decode(in, ws, base + (it < lim ? it : 0));
        if (it < lim) titem_load(tc, nxt, F.lane);
        while (it < lim) {
#pragma unroll
            for (int i = 0; i < 8; ++i) cur[i] = nxt[i];
            const TItem tcur = tc;
            const int itn = __builtin_amdgcn_readfirstlane(F.lane == 0 ? (int)atomicAdd((unsigned*)ctr, 1u) : 0);
            if (itn < lim) { tc = titem_decode(in, ws, base + itn); titem_load(tc, nxt, F.lane); }
            titem_process(tcur, cur, scr, F.lane);
            it = itn;
        }
    }
    mods_wait(F);
    {
        LAS unsigned* ctr2 = (LAS unsigned*)(F.lds + LDS_CTL + 36);
        for (;;) {
            const int it = __builtin_amdgcn_readfirstlane(F.lane == 0 ? (int)atomicAdd((unsigned*)ctr2, 1u) : 0);
            if (it >= 40) break;
            if (it < 32) p1_tokens<4>(F, 4 * (32 * (int)blockIdx.x + it)); else p1_tokens<1>(F, TL + 8 * (int)blockIdx.x + (it - 32));
        }
    }
}

struct DftP { const bf16* dbase; size_t dstride; const bf16* W; bf16* obase; size_t ostride; };
template <int MODE> __device__ __forceinline__ DftP dft_params(const Frame& F, int u) {
    const bf16* P = (const bf16*)(F.ws + WS_BUFP); bf16* Z = (bf16*)(F.ws + WS_BUFZ); bf16* MIX = (bf16*)(F.ws + WS_BUFA);
    DftP p;
    if constexpr (MODE == 0) { const int chunk = u & 3, n2 = (u >> 2) & 63, b = u >> 8;
        p.dbase = P + (size_t)(b * 4096 + n2) * EIN + chunk * 128; p.dstride = (size_t)64 * EIN; p.W = (const bf16*)(F.ws + WS_WA);
        p.obase = Z + (size_t)((b * 64) * 64 + n2) * 1024 + chunk * 128; p.ostride = (size_t)64 * 1024; }
    if constexpr (MODE == 1) { const int chunk = u & 3, n2 = (u >> 2) & 15, b = u >> 6;
        p.dbase = P + (size_t)(TL + b * 256 + n2) * EIN + chunk * 128; p.dstride = (size_t)16 * EIN; p.W = (const bf16*)(F.ws + WS_WAC);
        p.obase = Z + (size_t)(TL + (b * 16) * 16 + n2) * 1024 + chunk * 128; p.ostride = (size_t)16 * 1024; }
    if constexpr (MODE == 2) { const int chunk = u & 3, j1 = (u >> 2) & 63, b = u >> 8;
        p.dbase = Z + (size_t)((b * 64 + j1) * 64) * 1024 + chunk * 128; p.dstride = (size_t)1024; p.W = (const bf16*)(F.ws + WS_WC) + (size_t)j1 * 64 * 128;
        p.obase = MIX + (size_t)(b * 4096 + j1) * D + chunk * 128; p.ostride = (size_t)64 * D; }
    if constexpr (MODE == 3) { const int chunk = u & 3, j1 = (u >> 2) & 15, b = u >> 6;
        p.dbase = Z + (size_t)(TL + (b * 16 + j1) * 16) * 1024 + chunk * 128; p.dstride = (size_t)1024; p.W = (const bf16*)(F.ws + WS_WCC) + (size_t)j1 * 16 * 32;
        p.obase = MIX + (size_t)(TL + b * 256 + j1) * D + chunk * 128; p.ostride = (size_t)16 * D; }
    return p;
}
template <int MODE, int KD, int MD, int J>
__device__ __forceinline__ void dft_units(Frame& F, int nunits) {
    constexpr int LD = KD + 8;
    constexpr int NP = (KD * 16 + 511) / 512;
    constexpr int GM = KD / 8 - 1;
    LAS bf16* DT = (LAS bf16*)F.lds;
    u32x4 pre[NP];
    int u = F.vcu;
    if (u < nunits) { const DftP p = dft_params<MODE>(F, u);
#pragma unroll
        for (int i = 0; i < NP; ++i) { const int pc = F.tid + 512 * i; if (pc < KD * 16) { const int k = pc >> 4, c8 = pc & 15, ri = k / (KD / 2), nn = k % (KD / 2);
            pre[i] = __builtin_nontemporal_load((const u32x4*)(p.dbase + (size_t)nn * p.dstride + ri * 512 + c8 * 8)); } } }
    const int a = F.lane & 15, q = F.lane >> 4;
    for (; u < nunits; u += F.G) {
        const DftP p = dft_params<MODE>(F, u);
#pragma unroll
        for (int i = 0; i < NP; ++i) { const int pc = F.tid + 512 * i; if (pc < KD * 16) { const int k = pc >> 4, c8 = pc & 15; const u32x4 v = pre[i];
            LAS bf16* d = DT + (c8 * 8) * LD + (k ^ ((c8 & GM) << 3));
            d[0 * LD] = (bf16)(v.x & 0xffff); d[1 * LD] = (bf16)(v.x >> 16); d[2 * LD] = (bf16)(v.y & 0xffff); d[3 * LD] = (bf16)(v.y >> 16);
            d[4 * LD] = (bf16)(v.z & 0xffff); d[5 * LD] = (bf16)(v.z >> 16); d[6 * LD] = (bf16)(v.w & 0xffff); d[7 * LD] = (bf16)(v.w >> 16); } }
        __syncthreads();
        if (u + F.G < nunits) { const DftP pn = dft_params<MODE>(F, u + F.G);
#pragma unroll
            for (int i = 0; i < NP; ++i) { const int pc = F.tid + 512 * i; if (pc < KD * 16) { const int k = pc >> 4, c8 = pc & 15, ri = k / (KD / 2), nn = k % (KD / 2);
                pre[i] = __builtin_nontemporal_load((const u32x4*)(pn.dbase + (size_t)nn * pn.dstride + ri * 512 + c8 * 8)); } } }
        for (int task = F.wave; task < (MD / 16) * 2; task += NWAVES) {
            const int mt = task >> 1, cht = task & 1;
            f32x4 acc[4];
#pragma unroll
            for (int ct = 0; ct < 4; ++ct) acc[ct] = (f32x4){0.f, 0.f, 0.f, 0.f};
#pragma unroll
            for (int ks = 0; ks < KD / 32; ++ks) {
                const bf16x8 bw = *(const bf16x8*)(p.W + (size_t)(mt * 16 + a) * KD + ks * 32 + 8 * q);
#pragma unroll
                for (int ct = 0; ct < 4; ++ct) {
                    const int ch = cht * 64 + 16 * (a >> 2) + 4 * ct + (a & 3);
                    const bf16x8 av = *(const LAS bf16x8*)(DT + ch * LD + ((ks * 32 + 8 * q) ^ (((ch >> 3) & GM) << 3)));
                    acc[ct] = __builtin_amdgcn_mfma_f32_16x16x32_bf16(av, bw, acc[ct], 0, 0, 0);
                }
            }
            const int m = mt * 16 + a, rm = m / J, j = m % J;
            bf16* o = p.obase + (size_t)j * p.ostride + rm * 512 + cht * 64 + 16 * q;
            if constexpr (MODE >= 2 && FP8_OUT0 != 0) {
                unsigned char* o8 = F.ws + WS_BUFA + (size_t)(o - (bf16*)(F.ws + WS_BUFA));
#define HC8(x) __builtin_fminf(__builtin_fmaxf((x) * pg8::MIX0_SCALE, -448.0f), 448.0f)
                u32x4 w8; w8.x = pg8::pk4_fp8(HC8(acc[0][0]), HC8(acc[0][1]), HC8(acc[0][2]), HC8(acc[0][3])); w8.y = pg8::pk4_fp8(HC8(acc[1][0]), HC8(acc[1][1]), HC8(acc[1][2]), HC8(acc[1][3]));
                w8.z = pg8::pk4_fp8(HC8(acc[2][0]), HC8(acc[2][1]), HC8(acc[2][2]), HC8(acc[2][3])); w8.w = pg8::pk4_fp8(HC8(acc[3][0]), HC8(acc[3][1]), HC8(acc[3][2]), HC8(acc[3][3]));
#undef HC8
                *(u32x4*)o8 = w8;
            } else {
            u32x4 w0, w1;
            w0.x = pk2(acc[0][0], acc[0][1]); w0.y = pk2(acc[0][2], acc[0][3]); w0.z = pk2(acc[1][0], acc[1][1]); w0.w = pk2(acc[1][2], acc[1][3]);
            w1.x = pk2(acc[2][0], acc[2][1]); w1.y = pk2(acc[2][2], acc[2][3]); w1.z = pk2(acc[3][0], acc[3][1]); w1.w = pk2(acc[3][2], acc[3][3]);
            *(u32x4*)o = w0; *(u32x4*)(o + 8) = w1; }
        }
        __syncthreads();
    }
}

template <int MODE, int NR>
__device__ __forceinline__ void dft_units_a(Frame& F, int nunits) {
    constexpr int KD = 2 * NR, MD = 2 * NR, J = NR, LD = KD + 8, GM = KD / 8 - 1, ULD = 136;
    constexpr int NP = (NR * 16 + 511) / 512;
    LAS bf16* FDl = (LAS bf16*)F.lds; LAS bf16* U = (LAS bf16*)(F.lds + 69632); LAS bf16* DT = (LAS bf16*)(F.lds + 69632 + 64 * ULD * 2);
    { const bf16* FD = (const bf16*)(F.ws + WS_FD);
      for (int p = F.tid; p < 256 * 16; p += 512) { const int r = p >> 4, c8 = p & 15; *(LAS u32x4*)(FDl + r * ULD + 8 * c8) = *(const u32x4*)(FD + r * 128 + 8 * c8); } }
    u32x4 pre[NP];
    int u = F.vcu;
    if (u < nunits) { const DftP p = dft_params<MODE>(F, u);
#pragma unroll
        for (int i = 0; i < NP; ++i) { const int pc = F.tid + 512 * i; if (pc < NR * 16) pre[i] = __builtin_nontemporal_load((const u32x4*)(p.dbase + (size_t)(pc >> 4) * p.dstride + (pc & 15) * 8)); } }
    const int a = F.lane & 15, q = F.lane >> 4;
    for (; u < nunits; u += F.G) {
        const DftP p = dft_params<MODE>(F, u);
#pragma unroll
        for (int i = 0; i < NP; ++i) { const int pc = F.tid + 512 * i; if (pc < NR * 16) *(LAS u32x4*)(U + (pc >> 4) * ULD + (pc & 15) * 8) = pre[i]; }
        __syncthreads();
        if (u + F.G < nunits) { const DftP pn = dft_params<MODE>(F, u + F.G);
#pragma unroll
            for (int i = 0; i < NP; ++i) { const int pc = F.tid + 512 * i; if (pc < NR * 16) pre[i] = __builtin_nontemporal_load((const u32x4*)(pn.dbase + (size_t)(pc >> 4) * pn.dstride + (pc & 15) * 8)); } }
        {
            f32x4 acc[NR / 16][2];
#pragma unroll
            for (int mt = 0; mt < NR / 16; ++mt) { acc[mt][0] = (f32x4){0.f, 0.f, 0.f, 0.f}; acc[mt][1] = (f32x4){0.f, 0.f, 0.f, 0.f}; }
#pragma unroll
            for (int ks = 0; ks < 4; ++ks) {
                const bf16x8 b0 = *(const LAS bf16x8*)(FDl + ((2 * F.wave) * 16 + a) * ULD + ks * 32 + 8 * q), b1 = *(const LAS bf16x8*)(FDl + ((2 * F.wave + 1) * 16 + a) * ULD + ks * 32 + 8 * q);
#pragma unroll
                for (int mt = 0; mt < NR / 16; ++mt) { const bf16x8 av = *(const LAS bf16x8*)(U + (mt * 16 + a) * ULD + ks * 32 + 8 * q);
                    acc[mt][0] = __builtin_amdgcn_mfma_f32_16x16x32_bf16(av, b0, acc[mt][0], 0, 0, 0); acc[mt][1] = __builtin_amdgcn_mfma_f32_16x16x32_bf16(av, b1, acc[mt][1], 0, 0, 0); }
            }
#pragma unroll
            for (int t = 0; t < 2; ++t) { const int col = (2 * F.wave + t) * 16 + a, ri = col >> 7, k2 = col & 127;
#pragma unroll
                for (int mt = 0; mt < NR / 16; ++mt) { const int k0 = ri * NR + 16 * mt + 4 * q;
                    u32x2 w; w.x = pk2(acc[mt][t][0], acc[mt][t][1]); w.y = pk2(acc[mt][t][2], acc[mt][t][3]);
                    *(LAS u32x2*)(DT + k2 * LD + (k0 ^ (((k2 >> 3) & GM) << 3))) = w; } }
        }
        __syncthreads();
        for (int task = F.wave; task < (MD / 16) * 2; task += NWAVES) {
            const int mt = task >> 1, cht = task & 1;
            f32x4 acc[4];
#pragma unroll
            for (int ct = 0; ct < 4; ++ct) acc[ct] = (f32x4){0.f, 0.f, 0.f, 0.f};
#pragma unroll
            for (int ks = 0; ks < KD / 32; ++ks) {
                const bf16x8 bw = *(const bf16x8*)(p.W + (size_t)(mt * 16 + a) * KD + ks * 32 + 8 * q);
#pragma unroll
                for (int ct = 0; ct < 4; ++ct) {
                    const int ch = cht * 64 + 16 * (a >> 2) + 4 * ct + (a & 3);
                    const bf16x8 av = *(const LAS bf16x8*)(DT + ch * LD + ((ks * 32 + 8 * q) ^ (((ch >> 3) & GM) << 3)));
                    acc[ct] = __builtin_amdgcn_mfma_f32_16x16x32_bf16(av, bw, acc[ct], 0, 0, 0);
                }
            }
            const int m = mt * 16 + a, rm = m / J, j = m % J;
            bf16* o = p.obase + (size_t)j * p.ostride + rm * 512 + cht * 64 + 16 * q;
            u32x4 w0, w1;
            w0.x = pk2(acc[0][0], acc[0][1]); w0.y = pk2(acc[0][2], acc[0][3]); w0.z = pk2(acc[1][0], acc[1][1]); w0.w = pk2(acc[1][2], acc[1][3]);
            w1.x = pk2(acc[2][0], acc[2][1]); w1.y = pk2(acc[2][2], acc[2][3]); w1.z = pk2(acc[3][0], acc[3][1]); w1.w = pk2(acc[3][2], acc[3][3]);
            *(u32x4*)o = w0; *(u32x4*)(o + 8) = w1;
        }
        __syncthreads();
    }
}

__device__ __forceinline__ void phase_fourier_a_conv(Frame& F) {
    const bf16* P = (const bf16*)(F.ws + WS_BUFP);
    dft_units_a<0, 64>(F, 2048);
    __syncthreads();
    dft_units_a<1, 16>(F, 512);
    ctr_publish(F, WS_FAF, 0, xcd_census(F, [](int) { return true; }));
    bf16* MIX = (bf16*)(F.ws + WS_BUFA);
    const float* cw = F.in[I_ECONV];
    float w0[8], w1[8], w2[8];
#pragma unroll
    for (int i = 0; i < 8; ++i) { w0[i] = cw[8 * F.lane + i]; w1[i] = cw[512 + 8 * F.lane + i]; w2[i] = cw[1024 + 8 * F.lane + i]; }
    const int gw = F.vcu * NWAVES + F.wave, NGW = F.G * NWAVES;
    auto conv_tokens = [&](int t, auto ntc) {
        constexpr int NT = decltype(ntc)::value;
        int pos, len; if (t < TL) { pos = t & 4095; len = 4096; } else { pos = (t - TL) & 255; len = 256; }
        const bf16* row = P + (size_t)t * EIN + 8 * F.lane;
        u32x4 gb[NT], gc[NT + 2], uc[NT + 2];
#pragma unroll
        for (int d = 0; d < NT + 2; ++d) { const int pp = pos + d - 1;
            if (pp >= 0 && pp < len) { gc[d] = *(const u32x4*)(row + (ptrdiff_t)(d - 1) * EIN + 1024); uc[d] = *(const u32x4*)(row + (ptrdiff_t)(d - 1) * EIN + 1536); }
            else { gc[d] = (u32x4){0u, 0u, 0u, 0u}; uc[d] = (u32x4){0u, 0u, 0u, 0u}; } }
#pragma unroll
        for (int q = 0; q < NT; ++q) gb[q] = __builtin_nontemporal_load((const u32x4*)(row + (size_t)q * EIN + 512));
        float pl[NT + 2][8];
#pragma unroll
        for (int d = 0; d < NT + 2; ++d)
#pragma unroll
            for (int i = 0; i < 4; ++i) { pl[d][2 * i] = bflo(gc[d][i]) * bflo(uc[d][i]); pl[d][2 * i + 1] = bfhi(gc[d][i]) * bfhi(uc[d][i]); }
#pragma unroll
        for (int q = 0; q < NT; ++q) {
            float y[8];
#pragma unroll
            for (int i = 0; i < 4; ++i) {
                y[2 * i] = bflo(gb[q][i]) * (w0[2 * i] * pl[q][2 * i] + w1[2 * i] * pl[q + 1][2 * i] + w2[2 * i] * pl[q + 2][2 * i]);
                y[2 * i + 1] = bfhi(gb[q][i]) * (w0[2 * i + 1] * pl[q][2 * i + 1] + w1[2 * i + 1] * pl[q + 1][2 * i + 1] + w2[2 * i + 1] * pl[q + 2][2 * i + 1]);
            }
            if constexpr (FP8_OUT0 != 0) {
#define HC8(x) __builtin_fminf(__builtin_fmaxf((x) * pg8::MIX0_SCALE, -448.0f), 448.0f)
                u32x2 o8; o8.x = pg8::pk4_fp8(HC8(y[0]), HC8(y[1]), HC8(y[2]), HC8(y[3])); o8.y = pg8::pk4_fp8(HC8(y[4]), HC8(y[5]), HC8(y[6]), HC8(y[7]));
#undef HC8
                *(u32x2*)((unsigned char*)MIX + (size_t)(t + q) * D + 512 + 8 * F.lane) = o8;
            } else {
            u32x4 o; o.x = pk2(y[0], y[1]); o.y = pk2(y[2], y[3]); o.z = pk2(y[4], y[5]); o.w = pk2(y[6], y[7]);
            *(u32x4*)(MIX + (size_t)(t + q) * D + 512 + 8 * F.lane) = o; }
        }
    };
    for (int t = 4 * gw; t < TL; t += 4 * NGW) conv_tokens(t, std::integral_constant<int, 4>{});
    for (int t = TL + gw; t < T; t += NGW) conv_tokens(t, std::integral_constant<int, 1>{});
}

__device__ __forceinline__ void phase_fourier_c(Frame& F) {
    ctr_wait(F, WS_FAF, (unsigned)F.G);
    dft_units<2, 128, 64, 64>(F, 2048);
    dft_units<3, 32, 16, 16>(F, 512);
}

constexpr int RW_LD = 1032;
template <bool SPLIT>
__device__ __forceinline__ void phase_route(Frame& F, int layer, int ntok) {
    LAS bf16* rwh = (LAS bf16*)F.lds;
    LAS bf16* rwl = (LAS bf16*)(F.lds + 33024);
    LAS unsigned* cnt = (LAS unsigned*)(F.lds + 66048);
    LAS int* gb = (LAS int*)(F.lds + 66048 + 128);
    LAS float* lgs = (LAS float*)(F.lds + 66048 + 256) + F.wave * 256;
    LAS int* tinfo = (LAS int*)(F.lds + 66048 + 256 + 8192);
    LAS float* GS = (LAS float*)(F.lds + 81920);
    LAS float* SH = GS + 2048;
    const float* RW = F.in[I_RW];
    int tA, nA, tB, nB;
    if constexpr (SPLIT) {
        const int xs = F.vcu >> 5, rs = F.vcu & 31;
        if (rs >= 28) return;
        const int j = 28 * xs + rs;
        tA = 128 * j; nA = 128; tB = 28672 + 32 * j; nB = (j < 192) ? 32 : 0;
    } else { const int per_ = ntok / F.G; tA = blockIdx.x * per_; nA = per_; tB = 0; nB = 0; }
    const int r0 = mod_row(tA), mr1 = SPLIT ? mod_row(tB) : min(r0 + 1, 8);
    const float* mods = (const float*)(F.ws + WS_MODS) + (size_t)layer * 9 * 6144;
    const float* g = F.in[I_NFG] + layer * 1024;
    for (int i = F.tid; i < 16384; i += 512) { const int k = i >> 4, e = i & 15; const float w = RW[i]; const unsigned hi = f2bf(w); const float wl = w - __builtin_bit_cast(float, hi << 16);
        rwh[e * RW_LD + k] = (bf16)hi; rwl[e * RW_LD + k] = (bf16)f2bf(wl); }
    for (int i = F.tid; i < 2048; i += 512) { const int sl = i >> 10, c = i & 1023; const int rr = sl ? mr1 : r0; const float* m = mods + (size_t)rr * 6144;
        GS[i] = g[c] * (m[4 * 1024 + c] + 1.0f); SH[i] = m[3 * 1024 + c]; }
    if (F.tid < 16) cnt[F.tid] = 0u;
    __syncthreads();
    bf16* FB = (bf16*)(F.ws + WS_BUFA);
    const bool f8 = layer ? (FP8_G1_L1 != 0) : (FP8_G1_L0 != 0);
    int* route = (int*)(F.ws + WS_ROUTE);
    const int tk = F.lane & 15, kg = F.lane >> 4;
    for (int st = 0; st < 2; ++st) {
    const int t0 = st ? tB : tA, per = st ? nB : nA, li0 = st ? nA : 0;
    if (per == 0) break;
    if constexpr (SPLIT) { if (st == 0) ctr_wait(F, WS_P5F, 224u); else ctr_wait(F, WS_P5C, 32u); }
    for (int g0 = 16 * F.wave; g0 < per; g0 += 16 * NWAVES) {
        const int nv = min(16, per - g0);
        const int tq = t0 + g0 + (tk < nv ? tk : 0);
        const bf16* hr = h_row(F, tq) + 8 * kg;
        float s2 = 0.f;
        {
            u32x4 raw[32];
#pragma unroll
            for (int ks = 0; ks < 32; ++ks) raw[ks] = *(const u32x4*)(hr + 32 * ks);
#pragma unroll
            for (int ks = 0; ks < 32; ++ks)
#pragma unroll
                for (int i = 0; i < 4; ++i) { const float a = bflo(raw[ks][i]), b2 = bfhi(raw[ks][i]); s2 += a * a + b2 * b2; }
        }
        s2 += __shfl_xor(s2, 16); s2 += __shfl_xor(s2, 32);
        const float rstd = 1.0f / sqrtf(s2 * (1.0f / D) + EPS);
        const int sl = (mod_row(tq) != r0) ? 1024 : 0;
        const LAS float* gsp = GS + sl + 8 * kg; const LAS float* shp = SH + sl + 8 * kg;
        unsigned char* fb8 = (unsigned char*)FB + (size_t)tq * D + 8 * kg;
        bf16* fb16 = FB + (size_t)tq * D + 8 * kg;
        f32x4 acc = (f32x4){0.f, 0.f, 0.f, 0.f};
        u32x4 nx[8];
#pragma unroll
        for (int j = 0; j < 8; ++j) nx[j] = *(const u32x4*)(hr + 32 * j);
#pragma unroll 1
        for (int k4 = 0; k4 < 4; ++k4) {
            u32x4 cu[8];
#pragma unroll
            for (int j = 0; j < 8; ++j) cu[j] = nx[j];
            if (k4 < 3) {
#pragma unroll
                for (int j = 0; j < 8; ++j) nx[j] = *(const u32x4*)(hr + 32 * (8 * k4 + 8 + j)); }
#pragma unroll
            for (int j = 0; j < 8; ++j) {
                const int ks = 8 * k4 + j;
                const f32x4 g0v = *(const LAS f32x4*)(gsp + 32 * ks), g1v = *(const LAS f32x4*)(gsp + 32 * ks + 4), s0v = *(const LAS f32x4*)(shp + 32 * ks), s1v = *(const LAS f32x4*)(shp + 32 * ks + 4);
                float f[8];
                f[0] = bflo(cu[j].x) * rstd * g0v.x + s0v.x; f[1] = bfhi(cu[j].x) * rstd * g0v.y + s0v.y; f[2] = bflo(cu[j].y) * rstd * g0v.z + s0v.z; f[3] = bfhi(cu[j].y) * rstd * g0v.w + s0v.w;
                f[4] = bflo(cu[j].z) * rstd * g1v.x + s1v.x; f[5] = bfhi(cu[j].z) * rstd * g1v.y + s1v.y; f[6] = bflo(cu[j].w) * rstd * g1v.z + s1v.z; f[7] = bfhi(cu[j].w) * rstd * g1v.w + s1v.w;
                u32x4 hi, lo;
#pragma unroll
                for (int i = 0; i < 4; ++i) { const unsigned h0 = f2bf(f[2 * i]), h1 = f2bf(f[2 * i + 1]); hi[i] = h0 | (h1 << 16);
                    lo[i] = pk2(f[2 * i] - __builtin_bit_cast(float, h0 << 16), f[2 * i + 1] - __builtin_bit_cast(float, h1 << 16)); }
                if (tk < nv) {
                    if (f8) { u32x2 o; o.x = pg8::pk4_fp8(f[0], f[1], f[2], f[3]); o.y = pg8::pk4_fp8(f[4], f[5], f[6], f[7]); *(u32x2*)(fb8 + 32 * ks) = o; }
                    else *(u32x4*)(fb16 + 32 * ks) = hi;
                }
                const bf16x8 bh = *(const LAS bf16x8*)(rwh + tk * RW_LD + 32 * ks + 8 * kg), bl = *(const LAS bf16x8*)(rwl + tk * RW_LD + 32 * ks + 8 * kg);
                const bf16x8 ah = __builtin_bit_cast(bf16x8, hi), al = __builtin_bit_cast(bf16x8, lo);
                acc = __builtin_amdgcn_mfma_f32_16x16x32_bf16(ah, bh, acc, 0, 0, 0);
                acc = __builtin_amdgcn_mfma_f32_16x16x32_bf16(ah, bl, acc, 0, 0, 0);
                acc = __builtin_amdgcn_mfma_f32_16x16x32_bf16(al, bh, acc, 0, 0, 0);
            }
        }
#pragma unroll
        for (int j = 0; j < 4; ++j) lgs[(4 * kg + j) * 16 + tk] = acc[j];
        LDS_WAIT(); asm volatile("" ::: "memory");
        if (F.lane < nv) {
            const int tqq = t0 + g0 + F.lane;
            float aff[16], sel[16];
#pragma unroll
            for (int e4 = 0; e4 < 4; ++e4) { const f32x4 l4 = *(const LAS f32x4*)(lgs + F.lane * 16 + 4 * e4); const f32x4 b4 = *(const f32x4*)(F.in[I_RB] + 4 * e4);
                aff[4 * e4] = 1.0f / (1.0f + expf(-l4.x)); aff[4 * e4 + 1] = 1.0f / (1.0f + expf(-l4.y)); aff[4 * e4 + 2] = 1.0f / (1.0f + expf(-l4.z)); aff[4 * e4 + 3] = 1.0f / (1.0f + expf(-l4.w));
                sel[4 * e4] = aff[4 * e4] + b4.x; sel[4 * e4 + 1] = aff[4 * e4 + 1] + b4.y; sel[4 * e4 + 2] = aff[4 * e4 + 2] + b4.z; sel[4 * e4 + 3] = aff[4 * e4 + 3] + b4.w; }
            int best = 0; float bs = -1e30f;
#pragma unroll
            for (int gq = 0; gq < 4; ++gq) { const float a = sel[4 * gq], b = sel[4 * gq + 1], c = sel[4 * gq + 2], d = sel[4 * gq + 3];
                const float s = fmaxf(fmaxf(fmaxf(a + b, a + c), fmaxf(a + d, b + c)), fmaxf(b + d, c + d));
                if (s > bs) { bs = s; best = gq; } }
            float sv[4], av[4];
#pragma unroll
            for (int i = 0; i < 4; ++i) { sv[i] = sel[i]; av[i] = aff[i]; }
#pragma unroll
            for (int gq = 1; gq < 4; ++gq) if (best == gq) {
#pragma unroll
                for (int i = 0; i < 4; ++i) { sv[i] = sel[4 * gq + i]; av[i] = aff[4 * gq + i]; } }
            int i1 = 0; float s1 = sv[0], a1 = av[0];
#pragma unroll
            for (int i = 1; i < 4; ++i) if (sv[i] > s1) { s1 = sv[i]; a1 = av[i]; i1 = i; }
            int i2 = -1; float s2v = -1e30f, a2 = 0.f;
#pragma unroll
            for (int i = 0; i < 4; ++i) if (i != i1 && sv[i] > s2v) { s2v = sv[i]; a2 = av[i]; i2 = i; }
            const int e1 = 4 * best + i1, e2 = 4 * best + i2;
            const float wsum = a1 + a2, w1 = a1 / wsum, w2 = a2 / wsum;
            const unsigned r1 = atomicAdd((unsigned*)(cnt + e1), 1u), r2 = atomicAdd((unsigned*)(cnt + e2), 1u);
            int* ro = route + (size_t)tqq * 8;
            ro[0] = e1; ro[1] = e2; ro[4] = __builtin_bit_cast(int, w1); ro[5] = __builtin_bit_cast(int, w2);
            const int li = li0 + g0 + F.lane;
            tinfo[4 * li + 0] = e1; tinfo[4 * li + 1] = e2; tinfo[4 * li + 2] = (int)r1; tinfo[4 * li + 3] = (int)r2;
        }
        LDS_WAIT(); asm volatile("" ::: "memory");
    }
    }
    __syncthreads();
    if (F.tid < 16) gb[F.tid] = (int)__hip_atomic_fetch_add((unsigned*)(F.ws + WS_GCNT) + layer * 16 + F.tid, cnt[F.tid], __ATOMIC_RELAXED, __HIP_MEMORY_SCOPE_AGENT);
    __syncthreads();
    int* tokmap = (int*)(F.ws + WS_TOKMAP);
    for (int i = F.tid; i < nA + nB; i += 512) {
        const int tok = (i < nA) ? tA + i : tB + (i - nA);
        const int e1 = tinfo[4 * i], e2 = tinfo[4 * i + 1], p1 = gb[e1] + tinfo[4 * i + 2], p2 = gb[e2] + tinfo[4 * i + 3];
        tokmap[(size_t)e1 * T + p1] = tok; tokmap[(size_t)e2 * T + p2] = tok;
        int* ro = route + (size_t)tok * 8; ro[2] = p1; ro[3] = p2;
    }
}

__device__ __forceinline__ int moe_tables(Frame& F, int layer) {
    LAS int* tb = (LAS int*)(F.lds + LDS_CTL + 64); LAS int* cn = (LAS int*)(F.lds + LDS_CTL + 192);
    __syncthreads();
    if (F.tid < 16) cn[F.tid] = ld_coh((const int*)(F.ws + WS_GCNT) + layer * 16 + F.tid);
    __syncthreads();
    if (F.tid == 0) { int b = 0; for (int e = 0; e < 16; ++e) { tb[e] = b; b += (cn[e] + 255) >> 8; } tb[16] = b; }
    __syncthreads();
    return __builtin_amdgcn_readfirstlane(tb[16]);
}

typedef float f32x2 __attribute__((ext_vector_type(2)));
template <int NQ> __device__ __forceinline__ void combine_tokens(Frame& F, int layer, int t) {
    const float* mods = (const float*)(F.ws + WS_MODS);
    const unsigned char* OS = (const unsigned char*)(F.ws + WS_BUFP);
    const int* route = (const int*)(F.ws + WS_ROUTE);
    const LAS int* tb = (const LAS int*)(F.lds + LDS_CTL + 64);
    bf16* A = (bf16*)(F.ws + WS_BUFA);
    {
        int rc[NQ][4]; float w0[NQ], w1[NQ];
#pragma unroll
        for (int q = 0; q < NQ; ++q) { const int* ro = route + (size_t)(t + q) * 8;
#pragma unroll
            for (int i = 0; i < 4; ++i) rc[q][i] = ld_coh(ro + i);
            w0[q] = ld_cohf((const float*)(ro + 4)) * (1.0f / pg8::OS_SCALE); w1[q] = ld_cohf((const float*)(ro + 5)) * (1.0f / pg8::OS_SCALE); }
        f32x4 v[NQ][4]; unsigned oa[NQ][4], ob[NQ][4];
#pragma unroll
        for (int q = 0; q < NQ; ++q) { const bf16* hr = h_row(F, t + q);
            const size_t s0 = (size_t)(tb[rc[q][0]] * 256 + rc[q][2]) * D, s1 = (size_t)(tb[rc[q][1]] * 256 + rc[q][3]) * D;
#pragma unroll
            for (int j = 0; j < 4; ++j) { const int c = 4 * F.lane + 256 * j; { const u32x2 hv = *(const u32x2*)(hr + c); v[q][j] = (f32x4){bflo(hv.x), bfhi(hv.x), bflo(hv.y), bfhi(hv.y)}; } oa[q][j] = __builtin_nontemporal_load((const unsigned*)(OS + s0 + c)); ob[q][j] = __builtin_nontemporal_load((const unsigned*)(OS + s1 + c)); } }
        const int mr = mod_row(t);
        const float* m5 = mods + (size_t)(layer * 9 + mr) * 6144 + 5 * 1024;
#pragma unroll
        for (int j = 0; j < 4; ++j) { const f32x4 g5 = *(const f32x4*)(m5 + 4 * F.lane + 256 * j);
#pragma unroll
            for (int q = 0; q < NQ; ++q) { const f32x2 a0 = __builtin_amdgcn_cvt_pk_f32_fp8((int)oa[q][j], false), a1 = __builtin_amdgcn_cvt_pk_f32_fp8((int)oa[q][j], true), b0 = __builtin_amdgcn_cvt_pk_f32_fp8((int)ob[q][j], false), b1 = __builtin_amdgcn_cvt_pk_f32_fp8((int)ob[q][j], true);
                const f32x4 o = (f32x4){w0[q] * a0[0] + w1[q] * b0[0], w0[q] * a0[1] + w1[q] * b0[1], w0[q] * a1[0] + w1[q] * b1[0], w0[q] * a1[1] + w1[q] * b1[1]};
                v[q][j] = v[q][j] + g5 * o; } }
#pragma unroll
        for (int q = 0; q < NQ; ++q) {
            if (layer == 0) {
                bf16* hr = h_row(F, t + q);
#pragma unroll
                for (int j = 0; j < 4; ++j) { u32x2 o; o.x = pk2(v[q][j].x, v[q][j].y); o.y = pk2(v[q][j].z, v[q][j].w); *(u32x2*)(hr + 4 * F.lane + 256 * j) = o; }
                const float* m = mods + (size_t)(9 + mr) * 6144;
                if constexpr (FP8_IN1) norm_mod_store<true>(v[q], F.in[I_NMG] + 1024, m, m + 1024, (bf16*)((unsigned char*)A + (size_t)(t + q) * D), F.lane);
                else norm_mod_store(v[q], F.in[I_NMG] + 1024, m, m + 1024, A + (size_t)(t + q) * D, F.lane);
            } else {
                float s2 = 0.f;
#pragma unroll
                for (int j = 0; j < 4; ++j) s2 += (v[q][j].x * v[q][j].x + v[q][j].y * v[q][j].y) + (v[q][j].z * v[q][j].z + v[q][j].w * v[q][j].w);
                const float rstd = 1.0f / sqrtf(wave_sum(s2) * (1.0f / D) + EPS);
                float* orow = F.out + (size_t)(t + q) * D;
#pragma unroll
                for (int j = 0; j < 4; ++j) { const int c = 4 * F.lane + 256 * j; __builtin_nontemporal_store(v[q][j] * rstd * *(const f32x4*)(F.in[I_FG] + c), (f32x4*)(orow + c)); }
            }
        }
    }
}
__device__ __forceinline__ void phase_combine(Frame& F, int layer, int ntok) {
    const int gw = F.vcu * NWAVES + F.wave, NGW = F.G * NWAVES;
    if (layer == 0) { for (int t = 2 * gw; t < TL; t += 2 * NGW) combine_tokens<2>(F, 0, t); for (int t = TL + gw; t < ntok; t += NGW) combine_tokens<1>(F, 0, t); }
    else { for (int t = 4 * gw; t < TL; t += 4 * NGW) combine_tokens<4>(F, 1, t); }
}

constexpr int KV_LD = 72, VL_OFF = 384 * KV_LD * 2, ROPE_LDS = 131072;
typedef short v4i16_t __attribute__((ext_vector_type(4)));

__device__ __forceinline__ bf16x8 rope_pack(const u32x4 x1, const u32x4 x2, const LAS float* cs, const LAS float* sn, float scale, bool second) {
    const f32x4 c0 = *(const LAS f32x4*)cs, c1 = *(const LAS f32x4*)(cs + 4), s0 = *(const LAS f32x4*)sn, s1 = *(const LAS f32x4*)(sn + 4);
    float c[8] = {c0.x, c0.y, c0.z, c0.w, c1.x, c1.y, c1.z, c1.w}, s[8] = {s0.x, s0.y, s0.z, s0.w, s1.x, s1.y, s1.z, s1.w};
    float a[8], b[8];
#pragma unroll
    for (int i = 0; i < 4; ++i) { a[2 * i] = bflo(x1[i]); a[2 * i + 1] = bfhi(x1[i]); b[2 * i] = bflo(x2[i]); b[2 * i + 1] = bfhi(x2[i]); }
    float o[8];
#pragma unroll
    for (int i = 0; i < 8; ++i) o[i] = (second ? (b[i] * c[i] + a[i] * s[i]) : (a[i] * c[i] - b[i] * s[i])) * scale;
    u32x4 w; w.x = pk2(o[0], o[1]); w.y = pk2(o[2], o[3]); w.z = pk2(o[4], o[5]); w.w = pk2(o[6], o[7]);
    return __builtin_bit_cast(bf16x8, w);
}

struct AttnU { int b, qb, kvh; };
__device__ __forceinline__ AttnU attn_unit_of(int u) { AttnU r; r.kvh = u & 1; r.qb = (u >> 1) & 31; r.b = u >> 6; return r; }

__device__ __forceinline__ void attn_load_latk(Frame& F, const bf16* P1, AttnU u, u32x4 (&lk)[2][4]) {
    const u32x4 z = (u32x4){0u, 0u, 0u, 0u};
#pragma unroll
    for (int it = 0; it < 2; ++it) { const int task = F.tid + 512 * it, kidx = task >> 1, hh = task & 1, pos = u.qb * 128 - 128 + kidx;
        const bool ok = task < 768 && pos >= 0 && pos < NSEQ;
        const bf16* row = P1 + (size_t)(u.b * NSEQ + (ok ? pos : 0)) * OIN + 1024 + u.kvh * 64 + 8 * hh;
#pragma unroll
        for (int st = 0; st < 4; ++st) lk[it][st] = ok ? *(const u32x4*)(row + 16 * st) : z; }
}
__device__ __forceinline__ void attn_load_latv(Frame& F, const bf16* P1, AttnU u, u32x4 (&lv)[6]) {
    const u32x4 z = (u32x4){0u, 0u, 0u, 0u};
#pragma unroll
    for (int it = 0; it < 6; ++it) { const int task = F.tid + 512 * it, kidx = task >> 3, c8 = task & 7, pos = u.qb * 128 - 128 + kidx;
        const bool ok = pos >= 0 && pos < NSEQ;
        lv[it] = ok ? *(const u32x4*)(P1 + (size_t)(u.b * NSEQ + (ok ? pos : 0)) * OIN + 1152 + u.kvh * 64 + 8 * c8) : z; }
}
__device__ __forceinline__ void attn_write_lat(Frame& F, AttnU u, const u32x4 (&lk)[2][4], const u32x4 (&lv)[6]) {
    LAS bf16* KL = (LAS bf16*)F.lds; LAS bf16* VL = (LAS bf16*)(F.lds + VL_OFF); const LAS float* rope = (const LAS float*)(F.lds + ROPE_LDS);
#pragma unroll
    for (int it = 0; it < 2; ++it) { const int task = F.tid + 512 * it, kidx = task >> 1, hh = task & 1; int pos = u.qb * 128 - 128 + kidx; pos = pos < 0 ? 0 : (pos > NSEQ - 1 ? NSEQ - 1 : pos);
        if (task < 768) {
            LAS bf16* d = KL + kidx * KV_LD + 8 * hh;
            const LAS float* c0 = rope + (pos >> 6) * 16 + 8 * hh; const LAS float* c1 = rope + (pos & 63) * 16 + 8 * hh;
            *(LAS bf16x8*)(d) = rope_pack(lk[it][0], lk[it][1], c0, c0 + 1024, 1.0f, false);
            *(LAS bf16x8*)(d + 16) = rope_pack(lk[it][0], lk[it][1], c0, c0 + 1024, 1.0f, true);
            *(LAS bf16x8*)(d + 32) = rope_pack(lk[it][2], lk[it][3], c1, c1 + 1024, 1.0f, false);
            *(LAS bf16x8*)(d + 48) = rope_pack(lk[it][2], lk[it][3], c1, c1 + 1024, 1.0f, true);
        } }
#pragma unroll
    for (int it = 0; it < 6; ++it) { const int task = F.tid + 512 * it, kidx = task >> 3, c8 = task & 7; *(LAS u32x4*)(VL + kidx * KV_LD + 8 * c8) = lv[it]; }
}
__device__ __forceinline__ void attn_load_ctx(Frame& F, const bf16* P1, AttnU u, u32x4 (&ck)[4], u32x4 (&cv)[4]) {
#pragma unroll
    for (int it = 0; it < 4; ++it) { const int task = F.tid + 512 * it, kidx = task >> 3, c8 = task & 7;
        const bf16* row = P1 + (size_t)(TL + u.b * LCTX + kidx) * OIN + 1024 + u.kvh * 64 + 8 * c8;
        ck[it] = *(const u32x4*)row; cv[it] = *(const u32x4*)(row + 128); }
}
__device__ __forceinline__ void attn_write_ctx(Frame& F, const u32x4 (&ck)[4], const u32x4 (&cv)[4]) {
    LAS bf16* KL = (LAS bf16*)F.lds; LAS bf16* VL = (LAS bf16*)(F.lds + VL_OFF);
#pragma unroll
    for (int it = 0; it < 4; ++it) { const int task = F.tid + 512 * it, kidx = task >> 3, c8 = task & 7;
        *(LAS u32x4*)(KL + kidx * KV_LD + 8 * c8) = ck[it]; *(LAS u32x4*)(VL + kidx * KV_LD + 8 * c8) = cv[it]; }
}

__device__ __forceinline__ unsigned cvtpk(float lo, float hi) { unsigned r; asm volatile("v_cvt_pk_bf16_f32 %0, %1, %2" : "=v"(r) : "v"(lo), "v"(hi)); return r; }
__device__ __forceinline__ float xhalf_max(float x) { const auto r = __builtin_amdgcn_permlane32_swap(__builtin_bit_cast(unsigned, x), __builtin_bit_cast(unsigned, x), false, false);
    return fmaxf(__builtin_bit_cast(float, r[0]), __builtin_bit_cast(float, r[1])); }
__device__ __forceinline__ float xhalf_sum(float x) { const auto r = __builtin_amdgcn_permlane32_swap(__builtin_bit_cast(unsigned, x), __builtin_bit_cast(unsigned, x), false, false);
    return __builtin_bit_cast(float, r[0]) + __builtin_bit_cast(float, r[1]); }
__device__ __forceinline__ void attn_tiles(Frame& F, int kt0, int kt1, int mk0, int mk1, const bf16x8 (&qf)[4], f32x16 (&O)[2], float& mrun, float& lrun, int qrel) {
    if (kt0 > kt1) return;
    const LAS bf16* KL = (const LAS bf16*)F.lds; const LAS bf16* VL = (const LAS bf16*)(F.lds + VL_OFF);
    const int r32 = F.lane & 31, hh = F.lane >> 5;
    const int q4 = (F.lane & 15) >> 2, p4 = F.lane & 3, blk = (F.lane >> 4) & 1;
    const LAS bf16* kp = KL + (kt0 * 32 + r32) * KV_LD + 8 * hh;
    const LAS bf16* vp = VL + (kt0 * 32 + 4 * hh + q4) * KV_LD + 16 * blk + 4 * p4;
    bf16x8 kn[4];
#pragma unroll
    for (int st = 0; st < 4; ++st) kn[st] = *(const LAS bf16x8*)(kp + 16 * st);
    for (int kt = kt0; kt <= kt1; ++kt) {
        bf16x8 kf[4];
#pragma unroll
        for (int st = 0; st < 4; ++st) kf[st] = kn[st];
        v4i16_t vlo[2][2], vhi[2][2];
#pragma unroll
        for (int dt = 0; dt < 2; ++dt)
#pragma unroll
            for (int s2 = 0; s2 < 2; ++s2) { vlo[dt][s2] = __builtin_amdgcn_ds_read_tr16_b64_v4i16((LAS v4i16_t*)(vp + (16 * s2) * KV_LD + dt * 32));
                vhi[dt][s2] = __builtin_amdgcn_ds_read_tr16_b64_v4i16((LAS v4i16_t*)(vp + (16 * s2 + 8) * KV_LD + dt * 32)); }
        kp += 32 * KV_LD; vp += 32 * KV_LD;
        if (kt < kt1) {
#pragma unroll
            for (int st = 0; st < 4; ++st) kn[st] = *(const LAS bf16x8*)(kp + 16 * st); }
        __builtin_amdgcn_sched_barrier(0);
        f32x16 s;
#pragma unroll
        for (int r = 0; r < 16; ++r) s[r] = 0.f;
#pragma unroll
        for (int st = 0; st < 4; ++st) s = __builtin_amdgcn_mfma_f32_32x32x16_bf16(kf[st], qf[st], s, 0, 0, 0);
        if (kt == mk0 || kt == mk1) {
#pragma unroll
            for (int r = 0; r < 16; ++r) { const int dlt = kt * 32 + (r & 3) + 8 * (r >> 2) + 4 * hh - qrel; s[r] = (dlt <= 128 && dlt >= -128) ? s[r] : -INFINITY; } }
        float mx = fmaxf(fmaxf(s[0], s[1]), fmaxf(s[2], s[3]));
#pragma unroll
        for (int r = 4; r < 16; r += 4) mx = fmaxf(mx, fmaxf(fmaxf(s[r], s[r + 1]), fmaxf(s[r + 2], s[r + 3])));
        mx = xhalf_max(mx);
        const float mnew = fmaxf(mrun, mx);
        float ps0 = 0.f, ps1 = 0.f;
#pragma unroll
        for (int r = 0; r < 16; r += 2) { s[r] = __builtin_amdgcn_exp2f(s[r] - mnew); s[r + 1] = __builtin_amdgcn_exp2f(s[r + 1] - mnew); ps0 += s[r]; ps1 += s[r + 1]; }
        const float ps = xhalf_sum(ps0 + ps1);
        if (__any(mnew > mrun)) {
            const float alpha = __builtin_amdgcn_exp2f(mrun - mnew);
            lrun *= alpha;
#pragma unroll
            for (int dt = 0; dt < 2; ++dt)
#pragma unroll
                for (int r = 0; r < 16; ++r) O[dt][r] *= alpha;
        }
        lrun += ps; mrun = mnew;
        bf16x8 pb[2];
#pragma unroll
        for (int s2 = 0; s2 < 2; ++s2) { u32x4 w; w.x = cvtpk(s[8 * s2 + 0], s[8 * s2 + 1]); w.y = cvtpk(s[8 * s2 + 2], s[8 * s2 + 3]); w.z = cvtpk(s[8 * s2 + 4], s[8 * s2 + 5]); w.w = cvtpk(s[8 * s2 + 6], s[8 * s2 + 7]);
            pb[s2] = __builtin_bit_cast(bf16x8, w); }
#pragma unroll
        for (int dt = 0; dt < 2; ++dt)
#pragma unroll
            for (int s2 = 0; s2 < 2; ++s2) {
                const bf16x8 va = (bf16x8){vlo[dt][s2][0], vlo[dt][s2][1], vlo[dt][s2][2], vlo[dt][s2][3], vhi[dt][s2][0], vhi[dt][s2][1], vhi[dt][s2][2], vhi[dt][s2][3]};
                O[dt] = __builtin_amdgcn_mfma_f32_32x32x16_bf16(va, pb[s2], O[dt], 0, 0, 0);
            }
    }
}

__device__ __forceinline__ void phase_attn(Frame& F) {
    const bf16* P1 = (const bf16*)(F.ws + WS_BUFP);
    bf16* MIX = (bf16*)(F.ws + WS_BUFA);
    const int r32 = F.lane & 31, hh = F.lane >> 5;
    constexpr float QSC = 0.125f * 1.4426950408889634f;
    LAS float* ropel = (LAS float*)(F.lds + ROPE_LDS);
    for (int i = F.tid; i < 2048; i += 512) ropel[i] = ((const float*)(F.ws + WS_ROPE))[i];
    u32x4 lk[2][4], lv[6], ck[4], cv[4];
    const int nu = (512 - F.vcu + F.G - 1) / F.G;
    if (nu > 0) attn_load_latk(F, P1, attn_unit_of(F.vcu), lk);
    for (int ui = 0; ui < nu; ++ui) {
        const AttnU u = attn_unit_of(F.vcu + ui * F.G);
        u32x4 qr[2][4];
#pragma unroll
        for (int i = 0; i < 2; ++i) { const int task = F.wave + 8 * i, g = task & 3, sub = task >> 2, head = u.kvh * 4 + g, pos = u.qb * 128 + 32 * sub + r32;
            const bf16* row = P1 + (size_t)(u.b * NSEQ + pos) * OIN + 512 + head * 64 + 8 * hh;
#pragma unroll
            for (int st = 0; st < 4; ++st) qr[i][st] = __builtin_nontemporal_load((const u32x4*)(row + 16 * st)); }
        attn_load_latv(F, P1, u, lv);
        __syncthreads();
        attn_write_lat(F, u, lk, lv);
        bf16x8 qf[2][4]; f32x16 O[2][2]; float mrun[2], lrun[2];
#pragma unroll
        for (int i = 0; i < 2; ++i) { const int task = F.wave + 8 * i, g = task & 3, sub = task >> 2, head = u.kvh * 4 + g, pos = u.qb * 128 + 32 * sub + r32;
            const LAS float* c0 = ropel + (pos >> 6) * 16 + 8 * hh; const LAS float* c1 = ropel + (pos & 63) * 16 + 8 * hh;
            qf[i][0] = rope_pack(qr[i][0], qr[i][1], c0, c0 + 1024, QSC, false); qf[i][1] = rope_pack(qr[i][0], qr[i][1], c0, c0 + 1024, QSC, true);
            qf[i][2] = rope_pack(qr[i][2], qr[i][3], c1, c1 + 1024, QSC, false); qf[i][3] = rope_pack(qr[i][2], qr[i][3], c1, c1 + 1024, QSC, true);
            mrun[i] = F.in[I_OSINK][head] * 1.4426950408889634f; lrun[i] = 1.0f;
#pragma unroll
            for (int dt = 0; dt < 2; ++dt)
#pragma unroll
                for (int r = 0; r < 16; ++r) O[i][dt][r] = 0.f; }
        __syncthreads();
        const int kt_lo = (u.qb == 0) ? 4 : 0, kt_hi = (u.qb == 31) ? 7 : 11;
#pragma unroll
        for (int i = 0; i < 2; ++i) { const int sub = (F.wave + 8 * i) >> 2, qrel = 128 + 32 * sub + r32;
            attn_tiles(F, max(sub, kt_lo), min(sub + 8, kt_hi), sub, sub + 8, qf[i], O[i], mrun[i], lrun[i], qrel); }
        attn_load_ctx(F, P1, u, ck, cv);
        __syncthreads();
        attn_write_ctx(F, ck, cv);
        __syncthreads();
        if (ui + 1 < nu) attn_load_latk(F, P1, attn_unit_of(F.vcu + (ui + 1) * F.G), lk);
#pragma unroll
        for (int i = 0; i < 2; ++i) {
            attn_tiles(F, 0, 7, -1, -1, qf[i], O[i], mrun[i], lrun[i], 0);
            const int task = F.wave + 8 * i, g = task & 3, sub = task >> 2, head = u.kvh * 4 + g, pos = u.qb * 128 + 32 * sub + r32;
            const float inv = 1.0f / lrun[i];
            bf16* o = MIX + (size_t)(u.b * NSEQ + pos) * D + 512 + head * 64 + 4 * hh;
#pragma unroll
            for (int dt = 0; dt < 2; ++dt)
#pragma unroll
                for (int rg = 0; rg < 4; ++rg) {
                    if constexpr (FP8_OUT1) { const float i4 = inv * pg8::MIX1_SCALE; unsigned char* o8 = (unsigned char*)MIX + (size_t)(u.b * NSEQ + pos) * D + 512 + head * 64 + 4 * hh;
                        *(unsigned*)(o8 + dt * 32 + 8 * rg) = pg8::pk4_fp8(O[i][dt][4 * rg] * i4, O[i][dt][4 * rg + 1] * i4, O[i][dt][4 * rg + 2] * i4, O[i][dt][4 * rg + 3] * i4); }
                    else { u32x2 w; w.x = pk2(O[i][dt][4 * rg] * inv, O[i][dt][4 * rg + 1] * inv); w.y = pk2(O[i][dt][4 * rg + 2] * inv, O[i][dt][4 * rg + 3] * inv);
                    *(u32x2*)(o + dt * 32 + 8 * rg) = w; } }
        }
    }
    __syncthreads();
}

__device__ __forceinline__ void phase_pool_stencil(Frame& F) {
    const bf16* P1 = (const bf16*)(F.ws + WS_BUFP);
    bf16* MIX = (bf16*)(F.ws + WS_BUFA);
    const int gw = F.vcu * NWAVES + F.wave, NGW = F.G * NWAVES;
    const int r = 1 << (F.lane >> 4);
    constexpr int NT = 8, NR = NT + 16;
    for (int t = NT * gw; t < TL; t += NT * NGW) {
        const int pos = t & 4095;
        const bf16* base = P1 + (size_t)t * OIN + 8 * F.lane;
        u32x4 v[NR];
#pragma unroll
        for (int jj = 0; jj < NR; ++jj) { const int pj = pos + jj - 8; const bool ok = pj >= 0 && pj < NSEQ; v[jj] = ok ? *(const u32x4*)(base + (ptrdiff_t)(jj - 8) * OIN) : (u32x4){0u, 0u, 0u, 0u}; }
        float acc[NT][8];
#pragma unroll
        for (int q = 0; q < NT; ++q)
#pragma unroll
            for (int i = 0; i < 8; ++i) acc[q][i] = 0.f;
#pragma unroll
        for (int jj = 0; jj < NR; ++jj) {
            float x[8];
#pragma unroll
            for (int i = 0; i < 4; ++i) { x[2 * i] = bflo(v[jj][i]); x[2 * i + 1] = bfhi(v[jj][i]); }
#pragma unroll
            for (int q = 0; q < NT; ++q) { const int dd = jj - 8 - q; if (dd >= -8 && dd <= 8) { const float w = (dd <= r && dd >= -r) ? 1.0f : 0.0f;
#pragma unroll
                for (int i = 0; i < 8; ++i) acc[q][i] += w * x[i]; } }
        }
#pragma unroll
        for (int q = 0; q < NT; ++q) {
            const int pq = pos + q, lo = max(pq - r, 0), hi = min(pq + r + 1, NSEQ);
            const float ic = 1.0f / (float)(hi - lo);
            const u32x4 sv = v[q + 8];
            if constexpr (FP8_OUT1) {
                float y[8];
#pragma unroll
                for (int i = 0; i < 4; ++i) { y[2 * i] = __builtin_fminf(__builtin_fmaxf((acc[q][2 * i] * ic - bflo(sv[i])) * pg8::MIX1_SCALE, -448.0f), 448.0f); y[2 * i + 1] = __builtin_fminf(__builtin_fmaxf((acc[q][2 * i + 1] * ic - bfhi(sv[i])) * pg8::MIX1_SCALE, -448.0f), 448.0f); }
                u32x2 o8; o8.x = pg8::pk4_fp8(y[0], y[1], y[2], y[3]); o8.y = pg8::pk4_fp8(y[4], y[5], y[6], y[7]);
                *(u32x2*)((unsigned char*)MIX + (size_t)(t + q) * D + 8 * F.lane) = o8;
            } else {
            u32x4 o;
#pragma unroll
            for (int i = 0; i < 4; ++i) o[i] = pk2(acc[q][2 * i] * ic - bflo(sv[i]), acc[q][2 * i + 1] * ic - bfhi(sv[i]));
            *(u32x4*)(MIX + (size_t)(t + q) * D + 8 * F.lane) = o; }
        }
    }
}

__device__ __forceinline__ void phase_attn_pool(Frame& F) {
    phase_attn(F);
#ifdef DBG_ATTN2
    phase_attn(F);
#endif
    phase_pool_stencil(F);
    __syncthreads();
    convert_l1_range(F, 120 * L1T_N + F.vcu * L1A_N, L1A_N, 40);
}

constexpr int NPHASE = 20;
__global__ void __launch_bounds__(NWAVES * 64, 2) mk_fwd(Args args) {
    extern __shared__ __attribute__((aligned(16))) unsigned char lds_raw[];
    Frame F;
    F.lds = (LAS unsigned char*)lds_raw;
    F.tid = threadIdx.x; F.lane = F.tid & 63; F.wave = __builtin_amdgcn_readfirstlane(F.tid >> 6);
    F.G = gridDim.x; { const int bx = blockIdx.x; F.vcu = (F.G % 8 == 0) ? (bx % 8) * (F.G / 8) + bx / 8 : bx; }
    F.ws = args.ws; F.in = args.in; F.out = args.out;
    for (int u = F.tid; u < (LDS_BYTES - LDS_CTL) / 4; u += NWAVES * 64) ((LAS unsigned*)(F.lds + LDS_CTL))[u] = 0u;
    __syncthreads();
    const int lo = args.ph_lo, hi = args.ph_hi;
    XcdBarrier bar; bar.bar = (unsigned*)(F.ws + WS_CTL); bar.x = 0; bar.st = nullptr;
    if (hi - lo > 1) bar = xcd_barrier_post((unsigned*)(F.ws + WS_CTL), (volatile LAS unsigned*)(F.lds + LDS_CTL));
    if (F.tid == 0) { *((unsigned*)(F.ws + WS_XCDOF) + F.vcu) = xb_xcc_id(); *(LAS int*)(F.lds + LDS_CTL + 52) = (hi - lo > 1) ? 1 : 0; }
#define IN(k) (lo <= (k) && (k) < hi)
#ifndef PHASE_MASK
#define PHASE_MASK 0xffffffffu
#endif
#define PH(k, ...) if constexpr (((PHASE_MASK >> (k)) & 1u) != 0u) if (IN(k)) { { int t_ = F.tid; asm volatile("" : "+v"(t_)); F.tid = t_; F.lane = t_ & 63; } __VA_ARGS__ if constexpr (((DBG_DOUBLE >> (k)) & 1u) != 0u) { __VA_ARGS__ } }
#define SEAM(k) do { if (IN(k) && IN((k) + 1)) xcd_barrier(bar); } while (0)
    unsigned char* ws = F.ws;
    const float* mods = (const float*)(ws + WS_MODS);

    PH(1, { phase_prologue_a(F); }) SEAM(1);
    PH(2, {
        pg8::SchedDense S{(const char*)(ws + WS_BUFA), (const char*)(ws + WS_W_EIN), 1024, 8, 136, 0, 1088, F.vcu, F.G};
        pg8::EpiStore E{(bf16*)(ws + WS_BUFP), EIN};
        pg8::gemm_phase<pg8::EpiStore, pg8::SchedDense>(F.lds, 1024, S, E);
        if (F.vcu >= 64) { __syncthreads(); convert_l1_range(F, (F.vcu - 64) * L0T_N, L0T_N, 48, 0); }
    }) SEAM(2);
    PH(3, { phase_fourier_a_conv(F); })
    PH(4, { phase_fourier_c(F); }) SEAM(4);
    PH(5, {
        const int xs = F.vcu >> 5, rs = F.vcu & 31; const bool heavy = rs >= 28;
        if constexpr (FP8_OUT0 != 0) {
            pg8::SchedSplit S{(const char*)(ws + WS_BUFA), (const char*)(ws + WS_W_EOUT), 512, heavy ? 448 + 4 * xs + (rs - 28) : 28 * xs + rs, heavy ? 32 : 224, heavy ? 3 : 2};
            pg8::EpiResid<true> E{F.in[I_X], F.in[I_CTX], (bf16*)(ws + WS_HB), mods + 2 * 1024, 1.0f / (pg8::W1_SCALE * pg8::MIX0_SCALE)};
            pg8::gemm_phase<pg8::EpiResid<true>, pg8::SchedSplit, true>(F.lds, 512, S, E);
        } else {
        pg8::SchedSplit S{(const char*)(ws + WS_BUFA), (const char*)(ws + WS_W_EOUT), 1024, heavy ? 448 + 4 * xs + (rs - 28) : 28 * xs + rs, heavy ? 32 : 224, heavy ? 3 : 2};
        pg8::EpiResid<true> E{F.in[I_X], F.in[I_CTX], (bf16*)(ws + WS_HB), mods + 2 * 1024};
        pg8::gemm_phase<pg8::EpiResid<true>, pg8::SchedSplit>(F.lds, 1024, S, E); }
        ctr_publish(F, heavy ? WS_P5C : WS_P5F, heavy ? 2 : 1, xcd_census(F, [&](int v) { return ((v & 31) >= 28) == heavy; }));
    })
    PH(6, { phase_route<true>(F, 0, T); }) SEAM(6);
    PH(7, {
        const int ntile = moe_tables(F, 0);
        const int Lg = ntile & 63; const bool isLong = (F.vcu >> 2) < Lg;
        const unsigned nxc = xcd_census(F, [&](int v) { return ((v >> 2) < Lg) == isLong; });
        if constexpr (FP8_G1_L0) {
            pg8::SchedMoe<true> S{(const char*)(ws + WS_BUFA), (const char*)(ws + WS_W_M1) + (size_t)0 * 32 * MiB, (const int*)(ws + WS_TOKMAP), (const LAS int*)(F.lds + LDS_CTL + 64), (const LAS int*)(F.lds + LDS_CTL + 192), 512, (size_t)MiB, ntile * 4, F.vcu, F.G};
            pg8::EpiSwiglu8 E{(unsigned char*)(ws + WS_BUFZ), pg8::W1_SCALE};
            pg8::gemm_phase<pg8::EpiSwiglu8, pg8::SchedMoe<true>, true>(F.lds, 512, S, E);
        } else {
            pg8::SchedMoe<true> S{(const char*)(ws + WS_BUFA), (const char*)(ws + WS_W_M1) + (size_t)0 * 32 * MiB, (const int*)(ws + WS_TOKMAP), (const LAS int*)(F.lds + LDS_CTL + 64), (const LAS int*)(F.lds + LDS_CTL + 192), 1024, (size_t)2 * MiB, ntile * 4, F.vcu, F.G};
            if constexpr (FP8_G2_L0) { pg8::EpiSwiglu8 E{(unsigned char*)(ws + WS_BUFZ), 1.0f}; pg8::gemm_phase<pg8::EpiSwiglu8, pg8::SchedMoe<true>>(F.lds, 1024, S, E); }
            else { pg8::EpiSwiglu E{(bf16*)(ws + WS_BUFZ)}; pg8::gemm_phase<pg8::EpiSwiglu, pg8::SchedMoe<true>>(F.lds, 1024, S, E); }
        }
        ctr_publish(F, WS_G1CNT + (size_t)(0 * 2 + (isLong ? 1 : 0)) * 256, 3 + 0 * 2 + (isLong ? 1 : 0), nxc);
    })
    PH(8, {
        const int ntile = moe_tables(F, 0);
        const int Rp = ntile >> 6, Lg = ntile & 63, grp = F.vcu >> 2; const bool isLong = grp < Lg;
        const size_t cnt0 = WS_G1CNT + (size_t)(0 * 2) * 256;
        ctr_wait(F, cnt0 + (isLong ? 256 : 0), (unsigned)(isLong ? 4 * Lg : 256 - 4 * Lg));
        if constexpr (FP8_G2_L0) {
            { pg8::EpiStoreF8 E{(unsigned char*)(ws + WS_BUFP), 1024, pg8::OS_SCALE / (pg8::HID_SCALE * pg8::W2_SCALE)};
              pg8::SchedMoe<false> S{(const char*)(ws + WS_BUFZ), (const char*)(ws + WS_W_M2) + (size_t)0 * 16 * MiB, nullptr, (const LAS int*)(F.lds + LDS_CTL + 64), (const LAS int*)(F.lds + LDS_CTL + 192), 256, (size_t)512 * KiB, Rp * 256, F.vcu, F.G};
              pg8::gemm_phase<pg8::EpiStoreF8, pg8::SchedMoe<false>, true>(F.lds, 256, S, E); }
            const int nt2 = __builtin_amdgcn_readfirstlane(*(const LAS int*)(F.lds + LDS_CTL + 64 + 64)), Lg2 = nt2 & 63, grp2 = F.vcu >> 2;
            int xc = -1;
            if (grp2 < Lg2) { if (63 - grp2 < Lg2) xc = F.vcu; }
            else if (63 - grp2 < Lg2) xc = 4 * (63 - grp2) + (F.vcu & 3);
            if (xc >= 0) {
                if (grp2 >= Lg2) ctr_wait(F, WS_G1CNT + (size_t)(0 * 2 + 1) * 256, (unsigned)(4 * Lg2));
                pg8::EpiStoreF8 E{(unsigned char*)(ws + WS_BUFP), 1024, pg8::OS_SCALE / (pg8::HID_SCALE * pg8::W2_SCALE)};
                pg8::SchedMoe<false> S{(const char*)(ws + WS_BUFZ), (const char*)(ws + WS_W_M2) + (size_t)0 * 16 * MiB, nullptr, (const LAS int*)(F.lds + LDS_CTL + 64), (const LAS int*)(F.lds + LDS_CTL + 192), 256, (size_t)512 * KiB, nt2 * 4, (nt2 >> 6) * 256 + xc, 1 << 20};
                pg8::gemm_phase<pg8::EpiStoreF8, pg8::SchedMoe<false>, true>(F.lds, 256, S, E);
            }
        } else {
            if (Lg > 0 && Lg < 64) ctr_wait(F, cnt0 + (isLong ? 0 : 256), (unsigned)(isLong ? 256 - 4 * Lg : 4 * Lg));
            pg8::SchedMoe<false> S{(const char*)(ws + WS_BUFZ), (const char*)(ws + WS_W_M2) + (size_t)0 * 16 * MiB, nullptr, (const LAS int*)(F.lds + LDS_CTL + 64), (const LAS int*)(F.lds + LDS_CTL + 192), 512, (size_t)MiB, ntile * 4, F.vcu, F.G};
            pg8::EpiStore E{(bf16*)(ws + WS_BUFP), 1024};
            pg8::gemm_phase<pg8::EpiStore, pg8::SchedMoe<false>>(F.lds, 512, S, E);
        }
    }) SEAM(8);
    PH(9, { (void)moe_tables(F, 0); phase_combine(F, 0, T); }) SEAM(9);
    PH(10, {
        if constexpr (FP8_IN1) {
            pg8::SchedDense S{(const char*)(ws + WS_BUFA), (const char*)(ws + WS_W_OIN), 512, 5, 128, 4, 648, F.vcu, F.G};
            pg8::EpiStoreS E{(bf16*)(ws + WS_BUFP), OIN, 1.0f / pg8::W1_SCALE};
            pg8::gemm_phase<pg8::EpiStoreS, pg8::SchedDense, true>(F.lds, 512, S, E);
        } else {
        pg8::SchedDense S{(const char*)(ws + WS_BUFA), (const char*)(ws + WS_W_OIN), 1024, 5, 128, 4, 648, F.vcu, F.G};
        pg8::EpiStore E{(bf16*)(ws + WS_BUFP), OIN};
        pg8::gemm_phase<pg8::EpiStore, pg8::SchedDense>(F.lds, 1024, S, E); }
        if (F.vcu >= 136) { __syncthreads(); convert_l1_range(F, (F.vcu - 136) * L1T_N, L1T_N, 44); }
    }) SEAM(10);
    PH(11, { phase_attn_pool(F); }) SEAM(11);
    PH(12, {
        if constexpr (FP8_OUT1) {
            pg8::SchedDense S{(const char*)(ws + WS_BUFA), (const char*)(ws + WS_W_OOUT), 512, 4, 128, 0, 512, F.vcu, F.G};
            pg8::EpiResid<false> E{nullptr, nullptr, (bf16*)(ws + WS_HB), mods + 9 * 6144 + 2 * 1024, 1.0f / (pg8::W1_SCALE * pg8::MIX1_SCALE)};
            pg8::gemm_phase<pg8::EpiResid<false>, pg8::SchedDense, true>(F.lds, 512, S, E);
        } else {
        pg8::SchedDense S{(const char*)(ws + WS_BUFA), (const char*)(ws + WS_W_OOUT), 1024, 4, 128, 0, 512, F.vcu, F.G};
        pg8::EpiResid<false> E{nullptr, nullptr, (bf16*)(ws + WS_HB), mods + 9 * 6144 + 2 * 1024};
        pg8::gemm_phase<pg8::EpiResid<false>, pg8::SchedDense>(F.lds, 1024, S, E); }
    }) SEAM(12);
    PH(13, { phase_route<false>(F, 1, TL); }) SEAM(13);
    PH(14, {
        const int ntile = moe_tables(F, 1);
        const int Lg = ntile & 63; const bool isLong = (F.vcu >> 2) < Lg;
        const unsigned nxc = xcd_census(F, [&](int v) { return ((v >> 2) < Lg) == isLong; });
        if constexpr (FP8_G1_L1) {
            pg8::SchedMoe<true> S{(const char*)(ws + WS_BUFA), (const char*)(ws + WS_W_M1) + (size_t)1 * 32 * MiB, (const int*)(ws + WS_TOKMAP), (const LAS int*)(F.lds + LDS_CTL + 64), (const LAS int*)(F.lds + LDS_CTL + 192), 512, (size_t)MiB, ntile * 4, F.vcu, F.G};
            pg8::EpiSwiglu8 E{(unsigned char*)(ws + WS_BUFZ), pg8::W1_SCALE};
            pg8::gemm_phase<pg8::EpiSwiglu8, pg8::SchedMoe<true>, true>(F.lds, 512, S, E);
        } else {
            pg8::SchedMoe<true> S{(const char*)(ws + WS_BUFA), (const char*)(ws + WS_W_M1) + (size_t)1 * 32 * MiB, (const int*)(ws + WS_TOKMAP), (const LAS int*)(F.lds + LDS_CTL + 64), (const LAS int*)(F.lds + LDS_CTL + 192), 1024, (size_t)2 * MiB, ntile * 4, F.vcu, F.G};
            if constexpr (FP8_G2_L1) { pg8::EpiSwiglu8 E{(unsigned char*)(ws + WS_BUFZ), 1.0f}; pg8::gemm_phase<pg8::EpiSwiglu8, pg8::SchedMoe<true>>(F.lds, 1024, S, E); }
            else { pg8::EpiSwiglu E{(bf16*)(ws + WS_BUFZ)}; pg8::gemm_phase<pg8::EpiSwiglu, pg8::SchedMoe<true>>(F.lds, 1024, S, E); }
        }
        ctr_publish(F, WS_G1CNT + (size_t)(1 * 2 + (isLong ? 1 : 0)) * 256, 3 + 1 * 2 + (isLong ? 1 : 0), nxc);
    })
    PH(15, {
        const int ntile = moe_tables(F, 1);
        const int Rp = ntile >> 6, Lg = ntile & 63, grp = F.vcu >> 2; const bool isLong = grp < Lg;
        const size_t cnt0 = WS_G1CNT + (size_t)(1 * 2) * 256;
        ctr_wait(F, cnt0 + (isLong ? 256 : 0), (unsigned)(isLong ? 4 * Lg : 256 - 4 * Lg));
        if constexpr (FP8_G2_L1) {
            { pg8::EpiStoreF8 E{(unsigned char*)(ws + WS_BUFP), 1024, pg8::OS_SCALE / (pg8::HID_SCALE * pg8::W2_SCALE)};
              pg8::SchedMoe<false> S{(const char*)(ws + WS_BUFZ), (const char*)(ws + WS_W_M2) + (size_t)1 * 16 * MiB, nullptr, (const LAS int*)(F.lds + LDS_CTL + 64), (const LAS int*)(F.lds + LDS_CTL + 192), 256, (size_t)512 * KiB, Rp * 256, F.vcu, F.G};
              pg8::gemm_phase<pg8::EpiStoreF8, pg8::SchedMoe<false>, true>(F.lds, 256, S, E); }
            const int nt2 = __builtin_amdgcn_readfirstlane(*(const LAS int*)(F.lds + LDS_CTL + 64 + 64)), Lg2 = nt2 & 63, grp2 = F.vcu >> 2;
            int xc = -1;
            if (grp2 < Lg2) { if (63 - grp2 < Lg2) xc = F.vcu; }
            else if (63 - grp2 < Lg2) xc = 4 * (63 - grp2) + (F.vcu & 3);
            if (xc >= 0) {
                if (grp2 >= Lg2) ctr_wait(F, WS_G1CNT + (size_t)(1 * 2 + 1) * 256, (unsigned)(4 * Lg2));
                pg8::EpiStoreF8 E{(unsigned char*)(ws + WS_BUFP), 1024, pg8::OS_SCALE / (pg8::HID_SCALE * pg8::W2_SCALE)};
                pg8::SchedMoe<false> S{(const char*)(ws + WS_BUFZ), (const char*)(ws + WS_W_M2) + (size_t)1 * 16 * MiB, nullptr, (const LAS int*)(F.lds + LDS_CTL + 64), (const LAS int*)(F.lds + LDS_CTL + 192), 256, (size_t)512 * KiB, nt2 * 4, (nt2 >> 6) * 256 + xc, 1 << 20};
                pg8::gemm_phase<pg8::EpiStoreF8, pg8::SchedMoe<false>, true>(F.lds, 256, S, E);
            }
        } else {
            if (Lg > 0 && Lg < 64) ctr_wait(F, cnt0 + (isLong ? 0 : 256), (unsigned)(isLong ? 256 - 4 * Lg : 4 * Lg));
            pg8::SchedMoe<false> S{(const char*)(ws + WS_BUFZ), (const char*)(ws + WS_W_M2) + (size_t)1 * 16 * MiB, nullptr, (const LAS int*)(F.lds + LDS_CTL + 64), (const LAS int*)(F.lds + LDS_CTL + 192), 512, (size_t)MiB, ntile * 4, F.vcu, F.G};
            pg8::EpiStore E{(bf16*)(ws + WS_BUFP), 1024};
            pg8::gemm_phase<pg8::EpiStore, pg8::SchedMoe<false>>(F.lds, 512, S, E);
        }
    }) SEAM(15);
    PH(16, { (void)moe_tables(F, 1); phase_combine(F, 1, TL); }) SEAM(16);
#ifdef DBG_XBAR
    if (hi - lo > 1) { for (int xb = 0; xb < DBG_XBAR; ++xb) xcd_barrier(bar); }
#endif
#undef IN
#undef SEAM
}

extern "C" void kernel_launch(void* const* d_in, const int* in_sizes, int n_in, void* d_out, int out_size, void* d_ws, size_t ws_size, hipStream_t stream) {
    static int grid = 0;
    if (grid == 0) {
        if (n_in != 22 || ws_size < WS_END) { fprintf(stderr, "kernel_launch: unexpected inputs (n_in %d, ws %zu)\n", n_in, ws_size); grid = -1; return; }
        int dev = 0, cus = 0, per_cu = 0;
        if (hipGetDevice(&dev) != hipSuccess || hipDeviceGetAttribute(&cus, hipDeviceAttributeMultiprocessorCount, dev) != hipSuccess) { grid = -1; return; }
        if (hipFuncSetAttribute((const void*)mk_fwd, hipFuncAttributeMaxDynamicSharedMemorySize, LDS_BYTES) != hipSuccess) { fprintf(stderr, "kernel_launch: hipFuncSetAttribute failed\n"); grid = -1; return; }
        if (hipOccupancyMaxActiveBlocksPerMultiprocessor(&per_cu, (const void*)mk_fwd, NWAVES * 64, LDS_BYTES) != hipSuccess || per_cu < 1) { fprintf(stderr, "kernel_launch: occupancy query says %d\n", per_cu); }
        (void)hipGetLastError();
        grid = cus;
        if (grid != 256) { fprintf(stderr, "kernel_launch: %d CUs; this build assumes 256\n", grid); }
    }
    if (grid < 0) return;
    (void)hipMemsetAsync((char*)d_ws + WS_CTL, 0, CTL_ZERO_BYTES, stream);
    Args a{};
    for (int i = 0; i < 22; ++i) a.in[i] = (const float*)d_in[i];
    a.out = (float*)d_out; a.ws = (unsigned char*)d_ws;
#if MK_MULTI
    for (int p = 0; p <= DBG_STOP; ++p) { a.ph_lo = p; a.ph_hi = p + 1; hipLaunchKernelGGL(mk_fwd, dim3(grid), dim3(NWAVES * 64), LDS_BYTES, stream, a); }
    if (DBG_STOP < 16) { a.ph_lo = 17; a.ph_hi = 18; hipLaunchKernelGGL(mk_fwd, dim3(grid), dim3(NWAVES * 64), LDS_BYTES, stream, a); }
#else
    a.ph_lo = 0; a.ph_hi = 17;
    hipLaunchKernelGGL(mk_fwd, dim3(grid), dim3(NWAVES * 64), LDS_BYTES, stream, a);
#endif
}
```
